# Optimizing an MI355X kernel written in HIP

```python
import jax, jax.numpy as jnp
from jax import lax
import numpy as np

D_MODEL = 1024
BATCH = 8
SEQ = 2048
DEPTH = 2

MIX_WIDTH = D_MODEL // 2
N_BRANCH = 3
A_HEAD_DIM = 64
A_HEADS = MIX_WIDTH // A_HEAD_DIM
A_WIDTH = A_HEADS * A_HEAD_DIM
A_RANK_W = 64
A_RANK_A = 64
A_RANK_G = 128
A_GN_EPS = 64e-5
B_KEY_DIM = 128
B_VAL_DIM = 128
B_HEADS = MIX_WIDTH // B_VAL_DIM
B_WIDTH = B_HEADS * B_VAL_DIM
B_CHUNK = 64
C_HEAD_DIM = 64
C_HEADS = MIX_WIDTH // C_HEAD_DIM
C_KV_HEADS = 2
C_WIDTH = C_HEADS * C_HEAD_DIM
IDX_HEADS = 4
IDX_DIM = C_HEAD_DIM
TOPK_MAX = 256
Q_BLOCK = 128
ROPE_THETA = 10000.0
D_FF = 2816
CONV_WIDTH = 3
NORM_EPS = 1e-6

A_COLS = 3 * A_WIDTH + A_RANK_W + A_RANK_A + A_RANK_G
B_COLS = 4 * B_WIDTH
C_COLS = C_WIDTH + 2 * C_KV_HEADS * C_HEAD_DIM + IDX_HEADS * IDX_DIM + IDX_DIM + IDX_HEADS
GATE_COLS = N_BRANCH * D_MODEL
IN_COLS = A_COLS + B_COLS + C_COLS + GATE_COLS

kernel_name = 'hybrid_rwkv7_hgrn2_dsa_block'

F32 = jnp.float32


def _split(t, sizes):
    out, start = [], 0
    for s in sizes:
        out.append(t[..., start:start + s])
        start += s
    return out


def rms_norm(x, g):
    xf = x.astype(F32)
    y = xf * lax.rsqrt(jnp.mean(xf * xf, axis=-1, keepdims=True) + NORM_EPS)
    return (y * g.astype(F32)).astype(x.dtype)


def token_shift(p):
    return jnp.pad(p, ((0, 0), (1, 0), (0, 0)))[:, :-1]


def rope_tables(seq, dim):
    half = dim // 2
    inv_freq = ROPE_THETA ** (-jnp.arange(half, dtype=F32) * (2.0 / dim))
    ang = jnp.arange(seq, dtype=F32)[:, None] * inv_freq[None, :]
    return jnp.cos(ang), jnp.sin(ang)


def apply_rope(t, cos, sin):
    half = t.shape[-1] // 2
    tf = t.astype(F32)
    t1, t2 = tf[..., :half], tf[..., half:]
    c, s = cos[None, :, None, :], sin[None, :, None, :]
    return jnp.concatenate([t1 * c - t2 * s, t2 * c + t1 * s], axis=-1).astype(t.dtype)


def rwkv7_scan(r, w, k, v, a, b):
    bsz, _, heads, n = r.shape

    def step(state, inp):
        r_t, w_t, k_t, v_t, a_t, b_t = inp
        sa = jnp.einsum('bhij,bhj->bhi', state, a_t)
        state = (state * w_t[:, :, None, :] + sa[..., None] * b_t[:, :, None, :]
                 + v_t[..., None] * k_t[:, :, None, :])
        return state, jnp.einsum('bhij,bhj->bhi', state, r_t)

    xs = tuple(jnp.moveaxis(t, 1, 0) for t in (r, w, k, v, a, b))
    _, ys = lax.scan(step, jnp.zeros((bsz, heads, n, n), F32), xs)
    return jnp.moveaxis(ys, 0, 1)


def rwkv7_branch(p, mu, w0, w_up, a0, a_up, g_up, k_k, k_a, r_k, gn_g, gn_b):
    bsz, seq, _ = p.shape
    p = p + (token_shift(p) - p) * mu
    r, k, v, wd, ad, gd = _split(p, (A_WIDTH, A_WIDTH, A_WIDTH, A_RANK_W, A_RANK_A, A_RANK_G))
    w_log = -jax.nn.softplus(-(w0 + jnp.tanh(wd) @ w_up).astype(F32)) - 0.5
    decay = jnp.exp(-jnp.exp(w_log))
    a = jax.nn.sigmoid((a0 + ad @ a_up).astype(F32))
    g = jax.nn.sigmoid(gd) @ g_up

    def hd(t):
        return t.astype(F32).reshape(bsz, seq, A_HEADS, A_HEAD_DIM)

    kk = hd(k * k_k)
    kk = kk * lax.rsqrt(jnp.maximum(jnp.sum(kk * kk, axis=-1, keepdims=True), 1e-24))
    k_mod = hd(k.astype(F32) * (1.0 + (a - 1.0) * k_a.astype(F32)))
    r_h, v_h, a_h = hd(r), hd(v), hd(a)
    y = rwkv7_scan(r_h, hd(decay), k_mod, v_h, -kk, kk * a_h)
    mean = jnp.mean(y, axis=-1, keepdims=True)
    var = jnp.mean(jnp.square(y - mean), axis=-1, keepdims=True)
    y = ((y - mean) * lax.rsqrt(var + A_GN_EPS)).reshape(bsz, seq, A_WIDTH)
    y = y * gn_g.astype(F32) + gn_b.astype(F32)
    bonus = jnp.sum(r_h * k_mod * r_k.astype(F32), axis=-1, keepdims=True) * v_h
    y = y + bonus.reshape(bsz, seq, A_WIDTH)
    return (y * g.astype(F32)).astype(p.dtype)


def hgrn2_chunk_step(state, inp):
    q, k, g, v = inp
    b = jnp.cumsum(g, axis=2)
    causal = jnp.tril(jnp.ones((B_CHUNK, B_CHUNK), dtype=bool))
    diff = b[:, :, :, None, :] - b[:, :, None, :, :]
    decay = jnp.exp(jnp.where(causal[:, :, None], diff, -jnp.inf))
    scores = jnp.einsum('bhtd,bhsd,bhtsd->bhts', q, k, decay)
    o = (jnp.einsum('bhts,bhsv->bhtv', scores, v)
         + jnp.einsum('bhtd,bhdv->bhtv', q * jnp.exp(b), state))
    b_end = b[:, :, -1:, :]
    state = (state * jnp.exp(b_end)[:, :, 0, :, None]
             + jnp.einsum('bhsd,bhsv->bhdv', k * jnp.exp(b_end - b), v))
    return state, o


def hgrn2_branch(p, lb, gn_g):
    bsz, seq, _ = p.shape
    q, f, i, g = _split(p, (B_WIDTH, B_WIDTH, B_WIDTH, B_WIDTH))
    f = f.astype(F32)
    lb = lb.astype(F32)
    log_f = jnp.logaddexp(jnp.log(lb), jnp.log1p(-lb) + jax.nn.log_sigmoid(f))
    k_in = (1.0 - lb) * jax.nn.sigmoid(-f)
    n_chunk = seq // B_CHUNK

    def chunks(t, d):
        return t.astype(F32).reshape(bsz, n_chunk, B_CHUNK, B_HEADS, d).transpose(1, 0, 3, 2, 4)

    s0 = jnp.zeros((bsz, B_HEADS, B_KEY_DIM, B_VAL_DIM), F32)
    _, o = lax.scan(hgrn2_chunk_step, s0,
                    (chunks(q, B_KEY_DIM), chunks(k_in, B_KEY_DIM),
                     chunks(log_f, B_KEY_DIM), chunks(i, B_VAL_DIM)))
    o = o.transpose(1, 0, 3, 2, 4).reshape(bsz, seq, B_HEADS, B_VAL_DIM)
    o = o * lax.rsqrt(jnp.mean(o * o, axis=-1, keepdims=True) + NORM_EPS)
    o = o.reshape(bsz, seq, B_WIDTH) * gn_g.astype(F32) * jax.nn.silu(g.astype(F32))
    return o.astype(p.dtype)


def dsa_branch(p, cos, sin):
    bsz, seq, _ = p.shape
    kv_w = C_KV_HEADS * C_HEAD_DIM
    q, k, v, qi, ki, wi = _split(p, (C_WIDTH, kv_w, kv_w, IDX_HEADS * IDX_DIM, IDX_DIM, IDX_HEADS))
    q = apply_rope(q.reshape(bsz, seq, C_HEADS, C_HEAD_DIM), cos, sin)
    k = apply_rope(k.reshape(bsz, seq, C_KV_HEADS, C_HEAD_DIM), cos, sin)
    v = v.reshape(bsz, seq, C_KV_HEADS, C_HEAD_DIM)
    qi = apply_rope(qi.reshape(bsz, seq, IDX_HEADS, IDX_DIM), cos, sin)
    ki = apply_rope(ki[:, :, None, :], cos, sin)[:, :, 0, :].astype(F32)
    wi = wi.astype(F32) * (IDX_HEADS ** -0.5) * (IDX_DIM ** -0.5)
    n_blk = seq // Q_BLOCK
    k_sel = min(TOPK_MAX, seq // 4)
    group = C_HEADS // C_KV_HEADS
    s_pos = jnp.arange(seq)

    def blockify(t):
        return jnp.moveaxis(t.reshape(bsz, n_blk, Q_BLOCK, *t.shape[2:]), 1, 0)

    def attend(args):
        qb, qib, wib, t0 = args
        t_pos = t0 + jnp.arange(Q_BLOCK)
        causal = s_pos[None, :] <= t_pos[:, None]
        dots = jnp.einsum('bqhd,bsd->bqhs', qib.astype(F32), ki)
        score = jnp.einsum('bqhs,bqh->bqs', jax.nn.relu(dots), wib)
        score = jnp.where(causal[None], score, -jnp.inf)
        _, idx = lax.top_k(score, k_sel)
        kg = jax.vmap(lambda kb, ib: kb[ib])(k, idx)
        vg = jax.vmap(lambda vb, ib: vb[ib])(v, idx)
        valid = idx <= t_pos[None, :, None]
        qg = qb.reshape(bsz, Q_BLOCK, C_KV_HEADS, group, C_HEAD_DIM)
        logits = jnp.einsum('bqcgd,bqkcd->bqcgk', qg, kg).astype(F32) * (C_HEAD_DIM ** -0.5)
        logits = jnp.where(valid[:, :, None, None, :], logits, -jnp.inf)
        prob = jax.nn.softmax(logits, axis=-1).astype(vg.dtype)
        out = jnp.einsum('bqcgk,bqkcd->bqcgd', prob, vg)
        return out.reshape(bsz, Q_BLOCK, C_WIDTH)

    outs = lax.map(attend, (blockify(q), blockify(qi), blockify(wi),
                            jnp.arange(n_blk, dtype=jnp.int32) * Q_BLOCK))
    return jnp.moveaxis(outs, 0, 1).reshape(bsz, seq, C_WIDTH).astype(p.dtype)


def conv_glu(h, w_up, conv_w, conv_b, w_down):
    seq = h.shape[1]
    up = h @ w_up
    up_pad = jnp.pad(up, ((0, 0), (CONV_WIDTH - 1, 0), (0, 0)))
    c = conv_b
    for j in range(CONV_WIDTH):
        c = c + conv_w[j] * up_pad[:, j:j + seq]
    gate, val = _split(c, (D_FF, D_FF))
    return (jax.nn.silu(gate) * val) @ w_down


def setup_inputs(seed: int = 0) -> dict:
    key = jax.random.key(seed)
    ks = iter(jax.random.split(key, 32))

    def nrm(shape, scale):
        return jax.random.normal(next(ks), shape, F32) * scale

    def uni(shape, lo, hi):
        return jax.random.uniform(next(ks), shape, F32, lo, hi)

    f2 = 2 * D_FF
    return {
        'x': nrm((BATCH, SEQ, D_MODEL), 1.0),
        'norm_mix_g': 1.0 + nrm((DEPTH, D_MODEL), 0.02),
        'w_in': nrm((DEPTH, D_MODEL, IN_COLS), D_MODEL ** -0.5),
        'a_mu': uni((DEPTH, A_COLS), 0.0, 1.0),
        'a_w0': uni((DEPTH, A_WIDTH), -5.0, 0.0),
        'a_w_up': nrm((DEPTH, A_RANK_W, A_WIDTH), 0.5 * A_RANK_W ** -0.5),
        'a_a0': nrm((DEPTH, A_WIDTH), 0.5),
        'a_a_up': nrm((DEPTH, A_RANK_A, A_WIDTH), 0.5 * A_RANK_A ** -0.5),
        'a_g_up': nrm((DEPTH, A_RANK_G, A_WIDTH), A_RANK_G ** -0.5),
        'a_k_k': 0.85 + nrm((DEPTH, A_WIDTH), 0.05),
        'a_k_a': 1.0 + nrm((DEPTH, A_WIDTH), 0.05),
        'a_r_k': nrm((DEPTH, A_HEADS, A_HEAD_DIM), 0.1),
        'a_gn_g': 1.0 + nrm((DEPTH, A_WIDTH), 0.02),
        'a_gn_b': nrm((DEPTH, A_WIDTH), 0.02),
        'b_lb_logits': nrm((DEPTH, B_HEADS * B_KEY_DIM), 1.0),
        'b_gn_g': 1.0 + nrm((DEPTH, B_WIDTH), 0.02),
        'w_branch': nrm((DEPTH, N_BRANCH, MIX_WIDTH, D_MODEL), MIX_WIDTH ** -0.5),
        'w_o': nrm((DEPTH, D_MODEL, D_MODEL), D_MODEL ** -0.5),
        'norm_ffn_g': 1.0 + nrm((DEPTH, D_MODEL), 0.02),
        'w_up': nrm((DEPTH, D_MODEL, f2), D_MODEL ** -0.5),
        'conv_w': nrm((DEPTH, CONV_WIDTH, f2), CONV_WIDTH ** -0.5),
        'conv_b': nrm((DEPTH, f2), 0.02),
        'w_down': nrm((DEPTH, D_FF, D_MODEL), D_FF ** -0.5),
        'norm_final_g': 1.0 + nrm((D_MODEL,), 0.02),
    }


def reference(x, norm_mix_g, w_in, a_mu, a_w0, a_w_up, a_a0, a_a_up, a_g_up, a_k_k, a_k_a,
              a_r_k, a_gn_g, a_gn_b, b_lb_logits, b_gn_g, w_branch, w_o, norm_ffn_g,
              w_up, conv_w, conv_b, w_down, norm_final_g):
    bsz, seq, _ = x.shape
    cos, sin = rope_tables(seq, C_HEAD_DIM)
    lb_cum = jnp.cumsum(jax.nn.softmax(b_lb_logits.astype(F32), axis=0), axis=0)
    lower_bounds = lb_cum - lb_cum[0]
    h = x
    for layer in range(DEPTH):
        u = rms_norm(h, norm_mix_g[layer])
        p = u @ w_in[layer]
        p_a, p_b, p_c, p_gate = _split(p, (A_COLS, B_COLS, C_COLS, GATE_COLS))
        y_a = rwkv7_branch(p_a, a_mu[layer], a_w0[layer], a_w_up[layer], a_a0[layer],
                           a_a_up[layer], a_g_up[layer], a_k_k[layer], a_k_a[layer],
                           a_r_k[layer], a_gn_g[layer], a_gn_b[layer])
        y_b = hgrn2_branch(p_b, lower_bounds[layer], b_gn_g[layer])
        y_c = dsa_branch(p_c, cos, sin)
        ys = jnp.stack([y_a, y_b, y_c], axis=2)
        branch = jnp.einsum('bsnc,ncd->bsnd', ys, w_branch[layer])
        gates = jax.nn.sigmoid(p_gate.reshape(bsz, seq, N_BRANCH, D_MODEL))
        merged = jnp.sum(gates * branch, axis=2)
        h = h + merged @ w_o[layer]
        u = rms_norm(h, norm_ffn_g[layer])
        h = h + conv_glu(u, w_up[layer], conv_w[layer], conv_b[layer], w_down[layer])
    return rms_norm(h, norm_final_g)
```

```cpp
#include <hip/hip_runtime.h>
#include <hip/hip_cooperative_groups.h>
#include <cstdio>
#include <cstdint>
namespace cg = cooperative_groups;

#ifndef PHMASK
#define PHMASK 2047
#endif
#ifndef TKMASK
#define TKMASK 7
#endif
#ifndef MK_SINGLE
#define MK_SINGLE 1
#endif

#define LAS __attribute__((address_space(3)))
typedef unsigned short bf16_t;
typedef short bf16x8 __attribute__((ext_vector_type(8)));
typedef float f32x4 __attribute__((ext_vector_type(4)));
typedef float f32x2 __attribute__((ext_vector_type(2)));
typedef unsigned u32x4 __attribute__((ext_vector_type(4)));
typedef unsigned u32x2 __attribute__((ext_vector_type(2)));

constexpr int T_TOK = 16384, SEQ = 2048, DM = 1024;
constexpr int LDP = 6144;
constexpr int COL_PA = 1024, COL_PB = 2816, COL_PC = 4864;
constexpr int COL_YA = 1024, COL_MRG = 1536, COL_G = 2816, COL_YB = 3840, COL_YC = 4864, COL_ACT = 1024;
constexpr int C_Q = 4864, C_K = 5376, C_QI = 5632, C_KI = 5888, C_WI = 5952;
constexpr int IN_COLS = 8004, DFF = 2816, F2 = 5632;
constexpr size_t WS_WIN = 0, WS_WG = 10485760, WS_WBR = 16777216, WS_WO = 19922944, WS_WUP = 22020096, WS_WDN = 33554432;
constexpr size_t WS_P = 41943040, WS_HALO = 243269632, WS_VT = WS_HALO, WS_ROPE = 266338304;
constexpr int LDS_BYTES = 153600;
constexpr int SCS = 2052;
constexpr int MASK_OFF = 16 * SCS * 4;

struct Args { const float* in[24]; float* out; unsigned char* ws; int ph_lo, ph_hi; };

__device__ __forceinline__ unsigned f2bf(float f) { unsigned u = __builtin_bit_cast(unsigned, f); return (u + 0x7fffu + ((u >> 16) & 1u)) >> 16; }
__device__ __forceinline__ unsigned pk2(float lo, float hi) { return f2bf(lo) | (f2bf(hi) << 16); }
__device__ __forceinline__ float bf2f(bf16_t b) { return __builtin_bit_cast(float, (unsigned)b << 16); }
__device__ __forceinline__ float bflo(unsigned w) { return __builtin_bit_cast(float, w << 16); }
__device__ __forceinline__ float bfhi(unsigned w) { return __builtin_bit_cast(float, w & 0xffff0000u); }
__device__ __forceinline__ float wave_sum(float v) {
#pragma unroll
    for (int o = 1; o < 64; o <<= 1) v += __shfl_xor(v, o);
    return v;
}
__device__ __forceinline__ int wave_sum_i(int v) {
#pragma unroll
    for (int o = 1; o < 64; o <<= 1) v += __shfl_xor(v, o);
    return v;
}
template <int CTRL> __device__ __forceinline__ float dpp_mov(float x) {
    return __builtin_bit_cast(float, __builtin_amdgcn_update_dpp(0, __builtin_bit_cast(int, x), CTRL, 0xF, 0xF, true));
}
__device__ __forceinline__ float red8(float x) { x += dpp_mov<0xB1>(x); x += dpp_mov<0x4E>(x); x += dpp_mov<0x141>(x); return x; }
__device__ __forceinline__ float red16(float x) { x = red8(x); x += dpp_mov<0x140>(x); return x; }
__device__ __forceinline__ float sigmoidf_(float x) { return 1.f / (1.f + __expf(-x)); }

namespace pg8 {
constexpr int BM = 256, BK = 64, HALF = 128, HTB = HALF * BK * 2, NXCD = 8, WGM = 8;
__device__ __forceinline__ int lds_byte(int r, int c) { const int st = (r >> 4) * 2 + (c >> 5), rr = r & 15, cc = c & 31, ob = rr * 64 + cc * 2; return st * 1024 + (ob ^ (((ob >> 9) & 1) << 5)); }
__device__ __forceinline__ void stage_rc(int b, int& R, int& C) { const int st = b / 1024, sb = b % 1024, swz = sb ^ (((sb >> 9) & 1) << 5); R = (st >> 1) * 16 + swz / 64; C = (st & 1) * 32 + (swz % 64) / 2; }
__device__ __forceinline__ int perm32(int rho) { const int n = rho >> 4, i = rho & 15; return 8 * (i >> 2) + 4 * n + (i & 3); }
struct Unit { int pm, pn; };
struct Gemm { const bf16_t* A; const bf16_t* Bt; int lda, ldb, K; };
struct StaticOrder {
    int nM, nN, nwg, G, c;
    __device__ void init(int M, int N, int G_, int c_) { nM = M / BM; nN = N / BM; nwg = nM * nN; G = G_; c = c_; }
    __device__ bool next(int i, Unit& u) const {
        const long L = (long)i * G + c; if (L >= nwg) return false;
        int wgid = (int)L; { const int q = nwg / NXCD, r = nwg % NXCD, xcd = wgid % NXCD, off = wgid / NXCD; wgid = (xcd < r ? xcd * (q + 1) : r * (q + 1) + (xcd - r) * q) + off; }
        const int nig = WGM * nN, gid = wgid / nig, fm = gid * WGM, gsz = (nM - fm) < WGM ? (nM - fm) : WGM;
        u.pm = fm + ((wgid % nig) % gsz); u.pn = (wgid % nig) / gsz; return true;
    }
};
__device__ __forceinline__ unsigned cvt_pk_bf16(float lo, float hi) { unsigned r; asm volatile("v_cvt_pk_bf16_f32 %0, %1, %2" : "=v"(r) : "v"(lo), "v"(hi)); return r; }

template <class Epi, bool ALIGN_EPI>
__device__ __forceinline__ void gemm_phase(LAS unsigned char* lds, const Gemm g, const StaticOrder& S, const Epi& E, const int tid) {
    const int wid = __builtin_amdgcn_readfirstlane(tid >> 6), lane = tid & 63, wr = wid >> 2, wc = wid & 3, fr = lane & 15, fq = lane >> 4;
    const int K = g.K, nt = K / BK;
    unsigned voffA[2], voffB[2];
#pragma unroll
    for (int i = 0; i < 2; ++i) { int R, C; stage_rc(tid * 16 + i * 8192, R, C); const int Rb = (R & ~31) + perm32(R & 31);
        voffA[i] = (unsigned)(R * g.lda + C) * 2u; voffB[i] = (unsigned)(Rb * g.ldb + C) * 2u; }
    const size_t kstep = (size_t)(BK * 2);
    const size_t hstepA = (size_t)HALF * g.lda * 2, hstepB = (size_t)HALF * g.ldb * 2;
    const size_t tstepA = 2 * hstepA, tstepB = 2 * hstepB;
    const unsigned ldsw = (unsigned)wid * 1024u;
    const int aoff = lds_byte(wr * 64 + fr, fq * 8), boff = lds_byte(wc * 32 + fr, fq * 8);
#define PG8_SA(b, h) (((b) * 2 + (h)) * HTB)
#define PG8_SB(b, h) ((4 + (b) * 2 + (h)) * HTB)
#define PG8_STAGE(bufoff, gbase, voff) do { _Pragma("unroll") for (int _i = 0; _i < 2; ++_i) \
        __builtin_amdgcn_global_load_lds((const unsigned*)((const char*)(gbase) + (voff)[_i]), (LAS unsigned*)(lds + (bufoff) + ldsw + _i * 8192), 16, 0, 0); } while (0)
#define PG8_LDA(dst, b, h) do { _Pragma("unroll") for (int m = 0; m < 4; ++m) _Pragma("unroll") for (int k = 0; k < 2; ++k) dst[m][k] = *(const LAS bf16x8*)(lds + PG8_SA(b, h) + aoff + m * 2048 + k * 1024); } while (0)
#define PG8_LDB(dst, b, h) do { _Pragma("unroll") for (int n = 0; n < 2; ++n) _Pragma("unroll") for (int k = 0; k < 2; ++k) dst[n][k] = *(const LAS bf16x8*)(lds + PG8_SB(b, h) + boff + n * 2048 + k * 1024); } while (0)
#define PG8_MMA(ai, bj, At, Bt) do { __builtin_amdgcn_s_setprio(1); _Pragma("unroll") for (int m = 0; m < 4; ++m) _Pragma("unroll") for (int n = 0; n < 2; ++n) _Pragma("unroll") for (int k = 0; k < 2; ++k) \
        acc[ai][bj][m][n] = __builtin_amdgcn_mfma_f32_16x16x32_bf16(Bt[n][k], At[m][k], acc[ai][bj][m][n], 0, 0, 0); __builtin_amdgcn_s_setprio(0); } while (0)
#define PG8_WAIT_V(n) asm volatile("s_waitcnt vmcnt(" #n ")" ::: "memory")
#define PG8_WAIT_L(n) asm volatile("s_waitcnt lgkmcnt(" #n ")" ::: "memory")
#define PG8_BAR __builtin_amdgcn_s_barrier()
#define PG8_SCHED __builtin_amdgcn_sched_barrier(0)
    Unit cur, nxt; int ui = 0;
    if (!S.next(0, cur)) return;
    f32x4 acc[2][2][4][2];
#pragma unroll
    for (int a = 0; a < 2; ++a)
#pragma unroll
        for (int b = 0; b < 2; ++b)
#pragma unroll
            for (int m = 0; m < 4; ++m)
#pragma unroll
                for (int n = 0; n < 2; ++n) acc[a][b][m][n] = (f32x4){0.f, 0.f, 0.f, 0.f};
    bf16x8 At[4][2], B0[2][2], B1[2][2];
    const char* cA = (const char*)g.A + (size_t)cur.pm * tstepA; const char* cB = (const char*)g.Bt + (size_t)cur.pn * tstepB;
    PG8_STAGE(PG8_SB(0, 0), cB, voffB); PG8_STAGE(PG8_SB(0, 1), cB + hstepB, voffB); PG8_STAGE(PG8_SA(0, 0), cA, voffA); PG8_STAGE(PG8_SA(0, 1), cA + hstepA, voffA);
    if (wr == 1) PG8_BAR;
    PG8_WAIT_V(2); PG8_BAR;
    PG8_STAGE(PG8_SB(1, 0), cB + kstep, voffB); PG8_STAGE(PG8_SA(1, 0), cA + kstep, voffA); PG8_STAGE(PG8_SB(1, 1), cB + hstepB + kstep, voffB);
    PG8_WAIT_V(6); PG8_BAR;
    for (;;) {
        const bool has_next = S.next(ui + 1, nxt);
        const char* nA = has_next ? (const char*)g.A + (size_t)nxt.pm * tstepA : cA; const char* nB = has_next ? (const char*)g.Bt + (size_t)nxt.pn * tstepB : cB;
        for (int t = 0; t < nt; t += 2) {
            const bool last = (t == nt - 2);
            const char* a1 = cA + (size_t)(t + 1) * kstep;
            const char* a2 = last ? nA : cA + (size_t)(t + 2) * kstep; const char* b2 = last ? nB : cB + (size_t)(t + 2) * kstep;
            const char* a3 = a2 + kstep; const char* b3 = b2 + kstep;
            PG8_LDB(B0, 0, 0); PG8_LDB(B1, 0, 1); PG8_SCHED; PG8_LDA(At, 0, 0); PG8_STAGE(PG8_SA(1, 1), a1 + hstepA, voffA);
            PG8_WAIT_V(8); PG8_WAIT_L(0); PG8_BAR; PG8_MMA(0, 0, At, B0); PG8_MMA(0, 1, At, B1); PG8_BAR; PG8_SCHED;
            PG8_LDA(At, 0, 1); PG8_STAGE(PG8_SB(0, 0), b2, voffB); PG8_STAGE(PG8_SB(0, 1), b2 + hstepB, voffB); PG8_STAGE(PG8_SA(0, 0), a2, voffA);
            PG8_WAIT_V(8); PG8_WAIT_L(0); PG8_BAR; PG8_MMA(1, 0, At, B0); PG8_MMA(1, 1, At, B1); PG8_BAR; PG8_SCHED;
            PG8_LDB(B0, 1, 0); PG8_LDB(B1, 1, 1); PG8_SCHED; PG8_LDA(At, 1, 0); PG8_STAGE(PG8_SA(0, 1), a2 + hstepA, voffA);
            PG8_WAIT_V(8); PG8_WAIT_L(0); PG8_BAR; PG8_MMA(0, 0, At, B0); PG8_MMA(0, 1, At, B1); PG8_BAR; PG8_SCHED;
            PG8_LDA(At, 1, 1); PG8_STAGE(PG8_SB(1, 0), b3, voffB); PG8_STAGE(PG8_SB(1, 1), b3 + hstepB, voffB); PG8_STAGE(PG8_SA(1, 0), a3, voffA);
            PG8_WAIT_V(8); PG8_WAIT_L(0); PG8_BAR; PG8_MMA(1, 0, At, B0); PG8_MMA(1, 1, At, B1); PG8_BAR; PG8_SCHED;
        }
        if constexpr (ALIGN_EPI) { if (wr == 0) PG8_BAR; }
        E(acc, cur, wr, wc, fr, fq);
        if (!has_next) break;
#pragma unroll
        for (int a = 0; a < 2; ++a)
#pragma unroll
            for (int b = 0; b < 2; ++b)
#pragma unroll
                for (int m = 0; m < 4; ++m)
#pragma unroll
                    for (int n = 0; n < 2; ++n) acc[a][b][m][n] = (f32x4){0.f, 0.f, 0.f, 0.f};
        cur = nxt; cA = nA; cB = nB; ++ui;
        if constexpr (ALIGN_EPI) { if (wr == 1) PG8_BAR; }
    }
    PG8_WAIT_V(0);
    if constexpr (!ALIGN_EPI) { if (wr == 0) PG8_BAR; }
    PG8_BAR;
#undef PG8_SA
#undef PG8_SB
#undef PG8_STAGE
#undef PG8_LDA
#undef PG8_LDB
#undef PG8_MMA
#undef PG8_WAIT_V
#undef PG8_WAIT_L
#undef PG8_BAR
#undef PG8_SCHED
}

typedef f32x4 AccT[2][2][4][2];

struct EpiInProj {
    bf16_t* P; bf16_t* VT; const float* rope;
    __device__ __forceinline__ void operator()(AccT& acc, const Unit& u, int wr, int wc, int fr, int fq) const {
        const int row0 = u.pm * BM + wr * 64 + fr, colb = u.pn * BM + wc * 32 + 8 * fq;
#pragma unroll
        for (int ai = 0; ai < 2; ++ai)
#pragma unroll
            for (int m = 0; m < 4; ++m) {
                const int row = row0 + ai * HALF + m * 16, t = row & (SEQ - 1);
                bf16_t* rowp = P + (size_t)row * LDP + COL_PA;
#pragma unroll
                for (int bj = 0; bj < 2; ++bj) {
                    const int c = colb + bj * HALF;
                    f32x4 v0 = acc[ai][bj][m][0], v1 = acc[ai][bj][m][1];
                    if (u.pn >= 15) {
                        const int cl = c - 3840;
                        if (cl < 640 || (cl >= 768 && cl < 1088)) {
                            const float* cs = rope + ((size_t)t * 32 + ((cl & 63) >> 1)) * 2;
                            const f32x4 r0 = *(const f32x4*)cs, r1 = *(const f32x4*)(cs + 4);
                            f32x4 o0, o1;
                            o0[0] = v0[0] * r0[0] - v0[1] * r0[1]; o0[1] = v0[1] * r0[0] + v0[0] * r0[1];
                            o0[2] = v0[2] * r0[2] - v0[3] * r0[3]; o0[3] = v0[3] * r0[2] + v0[2] * r0[3];
                            o1[0] = v1[0] * r1[0] - v1[1] * r1[1]; o1[1] = v1[1] * r1[0] + v1[0] * r1[1];
                            o1[2] = v1[2] * r1[2] - v1[3] * r1[3]; o1[3] = v1[3] * r1[2] + v1[2] * r1[3];
                            v0 = o0; v1 = o1;
                        }
                    }
                    u32x4 w; w.x = cvt_pk_bf16(v0[0], v0[1]); w.y = cvt_pk_bf16(v0[2], v0[3]); w.z = cvt_pk_bf16(v1[0], v1[1]); w.w = cvt_pk_bf16(v1[2], v1[3]);
                    *(u32x4*)(rowp + c) = w;
                    if (u.pn == 17 && bj == 1) {
                        const int cv = c - 3840 - 640, b = row >> 11;
                        bf16_t* vt = VT + ((size_t)(b * 2 + (cv >> 6)) * 64 + (cv & 63)) * SEQ + t;
                        vt[0 * SEQ] = (bf16_t)(w.x & 0xffffu); vt[1 * SEQ] = (bf16_t)(w.x >> 16);
                        vt[2 * SEQ] = (bf16_t)(w.y & 0xffffu); vt[3 * SEQ] = (bf16_t)(w.y >> 16);
                        vt[4 * SEQ] = (bf16_t)(w.z & 0xffffu); vt[5 * SEQ] = (bf16_t)(w.z >> 16);
                        vt[6 * SEQ] = (bf16_t)(w.w & 0xffffu); vt[7 * SEQ] = (bf16_t)(w.w >> 16);
                    }
                }
            }
    }
};
struct EpiGate {
    bf16_t* P;
    __device__ __forceinline__ void operator()(AccT& acc, const Unit& u, int wr, int wc, int fr, int fq) const {
        const int row0 = u.pm * BM + wr * 64 + fr, colb = u.pn * BM + wc * 32 + 8 * fq;
#pragma unroll
        for (int ai = 0; ai < 2; ++ai)
#pragma unroll
            for (int m = 0; m < 4; ++m) {
                bf16_t* rowp = P + (size_t)(row0 + ai * HALF + m * 16) * LDP + COL_G + colb;
#pragma unroll
                for (int bj = 0; bj < 2; ++bj) {
                    const f32x4 v0 = acc[ai][bj][m][0], v1 = acc[ai][bj][m][1];
                    u32x4 w; w.x = cvt_pk_bf16(sigmoidf_(v0[0]), sigmoidf_(v0[1])); w.y = cvt_pk_bf16(sigmoidf_(v0[2]), sigmoidf_(v0[3]));
                    w.z = cvt_pk_bf16(sigmoidf_(v1[0]), sigmoidf_(v1[1])); w.w = cvt_pk_bf16(sigmoidf_(v1[2]), sigmoidf_(v1[3]));
                    *(u32x4*)(rowp + bj * HALF) = w;
                }
            }
    }
};
struct EpiMergeAcc {
    bf16_t* P; int first;
    __device__ __forceinline__ void operator()(AccT& acc, const Unit& u, int wr, int wc, int fr, int fq) const {
        const int row0 = u.pm * BM + wr * 64 + fr, colb = u.pn * BM + wc * 32 + 8 * fq;
#pragma unroll
        for (int ai = 0; ai < 2; ++ai)
#pragma unroll
            for (int m = 0; m < 4; ++m) {
                bf16_t* rowb = P + (size_t)(row0 + ai * HALF + m * 16) * LDP + colb;
#pragma unroll
                for (int bj = 0; bj < 2; ++bj) {
                    const f32x4 v0 = acc[ai][bj][m][0], v1 = acc[ai][bj][m][1];
                    unsigned long long* gp = (unsigned long long*)(rowb + COL_G + bj * HALF);
                    unsigned long long* mp = (unsigned long long*)(rowb + COL_MRG + bj * HALF);
                    const unsigned long long g0 = __hip_atomic_load(gp, __ATOMIC_RELAXED, __HIP_MEMORY_SCOPE_AGENT), g1 = __hip_atomic_load(gp + 1, __ATOMIC_RELAXED, __HIP_MEMORY_SCOPE_AGENT);
                    unsigned long long m0 = 0ull, m1 = 0ull;
                    if (!first) { m0 = __hip_atomic_load(mp, __ATOMIC_RELAXED, __HIP_MEMORY_SCOPE_AGENT); m1 = __hip_atomic_load(mp + 1, __ATOMIC_RELAXED, __HIP_MEMORY_SCOPE_AGENT); }
                    const unsigned ga = (unsigned)g0, gb = (unsigned)(g0 >> 32), gc = (unsigned)g1, gd = (unsigned)(g1 >> 32);
                    const unsigned ma = (unsigned)m0, mb = (unsigned)(m0 >> 32), mc = (unsigned)m1, md = (unsigned)(m1 >> 32);
                    u32x4 w;
                    w.x = cvt_pk_bf16(bflo(ma) + bflo(ga) * v0[0], bfhi(ma) + bfhi(ga) * v0[1]);
                    w.y = cvt_pk_bf16(bflo(mb) + bflo(gb) * v0[2], bfhi(mb) + bfhi(gb) * v0[3]);
                    w.z = cvt_pk_bf16(bflo(mc) + bflo(gc) * v1[0], bfhi(mc) + bfhi(gc) * v1[1]);
                    w.w = cvt_pk_bf16(bflo(md) + bflo(gd) * v1[2], bfhi(md) + bfhi(gd) * v1[3]);
                    *(u32x4*)(rowb + COL_MRG + bj * HALF) = w;
                }
            }
    }
};
struct EpiResid {
    const float* base; float* out;
    __device__ __forceinline__ void operator()(AccT& acc, const Unit& u, int wr, int wc, int fr, int fq) const {
        const int row0 = u.pm * BM + wr * 64 + fr, colb = u.pn * BM + wc * 32 + 8 * fq;
#pragma unroll
        for (int ai = 0; ai < 2; ++ai)
#pragma unroll
            for (int m = 0; m < 4; ++m) {
                const size_t off = (size_t)(row0 + ai * HALF + m * 16) * DM + colb;
#pragma unroll
                for (int bj = 0; bj < 2; ++bj) {
                    const f32x4 b0 = *(const f32x4*)(base + off + bj * HALF), b1 = *(const f32x4*)(base + off + bj * HALF + 4);
                    *(f32x4*)(out + off + bj * HALF) = b0 + acc[ai][bj][m][0];
                    *(f32x4*)(out + off + bj * HALF + 4) = b1 + acc[ai][bj][m][1];
                }
            }
    }
};
struct EpiUp {
    bf16_t* P; float* HALO; const float* cw; const float* cb;
    __device__ __forceinline__ void operator()(AccT& acc, const Unit& u, int wr, int wc, int fr_in, int fq_in) const {
        int fr = fr_in, fq = fq_in;
        asm volatile("" : "+v"(fr), "+v"(fq));
        const int row0 = u.pm * BM + wr * 64 + fr;
        const int jb = u.pn * 128 + wc * 32 + 8 * fq;
#pragma unroll
        for (int ai = 0; ai < 2; ++ai) {
            const int s = u.pm * 4 + ai * 2 + wr;
#pragma unroll
            for (int bj = 0; bj < 2; ++bj)
#pragma unroll
                for (int n = 0; n < 2; ++n) {
                    const int colp = u.pn * BM + bj * HALF + wc * 32 + 8 * fq + 4 * n;
                    if (fr < 2) *(f32x4*)(HALO + (size_t)(s * 4 + fr) * F2 + colp) = acc[ai][bj][0][n];
                    if (fr >= 14) *(f32x4*)(HALO + (size_t)(s * 4 + fr - 12) * F2 + colp) = acc[ai][bj][3][n];
                }
        }
#pragma unroll
        for (int ai = 0; ai < 2; ++ai)
#pragma unroll
            for (int m = 0; m < 4; ++m) {
                const int row = row0 + ai * HALF + m * 16;
#pragma unroll
                for (int n = 0; n < 2; ++n) {
                    f32x4 cv[2];
                    asm volatile("" ::: "memory");
#pragma unroll
                    for (int bj = 0; bj < 2; ++bj) {
                        const int co = bj * DFF + jb + 4 * n;
                        const f32x4 w0 = *(const f32x4*)(cw + co), w1 = *(const f32x4*)(cw + F2 + co), w2 = *(const f32x4*)(cw + 2 * F2 + co), bb = *(const f32x4*)(cb + co);
#pragma unroll
                        for (int e = 0; e < 4; ++e) {
                            const float cur = acc[ai][bj][m][n][e];
                            const float prv = m > 0 ? acc[ai][bj][m > 0 ? m - 1 : 0][n][e] : 0.f;
                            const float a1 = dpp_mov<0x121>(cur), a2 = dpp_mov<0x122>(cur), b1 = dpp_mov<0x121>(prv), b2 = dpp_mov<0x122>(prv);
                            const float p1 = fr >= 1 ? a1 : b1, p2 = fr >= 2 ? a2 : b2;
                            cv[bj][e] = bb[e] + w0[e] * p2 + w1[e] * p1 + w2[e] * cur;
                        }
                        __builtin_amdgcn_sched_barrier(0);
                    }
                    const f32x4 g0 = cv[0], v0 = cv[1];
                    u32x2 w;
                    w.x = cvt_pk_bf16(g0[0] * sigmoidf_(g0[0]) * v0[0], g0[1] * sigmoidf_(g0[1]) * v0[1]);
                    w.y = cvt_pk_bf16(g0[2] * sigmoidf_(g0[2]) * v0[2], g0[3] * sigmoidf_(g0[3]) * v0[3]);
                    if (!(m == 0 && fr < 2)) *(u32x2*)(P + (size_t)row * LDP + COL_ACT + jb + 4 * n) = w;
                    __builtin_amdgcn_sched_barrier(0);
                }
            }
    }
};
}

struct Ctx {
    const float* in[24]; float* out; unsigned char* ws;
    bf16_t* P; bf16_t* VT; float* HALO; float* ROPE;
    bf16_t *Win, *Wg, *Wbr, *Wo, *Wup, *Wdn;
    int tid, lane, wave, G, bid;
};

__device__ __forceinline__ int srccol(int mode, int n) {
    if (mode == 0) return n;
    if (mode == 2) return 4932 + n;
    if (mode == 3) { const int tile = n >> 8, w = n & 255, j = tile * 128 + (w & 127); return (w < 128) ? j : DFF + j; }
    if (n < 3840) return n;
    const int c = n - 3840;
    if (c >= 1092) return -1;
    if (c < 640 || (c >= 768 && c < 1088)) { const int base = c & ~63, i = c & 63; return 3840 + base + (i >> 1) + 32 * (i & 1); }
    return 3840 + c;
}
__device__ __forceinline__ void tr_item(const float* W, int ldw, int K, int N, bf16_t* WT, int mode, int item, LAS float* scr, int lane) {
    const int nblk = N / 32, kb = item / nblk, nb = item % nblk, k0 = 64 * kb, n0 = 32 * nb;
    const int sc = srccol(mode, n0 + (lane & 31));
#pragma unroll 8
    for (int i = 0; i < 32; ++i) { const int kk = 2 * i + (lane >> 5); scr[kk * 33 + (lane & 31)] = (sc >= 0) ? W[(size_t)(k0 + kk) * ldw + sc] : 0.f; }
    asm volatile("s_waitcnt lgkmcnt(0)" ::: "memory");
    const int c = lane & 7;
#pragma unroll
    for (int j = 0; j < 4; ++j) { const int n = (lane >> 3) + 8 * j; const LAS float* s = scr + (8 * c) * 33 + n;
        u32x4 o; o.x = pk2(s[0 * 33], s[1 * 33]); o.y = pk2(s[2 * 33], s[3 * 33]); o.z = pk2(s[4 * 33], s[5 * 33]); o.w = pk2(s[6 * 33], s[7 * 33]);
        *(u32x4*)(WT + (size_t)(n0 + n) * K + k0 + 8 * c) = o; }
    asm volatile("s_waitcnt lgkmcnt(0)" ::: "memory");
}
__device__ __forceinline__ void rms_row(const float* xrow, const float* g, bf16_t* obf, float* of32, int lane) {
    const f32x4* xr = (const f32x4*)xrow + lane; const f32x4* gr = (const f32x4*)g + lane;
    f32x4 v[4]; float s = 0.f;
#pragma unroll
    for (int j = 0; j < 4; ++j) { v[j] = xr[64 * j]; s += (v[j].x * v[j].x + v[j].y * v[j].y) + (v[j].z * v[j].z + v[j].w * v[j].w); }
    const float rs = 1.f / sqrtf(wave_sum(s) * (1.f / DM) + 1e-6f);
#pragma unroll
    for (int j = 0; j < 4; ++j) {
        const f32x4 gg = gr[64 * j]; const f32x4 o = v[j] * rs * gg;
        if (obf) { u32x2 w; w.x = pk2(o.x, o.y); w.y = pk2(o.z, o.w); *((u32x2*)obf + lane + 64 * j) = w; }
        else *((f32x4*)of32 + lane + 64 * j) = o;
    }
}
__device__ __forceinline__ void phase_prep(const Ctx& X, LAS unsigned char* lds, int layer) {
    LAS float* scr = (LAS float*)(lds + X.wave * 8448);
    const int gw = X.bid * 8 + X.wave, NGW = X.G * 8;
    constexpr int I_IN = 16 * 160, I_G = 16 * 96, I_BR = 8 * 32, I_O = 16 * 32, I_UP = 16 * 176, I_DN = 44 * 32;
    constexpr int NITEMS = I_IN + I_G + 3 * I_BR + I_O + I_UP + I_DN;
    const float* w_in = X.in[2] + (size_t)layer * DM * IN_COLS;
    const float* w_br = X.in[16] + (size_t)layer * 3 * 512 * DM;
    const float* w_o = X.in[17] + (size_t)layer * DM * DM;
    const float* w_up = X.in[19] + (size_t)layer * DM * F2;
    const float* w_dn = X.in[22] + (size_t)layer * DFF * DM;
    for (int it = gw; it < NITEMS; it += NGW) {
        int r = it;
        if (r < I_IN) { tr_item(w_in, IN_COLS, DM, 5120, X.Win, 1, r, scr, X.lane); continue; } r -= I_IN;
        if (r < I_G) { tr_item(w_in, IN_COLS, DM, 3072, X.Wg, 2, r, scr, X.lane); continue; } r -= I_G;
        if (r < 3 * I_BR) { const int b = r / I_BR; tr_item(w_br + (size_t)b * 512 * DM, DM, 512, DM, X.Wbr + (size_t)b * DM * 512, 0, r % I_BR, scr, X.lane); continue; } r -= 3 * I_BR;
        if (r < I_O) { tr_item(w_o, DM, DM, DM, X.Wo, 0, r, scr, X.lane); continue; } r -= I_O;
        if (r < I_UP) { tr_item(w_up, F2, DM, F2, X.Wup, 3, r, scr, X.lane); continue; } r -= I_UP;
        tr_item(w_dn, DM, DFF, DM, X.Wdn, 0, r, scr, X.lane);
    }
    const float* h = (layer == 0) ? X.in[0] : X.out;
    const float* g = X.in[1] + (size_t)layer * DM;
    for (int m = gw; m < T_TOK; m += NGW) rms_row(h + (size_t)m * DM, g, X.P + (size_t)m * LDP, nullptr, X.lane);
    if (layer == 0) {
        for (int idx = X.bid * 512 + X.tid; idx < SEQ * 32; idx += X.G * 512) {
            const int t = idx >> 5, p = idx & 31;
            const float inv = exp2f(-(float)p * 0.03125f * 13.287712379549449f);
            const float ang = (float)t * inv;
            const double rev = (double)ang * 0.15915494309189535;
            const float fr = (float)(rev - floor(rev));
            X.ROPE[2 * idx] = __builtin_amdgcn_cosf(fr); X.ROPE[2 * idx + 1] = __builtin_amdgcn_sinf(fr);
        }
    }
}

__device__ __forceinline__ void rwkv_task(const Ctx& X, LAS unsigned char* lds, int layer, int b, int h) {
    LAS float* A_ = (LAS float*)(lds);            LAS float* WR = (LAS float*)(lds + 8192);   LAS float* Wd = (LAS float*)(lds + 16384);
    LAS float* Bv = (LAS float*)(lds + 24576);    LAS float* Kk = (LAS float*)(lds + 32768);  LAS float* Vv = (LAS float*)(lds + 40960);
    LAS float* Rr = (LAS float*)(lds + 49152);    LAS float* Gg = (LAS float*)(lds + 57344);  LAS float* Yy = (LAS float*)(lds + 65536);
    LAS float* WD = (LAS float*)(lds + 73728);    LAS float* AD = (LAS float*)(lds + 81920);  LAS float* GD = (LAS float*)(lds + 90112);
    LAS float* SC = (LAS float*)(lds + 106496);   LAS float* CARRY = (LAS float*)(lds + 107008);
    const int tid = X.tid;
    const float* mu = X.in[3] + layer * 1792;
    const float* w0 = X.in[4] + layer * 512;   const float* w_up = X.in[5] + (size_t)layer * 64 * 512;
    const float* a0 = X.in[6] + layer * 512;   const float* a_up = X.in[7] + (size_t)layer * 64 * 512;
    const float* g_up = X.in[8] + (size_t)layer * 128 * 512;
    const float* k_k = X.in[9] + layer * 512;  const float* k_a = X.in[10] + layer * 512;  const float* r_k = X.in[11] + layer * 512;
    const float* gn_g = X.in[12] + layer * 512; const float* gn_b = X.in[13] + layer * 512;
    const int c = tid & 63, tg = tid >> 6, hc = h * 64 + c;
    const float p_w0 = w0[hc], p_a0 = a0[hc], p_kk = k_k[hc], p_ka = k_a[hc], p_rk = r_k[hc], p_gg = gn_g[hc], p_gb = gn_b[hc];
    const int rp = tid >> 3, jg = tid & 7, i0 = 2 * rp;
    float S0[8], S1[8];
#pragma unroll
    for (int j = 0; j < 8; ++j) { S0[j] = 0.f; S1[j] = 0.f; }
#pragma unroll 1
    for (int ch = 0; ch < SEQ / 32; ++ch) {
        const int t0 = ch * 32, par = ch & 1;
#pragma unroll 1
        for (int idx = tid; idx < 32 * 448; idx += 512) {
            const int tt = idx / 448, cc = idx - tt * 448;
            int col;
            if (cc < 64) col = h * 64 + cc; else if (cc < 128) col = 512 + h * 64 + (cc - 64); else if (cc < 192) col = 1024 + h * 64 + (cc - 128); else col = 1536 + (cc - 192);
            const size_t row = (size_t)b * SEQ + t0 + tt;
            const float cur = bf2f(X.P[row * LDP + COL_PA + col]);
            float prev;
            if (tt > 0) prev = bf2f(X.P[(row - 1) * LDP + COL_PA + col]); else prev = (ch > 0) ? CARRY[(par ^ 1) * 448 + cc] : 0.f;
            if (tt == 31) CARRY[par * 448 + cc] = cur;
            const float val = cur + (prev - cur) * mu[col];
            if (cc < 64) Rr[tt * 64 + cc] = val; else if (cc < 128) Kk[tt * 64 + cc - 64] = val; else if (cc < 192) Vv[tt * 64 + cc - 128] = val;
            else { const int lr = cc - 192; if (lr < 64) WD[tt * 64 + lr] = tanhf(val); else if (lr < 128) AD[tt * 64 + lr - 64] = val; else GD[tt * 128 + lr - 128] = sigmoidf_(val); }
        }
        __syncthreads();
        {
            float aw[4] = {0.f, 0.f, 0.f, 0.f}, aa[4] = {0.f, 0.f, 0.f, 0.f}, ag[4] = {0.f, 0.f, 0.f, 0.f};
#pragma unroll 2
            for (int m = 0; m < 64; m += 4) {
                const float u0 = w_up[(m + 0) * 512 + hc], u1 = w_up[(m + 1) * 512 + hc], u2 = w_up[(m + 2) * 512 + hc], u3 = w_up[(m + 3) * 512 + hc];
                const float q0 = a_up[(m + 0) * 512 + hc], q1 = a_up[(m + 1) * 512 + hc], q2 = a_up[(m + 2) * 512 + hc], q3 = a_up[(m + 3) * 512 + hc];
#pragma unroll
                for (int i = 0; i < 4; ++i) {
                    const f32x4 x = *(const LAS f32x4*)&WD[(4 * tg + i) * 64 + m]; aw[i] += x.x * u0 + x.y * u1 + x.z * u2 + x.w * u3;
                    const f32x4 y = *(const LAS f32x4*)&AD[(4 * tg + i) * 64 + m]; aa[i] += y.x * q0 + y.y * q1 + y.z * q2 + y.w * q3;
                }
            }
#pragma unroll 2
            for (int m = 0; m < 128; m += 4) {
                const float u0 = g_up[(m + 0) * 512 + hc], u1 = g_up[(m + 1) * 512 + hc], u2 = g_up[(m + 2) * 512 + hc], u3 = g_up[(m + 3) * 512 + hc];
#pragma unroll
                for (int i = 0; i < 4; ++i) { const f32x4 x = *(const LAS f32x4*)&GD[(4 * tg + i) * 128 + m]; ag[i] += x.x * u0 + x.y * u1 + x.z * u2 + x.w * u3; }
            }
#pragma unroll
            for (int i = 0; i < 4; ++i) {
                const int tt = 4 * tg + i;
                const float z = -(p_w0 + aw[i]);
                const float sp = fmaxf(z, 0.f) + log1pf(__expf(-fabsf(z)));
                const float decay = __expf(-__expf(-sp - 0.5f));
                const float a = sigmoidf_(p_a0 + aa[i]);
                const float kraw = Kk[tt * 64 + c], r = Rr[tt * 64 + c];
                float kk = kraw * p_kk;
                const float ss = wave_sum(kk * kk);
                kk *= 1.f / sqrtf(fmaxf(ss, 1e-24f));
                const float kmod = kraw * (1.f + (a - 1.f) * p_ka);
                const float bvec = kk * a;
                const float br = wave_sum(bvec * r), kr = wave_sum(kmod * r), bonus = wave_sum(r * kmod * p_rk);
                A_[tt * 64 + c] = -kk; Bv[tt * 64 + c] = bvec; Wd[tt * 64 + c] = decay; WR[tt * 64 + c] = decay * r; Kk[tt * 64 + c] = kmod; Gg[tt * 64 + c] = ag[i];
                if (c == 0) { SC[tt * 4 + 0] = br; SC[tt * 4 + 1] = kr; SC[tt * 4 + 2] = bonus; }
            }
        }
        __syncthreads();
        if (tid < 256) {
#pragma unroll 1
            for (int tt = 0; tt < 32; ++tt) {
                const f32x4 a_lo = *(const LAS f32x4*)&A_[tt * 64 + 8 * jg], a_hi = *(const LAS f32x4*)&A_[tt * 64 + 8 * jg + 4];
                const f32x4 r_lo = *(const LAS f32x4*)&WR[tt * 64 + 8 * jg], r_hi = *(const LAS f32x4*)&WR[tt * 64 + 8 * jg + 4];
                const f32x4 w_lo = *(const LAS f32x4*)&Wd[tt * 64 + 8 * jg], w_hi = *(const LAS f32x4*)&Wd[tt * 64 + 8 * jg + 4];
                const f32x4 b_lo = *(const LAS f32x4*)&Bv[tt * 64 + 8 * jg], b_hi = *(const LAS f32x4*)&Bv[tt * 64 + 8 * jg + 4];
                const f32x4 k_lo = *(const LAS f32x4*)&Kk[tt * 64 + 8 * jg], k_hi = *(const LAS f32x4*)&Kk[tt * 64 + 8 * jg + 4];
                const f32x2 vv = *(const LAS f32x2*)&Vv[tt * 64 + i0];
                const f32x2 sc = *(const LAS f32x2*)&SC[tt * 4];
                float av[8], rv[8], wv[8], bv[8], kv[8];
#pragma unroll
                for (int j = 0; j < 4; ++j) { av[j] = a_lo[j]; av[4 + j] = a_hi[j]; rv[j] = r_lo[j]; rv[4 + j] = r_hi[j]; wv[j] = w_lo[j]; wv[4 + j] = w_hi[j]; bv[j] = b_lo[j]; bv[4 + j] = b_hi[j]; kv[j] = k_lo[j]; kv[4 + j] = k_hi[j]; }
                float d10 = 0.f, d20 = 0.f, d11 = 0.f, d21 = 0.f;
#pragma unroll
                for (int j = 0; j < 8; ++j) { d10 += S0[j] * av[j]; d20 += S0[j] * rv[j]; d11 += S1[j] * av[j]; d21 += S1[j] * rv[j]; }
                d10 = red8(d10); d20 = red8(d20); d11 = red8(d11); d21 = red8(d21);
                const float y0 = d20 + d10 * sc.x + vv.x * sc.y, y1 = d21 + d11 * sc.x + vv.y * sc.y;
                if (jg == 0) *(LAS f32x2*)&Yy[tt * 64 + i0] = (f32x2){y0, y1};
#pragma unroll
                for (int j = 0; j < 8; ++j) { S0[j] = S0[j] * wv[j] + d10 * bv[j] + vv.x * kv[j]; S1[j] = S1[j] * wv[j] + d11 * bv[j] + vv.y * kv[j]; }
            }
        }
        __syncthreads();
#pragma unroll
        for (int i = 0; i < 4; ++i) {
            const int tt = 4 * tg + i;
            const float y = Yy[tt * 64 + c];
            const float mean = wave_sum(y) * (1.f / 64.f), d = y - mean;
            const float var = wave_sum(d * d) * (1.f / 64.f);
            float yn = d * (1.f / sqrtf(var + 64e-5f)) * p_gg + p_gb;
            yn += SC[tt * 4 + 2] * Vv[tt * 64 + c];
            const float o = yn * Gg[tt * 64 + c];
            X.P[((size_t)b * SEQ + t0 + tt) * LDP + COL_YA + hc] = (bf16_t)f2bf(o);
        }
        __syncthreads();
    }
}

__device__ __forceinline__ void hgrn_task(const Ctx& X, LAS unsigned char* lds, int layer, int b, int h, int vh) {
    LAS float* F = (LAS float*)(lds); LAS float* Q = (LAS float*)(lds + 16384); LAS float* Vv = (LAS float*)(lds + 32768); LAS float* O = (LAS float*)(lds + 40960);
    const int tid = X.tid;
    const float* lbl = X.in[14];
    const int rp = tid >> 4, dg = tid & 15, v0 = 2 * rp;
    float S0[8], S1[8];
#pragma unroll
    for (int j = 0; j < 8; ++j) { S0[j] = 0.f; S1[j] = 0.f; }
#pragma unroll 1
    for (int ch = 0; ch < SEQ / 32; ++ch) {
        const int t0 = ch * 32;
#pragma unroll 1
        for (int idx = tid; idx < 32 * 320; idx += 512) {
            const int tt = idx / 320, cc = idx - tt * 320;
            const size_t rowo = ((size_t)b * SEQ + t0 + tt) * LDP + COL_PB;
            if (cc < 128) {
                const float x = bf2f(X.P[rowo + 512 + h * 128 + cc]);
                float lb = 0.f;
                if (layer > 0) lb = 1.f / (1.f + __expf(lbl[h * 128 + cc] - lbl[512 + h * 128 + cc]));
                F[tt * 128 + cc] = lb + (1.f - lb) * sigmoidf_(x);
            } else if (cc < 256) Q[tt * 128 + cc - 128] = bf2f(X.P[rowo + h * 128 + cc - 128]);
            else Vv[tt * 64 + cc - 256] = bf2f(X.P[rowo + 1024 + h * 128 + vh * 64 + cc - 256]);
        }
        __syncthreads();
#pragma unroll 1
        for (int tt = 0; tt < 32; ++tt) {
            const f32x4 f_lo = *(const LAS f32x4*)&F[tt * 128 + 8 * dg], f_hi = *(const LAS f32x4*)&F[tt * 128 + 8 * dg + 4];
            const f32x4 q_lo = *(const LAS f32x4*)&Q[tt * 128 + 8 * dg], q_hi = *(const LAS f32x4*)&Q[tt * 128 + 8 * dg + 4];
            const f32x2 vv = *(const LAS f32x2*)&Vv[tt * 64 + v0];
            float o0 = 0.f, o1 = 0.f;
#pragma unroll
            for (int j = 0; j < 8; ++j) {
                const float f = j < 4 ? f_lo[j & 3] : f_hi[j & 3], q = j < 4 ? q_lo[j & 3] : q_hi[j & 3];
                S0[j] = vv.x + f * (S0[j] - vv.x); S1[j] = vv.y + f * (S1[j] - vv.y);
                o0 += q * S0[j]; o1 += q * S1[j];
            }
            o0 = red16(o0); o1 = red16(o1);
            if (dg == 0) *(LAS f32x2*)&O[tt * 64 + v0] = (f32x2){o0, o1};
        }
        __syncthreads();
        for (int idx = tid; idx < 32 * 64; idx += 512) {
            const int tt = idx >> 6, v = idx & 63;
            X.P[((size_t)b * SEQ + t0 + tt) * LDP + COL_YB + h * 128 + vh * 64 + v] = (bf16_t)f2bf(O[idx]);
        }
    }
    __syncthreads();
}

__device__ __forceinline__ unsigned f2ord(float f) { const unsigned u = __builtin_bit_cast(unsigned, f); return (u & 0x80000000u) ? ~u : (u | 0x80000000u); }

__device__ __forceinline__ void dsa_tile(const Ctx& X, LAS unsigned char* lds, int b, int q0) {
    LAS float* sc = (LAS float*)lds;
    LAS unsigned* MASK = (LAS unsigned*)(lds + MASK_OFF);
    const int lane = X.lane, w = X.wave, n = lane & 15, g = lane >> 4;
    const bf16_t* Pb = X.P + (size_t)b * SEQ * LDP;
#pragma unroll 1
    for (int sub = 0; sub < 4; ++sub) {
        const int qs = q0 + 16 * sub;
        {
            bf16x8 bq[4][2]; float wi[4];
            const bf16_t* qrow = Pb + (size_t)(qs + n) * LDP;
#pragma unroll
            for (int hh = 0; hh < 4; ++hh) {
#pragma unroll
                for (int ks = 0; ks < 2; ++ks) bq[hh][ks] = *(const bf16x8*)(qrow + C_QI + hh * 64 + ks * 32 + 8 * g);
                wi[hh] = bf2f(qrow[C_WI + hh]);
            }
            const int nkt = (qs + 16) >> 4;
#pragma unroll 1
            for (int kt = w; kt < nkt; kt += 8) {
                const bf16_t* krow = Pb + (size_t)(kt * 16 + n) * LDP + C_KI;
                const bf16x8 a0 = *(const bf16x8*)(krow + 8 * g), a1 = *(const bf16x8*)(krow + 32 + 8 * g);
                f32x4 s = (f32x4){0.f, 0.f, 0.f, 0.f};
#pragma unroll
                for (int hh = 0; hh < 4; ++hh) {
                    f32x4 d = __builtin_amdgcn_mfma_f32_16x16x32_bf16(a0, bq[hh][0], (f32x4){0.f, 0.f, 0.f, 0.f}, 0, 0, 0);
                    d = __builtin_amdgcn_mfma_f32_16x16x32_bf16(a1, bq[hh][1], d, 0, 0, 0);
#pragma unroll
                    for (int r = 0; r < 4; ++r) s[r] += wi[hh] * fmaxf(d[r], 0.f);
                }
                const int t = qs + n;
#pragma unroll
                for (int r = 0; r < 4; ++r) if (kt * 16 + 4 * g + r > t) s[r] = -INFINITY;
                *(LAS f32x4*)&sc[n * SCS + kt * 16 + 4 * g] = s;
            }
        }
        __syncthreads();
#pragma unroll 1
        for (int e = 0; e < 2; ++e) {
            const int qn = 2 * w + e, t = qs + qn;
            LAS unsigned* mrow = MASK + (sub * 16 + qn) * 64;
            if (t < 256) {
#pragma unroll
                for (int j = 0; j < 32; ++j) {
                    const unsigned long long sm = __ballot(j * 64 + lane <= t);
                    if (lane == 0) { mrow[2 * j] = (unsigned)sm; mrow[2 * j + 1] = (unsigned)(sm >> 32); }
                }
            } else {
                const int jn = (t >> 6) + 1;
                unsigned u[32];
#pragma unroll
                for (int j = 0; j < 32; ++j) {
                    u[j] = 0u;
                    if (j < jn) { const int key = j * 64 + lane; const float s = (key <= t) ? sc[qn * SCS + key] : -INFINITY; u[j] = f2ord(s); }
                }
                unsigned prefix = 0u;
#pragma unroll 1
                for (int bit = 31; bit >= 0; --bit) {
                    const unsigned cand = prefix | (1u << bit);
                    int cnt = 0;
#pragma unroll
                    for (int j = 0; j < 32; ++j) if (j < jn) cnt += (u[j] >= cand) ? 1 : 0;
                    cnt = wave_sum_i(cnt);
                    if (cnt >= 256) prefix = cand;
                }
                int cg_ = 0;
#pragma unroll
                for (int j = 0; j < 32; ++j) if (j < jn) cg_ += (u[j] > prefix) ? 1 : 0;
                cg_ = wave_sum_i(cg_);
                const int need = 256 - cg_;
                int cum = 0;
#pragma unroll
                for (int j = 0; j < 32; ++j) {
                    unsigned long long sm = 0ull;
                    if (j < jn) {
                        const bool eq = (u[j] == prefix);
                        const unsigned long long em = __ballot(eq);
                        const int rank = cum + (int)__builtin_amdgcn_mbcnt_hi((unsigned)(em >> 32), __builtin_amdgcn_mbcnt_lo((unsigned)em, 0u));
                        const bool sel = (u[j] > prefix) || (eq && rank < need);
                        sm = __ballot(sel);
                        cum += __popcll(em);
                    }
                    if (lane == 0) { mrow[2 * j] = (unsigned)sm; mrow[2 * j + 1] = (unsigned)(sm >> 32); }
                }
            }
        }
        __syncthreads();
    }
    const int qq = q0 + 8 * w + (n & 7);
    const LAS unsigned* mq = MASK + (8 * w + (n & 7)) * 64;
    const int nsteps = (q0 + 8 * w + 8 + 31) >> 5;
#pragma unroll 1
    for (int c = 0; c < 2; ++c) {
        bf16x8 bq[2][2];
#pragma unroll
        for (int j = 0; j < 2; ++j)
#pragma unroll
            for (int ks = 0; ks < 2; ++ks) bq[j][ks] = *(const bf16x8*)(Pb + (size_t)qq * LDP + C_Q + (c * 4 + 2 * j + (n >> 3)) * 64 + ks * 32 + 8 * g);
        float mrun[2] = {-INFINITY, -INFINITY}, lrun[2] = {0.f, 0.f};
        f32x4 oacc[4][2];
#pragma unroll
        for (int mt = 0; mt < 4; ++mt)
#pragma unroll
            for (int j = 0; j < 2; ++j) oacc[mt][j] = (f32x4){0.f, 0.f, 0.f, 0.f};
        const bf16_t* vtb = X.VT + ((size_t)(b * 2 + c) * 64) * SEQ;
#pragma unroll 1
        for (int s = 0; s < nsteps; ++s) {
            const int kb = 32 * s;
            f32x4 st[2][2];
#pragma unroll
            for (int tl = 0; tl < 2; ++tl) {
                const bf16_t* krow = Pb + (size_t)(kb + 16 * tl + n) * LDP + C_K + c * 64;
                const bf16x8 a0 = *(const bf16x8*)(krow + 8 * g), a1 = *(const bf16x8*)(krow + 32 + 8 * g);
#pragma unroll
                for (int j = 0; j < 2; ++j) {
                    f32x4 d = __builtin_amdgcn_mfma_f32_16x16x32_bf16(a0, bq[j][0], (f32x4){0.f, 0.f, 0.f, 0.f}, 0, 0, 0);
                    st[tl][j] = __builtin_amdgcn_mfma_f32_16x16x32_bf16(a1, bq[j][1], d, 0, 0, 0);
                }
            }
            const unsigned mw = mq[s];
            bf16x8 av[4];
#pragma unroll
            for (int mt = 0; mt < 4; ++mt) {
                const bf16_t* vp = vtb + (size_t)(mt * 16 + n) * SEQ + kb + 4 * g;
                const u32x2 lo = *(const u32x2*)vp, hi = *(const u32x2*)(vp + 16);
                u32x4 t4; t4.x = lo.x; t4.y = lo.y; t4.z = hi.x; t4.w = hi.y;
                av[mt] = __builtin_bit_cast(bf16x8, t4);
            }
#pragma unroll
            for (int j = 0; j < 2; ++j) {
                float lg[8];
#pragma unroll
                for (int tl = 0; tl < 2; ++tl)
#pragma unroll
                    for (int r = 0; r < 4; ++r) { const int bit = 16 * tl + 4 * g + r; lg[4 * tl + r] = ((mw >> bit) & 1u) ? st[tl][j][r] * 0.125f : -INFINITY; }
                float mx = lg[0];
#pragma unroll
                for (int i = 1; i < 8; ++i) mx = fmaxf(mx, lg[i]);
                mx = fmaxf(mx, __shfl_xor(mx, 16)); mx = fmaxf(mx, __shfl_xor(mx, 32));
                const float mnew = fmaxf(mrun[j], mx);
                const float muse = (mnew == -INFINITY) ? 0.f : mnew;
                const float alpha = __expf(mrun[j] - muse);
                float p[8], ps = 0.f;
#pragma unroll
                for (int i = 0; i < 8; ++i) { p[i] = __expf(lg[i] - muse); ps += p[i]; }
                ps += __shfl_xor(ps, 16); ps += __shfl_xor(ps, 32);
                lrun[j] = lrun[j] * alpha + ps; mrun[j] = mnew;
                u32x4 pw; pw.x = pg8::cvt_pk_bf16(p[0], p[1]); pw.y = pg8::cvt_pk_bf16(p[2], p[3]); pw.z = pg8::cvt_pk_bf16(p[4], p[5]); pw.w = pg8::cvt_pk_bf16(p[6], p[7]);
                const bf16x8 pb = __builtin_bit_cast(bf16x8, pw);
#pragma unroll
                for (int mt = 0; mt < 4; ++mt) {
                    oacc[mt][j] = oacc[mt][j] * alpha;
                    oacc[mt][j] = __builtin_amdgcn_mfma_f32_16x16x32_bf16(av[mt], pb, oacc[mt][j], 0, 0, 0);
                }
            }
        }
#pragma unroll
        for (int j = 0; j < 2; ++j) {
            const float il = 1.f / lrun[j];
            bf16_t* op = X.P + ((size_t)b * SEQ + qq) * LDP + COL_YC + (c * 4 + 2 * j + (n >> 3)) * 64 + 4 * g;
#pragma unroll
            for (int mt = 0; mt < 4; ++mt) {
                const f32x4 o = oacc[mt][j] * il;
                u32x2 wv; wv.x = pg8::cvt_pk_bf16(o[0], o[1]); wv.y = pg8::cvt_pk_bf16(o[2], o[3]);
                *(u32x2*)(op + mt * 16) = wv;
            }
        }
    }
    __syncthreads();
}

__device__ __forceinline__ void phase_mixers(const Ctx& X, LAS unsigned char* lds, int layer) {
    for (int task = X.bid; task < 256; task += X.G) {
        if (task < 64) { if (TKMASK & 1) rwkv_task(X, lds, layer, task >> 3, task & 7); }
        else if (task < 128) { const int k = task - 64; if (TKMASK & 2) hgrn_task(X, lds, layer, k >> 3, (k >> 1) & 3, k & 1); }
        else if (TKMASK & 4) { const int k = task - 128, b = k >> 4, p = k & 15; dsa_tile(X, lds, b, 64 * (31 - p)); dsa_tile(X, lds, b, 64 * p); }
    }
}

__device__ __forceinline__ void phase_hgrn_post(const Ctx& X, int layer) {
    const int gw = X.bid * 8 + X.wave, NGW = X.G * 8;
    const float* gn = X.in[15] + layer * 512;
    for (int it = gw; it < T_TOK * 4; it += NGW) {
        const int t = it >> 2, h = it & 3;
        bf16_t* rowp = X.P + (size_t)t * LDP;
        unsigned* op = (unsigned*)(rowp + COL_YB + h * 128) + X.lane;
        const unsigned ow = *op, gwd = *((const unsigned*)(rowp + COL_PB + 1536 + h * 128) + X.lane);
        const float o0 = bflo(ow), o1 = bfhi(ow), g0 = bflo(gwd), g1 = bfhi(gwd);
        const float rs = 1.f / sqrtf(wave_sum(o0 * o0 + o1 * o1) * (1.f / 128.f) + 1e-6f);
        const float y0 = o0 * rs * gn[h * 128 + 2 * X.lane] * (g0 * sigmoidf_(g0)), y1 = o1 * rs * gn[h * 128 + 2 * X.lane + 1] * (g1 * sigmoidf_(g1));
        *op = pk2(y0, y1);
    }
}

__device__ __forceinline__ void phase_fixup(const Ctx& X, int layer) {
    const float* cw = X.in[20] + (size_t)layer * 3 * F2; const float* cb = X.in[21] + (size_t)layer * F2;
    for (int idx = X.bid * 512 + X.tid; idx < 256 * 2 * DFF; idx += X.G * 512) {
        const int j = idx % DFF, sr = idx / DFF, s = sr >> 1, r = sr & 1;
        const int colg = (j >> 7) * 256 + (j & 127), colv = colg + 128;
        const bool seq0 = (s & 31) == 0;
        const float* H = X.HALO;
        float res[2];
#pragma unroll
        for (int part = 0; part < 2; ++part) {
            const int cp = part ? colv : colg, co = part * DFF + j;
            const float u0 = H[(size_t)(s * 4 + r) * F2 + cp];
            float u1, u2;
            if (r == 0) { u1 = seq0 ? 0.f : H[(size_t)((s - 1) * 4 + 3) * F2 + cp]; u2 = seq0 ? 0.f : H[(size_t)((s - 1) * 4 + 2) * F2 + cp]; }
            else { u1 = H[(size_t)(s * 4 + 0) * F2 + cp]; u2 = seq0 ? 0.f : H[(size_t)((s - 1) * 4 + 3) * F2 + cp]; }
            res[part] = cb[co] + cw[co] * u2 + cw[F2 + co] * u1 + cw[2 * F2 + co] * u0;
        }
        const float a = res[0] * sigmoidf_(res[0]) * res[1];
        X.P[(size_t)(s * 64 + r) * LDP + COL_ACT + j] = (bf16_t)f2bf(a);
    }
}

__global__ void __launch_bounds__(512, 2) mk_fwd(Args args) {
    extern __shared__ __attribute__((aligned(16))) unsigned char lds_raw[];
    LAS unsigned char* lds = (LAS unsigned char*)lds_raw;
    Ctx X;
#pragma unroll
    for (int i = 0; i < 24; ++i) X.in[i] = args.in[i];
    X.out = args.out; X.ws = args.ws;
    X.P = (bf16_t*)(args.ws + WS_P); X.VT = (bf16_t*)(args.ws + WS_VT); X.HALO = (float*)(args.ws + WS_HALO); X.ROPE = (float*)(args.ws + WS_ROPE);
    X.Win = (bf16_t*)(args.ws + WS_WIN); X.Wg = (bf16_t*)(args.ws + WS_WG); X.Wbr = (bf16_t*)(args.ws + WS_WBR);
    X.Wo = (bf16_t*)(args.ws + WS_WO); X.Wup = (bf16_t*)(args.ws + WS_WUP); X.Wdn = (bf16_t*)(args.ws + WS_WDN);
    X.tid = threadIdx.x; X.lane = X.tid & 63; X.wave = __builtin_amdgcn_readfirstlane(X.tid >> 6); X.G = gridDim.x; X.bid = blockIdx.x;

    for (int ph = args.ph_lo; ph < args.ph_hi; ++ph) {
        const int layer = ph / 10, sub = ph % 10;
        { int t_ = threadIdx.x; asm volatile("" : "+v"(t_)); X.tid = t_; X.lane = t_ & 63; }

        if (ph == 20 && (PHMASK & 1024)) {
            const int gw = X.bid * 8 + X.wave, NGW = X.G * 8;
            for (int m = gw; m < T_TOK; m += NGW) rms_row(X.out + (size_t)m * DM, X.in[23], nullptr, X.out + (size_t)m * DM, X.lane);
        } else if (sub == 0 && (PHMASK & 1)) {
            phase_prep(X, lds, layer);
        } else if (sub == 1 && (PHMASK & 2)) {
            pg8::Gemm g{X.P, X.Win, LDP, DM, DM}; pg8::StaticOrder S; S.init(T_TOK, 5120, X.G, X.bid);
            pg8::EpiInProj E{X.P, X.VT, X.ROPE};
            pg8::gemm_phase<pg8::EpiInProj, true>(lds, g, S, E, X.tid);
        } else if (sub == 2 && (PHMASK & 4)) {
            phase_mixers(X, lds, layer);
        } else if (sub == 3 && (PHMASK & 8)) {
            phase_hgrn_post(X, layer);
        } else if (sub == 4 && (PHMASK & 16)) {
#pragma unroll 1
            for (int br = 0; br < 3; ++br) {
                { pg8::Gemm g{X.P, X.Wg + (size_t)br * DM * DM, LDP, DM, DM}; pg8::StaticOrder S; S.init(T_TOK, DM, X.G, X.bid);
                  int t_ = X.tid; asm volatile("" : "+v"(t_));
                  pg8::EpiGate E{X.P}; pg8::gemm_phase<pg8::EpiGate, true>(lds, g, S, E, t_); }
                { const int ycol = br == 0 ? COL_YA : (br == 1 ? COL_YB : COL_YC);
                  pg8::Gemm g{X.P + ycol, X.Wbr + (size_t)br * DM * 512, LDP, 512, 512}; pg8::StaticOrder S; S.init(T_TOK, DM, X.G, X.bid);
                  int t_ = X.tid; asm volatile("" : "+v"(t_));
                  pg8::EpiMergeAcc E{X.P, br == 0 ? 1 : 0}; pg8::gemm_phase<pg8::EpiMergeAcc, true>(lds, g, S, E, t_); }
            }
        } else if (sub == 5 && (PHMASK & 32)) {
            pg8::Gemm g{X.P + COL_MRG, X.Wo, LDP, DM, DM}; pg8::StaticOrder S; S.init(T_TOK, DM, X.G, X.bid);
            pg8::EpiResid E{layer == 0 ? X.in[0] : X.out, X.out};
            pg8::gemm_phase<pg8::EpiResid, true>(lds, g, S, E, X.tid);
        } else if (sub == 6 && (PHMASK & 64)) {
            const int gw = X.bid * 8 + X.wave, NGW = X.G * 8;
            const float* g = X.in[18] + (size_t)layer * DM;
            for (int m = gw; m < T_TOK; m += NGW) rms_row(X.out + (size_t)m * DM, g, X.P + (size_t)m * LDP, nullptr, X.lane);
        } else if (sub == 7 && (PHMASK & 128)) {
            pg8::Gemm g{X.P, X.Wup, LDP, DM, DM}; pg8::StaticOrder S; S.init(T_TOK, F2, X.G, X.bid);
            pg8::EpiUp E{X.P, X.HALO, X.in[20] + (size_t)layer * 3 * F2, X.in[21] + (size_t)layer * F2};
            pg8::gemm_phase<pg8::EpiUp, true>(lds, g, S, E, X.tid);
        } else if (sub == 8 && (PHMASK & 256)) {
            phase_fixup(X, layer);
        } else if (PHMASK & 512) {
            pg8::Gemm g{X.P + COL_ACT, X.Wdn, LDP, DFF, DFF}; pg8::StaticOrder S; S.init(T_TOK, DM, X.G, X.bid);
            pg8::EpiResid E{X.out, X.out};
            pg8::gemm_phase<pg8::EpiResid, true>(lds, g, S, E, X.tid);
        }
        if (ph + 1 < args.ph_hi) cg::this_grid().sync();
    }
}

extern "C" void kernel_launch(void* const* d_in, const int* in_sizes, int n_in, void* d_out, int out_size, void* d_ws, size_t ws_size, hipStream_t stream) {
    static int grid = 0;
    if (grid == 0) {
        int dev = 0, cus = 0, per_cu = 0;
        (void)hipGetDevice(&dev);
        (void)hipDeviceGetAttribute(&cus, hipDeviceAttributeMultiprocessorCount, dev);
        if (hipFuncSetAttribute((const void*)mk_fwd, hipFuncAttributeMaxDynamicSharedMemorySize, LDS_BYTES) != hipSuccess) fprintf(stderr, "kernel_launch: hipFuncSetAttribute failed\n");
        if (hipOccupancyMaxActiveBlocksPerMultiprocessor(&per_cu, (const void*)mk_fwd, 512, LDS_BYTES) != hipSuccess || per_cu < 1) { fprintf(stderr, "kernel_launch: occupancy query gave %d\n", per_cu); per_cu = 1; }
        (void)hipGetLastError();
        grid = cus * 1;
        if (grid <= 0) grid = 256;
        if (ws_size < (size_t)268435456) fprintf(stderr, "kernel_launch: workspace too small (%zu)\n", ws_size);
    }
    Args a{};
    for (int i = 0; i < 24; ++i) a.in[i] = (const float*)d_in[i];
    a.out = (float*)d_out; a.ws = (unsigned char*)d_ws;
#if MK_SINGLE
    a.ph_lo = 0; a.ph_hi = 21;
    void* kargs[] = {&a};
    hipError_t e = hipLaunchCooperativeKernel((const void*)mk_fwd, dim3(grid), dim3(512), kargs, LDS_BYTES, stream);
    if (e != hipSuccess) fprintf(stderr, "cooperative launch failed: %s (grid %d)\n", hipGetErrorString(e), grid);
#else
    for (int ph = 0; ph < 21; ++ph) {
        a.ph_lo = ph; a.ph_hi = ph + 1;
        hipLaunchKernelGGL(mk_fwd, dim3(grid), dim3(512), LDS_BYTES, stream, a);
    }
#endif
}
```

```cpp
#include <hip/hip_runtime.h>
#include <hip/hip_cooperative_groups.h>
#include <cstdio>
#include <cstdint>
namespace cg = cooperative_groups;

#ifndef PHMASK
#define PHMASK 2047
#endif
#ifndef REPMASK
#define REPMASK 0
#endif
#ifndef PROBE_DOUBLE
#define PROBE_DOUBLE 0
#endif
#ifndef TKMASK
#define TKMASK 7
#endif
#ifndef MK_SINGLE
#define MK_SINGLE 1
#endif

#define LAS __attribute__((address_space(3)))
typedef unsigned short bf16_t;
typedef short bf16x8 __attribute__((ext_vector_type(8)));
typedef float f32x4 __attribute__((ext_vector_type(4)));
typedef float f32x2 __attribute__((ext_vector_type(2)));
typedef unsigned u32x4 __attribute__((ext_vector_type(4)));
typedef unsigned u32x2 __attribute__((ext_vector_type(2)));

constexpr int T_TOK = 16384, SEQ = 2048, DM = 1024;
constexpr int LDP = 6144;
constexpr int COL_PA = 1024, COL_PB = 2816, COL_PC = 4864;
constexpr int COL_YA = 1024, COL_MRG = 1536, COL_G = 2816, COL_YB = 3840, COL_YC = 4864, COL_ACT = 1024;
constexpr int C_Q = 4864, C_K = 5376, C_QI = 5632, C_KI = 5888, C_WI = 5952;
constexpr int IN_COLS = 8004, DFF = 2816, F2 = 5632;
constexpr size_t WS_WIN = 0, WS_WG = 10485760, WS_WBR = 16777216, WS_WO = 19922944, WS_WUP = 22020096, WS_WDN = 33554432;
constexpr size_t WS_P = 41943040, WS_HALO = 243269632, WS_VT = WS_HALO, WS_ROPE = 266338304, WS_BAR = 266862592;
constexpr int LDS_BYTES = 153600;
constexpr int SCS = 2052;
constexpr int MASK_OFF = 16 * SCS * 4;

struct Args { const float* in[24]; float* out; unsigned char* ws; int ph_lo, ph_hi; };

__device__ __forceinline__ unsigned f2bf(float f) { unsigned u = __builtin_bit_cast(unsigned, f); return (u + 0x7fffu + ((u >> 16) & 1u)) >> 16; }
__device__ __forceinline__ unsigned pk2(float lo, float hi) { return f2bf(lo) | (f2bf(hi) << 16); }
__device__ __forceinline__ float bf2f(bf16_t b) { return __builtin_bit_cast(float, (unsigned)b << 16); }
__device__ __forceinline__ float bflo(unsigned w) { return __builtin_bit_cast(float, w << 16); }
__device__ __forceinline__ float bfhi(unsigned w) { return __builtin_bit_cast(float, w & 0xffff0000u); }
__device__ __forceinline__ float wave_sum(float v) {
#pragma unroll
    for (int o = 1; o < 64; o <<= 1) v += __shfl_xor(v, o);
    return v;
}
__device__ __forceinline__ int wave_sum_i(int v) {
#pragma unroll
    for (int o = 1; o < 64; o <<= 1) v += __shfl_xor(v, o);
    return v;
}
template <int CTRL> __device__ __forceinline__ float dpp_mov(float x) {
    return __builtin_bit_cast(float, __builtin_amdgcn_update_dpp(0, __builtin_bit_cast(int, x), CTRL, 0xF, 0xF, true));
}
__device__ __forceinline__ float red8(float x) { x += dpp_mov<0xB1>(x); x += dpp_mov<0x4E>(x); x += dpp_mov<0x141>(x); return x; }
__device__ __forceinline__ float red16(float x) { x = red8(x); x += dpp_mov<0x140>(x); return x; }
__device__ __forceinline__ float sigmoidf_(float x) { return 1.f / (1.f + __expf(-x)); }

namespace pg8 {
constexpr int BM = 256, BK = 64, HALF = 128, HTB = HALF * BK * 2, NXCD = 8, WGM = 8;
__device__ __forceinline__ int lds_byte(int r, int c) { const int st = (r >> 4) * 2 + (c >> 5), rr = r & 15, cc = c & 31, ob = rr * 64 + cc * 2; return st * 1024 + (ob ^ (((ob >> 9) & 1) << 5)); }
__device__ __forceinline__ void stage_rc(int b, int& R, int& C) { const int st = b / 1024, sb = b % 1024, swz = sb ^ (((sb >> 9) & 1) << 5); R = (st >> 1) * 16 + swz / 64; C = (st & 1) * 32 + (swz % 64) / 2; }
__device__ __forceinline__ int perm32(int rho) { const int n = rho >> 4, i = rho & 15; return 8 * (i >> 2) + 4 * n + (i & 3); }
struct Unit { int pm, pn; };
struct Gemm { const bf16_t* A; const bf16_t* Bt; int lda, ldb, K; };
struct StaticOrder {
    int nM, nN, nwg, G, c;
    __device__ void init(int M, int N, int G_, int c_) { nM = M / BM; nN = N / BM; nwg = nM * nN; G = G_; c = c_; }
    __device__ bool next(int i, Unit& u) const {
        const long L = (long)i * G + c; if (L >= nwg) return false;
        int wgid = (int)L; { const int q = nwg / NXCD, r = nwg % NXCD, xcd = wgid % NXCD, off = wgid / NXCD; wgid = (xcd < r ? xcd * (q + 1) : r * (q + 1) + (xcd - r) * q) + off; }
        const int nig = WGM * nN, gid = wgid / nig, fm = gid * WGM, gsz = (nM - fm) < WGM ? (nM - fm) : WGM;
        u.pm = fm + ((wgid % nig) % gsz); u.pn = (wgid % nig) / gsz; return true;
    }
};
__device__ __forceinline__ unsigned cvt_pk_bf16(float lo, float hi) { unsigned r; asm volatile("v_cvt_pk_bf16_f32 %0, %1, %2" : "=v"(r) : "v"(lo), "v"(hi)); return r; }

template <class Epi, bool ALIGN_EPI>
__device__ __forceinline__ void gemm_phase(LAS unsigned char* lds, const Gemm g, const StaticOrder& S, const Epi& E, const int tid) {
    const int wid = __builtin_amdgcn_readfirstlane(tid >> 6), lane = tid & 63, wr = wid >> 2, wc = wid & 3, fr = lane & 15, fq = lane >> 4;
    const int K = g.K, nt = K / BK;
    unsigned voffA[2], voffB[2];
#pragma unroll
    for (int i = 0; i < 2; ++i) { int R, C; stage_rc(tid * 16 + i * 8192, R, C); const int Rb = (R & ~31) + perm32(R & 31);
        voffA[i] = (unsigned)(R * g.lda + C) * 2u; voffB[i] = (unsigned)(Rb * g.ldb + C) * 2u; }
    const size_t kstep = (size_t)(BK * 2);
    const size_t hstepA = (size_t)HALF * g.lda * 2, hstepB = (size_t)HALF * g.ldb * 2;
    const size_t tstepA = 2 * hstepA, tstepB = 2 * hstepB;
    const unsigned ldsw = (unsigned)wid * 1024u;
    const int aoff = lds_byte(wr * 64 + fr, fq * 8), boff = lds_byte(wc * 32 + fr, fq * 8);
#define PG8_SA(b, h) (((b) * 2 + (h)) * HTB)
#define PG8_SB(b, h) ((4 + (b) * 2 + (h)) * HTB)
#define PG8_STAGE(bufoff, gbase, voff) do { _Pragma("unroll") for (int _i = 0; _i < 2; ++_i) \
        __builtin_amdgcn_global_load_lds((const unsigned*)((const char*)(gbase) + (voff)[_i]), (LAS unsigned*)(lds + (bufoff) + ldsw + _i * 8192), 16, 0, 0); } while (0)
#define PG8_LDA(dst, b, h) do { _Pragma("unroll") for (int m = 0; m < 4; ++m) _Pragma("unroll") for (int k = 0; k < 2; ++k) dst[m][k] = *(const LAS bf16x8*)(lds + PG8_SA(b, h) + aoff + m * 2048 + k * 1024); } while (0)
#define PG8_LDB(dst, b, h) do { _Pragma("unroll") for (int n = 0; n < 2; ++n) _Pragma("unroll") for (int k = 0; k < 2; ++k) dst[n][k] = *(const LAS bf16x8*)(lds + PG8_SB(b, h) + boff + n * 2048 + k * 1024); } while (0)
#define PG8_MMA(ai, bj, At, Bt) do { __builtin_amdgcn_s_setprio(1); _Pragma("unroll") for (int m = 0; m < 4; ++m) _Pragma("unroll") for (int n = 0; n < 2; ++n) _Pragma("unroll") for (int k = 0; k < 2; ++k) \
        acc[ai][bj][m][n] = __builtin_amdgcn_mfma_f32_16x16x32_bf16(Bt[n][k], At[m][k], acc[ai][bj][m][n], 0, 0, 0); __builtin_amdgcn_s_setprio(0); } while (0)
#define PG8_WAIT_V(n) asm volatile("s_waitcnt vmcnt(" #n ")" ::: "memory")
#define PG8_WAIT_L(n) asm volatile("s_waitcnt lgkmcnt(" #n ")" ::: "memory")
#define PG8_BAR __builtin_amdgcn_s_barrier()
#define PG8_SCHED __builtin_amdgcn_sched_barrier(0)
    Unit cur, nxt; int ui = 0;
    if (!S.next(0, cur)) return;
    f32x4 acc[2][2][4][2];
#pragma unroll
    for (int a = 0; a < 2; ++a)
#pragma unroll
        for (int b = 0; b < 2; ++b)
#pragma unroll
            for (int m = 0; m < 4; ++m)
#pragma unroll
                for (int n = 0; n < 2; ++n) acc[a][b][m][n] = (f32x4){0.f, 0.f, 0.f, 0.f};
    bf16x8 At[4][2], B0[2][2], B1[2][2];
    const char* cA = (const char*)g.A + (size_t)cur.pm * tstepA; const char* cB = (const char*)g.Bt + (size_t)cur.pn * tstepB;
    PG8_STAGE(PG8_SB(0, 0), cB, voffB); PG8_STAGE(PG8_SB(0, 1), cB + hstepB, voffB); PG8_STAGE(PG8_SA(0, 0), cA, voffA); PG8_STAGE(PG8_SA(0, 1), cA + hstepA, voffA);
    if (wr == 1) PG8_BAR;
    PG8_WAIT_V(2); PG8_BAR;
    PG8_STAGE(PG8_SB(1, 0), cB + kstep, voffB); PG8_STAGE(PG8_SA(1, 0), cA + kstep, voffA); PG8_STAGE(PG8_SB(1, 1), cB + hstepB + kstep, voffB);
    PG8_WAIT_V(6); PG8_BAR;
    for (;;) {
        const bool has_next = S.next(ui + 1, nxt);
        const char* nA = has_next ? (const char*)g.A + (size_t)nxt.pm * tstepA : cA; const char* nB = has_next ? (const char*)g.Bt + (size_t)nxt.pn * tstepB : cB;
        for (int t = 0; t < nt; t += 2) {
            const bool last = (t == nt - 2);
            const char* a1 = cA + (size_t)(t + 1) * kstep;
            const char* a2 = last ? nA : cA + (size_t)(t + 2) * kstep; const char* b2 = last ? nB : cB + (size_t)(t + 2) * kstep;
            const char* a3 = a2 + kstep; const char* b3 = b2 + kstep;
            PG8_LDB(B0, 0, 0); PG8_LDB(B1, 0, 1); PG8_SCHED; PG8_LDA(At, 0, 0); PG8_STAGE(PG8_SA(1, 1), a1 + hstepA, voffA);
            PG8_WAIT_V(8); PG8_WAIT_L(0); PG8_BAR; PG8_MMA(0, 0, At, B0); PG8_MMA(0, 1, At, B1); PG8_BAR; PG8_SCHED;
            PG8_LDA(At, 0, 1); PG8_STAGE(PG8_SB(0, 0), b2, voffB); PG8_STAGE(PG8_SB(0, 1), b2 + hstepB, voffB); PG8_STAGE(PG8_SA(0, 0), a2, voffA);
            PG8_WAIT_V(8); PG8_WAIT_L(0); PG8_BAR; PG8_MMA(1, 0, At, B0); PG8_MMA(1, 1, At, B1); PG8_BAR; PG8_SCHED;
            PG8_LDB(B0, 1, 0); PG8_LDB(B1, 1, 1); PG8_SCHED; PG8_LDA(At, 1, 0); PG8_STAGE(PG8_SA(0, 1), a2 + hstepA, voffA);
            PG8_WAIT_V(8); PG8_WAIT_L(0); PG8_BAR; PG8_MMA(0, 0, At, B0); PG8_MMA(0, 1, At, B1); PG8_BAR; PG8_SCHED;
            PG8_LDA(At, 1, 1); PG8_STAGE(PG8_SB(1, 0), b3, voffB); PG8_STAGE(PG8_SB(1, 1), b3 + hstepB, voffB); PG8_STAGE(PG8_SA(1, 0), a3, voffA);
            PG8_WAIT_V(8); PG8_WAIT_L(0); PG8_BAR; PG8_MMA(1, 0, At, B0); PG8_MMA(1, 1, At, B1); PG8_BAR; PG8_SCHED;
        }
        if constexpr (ALIGN_EPI) { if (wr == 0) PG8_BAR; }
        E(acc, cur, wr, wc, fr, fq);
        if (!has_next) break;
#pragma unroll
        for (int a = 0; a < 2; ++a)
#pragma unroll
            for (int b = 0; b < 2; ++b)
#pragma unroll
                for (int m = 0; m < 4; ++m)
#pragma unroll
                    for (int n = 0; n < 2; ++n) acc[a][b][m][n] = (f32x4){0.f, 0.f, 0.f, 0.f};
        cur = nxt; cA = nA; cB = nB; ++ui;
        if constexpr (ALIGN_EPI) { if (wr == 1) PG8_BAR; }
    }
    PG8_WAIT_V(0);
    if constexpr (!ALIGN_EPI) { if (wr == 0) PG8_BAR; }
    PG8_BAR;
#undef PG8_SA
#undef PG8_SB
#undef PG8_STAGE
#undef PG8_LDA
#undef PG8_LDB
#undef PG8_MMA
#undef PG8_WAIT_V
#undef PG8_WAIT_L
#undef PG8_BAR
#undef PG8_SCHED
}

typedef f32x4 AccT[2][2][4][2];

struct EpiInProj {
    bf16_t* P; bf16_t* VT; const float* rope;
    __device__ __forceinline__ void operator()(AccT& acc, const Unit& u, int wr, int wc, int fr, int fq) const {
        const int row0 = u.pm * BM + wr * 64 + fr, colb = u.pn * BM + wc * 32 + 8 * fq;
#pragma unroll
        for (int ai = 0; ai < 2; ++ai)
#pragma unroll
            for (int m = 0; m < 4; ++m) {
                const int row = row0 + ai * HALF + m * 16, t = row & (SEQ - 1);
                bf16_t* rowp = P + (size_t)row * LDP + COL_PA;
#pragma unroll
                for (int bj = 0; bj < 2; ++bj) {
                    const int c = colb + bj * HALF;
                    f32x4 v0 = acc[ai][bj][m][0], v1 = acc[ai][bj][m][1];
                    if (u.pn >= 15) {
                        const int cl = c - 3840;
                        if (cl < 640 || (cl >= 768 && cl < 1088)) {
                            const float* cs = rope + ((size_t)t * 32 + ((cl & 63) >> 1)) * 2;
                            const f32x4 r0 = *(const f32x4*)cs, r1 = *(const f32x4*)(cs + 4);
                            f32x4 o0, o1;
                            o0[0] = v0[0] * r0[0] - v0[1] * r0[1]; o0[1] = v0[1] * r0[0] + v0[0] * r0[1];
                            o0[2] = v0[2] * r0[2] - v0[3] * r0[3]; o0[3] = v0[3] * r0[2] + v0[2] * r0[3];
                            o1[0] = v1[0] * r1[0] - v1[1] * r1[1]; o1[1] = v1[1] * r1[0] + v1[0] * r1[1];
                            o1[2] = v1[2] * r1[2] - v1[3] * r1[3]; o1[3] = v1[3] * r1[2] + v1[2] * r1[3];
                            v0 = o0; v1 = o1;
                        }
                    }
                    u32x4 w; w.x = cvt_pk_bf16(v0[0], v0[1]); w.y = cvt_pk_bf16(v0[2], v0[3]); w.z = cvt_pk_bf16(v1[0], v1[1]); w.w = cvt_pk_bf16(v1[2], v1[3]);
                    *(u32x4*)(rowp + c) = w;
                    if (u.pn == 17 && bj == 1) {
                        const int cv = c - 3840 - 640, b = row >> 11;
                        bf16_t* vt = VT + ((size_t)(b * 2 + (cv >> 6)) * 64 + (cv & 63)) * SEQ + t;
                        vt[0 * SEQ] = (bf16_t)(w.x & 0xffffu); vt[1 * SEQ] = (bf16_t)(w.x >> 16);
                        vt[2 * SEQ] = (bf16_t)(w.y & 0xffffu); vt[3 * SEQ] = (bf16_t)(w.y >> 16);
                        vt[4 * SEQ] = (bf16_t)(w.z & 0xffffu); vt[5 * SEQ] = (bf16_t)(w.z >> 16);
                        vt[6 * SEQ] = (bf16_t)(w.w & 0xffffu); vt[7 * SEQ] = (bf16_t)(w.w >> 16);
                    }
                }
            }
    }
};
struct EpiGate {
    bf16_t* P;
    __device__ __forceinline__ void operator()(AccT& acc, const Unit& u, int wr, int wc, int fr, int fq) const {
        const int row0 = u.pm * BM + wr * 64 + fr, colb = u.pn * BM + wc * 32 + 8 * fq;
#pragma unroll
        for (int ai = 0; ai < 2; ++ai)
#pragma unroll
            for (int m = 0; m < 4; ++m) {
                bf16_t* rowp = P + (size_t)(row0 + ai * HALF + m * 16) * LDP + COL_G + colb;
#pragma unroll
                for (int bj = 0; bj < 2; ++bj) {
                    const f32x4 v0 = acc[ai][bj][m][0], v1 = acc[ai][bj][m][1];
                    u32x4 w; w.x = cvt_pk_bf16(sigmoidf_(v0[0]), sigmoidf_(v0[1])); w.y = cvt_pk_bf16(sigmoidf_(v0[2]), sigmoidf_(v0[3]));
                    w.z = cvt_pk_bf16(sigmoidf_(v1[0]), sigmoidf_(v1[1])); w.w = cvt_pk_bf16(sigmoidf_(v1[2]), sigmoidf_(v1[3]));
                    *(u32x4*)(rowp + bj * HALF) = w;
                }
            }
    }
};
struct EpiMergeAcc {
    bf16_t* P; int first;
    __device__ __forceinline__ void operator()(AccT& acc, const Unit& u, int wr, int wc, int fr, int fq) const {
        const int row0 = u.pm * BM + wr * 64 + fr, colb = u.pn * BM + wc * 32 + 8 * fq;
#pragma unroll
        for (int ai = 0; ai < 2; ++ai)
#pragma unroll
            for (int m = 0; m < 4; ++m) {
                bf16_t* rowb = P + (size_t)(row0 + ai * HALF + m * 16) * LDP + colb;
#pragma unroll
                for (int bj = 0; bj < 2; ++bj) {
                    const f32x4 v0 = acc[ai][bj][m][0], v1 = acc[ai][bj][m][1];
                    unsigned long long* gp = (unsigned long long*)(rowb + COL_G + bj * HALF);
                    unsigned long long* mp = (unsigned long long*)(rowb + COL_MRG + bj * HALF);
                    const unsigned long long g0 = __hip_atomic_load(gp, __ATOMIC_RELAXED, __HIP_MEMORY_SCOPE_AGENT), g1 = __hip_atomic_load(gp + 1, __ATOMIC_RELAXED, __HIP_MEMORY_SCOPE_AGENT);
                    unsigned long long m0 = 0ull, m1 = 0ull;
                    if (!first) { m0 = __hip_atomic_load(mp, __ATOMIC_RELAXED, __HIP_MEMORY_SCOPE_AGENT); m1 = __hip_atomic_load(mp + 1, __ATOMIC_RELAXED, __HIP_MEMORY_SCOPE_AGENT); }
                    const unsigned ga = (unsigned)g0, gb = (unsigned)(g0 >> 32), gc = (unsigned)g1, gd = (unsigned)(g1 >> 32);
                    const unsigned ma = (unsigned)m0, mb = (unsigned)(m0 >> 32), mc = (unsigned)m1, md = (unsigned)(m1 >> 32);
                    u32x4 w;
                    w.x = cvt_pk_bf16(bflo(ma) + bflo(ga) * v0[0], bfhi(ma) + bfhi(ga) * v0[1]);
                    w.y = cvt_pk_bf16(bflo(mb) + bflo(gb) * v0[2], bfhi(mb) + bfhi(gb) * v0[3]);
                    w.z = cvt_pk_bf16(bflo(mc) + bflo(gc) * v1[0], bfhi(mc) + bfhi(gc) * v1[1]);
                    w.w = cvt_pk_bf16(bflo(md) + bflo(gd) * v1[2], bfhi(md) + bfhi(gd) * v1[3]);
                    *(u32x4*)(rowb + COL_MRG + bj * HALF) = w;
                }
            }
    }
};
struct EpiResid {
    const float* base; float* out;
    __device__ __forceinline__ void operator()(AccT& acc, const Unit& u, int wr, int wc, int fr, int fq) const {
        const int row0 = u.pm * BM + wr * 64 + fr, colb = u.pn * BM + wc * 32 + 8 * fq;
#pragma unroll
        for (int ai = 0; ai < 2; ++ai)
#pragma unroll
            for (int m = 0; m < 4; ++m) {
                const size_t off = (size_t)(row0 + ai * HALF + m * 16) * DM + colb;
#pragma unroll
                for (int bj = 0; bj < 2; ++bj) {
                    const f32x4 b0 = *(const f32x4*)(base + off + bj * HALF), b1 = *(const f32x4*)(base + off + bj * HALF + 4);
                    *(f32x4*)(out + off + bj * HALF) = b0 + acc[ai][bj][m][0];
                    *(f32x4*)(out + off + bj * HALF + 4) = b1 + acc[ai][bj][m][1];
                }
            }
    }
};
struct EpiUp {
    bf16_t* P; float* HALO; const float* cw; const float* cb;
    __device__ __forceinline__ void operator()(AccT& acc, const Unit& u, int wr, int wc, int fr_in, int fq_in) const {
        int fr = fr_in, fq = fq_in;
        asm volatile("" : "+v"(fr), "+v"(fq));
        const int row0 = u.pm * BM + wr * 64 + fr;
        const int jb = u.pn * 128 + wc * 32 + 8 * fq;
#pragma unroll
        for (int ai = 0; ai < 2; ++ai) {
            const int s = u.pm * 4 + ai * 2 + wr;
#pragma unroll
            for (int bj = 0; bj < 2; ++bj)
#pragma unroll
                for (int n = 0; n < 2; ++n) {
                    const int colp = u.pn * BM + bj * HALF + wc * 32 + 8 * fq + 4 * n;
                    if (fr < 2) *(f32x4*)(HALO + (size_t)(s * 4 + fr) * F2 + colp) = acc[ai][bj][0][n];
                    if (fr >= 14) *(f32x4*)(HALO + (size_t)(s * 4 + fr - 12) * F2 + colp) = acc[ai][bj][3][n];
                }
        }
#pragma unroll
        for (int ai = 0; ai < 2; ++ai)
#pragma unroll
            for (int m = 0; m < 4; ++m) {
                const int row = row0 + ai * HALF + m * 16;
#pragma unroll
                for (int n = 0; n < 2; ++n) {
                    f32x4 cv[2];
                    asm volatile("" ::: "memory");
#pragma unroll
                    for (int bj = 0; bj < 2; ++bj) {
                        const int co = bj * DFF + jb + 4 * n;
                        const f32x4 w0 = *(const f32x4*)(cw + co), w1 = *(const f32x4*)(cw + F2 + co), w2 = *(const f32x4*)(cw + 2 * F2 + co), bb = *(const f32x4*)(cb + co);
#pragma unroll
                        for (int e = 0; e < 4; ++e) {
                            const float cur = acc[ai][bj][m][n][e];
                            const float prv = m > 0 ? acc[ai][bj][m > 0 ? m - 1 : 0][n][e] : 0.f;
                            const float a1 = dpp_mov<0x121>(cur), a2 = dpp_mov<0x122>(cur), b1 = dpp_mov<0x121>(prv), b2 = dpp_mov<0x122>(prv);
                            const float p1 = fr >= 1 ? a1 : b1, p2 = fr >= 2 ? a2 : b2;
                            cv[bj][e] = bb[e] + w0[e] * p2 + w1[e] * p1 + w2[e] * cur;
                        }
                        __builtin_amdgcn_sched_barrier(0);
                    }
                    const f32x4 g0 = cv[0], v0 = cv[1];
                    u32x2 w;
                    w.x = cvt_pk_bf16(g0[0] * sigmoidf_(g0[0]) * v0[0], g0[1] * sigmoidf_(g0[1]) * v0[1]);
                    w.y = cvt_pk_bf16(g0[2] * sigmoidf_(g0[2]) * v0[2], g0[3] * sigmoidf_(g0[3]) * v0[3]);
                    if (!(m == 0 && fr < 2)) *(u32x2*)(P + (size_t)row * LDP + COL_ACT + jb + 4 * n) = w;
                    __builtin_amdgcn_sched_barrier(0);
                }
            }
    }
};
}

struct Ctx {
    const float* in[24]; float* out; unsigned char* ws;
    bf16_t* P; bf16_t* VT; float* HALO; float* ROPE;
    bf16_t *Win, *Wg, *Wbr, *Wo, *Wup, *Wdn;
    int tid, lane, wave, G, bid;
};

__device__ __forceinline__ int srccol(int mode, int n) {
    if (mode == 0) return n;
    if (mode == 2) return 4932 + n;
    if (mode == 3) { const int tile = n >> 8, w = n & 255, j = tile * 128 + (w & 127); return (w < 128) ? j : DFF + j; }
    if (n < 3840) return n;
    const int c = n - 3840;
    if (c >= 1092) return -1;
    if (c < 640 || (c >= 768 && c < 1088)) { const int base = c & ~63, i = c & 63; return 3840 + base + (i >> 1) + 32 * (i & 1); }
    return 3840 + c;
}
__device__ __forceinline__ void tr_item(const float* W, int ldw, int K, int N, bf16_t* WT, int mode, int item, LAS float* scr, int lane) {
    const int nblk = N / 32, kb = item / nblk, nb = item % nblk, k0 = 64 * kb, n0 = 32 * nb;
    const int sc = srccol(mode, n0 + (lane & 31));
#pragma unroll 8
    for (int i = 0; i < 32; ++i) { const int kk = 2 * i + (lane >> 5); scr[kk * 33 + (lane & 31)] = (sc >= 0) ? W[(size_t)(k0 + kk) * ldw + sc] : 0.f; }
    asm volatile("s_waitcnt lgkmcnt(0)" ::: "memory");
    const int c = lane & 7;
#pragma unroll
    for (int j = 0; j < 4; ++j) { const int n = (lane >> 3) + 8 * j; const LAS float* s = scr + (8 * c) * 33 + n;
        u32x4 o; o.x = pk2(s[0 * 33], s[1 * 33]); o.y = pk2(s[2 * 33], s[3 * 33]); o.z = pk2(s[4 * 33], s[5 * 33]); o.w = pk2(s[6 * 33], s[7 * 33]);
        *(u32x4*)(WT + (size_t)(n0 + n) * K + k0 + 8 * c) = o; }
    asm volatile("s_waitcnt lgkmcnt(0)" ::: "memory");
}
__device__ __forceinline__ void rms_row(const float* xrow, const float* g, bf16_t* obf, float* of32, int lane) {
    const f32x4* xr = (const f32x4*)xrow + lane; const f32x4* gr = (const f32x4*)g + lane;
    f32x4 v[4]; float s = 0.f;
#pragma unroll
    for (int j = 0; j < 4; ++j) { v[j] = xr[64 * j]; s += (v[j].x * v[j].x + v[j].y * v[j].y) + (v[j].z * v[j].z + v[j].w * v[j].w); }
    const float rs = 1.f / sqrtf(wave_sum(s) * (1.f / DM) + 1e-6f);
#pragma unroll
    for (int j = 0; j < 4; ++j) {
        const f32x4 gg = gr[64 * j]; const f32x4 o = v[j] * rs * gg;
        if (obf) { u32x2 w; w.x = pk2(o.x, o.y); w.y = pk2(o.z, o.w); *((u32x2*)obf + lane + 64 * j) = w; }
        else *((f32x4*)of32 + lane + 64 * j) = o;
    }
}
__device__ __forceinline__ void phase_prep(const Ctx& X, LAS unsigned char* lds, int layer) {
    LAS float* scr = (LAS float*)(lds + X.wave * 8448);
    const int gw = X.bid * 8 + X.wave, NGW = X.G * 8;
    constexpr int I_IN = 16 * 160, I_G = 16 * 96, I_BR = 8 * 32, I_O = 16 * 32, I_UP = 16 * 176, I_DN = 44 * 32;
    constexpr int NITEMS = I_IN + I_G + 3 * I_BR + I_O + I_UP + I_DN;
    const float* w_in = X.in[2] + (size_t)layer * DM * IN_COLS;
    const float* w_br = X.in[16] + (size_t)layer * 3 * 512 * DM;
    const float* w_o = X.in[17] + (size_t)layer * DM * DM;
    const float* w_up = X.in[19] + (size_t)layer * DM * F2;
    const float* w_dn = X.in[22] + (size_t)layer * DFF * DM;
    for (int it = gw; it < NITEMS; it += NGW) {
        int r = it;
        if (r < I_IN) { tr_item(w_in, IN_COLS, DM, 5120, X.Win, 1, r, scr, X.lane); continue; } r -= I_IN;
        if (r < I_G) { tr_item(w_in, IN_COLS, DM, 3072, X.Wg, 2, r, scr, X.lane); continue; } r -= I_G;
        if (r < 3 * I_BR) { const int b = r / I_BR; tr_item(w_br + (size_t)b * 512 * DM, DM, 512, DM, X.Wbr + (size_t)b * DM * 512, 0, r % I_BR, scr, X.lane); continue; } r -= 3 * I_BR;
        if (r < I_O) { tr_item(w_o, DM, DM, DM, X.Wo, 0, r, scr, X.lane); continue; } r -= I_O;
        if (r < I_UP) { tr_item(w_up, F2, DM, F2, X.Wup, 3, r, scr, X.lane); continue; } r -= I_UP;
        tr_item(w_dn, DM, DFF, DM, X.Wdn, 0, r, scr, X.lane);
    }
    const float* h = (layer == 0) ? X.in[0] : X.out;
    const float* g = X.in[1] + (size_t)layer * DM;
    for (int m = gw; m < T_TOK; m += NGW) rms_row(h + (size_t)m * DM, g, X.P + (size_t)m * LDP, nullptr, X.lane);
    if (layer == 0) {
        for (int idx = X.bid * 512 + X.tid; idx < SEQ * 32; idx += X.G * 512) {
            const int t = idx >> 5, p = idx & 31;
            const float inv = exp2f(-(float)p * 0.03125f * 13.287712379549449f);
            const float ang = (float)t * inv;
            const double rev = (double)ang * 0.15915494309189535;
            const float fr = (float)(rev - floor(rev));
            X.ROPE[2 * idx] = __builtin_amdgcn_cosf(fr); X.ROPE[2 * idx + 1] = __builtin_amdgcn_sinf(fr);
        }
    }
}

__device__ __forceinline__ void rwkv_task(const Ctx& X, LAS unsigned char* lds, int layer, int b, int h) {
    LAS float* A_ = (LAS float*)(lds);            LAS float* WR = (LAS float*)(lds + 8192);   LAS float* Wd = (LAS float*)(lds + 16384);
    LAS float* Bv = (LAS float*)(lds + 24576);    LAS float* Kk = (LAS float*)(lds + 32768);  LAS float* Vv = (LAS float*)(lds + 40960);
    LAS float* Rr = (LAS float*)(lds + 49152);    LAS float* Gg = (LAS float*)(lds + 57344);  LAS float* Yy = (LAS float*)(lds + 65536);
    LAS float* AS = (LAS float*)(lds + 73728);
    LAS bf16_t* WDb = (LAS bf16_t*)(lds + 81920);
    LAS bf16_t* ADb = (LAS bf16_t*)(lds + 86528);
    LAS bf16_t* GDb = (LAS bf16_t*)(lds + 91136);
    LAS bf16_t* WTu = (LAS bf16_t*)(lds + 99840);
    LAS bf16_t* WTa = (LAS bf16_t*)(lds + 109056);
    LAS bf16_t* WTg = (LAS bf16_t*)(lds + 118272);
    LAS float* SC = (LAS float*)(lds + 135680);
    LAS float* CARRY = (LAS float*)(lds + 136192);
    const int tid = X.tid, lane = tid & 63, wv = X.wave;
    const float* mu = X.in[3] + layer * 1792;
    const float* w0 = X.in[4] + layer * 512;   const float* w_up = X.in[5] + (size_t)layer * 64 * 512;
    const float* a0 = X.in[6] + layer * 512;   const float* a_up = X.in[7] + (size_t)layer * 64 * 512;
    const float* g_up = X.in[8] + (size_t)layer * 128 * 512;
    const float* k_k = X.in[9] + layer * 512;  const float* k_a = X.in[10] + layer * 512;  const float* r_k = X.in[11] + layer * 512;
    const float* gn_g = X.in[12] + layer * 512; const float* gn_b = X.in[13] + layer * 512;
    const int c = tid & 63, tg = tid >> 6, hc = h * 64 + c;
    const float p_kk = k_k[hc], p_ka = k_a[hc], p_rk = r_k[hc], p_gg = gn_g[hc], p_gb = gn_b[hc];
    const int mt = wv & 1, nt = wv >> 1, ln = lane & 15, lg = lane >> 4;
    const int chm = 16 * nt + ln;
    const float q_w0 = w0[h * 64 + chm], q_a0 = a0[h * 64 + chm];
    const int rp = tid >> 3, jg = tid & 7, i0 = 2 * rp;
    for (int idx = tid; idx < 64 * 64; idx += 512) { const int m = idx >> 6, cc = idx & 63;
        WTu[cc * 72 + m] = (bf16_t)f2bf(w_up[m * 512 + h * 64 + cc]); WTa[cc * 72 + m] = (bf16_t)f2bf(a_up[m * 512 + h * 64 + cc]); }
    for (int idx = tid; idx < 128 * 64; idx += 512) { const int m = idx >> 6, cc = idx & 63; WTg[cc * 136 + m] = (bf16_t)f2bf(g_up[m * 512 + h * 64 + cc]); }
    float S0[8], S1[8];
#pragma unroll
    for (int j = 0; j < 8; ++j) { S0[j] = 0.f; S1[j] = 0.f; }
    __syncthreads();
#pragma unroll 1
    for (int ch = 0; ch < SEQ / 32; ++ch) {
        const int t0 = ch * 32, par = ch & 1;
        {
            u32x4 cur4[4], prv4[4];
#pragma unroll
            for (int it = 0; it < 4; ++it) {
                const int idx = tid + 512 * it; const bool valid = idx < 32 * 56;
                const int tt = idx / 56, vv = idx - tt * 56;
                const int col = vv < 8 ? h * 64 + 8 * vv : (vv < 16 ? 512 + h * 64 + 8 * (vv - 8) : (vv < 24 ? 1024 + h * 64 + 8 * (vv - 16) : 1536 + 8 * (vv - 24)));
                const bf16_t* pc = X.P + ((size_t)b * SEQ + t0 + tt) * LDP + COL_PA + col;
                cur4[it] = (u32x4){0u, 0u, 0u, 0u}; prv4[it] = (u32x4){0u, 0u, 0u, 0u};
                if (valid) { cur4[it] = *(const u32x4*)pc; if (tt > 0) prv4[it] = *(const u32x4*)(pc - LDP); }
            }
#pragma unroll
            for (int it = 0; it < 4; ++it) {
                const int idx = tid + 512 * it;
                if (idx < 32 * 56) {
                    const int tt = idx / 56, vv = idx - tt * 56, cc0 = 8 * vv;
                    const int col = vv < 8 ? h * 64 + 8 * vv : (vv < 16 ? 512 + h * 64 + 8 * (vv - 8) : (vv < 24 ? 1024 + h * 64 + 8 * (vv - 16) : 1536 + 8 * (vv - 24)));
                    const f32x4 m0 = *(const f32x4*)(mu + col), m1 = *(const f32x4*)(mu + col + 4);
                    float cur[8], prv[8], val[8];
                    cur[0] = bflo(cur4[it].x); cur[1] = bfhi(cur4[it].x); cur[2] = bflo(cur4[it].y); cur[3] = bfhi(cur4[it].y);
                    cur[4] = bflo(cur4[it].z); cur[5] = bfhi(cur4[it].z); cur[6] = bflo(cur4[it].w); cur[7] = bfhi(cur4[it].w);
                    prv[0] = bflo(prv4[it].x); prv[1] = bfhi(prv4[it].x); prv[2] = bflo(prv4[it].y); prv[3] = bfhi(prv4[it].y);
                    prv[4] = bflo(prv4[it].z); prv[5] = bfhi(prv4[it].z); prv[6] = bflo(prv4[it].w); prv[7] = bfhi(prv4[it].w);
                    if (tt == 0) {
#pragma unroll
                        for (int e = 0; e < 8; ++e) prv[e] = (ch > 0) ? CARRY[(par ^ 1) * 448 + cc0 + e] : 0.f;
                    }
                    if (tt == 31) {
#pragma unroll
                        for (int e = 0; e < 8; ++e) CARRY[par * 448 + cc0 + e] = cur[e];
                    }
#pragma unroll
                    for (int e = 0; e < 8; ++e) val[e] = cur[e] + (prv[e] - cur[e]) * (e < 4 ? m0[e & 3] : m1[e & 3]);
                    if (vv < 24) {
                        LAS float* dst = (vv < 8 ? Rr : (vv < 16 ? Kk : Vv)) + tt * 64 + 8 * (vv & 7);
                        *(LAS f32x4*)dst = (f32x4){val[0], val[1], val[2], val[3]}; *(LAS f32x4*)(dst + 4) = (f32x4){val[4], val[5], val[6], val[7]};
                    } else {
                        const int lr0 = 8 * (vv - 24);
                        LAS bf16_t* dst;
                        if (lr0 < 64) { dst = WDb + tt * 72 + lr0;
#pragma unroll
                            for (int e = 0; e < 8; ++e) val[e] = tanhf(val[e]); }
                        else if (lr0 < 128) dst = ADb + tt * 72 + lr0 - 64;
                        else { dst = GDb + tt * 136 + lr0 - 128;
#pragma unroll
                            for (int e = 0; e < 8; ++e) val[e] = sigmoidf_(val[e]); }
                        u32x4 o; o.x = pk2(val[0], val[1]); o.y = pk2(val[2], val[3]); o.z = pk2(val[4], val[5]); o.w = pk2(val[6], val[7]);
                        *(LAS u32x4*)dst = o;
                    }
                }
            }
        }
        __syncthreads();
        {
            f32x4 cw_ = (f32x4){0.f, 0.f, 0.f, 0.f}, ca_ = cw_, cg_ = cw_;
#pragma unroll
            for (int ks = 0; ks < 2; ++ks) {
                const bf16x8 xa = *(const LAS bf16x8*)&WDb[(16 * mt + ln) * 72 + ks * 32 + 8 * lg], xb = *(const LAS bf16x8*)&WTu[(16 * nt + ln) * 72 + ks * 32 + 8 * lg];
                cw_ = __builtin_amdgcn_mfma_f32_16x16x32_bf16(xa, xb, cw_, 0, 0, 0);
                const bf16x8 ya = *(const LAS bf16x8*)&ADb[(16 * mt + ln) * 72 + ks * 32 + 8 * lg], yb = *(const LAS bf16x8*)&WTa[(16 * nt + ln) * 72 + ks * 32 + 8 * lg];
                ca_ = __builtin_amdgcn_mfma_f32_16x16x32_bf16(ya, yb, ca_, 0, 0, 0);
            }
#pragma unroll
            for (int ks = 0; ks < 4; ++ks) {
                const bf16x8 za = *(const LAS bf16x8*)&GDb[(16 * mt + ln) * 136 + ks * 32 + 8 * lg], zb = *(const LAS bf16x8*)&WTg[(16 * nt + ln) * 136 + ks * 32 + 8 * lg];
                cg_ = __builtin_amdgcn_mfma_f32_16x16x32_bf16(za, zb, cg_, 0, 0, 0);
            }
#pragma unroll
            for (int r = 0; r < 4; ++r) {
                const int tt = 16 * mt + 4 * lg + r;
                const float z = -(q_w0 + cw_[r]);
                const float sp = fmaxf(z, 0.f) + log1pf(__expf(-fabsf(z)));
                Wd[tt * 64 + chm] = __expf(-__expf(-sp - 0.5f));
                AS[tt * 64 + chm] = sigmoidf_(q_a0 + ca_[r]);
                Gg[tt * 64 + chm] = cg_[r];
            }
        }
        __syncthreads();
#pragma unroll
        for (int i = 0; i < 4; ++i) {
            const int tt = 4 * tg + i;
            const float decay = Wd[tt * 64 + c], a = AS[tt * 64 + c];
            const float kraw = Kk[tt * 64 + c], r = Rr[tt * 64 + c];
            float kk = kraw * p_kk;
            const float ss = wave_sum(kk * kk);
            kk *= 1.f / sqrtf(fmaxf(ss, 1e-24f));
            const float kmod = kraw * (1.f + (a - 1.f) * p_ka);
            const float bvec = kk * a;
            const float br = wave_sum(bvec * r), kr = wave_sum(kmod * r), bonus = wave_sum(r * kmod * p_rk);
            A_[tt * 64 + c] = -kk; Bv[tt * 64 + c] = bvec; WR[tt * 64 + c] = decay * r; Kk[tt * 64 + c] = kmod;
            if (c == 0) { SC[tt * 4 + 0] = br; SC[tt * 4 + 1] = kr; SC[tt * 4 + 2] = bonus; }
        }
        __syncthreads();
        if (tid < 256) {
#pragma unroll 2
            for (int tt = 0; tt < 32; ++tt) {
                const f32x4 a_lo = *(const LAS f32x4*)&A_[tt * 64 + 8 * jg], a_hi = *(const LAS f32x4*)&A_[tt * 64 + 8 * jg + 4];
                const f32x4 r_lo = *(const LAS f32x4*)&WR[tt * 64 + 8 * jg], r_hi = *(const LAS f32x4*)&WR[tt * 64 + 8 * jg + 4];
                const f32x4 w_lo = *(const LAS f32x4*)&Wd[tt * 64 + 8 * jg], w_hi = *(const LAS f32x4*)&Wd[tt * 64 + 8 * jg + 4];
                const f32x4 b_lo = *(const LAS f32x4*)&Bv[tt * 64 + 8 * jg], b_hi = *(const LAS f32x4*)&Bv[tt * 64 + 8 * jg + 4];
                const f32x4 k_lo = *(const LAS f32x4*)&Kk[tt * 64 + 8 * jg], k_hi = *(const LAS f32x4*)&Kk[tt * 64 + 8 * jg + 4];
                const f32x2 vv = *(const LAS f32x2*)&Vv[tt * 64 + i0];
                const f32x2 sc = *(const LAS f32x2*)&SC[tt * 4];
                float av[8], rv[8], wvv[8], bv[8], kv[8];
#pragma unroll
                for (int j = 0; j < 4; ++j) { av[j] = a_lo[j]; av[4 + j] = a_hi[j]; rv[j] = r_lo[j]; rv[4 + j] = r_hi[j]; wvv[j] = w_lo[j]; wvv[4 + j] = w_hi[j]; bv[j] = b_lo[j]; bv[4 + j] = b_hi[j]; kv[j] = k_lo[j]; kv[4 + j] = k_hi[j]; }
                float d10 = 0.f, d20 = 0.f, d11 = 0.f, d21 = 0.f;
#pragma unroll
                for (int j = 0; j < 8; ++j) { d10 += S0[j] * av[j]; d20 += S0[j] * rv[j]; d11 += S1[j] * av[j]; d21 += S1[j] * rv[j]; }
                d10 = red8(d10); d20 = red8(d20); d11 = red8(d11); d21 = red8(d21);
                const float y0 = d20 + d10 * sc.x + vv.x * sc.y, y1 = d21 + d11 * sc.x + vv.y * sc.y;
                if (jg == 0) *(LAS f32x2*)&Yy[tt * 64 + i0] = (f32x2){y0, y1};
#pragma unroll
                for (int j = 0; j < 8; ++j) { S0[j] = S0[j] * wvv[j] + d10 * bv[j] + vv.x * kv[j]; S1[j] = S1[j] * wvv[j] + d11 * bv[j] + vv.y * kv[j]; }
            }
        }
        __syncthreads();
#pragma unroll
        for (int i = 0; i < 4; ++i) {
            const int tt = 4 * tg + i;
            const float y = Yy[tt * 64 + c];
            const float mean = wave_sum(y) * (1.f / 64.f), d = y - mean;
            const float var = wave_sum(d * d) * (1.f / 64.f);
            float yn = d * (1.f / sqrtf(var + 64e-5f)) * p_gg + p_gb;
            yn += SC[tt * 4 + 2] * Vv[tt * 64 + c];
            const float o = yn * Gg[tt * 64 + c];
            X.P[((size_t)b * SEQ + t0 + tt) * LDP + COL_YA + hc] = (bf16_t)f2bf(o);
        }
        __syncthreads();
    }
}

__device__ __forceinline__ void hgrn_task(const Ctx& X, LAS unsigned char* lds, int layer, int b, int h, int vh) {
    LAS float* F = (LAS float*)(lds); LAS float* Q = (LAS float*)(lds + 16384); LAS float* Vv = (LAS float*)(lds + 32768); LAS float* O = (LAS float*)(lds + 40960);
    LAS float* LB = (LAS float*)(lds + 49152);
    const int tid = X.tid;
    const float* lbl = X.in[14];
    const int rp = tid >> 4, dg = tid & 15, v0 = 2 * rp;
    if (tid < 128) LB[tid] = (layer > 0) ? 1.f / (1.f + __expf(lbl[h * 128 + tid] - lbl[512 + h * 128 + tid])) : 0.f;
    float S0[8], S1[8];
#pragma unroll
    for (int j = 0; j < 8; ++j) { S0[j] = 0.f; S1[j] = 0.f; }
    __syncthreads();
#pragma unroll 1
    for (int ch = 0; ch < SEQ / 32; ++ch) {
        const int t0 = ch * 32;
        {
            u32x4 raw[3];
#pragma unroll
            for (int it = 0; it < 3; ++it) {
                const int idx = tid + 512 * it; raw[it] = (u32x4){0u, 0u, 0u, 0u};
                if (idx < 32 * 40) {
                    const int tt = idx / 40, vv = idx - tt * 40;
                    const int col = vv < 16 ? 512 + h * 128 + 8 * vv : (vv < 32 ? h * 128 + 8 * (vv - 16) : 1024 + h * 128 + vh * 64 + 8 * (vv - 32));
                    raw[it] = *(const u32x4*)(X.P + ((size_t)b * SEQ + t0 + tt) * LDP + COL_PB + col);
                }
            }
#pragma unroll
            for (int it = 0; it < 3; ++it) {
                const int idx = tid + 512 * it;
                if (idx < 32 * 40) {
                    const int tt = idx / 40, vv = idx - tt * 40;
                    float x[8];
                    x[0] = bflo(raw[it].x); x[1] = bfhi(raw[it].x); x[2] = bflo(raw[it].y); x[3] = bfhi(raw[it].y);
                    x[4] = bflo(raw[it].z); x[5] = bfhi(raw[it].z); x[6] = bflo(raw[it].w); x[7] = bfhi(raw[it].w);
                    LAS float* dst;
                    if (vv < 16) {
                        dst = F + tt * 128 + 8 * vv;
#pragma unroll
                        for (int e = 0; e < 8; ++e) { const float lb = LB[8 * vv + e]; x[e] = lb + (1.f - lb) * sigmoidf_(x[e]); }
                    } else if (vv < 32) dst = Q + tt * 128 + 8 * (vv - 16);
                    else dst = Vv + tt * 64 + 8 * (vv - 32);
                    *(LAS f32x4*)dst = (f32x4){x[0], x[1], x[2], x[3]}; *(LAS f32x4*)(dst + 4) = (f32x4){x[4], x[5], x[6], x[7]};
                }
            }
        }
        __syncthreads();
#pragma unroll 2
        for (int tt = 0; tt < 32; ++tt) {
            const f32x4 f_lo = *(const LAS f32x4*)&F[tt * 128 + 8 * dg], f_hi = *(const LAS f32x4*)&F[tt * 128 + 8 * dg + 4];
            const f32x4 q_lo = *(const LAS f32x4*)&Q[tt * 128 + 8 * dg], q_hi = *(const LAS f32x4*)&Q[tt * 128 + 8 * dg + 4];
            const f32x2 vv = *(const LAS f32x2*)&Vv[tt * 64 + v0];
            float o0 = 0.f, o1 = 0.f;
#pragma unroll
            for (int j = 0; j < 8; ++j) {
                const float f = j < 4 ? f_lo[j & 3] : f_hi[j & 3], q = j < 4 ? q_lo[j & 3] : q_hi[j & 3];
                S0[j] = vv.x + f * (S0[j] - vv.x); S1[j] = vv.y + f * (S1[j] - vv.y);
                o0 += q * S0[j]; o1 += q * S1[j];
            }
            o0 = red16(o0); o1 = red16(o1);
            if (dg == 0) *(LAS f32x2*)&O[tt * 64 + v0] = (f32x2){o0, o1};
        }
        __syncthreads();
        if (tid < 256) {
            const int tt = tid >> 3, v8 = (tid & 7) * 8;
            const f32x4 a = *(const LAS f32x4*)&O[tt * 64 + v8], c4 = *(const LAS f32x4*)&O[tt * 64 + v8 + 4];
            u32x4 o; o.x = pk2(a.x, a.y); o.y = pk2(a.z, a.w); o.z = pk2(c4.x, c4.y); o.w = pk2(c4.z, c4.w);
            *(u32x4*)(X.P + ((size_t)b * SEQ + t0 + tt) * LDP + COL_YB + h * 128 + vh * 64 + v8) = o;
        }
    }
    __syncthreads();
}

__device__ __forceinline__ unsigned f2ord(float f) { const unsigned u = __builtin_bit_cast(unsigned, f); return (u & 0x80000000u) ? ~u : (u | 0x80000000u); }

__device__ __forceinline__ void dsa_tile(const Ctx& X, LAS unsigned char* lds, int b, int q0) {
    LAS float* sc = (LAS float*)lds;
    LAS unsigned* MASK = (LAS unsigned*)(lds + MASK_OFF);
    const int lane = X.lane, w = X.wave, n = lane & 15, g = lane >> 4;
    const bf16_t* Pb = X.P + (size_t)b * SEQ * LDP;
#pragma unroll 1
    for (int sub = 0; sub < 4; ++sub) {
        const int qs = q0 + 16 * sub;
        {
            bf16x8 bq[4][2]; float wi[4];
            const bf16_t* qrow = Pb + (size_t)(qs + n) * LDP;
#pragma unroll
            for (int hh = 0; hh < 4; ++hh) {
#pragma unroll
                for (int ks = 0; ks < 2; ++ks) bq[hh][ks] = *(const bf16x8*)(qrow + C_QI + hh * 64 + ks * 32 + 8 * g);
                wi[hh] = bf2f(qrow[C_WI + hh]);
            }
            const int nkt = (qs + 16) >> 4;
            bf16x8 a0n = (bf16x8){0, 0, 0, 0, 0, 0, 0, 0}, a1n = a0n;
            if (w < nkt) { const bf16_t* krow = Pb + (size_t)(w * 16 + n) * LDP + C_KI; a0n = *(const bf16x8*)(krow + 8 * g); a1n = *(const bf16x8*)(krow + 32 + 8 * g); }
#pragma unroll 1
            for (int kt = w; kt < nkt; kt += 8) {
                const bf16x8 a0 = a0n, a1 = a1n;
                if (kt + 8 < nkt) { const bf16_t* krow = Pb + (size_t)((kt + 8) * 16 + n) * LDP + C_KI; a0n = *(const bf16x8*)(krow + 8 * g); a1n = *(const bf16x8*)(krow + 32 + 8 * g); }
                f32x4 s = (f32x4){0.f, 0.f, 0.f, 0.f};
#pragma unroll
                for (int hh = 0; hh < 4; ++hh) {
                    f32x4 d = __builtin_amdgcn_mfma_f32_16x16x32_bf16(a0, bq[hh][0], (f32x4){0.f, 0.f, 0.f, 0.f}, 0, 0, 0);
                    d = __builtin_amdgcn_mfma_f32_16x16x32_bf16(a1, bq[hh][1], d, 0, 0, 0);
#pragma unroll
                    for (int r = 0; r < 4; ++r) s[r] += wi[hh] * fmaxf(d[r], 0.f);
                }
                const int t = qs + n;
#pragma unroll
                for (int r = 0; r < 4; ++r) if (kt * 16 + 4 * g + r > t) s[r] = -INFINITY;
                *(LAS f32x4*)&sc[n * SCS + kt * 16 + 4 * g] = s;
            }
        }
        __syncthreads();
#pragma unroll 1
        for (int e = 0; e < 2; ++e) {
            const int qn = 2 * w + e, t = qs + qn;
            LAS unsigned* mrow = MASK + (sub * 16 + qn) * 64;
            if (t < 256) {
#pragma unroll
                for (int j = 0; j < 32; ++j) {
                    const unsigned long long sm = __ballot(j * 64 + lane <= t);
                    if (lane == 0) { mrow[2 * j] = (unsigned)sm; mrow[2 * j + 1] = (unsigned)(sm >> 32); }
                }
            } else {
                const int jn = (t >> 6) + 1;
                unsigned u[32];
#pragma unroll
                for (int j = 0; j < 32; ++j) {
                    u[j] = 0u;
                    if (j < jn) { const int key = j * 64 + lane; const float s = (key <= t) ? sc[qn * SCS + key] : -INFINITY; u[j] = f2ord(s); }
                }
                unsigned prefix = 0u;
#pragma unroll 1
                for (int bit = 31; bit >= 0; --bit) {
                    const unsigned cand = prefix | (1u << bit);
                    int cnt = 0;
#pragma unroll
                    for (int j = 0; j < 32; ++j) if (j < jn) cnt += (u[j] >= cand) ? 1 : 0;
                    cnt = wave_sum_i(cnt);
                    if (cnt >= 256) prefix = cand;
                }
                int cg_ = 0;
#pragma unroll
                for (int j = 0; j < 32; ++j) if (j < jn) cg_ += (u[j] > prefix) ? 1 : 0;
                cg_ = wave_sum_i(cg_);
                const int need = 256 - cg_;
                int cum = 0;
#pragma unroll
                for (int j = 0; j < 32; ++j) {
                    unsigned long long sm = 0ull;
                    if (j < jn) {
                        const bool eq = (u[j] == prefix);
                        const unsigned long long em = __ballot(eq);
                        const int rank = cum + (int)__builtin_amdgcn_mbcnt_hi((unsigned)(em >> 32), __builtin_amdgcn_mbcnt_lo((unsigned)em, 0u));
                        const bool sel = (u[j] > prefix) || (eq && rank < need);
                        sm = __ballot(sel);
                        cum += __popcll(em);
                    }
                    if (lane == 0) { mrow[2 * j] = (unsigned)sm; mrow[2 * j + 1] = (unsigned)(sm >> 32); }
                }
            }
        }
        __syncthreads();
    }
    const int qq = q0 + 8 * w + (n & 7);
    const LAS unsigned* mq = MASK + (8 * w + (n & 7)) * 64;
    const int nsteps = (q0 + 8 * w + 8 + 31) >> 5;
#pragma unroll 1
    for (int c = 0; c < 2; ++c) {
        bf16x8 bq[2][2];
#pragma unroll
        for (int j = 0; j < 2; ++j)
#pragma unroll
            for (int ks = 0; ks < 2; ++ks) bq[j][ks] = *(const bf16x8*)(Pb + (size_t)qq * LDP + C_Q + (c * 4 + 2 * j + (n >> 3)) * 64 + ks * 32 + 8 * g);
        float mrun[2] = {-INFINITY, -INFINITY}, lrun[2] = {0.f, 0.f};
        f32x4 oacc[4][2];
#pragma unroll
        for (int mt = 0; mt < 4; ++mt)
#pragma unroll
            for (int j = 0; j < 2; ++j) oacc[mt][j] = (f32x4){0.f, 0.f, 0.f, 0.f};
        const bf16_t* vtb = X.VT + ((size_t)(b * 2 + c) * 64) * SEQ;
#define DSA_LOAD(KA, VL, VH, kb_) do { _Pragma("unroll") for (int tl = 0; tl < 2; ++tl) { const bf16_t* krow = Pb + (size_t)((kb_) + 16 * tl + n) * LDP + C_K + c * 64; \
            KA[tl][0] = *(const bf16x8*)(krow + 8 * g); KA[tl][1] = *(const bf16x8*)(krow + 32 + 8 * g); } \
            _Pragma("unroll") for (int mt = 0; mt < 4; ++mt) { const bf16_t* vp = vtb + (size_t)(mt * 16 + n) * SEQ + (kb_) + 4 * g; VL[mt] = *(const u32x2*)vp; VH[mt] = *(const u32x2*)(vp + 16); } } while (0)
        bf16x8 kan[2][2]; u32x2 vln[4], vhn[4];
        DSA_LOAD(kan, vln, vhn, 0);
#pragma unroll 1
        for (int s = 0; s < nsteps; ++s) {
            const int kb = 32 * s;
            bf16x8 ka[2][2]; bf16x8 av[4];
#pragma unroll
            for (int tl = 0; tl < 2; ++tl) { ka[tl][0] = kan[tl][0]; ka[tl][1] = kan[tl][1]; }
#pragma unroll
            for (int mt = 0; mt < 4; ++mt) { u32x4 t4; t4.x = vln[mt].x; t4.y = vln[mt].y; t4.z = vhn[mt].x; t4.w = vhn[mt].y; av[mt] = __builtin_bit_cast(bf16x8, t4); }
            if (s + 1 < nsteps) DSA_LOAD(kan, vln, vhn, kb + 32);
            f32x4 st[2][2];
#pragma unroll
            for (int tl = 0; tl < 2; ++tl) {
#pragma unroll
                for (int j = 0; j < 2; ++j) {
                    f32x4 d = __builtin_amdgcn_mfma_f32_16x16x32_bf16(ka[tl][0], bq[j][0], (f32x4){0.f, 0.f, 0.f, 0.f}, 0, 0, 0);
                    st[tl][j] = __builtin_amdgcn_mfma_f32_16x16x32_bf16(ka[tl][1], bq[j][1], d, 0, 0, 0);
                }
            }
            const unsigned mw = mq[s];
#pragma unroll
            for (int j = 0; j < 2; ++j) {
                float lg[8];
#pragma unroll
                for (int tl = 0; tl < 2; ++tl)
#pragma unroll
                    for (int r = 0; r < 4; ++r) { const int bit = 16 * tl + 4 * g + r; lg[4 * tl + r] = ((mw >> bit) & 1u) ? st[tl][j][r] * 0.125f : -INFINITY; }
                float mx = lg[0];
#pragma unroll
                for (int i = 1; i < 8; ++i) mx = fmaxf(mx, lg[i]);
                mx = fmaxf(mx, __shfl_xor(mx, 16)); mx = fmaxf(mx, __shfl_xor(mx, 32));
                const float mnew = fmaxf(mrun[j], mx);
                const float muse = (mnew == -INFINITY) ? 0.f : mnew;
                const float alpha = __expf(mrun[j] - muse);
                float p[8], ps = 0.f;
#pragma unroll
                for (int i = 0; i < 8; ++i) { p[i] = __expf(lg[i] - muse); ps += p[i]; }
                ps += __shfl_xor(ps, 16); ps += __shfl_xor(ps, 32);
                lrun[j] = lrun[j] * alpha + ps; mrun[j] = mnew;
                u32x4 pw; pw.x = pg8::cvt_pk_bf16(p[0], p[1]); pw.y = pg8::cvt_pk_bf16(p[2], p[3]); pw.z = pg8::cvt_pk_bf16(p[4], p[5]); pw.w = pg8::cvt_pk_bf16(p[6], p[7]);
                const bf16x8 pb = __builtin_bit_cast(bf16x8, pw);
#pragma unroll
                for (int mt = 0; mt < 4; ++mt) {
                    oacc[mt][j] = oacc[mt][j] * alpha;
                    oacc[mt][j] = __builtin_amdgcn_mfma_f32_16x16x32_bf16(av[mt], pb, oacc[mt][j], 0, 0, 0);
                }
            }
        }
#pragma unroll
        for (int j = 0; j < 2; ++j) {
            const float il = 1.f / lrun[j];
            bf16_t* op = X.P + ((size_t)b * SEQ + qq) * LDP + COL_YC + (c * 4 + 2 * j + (n >> 3)) * 64 + 4 * g;
#pragma unroll
            for (int mt = 0; mt < 4; ++mt) {
                const f32x4 o = oacc[mt][j] * il;
                u32x2 wv; wv.x = pg8::cvt_pk_bf16(o[0], o[1]); wv.y = pg8::cvt_pk_bf16(o[2], o[3]);
                *(u32x2*)(op + mt * 16) = wv;
            }
        }
    }
#undef DSA_LOAD
    __syncthreads();
}

__device__ __forceinline__ void phase_mixers(const Ctx& X0, LAS unsigned char* lds, int layer) {
#pragma unroll 1
    for (int task = X0.bid; task < 256; task += X0.G) {
        Ctx X = X0;
        { int t_ = threadIdx.x; asm volatile("" : "+v"(t_)); X.tid = t_; X.lane = t_ & 63; }
        if (task < 64) { if (TKMASK & 1) rwkv_task(X, lds, layer, task >> 3, task & 7); }
        else if (task < 128) { const int k = task - 64; if (TKMASK & 2) hgrn_task(X, lds, layer, k >> 3, (k >> 1) & 3, k & 1); }
        else if (TKMASK & 4) {
            const int k = task - 128, b = k >> 4, p = k & 15;
#pragma unroll 1
            for (int rep = 0; rep < 2; ++rep) dsa_tile(X, lds, b, rep == 0 ? 64 * (31 - p) : 64 * p);
        }
    }
}

__device__ __forceinline__ void phase_hgrn_post(const Ctx& X, int layer) {
    const int gw = X.bid * 8 + X.wave, NGW = X.G * 8;
    const float* gn = X.in[15] + layer * 512;
    for (int it = gw; it < T_TOK * 4; it += NGW) {
        const int t = it >> 2, h = it & 3;
        bf16_t* rowp = X.P + (size_t)t * LDP;
        unsigned* op = (unsigned*)(rowp + COL_YB + h * 128) + X.lane;
        const unsigned ow = *op, gwd = *((const unsigned*)(rowp + COL_PB + 1536 + h * 128) + X.lane);
        const float o0 = bflo(ow), o1 = bfhi(ow), g0 = bflo(gwd), g1 = bfhi(gwd);
        const float rs = 1.f / sqrtf(wave_sum(o0 * o0 + o1 * o1) * (1.f / 128.f) + 1e-6f);
        const float y0 = o0 * rs * gn[h * 128 + 2 * X.lane] * (g0 * sigmoidf_(g0)), y1 = o1 * rs * gn[h * 128 + 2 * X.lane + 1] * (g1 * sigmoidf_(g1));
        *op = pk2(y0, y1);
    }
}

__device__ __forceinline__ void phase_fixup(const Ctx& X, int layer) {
    const float* cw = X.in[20] + (size_t)layer * 3 * F2; const float* cb = X.in[21] + (size_t)layer * F2;
    for (int idx = X.bid * 512 + X.tid; idx < 256 * 2 * DFF; idx += X.G * 512) {
        const int j = idx % DFF, sr = idx / DFF, s = sr >> 1, r = sr & 1;
        const int colg = (j >> 7) * 256 + (j & 127), colv = colg + 128;
        const bool seq0 = (s & 31) == 0;
        const float* H = X.HALO;
        float res[2];
#pragma unroll
        for (int part = 0; part < 2; ++part) {
            const int cp = part ? colv : colg, co = part * DFF + j;
            const float u0 = H[(size_t)(s * 4 + r) * F2 + cp];
            float u1, u2;
            if (r == 0) { u1 = seq0 ? 0.f : H[(size_t)((s - 1) * 4 + 3) * F2 + cp]; u2 = seq0 ? 0.f : H[(size_t)((s - 1) * 4 + 2) * F2 + cp]; }
            else { u1 = H[(size_t)(s * 4 + 0) * F2 + cp]; u2 = seq0 ? 0.f : H[(size_t)((s - 1) * 4 + 3) * F2 + cp]; }
            res[part] = cb[co] + cw[co] * u2 + cw[F2 + co] * u1 + cw[2 * F2 + co] * u0;
        }
        const float a = res[0] * sigmoidf_(res[0]) * res[1];
        X.P[(size_t)(s * 64 + r) * LDP + COL_ACT + j] = (bf16_t)f2bf(a);
    }
}

#define XB_TMO      128
#define XB_XCNT(j)  (256  + 64 * (j))
#define XB_XSUB(j)  (1280 + 64 * (j))
#define XB_XGEN(j)  (2304 + 64 * (j))
#define XB_TOP      3328
#define XB_TOPGEN   3392
#define XCD_BAR_WORDS 3456
#define XB_SPIN_CAP (1u << 22)
__device__ __forceinline__ unsigned xb_ld(unsigned* p)              { return __hip_atomic_load(p, __ATOMIC_RELAXED, __HIP_MEMORY_SCOPE_AGENT); }
__device__ __forceinline__ unsigned xb_add(unsigned* p, unsigned v) { return __hip_atomic_fetch_add(p, v, __ATOMIC_RELAXED, __HIP_MEMORY_SCOPE_AGENT); }
__device__ __forceinline__ unsigned xb_xcc_id() { return (unsigned)__builtin_amdgcn_s_getreg((3 << 11) | 20) & 0xFu; }
#define XB_SPIN(cond, bar) do { unsigned _sp = 0; while (cond) { __builtin_amdgcn_s_sleep(1); \
    if ((++_sp & 255u) == 0u) { if (xb_ld(&(bar)[XB_TMO])) break; if (_sp > XB_SPIN_CAP) { atomicAdd(&(bar)[XB_TMO], 1u); break; } } } } while (0)
struct XcdBarrier { unsigned* bar; unsigned x; volatile LAS unsigned* st; };
__device__ __forceinline__ XcdBarrier xcd_barrier_post(unsigned* bar, volatile LAS unsigned* st) {
    XcdBarrier b; b.bar = bar; b.x = xb_xcc_id(); b.st = st;
    if (threadIdx.x == 0) (void)xb_add(&bar[XB_XCNT(b.x)], 1u);
    return b;
}
__device__ __forceinline__ void xcd_barrier_complete(unsigned* bar, unsigned x, unsigned& nloc, unsigned& nx) {
    const unsigned G = gridDim.x * gridDim.y * gridDim.z;
    unsigned sum, cnt, mine, sp = 0u;
    for (;;) {
        sum = 0u; cnt = 0u; mine = 0u;
#pragma unroll
        for (unsigned j = 0; j < 16; ++j) { const unsigned c = xb_ld(&bar[XB_XCNT(j)]); sum += c; cnt += (c > 0u) ? 1u : 0u; mine = (j == x) ? c : mine; }
        if (sum == G) break;
        __builtin_amdgcn_s_sleep(1);
        if ((++sp & 255u) == 0u) { if (xb_ld(&bar[XB_TMO])) break; if (sp > XB_SPIN_CAP) { atomicAdd(&bar[XB_TMO], 1u); break; } }
    }
    nloc = mine > 0u ? mine : 1u; nx = cnt > 0u ? cnt : 1u;
}
__device__ __forceinline__ void xcd_barrier(const XcdBarrier& b) {
    asm volatile("s_waitcnt vmcnt(0)" ::: "memory");
    __syncthreads();
    if (threadIdx.x == 0) {
        unsigned* bar = b.bar;
        __builtin_amdgcn_s_waitcnt(0);
        unsigned nloc = b.st[0], nx = b.st[1];
        if (nloc == 0u) { xcd_barrier_complete(bar, b.x, nloc, nx); b.st[0] = nloc; b.st[1] = nx; }
        const unsigned old = xb_add(&bar[XB_XSUB(b.x)], 1u);
        const unsigned gen = old / nloc;
        if (old + 1u == (gen + 1u) * nloc) {
            __builtin_amdgcn_fence(__ATOMIC_RELEASE, "agent");
            asm volatile("s_waitcnt vmcnt(0)" ::: "memory");
            const unsigned og = xb_add(&bar[XB_TOP], 1u);
            const unsigned tg = og / nx;
            if (og + 1u == (tg + 1u) * nx) xb_add(&bar[XB_TOPGEN], 1u);
            else XB_SPIN(xb_ld(&bar[XB_TOPGEN]) == tg, bar);
            __builtin_amdgcn_fence(__ATOMIC_ACQUIRE, "agent");
            xb_add(&bar[XB_XGEN(b.x)], 1u);
            asm volatile("s_waitcnt vmcnt(0)" ::: "memory");
        } else {
            XB_SPIN(xb_ld(&bar[XB_XGEN(b.x)]) == gen, bar);
            __builtin_amdgcn_fence(__ATOMIC_ACQUIRE, "agent");
            asm volatile("s_waitcnt vmcnt(0)" ::: "memory");
        }
    }
    __syncthreads();
}

__global__ void __launch_bounds__(512, 2) mk_fwd(Args args) {
    extern __shared__ __attribute__((aligned(16))) unsigned char lds_raw[];
    LAS unsigned char* lds = (LAS unsigned char*)lds_raw;
    Ctx X;
#pragma unroll
    for (int i = 0; i < 24; ++i) X.in[i] = args.in[i];
    X.out = args.out; X.ws = args.ws;
    X.P = (bf16_t*)(args.ws + WS_P); X.VT = (bf16_t*)(args.ws + WS_VT); X.HALO = (float*)(args.ws + WS_HALO); X.ROPE = (float*)(args.ws + WS_ROPE);
    X.Win = (bf16_t*)(args.ws + WS_WIN); X.Wg = (bf16_t*)(args.ws + WS_WG); X.Wbr = (bf16_t*)(args.ws + WS_WBR);
    X.Wo = (bf16_t*)(args.ws + WS_WO); X.Wup = (bf16_t*)(args.ws + WS_WUP); X.Wdn = (bf16_t*)(args.ws + WS_WDN);
    X.tid = threadIdx.x; X.lane = X.tid & 63; X.wave = __builtin_amdgcn_readfirstlane(X.tid >> 6); X.G = gridDim.x; X.bid = blockIdx.x;

#if PROBE_DOUBLE
    for (int ph2 = args.ph_lo * 2; ph2 < args.ph_hi * 2; ++ph2) {
        const int ph = ph2 >> 1;
        const int layer = ph / 10, sub = ph % 10;
        const bool skip_ = (ph2 & 1) && !(ph < 20 && ((REPMASK >> sub) & 1));
#else
    volatile LAS unsigned* bst = (volatile LAS unsigned*)(lds + LDS_BYTES - 64);
    if (threadIdx.x < 2) bst[threadIdx.x] = 0u;
    __syncthreads();
    XcdBarrier gbar = xcd_barrier_post((unsigned*)(args.ws + WS_BAR), bst);
    for (int ph = args.ph_lo; ph < args.ph_hi; ++ph) {
        const int layer = ph / 10, sub = ph % 10;
        const bool skip_ = false;
#endif
        { int t_ = threadIdx.x; asm volatile("" : "+v"(t_)); X.tid = t_; X.lane = t_ & 63; }

        if (skip_) {
        } else if (ph == 20 && (PHMASK & 1024)) {
            const int gw = X.bid * 8 + X.wave, NGW = X.G * 8;
            for (int m = gw; m < T_TOK; m += NGW) rms_row(X.out + (size_t)m * DM, X.in[23], nullptr, X.out + (size_t)m * DM, X.lane);
        } else if (sub == 0 && (PHMASK & 1)) {
            phase_prep(X, lds, layer);
        } else if (sub == 1 && (PHMASK & 2)) {
            pg8::Gemm g{X.P, X.Win, LDP, DM, DM}; pg8::StaticOrder S; S.init(T_TOK, 5120, X.G, X.bid);
            pg8::EpiInProj E{X.P, X.VT, X.ROPE};
            pg8::gemm_phase<pg8::EpiInProj, true>(lds, g, S, E, X.tid);
        } else if (sub == 2 && (PHMASK & 4)) {
            phase_mixers(X, lds, layer);
        } else if (sub == 3 && (PHMASK & 8)) {
            phase_hgrn_post(X, layer);
        } else if (sub == 4 && (PHMASK & 16)) {
#pragma unroll 1
            for (int br = 0; br < 3; ++br) {
                { pg8::Gemm g{X.P, X.Wg + (size_t)br * DM * DM, LDP, DM, DM}; pg8::StaticOrder S; S.init(T_TOK, DM, X.G, X.bid);
                  int t_ = X.tid; asm volatile("" : "+v"(t_));
                  pg8::EpiGate E{X.P}; pg8::gemm_phase<pg8::EpiGate, true>(lds, g, S, E, t_); }
                { const int ycol = br == 0 ? COL_YA : (br == 1 ? COL_YB : COL_YC);
                  pg8::Gemm g{X.P + ycol, X.Wbr + (size_t)br * DM * 512, LDP, 512, 512}; pg8::StaticOrder S; S.init(T_TOK, DM, X.G, X.bid);
                  int t_ = X.tid; asm volatile("" : "+v"(t_));
                  pg8::EpiMergeAcc E{X.P, br == 0 ? 1 : 0}; pg8::gemm_phase<pg8::EpiMergeAcc, true>(lds, g, S, E, t_); }
            }
        } else if (sub == 5 && (PHMASK & 32)) {
            pg8::Gemm g{X.P + COL_MRG, X.Wo, LDP, DM, DM}; pg8::StaticOrder S; S.init(T_TOK, DM, X.G, X.bid);
            pg8::EpiResid E{layer == 0 ? X.in[0] : X.out, X.out};
            pg8::gemm_phase<pg8::EpiResid, true>(lds, g, S, E, X.tid);
        } else if (sub == 6 && (PHMASK & 64)) {
            const int gw = X.bid * 8 + X.wave, NGW = X.G * 8;
            const float* g = X.in[18] + (size_t)layer * DM;
            for (int m = gw; m < T_TOK; m += NGW) rms_row(X.out + (size_t)m * DM, g, X.P + (size_t)m * LDP, nullptr, X.lane);
        } else if (sub == 7 && (PHMASK & 128)) {
            pg8::Gemm g{X.P, X.Wup, LDP, DM, DM}; pg8::StaticOrder S; S.init(T_TOK, F2, X.G, X.bid);
            pg8::EpiUp E{X.P, X.HALO, X.in[20] + (size_t)layer * 3 * F2, X.in[21] + (size_t)layer * F2};
            pg8::gemm_phase<pg8::EpiUp, true>(lds, g, S, E, X.tid);
        } else if (sub == 8 && (PHMASK & 256)) {
            phase_fixup(X, layer);
        } else if (PHMASK & 512) {
            pg8::Gemm g{X.P + COL_ACT, X.Wdn, LDP, DFF, DFF}; pg8::StaticOrder S; S.init(T_TOK, DM, X.G, X.bid);
            pg8::EpiResid E{X.out, X.out};
            pg8::gemm_phase<pg8::EpiResid, true>(lds, g, S, E, X.tid);
        }
#if PROBE_DOUBLE
        if (ph2 + 1 < args.ph_hi * 2) cg::this_grid().sync();
#else
        if (ph + 1 < args.ph_hi) { if (ph == args.ph_lo) cg::this_grid().sync(); else xcd_barrier(gbar); }
#endif
    }
}

extern "C" void kernel_launch(void* const* d_in, const int* in_sizes, int n_in, void* d_out, int out_size, void* d_ws, size_t ws_size, hipStream_t stream) {
    static int grid = 0;
    if (grid == 0) {
        int dev = 0, cus = 0, per_cu = 0;
        (void)hipGetDevice(&dev);
        (void)hipDeviceGetAttribute(&cus, hipDeviceAttributeMultiprocessorCount, dev);
        if (hipFuncSetAttribute((const void*)mk_fwd, hipFuncAttributeMaxDynamicSharedMemorySize, LDS_BYTES) != hipSuccess) fprintf(stderr, "kernel_launch: hipFuncSetAttribute failed\n");
        if (hipOccupancyMaxActiveBlocksPerMultiprocessor(&per_cu, (const void*)mk_fwd, 512, LDS_BYTES) != hipSuccess || per_cu < 1) { fprintf(stderr, "kernel_launch: occupancy query gave %d\n", per_cu); per_cu = 1; }
        (void)hipGetLastError();
        grid = cus * 1;
        if (grid <= 0) grid = 256;
        if (ws_size < (size_t)268435456) fprintf(stderr, "kernel_launch: workspace too small (%zu)\n", ws_size);
    }
    Args a{};
    for (int i = 0; i < 24; ++i) a.in[i] = (const float*)d_in[i];
    a.out = (float*)d_out; a.ws = (unsigned char*)d_ws;
#if MK_SINGLE
    (void)hipMemsetAsync((char*)d_ws + WS_BAR, 0, XCD_BAR_WORDS * 4, stream);
    a.ph_lo = 0; a.ph_hi = 21;
    void* kargs[] = {&a};
    hipError_t e = hipLaunchCooperativeKernel((const void*)mk_fwd, dim3(grid), dim3(512), kargs, LDS_BYTES, stream);
    if (e != hipSuccess) fprintf(stderr, "cooperative launch failed: %s (grid %d)\n", hipGetErrorString(e), grid);
#else
    for (int ph = 0; ph < 21; ++ph) {
        a.ph_lo = ph; a.ph_hi = ph + 1;
        hipLaunchKernelGGL(mk_fwd, dim3(grid), dim3(512), LDS_BYTES, stream, a);
    }
#endif
}
```

```cpp
#include <hip/hip_runtime.h>
#include <hip/hip_cooperative_groups.h>
#include <cstdio>
#include <cstdint>
namespace cg = cooperative_groups;

#ifndef PHMASK
#define PHMASK 2047
#endif
#ifndef REPMASK
#define REPMASK 0
#endif
#ifndef PROBE_DOUBLE
#define PROBE_DOUBLE 0
#endif
#ifndef TKMASK
#define TKMASK 7
#endif
#ifndef MK_SINGLE
#define MK_SINGLE 1
#endif

#define LAS __attribute__((address_space(3)))
typedef unsigned short bf16_t;
typedef short bf16x8 __attribute__((ext_vector_type(8)));
typedef float f32x4 __attribute__((ext_vector_type(4)));
typedef float f32x2 __attribute__((ext_vector_type(2)));
typedef unsigned u32x4 __attribute__((ext_vector_type(4)));
typedef unsigned u32x2 __attribute__((ext_vector_type(2)));

constexpr int T_TOK = 16384, SEQ = 2048, DM = 1024;
constexpr int LDP = 6144;
constexpr int COL_PA = 1024, COL_PB = 2816, COL_PC = 4864;
constexpr int COL_YA = 1024, COL_MRG = 1536, COL_G = 2816, COL_YB = 3840, COL_YC = 4864, COL_ACT = 1024;
constexpr int C_Q = 4864, C_K = 5376, C_QI = 5632, C_KI = 5888, C_WI = 5952;
constexpr int IN_COLS = 8004, DFF = 2816, F2 = 5632;
constexpr size_t WS_WIN = 0, WS_WG = 10485760, WS_WBR = 16777216, WS_WO = 19922944, WS_WUP = 22020096, WS_WDN = 33554432;
constexpr size_t WS_P = 41943040, WS_HALO = 243269632, WS_VT = WS_HALO, WS_ROPE = 266338304, WS_BAR = 266862592;
constexpr int LDS_BYTES = 153600;
constexpr int SCS = 2052;
constexpr int MASK_OFF = 16 * SCS * 4;

struct Args { const float* in[24]; float* out; unsigned char* ws; int ph_lo, ph_hi; };

__device__ __forceinline__ unsigned f2bf(float f) { unsigned u = __builtin_bit_cast(unsigned, f); return (u + 0x7fffu + ((u >> 16) & 1u)) >> 16; }
__device__ __forceinline__ unsigned pk2(float lo, float hi) { return f2bf(lo) | (f2bf(hi) << 16); }
__device__ __forceinline__ float bf2f(bf16_t b) { return __builtin_bit_cast(float, (unsigned)b << 16); }
__device__ __forceinline__ float bflo(unsigned w) { return __builtin_bit_cast(float, w << 16); }
__device__ __forceinline__ float bfhi(unsigned w) { return __builtin_bit_cast(float, w & 0xffff0000u); }
__device__ __forceinline__ float wave_sum(float v) {
#pragma unroll
    for (int o = 1; o < 64; o <<= 1) v += __shfl_xor(v, o);
    return v;
}
__device__ __forceinline__ int wave_sum_i(int v) {
#pragma unroll
    for (int o = 1; o < 64; o <<= 1) v += __shfl_xor(v, o);
    return v;
}
template <int CTRL> __device__ __forceinline__ float dpp_mov(float x) {
    return __builtin_bit_cast(float, __builtin_amdgcn_update_dpp(0, __builtin_bit_cast(int, x), CTRL, 0xF, 0xF, true));
}
__device__ __forceinline__ float red8(float x) { x += dpp_mov<0xB1>(x); x += dpp_mov<0x4E>(x); x += dpp_mov<0x141>(x); return x; }
__device__ __forceinline__ float red16(float x) { x = red8(x); x += dpp_mov<0x140>(x); return x; }
__device__ __forceinline__ float sigmoidf_(float x) { return 1.f / (1.f + __expf(-x)); }

namespace pg8 {
constexpr int BM = 256, BK = 64, HALF = 128, HTB = HALF * BK * 2, NXCD = 8, WGM = 8;
__device__ __forceinline__ int lds_byte(int r, int c) { const int st = (r >> 4) * 2 + (c >> 5), rr = r & 15, cc = c & 31, ob = rr * 64 + cc * 2; return st * 1024 + (ob ^ (((ob >> 9) & 1) << 5)); }
__device__ __forceinline__ void stage_rc(int b, int& R, int& C) { const int st = b / 1024, sb = b % 1024, swz = sb ^ (((sb >> 9) & 1) << 5); R = (st >> 1) * 16 + swz / 64; C = (st & 1) * 32 + (swz % 64) / 2; }
__device__ __forceinline__ int perm32(int rho) { const int n = rho >> 4, i = rho & 15; return 8 * (i >> 2) + 4 * n + (i & 3); }
struct Unit { int pm, pn; };
struct Gemm { const bf16_t* A; const bf16_t* Bt; int lda, ldb, K; };
struct StaticOrder {
    int nM, nN, nwg, G, c;
    __device__ void init(int M, int N, int G_, int c_) { nM = M / BM; nN = N / BM; nwg = nM * nN; G = G_; c = c_; }
    __device__ bool next(int i, Unit& u) const {
        const long L = (long)i * G + c; if (L >= nwg) return false;
        int wgid = (int)L; { const int q = nwg / NXCD, r = nwg % NXCD, xcd = wgid % NXCD, off = wgid / NXCD; wgid = (xcd < r ? xcd * (q + 1) : r * (q + 1) + (xcd - r) * q) + off; }
        const int nig = WGM * nN, gid = wgid / nig, fm = gid * WGM, gsz = (nM - fm) < WGM ? (nM - fm) : WGM;
        u.pm = fm + ((wgid % nig) % gsz); u.pn = (wgid % nig) / gsz; return true;
    }
};
__device__ __forceinline__ unsigned cvt_pk_bf16(float lo, float hi) { unsigned r; asm volatile("v_cvt_pk_bf16_f32 %0, %1, %2" : "=v"(r) : "v"(lo), "v"(hi)); return r; }

template <class Epi, bool ALIGN_EPI>
__device__ __forceinline__ void gemm_phase(LAS unsigned char* lds, const Gemm g, const StaticOrder& S, const Epi& E, const int tid) {
    const int wid = __builtin_amdgcn_readfirstlane(tid >> 6), lane = tid & 63, wr = wid >> 2, wc = wid & 3, fr = lane & 15, fq = lane >> 4;
    const int K = g.K, nt = K / BK;
    unsigned voffA[2], voffB[2];
#pragma unroll
    for (int i = 0; i < 2; ++i) { int R, C; stage_rc(tid * 16 + i * 8192, R, C); const int Rb = (R & ~31) + perm32(R & 31);
        voffA[i] = (unsigned)(R * g.lda + C) * 2u; voffB[i] = (unsigned)(Rb * g.ldb + C) * 2u; }
    const size_t kstep = (size_t)(BK * 2);
    const size_t hstepA = (size_t)HALF * g.lda * 2, hstepB = (size_t)HALF * g.ldb * 2;
    const size_t tstepA = 2 * hstepA, tstepB = 2 * hstepB;
    const unsigned ldsw = (unsigned)wid * 1024u;
    const int aoff = lds_byte(wr * 64 + fr, fq * 8), boff = lds_byte(wc * 32 + fr, fq * 8);
#define PG8_SA(b, h) (((b) * 2 + (h)) * HTB)
#define PG8_SB(b, h) ((4 + (b) * 2 + (h)) * HTB)
#define PG8_STAGE(bufoff, gbase, voff) do { _Pragma("unroll") for (int _i = 0; _i < 2; ++_i) \
        __builtin_amdgcn_global_load_lds((const unsigned*)((const char*)(gbase) + (voff)[_i]), (LAS unsigned*)(lds + (bufoff) + ldsw + _i * 8192), 16, 0, 0); } while (0)
#define PG8_LDA(dst, b, h) do { _Pragma("unroll") for (int m = 0; m < 4; ++m) _Pragma("unroll") for (int k = 0; k < 2; ++k) dst[m][k] = *(const LAS bf16x8*)(lds + PG8_SA(b, h) + aoff + m * 2048 + k * 1024); } while (0)
#define PG8_LDB(dst, b, h) do { _Pragma("unroll") for (int n = 0; n < 2; ++n) _Pragma("unroll") for (int k = 0; k < 2; ++k) dst[n][k] = *(const LAS bf16x8*)(lds + PG8_SB(b, h) + boff + n * 2048 + k * 1024); } while (0)
#define PG8_MMA(ai, bj, At, Bt) do { __builtin_amdgcn_s_setprio(1); _Pragma("unroll") for (int m = 0; m < 4; ++m) _Pragma("unroll") for (int n = 0; n < 2; ++n) _Pragma("unroll") for (int k = 0; k < 2; ++k) \
        acc[ai][bj][m][n] = __builtin_amdgcn_mfma_f32_16x16x32_bf16(Bt[n][k], At[m][k], acc[ai][bj][m][n], 0, 0, 0); __builtin_amdgcn_s_setprio(0); } while (0)
#define PG8_WAIT_V(n) asm volatile("s_waitcnt vmcnt(" #n ")" ::: "memory")
#define PG8_WAIT_L(n) asm volatile("s_waitcnt lgkmcnt(" #n ")" ::: "memory")
#define PG8_BAR __builtin_amdgcn_s_barrier()
#define PG8_SCHED __builtin_amdgcn_sched_barrier(0)
    Unit cur, nxt; int ui = 0;
    if (!S.next(0, cur)) return;
    f32x4 acc[2][2][4][2];
#pragma unroll
    for (int a = 0; a < 2; ++a)
#pragma unroll
        for (int b = 0; b < 2; ++b)
#pragma unroll
            for (int m = 0; m < 4; ++m)
#pragma unroll
                for (int n = 0; n < 2; ++n) acc[a][b][m][n] = (f32x4){0.f, 0.f, 0.f, 0.f};
    bf16x8 At[4][2], B0[2][2], B1[2][2];
    const char* cA = (const char*)g.A + (size_t)cur.pm * tstepA; const char* cB = (const char*)g.Bt + (size_t)cur.pn * tstepB;
    PG8_STAGE(PG8_SB(0, 0), cB, voffB); PG8_STAGE(PG8_SB(0, 1), cB + hstepB, voffB); PG8_STAGE(PG8_SA(0, 0), cA, voffA); PG8_STAGE(PG8_SA(0, 1), cA + hstepA, voffA);
    if (wr == 1) PG8_BAR;
    PG8_WAIT_V(2); PG8_BAR;
    PG8_STAGE(PG8_SB(1, 0), cB + kstep, voffB); PG8_STAGE(PG8_SA(1, 0), cA + kstep, voffA); PG8_STAGE(PG8_SB(1, 1), cB + hstepB + kstep, voffB);
    PG8_WAIT_V(6); PG8_BAR;
    for (;;) {
        const bool has_next = S.next(ui + 1, nxt);
        const char* nA = has_next ? (const char*)g.A + (size_t)nxt.pm * tstepA : cA; const char* nB = has_next ? (const char*)g.Bt + (size_t)nxt.pn * tstepB : cB;
        for (int t = 0; t < nt; t += 2) {
            const bool last = (t == nt - 2);
            const char* a1 = cA + (size_t)(t + 1) * kstep;
            const char* a2 = last ? nA : cA + (size_t)(t + 2) * kstep; const char* b2 = last ? nB : cB + (size_t)(t + 2) * kstep;
            const char* a3 = a2 + kstep; const char* b3 = b2 + kstep;
            PG8_LDB(B0, 0, 0); PG8_LDB(B1, 0, 1); PG8_SCHED; PG8_LDA(At, 0, 0); PG8_STAGE(PG8_SA(1, 1), a1 + hstepA, voffA);
            PG8_WAIT_V(8); PG8_WAIT_L(0); PG8_BAR; PG8_MMA(0, 0, At, B0); PG8_MMA(0, 1, At, B1); PG8_BAR; PG8_SCHED;
            PG8_LDA(At, 0, 1); PG8_STAGE(PG8_SB(0, 0), b2, voffB); PG8_STAGE(PG8_SB(0, 1), b2 + hstepB, voffB); PG8_STAGE(PG8_SA(0, 0), a2, voffA);
            PG8_WAIT_V(8); PG8_WAIT_L(0); PG8_BAR; PG8_MMA(1, 0, At, B0); PG8_MMA(1, 1, At, B1); PG8_BAR; PG8_SCHED;
            PG8_LDB(B0, 1, 0); PG8_LDB(B1, 1, 1); PG8_SCHED; PG8_LDA(At, 1, 0); PG8_STAGE(PG8_SA(0, 1), a2 + hstepA, voffA);
            PG8_WAIT_V(8); PG8_WAIT_L(0); PG8_BAR; PG8_MMA(0, 0, At, B0); PG8_MMA(0, 1, At, B1); PG8_BAR; PG8_SCHED;
            PG8_LDA(At, 1, 1); PG8_STAGE(PG8_SB(1, 0), b3, voffB); PG8_STAGE(PG8_SB(1, 1), b3 + hstepB, voffB); PG8_STAGE(PG8_SA(1, 0), a3, voffA);
            PG8_WAIT_V(8); PG8_WAIT_L(0); PG8_BAR; PG8_MMA(1, 0, At, B0); PG8_MMA(1, 1, At, B1); PG8_BAR; PG8_SCHED;
        }
        if constexpr (ALIGN_EPI) { if (wr == 0) PG8_BAR; }
        E(acc, cur, wr, wc, fr, fq);
        if (!has_next) break;
#pragma unroll
        for (int a = 0; a < 2; ++a)
#pragma unroll
            for (int b = 0; b < 2; ++b)
#pragma unroll
                for (int m = 0; m < 4; ++m)
#pragma unroll
                    for (int n = 0; n < 2; ++n) acc[a][b][m][n] = (f32x4){0.f, 0.f, 0.f, 0.f};
        cur = nxt; cA = nA; cB = nB; ++ui;
        if constexpr (ALIGN_EPI) { if (wr == 1) PG8_BAR; }
    }
    PG8_WAIT_V(0);
    if constexpr (!ALIGN_EPI) { if (wr == 0) PG8_BAR; }
    PG8_BAR;
#undef PG8_SA
#undef PG8_SB
#undef PG8_STAGE
#undef PG8_LDA
#undef PG8_LDB
#undef PG8_MMA
#undef PG8_WAIT_V
#undef PG8_WAIT_L
#undef PG8_BAR
#undef PG8_SCHED
}

typedef f32x4 AccT[2][2][4][2];

struct EpiInProj {
    bf16_t* P; bf16_t* VT; const float* rope;
    __device__ __forceinline__ void operator()(AccT& acc, const Unit& u, int wr, int wc, int fr, int fq) const {
        const int row0 = u.pm * BM + wr * 64 + fr, colb = u.pn * BM + wc * 32 + 8 * fq;
#pragma unroll
        for (int ai = 0; ai < 2; ++ai)
#pragma unroll
            for (int m = 0; m < 4; ++m) {
                const int row = row0 + ai * HALF + m * 16, t = row & (SEQ - 1);
                bf16_t* rowp = P + (size_t)row * LDP + COL_PA;
#pragma unroll
                for (int bj = 0; bj < 2; ++bj) {
                    const int c = colb + bj * HALF;
                    f32x4 v0 = acc[ai][bj][m][0], v1 = acc[ai][bj][m][1];
                    if (u.pn >= 15) {
                        const int cl = c - 3840;
                        if (cl < 640 || (cl >= 768 && cl < 1088)) {
                            const float* cs = rope + ((size_t)t * 32 + ((cl & 63) >> 1)) * 2;
                            const f32x4 r0 = *(const f32x4*)cs, r1 = *(const f32x4*)(cs + 4);
                            f32x4 o0, o1;
                            o0[0] = v0[0] * r0[0] - v0[1] * r0[1]; o0[1] = v0[1] * r0[0] + v0[0] * r0[1];
                            o0[2] = v0[2] * r0[2] - v0[3] * r0[3]; o0[3] = v0[3] * r0[2] + v0[2] * r0[3];
                            o1[0] = v1[0] * r1[0] - v1[1] * r1[1]; o1[1] = v1[1] * r1[0] + v1[0] * r1[1];
                            o1[2] = v1[2] * r1[2] - v1[3] * r1[3]; o1[3] = v1[3] * r1[2] + v1[2] * r1[3];
                            v0 = o0; v1 = o1;
                        }
                    }
                    u32x4 w; w.x = cvt_pk_bf16(v0[0], v0[1]); w.y = cvt_pk_bf16(v0[2], v0[3]); w.z = cvt_pk_bf16(v1[0], v1[1]); w.w = cvt_pk_bf16(v1[2], v1[3]);
                    *(u32x4*)(rowp + c) = w;
                    if (u.pn == 17 && bj == 1) {
                        const int cv = c - 3840 - 640, b = row >> 11;
                        bf16_t* vt = VT + ((size_t)(b * 2 + (cv >> 6)) * 64 + (cv & 63)) * SEQ + t;
                        vt[0 * SEQ] = (bf16_t)(w.x & 0xffffu); vt[1 * SEQ] = (bf16_t)(w.x >> 16);
                        vt[2 * SEQ] = (bf16_t)(w.y & 0xffffu); vt[3 * SEQ] = (bf16_t)(w.y >> 16);
                        vt[4 * SEQ] = (bf16_t)(w.z & 0xffffu); vt[5 * SEQ] = (bf16_t)(w.z >> 16);
                        vt[6 * SEQ] = (bf16_t)(w.w & 0xffffu); vt[7 * SEQ] = (bf16_t)(w.w >> 16);
                    }
                }
            }
    }
};
struct EpiGate {
    bf16_t* P;
    __device__ __forceinline__ void operator()(AccT& acc, const Unit& u, int wr, int wc, int fr, int fq) const {
        const int row0 = u.pm * BM + wr * 64 + fr, colb = u.pn * BM + wc * 32 + 8 * fq;
#pragma unroll
        for (int ai = 0; ai < 2; ++ai)
#pragma unroll
            for (int m = 0; m < 4; ++m) {
                bf16_t* rowp = P + (size_t)(row0 + ai * HALF + m * 16) * LDP + COL_G + colb;
#pragma unroll
                for (int bj = 0; bj < 2; ++bj) {
                    const f32x4 v0 = acc[ai][bj][m][0], v1 = acc[ai][bj][m][1];
                    u32x4 w; w.x = cvt_pk_bf16(sigmoidf_(v0[0]), sigmoidf_(v0[1])); w.y = cvt_pk_bf16(sigmoidf_(v0[2]), sigmoidf_(v0[3]));
                    w.z = cvt_pk_bf16(sigmoidf_(v1[0]), sigmoidf_(v1[1])); w.w = cvt_pk_bf16(sigmoidf_(v1[2]), sigmoidf_(v1[3]));
                    *(u32x4*)(rowp + bj * HALF) = w;
                }
            }
    }
};
struct EpiMergeAcc {
    bf16_t* P; int first;
    __device__ __forceinline__ void operator()(AccT& acc, const Unit& u, int wr, int wc, int fr, int fq) const {
        const int row0 = u.pm * BM + wr * 64 + fr, colb = u.pn * BM + wc * 32 + 8 * fq;
#pragma unroll
        for (int ai = 0; ai < 2; ++ai)
#pragma unroll
            for (int m = 0; m < 4; ++m) {
                bf16_t* rowb = P + (size_t)(row0 + ai * HALF + m * 16) * LDP + colb;
#pragma unroll
                for (int bj = 0; bj < 2; ++bj) {
                    const f32x4 v0 = acc[ai][bj][m][0], v1 = acc[ai][bj][m][1];
                    unsigned long long* gp = (unsigned long long*)(rowb + COL_G + bj * HALF);
                    unsigned long long* mp = (unsigned long long*)(rowb + COL_MRG + bj * HALF);
                    const unsigned long long g0 = __hip_atomic_load(gp, __ATOMIC_RELAXED, __HIP_MEMORY_SCOPE_AGENT), g1 = __hip_atomic_load(gp + 1, __ATOMIC_RELAXED, __HIP_MEMORY_SCOPE_AGENT);
                    unsigned long long m0 = 0ull, m1 = 0ull;
                    if (!first) { m0 = __hip_atomic_load(mp, __ATOMIC_RELAXED, __HIP_MEMORY_SCOPE_AGENT); m1 = __hip_atomic_load(mp + 1, __ATOMIC_RELAXED, __HIP_MEMORY_SCOPE_AGENT); }
                    const unsigned ga = (unsigned)g0, gb = (unsigned)(g0 >> 32), gc = (unsigned)g1, gd = (unsigned)(g1 >> 32);
                    const unsigned ma = (unsigned)m0, mb = (unsigned)(m0 >> 32), mc = (unsigned)m1, md = (unsigned)(m1 >> 32);
                    u32x4 w;
                    w.x = cvt_pk_bf16(bflo(ma) + bflo(ga) * v0[0], bfhi(ma) + bfhi(ga) * v0[1]);
                    w.y = cvt_pk_bf16(bflo(mb) + bflo(gb) * v0[2], bfhi(mb) + bfhi(gb) * v0[3]);
                    w.z = cvt_pk_bf16(bflo(mc) + bflo(gc) * v1[0], bfhi(mc) + bfhi(gc) * v1[1]);
                    w.w = cvt_pk_bf16(bflo(md) + bflo(gd) * v1[2], bfhi(md) + bfhi(gd) * v1[3]);
                    *(u32x4*)(rowb + COL_MRG + bj * HALF) = w;
                }
            }
    }
};
struct EpiResid {
    const float* base; float* out;
    __device__ __forceinline__ void operator()(AccT& acc, const Unit& u, int wr, int wc, int fr, int fq) const {
        const int row0 = u.pm * BM + wr * 64 + fr, colb = u.pn * BM + wc * 32 + 8 * fq;
#pragma unroll
        for (int ai = 0; ai < 2; ++ai)
#pragma unroll
            for (int m = 0; m < 4; ++m) {
                const size_t off = (size_t)(row0 + ai * HALF + m * 16) * DM + colb;
#pragma unroll
                for (int bj = 0; bj < 2; ++bj) {
                    const f32x4 b0 = *(const f32x4*)(base + off + bj * HALF), b1 = *(const f32x4*)(base + off + bj * HALF + 4);
                    *(f32x4*)(out + off + bj * HALF) = b0 + acc[ai][bj][m][0];
                    *(f32x4*)(out + off + bj * HALF + 4) = b1 + acc[ai][bj][m][1];
                }
            }
    }
};
struct EpiUp {
    bf16_t* P; float* HALO; const float* cw; const float* cb;
    __device__ __forceinline__ void operator()(AccT& acc, const Unit& u, int wr, int wc, int fr_in, int fq_in) const {
        int fr = fr_in, fq = fq_in;
        asm volatile("" : "+v"(fr), "+v"(fq));
        const int row0 = u.pm * BM + wr * 64 + fr;
        const int jb = u.pn * 128 + wc * 32 + 8 * fq;
#pragma unroll
        for (int ai = 0; ai < 2; ++ai) {
            const int s = u.pm * 4 + ai * 2 + wr;
#pragma unroll
            for (int bj = 0; bj < 2; ++bj)
#pragma unroll
                for (int n = 0; n < 2; ++n) {
                    const int colp = u.pn * BM + bj * HALF + wc * 32 + 8 * fq + 4 * n;
                    if (fr < 2) *(f32x4*)(HALO + (size_t)(s * 4 + fr) * F2 + colp) = acc[ai][bj][0][n];
                    if (fr >= 14) *(f32x4*)(HALO + (size_t)(s * 4 + fr - 12) * F2 + colp) = acc[ai][bj][3][n];
                }
        }
#pragma unroll
        for (int ai = 0; ai < 2; ++ai)
#pragma unroll
            for (int m = 0; m < 4; ++m) {
                const int row = row0 + ai * HALF + m * 16;
#pragma unroll
                for (int n = 0; n < 2; ++n) {
                    f32x4 cv[2];
                    asm volatile("" ::: "memory");
#pragma unroll
                    for (int bj = 0; bj < 2; ++bj) {
                        const int co = bj * DFF + jb + 4 * n;
                        const f32x4 w0 = *(const f32x4*)(cw + co), w1 = *(const f32x4*)(cw + F2 + co), w2 = *(const f32x4*)(cw + 2 * F2 + co), bb = *(const f32x4*)(cb + co);
#pragma unroll
                        for (int e = 0; e < 4; ++e) {
                            const float cur = acc[ai][bj][m][n][e];
                            const float prv = m > 0 ? acc[ai][bj][m > 0 ? m - 1 : 0][n][e] : 0.f;
                            const float a1 = dpp_mov<0x121>(cur), a2 = dpp_mov<0x122>(cur), b1 = dpp_mov<0x121>(prv), b2 = dpp_mov<0x122>(prv);
                            const float p1 = fr >= 1 ? a1 : b1, p2 = fr >= 2 ? a2 : b2;
                            cv[bj][e] = bb[e] + w0[e] * p2 + w1[e] * p1 + w2[e] * cur;
                        }
                        __builtin_amdgcn_sched_barrier(0);
                    }
                    const f32x4 g0 = cv[0], v0 = cv[1];
                    u32x2 w;
                    w.x = cvt_pk_bf16(g0[0] * sigmoidf_(g0[0]) * v0[0], g0[1] * sigmoidf_(g0[1]) * v0[1]);
                    w.y = cvt_pk_bf16(g0[2] * sigmoidf_(g0[2]) * v0[2], g0[3] * sigmoidf_(g0[3]) * v0[3]);
                    if (!(m == 0 && fr < 2)) *(u32x2*)(P + (size_t)row * LDP + COL_ACT + jb + 4 * n) = w;
                    __builtin_amdgcn_sched_barrier(0);
                }
            }
    }
};
}

struct Ctx {
    const float* in[24]; float* out; unsigned char* ws;
    bf16_t* P; bf16_t* VT; float* HALO; float* ROPE;
    bf16_t *Win, *Wg, *Wbr, *Wo, *Wup, *Wdn;
    int tid, lane, wave, G, bid;
};

__device__ __forceinline__ int srccol(int mode, int n) {
    if (mode == 0) return n;
    if (mode == 2) return 4932 + n;
    if (mode == 3) { const int tile = n >> 8, w = n & 255, j = tile * 128 + (w & 127); return (w < 128) ? j : DFF + j; }
    if (n < 3840) return n;
    const int c = n - 3840;
    if (c >= 1092) return -1;
    if (c < 640 || (c >= 768 && c < 1088)) { const int base = c & ~63, i = c & 63; return 3840 + base + (i >> 1) + 32 * (i & 1); }
    return 3840 + c;
}
__device__ __forceinline__ void tr_item(const float* W, int ldw, int K, int N, bf16_t* WT, int mode, int item, LAS float* scr, int lane) {
    const int nblk = N / 32, kb = item / nblk, nb = item % nblk, k0 = 64 * kb, n0 = 32 * nb;
    const int sc = srccol(mode, n0 + (lane & 31));
#pragma unroll 8
    for (int i = 0; i < 32; ++i) { const int kk = 2 * i + (lane >> 5); scr[kk * 33 + (lane & 31)] = (sc >= 0) ? W[(size_t)(k0 + kk) * ldw + sc] : 0.f; }
    asm volatile("s_waitcnt lgkmcnt(0)" ::: "memory");
    const int c = lane & 7;
#pragma unroll
    for (int j = 0; j < 4; ++j) { const int n = (lane >> 3) + 8 * j; const LAS float* s = scr + (8 * c) * 33 + n;
        u32x4 o; o.x = pk2(s[0 * 33], s[1 * 33]); o.y = pk2(s[2 * 33], s[3 * 33]); o.z = pk2(s[4 * 33], s[5 * 33]); o.w = pk2(s[6 * 33], s[7 * 33]);
        *(u32x4*)(WT + (size_t)(n0 + n) * K + k0 + 8 * c) = o; }
    asm volatile("s_waitcnt lgkmcnt(0)" ::: "memory");
}
__device__ __forceinline__ void rms_row(const float* xrow, const float* g, bf16_t* obf, float* of32, int lane) {
    const f32x4* xr = (const f32x4*)xrow + lane; const f32x4* gr = (const f32x4*)g + lane;
    f32x4 v[4]; float s = 0.f;
#pragma unroll
    for (int j = 0; j < 4; ++j) { v[j] = xr[64 * j]; s += (v[j].x * v[j].x + v[j].y * v[j].y) + (v[j].z * v[j].z + v[j].w * v[j].w); }
    const float rs = 1.f / sqrtf(wave_sum(s) * (1.f / DM) + 1e-6f);
#pragma unroll
    for (int j = 0; j < 4; ++j) {
        const f32x4 gg = gr[64 * j]; const f32x4 o = v[j] * rs * gg;
        if (obf) { u32x2 w; w.x = pk2(o.x, o.y); w.y = pk2(o.z, o.w); *((u32x2*)obf + lane + 64 * j) = w; }
        else *((f32x4*)of32 + lane + 64 * j) = o;
    }
}
__device__ __forceinline__ void phase_prep(const Ctx& X, LAS unsigned char* lds, int layer) {
    LAS float* scr = (LAS float*)(lds + X.wave * 8448);
    const int gw = X.bid * 8 + X.wave, NGW = X.G * 8;
    constexpr int I_IN = 16 * 160, I_G = 16 * 96, I_BR = 8 * 32, I_O = 16 * 32, I_UP = 16 * 176, I_DN = 44 * 32;
    constexpr int NITEMS = I_IN + I_G + 3 * I_BR + I_O + I_UP + I_DN;
    const float* w_in = X.in[2] + (size_t)layer * DM * IN_COLS;
    const float* w_br = X.in[16] + (size_t)layer * 3 * 512 * DM;
    const float* w_o = X.in[17] + (size_t)layer * DM * DM;
    const float* w_up = X.in[19] + (size_t)layer * DM * F2;
    const float* w_dn = X.in[22] + (size_t)layer * DFF * DM;
    for (int it = gw; it < NITEMS; it += NGW) {
        int r = it;
        if (r < I_IN) { tr_item(w_in, IN_COLS, DM, 5120, X.Win, 1, r, scr, X.lane); continue; } r -= I_IN;
        if (r < I_G) { tr_item(w_in, IN_COLS, DM, 3072, X.Wg, 2, r, scr, X.lane); continue; } r -= I_G;
        if (r < 3 * I_BR) { const int b = r / I_BR; tr_item(w_br + (size_t)b * 512 * DM, DM, 512, DM, X.Wbr + (size_t)b * DM * 512, 0, r % I_BR, scr, X.lane); continue; } r -= 3 * I_BR;
        if (r < I_O) { tr_item(w_o, DM, DM, DM, X.Wo, 0, r, scr, X.lane); continue; } r -= I_O;
        if (r < I_UP) { tr_item(w_up, F2, DM, F2, X.Wup, 3, r, scr, X.lane); continue; } r -= I_UP;
        tr_item(w_dn, DM, DFF, DM, X.Wdn, 0, r, scr, X.lane);
    }
    const float* h = (layer == 0) ? X.in[0] : X.out;
    const float* g = X.in[1] + (size_t)layer * DM;
    for (int m = gw; m < T_TOK; m += NGW) rms_row(h + (size_t)m * DM, g, X.P + (size_t)m * LDP, nullptr, X.lane);
    if (layer == 0) {
        for (int idx = X.bid * 512 + X.tid; idx < SEQ * 32; idx += X.G * 512) {
            const int t = idx >> 5, p = idx & 31;
            const float inv = exp2f(-(float)p * 0.03125f * 13.287712379549449f);
            const float ang = (float)t * inv;
            const double rev = (double)ang * 0.15915494309189535;
            const float fr = (float)(rev - floor(rev));
            X.ROPE[2 * idx] = __builtin_amdgcn_cosf(fr); X.ROPE[2 * idx + 1] = __builtin_amdgcn_sinf(fr);
        }
    }
}

__device__ __forceinline__ float wave_sum_fast(float x) {
    x = red16(x);
    const float r0 = __builtin_bit_cast(float, __builtin_amdgcn_readlane(__builtin_bit_cast(int, x), 0)), r1 = __builtin_bit_cast(float, __builtin_amdgcn_readlane(__builtin_bit_cast(int, x), 16));
    const float r2 = __builtin_bit_cast(float, __builtin_amdgcn_readlane(__builtin_bit_cast(int, x), 32)), r3 = __builtin_bit_cast(float, __builtin_amdgcn_readlane(__builtin_bit_cast(int, x), 48));
    return (r0 + r1) + (r2 + r3);
}
#define LDS_BAR() do { asm volatile("s_waitcnt lgkmcnt(0)" ::: "memory"); __builtin_amdgcn_s_barrier(); asm volatile("" ::: "memory"); } while (0)
constexpr int RW_TS = 16, RW_NCH = SEQ / RW_TS, RW_BUF = 33280;
__device__ __forceinline__ void rwkv_task(const Ctx& X, LAS unsigned char* lds, int layer, int b, int h) {
    LAS float* Rr = (LAS float*)(lds + 66560);  LAS float* AS = (LAS float*)(lds + 70656);
    LAS bf16_t* WDb = (LAS bf16_t*)(lds + 74752);
    LAS bf16_t* ADb = (LAS bf16_t*)(lds + 77056);
    LAS bf16_t* GDb = (LAS bf16_t*)(lds + 79360);
    LAS bf16_t* WTu = (LAS bf16_t*)(lds + 83712);
    LAS bf16_t* WTa = (LAS bf16_t*)(lds + 92928);
    LAS bf16_t* WTg = (LAS bf16_t*)(lds + 102144);
    LAS float* CARRY = (LAS float*)(lds + 119552);
    LAS float* MU = (LAS float*)(lds + 123136);
    const int tid = X.tid, lane = tid & 63;
    const bool helper = X.wave >= 4;
    const int ht = tid & 255;
    const float* mu = X.in[3] + layer * 1792;
    const float* w0 = X.in[4] + layer * 512;   const float* w_up = X.in[5] + (size_t)layer * 64 * 512;
    const float* a0 = X.in[6] + layer * 512;   const float* a_up = X.in[7] + (size_t)layer * 64 * 512;
    const float* g_up = X.in[8] + (size_t)layer * 128 * 512;
    const float* k_k = X.in[9] + layer * 512;  const float* k_a = X.in[10] + layer * 512;  const float* r_k = X.in[11] + layer * 512;
    const float* gn_g = X.in[12] + layer * 512; const float* gn_b = X.in[13] + layer * 512;
    const int c = ht & 63, tg = ht >> 6, hc = h * 64 + c;
    const float p_kk = k_k[hc], p_ka = k_a[hc], p_rk = r_k[hc], p_gg = gn_g[hc], p_gb = gn_b[hc];
    const int nt = tg, ln = lane & 15, lg = lane >> 4, chm = 16 * nt + ln;
    const float q_w0 = w0[h * 64 + chm], q_a0 = a0[h * 64 + chm];
    const int rp = ht >> 3, jg = ht & 7, i0 = 2 * rp;
    for (int idx = tid; idx < 64 * 64; idx += 512) { const int m = idx >> 6, cc = idx & 63;
        WTu[cc * 72 + m] = (bf16_t)f2bf(w_up[m * 512 + h * 64 + cc]); WTa[cc * 72 + m] = (bf16_t)f2bf(a_up[m * 512 + h * 64 + cc]); }
    for (int idx = tid; idx < 128 * 64; idx += 512) { const int m = idx >> 6, cc = idx & 63; WTg[cc * 136 + m] = (bf16_t)f2bf(g_up[m * 512 + h * 64 + cc]); }
    if (tid < 448) { const int cc = tid; const int col = cc < 64 ? h * 64 + cc : (cc < 128 ? 512 + h * 64 + cc - 64 : (cc < 192 ? 1024 + h * 64 + cc - 128 : 1536 + cc - 192)); MU[cc] = mu[col]; }
    f32x2 S0[4], S1[4];
#pragma unroll
    for (int j = 0; j < 4; ++j) { S0[j] = (f32x2){0.f, 0.f}; S1[j] = (f32x2){0.f, 0.f}; }
    __syncthreads();

#define RW_ARR(bufi, k) ((LAS float*)(lds + (bufi) * RW_BUF + (k) * 4096))
#define RW_SC(bufi) ((LAS float*)(lds + (bufi) * RW_BUF + 32768))
#define RW_A_LOAD(chk) do { _Pragma("unroll") for (int it = 0; it < 4; ++it) { const int idx = ht + 256 * it; const int tt = idx / 56, vv = idx - tt * 56; \
        const int col = vv < 8 ? h * 64 + 8 * vv : (vv < 16 ? 512 + h * 64 + 8 * (vv - 8) : (vv < 24 ? 1024 + h * 64 + 8 * (vv - 16) : 1536 + 8 * (vv - 24))); \
        cur4[it] = (u32x4){0u, 0u, 0u, 0u}; prv4[it] = (u32x4){0u, 0u, 0u, 0u}; \
        if (idx < RW_TS * 56) { const bf16_t* pc = X.P + ((size_t)b * SEQ + (chk) * RW_TS + tt) * LDP + COL_PA + col; cur4[it] = *(const u32x4*)pc; if (tt > 0) prv4[it] = *(const u32x4*)(pc - LDP); } } } while (0)
    u32x4 cur4[4], prv4[4];
    if (helper) RW_A_LOAD(0);

#pragma unroll 1
    for (int i = -1; i < RW_NCH; ++i) {
        const int bufn = (i + 1) & 1, bufc = i & 1;
        if (helper) {
            const bool do_prep = (i + 1 < RW_NCH);
            if (i >= 1) {
                LAS float* Yy = RW_ARR(bufn, 7); LAS float* Gg = RW_ARR(bufn, 6); LAS float* Vv = RW_ARR(bufn, 5); LAS float* SC = RW_SC(bufn);
#pragma unroll
                for (int q = 0; q < 4; ++q) {
                    const int tt = 4 * tg + q;
                    const float y = Yy[tt * 64 + c];
                    const float mean = wave_sum_fast(y) * (1.f / 64.f), d = y - mean;
                    const float var = wave_sum_fast(d * d) * (1.f / 64.f);
                    float yn = d * (1.f / sqrtf(var + 64e-5f)) * p_gg + p_gb;
                    yn += SC[tt * 4 + 2] * Vv[tt * 64 + c];
                    const float o = yn * Gg[tt * 64 + c];
                    X.P[((size_t)b * SEQ + (i - 1) * RW_TS + tt) * LDP + COL_YA + hc] = (bf16_t)f2bf(o);
                }
            }
            LDS_BAR();
            if (do_prep) {
                LAS float* Kk = RW_ARR(bufn, 4); LAS float* Vv = RW_ARR(bufn, 5);
                const int par = (i + 1) & 1;
#pragma unroll
                for (int it = 0; it < 4; ++it) {
                    const int idx = ht + 256 * it;
                    if (idx < RW_TS * 56) {
                        const int tt = idx / 56, vv = idx - tt * 56, cc0 = 8 * vv;
                        const f32x4 m0 = *(const LAS f32x4*)&MU[cc0], m1 = *(const LAS f32x4*)&MU[cc0 + 4];
                        float cur[8], prv[8], val[8];
                        cur[0] = bflo(cur4[it].x); cur[1] = bfhi(cur4[it].x); cur[2] = bflo(cur4[it].y); cur[3] = bfhi(cur4[it].y);
                        cur[4] = bflo(cur4[it].z); cur[5] = bfhi(cur4[it].z); cur[6] = bflo(cur4[it].w); cur[7] = bfhi(cur4[it].w);
                        prv[0] = bflo(prv4[it].x); prv[1] = bfhi(prv4[it].x); prv[2] = bflo(prv4[it].y); prv[3] = bfhi(prv4[it].y);
                        prv[4] = bflo(prv4[it].z); prv[5] = bfhi(prv4[it].z); prv[6] = bflo(prv4[it].w); prv[7] = bfhi(prv4[it].w);
                        if (tt == 0) {
#pragma unroll
                            for (int e = 0; e < 8; ++e) prv[e] = (i + 1 > 0) ? CARRY[(par ^ 1) * 448 + cc0 + e] : 0.f;
                        }
                        if (tt == RW_TS - 1) {
#pragma unroll
                            for (int e = 0; e < 8; ++e) CARRY[par * 448 + cc0 + e] = cur[e];
                        }
#pragma unroll
                        for (int e = 0; e < 8; ++e) val[e] = cur[e] + (prv[e] - cur[e]) * (e < 4 ? m0[e & 3] : m1[e & 3]);
                        if (vv < 24) {
                            LAS float* dst = (vv < 8 ? Rr : (vv < 16 ? Kk : Vv)) + tt * 64 + 8 * (vv & 7);
                            *(LAS f32x4*)dst = (f32x4){val[0], val[1], val[2], val[3]}; *(LAS f32x4*)(dst + 4) = (f32x4){val[4], val[5], val[6], val[7]};
                        } else {
                            const int lr0 = 8 * (vv - 24);
                            LAS bf16_t* dst;
                            if (lr0 < 64) { dst = WDb + tt * 72 + lr0;
#pragma unroll
                                for (int e = 0; e < 8; ++e) { const float ex = __expf(2.f * val[e]); val[e] = 1.f - 2.f / (ex + 1.f); } }
                            else if (lr0 < 128) dst = ADb + tt * 72 + lr0 - 64;
                            else { dst = GDb + tt * 136 + lr0 - 128;
#pragma unroll
                                for (int e = 0; e < 8; ++e) val[e] = sigmoidf_(val[e]); }
                            u32x4 o; o.x = pk2(val[0], val[1]); o.y = pk2(val[2], val[3]); o.z = pk2(val[4], val[5]); o.w = pk2(val[6], val[7]);
                            *(LAS u32x4*)dst = o;
                        }
                    }
                }
            }
            if (i + 2 < RW_NCH) RW_A_LOAD(i + 2);
            LDS_BAR();
            if (do_prep) {
                LAS float* Wd = RW_ARR(bufn, 2); LAS float* Gg = RW_ARR(bufn, 6);
                f32x4 cw_ = (f32x4){0.f, 0.f, 0.f, 0.f}, ca_ = cw_, cg_ = cw_;
#pragma unroll
                for (int ks = 0; ks < 2; ++ks) {
                    const bf16x8 xa = *(const LAS bf16x8*)&WDb[ln * 72 + ks * 32 + 8 * lg], xb = *(const LAS bf16x8*)&WTu[(16 * nt + ln) * 72 + ks * 32 + 8 * lg];
                    cw_ = __builtin_amdgcn_mfma_f32_16x16x32_bf16(xa, xb, cw_, 0, 0, 0);
                    const bf16x8 ya = *(const LAS bf16x8*)&ADb[ln * 72 + ks * 32 + 8 * lg], yb = *(const LAS bf16x8*)&WTa[(16 * nt + ln) * 72 + ks * 32 + 8 * lg];
                    ca_ = __builtin_amdgcn_mfma_f32_16x16x32_bf16(ya, yb, ca_, 0, 0, 0);
                }
#pragma unroll
                for (int ks = 0; ks < 4; ++ks) {
                    const bf16x8 za = *(const LAS bf16x8*)&GDb[ln * 136 + ks * 32 + 8 * lg], zb = *(const LAS bf16x8*)&WTg[(16 * nt + ln) * 136 + ks * 32 + 8 * lg];
                    cg_ = __builtin_amdgcn_mfma_f32_16x16x32_bf16(za, zb, cg_, 0, 0, 0);
                }
#pragma unroll
                for (int r = 0; r < 4; ++r) {
                    const int tt = 4 * lg + r;
                    const float z = -(q_w0 + cw_[r]);
                    const float sp = fmaxf(z, 0.f) + __logf(1.f + __expf(-fabsf(z)));
                    Wd[tt * 64 + chm] = __expf(-__expf(-sp - 0.5f));
                    AS[tt * 64 + chm] = sigmoidf_(q_a0 + ca_[r]);
                    Gg[tt * 64 + chm] = cg_[r];
                }
            }
            LDS_BAR();
            if (do_prep) {
                LAS float* A_ = RW_ARR(bufn, 0); LAS float* WR = RW_ARR(bufn, 1); LAS float* Wd = RW_ARR(bufn, 2); LAS float* Bv = RW_ARR(bufn, 3); LAS float* Kk = RW_ARR(bufn, 4); LAS float* SC = RW_SC(bufn);
#pragma unroll
                for (int q = 0; q < 4; ++q) {
                    const int tt = 4 * tg + q;
                    const float decay = Wd[tt * 64 + c], a = AS[tt * 64 + c];
                    const float kraw = Kk[tt * 64 + c], r = Rr[tt * 64 + c];
                    float kk = kraw * p_kk;
                    const float ss = wave_sum_fast(kk * kk);
                    kk *= 1.f / sqrtf(fmaxf(ss, 1e-24f));
                    const float kmod = kraw * (1.f + (a - 1.f) * p_ka);
                    const float bvec = kk * a;
                    const float br = wave_sum_fast(bvec * r), kr = wave_sum_fast(kmod * r), bonus = wave_sum_fast(r * kmod * p_rk);
                    A_[tt * 64 + c] = -kk; Bv[tt * 64 + c] = bvec; WR[tt * 64 + c] = decay * r; Kk[tt * 64 + c] = kmod;
                    if (c == 0) { SC[tt * 4 + 0] = br; SC[tt * 4 + 1] = kr; SC[tt * 4 + 2] = bonus; }
                }
            }
            LDS_BAR();
        } else {
            LAS float* A_ = RW_ARR(bufc, 0); LAS float* WR = RW_ARR(bufc, 1); LAS float* Wd = RW_ARR(bufc, 2); LAS float* Bv = RW_ARR(bufc, 3);
            LAS float* Kk = RW_ARR(bufc, 4); LAS float* Vv = RW_ARR(bufc, 5); LAS float* Yy = RW_ARR(bufc, 7); LAS float* SC = RW_SC(bufc);
#pragma unroll 1
            for (int q4 = 0; q4 < 4; ++q4) {
                if (i >= 0) {
                    f32x2 yk[4];
#pragma unroll
                    for (int s4 = 0; s4 < 4; ++s4) {
                        const int tt = 4 * q4 + s4;
                        const f32x4 a_lo = *(const LAS f32x4*)&A_[tt * 64 + 8 * jg], a_hi = *(const LAS f32x4*)&A_[tt * 64 + 8 * jg + 4];
                        const f32x4 r_lo = *(const LAS f32x4*)&WR[tt * 64 + 8 * jg], r_hi = *(const LAS f32x4*)&WR[tt * 64 + 8 * jg + 4];
                        const f32x4 w_lo = *(const LAS f32x4*)&Wd[tt * 64 + 8 * jg], w_hi = *(const LAS f32x4*)&Wd[tt * 64 + 8 * jg + 4];
                        const f32x4 b_lo = *(const LAS f32x4*)&Bv[tt * 64 + 8 * jg], b_hi = *(const LAS f32x4*)&Bv[tt * 64 + 8 * jg + 4];
                        const f32x4 k_lo = *(const LAS f32x4*)&Kk[tt * 64 + 8 * jg], k_hi = *(const LAS f32x4*)&Kk[tt * 64 + 8 * jg + 4];
                        const f32x2 vv = *(const LAS f32x2*)&Vv[tt * 64 + i0];
                        const f32x2 sc = *(const LAS f32x2*)&SC[tt * 4];
                        const f32x2 av[4] = {{a_lo.x, a_lo.y}, {a_lo.z, a_lo.w}, {a_hi.x, a_hi.y}, {a_hi.z, a_hi.w}};
                        const f32x2 rv[4] = {{r_lo.x, r_lo.y}, {r_lo.z, r_lo.w}, {r_hi.x, r_hi.y}, {r_hi.z, r_hi.w}};
                        const f32x2 wv[4] = {{w_lo.x, w_lo.y}, {w_lo.z, w_lo.w}, {w_hi.x, w_hi.y}, {w_hi.z, w_hi.w}};
                        const f32x2 bv[4] = {{b_lo.x, b_lo.y}, {b_lo.z, b_lo.w}, {b_hi.x, b_hi.y}, {b_hi.z, b_hi.w}};
                        const f32x2 kv[4] = {{k_lo.x, k_lo.y}, {k_lo.z, k_lo.w}, {k_hi.x, k_hi.y}, {k_hi.z, k_hi.w}};
                        f32x2 e10 = S0[0] * av[0], e20 = S0[0] * rv[0], e11 = S1[0] * av[0], e21 = S1[0] * rv[0];
#pragma unroll
                        for (int j = 1; j < 4; ++j) { e10 += S0[j] * av[j]; e20 += S0[j] * rv[j]; e11 += S1[j] * av[j]; e21 += S1[j] * rv[j]; }
                        const float d10 = red8(e10.x + e10.y), d20 = red8(e20.x + e20.y), d11 = red8(e11.x + e11.y), d21 = red8(e21.x + e21.y);
                        yk[s4] = (f32x2){d20 + d10 * sc.x + vv.x * sc.y, d21 + d11 * sc.x + vv.y * sc.y};
                        const f32x2 d10v = (f32x2){d10, d10}, d11v = (f32x2){d11, d11}, v0v = (f32x2){vv.x, vv.x}, v1v = (f32x2){vv.y, vv.y};
#pragma unroll
                        for (int j = 0; j < 4; ++j) { S0[j] = S0[j] * wv[j] + (d10v * bv[j] + v0v * kv[j]); S1[j] = S1[j] * wv[j] + (d11v * bv[j] + v1v * kv[j]); }
                    }
                    if (jg == 0) {
#pragma unroll
                        for (int s4 = 0; s4 < 4; ++s4) *(LAS f32x2*)&Yy[(4 * q4 + s4) * 64 + i0] = yk[s4];
                    }
                }
                LDS_BAR();
            }
        }
    }
    if (helper) {
        const int bufl = (RW_NCH - 1) & 1;
        LAS float* Yy = RW_ARR(bufl, 7); LAS float* Gg = RW_ARR(bufl, 6); LAS float* Vv = RW_ARR(bufl, 5); LAS float* SC = RW_SC(bufl);
#pragma unroll
        for (int q = 0; q < 4; ++q) {
            const int tt = 4 * tg + q;
            const float y = Yy[tt * 64 + c];
            const float mean = wave_sum_fast(y) * (1.f / 64.f), d = y - mean;
            const float var = wave_sum_fast(d * d) * (1.f / 64.f);
            float yn = d * (1.f / sqrtf(var + 64e-5f)) * p_gg + p_gb;
            yn += SC[tt * 4 + 2] * Vv[tt * 64 + c];
            const float o = yn * Gg[tt * 64 + c];
            X.P[((size_t)b * SEQ + (RW_NCH - 1) * RW_TS + tt) * LDP + COL_YA + hc] = (bf16_t)f2bf(o);
        }
    }
    __syncthreads();
#undef RW_ARR
#undef RW_SC
#undef RW_A_LOAD
}

__device__ __forceinline__ void hgrn_task(const Ctx& X, LAS unsigned char* lds, int layer, int b, int h, int vh) {
    LAS float* F = (LAS float*)(lds); LAS float* Q = (LAS float*)(lds + 16384); LAS float* Vv = (LAS float*)(lds + 32768); LAS float* O = (LAS float*)(lds + 40960);
    LAS float* LB = (LAS float*)(lds + 49152);
    const int tid = X.tid;
    const float* lbl = X.in[14];
    const int rp = tid >> 4, dg = tid & 15, v0 = 2 * rp;
    if (tid < 128) LB[tid] = (layer > 0) ? 1.f / (1.f + __expf(lbl[h * 128 + tid] - lbl[512 + h * 128 + tid])) : 0.f;
    f32x2 S0[4], S1[4];
#pragma unroll
    for (int j = 0; j < 4; ++j) { S0[j] = (f32x2){0.f, 0.f}; S1[j] = (f32x2){0.f, 0.f}; }
#define HG_LOAD(chk) do { _Pragma("unroll") for (int it = 0; it < 3; ++it) { const int idx = tid + 512 * it; raw[it] = (u32x4){0u, 0u, 0u, 0u}; \
        if (idx < 32 * 40) { const int tt = idx / 40, vv = idx - tt * 40; \
            const int col = vv < 16 ? 512 + h * 128 + 8 * vv : (vv < 32 ? h * 128 + 8 * (vv - 16) : 1024 + h * 128 + vh * 64 + 8 * (vv - 32)); \
            raw[it] = *(const u32x4*)(X.P + ((size_t)b * SEQ + (chk) * 32 + tt) * LDP + COL_PB + col); } } } while (0)
    u32x4 raw[3];
    HG_LOAD(0);
    __syncthreads();
#pragma unroll 1
    for (int ch = 0; ch < SEQ / 32; ++ch) {
        const int t0 = ch * 32;
#pragma unroll
        for (int it = 0; it < 3; ++it) {
            const int idx = tid + 512 * it;
            if (idx < 32 * 40) {
                const int tt = idx / 40, vv = idx - tt * 40;
                float x[8];
                x[0] = bflo(raw[it].x); x[1] = bfhi(raw[it].x); x[2] = bflo(raw[it].y); x[3] = bfhi(raw[it].y);
                x[4] = bflo(raw[it].z); x[5] = bfhi(raw[it].z); x[6] = bflo(raw[it].w); x[7] = bfhi(raw[it].w);
                LAS float* dst;
                if (vv < 16) {
                    dst = F + tt * 128 + 8 * vv;
#pragma unroll
                    for (int e = 0; e < 8; ++e) { const float lb = LB[8 * vv + e]; x[e] = lb + (1.f - lb) * sigmoidf_(x[e]); }
                } else if (vv < 32) dst = Q + tt * 128 + 8 * (vv - 16);
                else dst = Vv + tt * 64 + 8 * (vv - 32);
                *(LAS f32x4*)dst = (f32x4){x[0], x[1], x[2], x[3]}; *(LAS f32x4*)(dst + 4) = (f32x4){x[4], x[5], x[6], x[7]};
            }
        }
        if (ch + 1 < SEQ / 32) HG_LOAD(ch + 1);
        LDS_BAR();
#pragma unroll 4
        for (int tt = 0; tt < 32; ++tt) {
            const f32x4 f_lo = *(const LAS f32x4*)&F[tt * 128 + 8 * dg], f_hi = *(const LAS f32x4*)&F[tt * 128 + 8 * dg + 4];
            const f32x4 q_lo = *(const LAS f32x4*)&Q[tt * 128 + 8 * dg], q_hi = *(const LAS f32x4*)&Q[tt * 128 + 8 * dg + 4];
            const f32x2 vv = *(const LAS f32x2*)&Vv[tt * 64 + v0];
            const f32x2 f2[4] = {{f_lo.x, f_lo.y}, {f_lo.z, f_lo.w}, {f_hi.x, f_hi.y}, {f_hi.z, f_hi.w}};
            const f32x2 q2[4] = {{q_lo.x, q_lo.y}, {q_lo.z, q_lo.w}, {q_hi.x, q_hi.y}, {q_hi.z, q_hi.w}};
            const f32x2 v0v = (f32x2){vv.x, vv.x}, v1v = (f32x2){vv.y, vv.y};
            f32x2 a0 = (f32x2){0.f, 0.f}, a1 = (f32x2){0.f, 0.f};
#pragma unroll
            for (int j = 0; j < 4; ++j) {
                S0[j] = v0v + f2[j] * (S0[j] - v0v); S1[j] = v1v + f2[j] * (S1[j] - v1v);
                a0 += q2[j] * S0[j]; a1 += q2[j] * S1[j];
            }
            const float o0 = red16(a0.x + a0.y), o1 = red16(a1.x + a1.y);
            if (dg == 0) *(LAS f32x2*)&O[tt * 64 + v0] = (f32x2){o0, o1};
        }
        LDS_BAR();
        if (tid < 256) {
            const int tt = tid >> 3, v8 = (tid & 7) * 8;
            const f32x4 a = *(const LAS f32x4*)&O[tt * 64 + v8], c4 = *(const LAS f32x4*)&O[tt * 64 + v8 + 4];
            u32x4 o; o.x = pk2(a.x, a.y); o.y = pk2(a.z, a.w); o.z = pk2(c4.x, c4.y); o.w = pk2(c4.z, c4.w);
            *(u32x4*)(X.P + ((size_t)b * SEQ + t0 + tt) * LDP + COL_YB + h * 128 + vh * 64 + v8) = o;
        }
    }
#undef HG_LOAD
    __syncthreads();
}

__device__ __forceinline__ unsigned f2ord(float f) { const unsigned u = __builtin_bit_cast(unsigned, f); return (u & 0x80000000u) ? ~u : (u | 0x80000000u); }

__device__ __forceinline__ void dsa_tile(const Ctx& X, LAS unsigned char* lds, int b, int q0) {
    LAS float* sc = (LAS float*)lds;
    LAS unsigned* MASK = (LAS unsigned*)(lds + MASK_OFF);
    const int lane = X.lane, w = X.wave, n = lane & 15, g = lane >> 4;
    const bf16_t* Pb = X.P + (size_t)b * SEQ * LDP;
#pragma unroll 1
    for (int sub = 0; sub < 4; ++sub) {
        const int qs = q0 + 16 * sub;
        {
            bf16x8 bq[4][2]; float wi[4];
            const bf16_t* qrow = Pb + (size_t)(qs + n) * LDP;
#pragma unroll
            for (int hh = 0; hh < 4; ++hh) {
#pragma unroll
                for (int ks = 0; ks < 2; ++ks) bq[hh][ks] = *(const bf16x8*)(qrow + C_QI + hh * 64 + ks * 32 + 8 * g);
                wi[hh] = bf2f(qrow[C_WI + hh]);
            }
            const int nkt = (qs + 16) >> 4;
            bf16x8 a0n = (bf16x8){0, 0, 0, 0, 0, 0, 0, 0}, a1n = a0n;
            if (w < nkt) { const bf16_t* krow = Pb + (size_t)(w * 16 + n) * LDP + C_KI; a0n = *(const bf16x8*)(krow + 8 * g); a1n = *(const bf16x8*)(krow + 32 + 8 * g); }
#pragma unroll 1
            for (int kt = w; kt < nkt; kt += 8) {
                const bf16x8 a0 = a0n, a1 = a1n;
                if (kt + 8 < nkt) { const bf16_t* krow = Pb + (size_t)((kt + 8) * 16 + n) * LDP + C_KI; a0n = *(const bf16x8*)(krow + 8 * g); a1n = *(const bf16x8*)(krow + 32 + 8 * g); }
                f32x4 s = (f32x4){0.f, 0.f, 0.f, 0.f};
#pragma unroll
                for (int hh = 0; hh < 4; ++hh) {
                    f32x4 d = __builtin_amdgcn_mfma_f32_16x16x32_bf16(a0, bq[hh][0], (f32x4){0.f, 0.f, 0.f, 0.f}, 0, 0, 0);
                    d = __builtin_amdgcn_mfma_f32_16x16x32_bf16(a1, bq[hh][1], d, 0, 0, 0);
#pragma unroll
                    for (int r = 0; r < 4; ++r) s[r] += wi[hh] * fmaxf(d[r], 0.f);
                }
                const int t = qs + n;
#pragma unroll
                for (int r = 0; r < 4; ++r) if (kt * 16 + 4 * g + r > t) s[r] = -INFINITY;
                *(LAS f32x4*)&sc[n * SCS + kt * 16 + 4 * g] = s;
            }
        }
        __syncthreads();
#pragma unroll 1
        for (int e = 0; e < 2; ++e) {
            const int qn = 2 * w + e, t = qs + qn;
            LAS unsigned* mrow = MASK + (sub * 16 + qn) * 64;
            if (t < 256) {
#pragma unroll
                for (int j = 0; j < 32; ++j) {
                    const unsigned long long sm = __ballot(j * 64 + lane <= t);
                    if (lane == 0) { mrow[2 * j] = (unsigned)sm; mrow[2 * j + 1] = (unsigned)(sm >> 32); }
                }
            } else {
                const int jn = (t >> 6) + 1;
                unsigned u[32];
#pragma unroll
                for (int j = 0; j < 32; ++j) {
                    u[j] = 0u;
                    if (j < jn) { const int key = j * 64 + lane; const float s = (key <= t) ? sc[qn * SCS + key] : -INFINITY; u[j] = f2ord(s); }
                }
                unsigned prefix = 0u;
#pragma unroll 1
                for (int bit = 31; bit >= 0; --bit) {
                    const unsigned cand = prefix | (1u << bit);
                    int cnt = 0;
#pragma unroll
                    for (int j = 0; j < 32; ++j) if (j < jn) cnt += __popcll(__ballot(u[j] >= cand));
                    if (cnt >= 256) prefix = cand;
                }
                int cg_ = 0;
#pragma unroll
                for (int j = 0; j < 32; ++j) if (j < jn) cg_ += __popcll(__ballot(u[j] > prefix));
                const int need = 256 - cg_;
                int cum = 0;
#pragma unroll
                for (int j = 0; j < 32; ++j) {
                    unsigned long long sm = 0ull;
                    if (j < jn) {
                        const bool eq = (u[j] == prefix);
                        const unsigned long long em = __ballot(eq);
                        const int rank = cum + (int)__builtin_amdgcn_mbcnt_hi((unsigned)(em >> 32), __builtin_amdgcn_mbcnt_lo((unsigned)em, 0u));
                        const bool sel = (u[j] > prefix) || (eq && rank < need);
                        sm = __ballot(sel);
                        cum += __popcll(em);
                    }
                    if (lane == 0) { mrow[2 * j] = (unsigned)sm; mrow[2 * j + 1] = (unsigned)(sm >> 32); }
                }
            }
        }
        __syncthreads();
    }
    const int qq = q0 + 8 * w + (n & 7);
    const LAS unsigned* mq = MASK + (8 * w + (n & 7)) * 64;
    const int nsteps = (q0 + 8 * w + 8 + 31) >> 5;
#pragma unroll 1
    for (int c = 0; c < 2; ++c) {
        bf16x8 bq[2][2];
#pragma unroll
        for (int j = 0; j < 2; ++j)
#pragma unroll
            for (int ks = 0; ks < 2; ++ks) bq[j][ks] = *(const bf16x8*)(Pb + (size_t)qq * LDP + C_Q + (c * 4 + 2 * j + (n >> 3)) * 64 + ks * 32 + 8 * g);
        float lrun[2] = {0.f, 0.f};
        f32x4 oacc[4][2];
#pragma unroll
        for (int mt = 0; mt < 4; ++mt)
#pragma unroll
            for (int j = 0; j < 2; ++j) oacc[mt][j] = (f32x4){0.f, 0.f, 0.f, 0.f};
        const bf16_t* vtb = X.VT + ((size_t)(b * 2 + c) * 64) * SEQ;
#define DSA_LOAD(KA, VL, VH, kb_) do { _Pragma("unroll") for (int tl = 0; tl < 2; ++tl) { const bf16_t* krow = Pb + (size_t)((kb_) + 16 * tl + n) * LDP + C_K + c * 64; \
            KA[tl][0] = *(const bf16x8*)(krow + 8 * g); KA[tl][1] = *(const bf16x8*)(krow + 32 + 8 * g); } \
            _Pragma("unroll") for (int mt = 0; mt < 4; ++mt) { const bf16_t* vp = vtb + (size_t)(mt * 16 + n) * SEQ + (kb_) + 4 * g; VL[mt] = *(const u32x2*)vp; VH[mt] = *(const u32x2*)(vp + 16); } } while (0)
        bf16x8 kan[2][2]; u32x2 vln[4], vhn[4];
        DSA_LOAD(kan, vln, vhn, 0);
#pragma unroll 1
        for (int s = 0; s < nsteps; ++s) {
            const int kb = 32 * s;
            bf16x8 ka[2][2]; bf16x8 av[4];
#pragma unroll
            for (int tl = 0; tl < 2; ++tl) { ka[tl][0] = kan[tl][0]; ka[tl][1] = kan[tl][1]; }
#pragma unroll
            for (int mt = 0; mt < 4; ++mt) { u32x4 t4; t4.x = vln[mt].x; t4.y = vln[mt].y; t4.z = vhn[mt].x; t4.w = vhn[mt].y; av[mt] = __builtin_bit_cast(bf16x8, t4); }
            if (s + 1 < nsteps) DSA_LOAD(kan, vln, vhn, kb + 32);
            f32x4 st[2][2];
#pragma unroll
            for (int tl = 0; tl < 2; ++tl) {
#pragma unroll
                for (int j = 0; j < 2; ++j) {
                    f32x4 d = __builtin_amdgcn_mfma_f32_16x16x32_bf16(ka[tl][0], bq[j][0], (f32x4){0.f, 0.f, 0.f, 0.f}, 0, 0, 0);
                    st[tl][j] = __builtin_amdgcn_mfma_f32_16x16x32_bf16(ka[tl][1], bq[j][1], d, 0, 0, 0);
                }
            }
            const unsigned mw = mq[s];
#pragma unroll
            for (int j = 0; j < 2; ++j) {
                float p[8], ps = 0.f;
#pragma unroll
                for (int tl = 0; tl < 2; ++tl)
#pragma unroll
                    for (int r = 0; r < 4; ++r) { const int bit = 16 * tl + 4 * g + r; const float e = __expf(fminf(st[tl][j][r] * 0.125f, 60.f)); p[4 * tl + r] = ((mw >> bit) & 1u) ? e : 0.f; ps += p[4 * tl + r]; }
                lrun[j] += ps;
                u32x4 pw; pw.x = pg8::cvt_pk_bf16(p[0], p[1]); pw.y = pg8::cvt_pk_bf16(p[2], p[3]); pw.z = pg8::cvt_pk_bf16(p[4], p[5]); pw.w = pg8::cvt_pk_bf16(p[6], p[7]);
                const bf16x8 pb = __builtin_bit_cast(bf16x8, pw);
#pragma unroll
                for (int mt = 0; mt < 4; ++mt) oacc[mt][j] = __builtin_amdgcn_mfma_f32_16x16x32_bf16(av[mt], pb, oacc[mt][j], 0, 0, 0);
            }
        }
#pragma unroll
        for (int j = 0; j < 2; ++j) {
            float lt = lrun[j]; lt += __shfl_xor(lt, 16); lt += __shfl_xor(lt, 32);
            const float il = 1.f / lt;
            bf16_t* op = X.P + ((size_t)b * SEQ + qq) * LDP + COL_YC + (c * 4 + 2 * j + (n >> 3)) * 64 + 4 * g;
#pragma unroll
            for (int mt = 0; mt < 4; ++mt) {
                const f32x4 o = oacc[mt][j] * il;
                u32x2 wv; wv.x = pg8::cvt_pk_bf16(o[0], o[1]); wv.y = pg8::cvt_pk_bf16(o[2], o[3]);
                *(u32x2*)(op + mt * 16) = wv;
            }
        }
    }
#undef DSA_LOAD
    __syncthreads();
}

__device__ __forceinline__ void phase_mixers(const Ctx& X0, LAS unsigned char* lds, int layer) {
#pragma unroll 1
    for (int task = X0.bid; task < 256; task += X0.G) {
        Ctx X = X0;
        { int t_ = threadIdx.x; asm volatile("" : "+v"(t_)); X.tid = t_; X.lane = t_ & 63; }
        if (task < 64) { if (TKMASK & 1) rwkv_task(X, lds, layer, task >> 3, task & 7); }
        else if (task < 128) { const int k = task - 64; if (TKMASK & 2) hgrn_task(X, lds, layer, k >> 3, (k >> 1) & 3, k & 1); }
        else if (TKMASK & 4) {
            const int k = task - 128, b = k >> 4, p = k & 15;
#pragma unroll 1
            for (int rep = 0; rep < 2; ++rep) dsa_tile(X, lds, b, rep == 0 ? 64 * (31 - p) : 64 * p);
        }
    }
}

__device__ __forceinline__ void phase_hgrn_post(const Ctx& X, int layer) {
    const int gw = X.bid * 8 + X.wave, NGW = X.G * 8;
    const float* gn = X.in[15] + layer * 512;
    for (int it = gw; it < T_TOK * 4; it += NGW) {
        const int t = it >> 2, h = it & 3;
        bf16_t* rowp = X.P + (size_t)t * LDP;
        unsigned* op = (unsigned*)(rowp + COL_YB + h * 128) + X.lane;
        const unsigned ow = *op, gwd = *((const unsigned*)(rowp + COL_PB + 1536 + h * 128) + X.lane);
        const float o0 = bflo(ow), o1 = bfhi(ow), g0 = bflo(gwd), g1 = bfhi(gwd);
        const float rs = 1.f / sqrtf(wave_sum(o0 * o0 + o1 * o1) * (1.f / 128.f) + 1e-6f);
        const float y0 = o0 * rs * gn[h * 128 + 2 * X.lane] * (g0 * sigmoidf_(g0)), y1 = o1 * rs * gn[h * 128 + 2 * X.lane + 1] * (g1 * sigmoidf_(g1));
        *op = pk2(y0, y1);
    }
}

__device__ __forceinline__ void phase_fixup(const Ctx& X, int layer) {
    const float* cw = X.in[20] + (size_t)layer * 3 * F2; const float* cb = X.in[21] + (size_t)layer * F2;
    for (int idx = X.bid * 512 + X.tid; idx < 256 * 2 * DFF; idx += X.G * 512) {
        const int j = idx % DFF, sr = idx / DFF, s = sr >> 1, r = sr & 1;
        const int colg = (j >> 7) * 256 + (j & 127), colv = colg + 128;
        const bool seq0 = (s & 31) == 0;
        const float* H = X.HALO;
        float res[2];
#pragma unroll
        for (int part = 0; part < 2; ++part) {
            const int cp = part ? colv : colg, co = part * DFF + j;
            const float u0 = H[(size_t)(s * 4 + r) * F2 + cp];
            float u1, u2;
            if (r == 0) { u1 = seq0 ? 0.f : H[(size_t)((s - 1) * 4 + 3) * F2 + cp]; u2 = seq0 ? 0.f : H[(size_t)((s - 1) * 4 + 2) * F2 + cp]; }
            else { u1 = H[(size_t)(s * 4 + 0) * F2 + cp]; u2 = seq0 ? 0.f : H[(size_t)((s - 1) * 4 + 3) * F2 + cp]; }
            res[part] = cb[co] + cw[co] * u2 + cw[F2 + co] * u1 + cw[2 * F2 + co] * u0;
        }
        const float a = res[0] * sigmoidf_(res[0]) * res[1];
        X.P[(size_t)(s * 64 + r) * LDP + COL_ACT + j] = (bf16_t)f2bf(a);
    }
}

#define XB_TMO      128
#define XB_XCNT(j)  (256  + 64 * (j))
#define XB_XSUB(j)  (1280 + 64 * (j))
#define XB_XGEN(j)  (2304 + 64 * (j))
#define XB_TOP      3328
#define XB_TOPGEN   3392
#define XCD_BAR_WORDS 3456
#define XB_SPIN_CAP (1u << 22)
__device__ __forceinline__ unsigned xb_ld(unsigned* p)              { return __hip_atomic_load(p, __ATOMIC_RELAXED, __HIP_MEMORY_SCOPE_AGENT); }
__device__ __forceinline__ unsigned xb_add(unsigned* p, unsigned v) { return __hip_atomic_fetch_add(p, v, __ATOMIC_RELAXED, __HIP_MEMORY_SCOPE_AGENT); }
__device__ __forceinline__ unsigned xb_xcc_id() { return (unsigned)__builtin_amdgcn_s_getreg((3 << 11) | 20) & 0xFu; }
#define XB_SPIN(cond, bar) do { unsigned _sp = 0; while (cond) { __builtin_amdgcn_s_sleep(1); \
    if ((++_sp & 255u) == 0u) { if (xb_ld(&(bar)[XB_TMO])) break; if (_sp > XB_SPIN_CAP) { atomicAdd(&(bar)[XB_TMO], 1u); break; } } } } while (0)
struct XcdBarrier { unsigned* bar; unsigned x; volatile LAS unsigned* st; };
__device__ __forceinline__ XcdBarrier xcd_barrier_post(unsigned* bar, volatile LAS unsigned* st) {
    XcdBarrier b; b.bar = bar; b.x = xb_xcc_id(); b.st = st;
    if (threadIdx.x == 0) (void)xb_add(&bar[XB_XCNT(b.x)], 1u);
    return b;
}
__device__ __forceinline__ void xcd_barrier_complete(unsigned* bar, unsigned x, unsigned& nloc, unsigned& nx) {
    const unsigned G = gridDim.x * gridDim.y * gridDim.z;
    unsigned sum, cnt, mine, sp = 0u;
    for (;;) {
        sum = 0u; cnt = 0u; mine = 0u;
#pragma unroll
        for (unsigned j = 0; j < 16; ++j) { const unsigned c = xb_ld(&bar[XB_XCNT(j)]); sum += c; cnt += (c > 0u) ? 1u : 0u; mine = (j == x) ? c : mine; }
        if (sum == G) break;
        __builtin_amdgcn_s_sleep(1);
        if ((++sp & 255u) == 0u) { if (xb_ld(&bar[XB_TMO])) break; if (sp > XB_SPIN_CAP) { atomicAdd(&bar[XB_TMO], 1u); break; } }
    }
    nloc = mine > 0u ? mine : 1u; nx = cnt > 0u ? cnt : 1u;
}
__device__ __forceinline__ void xcd_barrier(const XcdBarrier& b) {
    asm volatile("s_waitcnt vmcnt(0)" ::: "memory");
    __syncthreads();
    if (threadIdx.x == 0) {
        unsigned* bar = b.bar;
        __builtin_amdgcn_s_waitcnt(0);
        unsigned nloc = b.st[0], nx = b.st[1];
        if (nloc == 0u) { xcd_barrier_complete(bar, b.x, nloc, nx); b.st[0] = nloc; b.st[1] = nx; }
        const unsigned old = xb_add(&bar[XB_XSUB(b.x)], 1u);
        const unsigned gen = old / nloc;
        if (old + 1u == (gen + 1u) * nloc) {
            __builtin_amdgcn_fence(__ATOMIC_RELEASE, "agent");
            asm volatile("s_waitcnt vmcnt(0)" ::: "memory");
            const unsigned og = xb_add(&bar[XB_TOP], 1u);
            const unsigned tg = og / nx;
            if (og + 1u == (tg + 1u) * nx) xb_add(&bar[XB_TOPGEN], 1u);
            else XB_SPIN(xb_ld(&bar[XB_TOPGEN]) == tg, bar);
            __builtin_amdgcn_fence(__ATOMIC_ACQUIRE, "agent");
            xb_add(&bar[XB_XGEN(b.x)], 1u);
            asm volatile("s_waitcnt vmcnt(0)" ::: "memory");
        } else {
            XB_SPIN(xb_ld(&bar[XB_XGEN(b.x)]) == gen, bar);
            __builtin_amdgcn_fence(__ATOMIC_ACQUIRE, "agent");
            asm volatile("s_waitcnt vmcnt(0)" ::: "memory");
        }
    }
    __syncthreads();
}

__global__ void __launch_bounds__(512, 2) mk_fwd(Args args) {
    extern __shared__ __attribute__((aligned(16))) unsigned char lds_raw[];
    LAS unsigned char* lds = (LAS unsigned char*)lds_raw;
    Ctx X;
#pragma unroll
    for (int i = 0; i < 24; ++i) X.in[i] = args.in[i];
    X.out = args.out; X.ws = args.ws;
    X.P = (bf16_t*)(args.ws + WS_P); X.VT = (bf16_t*)(args.ws + WS_VT); X.HALO = (float*)(args.ws + WS_HALO); X.ROPE = (float*)(args.ws + WS_ROPE);
    X.Win = (bf16_t*)(args.ws + WS_WIN); X.Wg = (bf16_t*)(args.ws + WS_WG); X.Wbr = (bf16_t*)(args.ws + WS_WBR);
    X.Wo = (bf16_t*)(args.ws + WS_WO); X.Wup = (bf16_t*)(args.ws + WS_WUP); X.Wdn = (bf16_t*)(args.ws + WS_WDN);
    X.tid = threadIdx.x; X.lane = X.tid & 63; X.wave = __builtin_amdgcn_readfirstlane(X.tid >> 6); X.G = gridDim.x; X.bid = blockIdx.x;

#if PROBE_DOUBLE
    for (int ph2 = args.ph_lo * 2; ph2 < args.ph_hi * 2; ++ph2) {
        const int ph = ph2 >> 1;
        const int layer = ph / 10, sub = ph % 10;
        const bool skip_ = (ph2 & 1) && !(ph < 20 && ((REPMASK >> sub) & 1));
#else
    volatile LAS unsigned* bst = (volatile LAS unsigned*)(lds + LDS_BYTES - 64);
    if (threadIdx.x < 2) bst[threadIdx.x] = 0u;
    __syncthreads();
    XcdBarrier gbar = xcd_barrier_post((unsigned*)(args.ws + WS_BAR), bst);
    for (int ph = args.ph_lo; ph < args.ph_hi; ++ph) {
        const int layer = ph / 10, sub = ph % 10;
        const bool skip_ = false;
#endif
        { int t_ = threadIdx.x; asm volatile("" : "+v"(t_)); X.tid = t_; X.lane = t_ & 63; }

        if (skip_) {
        } else if (ph == 20 && (PHMASK & 1024)) {
            const int gw = X.bid * 8 + X.wave, NGW = X.G * 8;
            for (int m = gw; m < T_TOK; m += NGW) rms_row(X.out + (size_t)m * DM, X.in[23], nullptr, X.out + (size_t)m * DM, X.lane);
        } else if (sub == 0 && (PHMASK & 1)) {
            phase_prep(X, lds, layer);
        } else if (sub == 1 && (PHMASK & 2)) {
            pg8::Gemm g{X.P, X.Win, LDP, DM, DM}; pg8::StaticOrder S; S.init(T_TOK, 5120, X.G, X.bid);
            pg8::EpiInProj E{X.P, X.VT, X.ROPE};
            pg8::gemm_phase<pg8::EpiInProj, true>(lds, g, S, E, X.tid);
        } else if (sub == 2 && (PHMASK & 4)) {
            phase_mixers(X, lds, layer);
        } else if (sub == 3 && (PHMASK & 8)) {
            phase_hgrn_post(X, layer);
        } else if (sub == 4 && (PHMASK & 16)) {
#pragma unroll 1
            for (int br = 0; br < 3; ++br) {
                { pg8::Gemm g{X.P, X.Wg + (size_t)br * DM * DM, LDP, DM, DM}; pg8::StaticOrder S; S.init(T_TOK, DM, X.G, X.bid);
                  int t_ = X.tid; asm volatile("" : "+v"(t_));
                  pg8::EpiGate E{X.P}; pg8::gemm_phase<pg8::EpiGate, true>(lds, g, S, E, t_); }
                { const int ycol = br == 0 ? COL_YA : (br == 1 ? COL_YB : COL_YC);
                  pg8::Gemm g{X.P + ycol, X.Wbr + (size_t)br * DM * 512, LDP, 512, 512}; pg8::StaticOrder S; S.init(T_TOK, DM, X.G, X.bid);
                  int t_ = X.tid; asm volatile("" : "+v"(t_));
                  pg8::EpiMergeAcc E{X.P, br == 0 ? 1 : 0}; pg8::gemm_phase<pg8::EpiMergeAcc, true>(lds, g, S, E, t_); }
            }
        } else if (sub == 5 && (PHMASK & 32)) {
            pg8::Gemm g{X.P + COL_MRG, X.Wo, LDP, DM, DM}; pg8::StaticOrder S; S.init(T_TOK, DM, X.G, X.bid);
            pg8::EpiResid E{layer == 0 ? X.in[0] : X.out, X.out};
            pg8::gemm_phase<pg8::EpiResid, true>(lds, g, S, E, X.tid);
        } else if (sub == 6 && (PHMASK & 64)) {
            const int gw = X.bid * 8 + X.wave, NGW = X.G * 8;
            const float* g = X.in[18] + (size_t)layer * DM;
            for (int m = gw; m < T_TOK; m += NGW) rms_row(X.out + (size_t)m * DM, g, X.P + (size_t)m * LDP, nullptr, X.lane);
        } else if (sub == 7 && (PHMASK & 128)) {
            pg8::Gemm g{X.P, X.Wup, LDP, DM, DM}; pg8::StaticOrder S; S.init(T_TOK, F2, X.G, X.bid);
            pg8::EpiUp E{X.P, X.HALO, X.in[20] + (size_t)layer * 3 * F2, X.in[21] + (size_t)layer * F2};
            pg8::gemm_phase<pg8::EpiUp, true>(lds, g, S, E, X.tid);
        } else if (sub == 8 && (PHMASK & 256)) {
            phase_fixup(X, layer);
        } else if (PHMASK & 512) {
            pg8::Gemm g{X.P + COL_ACT, X.Wdn, LDP, DFF, DFF}; pg8::StaticOrder S; S.init(T_TOK, DM, X.G, X.bid);
            pg8::EpiResid E{X.out, X.out};
            pg8::gemm_phase<pg8::EpiResid, true>(lds, g, S, E, X.tid);
        }
#if PROBE_DOUBLE
        if (ph2 + 1 < args.ph_hi * 2) cg::this_grid().sync();
#else
        if (ph + 1 < args.ph_hi) { if (ph == args.ph_lo) cg::this_grid().sync(); else xcd_barrier(gbar); }
#endif
    }
}

extern "C" void kernel_launch(void* const* d_in, const int* in_sizes, int n_in, void* d_out, int out_size, void* d_ws, size_t ws_size, hipStream_t stream) {
    static int grid = 0;
    if (grid == 0) {
        int dev = 0, cus = 0, per_cu = 0;
        (void)hipGetDevice(&dev);
        (void)hipDeviceGetAttribute(&cus, hipDeviceAttributeMultiprocessorCount, dev);
        if (hipFuncSetAttribute((const void*)mk_fwd, hipFuncAttributeMaxDynamicSharedMemorySize, LDS_BYTES) != hipSuccess) fprintf(stderr, "kernel_launch: hipFuncSetAttribute failed\n");
        if (hipOccupancyMaxActiveBlocksPerMultiprocessor(&per_cu, (const void*)mk_fwd, 512, LDS_BYTES) != hipSuccess || per_cu < 1) { fprintf(stderr, "kernel_launch: occupancy query gave %d\n", per_cu); per_cu = 1; }
        (void)hipGetLastError();
        grid = cus * 1;
        if (grid <= 0) grid = 256;
        if (ws_size < (size_t)268435456) fprintf(stderr, "kernel_launch: workspace too small (%zu)\n", ws_size);
    }
    Args a{};
    for (int i = 0; i < 24; ++i) a.in[i] = (const float*)d_in[i];
    a.out = (float*)d_out; a.ws = (unsigned char*)d_ws;
#if MK_SINGLE
    (void)hipMemsetAsync((char*)d_ws + WS_BAR, 0, XCD_BAR_WORDS * 4, stream);
    a.ph_lo = 0; a.ph_hi = 21;
    void* kargs[] = {&a};
    hipError_t e = hipLaunchCooperativeKernel((const void*)mk_fwd, dim3(grid), dim3(512), kargs, LDS_BYTES, stream);
    if (e != hipSuccess) fprintf(stderr, "cooperative launch failed: %s (grid %d)\n", hipGetErrorString(e), grid);
#else
    for (int ph = 0; ph < 21; ++ph) {
        a.ph_lo = ph; a.ph_hi = ph + 1;
        hipLaunchKernelGGL(mk_fwd, dim3(grid), dim3(512), LDS_BYTES, stream, a);
    }
#endif
}
```

```cpp
#include <hip/hip_runtime.h>
#include <hip/hip_cooperative_groups.h>
#include <cstdio>
#include <cstdint>
namespace cg = cooperative_groups;

#ifndef PHMASK
#define PHMASK 2047
#endif
#ifndef REPMASK
#define REPMASK 0
#endif
#ifndef PROBE_DOUBLE
#define PROBE_DOUBLE 0
#endif
#ifndef PROBE_SCAN2
#define PROBE_SCAN2 0
#endif
#ifndef TKMASK
#define TKMASK 7
#endif
#ifndef MK_SINGLE
#define MK_SINGLE 1
#endif

#define LAS __attribute__((address_space(3)))
typedef unsigned short bf16_t;
typedef short bf16x8 __attribute__((ext_vector_type(8)));
typedef float f32x4 __attribute__((ext_vector_type(4)));
typedef float f32x2 __attribute__((ext_vector_type(2)));
typedef unsigned u32x4 __attribute__((ext_vector_type(4)));
typedef unsigned u32x2 __attribute__((ext_vector_type(2)));

constexpr int T_TOK = 16384, SEQ = 2048, DM = 1024;
constexpr int LDP = 6144;
constexpr int COL_PA = 1024, COL_PB = 2816, COL_PC = 4864;
constexpr int COL_YA = 1024, COL_MRG = 1536, COL_G = 2816, COL_YB = 3840, COL_YC = 4864, COL_ACT = 1024;
constexpr int C_Q = 4864, C_K = 5376, C_QI = 5632, C_KI = 5888, C_WI = 5952;
constexpr int IN_COLS = 8004, DFF = 2816, F2 = 5632;
constexpr size_t WS_WIN = 0, WS_WG = 10485760, WS_WBR = 16777216, WS_WO = 19922944, WS_WUP = 22020096, WS_WDN = 33554432;
constexpr size_t WS_P = 41943040, WS_HALO = 243269632, WS_VT = WS_HALO, WS_ROPE = 266338304, WS_BAR = 266862592, WS_BND = WS_HALO + 4194304, WS_SCAL = WS_HALO + 8388608;
constexpr int LDS_BYTES = 153600;
constexpr int SCS = 2052;
constexpr int MASK_OFF = 16 * SCS * 4;

struct Args { const float* in[24]; float* out; unsigned char* ws; int ph_lo, ph_hi; };

__device__ __forceinline__ unsigned f2bf(float f) { unsigned u = __builtin_bit_cast(unsigned, f); return (u + 0x7fffu + ((u >> 16) & 1u)) >> 16; }
__device__ __forceinline__ unsigned pk2(float lo, float hi) { return f2bf(lo) | (f2bf(hi) << 16); }
__device__ __forceinline__ float bf2f(bf16_t b) { return __builtin_bit_cast(float, (unsigned)b << 16); }
__device__ __forceinline__ float bflo(unsigned w) { return __builtin_bit_cast(float, w << 16); }
__device__ __forceinline__ float bfhi(unsigned w) { return __builtin_bit_cast(float, w & 0xffff0000u); }
__device__ __forceinline__ float wave_sum(float v) {
#pragma unroll
    for (int o = 1; o < 64; o <<= 1) v += __shfl_xor(v, o);
    return v;
}
__device__ __forceinline__ int wave_sum_i(int v) {
#pragma unroll
    for (int o = 1; o < 64; o <<= 1) v += __shfl_xor(v, o);
    return v;
}
template <int CTRL> __device__ __forceinline__ float dpp_mov(float x) {
    return __builtin_bit_cast(float, __builtin_amdgcn_update_dpp(0, __builtin_bit_cast(int, x), CTRL, 0xF, 0xF, true));
}
__device__ __forceinline__ float red8(float x) { x += dpp_mov<0xB1>(x); x += dpp_mov<0x4E>(x); x += dpp_mov<0x141>(x); return x; }
__device__ __forceinline__ float red16(float x) { x = red8(x); x += dpp_mov<0x140>(x); return x; }
__device__ __forceinline__ float sigmoidf_(float x) { return 1.f / (1.f + __expf(-x)); }

namespace pg8 {
constexpr int BM = 256, BK = 64, HALF = 128, HTB = HALF * BK * 2, NXCD = 8, WGM = 8;
__device__ __forceinline__ int lds_byte(int r, int c) { const int st = (r >> 4) * 2 + (c >> 5), rr = r & 15, cc = c & 31, ob = rr * 64 + cc * 2; return st * 1024 + (ob ^ (((ob >> 9) & 1) << 5)); }
__device__ __forceinline__ void stage_rc(int b, int& R, int& C) { const int st = b / 1024, sb = b % 1024, swz = sb ^ (((sb >> 9) & 1) << 5); R = (st >> 1) * 16 + swz / 64; C = (st & 1) * 32 + (swz % 64) / 2; }
__device__ __forceinline__ int perm32(int rho) { const int n = rho >> 4, i = rho & 15; return 8 * (i >> 2) + 4 * n + (i & 3); }
struct Unit { int pm, pn; };
struct Gemm { const bf16_t* A; const bf16_t* Bt; int lda, ldb, K; };
struct StaticOrder {
    int nM, nN, nwg, G, c;
    __device__ void init(int M, int N, int G_, int c_) { nM = M / BM; nN = N / BM; nwg = nM * nN; G = G_; c = c_; }
    __device__ bool next(int i, Unit& u) const {
        const long L = (long)i * G + c; if (L >= nwg) return false;
        int wgid = (int)L; { const int q = nwg / NXCD, r = nwg % NXCD, xcd = wgid % NXCD, off = wgid / NXCD; wgid = (xcd < r ? xcd * (q + 1) : r * (q + 1) + (xcd - r) * q) + off; }
        const int nig = WGM * nN, gid = wgid / nig, fm = gid * WGM, gsz = (nM - fm) < WGM ? (nM - fm) : WGM;
        u.pm = fm + ((wgid % nig) % gsz); u.pn = (wgid % nig) / gsz; return true;
    }
};
__device__ __forceinline__ unsigned cvt_pk_bf16(float lo, float hi) { unsigned r; asm volatile("v_cvt_pk_bf16_f32 %0, %1, %2" : "=v"(r) : "v"(lo), "v"(hi)); return r; }

template <class Epi, bool ALIGN_EPI>
__device__ __forceinline__ void gemm_phase(LAS unsigned char* lds, const Gemm g, const StaticOrder& S, const Epi& E, const int tid) {
    const int wid = __builtin_amdgcn_readfirstlane(tid >> 6), lane = tid & 63, wr = wid >> 2, wc = wid & 3, fr = lane & 15, fq = lane >> 4;
    const int K = g.K, nt = K / BK;
    unsigned voffA[2], voffB[2];
#pragma unroll
    for (int i = 0; i < 2; ++i) { int R, C; stage_rc(tid * 16 + i * 8192, R, C); const int Rb = (R & ~31) + perm32(R & 31);
        voffA[i] = (unsigned)(R * g.lda + C) * 2u; voffB[i] = (unsigned)(Rb * g.ldb + C) * 2u; }
    const size_t kstep = (size_t)(BK * 2);
    const size_t hstepA = (size_t)HALF * g.lda * 2, hstepB = (size_t)HALF * g.ldb * 2;
    const size_t tstepA = 2 * hstepA, tstepB = 2 * hstepB;
    const unsigned ldsw = (unsigned)wid * 1024u;
    const int aoff = lds_byte(wr * 64 + fr, fq * 8), boff = lds_byte(wc * 32 + fr, fq * 8);
#define PG8_SA(b, h) (((b) * 2 + (h)) * HTB)
#define PG8_SB(b, h) ((4 + (b) * 2 + (h)) * HTB)
#define PG8_STAGE(bufoff, gbase, voff) do { _Pragma("unroll") for (int _i = 0; _i < 2; ++_i) \
        __builtin_amdgcn_global_load_lds((const unsigned*)((const char*)(gbase) + (voff)[_i]), (LAS unsigned*)(lds + (bufoff) + ldsw + _i * 8192), 16, 0, 0); } while (0)
#define PG8_LDA(dst, b, h) do { _Pragma("unroll") for (int m = 0; m < 4; ++m) _Pragma("unroll") for (int k = 0; k < 2; ++k) dst[m][k] = *(const LAS bf16x8*)(lds + PG8_SA(b, h) + aoff + m * 2048 + k * 1024); } while (0)
#define PG8_LDB(dst, b, h) do { _Pragma("unroll") for (int n = 0; n < 2; ++n) _Pragma("unroll") for (int k = 0; k < 2; ++k) dst[n][k] = *(const LAS bf16x8*)(lds + PG8_SB(b, h) + boff + n * 2048 + k * 1024); } while (0)
#define PG8_MMA(ai, bj, At, Bt) do { __builtin_amdgcn_s_setprio(1); _Pragma("unroll") for (int m = 0; m < 4; ++m) _Pragma("unroll") for (int n = 0; n < 2; ++n) _Pragma("unroll") for (int k = 0; k < 2; ++k) \
        acc[ai][bj][m][n] = __builtin_amdgcn_mfma_f32_16x16x32_bf16(Bt[n][k], At[m][k], acc[ai][bj][m][n], 0, 0, 0); __builtin_amdgcn_s_setprio(0); } while (0)
#define PG8_WAIT_V(n) asm volatile("s_waitcnt vmcnt(" #n ")" ::: "memory")
#define PG8_WAIT_L(n) asm volatile("s_waitcnt lgkmcnt(" #n ")" ::: "memory")
#define PG8_BAR __builtin_amdgcn_s_barrier()
#define PG8_SCHED __builtin_amdgcn_sched_barrier(0)
    Unit cur, nxt; int ui = 0;
    if (!S.next(0, cur)) return;
    f32x4 acc[2][2][4][2];
#pragma unroll
    for (int a = 0; a < 2; ++a)
#pragma unroll
        for (int b = 0; b < 2; ++b)
#pragma unroll
            for (int m = 0; m < 4; ++m)
#pragma unroll
                for (int n = 0; n < 2; ++n) acc[a][b][m][n] = (f32x4){0.f, 0.f, 0.f, 0.f};
    bf16x8 At[4][2], B0[2][2], B1[2][2];
    const char* cA = (const char*)g.A + (size_t)cur.pm * tstepA; const char* cB = (const char*)g.Bt + (size_t)cur.pn * tstepB;
    PG8_STAGE(PG8_SB(0, 0), cB, voffB); PG8_STAGE(PG8_SB(0, 1), cB + hstepB, voffB); PG8_STAGE(PG8_SA(0, 0), cA, voffA); PG8_STAGE(PG8_SA(0, 1), cA + hstepA, voffA);
    if (wr == 1) PG8_BAR;
    PG8_WAIT_V(2); PG8_BAR;
    PG8_STAGE(PG8_SB(1, 0), cB + kstep, voffB); PG8_STAGE(PG8_SA(1, 0), cA + kstep, voffA); PG8_STAGE(PG8_SB(1, 1), cB + hstepB + kstep, voffB);
    PG8_WAIT_V(6); PG8_BAR;
    for (;;) {
        const bool has_next = S.next(ui + 1, nxt);
        const char* nA = has_next ? (const char*)g.A + (size_t)nxt.pm * tstepA : cA; const char* nB = has_next ? (const char*)g.Bt + (size_t)nxt.pn * tstepB : cB;
        for (int t = 0; t < nt; t += 2) {
            const bool last = (t == nt - 2);
            const char* a1 = cA + (size_t)(t + 1) * kstep;
            const char* a2 = last ? nA : cA + (size_t)(t + 2) * kstep; const char* b2 = last ? nB : cB + (size_t)(t + 2) * kstep;
            const char* a3 = a2 + kstep; const char* b3 = b2 + kstep;
            PG8_LDB(B0, 0, 0); PG8_LDB(B1, 0, 1); PG8_SCHED; PG8_LDA(At, 0, 0); PG8_STAGE(PG8_SA(1, 1), a1 + hstepA, voffA);
            PG8_WAIT_V(8); PG8_WAIT_L(0); PG8_BAR; PG8_MMA(0, 0, At, B0); PG8_MMA(0, 1, At, B1); PG8_BAR; PG8_SCHED;
            PG8_LDA(At, 0, 1); PG8_STAGE(PG8_SB(0, 0), b2, voffB); PG8_STAGE(PG8_SB(0, 1), b2 + hstepB, voffB); PG8_STAGE(PG8_SA(0, 0), a2, voffA);
            PG8_WAIT_V(8); PG8_WAIT_L(0); PG8_BAR; PG8_MMA(1, 0, At, B0); PG8_MMA(1, 1, At, B1); PG8_BAR; PG8_SCHED;
            PG8_LDB(B0, 1, 0); PG8_LDB(B1, 1, 1); PG8_SCHED; PG8_LDA(At, 1, 0); PG8_STAGE(PG8_SA(0, 1), a2 + hstepA, voffA);
            PG8_WAIT_V(8); PG8_WAIT_L(0); PG8_BAR; PG8_MMA(0, 0, At, B0); PG8_MMA(0, 1, At, B1); PG8_BAR; PG8_SCHED;
            PG8_LDA(At, 1, 1); PG8_STAGE(PG8_SB(1, 0), b3, voffB); PG8_STAGE(PG8_SB(1, 1), b3 + hstepB, voffB); PG8_STAGE(PG8_SA(1, 0), a3, voffA);
            PG8_WAIT_V(8); PG8_WAIT_L(0); PG8_BAR; PG8_MMA(1, 0, At, B0); PG8_MMA(1, 1, At, B1); PG8_BAR; PG8_SCHED;
        }
        if constexpr (ALIGN_EPI) { if (wr == 0) PG8_BAR; }
        E(acc, cur, wr, wc, fr, fq);
        if (!has_next) break;
#pragma unroll
        for (int a = 0; a < 2; ++a)
#pragma unroll
            for (int b = 0; b < 2; ++b)
#pragma unroll
                for (int m = 0; m < 4; ++m)
#pragma unroll
                    for (int n = 0; n < 2; ++n) acc[a][b][m][n] = (f32x4){0.f, 0.f, 0.f, 0.f};
        cur = nxt; cA = nA; cB = nB; ++ui;
        if constexpr (ALIGN_EPI) { if (wr == 1) PG8_BAR; }
    }
    PG8_WAIT_V(0);
    if constexpr (!ALIGN_EPI) { if (wr == 0) PG8_BAR; }
    PG8_BAR;
#undef PG8_SA
#undef PG8_SB
#undef PG8_STAGE
#undef PG8_LDA
#undef PG8_LDB
#undef PG8_MMA
#undef PG8_WAIT_V
#undef PG8_WAIT_L
#undef PG8_BAR
#undef PG8_SCHED
}

typedef f32x4 AccT[2][2][4][2];

struct EpiInProj {
    bf16_t* P; bf16_t* VT; const float* rope; bf16_t* BND;
    __device__ __forceinline__ void operator()(AccT& acc, const Unit& u, int wr, int wc, int fr, int fq) const {
        const int row0 = u.pm * BM + wr * 64 + fr, colb = u.pn * BM + wc * 32 + 8 * fq;
#pragma unroll
        for (int ai = 0; ai < 2; ++ai)
#pragma unroll
            for (int m = 0; m < 4; ++m) {
                const int row = row0 + ai * HALF + m * 16, t = row & (SEQ - 1);
                bf16_t* rowp = P + (size_t)row * LDP + COL_PA;
#pragma unroll
                for (int bj = 0; bj < 2; ++bj) {
                    const int c = colb + bj * HALF;
                    f32x4 v0 = acc[ai][bj][m][0], v1 = acc[ai][bj][m][1];
                    if (u.pn >= 15) {
                        const int cl = c - 3840;
                        if (cl < 640 || (cl >= 768 && cl < 1088)) {
                            const float* cs = rope + ((size_t)t * 32 + ((cl & 63) >> 1)) * 2;
                            const f32x4 r0 = *(const f32x4*)cs, r1 = *(const f32x4*)(cs + 4);
                            f32x4 o0, o1;
                            o0[0] = v0[0] * r0[0] - v0[1] * r0[1]; o0[1] = v0[1] * r0[0] + v0[0] * r0[1];
                            o0[2] = v0[2] * r0[2] - v0[3] * r0[3]; o0[3] = v0[3] * r0[2] + v0[2] * r0[3];
                            o1[0] = v1[0] * r1[0] - v1[1] * r1[1]; o1[1] = v1[1] * r1[0] + v1[0] * r1[1];
                            o1[2] = v1[2] * r1[2] - v1[3] * r1[3]; o1[3] = v1[3] * r1[2] + v1[2] * r1[3];
                            v0 = o0; v1 = o1;
                        }
                    }
                    u32x4 w; w.x = cvt_pk_bf16(v0[0], v0[1]); w.y = cvt_pk_bf16(v0[2], v0[3]); w.z = cvt_pk_bf16(v1[0], v1[1]); w.w = cvt_pk_bf16(v1[2], v1[3]);
                    *(u32x4*)(rowp + c) = w;
                    if (u.pn < 7 && fr == 15) *(u32x4*)(BND + (size_t)(row >> 4) * 1792 + c) = w;
                    if (u.pn == 17 && bj == 1) {
                        const int cv = c - 3840 - 640, b = row >> 11;
                        bf16_t* vt = VT + ((size_t)(b * 2 + (cv >> 6)) * 64 + (cv & 63)) * SEQ + t;
                        vt[0 * SEQ] = (bf16_t)(w.x & 0xffffu); vt[1 * SEQ] = (bf16_t)(w.x >> 16);
                        vt[2 * SEQ] = (bf16_t)(w.y & 0xffffu); vt[3 * SEQ] = (bf16_t)(w.y >> 16);
                        vt[4 * SEQ] = (bf16_t)(w.z & 0xffffu); vt[5 * SEQ] = (bf16_t)(w.z >> 16);
                        vt[6 * SEQ] = (bf16_t)(w.w & 0xffffu); vt[7 * SEQ] = (bf16_t)(w.w >> 16);
                    }
                }
            }
    }
};
struct EpiGate {
    bf16_t* P;
    __device__ __forceinline__ void operator()(AccT& acc, const Unit& u, int wr, int wc, int fr, int fq) const {
        const int row0 = u.pm * BM + wr * 64 + fr, colb = u.pn * BM + wc * 32 + 8 * fq;
#pragma unroll
        for (int ai = 0; ai < 2; ++ai)
#pragma unroll
            for (int m = 0; m < 4; ++m) {
                bf16_t* rowp = P + (size_t)(row0 + ai * HALF + m * 16) * LDP + COL_G + colb;
#pragma unroll
                for (int bj = 0; bj < 2; ++bj) {
                    const f32x4 v0 = acc[ai][bj][m][0], v1 = acc[ai][bj][m][1];
                    u32x4 w; w.x = cvt_pk_bf16(sigmoidf_(v0[0]), sigmoidf_(v0[1])); w.y = cvt_pk_bf16(sigmoidf_(v0[2]), sigmoidf_(v0[3]));
                    w.z = cvt_pk_bf16(sigmoidf_(v1[0]), sigmoidf_(v1[1])); w.w = cvt_pk_bf16(sigmoidf_(v1[2]), sigmoidf_(v1[3]));
                    *(u32x4*)(rowp + bj * HALF) = w;
                }
            }
    }
};
struct EpiMergeAcc {
    bf16_t* P; int first;
    __device__ __forceinline__ void operator()(AccT& acc, const Unit& u, int wr, int wc, int fr, int fq) const {
        const int row0 = u.pm * BM + wr * 64 + fr, colb = u.pn * BM + wc * 32 + 8 * fq;
#pragma unroll
        for (int ai = 0; ai < 2; ++ai)
#pragma unroll
            for (int m = 0; m < 4; ++m) {
                bf16_t* rowb = P + (size_t)(row0 + ai * HALF + m * 16) * LDP + colb;
#pragma unroll
                for (int bj = 0; bj < 2; ++bj) {
                    const f32x4 v0 = acc[ai][bj][m][0], v1 = acc[ai][bj][m][1];
                    unsigned long long* gp = (unsigned long long*)(rowb + COL_G + bj * HALF);
                    unsigned long long* mp = (unsigned long long*)(rowb + COL_MRG + bj * HALF);
                    const unsigned long long g0 = __hip_atomic_load(gp, __ATOMIC_RELAXED, __HIP_MEMORY_SCOPE_AGENT), g1 = __hip_atomic_load(gp + 1, __ATOMIC_RELAXED, __HIP_MEMORY_SCOPE_AGENT);
                    unsigned long long m0 = 0ull, m1 = 0ull;
                    if (!first) { m0 = __hip_atomic_load(mp, __ATOMIC_RELAXED, __HIP_MEMORY_SCOPE_AGENT); m1 = __hip_atomic_load(mp + 1, __ATOMIC_RELAXED, __HIP_MEMORY_SCOPE_AGENT); }
                    const unsigned ga = (unsigned)g0, gb = (unsigned)(g0 >> 32), gc = (unsigned)g1, gd = (unsigned)(g1 >> 32);
                    const unsigned ma = (unsigned)m0, mb = (unsigned)(m0 >> 32), mc = (unsigned)m1, md = (unsigned)(m1 >> 32);
                    u32x4 w;
                    w.x = cvt_pk_bf16(bflo(ma) + bflo(ga) * v0[0], bfhi(ma) + bfhi(ga) * v0[1]);
                    w.y = cvt_pk_bf16(bflo(mb) + bflo(gb) * v0[2], bfhi(mb) + bfhi(gb) * v0[3]);
                    w.z = cvt_pk_bf16(bflo(mc) + bflo(gc) * v1[0], bfhi(mc) + bfhi(gc) * v1[1]);
                    w.w = cvt_pk_bf16(bflo(md) + bflo(gd) * v1[2], bfhi(md) + bfhi(gd) * v1[3]);
                    *(u32x4*)(rowb + COL_MRG + bj * HALF) = w;
                }
            }
    }
};
struct EpiResid {
    const float* base; float* out;
    __device__ __forceinline__ void operator()(AccT& acc, const Unit& u, int wr, int wc, int fr, int fq) const {
        const int row0 = u.pm * BM + wr * 64 + fr, colb = u.pn * BM + wc * 32 + 8 * fq;
#pragma unroll
        for (int ai = 0; ai < 2; ++ai)
#pragma unroll
            for (int m = 0; m < 4; ++m) {
                const size_t off = (size_t)(row0 + ai * HALF + m * 16) * DM + colb;
#pragma unroll
                for (int bj = 0; bj < 2; ++bj) {
                    const f32x4 b0 = *(const f32x4*)(base + off + bj * HALF), b1 = *(const f32x4*)(base + off + bj * HALF + 4);
                    *(f32x4*)(out + off + bj * HALF) = b0 + acc[ai][bj][m][0];
                    *(f32x4*)(out + off + bj * HALF + 4) = b1 + acc[ai][bj][m][1];
                }
            }
    }
};
struct EpiUp {
    bf16_t* P; float* HALO; const float* cw; const float* cb;
    __device__ __forceinline__ void operator()(AccT& acc, const Unit& u, int wr, int wc, int fr_in, int fq_in) const {
        int fr = fr_in, fq = fq_in;
        asm volatile("" : "+v"(fr), "+v"(fq));
        const int row0 = u.pm * BM + wr * 64 + fr;
        const int jb = u.pn * 128 + wc * 32 + 8 * fq;
#pragma unroll
        for (int ai = 0; ai < 2; ++ai) {
            const int s = u.pm * 4 + ai * 2 + wr;
#pragma unroll
            for (int bj = 0; bj < 2; ++bj)
#pragma unroll
                for (int n = 0; n < 2; ++n) {
                    const int colp = u.pn * BM + bj * HALF + wc * 32 + 8 * fq + 4 * n;
                    if (fr < 2) *(f32x4*)(HALO + (size_t)(s * 4 + fr) * F2 + colp) = acc[ai][bj][0][n];
                    if (fr >= 14) *(f32x4*)(HALO + (size_t)(s * 4 + fr - 12) * F2 + colp) = acc[ai][bj][3][n];
                }
        }
#pragma unroll
        for (int ai = 0; ai < 2; ++ai)
#pragma unroll
            for (int m = 0; m < 4; ++m) {
                const int row = row0 + ai * HALF + m * 16;
#pragma unroll
                for (int n = 0; n < 2; ++n) {
                    f32x4 cv[2];
                    asm volatile("" ::: "memory");
#pragma unroll
                    for (int bj = 0; bj < 2; ++bj) {
                        const int co = bj * DFF + jb + 4 * n;
                        const f32x4 w0 = *(const f32x4*)(cw + co), w1 = *(const f32x4*)(cw + F2 + co), w2 = *(const f32x4*)(cw + 2 * F2 + co), bb = *(const f32x4*)(cb + co);
#pragma unroll
                        for (int e = 0; e < 4; ++e) {
                            const float cur = acc[ai][bj][m][n][e];
                            const float prv = m > 0 ? acc[ai][bj][m > 0 ? m - 1 : 0][n][e] : 0.f;
                            const float a1 = dpp_mov<0x121>(cur), a2 = dpp_mov<0x122>(cur), b1 = dpp_mov<0x121>(prv), b2 = dpp_mov<0x122>(prv);
                            const float p1 = fr >= 1 ? a1 : b1, p2 = fr >= 2 ? a2 : b2;
                            cv[bj][e] = bb[e] + w0[e] * p2 + w1[e] * p1 + w2[e] * cur;
                        }
                        __builtin_amdgcn_sched_barrier(0);
                    }
                    const f32x4 g0 = cv[0], v0 = cv[1];
                    u32x2 w;
                    w.x = cvt_pk_bf16(g0[0] * sigmoidf_(g0[0]) * v0[0], g0[1] * sigmoidf_(g0[1]) * v0[1]);
                    w.y = cvt_pk_bf16(g0[2] * sigmoidf_(g0[2]) * v0[2], g0[3] * sigmoidf_(g0[3]) * v0[3]);
                    if (!(m == 0 && fr < 2)) *(u32x2*)(P + (size_t)row * LDP + COL_ACT + jb + 4 * n) = w;
                    __builtin_amdgcn_sched_barrier(0);
                }
            }
    }
};
}

struct Ctx {
    const float* in[24]; float* out; unsigned char* ws;
    bf16_t* P; bf16_t* VT; float* HALO; float* ROPE;
    bf16_t *Win, *Wg, *Wbr, *Wo, *Wup, *Wdn;
    int tid, lane, wave, G, bid;
};

__device__ __forceinline__ int srccol(int mode, int n) {
    if (mode == 0) return n;
    if (mode == 2) return 4932 + n;
    if (mode == 3) { const int tile = n >> 8, w = n & 255, j = tile * 128 + (w & 127); return (w < 128) ? j : DFF + j; }
    if (n < 3840) return n;
    const int c = n - 3840;
    if (c >= 1092) return -1;
    if (c < 640 || (c >= 768 && c < 1088)) { const int base = c & ~63, i = c & 63; return 3840 + base + (i >> 1) + 32 * (i & 1); }
    return 3840 + c;
}
__device__ __forceinline__ void tr_item(const float* W, int ldw, int K, int N, bf16_t* WT, int mode, int item, LAS float* scr, int lane) {
    const int nblk = N / 32, kb = item / nblk, nb = item % nblk, k0 = 64 * kb, n0 = 32 * nb;
    const int sc = srccol(mode, n0 + (lane & 31));
#pragma unroll 8
    for (int i = 0; i < 32; ++i) { const int kk = 2 * i + (lane >> 5); scr[kk * 33 + (lane & 31)] = (sc >= 0) ? W[(size_t)(k0 + kk) * ldw + sc] : 0.f; }
    asm volatile("s_waitcnt lgkmcnt(0)" ::: "memory");
    const int c = lane & 7;
#pragma unroll
    for (int j = 0; j < 4; ++j) { const int n = (lane >> 3) + 8 * j; const LAS float* s = scr + (8 * c) * 33 + n;
        u32x4 o; o.x = pk2(s[0 * 33], s[1 * 33]); o.y = pk2(s[2 * 33], s[3 * 33]); o.z = pk2(s[4 * 33], s[5 * 33]); o.w = pk2(s[6 * 33], s[7 * 33]);
        *(u32x4*)(WT + (size_t)(n0 + n) * K + k0 + 8 * c) = o; }
    asm volatile("s_waitcnt lgkmcnt(0)" ::: "memory");
}
__device__ __forceinline__ void rms_row(const float* xrow, const float* g, bf16_t* obf, float* of32, int lane) {
    const f32x4* xr = (const f32x4*)xrow + lane; const f32x4* gr = (const f32x4*)g + lane;
    f32x4 v[4]; float s = 0.f;
#pragma unroll
    for (int j = 0; j < 4; ++j) { v[j] = xr[64 * j]; s += (v[j].x * v[j].x + v[j].y * v[j].y) + (v[j].z * v[j].z + v[j].w * v[j].w); }
    const float rs = 1.f / sqrtf(wave_sum(s) * (1.f / DM) + 1e-6f);
#pragma unroll
    for (int j = 0; j < 4; ++j) {
        const f32x4 gg = gr[64 * j]; const f32x4 o = v[j] * rs * gg;
        if (obf) { u32x2 w; w.x = pk2(o.x, o.y); w.y = pk2(o.z, o.w); *((u32x2*)obf + lane + 64 * j) = w; }
        else *((f32x4*)of32 + lane + 64 * j) = o;
    }
}
__device__ __forceinline__ void phase_prep(const Ctx& X, LAS unsigned char* lds, int layer) {
    LAS float* scr = (LAS float*)(lds + X.wave * 8448);
    const int gw = X.bid * 8 + X.wave, NGW = X.G * 8;
    constexpr int I_IN = 16 * 160, I_G = 16 * 96, I_BR = 8 * 32, I_O = 16 * 32, I_UP = 16 * 176, I_DN = 44 * 32;
    constexpr int NITEMS = I_IN + I_G + 3 * I_BR + I_O + I_UP + I_DN;
    const float* w_in = X.in[2] + (size_t)layer * DM * IN_COLS;
    const float* w_br = X.in[16] + (size_t)layer * 3 * 512 * DM;
    const float* w_o = X.in[17] + (size_t)layer * DM * DM;
    const float* w_up = X.in[19] + (size_t)layer * DM * F2;
    const float* w_dn = X.in[22] + (size_t)layer * DFF * DM;
    for (int it = gw; it < NITEMS; it += NGW) {
        int r = it;
        if (r < I_IN) { tr_item(w_in, IN_COLS, DM, 5120, X.Win, 1, r, scr, X.lane); continue; } r -= I_IN;
        if (r < I_G) { tr_item(w_in, IN_COLS, DM, 3072, X.Wg, 2, r, scr, X.lane); continue; } r -= I_G;
        if (r < 3 * I_BR) { const int b = r / I_BR; tr_item(w_br + (size_t)b * 512 * DM, DM, 512, DM, X.Wbr + (size_t)b * DM * 512, 0, r % I_BR, scr, X.lane); continue; } r -= 3 * I_BR;
        if (r < I_O) { tr_item(w_o, DM, DM, DM, X.Wo, 0, r, scr, X.lane); continue; } r -= I_O;
        if (r < I_UP) { tr_item(w_up, F2, DM, F2, X.Wup, 3, r, scr, X.lane); continue; } r -= I_UP;
        tr_item(w_dn, DM, DFF, DM, X.Wdn, 0, r, scr, X.lane);
    }
    const float* h = (layer == 0) ? X.in[0] : X.out;
    const float* g = X.in[1] + (size_t)layer * DM;
    for (int m = gw; m < T_TOK; m += NGW) rms_row(h + (size_t)m * DM, g, X.P + (size_t)m * LDP, nullptr, X.lane);
    if (layer == 0) {
        for (int idx = X.bid * 512 + X.tid; idx < SEQ * 32; idx += X.G * 512) {
            const int t = idx >> 5, p = idx & 31;
            const float inv = exp2f(-(float)p * 0.03125f * 13.287712379549449f);
            const float ang = (float)t * inv;
            const double rev = (double)ang * 0.15915494309189535;
            const float fr = (float)(rev - floor(rev));
            X.ROPE[2 * idx] = __builtin_amdgcn_cosf(fr); X.ROPE[2 * idx + 1] = __builtin_amdgcn_sinf(fr);
        }
    }
}

__device__ __forceinline__ float wave_sum_fast(float x) {
    x = red16(x);
    const float r0 = __builtin_bit_cast(float, __builtin_amdgcn_readlane(__builtin_bit_cast(int, x), 0)), r1 = __builtin_bit_cast(float, __builtin_amdgcn_readlane(__builtin_bit_cast(int, x), 16));
    const float r2 = __builtin_bit_cast(float, __builtin_amdgcn_readlane(__builtin_bit_cast(int, x), 32)), r3 = __builtin_bit_cast(float, __builtin_amdgcn_readlane(__builtin_bit_cast(int, x), 48));
    return (r0 + r1) + (r2 + r3);
}
#define LDS_BAR() do { asm volatile("s_waitcnt lgkmcnt(0)" ::: "memory"); __builtin_amdgcn_s_barrier(); asm volatile("" ::: "memory"); } while (0)
constexpr int RW_TS = 16, RW_NCH = SEQ / RW_TS, RW_BUF = 33280;
__device__ __forceinline__ void phase_rwkv_pre(const Ctx& X, LAS unsigned char* lds, int layer) {
    LAS float* Rr = (LAS float*)(lds);           LAS float* Kk = (LAS float*)(lds + 4096);   LAS float* Vv = (LAS float*)(lds + 8192);
    LAS float* W1 = (LAS float*)(lds + 12288);   LAS float* AS = (LAS float*)(lds + 16384);
    LAS bf16_t* WDb = (LAS bf16_t*)(lds + 20480);
    LAS bf16_t* ADb = (LAS bf16_t*)(lds + 22784);
    LAS bf16_t* WTu = (LAS bf16_t*)(lds + 25088);
    LAS bf16_t* WTa = (LAS bf16_t*)(lds + 34304);
    LAS float* MU = (LAS float*)(lds + 43520);
    const int tid = X.tid, lane = tid & 63, wv = X.wave;
    const float* mu = X.in[3] + layer * 1792;
    const float* w0 = X.in[4] + layer * 512;   const float* w_up = X.in[5] + (size_t)layer * 64 * 512;
    const float* a0 = X.in[6] + layer * 512;   const float* a_up = X.in[7] + (size_t)layer * 64 * 512;
    const float* k_k = X.in[9] + layer * 512;  const float* k_a = X.in[10] + layer * 512;  const float* r_k = X.in[11] + layer * 512;
    const bf16_t* BND = (const bf16_t*)(X.ws + WS_BND);
    float* SCAL = (float*)(X.ws + WS_SCAL);
    const int ln = lane & 15, lg = lane >> 4;
    int last_h = -1;
    float p_kk = 0.f, p_ka = 0.f, p_rk = 0.f, q_w0 = 0.f, q_a0 = 0.f;
    const int c = tid & 63, tg = tid >> 6;
#pragma unroll 1
    for (int u = X.bid; u < 8192; u += X.G) {
        const int h = u & 7, tile = u >> 3, hc = h * 64 + c;
        if (h != last_h) {
            __syncthreads();
            for (int idx = tid; idx < 64 * 64; idx += 512) { const int m = idx >> 6, cc = idx & 63;
                WTu[cc * 72 + m] = (bf16_t)f2bf(w_up[m * 512 + h * 64 + cc]); WTa[cc * 72 + m] = (bf16_t)f2bf(a_up[m * 512 + h * 64 + cc]); }
            if (tid < 320) { const int cc = tid; const int col = cc < 64 ? h * 64 + cc : (cc < 128 ? 512 + h * 64 + cc - 64 : (cc < 192 ? 1024 + h * 64 + cc - 128 : 1536 + cc - 192)); MU[cc] = mu[col]; }
            p_kk = k_k[hc]; p_ka = k_a[hc]; p_rk = r_k[hc];
            q_w0 = w0[h * 64 + 16 * (wv & 3) + ln]; q_a0 = a0[h * 64 + 16 * (wv & 3) + ln];
            last_h = h;
            __syncthreads();
        }
#pragma unroll
        for (int it = 0; it < 2; ++it) {
            const int idx = tid + 512 * it;
            if (idx < 16 * 40) {
                const int tt = idx / 40, vv = idx - tt * 40, cc0 = 8 * vv;
                const int col = vv < 8 ? h * 64 + 8 * vv : (vv < 16 ? 512 + h * 64 + 8 * (vv - 8) : (vv < 24 ? 1024 + h * 64 + 8 * (vv - 16) : 1536 + 8 * (vv - 24)));
                const size_t row = (size_t)tile * 16 + tt;
                const u32x4 c4 = *(const u32x4*)(X.P + row * LDP + COL_PA + col);
                u32x4 p4 = (u32x4){0u, 0u, 0u, 0u};
                if (tt > 0) p4 = *(const u32x4*)(X.P + (row - 1) * LDP + COL_PA + col);
                else if ((tile & 127) != 0) p4 = *(const u32x4*)(BND + (size_t)(tile - 1) * 1792 + col);
                const f32x4 m0 = *(const LAS f32x4*)&MU[cc0], m1 = *(const LAS f32x4*)&MU[cc0 + 4];
                float cur[8], prv[8], val[8];
                cur[0] = bflo(c4.x); cur[1] = bfhi(c4.x); cur[2] = bflo(c4.y); cur[3] = bfhi(c4.y); cur[4] = bflo(c4.z); cur[5] = bfhi(c4.z); cur[6] = bflo(c4.w); cur[7] = bfhi(c4.w);
                prv[0] = bflo(p4.x); prv[1] = bfhi(p4.x); prv[2] = bflo(p4.y); prv[3] = bfhi(p4.y); prv[4] = bflo(p4.z); prv[5] = bfhi(p4.z); prv[6] = bflo(p4.w); prv[7] = bfhi(p4.w);
#pragma unroll
                for (int e = 0; e < 8; ++e) val[e] = cur[e] + (prv[e] - cur[e]) * (e < 4 ? m0[e & 3] : m1[e & 3]);
                if (vv < 24) {
#pragma unroll
                    for (int e = 0; e < 8; ++e) val[e] = bf2f((bf16_t)f2bf(val[e]));
                    LAS float* dst = (vv < 8 ? Rr : (vv < 16 ? Kk : Vv)) + tt * 64 + 8 * (vv & 7);
                    *(LAS f32x4*)dst = (f32x4){val[0], val[1], val[2], val[3]}; *(LAS f32x4*)(dst + 4) = (f32x4){val[4], val[5], val[6], val[7]};
                } else {
                    const int lr0 = 8 * (vv - 24);
                    LAS bf16_t* dst;
                    if (lr0 < 64) { dst = WDb + tt * 72 + lr0;
#pragma unroll
                        for (int e = 0; e < 8; ++e) { const float ex = __expf(2.f * val[e]); val[e] = 1.f - 2.f / (ex + 1.f); } }
                    else dst = ADb + tt * 72 + lr0 - 64;
                    u32x4 o; o.x = pk2(val[0], val[1]); o.y = pk2(val[2], val[3]); o.z = pk2(val[4], val[5]); o.w = pk2(val[6], val[7]);
                    *(LAS u32x4*)dst = o;
                }
            }
        }
        __syncthreads();
        if (wv < 4) {
            const int nt = wv, chm = 16 * nt + ln;
            f32x4 cw_ = (f32x4){0.f, 0.f, 0.f, 0.f}, ca_ = cw_;
#pragma unroll
            for (int ks = 0; ks < 2; ++ks) {
                const bf16x8 xa = *(const LAS bf16x8*)&WDb[ln * 72 + ks * 32 + 8 * lg], xb = *(const LAS bf16x8*)&WTu[(16 * nt + ln) * 72 + ks * 32 + 8 * lg];
                cw_ = __builtin_amdgcn_mfma_f32_16x16x32_bf16(xa, xb, cw_, 0, 0, 0);
                const bf16x8 ya = *(const LAS bf16x8*)&ADb[ln * 72 + ks * 32 + 8 * lg], yb = *(const LAS bf16x8*)&WTa[(16 * nt + ln) * 72 + ks * 32 + 8 * lg];
                ca_ = __builtin_amdgcn_mfma_f32_16x16x32_bf16(ya, yb, ca_, 0, 0, 0);
            }
#pragma unroll
            for (int r = 0; r < 4; ++r) {
                const int tt = 4 * lg + r;
                const float z = -(q_w0 + cw_[r]);
                const float sp = fmaxf(z, 0.f) + __logf(1.f + __expf(-fabsf(z)));
                const float e = __expf(-sp - 0.5f);
                W1[tt * 64 + chm] = bf2f((bf16_t)f2bf(-expm1f(-e)));
                AS[tt * 64 + chm] = bf2f((bf16_t)f2bf(sigmoidf_(q_a0 + ca_[r])));
            }
        }
        __syncthreads();
#pragma unroll
        for (int q = 0; q < 2; ++q) {
            const int tt = 2 * tg + q;
            const size_t row = (size_t)tile * 16 + tt;
            const float w1 = W1[tt * 64 + c], a = AS[tt * 64 + c];
            const float kraw = Kk[tt * 64 + c], r = Rr[tt * 64 + c], v = Vv[tt * 64 + c];
            const float kk0 = kraw * p_kk;
            const float inv = 1.f / sqrtf(fmaxf(wave_sum_fast(kk0 * kk0), 1e-24f));
            const float kk = kk0 * inv;
            const float kmod = kraw * (1.f + (a - 1.f) * p_ka);
            const float bvec = kk * a;
            const float br = wave_sum_fast(bvec * r), kr = wave_sum_fast(kmod * r), bonus = wave_sum_fast(r * kmod * p_rk);
            bf16_t* rp_ = X.P + row * LDP;
            rp_[COL_PA + hc] = (bf16_t)f2bf(r); rp_[COL_PA + 512 + hc] = (bf16_t)f2bf(kraw); rp_[COL_PA + 1024 + hc] = (bf16_t)f2bf(v);
            rp_[hc] = (bf16_t)f2bf(w1); rp_[512 + hc] = (bf16_t)f2bf(a);
            if (c == 0) *(f32x4*)(SCAL + (row * 8 + h) * 4) = (f32x4){inv, br, kr, bonus};
        }
        __syncthreads();
    }
}

__device__ __forceinline__ void rwkv_task(const Ctx& X, LAS unsigned char* lds, int layer, int b, int h) {
    LAS bf16_t* GDb = (LAS bf16_t*)(lds + 66560);
    LAS bf16_t* WTg = (LAS bf16_t*)(lds + 70912);
    const int tid = X.tid, lane = tid & 63;
    const bool helper = X.wave >= 4;
    const int ht = tid & 255;
    const float* mu = X.in[3] + layer * 1792;
    const float* g_up = X.in[8] + (size_t)layer * 128 * 512;
    const float* k_k = X.in[9] + layer * 512;  const float* k_a = X.in[10] + layer * 512;
    const float* gn_g = X.in[12] + layer * 512; const float* gn_b = X.in[13] + layer * 512;
    const float* SCAL = (const float*)(X.ws + WS_SCAL);
    const int tt_h = ht >> 4, cg4 = (ht & 15) * 4;
    const f32x4 p_kk = *(const f32x4*)(k_k + h * 64 + cg4), p_ka = *(const f32x4*)(k_a + h * 64 + cg4);
    const f32x4 p_gg = *(const f32x4*)(gn_g + h * 64 + cg4), p_gb = *(const f32x4*)(gn_b + h * 64 + cg4);
    const int gv8 = (ht & 15) * 8;
    const f32x4 mg0 = *(const f32x4*)(mu + 1664 + gv8), mg1 = *(const f32x4*)(mu + 1664 + gv8 + 4);
    const int nt = (ht >> 6), ln = lane & 15, lg = lane >> 4, chm = 16 * nt + ln;
    const int rp = ht >> 3, jg = ht & 7, i0 = 2 * rp;
    for (int idx = tid; idx < 128 * 64; idx += 512) { const int m = idx >> 6, cc = idx & 63; WTg[cc * 136 + m] = (bf16_t)f2bf(g_up[m * 512 + h * 64 + cc]); }
    f32x2 S0[4], S1[4];
#pragma unroll
    for (int j = 0; j < 4; ++j) { S0[j] = (f32x2){0.f, 0.f}; S1[j] = (f32x2){0.f, 0.f}; }
#if PROBE_SCAN2
    f32x2 T0[4], T1[4];
#pragma unroll
    for (int j = 0; j < 4; ++j) { T0[j] = (f32x2){0.f, 0.f}; T1[j] = (f32x2){0.f, 0.f}; }
#endif
    __syncthreads();

#define RW_ARR(bufi, k) ((LAS float*)(lds + (bufi) * RW_BUF + (k) * 4096))
#define RW_SC(bufi) ((LAS float*)(lds + (bufi) * RW_BUF + 32768))
#define RW_LOAD(chk, L) do { const size_t row_ = (size_t)b * SEQ + (chk) * RW_TS + tt_h; const bf16_t* rp_ = X.P + row_ * LDP; \
        l_r##L = *(const u32x2*)(rp_ + COL_PA + h * 64 + cg4); l_k##L = *(const u32x2*)(rp_ + COL_PA + 512 + h * 64 + cg4); l_v##L = *(const u32x2*)(rp_ + COL_PA + 1024 + h * 64 + cg4); \
        l_w##L = *(const u32x2*)(rp_ + h * 64 + cg4); l_a##L = *(const u32x2*)(rp_ + 512 + h * 64 + cg4); l_s##L = *(const f32x4*)(SCAL + (row_ * 8 + h) * 4); \
        l_gc##L = *(const u32x4*)(rp_ + COL_PA + 1664 + gv8); l_gp##L = (u32x4){0u, 0u, 0u, 0u}; if ((chk) * RW_TS + tt_h > 0) l_gp##L = *(const u32x4*)(rp_ - LDP + COL_PA + 1664 + gv8); } while (0)
    u32x2 l_rA, l_kA, l_vA, l_wA, l_aA; f32x4 l_sA; u32x4 l_gcA, l_gpA;
    u32x2 l_rB, l_kB, l_vB, l_wB, l_aB; f32x4 l_sB; u32x4 l_gcB, l_gpB;
    l_rA = l_kA = l_vA = l_wA = l_aA = l_rB = l_kB = l_vB = l_wB = l_aB = (u32x2){0u, 0u}; l_sA = l_sB = (f32x4){0.f, 0.f, 0.f, 0.f}; l_gcA = l_gpA = l_gcB = l_gpB = (u32x4){0u, 0u, 0u, 0u};
    if (helper) { RW_LOAD(0, A); RW_LOAD(1, B); }

#pragma unroll 1
    for (int i0_ = -1; i0_ < RW_NCH; i0_ += 2) {
        { const int i = i0_;

        const int bufn = (i + 1) & 1, bufc = i & 1;
        if (helper) {
            const bool do_prep = (i + 1 < RW_NCH);
            if (i >= 1) {
                LAS float* Yy = RW_ARR(bufn, 7); LAS float* Gg = RW_ARR(bufn, 6); LAS float* Vv = RW_ARR(bufn, 5); LAS float* SC = RW_SC(bufn);
                const f32x4 y = *(const LAS f32x4*)&Yy[tt_h * 64 + cg4], gg = *(const LAS f32x4*)&Gg[tt_h * 64 + cg4], vv = *(const LAS f32x4*)&Vv[tt_h * 64 + cg4];
                const float bonus = SC[tt_h * 4 + 2];
                const float mean = red16((y.x + y.y) + (y.z + y.w)) * (1.f / 64.f);
                const f32x4 d = y - mean;
                const float var = red16((d.x * d.x + d.y * d.y) + (d.z * d.z + d.w * d.w)) * (1.f / 64.f);
                const float rs = 1.f / sqrtf(var + 64e-5f);
                const f32x4 o = (d * rs * p_gg + p_gb + vv * bonus) * gg;
                u32x2 w; w.x = pk2(o.x, o.y); w.y = pk2(o.z, o.w);
                *(u32x2*)(X.P + ((size_t)b * SEQ + (i - 1) * RW_TS + tt_h) * LDP + COL_YA + h * 64 + cg4) = w;
            }
            LDS_BAR();
            if (do_prep) {
                const f32x4 r = (f32x4){bflo(l_rA.x), bfhi(l_rA.x), bflo(l_rA.y), bfhi(l_rA.y)}, k = (f32x4){bflo(l_kA.x), bfhi(l_kA.x), bflo(l_kA.y), bfhi(l_kA.y)};
                const f32x4 v = (f32x4){bflo(l_vA.x), bfhi(l_vA.x), bflo(l_vA.y), bfhi(l_vA.y)}, w1 = (f32x4){bflo(l_wA.x), bfhi(l_wA.x), bflo(l_wA.y), bfhi(l_wA.y)};
                const f32x4 a = (f32x4){bflo(l_aA.x), bfhi(l_aA.x), bflo(l_aA.y), bfhi(l_aA.y)};
                const f32x4 kk = k * p_kk * l_sA.x;
                const f32x4 decay = 1.f - w1;
                *(LAS f32x4*)&RW_ARR(bufn, 0)[tt_h * 64 + cg4] = -kk;
                *(LAS f32x4*)&RW_ARR(bufn, 1)[tt_h * 64 + cg4] = decay * r;
                *(LAS f32x4*)&RW_ARR(bufn, 2)[tt_h * 64 + cg4] = decay;
                *(LAS f32x4*)&RW_ARR(bufn, 3)[tt_h * 64 + cg4] = kk * a;
                *(LAS f32x4*)&RW_ARR(bufn, 4)[tt_h * 64 + cg4] = k * (1.f + (a - 1.f) * p_ka);
                *(LAS f32x4*)&RW_ARR(bufn, 5)[tt_h * 64 + cg4] = v;
                if (cg4 == 0) { LAS float* SC = RW_SC(bufn); SC[tt_h * 4 + 0] = l_sA.y; SC[tt_h * 4 + 1] = l_sA.z; SC[tt_h * 4 + 2] = l_sA.w; }
                float gc[8], gp[8];
                gc[0] = bflo(l_gcA.x); gc[1] = bfhi(l_gcA.x); gc[2] = bflo(l_gcA.y); gc[3] = bfhi(l_gcA.y); gc[4] = bflo(l_gcA.z); gc[5] = bfhi(l_gcA.z); gc[6] = bflo(l_gcA.w); gc[7] = bfhi(l_gcA.w);
                gp[0] = bflo(l_gpA.x); gp[1] = bfhi(l_gpA.x); gp[2] = bflo(l_gpA.y); gp[3] = bfhi(l_gpA.y); gp[4] = bflo(l_gpA.z); gp[5] = bfhi(l_gpA.z); gp[6] = bflo(l_gpA.w); gp[7] = bfhi(l_gpA.w);
#pragma unroll
                for (int e = 0; e < 8; ++e) gc[e] = sigmoidf_(gc[e] + (gp[e] - gc[e]) * (e < 4 ? mg0[e & 3] : mg1[e & 3]));
                u32x4 o; o.x = pk2(gc[0], gc[1]); o.y = pk2(gc[2], gc[3]); o.z = pk2(gc[4], gc[5]); o.w = pk2(gc[6], gc[7]);
                *(LAS u32x4*)&GDb[tt_h * 136 + gv8] = o;
            }
            if (i + 3 < RW_NCH) RW_LOAD(i + 3, A);
            LDS_BAR();
            if (do_prep) {
                LAS float* Gg = RW_ARR(bufn, 6);
                f32x4 cg_ = (f32x4){0.f, 0.f, 0.f, 0.f};
#pragma unroll
                for (int ks = 0; ks < 4; ++ks) {
                    const bf16x8 za = *(const LAS bf16x8*)&GDb[ln * 136 + ks * 32 + 8 * lg], zb = *(const LAS bf16x8*)&WTg[(16 * nt + ln) * 136 + ks * 32 + 8 * lg];
                    cg_ = __builtin_amdgcn_mfma_f32_16x16x32_bf16(za, zb, cg_, 0, 0, 0);
                }
#pragma unroll
                for (int r = 0; r < 4; ++r) Gg[(4 * lg + r) * 64 + chm] = cg_[r];
            }
            LDS_BAR();
            LDS_BAR();
        } else {
            LAS float* A_ = RW_ARR(bufc, 0); LAS float* WR = RW_ARR(bufc, 1); LAS float* Wd = RW_ARR(bufc, 2); LAS float* Bv = RW_ARR(bufc, 3);
            LAS float* Kk = RW_ARR(bufc, 4); LAS float* Vv = RW_ARR(bufc, 5); LAS float* Yy = RW_ARR(bufc, 7); LAS float* SC = RW_SC(bufc);
#pragma unroll 1
            for (int q4 = 0; q4 < 4; ++q4) {
                if (i >= 0) {
                    f32x2 yk[4];
#pragma unroll
                    for (int s4 = 0; s4 < 4; ++s4) {
                        const int tt = 4 * q4 + s4;
                        const f32x4 a_lo = *(const LAS f32x4*)&A_[tt * 64 + 8 * jg], a_hi = *(const LAS f32x4*)&A_[tt * 64 + 8 * jg + 4];
                        const f32x4 r_lo = *(const LAS f32x4*)&WR[tt * 64 + 8 * jg], r_hi = *(const LAS f32x4*)&WR[tt * 64 + 8 * jg + 4];
                        const f32x4 w_lo = *(const LAS f32x4*)&Wd[tt * 64 + 8 * jg], w_hi = *(const LAS f32x4*)&Wd[tt * 64 + 8 * jg + 4];
                        const f32x4 b_lo = *(const LAS f32x4*)&Bv[tt * 64 + 8 * jg], b_hi = *(const LAS f32x4*)&Bv[tt * 64 + 8 * jg + 4];
                        const f32x4 k_lo = *(const LAS f32x4*)&Kk[tt * 64 + 8 * jg], k_hi = *(const LAS f32x4*)&Kk[tt * 64 + 8 * jg + 4];
                        const f32x2 vv = *(const LAS f32x2*)&Vv[tt * 64 + i0];
                        const f32x2 sc = *(const LAS f32x2*)&SC[tt * 4];
                        const f32x2 av[4] = {{a_lo.x, a_lo.y}, {a_lo.z, a_lo.w}, {a_hi.x, a_hi.y}, {a_hi.z, a_hi.w}};
                        const f32x2 rv[4] = {{r_lo.x, r_lo.y}, {r_lo.z, r_lo.w}, {r_hi.x, r_hi.y}, {r_hi.z, r_hi.w}};
                        const f32x2 wv[4] = {{w_lo.x, w_lo.y}, {w_lo.z, w_lo.w}, {w_hi.x, w_hi.y}, {w_hi.z, w_hi.w}};
                        const f32x2 bv[4] = {{b_lo.x, b_lo.y}, {b_lo.z, b_lo.w}, {b_hi.x, b_hi.y}, {b_hi.z, b_hi.w}};
                        const f32x2 kv[4] = {{k_lo.x, k_lo.y}, {k_lo.z, k_lo.w}, {k_hi.x, k_hi.y}, {k_hi.z, k_hi.w}};
                        f32x2 e10 = S0[0] * av[0], e20 = S0[0] * rv[0], e11 = S1[0] * av[0], e21 = S1[0] * rv[0];
#pragma unroll
                        for (int j = 1; j < 4; ++j) { e10 += S0[j] * av[j]; e20 += S0[j] * rv[j]; e11 += S1[j] * av[j]; e21 += S1[j] * rv[j]; }
                        const float d10 = red8(e10.x + e10.y), d20 = red8(e20.x + e20.y), d11 = red8(e11.x + e11.y), d21 = red8(e21.x + e21.y);
                        yk[s4] = (f32x2){d20 + d10 * sc.x + vv.x * sc.y, d21 + d11 * sc.x + vv.y * sc.y};
                        const f32x2 d10v = (f32x2){d10, d10}, d11v = (f32x2){d11, d11}, v0v = (f32x2){vv.x, vv.x}, v1v = (f32x2){vv.y, vv.y};
#pragma unroll
                        for (int j = 0; j < 4; ++j) { S0[j] = S0[j] * wv[j] + (d10v * bv[j] + v0v * kv[j]); S1[j] = S1[j] * wv[j] + (d11v * bv[j] + v1v * kv[j]); }
                    }
                    if (jg == 0) {
#pragma unroll
                        for (int s4 = 0; s4 < 4; ++s4) *(LAS f32x2*)&Yy[(4 * q4 + s4) * 64 + i0] = yk[s4];
                    }

#if PROBE_SCAN2
                    {
#pragma unroll
                    for (int s4 = 0; s4 < 4; ++s4) {
                        const int tt = 4 * q4 + s4;
                        const f32x4 a_lo = *(const LAS f32x4*)&A_[tt * 64 + 8 * jg], a_hi = *(const LAS f32x4*)&A_[tt * 64 + 8 * jg + 4];
                        const f32x4 r_lo = *(const LAS f32x4*)&WR[tt * 64 + 8 * jg], r_hi = *(const LAS f32x4*)&WR[tt * 64 + 8 * jg + 4];
                        const f32x4 w_lo = *(const LAS f32x4*)&Wd[tt * 64 + 8 * jg], w_hi = *(const LAS f32x4*)&Wd[tt * 64 + 8 * jg + 4];
                        const f32x4 b_lo = *(const LAS f32x4*)&Bv[tt * 64 + 8 * jg], b_hi = *(const LAS f32x4*)&Bv[tt * 64 + 8 * jg + 4];
                        const f32x4 k_lo = *(const LAS f32x4*)&Kk[tt * 64 + 8 * jg], k_hi = *(const LAS f32x4*)&Kk[tt * 64 + 8 * jg + 4];
                        const f32x2 vv = *(const LAS f32x2*)&Vv[tt * 64 + i0];
                        const f32x2 av[4] = {{a_lo.x, a_lo.y}, {a_lo.z, a_lo.w}, {a_hi.x, a_hi.y}, {a_hi.z, a_hi.w}};
                        const f32x2 rv[4] = {{r_lo.x, r_lo.y}, {r_lo.z, r_lo.w}, {r_hi.x, r_hi.y}, {r_hi.z, r_hi.w}};
                        const f32x2 wv[4] = {{w_lo.x, w_lo.y}, {w_lo.z, w_lo.w}, {w_hi.x, w_hi.y}, {w_hi.z, w_hi.w}};
                        const f32x2 bv[4] = {{b_lo.x, b_lo.y}, {b_lo.z, b_lo.w}, {b_hi.x, b_hi.y}, {b_hi.z, b_hi.w}};
                        const f32x2 kv[4] = {{k_lo.x, k_lo.y}, {k_lo.z, k_lo.w}, {k_hi.x, k_hi.y}, {k_hi.z, k_hi.w}};
                        f32x2 e10 = T0[0] * av[0], e20 = T0[0] * rv[0], e11 = T1[0] * av[0], e21 = T1[0] * rv[0];
#pragma unroll
                        for (int j = 1; j < 4; ++j) { e10 += T0[j] * av[j]; e20 += T0[j] * rv[j]; e11 += T1[j] * av[j]; e21 += T1[j] * rv[j]; }
                        const float d10 = red8(e10.x + e10.y), d20 = red8(e20.x + e20.y), d11 = red8(e11.x + e11.y), d21 = red8(e21.x + e21.y);
                        const f32x2 d10v = (f32x2){d10 + d20, d10}, d11v = (f32x2){d11 + d21, d11}, v0v = (f32x2){vv.x, vv.x}, v1v = (f32x2){vv.y, vv.y};
#pragma unroll
                        for (int j = 0; j < 4; ++j) { T0[j] = T0[j] * wv[j] + (d10v * bv[j] + v0v * kv[j]); T1[j] = T1[j] * wv[j] + (d11v * bv[j] + v1v * kv[j]); }
                    }
                    }
#endif
                }
                LDS_BAR();
            }
        }
            }
        if (i0_ + 1 < RW_NCH) { const int i = i0_ + 1;

        const int bufn = (i + 1) & 1, bufc = i & 1;
        if (helper) {
            const bool do_prep = (i + 1 < RW_NCH);
            if (i >= 1) {
                LAS float* Yy = RW_ARR(bufn, 7); LAS float* Gg = RW_ARR(bufn, 6); LAS float* Vv = RW_ARR(bufn, 5); LAS float* SC = RW_SC(bufn);
                const f32x4 y = *(const LAS f32x4*)&Yy[tt_h * 64 + cg4], gg = *(const LAS f32x4*)&Gg[tt_h * 64 + cg4], vv = *(const LAS f32x4*)&Vv[tt_h * 64 + cg4];
                const float bonus = SC[tt_h * 4 + 2];
                const float mean = red16((y.x + y.y) + (y.z + y.w)) * (1.f / 64.f);
                const f32x4 d = y - mean;
                const float var = red16((d.x * d.x + d.y * d.y) + (d.z * d.z + d.w * d.w)) * (1.f / 64.f);
                const float rs = 1.f / sqrtf(var + 64e-5f);
                const f32x4 o = (d * rs * p_gg + p_gb + vv * bonus) * gg;
                u32x2 w; w.x = pk2(o.x, o.y); w.y = pk2(o.z, o.w);
                *(u32x2*)(X.P + ((size_t)b * SEQ + (i - 1) * RW_TS + tt_h) * LDP + COL_YA + h * 64 + cg4) = w;
            }
            LDS_BAR();
            if (do_prep) {
                const f32x4 r = (f32x4){bflo(l_rB.x), bfhi(l_rB.x), bflo(l_rB.y), bfhi(l_rB.y)}, k = (f32x4){bflo(l_kB.x), bfhi(l_kB.x), bflo(l_kB.y), bfhi(l_kB.y)};
                const f32x4 v = (f32x4){bflo(l_vB.x), bfhi(l_vB.x), bflo(l_vB.y), bfhi(l_vB.y)}, w1 = (f32x4){bflo(l_wB.x), bfhi(l_wB.x), bflo(l_wB.y), bfhi(l_wB.y)};
                const f32x4 a = (f32x4){bflo(l_aB.x), bfhi(l_aB.x), bflo(l_aB.y), bfhi(l_aB.y)};
                const f32x4 kk = k * p_kk * l_sB.x;
                const f32x4 decay = 1.f - w1;
                *(LAS f32x4*)&RW_ARR(bufn, 0)[tt_h * 64 + cg4] = -kk;
                *(LAS f32x4*)&RW_ARR(bufn, 1)[tt_h * 64 + cg4] = decay * r;
                *(LAS f32x4*)&RW_ARR(bufn, 2)[tt_h * 64 + cg4] = decay;
                *(LAS f32x4*)&RW_ARR(bufn, 3)[tt_h * 64 + cg4] = kk * a;
                *(LAS f32x4*)&RW_ARR(bufn, 4)[tt_h * 64 + cg4] = k * (1.f + (a - 1.f) * p_ka);
                *(LAS f32x4*)&RW_ARR(bufn, 5)[tt_h * 64 + cg4] = v;
                if (cg4 == 0) { LAS float* SC = RW_SC(bufn); SC[tt_h * 4 + 0] = l_sB.y; SC[tt_h * 4 + 1] = l_sB.z; SC[tt_h * 4 + 2] = l_sB.w; }
                float gc[8], gp[8];
                gc[0] = bflo(l_gcB.x); gc[1] = bfhi(l_gcB.x); gc[2] = bflo(l_gcB.y); gc[3] = bfhi(l_gcB.y); gc[4] = bflo(l_gcB.z); gc[5] = bfhi(l_gcB.z); gc[6] = bflo(l_gcB.w); gc[7] = bfhi(l_gcB.w);
                gp[0] = bflo(l_gpB.x); gp[1] = bfhi(l_gpB.x); gp[2] = bflo(l_gpB.y); gp[3] = bfhi(l_gpB.y); gp[4] = bflo(l_gpB.z); gp[5] = bfhi(l_gpB.z); gp[6] = bflo(l_gpB.w); gp[7] = bfhi(l_gpB.w);
#pragma unroll
                for (int e = 0; e < 8; ++e) gc[e] = sigmoidf_(gc[e] + (gp[e] - gc[e]) * (e < 4 ? mg0[e & 3] : mg1[e & 3]));
                u32x4 o; o.x = pk2(gc[0], gc[1]); o.y = pk2(gc[2], gc[3]); o.z = pk2(gc[4], gc[5]); o.w = pk2(gc[6], gc[7]);
                *(LAS u32x4*)&GDb[tt_h * 136 + gv8] = o;
            }
            if (i + 3 < RW_NCH) RW_LOAD(i + 3, B);
            LDS_BAR();
            if (do_prep) {
                LAS float* Gg = RW_ARR(bufn, 6);
                f32x4 cg_ = (f32x4){0.f, 0.f, 0.f, 0.f};
#pragma unroll
                for (int ks = 0; ks < 4; ++ks) {
                    const bf16x8 za = *(const LAS bf16x8*)&GDb[ln * 136 + ks * 32 + 8 * lg], zb = *(const LAS bf16x8*)&WTg[(16 * nt + ln) * 136 + ks * 32 + 8 * lg];
                    cg_ = __builtin_amdgcn_mfma_f32_16x16x32_bf16(za, zb, cg_, 0, 0, 0);
                }
#pragma unroll
                for (int r = 0; r < 4; ++r) Gg[(4 * lg + r) * 64 + chm] = cg_[r];
            }
            LDS_BAR();
            LDS_BAR();
        } else {
            LAS float* A_ = RW_ARR(bufc, 0); LAS float* WR = RW_ARR(bufc, 1); LAS float* Wd = RW_ARR(bufc, 2); LAS float* Bv = RW_ARR(bufc, 3);
            LAS float* Kk = RW_ARR(bufc, 4); LAS float* Vv = RW_ARR(bufc, 5); LAS float* Yy = RW_ARR(bufc, 7); LAS float* SC = RW_SC(bufc);
#pragma unroll 1
            for (int q4 = 0; q4 < 4; ++q4) {
                if (i >= 0) {
                    f32x2 yk[4];
#pragma unroll
                    for (int s4 = 0; s4 < 4; ++s4) {
                        const int tt = 4 * q4 + s4;
                        const f32x4 a_lo = *(const LAS f32x4*)&A_[tt * 64 + 8 * jg], a_hi = *(const LAS f32x4*)&A_[tt * 64 + 8 * jg + 4];
                        const f32x4 r_lo = *(const LAS f32x4*)&WR[tt * 64 + 8 * jg], r_hi = *(const LAS f32x4*)&WR[tt * 64 + 8 * jg + 4];
                        const f32x4 w_lo = *(const LAS f32x4*)&Wd[tt * 64 + 8 * jg], w_hi = *(const LAS f32x4*)&Wd[tt * 64 + 8 * jg + 4];
                        const f32x4 b_lo = *(const LAS f32x4*)&Bv[tt * 64 + 8 * jg], b_hi = *(const LAS f32x4*)&Bv[tt * 64 + 8 * jg + 4];
                        const f32x4 k_lo = *(const LAS f32x4*)&Kk[tt * 64 + 8 * jg], k_hi = *(const LAS f32x4*)&Kk[tt * 64 + 8 * jg + 4];
                        const f32x2 vv = *(const LAS f32x2*)&Vv[tt * 64 + i0];
                        const f32x2 sc = *(const LAS f32x2*)&SC[tt * 4];
                        const f32x2 av[4] = {{a_lo.x, a_lo.y}, {a_lo.z, a_lo.w}, {a_hi.x, a_hi.y}, {a_hi.z, a_hi.w}};
                        const f32x2 rv[4] = {{r_lo.x, r_lo.y}, {r_lo.z, r_lo.w}, {r_hi.x, r_hi.y}, {r_hi.z, r_hi.w}};
                        const f32x2 wv[4] = {{w_lo.x, w_lo.y}, {w_lo.z, w_lo.w}, {w_hi.x, w_hi.y}, {w_hi.z, w_hi.w}};
                        const f32x2 bv[4] = {{b_lo.x, b_lo.y}, {b_lo.z, b_lo.w}, {b_hi.x, b_hi.y}, {b_hi.z, b_hi.w}};
                        const f32x2 kv[4] = {{k_lo.x, k_lo.y}, {k_lo.z, k_lo.w}, {k_hi.x, k_hi.y}, {k_hi.z, k_hi.w}};
                        f32x2 e10 = S0[0] * av[0], e20 = S0[0] * rv[0], e11 = S1[0] * av[0], e21 = S1[0] * rv[0];
#pragma unroll
                        for (int j = 1; j < 4; ++j) { e10 += S0[j] * av[j]; e20 += S0[j] * rv[j]; e11 += S1[j] * av[j]; e21 += S1[j] * rv[j]; }
                        const float d10 = red8(e10.x + e10.y), d20 = red8(e20.x + e20.y), d11 = red8(e11.x + e11.y), d21 = red8(e21.x + e21.y);
                        yk[s4] = (f32x2){d20 + d10 * sc.x + vv.x * sc.y, d21 + d11 * sc.x + vv.y * sc.y};
                        const f32x2 d10v = (f32x2){d10, d10}, d11v = (f32x2){d11, d11}, v0v = (f32x2){vv.x, vv.x}, v1v = (f32x2){vv.y, vv.y};
#pragma unroll
                        for (int j = 0; j < 4; ++j) { S0[j] = S0[j] * wv[j] + (d10v * bv[j] + v0v * kv[j]); S1[j] = S1[j] * wv[j] + (d11v * bv[j] + v1v * kv[j]); }
                    }
                    if (jg == 0) {
#pragma unroll
                        for (int s4 = 0; s4 < 4; ++s4) *(LAS f32x2*)&Yy[(4 * q4 + s4) * 64 + i0] = yk[s4];
                    }

#if PROBE_SCAN2
                    {
#pragma unroll
                    for (int s4 = 0; s4 < 4; ++s4) {
                        const int tt = 4 * q4 + s4;
                        const f32x4 a_lo = *(const LAS f32x4*)&A_[tt * 64 + 8 * jg], a_hi = *(const LAS f32x4*)&A_[tt * 64 + 8 * jg + 4];
                        const f32x4 r_lo = *(const LAS f32x4*)&WR[tt * 64 + 8 * jg], r_hi = *(const LAS f32x4*)&WR[tt * 64 + 8 * jg + 4];
                        const f32x4 w_lo = *(const LAS f32x4*)&Wd[tt * 64 + 8 * jg], w_hi = *(const LAS f32x4*)&Wd[tt * 64 + 8 * jg + 4];
                        const f32x4 b_lo = *(const LAS f32x4*)&Bv[tt * 64 + 8 * jg], b_hi = *(const LAS f32x4*)&Bv[tt * 64 + 8 * jg + 4];
                        const f32x4 k_lo = *(const LAS f32x4*)&Kk[tt * 64 + 8 * jg], k_hi = *(const LAS f32x4*)&Kk[tt * 64 + 8 * jg + 4];
                        const f32x2 vv = *(const LAS f32x2*)&Vv[tt * 64 + i0];
                        const f32x2 av[4] = {{a_lo.x, a_lo.y}, {a_lo.z, a_lo.w}, {a_hi.x, a_hi.y}, {a_hi.z, a_hi.w}};
                        const f32x2 rv[4] = {{r_lo.x, r_lo.y}, {r_lo.z, r_lo.w}, {r_hi.x, r_hi.y}, {r_hi.z, r_hi.w}};
                        const f32x2 wv[4] = {{w_lo.x, w_lo.y}, {w_lo.z, w_lo.w}, {w_hi.x, w_hi.y}, {w_hi.z, w_hi.w}};
                        const f32x2 bv[4] = {{b_lo.x, b_lo.y}, {b_lo.z, b_lo.w}, {b_hi.x, b_hi.y}, {b_hi.z, b_hi.w}};
                        const f32x2 kv[4] = {{k_lo.x, k_lo.y}, {k_lo.z, k_lo.w}, {k_hi.x, k_hi.y}, {k_hi.z, k_hi.w}};
                        f32x2 e10 = T0[0] * av[0], e20 = T0[0] * rv[0], e11 = T1[0] * av[0], e21 = T1[0] * rv[0];
#pragma unroll
                        for (int j = 1; j < 4; ++j) { e10 += T0[j] * av[j]; e20 += T0[j] * rv[j]; e11 += T1[j] * av[j]; e21 += T1[j] * rv[j]; }
                        const float d10 = red8(e10.x + e10.y), d20 = red8(e20.x + e20.y), d11 = red8(e11.x + e11.y), d21 = red8(e21.x + e21.y);
                        const f32x2 d10v = (f32x2){d10 + d20, d10}, d11v = (f32x2){d11 + d21, d11}, v0v = (f32x2){vv.x, vv.x}, v1v = (f32x2){vv.y, vv.y};
#pragma unroll
                        for (int j = 0; j < 4; ++j) { T0[j] = T0[j] * wv[j] + (d10v * bv[j] + v0v * kv[j]); T1[j] = T1[j] * wv[j] + (d11v * bv[j] + v1v * kv[j]); }
                    }
                    }
#endif
                }
                LDS_BAR();
            }
        }
            }
    }
    if (helper) {
        const int bufl = (RW_NCH - 1) & 1;
        LAS float* Yy = RW_ARR(bufl, 7); LAS float* Gg = RW_ARR(bufl, 6); LAS float* Vv = RW_ARR(bufl, 5); LAS float* SC = RW_SC(bufl);
        const f32x4 y = *(const LAS f32x4*)&Yy[tt_h * 64 + cg4], gg = *(const LAS f32x4*)&Gg[tt_h * 64 + cg4], vv = *(const LAS f32x4*)&Vv[tt_h * 64 + cg4];
        const float bonus = SC[tt_h * 4 + 2];
        const float mean = red16((y.x + y.y) + (y.z + y.w)) * (1.f / 64.f);
        const f32x4 d = y - mean;
        const float var = red16((d.x * d.x + d.y * d.y) + (d.z * d.z + d.w * d.w)) * (1.f / 64.f);
        const float rs = 1.f / sqrtf(var + 64e-5f);
        const f32x4 o = (d * rs * p_gg + p_gb + vv * bonus) * gg;
        u32x2 w; w.x = pk2(o.x, o.y); w.y = pk2(o.z, o.w);
        *(u32x2*)(X.P + ((size_t)b * SEQ + (RW_NCH - 1) * RW_TS + tt_h) * LDP + COL_YA + h * 64 + cg4) = w;
    }
    __syncthreads();
#undef RW_ARR
#undef RW_SC
#undef RW_LOAD
}

__device__ __forceinline__ void hgrn_task(const Ctx& X, LAS unsigned char* lds, int layer, int b, int h, int vh) {
    LAS float* F = (LAS float*)(lds); LAS float* Q = (LAS float*)(lds + 16384); LAS float* Vv = (LAS float*)(lds + 32768); LAS float* O = (LAS float*)(lds + 40960);
    LAS float* LB = (LAS float*)(lds + 49152);
    const int tid = X.tid;
    const float* lbl = X.in[14];
    const int rp = tid >> 4, dg = tid & 15, v0 = 2 * rp;
    if (tid < 128) LB[tid] = (layer > 0) ? 1.f / (1.f + __expf(lbl[h * 128 + tid] - lbl[512 + h * 128 + tid])) : 0.f;
    f32x2 S0[4], S1[4];
#pragma unroll
    for (int j = 0; j < 4; ++j) { S0[j] = (f32x2){0.f, 0.f}; S1[j] = (f32x2){0.f, 0.f}; }
#define HG_LOAD(chk) do { _Pragma("unroll") for (int it = 0; it < 3; ++it) { const int idx = tid + 512 * it; raw[it] = (u32x4){0u, 0u, 0u, 0u}; \
        if (idx < 32 * 40) { const int tt = idx / 40, vv = idx - tt * 40; \
            const int col = vv < 16 ? 512 + h * 128 + 8 * vv : (vv < 32 ? h * 128 + 8 * (vv - 16) : 1024 + h * 128 + vh * 64 + 8 * (vv - 32)); \
            raw[it] = *(const u32x4*)(X.P + ((size_t)b * SEQ + (chk) * 32 + tt) * LDP + COL_PB + col); } } } while (0)
    u32x4 raw[3];
    HG_LOAD(0);
    __syncthreads();
#pragma unroll 1
    for (int ch = 0; ch < SEQ / 32; ++ch) {
        const int t0 = ch * 32;
#pragma unroll
        for (int it = 0; it < 3; ++it) {
            const int idx = tid + 512 * it;
            if (idx < 32 * 40) {
                const int tt = idx / 40, vv = idx - tt * 40;
                float x[8];
                x[0] = bflo(raw[it].x); x[1] = bfhi(raw[it].x); x[2] = bflo(raw[it].y); x[3] = bfhi(raw[it].y);
                x[4] = bflo(raw[it].z); x[5] = bfhi(raw[it].z); x[6] = bflo(raw[it].w); x[7] = bfhi(raw[it].w);
                LAS float* dst;
                if (vv < 16) {
                    dst = F + tt * 128 + 8 * vv;
#pragma unroll
                    for (int e = 0; e < 8; ++e) { const float lb = LB[8 * vv + e]; x[e] = lb + (1.f - lb) * sigmoidf_(x[e]); }
                } else if (vv < 32) dst = Q + tt * 128 + 8 * (vv - 16);
                else dst = Vv + tt * 64 + 8 * (vv - 32);
                *(LAS f32x4*)dst = (f32x4){x[0], x[1], x[2], x[3]}; *(LAS f32x4*)(dst + 4) = (f32x4){x[4], x[5], x[6], x[7]};
            }
        }
        if (ch + 1 < SEQ / 32) HG_LOAD(ch + 1);
        LDS_BAR();
#pragma unroll 4
        for (int tt = 0; tt < 32; ++tt) {
            const f32x4 f_lo = *(const LAS f32x4*)&F[tt * 128 + 8 * dg], f_hi = *(const LAS f32x4*)&F[tt * 128 + 8 * dg + 4];
            const f32x4 q_lo = *(const LAS f32x4*)&Q[tt * 128 + 8 * dg], q_hi = *(const LAS f32x4*)&Q[tt * 128 + 8 * dg + 4];
            const f32x2 vv = *(const LAS f32x2*)&Vv[tt * 64 + v0];
            const f32x2 f2[4] = {{f_lo.x, f_lo.y}, {f_lo.z, f_lo.w}, {f_hi.x, f_hi.y}, {f_hi.z, f_hi.w}};
            const f32x2 q2[4] = {{q_lo.x, q_lo.y}, {q_lo.z, q_lo.w}, {q_hi.x, q_hi.y}, {q_hi.z, q_hi.w}};
            const f32x2 v0v = (f32x2){vv.x, vv.x}, v1v = (f32x2){vv.y, vv.y};
            f32x2 a0 = (f32x2){0.f, 0.f}, a1 = (f32x2){0.f, 0.f};
#pragma unroll
            for (int j = 0; j < 4; ++j) {
                S0[j] = v0v + f2[j] * (S0[j] - v0v); S1[j] = v1v + f2[j] * (S1[j] - v1v);
                a0 += q2[j] * S0[j]; a1 += q2[j] * S1[j];
            }
            const float o0 = red16(a0.x + a0.y), o1 = red16(a1.x + a1.y);
            if (dg == 0) *(LAS f32x2*)&O[tt * 64 + v0] = (f32x2){o0, o1};
        }
        LDS_BAR();
        if (tid < 256) {
            const int tt = tid >> 3, v8 = (tid & 7) * 8;
            const f32x4 a = *(const LAS f32x4*)&O[tt * 64 + v8], c4 = *(const LAS f32x4*)&O[tt * 64 + v8 + 4];
            u32x4 o; o.x = pk2(a.x, a.y); o.y = pk2(a.z, a.w); o.z = pk2(c4.x, c4.y); o.w = pk2(c4.z, c4.w);
            *(u32x4*)(X.P + ((size_t)b * SEQ + t0 + tt) * LDP + COL_YB + h * 128 + vh * 64 + v8) = o;
        }
    }
#undef HG_LOAD
    __syncthreads();
}

__device__ __forceinline__ unsigned f2ord(float f) { const unsigned u = __builtin_bit_cast(unsigned, f); return (u & 0x80000000u) ? ~u : (u | 0x80000000u); }

__device__ __forceinline__ void dsa_tile(const Ctx& X, LAS unsigned char* lds, int b, int q0) {
    LAS float* sc = (LAS float*)lds;
    LAS unsigned* MASK = (LAS unsigned*)(lds + MASK_OFF);
    const int lane = X.lane, w = X.wave, n = lane & 15, g = lane >> 4;
    const bf16_t* Pb = X.P + (size_t)b * SEQ * LDP;
#pragma unroll 1
    for (int sub = 0; sub < 4; ++sub) {
        const int qs = q0 + 16 * sub;
        {
            bf16x8 bq[4][2]; float wi[4];
            const bf16_t* qrow = Pb + (size_t)(qs + n) * LDP;
#pragma unroll
            for (int hh = 0; hh < 4; ++hh) {
#pragma unroll
                for (int ks = 0; ks < 2; ++ks) bq[hh][ks] = *(const bf16x8*)(qrow + C_QI + hh * 64 + ks * 32 + 8 * g);
                wi[hh] = bf2f(qrow[C_WI + hh]);
            }
            const int nkt = (qs + 16) >> 4;
            bf16x8 a0n = (bf16x8){0, 0, 0, 0, 0, 0, 0, 0}, a1n = a0n;
            if (w < nkt) { const bf16_t* krow = Pb + (size_t)(w * 16 + n) * LDP + C_KI; a0n = *(const bf16x8*)(krow + 8 * g); a1n = *(const bf16x8*)(krow + 32 + 8 * g); }
#pragma unroll 1
            for (int kt = w; kt < nkt; kt += 8) {
                const bf16x8 a0 = a0n, a1 = a1n;
                if (kt + 8 < nkt) { const bf16_t* krow = Pb + (size_t)((kt + 8) * 16 + n) * LDP + C_KI; a0n = *(const bf16x8*)(krow + 8 * g); a1n = *(const bf16x8*)(krow + 32 + 8 * g); }
                f32x4 s = (f32x4){0.f, 0.f, 0.f, 0.f};
#pragma unroll
                for (int hh = 0; hh < 4; ++hh) {
                    f32x4 d = __builtin_amdgcn_mfma_f32_16x16x32_bf16(a0, bq[hh][0], (f32x4){0.f, 0.f, 0.f, 0.f}, 0, 0, 0);
                    d = __builtin_amdgcn_mfma_f32_16x16x32_bf16(a1, bq[hh][1], d, 0, 0, 0);
#pragma unroll
                    for (int r = 0; r < 4; ++r) s[r] += wi[hh] * fmaxf(d[r], 0.f);
                }
                const int t = qs + n;
#pragma unroll
                for (int r = 0; r < 4; ++r) if (kt * 16 + 4 * g + r > t) s[r] = -INFINITY;
                *(LAS f32x4*)&sc[n * SCS + kt * 16 + 4 * g] = s;
            }
        }
        __syncthreads();
#pragma unroll 1
        for (int e = 0; e < 2; ++e) {
            const int qn = 2 * w + e, t = qs + qn;
            LAS unsigned* mrow = MASK + (sub * 16 + qn) * 64;
            if (t < 256) {
#pragma unroll
                for (int j = 0; j < 32; ++j) {
                    const unsigned long long sm = __ballot(j * 64 + lane <= t);
                    if (lane == 0) { mrow[2 * j] = (unsigned)sm; mrow[2 * j + 1] = (unsigned)(sm >> 32); }
                }
            } else {
                const int jn = (t >> 6) + 1;
                unsigned u[32];
#pragma unroll
                for (int j = 0; j < 32; ++j) {
                    u[j] = 0u;
                    if (j < jn) { const int key = j * 64 + lane; const float s = (key <= t) ? sc[qn * SCS + key] : -INFINITY; u[j] = f2ord(s); }
                }
                unsigned prefix = 0u;
#pragma unroll 1
                for (int bit = 31; bit >= 0; --bit) {
                    const unsigned cand = prefix | (1u << bit);
                    int c0 = 0, c1 = 0;
#pragma unroll
                    for (int j = 0; j < 32; j += 2) { c0 += (u[j] >= cand) ? 1 : 0; c1 += (u[j + 1] >= cand) ? 1 : 0; }
                    const int cnt = (int)wave_sum_fast((float)(c0 + c1));
                    if (cnt >= 256) prefix = cand;
                }
                int cg_ = 0;
#pragma unroll
                for (int j = 0; j < 32; ++j) if (j < jn) cg_ += __popcll(__ballot(u[j] > prefix));
                const int need = 256 - cg_;
                int cum = 0;
#pragma unroll
                for (int j = 0; j < 32; ++j) {
                    unsigned long long sm = 0ull;
                    if (j < jn) {
                        const bool eq = (u[j] == prefix);
                        const unsigned long long em = __ballot(eq);
                        const int rank = cum + (int)__builtin_amdgcn_mbcnt_hi((unsigned)(em >> 32), __builtin_amdgcn_mbcnt_lo((unsigned)em, 0u));
                        const bool sel = (u[j] > prefix) || (eq && rank < need);
                        sm = __ballot(sel);
                        cum += __popcll(em);
                    }
                    if (lane == 0) { mrow[2 * j] = (unsigned)sm; mrow[2 * j + 1] = (unsigned)(sm >> 32); }
                }
            }
        }
        __syncthreads();
    }
    const int qq = q0 + 8 * w + (n & 7);
    const LAS unsigned* mq = MASK + (8 * w + (n & 7)) * 64;
    const int nsteps = (q0 + 8 * w + 8 + 31) >> 5;
#pragma unroll 1
    for (int c = 0; c < 2; ++c) {
        bf16x8 bq[2][2];
#pragma unroll
        for (int j = 0; j < 2; ++j)
#pragma unroll
            for (int ks = 0; ks < 2; ++ks) bq[j][ks] = *(const bf16x8*)(Pb + (size_t)qq * LDP + C_Q + (c * 4 + 2 * j + (n >> 3)) * 64 + ks * 32 + 8 * g);
        float lrun[2] = {0.f, 0.f};
        f32x4 oacc[4][2];
#pragma unroll
        for (int mt = 0; mt < 4; ++mt)
#pragma unroll
            for (int j = 0; j < 2; ++j) oacc[mt][j] = (f32x4){0.f, 0.f, 0.f, 0.f};
        const bf16_t* vtb = X.VT + ((size_t)(b * 2 + c) * 64) * SEQ;
#define DSA_LOAD(KA, VL, VH, kb_) do { _Pragma("unroll") for (int tl = 0; tl < 2; ++tl) { const bf16_t* krow = Pb + (size_t)((kb_) + 16 * tl + n) * LDP + C_K + c * 64; \
            KA[tl][0] = *(const bf16x8*)(krow + 8 * g); KA[tl][1] = *(const bf16x8*)(krow + 32 + 8 * g); } \
            _Pragma("unroll") for (int mt = 0; mt < 4; ++mt) { const bf16_t* vp = vtb + (size_t)(mt * 16 + n) * SEQ + (kb_) + 4 * g; VL[mt] = *(const u32x2*)vp; VH[mt] = *(const u32x2*)(vp + 16); } } while (0)
        bf16x8 kan[2][2]; u32x2 vln[4], vhn[4];
        DSA_LOAD(kan, vln, vhn, 0);
#pragma unroll 1
        for (int s = 0; s < nsteps; ++s) {
            const int kb = 32 * s;
            bf16x8 ka[2][2]; bf16x8 av[4];
#pragma unroll
            for (int tl = 0; tl < 2; ++tl) { ka[tl][0] = kan[tl][0]; ka[tl][1] = kan[tl][1]; }
#pragma unroll
            for (int mt = 0; mt < 4; ++mt) { u32x4 t4; t4.x = vln[mt].x; t4.y = vln[mt].y; t4.z = vhn[mt].x; t4.w = vhn[mt].y; av[mt] = __builtin_bit_cast(bf16x8, t4); }
            if (s + 1 < nsteps) DSA_LOAD(kan, vln, vhn, kb + 32);
            f32x4 st[2][2];
#pragma unroll
            for (int tl = 0; tl < 2; ++tl) {
#pragma unroll
                for (int j = 0; j < 2; ++j) {
                    f32x4 d = __builtin_amdgcn_mfma_f32_16x16x32_bf16(ka[tl][0], bq[j][0], (f32x4){0.f, 0.f, 0.f, 0.f}, 0, 0, 0);
                    st[tl][j] = __builtin_amdgcn_mfma_f32_16x16x32_bf16(ka[tl][1], bq[j][1], d, 0, 0, 0);
                }
            }
            const unsigned mw = mq[s];
#pragma unroll
            for (int j = 0; j < 2; ++j) {
                float p[8], ps = 0.f;
#pragma unroll
                for (int tl = 0; tl < 2; ++tl)
#pragma unroll
                    for (int r = 0; r < 4; ++r) { const int bit = 16 * tl + 4 * g + r; const float e = __expf(fminf(st[tl][j][r] * 0.125f, 60.f)); p[4 * tl + r] = ((mw >> bit) & 1u) ? e : 0.f; ps += p[4 * tl + r]; }
                lrun[j] += ps;
                u32x4 pw; pw.x = pg8::cvt_pk_bf16(p[0], p[1]); pw.y = pg8::cvt_pk_bf16(p[2], p[3]); pw.z = pg8::cvt_pk_bf16(p[4], p[5]); pw.w = pg8::cvt_pk_bf16(p[6], p[7]);
                const bf16x8 pb = __builtin_bit_cast(bf16x8, pw);
#pragma unroll
                for (int mt = 0; mt < 4; ++mt) oacc[mt][j] = __builtin_amdgcn_mfma_f32_16x16x32_bf16(av[mt], pb, oacc[mt][j], 0, 0, 0);
            }
        }
#pragma unroll
        for (int j = 0; j < 2; ++j) {
            float lt = lrun[j]; lt += __shfl_xor(lt, 16); lt += __shfl_xor(lt, 32);
            const float il = 1.f / lt;
            bf16_t* op = X.P + ((size_t)b * SEQ + qq) * LDP + COL_YC + (c * 4 + 2 * j + (n >> 3)) * 64 + 4 * g;
#pragma unroll
            for (int mt = 0; mt < 4; ++mt) {
                const f32x4 o = oacc[mt][j] * il;
                u32x2 wv; wv.x = pg8::cvt_pk_bf16(o[0], o[1]); wv.y = pg8::cvt_pk_bf16(o[2], o[3]);
                *(u32x2*)(op + mt * 16) = wv;
            }
        }
    }
#undef DSA_LOAD
    __syncthreads();
}

__device__ __forceinline__ void phase_mixers(const Ctx& X0, LAS unsigned char* lds, int layer) {
#pragma unroll 1
    for (int task = X0.bid; task < 128; task += X0.G) {
        Ctx X = X0;
        { int t_ = threadIdx.x; asm volatile("" : "+v"(t_)); X.tid = t_; X.lane = t_ & 63; }
        if (task < 64) { if (TKMASK & 1) rwkv_task(X, lds, layer, task >> 3, task & 7); }
        else { const int k = task - 64; if (TKMASK & 2) hgrn_task(X, lds, layer, k >> 3, (k >> 1) & 3, k & 1); }
    }
    volatile LAS unsigned* tw = (volatile LAS unsigned*)(lds + LDS_BYTES - 128);
    unsigned* ctr = (unsigned*)(X0.ws + WS_BAR + 14336) + 16 * layer;
#pragma unroll 1
    for (;;) {
        Ctx X = X0;
        { int t_ = threadIdx.x; asm volatile("" : "+v"(t_)); X.tid = t_; X.lane = t_ & 63; }
        __syncthreads();
        if (threadIdx.x == 0) tw[0] = __hip_atomic_fetch_add(ctr, 1u, __ATOMIC_RELAXED, __HIP_MEMORY_SCOPE_AGENT);
        __syncthreads();
        const int t = (int)tw[0];
        if (t >= 256) break;
        if (TKMASK & 4) dsa_tile(X, lds, t & 7, 64 * (31 - (t >> 3)));
    }
}

__device__ __forceinline__ void phase_hgrn_post(const Ctx& X, int layer) {
    const int gw = X.bid * 8 + X.wave, NGW = X.G * 8;
    const float* gn = X.in[15] + layer * 512;
    for (int it = gw; it < T_TOK * 4; it += NGW) {
        const int t = it >> 2, h = it & 3;
        bf16_t* rowp = X.P + (size_t)t * LDP;
        unsigned* op = (unsigned*)(rowp + COL_YB + h * 128) + X.lane;
        const unsigned ow = *op, gwd = *((const unsigned*)(rowp + COL_PB + 1536 + h * 128) + X.lane);
        const float o0 = bflo(ow), o1 = bfhi(ow), g0 = bflo(gwd), g1 = bfhi(gwd);
        const float rs = 1.f / sqrtf(wave_sum(o0 * o0 + o1 * o1) * (1.f / 128.f) + 1e-6f);
        const float y0 = o0 * rs * gn[h * 128 + 2 * X.lane] * (g0 * sigmoidf_(g0)), y1 = o1 * rs * gn[h * 128 + 2 * X.lane + 1] * (g1 * sigmoidf_(g1));
        *op = pk2(y0, y1);
    }
}

__device__ __forceinline__ void phase_fixup(const Ctx& X, int layer) {
    const float* cw = X.in[20] + (size_t)layer * 3 * F2; const float* cb = X.in[21] + (size_t)layer * F2;
    for (int idx = X.bid * 512 + X.tid; idx < 256 * 2 * DFF; idx += X.G * 512) {
        const int j = idx % DFF, sr = idx / DFF, s = sr >> 1, r = sr & 1;
        const int colg = (j >> 7) * 256 + (j & 127), colv = colg + 128;
        const bool seq0 = (s & 31) == 0;
        const float* H = X.HALO;
        float res[2];
#pragma unroll
        for (int part = 0; part < 2; ++part) {
            const int cp = part ? colv : colg, co = part * DFF + j;
            const float u0 = H[(size_t)(s * 4 + r) * F2 + cp];
            float u1, u2;
            if (r == 0) { u1 = seq0 ? 0.f : H[(size_t)((s - 1) * 4 + 3) * F2 + cp]; u2 = seq0 ? 0.f : H[(size_t)((s - 1) * 4 + 2) * F2 + cp]; }
            else { u1 = H[(size_t)(s * 4 + 0) * F2 + cp]; u2 = seq0 ? 0.f : H[(size_t)((s - 1) * 4 + 3) * F2 + cp]; }
            res[part] = cb[co] + cw[co] * u2 + cw[F2 + co] * u1 + cw[2 * F2 + co] * u0;
        }
        const float a = res[0] * sigmoidf_(res[0]) * res[1];
        X.P[(size_t)(s * 64 + r) * LDP + COL_ACT + j] = (bf16_t)f2bf(a);
    }
}

#define XB_TMO      128
#define XB_XCNT(j)  (256  + 64 * (j))
#define XB_XSUB(j)  (1280 + 64 * (j))
#define XB_XGEN(j)  (2304 + 64 * (j))
#define XB_TOP      3328
#define XB_TOPGEN   3392
#define XCD_BAR_WORDS 3456
#define XB_SPIN_CAP (1u << 22)
__device__ __forceinline__ unsigned xb_ld(unsigned* p)              { return __hip_atomic_load(p, __ATOMIC_RELAXED, __HIP_MEMORY_SCOPE_AGENT); }
__device__ __forceinline__ unsigned xb_add(unsigned* p, unsigned v) { return __hip_atomic_fetch_add(p, v, __ATOMIC_RELAXED, __HIP_MEMORY_SCOPE_AGENT); }
__device__ __forceinline__ unsigned xb_xcc_id() { return (unsigned)__builtin_amdgcn_s_getreg((3 << 11) | 20) & 0xFu; }
#define XB_SPIN(cond, bar) do { unsigned _sp = 0; while (cond) { __builtin_amdgcn_s_sleep(1); \
    if ((++_sp & 255u) == 0u) { if (xb_ld(&(bar)[XB_TMO])) break; if (_sp > XB_SPIN_CAP) { atomicAdd(&(bar)[XB_TMO], 1u); break; } } } } while (0)
struct XcdBarrier { unsigned* bar; unsigned x; volatile LAS unsigned* st; };
__device__ __forceinline__ XcdBarrier xcd_barrier_post(unsigned* bar, volatile LAS unsigned* st) {
    XcdBarrier b; b.bar = bar; b.x = xb_xcc_id(); b.st = st;
    if (threadIdx.x == 0) (void)xb_add(&bar[XB_XCNT(b.x)], 1u);
    return b;
}
__device__ __forceinline__ void xcd_barrier_complete(unsigned* bar, unsigned x, unsigned& nloc, unsigned& nx) {
    const unsigned G = gridDim.x * gridDim.y * gridDim.z;
    unsigned sum, cnt, mine, sp = 0u;
    for (;;) {
        sum = 0u; cnt = 0u; mine = 0u;
#pragma unroll
        for (unsigned j = 0; j < 16; ++j) { const unsigned c = xb_ld(&bar[XB_XCNT(j)]); sum += c; cnt += (c > 0u) ? 1u : 0u; mine = (j == x) ? c : mine; }
        if (sum == G) break;
        __builtin_amdgcn_s_sleep(1);
        if ((++sp & 255u) == 0u) { if (xb_ld(&bar[XB_TMO])) break; if (sp > XB_SPIN_CAP) { atomicAdd(&bar[XB_TMO], 1u); break; } }
    }
    nloc = mine > 0u ? mine : 1u; nx = cnt > 0u ? cnt : 1u;
}
__device__ __forceinline__ void xcd_barrier(const XcdBarrier& b) {
    asm volatile("s_waitcnt vmcnt(0)" ::: "memory");
    __syncthreads();
    if (threadIdx.x == 0) {
        unsigned* bar = b.bar;
        __builtin_amdgcn_s_waitcnt(0);
        unsigned nloc = b.st[0], nx = b.st[1];
        if (nloc == 0u) { xcd_barrier_complete(bar, b.x, nloc, nx); b.st[0] = nloc; b.st[1] = nx; }
        const unsigned old = xb_add(&bar[XB_XSUB(b.x)], 1u);
        const unsigned gen = old / nloc;
        if (old + 1u == (gen + 1u) * nloc) {
            __builtin_amdgcn_fence(__ATOMIC_RELEASE, "agent");
            asm volatile("s_waitcnt vmcnt(0)" ::: "memory");
            const unsigned og = xb_add(&bar[XB_TOP], 1u);
            const unsigned tg = og / nx;
            if (og + 1u == (tg + 1u) * nx) xb_add(&bar[XB_TOPGEN], 1u);
            else XB_SPIN(xb_ld(&bar[XB_TOPGEN]) == tg, bar);
            __builtin_amdgcn_fence(__ATOMIC_ACQUIRE, "agent");
            xb_add(&bar[XB_XGEN(b.x)], 1u);
            asm volatile("s_waitcnt vmcnt(0)" ::: "memory");
        } else {
            XB_SPIN(xb_ld(&bar[XB_XGEN(b.x)]) == gen, bar);
            __builtin_amdgcn_fence(__ATOMIC_ACQUIRE, "agent");
            asm volatile("s_waitcnt vmcnt(0)" ::: "memory");
        }
    }
    __syncthreads();
}

__global__ void __launch_bounds__(512, 2) mk_fwd(Args args) {
    extern __shared__ __attribute__((aligned(16))) unsigned char lds_raw[];
    LAS unsigned char* lds = (LAS unsigned char*)lds_raw;
    Ctx X;
#pragma unroll
    for (int i = 0; i < 24; ++i) X.in[i] = args.in[i];
    X.out = args.out; X.ws = args.ws;
    X.P = (bf16_t*)(args.ws + WS_P); X.VT = (bf16_t*)(args.ws + WS_VT); X.HALO = (float*)(args.ws + WS_HALO); X.ROPE = (float*)(args.ws + WS_ROPE);
    X.Win = (bf16_t*)(args.ws + WS_WIN); X.Wg = (bf16_t*)(args.ws + WS_WG); X.Wbr = (bf16_t*)(args.ws + WS_WBR);
    X.Wo = (bf16_t*)(args.ws + WS_WO); X.Wup = (bf16_t*)(args.ws + WS_WUP); X.Wdn = (bf16_t*)(args.ws + WS_WDN);
    X.tid = threadIdx.x; X.lane = X.tid & 63; X.wave = __builtin_amdgcn_readfirstlane(X.tid >> 6); X.G = gridDim.x; X.bid = blockIdx.x;

#if PROBE_DOUBLE
    for (int ph2 = args.ph_lo * 2; ph2 < args.ph_hi * 2; ++ph2) {
        const int ph = ph2 >> 1;
        const int layer = ph / 11, sub = ph % 11;
        const bool skip_ = (ph2 & 1) && !(ph < 22 && ((REPMASK >> sub) & 1));
#else
    volatile LAS unsigned* bst = (volatile LAS unsigned*)(lds + LDS_BYTES - 64);
    if (threadIdx.x < 2) bst[threadIdx.x] = 0u;
    __syncthreads();
    XcdBarrier gbar = xcd_barrier_post((unsigned*)(args.ws + WS_BAR), bst);
    for (int ph = args.ph_lo; ph < args.ph_hi; ++ph) {
        const int layer = ph / 11, sub = ph % 11;
        const bool skip_ = false;
#endif
        { int t_ = threadIdx.x; asm volatile("" : "+v"(t_)); X.tid = t_; X.lane = t_ & 63; }

        if (skip_) {
        } else if (ph == 22 && (PHMASK & 1024)) {
            const int gw = X.bid * 8 + X.wave, NGW = X.G * 8;
            for (int m = gw; m < T_TOK; m += NGW) rms_row(X.out + (size_t)m * DM, X.in[23], nullptr, X.out + (size_t)m * DM, X.lane);
        } else if (sub == 0 && (PHMASK & 1)) {
            phase_prep(X, lds, layer);
        } else if (sub == 1 && (PHMASK & 2)) {
            pg8::Gemm g{X.P, X.Win, LDP, DM, DM}; pg8::StaticOrder S; S.init(T_TOK, 5120, X.G, X.bid);
            pg8::EpiInProj E{X.P, X.VT, X.ROPE, (bf16_t*)(X.ws + WS_BND)};
            pg8::gemm_phase<pg8::EpiInProj, true>(lds, g, S, E, X.tid);
        } else if (sub == 2 && (PHMASK & 4)) {
            phase_rwkv_pre(X, lds, layer);
        } else if (sub == 3 && (PHMASK & 4)) {
            phase_mixers(X, lds, layer);
        } else if (sub == 4 && (PHMASK & 8)) {
            phase_hgrn_post(X, layer);
            { const int gw = X.bid * 8 + X.wave, NGW = X.G * 8; const float* hh = (layer == 0) ? X.in[0] : X.out; const float* g = X.in[1] + (size_t)layer * DM;
              for (int m = gw; m < T_TOK; m += NGW) rms_row(hh + (size_t)m * DM, g, X.P + (size_t)m * LDP, nullptr, X.lane); }
        } else if (sub == 5 && (PHMASK & 16)) {
#pragma unroll 1
            for (int br = 0; br < 3; ++br) {
                { pg8::Gemm g{X.P, X.Wg + (size_t)br * DM * DM, LDP, DM, DM}; pg8::StaticOrder S; S.init(T_TOK, DM, X.G, X.bid);
                  int t_ = X.tid; asm volatile("" : "+v"(t_));
                  pg8::EpiGate E{X.P}; pg8::gemm_phase<pg8::EpiGate, true>(lds, g, S, E, t_); }
                { const int ycol = br == 0 ? COL_YA : (br == 1 ? COL_YB : COL_YC);
                  pg8::Gemm g{X.P + ycol, X.Wbr + (size_t)br * DM * 512, LDP, 512, 512}; pg8::StaticOrder S; S.init(T_TOK, DM, X.G, X.bid);
                  int t_ = X.tid; asm volatile("" : "+v"(t_));
                  pg8::EpiMergeAcc E{X.P, br == 0 ? 1 : 0}; pg8::gemm_phase<pg8::EpiMergeAcc, true>(lds, g, S, E, t_); }
            }
        } else if (sub == 6 && (PHMASK & 32)) {
            pg8::Gemm g{X.P + COL_MRG, X.Wo, LDP, DM, DM}; pg8::StaticOrder S; S.init(T_TOK, DM, X.G, X.bid);
            pg8::EpiResid E{layer == 0 ? X.in[0] : X.out, X.out};
            pg8::gemm_phase<pg8::EpiResid, true>(lds, g, S, E, X.tid);
        } else if (sub == 7 && (PHMASK & 64)) {
            const int gw = X.bid * 8 + X.wave, NGW = X.G * 8;
            const float* g = X.in[18] + (size_t)layer * DM;
            for (int m = gw; m < T_TOK; m += NGW) rms_row(X.out + (size_t)m * DM, g, X.P + (size_t)m * LDP, nullptr, X.lane);
        } else if (sub == 8 && (PHMASK & 128)) {
            pg8::Gemm g{X.P, X.Wup, LDP, DM, DM}; pg8::StaticOrder S; S.init(T_TOK, F2, X.G, X.bid);
            pg8::EpiUp E{X.P, X.HALO, X.in[20] + (size_t)layer * 3 * F2, X.in[21] + (size_t)layer * F2};
            pg8::gemm_phase<pg8::EpiUp, true>(lds, g, S, E, X.tid);
        } else if (sub == 9 && (PHMASK & 256)) {
            phase_fixup(X, layer);
        } else if (sub == 10 && (PHMASK & 512)) {
            pg8::Gemm g{X.P + COL_ACT, X.Wdn, LDP, DFF, DFF}; pg8::StaticOrder S; S.init(T_TOK, DM, X.G, X.bid);
            pg8::EpiResid E{X.out, X.out};
            pg8::gemm_phase<pg8::EpiResid, true>(lds, g, S, E, X.tid);
        }
#if PROBE_DOUBLE
        if (ph2 + 1 < args.ph_hi * 2) cg::this_grid().sync();
#else
        if (ph + 1 < args.ph_hi) { if (ph == args.ph_lo) cg::this_grid().sync(); else xcd_barrier(gbar); }
#endif
    }
}

extern "C" void kernel_launch(void* const* d_in, const int* in_sizes, int n_in, void* d_out, int out_size, void* d_ws, size_t ws_size, hipStream_t stream) {
    static int grid = 0;
    if (grid == 0) {
        int dev = 0, cus = 0, per_cu = 0;
        (void)hipGetDevice(&dev);
        (void)hipDeviceGetAttribute(&cus, hipDeviceAttributeMultiprocessorCount, dev);
        if (hipFuncSetAttribute((const void*)mk_fwd, hipFuncAttributeMaxDynamicSharedMemorySize, LDS_BYTES) != hipSuccess) fprintf(stderr, "kernel_launch: hipFuncSetAttribute failed\n");
        if (hipOccupancyMaxActiveBlocksPerMultiprocessor(&per_cu, (const void*)mk_fwd, 512, LDS_BYTES) != hipSuccess || per_cu < 1) { fprintf(stderr, "kernel_launch: occupancy query gave %d\n", per_cu); per_cu = 1; }
        (void)hipGetLastError();
        grid = cus * 1;
        if (grid <= 0) grid = 256;
        if (ws_size < (size_t)268435456) fprintf(stderr, "kernel_launch: workspace too small (%zu)\n", ws_size);
    }
    Args a{};
    for (int i = 0; i < 24; ++i) a.in[i] = (const float*)d_in[i];
    a.out = (float*)d_out; a.ws = (unsigned char*)d_ws;
#if MK_SINGLE
    (void)hipMemsetAsync((char*)d_ws + WS_BAR, 0, 16384, stream);
    a.ph_lo = 0; a.ph_hi = 23;
    void* kargs[] = {&a};
    hipError_t e = hipLaunchCooperativeKernel((const void*)mk_fwd, dim3(grid), dim3(512), kargs, LDS_BYTES, stream);
    if (e != hipSuccess) fprintf(stderr, "cooperative launch failed: %s (grid %d)\n", hipGetErrorString(e), grid);
#else
    for (int ph = 0; ph < 23; ++ph) {
        a.ph_lo = ph; a.ph_hi = ph + 1;
        hipLaunchKernelGGL(mk_fwd, dim3(grid), dim3(512), LDS_BYTES, stream, a);
    }
#endif
}
```

```cpp
#include <hip/hip_runtime.h>
#include <hip/hip_cooperative_groups.h>
#include <cstdio>
#include <cstdint>
namespace cg = cooperative_groups;

#ifndef PHMASK
#define PHMASK 2047
#endif
#ifndef REPMASK
#define REPMASK 0
#endif
#ifndef PROBE_DOUBLE
#define PROBE_DOUBLE 0
#endif
#ifndef PROBE_SCAN2
#define PROBE_SCAN2 0
#endif
#ifndef TKMASK
#define TKMASK 7
#endif
#ifndef MK_SINGLE
#define MK_SINGLE 1
#endif

#define LAS __attribute__((address_space(3)))
typedef unsigned short bf16_t;
typedef short bf16x8 __attribute__((ext_vector_type(8)));
typedef float f32x4 __attribute__((ext_vector_type(4)));
typedef float f32x2 __attribute__((ext_vector_type(2)));
typedef unsigned u32x4 __attribute__((ext_vector_type(4)));
typedef unsigned u32x2 __attribute__((ext_vector_type(2)));

constexpr int T_TOK = 16384, SEQ = 2048, DM = 1024;
constexpr int LDP = 6144;
constexpr int COL_PA = 1024, COL_PB = 2816, COL_PC = 4864;
constexpr int COL_YA = 1024, COL_MRG = 1536, COL_G = 2816, COL_YB = 3840, COL_YC = 4864, COL_ACT = 1024;
constexpr int C_Q = 4864, C_K = 5376, C_QI = 5632, C_KI = 5888, C_WI = 5952;
constexpr int IN_COLS = 8004, DFF = 2816, F2 = 5632;
constexpr size_t WS_WIN = 0, WS_WG = 10485760, WS_WBR = 16777216, WS_WO = 19922944, WS_WUP = 22020096, WS_WDN = 33554432;
constexpr size_t WS_P = 41943040, WS_HALO = 243269632, WS_VT = WS_HALO, WS_ROPE = 266338304, WS_BAR = 266862592, WS_BND = WS_HALO + 4194304, WS_SCAL = WS_HALO + 8388608;
constexpr int LDS_BYTES = 153600;
constexpr int SCS = 2052;
constexpr int MASK_OFF = 16 * SCS * 4;

struct Args { const float* in[24]; float* out; unsigned char* ws; int ph_lo, ph_hi; };

__device__ __forceinline__ unsigned f2bf(float f) { unsigned u = __builtin_bit_cast(unsigned, f); return (u + 0x7fffu + ((u >> 16) & 1u)) >> 16; }
__device__ __forceinline__ unsigned pk2(float lo, float hi) { return f2bf(lo) | (f2bf(hi) << 16); }
__device__ __forceinline__ float bf2f(bf16_t b) { return __builtin_bit_cast(float, (unsigned)b << 16); }
__device__ __forceinline__ float bflo(unsigned w) { return __builtin_bit_cast(float, w << 16); }
__device__ __forceinline__ float bfhi(unsigned w) { return __builtin_bit_cast(float, w & 0xffff0000u); }
__device__ __forceinline__ float wave_sum(float v) {
#pragma unroll
    for (int o = 1; o < 64; o <<= 1) v += __shfl_xor(v, o);
    return v;
}
__device__ __forceinline__ int wave_sum_i(int v) {
#pragma unroll
    for (int o = 1; o < 64; o <<= 1) v += __shfl_xor(v, o);
    return v;
}
template <int CTRL> __device__ __forceinline__ float dpp_mov(float x) {
    return __builtin_bit_cast(float, __builtin_amdgcn_update_dpp(0, __builtin_bit_cast(int, x), CTRL, 0xF, 0xF, true));
}
__device__ __forceinline__ float red8(float x) { x += dpp_mov<0xB1>(x); x += dpp_mov<0x4E>(x); x += dpp_mov<0x141>(x); return x; }
__device__ __forceinline__ float red16(float x) { x = red8(x); x += dpp_mov<0x140>(x); return x; }
__device__ __forceinline__ float sigmoidf_(float x) { return 1.f / (1.f + __expf(-x)); }

namespace pg8 {
constexpr int BM = 256, BK = 64, HALF = 128, HTB = HALF * BK * 2, NXCD = 8, WGM = 8;
__device__ __forceinline__ int lds_byte(int r, int c) { const int st = (r >> 4) * 2 + (c >> 5), rr = r & 15, cc = c & 31, ob = rr * 64 + cc * 2; return st * 1024 + (ob ^ (((ob >> 9) & 1) << 5)); }
__device__ __forceinline__ void stage_rc(int b, int& R, int& C) { const int st = b / 1024, sb = b % 1024, swz = sb ^ (((sb >> 9) & 1) << 5); R = (st >> 1) * 16 + swz / 64; C = (st & 1) * 32 + (swz % 64) / 2; }
__device__ __forceinline__ int perm32(int rho) { const int n = rho >> 4, i = rho & 15; return 8 * (i >> 2) + 4 * n + (i & 3); }
struct Unit { int pm, pn; };
struct Gemm { const bf16_t* A; const bf16_t* Bt; int lda, ldb, K; };
struct StaticOrder {
    int nM, nN, nwg, G, c;
    __device__ void init(int M, int N, int G_, int c_) { nM = M / BM; nN = N / BM; nwg = nM * nN; G = G_; c = c_; }
    __device__ bool next(int i, Unit& u) const {
        const long L = (long)i * G + c; if (L >= nwg) return false;
        int wgid = (int)L; { const int q = nwg / NXCD, r = nwg % NXCD, xcd = wgid % NXCD, off = wgid / NXCD; wgid = (xcd < r ? xcd * (q + 1) : r * (q + 1) + (xcd - r) * q) + off; }
        const int nig = WGM * nN, gid = wgid / nig, fm = gid * WGM, gsz = (nM - fm) < WGM ? (nM - fm) : WGM;
        u.pm = fm + ((wgid % nig) % gsz); u.pn = (wgid % nig) / gsz; return true;
    }
};
__device__ __forceinline__ unsigned cvt_pk_bf16(float lo, float hi) { unsigned r; asm volatile("v_cvt_pk_bf16_f32 %0, %1, %2" : "=v"(r) : "v"(lo), "v"(hi)); return r; }

template <class Epi, bool ALIGN_EPI>
__device__ __forceinline__ void gemm_phase(LAS unsigned char* lds, const Gemm g, const StaticOrder& S, const Epi& E, const int tid) {
    const int wid = __builtin_amdgcn_readfirstlane(tid >> 6), lane = tid & 63, wr = wid >> 2, wc = wid & 3, fr = lane & 15, fq = lane >> 4;
    const int K = g.K, nt = K / BK;
    unsigned voffA[2], voffB[2];
#pragma unroll
    for (int i = 0; i < 2; ++i) { int R, C; stage_rc(tid * 16 + i * 8192, R, C); const int Rb = (R & ~31) + perm32(R & 31);
        voffA[i] = (unsigned)(R * g.lda + C) * 2u; voffB[i] = (unsigned)(Rb * g.ldb + C) * 2u; }
    const size_t kstep = (size_t)(BK * 2);
    const size_t hstepA = (size_t)HALF * g.lda * 2, hstepB = (size_t)HALF * g.ldb * 2;
    const size_t tstepA = 2 * hstepA, tstepB = 2 * hstepB;
    const unsigned ldsw = (unsigned)wid * 1024u;
    const int aoff = lds_byte(wr * 64 + fr, fq * 8), boff = lds_byte(wc * 32 + fr, fq * 8);
#define PG8_SA(b, h) (((b) * 2 + (h)) * HTB)
#define PG8_SB(b, h) ((4 + (b) * 2 + (h)) * HTB)
#define PG8_STAGE(bufoff, gbase, voff) do { _Pragma("unroll") for (int _i = 0; _i < 2; ++_i) \
        __builtin_amdgcn_global_load_lds((const unsigned*)((const char*)(gbase) + (voff)[_i]), (LAS unsigned*)(lds + (bufoff) + ldsw + _i * 8192), 16, 0, 0); } while (0)
#define PG8_LDA(dst, b, h) do { _Pragma("unroll") for (int m = 0; m < 4; ++m) _Pragma("unroll") for (int k = 0; k < 2; ++k) dst[m][k] = *(const LAS bf16x8*)(lds + PG8_SA(b, h) + aoff + m * 2048 + k * 1024); } while (0)
#define PG8_LDB(dst, b, h) do { _Pragma("unroll") for (int n = 0; n < 2; ++n) _Pragma("unroll") for (int k = 0; k < 2; ++k) dst[n][k] = *(const LAS bf16x8*)(lds + PG8_SB(b, h) + boff + n * 2048 + k * 1024); } while (0)
#define PG8_MMA(ai, bj, At, Bt) do { __builtin_amdgcn_s_setprio(1); _Pragma("unroll") for (int m = 0; m < 4; ++m) _Pragma("unroll") for (int n = 0; n < 2; ++n) _Pragma("unroll") for (int k = 0; k < 2; ++k) \
        acc[ai][bj][m][n] = __builtin_amdgcn_mfma_f32_16x16x32_bf16(Bt[n][k], At[m][k], acc[ai][bj][m][n], 0, 0, 0); __builtin_amdgcn_s_setprio(0); } while (0)
#define PG8_WAIT_V(n) asm volatile("s_waitcnt vmcnt(" #n ")" ::: "memory")
#define PG8_WAIT_L(n) asm volatile("s_waitcnt lgkmcnt(" #n ")" ::: "memory")
#define PG8_BAR __builtin_amdgcn_s_barrier()
#define PG8_SCHED __builtin_amdgcn_sched_barrier(0)
    Unit cur, nxt; int ui = 0;
    if (!S.next(0, cur)) return;
    f32x4 acc[2][2][4][2];
#pragma unroll
    for (int a = 0; a < 2; ++a)
#pragma unroll
        for (int b = 0; b < 2; ++b)
#pragma unroll
            for (int m = 0; m < 4; ++m)
#pragma unroll
                for (int n = 0; n < 2; ++n) acc[a][b][m][n] = (f32x4){0.f, 0.f, 0.f, 0.f};
    bf16x8 At[4][2], B0[2][2], B1[2][2];
    const char* cA = (const char*)g.A + (size_t)cur.pm * tstepA; const char* cB = (const char*)g.Bt + (size_t)cur.pn * tstepB;
    PG8_STAGE(PG8_SB(0, 0), cB, voffB); PG8_STAGE(PG8_SB(0, 1), cB + hstepB, voffB); PG8_STAGE(PG8_SA(0, 0), cA, voffA); PG8_STAGE(PG8_SA(0, 1), cA + hstepA, voffA);
    if (wr == 1) PG8_BAR;
    PG8_WAIT_V(2); PG8_BAR;
    PG8_STAGE(PG8_SB(1, 0), cB + kstep, voffB); PG8_STAGE(PG8_SA(1, 0), cA + kstep, voffA); PG8_STAGE(PG8_SB(1, 1), cB + hstepB + kstep, voffB);
    PG8_WAIT_V(6); PG8_BAR;
    for (;;) {
        const bool has_next = S.next(ui + 1, nxt);
        const char* nA = has_next ? (const char*)g.A + (size_t)nxt.pm * tstepA : cA; const char* nB = has_next ? (const char*)g.Bt + (size_t)nxt.pn * tstepB : cB;
        for (int t = 0; t < nt; t += 2) {
            const bool last = (t == nt - 2);
            const char* a1 = cA + (size_t)(t + 1) * kstep;
            const char* a2 = last ? nA : cA + (size_t)(t + 2) * kstep; const char* b2 = last ? nB : cB + (size_t)(t + 2) * kstep;
            const char* a3 = a2 + kstep; const char* b3 = b2 + kstep;
            PG8_LDB(B0, 0, 0); PG8_LDB(B1, 0, 1); PG8_SCHED; PG8_LDA(At, 0, 0); PG8_STAGE(PG8_SA(1, 1), a1 + hstepA, voffA);
            PG8_WAIT_V(8); PG8_WAIT_L(0); PG8_BAR; PG8_MMA(0, 0, At, B0); PG8_MMA(0, 1, At, B1); PG8_BAR; PG8_SCHED;
            PG8_LDA(At, 0, 1); PG8_STAGE(PG8_SB(0, 0), b2, voffB); PG8_STAGE(PG8_SB(0, 1), b2 + hstepB, voffB); PG8_STAGE(PG8_SA(0, 0), a2, voffA);
            PG8_WAIT_V(8); PG8_WAIT_L(0); PG8_BAR; PG8_MMA(1, 0, At, B0); PG8_MMA(1, 1, At, B1); PG8_BAR; PG8_SCHED;
            PG8_LDB(B0, 1, 0); PG8_LDB(B1, 1, 1); PG8_SCHED; PG8_LDA(At, 1, 0); PG8_STAGE(PG8_SA(0, 1), a2 + hstepA, voffA);
            PG8_WAIT_V(8); PG8_WAIT_L(0); PG8_BAR; PG8_MMA(0, 0, At, B0); PG8_MMA(0, 1, At, B1); PG8_BAR; PG8_SCHED;
            PG8_LDA(At, 1, 1); PG8_STAGE(PG8_SB(1, 0), b3, voffB); PG8_STAGE(PG8_SB(1, 1), b3 + hstepB, voffB); PG8_STAGE(PG8_SA(1, 0), a3, voffA);
            PG8_WAIT_V(8); PG8_WAIT_L(0); PG8_BAR; PG8_MMA(1, 0, At, B0); PG8_MMA(1, 1, At, B1); PG8_BAR; PG8_SCHED;
        }
        if constexpr (ALIGN_EPI) { if (wr == 0) PG8_BAR; }
        E(acc, cur, wr, wc, fr, fq);
        if (!has_next) break;
#pragma unroll
        for (int a = 0; a < 2; ++a)
#pragma unroll
            for (int b = 0; b < 2; ++b)
#pragma unroll
                for (int m = 0; m < 4; ++m)
#pragma unroll
                    for (int n = 0; n < 2; ++n) acc[a][b][m][n] = (f32x4){0.f, 0.f, 0.f, 0.f};
        cur = nxt; cA = nA; cB = nB; ++ui;
        if constexpr (ALIGN_EPI) { if (wr == 1) PG8_BAR; }
    }
    PG8_WAIT_V(0);
    if constexpr (!ALIGN_EPI) { if (wr == 0) PG8_BAR; }
    PG8_BAR;
#undef PG8_SA
#undef PG8_SB
#undef PG8_STAGE
#undef PG8_LDA
#undef PG8_LDB
#undef PG8_MMA
#undef PG8_WAIT_V
#undef PG8_WAIT_L
#undef PG8_BAR
#undef PG8_SCHED
}

typedef f32x4 AccT[2][2][4][2];

struct EpiInProj {
    bf16_t* P; bf16_t* VT; const float* rope; bf16_t* BND;
    __device__ __forceinline__ void operator()(AccT& acc, const Unit& u, int wr, int wc, int fr, int fq) const {
        const int row0 = u.pm * BM + wr * 64 + fr, colb = u.pn * BM + wc * 32 + 8 * fq;
#pragma unroll
        for (int ai = 0; ai < 2; ++ai)
#pragma unroll
            for (int m = 0; m < 4; ++m) {
                const int row = row0 + ai * HALF + m * 16, t = row & (SEQ - 1);
                bf16_t* rowp = P + (size_t)row * LDP + COL_PA;
#pragma unroll
                for (int bj = 0; bj < 2; ++bj) {
                    const int c = colb + bj * HALF;
                    f32x4 v0 = acc[ai][bj][m][0], v1 = acc[ai][bj][m][1];
                    if (u.pn >= 15) {
                        const int cl = c - 3840;
                        if (cl < 640 || (cl >= 768 && cl < 1088)) {
                            const float* cs = rope + ((size_t)t * 32 + ((cl & 63) >> 1)) * 2;
                            const f32x4 r0 = *(const f32x4*)cs, r1 = *(const f32x4*)(cs + 4);
                            f32x4 o0, o1;
                            o0[0] = v0[0] * r0[0] - v0[1] * r0[1]; o0[1] = v0[1] * r0[0] + v0[0] * r0[1];
                            o0[2] = v0[2] * r0[2] - v0[3] * r0[3]; o0[3] = v0[3] * r0[2] + v0[2] * r0[3];
                            o1[0] = v1[0] * r1[0] - v1[1] * r1[1]; o1[1] = v1[1] * r1[0] + v1[0] * r1[1];
                            o1[2] = v1[2] * r1[2] - v1[3] * r1[3]; o1[3] = v1[3] * r1[2] + v1[2] * r1[3];
                            v0 = o0; v1 = o1;
                        }
                    }
                    u32x4 w; w.x = cvt_pk_bf16(v0[0], v0[1]); w.y = cvt_pk_bf16(v0[2], v0[3]); w.z = cvt_pk_bf16(v1[0], v1[1]); w.w = cvt_pk_bf16(v1[2], v1[3]);
                    *(u32x4*)(rowp + c) = w;
                    if (u.pn < 7 && fr == 15) *(u32x4*)(BND + (size_t)(row >> 4) * 1792 + c) = w;
                    if (u.pn == 17 && bj == 1) {
                        const int cv = c - 3840 - 640, b = row >> 11;
                        bf16_t* vt = VT + ((size_t)(b * 2 + (cv >> 6)) * 64 + (cv & 63)) * SEQ + t;
                        vt[0 * SEQ] = (bf16_t)(w.x & 0xffffu); vt[1 * SEQ] = (bf16_t)(w.x >> 16);
                        vt[2 * SEQ] = (bf16_t)(w.y & 0xffffu); vt[3 * SEQ] = (bf16_t)(w.y >> 16);
                        vt[4 * SEQ] = (bf16_t)(w.z & 0xffffu); vt[5 * SEQ] = (bf16_t)(w.z >> 16);
                        vt[6 * SEQ] = (bf16_t)(w.w & 0xffffu); vt[7 * SEQ] = (bf16_t)(w.w >> 16);
                    }
                }
            }
    }
};
struct EpiGate {
    bf16_t* P;
    __device__ __forceinline__ void operator()(AccT& acc, const Unit& u, int wr, int wc, int fr, int fq) const {
        const int row0 = u.pm * BM + wr * 64 + fr, colb = u.pn * BM + wc * 32 + 8 * fq;
#pragma unroll
        for (int ai = 0; ai < 2; ++ai)
#pragma unroll
            for (int m = 0; m < 4; ++m) {
                bf16_t* rowp = P + (size_t)(row0 + ai * HALF + m * 16) * LDP + COL_G + colb;
#pragma unroll
                for (int bj = 0; bj < 2; ++bj) {
                    const f32x4 v0 = acc[ai][bj][m][0], v1 = acc[ai][bj][m][1];
                    u32x4 w; w.x = cvt_pk_bf16(sigmoidf_(v0[0]), sigmoidf_(v0[1])); w.y = cvt_pk_bf16(sigmoidf_(v0[2]), sigmoidf_(v0[3]));
                    w.z = cvt_pk_bf16(sigmoidf_(v1[0]), sigmoidf_(v1[1])); w.w = cvt_pk_bf16(sigmoidf_(v1[2]), sigmoidf_(v1[3]));
                    *(u32x4*)(rowp + bj * HALF) = w;
                }
            }
    }
};
struct EpiMergeAcc {
    bf16_t* P; int first;
    __device__ __forceinline__ void operator()(AccT& acc, const Unit& u, int wr, int wc, int fr, int fq) const {
        const int row0 = u.pm * BM + wr * 64 + fr, colb = u.pn * BM + wc * 32 + 8 * fq;
#pragma unroll
        for (int ai = 0; ai < 2; ++ai)
#pragma unroll
            for (int m = 0; m < 4; ++m) {
                bf16_t* rowb = P + (size_t)(row0 + ai * HALF + m * 16) * LDP + colb;
#pragma unroll
                for (int bj = 0; bj < 2; ++bj) {
                    const f32x4 v0 = acc[ai][bj][m][0], v1 = acc[ai][bj][m][1];
                    unsigned long long* gp = (unsigned long long*)(rowb + COL_G + bj * HALF);
                    unsigned long long* mp = (unsigned long long*)(rowb + COL_MRG + bj * HALF);
                    const unsigned long long g0 = __hip_atomic_load(gp, __ATOMIC_RELAXED, __HIP_MEMORY_SCOPE_AGENT), g1 = __hip_atomic_load(gp + 1, __ATOMIC_RELAXED, __HIP_MEMORY_SCOPE_AGENT);
                    unsigned long long m0 = 0ull, m1 = 0ull;
                    if (!first) { m0 = __hip_atomic_load(mp, __ATOMIC_RELAXED, __HIP_MEMORY_SCOPE_AGENT); m1 = __hip_atomic_load(mp + 1, __ATOMIC_RELAXED, __HIP_MEMORY_SCOPE_AGENT); }
                    const unsigned ga = (unsigned)g0, gb = (unsigned)(g0 >> 32), gc = (unsigned)g1, gd = (unsigned)(g1 >> 32);
                    const unsigned ma = (unsigned)m0, mb = (unsigned)(m0 >> 32), mc = (unsigned)m1, md = (unsigned)(m1 >> 32);
                    u32x4 w;
                    w.x = cvt_pk_bf16(bflo(ma) + bflo(ga) * v0[0], bfhi(ma) + bfhi(ga) * v0[1]);
                    w.y = cvt_pk_bf16(bflo(mb) + bflo(gb) * v0[2], bfhi(mb) + bfhi(gb) * v0[3]);
                    w.z = cvt_pk_bf16(bflo(mc) + bflo(gc) * v1[0], bfhi(mc) + bfhi(gc) * v1[1]);
                    w.w = cvt_pk_bf16(bflo(md) + bflo(gd) * v1[2], bfhi(md) + bfhi(gd) * v1[3]);
                    *(u32x4*)(rowb + COL_MRG + bj * HALF) = w;
                }
            }
    }
};
struct EpiResid {
    const float* base; float* out;
    __device__ __forceinline__ void operator()(AccT& acc, const Unit& u, int wr, int wc, int fr, int fq) const {
        const int row0 = u.pm * BM + wr * 64 + fr, colb = u.pn * BM + wc * 32 + 8 * fq;
#pragma unroll
        for (int ai = 0; ai < 2; ++ai)
#pragma unroll
            for (int m = 0; m < 4; ++m) {
                const size_t off = (size_t)(row0 + ai * HALF + m * 16) * DM + colb;
#pragma unroll
                for (int bj = 0; bj < 2; ++bj) {
                    const f32x4 b0 = *(const f32x4*)(base + off + bj * HALF), b1 = *(const f32x4*)(base + off + bj * HALF + 4);
                    *(f32x4*)(out + off + bj * HALF) = b0 + acc[ai][bj][m][0];
                    *(f32x4*)(out + off + bj * HALF + 4) = b1 + acc[ai][bj][m][1];
                }
            }
    }
};
struct EpiUp {
    bf16_t* P; float* HALO; const float* cw; const float* cb;
    __device__ __forceinline__ void operator()(AccT& acc, const Unit& u, int wr, int wc, int fr_in, int fq_in) const {
        int fr = fr_in, fq = fq_in;
        asm volatile("" : "+v"(fr), "+v"(fq));
        const int row0 = u.pm * BM + wr * 64 + fr;
        const int jb = u.pn * 128 + wc * 32 + 8 * fq;
#pragma unroll
        for (int ai = 0; ai < 2; ++ai) {
            const int s = u.pm * 4 + ai * 2 + wr;
#pragma unroll
            for (int bj = 0; bj < 2; ++bj)
#pragma unroll
                for (int n = 0; n < 2; ++n) {
                    const int colp = u.pn * BM + bj * HALF + wc * 32 + 8 * fq + 4 * n;
                    if (fr < 2) *(f32x4*)(HALO + (size_t)(s * 4 + fr) * F2 + colp) = acc[ai][bj][0][n];
                    if (fr >= 14) *(f32x4*)(HALO + (size_t)(s * 4 + fr - 12) * F2 + colp) = acc[ai][bj][3][n];
                }
        }
#pragma unroll
        for (int ai = 0; ai < 2; ++ai)
#pragma unroll
            for (int m = 0; m < 4; ++m) {
                const int row = row0 + ai * HALF + m * 16;
#pragma unroll
                for (int n = 0; n < 2; ++n) {
                    f32x4 cv[2];
                    asm volatile("" ::: "memory");
#pragma unroll
                    for (int bj = 0; bj < 2; ++bj) {
                        const int co = bj * DFF + jb + 4 * n;
                        const f32x4 w0 = *(const f32x4*)(cw + co), w1 = *(const f32x4*)(cw + F2 + co), w2 = *(const f32x4*)(cw + 2 * F2 + co), bb = *(const f32x4*)(cb + co);
#pragma unroll
                        for (int e = 0; e < 4; ++e) {
                            const float cur = acc[ai][bj][m][n][e];
                            const float prv = m > 0 ? acc[ai][bj][m > 0 ? m - 1 : 0][n][e] : 0.f;
                            const float a1 = dpp_mov<0x121>(cur), a2 = dpp_mov<0x122>(cur), b1 = dpp_mov<0x121>(prv), b2 = dpp_mov<0x122>(prv);
                            const float p1 = fr >= 1 ? a1 : b1, p2 = fr >= 2 ? a2 : b2;
                            cv[bj][e] = bb[e] + w0[e] * p2 + w1[e] * p1 + w2[e] * cur;
                        }
                        __builtin_amdgcn_sched_barrier(0);
                    }
                    const f32x4 g0 = cv[0], v0 = cv[1];
                    u32x2 w;
                    w.x = cvt_pk_bf16(g0[0] * sigmoidf_(g0[0]) * v0[0], g0[1] * sigmoidf_(g0[1]) * v0[1]);
                    w.y = cvt_pk_bf16(g0[2] * sigmoidf_(g0[2]) * v0[2], g0[3] * sigmoidf_(g0[3]) * v0[3]);
                    if (!(m == 0 && fr < 2)) *(u32x2*)(P + (size_t)row * LDP + COL_ACT + jb + 4 * n) = w;
                    __builtin_amdgcn_sched_barrier(0);
                }
            }
    }
};
}

struct Ctx {
    const float* in[24]; float* out; unsigned char* ws;
    bf16_t* P; bf16_t* VT; float* HALO; float* ROPE;
    bf16_t *Win, *Wg, *Wbr, *Wo, *Wup, *Wdn;
    int tid, lane, wave, G, bid;
};

__device__ __forceinline__ int srccol(int mode, int n) {
    if (mode == 0) return n;
    if (mode == 2) return 4932 + n;
    if (mode == 3) { const int tile = n >> 8, w = n & 255, j = tile * 128 + (w & 127); return (w < 128) ? j : DFF + j; }
    if (n < 3840) return n;
    const int c = n - 3840;
    if (c >= 1092) return -1;
    if (c < 640 || (c >= 768 && c < 1088)) { const int base = c & ~63, i = c & 63; return 3840 + base + (i >> 1) + 32 * (i & 1); }
    return 3840 + c;
}
__device__ __forceinline__ void tr_item(const float* W, int ldw, int K, int N, bf16_t* WT, int mode, int item, LAS float* scr, int lane) {
    const int nblk = N / 32, kb = item / nblk, nb = item % nblk, k0 = 64 * kb, n0 = 32 * nb;
    const int sc = srccol(mode, n0 + (lane & 31));
#pragma unroll 8
    for (int i = 0; i < 32; ++i) { const int kk = 2 * i + (lane >> 5); scr[kk * 33 + (lane & 31)] = (sc >= 0) ? W[(size_t)(k0 + kk) * ldw + sc] : 0.f; }
    asm volatile("s_waitcnt lgkmcnt(0)" ::: "memory");
    const int c = lane & 7;
#pragma unroll
    for (int j = 0; j < 4; ++j) { const int n = (lane >> 3) + 8 * j; const LAS float* s = scr + (8 * c) * 33 + n;
        u32x4 o; o.x = pk2(s[0 * 33], s[1 * 33]); o.y = pk2(s[2 * 33], s[3 * 33]); o.z = pk2(s[4 * 33], s[5 * 33]); o.w = pk2(s[6 * 33], s[7 * 33]);
        *(u32x4*)(WT + (size_t)(n0 + n) * K + k0 + 8 * c) = o; }
    asm volatile("s_waitcnt lgkmcnt(0)" ::: "memory");
}
__device__ __forceinline__ void rms_row(const float* xrow, const float* g, bf16_t* obf, float* of32, int lane) {
    const f32x4* xr = (const f32x4*)xrow + lane; const f32x4* gr = (const f32x4*)g + lane;
    f32x4 v[4]; float s = 0.f;
#pragma unroll
    for (int j = 0; j < 4; ++j) { v[j] = xr[64 * j]; s += (v[j].x * v[j].x + v[j].y * v[j].y) + (v[j].z * v[j].z + v[j].w * v[j].w); }
    const float rs = 1.f / sqrtf(wave_sum(s) * (1.f / DM) + 1e-6f);
#pragma unroll
    for (int j = 0; j < 4; ++j) {
        const f32x4 gg = gr[64 * j]; const f32x4 o = v[j] * rs * gg;
        if (obf) { u32x2 w; w.x = pk2(o.x, o.y); w.y = pk2(o.z, o.w); *((u32x2*)obf + lane + 64 * j) = w; }
        else *((f32x4*)of32 + lane + 64 * j) = o;
    }
}
__device__ __forceinline__ void phase_prep(const Ctx& X, LAS unsigned char* lds, int layer) {
    LAS float* scr = (LAS float*)(lds + X.wave * 8448);
    const int gw = X.bid * 8 + X.wave, NGW = X.G * 8;
    constexpr int I_IN = 16 * 160, I_G = 16 * 96, I_BR = 8 * 32, I_O = 16 * 32, I_UP = 16 * 176, I_DN = 44 * 32;
    constexpr int NITEMS = I_IN + I_G + 3 * I_BR + I_O + I_UP + I_DN;
    const float* w_in = X.in[2] + (size_t)layer * DM * IN_COLS;
    const float* w_br = X.in[16] + (size_t)layer * 3 * 512 * DM;
    const float* w_o = X.in[17] + (size_t)layer * DM * DM;
    const float* w_up = X.in[19] + (size_t)layer * DM * F2;
    const float* w_dn = X.in[22] + (size_t)layer * DFF * DM;
    for (int it = gw; it < NITEMS; it += NGW) {
        int r = it;
        if (r < I_IN) { tr_item(w_in, IN_COLS, DM, 5120, X.Win, 1, r, scr, X.lane); continue; } r -= I_IN;
        if (r < I_G) { tr_item(w_in, IN_COLS, DM, 3072, X.Wg, 2, r, scr, X.lane); continue; } r -= I_G;
        if (r < 3 * I_BR) { const int b = r / I_BR; tr_item(w_br + (size_t)b * 512 * DM, DM, 512, DM, X.Wbr + (size_t)b * DM * 512, 0, r % I_BR, scr, X.lane); continue; } r -= 3 * I_BR;
        if (r < I_O) { tr_item(w_o, DM, DM, DM, X.Wo, 0, r, scr, X.lane); continue; } r -= I_O;
        if (r < I_UP) { tr_item(w_up, F2, DM, F2, X.Wup, 3, r, scr, X.lane); continue; } r -= I_UP;
        tr_item(w_dn, DM, DFF, DM, X.Wdn, 0, r, scr, X.lane);
    }
    const float* h = (layer == 0) ? X.in[0] : X.out;
    const float* g = X.in[1] + (size_t)layer * DM;
    for (int m = gw; m < T_TOK; m += NGW) rms_row(h + (size_t)m * DM, g, X.P + (size_t)m * LDP, nullptr, X.lane);
    if (layer == 0) {
        for (int idx = X.bid * 512 + X.tid; idx < SEQ * 32; idx += X.G * 512) {
            const int t = idx >> 5, p = idx & 31;
            const float inv = exp2f(-(float)p * 0.03125f * 13.287712379549449f);
            const float ang = (float)t * inv;
            const double rev = (double)ang * 0.15915494309189535;
            const float fr = (float)(rev - floor(rev));
            X.ROPE[2 * idx] = __builtin_amdgcn_cosf(fr); X.ROPE[2 * idx + 1] = __builtin_amdgcn_sinf(fr);
        }
    }
}

__device__ __forceinline__ float wave_sum_fast(float x) {
    x = red16(x);
    const float r0 = __builtin_bit_cast(float, __builtin_amdgcn_readlane(__builtin_bit_cast(int, x), 0)), r1 = __builtin_bit_cast(float, __builtin_amdgcn_readlane(__builtin_bit_cast(int, x), 16));
    const float r2 = __builtin_bit_cast(float, __builtin_amdgcn_readlane(__builtin_bit_cast(int, x), 32)), r3 = __builtin_bit_cast(float, __builtin_amdgcn_readlane(__builtin_bit_cast(int, x), 48));
    return (r0 + r1) + (r2 + r3);
}
#define LDS_BAR() do { asm volatile("s_waitcnt lgkmcnt(0)" ::: "memory"); __builtin_amdgcn_s_barrier(); asm volatile("" ::: "memory"); } while (0)
constexpr int RW_TS = 16, RW_NCH = SEQ / RW_TS, RW_BUF = 33280;
__device__ __forceinline__ void phase_rwkv_pre(const Ctx& X, LAS unsigned char* lds, int layer) {
    LAS float* Rr = (LAS float*)(lds);           LAS float* Kk = (LAS float*)(lds + 4096);   LAS float* Vv = (LAS float*)(lds + 8192);
    LAS float* W1 = (LAS float*)(lds + 12288);   LAS float* AS = (LAS float*)(lds + 16384);
    LAS bf16_t* WDb = (LAS bf16_t*)(lds + 20480);
    LAS bf16_t* ADb = (LAS bf16_t*)(lds + 22784);
    LAS bf16_t* WTu = (LAS bf16_t*)(lds + 25088);
    LAS bf16_t* WTa = (LAS bf16_t*)(lds + 34304);
    LAS float* MU = (LAS float*)(lds + 43520);
    const int tid = X.tid, lane = tid & 63, wv = X.wave;
    const float* mu = X.in[3] + layer * 1792;
    const float* w0 = X.in[4] + layer * 512;   const float* w_up = X.in[5] + (size_t)layer * 64 * 512;
    const float* a0 = X.in[6] + layer * 512;   const float* a_up = X.in[7] + (size_t)layer * 64 * 512;
    const float* k_k = X.in[9] + layer * 512;  const float* k_a = X.in[10] + layer * 512;  const float* r_k = X.in[11] + layer * 512;
    const bf16_t* BND = (const bf16_t*)(X.ws + WS_BND);
    float* SCAL = (float*)(X.ws + WS_SCAL);
    const int ln = lane & 15, lg = lane >> 4;
    int last_h = -1;
    float p_kk = 0.f, p_ka = 0.f, p_rk = 0.f, q_w0 = 0.f, q_a0 = 0.f;
    const int c = tid & 63, tg = tid >> 6;
    u32x4 pc4[2], pp4[2]; bool have_pf = false;
    pc4[0] = pc4[1] = pp4[0] = pp4[1] = (u32x4){0u, 0u, 0u, 0u};
#define PRE_LOAD(uu) do { const int h_ = (uu) & 7, tile_ = (uu) >> 3; _Pragma("unroll") for (int it = 0; it < 2; ++it) { const int idx = tid + 512 * it; pc4[it] = (u32x4){0u, 0u, 0u, 0u}; pp4[it] = (u32x4){0u, 0u, 0u, 0u}; \
        if (idx < 16 * 40) { const int tt = idx / 40, vv = idx - tt * 40; \
            const int col = vv < 8 ? h_ * 64 + 8 * vv : (vv < 16 ? 512 + h_ * 64 + 8 * (vv - 8) : (vv < 24 ? 1024 + h_ * 64 + 8 * (vv - 16) : 1536 + 8 * (vv - 24))); \
            const size_t row = (size_t)tile_ * 16 + tt; pc4[it] = *(const u32x4*)(X.P + row * LDP + COL_PA + col); \
            if (tt > 0) pp4[it] = *(const u32x4*)(X.P + (row - 1) * LDP + COL_PA + col); else if ((tile_ & 127) != 0) pp4[it] = *(const u32x4*)(BND + (size_t)(tile_ - 1) * 1792 + col); } } } while (0)
#pragma unroll 1
    for (int u = X.bid; u < 8192; u += X.G) {
        const int h = u & 7, tile = u >> 3, hc = h * 64 + c;
        if (h != last_h) {
            __syncthreads();
            for (int idx = tid; idx < 64 * 64; idx += 512) { const int m = idx >> 6, cc = idx & 63;
                WTu[cc * 72 + m] = (bf16_t)f2bf(w_up[m * 512 + h * 64 + cc]); WTa[cc * 72 + m] = (bf16_t)f2bf(a_up[m * 512 + h * 64 + cc]); }
            if (tid < 320) { const int cc = tid; const int col = cc < 64 ? h * 64 + cc : (cc < 128 ? 512 + h * 64 + cc - 64 : (cc < 192 ? 1024 + h * 64 + cc - 128 : 1536 + cc - 192)); MU[cc] = mu[col]; }
            p_kk = k_k[hc]; p_ka = k_a[hc]; p_rk = r_k[hc];
            q_w0 = w0[h * 64 + 16 * (wv & 3) + ln]; q_a0 = a0[h * 64 + 16 * (wv & 3) + ln];
            last_h = h;
            __syncthreads();
        }
        if (!have_pf) { PRE_LOAD(u); }
#pragma unroll
        for (int it = 0; it < 2; ++it) {
            const int idx = tid + 512 * it;
            if (idx < 16 * 40) {
                const int tt = idx / 40, vv = idx - tt * 40, cc0 = 8 * vv;
                const u32x4 c4 = pc4[it], p4 = pp4[it];
                const f32x4 m0 = *(const LAS f32x4*)&MU[cc0], m1 = *(const LAS f32x4*)&MU[cc0 + 4];
                float cur[8], prv[8], val[8];
                cur[0] = bflo(c4.x); cur[1] = bfhi(c4.x); cur[2] = bflo(c4.y); cur[3] = bfhi(c4.y); cur[4] = bflo(c4.z); cur[5] = bfhi(c4.z); cur[6] = bflo(c4.w); cur[7] = bfhi(c4.w);
                prv[0] = bflo(p4.x); prv[1] = bfhi(p4.x); prv[2] = bflo(p4.y); prv[3] = bfhi(p4.y); prv[4] = bflo(p4.z); prv[5] = bfhi(p4.z); prv[6] = bflo(p4.w); prv[7] = bfhi(p4.w);
#pragma unroll
                for (int e = 0; e < 8; ++e) val[e] = cur[e] + (prv[e] - cur[e]) * (e < 4 ? m0[e & 3] : m1[e & 3]);
                if (vv < 24) {
#pragma unroll
                    for (int e = 0; e < 8; ++e) val[e] = bf2f((bf16_t)f2bf(val[e]));
                    LAS float* dst = (vv < 8 ? Rr : (vv < 16 ? Kk : Vv)) + tt * 64 + 8 * (vv & 7);
                    *(LAS f32x4*)dst = (f32x4){val[0], val[1], val[2], val[3]}; *(LAS f32x4*)(dst + 4) = (f32x4){val[4], val[5], val[6], val[7]};
                } else {
                    const int lr0 = 8 * (vv - 24);
                    LAS bf16_t* dst;
                    if (lr0 < 64) { dst = WDb + tt * 72 + lr0;
#pragma unroll
                        for (int e = 0; e < 8; ++e) { const float ex = __expf(2.f * val[e]); val[e] = 1.f - 2.f / (ex + 1.f); } }
                    else dst = ADb + tt * 72 + lr0 - 64;
                    u32x4 o; o.x = pk2(val[0], val[1]); o.y = pk2(val[2], val[3]); o.z = pk2(val[4], val[5]); o.w = pk2(val[6], val[7]);
                    *(LAS u32x4*)dst = o;
                }
            }
        }
        have_pf = false;
        if (u + X.G < 8192 && ((u + X.G) & 7) == h) { PRE_LOAD(u + X.G); have_pf = true; }
        LDS_BAR();
        if (wv < 4) {
            const int nt = wv, chm = 16 * nt + ln;
            f32x4 cw_ = (f32x4){0.f, 0.f, 0.f, 0.f}, ca_ = cw_;
#pragma unroll
            for (int ks = 0; ks < 2; ++ks) {
                const bf16x8 xa = *(const LAS bf16x8*)&WDb[ln * 72 + ks * 32 + 8 * lg], xb = *(const LAS bf16x8*)&WTu[(16 * nt + ln) * 72 + ks * 32 + 8 * lg];
                cw_ = __builtin_amdgcn_mfma_f32_16x16x32_bf16(xa, xb, cw_, 0, 0, 0);
                const bf16x8 ya = *(const LAS bf16x8*)&ADb[ln * 72 + ks * 32 + 8 * lg], yb = *(const LAS bf16x8*)&WTa[(16 * nt + ln) * 72 + ks * 32 + 8 * lg];
                ca_ = __builtin_amdgcn_mfma_f32_16x16x32_bf16(ya, yb, ca_, 0, 0, 0);
            }
#pragma unroll
            for (int r = 0; r < 4; ++r) {
                const int tt = 4 * lg + r;
                const float z = -(q_w0 + cw_[r]);
                const float sp = fmaxf(z, 0.f) + __logf(1.f + __expf(-fabsf(z)));
                const float e = __expf(-sp - 0.5f);
                W1[tt * 64 + chm] = bf2f((bf16_t)f2bf(-expm1f(-e)));
                AS[tt * 64 + chm] = bf2f((bf16_t)f2bf(sigmoidf_(q_a0 + ca_[r])));
            }
        }
        LDS_BAR();
#pragma unroll
        for (int q = 0; q < 2; ++q) {
            const int tt = 2 * tg + q;
            const size_t row = (size_t)tile * 16 + tt;
            const float w1 = W1[tt * 64 + c], a = AS[tt * 64 + c];
            const float kraw = Kk[tt * 64 + c], r = Rr[tt * 64 + c], v = Vv[tt * 64 + c];
            const float kk0 = kraw * p_kk;
            const float inv = 1.f / sqrtf(fmaxf(wave_sum_fast(kk0 * kk0), 1e-24f));
            const float kk = kk0 * inv;
            const float kmod = kraw * (1.f + (a - 1.f) * p_ka);
            const float bvec = kk * a;
            const float br = wave_sum_fast(bvec * r), kr = wave_sum_fast(kmod * r), bonus = wave_sum_fast(r * kmod * p_rk);
            bf16_t* rp_ = X.P + row * LDP;
            rp_[COL_PA + hc] = (bf16_t)f2bf(r); rp_[COL_PA + 512 + hc] = (bf16_t)f2bf(kraw); rp_[COL_PA + 1024 + hc] = (bf16_t)f2bf(v);
            rp_[hc] = (bf16_t)f2bf(w1); rp_[512 + hc] = (bf16_t)f2bf(a);
            if (c == 0) *(f32x4*)(SCAL + (row * 8 + h) * 4) = (f32x4){inv, br, kr, bonus};
        }
        LDS_BAR();
    }
}

__device__ __forceinline__ void rwkv_task(const Ctx& X, LAS unsigned char* lds, int layer, int b, int h) {
    LAS bf16_t* GDb = (LAS bf16_t*)(lds + 66560);
    LAS bf16_t* WTg = (LAS bf16_t*)(lds + 70912);
    LAS float* BON = (LAS float*)(lds + 88320);
    const int tid = X.tid, lane = tid & 63;
    const bool helper = X.wave >= 4;
    const int ht = tid & 255;
    const float* mu = X.in[3] + layer * 1792;
    const float* g_up = X.in[8] + (size_t)layer * 128 * 512;
    const float* k_k = X.in[9] + layer * 512;  const float* k_a = X.in[10] + layer * 512;
    const float* gn_g = X.in[12] + layer * 512; const float* gn_b = X.in[13] + layer * 512;
    const float* SCAL = (const float*)(X.ws + WS_SCAL);
    const int tt_h = ht >> 4, cg4 = (ht & 15) * 4;
    const f32x4 p_kk = *(const f32x4*)(k_k + h * 64 + cg4), p_ka = *(const f32x4*)(k_a + h * 64 + cg4);
    const f32x4 p_gg = *(const f32x4*)(gn_g + h * 64 + cg4), p_gb = *(const f32x4*)(gn_b + h * 64 + cg4);
    const int gv8 = (ht & 15) * 8;
    const f32x4 mg0 = *(const f32x4*)(mu + 1664 + gv8), mg1 = *(const f32x4*)(mu + 1664 + gv8 + 4);
    const int nt = (ht >> 6), ln = lane & 15, lg = lane >> 4, chm = 16 * nt + ln;
    const int rp = ht >> 3, jg = ht & 7, i0 = 2 * rp;
    for (int idx = tid; idx < 128 * 64; idx += 512) { const int m = idx >> 6, cc = idx & 63; WTg[cc * 136 + m] = (bf16_t)f2bf(g_up[m * 512 + h * 64 + cc]); }
    f32x2 S0[4], S1[4];
#pragma unroll
    for (int j = 0; j < 4; ++j) { S0[j] = (f32x2){0.f, 0.f}; S1[j] = (f32x2){0.f, 0.f}; }
#if PROBE_SCAN2
    f32x2 T0[4], T1[4];
#pragma unroll
    for (int j = 0; j < 4; ++j) { T0[j] = (f32x2){0.f, 0.f}; T1[j] = (f32x2){0.f, 0.f}; }
#endif
    __syncthreads();

#define RW_ARR(bufi, k) ((LAS float*)(lds + (bufi) * RW_BUF + (k) * 4096))
#define RW_SC(bufi) ((LAS float*)(lds + (bufi) * RW_BUF + 32768))
#define RW_LOAD(chk, L) do { const size_t row_ = (size_t)b * SEQ + (chk) * RW_TS + tt_h; const bf16_t* rp_ = X.P + row_ * LDP; \
        l_r##L = *(const u32x2*)(rp_ + COL_PA + h * 64 + cg4); l_k##L = *(const u32x2*)(rp_ + COL_PA + 512 + h * 64 + cg4); l_v##L = *(const u32x2*)(rp_ + COL_PA + 1024 + h * 64 + cg4); \
        l_w##L = *(const u32x2*)(rp_ + h * 64 + cg4); l_a##L = *(const u32x2*)(rp_ + 512 + h * 64 + cg4); l_s##L = *(const f32x4*)(SCAL + (row_ * 8 + h) * 4); \
        l_gc##L = *(const u32x4*)(rp_ + COL_PA + 1664 + gv8); l_gp##L = (u32x4){0u, 0u, 0u, 0u}; if ((chk) * RW_TS + tt_h > 0) l_gp##L = *(const u32x4*)(rp_ - LDP + COL_PA + 1664 + gv8); } while (0)
    u32x2 l_rA, l_kA, l_vA, l_wA, l_aA; f32x4 l_sA; u32x4 l_gcA, l_gpA;
    u32x2 l_rB, l_kB, l_vB, l_wB, l_aB; f32x4 l_sB; u32x4 l_gcB, l_gpB;
    l_rA = l_kA = l_vA = l_wA = l_aA = l_rB = l_kB = l_vB = l_wB = l_aB = (u32x2){0u, 0u}; l_sA = l_sB = (f32x4){0.f, 0.f, 0.f, 0.f}; l_gcA = l_gpA = l_gcB = l_gpB = (u32x4){0u, 0u, 0u, 0u};
    if (helper) { RW_LOAD(0, A); RW_LOAD(1, B); }

#pragma unroll 1
    for (int i0_ = -1; i0_ < RW_NCH; i0_ += 2) {
        { const int i = i0_;

        const int bufn = (i + 1) & 1, bufc = i & 1;
        if (helper) {
            const bool do_prep = (i + 1 < RW_NCH);
            if (i >= 1) {
                LAS float* Yy = RW_ARR(bufn, 7); LAS float* Gg = RW_ARR(bufn, 6); LAS float* Vv = RW_ARR(bufn, 5); LAS float* SC = RW_SC(bufn);
                const f32x4 y = *(const LAS f32x4*)&Yy[tt_h * 64 + cg4], gg = *(const LAS f32x4*)&Gg[tt_h * 64 + cg4], vv = *(const LAS f32x4*)&Vv[tt_h * 64 + cg4];
                const float bonus = BON[((i - 1) % 3) * 16 + tt_h];
                const float mean = red16((y.x + y.y) + (y.z + y.w)) * (1.f / 64.f);
                const f32x4 d = y - mean;
                const float var = red16((d.x * d.x + d.y * d.y) + (d.z * d.z + d.w * d.w)) * (1.f / 64.f);
                const float rs = 1.f / sqrtf(var + 64e-5f);
                const f32x4 o = (d * rs * p_gg + p_gb + vv * bonus) * gg;
                u32x2 w; w.x = pk2(o.x, o.y); w.y = pk2(o.z, o.w);
                *(u32x2*)(X.P + ((size_t)b * SEQ + (i - 1) * RW_TS + tt_h) * LDP + COL_YA + h * 64 + cg4) = w;
            }
            if (do_prep) {
                const f32x4 r = (f32x4){bflo(l_rA.x), bfhi(l_rA.x), bflo(l_rA.y), bfhi(l_rA.y)}, k = (f32x4){bflo(l_kA.x), bfhi(l_kA.x), bflo(l_kA.y), bfhi(l_kA.y)};
                const f32x4 v = (f32x4){bflo(l_vA.x), bfhi(l_vA.x), bflo(l_vA.y), bfhi(l_vA.y)}, w1 = (f32x4){bflo(l_wA.x), bfhi(l_wA.x), bflo(l_wA.y), bfhi(l_wA.y)};
                const f32x4 a = (f32x4){bflo(l_aA.x), bfhi(l_aA.x), bflo(l_aA.y), bfhi(l_aA.y)};
                const f32x4 kk = k * p_kk * l_sA.x;
                const f32x4 decay = 1.f - w1;
                *(LAS f32x4*)&RW_ARR(bufn, 0)[tt_h * 64 + cg4] = -kk;
                *(LAS f32x4*)&RW_ARR(bufn, 1)[tt_h * 64 + cg4] = decay * r;
                *(LAS f32x4*)&RW_ARR(bufn, 2)[tt_h * 64 + cg4] = decay;
                *(LAS f32x4*)&RW_ARR(bufn, 3)[tt_h * 64 + cg4] = kk * a;
                *(LAS f32x4*)&RW_ARR(bufn, 4)[tt_h * 64 + cg4] = k * (1.f + (a - 1.f) * p_ka);
                *(LAS f32x4*)&RW_ARR(bufn, 5)[tt_h * 64 + cg4] = v;
                if (cg4 == 0) { LAS float* SC = RW_SC(bufn); SC[tt_h * 4 + 0] = l_sA.y; SC[tt_h * 4 + 1] = l_sA.z; BON[((i + 1) % 3) * 16 + tt_h] = l_sA.w; }
                float gc[8], gp[8];
                gc[0] = bflo(l_gcA.x); gc[1] = bfhi(l_gcA.x); gc[2] = bflo(l_gcA.y); gc[3] = bfhi(l_gcA.y); gc[4] = bflo(l_gcA.z); gc[5] = bfhi(l_gcA.z); gc[6] = bflo(l_gcA.w); gc[7] = bfhi(l_gcA.w);
                gp[0] = bflo(l_gpA.x); gp[1] = bfhi(l_gpA.x); gp[2] = bflo(l_gpA.y); gp[3] = bfhi(l_gpA.y); gp[4] = bflo(l_gpA.z); gp[5] = bfhi(l_gpA.z); gp[6] = bflo(l_gpA.w); gp[7] = bfhi(l_gpA.w);
#pragma unroll
                for (int e = 0; e < 8; ++e) gc[e] = sigmoidf_(gc[e] + (gp[e] - gc[e]) * (e < 4 ? mg0[e & 3] : mg1[e & 3]));
                u32x4 o; o.x = pk2(gc[0], gc[1]); o.y = pk2(gc[2], gc[3]); o.z = pk2(gc[4], gc[5]); o.w = pk2(gc[6], gc[7]);
                *(LAS u32x4*)&GDb[tt_h * 136 + gv8] = o;
            }
            if (i + 3 < RW_NCH) RW_LOAD(i + 3, A);
            LDS_BAR();
            if (do_prep) {
                LAS float* Gg = RW_ARR(bufn, 6);
                f32x4 cg_ = (f32x4){0.f, 0.f, 0.f, 0.f};
#pragma unroll
                for (int ks = 0; ks < 4; ++ks) {
                    const bf16x8 za = *(const LAS bf16x8*)&GDb[ln * 136 + ks * 32 + 8 * lg], zb = *(const LAS bf16x8*)&WTg[(16 * nt + ln) * 136 + ks * 32 + 8 * lg];
                    cg_ = __builtin_amdgcn_mfma_f32_16x16x32_bf16(za, zb, cg_, 0, 0, 0);
                }
#pragma unroll
                for (int r = 0; r < 4; ++r) Gg[(4 * lg + r) * 64 + chm] = cg_[r];
            }
            LDS_BAR();
        } else {
            LAS float* A_ = RW_ARR(bufc, 0); LAS float* WR = RW_ARR(bufc, 1); LAS float* Wd = RW_ARR(bufc, 2); LAS float* Bv = RW_ARR(bufc, 3);
            LAS float* Kk = RW_ARR(bufc, 4); LAS float* Vv = RW_ARR(bufc, 5); LAS float* Yy = RW_ARR(bufc, 7); LAS float* SC = RW_SC(bufc);
#pragma unroll 1
            for (int q4 = 0; q4 < 4; ++q4) {
                if (i >= 0) {
                    f32x2 yk[4];
#pragma unroll
                    for (int s4 = 0; s4 < 4; ++s4) {
                        const int tt = 4 * q4 + s4;
                        const f32x4 a_lo = *(const LAS f32x4*)&A_[tt * 64 + 8 * jg], a_hi = *(const LAS f32x4*)&A_[tt * 64 + 8 * jg + 4];
                        const f32x4 r_lo = *(const LAS f32x4*)&WR[tt * 64 + 8 * jg], r_hi = *(const LAS f32x4*)&WR[tt * 64 + 8 * jg + 4];
                        const f32x4 w_lo = *(const LAS f32x4*)&Wd[tt * 64 + 8 * jg], w_hi = *(const LAS f32x4*)&Wd[tt * 64 + 8 * jg + 4];
                        const f32x4 b_lo = *(const LAS f32x4*)&Bv[tt * 64 + 8 * jg], b_hi = *(const LAS f32x4*)&Bv[tt * 64 + 8 * jg + 4];
                        const f32x4 k_lo = *(const LAS f32x4*)&Kk[tt * 64 + 8 * jg], k_hi = *(const LAS f32x4*)&Kk[tt * 64 + 8 * jg + 4];
                        const f32x2 vv = *(const LAS f32x2*)&Vv[tt * 64 + i0];
                        const f32x2 sc = *(const LAS f32x2*)&SC[tt * 4];
                        const f32x2 av[4] = {{a_lo.x, a_lo.y}, {a_lo.z, a_lo.w}, {a_hi.x, a_hi.y}, {a_hi.z, a_hi.w}};
                        const f32x2 rv[4] = {{r_lo.x, r_lo.y}, {r_lo.z, r_lo.w}, {r_hi.x, r_hi.y}, {r_hi.z, r_hi.w}};
                        const f32x2 wv[4] = {{w_lo.x, w_lo.y}, {w_lo.z, w_lo.w}, {w_hi.x, w_hi.y}, {w_hi.z, w_hi.w}};
                        const f32x2 bv[4] = {{b_lo.x, b_lo.y}, {b_lo.z, b_lo.w}, {b_hi.x, b_hi.y}, {b_hi.z, b_hi.w}};
                        const f32x2 kv[4] = {{k_lo.x, k_lo.y}, {k_lo.z, k_lo.w}, {k_hi.x, k_hi.y}, {k_hi.z, k_hi.w}};
                        f32x2 e10 = S0[0] * av[0], e20 = S0[0] * rv[0], e11 = S1[0] * av[0], e21 = S1[0] * rv[0];
#pragma unroll
                        for (int j = 1; j < 4; ++j) { e10 += S0[j] * av[j]; e20 += S0[j] * rv[j]; e11 += S1[j] * av[j]; e21 += S1[j] * rv[j]; }
                        const float d10 = red8(e10.x + e10.y), d20 = red8(e20.x + e20.y), d11 = red8(e11.x + e11.y), d21 = red8(e21.x + e21.y);
                        yk[s4] = (f32x2){d20 + d10 * sc.x + vv.x * sc.y, d21 + d11 * sc.x + vv.y * sc.y};
                        const f32x2 d10v = (f32x2){d10, d10}, d11v = (f32x2){d11, d11}, v0v = (f32x2){vv.x, vv.x}, v1v = (f32x2){vv.y, vv.y};
#pragma unroll
                        for (int j = 0; j < 4; ++j) { S0[j] = S0[j] * wv[j] + (d10v * bv[j] + v0v * kv[j]); S1[j] = S1[j] * wv[j] + (d11v * bv[j] + v1v * kv[j]); }
                    }
                    if (jg == 0) {
#pragma unroll
                        for (int s4 = 0; s4 < 4; ++s4) *(LAS f32x2*)&Yy[(4 * q4 + s4) * 64 + i0] = yk[s4];
                    }

#if PROBE_SCAN2
                    {
#pragma unroll
                    for (int s4 = 0; s4 < 4; ++s4) {
                        const int tt = 4 * q4 + s4;
                        const f32x4 a_lo = *(const LAS f32x4*)&A_[tt * 64 + 8 * jg], a_hi = *(const LAS f32x4*)&A_[tt * 64 + 8 * jg + 4];
                        const f32x4 r_lo = *(const LAS f32x4*)&WR[tt * 64 + 8 * jg], r_hi = *(const LAS f32x4*)&WR[tt * 64 + 8 * jg + 4];
                        const f32x4 w_lo = *(const LAS f32x4*)&Wd[tt * 64 + 8 * jg], w_hi = *(const LAS f32x4*)&Wd[tt * 64 + 8 * jg + 4];
                        const f32x4 b_lo = *(const LAS f32x4*)&Bv[tt * 64 + 8 * jg], b_hi = *(const LAS f32x4*)&Bv[tt * 64 + 8 * jg + 4];
                        const f32x4 k_lo = *(const LAS f32x4*)&Kk[tt * 64 + 8 * jg], k_hi = *(const LAS f32x4*)&Kk[tt * 64 + 8 * jg + 4];
                        const f32x2 vv = *(const LAS f32x2*)&Vv[tt * 64 + i0];
                        const f32x2 av[4] = {{a_lo.x, a_lo.y}, {a_lo.z, a_lo.w}, {a_hi.x, a_hi.y}, {a_hi.z, a_hi.w}};
                        const f32x2 rv[4] = {{r_lo.x, r_lo.y}, {r_lo.z, r_lo.w}, {r_hi.x, r_hi.y}, {r_hi.z, r_hi.w}};
                        const f32x2 wv[4] = {{w_lo.x, w_lo.y}, {w_lo.z, w_lo.w}, {w_hi.x, w_hi.y}, {w_hi.z, w_hi.w}};
                        const f32x2 bv[4] = {{b_lo.x, b_lo.y}, {b_lo.z, b_lo.w}, {b_hi.x, b_hi.y}, {b_hi.z, b_hi.w}};
                        const f32x2 kv[4] = {{k_lo.x, k_lo.y}, {k_lo.z, k_lo.w}, {k_hi.x, k_hi.y}, {k_hi.z, k_hi.w}};
                        f32x2 e10 = T0[0] * av[0], e20 = T0[0] * rv[0], e11 = T1[0] * av[0], e21 = T1[0] * rv[0];
#pragma unroll
                        for (int j = 1; j < 4; ++j) { e10 += T0[j] * av[j]; e20 += T0[j] * rv[j]; e11 += T1[j] * av[j]; e21 += T1[j] * rv[j]; }
                        const float d10 = red8(e10.x + e10.y), d20 = red8(e20.x + e20.y), d11 = red8(e11.x + e11.y), d21 = red8(e21.x + e21.y);
                        const f32x2 d10v = (f32x2){d10 + d20, d10}, d11v = (f32x2){d11 + d21, d11}, v0v = (f32x2){vv.x, vv.x}, v1v = (f32x2){vv.y, vv.y};
#pragma unroll
                        for (int j = 0; j < 4; ++j) { T0[j] = T0[j] * wv[j] + (d10v * bv[j] + v0v * kv[j]); T1[j] = T1[j] * wv[j] + (d11v * bv[j] + v1v * kv[j]); }
                    }
                    }
#endif
                }
                if (q4 & 1) LDS_BAR();
            }
        }
            }
        if (i0_ + 1 < RW_NCH) { const int i = i0_ + 1;

        const int bufn = (i + 1) & 1, bufc = i & 1;
        if (helper) {
            const bool do_prep = (i + 1 < RW_NCH);
            if (i >= 1) {
                LAS float* Yy = RW_ARR(bufn, 7); LAS float* Gg = RW_ARR(bufn, 6); LAS float* Vv = RW_ARR(bufn, 5); LAS float* SC = RW_SC(bufn);
                const f32x4 y = *(const LAS f32x4*)&Yy[tt_h * 64 + cg4], gg = *(const LAS f32x4*)&Gg[tt_h * 64 + cg4], vv = *(const LAS f32x4*)&Vv[tt_h * 64 + cg4];
                const float bonus = BON[((i - 1) % 3) * 16 + tt_h];
                const float mean = red16((y.x + y.y) + (y.z + y.w)) * (1.f / 64.f);
                const f32x4 d = y - mean;
                const float var = red16((d.x * d.x + d.y * d.y) + (d.z * d.z + d.w * d.w)) * (1.f / 64.f);
                const float rs = 1.f / sqrtf(var + 64e-5f);
                const f32x4 o = (d * rs * p_gg + p_gb + vv * bonus) * gg;
                u32x2 w; w.x = pk2(o.x, o.y); w.y = pk2(o.z, o.w);
                *(u32x2*)(X.P + ((size_t)b * SEQ + (i - 1) * RW_TS + tt_h) * LDP + COL_YA + h * 64 + cg4) = w;
            }
            if (do_prep) {
                const f32x4 r = (f32x4){bflo(l_rB.x), bfhi(l_rB.x), bflo(l_rB.y), bfhi(l_rB.y)}, k = (f32x4){bflo(l_kB.x), bfhi(l_kB.x), bflo(l_kB.y), bfhi(l_kB.y)};
                const f32x4 v = (f32x4){bflo(l_vB.x), bfhi(l_vB.x), bflo(l_vB.y), bfhi(l_vB.y)}, w1 = (f32x4){bflo(l_wB.x), bfhi(l_wB.x), bflo(l_wB.y), bfhi(l_wB.y)};
                const f32x4 a = (f32x4){bflo(l_aB.x), bfhi(l_aB.x), bflo(l_aB.y), bfhi(l_aB.y)};
                const f32x4 kk = k * p_kk * l_sB.x;
                const f32x4 decay = 1.f - w1;
                *(LAS f32x4*)&RW_ARR(bufn, 0)[tt_h * 64 + cg4] = -kk;
                *(LAS f32x4*)&RW_ARR(bufn, 1)[tt_h * 64 + cg4] = decay * r;
                *(LAS f32x4*)&RW_ARR(bufn, 2)[tt_h * 64 + cg4] = decay;
                *(LAS f32x4*)&RW_ARR(bufn, 3)[tt_h * 64 + cg4] = kk * a;
                *(LAS f32x4*)&RW_ARR(bufn, 4)[tt_h * 64 + cg4] = k * (1.f + (a - 1.f) * p_ka);
                *(LAS f32x4*)&RW_ARR(bufn, 5)[tt_h * 64 + cg4] = v;
                if (cg4 == 0) { LAS float* SC = RW_SC(bufn); SC[tt_h * 4 + 0] = l_sB.y; SC[tt_h * 4 + 1] = l_sB.z; BON[((i + 1) % 3) * 16 + tt_h] = l_sB.w; }
                float gc[8], gp[8];
                gc[0] = bflo(l_gcB.x); gc[1] = bfhi(l_gcB.x); gc[2] = bflo(l_gcB.y); gc[3] = bfhi(l_gcB.y); gc[4] = bflo(l_gcB.z); gc[5] = bfhi(l_gcB.z); gc[6] = bflo(l_gcB.w); gc[7] = bfhi(l_gcB.w);
                gp[0] = bflo(l_gpB.x); gp[1] = bfhi(l_gpB.x); gp[2] = bflo(l_gpB.y); gp[3] = bfhi(l_gpB.y); gp[4] = bflo(l_gpB.z); gp[5] = bfhi(l_gpB.z); gp[6] = bflo(l_gpB.w); gp[7] = bfhi(l_gpB.w);
#pragma unroll
                for (int e = 0; e < 8; ++e) gc[e] = sigmoidf_(gc[e] + (gp[e] - gc[e]) * (e < 4 ? mg0[e & 3] : mg1[e & 3]));
                u32x4 o; o.x = pk2(gc[0], gc[1]); o.y = pk2(gc[2], gc[3]); o.z = pk2(gc[4], gc[5]); o.w = pk2(gc[6], gc[7]);
                *(LAS u32x4*)&GDb[tt_h * 136 + gv8] = o;
            }
            if (i + 3 < RW_NCH) RW_LOAD(i + 3, B);
            LDS_BAR();
            if (do_prep) {
                LAS float* Gg = RW_ARR(bufn, 6);
                f32x4 cg_ = (f32x4){0.f, 0.f, 0.f, 0.f};
#pragma unroll
                for (int ks = 0; ks < 4; ++ks) {
                    const bf16x8 za = *(const LAS bf16x8*)&GDb[ln * 136 + ks * 32 + 8 * lg], zb = *(const LAS bf16x8*)&WTg[(16 * nt + ln) * 136 + ks * 32 + 8 * lg];
                    cg_ = __builtin_amdgcn_mfma_f32_16x16x32_bf16(za, zb, cg_, 0, 0, 0);
                }
#pragma unroll
                for (int r = 0; r < 4; ++r) Gg[(4 * lg + r) * 64 + chm] = cg_[r];
            }
            LDS_BAR();
        } else {
            LAS float* A_ = RW_ARR(bufc, 0); LAS float* WR = RW_ARR(bufc, 1); LAS float* Wd = RW_ARR(bufc, 2); LAS float* Bv = RW_ARR(bufc, 3);
            LAS float* Kk = RW_ARR(bufc, 4); LAS float* Vv = RW_ARR(bufc, 5); LAS float* Yy = RW_ARR(bufc, 7); LAS float* SC = RW_SC(bufc);
#pragma unroll 1
            for (int q4 = 0; q4 < 4; ++q4) {
                if (i >= 0) {
                    f32x2 yk[4];
#pragma unroll
                    for (int s4 = 0; s4 < 4; ++s4) {
                        const int tt = 4 * q4 + s4;
                        const f32x4 a_lo = *(const LAS f32x4*)&A_[tt * 64 + 8 * jg], a_hi = *(const LAS f32x4*)&A_[tt * 64 + 8 * jg + 4];
                        const f32x4 r_lo = *(const LAS f32x4*)&WR[tt * 64 + 8 * jg], r_hi = *(const LAS f32x4*)&WR[tt * 64 + 8 * jg + 4];
                        const f32x4 w_lo = *(const LAS f32x4*)&Wd[tt * 64 + 8 * jg], w_hi = *(const LAS f32x4*)&Wd[tt * 64 + 8 * jg + 4];
                        const f32x4 b_lo = *(const LAS f32x4*)&Bv[tt * 64 + 8 * jg], b_hi = *(const LAS f32x4*)&Bv[tt * 64 + 8 * jg + 4];
                        const f32x4 k_lo = *(const LAS f32x4*)&Kk[tt * 64 + 8 * jg], k_hi = *(const LAS f32x4*)&Kk[tt * 64 + 8 * jg + 4];
                        const f32x2 vv = *(const LAS f32x2*)&Vv[tt * 64 + i0];
                        const f32x2 sc = *(const LAS f32x2*)&SC[tt * 4];
                        const f32x2 av[4] = {{a_lo.x, a_lo.y}, {a_lo.z, a_lo.w}, {a_hi.x, a_hi.y}, {a_hi.z, a_hi.w}};
                        const f32x2 rv[4] = {{r_lo.x, r_lo.y}, {r_lo.z, r_lo.w}, {r_hi.x, r_hi.y}, {r_hi.z, r_hi.w}};
                        const f32x2 wv[4] = {{w_lo.x, w_lo.y}, {w_lo.z, w_lo.w}, {w_hi.x, w_hi.y}, {w_hi.z, w_hi.w}};
                        const f32x2 bv[4] = {{b_lo.x, b_lo.y}, {b_lo.z, b_lo.w}, {b_hi.x, b_hi.y}, {b_hi.z, b_hi.w}};
                        const f32x2 kv[4] = {{k_lo.x, k_lo.y}, {k_lo.z, k_lo.w}, {k_hi.x, k_hi.y}, {k_hi.z, k_hi.w}};
                        f32x2 e10 = S0[0] * av[0], e20 = S0[0] * rv[0], e11 = S1[0] * av[0], e21 = S1[0] * rv[0];
#pragma unroll
                        for (int j = 1; j < 4; ++j) { e10 += S0[j] * av[j]; e20 += S0[j] * rv[j]; e11 += S1[j] * av[j]; e21 += S1[j] * rv[j]; }
                        const float d10 = red8(e10.x + e10.y), d20 = red8(e20.x + e20.y), d11 = red8(e11.x + e11.y), d21 = red8(e21.x + e21.y);
                        yk[s4] = (f32x2){d20 + d10 * sc.x + vv.x * sc.y, d21 + d11 * sc.x + vv.y * sc.y};
                        const f32x2 d10v = (f32x2){d10, d10}, d11v = (f32x2){d11, d11}, v0v = (f32x2){vv.x, vv.x}, v1v = (f32x2){vv.y, vv.y};
#pragma unroll
                        for (int j = 0; j < 4; ++j) { S0[j] = S0[j] * wv[j] + (d10v * bv[j] + v0v * kv[j]); S1[j] = S1[j] * wv[j] + (d11v * bv[j] + v1v * kv[j]); }
                    }
                    if (jg == 0) {
#pragma unroll
                        for (int s4 = 0; s4 < 4; ++s4) *(LAS f32x2*)&Yy[(4 * q4 + s4) * 64 + i0] = yk[s4];
                    }

#if PROBE_SCAN2
                    {
#pragma unroll
                    for (int s4 = 0; s4 < 4; ++s4) {
                        const int tt = 4 * q4 + s4;
                        const f32x4 a_lo = *(const LAS f32x4*)&A_[tt * 64 + 8 * jg], a_hi = *(const LAS f32x4*)&A_[tt * 64 + 8 * jg + 4];
                        const f32x4 r_lo = *(const LAS f32x4*)&WR[tt * 64 + 8 * jg], r_hi = *(const LAS f32x4*)&WR[tt * 64 + 8 * jg + 4];
                        const f32x4 w_lo = *(const LAS f32x4*)&Wd[tt * 64 + 8 * jg], w_hi = *(const LAS f32x4*)&Wd[tt * 64 + 8 * jg + 4];
                        const f32x4 b_lo = *(const LAS f32x4*)&Bv[tt * 64 + 8 * jg], b_hi = *(const LAS f32x4*)&Bv[tt * 64 + 8 * jg + 4];
                        const f32x4 k_lo = *(const LAS f32x4*)&Kk[tt * 64 + 8 * jg], k_hi = *(const LAS f32x4*)&Kk[tt * 64 + 8 * jg + 4];
                        const f32x2 vv = *(const LAS f32x2*)&Vv[tt * 64 + i0];
                        const f32x2 av[4] = {{a_lo.x, a_lo.y}, {a_lo.z, a_lo.w}, {a_hi.x, a_hi.y}, {a_hi.z, a_hi.w}};
                        const f32x2 rv[4] = {{r_lo.x, r_lo.y}, {r_lo.z, r_lo.w}, {r_hi.x, r_hi.y}, {r_hi.z, r_hi.w}};
                        const f32x2 wv[4] = {{w_lo.x, w_lo.y}, {w_lo.z, w_lo.w}, {w_hi.x, w_hi.y}, {w_hi.z, w_hi.w}};
                        const f32x2 bv[4] = {{b_lo.x, b_lo.y}, {b_lo.z, b_lo.w}, {b_hi.x, b_hi.y}, {b_hi.z, b_hi.w}};
                        const f32x2 kv[4] = {{k_lo.x, k_lo.y}, {k_lo.z, k_lo.w}, {k_hi.x, k_hi.y}, {k_hi.z, k_hi.w}};
                        f32x2 e10 = T0[0] * av[0], e20 = T0[0] * rv[0], e11 = T1[0] * av[0], e21 = T1[0] * rv[0];
#pragma unroll
                        for (int j = 1; j < 4; ++j) { e10 += T0[j] * av[j]; e20 += T0[j] * rv[j]; e11 += T1[j] * av[j]; e21 += T1[j] * rv[j]; }
                        const float d10 = red8(e10.x + e10.y), d20 = red8(e20.x + e20.y), d11 = red8(e11.x + e11.y), d21 = red8(e21.x + e21.y);
                        const f32x2 d10v = (f32x2){d10 + d20, d10}, d11v = (f32x2){d11 + d21, d11}, v0v = (f32x2){vv.x, vv.x}, v1v = (f32x2){vv.y, vv.y};
#pragma unroll
                        for (int j = 0; j < 4; ++j) { T0[j] = T0[j] * wv[j] + (d10v * bv[j] + v0v * kv[j]); T1[j] = T1[j] * wv[j] + (d11v * bv[j] + v1v * kv[j]); }
                    }
                    }
#endif
                }
                if (q4 & 1) LDS_BAR();
            }
        }
            }
    }
    if (helper) {
        const int bufl = (RW_NCH - 1) & 1;
        LAS float* Yy = RW_ARR(bufl, 7); LAS float* Gg = RW_ARR(bufl, 6); LAS float* Vv = RW_ARR(bufl, 5); LAS float* SC = RW_SC(bufl);
        const f32x4 y = *(const LAS f32x4*)&Yy[tt_h * 64 + cg4], gg = *(const LAS f32x4*)&Gg[tt_h * 64 + cg4], vv = *(const LAS f32x4*)&Vv[tt_h * 64 + cg4];
        const float bonus = BON[((RW_NCH - 1) % 3) * 16 + tt_h];
        const float mean = red16((y.x + y.y) + (y.z + y.w)) * (1.f / 64.f);
        const f32x4 d = y - mean;
        const float var = red16((d.x * d.x + d.y * d.y) + (d.z * d.z + d.w * d.w)) * (1.f / 64.f);
        const float rs = 1.f / sqrtf(var + 64e-5f);
        const f32x4 o = (d * rs * p_gg + p_gb + vv * bonus) * gg;
        u32x2 w; w.x = pk2(o.x, o.y); w.y = pk2(o.z, o.w);
        *(u32x2*)(X.P + ((size_t)b * SEQ + (RW_NCH - 1) * RW_TS + tt_h) * LDP + COL_YA + h * 64 + cg4) = w;
    }
    __syncthreads();
#undef RW_ARR
#undef RW_SC
#undef RW_LOAD
}

__device__ __forceinline__ void hgrn_task(const Ctx& X, LAS unsigned char* lds, int layer, int b, int h, int vh) {
    LAS float* F = (LAS float*)(lds); LAS float* Q = (LAS float*)(lds + 16384); LAS float* Vv = (LAS float*)(lds + 32768); LAS float* O = (LAS float*)(lds + 40960);
    LAS float* LB = (LAS float*)(lds + 49152);
    const int tid = X.tid;
    const float* lbl = X.in[14];
    const int rp = tid >> 4, dg = tid & 15, v0 = 2 * rp;
    if (tid < 128) LB[tid] = (layer > 0) ? 1.f / (1.f + __expf(lbl[h * 128 + tid] - lbl[512 + h * 128 + tid])) : 0.f;
    f32x2 S0[4], S1[4];
#pragma unroll
    for (int j = 0; j < 4; ++j) { S0[j] = (f32x2){0.f, 0.f}; S1[j] = (f32x2){0.f, 0.f}; }
#define HG_LOAD(chk) do { _Pragma("unroll") for (int it = 0; it < 3; ++it) { const int idx = tid + 512 * it; raw[it] = (u32x4){0u, 0u, 0u, 0u}; \
        if (idx < 32 * 40) { const int tt = idx / 40, vv = idx - tt * 40; \
            const int col = vv < 16 ? 512 + h * 128 + 8 * vv : (vv < 32 ? h * 128 + 8 * (vv - 16) : 1024 + h * 128 + vh * 64 + 8 * (vv - 32)); \
            raw[it] = *(const u32x4*)(X.P + ((size_t)b * SEQ + (chk) * 32 + tt) * LDP + COL_PB + col); } } } while (0)
    u32x4 raw[3];
    HG_LOAD(0);
    __syncthreads();
#pragma unroll 1
    for (int ch = 0; ch < SEQ / 32; ++ch) {
        const int t0 = ch * 32;
#pragma unroll
        for (int it = 0; it < 3; ++it) {
            const int idx = tid + 512 * it;
            if (idx < 32 * 40) {
                const int tt = idx / 40, vv = idx - tt * 40;
                float x[8];
                x[0] = bflo(raw[it].x); x[1] = bfhi(raw[it].x); x[2] = bflo(raw[it].y); x[3] = bfhi(raw[it].y);
                x[4] = bflo(raw[it].z); x[5] = bfhi(raw[it].z); x[6] = bflo(raw[it].w); x[7] = bfhi(raw[it].w);
                LAS float* dst;
                if (vv < 16) {
                    dst = F + tt * 128 + 8 * vv;
#pragma unroll
                    for (int e = 0; e < 8; ++e) { const float lb = LB[8 * vv + e]; x[e] = lb + (1.f - lb) * sigmoidf_(x[e]); }
                } else if (vv < 32) dst = Q + tt * 128 + 8 * (vv - 16);
                else dst = Vv + tt * 64 + 8 * (vv - 32);
                *(LAS f32x4*)dst = (f32x4){x[0], x[1], x[2], x[3]}; *(LAS f32x4*)(dst + 4) = (f32x4){x[4], x[5], x[6], x[7]};
            }
        }
        if (ch + 1 < SEQ / 32) HG_LOAD(ch + 1);
        LDS_BAR();
#pragma unroll 4
        for (int tt = 0; tt < 32; ++tt) {
            const f32x4 f_lo = *(const LAS f32x4*)&F[tt * 128 + 8 * dg], f_hi = *(const LAS f32x4*)&F[tt * 128 + 8 * dg + 4];
            const f32x4 q_lo = *(const LAS f32x4*)&Q[tt * 128 + 8 * dg], q_hi = *(const LAS f32x4*)&Q[tt * 128 + 8 * dg + 4];
            const f32x2 vv = *(const LAS f32x2*)&Vv[tt * 64 + v0];
            const f32x2 f2[4] = {{f_lo.x, f_lo.y}, {f_lo.z, f_lo.w}, {f_hi.x, f_hi.y}, {f_hi.z, f_hi.w}};
            const f32x2 q2[4] = {{q_lo.x, q_lo.y}, {q_lo.z, q_lo.w}, {q_hi.x, q_hi.y}, {q_hi.z, q_hi.w}};
            const f32x2 v0v = (f32x2){vv.x, vv.x}, v1v = (f32x2){vv.y, vv.y};
            f32x2 a0 = (f32x2){0.f, 0.f}, a1 = (f32x2){0.f, 0.f};
#pragma unroll
            for (int j = 0; j < 4; ++j) {
                S0[j] = v0v + f2[j] * (S0[j] - v0v); S1[j] = v1v + f2[j] * (S1[j] - v1v);
                a0 += q2[j] * S0[j]; a1 += q2[j] * S1[j];
            }
            const float o0 = red16(a0.x + a0.y), o1 = red16(a1.x + a1.y);
            if (dg == 0) *(LAS f32x2*)&O[tt * 64 + v0] = (f32x2){o0, o1};
        }
        LDS_BAR();
        if (tid < 256) {
            const int tt = tid >> 3, v8 = (tid & 7) * 8;
            const f32x4 a = *(const LAS f32x4*)&O[tt * 64 + v8], c4 = *(const LAS f32x4*)&O[tt * 64 + v8 + 4];
            u32x4 o; o.x = pk2(a.x, a.y); o.y = pk2(a.z, a.w); o.z = pk2(c4.x, c4.y); o.w = pk2(c4.z, c4.w);
            *(u32x4*)(X.P + ((size_t)b * SEQ + t0 + tt) * LDP + COL_YB + h * 128 + vh * 64 + v8) = o;
        }
    }
#undef HG_LOAD
    __syncthreads();
}

__device__ __forceinline__ unsigned f2ord(float f) { const unsigned u = __builtin_bit_cast(unsigned, f); return (u & 0x80000000u) ? ~u : (u | 0x80000000u); }

__device__ __forceinline__ void dsa_tile(const Ctx& X, LAS unsigned char* lds, int b, int q0) {
    LAS float* sc = (LAS float*)lds;
    LAS unsigned* MASK = (LAS unsigned*)(lds + MASK_OFF);
    const int lane = X.lane, w = X.wave, n = lane & 15, g = lane >> 4;
    const bf16_t* Pb = X.P + (size_t)b * SEQ * LDP;
#pragma unroll 1
    for (int sub = 0; sub < 4; ++sub) {
        const int qs = q0 + 16 * sub;
        {
            bf16x8 bq[4][2]; float wi[4];
            const bf16_t* qrow = Pb + (size_t)(qs + n) * LDP;
#pragma unroll
            for (int hh = 0; hh < 4; ++hh) {
#pragma unroll
                for (int ks = 0; ks < 2; ++ks) bq[hh][ks] = *(const bf16x8*)(qrow + C_QI + hh * 64 + ks * 32 + 8 * g);
                wi[hh] = bf2f(qrow[C_WI + hh]);
            }
            const int nkt = (qs + 16) >> 4;
            bf16x8 a0n = (bf16x8){0, 0, 0, 0, 0, 0, 0, 0}, a1n = a0n;
            if (w < nkt) { const bf16_t* krow = Pb + (size_t)(w * 16 + n) * LDP + C_KI; a0n = *(const bf16x8*)(krow + 8 * g); a1n = *(const bf16x8*)(krow + 32 + 8 * g); }
#pragma unroll 1
            for (int kt = w; kt < nkt; kt += 8) {
                const bf16x8 a0 = a0n, a1 = a1n;
                if (kt + 8 < nkt) { const bf16_t* krow = Pb + (size_t)((kt + 8) * 16 + n) * LDP + C_KI; a0n = *(const bf16x8*)(krow + 8 * g); a1n = *(const bf16x8*)(krow + 32 + 8 * g); }
                f32x4 s = (f32x4){0.f, 0.f, 0.f, 0.f};
#pragma unroll
                for (int hh = 0; hh < 4; ++hh) {
                    f32x4 d = __builtin_amdgcn_mfma_f32_16x16x32_bf16(a0, bq[hh][0], (f32x4){0.f, 0.f, 0.f, 0.f}, 0, 0, 0);
                    d = __builtin_amdgcn_mfma_f32_16x16x32_bf16(a1, bq[hh][1], d, 0, 0, 0);
#pragma unroll
                    for (int r = 0; r < 4; ++r) s[r] += wi[hh] * fmaxf(d[r], 0.f);
                }
                const int t = qs + n;
#pragma unroll
                for (int r = 0; r < 4; ++r) if (kt * 16 + 4 * g + r > t) s[r] = -INFINITY;
                *(LAS f32x4*)&sc[n * SCS + kt * 16 + 4 * g] = s;
            }
        }
        __syncthreads();
#pragma unroll 1
        for (int e = 0; e < 2; ++e) {
            const int qn = 2 * w + e, t = qs + qn;
            LAS unsigned* mrow = MASK + (sub * 16 + qn) * 64;
            if (t < 256) {
#pragma unroll
                for (int j = 0; j < 32; ++j) {
                    const unsigned long long sm = __ballot(j * 64 + lane <= t);
                    if (lane == 0) { mrow[2 * j] = (unsigned)sm; mrow[2 * j + 1] = (unsigned)(sm >> 32); }
                }
            } else {
                const int jn = (t >> 6) + 1;
                unsigned u[32];
#pragma unroll
                for (int j = 0; j < 32; ++j) {
                    u[j] = 0u;
                    if (j < jn) { const int key = j * 64 + lane; const float s = (key <= t) ? sc[qn * SCS + key] : -INFINITY; u[j] = f2ord(s); }
                }
                unsigned prefix = 0u;
#define DSA_BITSEARCH(JN) do { _Pragma("unroll 1") for (int bit = 31; bit >= 0; --bit) { const unsigned cand = prefix | (1u << bit); int c0 = 0, c1 = 0; \
                    _Pragma("unroll") for (int j = 0; j < (JN); j += 2) { c0 += (u[j] >= cand) ? 1 : 0; c1 += (u[j + 1] >= cand) ? 1 : 0; } \
                    const int cnt = (int)wave_sum_fast((float)(c0 + c1)); if (cnt >= 256) prefix = cand; } } while (0)
                if (jn <= 8) DSA_BITSEARCH(8); else if (jn <= 16) DSA_BITSEARCH(16); else if (jn <= 24) DSA_BITSEARCH(24); else DSA_BITSEARCH(32);
#undef DSA_BITSEARCH
                int cg_ = 0;
#pragma unroll
                for (int j = 0; j < 32; ++j) if (j < jn) cg_ += __popcll(__ballot(u[j] > prefix));
                const int need = 256 - cg_;
                int cum = 0;
#pragma unroll
                for (int j = 0; j < 32; ++j) {
                    unsigned long long sm = 0ull;
                    if (j < jn) {
                        const bool eq = (u[j] == prefix);
                        const unsigned long long em = __ballot(eq);
                        const int rank = cum + (int)__builtin_amdgcn_mbcnt_hi((unsigned)(em >> 32), __builtin_amdgcn_mbcnt_lo((unsigned)em, 0u));
                        const bool sel = (u[j] > prefix) || (eq && rank < need);
                        sm = __ballot(sel);
                        cum += __popcll(em);
                    }
                    if (lane == 0) { mrow[2 * j] = (unsigned)sm; mrow[2 * j + 1] = (unsigned)(sm >> 32); }
                }
            }
        }
        __syncthreads();
    }
    const int qq = q0 + 8 * w + (n & 7);
    const LAS unsigned* mq = MASK + (8 * w + (n & 7)) * 64;
    const int nsteps = (q0 + 8 * w + 8 + 31) >> 5;
    const int nblk = (q0 + 64 + 127) >> 7;
    LAS bf16_t* KT = (LAS bf16_t*)lds;
    LAS bf16_t* VTT = (LAS bf16_t*)(lds + 36864);
    const int tid = X.tid;
#pragma unroll 1
    for (int c = 0; c < 2; ++c) {
        bf16x8 bq[2][2];
#pragma unroll
        for (int j = 0; j < 2; ++j)
#pragma unroll
            for (int ks = 0; ks < 2; ++ks) bq[j][ks] = *(const bf16x8*)(Pb + (size_t)qq * LDP + C_Q + (c * 4 + 2 * j + (n >> 3)) * 64 + ks * 32 + 8 * g);
        float lrun[2] = {0.f, 0.f};
        f32x4 oacc[4][2];
#pragma unroll
        for (int mt = 0; mt < 4; ++mt)
#pragma unroll
            for (int j = 0; j < 2; ++j) oacc[mt][j] = (f32x4){0.f, 0.f, 0.f, 0.f};
        const bf16_t* vtb = X.VT + ((size_t)(b * 2 + c) * 64) * SEQ;
        u32x4 gk[2], gv[2];
#define DSA_GLOAD(kblk) do { _Pragma("unroll") for (int it = 0; it < 2; ++it) { const int idx = tid + 512 * it; \
            gk[it] = *(const u32x4*)(Pb + (size_t)((kblk) * 128 + (idx >> 3)) * LDP + C_K + c * 64 + (idx & 7) * 8); \
            gv[it] = *(const u32x4*)(vtb + (size_t)(idx >> 4) * SEQ + (kblk) * 128 + (idx & 15) * 8); } } while (0)
#define DSA_LSTORE(bufi) do { _Pragma("unroll") for (int it = 0; it < 2; ++it) { const int idx = tid + 512 * it; \
            *(LAS u32x4*)(KT + (bufi) * 9216 + (idx >> 3) * 72 + (idx & 7) * 8) = gk[it]; \
            *(LAS u32x4*)(VTT + (bufi) * 8704 + (idx >> 4) * 136 + (idx & 15) * 8) = gv[it]; } } while (0)
        DSA_GLOAD(0);
        LDS_BAR();
        DSA_LSTORE(0);
        LDS_BAR();
#pragma unroll 1
        for (int kb = 0; kb < nblk; ++kb) {
            const int buf = kb & 1;
            if (kb + 1 < nblk) DSA_GLOAD(kb + 1);
            const LAS bf16_t* Kb = KT + buf * 9216; const LAS bf16_t* Vb = VTT + buf * 8704;
#pragma unroll 1
            for (int sl = 0; sl < 4; ++sl) {
                const int sg = kb * 4 + sl;
                if (sg < nsteps) {
                    f32x4 st[2][2];
#pragma unroll
                    for (int tl = 0; tl < 2; ++tl) {
                        const LAS bf16_t* kr = Kb + (32 * sl + 16 * tl + n) * 72;
                        const bf16x8 a0 = *(const LAS bf16x8*)(kr + 8 * g), a1 = *(const LAS bf16x8*)(kr + 32 + 8 * g);
#pragma unroll
                        for (int j = 0; j < 2; ++j) {
                            f32x4 d = __builtin_amdgcn_mfma_f32_16x16x32_bf16(a0, bq[j][0], (f32x4){0.f, 0.f, 0.f, 0.f}, 0, 0, 0);
                            st[tl][j] = __builtin_amdgcn_mfma_f32_16x16x32_bf16(a1, bq[j][1], d, 0, 0, 0);
                        }
                    }
                    bf16x8 av[4];
#pragma unroll
                    for (int mt = 0; mt < 4; ++mt) {
                        const LAS bf16_t* vp = Vb + (mt * 16 + n) * 136 + 32 * sl + 4 * g;
                        const u32x2 lo = *(const LAS u32x2*)vp, hi = *(const LAS u32x2*)(vp + 16);
                        u32x4 t4; t4.x = lo.x; t4.y = lo.y; t4.z = hi.x; t4.w = hi.y;
                        av[mt] = __builtin_bit_cast(bf16x8, t4);
                    }
                    const unsigned mw = mq[sg];
#pragma unroll
                    for (int j = 0; j < 2; ++j) {
                        float p[8], ps = 0.f;
#pragma unroll
                        for (int tl = 0; tl < 2; ++tl)
#pragma unroll
                            for (int r = 0; r < 4; ++r) { const int bit = 16 * tl + 4 * g + r; const float e = __expf(fminf(st[tl][j][r] * 0.125f, 60.f)); p[4 * tl + r] = ((mw >> bit) & 1u) ? e : 0.f; ps += p[4 * tl + r]; }
                        lrun[j] += ps;
                        u32x4 pw; pw.x = pg8::cvt_pk_bf16(p[0], p[1]); pw.y = pg8::cvt_pk_bf16(p[2], p[3]); pw.z = pg8::cvt_pk_bf16(p[4], p[5]); pw.w = pg8::cvt_pk_bf16(p[6], p[7]);
                        const bf16x8 pb = __builtin_bit_cast(bf16x8, pw);
#pragma unroll
                        for (int mt = 0; mt < 4; ++mt) oacc[mt][j] = __builtin_amdgcn_mfma_f32_16x16x32_bf16(av[mt], pb, oacc[mt][j], 0, 0, 0);
                    }
                }
            }
            if (kb + 1 < nblk) DSA_LSTORE(buf ^ 1);
            LDS_BAR();
        }
#pragma unroll
        for (int j = 0; j < 2; ++j) {
            float lt = lrun[j]; lt += __shfl_xor(lt, 16); lt += __shfl_xor(lt, 32);
            const float il = 1.f / lt;
            bf16_t* op = X.P + ((size_t)b * SEQ + qq) * LDP + COL_YC + (c * 4 + 2 * j + (n >> 3)) * 64 + 4 * g;
#pragma unroll
            for (int mt = 0; mt < 4; ++mt) {
                const f32x4 o = oacc[mt][j] * il;
                u32x2 wv; wv.x = pg8::cvt_pk_bf16(o[0], o[1]); wv.y = pg8::cvt_pk_bf16(o[2], o[3]);
                *(u32x2*)(op + mt * 16) = wv;
            }
        }
    }
#undef DSA_GLOAD
#undef DSA_LSTORE
    __syncthreads();
}

__device__ __forceinline__ void phase_mixers(const Ctx& X0, LAS unsigned char* lds, int layer) {
#pragma unroll 1
    for (int task = X0.bid; task < 128; task += X0.G) {
        Ctx X = X0;
        { int t_ = threadIdx.x; asm volatile("" : "+v"(t_)); X.tid = t_; X.lane = t_ & 63; }
        if (task < 64) { if (TKMASK & 1) rwkv_task(X, lds, layer, task >> 3, task & 7); }
        else { const int k = task - 64; if (TKMASK & 2) hgrn_task(X, lds, layer, k >> 3, (k >> 1) & 3, k & 1); }
    }
    volatile LAS unsigned* tw = (volatile LAS unsigned*)(lds + LDS_BYTES - 128);
    unsigned* ctr = (unsigned*)(X0.ws + WS_BAR + 14336) + 16 * layer;
#pragma unroll 1
    for (;;) {
        Ctx X = X0;
        { int t_ = threadIdx.x; asm volatile("" : "+v"(t_)); X.tid = t_; X.lane = t_ & 63; }
        __syncthreads();
        if (threadIdx.x == 0) tw[0] = __hip_atomic_fetch_add(ctr, 1u, __ATOMIC_RELAXED, __HIP_MEMORY_SCOPE_AGENT);
        __syncthreads();
        const int t = (int)tw[0];
        if (t >= 256) break;
        if (TKMASK & 4) dsa_tile(X, lds, t & 7, 64 * (31 - (t >> 3)));
    }
}

__device__ __forceinline__ void phase_hgrn_post(const Ctx& X, int layer) {
    const int gw = X.bid * 8 + X.wave, NGW = X.G * 8;
    const float* gn = X.in[15] + layer * 512;
    for (int it = gw; it < T_TOK * 4; it += NGW) {
        const int t = it >> 2, h = it & 3;
        bf16_t* rowp = X.P + (size_t)t * LDP;
        unsigned* op = (unsigned*)(rowp + COL_YB + h * 128) + X.lane;
        const unsigned ow = *op, gwd = *((const unsigned*)(rowp + COL_PB + 1536 + h * 128) + X.lane);
        const float o0 = bflo(ow), o1 = bfhi(ow), g0 = bflo(gwd), g1 = bfhi(gwd);
        const float rs = 1.f / sqrtf(wave_sum(o0 * o0 + o1 * o1) * (1.f / 128.f) + 1e-6f);
        const float y0 = o0 * rs * gn[h * 128 + 2 * X.lane] * (g0 * sigmoidf_(g0)), y1 = o1 * rs * gn[h * 128 + 2 * X.lane + 1] * (g1 * sigmoidf_(g1));
        *op = pk2(y0, y1);
    }
}

__device__ __forceinline__ void phase_fixup(const Ctx& X, int layer) {
    const float* cw = X.in[20] + (size_t)layer * 3 * F2; const float* cb = X.in[21] + (size_t)layer * F2;
    for (int idx = X.bid * 512 + X.tid; idx < 256 * 2 * DFF; idx += X.G * 512) {
        const int j = idx % DFF, sr = idx / DFF, s = sr >> 1, r = sr & 1;
        const int colg = (j >> 7) * 256 + (j & 127), colv = colg + 128;
        const bool seq0 = (s & 31) == 0;
        const float* H = X.HALO;
        float res[2];
#pragma unroll
        for (int part = 0; part < 2; ++part) {
            const int cp = part ? colv : colg, co = part * DFF + j;
            const float u0 = H[(size_t)(s * 4 + r) * F2 + cp];
            float u1, u2;
            if (r == 0) { u1 = seq0 ? 0.f : H[(size_t)((s - 1) * 4 + 3) * F2 + cp]; u2 = seq0 ? 0.f : H[(size_t)((s - 1) * 4 + 2) * F2 + cp]; }
            else { u1 = H[(size_t)(s * 4 + 0) * F2 + cp]; u2 = seq0 ? 0.f : H[(size_t)((s - 1) * 4 + 3) * F2 + cp]; }
            res[part] = cb[co] + cw[co] * u2 + cw[F2 + co] * u1 + cw[2 * F2 + co] * u0;
        }
        const float a = res[0] * sigmoidf_(res[0]) * res[1];
        X.P[(size_t)(s * 64 + r) * LDP + COL_ACT + j] = (bf16_t)f2bf(a);
    }
}

#define XB_TMO      128
#define XB_XCNT(j)  (256  + 64 * (j))
#define XB_XSUB(j)  (1280 + 64 * (j))
#define XB_XGEN(j)  (2304 + 64 * (j))
#define XB_TOP      3328
#define XB_TOPGEN   3392
#define XCD_BAR_WORDS 3456
#define XB_SPIN_CAP (1u << 22)
__device__ __forceinline__ unsigned xb_ld(unsigned* p)              { return __hip_atomic_load(p, __ATOMIC_RELAXED, __HIP_MEMORY_SCOPE_AGENT); }
__device__ __forceinline__ unsigned xb_add(unsigned* p, unsigned v) { return __hip_atomic_fetch_add(p, v, __ATOMIC_RELAXED, __HIP_MEMORY_SCOPE_AGENT); }
__device__ __forceinline__ unsigned xb_xcc_id() { return (unsigned)__builtin_amdgcn_s_getreg((3 << 11) | 20) & 0xFu; }
#define XB_SPIN(cond, bar) do { unsigned _sp = 0; while (cond) { __builtin_amdgcn_s_sleep(1); \
    if ((++_sp & 255u) == 0u) { if (xb_ld(&(bar)[XB_TMO])) break; if (_sp > XB_SPIN_CAP) { atomicAdd(&(bar)[XB_TMO], 1u); break; } } } } while (0)
struct XcdBarrier { unsigned* bar; unsigned x; volatile LAS unsigned* st; };
__device__ __forceinline__ XcdBarrier xcd_barrier_post(unsigned* bar, volatile LAS unsigned* st) {
    XcdBarrier b; b.bar = bar; b.x = xb_xcc_id(); b.st = st;
    if (threadIdx.x == 0) (void)xb_add(&bar[XB_XCNT(b.x)], 1u);
    return b;
}
__device__ __forceinline__ void xcd_barrier_complete(unsigned* bar, unsigned x, unsigned& nloc, unsigned& nx) {
    const unsigned G = gridDim.x * gridDim.y * gridDim.z;
    unsigned sum, cnt, mine, sp = 0u;
    for (;;) {
        sum = 0u; cnt = 0u; mine = 0u;
#pragma unroll
        for (unsigned j = 0; j < 16; ++j) { const unsigned c = xb_ld(&bar[XB_XCNT(j)]); sum += c; cnt += (c > 0u) ? 1u : 0u; mine = (j == x) ? c : mine; }
        if (sum == G) break;
        __builtin_amdgcn_s_sleep(1);
        if ((++sp & 255u) == 0u) { if (xb_ld(&bar[XB_TMO])) break; if (sp > XB_SPIN_CAP) { atomicAdd(&bar[XB_TMO], 1u); break; } }
    }
    nloc = mine > 0u ? mine : 1u; nx = cnt > 0u ? cnt : 1u;
}
__device__ __forceinline__ void xcd_barrier(const XcdBarrier& b) {
    asm volatile("s_waitcnt vmcnt(0)" ::: "memory");
    __syncthreads();
    if (threadIdx.x == 0) {
        unsigned* bar = b.bar;
        __builtin_amdgcn_s_waitcnt(0);
        unsigned nloc = b.st[0], nx = b.st[1];
        if (nloc == 0u) { xcd_barrier_complete(bar, b.x, nloc, nx); b.st[0] = nloc; b.st[1] = nx; }
        const unsigned old = xb_add(&bar[XB_XSUB(b.x)], 1u);
        const unsigned gen = old / nloc;
        if (old + 1u == (gen + 1u) * nloc) {
            __builtin_amdgcn_fence(__ATOMIC_RELEASE, "agent");
            asm volatile("s_waitcnt vmcnt(0)" ::: "memory");
            const unsigned og = xb_add(&bar[XB_TOP], 1u);
            const unsigned tg = og / nx;
            if (og + 1u == (tg + 1u) * nx) xb_add(&bar[XB_TOPGEN], 1u);
            else XB_SPIN(xb_ld(&bar[XB_TOPGEN]) == tg, bar);
            __builtin_amdgcn_fence(__ATOMIC_ACQUIRE, "agent");
            xb_add(&bar[XB_XGEN(b.x)], 1u);
            asm volatile("s_waitcnt vmcnt(0)" ::: "memory");
        } else {
            XB_SPIN(xb_ld(&bar[XB_XGEN(b.x)]) == gen, bar);
            __builtin_amdgcn_fence(__ATOMIC_ACQUIRE, "agent");
            asm volatile("s_waitcnt vmcnt(0)" ::: "memory");
        }
    }
    __syncthreads();
}

__global__ void __launch_bounds__(512, 2) mk_fwd(Args args) {
    extern __shared__ __attribute__((aligned(16))) unsigned char lds_raw[];
    LAS unsigned char* lds = (LAS unsigned char*)lds_raw;
    Ctx X;
#pragma unroll
    for (int i = 0; i < 24; ++i) X.in[i] = args.in[i];
    X.out = args.out; X.ws = args.ws;
    X.P = (bf16_t*)(args.ws + WS_P); X.VT = (bf16_t*)(args.ws + WS_VT); X.HALO = (float*)(args.ws + WS_HALO); X.ROPE = (float*)(args.ws + WS_ROPE);
    X.Win = (bf16_t*)(args.ws + WS_WIN); X.Wg = (bf16_t*)(args.ws + WS_WG); X.Wbr = (bf16_t*)(args.ws + WS_WBR);
    X.Wo = (bf16_t*)(args.ws + WS_WO); X.Wup = (bf16_t*)(args.ws + WS_WUP); X.Wdn = (bf16_t*)(args.ws + WS_WDN);
    X.tid = threadIdx.x; X.lane = X.tid & 63; X.wave = __builtin_amdgcn_readfirstlane(X.tid >> 6); X.G = gridDim.x; X.bid = blockIdx.x;

#if PROBE_DOUBLE
    for (int ph2 = args.ph_lo * 2; ph2 < args.ph_hi * 2; ++ph2) {
        const int ph = ph2 >> 1;
        const int layer = ph / 11, sub = ph % 11;
        const bool skip_ = (ph2 & 1) && !(ph < 22 && ((REPMASK >> sub) & 1));
#else
    volatile LAS unsigned* bst = (volatile LAS unsigned*)(lds + LDS_BYTES - 64);
    if (threadIdx.x < 2) bst[threadIdx.x] = 0u;
    __syncthreads();
    XcdBarrier gbar = xcd_barrier_post((unsigned*)(args.ws + WS_BAR), bst);
    for (int ph = args.ph_lo; ph < args.ph_hi; ++ph) {
        const int layer = ph / 11, sub = ph % 11;
        const bool skip_ = false;
#endif
        { int t_ = threadIdx.x; asm volatile("" : "+v"(t_)); X.tid = t_; X.lane = t_ & 63; }

        if (skip_) {
        } else if (ph == 22 && (PHMASK & 1024)) {
            const int gw = X.bid * 8 + X.wave, NGW = X.G * 8;
            for (int m = gw; m < T_TOK; m += NGW) rms_row(X.out + (size_t)m * DM, X.in[23], nullptr, X.out + (size_t)m * DM, X.lane);
        } else if (sub == 0 && (PHMASK & 1)) {
            phase_prep(X, lds, layer);
        } else if (sub == 1 && (PHMASK & 2)) {
            pg8::Gemm g{X.P, X.Win, LDP, DM, DM}; pg8::StaticOrder S; S.init(T_TOK, 5120, X.G, X.bid);
            pg8::EpiInProj E{X.P, X.VT, X.ROPE, (bf16_t*)(X.ws + WS_BND)};
            pg8::gemm_phase<pg8::EpiInProj, true>(lds, g, S, E, X.tid);
        } else if (sub == 2 && (PHMASK & 4)) {
            phase_rwkv_pre(X, lds, layer);
        } else if (sub == 3 && (PHMASK & 4)) {
            phase_mixers(X, lds, layer);
        } else if (sub == 4 && (PHMASK & 8)) {
            phase_hgrn_post(X, layer);
            { const int gw = X.bid * 8 + X.wave, NGW = X.G * 8; const float* hh = (layer == 0) ? X.in[0] : X.out; const float* g = X.in[1] + (size_t)layer * DM;
              for (int m = gw; m < T_TOK; m += NGW) rms_row(hh + (size_t)m * DM, g, X.P + (size_t)m * LDP, nullptr, X.lane); }
        } else if (sub == 5 && (PHMASK & 16)) {
#pragma unroll 1
            for (int br = 0; br < 3; ++br) {
                { pg8::Gemm g{X.P, X.Wg + (size_t)br * DM * DM, LDP, DM, DM}; pg8::StaticOrder S; S.init(T_TOK, DM, X.G, X.bid);
                  int t_ = X.tid; asm volatile("" : "+v"(t_));
                  pg8::EpiGate E{X.P}; pg8::gemm_phase<pg8::EpiGate, true>(lds, g, S, E, t_); }
                { const int ycol = br == 0 ? COL_YA : (br == 1 ? COL_YB : COL_YC);
                  pg8::Gemm g{X.P + ycol, X.Wbr + (size_t)br * DM * 512, LDP, 512, 512}; pg8::StaticOrder S; S.init(T_TOK, DM, X.G, X.bid);
                  int t_ = X.tid; asm volatile("" : "+v"(t_));
                  pg8::EpiMergeAcc E{X.P, br == 0 ? 1 : 0}; pg8::gemm_phase<pg8::EpiMergeAcc, true>(lds, g, S, E, t_); }
            }
        } else if (sub == 6 && (PHMASK & 32)) {
            pg8::Gemm g{X.P + COL_MRG, X.Wo, LDP, DM, DM}; pg8::StaticOrder S; S.init(T_TOK, DM, X.G, X.bid);
            pg8::EpiResid E{layer == 0 ? X.in[0] : X.out, X.out};
            pg8::gemm_phase<pg8::EpiResid, true>(lds, g, S, E, X.tid);
        } else if (sub == 7 && (PHMASK & 64)) {
            const int gw = X.bid * 8 + X.wave, NGW = X.G * 8;
            const float* g = X.in[18] + (size_t)layer * DM;
            for (int m = gw; m < T_TOK; m += NGW) rms_row(X.out + (size_t)m * DM, g, X.P + (size_t)m * LDP, nullptr, X.lane);
        } else if (sub == 8 && (PHMASK & 128)) {
            pg8::Gemm g{X.P, X.Wup, LDP, DM, DM}; pg8::StaticOrder S; S.init(T_TOK, F2, X.G, X.bid);
            pg8::EpiUp E{X.P, X.HALO, X.in[20] + (size_t)layer * 3 * F2, X.in[21] + (size_t)layer * F2};
            pg8::gemm_phase<pg8::EpiUp, true>(lds, g, S, E, X.tid);
        } else if (sub == 9 && (PHMASK & 256)) {
            phase_fixup(X, layer);
        } else if (sub == 10 && (PHMASK & 512)) {
            pg8::Gemm g{X.P + COL_ACT, X.Wdn, LDP, DFF, DFF}; pg8::StaticOrder S; S.init(T_TOK, DM, X.G, X.bid);
            pg8::EpiResid E{X.out, X.out};
            pg8::gemm_phase<pg8::EpiResid, true>(lds, g, S, E, X.tid);
        }
#if PROBE_DOUBLE
        if (ph2 + 1 < args.ph_hi * 2) cg::this_grid().sync();
#else
        if (ph + 1 < args.ph_hi) { if (ph == args.ph_lo) cg::this_grid().sync(); else xcd_barrier(gbar); }
#endif
    }
}

extern "C" void kernel_launch(void* const* d_in, const int* in_sizes, int n_in, void* d_out, int out_size, void* d_ws, size_t ws_size, hipStream_t stream) {
    static int grid = 0;
    if (grid == 0) {
        int dev = 0, cus = 0, per_cu = 0;
        (void)hipGetDevice(&dev);
        (void)hipDeviceGetAttribute(&cus, hipDeviceAttributeMultiprocessorCount, dev);
        if (hipFuncSetAttribute((const void*)mk_fwd, hipFuncAttributeMaxDynamicSharedMemorySize, LDS_BYTES) != hipSuccess) fprintf(stderr, "kernel_launch: hipFuncSetAttribute failed\n");
        if (hipOccupancyMaxActiveBlocksPerMultiprocessor(&per_cu, (const void*)mk_fwd, 512, LDS_BYTES) != hipSuccess || per_cu < 1) { fprintf(stderr, "kernel_launch: occupancy query gave %d\n", per_cu); per_cu = 1; }
        (void)hipGetLastError();
        grid = cus * 1;
        if (grid <= 0) grid = 256;
        if (ws_size < (size_t)268435456) fprintf(stderr, "kernel_launch: workspace too small (%zu)\n", ws_size);
    }
    Args a{};
    for (int i = 0; i < 24; ++i) a.in[i] = (const float*)d_in[i];
    a.out = (float*)d_out; a.ws = (unsigned char*)d_ws;
#if MK_SINGLE
    (void)hipMemsetAsync((char*)d_ws + WS_BAR, 0, 16384, stream);
    a.ph_lo = 0; a.ph_hi = 23;
    void* kargs[] = {&a};
    hipError_t e = hipLaunchCooperativeKernel((const void*)mk_fwd, dim3(grid), dim3(512), kargs, LDS_BYTES, stream);
    if (e != hipSuccess) fprintf(stderr, "cooperative launch failed: %s (grid %d)\n", hipGetErrorString(e), grid);
#else
    for (int ph = 0; ph < 23; ++ph) {
        a.ph_lo = ph; a.ph_hi = ph + 1;
        hipLaunchKernelGGL(mk_fwd, dim3(grid), dim3(512), LDS_BYTES, stream, a);
    }
#endif
}
```

```cpp
#include <hip/hip_runtime.h>
#include <hip/hip_cooperative_groups.h>
#include <cstdio>
#include <cstdint>
namespace cg = cooperative_groups;

#ifndef PHMASK
#define PHMASK 2047
#endif
#ifndef REPMASK
#define REPMASK 0
#endif
#ifndef PROBE_DOUBLE
#define PROBE_DOUBLE 0
#endif
#ifndef PROBE_SCAN2
#define PROBE_SCAN2 0
#endif
#ifndef TKMASK
#define TKMASK 7
#endif
#ifndef MK_SINGLE
#define MK_SINGLE 1
#endif

#define LAS __attribute__((address_space(3)))
typedef unsigned short bf16_t;
typedef short bf16x8 __attribute__((ext_vector_type(8)));
typedef float f32x4 __attribute__((ext_vector_type(4)));
typedef float f32x2 __attribute__((ext_vector_type(2)));
typedef unsigned u32x4 __attribute__((ext_vector_type(4)));
typedef unsigned u32x2 __attribute__((ext_vector_type(2)));

constexpr int T_TOK = 16384, SEQ = 2048, DM = 1024;
constexpr int LDP = 6144;
constexpr int COL_PA = 1024, COL_PB = 2816, COL_PC = 4864;
constexpr int COL_YA = 1024, COL_MRG = 1536, COL_G = 2816, COL_YB = 3840, COL_YC = 4864, COL_ACT = 1024;
constexpr int C_Q = 4864, C_K = 5376, C_QI = 5632, C_KI = 5888, C_WI = 5952;
constexpr int IN_COLS = 8004, DFF = 2816, F2 = 5632;
constexpr size_t WS_WIN = 0, WS_WG = 10485760, WS_WBR = 16777216, WS_WO = 19922944, WS_WUP = 22020096, WS_WDN = 33554432;
constexpr size_t WS_P = 41943040, WS_HALO = 243269632, WS_VT = WS_HALO, WS_ROPE = 266338304, WS_BAR = 266862592, WS_BND = WS_HALO + 4194304, WS_SCAL = WS_HALO + 8388608;
constexpr int LDS_BYTES = 153600;
constexpr int SCS = 2052;
constexpr int MASK_OFF = 16 * SCS * 4;

struct Args { const float* in[24]; float* out; unsigned char* ws; int ph_lo, ph_hi; };

__device__ __forceinline__ unsigned f2bf(float f) { unsigned u = __builtin_bit_cast(unsigned, f); return (u + 0x7fffu + ((u >> 16) & 1u)) >> 16; }
__device__ __forceinline__ unsigned pk2(float lo, float hi) { return f2bf(lo) | (f2bf(hi) << 16); }
__device__ __forceinline__ float bf2f(bf16_t b) { return __builtin_bit_cast(float, (unsigned)b << 16); }
__device__ __forceinline__ float bflo(unsigned w) { return __builtin_bit_cast(float, w << 16); }
__device__ __forceinline__ float bfhi(unsigned w) { return __builtin_bit_cast(float, w & 0xffff0000u); }
__device__ __forceinline__ float wave_sum(float v) {
#pragma unroll
    for (int o = 1; o < 64; o <<= 1) v += __shfl_xor(v, o);
    return v;
}
__device__ __forceinline__ int wave_sum_i(int v) {
#pragma unroll
    for (int o = 1; o < 64; o <<= 1) v += __shfl_xor(v, o);
    return v;
}
template <int CTRL> __device__ __forceinline__ float dpp_mov(float x) {
    return __builtin_bit_cast(float, __builtin_amdgcn_update_dpp(0, __builtin_bit_cast(int, x), CTRL, 0xF, 0xF, true));
}
__device__ __forceinline__ float red8(float x) { x += dpp_mov<0xB1>(x); x += dpp_mov<0x4E>(x); x += dpp_mov<0x141>(x); return x; }
__device__ __forceinline__ float red16(float x) { x = red8(x); x += dpp_mov<0x140>(x); return x; }
__device__ __forceinline__ float sigmoidf_(float x) { return 1.f / (1.f + __expf(-x)); }

namespace pg8 {
constexpr int BM = 256, BK = 64, HALF = 128, HTB = HALF * BK * 2, NXCD = 8, WGM = 8;
__device__ __forceinline__ int lds_byte(int r, int c) { const int st = (r >> 4) * 2 + (c >> 5), rr = r & 15, cc = c & 31, ob = rr * 64 + cc * 2; return st * 1024 + (ob ^ (((ob >> 9) & 1) << 5)); }
__device__ __forceinline__ void stage_rc(int b, int& R, int& C) { const int st = b / 1024, sb = b % 1024, swz = sb ^ (((sb >> 9) & 1) << 5); R = (st >> 1) * 16 + swz / 64; C = (st & 1) * 32 + (swz % 64) / 2; }
__device__ __forceinline__ int perm32(int rho) { const int n = rho >> 4, i = rho & 15; return 8 * (i >> 2) + 4 * n + (i & 3); }
struct Unit { int pm, pn; };
struct Gemm { const bf16_t* A; const bf16_t* Bt; int lda, ldb, K; };
struct StaticOrder {
    int nM, nN, nwg, G, c;
    __device__ void init(int M, int N, int G_, int c_) { nM = M / BM; nN = N / BM; nwg = nM * nN; G = G_; c = c_; }
    __device__ bool next(int i, Unit& u) const {
        const long L = (long)i * G + c; if (L >= nwg) return false;
        int wgid = (int)L; { const int q = nwg / NXCD, r = nwg % NXCD, xcd = wgid % NXCD, off = wgid / NXCD; wgid = (xcd < r ? xcd * (q + 1) : r * (q + 1) + (xcd - r) * q) + off; }
        const int nig = WGM * nN, gid = wgid / nig, fm = gid * WGM, gsz = (nM - fm) < WGM ? (nM - fm) : WGM;
        u.pm = fm + ((wgid % nig) % gsz); u.pn = (wgid % nig) / gsz; return true;
    }
};
__device__ __forceinline__ unsigned cvt_pk_bf16(float lo, float hi) { unsigned r; asm volatile("v_cvt_pk_bf16_f32 %0, %1, %2" : "=v"(r) : "v"(lo), "v"(hi)); return r; }

template <class Epi, bool ALIGN_EPI>
__device__ __forceinline__ void gemm_phase(LAS unsigned char* lds, const Gemm g, const StaticOrder& S, const Epi& E, const int tid) {
    const int wid = __builtin_amdgcn_readfirstlane(tid >> 6), lane = tid & 63, wr = wid >> 2, wc = wid & 3, fr = lane & 15, fq = lane >> 4;
    const int K = g.K, nt = K / BK;
    unsigned voffA[2], voffB[2];
#pragma unroll
    for (int i = 0; i < 2; ++i) { int R, C; stage_rc(tid * 16 + i * 8192, R, C); const int Rb = (R & ~31) + perm32(R & 31);
        voffA[i] = (unsigned)(R * g.lda + C) * 2u; voffB[i] = (unsigned)(Rb * g.ldb + C) * 2u; }
    const size_t kstep = (size_t)(BK * 2);
    const size_t hstepA = (size_t)HALF * g.lda * 2, hstepB = (size_t)HALF * g.ldb * 2;
    const size_t tstepA = 2 * hstepA, tstepB = 2 * hstepB;
    const unsigned ldsw = (unsigned)wid * 1024u;
    const int aoff = lds_byte(wr * 64 + fr, fq * 8), boff = lds_byte(wc * 32 + fr, fq * 8);
#define PG8_SA(b, h) (((b) * 2 + (h)) * HTB)
#define PG8_SB(b, h) ((4 + (b) * 2 + (h)) * HTB)
#define PG8_STAGE(bufoff, gbase, voff) do { _Pragma("unroll") for (int _i = 0; _i < 2; ++_i) \
        __builtin_amdgcn_global_load_lds((const unsigned*)((const char*)(gbase) + (voff)[_i]), (LAS unsigned*)(lds + (bufoff) + ldsw + _i * 8192), 16, 0, 0); } while (0)
#define PG8_LDA(dst, b, h) do { _Pragma("unroll") for (int m = 0; m < 4; ++m) _Pragma("unroll") for (int k = 0; k < 2; ++k) dst[m][k] = *(const LAS bf16x8*)(lds + PG8_SA(b, h) + aoff + m * 2048 + k * 1024); } while (0)
#define PG8_LDB(dst, b, h) do { _Pragma("unroll") for (int n = 0; n < 2; ++n) _Pragma("unroll") for (int k = 0; k < 2; ++k) dst[n][k] = *(const LAS bf16x8*)(lds + PG8_SB(b, h) + boff + n * 2048 + k * 1024); } while (0)
#define PG8_MMA(ai, bj, At, Bt) do { __builtin_amdgcn_s_setprio(1); _Pragma("unroll") for (int m = 0; m < 4; ++m) _Pragma("unroll") for (int n = 0; n < 2; ++n) _Pragma("unroll") for (int k = 0; k < 2; ++k) \
        acc[ai][bj][m][n] = __builtin_amdgcn_mfma_f32_16x16x32_bf16(Bt[n][k], At[m][k], acc[ai][bj][m][n], 0, 0, 0); __builtin_amdgcn_s_setprio(0); } while (0)
#define PG8_WAIT_V(n) asm volatile("s_waitcnt vmcnt(" #n ")" ::: "memory")
#define PG8_WAIT_L(n) asm volatile("s_waitcnt lgkmcnt(" #n ")" ::: "memory")
#define PG8_BAR __builtin_amdgcn_s_barrier()
#define PG8_SCHED __builtin_amdgcn_sched_barrier(0)
    Unit cur, nxt; int ui = 0;
    if (!S.next(0, cur)) return;
    f32x4 acc[2][2][4][2];
#pragma unroll
    for (int a = 0; a < 2; ++a)
#pragma unroll
        for (int b = 0; b < 2; ++b)
#pragma unroll
            for (int m = 0; m < 4; ++m)
#pragma unroll
                for (int n = 0; n < 2; ++n) acc[a][b][m][n] = (f32x4){0.f, 0.f, 0.f, 0.f};
    bf16x8 At[4][2], B0[2][2], B1[2][2];
    const char* cA = (const char*)g.A + (size_t)cur.pm * tstepA; const char* cB = (const char*)g.Bt + (size_t)cur.pn * tstepB;
    PG8_STAGE(PG8_SB(0, 0), cB, voffB); PG8_STAGE(PG8_SB(0, 1), cB + hstepB, voffB); PG8_STAGE(PG8_SA(0, 0), cA, voffA); PG8_STAGE(PG8_SA(0, 1), cA + hstepA, voffA);
    if (wr == 1) PG8_BAR;
    PG8_WAIT_V(2); PG8_BAR;
    PG8_STAGE(PG8_SB(1, 0), cB + kstep, voffB); PG8_STAGE(PG8_SA(1, 0), cA + kstep, voffA); PG8_STAGE(PG8_SB(1, 1), cB + hstepB + kstep, voffB);
    PG8_WAIT_V(6); PG8_BAR;
    for (;;) {
        const bool has_next = S.next(ui + 1, nxt);
        const char* nA = has_next ? (const char*)g.A + (size_t)nxt.pm * tstepA : cA; const char* nB = has_next ? (const char*)g.Bt + (size_t)nxt.pn * tstepB : cB;
        for (int t = 0; t < nt; t += 2) {
            const bool last = (t == nt - 2);
            const char* a1 = cA + (size_t)(t + 1) * kstep;
            const char* a2 = last ? nA : cA + (size_t)(t + 2) * kstep; const char* b2 = last ? nB : cB + (size_t)(t + 2) * kstep;
            const char* a3 = a2 + kstep; const char* b3 = b2 + kstep;
            PG8_LDB(B0, 0, 0); PG8_LDB(B1, 0, 1); PG8_SCHED; PG8_LDA(At, 0, 0); PG8_STAGE(PG8_SA(1, 1), a1 + hstepA, voffA);
            PG8_WAIT_V(8); PG8_WAIT_L(0); PG8_BAR; PG8_MMA(0, 0, At, B0); PG8_MMA(0, 1, At, B1); PG8_BAR; PG8_SCHED;
            PG8_LDA(At, 0, 1); PG8_STAGE(PG8_SB(0, 0), b2, voffB); PG8_STAGE(PG8_SB(0, 1), b2 + hstepB, voffB); PG8_STAGE(PG8_SA(0, 0), a2, voffA);
            PG8_WAIT_V(8); PG8_WAIT_L(0); PG8_BAR; PG8_MMA(1, 0, At, B0); PG8_MMA(1, 1, At, B1); PG8_BAR; PG8_SCHED;
            PG8_LDB(B0, 1, 0); PG8_LDB(B1, 1, 1); PG8_SCHED; PG8_LDA(At, 1, 0); PG8_STAGE(PG8_SA(0, 1), a2 + hstepA, voffA);
            PG8_WAIT_V(8); PG8_WAIT_L(0); PG8_BAR; PG8_MMA(0, 0, At, B0); PG8_MMA(0, 1, At, B1); PG8_BAR; PG8_SCHED;
            PG8_LDA(At, 1, 1); PG8_STAGE(PG8_SB(1, 0), b3, voffB); PG8_STAGE(PG8_SB(1, 1), b3 + hstepB, voffB); PG8_STAGE(PG8_SA(1, 0), a3, voffA);
            PG8_WAIT_V(8); PG8_WAIT_L(0); PG8_BAR; PG8_MMA(1, 0, At, B0); PG8_MMA(1, 1, At, B1); PG8_BAR; PG8_SCHED;
        }
        if constexpr (ALIGN_EPI) { if (wr == 0) PG8_BAR; }
        E(acc, cur, wr, wc, fr, fq);
        if (!has_next) break;
#pragma unroll
        for (int a = 0; a < 2; ++a)
#pragma unroll
            for (int b = 0; b < 2; ++b)
#pragma unroll
                for (int m = 0; m < 4; ++m)
#pragma unroll
                    for (int n = 0; n < 2; ++n) acc[a][b][m][n] = (f32x4){0.f, 0.f, 0.f, 0.f};
        cur = nxt; cA = nA; cB = nB; ++ui;
        if constexpr (ALIGN_EPI) { if (wr == 1) PG8_BAR; }
    }
    PG8_WAIT_V(0);
    if constexpr (!ALIGN_EPI) { if (wr == 0) PG8_BAR; }
    PG8_BAR;
#undef PG8_SA
#undef PG8_SB
#undef PG8_STAGE
#undef PG8_LDA
#undef PG8_LDB
#undef PG8_MMA
#undef PG8_WAIT_V
#undef PG8_WAIT_L
#undef PG8_BAR
#undef PG8_SCHED
}

typedef f32x4 AccT[2][2][4][2];

struct EpiInProj {
    bf16_t* P; bf16_t* VT; const float* rope; bf16_t* BND;
    __device__ __forceinline__ void operator()(AccT& acc, const Unit& u, int wr, int wc, int fr, int fq) const {
        const int row0 = u.pm * BM + wr * 64 + fr, colb = u.pn * BM + wc * 32 + 8 * fq;
#pragma unroll
        for (int ai = 0; ai < 2; ++ai)
#pragma unroll
            for (int m = 0; m < 4; ++m) {
                const int row = row0 + ai * HALF + m * 16, t = row & (SEQ - 1);
                bf16_t* rowp = P + (size_t)row * LDP + COL_PA;
#pragma unroll
                for (int bj = 0; bj < 2; ++bj) {
                    const int c = colb + bj * HALF;
                    f32x4 v0 = acc[ai][bj][m][0], v1 = acc[ai][bj][m][1];
                    if (u.pn >= 15) {
                        const int cl = c - 3840;
                        if (cl < 640 || (cl >= 768 && cl < 1088)) {
                            const float* cs = rope + ((size_t)t * 32 + ((cl & 63) >> 1)) * 2;
                            const f32x4 r0 = *(const f32x4*)cs, r1 = *(const f32x4*)(cs + 4);
                            f32x4 o0, o1;
                            o0[0] = v0[0] * r0[0] - v0[1] * r0[1]; o0[1] = v0[1] * r0[0] + v0[0] * r0[1];
                            o0[2] = v0[2] * r0[2] - v0[3] * r0[3]; o0[3] = v0[3] * r0[2] + v0[2] * r0[3];
                            o1[0] = v1[0] * r1[0] - v1[1] * r1[1]; o1[1] = v1[1] * r1[0] + v1[0] * r1[1];
                            o1[2] = v1[2] * r1[2] - v1[3] * r1[3]; o1[3] = v1[3] * r1[2] + v1[2] * r1[3];
                            v0 = o0; v1 = o1;
                        }
                    }
                    u32x4 w; w.x = cvt_pk_bf16(v0[0], v0[1]); w.y = cvt_pk_bf16(v0[2], v0[3]); w.z = cvt_pk_bf16(v1[0], v1[1]); w.w = cvt_pk_bf16(v1[2], v1[3]);
                    *(u32x4*)(rowp + c) = w;
                    if (u.pn < 7 && fr == 15) *(u32x4*)(BND + (size_t)(row >> 4) * 1792 + c) = w;
                    if (u.pn == 17 && bj == 1) {
                        const int cv = c - 3840 - 640, b = row >> 11;
                        bf16_t* vt = VT + ((size_t)(b * 2 + (cv >> 6)) * 64 + (cv & 63)) * SEQ + t;
                        vt[0 * SEQ] = (bf16_t)(w.x & 0xffffu); vt[1 * SEQ] = (bf16_t)(w.x >> 16);
                        vt[2 * SEQ] = (bf16_t)(w.y & 0xffffu); vt[3 * SEQ] = (bf16_t)(w.y >> 16);
                        vt[4 * SEQ] = (bf16_t)(w.z & 0xffffu); vt[5 * SEQ] = (bf16_t)(w.z >> 16);
                        vt[6 * SEQ] = (bf16_t)(w.w & 0xffffu); vt[7 * SEQ] = (bf16_t)(w.w >> 16);
                    }
                }
            }
    }
};
struct EpiGate {
    bf16_t* P;
    __device__ __forceinline__ void operator()(AccT& acc, const Unit& u, int wr, int wc, int fr, int fq) const {
        const int row0 = u.pm * BM + wr * 64 + fr, colb = u.pn * BM + wc * 32 + 8 * fq;
#pragma unroll
        for (int ai = 0; ai < 2; ++ai)
#pragma unroll
            for (int m = 0; m < 4; ++m) {
                bf16_t* rowp = P + (size_t)(row0 + ai * HALF + m * 16) * LDP + COL_G + colb;
#pragma unroll
                for (int bj = 0; bj < 2; ++bj) {
                    const f32x4 v0 = acc[ai][bj][m][0], v1 = acc[ai][bj][m][1];
                    u32x4 w; w.x = cvt_pk_bf16(sigmoidf_(v0[0]), sigmoidf_(v0[1])); w.y = cvt_pk_bf16(sigmoidf_(v0[2]), sigmoidf_(v0[3]));
                    w.z = cvt_pk_bf16(sigmoidf_(v1[0]), sigmoidf_(v1[1])); w.w = cvt_pk_bf16(sigmoidf_(v1[2]), sigmoidf_(v1[3]));
                    *(u32x4*)(rowp + bj * HALF) = w;
                }
            }
    }
};
struct EpiMergeAcc {
    bf16_t* P; int first;
    __device__ __forceinline__ void operator()(AccT& acc, const Unit& u, int wr, int wc, int fr, int fq) const {
        const int row0 = u.pm * BM + wr * 64 + fr, colb = u.pn * BM + wc * 32 + 8 * fq;
#pragma unroll
        for (int ai = 0; ai < 2; ++ai)
#pragma unroll
            for (int m = 0; m < 4; ++m) {
                bf16_t* rowb = P + (size_t)(row0 + ai * HALF + m * 16) * LDP + colb;
#pragma unroll
                for (int bj = 0; bj < 2; ++bj) {
                    const f32x4 v0 = acc[ai][bj][m][0], v1 = acc[ai][bj][m][1];
                    unsigned long long* gp = (unsigned long long*)(rowb + COL_G + bj * HALF);
                    unsigned long long* mp = (unsigned long long*)(rowb + COL_MRG + bj * HALF);
                    const unsigned long long g0 = __hip_atomic_load(gp, __ATOMIC_RELAXED, __HIP_MEMORY_SCOPE_AGENT), g1 = __hip_atomic_load(gp + 1, __ATOMIC_RELAXED, __HIP_MEMORY_SCOPE_AGENT);
                    unsigned long long m0 = 0ull, m1 = 0ull;
                    if (!first) { m0 = __hip_atomic_load(mp, __ATOMIC_RELAXED, __HIP_MEMORY_SCOPE_AGENT); m1 = __hip_atomic_load(mp + 1, __ATOMIC_RELAXED, __HIP_MEMORY_SCOPE_AGENT); }
                    const unsigned ga = (unsigned)g0, gb = (unsigned)(g0 >> 32), gc = (unsigned)g1, gd = (unsigned)(g1 >> 32);
                    const unsigned ma = (unsigned)m0, mb = (unsigned)(m0 >> 32), mc = (unsigned)m1, md = (unsigned)(m1 >> 32);
                    u32x4 w;
                    w.x = cvt_pk_bf16(bflo(ma) + bflo(ga) * v0[0], bfhi(ma) + bfhi(ga) * v0[1]);
                    w.y = cvt_pk_bf16(bflo(mb) + bflo(gb) * v0[2], bfhi(mb) + bfhi(gb) * v0[3]);
                    w.z = cvt_pk_bf16(bflo(mc) + bflo(gc) * v1[0], bfhi(mc) + bfhi(gc) * v1[1]);
                    w.w = cvt_pk_bf16(bflo(md) + bflo(gd) * v1[2], bfhi(md) + bfhi(gd) * v1[3]);
                    *(u32x4*)(rowb + COL_MRG + bj * HALF) = w;
                }
            }
    }
};
struct EpiResid {
    const float* base; float* out;
    __device__ __forceinline__ void operator()(AccT& acc, const Unit& u, int wr, int wc, int fr, int fq) const {
        const int row0 = u.pm * BM + wr * 64 + fr, colb = u.pn * BM + wc * 32 + 8 * fq;
#pragma unroll
        for (int ai = 0; ai < 2; ++ai)
#pragma unroll
            for (int m = 0; m < 4; ++m) {
                const size_t off = (size_t)(row0 + ai * HALF + m * 16) * DM + colb;
#pragma unroll
                for (int bj = 0; bj < 2; ++bj) {
                    const f32x4 b0 = *(const f32x4*)(base + off + bj * HALF), b1 = *(const f32x4*)(base + off + bj * HALF + 4);
                    *(f32x4*)(out + off + bj * HALF) = b0 + acc[ai][bj][m][0];
                    *(f32x4*)(out + off + bj * HALF + 4) = b1 + acc[ai][bj][m][1];
                }
            }
    }
};
struct EpiUp {
    bf16_t* P; float* HALO; const float* cw; const float* cb; LAS float* CW;
    __device__ __forceinline__ void operator()(AccT& acc, const Unit& u, int wr, int wc, int fr_in, int fq_in) const {
        int fr = fr_in, fq = fq_in;
        asm volatile("" : "+v"(fr), "+v"(fq));
        const int row0 = u.pm * BM + wr * 64 + fr;
        const int jb = u.pn * 128 + wc * 32 + 8 * fq;
        {
            const int tl = (wr * 4 + wc) * 64 + fq * 16 + fr;
#pragma unroll
            for (int it = 0; it < 2; ++it) { const int k = tl + 512 * it, p = k >> 8, col = k & 255, co = (col >> 7) * DFF + u.pn * 128 + (col & 127);
                CW[k] = (p < 3) ? cw[p * F2 + co] : cb[co]; }
            asm volatile("s_waitcnt lgkmcnt(0)" ::: "memory"); __builtin_amdgcn_s_barrier(); asm volatile("" ::: "memory");
        }
#pragma unroll
        for (int ai = 0; ai < 2; ++ai) {
            const int s = u.pm * 4 + ai * 2 + wr;
#pragma unroll
            for (int bj = 0; bj < 2; ++bj)
#pragma unroll
                for (int n = 0; n < 2; ++n) {
                    const int colp = u.pn * BM + bj * HALF + wc * 32 + 8 * fq + 4 * n;
                    if (fr < 2) *(f32x4*)(HALO + (size_t)(s * 4 + fr) * F2 + colp) = acc[ai][bj][0][n];
                    if (fr >= 14) *(f32x4*)(HALO + (size_t)(s * 4 + fr - 12) * F2 + colp) = acc[ai][bj][3][n];
                }
        }
#pragma unroll
        for (int ai = 0; ai < 2; ++ai)
#pragma unroll
            for (int m = 0; m < 4; ++m) {
                const int row = row0 + ai * HALF + m * 16;
#pragma unroll
                for (int n = 0; n < 2; ++n) {
                    f32x4 cv[2];
#pragma unroll
                    for (int bj = 0; bj < 2; ++bj) {
                        const int cl = bj * 128 + wc * 32 + 8 * fq + 4 * n;
                        const f32x4 w0 = *(const LAS f32x4*)&CW[cl], w1 = *(const LAS f32x4*)&CW[256 + cl], w2 = *(const LAS f32x4*)&CW[512 + cl], bb = *(const LAS f32x4*)&CW[768 + cl];
#pragma unroll
                        for (int e = 0; e < 4; ++e) {
                            const float cur = acc[ai][bj][m][n][e];
                            const float prv = m > 0 ? acc[ai][bj][m > 0 ? m - 1 : 0][n][e] : 0.f;
                            const float a1 = dpp_mov<0x121>(cur), a2 = dpp_mov<0x122>(cur), b1 = dpp_mov<0x121>(prv), b2 = dpp_mov<0x122>(prv);
                            const float p1 = fr >= 1 ? a1 : b1, p2 = fr >= 2 ? a2 : b2;
                            cv[bj][e] = bb[e] + w0[e] * p2 + w1[e] * p1 + w2[e] * cur;
                        }
                        __builtin_amdgcn_sched_barrier(0);
                    }
                    const f32x4 g0 = cv[0], v0 = cv[1];
                    u32x2 w;
                    w.x = cvt_pk_bf16(g0[0] * sigmoidf_(g0[0]) * v0[0], g0[1] * sigmoidf_(g0[1]) * v0[1]);
                    w.y = cvt_pk_bf16(g0[2] * sigmoidf_(g0[2]) * v0[2], g0[3] * sigmoidf_(g0[3]) * v0[3]);
                    if (!(m == 0 && fr < 2)) *(u32x2*)(P + (size_t)row * LDP + COL_ACT + jb + 4 * n) = w;
                    __builtin_amdgcn_sched_barrier(0);
                }
            }
    }
};
}

struct Ctx {
    const float* in[24]; float* out; unsigned char* ws;
    bf16_t* P; bf16_t* VT; float* HALO; float* ROPE;
    bf16_t *Win, *Wg, *Wbr, *Wo, *Wup, *Wdn;
    int tid, lane, wave, G, bid;
};

__device__ __forceinline__ int srccol(int mode, int n) {
    if (mode == 0) return n;
    if (mode == 2) return 4932 + n;
    if (mode == 3) { const int tile = n >> 8, w = n & 255, j = tile * 128 + (w & 127); return (w < 128) ? j : DFF + j; }
    if (n < 3840) return n;
    const int c = n - 3840;
    if (c >= 1092) return -1;
    if (c < 640 || (c >= 768 && c < 1088)) { const int base = c & ~63, i = c & 63; return 3840 + base + (i >> 1) + 32 * (i & 1); }
    return 3840 + c;
}
__device__ __forceinline__ void tr_item(const float* W, int ldw, int K, int N, bf16_t* WT, int mode, int item, LAS float* scr, int lane) {
    const int nblk = N / 32, kb = item / nblk, nb = item % nblk, k0 = 64 * kb, n0 = 32 * nb;
    const int sc = srccol(mode, n0 + (lane & 31));
#pragma unroll 8
    for (int i = 0; i < 32; ++i) { const int kk = 2 * i + (lane >> 5); scr[kk * 33 + (lane & 31)] = (sc >= 0) ? W[(size_t)(k0 + kk) * ldw + sc] : 0.f; }
    asm volatile("s_waitcnt lgkmcnt(0)" ::: "memory");
    const int c = lane & 7;
#pragma unroll
    for (int j = 0; j < 4; ++j) { const int n = (lane >> 3) + 8 * j; const LAS float* s = scr + (8 * c) * 33 + n;
        u32x4 o; o.x = pk2(s[0 * 33], s[1 * 33]); o.y = pk2(s[2 * 33], s[3 * 33]); o.z = pk2(s[4 * 33], s[5 * 33]); o.w = pk2(s[6 * 33], s[7 * 33]);
        *(u32x4*)(WT + (size_t)(n0 + n) * K + k0 + 8 * c) = o; }
    asm volatile("s_waitcnt lgkmcnt(0)" ::: "memory");
}
__device__ __forceinline__ void rms_row(const float* xrow, const float* g, bf16_t* obf, float* of32, int lane) {
    const f32x4* xr = (const f32x4*)xrow + lane; const f32x4* gr = (const f32x4*)g + lane;
    f32x4 v[4]; float s = 0.f;
#pragma unroll
    for (int j = 0; j < 4; ++j) { v[j] = xr[64 * j]; s += (v[j].x * v[j].x + v[j].y * v[j].y) + (v[j].z * v[j].z + v[j].w * v[j].w); }
    const float rs = 1.f / sqrtf(wave_sum(s) * (1.f / DM) + 1e-6f);
#pragma unroll
    for (int j = 0; j < 4; ++j) {
        const f32x4 gg = gr[64 * j]; const f32x4 o = v[j] * rs * gg;
        if (obf) { u32x2 w; w.x = pk2(o.x, o.y); w.y = pk2(o.z, o.w); *((u32x2*)obf + lane + 64 * j) = w; }
        else *((f32x4*)of32 + lane + 64 * j) = o;
    }
}
__device__ __forceinline__ void rms_pass(const Ctx& X, const float* src, const float* g, bf16_t* obf, float* of32) {
    const int gw = X.bid * 8 + X.wave, NGW = X.G * 8, lane = X.lane;
    const f32x4* gr = (const f32x4*)g + lane;
    f32x4 gg[4];
#pragma unroll
    for (int j = 0; j < 4; ++j) gg[j] = gr[64 * j];
#pragma unroll 1
    for (int m = gw; m < T_TOK; m += 4 * NGW) {
        f32x4 v[4][4]; float ss[4]; int mr[4];
#pragma unroll
        for (int r = 0; r < 4; ++r) { mr[r] = m + r * NGW; const int ml = mr[r] < T_TOK ? mr[r] : m; const f32x4* x = (const f32x4*)(src + (size_t)ml * DM) + lane;
#pragma unroll
            for (int j = 0; j < 4; ++j) v[r][j] = x[64 * j]; }
#pragma unroll
        for (int r = 0; r < 4; ++r) { float a = 0.f;
#pragma unroll
            for (int j = 0; j < 4; ++j) a += (v[r][j].x * v[r][j].x + v[r][j].y * v[r][j].y) + (v[r][j].z * v[r][j].z + v[r][j].w * v[r][j].w);
            ss[r] = 1.f / sqrtf(wave_sum(a) * (1.f / DM) + 1e-6f); }
#pragma unroll
        for (int r = 0; r < 4; ++r) {
            if (mr[r] < T_TOK) {
#pragma unroll
                for (int j = 0; j < 4; ++j) {
                    const f32x4 o = v[r][j] * ss[r] * gg[j];
                    if (obf) { u32x2 w; w.x = pk2(o.x, o.y); w.y = pk2(o.z, o.w); *((u32x2*)(obf + (size_t)mr[r] * LDP) + lane + 64 * j) = w; }
                    else *((f32x4*)(of32 + (size_t)mr[r] * DM) + lane + 64 * j) = o;
                }
            }
        }
    }
}
__device__ __forceinline__ void phase_prep(const Ctx& X, LAS unsigned char* lds, int layer) {
    LAS float* scr = (LAS float*)(lds + X.wave * 8448);
    const int gw = X.bid * 8 + X.wave, NGW = X.G * 8;
    constexpr int I_IN = 16 * 160, I_G = 16 * 96, I_BR = 8 * 32, I_O = 16 * 32, I_UP = 16 * 176, I_DN = 44 * 32;
    constexpr int NITEMS = I_IN + I_G + 3 * I_BR + I_O + I_UP + I_DN;
    const float* w_in = X.in[2] + (size_t)layer * DM * IN_COLS;
    const float* w_br = X.in[16] + (size_t)layer * 3 * 512 * DM;
    const float* w_o = X.in[17] + (size_t)layer * DM * DM;
    const float* w_up = X.in[19] + (size_t)layer * DM * F2;
    const float* w_dn = X.in[22] + (size_t)layer * DFF * DM;
    for (int it = gw; it < NITEMS; it += NGW) {
        int r = it;
        if (r < I_IN) { tr_item(w_in, IN_COLS, DM, 5120, X.Win, 1, r, scr, X.lane); continue; } r -= I_IN;
        if (r < I_G) { tr_item(w_in, IN_COLS, DM, 3072, X.Wg, 2, r, scr, X.lane); continue; } r -= I_G;
        if (r < 3 * I_BR) { const int b = r / I_BR; tr_item(w_br + (size_t)b * 512 * DM, DM, 512, DM, X.Wbr + (size_t)b * DM * 512, 0, r % I_BR, scr, X.lane); continue; } r -= 3 * I_BR;
        if (r < I_O) { tr_item(w_o, DM, DM, DM, X.Wo, 0, r, scr, X.lane); continue; } r -= I_O;
        if (r < I_UP) { tr_item(w_up, F2, DM, F2, X.Wup, 3, r, scr, X.lane); continue; } r -= I_UP;
        tr_item(w_dn, DM, DFF, DM, X.Wdn, 0, r, scr, X.lane);
    }
    const float* h = (layer == 0) ? X.in[0] : X.out;
    const float* g = X.in[1] + (size_t)layer * DM;
    rms_pass(X, h, g, X.P, nullptr);
    if (layer == 0) {
        for (int idx = X.bid * 512 + X.tid; idx < SEQ * 32; idx += X.G * 512) {
            const int t = idx >> 5, p = idx & 31;
            const float inv = exp2f(-(float)p * 0.03125f * 13.287712379549449f);
            const float ang = (float)t * inv;
            const double rev = (double)ang * 0.15915494309189535;
            const float fr = (float)(rev - floor(rev));
            X.ROPE[2 * idx] = __builtin_amdgcn_cosf(fr); X.ROPE[2 * idx + 1] = __builtin_amdgcn_sinf(fr);
        }
    }
}

__device__ __forceinline__ float wave_sum_fast(float x) {
    x = red16(x);
    const float r0 = __builtin_bit_cast(float, __builtin_amdgcn_readlane(__builtin_bit_cast(int, x), 0)), r1 = __builtin_bit_cast(float, __builtin_amdgcn_readlane(__builtin_bit_cast(int, x), 16));
    const float r2 = __builtin_bit_cast(float, __builtin_amdgcn_readlane(__builtin_bit_cast(int, x), 32)), r3 = __builtin_bit_cast(float, __builtin_amdgcn_readlane(__builtin_bit_cast(int, x), 48));
    return (r0 + r1) + (r2 + r3);
}
#define LDS_BAR() do { asm volatile("s_waitcnt lgkmcnt(0)" ::: "memory"); __builtin_amdgcn_s_barrier(); asm volatile("" ::: "memory"); } while (0)
constexpr int RW_TS = 16, RW_NCH = SEQ / RW_TS, RW_BUF = 33280;
__device__ __forceinline__ void phase_rwkv_pre(const Ctx& X, LAS unsigned char* lds, int layer) {
    LAS float* Rr = (LAS float*)(lds);           LAS float* Kk = (LAS float*)(lds + 8192);   LAS float* Vv = (LAS float*)(lds + 16384);
    LAS float* W1 = (LAS float*)(lds + 24576);   LAS float* AS = (LAS float*)(lds + 32768);
    LAS bf16_t* WDb = (LAS bf16_t*)(lds + 40960);
    LAS bf16_t* ADb = (LAS bf16_t*)(lds + 45568);
    LAS bf16_t* WTu = (LAS bf16_t*)(lds + 50176);
    LAS bf16_t* WTa = (LAS bf16_t*)(lds + 59392);
    LAS float* MU = (LAS float*)(lds + 68608);
    const int tid = X.tid, lane = tid & 63, wv = X.wave;
    const float* mu = X.in[3] + layer * 1792;
    const float* w0 = X.in[4] + layer * 512;   const float* w_up = X.in[5] + (size_t)layer * 64 * 512;
    const float* a0 = X.in[6] + layer * 512;   const float* a_up = X.in[7] + (size_t)layer * 64 * 512;
    const float* k_k = X.in[9] + layer * 512;  const float* k_a = X.in[10] + layer * 512;  const float* r_k = X.in[11] + layer * 512;
    const bf16_t* BND = (const bf16_t*)(X.ws + WS_BND);
    float* SCAL = (float*)(X.ws + WS_SCAL);
    const int ln = lane & 15, lg = lane >> 4;
    int last_h = -1;
    float p_kk = 0.f, p_ka = 0.f, p_rk = 0.f, q_w0 = 0.f, q_a0 = 0.f;
    const int c = tid & 63, tg = tid >> 6;
    u32x4 pc4[3], pp4[3]; bool have_pf = false;
    pc4[0] = pc4[1] = pc4[2] = pp4[0] = pp4[1] = pp4[2] = (u32x4){0u, 0u, 0u, 0u};
#define PRE_LOAD(uu) do { const int h_ = (uu) & 7, tp_ = (uu) >> 3; _Pragma("unroll") for (int it = 0; it < 3; ++it) { const int idx = tid + 512 * it; pc4[it] = (u32x4){0u, 0u, 0u, 0u}; pp4[it] = (u32x4){0u, 0u, 0u, 0u}; \
        if (idx < 32 * 40) { const int tt = idx / 40, vv = idx - tt * 40; \
            const int col = vv < 8 ? h_ * 64 + 8 * vv : (vv < 16 ? 512 + h_ * 64 + 8 * (vv - 8) : (vv < 24 ? 1024 + h_ * 64 + 8 * (vv - 16) : 1536 + 8 * (vv - 24))); \
            const size_t row = (size_t)tp_ * 32 + tt; pc4[it] = *(const u32x4*)(X.P + row * LDP + COL_PA + col); \
            if (tt > 0) pp4[it] = *(const u32x4*)(X.P + (row - 1) * LDP + COL_PA + col); else if ((tp_ & 63) != 0) pp4[it] = *(const u32x4*)(BND + (size_t)(2 * tp_ - 1) * 1792 + col); } } } while (0)
#pragma unroll 1
    for (int u = X.bid; u < 4096; u += X.G) {
        const int h = u & 7, tp = u >> 3, hc = h * 64 + c;
        if (h != last_h) {
            __syncthreads();
            for (int idx = tid; idx < 64 * 64; idx += 512) { const int m = idx >> 6, cc = idx & 63;
                WTu[cc * 72 + m] = (bf16_t)f2bf(w_up[m * 512 + h * 64 + cc]); WTa[cc * 72 + m] = (bf16_t)f2bf(a_up[m * 512 + h * 64 + cc]); }
            if (tid < 320) { const int cc = tid; const int col = cc < 64 ? h * 64 + cc : (cc < 128 ? 512 + h * 64 + cc - 64 : (cc < 192 ? 1024 + h * 64 + cc - 128 : 1536 + cc - 192)); MU[cc] = mu[col]; }
            p_kk = k_k[hc]; p_ka = k_a[hc]; p_rk = r_k[hc];
            q_w0 = w0[h * 64 + 16 * (wv >> 1) + ln]; q_a0 = a0[h * 64 + 16 * (wv >> 1) + ln];
            last_h = h;
            __syncthreads();
        }
        if (!have_pf) { PRE_LOAD(u); }
#pragma unroll
        for (int it = 0; it < 3; ++it) {
            const int idx = tid + 512 * it;
            if (idx < 32 * 40) {
                const int tt = idx / 40, vv = idx - tt * 40, cc0 = 8 * vv;
                const u32x4 c4 = pc4[it], p4 = pp4[it];
                const f32x4 m0 = *(const LAS f32x4*)&MU[cc0], m1 = *(const LAS f32x4*)&MU[cc0 + 4];
                float cur[8], prv[8], val[8];
                cur[0] = bflo(c4.x); cur[1] = bfhi(c4.x); cur[2] = bflo(c4.y); cur[3] = bfhi(c4.y); cur[4] = bflo(c4.z); cur[5] = bfhi(c4.z); cur[6] = bflo(c4.w); cur[7] = bfhi(c4.w);
                prv[0] = bflo(p4.x); prv[1] = bfhi(p4.x); prv[2] = bflo(p4.y); prv[3] = bfhi(p4.y); prv[4] = bflo(p4.z); prv[5] = bfhi(p4.z); prv[6] = bflo(p4.w); prv[7] = bfhi(p4.w);
#pragma unroll
                for (int e = 0; e < 8; ++e) val[e] = cur[e] + (prv[e] - cur[e]) * (e < 4 ? m0[e & 3] : m1[e & 3]);
                if (vv < 24) {
#pragma unroll
                    for (int e = 0; e < 8; ++e) val[e] = bf2f((bf16_t)f2bf(val[e]));
                    LAS float* dst = (vv < 8 ? Rr : (vv < 16 ? Kk : Vv)) + tt * 64 + 8 * (vv & 7);
                    *(LAS f32x4*)dst = (f32x4){val[0], val[1], val[2], val[3]}; *(LAS f32x4*)(dst + 4) = (f32x4){val[4], val[5], val[6], val[7]};
                } else {
                    const int lr0 = 8 * (vv - 24);
                    LAS bf16_t* dst;
                    if (lr0 < 64) { dst = WDb + tt * 72 + lr0;
#pragma unroll
                        for (int e = 0; e < 8; ++e) { const float ex = __expf(2.f * val[e]); val[e] = 1.f - 2.f / (ex + 1.f); } }
                    else dst = ADb + tt * 72 + lr0 - 64;
                    u32x4 o; o.x = pk2(val[0], val[1]); o.y = pk2(val[2], val[3]); o.z = pk2(val[4], val[5]); o.w = pk2(val[6], val[7]);
                    *(LAS u32x4*)dst = o;
                }
            }
        }
        have_pf = false;
        if (u + X.G < 4096 && ((u + X.G) & 7) == h) { PRE_LOAD(u + X.G); have_pf = true; }
        LDS_BAR();
        {
            const int mt = wv & 1, nt = wv >> 1, chm = 16 * nt + ln;
            f32x4 cw_ = (f32x4){0.f, 0.f, 0.f, 0.f}, ca_ = cw_;
#pragma unroll
            for (int ks = 0; ks < 2; ++ks) {
                const bf16x8 xa = *(const LAS bf16x8*)&WDb[(16 * mt + ln) * 72 + ks * 32 + 8 * lg], xb = *(const LAS bf16x8*)&WTu[(16 * nt + ln) * 72 + ks * 32 + 8 * lg];
                cw_ = __builtin_amdgcn_mfma_f32_16x16x32_bf16(xa, xb, cw_, 0, 0, 0);
                const bf16x8 ya = *(const LAS bf16x8*)&ADb[(16 * mt + ln) * 72 + ks * 32 + 8 * lg], yb = *(const LAS bf16x8*)&WTa[(16 * nt + ln) * 72 + ks * 32 + 8 * lg];
                ca_ = __builtin_amdgcn_mfma_f32_16x16x32_bf16(ya, yb, ca_, 0, 0, 0);
            }
#pragma unroll
            for (int r = 0; r < 4; ++r) {
                const int tt = 16 * mt + 4 * lg + r;
                const float z = -(q_w0 + cw_[r]);
                const float sp = fmaxf(z, 0.f) + __logf(1.f + __expf(-fabsf(z)));
                const float e = __expf(-sp - 0.5f);
                W1[tt * 64 + chm] = bf2f((bf16_t)f2bf(-expm1f(-e)));
                AS[tt * 64 + chm] = bf2f((bf16_t)f2bf(sigmoidf_(q_a0 + ca_[r])));
            }
        }
        LDS_BAR();
#pragma unroll
        for (int q = 0; q < 4; ++q) {
            const int tt = 4 * tg + q;
            const size_t row = (size_t)tp * 32 + tt;
            const float w1 = W1[tt * 64 + c], a = AS[tt * 64 + c];
            const float kraw = Kk[tt * 64 + c], r = Rr[tt * 64 + c], v = Vv[tt * 64 + c];
            const float kk0 = kraw * p_kk;
            const float inv = 1.f / sqrtf(fmaxf(wave_sum_fast(kk0 * kk0), 1e-24f));
            const float kk = kk0 * inv;
            const float kmod = kraw * (1.f + (a - 1.f) * p_ka);
            const float bvec = kk * a;
            const float br = wave_sum_fast(bvec * r), kr = wave_sum_fast(kmod * r), bonus = wave_sum_fast(r * kmod * p_rk);
            bf16_t* rp_ = X.P + row * LDP;
            rp_[COL_PA + hc] = (bf16_t)f2bf(r); rp_[COL_PA + 512 + hc] = (bf16_t)f2bf(kraw); rp_[COL_PA + 1024 + hc] = (bf16_t)f2bf(v);
            rp_[hc] = (bf16_t)f2bf(w1); rp_[512 + hc] = (bf16_t)f2bf(a);
            if (c == 0) *(f32x4*)(SCAL + (row * 8 + h) * 4) = (f32x4){inv, br, kr, bonus};
        }
        LDS_BAR();
    }
}

__device__ __forceinline__ void rwkv_task(const Ctx& X, LAS unsigned char* lds, int layer, int b, int h) {
    LAS bf16_t* GDb = (LAS bf16_t*)(lds + 66560);
    LAS bf16_t* WTg = (LAS bf16_t*)(lds + 70912);
    LAS float* BON = (LAS float*)(lds + 88320);
    const int tid = X.tid, lane = tid & 63;
    const bool helper = X.wave >= 4;
    const int ht = tid & 255;
    const float* mu = X.in[3] + layer * 1792;
    const float* g_up = X.in[8] + (size_t)layer * 128 * 512;
    const float* k_k = X.in[9] + layer * 512;  const float* k_a = X.in[10] + layer * 512;
    const float* gn_g = X.in[12] + layer * 512; const float* gn_b = X.in[13] + layer * 512;
    const float* SCAL = (const float*)(X.ws + WS_SCAL);
    const int tt_h = ht >> 4, cg4 = (ht & 15) * 4;
    const f32x4 p_kk = *(const f32x4*)(k_k + h * 64 + cg4), p_ka = *(const f32x4*)(k_a + h * 64 + cg4);
    const f32x4 p_gg = *(const f32x4*)(gn_g + h * 64 + cg4), p_gb = *(const f32x4*)(gn_b + h * 64 + cg4);
    const int gv8 = (ht & 15) * 8;
    const f32x4 mg0 = *(const f32x4*)(mu + 1664 + gv8), mg1 = *(const f32x4*)(mu + 1664 + gv8 + 4);
    const int nt = (ht >> 6), ln = lane & 15, lg = lane >> 4, chm = 16 * nt + ln;
    const int rp = ht >> 3, jg = ht & 7, i0 = 2 * rp;
    for (int idx = tid; idx < 128 * 64; idx += 512) { const int m = idx >> 6, cc = idx & 63; WTg[cc * 136 + m] = (bf16_t)f2bf(g_up[m * 512 + h * 64 + cc]); }
    f32x2 S0[4], S1[4];
#pragma unroll
    for (int j = 0; j < 4; ++j) { S0[j] = (f32x2){0.f, 0.f}; S1[j] = (f32x2){0.f, 0.f}; }
#if PROBE_SCAN2
    f32x2 T0[4], T1[4];
#pragma unroll
    for (int j = 0; j < 4; ++j) { T0[j] = (f32x2){0.f, 0.f}; T1[j] = (f32x2){0.f, 0.f}; }
#endif
    __syncthreads();

#define RW_ARR(bufi, k) ((LAS float*)(lds + (bufi) * RW_BUF + (k) * 4096))
#define RW_SC(bufi) ((LAS float*)(lds + (bufi) * RW_BUF + 32768))
#define RW_LOAD(chk, L) do { const size_t row_ = (size_t)b * SEQ + (chk) * RW_TS + tt_h; const bf16_t* rp_ = X.P + row_ * LDP; \
        l_r##L = *(const u32x2*)(rp_ + COL_PA + h * 64 + cg4); l_k##L = *(const u32x2*)(rp_ + COL_PA + 512 + h * 64 + cg4); l_v##L = *(const u32x2*)(rp_ + COL_PA + 1024 + h * 64 + cg4); \
        l_w##L = *(const u32x2*)(rp_ + h * 64 + cg4); l_a##L = *(const u32x2*)(rp_ + 512 + h * 64 + cg4); l_s##L = *(const f32x4*)(SCAL + (row_ * 8 + h) * 4); \
        l_gc##L = *(const u32x4*)(rp_ + COL_PA + 1664 + gv8); l_gp##L = (u32x4){0u, 0u, 0u, 0u}; if ((chk) * RW_TS + tt_h > 0) l_gp##L = *(const u32x4*)(rp_ - LDP + COL_PA + 1664 + gv8); } while (0)
    u32x2 l_rA, l_kA, l_vA, l_wA, l_aA; f32x4 l_sA; u32x4 l_gcA, l_gpA;
    u32x2 l_rB, l_kB, l_vB, l_wB, l_aB; f32x4 l_sB; u32x4 l_gcB, l_gpB;
    l_rA = l_kA = l_vA = l_wA = l_aA = l_rB = l_kB = l_vB = l_wB = l_aB = (u32x2){0u, 0u}; l_sA = l_sB = (f32x4){0.f, 0.f, 0.f, 0.f}; l_gcA = l_gpA = l_gcB = l_gpB = (u32x4){0u, 0u, 0u, 0u};
    if (helper) { RW_LOAD(0, A); RW_LOAD(1, B); }

#pragma unroll 1
    for (int i0_ = -1; i0_ < RW_NCH; i0_ += 2) {
        { const int i = i0_;

        const int bufn = (i + 1) & 1, bufc = i & 1;
        if (helper) {
            const bool do_prep = (i + 1 < RW_NCH);
            if (i >= 1) {
                LAS float* Yy = RW_ARR(bufn, 7); LAS float* Gg = RW_ARR(bufn, 6); LAS float* Vv = RW_ARR(bufn, 5); LAS float* SC = RW_SC(bufn);
                const f32x4 y = *(const LAS f32x4*)&Yy[tt_h * 64 + cg4], gg = *(const LAS f32x4*)&Gg[tt_h * 64 + cg4], vv = *(const LAS f32x4*)&Vv[tt_h * 64 + cg4];
                const float bonus = BON[((i - 1) % 3) * 16 + tt_h];
                const float mean = red16((y.x + y.y) + (y.z + y.w)) * (1.f / 64.f);
                const f32x4 d = y - mean;
                const float var = red16((d.x * d.x + d.y * d.y) + (d.z * d.z + d.w * d.w)) * (1.f / 64.f);
                const float rs = 1.f / sqrtf(var + 64e-5f);
                const f32x4 o = (d * rs * p_gg + p_gb + vv * bonus) * gg;
                u32x2 w; w.x = pk2(o.x, o.y); w.y = pk2(o.z, o.w);
                *(u32x2*)(X.P + ((size_t)b * SEQ + (i - 1) * RW_TS + tt_h) * LDP + COL_YA + h * 64 + cg4) = w;
            }
            if (do_prep) {
                const f32x4 r = (f32x4){bflo(l_rA.x), bfhi(l_rA.x), bflo(l_rA.y), bfhi(l_rA.y)}, k = (f32x4){bflo(l_kA.x), bfhi(l_kA.x), bflo(l_kA.y), bfhi(l_kA.y)};
                const f32x4 v = (f32x4){bflo(l_vA.x), bfhi(l_vA.x), bflo(l_vA.y), bfhi(l_vA.y)}, w1 = (f32x4){bflo(l_wA.x), bfhi(l_wA.x), bflo(l_wA.y), bfhi(l_wA.y)};
                const f32x4 a = (f32x4){bflo(l_aA.x), bfhi(l_aA.x), bflo(l_aA.y), bfhi(l_aA.y)};
                const f32x4 kk = k * p_kk * l_sA.x;
                const f32x4 decay = 1.f - w1;
                *(LAS f32x4*)&RW_ARR(bufn, 0)[tt_h * 64 + cg4] = -kk;
                *(LAS f32x4*)&RW_ARR(bufn, 1)[tt_h * 64 + cg4] = decay * r;
                *(LAS f32x4*)&RW_ARR(bufn, 2)[tt_h * 64 + cg4] = decay;
                *(LAS f32x4*)&RW_ARR(bufn, 3)[tt_h * 64 + cg4] = kk * a;
                *(LAS f32x4*)&RW_ARR(bufn, 4)[tt_h * 64 + cg4] = k * (1.f + (a - 1.f) * p_ka);
                *(LAS f32x4*)&RW_ARR(bufn, 5)[tt_h * 64 + cg4] = v;
                if (cg4 == 0) { LAS float* SC = RW_SC(bufn); SC[tt_h * 4 + 0] = l_sA.y; SC[tt_h * 4 + 1] = l_sA.z; BON[((i + 1) % 3) * 16 + tt_h] = l_sA.w; }
                float gc[8], gp[8];
                gc[0] = bflo(l_gcA.x); gc[1] = bfhi(l_gcA.x); gc[2] = bflo(l_gcA.y); gc[3] = bfhi(l_gcA.y); gc[4] = bflo(l_gcA.z); gc[5] = bfhi(l_gcA.z); gc[6] = bflo(l_gcA.w); gc[7] = bfhi(l_gcA.w);
                gp[0] = bflo(l_gpA.x); gp[1] = bfhi(l_gpA.x); gp[2] = bflo(l_gpA.y); gp[3] = bfhi(l_gpA.y); gp[4] = bflo(l_gpA.z); gp[5] = bfhi(l_gpA.z); gp[6] = bflo(l_gpA.w); gp[7] = bfhi(l_gpA.w);
#pragma unroll
                for (int e = 0; e < 8; ++e) gc[e] = sigmoidf_(gc[e] + (gp[e] - gc[e]) * (e < 4 ? mg0[e & 3] : mg1[e & 3]));
                u32x4 o; o.x = pk2(gc[0], gc[1]); o.y = pk2(gc[2], gc[3]); o.z = pk2(gc[4], gc[5]); o.w = pk2(gc[6], gc[7]);
                *(LAS u32x4*)&GDb[tt_h * 136 + gv8] = o;
            }
            if (i + 3 < RW_NCH) RW_LOAD(i + 3, A);
            LDS_BAR();
            if (do_prep) {
                LAS float* Gg = RW_ARR(bufn, 6);
                f32x4 cg_ = (f32x4){0.f, 0.f, 0.f, 0.f};
#pragma unroll
                for (int ks = 0; ks < 4; ++ks) {
                    const bf16x8 za = *(const LAS bf16x8*)&GDb[ln * 136 + ks * 32 + 8 * lg], zb = *(const LAS bf16x8*)&WTg[(16 * nt + ln) * 136 + ks * 32 + 8 * lg];
                    cg_ = __builtin_amdgcn_mfma_f32_16x16x32_bf16(za, zb, cg_, 0, 0, 0);
                }
#pragma unroll
                for (int r = 0; r < 4; ++r) Gg[(4 * lg + r) * 64 + chm] = cg_[r];
            }
            LDS_BAR();
        } else {
            LAS float* A_ = RW_ARR(bufc, 0); LAS float* WR = RW_ARR(bufc, 1); LAS float* Wd = RW_ARR(bufc, 2); LAS float* Bv = RW_ARR(bufc, 3);
            LAS float* Kk = RW_ARR(bufc, 4); LAS float* Vv = RW_ARR(bufc, 5); LAS float* Yy = RW_ARR(bufc, 7); LAS float* SC = RW_SC(bufc);
#pragma unroll 1
            for (int q4 = 0; q4 < 4; ++q4) {
                if (i >= 0) {
                    f32x2 yk[4];
#pragma unroll
                    for (int s4 = 0; s4 < 4; ++s4) {
                        const int tt = 4 * q4 + s4;
                        const f32x4 a_lo = *(const LAS f32x4*)&A_[tt * 64 + 8 * jg], a_hi = *(const LAS f32x4*)&A_[tt * 64 + 8 * jg + 4];
                        const f32x4 r_lo = *(const LAS f32x4*)&WR[tt * 64 + 8 * jg], r_hi = *(const LAS f32x4*)&WR[tt * 64 + 8 * jg + 4];
                        const f32x4 w_lo = *(const LAS f32x4*)&Wd[tt * 64 + 8 * jg], w_hi = *(const LAS f32x4*)&Wd[tt * 64 + 8 * jg + 4];
                        const f32x4 b_lo = *(const LAS f32x4*)&Bv[tt * 64 + 8 * jg], b_hi = *(const LAS f32x4*)&Bv[tt * 64 + 8 * jg + 4];
                        const f32x4 k_lo = *(const LAS f32x4*)&Kk[tt * 64 + 8 * jg], k_hi = *(const LAS f32x4*)&Kk[tt * 64 + 8 * jg + 4];
                        const f32x2 vv = *(const LAS f32x2*)&Vv[tt * 64 + i0];
                        const f32x2 sc = *(const LAS f32x2*)&SC[tt * 4];
                        const f32x2 av[4] = {{a_lo.x, a_lo.y}, {a_lo.z, a_lo.w}, {a_hi.x, a_hi.y}, {a_hi.z, a_hi.w}};
                        const f32x2 rv[4] = {{r_lo.x, r_lo.y}, {r_lo.z, r_lo.w}, {r_hi.x, r_hi.y}, {r_hi.z, r_hi.w}};
                        const f32x2 wv[4] = {{w_lo.x, w_lo.y}, {w_lo.z, w_lo.w}, {w_hi.x, w_hi.y}, {w_hi.z, w_hi.w}};
                        const f32x2 bv[4] = {{b_lo.x, b_lo.y}, {b_lo.z, b_lo.w}, {b_hi.x, b_hi.y}, {b_hi.z, b_hi.w}};
                        const f32x2 kv[4] = {{k_lo.x, k_lo.y}, {k_lo.z, k_lo.w}, {k_hi.x, k_hi.y}, {k_hi.z, k_hi.w}};
                        f32x2 e10 = S0[0] * av[0], e20 = S0[0] * rv[0], e11 = S1[0] * av[0], e21 = S1[0] * rv[0];
#pragma unroll
                        for (int j = 1; j < 4; ++j) { e10 += S0[j] * av[j]; e20 += S0[j] * rv[j]; e11 += S1[j] * av[j]; e21 += S1[j] * rv[j]; }
                        const float d10 = red8(e10.x + e10.y), d20 = red8(e20.x + e20.y), d11 = red8(e11.x + e11.y), d21 = red8(e21.x + e21.y);
                        yk[s4] = (f32x2){d20 + d10 * sc.x + vv.x * sc.y, d21 + d11 * sc.x + vv.y * sc.y};
                        const f32x2 d10v = (f32x2){d10, d10}, d11v = (f32x2){d11, d11}, v0v = (f32x2){vv.x, vv.x}, v1v = (f32x2){vv.y, vv.y};
#pragma unroll
                        for (int j = 0; j < 4; ++j) { S0[j] = S0[j] * wv[j] + (d10v * bv[j] + v0v * kv[j]); S1[j] = S1[j] * wv[j] + (d11v * bv[j] + v1v * kv[j]); }
                    }
                    if (jg == 0) {
#pragma unroll
                        for (int s4 = 0; s4 < 4; ++s4) *(LAS f32x2*)&Yy[(4 * q4 + s4) * 64 + i0] = yk[s4];
                    }

#if PROBE_SCAN2
                    {
#pragma unroll
                    for (int s4 = 0; s4 < 4; ++s4) {
                        const int tt = 4 * q4 + s4;
                        const f32x4 a_lo = *(const LAS f32x4*)&A_[tt * 64 + 8 * jg], a_hi = *(const LAS f32x4*)&A_[tt * 64 + 8 * jg + 4];
                        const f32x4 r_lo = *(const LAS f32x4*)&WR[tt * 64 + 8 * jg], r_hi = *(const LAS f32x4*)&WR[tt * 64 + 8 * jg + 4];
                        const f32x4 w_lo = *(const LAS f32x4*)&Wd[tt * 64 + 8 * jg], w_hi = *(const LAS f32x4*)&Wd[tt * 64 + 8 * jg + 4];
                        const f32x4 b_lo = *(const LAS f32x4*)&Bv[tt * 64 + 8 * jg], b_hi = *(const LAS f32x4*)&Bv[tt * 64 + 8 * jg + 4];
                        const f32x4 k_lo = *(const LAS f32x4*)&Kk[tt * 64 + 8 * jg], k_hi = *(const LAS f32x4*)&Kk[tt * 64 + 8 * jg + 4];
                        const f32x2 vv = *(const LAS f32x2*)&Vv[tt * 64 + i0];
                        const f32x2 av[4] = {{a_lo.x, a_lo.y}, {a_lo.z, a_lo.w}, {a_hi.x, a_hi.y}, {a_hi.z, a_hi.w}};
                        const f32x2 rv[4] = {{r_lo.x, r_lo.y}, {r_lo.z, r_lo.w}, {r_hi.x, r_hi.y}, {r_hi.z, r_hi.w}};
                        const f32x2 wv[4] = {{w_lo.x, w_lo.y}, {w_lo.z, w_lo.w}, {w_hi.x, w_hi.y}, {w_hi.z, w_hi.w}};
                        const f32x2 bv[4] = {{b_lo.x, b_lo.y}, {b_lo.z, b_lo.w}, {b_hi.x, b_hi.y}, {b_hi.z, b_hi.w}};
                        const f32x2 kv[4] = {{k_lo.x, k_lo.y}, {k_lo.z, k_lo.w}, {k_hi.x, k_hi.y}, {k_hi.z, k_hi.w}};
                        f32x2 e10 = T0[0] * av[0], e20 = T0[0] * rv[0], e11 = T1[0] * av[0], e21 = T1[0] * rv[0];
#pragma unroll
                        for (int j = 1; j < 4; ++j) { e10 += T0[j] * av[j]; e20 += T0[j] * rv[j]; e11 += T1[j] * av[j]; e21 += T1[j] * rv[j]; }
                        const float d10 = red8(e10.x + e10.y), d20 = red8(e20.x + e20.y), d11 = red8(e11.x + e11.y), d21 = red8(e21.x + e21.y);
                        const f32x2 d10v = (f32x2){d10 + d20, d10}, d11v = (f32x2){d11 + d21, d11}, v0v = (f32x2){vv.x, vv.x}, v1v = (f32x2){vv.y, vv.y};
#pragma unroll
                        for (int j = 0; j < 4; ++j) { T0[j] = T0[j] * wv[j] + (d10v * bv[j] + v0v * kv[j]); T1[j] = T1[j] * wv[j] + (d11v * bv[j] + v1v * kv[j]); }
                    }
                    }
#endif
                }
                if (q4 & 1) LDS_BAR();
            }
        }
            }
        if (i0_ + 1 < RW_NCH) { const int i = i0_ + 1;

        const int bufn = (i + 1) & 1, bufc = i & 1;
        if (helper) {
            const bool do_prep = (i + 1 < RW_NCH);
            if (i >= 1) {
                LAS float* Yy = RW_ARR(bufn, 7); LAS float* Gg = RW_ARR(bufn, 6); LAS float* Vv = RW_ARR(bufn, 5); LAS float* SC = RW_SC(bufn);
                const f32x4 y = *(const LAS f32x4*)&Yy[tt_h * 64 + cg4], gg = *(const LAS f32x4*)&Gg[tt_h * 64 + cg4], vv = *(const LAS f32x4*)&Vv[tt_h * 64 + cg4];
                const float bonus = BON[((i - 1) % 3) * 16 + tt_h];
                const float mean = red16((y.x + y.y) + (y.z + y.w)) * (1.f / 64.f);
                const f32x4 d = y - mean;
                const float var = red16((d.x * d.x + d.y * d.y) + (d.z * d.z + d.w * d.w)) * (1.f / 64.f);
                const float rs = 1.f / sqrtf(var + 64e-5f);
                const f32x4 o = (d * rs * p_gg + p_gb + vv * bonus) * gg;
                u32x2 w; w.x = pk2(o.x, o.y); w.y = pk2(o.z, o.w);
                *(u32x2*)(X.P + ((size_t)b * SEQ + (i - 1) * RW_TS + tt_h) * LDP + COL_YA + h * 64 + cg4) = w;
            }
            if (do_prep) {
                const f32x4 r = (f32x4){bflo(l_rB.x), bfhi(l_rB.x), bflo(l_rB.y), bfhi(l_rB.y)}, k = (f32x4){bflo(l_kB.x), bfhi(l_kB.x), bflo(l_kB.y), bfhi(l_kB.y)};
                const f32x4 v = (f32x4){bflo(l_vB.x), bfhi(l_vB.x), bflo(l_vB.y), bfhi(l_vB.y)}, w1 = (f32x4){bflo(l_wB.x), bfhi(l_wB.x), bflo(l_wB.y), bfhi(l_wB.y)};
                const f32x4 a = (f32x4){bflo(l_aB.x), bfhi(l_aB.x), bflo(l_aB.y), bfhi(l_aB.y)};
                const f32x4 kk = k * p_kk * l_sB.x;
                const f32x4 decay = 1.f - w1;
                *(LAS f32x4*)&RW_ARR(bufn, 0)[tt_h * 64 + cg4] = -kk;
                *(LAS f32x4*)&RW_ARR(bufn, 1)[tt_h * 64 + cg4] = decay * r;
                *(LAS f32x4*)&RW_ARR(bufn, 2)[tt_h * 64 + cg4] = decay;
                *(LAS f32x4*)&RW_ARR(bufn, 3)[tt_h * 64 + cg4] = kk * a;
                *(LAS f32x4*)&RW_ARR(bufn, 4)[tt_h * 64 + cg4] = k * (1.f + (a - 1.f) * p_ka);
                *(LAS f32x4*)&RW_ARR(bufn, 5)[tt_h * 64 + cg4] = v;
                if (cg4 == 0) { LAS float* SC = RW_SC(bufn); SC[tt_h * 4 + 0] = l_sB.y; SC[tt_h * 4 + 1] = l_sB.z; BON[((i + 1) % 3) * 16 + tt_h] = l_sB.w; }
                float gc[8], gp[8];
                gc[0] = bflo(l_gcB.x); gc[1] = bfhi(l_gcB.x); gc[2] = bflo(l_gcB.y); gc[3] = bfhi(l_gcB.y); gc[4] = bflo(l_gcB.z); gc[5] = bfhi(l_gcB.z); gc[6] = bflo(l_gcB.w); gc[7] = bfhi(l_gcB.w);
                gp[0] = bflo(l_gpB.x); gp[1] = bfhi(l_gpB.x); gp[2] = bflo(l_gpB.y); gp[3] = bfhi(l_gpB.y); gp[4] = bflo(l_gpB.z); gp[5] = bfhi(l_gpB.z); gp[6] = bflo(l_gpB.w); gp[7] = bfhi(l_gpB.w);
#pragma unroll
                for (int e = 0; e < 8; ++e) gc[e] = sigmoidf_(gc[e] + (gp[e] - gc[e]) * (e < 4 ? mg0[e & 3] : mg1[e & 3]));
                u32x4 o; o.x = pk2(gc[0], gc[1]); o.y = pk2(gc[2], gc[3]); o.z = pk2(gc[4], gc[5]); o.w = pk2(gc[6], gc[7]);
                *(LAS u32x4*)&GDb[tt_h * 136 + gv8] = o;
            }
            if (i + 3 < RW_NCH) RW_LOAD(i + 3, B);
            LDS_BAR();
            if (do_prep) {
                LAS float* Gg = RW_ARR(bufn, 6);
                f32x4 cg_ = (f32x4){0.f, 0.f, 0.f, 0.f};
#pragma unroll
                for (int ks = 0; ks < 4; ++ks) {
                    const bf16x8 za = *(const LAS bf16x8*)&GDb[ln * 136 + ks * 32 + 8 * lg], zb = *(const LAS bf16x8*)&WTg[(16 * nt + ln) * 136 + ks * 32 + 8 * lg];
                    cg_ = __builtin_amdgcn_mfma_f32_16x16x32_bf16(za, zb, cg_, 0, 0, 0);
                }
#pragma unroll
                for (int r = 0; r < 4; ++r) Gg[(4 * lg + r) * 64 + chm] = cg_[r];
            }
            LDS_BAR();
        } else {
            LAS float* A_ = RW_ARR(bufc, 0); LAS float* WR = RW_ARR(bufc, 1); LAS float* Wd = RW_ARR(bufc, 2); LAS float* Bv = RW_ARR(bufc, 3);
            LAS float* Kk = RW_ARR(bufc, 4); LAS float* Vv = RW_ARR(bufc, 5); LAS float* Yy = RW_ARR(bufc, 7); LAS float* SC = RW_SC(bufc);
#pragma unroll 1
            for (int q4 = 0; q4 < 4; ++q4) {
                if (i >= 0) {
                    f32x2 yk[4];
#pragma unroll
                    for (int s4 = 0; s4 < 4; ++s4) {
                        const int tt = 4 * q4 + s4;
                        const f32x4 a_lo = *(const LAS f32x4*)&A_[tt * 64 + 8 * jg], a_hi = *(const LAS f32x4*)&A_[tt * 64 + 8 * jg + 4];
                        const f32x4 r_lo = *(const LAS f32x4*)&WR[tt * 64 + 8 * jg], r_hi = *(const LAS f32x4*)&WR[tt * 64 + 8 * jg + 4];
                        const f32x4 w_lo = *(const LAS f32x4*)&Wd[tt * 64 + 8 * jg], w_hi = *(const LAS f32x4*)&Wd[tt * 64 + 8 * jg + 4];
                        const f32x4 b_lo = *(const LAS f32x4*)&Bv[tt * 64 + 8 * jg], b_hi = *(const LAS f32x4*)&Bv[tt * 64 + 8 * jg + 4];
                        const f32x4 k_lo = *(const LAS f32x4*)&Kk[tt * 64 + 8 * jg], k_hi = *(const LAS f32x4*)&Kk[tt * 64 + 8 * jg + 4];
                        const f32x2 vv = *(const LAS f32x2*)&Vv[tt * 64 + i0];
                        const f32x2 sc = *(const LAS f32x2*)&SC[tt * 4];
                        const f32x2 av[4] = {{a_lo.x, a_lo.y}, {a_lo.z, a_lo.w}, {a_hi.x, a_hi.y}, {a_hi.z, a_hi.w}};
                        const f32x2 rv[4] = {{r_lo.x, r_lo.y}, {r_lo.z, r_lo.w}, {r_hi.x, r_hi.y}, {r_hi.z, r_hi.w}};
                        const f32x2 wv[4] = {{w_lo.x, w_lo.y}, {w_lo.z, w_lo.w}, {w_hi.x, w_hi.y}, {w_hi.z, w_hi.w}};
                        const f32x2 bv[4] = {{b_lo.x, b_lo.y}, {b_lo.z, b_lo.w}, {b_hi.x, b_hi.y}, {b_hi.z, b_hi.w}};
                        const f32x2 kv[4] = {{k_lo.x, k_lo.y}, {k_lo.z, k_lo.w}, {k_hi.x, k_hi.y}, {k_hi.z, k_hi.w}};
                        f32x2 e10 = S0[0] * av[0], e20 = S0[0] * rv[0], e11 = S1[0] * av[0], e21 = S1[0] * rv[0];
#pragma unroll
                        for (int j = 1; j < 4; ++j) { e10 += S0[j] * av[j]; e20 += S0[j] * rv[j]; e11 += S1[j] * av[j]; e21 += S1[j] * rv[j]; }
                        const float d10 = red8(e10.x + e10.y), d20 = red8(e20.x + e20.y), d11 = red8(e11.x + e11.y), d21 = red8(e21.x + e21.y);
                        yk[s4] = (f32x2){d20 + d10 * sc.x + vv.x * sc.y, d21 + d11 * sc.x + vv.y * sc.y};
                        const f32x2 d10v = (f32x2){d10, d10}, d11v = (f32x2){d11, d11}, v0v = (f32x2){vv.x, vv.x}, v1v = (f32x2){vv.y, vv.y};
#pragma unroll
                        for (int j = 0; j < 4; ++j) { S0[j] = S0[j] * wv[j] + (d10v * bv[j] + v0v * kv[j]); S1[j] = S1[j] * wv[j] + (d11v * bv[j] + v1v * kv[j]); }
                    }
                    if (jg == 0) {
#pragma unroll
                        for (int s4 = 0; s4 < 4; ++s4) *(LAS f32x2*)&Yy[(4 * q4 + s4) * 64 + i0] = yk[s4];
                    }

#if PROBE_SCAN2
                    {
#pragma unroll
                    for (int s4 = 0; s4 < 4; ++s4) {
                        const int tt = 4 * q4 + s4;
                        const f32x4 a_lo = *(const LAS f32x4*)&A_[tt * 64 + 8 * jg], a_hi = *(const LAS f32x4*)&A_[tt * 64 + 8 * jg + 4];
                        const f32x4 r_lo = *(const LAS f32x4*)&WR[tt * 64 + 8 * jg], r_hi = *(const LAS f32x4*)&WR[tt * 64 + 8 * jg + 4];
                        const f32x4 w_lo = *(const LAS f32x4*)&Wd[tt * 64 + 8 * jg], w_hi = *(const LAS f32x4*)&Wd[tt * 64 + 8 * jg + 4];
                        const f32x4 b_lo = *(const LAS f32x4*)&Bv[tt * 64 + 8 * jg], b_hi = *(const LAS f32x4*)&Bv[tt * 64 + 8 * jg + 4];
                        const f32x4 k_lo = *(const LAS f32x4*)&Kk[tt * 64 + 8 * jg], k_hi = *(const LAS f32x4*)&Kk[tt * 64 + 8 * jg + 4];
                        const f32x2 vv = *(const LAS f32x2*)&Vv[tt * 64 + i0];
                        const f32x2 av[4] = {{a_lo.x, a_lo.y}, {a_lo.z, a_lo.w}, {a_hi.x, a_hi.y}, {a_hi.z, a_hi.w}};
                        const f32x2 rv[4] = {{r_lo.x, r_lo.y}, {r_lo.z, r_lo.w}, {r_hi.x, r_hi.y}, {r_hi.z, r_hi.w}};
                        const f32x2 wv[4] = {{w_lo.x, w_lo.y}, {w_lo.z, w_lo.w}, {w_hi.x, w_hi.y}, {w_hi.z, w_hi.w}};
                        const f32x2 bv[4] = {{b_lo.x, b_lo.y}, {b_lo.z, b_lo.w}, {b_hi.x, b_hi.y}, {b_hi.z, b_hi.w}};
                        const f32x2 kv[4] = {{k_lo.x, k_lo.y}, {k_lo.z, k_lo.w}, {k_hi.x, k_hi.y}, {k_hi.z, k_hi.w}};
                        f32x2 e10 = T0[0] * av[0], e20 = T0[0] * rv[0], e11 = T1[0] * av[0], e21 = T1[0] * rv[0];
#pragma unroll
                        for (int j = 1; j < 4; ++j) { e10 += T0[j] * av[j]; e20 += T0[j] * rv[j]; e11 += T1[j] * av[j]; e21 += T1[j] * rv[j]; }
                        const float d10 = red8(e10.x + e10.y), d20 = red8(e20.x + e20.y), d11 = red8(e11.x + e11.y), d21 = red8(e21.x + e21.y);
                        const f32x2 d10v = (f32x2){d10 + d20, d10}, d11v = (f32x2){d11 + d21, d11}, v0v = (f32x2){vv.x, vv.x}, v1v = (f32x2){vv.y, vv.y};
#pragma unroll
                        for (int j = 0; j < 4; ++j) { T0[j] = T0[j] * wv[j] + (d10v * bv[j] + v0v * kv[j]); T1[j] = T1[j] * wv[j] + (d11v * bv[j] + v1v * kv[j]); }
                    }
                    }
#endif
                }
                if (q4 & 1) LDS_BAR();
            }
        }
            }
    }
    if (helper) {
        const int bufl = (RW_NCH - 1) & 1;
        LAS float* Yy = RW_ARR(bufl, 7); LAS float* Gg = RW_ARR(bufl, 6); LAS float* Vv = RW_ARR(bufl, 5); LAS float* SC = RW_SC(bufl);
        const f32x4 y = *(const LAS f32x4*)&Yy[tt_h * 64 + cg4], gg = *(const LAS f32x4*)&Gg[tt_h * 64 + cg4], vv = *(const LAS f32x4*)&Vv[tt_h * 64 + cg4];
        const float bonus = BON[((RW_NCH - 1) % 3) * 16 + tt_h];
        const float mean = red16((y.x + y.y) + (y.z + y.w)) * (1.f / 64.f);
        const f32x4 d = y - mean;
        const float var = red16((d.x * d.x + d.y * d.y) + (d.z * d.z + d.w * d.w)) * (1.f / 64.f);
        const float rs = 1.f / sqrtf(var + 64e-5f);
        const f32x4 o = (d * rs * p_gg + p_gb + vv * bonus) * gg;
        u32x2 w; w.x = pk2(o.x, o.y); w.y = pk2(o.z, o.w);
        *(u32x2*)(X.P + ((size_t)b * SEQ + (RW_NCH - 1) * RW_TS + tt_h) * LDP + COL_YA + h * 64 + cg4) = w;
    }
    __syncthreads();
#undef RW_ARR
#undef RW_SC
#undef RW_LOAD
}

__device__ __forceinline__ void hgrn_task(const Ctx& X, LAS unsigned char* lds, int layer, int b, int h, int vh) {
    LAS float* F = (LAS float*)(lds); LAS float* Q = (LAS float*)(lds + 16384); LAS float* Vv = (LAS float*)(lds + 32768); LAS float* O = (LAS float*)(lds + 40960);
    LAS float* LB = (LAS float*)(lds + 49152);
    const int tid = X.tid;
    const float* lbl = X.in[14];
    const int rp = tid >> 4, dg = tid & 15, v0 = 2 * rp;
    if (tid < 128) LB[tid] = (layer > 0) ? 1.f / (1.f + __expf(lbl[h * 128 + tid] - lbl[512 + h * 128 + tid])) : 0.f;
    f32x2 S0[4], S1[4];
#pragma unroll
    for (int j = 0; j < 4; ++j) { S0[j] = (f32x2){0.f, 0.f}; S1[j] = (f32x2){0.f, 0.f}; }
#define HG_LOAD(chk) do { _Pragma("unroll") for (int it = 0; it < 3; ++it) { const int idx = tid + 512 * it; raw[it] = (u32x4){0u, 0u, 0u, 0u}; \
        if (idx < 32 * 40) { const int tt = idx / 40, vv = idx - tt * 40; \
            const int col = vv < 16 ? 512 + h * 128 + 8 * vv : (vv < 32 ? h * 128 + 8 * (vv - 16) : 1024 + h * 128 + vh * 64 + 8 * (vv - 32)); \
            raw[it] = *(const u32x4*)(X.P + ((size_t)b * SEQ + (chk) * 32 + tt) * LDP + COL_PB + col); } } } while (0)
    u32x4 raw[3];
    HG_LOAD(0);
    __syncthreads();
#pragma unroll 1
    for (int ch = 0; ch < SEQ / 32; ++ch) {
        const int t0 = ch * 32;
#pragma unroll
        for (int it = 0; it < 3; ++it) {
            const int idx = tid + 512 * it;
            if (idx < 32 * 40) {
                const int tt = idx / 40, vv = idx - tt * 40;
                float x[8];
                x[0] = bflo(raw[it].x); x[1] = bfhi(raw[it].x); x[2] = bflo(raw[it].y); x[3] = bfhi(raw[it].y);
                x[4] = bflo(raw[it].z); x[5] = bfhi(raw[it].z); x[6] = bflo(raw[it].w); x[7] = bfhi(raw[it].w);
                LAS float* dst;
                if (vv < 16) {
                    dst = F + tt * 128 + 8 * vv;
#pragma unroll
                    for (int e = 0; e < 8; ++e) { const float lb = LB[8 * vv + e]; x[e] = lb + (1.f - lb) * sigmoidf_(x[e]); }
                } else if (vv < 32) dst = Q + tt * 128 + 8 * (vv - 16);
                else dst = Vv + tt * 64 + 8 * (vv - 32);
                *(LAS f32x4*)dst = (f32x4){x[0], x[1], x[2], x[3]}; *(LAS f32x4*)(dst + 4) = (f32x4){x[4], x[5], x[6], x[7]};
            }
        }
        if (ch + 1 < SEQ / 32) HG_LOAD(ch + 1);
        LDS_BAR();
#pragma unroll 4
        for (int tt = 0; tt < 32; ++tt) {
            const f32x4 f_lo = *(const LAS f32x4*)&F[tt * 128 + 8 * dg], f_hi = *(const LAS f32x4*)&F[tt * 128 + 8 * dg + 4];
            const f32x4 q_lo = *(const LAS f32x4*)&Q[tt * 128 + 8 * dg], q_hi = *(const LAS f32x4*)&Q[tt * 128 + 8 * dg + 4];
            const f32x2 vv = *(const LAS f32x2*)&Vv[tt * 64 + v0];
            const f32x2 f2[4] = {{f_lo.x, f_lo.y}, {f_lo.z, f_lo.w}, {f_hi.x, f_hi.y}, {f_hi.z, f_hi.w}};
            const f32x2 q2[4] = {{q_lo.x, q_lo.y}, {q_lo.z, q_lo.w}, {q_hi.x, q_hi.y}, {q_hi.z, q_hi.w}};
            const f32x2 v0v = (f32x2){vv.x, vv.x}, v1v = (f32x2){vv.y, vv.y};
            f32x2 a0 = (f32x2){0.f, 0.f}, a1 = (f32x2){0.f, 0.f};
#pragma unroll
            for (int j = 0; j < 4; ++j) {
                S0[j] = v0v + f2[j] * (S0[j] - v0v); S1[j] = v1v + f2[j] * (S1[j] - v1v);
                a0 += q2[j] * S0[j]; a1 += q2[j] * S1[j];
            }
            const float o0 = red16(a0.x + a0.y), o1 = red16(a1.x + a1.y);
            if (dg == 0) *(LAS f32x2*)&O[tt * 64 + v0] = (f32x2){o0, o1};
        }
        LDS_BAR();
        if (tid < 256) {
            const int tt = tid >> 3, v8 = (tid & 7) * 8;
            const f32x4 a = *(const LAS f32x4*)&O[tt * 64 + v8], c4 = *(const LAS f32x4*)&O[tt * 64 + v8 + 4];
            u32x4 o; o.x = pk2(a.x, a.y); o.y = pk2(a.z, a.w); o.z = pk2(c4.x, c4.y); o.w = pk2(c4.z, c4.w);
            *(u32x4*)(X.P + ((size_t)b * SEQ + t0 + tt) * LDP + COL_YB + h * 128 + vh * 64 + v8) = o;
        }
    }
#undef HG_LOAD
    __syncthreads();
}

__device__ __forceinline__ unsigned f2ord(float f) { const unsigned u = __builtin_bit_cast(unsigned, f); return (u & 0x80000000u) ? ~u : (u | 0x80000000u); }

__device__ __forceinline__ void dsa_tile(const Ctx& X, LAS unsigned char* lds, int b, int q0) {
    LAS float* sc = (LAS float*)lds;
    LAS unsigned* MASK = (LAS unsigned*)(lds + MASK_OFF);
    const int lane = X.lane, w = X.wave, n = lane & 15, g = lane >> 4;
    const bf16_t* Pb = X.P + (size_t)b * SEQ * LDP;
#pragma unroll 1
    for (int sub = 0; sub < 4; ++sub) {
        const int qs = q0 + 16 * sub;
        {
            bf16x8 bq[4][2]; float wi[4];
            const bf16_t* qrow = Pb + (size_t)(qs + n) * LDP;
#pragma unroll
            for (int hh = 0; hh < 4; ++hh) {
#pragma unroll
                for (int ks = 0; ks < 2; ++ks) bq[hh][ks] = *(const bf16x8*)(qrow + C_QI + hh * 64 + ks * 32 + 8 * g);
                wi[hh] = bf2f(qrow[C_WI + hh]);
            }
            const int nkt = (qs + 16) >> 4;
            bf16x8 a0n = (bf16x8){0, 0, 0, 0, 0, 0, 0, 0}, a1n = a0n;
            if (w < nkt) { const bf16_t* krow = Pb + (size_t)(w * 16 + n) * LDP + C_KI; a0n = *(const bf16x8*)(krow + 8 * g); a1n = *(const bf16x8*)(krow + 32 + 8 * g); }
#pragma unroll 1
            for (int kt = w; kt < nkt; kt += 8) {
                const bf16x8 a0 = a0n, a1 = a1n;
                if (kt + 8 < nkt) { const bf16_t* krow = Pb + (size_t)((kt + 8) * 16 + n) * LDP + C_KI; a0n = *(const bf16x8*)(krow + 8 * g); a1n = *(const bf16x8*)(krow + 32 + 8 * g); }
                f32x4 s = (f32x4){0.f, 0.f, 0.f, 0.f};
#pragma unroll
                for (int hh = 0; hh < 4; ++hh) {
                    f32x4 d = __builtin_amdgcn_mfma_f32_16x16x32_bf16(a0, bq[hh][0], (f32x4){0.f, 0.f, 0.f, 0.f}, 0, 0, 0);
                    d = __builtin_amdgcn_mfma_f32_16x16x32_bf16(a1, bq[hh][1], d, 0, 0, 0);
#pragma unroll
                    for (int r = 0; r < 4; ++r) s[r] += wi[hh] * fmaxf(d[r], 0.f);
                }
                const int t = qs + n;
#pragma unroll
                for (int r = 0; r < 4; ++r) if (kt * 16 + 4 * g + r > t) s[r] = -INFINITY;
                *(LAS f32x4*)&sc[n * SCS + kt * 16 + 4 * g] = s;
            }
        }
        __syncthreads();
#pragma unroll 1
        for (int e = 0; e < 2; ++e) {
            const int qn = 2 * w + e, t = qs + qn;
            LAS unsigned* mrow = MASK + (sub * 16 + qn) * 64;
            if (t < 256) {
#pragma unroll
                for (int j = 0; j < 32; ++j) {
                    const unsigned long long sm = __ballot(j * 64 + lane <= t);
                    if (lane == 0) { mrow[2 * j] = (unsigned)sm; mrow[2 * j + 1] = (unsigned)(sm >> 32); }
                }
            } else {
                const int jn = (t >> 6) + 1;
                unsigned u[32];
#pragma unroll
                for (int j = 0; j < 32; ++j) {
                    u[j] = 0u;
                    if (j < jn) { const int key = j * 64 + lane; const float s = (key <= t) ? sc[qn * SCS + key] : -INFINITY; u[j] = f2ord(s); }
                }
                unsigned prefix = 0u;
#define DSA_BITSEARCH(JN) do { _Pragma("unroll 1") for (int bit = 31; bit >= 0; --bit) { const unsigned cand = prefix | (1u << bit); int c0 = 0, c1 = 0; \
                    _Pragma("unroll") for (int j = 0; j < (JN); j += 2) { c0 += (u[j] >= cand) ? 1 : 0; c1 += (u[j + 1] >= cand) ? 1 : 0; } \
                    const int cnt = (int)wave_sum_fast((float)(c0 + c1)); if (cnt >= 256) prefix = cand; } } while (0)
                if (jn <= 8) DSA_BITSEARCH(8); else if (jn <= 16) DSA_BITSEARCH(16); else if (jn <= 24) DSA_BITSEARCH(24); else DSA_BITSEARCH(32);
#undef DSA_BITSEARCH
                int cg_ = 0;
#pragma unroll
                for (int j = 0; j < 32; ++j) if (j < jn) cg_ += __popcll(__ballot(u[j] > prefix));
                const int need = 256 - cg_;
                int cum = 0;
#pragma unroll
                for (int j = 0; j < 32; ++j) {
                    unsigned long long sm = 0ull;
                    if (j < jn) {
                        const bool eq = (u[j] == prefix);
                        const unsigned long long em = __ballot(eq);
                        const int rank = cum + (int)__builtin_amdgcn_mbcnt_hi((unsigned)(em >> 32), __builtin_amdgcn_mbcnt_lo((unsigned)em, 0u));
                        const bool sel = (u[j] > prefix) || (eq && rank < need);
                        sm = __ballot(sel);
                        cum += __popcll(em);
                    }
                    if (lane == 0) { mrow[2 * j] = (unsigned)sm; mrow[2 * j + 1] = (unsigned)(sm >> 32); }
                }
            }
        }
        __syncthreads();
    }
    const int qq = q0 + 8 * w + (n & 7);
    const LAS unsigned* mq = MASK + (8 * w + (n & 7)) * 64;
    const int nsteps = (q0 + 8 * w + 8 + 31) >> 5;
    const int nblk = (q0 + 64 + 127) >> 7;
    LAS bf16_t* KT = (LAS bf16_t*)lds;
    LAS bf16_t* VTT = (LAS bf16_t*)(lds + 36864);
    const int tid = X.tid;
#pragma unroll 1
    for (int c = 0; c < 2; ++c) {
        bf16x8 bq[2][2];
#pragma unroll
        for (int j = 0; j < 2; ++j)
#pragma unroll
            for (int ks = 0; ks < 2; ++ks) bq[j][ks] = *(const bf16x8*)(Pb + (size_t)qq * LDP + C_Q + (c * 4 + 2 * j + (n >> 3)) * 64 + ks * 32 + 8 * g);
        float lrun[2] = {0.f, 0.f};
        f32x4 oacc[4][2];
#pragma unroll
        for (int mt = 0; mt < 4; ++mt)
#pragma unroll
            for (int j = 0; j < 2; ++j) oacc[mt][j] = (f32x4){0.f, 0.f, 0.f, 0.f};
        const bf16_t* vtb = X.VT + ((size_t)(b * 2 + c) * 64) * SEQ;
        u32x4 gk[2], gv[2];
#define DSA_GLOAD(kblk) do { _Pragma("unroll") for (int it = 0; it < 2; ++it) { const int idx = tid + 512 * it; \
            gk[it] = *(const u32x4*)(Pb + (size_t)((kblk) * 128 + (idx >> 3)) * LDP + C_K + c * 64 + (idx & 7) * 8); \
            gv[it] = *(const u32x4*)(vtb + (size_t)(idx >> 4) * SEQ + (kblk) * 128 + (idx & 15) * 8); } } while (0)
#define DSA_LSTORE(bufi) do { _Pragma("unroll") for (int it = 0; it < 2; ++it) { const int idx = tid + 512 * it; \
            *(LAS u32x4*)(KT + (bufi) * 9216 + (idx >> 3) * 72 + (idx & 7) * 8) = gk[it]; \
            *(LAS u32x4*)(VTT + (bufi) * 8704 + (idx >> 4) * 136 + (idx & 15) * 8) = gv[it]; } } while (0)
        DSA_GLOAD(0);
        LDS_BAR();
        DSA_LSTORE(0);
        LDS_BAR();
#pragma unroll 1
        for (int kb = 0; kb < nblk; ++kb) {
            const int buf = kb & 1;
            if (kb + 1 < nblk) DSA_GLOAD(kb + 1);
            const LAS bf16_t* Kb = KT + buf * 9216; const LAS bf16_t* Vb = VTT + buf * 8704;
#pragma unroll 1
            for (int sl = 0; sl < 4; ++sl) {
                const int sg = kb * 4 + sl;
                if (sg < nsteps) {
                    f32x4 st[2][2];
#pragma unroll
                    for (int tl = 0; tl < 2; ++tl) {
                        const LAS bf16_t* kr = Kb + (32 * sl + 16 * tl + n) * 72;
                        const bf16x8 a0 = *(const LAS bf16x8*)(kr + 8 * g), a1 = *(const LAS bf16x8*)(kr + 32 + 8 * g);
#pragma unroll
                        for (int j = 0; j < 2; ++j) {
                            f32x4 d = __builtin_amdgcn_mfma_f32_16x16x32_bf16(a0, bq[j][0], (f32x4){0.f, 0.f, 0.f, 0.f}, 0, 0, 0);
                            st[tl][j] = __builtin_amdgcn_mfma_f32_16x16x32_bf16(a1, bq[j][1], d, 0, 0, 0);
                        }
                    }
                    bf16x8 av[4];
#pragma unroll
                    for (int mt = 0; mt < 4; ++mt) {
                        const LAS bf16_t* vp = Vb + (mt * 16 + n) * 136 + 32 * sl + 4 * g;
                        const u32x2 lo = *(const LAS u32x2*)vp, hi = *(const LAS u32x2*)(vp + 16);
                        u32x4 t4; t4.x = lo.x; t4.y = lo.y; t4.z = hi.x; t4.w = hi.y;
                        av[mt] = __builtin_bit_cast(bf16x8, t4);
                    }
                    const unsigned mw = mq[sg];
#pragma unroll
                    for (int j = 0; j < 2; ++j) {
                        float p[8], ps = 0.f;
#pragma unroll
                        for (int tl = 0; tl < 2; ++tl)
#pragma unroll
                            for (int r = 0; r < 4; ++r) { const int bit = 16 * tl + 4 * g + r; const float e = __expf(fminf(st[tl][j][r] * 0.125f, 60.f)); p[4 * tl + r] = ((mw >> bit) & 1u) ? e : 0.f; ps += p[4 * tl + r]; }
                        lrun[j] += ps;
                        u32x4 pw; pw.x = pg8::cvt_pk_bf16(p[0], p[1]); pw.y = pg8::cvt_pk_bf16(p[2], p[3]); pw.z = pg8::cvt_pk_bf16(p[4], p[5]); pw.w = pg8::cvt_pk_bf16(p[6], p[7]);
                        const bf16x8 pb = __builtin_bit_cast(bf16x8, pw);
#pragma unroll
                        for (int mt = 0; mt < 4; ++mt) oacc[mt][j] = __builtin_amdgcn_mfma_f32_16x16x32_bf16(av[mt], pb, oacc[mt][j], 0, 0, 0);
                    }
                }
            }
            if (kb + 1 < nblk) DSA_LSTORE(buf ^ 1);
            LDS_BAR();
        }
#pragma unroll
        for (int j = 0; j < 2; ++j) {
            float lt = lrun[j]; lt += __shfl_xor(lt, 16); lt += __shfl_xor(lt, 32);
            const float il = 1.f / lt;
            bf16_t* op = X.P + ((size_t)b * SEQ + qq) * LDP + COL_YC + (c * 4 + 2 * j + (n >> 3)) * 64 + 4 * g;
#pragma unroll
            for (int mt = 0; mt < 4; ++mt) {
                const f32x4 o = oacc[mt][j] * il;
                u32x2 wv; wv.x = pg8::cvt_pk_bf16(o[0], o[1]); wv.y = pg8::cvt_pk_bf16(o[2], o[3]);
                *(u32x2*)(op + mt * 16) = wv;
            }
        }
    }
#undef DSA_GLOAD
#undef DSA_LSTORE
    __syncthreads();
}

__device__ __forceinline__ void phase_mixers(const Ctx& X0, LAS unsigned char* lds, int layer) {
#pragma unroll 1
    for (int task = X0.bid; task < 128; task += X0.G) {
        Ctx X = X0;
        { int t_ = threadIdx.x; asm volatile("" : "+v"(t_)); X.tid = t_; X.lane = t_ & 63; }
        if (task < 64) { if (TKMASK & 1) rwkv_task(X, lds, layer, task >> 3, task & 7); }
        else { const int k = task - 64; if (TKMASK & 2) hgrn_task(X, lds, layer, k >> 3, (k >> 1) & 3, k & 1); }
    }
    volatile LAS unsigned* tw = (volatile LAS unsigned*)(lds + LDS_BYTES - 128);
    unsigned* ctr = (unsigned*)(X0.ws + WS_BAR + 14336) + 16 * layer;
#pragma unroll 1
    for (;;) {
        Ctx X = X0;
        { int t_ = threadIdx.x; asm volatile("" : "+v"(t_)); X.tid = t_; X.lane = t_ & 63; }
        __syncthreads();
        if (threadIdx.x == 0) tw[0] = __hip_atomic_fetch_add(ctr, 1u, __ATOMIC_RELAXED, __HIP_MEMORY_SCOPE_AGENT);
        __syncthreads();
        const int t = (int)tw[0];
        if (t >= 256) break;
        if (TKMASK & 4) dsa_tile(X, lds, t & 7, 64 * (31 - (t >> 3)));
    }
}

__device__ __forceinline__ void phase_hgrn_post(const Ctx& X, int layer) {
    const int gw = X.bid * 8 + X.wave, NGW = X.G * 8;
    const float* gn = X.in[15] + layer * 512;
#pragma unroll 1
    for (int it0 = gw; it0 < T_TOK * 4; it0 += 4 * NGW) {
        unsigned ow[4], gwd[4]; unsigned* op[4];
#pragma unroll
        for (int r = 0; r < 4; ++r) {
            const int it = it0 + r * NGW < T_TOK * 4 ? it0 + r * NGW : it0;
            const int t = it >> 2, h = it & 3;
            bf16_t* rowp = X.P + (size_t)t * LDP;
            op[r] = (unsigned*)(rowp + COL_YB + h * 128) + X.lane;
            ow[r] = *op[r]; gwd[r] = *((const unsigned*)(rowp + COL_PB + 1536 + h * 128) + X.lane);
        }
#pragma unroll
        for (int r = 0; r < 4; ++r) {
            const int it = it0 + r * NGW;
            const int h = it & 3;
            const float o0 = bflo(ow[r]), o1 = bfhi(ow[r]), g0 = bflo(gwd[r]), g1 = bfhi(gwd[r]);
            const float rs = 1.f / sqrtf(wave_sum(o0 * o0 + o1 * o1) * (1.f / 128.f) + 1e-6f);
            const float y0 = o0 * rs * gn[h * 128 + 2 * X.lane] * (g0 * sigmoidf_(g0)), y1 = o1 * rs * gn[h * 128 + 2 * X.lane + 1] * (g1 * sigmoidf_(g1));
            if (it < T_TOK * 4) *op[r] = pk2(y0, y1);
        }
    }
}

__device__ __forceinline__ void phase_fixup(const Ctx& X, int layer) {
    const float* cw = X.in[20] + (size_t)layer * 3 * F2; const float* cb = X.in[21] + (size_t)layer * F2;
    for (int idx = X.bid * 512 + X.tid; idx < 256 * 2 * DFF; idx += X.G * 512) {
        const int j = idx % DFF, sr = idx / DFF, s = sr >> 1, r = sr & 1;
        const int colg = (j >> 7) * 256 + (j & 127), colv = colg + 128;
        const bool seq0 = (s & 31) == 0;
        const float* H = X.HALO;
        float res[2];
#pragma unroll
        for (int part = 0; part < 2; ++part) {
            const int cp = part ? colv : colg, co = part * DFF + j;
            const float u0 = H[(size_t)(s * 4 + r) * F2 + cp];
            float u1, u2;
            if (r == 0) { u1 = seq0 ? 0.f : H[(size_t)((s - 1) * 4 + 3) * F2 + cp]; u2 = seq0 ? 0.f : H[(size_t)((s - 1) * 4 + 2) * F2 + cp]; }
            else { u1 = H[(size_t)(s * 4 + 0) * F2 + cp]; u2 = seq0 ? 0.f : H[(size_t)((s - 1) * 4 + 3) * F2 + cp]; }
            res[part] = cb[co] + cw[co] * u2 + cw[F2 + co] * u1 + cw[2 * F2 + co] * u0;
        }
        const float a = res[0] * sigmoidf_(res[0]) * res[1];
        X.P[(size_t)(s * 64 + r) * LDP + COL_ACT + j] = (bf16_t)f2bf(a);
    }
}

#define XB_TMO      128
#define XB_XCNT(j)  (256  + 64 * (j))
#define XB_XSUB(j)  (1280 + 64 * (j))
#define XB_XGEN(j)  (2304 + 64 * (j))
#define XB_TOP      3328
#define XB_TOPGEN   3392
#define XCD_BAR_WORDS 3456
#define XB_SPIN_CAP (1u << 22)
__device__ __forceinline__ unsigned xb_ld(unsigned* p)              { return __hip_atomic_load(p, __ATOMIC_RELAXED, __HIP_MEMORY_SCOPE_AGENT); }
__device__ __forceinline__ unsigned xb_add(unsigned* p, unsigned v) { return __hip_atomic_fetch_add(p, v, __ATOMIC_RELAXED, __HIP_MEMORY_SCOPE_AGENT); }
__device__ __forceinline__ unsigned xb_xcc_id() { return (unsigned)__builtin_amdgcn_s_getreg((3 << 11) | 20) & 0xFu; }
#define XB_SPIN(cond, bar) do { unsigned _sp = 0; while (cond) { __builtin_amdgcn_s_sleep(1); \
    if ((++_sp & 255u) == 0u) { if (xb_ld(&(bar)[XB_TMO])) break; if (_sp > XB_SPIN_CAP) { atomicAdd(&(bar)[XB_TMO], 1u); break; } } } } while (0)
struct XcdBarrier { unsigned* bar; unsigned x; volatile LAS unsigned* st; };
__device__ __forceinline__ XcdBarrier xcd_barrier_post(unsigned* bar, volatile LAS unsigned* st) {
    XcdBarrier b; b.bar = bar; b.x = xb_xcc_id(); b.st = st;
    if (threadIdx.x == 0) (void)xb_add(&bar[XB_XCNT(b.x)], 1u);
    return b;
}
__device__ __forceinline__ void xcd_barrier_complete(unsigned* bar, unsigned x, unsigned& nloc, unsigned& nx) {
    const unsigned G = gridDim.x * gridDim.y * gridDim.z;
    unsigned sum, cnt, mine, sp = 0u;
    for (;;) {
        sum = 0u; cnt = 0u; mine = 0u;
#pragma unroll
        for (unsigned j = 0; j < 16; ++j) { const unsigned c = xb_ld(&bar[XB_XCNT(j)]); sum += c; cnt += (c > 0u) ? 1u : 0u; mine = (j == x) ? c : mine; }
        if (sum == G) break;
        __builtin_amdgcn_s_sleep(1);
        if ((++sp & 255u) == 0u) { if (xb_ld(&bar[XB_TMO])) break; if (sp > XB_SPIN_CAP) { atomicAdd(&bar[XB_TMO], 1u); break; } }
    }
    nloc = mine > 0u ? mine : 1u; nx = cnt > 0u ? cnt : 1u;
}
__device__ __forceinline__ void xcd_barrier(const XcdBarrier& b) {
    asm volatile("s_waitcnt vmcnt(0)" ::: "memory");
    __syncthreads();
    if (threadIdx.x == 0) {
        unsigned* bar = b.bar;
        __builtin_amdgcn_s_waitcnt(0);
        unsigned nloc = b.st[0], nx = b.st[1];
        if (nloc == 0u) { xcd_barrier_complete(bar, b.x, nloc, nx); b.st[0] = nloc; b.st[1] = nx; }
        const unsigned old = xb_add(&bar[XB_XSUB(b.x)], 1u);
        const unsigned gen = old / nloc;
        if (old + 1u == (gen + 1u) * nloc) {
            __builtin_amdgcn_fence(__ATOMIC_RELEASE, "agent");
            asm volatile("s_waitcnt vmcnt(0)" ::: "memory");
            const unsigned og = xb_add(&bar[XB_TOP], 1u);
            const unsigned tg = og / nx;
            if (og + 1u == (tg + 1u) * nx) xb_add(&bar[XB_TOPGEN], 1u);
            else XB_SPIN(xb_ld(&bar[XB_TOPGEN]) == tg, bar);
            __builtin_amdgcn_fence(__ATOMIC_ACQUIRE, "agent");
            xb_add(&bar[XB_XGEN(b.x)], 1u);
            asm volatile("s_waitcnt vmcnt(0)" ::: "memory");
        } else {
            XB_SPIN(xb_ld(&bar[XB_XGEN(b.x)]) == gen, bar);
            __builtin_amdgcn_fence(__ATOMIC_ACQUIRE, "agent");
            asm volatile("s_waitcnt vmcnt(0)" ::: "memory");
        }
    }
    __syncthreads();
}

__global__ void __launch_bounds__(512, 2) mk_fwd(Args args) {
    extern __shared__ __attribute__((aligned(16))) unsigned char lds_raw[];
    LAS unsigned char* lds = (LAS unsigned char*)lds_raw;
    Ctx X;
#pragma unroll
    for (int i = 0; i < 24; ++i) X.in[i] = args.in[i];
    X.out = args.out; X.ws = args.ws;
    X.P = (bf16_t*)(args.ws + WS_P); X.VT = (bf16_t*)(args.ws + WS_VT); X.HALO = (float*)(args.ws + WS_HALO); X.ROPE = (float*)(args.ws + WS_ROPE);
    X.Win = (bf16_t*)(args.ws + WS_WIN); X.Wg = (bf16_t*)(args.ws + WS_WG); X.Wbr = (bf16_t*)(args.ws + WS_WBR);
    X.Wo = (bf16_t*)(args.ws + WS_WO); X.Wup = (bf16_t*)(args.ws + WS_WUP); X.Wdn = (bf16_t*)(args.ws + WS_WDN);
    X.tid = threadIdx.x; X.lane = X.tid & 63; X.wave = __builtin_amdgcn_readfirstlane(X.tid >> 6); X.G = gridDim.x; X.bid = blockIdx.x;

#if PROBE_DOUBLE
    for (int ph2 = args.ph_lo * 2; ph2 < args.ph_hi * 2; ++ph2) {
        const int ph = ph2 >> 1;
        const int layer = ph / 11, sub = ph % 11;
        const bool skip_ = (ph2 & 1) && !(ph < 22 && ((REPMASK >> sub) & 1));
#else
    volatile LAS unsigned* bst = (volatile LAS unsigned*)(lds + LDS_BYTES - 64);
    if (threadIdx.x < 2) bst[threadIdx.x] = 0u;
    __syncthreads();
    XcdBarrier gbar = xcd_barrier_post((unsigned*)(args.ws + WS_BAR), bst);
    for (int ph = args.ph_lo; ph < args.ph_hi; ++ph) {
        const int layer = ph / 11, sub = ph % 11;
        const bool skip_ = false;
#endif
        { int t_ = threadIdx.x; asm volatile("" : "+v"(t_)); X.tid = t_; X.lane = t_ & 63; }

        if (skip_) {
        } else if (ph == 22 && (PHMASK & 1024)) {
            const int gw = X.bid * 8 + X.wave, NGW = X.G * 8;
            (void)gw; (void)NGW; rms_pass(X, X.out, X.in[23], nullptr, X.out);
        } else if (sub == 0 && (PHMASK & 1)) {
            phase_prep(X, lds, layer);
        } else if (sub == 1 && (PHMASK & 2)) {
            pg8::Gemm g{X.P, X.Win, LDP, DM, DM}; pg8::StaticOrder S; S.init(T_TOK, 5120, X.G, X.bid);
            pg8::EpiInProj E{X.P, X.VT, X.ROPE, (bf16_t*)(X.ws + WS_BND)};
            pg8::gemm_phase<pg8::EpiInProj, true>(lds, g, S, E, X.tid);
        } else if (sub == 2 && (PHMASK & 4)) {
            phase_rwkv_pre(X, lds, layer);
        } else if (sub == 3 && (PHMASK & 4)) {
            phase_mixers(X, lds, layer);
        } else if (sub == 4 && (PHMASK & 8)) {
            phase_hgrn_post(X, layer);
            { const int gw = X.bid * 8 + X.wave, NGW = X.G * 8; const float* hh = (layer == 0) ? X.in[0] : X.out; const float* g = X.in[1] + (size_t)layer * DM;
              (void)gw; (void)NGW; rms_pass(X, hh, g, X.P, nullptr); }
        } else if (sub == 5 && (PHMASK & 16)) {
#pragma unroll 1
            for (int br = 0; br < 3; ++br) {
                { pg8::Gemm g{X.P, X.Wg + (size_t)br * DM * DM, LDP, DM, DM}; pg8::StaticOrder S; S.init(T_TOK, DM, X.G, X.bid);
                  int t_ = X.tid; asm volatile("" : "+v"(t_));
                  pg8::EpiGate E{X.P}; pg8::gemm_phase<pg8::EpiGate, true>(lds, g, S, E, t_); }
                { const int ycol = br == 0 ? COL_YA : (br == 1 ? COL_YB : COL_YC);
                  pg8::Gemm g{X.P + ycol, X.Wbr + (size_t)br * DM * 512, LDP, 512, 512}; pg8::StaticOrder S; S.init(T_TOK, DM, X.G, X.bid);
                  int t_ = X.tid; asm volatile("" : "+v"(t_));
                  pg8::EpiMergeAcc E{X.P, br == 0 ? 1 : 0}; pg8::gemm_phase<pg8::EpiMergeAcc, true>(lds, g, S, E, t_); }
            }
        } else if (sub == 6 && (PHMASK & 32)) {
            pg8::Gemm g{X.P + COL_MRG, X.Wo, LDP, DM, DM}; pg8::StaticOrder S; S.init(T_TOK, DM, X.G, X.bid);
            pg8::EpiResid E{layer == 0 ? X.in[0] : X.out, X.out};
            pg8::gemm_phase<pg8::EpiResid, true>(lds, g, S, E, X.tid);
        } else if (sub == 7 && (PHMASK & 64)) {
            const int gw = X.bid * 8 + X.wave, NGW = X.G * 8;
            const float* g = X.in[18] + (size_t)layer * DM;
            (void)gw; (void)NGW; rms_pass(X, X.out, g, X.P, nullptr);
        } else if (sub == 8 && (PHMASK & 128)) {
            pg8::Gemm g{X.P, X.Wup, LDP, DM, DM}; pg8::StaticOrder S; S.init(T_TOK, F2, X.G, X.bid);
            pg8::EpiUp E{X.P, X.HALO, X.in[20] + (size_t)layer * 3 * F2, X.in[21] + (size_t)layer * F2, (LAS float*)(lds + 131072)};
            pg8::gemm_phase<pg8::EpiUp, true>(lds, g, S, E, X.tid);
        } else if (sub == 9 && (PHMASK & 256)) {
            phase_fixup(X, layer);
        } else if (sub == 10 && (PHMASK & 512)) {
            pg8::Gemm g{X.P + COL_ACT, X.Wdn, LDP, DFF, DFF}; pg8::StaticOrder S; S.init(T_TOK, DM, X.G, X.bid);
            pg8::EpiResid E{X.out, X.out};
            pg8::gemm_phase<pg8::EpiResid, true>(lds, g, S, E, X.tid);
        }
#if PROBE_DOUBLE
        if (ph2 + 1 < args.ph_hi * 2) cg::this_grid().sync();
#else
        if (ph + 1 < args.ph_hi) { if (ph == args.ph_lo) cg::this_grid().sync(); else xcd_barrier(gbar); }
#endif
    }
}

extern "C" void kernel_launch(void* const* d_in, const int* in_sizes, int n_in, void* d_out, int out_size, void* d_ws, size_t ws_size, hipStream_t stream) {
    static int grid = 0;
    if (grid == 0) {
        int dev = 0, cus = 0, per_cu = 0;
        (void)hipGetDevice(&dev);
        (void)hipDeviceGetAttribute(&cus, hipDeviceAttributeMultiprocessorCount, dev);
        if (hipFuncSetAttribute((const void*)mk_fwd, hipFuncAttributeMaxDynamicSharedMemorySize, LDS_BYTES) != hipSuccess) fprintf(stderr, "kernel_launch: hipFuncSetAttribute failed\n");
        if (hipOccupancyMaxActiveBlocksPerMultiprocessor(&per_cu, (const void*)mk_fwd, 512, LDS_BYTES) != hipSuccess || per_cu < 1) { fprintf(stderr, "kernel_launch: occupancy query gave %d\n", per_cu); per_cu = 1; }
        (void)hipGetLastError();
        grid = cus * 1;
        if (grid <= 0) grid = 256;
        if (ws_size < (size_t)268435456) fprintf(stderr, "kernel_launch: workspace too small (%zu)\n", ws_size);
    }
    Args a{};
    for (int i = 0; i < 24; ++i) a.in[i] = (const float*)d_in[i];
    a.out = (float*)d_out; a.ws = (unsigned char*)d_ws;
#if MK_SINGLE
    (void)hipMemsetAsync((char*)d_ws + WS_BAR, 0, 16384, stream);
    a.ph_lo = 0; a.ph_hi = 23;
    void* kargs[] = {&a};
    hipError_t e = hipLaunchCooperativeKernel((const void*)mk_fwd, dim3(grid), dim3(512), kargs, LDS_BYTES, stream);
    if (e != hipSuccess) fprintf(stderr, "cooperative launch failed: %s (grid %d)\n", hipGetErrorString(e), grid);
#else
    for (int ph = 0; ph < 23; ++ph) {
        a.ph_lo = ph; a.ph_hi = ph + 1;
        hipLaunchKernelGGL(mk_fwd, dim3(grid), dim3(512), LDS_BYTES, stream, a);
    }
#endif
}
```

```cpp
#include <hip/hip_runtime.h>
#include <hip/hip_cooperative_groups.h>
#include <cstdio>
#include <cstdint>
namespace cg = cooperative_groups;

#ifndef PHMASK
#define PHMASK 2047
#endif
#ifndef REPMASK
#define REPMASK 0
#endif
#ifndef PROBE_DOUBLE
#define PROBE_DOUBLE 0
#endif
#ifndef PROBE_SCAN2
#define PROBE_SCAN2 0
#endif
#ifndef TKMASK
#define TKMASK 7
#endif
#ifndef MK_SINGLE
#define MK_SINGLE 1
#endif

#define LAS __attribute__((address_space(3)))
typedef unsigned short bf16_t;
typedef short bf16x8 __attribute__((ext_vector_type(8)));
typedef float f32x4 __attribute__((ext_vector_type(4)));
typedef float f32x2 __attribute__((ext_vector_type(2)));
typedef unsigned u32x4 __attribute__((ext_vector_type(4)));
typedef unsigned u32x2 __attribute__((ext_vector_type(2)));

constexpr int T_TOK = 16384, SEQ = 2048, DM = 1024;
constexpr int LDP = 6144;
constexpr int COL_PA = 1024, COL_PB = 2816, COL_PC = 4864;
constexpr int COL_YA = 1024, COL_MRG = 1536, COL_G = 2816, COL_YB = 3840, COL_YC = 4864, COL_ACT = 1024;
constexpr int C_Q = 4864, C_K = 5376, C_QI = 5632, C_KI = 5888, C_WI = 5952;
constexpr int IN_COLS = 8004, DFF = 2816, F2 = 5632;
constexpr size_t WS_WIN = 0, WS_WG = 10485760, WS_WBR = 16777216, WS_WO = 19922944, WS_WUP = 22020096, WS_WDN = 33554432;
constexpr size_t WS_P = 41943040, WS_HALO = 243269632, WS_VT = WS_HALO, WS_ROPE = 266338304, WS_BAR = 266862592, WS_BND = WS_HALO + 4194304, WS_SCAL = WS_HALO + 8388608;
constexpr int LDS_BYTES = 153600;
constexpr int SCS = 2052;
constexpr int MASK_OFF = 16 * SCS * 4;

struct Args { const float* in[24]; float* out; unsigned char* ws; int ph_lo, ph_hi; };

__device__ __forceinline__ unsigned f2bf(float f) { unsigned u = __builtin_bit_cast(unsigned, f); return (u + 0x7fffu + ((u >> 16) & 1u)) >> 16; }
__device__ __forceinline__ unsigned pk2(float lo, float hi) { return f2bf(lo) | (f2bf(hi) << 16); }
__device__ __forceinline__ float bf2f(bf16_t b) { return __builtin_bit_cast(float, (unsigned)b << 16); }
__device__ __forceinline__ float bflo(unsigned w) { return __builtin_bit_cast(float, w << 16); }
__device__ __forceinline__ float bfhi(unsigned w) { return __builtin_bit_cast(float, w & 0xffff0000u); }
__device__ __forceinline__ float wave_sum(float v) {
#pragma unroll
    for (int o = 1; o < 64; o <<= 1) v += __shfl_xor(v, o);
    return v;
}
__device__ __forceinline__ int wave_sum_i(int v) {
#pragma unroll
    for (int o = 1; o < 64; o <<= 1) v += __shfl_xor(v, o);
    return v;
}
template <int CTRL> __device__ __forceinline__ float dpp_mov(float x) {
    return __builtin_bit_cast(float, __builtin_amdgcn_update_dpp(0, __builtin_bit_cast(int, x), CTRL, 0xF, 0xF, true));
}
__device__ __forceinline__ float red8(float x) { x += dpp_mov<0xB1>(x); x += dpp_mov<0x4E>(x); x += dpp_mov<0x141>(x); return x; }
__device__ __forceinline__ float red16(float x) { x = red8(x); x += dpp_mov<0x140>(x); return x; }
__device__ __forceinline__ float sigmoidf_(float x) { return 1.f / (1.f + __expf(-x)); }

namespace pg8 {
constexpr int BM = 256, BK = 64, HALF = 128, HTB = HALF * BK * 2, NXCD = 8, WGM = 8;
__device__ __forceinline__ int lds_byte(int r, int c) { const int st = (r >> 4) * 2 + (c >> 5), rr = r & 15, cc = c & 31, ob = rr * 64 + cc * 2; return st * 1024 + (ob ^ (((ob >> 9) & 1) << 5)); }
__device__ __forceinline__ void stage_rc(int b, int& R, int& C) { const int st = b / 1024, sb = b % 1024, swz = sb ^ (((sb >> 9) & 1) << 5); R = (st >> 1) * 16 + swz / 64; C = (st & 1) * 32 + (swz % 64) / 2; }
__device__ __forceinline__ int perm32(int rho) { const int n = rho >> 4, i = rho & 15; return 8 * (i >> 2) + 4 * n + (i & 3); }
struct Unit { int pm, pn; };
struct Gemm { const bf16_t* A; const bf16_t* Bt; int lda, ldb, K; };
struct StaticOrder {
    int nM, nN, nwg, G, c;
    __device__ void init(int M, int N, int G_, int c_) { nM = M / BM; nN = N / BM; nwg = nM * nN; G = G_; c = c_; }
    __device__ bool next(int i, Unit& u) const {
        const long L = (long)i * G + c; if (L >= nwg) return false;
        int wgid = (int)L; { const int q = nwg / NXCD, r = nwg % NXCD, xcd = wgid % NXCD, off = wgid / NXCD; wgid = (xcd < r ? xcd * (q + 1) : r * (q + 1) + (xcd - r) * q) + off; }
        const int nig = WGM * nN, gid = wgid / nig, fm = gid * WGM, gsz = (nM - fm) < WGM ? (nM - fm) : WGM;
        u.pm = fm + ((wgid % nig) % gsz); u.pn = (wgid % nig) / gsz; return true;
    }
};
__device__ __forceinline__ unsigned cvt_pk_bf16(float lo, float hi) { unsigned r; asm volatile("v_cvt_pk_bf16_f32 %0, %1, %2" : "=v"(r) : "v"(lo), "v"(hi)); return r; }

template <class Epi, bool ALIGN_EPI>
__device__ __forceinline__ void gemm_phase(LAS unsigned char* lds, const Gemm g, const StaticOrder& S, const Epi& E, const int tid) {
    const int wid = __builtin_amdgcn_readfirstlane(tid >> 6), lane = tid & 63, wr = wid >> 2, wc = wid & 3, fr = lane & 15, fq = lane >> 4;
    const int K = g.K, nt = K / BK;
    unsigned voffA[2], voffB[2];
#pragma unroll
    for (int i = 0; i < 2; ++i) { int R, C; stage_rc(tid * 16 + i * 8192, R, C); const int Rb = (R & ~31) + perm32(R & 31);
        voffA[i] = (unsigned)(R * g.lda + C) * 2u; voffB[i] = (unsigned)(Rb * g.ldb + C) * 2u; }
    const size_t kstep = (size_t)(BK * 2);
    const size_t hstepA = (size_t)HALF * g.lda * 2, hstepB = (size_t)HALF * g.ldb * 2;
    const size_t tstepA = 2 * hstepA, tstepB = 2 * hstepB;
    const unsigned ldsw = (unsigned)wid * 1024u;
    const int aoff = lds_byte(wr * 64 + fr, fq * 8), boff = lds_byte(wc * 32 + fr, fq * 8);
#define PG8_SA(b, h) (((b) * 2 + (h)) * HTB)
#define PG8_SB(b, h) ((4 + (b) * 2 + (h)) * HTB)
#define PG8_STAGE(bufoff, gbase, voff) do { _Pragma("unroll") for (int _i = 0; _i < 2; ++_i) \
        __builtin_amdgcn_global_load_lds((const unsigned*)((const char*)(gbase) + (voff)[_i]), (LAS unsigned*)(lds + (bufoff) + ldsw + _i * 8192), 16, 0, 0); } while (0)
#define PG8_LDA(dst, b, h) do { _Pragma("unroll") for (int m = 0; m < 4; ++m) _Pragma("unroll") for (int k = 0; k < 2; ++k) dst[m][k] = *(const LAS bf16x8*)(lds + PG8_SA(b, h) + aoff + m * 2048 + k * 1024); } while (0)
#define PG8_LDB(dst, b, h) do { _Pragma("unroll") for (int n = 0; n < 2; ++n) _Pragma("unroll") for (int k = 0; k < 2; ++k) dst[n][k] = *(const LAS bf16x8*)(lds + PG8_SB(b, h) + boff + n * 2048 + k * 1024); } while (0)
#define PG8_MMA(ai, bj, At, Bt) do { __builtin_amdgcn_s_setprio(1); _Pragma("unroll") for (int m = 0; m < 4; ++m) _Pragma("unroll") for (int n = 0; n < 2; ++n) _Pragma("unroll") for (int k = 0; k < 2; ++k) \
        acc[ai][bj][m][n] = __builtin_amdgcn_mfma_f32_16x16x32_bf16(Bt[n][k], At[m][k], acc[ai][bj][m][n], 0, 0, 0); __builtin_amdgcn_s_setprio(0); } while (0)
#define PG8_WAIT_V(n) asm volatile("s_waitcnt vmcnt(" #n ")" ::: "memory")
#define PG8_WAIT_L(n) asm volatile("s_waitcnt lgkmcnt(" #n ")" ::: "memory")
#define PG8_BAR __builtin_amdgcn_s_barrier()
#define PG8_SCHED __builtin_amdgcn_sched_barrier(0)
    Unit cur, nxt; int ui = 0;
    if (!S.next(0, cur)) return;
    f32x4 acc[2][2][4][2];
#pragma unroll
    for (int a = 0; a < 2; ++a)
#pragma unroll
        for (int b = 0; b < 2; ++b)
#pragma unroll
            for (int m = 0; m < 4; ++m)
#pragma unroll
                for (int n = 0; n < 2; ++n) acc[a][b][m][n] = (f32x4){0.f, 0.f, 0.f, 0.f};
    bf16x8 At[4][2], B0[2][2], B1[2][2];
    const char* cA = (const char*)g.A + (size_t)cur.pm * tstepA; const char* cB = (const char*)g.Bt + (size_t)cur.pn * tstepB;
    PG8_STAGE(PG8_SB(0, 0), cB, voffB); PG8_STAGE(PG8_SB(0, 1), cB + hstepB, voffB); PG8_STAGE(PG8_SA(0, 0), cA, voffA); PG8_STAGE(PG8_SA(0, 1), cA + hstepA, voffA);
    if (wr == 1) PG8_BAR;
    PG8_WAIT_V(2); PG8_BAR;
    PG8_STAGE(PG8_SB(1, 0), cB + kstep, voffB); PG8_STAGE(PG8_SA(1, 0), cA + kstep, voffA); PG8_STAGE(PG8_SB(1, 1), cB + hstepB + kstep, voffB);
    PG8_WAIT_V(6); PG8_BAR;
    for (;;) {
        const bool has_next = S.next(ui + 1, nxt);
        const char* nA = has_next ? (const char*)g.A + (size_t)nxt.pm * tstepA : cA; const char* nB = has_next ? (const char*)g.Bt + (size_t)nxt.pn * tstepB : cB;
        for (int t = 0; t < nt; t += 2) {
            const bool last = (t == nt - 2);
            const char* a1 = cA + (size_t)(t + 1) * kstep;
            const char* a2 = last ? nA : cA + (size_t)(t + 2) * kstep; const char* b2 = last ? nB : cB + (size_t)(t + 2) * kstep;
            const char* a3 = a2 + kstep; const char* b3 = b2 + kstep;
            PG8_LDB(B0, 0, 0); PG8_LDB(B1, 0, 1); PG8_SCHED; PG8_LDA(At, 0, 0); PG8_STAGE(PG8_SA(1, 1), a1 + hstepA, voffA);
            PG8_WAIT_V(8); PG8_WAIT_L(0); PG8_BAR; PG8_MMA(0, 0, At, B0); PG8_MMA(0, 1, At, B1); PG8_BAR; PG8_SCHED;
            PG8_LDA(At, 0, 1); PG8_STAGE(PG8_SB(0, 0), b2, voffB); PG8_STAGE(PG8_SB(0, 1), b2 + hstepB, voffB); PG8_STAGE(PG8_SA(0, 0), a2, voffA);
            PG8_WAIT_V(8); PG8_WAIT_L(0); PG8_BAR; PG8_MMA(1, 0, At, B0); PG8_MMA(1, 1, At, B1); PG8_BAR; PG8_SCHED;
            PG8_LDB(B0, 1, 0); PG8_LDB(B1, 1, 1); PG8_SCHED; PG8_LDA(At, 1, 0); PG8_STAGE(PG8_SA(0, 1), a2 + hstepA, voffA);
            PG8_WAIT_V(8); PG8_WAIT_L(0); PG8_BAR; PG8_MMA(0, 0, At, B0); PG8_MMA(0, 1, At, B1); PG8_BAR; PG8_SCHED;
            PG8_LDA(At, 1, 1); PG8_STAGE(PG8_SB(1, 0), b3, voffB); PG8_STAGE(PG8_SB(1, 1), b3 + hstepB, voffB); PG8_STAGE(PG8_SA(1, 0), a3, voffA);
            PG8_WAIT_V(8); PG8_WAIT_L(0); PG8_BAR; PG8_MMA(1, 0, At, B0); PG8_MMA(1, 1, At, B1); PG8_BAR; PG8_SCHED;
        }
        if constexpr (ALIGN_EPI) { if (wr == 0) PG8_BAR; }
        E(acc, cur, wr, wc, fr, fq);
        if (!has_next) break;
#pragma unroll
        for (int a = 0; a < 2; ++a)
#pragma unroll
            for (int b = 0; b < 2; ++b)
#pragma unroll
                for (int m = 0; m < 4; ++m)
#pragma unroll
                    for (int n = 0; n < 2; ++n) acc[a][b][m][n] = (f32x4){0.f, 0.f, 0.f, 0.f};
        cur = nxt; cA = nA; cB = nB; ++ui;
        if constexpr (ALIGN_EPI) { if (wr == 1) PG8_BAR; }
    }
    PG8_WAIT_V(0);
    if constexpr (!ALIGN_EPI) { if (wr == 0) PG8_BAR; }
    PG8_BAR;
#undef PG8_SA
#undef PG8_SB
#undef PG8_STAGE
#undef PG8_LDA
#undef PG8_LDB
#undef PG8_MMA
#undef PG8_WAIT_V
#undef PG8_WAIT_L
#undef PG8_BAR
#undef PG8_SCHED
}

typedef f32x4 AccT[2][2][4][2];

struct EpiInProj {
    bf16_t* P; bf16_t* VT; const float* rope; bf16_t* BND;
    __device__ __forceinline__ void operator()(AccT& acc, const Unit& u, int wr, int wc, int fr, int fq) const {
        const int row0 = u.pm * BM + wr * 64 + fr, colb = u.pn * BM + wc * 32 + 8 * fq;
#pragma unroll
        for (int ai = 0; ai < 2; ++ai)
#pragma unroll
            for (int m = 0; m < 4; ++m) {
                const int row = row0 + ai * HALF + m * 16, t = row & (SEQ - 1);
                bf16_t* rowp = P + (size_t)row * LDP + COL_PA;
#pragma unroll
                for (int bj = 0; bj < 2; ++bj) {
                    const int c = colb + bj * HALF;
                    f32x4 v0 = acc[ai][bj][m][0], v1 = acc[ai][bj][m][1];
                    if (u.pn >= 15) {
                        const int cl = c - 3840;
                        if (cl < 640 || (cl >= 768 && cl < 1088)) {
                            const float* cs = rope + ((size_t)t * 32 + ((cl & 63) >> 1)) * 2;
                            const f32x4 r0 = *(const f32x4*)cs, r1 = *(const f32x4*)(cs + 4);
                            f32x4 o0, o1;
                            o0[0] = v0[0] * r0[0] - v0[1] * r0[1]; o0[1] = v0[1] * r0[0] + v0[0] * r0[1];
                            o0[2] = v0[2] * r0[2] - v0[3] * r0[3]; o0[3] = v0[3] * r0[2] + v0[2] * r0[3];
                            o1[0] = v1[0] * r1[0] - v1[1] * r1[1]; o1[1] = v1[1] * r1[0] + v1[0] * r1[1];
                            o1[2] = v1[2] * r1[2] - v1[3] * r1[3]; o1[3] = v1[3] * r1[2] + v1[2] * r1[3];
                            v0 = o0; v1 = o1;
                        }
                    }
                    u32x4 w; w.x = cvt_pk_bf16(v0[0], v0[1]); w.y = cvt_pk_bf16(v0[2], v0[3]); w.z = cvt_pk_bf16(v1[0], v1[1]); w.w = cvt_pk_bf16(v1[2], v1[3]);
                    *(u32x4*)(rowp + c) = w;
                    if (u.pn < 7 && fr == 15) *(u32x4*)(BND + (size_t)(row >> 4) * 1792 + c) = w;
                    if (u.pn == 17 && bj == 1) {
                        const int cv = c - 3840 - 640, b = row >> 11;
                        bf16_t* vt = VT + ((size_t)(b * 2 + (cv >> 6)) * 64 + (cv & 63)) * SEQ + t;
                        vt[0 * SEQ] = (bf16_t)(w.x & 0xffffu); vt[1 * SEQ] = (bf16_t)(w.x >> 16);
                        vt[2 * SEQ] = (bf16_t)(w.y & 0xffffu); vt[3 * SEQ] = (bf16_t)(w.y >> 16);
                        vt[4 * SEQ] = (bf16_t)(w.z & 0xffffu); vt[5 * SEQ] = (bf16_t)(w.z >> 16);
                        vt[6 * SEQ] = (bf16_t)(w.w & 0xffffu); vt[7 * SEQ] = (bf16_t)(w.w >> 16);
                    }
                }
            }
    }
};
struct EpiGate {
    bf16_t* P;
    __device__ __forceinline__ void operator()(AccT& acc, const Unit& u, int wr, int wc, int fr, int fq) const {
        const int row0 = u.pm * BM + wr * 64 + fr, colb = u.pn * BM + wc * 32 + 8 * fq;
#pragma unroll
        for (int ai = 0; ai < 2; ++ai)
#pragma unroll
            for (int m = 0; m < 4; ++m) {
                bf16_t* rowp = P + (size_t)(row0 + ai * HALF + m * 16) * LDP + COL_G + colb;
#pragma unroll
                for (int bj = 0; bj < 2; ++bj) {
                    const f32x4 v0 = acc[ai][bj][m][0], v1 = acc[ai][bj][m][1];
                    u32x4 w; w.x = cvt_pk_bf16(sigmoidf_(v0[0]), sigmoidf_(v0[1])); w.y = cvt_pk_bf16(sigmoidf_(v0[2]), sigmoidf_(v0[3]));
                    w.z = cvt_pk_bf16(sigmoidf_(v1[0]), sigmoidf_(v1[1])); w.w = cvt_pk_bf16(sigmoidf_(v1[2]), sigmoidf_(v1[3]));
                    *(u32x4*)(rowp + bj * HALF) = w;
                }
            }
    }
};
struct EpiMergeAcc {
    bf16_t* P; int first;
    __device__ __forceinline__ void operator()(AccT& acc, const Unit& u, int wr, int wc, int fr, int fq) const {
        const int row0 = u.pm * BM + wr * 64 + fr, colb = u.pn * BM + wc * 32 + 8 * fq;
#pragma unroll
        for (int ai = 0; ai < 2; ++ai)
#pragma unroll
            for (int m = 0; m < 4; ++m) {
                bf16_t* rowb = P + (size_t)(row0 + ai * HALF + m * 16) * LDP + colb;
#pragma unroll
                for (int bj = 0; bj < 2; ++bj) {
                    const f32x4 v0 = acc[ai][bj][m][0], v1 = acc[ai][bj][m][1];
                    unsigned long long* gp = (unsigned long long*)(rowb + COL_G + bj * HALF);
                    unsigned long long* mp = (unsigned long long*)(rowb + COL_MRG + bj * HALF);
                    const unsigned long long g0 = __hip_atomic_load(gp, __ATOMIC_RELAXED, __HIP_MEMORY_SCOPE_AGENT), g1 = __hip_atomic_load(gp + 1, __ATOMIC_RELAXED, __HIP_MEMORY_SCOPE_AGENT);
                    unsigned long long m0 = 0ull, m1 = 0ull;
                    if (!first) { m0 = __hip_atomic_load(mp, __ATOMIC_RELAXED, __HIP_MEMORY_SCOPE_AGENT); m1 = __hip_atomic_load(mp + 1, __ATOMIC_RELAXED, __HIP_MEMORY_SCOPE_AGENT); }
                    const unsigned ga = (unsigned)g0, gb = (unsigned)(g0 >> 32), gc = (unsigned)g1, gd = (unsigned)(g1 >> 32);
                    const unsigned ma = (unsigned)m0, mb = (unsigned)(m0 >> 32), mc = (unsigned)m1, md = (unsigned)(m1 >> 32);
                    u32x4 w;
                    w.x = cvt_pk_bf16(bflo(ma) + bflo(ga) * v0[0], bfhi(ma) + bfhi(ga) * v0[1]);
                    w.y = cvt_pk_bf16(bflo(mb) + bflo(gb) * v0[2], bfhi(mb) + bfhi(gb) * v0[3]);
                    w.z = cvt_pk_bf16(bflo(mc) + bflo(gc) * v1[0], bfhi(mc) + bfhi(gc) * v1[1]);
                    w.w = cvt_pk_bf16(bflo(md) + bflo(gd) * v1[2], bfhi(md) + bfhi(gd) * v1[3]);
                    *(u32x4*)(rowb + COL_MRG + bj * HALF) = w;
                }
            }
    }
};
struct EpiResid {
    const float* base; float* out;
    __device__ __forceinline__ void operator()(AccT& acc, const Unit& u, int wr, int wc, int fr, int fq) const {
        const int row0 = u.pm * BM + wr * 64 + fr, colb = u.pn * BM + wc * 32 + 8 * fq;
#pragma unroll
        for (int ai = 0; ai < 2; ++ai)
#pragma unroll
            for (int m = 0; m < 4; ++m) {
                const size_t off = (size_t)(row0 + ai * HALF + m * 16) * DM + colb;
#pragma unroll
                for (int bj = 0; bj < 2; ++bj) {
                    const f32x4 b0 = *(const f32x4*)(base + off + bj * HALF), b1 = *(const f32x4*)(base + off + bj * HALF + 4);
                    *(f32x4*)(out + off + bj * HALF) = b0 + acc[ai][bj][m][0];
                    *(f32x4*)(out + off + bj * HALF + 4) = b1 + acc[ai][bj][m][1];
                }
            }
    }
};
struct EpiUp {
    bf16_t* P; float* HALO; const float* cw; const float* cb; LAS float* CW;
    __device__ __forceinline__ void operator()(AccT& acc, const Unit& u, int wr, int wc, int fr_in, int fq_in) const {
        int fr = fr_in, fq = fq_in;
        asm volatile("" : "+v"(fr), "+v"(fq));
        const int row0 = u.pm * BM + wr * 64 + fr;
        const int jb = u.pn * 128 + wc * 32 + 8 * fq;
        {
            const int tl = (wr * 4 + wc) * 64 + fq * 16 + fr;
#pragma unroll
            for (int it = 0; it < 2; ++it) { const int k = tl + 512 * it, p = k >> 8, col = k & 255, co = (col >> 7) * DFF + u.pn * 128 + (col & 127);
                CW[k] = (p < 3) ? cw[p * F2 + co] : cb[co]; }
            asm volatile("s_waitcnt lgkmcnt(0)" ::: "memory"); __builtin_amdgcn_s_barrier(); asm volatile("" ::: "memory");
        }
#pragma unroll
        for (int ai = 0; ai < 2; ++ai) {
            const int s = u.pm * 4 + ai * 2 + wr;
#pragma unroll
            for (int bj = 0; bj < 2; ++bj)
#pragma unroll
                for (int n = 0; n < 2; ++n) {
                    const int colp = u.pn * BM + bj * HALF + wc * 32 + 8 * fq + 4 * n;
                    if (fr < 2) *(f32x4*)(HALO + (size_t)(s * 4 + fr) * F2 + colp) = acc[ai][bj][0][n];
                    if (fr >= 14) *(f32x4*)(HALO + (size_t)(s * 4 + fr - 12) * F2 + colp) = acc[ai][bj][3][n];
                }
        }
#pragma unroll
        for (int ai = 0; ai < 2; ++ai)
#pragma unroll
            for (int m = 0; m < 4; ++m) {
                const int row = row0 + ai * HALF + m * 16;
#pragma unroll
                for (int n = 0; n < 2; ++n) {
                    f32x4 cv[2];
#pragma unroll
                    for (int bj = 0; bj < 2; ++bj) {
                        const int cl = bj * 128 + wc * 32 + 8 * fq + 4 * n;
                        const f32x4 w0 = *(const LAS f32x4*)&CW[cl], w1 = *(const LAS f32x4*)&CW[256 + cl], w2 = *(const LAS f32x4*)&CW[512 + cl], bb = *(const LAS f32x4*)&CW[768 + cl];
#pragma unroll
                        for (int e = 0; e < 4; ++e) {
                            const float cur = acc[ai][bj][m][n][e];
                            const float prv = m > 0 ? acc[ai][bj][m > 0 ? m - 1 : 0][n][e] : 0.f;
                            const float a1 = dpp_mov<0x121>(cur), a2 = dpp_mov<0x122>(cur), b1 = dpp_mov<0x121>(prv), b2 = dpp_mov<0x122>(prv);
                            const float p1 = fr >= 1 ? a1 : b1, p2 = fr >= 2 ? a2 : b2;
                            cv[bj][e] = bb[e] + w0[e] * p2 + w1[e] * p1 + w2[e] * cur;
                        }
                        __builtin_amdgcn_sched_barrier(0);
                    }
                    const f32x4 g0 = cv[0], v0 = cv[1];
                    u32x2 w;
                    w.x = cvt_pk_bf16(g0[0] * sigmoidf_(g0[0]) * v0[0], g0[1] * sigmoidf_(g0[1]) * v0[1]);
                    w.y = cvt_pk_bf16(g0[2] * sigmoidf_(g0[2]) * v0[2], g0[3] * sigmoidf_(g0[3]) * v0[3]);
                    if (!(m == 0 && fr < 2)) *(u32x2*)(P + (size_t)row * LDP + COL_ACT + jb + 4 * n) = w;
                    __builtin_amdgcn_sched_barrier(0);
                }
            }
    }
};
}

struct Ctx {
    const float* in[24]; float* out; unsigned char* ws;
    bf16_t* P; bf16_t* VT; float* HALO; float* ROPE;
    bf16_t *Win, *Wg, *Wbr, *Wo, *Wup, *Wdn;
    int tid, lane, wave, G, bid;
};

__device__ __forceinline__ int srccol(int mode, int n) {
    if (mode == 0) return n;
    if (mode == 2) return 4932 + n;
    if (mode == 3) { const int tile = n >> 8, w = n & 255, j = tile * 128 + (w & 127); return (w < 128) ? j : DFF + j; }
    if (n < 3840) return n;
    const int c = n - 3840;
    if (c >= 1092) return -1;
    if (c < 640 || (c >= 768 && c < 1088)) { const int base = c & ~63, i = c & 63; return 3840 + base + (i >> 1) + 32 * (i & 1); }
    return 3840 + c;
}
__device__ __forceinline__ void tr_item(const float* W, int ldw, int K, int N, bf16_t* WT, int mode, int item, LAS float* scr, int lane) {
    const int nblk = N / 32, kb = item / nblk, nb = item % nblk, k0 = 64 * kb, n0 = 32 * nb;
    const int sc = srccol(mode, n0 + (lane & 31));
#pragma unroll 8
    for (int i = 0; i < 32; ++i) { const int kk = 2 * i + (lane >> 5); scr[kk * 33 + (lane & 31)] = (sc >= 0) ? W[(size_t)(k0 + kk) * ldw + sc] : 0.f; }
    asm volatile("s_waitcnt lgkmcnt(0)" ::: "memory");
    const int c = lane & 7;
#pragma unroll
    for (int j = 0; j < 4; ++j) { const int n = (lane >> 3) + 8 * j; const LAS float* s = scr + (8 * c) * 33 + n;
        u32x4 o; o.x = pk2(s[0 * 33], s[1 * 33]); o.y = pk2(s[2 * 33], s[3 * 33]); o.z = pk2(s[4 * 33], s[5 * 33]); o.w = pk2(s[6 * 33], s[7 * 33]);
        *(u32x4*)(WT + (size_t)(n0 + n) * K + k0 + 8 * c) = o; }
    asm volatile("s_waitcnt lgkmcnt(0)" ::: "memory");
}
__device__ __forceinline__ void rms_row(const float* xrow, const float* g, bf16_t* obf, float* of32, int lane) {
    const f32x4* xr = (const f32x4*)xrow + lane; const f32x4* gr = (const f32x4*)g + lane;
    f32x4 v[4]; float s = 0.f;
#pragma unroll
    for (int j = 0; j < 4; ++j) { v[j] = xr[64 * j]; s += (v[j].x * v[j].x + v[j].y * v[j].y) + (v[j].z * v[j].z + v[j].w * v[j].w); }
    const float rs = 1.f / sqrtf(wave_sum(s) * (1.f / DM) + 1e-6f);
#pragma unroll
    for (int j = 0; j < 4; ++j) {
        const f32x4 gg = gr[64 * j]; const f32x4 o = v[j] * rs * gg;
        if (obf) { u32x2 w; w.x = pk2(o.x, o.y); w.y = pk2(o.z, o.w); *((u32x2*)obf + lane + 64 * j) = w; }
        else *((f32x4*)of32 + lane + 64 * j) = o;
    }
}
__device__ __forceinline__ void rms_pass(const Ctx& X, const float* src, const float* g, bf16_t* obf, float* of32) {
    const int gw = X.bid * 8 + X.wave, NGW = X.G * 8, lane = X.lane;
    const f32x4* gr = (const f32x4*)g + lane;
    f32x4 gg[4];
#pragma unroll
    for (int j = 0; j < 4; ++j) gg[j] = gr[64 * j];
#pragma unroll 1
    for (int m = gw; m < T_TOK; m += 4 * NGW) {
        f32x4 v[4][4]; float ss[4]; int mr[4];
#pragma unroll
        for (int r = 0; r < 4; ++r) { mr[r] = m + r * NGW; const int ml = mr[r] < T_TOK ? mr[r] : m; const f32x4* x = (const f32x4*)(src + (size_t)ml * DM) + lane;
#pragma unroll
            for (int j = 0; j < 4; ++j) v[r][j] = x[64 * j]; }
#pragma unroll
        for (int r = 0; r < 4; ++r) { float a = 0.f;
#pragma unroll
            for (int j = 0; j < 4; ++j) a += (v[r][j].x * v[r][j].x + v[r][j].y * v[r][j].y) + (v[r][j].z * v[r][j].z + v[r][j].w * v[r][j].w);
            ss[r] = 1.f / sqrtf(wave_sum(a) * (1.f / DM) + 1e-6f); }
#pragma unroll
        for (int r = 0; r < 4; ++r) {
            if (mr[r] < T_TOK) {
#pragma unroll
                for (int j = 0; j < 4; ++j) {
                    const f32x4 o = v[r][j] * ss[r] * gg[j];
                    if (obf) { u32x2 w; w.x = pk2(o.x, o.y); w.y = pk2(o.z, o.w); *((u32x2*)(obf + (size_t)mr[r] * LDP) + lane + 64 * j) = w; }
                    else *((f32x4*)(of32 + (size_t)mr[r] * DM) + lane + 64 * j) = o;
                }
            }
        }
    }
}
__device__ __forceinline__ void phase_prep(const Ctx& X, LAS unsigned char* lds, int layer) {
    LAS float* scr = (LAS float*)(lds + X.wave * 8448);
    const int gw = X.bid * 8 + X.wave, NGW = X.G * 8;
    constexpr int I_IN = 16 * 160, I_G = 16 * 96, I_BR = 8 * 32, I_O = 16 * 32, I_UP = 16 * 176, I_DN = 44 * 32;
    constexpr int NITEMS = I_IN + I_G + 3 * I_BR + I_O + I_UP + I_DN;
    const float* w_in = X.in[2] + (size_t)layer * DM * IN_COLS;
    const float* w_br = X.in[16] + (size_t)layer * 3 * 512 * DM;
    const float* w_o = X.in[17] + (size_t)layer * DM * DM;
    const float* w_up = X.in[19] + (size_t)layer * DM * F2;
    const float* w_dn = X.in[22] + (size_t)layer * DFF * DM;
    for (int it = gw; it < NITEMS; it += NGW) {
        int r = it;
        if (r < I_IN) { tr_item(w_in, IN_COLS, DM, 5120, X.Win, 1, r, scr, X.lane); continue; } r -= I_IN;
        if (r < I_G) { tr_item(w_in, IN_COLS, DM, 3072, X.Wg, 2, r, scr, X.lane); continue; } r -= I_G;
        if (r < 3 * I_BR) { const int b = r / I_BR; tr_item(w_br + (size_t)b * 512 * DM, DM, 512, DM, X.Wbr + (size_t)b * DM * 512, 0, r % I_BR, scr, X.lane); continue; } r -= 3 * I_BR;
        if (r < I_O) { tr_item(w_o, DM, DM, DM, X.Wo, 0, r, scr, X.lane); continue; } r -= I_O;
        if (r < I_UP) { tr_item(w_up, F2, DM, F2, X.Wup, 3, r, scr, X.lane); continue; } r -= I_UP;
        tr_item(w_dn, DM, DFF, DM, X.Wdn, 0, r, scr, X.lane);
    }
    const float* h = (layer == 0) ? X.in[0] : X.out;
    const float* g = X.in[1] + (size_t)layer * DM;
    rms_pass(X, h, g, X.P, nullptr);
    if (layer == 0) {
        for (int idx = X.bid * 512 + X.tid; idx < SEQ * 32; idx += X.G * 512) {
            const int t = idx >> 5, p = idx & 31;
            const float inv = exp2f(-(float)p * 0.03125f * 13.287712379549449f);
            const float ang = (float)t * inv;
            const double rev = (double)ang * 0.15915494309189535;
            const float fr = (float)(rev - floor(rev));
            X.ROPE[2 * idx] = __builtin_amdgcn_cosf(fr); X.ROPE[2 * idx + 1] = __builtin_amdgcn_sinf(fr);
        }
    }
}

__device__ __forceinline__ float wave_sum_fast(float x) {
    x = red16(x);
    const float r0 = __builtin_bit_cast(float, __builtin_amdgcn_readlane(__builtin_bit_cast(int, x), 0)), r1 = __builtin_bit_cast(float, __builtin_amdgcn_readlane(__builtin_bit_cast(int, x), 16));
    const float r2 = __builtin_bit_cast(float, __builtin_amdgcn_readlane(__builtin_bit_cast(int, x), 32)), r3 = __builtin_bit_cast(float, __builtin_amdgcn_readlane(__builtin_bit_cast(int, x), 48));
    return (r0 + r1) + (r2 + r3);
}
#define LDS_BAR() do { asm volatile("s_waitcnt lgkmcnt(0)" ::: "memory"); __builtin_amdgcn_s_barrier(); asm volatile("" ::: "memory"); } while (0)
constexpr int RW_TS = 16, RW_NCH = SEQ / RW_TS, RW_BUF = 33280;
__device__ __forceinline__ void phase_rwkv_pre(const Ctx& X, LAS unsigned char* lds, int layer) {
    LAS float* Rr = (LAS float*)(lds);           LAS float* Kk = (LAS float*)(lds + 8192);   LAS float* Vv = (LAS float*)(lds + 16384);
    LAS float* W1 = (LAS float*)(lds + 24576);   LAS float* AS = (LAS float*)(lds + 32768);
    LAS bf16_t* WDb = (LAS bf16_t*)(lds + 40960);
    LAS bf16_t* ADb = (LAS bf16_t*)(lds + 45568);
    LAS bf16_t* WTu = (LAS bf16_t*)(lds + 50176);
    LAS bf16_t* WTa = (LAS bf16_t*)(lds + 59392);
    LAS float* MU = (LAS float*)(lds + 68608);
    const int tid = X.tid, lane = tid & 63, wv = X.wave;
    const float* mu = X.in[3] + layer * 1792;
    const float* w0 = X.in[4] + layer * 512;   const float* w_up = X.in[5] + (size_t)layer * 64 * 512;
    const float* a0 = X.in[6] + layer * 512;   const float* a_up = X.in[7] + (size_t)layer * 64 * 512;
    const float* k_k = X.in[9] + layer * 512;  const float* k_a = X.in[10] + layer * 512;  const float* r_k = X.in[11] + layer * 512;
    const bf16_t* BND = (const bf16_t*)(X.ws + WS_BND);
    float* SCAL = (float*)(X.ws + WS_SCAL);
    const int ln = lane & 15, lg = lane >> 4;
    int last_h = -1;
    float p_kk = 0.f, p_ka = 0.f, p_rk = 0.f, q_w0 = 0.f, q_a0 = 0.f;
    const int c = tid & 63, tg = tid >> 6;
    u32x4 pc4[3], pp4[3]; bool have_pf = false;
    pc4[0] = pc4[1] = pc4[2] = pp4[0] = pp4[1] = pp4[2] = (u32x4){0u, 0u, 0u, 0u};
#define PRE_LOAD(uu) do { const int h_ = (uu) & 7, tp_ = (uu) >> 3; _Pragma("unroll") for (int it = 0; it < 3; ++it) { const int idx = tid + 512 * it; pc4[it] = (u32x4){0u, 0u, 0u, 0u}; pp4[it] = (u32x4){0u, 0u, 0u, 0u}; \
        if (idx < 32 * 40) { const int tt = idx / 40, vv = idx - tt * 40; \
            const int col = vv < 8 ? h_ * 64 + 8 * vv : (vv < 16 ? 512 + h_ * 64 + 8 * (vv - 8) : (vv < 24 ? 1024 + h_ * 64 + 8 * (vv - 16) : 1536 + 8 * (vv - 24))); \
            const size_t row = (size_t)tp_ * 32 + tt; pc4[it] = *(const u32x4*)(X.P + row * LDP + COL_PA + col); \
            if (tt > 0) pp4[it] = *(const u32x4*)(X.P + (row - 1) * LDP + COL_PA + col); else if ((tp_ & 63) != 0) pp4[it] = *(const u32x4*)(BND + (size_t)(2 * tp_ - 1) * 1792 + col); } } } while (0)
#pragma unroll 1
    for (int u = X.bid; u < 4096; u += X.G) {
        const int h = u & 7, tp = u >> 3, hc = h * 64 + c;
        if (h != last_h) {
            __syncthreads();
            for (int idx = tid; idx < 64 * 64; idx += 512) { const int m = idx >> 6, cc = idx & 63;
                WTu[cc * 72 + m] = (bf16_t)f2bf(w_up[m * 512 + h * 64 + cc]); WTa[cc * 72 + m] = (bf16_t)f2bf(a_up[m * 512 + h * 64 + cc]); }
            if (tid < 320) { const int cc = tid; const int col = cc < 64 ? h * 64 + cc : (cc < 128 ? 512 + h * 64 + cc - 64 : (cc < 192 ? 1024 + h * 64 + cc - 128 : 1536 + cc - 192)); MU[cc] = mu[col]; }
            p_kk = k_k[hc]; p_ka = k_a[hc]; p_rk = r_k[hc];
            q_w0 = w0[h * 64 + 16 * (wv >> 1) + ln]; q_a0 = a0[h * 64 + 16 * (wv >> 1) + ln];
            last_h = h;
            __syncthreads();
        }
        if (!have_pf) { PRE_LOAD(u); }
#pragma unroll
        for (int it = 0; it < 3; ++it) {
            const int idx = tid + 512 * it;
            if (idx < 32 * 40) {
                const int tt = idx / 40, vv = idx - tt * 40, cc0 = 8 * vv;
                const u32x4 c4 = pc4[it], p4 = pp4[it];
                const f32x4 m0 = *(const LAS f32x4*)&MU[cc0], m1 = *(const LAS f32x4*)&MU[cc0 + 4];
                float cur[8], prv[8], val[8];
                cur[0] = bflo(c4.x); cur[1] = bfhi(c4.x); cur[2] = bflo(c4.y); cur[3] = bfhi(c4.y); cur[4] = bflo(c4.z); cur[5] = bfhi(c4.z); cur[6] = bflo(c4.w); cur[7] = bfhi(c4.w);
                prv[0] = bflo(p4.x); prv[1] = bfhi(p4.x); prv[2] = bflo(p4.y); prv[3] = bfhi(p4.y); prv[4] = bflo(p4.z); prv[5] = bfhi(p4.z); prv[6] = bflo(p4.w); prv[7] = bfhi(p4.w);
#pragma unroll
                for (int e = 0; e < 8; ++e) val[e] = cur[e] + (prv[e] - cur[e]) * (e < 4 ? m0[e & 3] : m1[e & 3]);
                if (vv < 24) {
#pragma unroll
                    for (int e = 0; e < 8; ++e) val[e] = bf2f((bf16_t)f2bf(val[e]));
                    LAS float* dst = (vv < 8 ? Rr : (vv < 16 ? Kk : Vv)) + tt * 64 + 8 * (vv & 7);
                    *(LAS f32x4*)dst = (f32x4){val[0], val[1], val[2], val[3]}; *(LAS f32x4*)(dst + 4) = (f32x4){val[4], val[5], val[6], val[7]};
                } else {
                    const int lr0 = 8 * (vv - 24);
                    LAS bf16_t* dst;
                    if (lr0 < 64) { dst = WDb + tt * 72 + lr0;
#pragma unroll
                        for (int e = 0; e < 8; ++e) { const float ex = __expf(2.f * val[e]); val[e] = 1.f - 2.f / (ex + 1.f); } }
                    else dst = ADb + tt * 72 + lr0 - 64;
                    u32x4 o; o.x = pk2(val[0], val[1]); o.y = pk2(val[2], val[3]); o.z = pk2(val[4], val[5]); o.w = pk2(val[6], val[7]);
                    *(LAS u32x4*)dst = o;
                }
            }
        }
        have_pf = false;
        if (u + X.G < 4096 && ((u + X.G) & 7) == h) { PRE_LOAD(u + X.G); have_pf = true; }
        LDS_BAR();
        {
            const int mt = wv & 1, nt = wv >> 1, chm = 16 * nt + ln;
            f32x4 cw_ = (f32x4){0.f, 0.f, 0.f, 0.f}, ca_ = cw_;
#pragma unroll
            for (int ks = 0; ks < 2; ++ks) {
                const bf16x8 xa = *(const LAS bf16x8*)&WDb[(16 * mt + ln) * 72 + ks * 32 + 8 * lg], xb = *(const LAS bf16x8*)&WTu[(16 * nt + ln) * 72 + ks * 32 + 8 * lg];
                cw_ = __builtin_amdgcn_mfma_f32_16x16x32_bf16(xa, xb, cw_, 0, 0, 0);
                const bf16x8 ya = *(const LAS bf16x8*)&ADb[(16 * mt + ln) * 72 + ks * 32 + 8 * lg], yb = *(const LAS bf16x8*)&WTa[(16 * nt + ln) * 72 + ks * 32 + 8 * lg];
                ca_ = __builtin_amdgcn_mfma_f32_16x16x32_bf16(ya, yb, ca_, 0, 0, 0);
            }
#pragma unroll
            for (int r = 0; r < 4; ++r) {
                const int tt = 16 * mt + 4 * lg + r;
                const float z = -(q_w0 + cw_[r]);
                const float sp = fmaxf(z, 0.f) + __logf(1.f + __expf(-fabsf(z)));
                const float e = __expf(-sp - 0.5f);
                W1[tt * 64 + chm] = bf2f((bf16_t)f2bf(-expm1f(-e)));
                AS[tt * 64 + chm] = bf2f((bf16_t)f2bf(sigmoidf_(q_a0 + ca_[r])));
            }
        }
        LDS_BAR();
#pragma unroll
        for (int q = 0; q < 4; ++q) {
            const int tt = 4 * tg + q;
            const size_t row = (size_t)tp * 32 + tt;
            const float w1 = W1[tt * 64 + c], a = AS[tt * 64 + c];
            const float kraw = Kk[tt * 64 + c], r = Rr[tt * 64 + c], v = Vv[tt * 64 + c];
            const float kk0 = kraw * p_kk;
            const float inv = 1.f / sqrtf(fmaxf(wave_sum_fast(kk0 * kk0), 1e-24f));
            const float kk = kk0 * inv;
            const float kmod = kraw * (1.f + (a - 1.f) * p_ka);
            const float bvec = kk * a;
            const float br = wave_sum_fast(bvec * r), kr = wave_sum_fast(kmod * r), bonus = wave_sum_fast(r * kmod * p_rk);
            bf16_t* rp_ = X.P + row * LDP;
            rp_[COL_PA + hc] = (bf16_t)f2bf(r); rp_[COL_PA + 512 + hc] = (bf16_t)f2bf(kraw); rp_[COL_PA + 1024 + hc] = (bf16_t)f2bf(v);
            rp_[hc] = (bf16_t)f2bf(w1); rp_[512 + hc] = (bf16_t)f2bf(a);
            if (c == 0) *(f32x4*)(SCAL + (row * 8 + h) * 4) = (f32x4){inv, br, kr, bonus};
        }
        LDS_BAR();
    }
}

__device__ __forceinline__ void rwkv_task(const Ctx& X, LAS unsigned char* lds, int layer, int b, int h) {
    LAS bf16_t* GDb = (LAS bf16_t*)(lds + 66560);
    LAS bf16_t* WTg = (LAS bf16_t*)(lds + 70912);
    LAS float* BON = (LAS float*)(lds + 88320);
    const int tid = X.tid, lane = tid & 63;
    const bool helper = X.wave >= 4;
    const int ht = tid & 255;
    const float* mu = X.in[3] + layer * 1792;
    const float* g_up = X.in[8] + (size_t)layer * 128 * 512;
    const float* k_k = X.in[9] + layer * 512;  const float* k_a = X.in[10] + layer * 512;
    const float* gn_g = X.in[12] + layer * 512; const float* gn_b = X.in[13] + layer * 512;
    const float* SCAL = (const float*)(X.ws + WS_SCAL);
    const int tt_h = ht >> 4, cg4 = (ht & 15) * 4;
    const f32x4 p_kk = *(const f32x4*)(k_k + h * 64 + cg4), p_ka = *(const f32x4*)(k_a + h * 64 + cg4);
    const f32x4 p_gg = *(const f32x4*)(gn_g + h * 64 + cg4), p_gb = *(const f32x4*)(gn_b + h * 64 + cg4);
    const int gv8 = (ht & 15) * 8;
    const f32x4 mg0 = *(const f32x4*)(mu + 1664 + gv8), mg1 = *(const f32x4*)(mu + 1664 + gv8 + 4);
    const int nt = (ht >> 6), ln = lane & 15, lg = lane >> 4, chm = 16 * nt + ln;
    const int rp = ht >> 3, jg = ht & 7, i0 = 2 * rp;
    for (int idx = tid; idx < 128 * 64; idx += 512) { const int m = idx >> 6, cc = idx & 63; WTg[cc * 136 + m] = (bf16_t)f2bf(g_up[m * 512 + h * 64 + cc]); }
    f32x2 S0[4], S1[4];
#pragma unroll
    for (int j = 0; j < 4; ++j) { S0[j] = (f32x2){0.f, 0.f}; S1[j] = (f32x2){0.f, 0.f}; }
#if PROBE_SCAN2
    f32x2 T0[4], T1[4];
#pragma unroll
    for (int j = 0; j < 4; ++j) { T0[j] = (f32x2){0.f, 0.f}; T1[j] = (f32x2){0.f, 0.f}; }
#endif
    __syncthreads();

#define RW_ARR(bufi, k) ((LAS float*)(lds + (bufi) * RW_BUF + (k) * 4096))
#define RW_SC(bufi) ((LAS float*)(lds + (bufi) * RW_BUF + 32768))
#define RW_LOAD(chk, L) do { const size_t row_ = (size_t)b * SEQ + (chk) * RW_TS + tt_h; const bf16_t* rp_ = X.P + row_ * LDP; \
        l_r##L = *(const u32x2*)(rp_ + COL_PA + h * 64 + cg4); l_k##L = *(const u32x2*)(rp_ + COL_PA + 512 + h * 64 + cg4); l_v##L = *(const u32x2*)(rp_ + COL_PA + 1024 + h * 64 + cg4); \
        l_w##L = *(const u32x2*)(rp_ + h * 64 + cg4); l_a##L = *(const u32x2*)(rp_ + 512 + h * 64 + cg4); l_s##L = *(const f32x4*)(SCAL + (row_ * 8 + h) * 4); \
        l_gc##L = *(const u32x4*)(rp_ + COL_PA + 1664 + gv8); l_gp##L = (u32x4){0u, 0u, 0u, 0u}; if ((chk) * RW_TS + tt_h > 0) l_gp##L = *(const u32x4*)(rp_ - LDP + COL_PA + 1664 + gv8); } while (0)
    u32x2 l_rA, l_kA, l_vA, l_wA, l_aA; f32x4 l_sA; u32x4 l_gcA, l_gpA;
    u32x2 l_rB, l_kB, l_vB, l_wB, l_aB; f32x4 l_sB; u32x4 l_gcB, l_gpB;
    l_rA = l_kA = l_vA = l_wA = l_aA = l_rB = l_kB = l_vB = l_wB = l_aB = (u32x2){0u, 0u}; l_sA = l_sB = (f32x4){0.f, 0.f, 0.f, 0.f}; l_gcA = l_gpA = l_gcB = l_gpB = (u32x4){0u, 0u, 0u, 0u};
    if (helper) { RW_LOAD(0, A); RW_LOAD(1, B); }

#pragma unroll 1
    for (int i0_ = -1; i0_ < RW_NCH; i0_ += 2) {
        { const int i = i0_;

        const int bufn = (i + 1) & 1, bufc = i & 1;
        if (helper) {
            const bool do_prep = (i + 1 < RW_NCH);
            if (i >= 1) {
                LAS float* Yy = RW_ARR(bufn, 7); LAS float* Gg = RW_ARR(bufn, 6); LAS float* Vv = RW_ARR(bufn, 5); LAS float* SC = RW_SC(bufn);
                const f32x4 y = *(const LAS f32x4*)&Yy[tt_h * 64 + cg4], gg = *(const LAS f32x4*)&Gg[tt_h * 64 + cg4], vv = *(const LAS f32x4*)&Vv[tt_h * 64 + cg4];
                const float bonus = BON[((i - 1) % 3) * 16 + tt_h];
                const float mean = red16((y.x + y.y) + (y.z + y.w)) * (1.f / 64.f);
                const f32x4 d = y - mean;
                const float var = red16((d.x * d.x + d.y * d.y) + (d.z * d.z + d.w * d.w)) * (1.f / 64.f);
                const float rs = 1.f / sqrtf(var + 64e-5f);
                const f32x4 o = (d * rs * p_gg + p_gb + vv * bonus) * gg;
                u32x2 w; w.x = pk2(o.x, o.y); w.y = pk2(o.z, o.w);
                *(u32x2*)(X.P + ((size_t)b * SEQ + (i - 1) * RW_TS + tt_h) * LDP + COL_YA + h * 64 + cg4) = w;
            }
            if (do_prep) {
                const f32x4 r = (f32x4){bflo(l_rA.x), bfhi(l_rA.x), bflo(l_rA.y), bfhi(l_rA.y)}, k = (f32x4){bflo(l_kA.x), bfhi(l_kA.x), bflo(l_kA.y), bfhi(l_kA.y)};
                const f32x4 v = (f32x4){bflo(l_vA.x), bfhi(l_vA.x), bflo(l_vA.y), bfhi(l_vA.y)}, w1 = (f32x4){bflo(l_wA.x), bfhi(l_wA.x), bflo(l_wA.y), bfhi(l_wA.y)};
                const f32x4 a = (f32x4){bflo(l_aA.x), bfhi(l_aA.x), bflo(l_aA.y), bfhi(l_aA.y)};
                const f32x4 kk = k * p_kk * l_sA.x;
                const f32x4 decay = 1.f - w1;
                *(LAS f32x4*)&RW_ARR(bufn, 0)[tt_h * 64 + cg4] = -kk;
                *(LAS f32x4*)&RW_ARR(bufn, 1)[tt_h * 64 + cg4] = decay * r;
                *(LAS f32x4*)&RW_ARR(bufn, 2)[tt_h * 64 + cg4] = decay;
                *(LAS f32x4*)&RW_ARR(bufn, 3)[tt_h * 64 + cg4] = kk * a;
                *(LAS f32x4*)&RW_ARR(bufn, 4)[tt_h * 64 + cg4] = k * (1.f + (a - 1.f) * p_ka);
                *(LAS f32x4*)&RW_ARR(bufn, 5)[tt_h * 64 + cg4] = v;
                if (cg4 == 0) { LAS float* SC = RW_SC(bufn); SC[tt_h * 4 + 0] = l_sA.y; SC[tt_h * 4 + 1] = l_sA.z; BON[((i + 1) % 3) * 16 + tt_h] = l_sA.w; }
                float gc[8], gp[8];
                gc[0] = bflo(l_gcA.x); gc[1] = bfhi(l_gcA.x); gc[2] = bflo(l_gcA.y); gc[3] = bfhi(l_gcA.y); gc[4] = bflo(l_gcA.z); gc[5] = bfhi(l_gcA.z); gc[6] = bflo(l_gcA.w); gc[7] = bfhi(l_gcA.w);
                gp[0] = bflo(l_gpA.x); gp[1] = bfhi(l_gpA.x); gp[2] = bflo(l_gpA.y); gp[3] = bfhi(l_gpA.y); gp[4] = bflo(l_gpA.z); gp[5] = bfhi(l_gpA.z); gp[6] = bflo(l_gpA.w); gp[7] = bfhi(l_gpA.w);
#pragma unroll
                for (int e = 0; e < 8; ++e) gc[e] = sigmoidf_(gc[e] + (gp[e] - gc[e]) * (e < 4 ? mg0[e & 3] : mg1[e & 3]));
                u32x4 o; o.x = pk2(gc[0], gc[1]); o.y = pk2(gc[2], gc[3]); o.z = pk2(gc[4], gc[5]); o.w = pk2(gc[6], gc[7]);
                *(LAS u32x4*)&GDb[tt_h * 136 + gv8] = o;
            }
            if (i + 3 < RW_NCH) RW_LOAD(i + 3, A);
            LDS_BAR();
            if (do_prep) {
                LAS float* Gg = RW_ARR(bufn, 6);
                f32x4 cg_ = (f32x4){0.f, 0.f, 0.f, 0.f};
#pragma unroll
                for (int ks = 0; ks < 4; ++ks) {
                    const bf16x8 za = *(const LAS bf16x8*)&GDb[ln * 136 + ks * 32 + 8 * lg], zb = *(const LAS bf16x8*)&WTg[(16 * nt + ln) * 136 + ks * 32 + 8 * lg];
                    cg_ = __builtin_amdgcn_mfma_f32_16x16x32_bf16(za, zb, cg_, 0, 0, 0);
                }
#pragma unroll
                for (int r = 0; r < 4; ++r) Gg[(4 * lg + r) * 64 + chm] = cg_[r];
            }
            LDS_BAR();
        } else {
            LAS float* A_ = RW_ARR(bufc, 0); LAS float* WR = RW_ARR(bufc, 1); LAS float* Wd = RW_ARR(bufc, 2); LAS float* Bv = RW_ARR(bufc, 3);
            LAS float* Kk = RW_ARR(bufc, 4); LAS float* Vv = RW_ARR(bufc, 5); LAS float* Yy = RW_ARR(bufc, 7); LAS float* SC = RW_SC(bufc);
#pragma unroll 1
            for (int q4 = 0; q4 < 4; ++q4) {
                if (i >= 0) {
                    f32x2 yk[4];
#pragma unroll
                    for (int s4 = 0; s4 < 4; ++s4) {
                        const int tt = 4 * q4 + s4;
                        const f32x4 a_lo = *(const LAS f32x4*)&A_[tt * 64 + 8 * jg], a_hi = *(const LAS f32x4*)&A_[tt * 64 + 8 * jg + 4];
                        const f32x4 r_lo = *(const LAS f32x4*)&WR[tt * 64 + 8 * jg], r_hi = *(const LAS f32x4*)&WR[tt * 64 + 8 * jg + 4];
                        const f32x4 w_lo = *(const LAS f32x4*)&Wd[tt * 64 + 8 * jg], w_hi = *(const LAS f32x4*)&Wd[tt * 64 + 8 * jg + 4];
                        const f32x4 b_lo = *(const LAS f32x4*)&Bv[tt * 64 + 8 * jg], b_hi = *(const LAS f32x4*)&Bv[tt * 64 + 8 * jg + 4];
                        const f32x4 k_lo = *(const LAS f32x4*)&Kk[tt * 64 + 8 * jg], k_hi = *(const LAS f32x4*)&Kk[tt * 64 + 8 * jg + 4];
                        const f32x2 vv = *(const LAS f32x2*)&Vv[tt * 64 + i0];
                        const f32x2 sc = *(const LAS f32x2*)&SC[tt * 4];
                        const f32x2 av[4] = {{a_lo.x, a_lo.y}, {a_lo.z, a_lo.w}, {a_hi.x, a_hi.y}, {a_hi.z, a_hi.w}};
                        const f32x2 rv[4] = {{r_lo.x, r_lo.y}, {r_lo.z, r_lo.w}, {r_hi.x, r_hi.y}, {r_hi.z, r_hi.w}};
                        const f32x2 wv[4] = {{w_lo.x, w_lo.y}, {w_lo.z, w_lo.w}, {w_hi.x, w_hi.y}, {w_hi.z, w_hi.w}};
                        const f32x2 bv[4] = {{b_lo.x, b_lo.y}, {b_lo.z, b_lo.w}, {b_hi.x, b_hi.y}, {b_hi.z, b_hi.w}};
                        const f32x2 kv[4] = {{k_lo.x, k_lo.y}, {k_lo.z, k_lo.w}, {k_hi.x, k_hi.y}, {k_hi.z, k_hi.w}};
                        f32x2 e10 = S0[0] * av[0], e20 = S0[0] * rv[0], e11 = S1[0] * av[0], e21 = S1[0] * rv[0];
#pragma unroll
                        for (int j = 1; j < 4; ++j) { e10 += S0[j] * av[j]; e20 += S0[j] * rv[j]; e11 += S1[j] * av[j]; e21 += S1[j] * rv[j]; }
                        const float d10 = red8(e10.x + e10.y), d20 = red8(e20.x + e20.y), d11 = red8(e11.x + e11.y), d21 = red8(e21.x + e21.y);
                        yk[s4] = (f32x2){d20 + d10 * sc.x + vv.x * sc.y, d21 + d11 * sc.x + vv.y * sc.y};
                        const f32x2 d10v = (f32x2){d10, d10}, d11v = (f32x2){d11, d11}, v0v = (f32x2){vv.x, vv.x}, v1v = (f32x2){vv.y, vv.y};
#pragma unroll
                        for (int j = 0; j < 4; ++j) { S0[j] = S0[j] * wv[j] + (d10v * bv[j] + v0v * kv[j]); S1[j] = S1[j] * wv[j] + (d11v * bv[j] + v1v * kv[j]); }
                    }
                    if (jg == 0) {
#pragma unroll
                        for (int s4 = 0; s4 < 4; ++s4) *(LAS f32x2*)&Yy[(4 * q4 + s4) * 64 + i0] = yk[s4];
                    }

#if PROBE_SCAN2
                    {
#pragma unroll
                    for (int s4 = 0; s4 < 4; ++s4) {
                        const int tt = 4 * q4 + s4;
                        const f32x4 a_lo = *(const LAS f32x4*)&A_[tt * 64 + 8 * jg], a_hi = *(const LAS f32x4*)&A_[tt * 64 + 8 * jg + 4];
                        const f32x4 r_lo = *(const LAS f32x4*)&WR[tt * 64 + 8 * jg], r_hi = *(const LAS f32x4*)&WR[tt * 64 + 8 * jg + 4];
                        const f32x4 w_lo = *(const LAS f32x4*)&Wd[tt * 64 + 8 * jg], w_hi = *(const LAS f32x4*)&Wd[tt * 64 + 8 * jg + 4];
                        const f32x4 b_lo = *(const LAS f32x4*)&Bv[tt * 64 + 8 * jg], b_hi = *(const LAS f32x4*)&Bv[tt * 64 + 8 * jg + 4];
                        const f32x4 k_lo = *(const LAS f32x4*)&Kk[tt * 64 + 8 * jg], k_hi = *(const LAS f32x4*)&Kk[tt * 64 + 8 * jg + 4];
                        const f32x2 vv = *(const LAS f32x2*)&Vv[tt * 64 + i0];
                        const f32x2 av[4] = {{a_lo.x, a_lo.y}, {a_lo.z, a_lo.w}, {a_hi.x, a_hi.y}, {a_hi.z, a_hi.w}};
                        const f32x2 rv[4] = {{r_lo.x, r_lo.y}, {r_lo.z, r_lo.w}, {r_hi.x, r_hi.y}, {r_hi.z, r_hi.w}};
                        const f32x2 wv[4] = {{w_lo.x, w_lo.y}, {w_lo.z, w_lo.w}, {w_hi.x, w_hi.y}, {w_hi.z, w_hi.w}};
                        const f32x2 bv[4] = {{b_lo.x, b_lo.y}, {b_lo.z, b_lo.w}, {b_hi.x, b_hi.y}, {b_hi.z, b_hi.w}};
                        const f32x2 kv[4] = {{k_lo.x, k_lo.y}, {k_lo.z, k_lo.w}, {k_hi.x, k_hi.y}, {k_hi.z, k_hi.w}};
                        f32x2 e10 = T0[0] * av[0], e20 = T0[0] * rv[0], e11 = T1[0] * av[0], e21 = T1[0] * rv[0];
#pragma unroll
                        for (int j = 1; j < 4; ++j) { e10 += T0[j] * av[j]; e20 += T0[j] * rv[j]; e11 += T1[j] * av[j]; e21 += T1[j] * rv[j]; }
                        const float d10 = red8(e10.x + e10.y), d20 = red8(e20.x + e20.y), d11 = red8(e11.x + e11.y), d21 = red8(e21.x + e21.y);
                        const f32x2 d10v = (f32x2){d10 + d20, d10}, d11v = (f32x2){d11 + d21, d11}, v0v = (f32x2){vv.x, vv.x}, v1v = (f32x2){vv.y, vv.y};
#pragma unroll
                        for (int j = 0; j < 4; ++j) { T0[j] = T0[j] * wv[j] + (d10v * bv[j] + v0v * kv[j]); T1[j] = T1[j] * wv[j] + (d11v * bv[j] + v1v * kv[j]); }
                    }
                    }
#endif
                }
                if (q4 & 1) LDS_BAR();
            }
        }
            }
        if (i0_ + 1 < RW_NCH) { const int i = i0_ + 1;

        const int bufn = (i + 1) & 1, bufc = i & 1;
        if (helper) {
            const bool do_prep = (i + 1 < RW_NCH);
            if (i >= 1) {
                LAS float* Yy = RW_ARR(bufn, 7); LAS float* Gg = RW_ARR(bufn, 6); LAS float* Vv = RW_ARR(bufn, 5); LAS float* SC = RW_SC(bufn);
                const f32x4 y = *(const LAS f32x4*)&Yy[tt_h * 64 + cg4], gg = *(const LAS f32x4*)&Gg[tt_h * 64 + cg4], vv = *(const LAS f32x4*)&Vv[tt_h * 64 + cg4];
                const float bonus = BON[((i - 1) % 3) * 16 + tt_h];
                const float mean = red16((y.x + y.y) + (y.z + y.w)) * (1.f / 64.f);
                const f32x4 d = y - mean;
                const float var = red16((d.x * d.x + d.y * d.y) + (d.z * d.z + d.w * d.w)) * (1.f / 64.f);
                const float rs = 1.f / sqrtf(var + 64e-5f);
                const f32x4 o = (d * rs * p_gg + p_gb + vv * bonus) * gg;
                u32x2 w; w.x = pk2(o.x, o.y); w.y = pk2(o.z, o.w);
                *(u32x2*)(X.P + ((size_t)b * SEQ + (i - 1) * RW_TS + tt_h) * LDP + COL_YA + h * 64 + cg4) = w;
            }
            if (do_prep) {
                const f32x4 r = (f32x4){bflo(l_rB.x), bfhi(l_rB.x), bflo(l_rB.y), bfhi(l_rB.y)}, k = (f32x4){bflo(l_kB.x), bfhi(l_kB.x), bflo(l_kB.y), bfhi(l_kB.y)};
                const f32x4 v = (f32x4){bflo(l_vB.x), bfhi(l_vB.x), bflo(l_vB.y), bfhi(l_vB.y)}, w1 = (f32x4){bflo(l_wB.x), bfhi(l_wB.x), bflo(l_wB.y), bfhi(l_wB.y)};
                const f32x4 a = (f32x4){bflo(l_aB.x), bfhi(l_aB.x), bflo(l_aB.y), bfhi(l_aB.y)};
                const f32x4 kk = k * p_kk * l_sB.x;
                const f32x4 decay = 1.f - w1;
                *(LAS f32x4*)&RW_ARR(bufn, 0)[tt_h * 64 + cg4] = -kk;
                *(LAS f32x4*)&RW_ARR(bufn, 1)[tt_h * 64 + cg4] = decay * r;
                *(LAS f32x4*)&RW_ARR(bufn, 2)[tt_h * 64 + cg4] = decay;
                *(LAS f32x4*)&RW_ARR(bufn, 3)[tt_h * 64 + cg4] = kk * a;
                *(LAS f32x4*)&RW_ARR(bufn, 4)[tt_h * 64 + cg4] = k * (1.f + (a - 1.f) * p_ka);
                *(LAS f32x4*)&RW_ARR(bufn, 5)[tt_h * 64 + cg4] = v;
                if (cg4 == 0) { LAS float* SC = RW_SC(bufn); SC[tt_h * 4 + 0] = l_sB.y; SC[tt_h * 4 + 1] = l_sB.z; BON[((i + 1) % 3) * 16 + tt_h] = l_sB.w; }
                float gc[8], gp[8];
                gc[0] = bflo(l_gcB.x); gc[1] = bfhi(l_gcB.x); gc[2] = bflo(l_gcB.y); gc[3] = bfhi(l_gcB.y); gc[4] = bflo(l_gcB.z); gc[5] = bfhi(l_gcB.z); gc[6] = bflo(l_gcB.w); gc[7] = bfhi(l_gcB.w);
                gp[0] = bflo(l_gpB.x); gp[1] = bfhi(l_gpB.x); gp[2] = bflo(l_gpB.y); gp[3] = bfhi(l_gpB.y); gp[4] = bflo(l_gpB.z); gp[5] = bfhi(l_gpB.z); gp[6] = bflo(l_gpB.w); gp[7] = bfhi(l_gpB.w);
#pragma unroll
                for (int e = 0; e < 8; ++e) gc[e] = sigmoidf_(gc[e] + (gp[e] - gc[e]) * (e < 4 ? mg0[e & 3] : mg1[e & 3]));
                u32x4 o; o.x = pk2(gc[0], gc[1]); o.y = pk2(gc[2], gc[3]); o.z = pk2(gc[4], gc[5]); o.w = pk2(gc[6], gc[7]);
                *(LAS u32x4*)&GDb[tt_h * 136 + gv8] = o;
            }
            if (i + 3 < RW_NCH) RW_LOAD(i + 3, B);
            LDS_BAR();
            if (do_prep) {
                LAS float* Gg = RW_ARR(bufn, 6);
                f32x4 cg_ = (f32x4){0.f, 0.f, 0.f, 0.f};
#pragma unroll
                for (int ks = 0; ks < 4; ++ks) {
                    const bf16x8 za = *(const LAS bf16x8*)&GDb[ln * 136 + ks * 32 + 8 * lg], zb = *(const LAS bf16x8*)&WTg[(16 * nt + ln) * 136 + ks * 32 + 8 * lg];
                    cg_ = __builtin_amdgcn_mfma_f32_16x16x32_bf16(za, zb, cg_, 0, 0, 0);
                }
#pragma unroll
                for (int r = 0; r < 4; ++r) Gg[(4 * lg + r) * 64 + chm] = cg_[r];
            }
            LDS_BAR();
        } else {
            LAS float* A_ = RW_ARR(bufc, 0); LAS float* WR = RW_ARR(bufc, 1); LAS float* Wd = RW_ARR(bufc, 2); LAS float* Bv = RW_ARR(bufc, 3);
            LAS float* Kk = RW_ARR(bufc, 4); LAS float* Vv = RW_ARR(bufc, 5); LAS float* Yy = RW_ARR(bufc, 7); LAS float* SC = RW_SC(bufc);
#pragma unroll 1
            for (int q4 = 0; q4 < 4; ++q4) {
                if (i >= 0) {
                    f32x2 yk[4];
#pragma unroll
                    for (int s4 = 0; s4 < 4; ++s4) {
                        const int tt = 4 * q4 + s4;
                        const f32x4 a_lo = *(const LAS f32x4*)&A_[tt * 64 + 8 * jg], a_hi = *(const LAS f32x4*)&A_[tt * 64 + 8 * jg + 4];
                        const f32x4 r_lo = *(const LAS f32x4*)&WR[tt * 64 + 8 * jg], r_hi = *(const LAS f32x4*)&WR[tt * 64 + 8 * jg + 4];
                        const f32x4 w_lo = *(const LAS f32x4*)&Wd[tt * 64 + 8 * jg], w_hi = *(const LAS f32x4*)&Wd[tt * 64 + 8 * jg + 4];
                        const f32x4 b_lo = *(const LAS f32x4*)&Bv[tt * 64 + 8 * jg], b_hi = *(const LAS f32x4*)&Bv[tt * 64 + 8 * jg + 4];
                        const f32x4 k_lo = *(const LAS f32x4*)&Kk[tt * 64 + 8 * jg], k_hi = *(const LAS f32x4*)&Kk[tt * 64 + 8 * jg + 4];
                        const f32x2 vv = *(const LAS f32x2*)&Vv[tt * 64 + i0];
                        const f32x2 sc = *(const LAS f32x2*)&SC[tt * 4];
                        const f32x2 av[4] = {{a_lo.x, a_lo.y}, {a_lo.z, a_lo.w}, {a_hi.x, a_hi.y}, {a_hi.z, a_hi.w}};
                        const f32x2 rv[4] = {{r_lo.x, r_lo.y}, {r_lo.z, r_lo.w}, {r_hi.x, r_hi.y}, {r_hi.z, r_hi.w}};
                        const f32x2 wv[4] = {{w_lo.x, w_lo.y}, {w_lo.z, w_lo.w}, {w_hi.x, w_hi.y}, {w_hi.z, w_hi.w}};
                        const f32x2 bv[4] = {{b_lo.x, b_lo.y}, {b_lo.z, b_lo.w}, {b_hi.x, b_hi.y}, {b_hi.z, b_hi.w}};
                        const f32x2 kv[4] = {{k_lo.x, k_lo.y}, {k_lo.z, k_lo.w}, {k_hi.x, k_hi.y}, {k_hi.z, k_hi.w}};
                        f32x2 e10 = S0[0] * av[0], e20 = S0[0] * rv[0], e11 = S1[0] * av[0], e21 = S1[0] * rv[0];
#pragma unroll
                        for (int j = 1; j < 4; ++j) { e10 += S0[j] * av[j]; e20 += S0[j] * rv[j]; e11 += S1[j] * av[j]; e21 += S1[j] * rv[j]; }
                        const float d10 = red8(e10.x + e10.y), d20 = red8(e20.x + e20.y), d11 = red8(e11.x + e11.y), d21 = red8(e21.x + e21.y);
                        yk[s4] = (f32x2){d20 + d10 * sc.x + vv.x * sc.y, d21 + d11 * sc.x + vv.y * sc.y};
                        const f32x2 d10v = (f32x2){d10, d10}, d11v = (f32x2){d11, d11}, v0v = (f32x2){vv.x, vv.x}, v1v = (f32x2){vv.y, vv.y};
#pragma unroll
                        for (int j = 0; j < 4; ++j) { S0[j] = S0[j] * wv[j] + (d10v * bv[j] + v0v * kv[j]); S1[j] = S1[j] * wv[j] + (d11v * bv[j] + v1v * kv[j]); }
                    }
                    if (jg == 0) {
#pragma unroll
                        for (int s4 = 0; s4 < 4; ++s4) *(LAS f32x2*)&Yy[(4 * q4 + s4) * 64 + i0] = yk[s4];
                    }

#if PROBE_SCAN2
                    {
#pragma unroll
                    for (int s4 = 0; s4 < 4; ++s4) {
                        const int tt = 4 * q4 + s4;
                        const f32x4 a_lo = *(const LAS f32x4*)&A_[tt * 64 + 8 * jg], a_hi = *(const LAS f32x4*)&A_[tt * 64 + 8 * jg + 4];
                        const f32x4 r_lo = *(const LAS f32x4*)&WR[tt * 64 + 8 * jg], r_hi = *(const LAS f32x4*)&WR[tt * 64 + 8 * jg + 4];
                        const f32x4 w_lo = *(const LAS f32x4*)&Wd[tt * 64 + 8 * jg], w_hi = *(const LAS f32x4*)&Wd[tt * 64 + 8 * jg + 4];
                        const f32x4 b_lo = *(const LAS f32x4*)&Bv[tt * 64 + 8 * jg], b_hi = *(const LAS f32x4*)&Bv[tt * 64 + 8 * jg + 4];
                        const f32x4 k_lo = *(const LAS f32x4*)&Kk[tt * 64 + 8 * jg], k_hi = *(const LAS f32x4*)&Kk[tt * 64 + 8 * jg + 4];
                        const f32x2 vv = *(const LAS f32x2*)&Vv[tt * 64 + i0];
                        const f32x2 av[4] = {{a_lo.x, a_lo.y}, {a_lo.z, a_lo.w}, {a_hi.x, a_hi.y}, {a_hi.z, a_hi.w}};
                        const f32x2 rv[4] = {{r_lo.x, r_lo.y}, {r_lo.z, r_lo.w}, {r_hi.x, r_hi.y}, {r_hi.z, r_hi.w}};
                        const f32x2 wv[4] = {{w_lo.x, w_lo.y}, {w_lo.z, w_lo.w}, {w_hi.x, w_hi.y}, {w_hi.z, w_hi.w}};
                        const f32x2 bv[4] = {{b_lo.x, b_lo.y}, {b_lo.z, b_lo.w}, {b_hi.x, b_hi.y}, {b_hi.z, b_hi.w}};
                        const f32x2 kv[4] = {{k_lo.x, k_lo.y}, {k_lo.z, k_lo.w}, {k_hi.x, k_hi.y}, {k_hi.z, k_hi.w}};
                        f32x2 e10 = T0[0] * av[0], e20 = T0[0] * rv[0], e11 = T1[0] * av[0], e21 = T1[0] * rv[0];
#pragma unroll
                        for (int j = 1; j < 4; ++j) { e10 += T0[j] * av[j]; e20 += T0[j] * rv[j]; e11 += T1[j] * av[j]; e21 += T1[j] * rv[j]; }
                        const float d10 = red8(e10.x + e10.y), d20 = red8(e20.x + e20.y), d11 = red8(e11.x + e11.y), d21 = red8(e21.x + e21.y);
                        const f32x2 d10v = (f32x2){d10 + d20, d10}, d11v = (f32x2){d11 + d21, d11}, v0v = (f32x2){vv.x, vv.x}, v1v = (f32x2){vv.y, vv.y};
#pragma unroll
                        for (int j = 0; j < 4; ++j) { T0[j] = T0[j] * wv[j] + (d10v * bv[j] + v0v * kv[j]); T1[j] = T1[j] * wv[j] + (d11v * bv[j] + v1v * kv[j]); }
                    }
                    }
#endif
                }
                if (q4 & 1) LDS_BAR();
            }
        }
            }
    }
    if (helper) {
        const int bufl = (RW_NCH - 1) & 1;
        LAS float* Yy = RW_ARR(bufl, 7); LAS float* Gg = RW_ARR(bufl, 6); LAS float* Vv = RW_ARR(bufl, 5); LAS float* SC = RW_SC(bufl);
        const f32x4 y = *(const LAS f32x4*)&Yy[tt_h * 64 + cg4], gg = *(const LAS f32x4*)&Gg[tt_h * 64 + cg4], vv = *(const LAS f32x4*)&Vv[tt_h * 64 + cg4];
        const float bonus = BON[((RW_NCH - 1) % 3) * 16 + tt_h];
        const float mean = red16((y.x + y.y) + (y.z + y.w)) * (1.f / 64.f);
        const f32x4 d = y - mean;
        const float var = red16((d.x * d.x + d.y * d.y) + (d.z * d.z + d.w * d.w)) * (1.f / 64.f);
        const float rs = 1.f / sqrtf(var + 64e-5f);
        const f32x4 o = (d * rs * p_gg + p_gb + vv * bonus) * gg;
        u32x2 w; w.x = pk2(o.x, o.y); w.y = pk2(o.z, o.w);
        *(u32x2*)(X.P + ((size_t)b * SEQ + (RW_NCH - 1) * RW_TS + tt_h) * LDP + COL_YA + h * 64 + cg4) = w;
    }
    __syncthreads();
#undef RW_ARR
#undef RW_SC
#undef RW_LOAD
}

__device__ __forceinline__ void hgrn_task(const Ctx& X, LAS unsigned char* lds, int layer, int b, int h, int vh) {
    LAS float* F = (LAS float*)(lds); LAS float* Q = (LAS float*)(lds + 16384); LAS float* Vv = (LAS float*)(lds + 32768); LAS float* O = (LAS float*)(lds + 40960);
    LAS float* LB = (LAS float*)(lds + 49152);
    const int tid = X.tid;
    const float* lbl = X.in[14];
    const int rp = tid >> 4, dg = tid & 15, v0 = 2 * rp;
    if (tid < 128) LB[tid] = (layer > 0) ? 1.f / (1.f + __expf(lbl[h * 128 + tid] - lbl[512 + h * 128 + tid])) : 0.f;
    f32x2 S0[4], S1[4];
#pragma unroll
    for (int j = 0; j < 4; ++j) { S0[j] = (f32x2){0.f, 0.f}; S1[j] = (f32x2){0.f, 0.f}; }
#define HG_LOAD(chk) do { _Pragma("unroll") for (int it = 0; it < 3; ++it) { const int idx = tid + 512 * it; raw[it] = (u32x4){0u, 0u, 0u, 0u}; \
        if (idx < 32 * 40) { const int tt = idx / 40, vv = idx - tt * 40; \
            const int col = vv < 16 ? 512 + h * 128 + 8 * vv : (vv < 32 ? h * 128 + 8 * (vv - 16) : 1024 + h * 128 + vh * 64 + 8 * (vv - 32)); \
            raw[it] = *(const u32x4*)(X.P + ((size_t)b * SEQ + (chk) * 32 + tt) * LDP + COL_PB + col); } } } while (0)
    u32x4 raw[3];
    HG_LOAD(0);
    __syncthreads();
#pragma unroll 1
    for (int ch = 0; ch < SEQ / 32; ++ch) {
        const int t0 = ch * 32;
#pragma unroll
        for (int it = 0; it < 3; ++it) {
            const int idx = tid + 512 * it;
            if (idx < 32 * 40) {
                const int tt = idx / 40, vv = idx - tt * 40;
                float x[8];
                x[0] = bflo(raw[it].x); x[1] = bfhi(raw[it].x); x[2] = bflo(raw[it].y); x[3] = bfhi(raw[it].y);
                x[4] = bflo(raw[it].z); x[5] = bfhi(raw[it].z); x[6] = bflo(raw[it].w); x[7] = bfhi(raw[it].w);
                LAS float* dst;
                if (vv < 16) {
                    dst = F + tt * 128 + 8 * vv;
#pragma unroll
                    for (int e = 0; e < 8; ++e) { const float lb = LB[8 * vv + e]; x[e] = lb + (1.f - lb) * sigmoidf_(x[e]); }
                } else if (vv < 32) dst = Q + tt * 128 + 8 * (vv - 16);
                else dst = Vv + tt * 64 + 8 * (vv - 32);
                *(LAS f32x4*)dst = (f32x4){x[0], x[1], x[2], x[3]}; *(LAS f32x4*)(dst + 4) = (f32x4){x[4], x[5], x[6], x[7]};
            }
        }
        if (ch + 1 < SEQ / 32) HG_LOAD(ch + 1);
        LDS_BAR();
#pragma unroll 4
        for (int tt = 0; tt < 32; ++tt) {
            const f32x4 f_lo = *(const LAS f32x4*)&F[tt * 128 + 8 * dg], f_hi = *(const LAS f32x4*)&F[tt * 128 + 8 * dg + 4];
            const f32x4 q_lo = *(const LAS f32x4*)&Q[tt * 128 + 8 * dg], q_hi = *(const LAS f32x4*)&Q[tt * 128 + 8 * dg + 4];
            const f32x2 vv = *(const LAS f32x2*)&Vv[tt * 64 + v0];
            const f32x2 f2[4] = {{f_lo.x, f_lo.y}, {f_lo.z, f_lo.w}, {f_hi.x, f_hi.y}, {f_hi.z, f_hi.w}};
            const f32x2 q2[4] = {{q_lo.x, q_lo.y}, {q_lo.z, q_lo.w}, {q_hi.x, q_hi.y}, {q_hi.z, q_hi.w}};
            const f32x2 v0v = (f32x2){vv.x, vv.x}, v1v = (f32x2){vv.y, vv.y};
            f32x2 a0 = (f32x2){0.f, 0.f}, a1 = (f32x2){0.f, 0.f};
#pragma unroll
            for (int j = 0; j < 4; ++j) {
                S0[j] = v0v + f2[j] * (S0[j] - v0v); S1[j] = v1v + f2[j] * (S1[j] - v1v);
                a0 += q2[j] * S0[j]; a1 += q2[j] * S1[j];
            }
            const float o0 = red16(a0.x + a0.y), o1 = red16(a1.x + a1.y);
            if (dg == 0) *(LAS f32x2*)&O[tt * 64 + v0] = (f32x2){o0, o1};
        }
        LDS_BAR();
        if (tid < 256) {
            const int tt = tid >> 3, v8 = (tid & 7) * 8;
            const f32x4 a = *(const LAS f32x4*)&O[tt * 64 + v8], c4 = *(const LAS f32x4*)&O[tt * 64 + v8 + 4];
            u32x4 o; o.x = pk2(a.x, a.y); o.y = pk2(a.z, a.w); o.z = pk2(c4.x, c4.y); o.w = pk2(c4.z, c4.w);
            *(u32x4*)(X.P + ((size_t)b * SEQ + t0 + tt) * LDP + COL_YB + h * 128 + vh * 64 + v8) = o;
        }
    }
#undef HG_LOAD
    __syncthreads();
}

__device__ __forceinline__ unsigned f2ord(float f) { const unsigned u = __builtin_bit_cast(unsigned, f); return (u & 0x80000000u) ? ~u : (u | 0x80000000u); }

__device__ __forceinline__ void dsa_tile(const Ctx& X, LAS unsigned char* lds, int b, int q0) {
    LAS float* sc = (LAS float*)lds;
    LAS unsigned* MASK = (LAS unsigned*)(lds + MASK_OFF);
    const int lane = X.lane, w = X.wave, n = lane & 15, g = lane >> 4;
    const bf16_t* Pb = X.P + (size_t)b * SEQ * LDP;
#pragma unroll 1
    for (int sub = 0; sub < 4; ++sub) {
        const int qs = q0 + 16 * sub;
        {
            bf16x8 bq[4][2]; float wi[4];
            const bf16_t* qrow = Pb + (size_t)(qs + n) * LDP;
#pragma unroll
            for (int hh = 0; hh < 4; ++hh) {
#pragma unroll
                for (int ks = 0; ks < 2; ++ks) bq[hh][ks] = *(const bf16x8*)(qrow + C_QI + hh * 64 + ks * 32 + 8 * g);
                wi[hh] = bf2f(qrow[C_WI + hh]);
            }
            const int nkt = (qs + 16) >> 4;
            bf16x8 a0n = (bf16x8){0, 0, 0, 0, 0, 0, 0, 0}, a1n = a0n;
            if (w < nkt) { const bf16_t* krow = Pb + (size_t)(w * 16 + n) * LDP + C_KI; a0n = *(const bf16x8*)(krow + 8 * g); a1n = *(const bf16x8*)(krow + 32 + 8 * g); }
#pragma unroll 1
            for (int kt = w; kt < nkt; kt += 8) {
                const bf16x8 a0 = a0n, a1 = a1n;
                if (kt + 8 < nkt) { const bf16_t* krow = Pb + (size_t)((kt + 8) * 16 + n) * LDP + C_KI; a0n = *(const bf16x8*)(krow + 8 * g); a1n = *(const bf16x8*)(krow + 32 + 8 * g); }
                f32x4 s = (f32x4){0.f, 0.f, 0.f, 0.f};
#pragma unroll
                for (int hh = 0; hh < 4; ++hh) {
                    f32x4 d = __builtin_amdgcn_mfma_f32_16x16x32_bf16(a0, bq[hh][0], (f32x4){0.f, 0.f, 0.f, 0.f}, 0, 0, 0);
                    d = __builtin_amdgcn_mfma_f32_16x16x32_bf16(a1, bq[hh][1], d, 0, 0, 0);
#pragma unroll
                    for (int r = 0; r < 4; ++r) s[r] += wi[hh] * fmaxf(d[r], 0.f);
                }
                const int t = qs + n;
#pragma unroll
                for (int r = 0; r < 4; ++r) if (kt * 16 + 4 * g + r > t) s[r] = -INFINITY;
                *(LAS f32x4*)&sc[n * SCS + kt * 16 + 4 * g] = s;
            }
        }
        __syncthreads();
#pragma unroll 1
        for (int e = 0; e < 2; ++e) {
            const int qn = 2 * w + e, t = qs + qn;
            LAS unsigned* mrow = MASK + (sub * 16 + qn) * 64;
            if (t < 256) {
#pragma unroll
                for (int j = 0; j < 32; ++j) {
                    const unsigned long long sm = __ballot(j * 64 + lane <= t);
                    if (lane == 0) { mrow[2 * j] = (unsigned)sm; mrow[2 * j + 1] = (unsigned)(sm >> 32); }
                }
            } else {
                const int jn = (t >> 6) + 1;
                unsigned u[32];
#pragma unroll
                for (int j = 0; j < 32; ++j) {
                    u[j] = 0u;
                    if (j < jn) { const int key = j * 64 + lane; const float s = (key <= t) ? sc[qn * SCS + key] : -INFINITY; u[j] = f2ord(s); }
                }
                unsigned prefix = 0u;
#define DSA_BITSEARCH(JN) do { _Pragma("unroll 1") for (int bit = 31; bit >= 0; --bit) { const unsigned cand = prefix | (1u << bit); int c0 = 0, c1 = 0; \
                    _Pragma("unroll") for (int j = 0; j < (JN); j += 2) { c0 += (u[j] >= cand) ? 1 : 0; c1 += (u[j + 1] >= cand) ? 1 : 0; } \
                    const int cnt = (int)wave_sum_fast((float)(c0 + c1)); if (cnt >= 256) prefix = cand; } } while (0)
                if (jn <= 8) DSA_BITSEARCH(8); else if (jn <= 16) DSA_BITSEARCH(16); else if (jn <= 24) DSA_BITSEARCH(24); else DSA_BITSEARCH(32);
#undef DSA_BITSEARCH
                int cg_ = 0;
#pragma unroll
                for (int j = 0; j < 32; ++j) if (j < jn) cg_ += __popcll(__ballot(u[j] > prefix));
                const int need = 256 - cg_;
                int cum = 0;
#pragma unroll
                for (int j = 0; j < 32; ++j) {
                    unsigned long long sm = 0ull;
                    if (j < jn) {
                        const bool eq = (u[j] == prefix);
                        const unsigned long long em = __ballot(eq);
                        const int rank = cum + (int)__builtin_amdgcn_mbcnt_hi((unsigned)(em >> 32), __builtin_amdgcn_mbcnt_lo((unsigned)em, 0u));
                        const bool sel = (u[j] > prefix) || (eq && rank < need);
                        sm = __ballot(sel);
                        cum += __popcll(em);
                    }
                    if (lane == 0) { mrow[2 * j] = (unsigned)sm; mrow[2 * j + 1] = (unsigned)(sm >> 32); }
                }
            }
        }
        __syncthreads();
    }
    const int qq = q0 + 8 * w + (n & 7);
    const LAS unsigned* mq = MASK + (8 * w + (n & 7)) * 64;
    const int nsteps = (q0 + 8 * w + 8 + 31) >> 5;
    const int nblk = (q0 + 64 + 127) >> 7;
    LAS bf16_t* KT = (LAS bf16_t*)lds;
    LAS bf16_t* VTT = (LAS bf16_t*)(lds + 36864);
    const int tid = X.tid;
#pragma unroll 1
    for (int c = 0; c < 2; ++c) {
        bf16x8 bq[2][2];
#pragma unroll
        for (int j = 0; j < 2; ++j)
#pragma unroll
            for (int ks = 0; ks < 2; ++ks) bq[j][ks] = *(const bf16x8*)(Pb + (size_t)qq * LDP + C_Q + (c * 4 + 2 * j + (n >> 3)) * 64 + ks * 32 + 8 * g);
        float lrun[2] = {0.f, 0.f};
        f32x4 oacc[4][2];
#pragma unroll
        for (int mt = 0; mt < 4; ++mt)
#pragma unroll
            for (int j = 0; j < 2; ++j) oacc[mt][j] = (f32x4){0.f, 0.f, 0.f, 0.f};
        const bf16_t* vtb = X.VT + ((size_t)(b * 2 + c) * 64) * SEQ;
        u32x4 gk[2], gv[2];
#define DSA_GLOAD(kblk) do { _Pragma("unroll") for (int it = 0; it < 2; ++it) { const int idx = tid + 512 * it; \
            gk[it] = *(const u32x4*)(Pb + (size_t)((kblk) * 128 + (idx >> 3)) * LDP + C_K + c * 64 + (idx & 7) * 8); \
            gv[it] = *(const u32x4*)(vtb + (size_t)(idx >> 4) * SEQ + (kblk) * 128 + (idx & 15) * 8); } } while (0)
#define DSA_LSTORE(bufi) do { _Pragma("unroll") for (int it = 0; it < 2; ++it) { const int idx = tid + 512 * it; \
            *(LAS u32x4*)(KT + (bufi) * 9216 + (idx >> 3) * 72 + (idx & 7) * 8) = gk[it]; \
            *(LAS u32x4*)(VTT + (bufi) * 8704 + (idx >> 4) * 136 + (idx & 15) * 8) = gv[it]; } } while (0)
        DSA_GLOAD(0);
        LDS_BAR();
        DSA_LSTORE(0);
        LDS_BAR();
#pragma unroll 1
        for (int kb = 0; kb < nblk; ++kb) {
            const int buf = kb & 1;
            if (kb + 1 < nblk) DSA_GLOAD(kb + 1);
            const LAS bf16_t* Kb = KT + buf * 9216; const LAS bf16_t* Vb = VTT + buf * 8704;
#pragma unroll 1
            for (int sl = 0; sl < 4; ++sl) {
                const int sg = kb * 4 + sl;
                if (sg < nsteps) {
                    f32x4 st[2][2];
#pragma unroll
                    for (int tl = 0; tl < 2; ++tl) {
                        const LAS bf16_t* kr = Kb + (32 * sl + 16 * tl + n) * 72;
                        const bf16x8 a0 = *(const LAS bf16x8*)(kr + 8 * g), a1 = *(const LAS bf16x8*)(kr + 32 + 8 * g);
#pragma unroll
                        for (int j = 0; j < 2; ++j) {
                            f32x4 d = __builtin_amdgcn_mfma_f32_16x16x32_bf16(a0, bq[j][0], (f32x4){0.f, 0.f, 0.f, 0.f}, 0, 0, 0);
                            st[tl][j] = __builtin_amdgcn_mfma_f32_16x16x32_bf16(a1, bq[j][1], d, 0, 0, 0);
                        }
                    }
                    bf16x8 av[4];
#pragma unroll
                    for (int mt = 0; mt < 4; ++mt) {
                        const LAS bf16_t* vp = Vb + (mt * 16 + n) * 136 + 32 * sl + 4 * g;
                        const u32x2 lo = *(const LAS u32x2*)vp, hi = *(const LAS u32x2*)(vp + 16);
                        u32x4 t4; t4.x = lo.x; t4.y = lo.y; t4.z = hi.x; t4.w = hi.y;
                        av[mt] = __builtin_bit_cast(bf16x8, t4);
                    }
                    const unsigned mw = mq[sg];
#pragma unroll
                    for (int j = 0; j < 2; ++j) {
                        float p[8], ps = 0.f;
#pragma unroll
                        for (int tl = 0; tl < 2; ++tl)
#pragma unroll
                            for (int r = 0; r < 4; ++r) { const int bit = 16 * tl + 4 * g + r; const float e = __expf(fminf(st[tl][j][r] * 0.125f, 60.f)); p[4 * tl + r] = ((mw >> bit) & 1u) ? e : 0.f; ps += p[4 * tl + r]; }
                        lrun[j] += ps;
                        u32x4 pw; pw.x = pg8::cvt_pk_bf16(p[0], p[1]); pw.y = pg8::cvt_pk_bf16(p[2], p[3]); pw.z = pg8::cvt_pk_bf16(p[4], p[5]); pw.w = pg8::cvt_pk_bf16(p[6], p[7]);
                        const bf16x8 pb = __builtin_bit_cast(bf16x8, pw);
#pragma unroll
                        for (int mt = 0; mt < 4; ++mt) oacc[mt][j] = __builtin_amdgcn_mfma_f32_16x16x32_bf16(av[mt], pb, oacc[mt][j], 0, 0, 0);
                    }
                }
            }
            if (kb + 1 < nblk) DSA_LSTORE(buf ^ 1);
            LDS_BAR();
        }
#pragma unroll
        for (int j = 0; j < 2; ++j) {
            float lt = lrun[j]; lt += __shfl_xor(lt, 16); lt += __shfl_xor(lt, 32);
            const float il = 1.f / lt;
            bf16_t* op = X.P + ((size_t)b * SEQ + qq) * LDP + COL_YC + (c * 4 + 2 * j + (n >> 3)) * 64 + 4 * g;
#pragma unroll
            for (int mt = 0; mt < 4; ++mt) {
                const f32x4 o = oacc[mt][j] * il;
                u32x2 wv; wv.x = pg8::cvt_pk_bf16(o[0], o[1]); wv.y = pg8::cvt_pk_bf16(o[2], o[3]);
                *(u32x2*)(op + mt * 16) = wv;
            }
        }
    }
#undef DSA_GLOAD
#undef DSA_LSTORE
    __syncthreads();
}

__device__ __forceinline__ void phase_mixers(const Ctx& X0, LAS unsigned char* lds, int layer) {
#pragma unroll 1
    for (int task = X0.bid; task < 128; task += X0.G) {
        Ctx X = X0;
        { int t_ = threadIdx.x; asm volatile("" : "+v"(t_)); X.tid = t_; X.lane = t_ & 63; }
        if (task < 64) { if (TKMASK & 1) rwkv_task(X, lds, layer, task >> 3, task & 7); }
        else { const int k = task - 64; if (TKMASK & 2) hgrn_task(X, lds, layer, k >> 3, (k >> 1) & 3, k & 1); }
    }
    volatile LAS unsigned* tw = (volatile LAS unsigned*)(lds + LDS_BYTES - 128);
    unsigned* ctr = (unsigned*)(X0.ws + WS_BAR + 14336) + 16 * layer;
#pragma unroll 1
    for (;;) {
        Ctx X = X0;
        { int t_ = threadIdx.x; asm volatile("" : "+v"(t_)); X.tid = t_; X.lane = t_ & 63; }
        __syncthreads();
        if (threadIdx.x == 0) tw[0] = __hip_atomic_fetch_add(ctr, 1u, __ATOMIC_RELAXED, __HIP_MEMORY_SCOPE_AGENT);
        __syncthreads();
        const int t = (int)tw[0];
        if (t >= 256) break;
        if (TKMASK & 4) dsa_tile(X, lds, t & 7, 64 * (31 - (t >> 3)));
    }
}

__device__ __forceinline__ void phase_hgrn_post(const Ctx& X, int layer) {
    const int gw = X.bid * 8 + X.wave, NGW = X.G * 8;
    const float* gn = X.in[15] + layer * 512;
#pragma unroll 1
    for (int it0 = gw; it0 < T_TOK * 4; it0 += 4 * NGW) {
        unsigned ow[4], gwd[4]; unsigned* op[4];
#pragma unroll
        for (int r = 0; r < 4; ++r) {
            const int it = it0 + r * NGW < T_TOK * 4 ? it0 + r * NGW : it0;
            const int t = it >> 2, h = it & 3;
            bf16_t* rowp = X.P + (size_t)t * LDP;
            op[r] = (unsigned*)(rowp + COL_YB + h * 128) + X.lane;
            ow[r] = *op[r]; gwd[r] = *((const unsigned*)(rowp + COL_PB + 1536 + h * 128) + X.lane);
        }
#pragma unroll
        for (int r = 0; r < 4; ++r) {
            const int it = it0 + r * NGW;
            const int h = it & 3;
            const float o0 = bflo(ow[r]), o1 = bfhi(ow[r]), g0 = bflo(gwd[r]), g1 = bfhi(gwd[r]);
            const float rs = 1.f / sqrtf(wave_sum(o0 * o0 + o1 * o1) * (1.f / 128.f) + 1e-6f);
            const float y0 = o0 * rs * gn[h * 128 + 2 * X.lane] * (g0 * sigmoidf_(g0)), y1 = o1 * rs * gn[h * 128 + 2 * X.lane + 1] * (g1 * sigmoidf_(g1));
            if (it < T_TOK * 4) *op[r] = pk2(y0, y1);
        }
    }
}

__device__ __forceinline__ void phase_fixup(const Ctx& X, int layer) {
    const float* cw = X.in[20] + (size_t)layer * 3 * F2; const float* cb = X.in[21] + (size_t)layer * F2;
#pragma unroll 4
    for (int idx = X.bid * 512 + X.tid; idx < 256 * 2 * DFF; idx += X.G * 512) {
        const int j = idx % DFF, sr = idx / DFF, s = sr >> 1, r = sr & 1;
        const int colg = (j >> 7) * 256 + (j & 127), colv = colg + 128;
        const bool seq0 = (s & 31) == 0;
        const float* H = X.HALO;
        float res[2];
#pragma unroll
        for (int part = 0; part < 2; ++part) {
            const int cp = part ? colv : colg, co = part * DFF + j;
            const float u0 = H[(size_t)(s * 4 + r) * F2 + cp];
            float u1, u2;
            if (r == 0) { u1 = seq0 ? 0.f : H[(size_t)((s - 1) * 4 + 3) * F2 + cp]; u2 = seq0 ? 0.f : H[(size_t)((s - 1) * 4 + 2) * F2 + cp]; }
            else { u1 = H[(size_t)(s * 4 + 0) * F2 + cp]; u2 = seq0 ? 0.f : H[(size_t)((s - 1) * 4 + 3) * F2 + cp]; }
            res[part] = cb[co] + cw[co] * u2 + cw[F2 + co] * u1 + cw[2 * F2 + co] * u0;
        }
        const float a = res[0] * sigmoidf_(res[0]) * res[1];
        X.P[(size_t)(s * 64 + r) * LDP + COL_ACT + j] = (bf16_t)f2bf(a);
    }
}

#define XB_TMO      128
#define XB_XCNT(j)  (256  + 64 * (j))
#define XB_XSUB(j)  (1280 + 64 * (j))
#define XB_XGEN(j)  (2304 + 64 * (j))
#define XB_TOP      3328
#define XB_TOPGEN   3392
#define XCD_BAR_WORDS 3456
#define XB_SPIN_CAP (1u << 22)
__device__ __forceinline__ unsigned xb_ld(unsigned* p)              { return __hip_atomic_load(p, __ATOMIC_RELAXED, __HIP_MEMORY_SCOPE_AGENT); }
__device__ __forceinline__ unsigned xb_add(unsigned* p, unsigned v) { return __hip_atomic_fetch_add(p, v, __ATOMIC_RELAXED, __HIP_MEMORY_SCOPE_AGENT); }
__device__ __forceinline__ unsigned xb_xcc_id() { return (unsigned)__builtin_amdgcn_s_getreg((3 << 11) | 20) & 0xFu; }
#define XB_SPIN(cond, bar) do { unsigned _sp = 0; while (cond) { __builtin_amdgcn_s_sleep(1); \
    if ((++_sp & 255u) == 0u) { if (xb_ld(&(bar)[XB_TMO])) break; if (_sp > XB_SPIN_CAP) { atomicAdd(&(bar)[XB_TMO], 1u); break; } } } } while (0)
struct XcdBarrier { unsigned* bar; unsigned x; volatile LAS unsigned* st; };
__device__ __forceinline__ XcdBarrier xcd_barrier_post(unsigned* bar, volatile LAS unsigned* st) {
    XcdBarrier b; b.bar = bar; b.x = xb_xcc_id(); b.st = st;
    if (threadIdx.x == 0) (void)xb_add(&bar[XB_XCNT(b.x)], 1u);
    return b;
}
__device__ __forceinline__ void xcd_barrier_complete(unsigned* bar, unsigned x, unsigned& nloc, unsigned& nx) {
    const unsigned G = gridDim.x * gridDim.y * gridDim.z;
    unsigned sum, cnt, mine, sp = 0u;
    for (;;) {
        sum = 0u; cnt = 0u; mine = 0u;
#pragma unroll
        for (unsigned j = 0; j < 16; ++j) { const unsigned c = xb_ld(&bar[XB_XCNT(j)]); sum += c; cnt += (c > 0u) ? 1u : 0u; mine = (j == x) ? c : mine; }
        if (sum == G) break;
        __builtin_amdgcn_s_sleep(1);
        if ((++sp & 255u) == 0u) { if (xb_ld(&bar[XB_TMO])) break; if (sp > XB_SPIN_CAP) { atomicAdd(&bar[XB_TMO], 1u); break; } }
    }
    nloc = mine > 0u ? mine : 1u; nx = cnt > 0u ? cnt : 1u;
}
__device__ __forceinline__ void xcd_barrier(const XcdBarrier& b) {
    asm volatile("s_waitcnt vmcnt(0)" ::: "memory");
    __syncthreads();
    if (threadIdx.x == 0) {
        unsigned* bar = b.bar;
        __builtin_amdgcn_s_waitcnt(0);
        unsigned nloc = b.st[0], nx = b.st[1];
        if (nloc == 0u) { xcd_barrier_complete(bar, b.x, nloc, nx); b.st[0] = nloc; b.st[1] = nx; }
        const unsigned old = xb_add(&bar[XB_XSUB(b.x)], 1u);
        const unsigned gen = old / nloc;
        if (old + 1u == (gen + 1u) * nloc) {
            __builtin_amdgcn_fence(__ATOMIC_RELEASE, "agent");
            asm volatile("s_waitcnt vmcnt(0)" ::: "memory");
            const unsigned og = xb_add(&bar[XB_TOP], 1u);
            const unsigned tg = og / nx;
            if (og + 1u == (tg + 1u) * nx) xb_add(&bar[XB_TOPGEN], 1u);
            else XB_SPIN(xb_ld(&bar[XB_TOPGEN]) == tg, bar);
            __builtin_amdgcn_fence(__ATOMIC_ACQUIRE, "agent");
            xb_add(&bar[XB_XGEN(b.x)], 1u);
            asm volatile("s_waitcnt vmcnt(0)" ::: "memory");
        } else {
            XB_SPIN(xb_ld(&bar[XB_XGEN(b.x)]) == gen, bar);
            __builtin_amdgcn_fence(__ATOMIC_ACQUIRE, "agent");
            asm volatile("s_waitcnt vmcnt(0)" ::: "memory");
        }
    }
    __syncthreads();
}

__global__ void __launch_bounds__(512, 2) mk_fwd(Args args) {
    extern __shared__ __attribute__((aligned(16))) unsigned char lds_raw[];
    LAS unsigned char* lds = (LAS unsigned char*)lds_raw;
    Ctx X;
#pragma unroll
    for (int i = 0; i < 24; ++i) X.in[i] = args.in[i];
    X.out = args.out; X.ws = args.ws;
    X.P = (bf16_t*)(args.ws + WS_P); X.VT = (bf16_t*)(args.ws + WS_VT); X.HALO = (float*)(args.ws + WS_HALO); X.ROPE = (float*)(args.ws + WS_ROPE);
    X.Win = (bf16_t*)(args.ws + WS_WIN); X.Wg = (bf16_t*)(args.ws + WS_WG); X.Wbr = (bf16_t*)(args.ws + WS_WBR);
    X.Wo = (bf16_t*)(args.ws + WS_WO); X.Wup = (bf16_t*)(args.ws + WS_WUP); X.Wdn = (bf16_t*)(args.ws + WS_WDN);
    X.tid = threadIdx.x; X.lane = X.tid & 63; X.wave = __builtin_amdgcn_readfirstlane(X.tid >> 6); X.G = gridDim.x; X.bid = blockIdx.x;

#if PROBE_DOUBLE
    for (int ph2 = args.ph_lo * 2; ph2 < args.ph_hi * 2; ++ph2) {
        const int ph = ph2 >> 1;
        const int layer = ph / 11, sub = ph % 11;
        const bool skip_ = (ph2 & 1) && !(ph < 22 && ((REPMASK >> sub) & 1));
#else
    volatile LAS unsigned* bst = (volatile LAS unsigned*)(lds + LDS_BYTES - 64);
    if (threadIdx.x < 2) bst[threadIdx.x] = 0u;
    __syncthreads();
    XcdBarrier gbar = xcd_barrier_post((unsigned*)(args.ws + WS_BAR), bst);
    for (int ph = args.ph_lo; ph < args.ph_hi; ++ph) {
        const int layer = ph / 11, sub = ph % 11;
        const bool skip_ = false;
#endif
        { int t_ = threadIdx.x; asm volatile("" : "+v"(t_)); X.tid = t_; X.lane = t_ & 63; }

        if (skip_) {
        } else if (ph == 22 && (PHMASK & 1024)) {
            const int gw = X.bid * 8 + X.wave, NGW = X.G * 8;
            (void)gw; (void)NGW; rms_pass(X, X.out, X.in[23], nullptr, X.out);
        } else if (sub == 0 && (PHMASK & 1)) {
            phase_prep(X, lds, layer);
        } else if (sub == 1 && (PHMASK & 2)) {
            pg8::Gemm g{X.P, X.Win, LDP, DM, DM}; pg8::StaticOrder S; S.init(T_TOK, 5120, X.G, X.bid);
            pg8::EpiInProj E{X.P, X.VT, X.ROPE, (bf16_t*)(X.ws + WS_BND)};
            pg8::gemm_phase<pg8::EpiInProj, true>(lds, g, S, E, X.tid);
        } else if (sub == 2 && (PHMASK & 4)) {
            phase_rwkv_pre(X, lds, layer);
        } else if (sub == 3 && (PHMASK & 4)) {
            phase_mixers(X, lds, layer);
        } else if (sub == 4 && (PHMASK & 8)) {
            phase_hgrn_post(X, layer);
            { const int gw = X.bid * 8 + X.wave, NGW = X.G * 8; const float* hh = (layer == 0) ? X.in[0] : X.out; const float* g = X.in[1] + (size_t)layer * DM;
              (void)gw; (void)NGW; rms_pass(X, hh, g, X.P, nullptr); }
        } else if (sub == 5 && (PHMASK & 16)) {
#pragma unroll 1
            for (int br = 0; br < 3; ++br) {
                { pg8::Gemm g{X.P, X.Wg + (size_t)br * DM * DM, LDP, DM, DM}; pg8::StaticOrder S; S.init(T_TOK, DM, X.G, X.bid);
                  int t_ = X.tid; asm volatile("" : "+v"(t_));
                  pg8::EpiGate E{X.P}; pg8::gemm_phase<pg8::EpiGate, true>(lds, g, S, E, t_); }
                { const int ycol = br == 0 ? COL_YA : (br == 1 ? COL_YB : COL_YC);
                  pg8::Gemm g{X.P + ycol, X.Wbr + (size_t)br * DM * 512, LDP, 512, 512}; pg8::StaticOrder S; S.init(T_TOK, DM, X.G, X.bid);
                  int t_ = X.tid; asm volatile("" : "+v"(t_));
                  pg8::EpiMergeAcc E{X.P, br == 0 ? 1 : 0}; pg8::gemm_phase<pg8::EpiMergeAcc, true>(lds, g, S, E, t_); }
            }
        } else if (sub == 6 && (PHMASK & 32)) {
            pg8::Gemm g{X.P + COL_MRG, X.Wo, LDP, DM, DM}; pg8::StaticOrder S; S.init(T_TOK, DM, X.G, X.bid);
            pg8::EpiResid E{layer == 0 ? X.in[0] : X.out, X.out};
            pg8::gemm_phase<pg8::EpiResid, true>(lds, g, S, E, X.tid);
        } else if (sub == 7 && (PHMASK & 64)) {
            const int gw = X.bid * 8 + X.wave, NGW = X.G * 8;
            const float* g = X.in[18] + (size_t)layer * DM;
            (void)gw; (void)NGW; rms_pass(X, X.out, g, X.P, nullptr);
        } else if (sub == 8 && (PHMASK & 128)) {
            pg8::Gemm g{X.P, X.Wup, LDP, DM, DM}; pg8::StaticOrder S; S.init(T_TOK, F2, X.G, X.bid);
            pg8::EpiUp E{X.P, X.HALO, X.in[20] + (size_t)layer * 3 * F2, X.in[21] + (size_t)layer * F2, (LAS float*)(lds + 131072)};
            pg8::gemm_phase<pg8::EpiUp, true>(lds, g, S, E, X.tid);
        } else if (sub == 9 && (PHMASK & 256)) {
            phase_fixup(X, layer);
        } else if (sub == 10 && (PHMASK & 512)) {
            pg8::Gemm g{X.P + COL_ACT, X.Wdn, LDP, DFF, DFF}; pg8::StaticOrder S; S.init(T_TOK, DM, X.G, X.bid);
            pg8::EpiResid E{X.out, X.out};
            pg8::gemm_phase<pg8::EpiResid, true>(lds, g, S, E, X.tid);
        }
#if PROBE_DOUBLE
        if (ph2 + 1 < args.ph_hi * 2) cg::this_grid().sync();
#else
        if (ph + 1 < args.ph_hi) { if (ph == args.ph_lo) cg::this_grid().sync(); else xcd_barrier(gbar); }
#endif
    }
}

extern "C" void kernel_launch(void* const* d_in, const int* in_sizes, int n_in, void* d_out, int out_size, void* d_ws, size_t ws_size, hipStream_t stream) {
    static int grid = 0;
    if (grid == 0) {
        int dev = 0, cus = 0, per_cu = 0;
        (void)hipGetDevice(&dev);
        (void)hipDeviceGetAttribute(&cus, hipDeviceAttributeMultiprocessorCount, dev);
        if (hipFuncSetAttribute((const void*)mk_fwd, hipFuncAttributeMaxDynamicSharedMemorySize, LDS_BYTES) != hipSuccess) fprintf(stderr, "kernel_launch: hipFuncSetAttribute failed\n");
        if (hipOccupancyMaxActiveBlocksPerMultiprocessor(&per_cu, (const void*)mk_fwd, 512, LDS_BYTES) != hipSuccess || per_cu < 1) { fprintf(stderr, "kernel_launch: occupancy query gave %d\n", per_cu); per_cu = 1; }
        (void)hipGetLastError();
        grid = cus * 1;
        if (grid <= 0) grid = 256;
        if (ws_size < (size_t)268435456) fprintf(stderr, "kernel_launch: workspace too small (%zu)\n", ws_size);
    }
    Args a{};
    for (int i = 0; i < 24; ++i) a.in[i] = (const float*)d_in[i];
    a.out = (float*)d_out; a.ws = (unsigned char*)d_ws;
#if MK_SINGLE
    (void)hipMemsetAsync((char*)d_ws + WS_BAR, 0, 16384, stream);
    a.ph_lo = 0; a.ph_hi = 23;
    void* kargs[] = {&a};
    hipError_t e = hipLaunchCooperativeKernel((const void*)mk_fwd, dim3(grid), dim3(512), kargs, LDS_BYTES, stream);
    if (e != hipSuccess) fprintf(stderr, "cooperative launch failed: %s (grid %d)\n", hipGetErrorString(e), grid);
#else
    for (int ph = 0; ph < 23; ++ph) {
        a.ph_lo = ph; a.ph_hi = ph + 1;
        hipLaunchKernelGGL(mk_fwd, dim3(grid), dim3(512), LDS_BYTES, stream, a);
    }
#endif
}
```

```cpp
#include <hip/hip_runtime.h>
#include <hip/hip_cooperative_groups.h>
#include <cstdio>
#include <cstdint>
namespace cg = cooperative_groups;

#ifndef PHMASK
#define PHMASK 2047
#endif
#ifndef REPMASK
#define REPMASK 0
#endif
#ifndef PROBE_DOUBLE
#define PROBE_DOUBLE 0
#endif
#ifndef PROBE_SCAN2
#define PROBE_SCAN2 0
#endif
#ifndef TKMASK
#define TKMASK 7
#endif
#ifndef MK_SINGLE
#define MK_SINGLE 1
#endif

#define LAS __attribute__((address_space(3)))
typedef unsigned short bf16_t;
typedef short bf16x8 __attribute__((ext_vector_type(8)));
typedef float f32x4 __attribute__((ext_vector_type(4)));
typedef float f32x2 __attribute__((ext_vector_type(2)));
typedef unsigned u32x4 __attribute__((ext_vector_type(4)));
typedef unsigned u32x2 __attribute__((ext_vector_type(2)));

constexpr int T_TOK = 16384, SEQ = 2048, DM = 1024;
constexpr int LDP = 6144;
constexpr int COL_PA = 1024, COL_PB = 2816, COL_PC = 4864;
constexpr int COL_YA = 1024, COL_MRG = 1536, COL_G = 2816, COL_YB = 3840, COL_YC = 4864, COL_ACT = 1024;
constexpr int C_Q = 4864, C_K = 5376, C_QI = 5632, C_KI = 5888, C_WI = 5952;
constexpr int IN_COLS = 8004, DFF = 2816, F2 = 5632;
constexpr size_t WS_WIN = 0, WS_WG = 10485760, WS_WBR = 16777216, WS_WO = 19922944, WS_WUP = 22020096, WS_WDN = 33554432;
constexpr size_t WS_P = 41943040, WS_HALO = 243269632, WS_VT = WS_HALO, WS_ROPE = 266338304, WS_BAR = 266862592, WS_BND = WS_HALO + 4194304, WS_SCAL = WS_HALO + 8388608;
constexpr int LDS_BYTES = 153600;
constexpr int SCS = 2052;
constexpr int MASK_OFF = 16 * SCS * 4;

struct Args { const float* in[24]; float* out; unsigned char* ws; int ph_lo, ph_hi; };

__device__ __forceinline__ unsigned f2bf(float f) { unsigned u = __builtin_bit_cast(unsigned, f); return (u + 0x7fffu + ((u >> 16) & 1u)) >> 16; }
__device__ __forceinline__ unsigned pk2(float lo, float hi) { return f2bf(lo) | (f2bf(hi) << 16); }
__device__ __forceinline__ float bf2f(bf16_t b) { return __builtin_bit_cast(float, (unsigned)b << 16); }
__device__ __forceinline__ float bflo(unsigned w) { return __builtin_bit_cast(float, w << 16); }
__device__ __forceinline__ float bfhi(unsigned w) { return __builtin_bit_cast(float, w & 0xffff0000u); }
__device__ __forceinline__ float wave_sum(float v) {
#pragma unroll
    for (int o = 1; o < 64; o <<= 1) v += __shfl_xor(v, o);
    return v;
}
__device__ __forceinline__ int wave_sum_i(int v) {
#pragma unroll
    for (int o = 1; o < 64; o <<= 1) v += __shfl_xor(v, o);
    return v;
}
template <int CTRL> __device__ __forceinline__ float dpp_mov(float x) {
    return __builtin_bit_cast(float, __builtin_amdgcn_update_dpp(0, __builtin_bit_cast(int, x), CTRL, 0xF, 0xF, true));
}
__device__ __forceinline__ float red8(float x) { x += dpp_mov<0xB1>(x); x += dpp_mov<0x4E>(x); x += dpp_mov<0x141>(x); return x; }
__device__ __forceinline__ float red16(float x) { x = red8(x); x += dpp_mov<0x140>(x); return x; }
__device__ __forceinline__ float sigmoidf_(float x) { return 1.f / (1.f + __expf(-x)); }

namespace pg8 {
constexpr int BM = 256, BK = 64, HALF = 128, HTB = HALF * BK * 2, NXCD = 8, WGM = 8;
__device__ __forceinline__ int lds_byte(int r, int c) { const int st = (r >> 4) * 2 + (c >> 5), rr = r & 15, cc = c & 31, ob = rr * 64 + cc * 2; return st * 1024 + (ob ^ (((ob >> 9) & 1) << 5)); }
__device__ __forceinline__ void stage_rc(int b, int& R, int& C) { const int st = b / 1024, sb = b % 1024, swz = sb ^ (((sb >> 9) & 1) << 5); R = (st >> 1) * 16 + swz / 64; C = (st & 1) * 32 + (swz % 64) / 2; }
__device__ __forceinline__ int perm32(int rho) { const int n = rho >> 4, i = rho & 15; return 8 * (i >> 2) + 4 * n + (i & 3); }
struct Unit { int pm, pn; };
struct Gemm { const bf16_t* A; const bf16_t* Bt; int lda, ldb, K; };
struct StaticOrder {
    int nM, nN, nwg, G, c;
    __device__ void init(int M, int N, int G_, int c_) { nM = M / BM; nN = N / BM; nwg = nM * nN; G = G_; c = c_; }
    __device__ bool next(int i, Unit& u) const {
        const long L = (long)i * G + c; if (L >= nwg) return false;
        int wgid = (int)L; { const int q = nwg / NXCD, r = nwg % NXCD, xcd = wgid % NXCD, off = wgid / NXCD; wgid = (xcd < r ? xcd * (q + 1) : r * (q + 1) + (xcd - r) * q) + off; }
        const int nig = WGM * nN, gid = wgid / nig, fm = gid * WGM, gsz = (nM - fm) < WGM ? (nM - fm) : WGM;
        u.pm = fm + ((wgid % nig) % gsz); u.pn = (wgid % nig) / gsz; return true;
    }
};
__device__ __forceinline__ unsigned cvt_pk_bf16(float lo, float hi) { unsigned r; asm volatile("v_cvt_pk_bf16_f32 %0, %1, %2" : "=v"(r) : "v"(lo), "v"(hi)); return r; }

template <class Epi, bool ALIGN_EPI>
__device__ __forceinline__ void gemm_phase(LAS unsigned char* lds, const Gemm g, const StaticOrder& S, const Epi& E, const int tid) {
    const int wid = __builtin_amdgcn_readfirstlane(tid >> 6), lane = tid & 63, wr = wid >> 2, wc = wid & 3, fr = lane & 15, fq = lane >> 4;
    const int K = g.K, nt = K / BK;
    unsigned voffA[2], voffB[2];
#pragma unroll
    for (int i = 0; i < 2; ++i) { int R, C; stage_rc(tid * 16 + i * 8192, R, C); const int Rb = (R & ~31) + perm32(R & 31);
        voffA[i] = (unsigned)(R * g.lda + C) * 2u; voffB[i] = (unsigned)(Rb * g.ldb + C) * 2u; }
    const size_t kstep = (size_t)(BK * 2);
    const size_t hstepA = (size_t)HALF * g.lda * 2, hstepB = (size_t)HALF * g.ldb * 2;
    const size_t tstepA = 2 * hstepA, tstepB = 2 * hstepB;
    const unsigned ldsw = (unsigned)wid * 1024u;
    const int aoff = lds_byte(wr * 64 + fr, fq * 8), boff = lds_byte(wc * 32 + fr, fq * 8);
#define PG8_SA(b, h) (((b) * 2 + (h)) * HTB)
#define PG8_SB(b, h) ((4 + (b) * 2 + (h)) * HTB)
#define PG8_STAGE(bufoff, gbase, voff) do { _Pragma("unroll") for (int _i = 0; _i < 2; ++_i) \
        __builtin_amdgcn_global_load_lds((const unsigned*)((const char*)(gbase) + (voff)[_i]), (LAS unsigned*)(lds + (bufoff) + ldsw + _i * 8192), 16, 0, 0); } while (0)
#define PG8_LDA(dst, b, h) do { _Pragma("unroll") for (int m = 0; m < 4; ++m) _Pragma("unroll") for (int k = 0; k < 2; ++k) dst[m][k] = *(const LAS bf16x8*)(lds + PG8_SA(b, h) + aoff + m * 2048 + k * 1024); } while (0)
#define PG8_LDB(dst, b, h) do { _Pragma("unroll") for (int n = 0; n < 2; ++n) _Pragma("unroll") for (int k = 0; k < 2; ++k) dst[n][k] = *(const LAS bf16x8*)(lds + PG8_SB(b, h) + boff + n * 2048 + k * 1024); } while (0)
#define PG8_MMA(ai, bj, At, Bt) do { __builtin_amdgcn_s_setprio(1); _Pragma("unroll") for (int m = 0; m < 4; ++m) _Pragma("unroll") for (int n = 0; n < 2; ++n) _Pragma("unroll") for (int k = 0; k < 2; ++k) \
        acc[ai][bj][m][n] = __builtin_amdgcn_mfma_f32_16x16x32_bf16(Bt[n][k], At[m][k], acc[ai][bj][m][n], 0, 0, 0); __builtin_amdgcn_s_setprio(0); } while (0)
#define PG8_WAIT_V(n) asm volatile("s_waitcnt vmcnt(" #n ")" ::: "memory")
#define PG8_WAIT_L(n) asm volatile("s_waitcnt lgkmcnt(" #n ")" ::: "memory")
#define PG8_BAR __builtin_amdgcn_s_barrier()
#define PG8_SCHED __builtin_amdgcn_sched_barrier(0)
    Unit cur, nxt; int ui = 0;
    if (!S.next(0, cur)) return;
    f32x4 acc[2][2][4][2];
#pragma unroll
    for (int a = 0; a < 2; ++a)
#pragma unroll
        for (int b = 0; b < 2; ++b)
#pragma unroll
            for (int m = 0; m < 4; ++m)
#pragma unroll
                for (int n = 0; n < 2; ++n) acc[a][b][m][n] = (f32x4){0.f, 0.f, 0.f, 0.f};
    bf16x8 At[4][2], B0[2][2], B1[2][2];
    const char* cA = (const char*)g.A + (size_t)cur.pm * tstepA; const char* cB = (const char*)g.Bt + (size_t)cur.pn * tstepB;
    PG8_STAGE(PG8_SB(0, 0), cB, voffB); PG8_STAGE(PG8_SB(0, 1), cB + hstepB, voffB); PG8_STAGE(PG8_SA(0, 0), cA, voffA); PG8_STAGE(PG8_SA(0, 1), cA + hstepA, voffA);
    if (wr == 1) PG8_BAR;
    PG8_WAIT_V(2); PG8_BAR;
    PG8_STAGE(PG8_SB(1, 0), cB + kstep, voffB); PG8_STAGE(PG8_SA(1, 0), cA + kstep, voffA); PG8_STAGE(PG8_SB(1, 1), cB + hstepB + kstep, voffB);
    PG8_WAIT_V(6); PG8_BAR;
    for (;;) {
        const bool has_next = S.next(ui + 1, nxt);
        const char* nA = has_next ? (const char*)g.A + (size_t)nxt.pm * tstepA : cA; const char* nB = has_next ? (const char*)g.Bt + (size_t)nxt.pn * tstepB : cB;
        for (int t = 0; t < nt; t += 2) {
            const bool last = (t == nt - 2);
            const char* a1 = cA + (size_t)(t + 1) * kstep;
            const char* a2 = last ? nA : cA + (size_t)(t + 2) * kstep; const char* b2 = last ? nB : cB + (size_t)(t + 2) * kstep;
            const char* a3 = a2 + kstep; const char* b3 = b2 + kstep;
            PG8_LDB(B0, 0, 0); PG8_LDB(B1, 0, 1); PG8_SCHED; PG8_LDA(At, 0, 0); PG8_STAGE(PG8_SA(1, 1), a1 + hstepA, voffA);
            PG8_WAIT_V(8); PG8_WAIT_L(0); PG8_BAR; PG8_MMA(0, 0, At, B0); PG8_MMA(0, 1, At, B1); PG8_BAR; PG8_SCHED;
            PG8_LDA(At, 0, 1); PG8_STAGE(PG8_SB(0, 0), b2, voffB); PG8_STAGE(PG8_SB(0, 1), b2 + hstepB, voffB); PG8_STAGE(PG8_SA(0, 0), a2, voffA);
            PG8_WAIT_V(8); PG8_WAIT_L(0); PG8_BAR; PG8_MMA(1, 0, At, B0); PG8_MMA(1, 1, At, B1); PG8_BAR; PG8_SCHED;
            PG8_LDB(B0, 1, 0); PG8_LDB(B1, 1, 1); PG8_SCHED; PG8_LDA(At, 1, 0); PG8_STAGE(PG8_SA(0, 1), a2 + hstepA, voffA);
            PG8_WAIT_V(8); PG8_WAIT_L(0); PG8_BAR; PG8_MMA(0, 0, At, B0); PG8_MMA(0, 1, At, B1); PG8_BAR; PG8_SCHED;
            PG8_LDA(At, 1, 1); PG8_STAGE(PG8_SB(1, 0), b3, voffB); PG8_STAGE(PG8_SB(1, 1), b3 + hstepB, voffB); PG8_STAGE(PG8_SA(1, 0), a3, voffA);
            PG8_WAIT_V(8); PG8_WAIT_L(0); PG8_BAR; PG8_MMA(1, 0, At, B0); PG8_MMA(1, 1, At, B1); PG8_BAR; PG8_SCHED;
        }
        if constexpr (ALIGN_EPI) { if (wr == 0) PG8_BAR; }
        E(acc, cur, wr, wc, fr, fq);
        if (!has_next) break;
#pragma unroll
        for (int a = 0; a < 2; ++a)
#pragma unroll
            for (int b = 0; b < 2; ++b)
#pragma unroll
                for (int m = 0; m < 4; ++m)
#pragma unroll
                    for (int n = 0; n < 2; ++n) acc[a][b][m][n] = (f32x4){0.f, 0.f, 0.f, 0.f};
        cur = nxt; cA = nA; cB = nB; ++ui;
        if constexpr (ALIGN_EPI) { if (wr == 1) PG8_BAR; }
    }
    PG8_WAIT_V(0);
    if constexpr (!ALIGN_EPI) { if (wr == 0) PG8_BAR; }
    PG8_BAR;
#undef PG8_SA
#undef PG8_SB
#undef PG8_STAGE
#undef PG8_LDA
#undef PG8_LDB
#undef PG8_MMA
#undef PG8_WAIT_V
#undef PG8_WAIT_L
#undef PG8_BAR
#undef PG8_SCHED
}

typedef f32x4 AccT[2][2][4][2];

struct EpiInProj {
    bf16_t* P; bf16_t* VT; const float* rope; bf16_t* BND;
    __device__ __forceinline__ void operator()(AccT& acc, const Unit& u, int wr, int wc, int fr, int fq) const {
        const int row0 = u.pm * BM + wr * 64 + fr, colb = u.pn * BM + wc * 32 + 8 * fq;
#pragma unroll
        for (int ai = 0; ai < 2; ++ai)
#pragma unroll
            for (int m = 0; m < 4; ++m) {
                const int row = row0 + ai * HALF + m * 16, t = row & (SEQ - 1);
                bf16_t* rowp = P + (size_t)row * LDP + COL_PA;
#pragma unroll
                for (int bj = 0; bj < 2; ++bj) {
                    const int c = colb + bj * HALF;
                    f32x4 v0 = acc[ai][bj][m][0], v1 = acc[ai][bj][m][1];
                    if (u.pn >= 15) {
                        const int cl = c - 3840;
                        if (cl < 640 || (cl >= 768 && cl < 1088)) {
                            const float* cs = rope + ((size_t)t * 32 + ((cl & 63) >> 1)) * 2;
                            const f32x4 r0 = *(const f32x4*)cs, r1 = *(const f32x4*)(cs + 4);
                            f32x4 o0, o1;
                            o0[0] = v0[0] * r0[0] - v0[1] * r0[1]; o0[1] = v0[1] * r0[0] + v0[0] * r0[1];
                            o0[2] = v0[2] * r0[2] - v0[3] * r0[3]; o0[3] = v0[3] * r0[2] + v0[2] * r0[3];
                            o1[0] = v1[0] * r1[0] - v1[1] * r1[1]; o1[1] = v1[1] * r1[0] + v1[0] * r1[1];
                            o1[2] = v1[2] * r1[2] - v1[3] * r1[3]; o1[3] = v1[3] * r1[2] + v1[2] * r1[3];
                            v0 = o0; v1 = o1;
                        }
                    }
                    u32x4 w; w.x = cvt_pk_bf16(v0[0], v0[1]); w.y = cvt_pk_bf16(v0[2], v0[3]); w.z = cvt_pk_bf16(v1[0], v1[1]); w.w = cvt_pk_bf16(v1[2], v1[3]);
                    *(u32x4*)(rowp + c) = w;
                    if (u.pn < 7 && fr == 15) *(u32x4*)(BND + (size_t)(row >> 4) * 1792 + c) = w;
                    if (u.pn == 17 && bj == 1) {
                        const int cv = c - 3840 - 640, b = row >> 11;
                        bf16_t* vt = VT + ((size_t)(b * 2 + (cv >> 6)) * 64 + (cv & 63)) * SEQ + t;
                        vt[0 * SEQ] = (bf16_t)(w.x & 0xffffu); vt[1 * SEQ] = (bf16_t)(w.x >> 16);
                        vt[2 * SEQ] = (bf16_t)(w.y & 0xffffu); vt[3 * SEQ] = (bf16_t)(w.y >> 16);
                        vt[4 * SEQ] = (bf16_t)(w.z & 0xffffu); vt[5 * SEQ] = (bf16_t)(w.z >> 16);
                        vt[6 * SEQ] = (bf16_t)(w.w & 0xffffu); vt[7 * SEQ] = (bf16_t)(w.w >> 16);
                    }
                }
            }
    }
};
struct EpiGate {
    bf16_t* P;
    __device__ __forceinline__ void operator()(AccT& acc, const Unit& u, int wr, int wc, int fr, int fq) const {
        const int row0 = u.pm * BM + wr * 64 + fr, colb = u.pn * BM + wc * 32 + 8 * fq;
#pragma unroll
        for (int ai = 0; ai < 2; ++ai)
#pragma unroll
            for (int m = 0; m < 4; ++m) {
                bf16_t* rowp = P + (size_t)(row0 + ai * HALF + m * 16) * LDP + COL_G + colb;
#pragma unroll
                for (int bj = 0; bj < 2; ++bj) {
                    const f32x4 v0 = acc[ai][bj][m][0], v1 = acc[ai][bj][m][1];
                    u32x4 w; w.x = cvt_pk_bf16(sigmoidf_(v0[0]), sigmoidf_(v0[1])); w.y = cvt_pk_bf16(sigmoidf_(v0[2]), sigmoidf_(v0[3]));
                    w.z = cvt_pk_bf16(sigmoidf_(v1[0]), sigmoidf_(v1[1])); w.w = cvt_pk_bf16(sigmoidf_(v1[2]), sigmoidf_(v1[3]));
                    *(u32x4*)(rowp + bj * HALF) = w;
                }
            }
    }
};
struct EpiMergeAcc {
    bf16_t* P; int first;
    __device__ __forceinline__ void operator()(AccT& acc, const Unit& u, int wr, int wc, int fr, int fq) const {
        const int row0 = u.pm * BM + wr * 64 + fr, colb = u.pn * BM + wc * 32 + 8 * fq;
#pragma unroll
        for (int ai = 0; ai < 2; ++ai)
#pragma unroll
            for (int m = 0; m < 4; ++m) {
                bf16_t* rowb = P + (size_t)(row0 + ai * HALF + m * 16) * LDP + colb;
#pragma unroll
                for (int bj = 0; bj < 2; ++bj) {
                    const f32x4 v0 = acc[ai][bj][m][0], v1 = acc[ai][bj][m][1];
                    unsigned long long* gp = (unsigned long long*)(rowb + COL_G + bj * HALF);
                    unsigned long long* mp = (unsigned long long*)(rowb + COL_MRG + bj * HALF);
                    const unsigned long long g0 = __hip_atomic_load(gp, __ATOMIC_RELAXED, __HIP_MEMORY_SCOPE_AGENT), g1 = __hip_atomic_load(gp + 1, __ATOMIC_RELAXED, __HIP_MEMORY_SCOPE_AGENT);
                    unsigned long long m0 = 0ull, m1 = 0ull;
                    if (!first) { m0 = __hip_atomic_load(mp, __ATOMIC_RELAXED, __HIP_MEMORY_SCOPE_AGENT); m1 = __hip_atomic_load(mp + 1, __ATOMIC_RELAXED, __HIP_MEMORY_SCOPE_AGENT); }
                    const unsigned ga = (unsigned)g0, gb = (unsigned)(g0 >> 32), gc = (unsigned)g1, gd = (unsigned)(g1 >> 32);
                    const unsigned ma = (unsigned)m0, mb = (unsigned)(m0 >> 32), mc = (unsigned)m1, md = (unsigned)(m1 >> 32);
                    u32x4 w;
                    w.x = cvt_pk_bf16(bflo(ma) + bflo(ga) * v0[0], bfhi(ma) + bfhi(ga) * v0[1]);
                    w.y = cvt_pk_bf16(bflo(mb) + bflo(gb) * v0[2], bfhi(mb) + bfhi(gb) * v0[3]);
                    w.z = cvt_pk_bf16(bflo(mc) + bflo(gc) * v1[0], bfhi(mc) + bfhi(gc) * v1[1]);
                    w.w = cvt_pk_bf16(bflo(md) + bflo(gd) * v1[2], bfhi(md) + bfhi(gd) * v1[3]);
                    *(u32x4*)(rowb + COL_MRG + bj * HALF) = w;
                }
            }
    }
};
struct EpiResid {
    const float* base; float* out;
    __device__ __forceinline__ void operator()(AccT& acc, const Unit& u, int wr, int wc, int fr, int fq) const {
        const int row0 = u.pm * BM + wr * 64 + fr, colb = u.pn * BM + wc * 32 + 8 * fq;
#pragma unroll
        for (int ai = 0; ai < 2; ++ai)
#pragma unroll
            for (int m = 0; m < 4; ++m) {
                const size_t off = (size_t)(row0 + ai * HALF + m * 16) * DM + colb;
#pragma unroll
                for (int bj = 0; bj < 2; ++bj) {
                    const f32x4 b0 = *(const f32x4*)(base + off + bj * HALF), b1 = *(const f32x4*)(base + off + bj * HALF + 4);
                    *(f32x4*)(out + off + bj * HALF) = b0 + acc[ai][bj][m][0];
                    *(f32x4*)(out + off + bj * HALF + 4) = b1 + acc[ai][bj][m][1];
                }
            }
    }
};
struct EpiUp {
    bf16_t* P; float* HALO; const float* cw; const float* cb; LAS float* CW;
    __device__ __forceinline__ void operator()(AccT& acc, const Unit& u, int wr, int wc, int fr_in, int fq_in) const {
        int fr = fr_in, fq = fq_in;
        asm volatile("" : "+v"(fr), "+v"(fq));
        const int row0 = u.pm * BM + wr * 64 + fr;
        const int jb = u.pn * 128 + wc * 32 + 8 * fq;
        {
            const int tl = (wr * 4 + wc) * 64 + fq * 16 + fr;
#pragma unroll
            for (int it = 0; it < 2; ++it) { const int k = tl + 512 * it, p = k >> 8, col = k & 255, co = (col >> 7) * DFF + u.pn * 128 + (col & 127);
                CW[k] = (p < 3) ? cw[p * F2 + co] : cb[co]; }
            asm volatile("s_waitcnt lgkmcnt(0)" ::: "memory"); __builtin_amdgcn_s_barrier(); asm volatile("" ::: "memory");
        }
#pragma unroll
        for (int ai = 0; ai < 2; ++ai) {
            const int s = u.pm * 4 + ai * 2 + wr;
#pragma unroll
            for (int bj = 0; bj < 2; ++bj)
#pragma unroll
                for (int n = 0; n < 2; ++n) {
                    const int colp = u.pn * BM + bj * HALF + wc * 32 + 8 * fq + 4 * n;
                    if (fr < 2) *(f32x4*)(HALO + (size_t)(s * 4 + fr) * F2 + colp) = acc[ai][bj][0][n];
                    if (fr >= 14) *(f32x4*)(HALO + (size_t)(s * 4 + fr - 12) * F2 + colp) = acc[ai][bj][3][n];
                }
        }
#pragma unroll
        for (int ai = 0; ai < 2; ++ai)
#pragma unroll
            for (int m = 0; m < 4; ++m) {
                const int row = row0 + ai * HALF + m * 16;
#pragma unroll
                for (int n = 0; n < 2; ++n) {
                    f32x4 cv[2];
#pragma unroll
                    for (int bj = 0; bj < 2; ++bj) {
                        const int cl = bj * 128 + wc * 32 + 8 * fq + 4 * n;
                        const f32x4 w0 = *(const LAS f32x4*)&CW[cl], w1 = *(const LAS f32x4*)&CW[256 + cl], w2 = *(const LAS f32x4*)&CW[512 + cl], bb = *(const LAS f32x4*)&CW[768 + cl];
#pragma unroll
                        for (int e = 0; e < 4; ++e) {
                            const float cur = acc[ai][bj][m][n][e];
                            const float prv = m > 0 ? acc[ai][bj][m > 0 ? m - 1 : 0][n][e] : 0.f;
                            const float a1 = dpp_mov<0x121>(cur), a2 = dpp_mov<0x122>(cur), b1 = dpp_mov<0x121>(prv), b2 = dpp_mov<0x122>(prv);
                            const float p1 = fr >= 1 ? a1 : b1, p2 = fr >= 2 ? a2 : b2;
                            cv[bj][e] = bb[e] + w0[e] * p2 + w1[e] * p1 + w2[e] * cur;
                        }
                        __builtin_amdgcn_sched_barrier(0);
                    }
                    const f32x4 g0 = cv[0], v0 = cv[1];
                    u32x2 w;
                    w.x = cvt_pk_bf16(g0[0] * sigmoidf_(g0[0]) * v0[0], g0[1] * sigmoidf_(g0[1]) * v0[1]);
                    w.y = cvt_pk_bf16(g0[2] * sigmoidf_(g0[2]) * v0[2], g0[3] * sigmoidf_(g0[3]) * v0[3]);
                    if (!(m == 0 && fr < 2)) *(u32x2*)(P + (size_t)row * LDP + COL_ACT + jb + 4 * n) = w;
                    __builtin_amdgcn_sched_barrier(0);
                }
            }
    }
};
}

struct Ctx {
    const float* in[24]; float* out; unsigned char* ws;
    bf16_t* P; bf16_t* VT; float* HALO; float* ROPE;
    bf16_t *Win, *Wg, *Wbr, *Wo, *Wup, *Wdn;
    int tid, lane, wave, G, bid;
};

__device__ __forceinline__ int srccol(int mode, int n) {
    if (mode == 0) return n;
    if (mode == 2) return 4932 + n;
    if (mode == 3) { const int tile = n >> 8, w = n & 255, j = tile * 128 + (w & 127); return (w < 128) ? j : DFF + j; }
    if (n < 3840) return n;
    const int c = n - 3840;
    if (c >= 1092) return -1;
    if (c < 640 || (c >= 768 && c < 1088)) { const int base = c & ~63, i = c & 63; return 3840 + base + (i >> 1) + 32 * (i & 1); }
    return 3840 + c;
}
__device__ __forceinline__ void tr_item(const float* W, int ldw, int K, int N, bf16_t* WT, int mode, int item, LAS float* scr, int lane) {
    const int nblk = N / 32, kb = item / nblk, nb = item % nblk, k0 = 64 * kb, n0 = 32 * nb;
    const int sc = srccol(mode, n0 + (lane & 31));
    float wv_[32];
#pragma unroll
    for (int i = 0; i < 32; ++i) { const int kk = 2 * i + (lane >> 5); wv_[i] = (sc >= 0) ? W[(size_t)(k0 + kk) * ldw + sc] : 0.f; }
#pragma unroll
    for (int i = 0; i < 32; ++i) { const int kk = 2 * i + (lane >> 5); scr[kk * 33 + (lane & 31)] = wv_[i]; }
    asm volatile("s_waitcnt lgkmcnt(0)" ::: "memory");
    const int c = lane & 7;
#pragma unroll
    for (int j = 0; j < 4; ++j) { const int n = (lane >> 3) + 8 * j; const LAS float* s = scr + (8 * c) * 33 + n;
        u32x4 o; o.x = pk2(s[0 * 33], s[1 * 33]); o.y = pk2(s[2 * 33], s[3 * 33]); o.z = pk2(s[4 * 33], s[5 * 33]); o.w = pk2(s[6 * 33], s[7 * 33]);
        *(u32x4*)(WT + (size_t)(n0 + n) * K + k0 + 8 * c) = o; }
    asm volatile("s_waitcnt lgkmcnt(0)" ::: "memory");
}
__device__ __forceinline__ void rms_row(const float* xrow, const float* g, bf16_t* obf, float* of32, int lane) {
    const f32x4* xr = (const f32x4*)xrow + lane; const f32x4* gr = (const f32x4*)g + lane;
    f32x4 v[4]; float s = 0.f;
#pragma unroll
    for (int j = 0; j < 4; ++j) { v[j] = xr[64 * j]; s += (v[j].x * v[j].x + v[j].y * v[j].y) + (v[j].z * v[j].z + v[j].w * v[j].w); }
    const float rs = 1.f / sqrtf(wave_sum(s) * (1.f / DM) + 1e-6f);
#pragma unroll
    for (int j = 0; j < 4; ++j) {
        const f32x4 gg = gr[64 * j]; const f32x4 o = v[j] * rs * gg;
        if (obf) { u32x2 w; w.x = pk2(o.x, o.y); w.y = pk2(o.z, o.w); *((u32x2*)obf + lane + 64 * j) = w; }
        else *((f32x4*)of32 + lane + 64 * j) = o;
    }
}
__device__ __forceinline__ void rms_pass(const Ctx& X, const float* src, const float* g, bf16_t* obf, float* of32) {
    const int gw = X.bid * 8 + X.wave, NGW = X.G * 8, lane = X.lane;
    const f32x4* gr = (const f32x4*)g + lane;
    f32x4 gg[4];
#pragma unroll
    for (int j = 0; j < 4; ++j) gg[j] = gr[64 * j];
#pragma unroll 1
    for (int m = gw; m < T_TOK; m += 4 * NGW) {
        f32x4 v[4][4]; float ss[4]; int mr[4];
#pragma unroll
        for (int r = 0; r < 4; ++r) { mr[r] = m + r * NGW; const int ml = mr[r] < T_TOK ? mr[r] : m; const f32x4* x = (const f32x4*)(src + (size_t)ml * DM) + lane;
#pragma unroll
            for (int j = 0; j < 4; ++j) v[r][j] = x[64 * j]; }
#pragma unroll
        for (int r = 0; r < 4; ++r) { float a = 0.f;
#pragma unroll
            for (int j = 0; j < 4; ++j) a += (v[r][j].x * v[r][j].x + v[r][j].y * v[r][j].y) + (v[r][j].z * v[r][j].z + v[r][j].w * v[r][j].w);
            ss[r] = 1.f / sqrtf(wave_sum(a) * (1.f / DM) + 1e-6f); }
#pragma unroll
        for (int r = 0; r < 4; ++r) {
            if (mr[r] < T_TOK) {
#pragma unroll
                for (int j = 0; j < 4; ++j) {
                    const f32x4 o = v[r][j] * ss[r] * gg[j];
                    if (obf) { u32x2 w; w.x = pk2(o.x, o.y); w.y = pk2(o.z, o.w); *((u32x2*)(obf + (size_t)mr[r] * LDP) + lane + 64 * j) = w; }
                    else *((f32x4*)(of32 + (size_t)mr[r] * DM) + lane + 64 * j) = o;
                }
            }
        }
    }
}
__device__ __forceinline__ void phase_prep(const Ctx& X, LAS unsigned char* lds, int layer) {
    LAS float* scr = (LAS float*)(lds + X.wave * 8448);
    const int gw = X.bid * 8 + X.wave, NGW = X.G * 8;
    constexpr int I_IN = 16 * 160, I_G = 16 * 96, I_BR = 8 * 32, I_O = 16 * 32, I_UP = 16 * 176, I_DN = 44 * 32;
    constexpr int NITEMS = I_IN + I_G + 3 * I_BR + I_O + I_UP + I_DN;
    const float* w_in = X.in[2] + (size_t)layer * DM * IN_COLS;
    const float* w_br = X.in[16] + (size_t)layer * 3 * 512 * DM;
    const float* w_o = X.in[17] + (size_t)layer * DM * DM;
    const float* w_up = X.in[19] + (size_t)layer * DM * F2;
    const float* w_dn = X.in[22] + (size_t)layer * DFF * DM;
    for (int it = gw; it < NITEMS; it += NGW) {
        int r = it;
        if (r < I_IN) { tr_item(w_in, IN_COLS, DM, 5120, X.Win, 1, r, scr, X.lane); continue; } r -= I_IN;
        if (r < I_G) { tr_item(w_in, IN_COLS, DM, 3072, X.Wg, 2, r, scr, X.lane); continue; } r -= I_G;
        if (r < 3 * I_BR) { const int b = r / I_BR; tr_item(w_br + (size_t)b * 512 * DM, DM, 512, DM, X.Wbr + (size_t)b * DM * 512, 0, r % I_BR, scr, X.lane); continue; } r -= 3 * I_BR;
        if (r < I_O) { tr_item(w_o, DM, DM, DM, X.Wo, 0, r, scr, X.lane); continue; } r -= I_O;
        if (r < I_UP) { tr_item(w_up, F2, DM, F2, X.Wup, 3, r, scr, X.lane); continue; } r -= I_UP;
        tr_item(w_dn, DM, DFF, DM, X.Wdn, 0, r, scr, X.lane);
    }
    const float* h = (layer == 0) ? X.in[0] : X.out;
    const float* g = X.in[1] + (size_t)layer * DM;
    rms_pass(X, h, g, X.P, nullptr);
    if (layer == 0) {
        for (int idx = X.bid * 512 + X.tid; idx < SEQ * 32; idx += X.G * 512) {
            const int t = idx >> 5, p = idx & 31;
            const float inv = exp2f(-(float)p * 0.03125f * 13.287712379549449f);
            const float ang = (float)t * inv;
            const double rev = (double)ang * 0.15915494309189535;
            const float fr = (float)(rev - floor(rev));
            X.ROPE[2 * idx] = __builtin_amdgcn_cosf(fr); X.ROPE[2 * idx + 1] = __builtin_amdgcn_sinf(fr);
        }
    }
}

__device__ __forceinline__ float wave_sum_fast(float x) {
    x = red16(x);
    const float r0 = __builtin_bit_cast(float, __builtin_amdgcn_readlane(__builtin_bit_cast(int, x), 0)), r1 = __builtin_bit_cast(float, __builtin_amdgcn_readlane(__builtin_bit_cast(int, x), 16));
    const float r2 = __builtin_bit_cast(float, __builtin_amdgcn_readlane(__builtin_bit_cast(int, x), 32)), r3 = __builtin_bit_cast(float, __builtin_amdgcn_readlane(__builtin_bit_cast(int, x), 48));
    return (r0 + r1) + (r2 + r3);
}
#define LDS_BAR() do { asm volatile("s_waitcnt lgkmcnt(0)" ::: "memory"); __builtin_amdgcn_s_barrier(); asm volatile("" ::: "memory"); } while (0)
constexpr int RW_TS = 16, RW_NCH = SEQ / RW_TS, RW_BUF = 33280;
__device__ __forceinline__ void phase_rwkv_pre(const Ctx& X, LAS unsigned char* lds, int layer) {
    LAS float* Rr = (LAS float*)(lds);           LAS float* Kk = (LAS float*)(lds + 8192);   LAS float* Vv = (LAS float*)(lds + 16384);
    LAS float* W1 = (LAS float*)(lds + 24576);   LAS float* AS = (LAS float*)(lds + 32768);
    LAS bf16_t* WDb = (LAS bf16_t*)(lds + 40960);
    LAS bf16_t* ADb = (LAS bf16_t*)(lds + 45568);
    LAS bf16_t* WTu = (LAS bf16_t*)(lds + 50176);
    LAS bf16_t* WTa = (LAS bf16_t*)(lds + 59392);
    LAS float* MU = (LAS float*)(lds + 68608);
    const int tid = X.tid, lane = tid & 63, wv = X.wave;
    const float* mu = X.in[3] + layer * 1792;
    const float* w0 = X.in[4] + layer * 512;   const float* w_up = X.in[5] + (size_t)layer * 64 * 512;
    const float* a0 = X.in[6] + layer * 512;   const float* a_up = X.in[7] + (size_t)layer * 64 * 512;
    const float* k_k = X.in[9] + layer * 512;  const float* k_a = X.in[10] + layer * 512;  const float* r_k = X.in[11] + layer * 512;
    const bf16_t* BND = (const bf16_t*)(X.ws + WS_BND);
    float* SCAL = (float*)(X.ws + WS_SCAL);
    const int ln = lane & 15, lg = lane >> 4;
    int last_h = -1;
    float p_kk = 0.f, p_ka = 0.f, p_rk = 0.f, q_w0 = 0.f, q_a0 = 0.f;
    const int c = tid & 63, tg = tid >> 6;
    u32x4 pc4[3], pp4[3]; bool have_pf = false;
    pc4[0] = pc4[1] = pc4[2] = pp4[0] = pp4[1] = pp4[2] = (u32x4){0u, 0u, 0u, 0u};
#define PRE_LOAD(uu) do { const int h_ = (uu) & 7, tp_ = (uu) >> 3; _Pragma("unroll") for (int it = 0; it < 3; ++it) { const int idx = tid + 512 * it; pc4[it] = (u32x4){0u, 0u, 0u, 0u}; pp4[it] = (u32x4){0u, 0u, 0u, 0u}; \
        if (idx < 32 * 40) { const int tt = idx / 40, vv = idx - tt * 40; \
            const int col = vv < 8 ? h_ * 64 + 8 * vv : (vv < 16 ? 512 + h_ * 64 + 8 * (vv - 8) : (vv < 24 ? 1024 + h_ * 64 + 8 * (vv - 16) : 1536 + 8 * (vv - 24))); \
            const size_t row = (size_t)tp_ * 32 + tt; pc4[it] = *(const u32x4*)(X.P + row * LDP + COL_PA + col); \
            if (tt > 0) pp4[it] = *(const u32x4*)(X.P + (row - 1) * LDP + COL_PA + col); else if ((tp_ & 63) != 0) pp4[it] = *(const u32x4*)(BND + (size_t)(2 * tp_ - 1) * 1792 + col); } } } while (0)
#pragma unroll 1
    for (int u = X.bid; u < 4096; u += X.G) {
        const int h = u & 7, tp = u >> 3, hc = h * 64 + c;
        if (h != last_h) {
            __syncthreads();
            for (int idx = tid; idx < 64 * 64; idx += 512) { const int m = idx >> 6, cc = idx & 63;
                WTu[cc * 72 + m] = (bf16_t)f2bf(w_up[m * 512 + h * 64 + cc]); WTa[cc * 72 + m] = (bf16_t)f2bf(a_up[m * 512 + h * 64 + cc]); }
            if (tid < 320) { const int cc = tid; const int col = cc < 64 ? h * 64 + cc : (cc < 128 ? 512 + h * 64 + cc - 64 : (cc < 192 ? 1024 + h * 64 + cc - 128 : 1536 + cc - 192)); MU[cc] = mu[col]; }
            p_kk = k_k[hc]; p_ka = k_a[hc]; p_rk = r_k[hc];
            q_w0 = w0[h * 64 + 16 * (wv >> 1) + ln]; q_a0 = a0[h * 64 + 16 * (wv >> 1) + ln];
            last_h = h;
            __syncthreads();
        }
        if (!have_pf) { PRE_LOAD(u); }
#pragma unroll
        for (int it = 0; it < 3; ++it) {
            const int idx = tid + 512 * it;
            if (idx < 32 * 40) {
                const int tt = idx / 40, vv = idx - tt * 40, cc0 = 8 * vv;
                const u32x4 c4 = pc4[it], p4 = pp4[it];
                const f32x4 m0 = *(const LAS f32x4*)&MU[cc0], m1 = *(const LAS f32x4*)&MU[cc0 + 4];
                float cur[8], prv[8], val[8];
                cur[0] = bflo(c4.x); cur[1] = bfhi(c4.x); cur[2] = bflo(c4.y); cur[3] = bfhi(c4.y); cur[4] = bflo(c4.z); cur[5] = bfhi(c4.z); cur[6] = bflo(c4.w); cur[7] = bfhi(c4.w);
                prv[0] = bflo(p4.x); prv[1] = bfhi(p4.x); prv[2] = bflo(p4.y); prv[3] = bfhi(p4.y); prv[4] = bflo(p4.z); prv[5] = bfhi(p4.z); prv[6] = bflo(p4.w); prv[7] = bfhi(p4.w);
#pragma unroll
                for (int e = 0; e < 8; ++e) val[e] = cur[e] + (prv[e] - cur[e]) * (e < 4 ? m0[e & 3] : m1[e & 3]);
                if (vv < 24) {
#pragma unroll
                    for (int e = 0; e < 8; ++e) val[e] = bf2f((bf16_t)f2bf(val[e]));
                    LAS float* dst = (vv < 8 ? Rr : (vv < 16 ? Kk : Vv)) + tt * 64 + 8 * (vv & 7);
                    *(LAS f32x4*)dst = (f32x4){val[0], val[1], val[2], val[3]}; *(LAS f32x4*)(dst + 4) = (f32x4){val[4], val[5], val[6], val[7]};
                } else {
                    const int lr0 = 8 * (vv - 24);
                    LAS bf16_t* dst;
                    if (lr0 < 64) { dst = WDb + tt * 72 + lr0;
#pragma unroll
                        for (int e = 0; e < 8; ++e) { const float ex = __expf(2.f * val[e]); val[e] = 1.f - 2.f / (ex + 1.f); } }
                    else dst = ADb + tt * 72 + lr0 - 64;
                    u32x4 o; o.x = pk2(val[0], val[1]); o.y = pk2(val[2], val[3]); o.z = pk2(val[4], val[5]); o.w = pk2(val[6], val[7]);
                    *(LAS u32x4*)dst = o;
                }
            }
        }
        have_pf = false;
        if (u + X.G < 4096 && ((u + X.G) & 7) == h) { PRE_LOAD(u + X.G); have_pf = true; }
        LDS_BAR();
        {
            const int mt = wv & 1, nt = wv >> 1, chm = 16 * nt + ln;
            f32x4 cw_ = (f32x4){0.f, 0.f, 0.f, 0.f}, ca_ = cw_;
#pragma unroll
            for (int ks = 0; ks < 2; ++ks) {
                const bf16x8 xa = *(const LAS bf16x8*)&WDb[(16 * mt + ln) * 72 + ks * 32 + 8 * lg], xb = *(const LAS bf16x8*)&WTu[(16 * nt + ln) * 72 + ks * 32 + 8 * lg];
                cw_ = __builtin_amdgcn_mfma_f32_16x16x32_bf16(xa, xb, cw_, 0, 0, 0);
                const bf16x8 ya = *(const LAS bf16x8*)&ADb[(16 * mt + ln) * 72 + ks * 32 + 8 * lg], yb = *(const LAS bf16x8*)&WTa[(16 * nt + ln) * 72 + ks * 32 + 8 * lg];
                ca_ = __builtin_amdgcn_mfma_f32_16x16x32_bf16(ya, yb, ca_, 0, 0, 0);
            }
#pragma unroll
            for (int r = 0; r < 4; ++r) {
                const int tt = 16 * mt + 4 * lg + r;
                const float z = -(q_w0 + cw_[r]);
                const float sp = fmaxf(z, 0.f) + __logf(1.f + __expf(-fabsf(z)));
                const float e = __expf(-sp - 0.5f);
                W1[tt * 64 + chm] = bf2f((bf16_t)f2bf(-expm1f(-e)));
                AS[tt * 64 + chm] = bf2f((bf16_t)f2bf(sigmoidf_(q_a0 + ca_[r])));
            }
        }
        LDS_BAR();
#pragma unroll
        for (int q = 0; q < 4; ++q) {
            const int tt = 4 * tg + q;
            const size_t row = (size_t)tp * 32 + tt;
            const float w1 = W1[tt * 64 + c], a = AS[tt * 64 + c];
            const float kraw = Kk[tt * 64 + c], r = Rr[tt * 64 + c], v = Vv[tt * 64 + c];
            const float kk0 = kraw * p_kk;
            const float inv = 1.f / sqrtf(fmaxf(wave_sum_fast(kk0 * kk0), 1e-24f));
            const float kk = kk0 * inv;
            const float kmod = kraw * (1.f + (a - 1.f) * p_ka);
            const float bvec = kk * a;
            const float br = wave_sum_fast(bvec * r), kr = wave_sum_fast(kmod * r), bonus = wave_sum_fast(r * kmod * p_rk);
            bf16_t* rp_ = X.P + row * LDP;
            rp_[COL_PA + hc] = (bf16_t)f2bf(r); rp_[COL_PA + 512 + hc] = (bf16_t)f2bf(kraw); rp_[COL_PA + 1024 + hc] = (bf16_t)f2bf(v);
            rp_[hc] = (bf16_t)f2bf(w1); rp_[512 + hc] = (bf16_t)f2bf(a);
            if (c == 0) *(f32x4*)(SCAL + (row * 8 + h) * 4) = (f32x4){inv, br, kr, bonus};
        }
        LDS_BAR();
    }
}

__device__ __forceinline__ void rwkv_task(const Ctx& X, LAS unsigned char* lds, int layer, int b, int h) {
    LAS bf16_t* GDb = (LAS bf16_t*)(lds + 66560);
    LAS bf16_t* WTg = (LAS bf16_t*)(lds + 70912);
    LAS float* BON = (LAS float*)(lds + 88320);
    const int tid = X.tid, lane = tid & 63;
    const bool helper = X.wave >= 4;
    const int ht = tid & 255;
    const float* mu = X.in[3] + layer * 1792;
    const float* g_up = X.in[8] + (size_t)layer * 128 * 512;
    const float* k_k = X.in[9] + layer * 512;  const float* k_a = X.in[10] + layer * 512;
    const float* gn_g = X.in[12] + layer * 512; const float* gn_b = X.in[13] + layer * 512;
    const float* SCAL = (const float*)(X.ws + WS_SCAL);
    const int tt_h = ht >> 4, cg4 = (ht & 15) * 4;
    const f32x4 p_kk = *(const f32x4*)(k_k + h * 64 + cg4), p_ka = *(const f32x4*)(k_a + h * 64 + cg4);
    const f32x4 p_gg = *(const f32x4*)(gn_g + h * 64 + cg4), p_gb = *(const f32x4*)(gn_b + h * 64 + cg4);
    const int gv8 = (ht & 15) * 8;
    const f32x4 mg0 = *(const f32x4*)(mu + 1664 + gv8), mg1 = *(const f32x4*)(mu + 1664 + gv8 + 4);
    const int nt = (ht >> 6), ln = lane & 15, lg = lane >> 4, chm = 16 * nt + ln;
    const int rp = ht >> 3, jg = ht & 7, i0 = 2 * rp;
    for (int idx = tid; idx < 128 * 64; idx += 512) { const int m = idx >> 6, cc = idx & 63; WTg[cc * 136 + m] = (bf16_t)f2bf(g_up[m * 512 + h * 64 + cc]); }
    f32x2 S0[4], S1[4];
#pragma unroll
    for (int j = 0; j < 4; ++j) { S0[j] = (f32x2){0.f, 0.f}; S1[j] = (f32x2){0.f, 0.f}; }
#if PROBE_SCAN2
    f32x2 T0[4], T1[4];
#pragma unroll
    for (int j = 0; j < 4; ++j) { T0[j] = (f32x2){0.f, 0.f}; T1[j] = (f32x2){0.f, 0.f}; }
#endif
    __syncthreads();

#define RW_ARR(bufi, k) ((LAS float*)(lds + (bufi) * RW_BUF + (k) * 4096))
#define RW_SC(bufi) ((LAS float*)(lds + (bufi) * RW_BUF + 32768))
#define RW_LOAD(chk, L) do { const size_t row_ = (size_t)b * SEQ + (chk) * RW_TS + tt_h; const bf16_t* rp_ = X.P + row_ * LDP; \
        l_r##L = *(const u32x2*)(rp_ + COL_PA + h * 64 + cg4); l_k##L = *(const u32x2*)(rp_ + COL_PA + 512 + h * 64 + cg4); l_v##L = *(const u32x2*)(rp_ + COL_PA + 1024 + h * 64 + cg4); \
        l_w##L = *(const u32x2*)(rp_ + h * 64 + cg4); l_a##L = *(const u32x2*)(rp_ + 512 + h * 64 + cg4); l_s##L = *(const f32x4*)(SCAL + (row_ * 8 + h) * 4); \
        l_gc##L = *(const u32x4*)(rp_ + COL_PA + 1664 + gv8); l_gp##L = (u32x4){0u, 0u, 0u, 0u}; if ((chk) * RW_TS + tt_h > 0) l_gp##L = *(const u32x4*)(rp_ - LDP + COL_PA + 1664 + gv8); } while (0)
    u32x2 l_rA, l_kA, l_vA, l_wA, l_aA; f32x4 l_sA; u32x4 l_gcA, l_gpA;
    u32x2 l_rB, l_kB, l_vB, l_wB, l_aB; f32x4 l_sB; u32x4 l_gcB, l_gpB;
    l_rA = l_kA = l_vA = l_wA = l_aA = l_rB = l_kB = l_vB = l_wB = l_aB = (u32x2){0u, 0u}; l_sA = l_sB = (f32x4){0.f, 0.f, 0.f, 0.f}; l_gcA = l_gpA = l_gcB = l_gpB = (u32x4){0u, 0u, 0u, 0u};
    if (helper) { RW_LOAD(0, A); RW_LOAD(1, B); }

#pragma unroll 1
    for (int i0_ = -1; i0_ < RW_NCH; i0_ += 2) {
        { const int i = i0_;

        const int bufn = (i + 1) & 1, bufc = i & 1;
        if (helper) {
            const bool do_prep = (i + 1 < RW_NCH);
            if (i >= 1) {
                LAS float* Yy = RW_ARR(bufn, 7); LAS float* Gg = RW_ARR(bufn, 6); LAS float* Vv = RW_ARR(bufn, 5); LAS float* SC = RW_SC(bufn);
                const f32x4 y = *(const LAS f32x4*)&Yy[tt_h * 64 + cg4], gg = *(const LAS f32x4*)&Gg[tt_h * 64 + cg4], vv = *(const LAS f32x4*)&Vv[tt_h * 64 + cg4];
                const float bonus = BON[((i - 1) % 3) * 16 + tt_h];
                const float mean = red16((y.x + y.y) + (y.z + y.w)) * (1.f / 64.f);
                const f32x4 d = y - mean;
                const float var = red16((d.x * d.x + d.y * d.y) + (d.z * d.z + d.w * d.w)) * (1.f / 64.f);
                const float rs = 1.f / sqrtf(var + 64e-5f);
                const f32x4 o = (d * rs * p_gg + p_gb + vv * bonus) * gg;
                u32x2 w; w.x = pk2(o.x, o.y); w.y = pk2(o.z, o.w);
                *(u32x2*)(X.P + ((size_t)b * SEQ + (i - 1) * RW_TS + tt_h) * LDP + COL_YA + h * 64 + cg4) = w;
            }
            if (do_prep) {
                const f32x4 r = (f32x4){bflo(l_rA.x), bfhi(l_rA.x), bflo(l_rA.y), bfhi(l_rA.y)}, k = (f32x4){bflo(l_kA.x), bfhi(l_kA.x), bflo(l_kA.y), bfhi(l_kA.y)};
                const f32x4 v = (f32x4){bflo(l_vA.x), bfhi(l_vA.x), bflo(l_vA.y), bfhi(l_vA.y)}, w1 = (f32x4){bflo(l_wA.x), bfhi(l_wA.x), bflo(l_wA.y), bfhi(l_wA.y)};
                const f32x4 a = (f32x4){bflo(l_aA.x), bfhi(l_aA.x), bflo(l_aA.y), bfhi(l_aA.y)};
                const f32x4 kk = k * p_kk * l_sA.x;
                const f32x4 decay = 1.f - w1;
                *(LAS f32x4*)&RW_ARR(bufn, 0)[tt_h * 64 + cg4] = -kk;
                *(LAS f32x4*)&RW_ARR(bufn, 1)[tt_h * 64 + cg4] = decay * r;
                *(LAS f32x4*)&RW_ARR(bufn, 2)[tt_h * 64 + cg4] = decay;
                *(LAS f32x4*)&RW_ARR(bufn, 3)[tt_h * 64 + cg4] = kk * a;
                *(LAS f32x4*)&RW_ARR(bufn, 4)[tt_h * 64 + cg4] = k * (1.f + (a - 1.f) * p_ka);
                *(LAS f32x4*)&RW_ARR(bufn, 5)[tt_h * 64 + cg4] = v;
                if (cg4 == 0) { LAS float* SC = RW_SC(bufn); SC[tt_h * 4 + 0] = l_sA.y; SC[tt_h * 4 + 1] = l_sA.z; BON[((i + 1) % 3) * 16 + tt_h] = l_sA.w; }
                float gc[8], gp[8];
                gc[0] = bflo(l_gcA.x); gc[1] = bfhi(l_gcA.x); gc[2] = bflo(l_gcA.y); gc[3] = bfhi(l_gcA.y); gc[4] = bflo(l_gcA.z); gc[5] = bfhi(l_gcA.z); gc[6] = bflo(l_gcA.w); gc[7] = bfhi(l_gcA.w);
                gp[0] = bflo(l_gpA.x); gp[1] = bfhi(l_gpA.x); gp[2] = bflo(l_gpA.y); gp[3] = bfhi(l_gpA.y); gp[4] = bflo(l_gpA.z); gp[5] = bfhi(l_gpA.z); gp[6] = bflo(l_gpA.w); gp[7] = bfhi(l_gpA.w);
#pragma unroll
                for (int e = 0; e < 8; ++e) gc[e] = sigmoidf_(gc[e] + (gp[e] - gc[e]) * (e < 4 ? mg0[e & 3] : mg1[e & 3]));
                u32x4 o; o.x = pk2(gc[0], gc[1]); o.y = pk2(gc[2], gc[3]); o.z = pk2(gc[4], gc[5]); o.w = pk2(gc[6], gc[7]);
                *(LAS u32x4*)&GDb[tt_h * 136 + gv8] = o;
            }
            if (i + 3 < RW_NCH) RW_LOAD(i + 3, A);
            LDS_BAR();
            if (do_prep) {
                LAS float* Gg = RW_ARR(bufn, 6);
                f32x4 cg_ = (f32x4){0.f, 0.f, 0.f, 0.f};
#pragma unroll
                for (int ks = 0; ks < 4; ++ks) {
                    const bf16x8 za = *(const LAS bf16x8*)&GDb[ln * 136 + ks * 32 + 8 * lg], zb = *(const LAS bf16x8*)&WTg[(16 * nt + ln) * 136 + ks * 32 + 8 * lg];
                    cg_ = __builtin_amdgcn_mfma_f32_16x16x32_bf16(za, zb, cg_, 0, 0, 0);
                }
#pragma unroll
                for (int r = 0; r < 4; ++r) Gg[(4 * lg + r) * 64 + chm] = cg_[r];
            }
            LDS_BAR();
        } else {
            LAS float* A_ = RW_ARR(bufc, 0); LAS float* WR = RW_ARR(bufc, 1); LAS float* Wd = RW_ARR(bufc, 2); LAS float* Bv = RW_ARR(bufc, 3);
            LAS float* Kk = RW_ARR(bufc, 4); LAS float* Vv = RW_ARR(bufc, 5); LAS float* Yy = RW_ARR(bufc, 7); LAS float* SC = RW_SC(bufc);
#pragma unroll 1
            for (int q4 = 0; q4 < 4; ++q4) {
                if (i >= 0) {
                    f32x2 yk[4];
#pragma unroll
                    for (int s4 = 0; s4 < 4; ++s4) {
                        const int tt = 4 * q4 + s4;
                        const f32x4 a_lo = *(const LAS f32x4*)&A_[tt * 64 + 8 * jg], a_hi = *(const LAS f32x4*)&A_[tt * 64 + 8 * jg + 4];
                        const f32x4 r_lo = *(const LAS f32x4*)&WR[tt * 64 + 8 * jg], r_hi = *(const LAS f32x4*)&WR[tt * 64 + 8 * jg + 4];
                        const f32x4 w_lo = *(const LAS f32x4*)&Wd[tt * 64 + 8 * jg], w_hi = *(const LAS f32x4*)&Wd[tt * 64 + 8 * jg + 4];
                        const f32x4 b_lo = *(const LAS f32x4*)&Bv[tt * 64 + 8 * jg], b_hi = *(const LAS f32x4*)&Bv[tt * 64 + 8 * jg + 4];
                        const f32x4 k_lo = *(const LAS f32x4*)&Kk[tt * 64 + 8 * jg], k_hi = *(const LAS f32x4*)&Kk[tt * 64 + 8 * jg + 4];
                        const f32x2 vv = *(const LAS f32x2*)&Vv[tt * 64 + i0];
                        const f32x2 sc = *(const LAS f32x2*)&SC[tt * 4];
                        const f32x2 av[4] = {{a_lo.x, a_lo.y}, {a_lo.z, a_lo.w}, {a_hi.x, a_hi.y}, {a_hi.z, a_hi.w}};
                        const f32x2 rv[4] = {{r_lo.x, r_lo.y}, {r_lo.z, r_lo.w}, {r_hi.x, r_hi.y}, {r_hi.z, r_hi.w}};
                        const f32x2 wv[4] = {{w_lo.x, w_lo.y}, {w_lo.z, w_lo.w}, {w_hi.x, w_hi.y}, {w_hi.z, w_hi.w}};
                        const f32x2 bv[4] = {{b_lo.x, b_lo.y}, {b_lo.z, b_lo.w}, {b_hi.x, b_hi.y}, {b_hi.z, b_hi.w}};
                        const f32x2 kv[4] = {{k_lo.x, k_lo.y}, {k_lo.z, k_lo.w}, {k_hi.x, k_hi.y}, {k_hi.z, k_hi.w}};
                        f32x2 e10 = S0[0] * av[0], e20 = S0[0] * rv[0], e11 = S1[0] * av[0], e21 = S1[0] * rv[0];
#pragma unroll
                        for (int j = 1; j < 4; ++j) { e10 += S0[j] * av[j]; e20 += S0[j] * rv[j]; e11 += S1[j] * av[j]; e21 += S1[j] * rv[j]; }
                        const float d10 = red8(e10.x + e10.y), d20 = red8(e20.x + e20.y), d11 = red8(e11.x + e11.y), d21 = red8(e21.x + e21.y);
                        yk[s4] = (f32x2){d20 + d10 * sc.x + vv.x * sc.y, d21 + d11 * sc.x + vv.y * sc.y};
                        const f32x2 d10v = (f32x2){d10, d10}, d11v = (f32x2){d11, d11}, v0v = (f32x2){vv.x, vv.x}, v1v = (f32x2){vv.y, vv.y};
#pragma unroll
                        for (int j = 0; j < 4; ++j) { S0[j] = S0[j] * wv[j] + (d10v * bv[j] + v0v * kv[j]); S1[j] = S1[j] * wv[j] + (d11v * bv[j] + v1v * kv[j]); }
                    }
                    if (jg == 0) {
#pragma unroll
                        for (int s4 = 0; s4 < 4; ++s4) *(LAS f32x2*)&Yy[(4 * q4 + s4) * 64 + i0] = yk[s4];
                    }

#if PROBE_SCAN2
                    {
#pragma unroll
                    for (int s4 = 0; s4 < 4; ++s4) {
                        const int tt = 4 * q4 + s4;
                        const f32x4 a_lo = *(const LAS f32x4*)&A_[tt * 64 + 8 * jg], a_hi = *(const LAS f32x4*)&A_[tt * 64 + 8 * jg + 4];
                        const f32x4 r_lo = *(const LAS f32x4*)&WR[tt * 64 + 8 * jg], r_hi = *(const LAS f32x4*)&WR[tt * 64 + 8 * jg + 4];
                        const f32x4 w_lo = *(const LAS f32x4*)&Wd[tt * 64 + 8 * jg], w_hi = *(const LAS f32x4*)&Wd[tt * 64 + 8 * jg + 4];
                        const f32x4 b_lo = *(const LAS f32x4*)&Bv[tt * 64 + 8 * jg], b_hi = *(const LAS f32x4*)&Bv[tt * 64 + 8 * jg + 4];
                        const f32x4 k_lo = *(const LAS f32x4*)&Kk[tt * 64 + 8 * jg], k_hi = *(const LAS f32x4*)&Kk[tt * 64 + 8 * jg + 4];
                        const f32x2 vv = *(const LAS f32x2*)&Vv[tt * 64 + i0];
                        const f32x2 av[4] = {{a_lo.x, a_lo.y}, {a_lo.z, a_lo.w}, {a_hi.x, a_hi.y}, {a_hi.z, a_hi.w}};
                        const f32x2 rv[4] = {{r_lo.x, r_lo.y}, {r_lo.z, r_lo.w}, {r_hi.x, r_hi.y}, {r_hi.z, r_hi.w}};
                        const f32x2 wv[4] = {{w_lo.x, w_lo.y}, {w_lo.z, w_lo.w}, {w_hi.x, w_hi.y}, {w_hi.z, w_hi.w}};
                        const f32x2 bv[4] = {{b_lo.x, b_lo.y}, {b_lo.z, b_lo.w}, {b_hi.x, b_hi.y}, {b_hi.z, b_hi.w}};
                        const f32x2 kv[4] = {{k_lo.x, k_lo.y}, {k_lo.z, k_lo.w}, {k_hi.x, k_hi.y}, {k_hi.z, k_hi.w}};
                        f32x2 e10 = T0[0] * av[0], e20 = T0[0] * rv[0], e11 = T1[0] * av[0], e21 = T1[0] * rv[0];
#pragma unroll
                        for (int j = 1; j < 4; ++j) { e10 += T0[j] * av[j]; e20 += T0[j] * rv[j]; e11 += T1[j] * av[j]; e21 += T1[j] * rv[j]; }
                        const float d10 = red8(e10.x + e10.y), d20 = red8(e20.x + e20.y), d11 = red8(e11.x + e11.y), d21 = red8(e21.x + e21.y);
                        const f32x2 d10v = (f32x2){d10 + d20, d10}, d11v = (f32x2){d11 + d21, d11}, v0v = (f32x2){vv.x, vv.x}, v1v = (f32x2){vv.y, vv.y};
#pragma unroll
                        for (int j = 0; j < 4; ++j) { T0[j] = T0[j] * wv[j] + (d10v * bv[j] + v0v * kv[j]); T1[j] = T1[j] * wv[j] + (d11v * bv[j] + v1v * kv[j]); }
                    }
                    }
#endif
                }
                if (q4 & 1) LDS_BAR();
            }
        }
            }
        if (i0_ + 1 < RW_NCH) { const int i = i0_ + 1;

        const int bufn = (i + 1) & 1, bufc = i & 1;
        if (helper) {
            const bool do_prep = (i + 1 < RW_NCH);
            if (i >= 1) {
                LAS float* Yy = RW_ARR(bufn, 7); LAS float* Gg = RW_ARR(bufn, 6); LAS float* Vv = RW_ARR(bufn, 5); LAS float* SC = RW_SC(bufn);
                const f32x4 y = *(const LAS f32x4*)&Yy[tt_h * 64 + cg4], gg = *(const LAS f32x4*)&Gg[tt_h * 64 + cg4], vv = *(const LAS f32x4*)&Vv[tt_h * 64 + cg4];
                const float bonus = BON[((i - 1) % 3) * 16 + tt_h];
                const float mean = red16((y.x + y.y) + (y.z + y.w)) * (1.f / 64.f);
                const f32x4 d = y - mean;
                const float var = red16((d.x * d.x + d.y * d.y) + (d.z * d.z + d.w * d.w)) * (1.f / 64.f);
                const float rs = 1.f / sqrtf(var + 64e-5f);
                const f32x4 o = (d * rs * p_gg + p_gb + vv * bonus) * gg;
                u32x2 w; w.x = pk2(o.x, o.y); w.y = pk2(o.z, o.w);
                *(u32x2*)(X.P + ((size_t)b * SEQ + (i - 1) * RW_TS + tt_h) * LDP + COL_YA + h * 64 + cg4) = w;
            }
            if (do_prep) {
                const f32x4 r = (f32x4){bflo(l_rB.x), bfhi(l_rB.x), bflo(l_rB.y), bfhi(l_rB.y)}, k = (f32x4){bflo(l_kB.x), bfhi(l_kB.x), bflo(l_kB.y), bfhi(l_kB.y)};
                const f32x4 v = (f32x4){bflo(l_vB.x), bfhi(l_vB.x), bflo(l_vB.y), bfhi(l_vB.y)}, w1 = (f32x4){bflo(l_wB.x), bfhi(l_wB.x), bflo(l_wB.y), bfhi(l_wB.y)};
                const f32x4 a = (f32x4){bflo(l_aB.x), bfhi(l_aB.x), bflo(l_aB.y), bfhi(l_aB.y)};
                const f32x4 kk = k * p_kk * l_sB.x;
                const f32x4 decay = 1.f - w1;
                *(LAS f32x4*)&RW_ARR(bufn, 0)[tt_h * 64 + cg4] = -kk;
                *(LAS f32x4*)&RW_ARR(bufn, 1)[tt_h * 64 + cg4] = decay * r;
                *(LAS f32x4*)&RW_ARR(bufn, 2)[tt_h * 64 + cg4] = decay;
                *(LAS f32x4*)&RW_ARR(bufn, 3)[tt_h * 64 + cg4] = kk * a;
                *(LAS f32x4*)&RW_ARR(bufn, 4)[tt_h * 64 + cg4] = k * (1.f + (a - 1.f) * p_ka);
                *(LAS f32x4*)&RW_ARR(bufn, 5)[tt_h * 64 + cg4] = v;
                if (cg4 == 0) { LAS float* SC = RW_SC(bufn); SC[tt_h * 4 + 0] = l_sB.y; SC[tt_h * 4 + 1] = l_sB.z; BON[((i + 1) % 3) * 16 + tt_h] = l_sB.w; }
                float gc[8], gp[8];
                gc[0] = bflo(l_gcB.x); gc[1] = bfhi(l_gcB.x); gc[2] = bflo(l_gcB.y); gc[3] = bfhi(l_gcB.y); gc[4] = bflo(l_gcB.z); gc[5] = bfhi(l_gcB.z); gc[6] = bflo(l_gcB.w); gc[7] = bfhi(l_gcB.w);
                gp[0] = bflo(l_gpB.x); gp[1] = bfhi(l_gpB.x); gp[2] = bflo(l_gpB.y); gp[3] = bfhi(l_gpB.y); gp[4] = bflo(l_gpB.z); gp[5] = bfhi(l_gpB.z); gp[6] = bflo(l_gpB.w); gp[7] = bfhi(l_gpB.w);
#pragma unroll
                for (int e = 0; e < 8; ++e) gc[e] = sigmoidf_(gc[e] + (gp[e] - gc[e]) * (e < 4 ? mg0[e & 3] : mg1[e & 3]));
                u32x4 o; o.x = pk2(gc[0], gc[1]); o.y = pk2(gc[2], gc[3]); o.z = pk2(gc[4], gc[5]); o.w = pk2(gc[6], gc[7]);
                *(LAS u32x4*)&GDb[tt_h * 136 + gv8] = o;
            }
            if (i + 3 < RW_NCH) RW_LOAD(i + 3, B);
            LDS_BAR();
            if (do_prep) {
                LAS float* Gg = RW_ARR(bufn, 6);
                f32x4 cg_ = (f32x4){0.f, 0.f, 0.f, 0.f};
#pragma unroll
                for (int ks = 0; ks < 4; ++ks) {
                    const bf16x8 za = *(const LAS bf16x8*)&GDb[ln * 136 + ks * 32 + 8 * lg], zb = *(const LAS bf16x8*)&WTg[(16 * nt + ln) * 136 + ks * 32 + 8 * lg];
                    cg_ = __builtin_amdgcn_mfma_f32_16x16x32_bf16(za, zb, cg_, 0, 0, 0);
                }
#pragma unroll
                for (int r = 0; r < 4; ++r) Gg[(4 * lg + r) * 64 + chm] = cg_[r];
            }
            LDS_BAR();
        } else {
            LAS float* A_ = RW_ARR(bufc, 0); LAS float* WR = RW_ARR(bufc, 1); LAS float* Wd = RW_ARR(bufc, 2); LAS float* Bv = RW_ARR(bufc, 3);
            LAS float* Kk = RW_ARR(bufc, 4); LAS float* Vv = RW_ARR(bufc, 5); LAS float* Yy = RW_ARR(bufc, 7); LAS float* SC = RW_SC(bufc);
#pragma unroll 1
            for (int q4 = 0; q4 < 4; ++q4) {
                if (i >= 0) {
                    f32x2 yk[4];
#pragma unroll
                    for (int s4 = 0; s4 < 4; ++s4) {
                        const int tt = 4 * q4 + s4;
                        const f32x4 a_lo = *(const LAS f32x4*)&A_[tt * 64 + 8 * jg], a_hi = *(const LAS f32x4*)&A_[tt * 64 + 8 * jg + 4];
                        const f32x4 r_lo = *(const LAS f32x4*)&WR[tt * 64 + 8 * jg], r_hi = *(const LAS f32x4*)&WR[tt * 64 + 8 * jg + 4];
                        const f32x4 w_lo = *(const LAS f32x4*)&Wd[tt * 64 + 8 * jg], w_hi = *(const LAS f32x4*)&Wd[tt * 64 + 8 * jg + 4];
                        const f32x4 b_lo = *(const LAS f32x4*)&Bv[tt * 64 + 8 * jg], b_hi = *(const LAS f32x4*)&Bv[tt * 64 + 8 * jg + 4];
                        const f32x4 k_lo = *(const LAS f32x4*)&Kk[tt * 64 + 8 * jg], k_hi = *(const LAS f32x4*)&Kk[tt * 64 + 8 * jg + 4];
                        const f32x2 vv = *(const LAS f32x2*)&Vv[tt * 64 + i0];
                        const f32x2 sc = *(const LAS f32x2*)&SC[tt * 4];
                        const f32x2 av[4] = {{a_lo.x, a_lo.y}, {a_lo.z, a_lo.w}, {a_hi.x, a_hi.y}, {a_hi.z, a_hi.w}};
                        const f32x2 rv[4] = {{r_lo.x, r_lo.y}, {r_lo.z, r_lo.w}, {r_hi.x, r_hi.y}, {r_hi.z, r_hi.w}};
                        const f32x2 wv[4] = {{w_lo.x, w_lo.y}, {w_lo.z, w_lo.w}, {w_hi.x, w_hi.y}, {w_hi.z, w_hi.w}};
                        const f32x2 bv[4] = {{b_lo.x, b_lo.y}, {b_lo.z, b_lo.w}, {b_hi.x, b_hi.y}, {b_hi.z, b_hi.w}};
                        const f32x2 kv[4] = {{k_lo.x, k_lo.y}, {k_lo.z, k_lo.w}, {k_hi.x, k_hi.y}, {k_hi.z, k_hi.w}};
                        f32x2 e10 = S0[0] * av[0], e20 = S0[0] * rv[0], e11 = S1[0] * av[0], e21 = S1[0] * rv[0];
#pragma unroll
                        for (int j = 1; j < 4; ++j) { e10 += S0[j] * av[j]; e20 += S0[j] * rv[j]; e11 += S1[j] * av[j]; e21 += S1[j] * rv[j]; }
                        const float d10 = red8(e10.x + e10.y), d20 = red8(e20.x + e20.y), d11 = red8(e11.x + e11.y), d21 = red8(e21.x + e21.y);
                        yk[s4] = (f32x2){d20 + d10 * sc.x + vv.x * sc.y, d21 + d11 * sc.x + vv.y * sc.y};
                        const f32x2 d10v = (f32x2){d10, d10}, d11v = (f32x2){d11, d11}, v0v = (f32x2){vv.x, vv.x}, v1v = (f32x2){vv.y, vv.y};
#pragma unroll
                        for (int j = 0; j < 4; ++j) { S0[j] = S0[j] * wv[j] + (d10v * bv[j] + v0v * kv[j]); S1[j] = S1[j] * wv[j] + (d11v * bv[j] + v1v * kv[j]); }
                    }
                    if (jg == 0) {
#pragma unroll
                        for (int s4 = 0; s4 < 4; ++s4) *(LAS f32x2*)&Yy[(4 * q4 + s4) * 64 + i0] = yk[s4];
                    }

#if PROBE_SCAN2
                    {
#pragma unroll
                    for (int s4 = 0; s4 < 4; ++s4) {
                        const int tt = 4 * q4 + s4;
                        const f32x4 a_lo = *(const LAS f32x4*)&A_[tt * 64 + 8 * jg], a_hi = *(const LAS f32x4*)&A_[tt * 64 + 8 * jg + 4];
                        const f32x4 r_lo = *(const LAS f32x4*)&WR[tt * 64 + 8 * jg], r_hi = *(const LAS f32x4*)&WR[tt * 64 + 8 * jg + 4];
                        const f32x4 w_lo = *(const LAS f32x4*)&Wd[tt * 64 + 8 * jg], w_hi = *(const LAS f32x4*)&Wd[tt * 64 + 8 * jg + 4];
                        const f32x4 b_lo = *(const LAS f32x4*)&Bv[tt * 64 + 8 * jg], b_hi = *(const LAS f32x4*)&Bv[tt * 64 + 8 * jg + 4];
                        const f32x4 k_lo = *(const LAS f32x4*)&Kk[tt * 64 + 8 * jg], k_hi = *(const LAS f32x4*)&Kk[tt * 64 + 8 * jg + 4];
                        const f32x2 vv = *(const LAS f32x2*)&Vv[tt * 64 + i0];
                        const f32x2 av[4] = {{a_lo.x, a_lo.y}, {a_lo.z, a_lo.w}, {a_hi.x, a_hi.y}, {a_hi.z, a_hi.w}};
                        const f32x2 rv[4] = {{r_lo.x, r_lo.y}, {r_lo.z, r_lo.w}, {r_hi.x, r_hi.y}, {r_hi.z, r_hi.w}};
                        const f32x2 wv[4] = {{w_lo.x, w_lo.y}, {w_lo.z, w_lo.w}, {w_hi.x, w_hi.y}, {w_hi.z, w_hi.w}};
                        const f32x2 bv[4] = {{b_lo.x, b_lo.y}, {b_lo.z, b_lo.w}, {b_hi.x, b_hi.y}, {b_hi.z, b_hi.w}};
                        const f32x2 kv[4] = {{k_lo.x, k_lo.y}, {k_lo.z, k_lo.w}, {k_hi.x, k_hi.y}, {k_hi.z, k_hi.w}};
                        f32x2 e10 = T0[0] * av[0], e20 = T0[0] * rv[0], e11 = T1[0] * av[0], e21 = T1[0] * rv[0];
#pragma unroll
                        for (int j = 1; j < 4; ++j) { e10 += T0[j] * av[j]; e20 += T0[j] * rv[j]; e11 += T1[j] * av[j]; e21 += T1[j] * rv[j]; }
                        const float d10 = red8(e10.x + e10.y), d20 = red8(e20.x + e20.y), d11 = red8(e11.x + e11.y), d21 = red8(e21.x + e21.y);
                        const f32x2 d10v = (f32x2){d10 + d20, d10}, d11v = (f32x2){d11 + d21, d11}, v0v = (f32x2){vv.x, vv.x}, v1v = (f32x2){vv.y, vv.y};
#pragma unroll
                        for (int j = 0; j < 4; ++j) { T0[j] = T0[j] * wv[j] + (d10v * bv[j] + v0v * kv[j]); T1[j] = T1[j] * wv[j] + (d11v * bv[j] + v1v * kv[j]); }
                    }
                    }
#endif
                }
                if (q4 & 1) LDS_BAR();
            }
        }
            }
    }
    if (helper) {
        const int bufl = (RW_NCH - 1) & 1;
        LAS float* Yy = RW_ARR(bufl, 7); LAS float* Gg = RW_ARR(bufl, 6); LAS float* Vv = RW_ARR(bufl, 5); LAS float* SC = RW_SC(bufl);
        const f32x4 y = *(const LAS f32x4*)&Yy[tt_h * 64 + cg4], gg = *(const LAS f32x4*)&Gg[tt_h * 64 + cg4], vv = *(const LAS f32x4*)&Vv[tt_h * 64 + cg4];
        const float bonus = BON[((RW_NCH - 1) % 3) * 16 + tt_h];
        const float mean = red16((y.x + y.y) + (y.z + y.w)) * (1.f / 64.f);
        const f32x4 d = y - mean;
        const float var = red16((d.x * d.x + d.y * d.y) + (d.z * d.z + d.w * d.w)) * (1.f / 64.f);
        const float rs = 1.f / sqrtf(var + 64e-5f);
        const f32x4 o = (d * rs * p_gg + p_gb + vv * bonus) * gg;
        u32x2 w; w.x = pk2(o.x, o.y); w.y = pk2(o.z, o.w);
        *(u32x2*)(X.P + ((size_t)b * SEQ + (RW_NCH - 1) * RW_TS + tt_h) * LDP + COL_YA + h * 64 + cg4) = w;
    }
    __syncthreads();
#undef RW_ARR
#undef RW_SC
#undef RW_LOAD
}

__device__ __forceinline__ void hgrn_task(const Ctx& X, LAS unsigned char* lds, int layer, int b, int h, int vh) {
    LAS float* F = (LAS float*)(lds); LAS float* Q = (LAS float*)(lds + 16384); LAS float* Vv = (LAS float*)(lds + 32768); LAS float* O = (LAS float*)(lds + 40960);
    LAS float* LB = (LAS float*)(lds + 49152);
    const int tid = X.tid;
    const float* lbl = X.in[14];
    const int rp = tid >> 4, dg = tid & 15, v0 = 2 * rp;
    if (tid < 128) LB[tid] = (layer > 0) ? 1.f / (1.f + __expf(lbl[h * 128 + tid] - lbl[512 + h * 128 + tid])) : 0.f;
    f32x2 S0[4], S1[4];
#pragma unroll
    for (int j = 0; j < 4; ++j) { S0[j] = (f32x2){0.f, 0.f}; S1[j] = (f32x2){0.f, 0.f}; }
#define HG_LOAD(chk) do { _Pragma("unroll") for (int it = 0; it < 3; ++it) { const int idx = tid + 512 * it; raw[it] = (u32x4){0u, 0u, 0u, 0u}; \
        if (idx < 32 * 40) { const int tt = idx / 40, vv = idx - tt * 40; \
            const int col = vv < 16 ? 512 + h * 128 + 8 * vv : (vv < 32 ? h * 128 + 8 * (vv - 16) : 1024 + h * 128 + vh * 64 + 8 * (vv - 32)); \
            raw[it] = *(const u32x4*)(X.P + ((size_t)b * SEQ + (chk) * 32 + tt) * LDP + COL_PB + col); } } } while (0)
    u32x4 raw[3];
    HG_LOAD(0);
    __syncthreads();
#pragma unroll 1
    for (int ch = 0; ch < SEQ / 32; ++ch) {
        const int t0 = ch * 32;
#pragma unroll
        for (int it = 0; it < 3; ++it) {
            const int idx = tid + 512 * it;
            if (idx < 32 * 40) {
                const int tt = idx / 40, vv = idx - tt * 40;
                float x[8];
                x[0] = bflo(raw[it].x); x[1] = bfhi(raw[it].x); x[2] = bflo(raw[it].y); x[3] = bfhi(raw[it].y);
                x[4] = bflo(raw[it].z); x[5] = bfhi(raw[it].z); x[6] = bflo(raw[it].w); x[7] = bfhi(raw[it].w);
                LAS float* dst;
                if (vv < 16) {
                    dst = F + tt * 128 + 8 * vv;
#pragma unroll
                    for (int e = 0; e < 8; ++e) { const float lb = LB[8 * vv + e]; x[e] = lb + (1.f - lb) * sigmoidf_(x[e]); }
                } else if (vv < 32) dst = Q + tt * 128 + 8 * (vv - 16);
                else dst = Vv + tt * 64 + 8 * (vv - 32);
                *(LAS f32x4*)dst = (f32x4){x[0], x[1], x[2], x[3]}; *(LAS f32x4*)(dst + 4) = (f32x4){x[4], x[5], x[6], x[7]};
            }
        }
        if (ch + 1 < SEQ / 32) HG_LOAD(ch + 1);
        LDS_BAR();
#pragma unroll 4
        for (int tt = 0; tt < 32; ++tt) {
            const f32x4 f_lo = *(const LAS f32x4*)&F[tt * 128 + 8 * dg], f_hi = *(const LAS f32x4*)&F[tt * 128 + 8 * dg + 4];
            const f32x4 q_lo = *(const LAS f32x4*)&Q[tt * 128 + 8 * dg], q_hi = *(const LAS f32x4*)&Q[tt * 128 + 8 * dg + 4];
            const f32x2 vv = *(const LAS f32x2*)&Vv[tt * 64 + v0];
            const f32x2 f2[4] = {{f_lo.x, f_lo.y}, {f_lo.z, f_lo.w}, {f_hi.x, f_hi.y}, {f_hi.z, f_hi.w}};
            const f32x2 q2[4] = {{q_lo.x, q_lo.y}, {q_lo.z, q_lo.w}, {q_hi.x, q_hi.y}, {q_hi.z, q_hi.w}};
            const f32x2 v0v = (f32x2){vv.x, vv.x}, v1v = (f32x2){vv.y, vv.y};
            f32x2 a0 = (f32x2){0.f, 0.f}, a1 = (f32x2){0.f, 0.f};
#pragma unroll
            for (int j = 0; j < 4; ++j) {
                S0[j] = v0v + f2[j] * (S0[j] - v0v); S1[j] = v1v + f2[j] * (S1[j] - v1v);
                a0 += q2[j] * S0[j]; a1 += q2[j] * S1[j];
            }
            const float o0 = red16(a0.x + a0.y), o1 = red16(a1.x + a1.y);
            if (dg == 0) *(LAS f32x2*)&O[tt * 64 + v0] = (f32x2){o0, o1};
        }
        LDS_BAR();
        if (tid < 256) {
            const int tt = tid >> 3, v8 = (tid & 7) * 8;
            const f32x4 a = *(const LAS f32x4*)&O[tt * 64 + v8], c4 = *(const LAS f32x4*)&O[tt * 64 + v8 + 4];
            u32x4 o; o.x = pk2(a.x, a.y); o.y = pk2(a.z, a.w); o.z = pk2(c4.x, c4.y); o.w = pk2(c4.z, c4.w);
            *(u32x4*)(X.P + ((size_t)b * SEQ + t0 + tt) * LDP + COL_YB + h * 128 + vh * 64 + v8) = o;
        }
    }
#undef HG_LOAD
    __syncthreads();
}

__device__ __forceinline__ unsigned f2ord(float f) { const unsigned u = __builtin_bit_cast(unsigned, f); return (u & 0x80000000u) ? ~u : (u | 0x80000000u); }

__device__ __forceinline__ void dsa_tile(const Ctx& X, LAS unsigned char* lds, int b, int q0) {
    LAS float* sc = (LAS float*)lds;
    LAS unsigned* MASK = (LAS unsigned*)(lds + MASK_OFF);
    const int lane = X.lane, w = X.wave, n = lane & 15, g = lane >> 4;
    const bf16_t* Pb = X.P + (size_t)b * SEQ * LDP;
#pragma unroll 1
    for (int sub = 0; sub < 4; ++sub) {
        const int qs = q0 + 16 * sub;
        {
            bf16x8 bq[4][2]; float wi[4];
            const bf16_t* qrow = Pb + (size_t)(qs + n) * LDP;
#pragma unroll
            for (int hh = 0; hh < 4; ++hh) {
#pragma unroll
                for (int ks = 0; ks < 2; ++ks) bq[hh][ks] = *(const bf16x8*)(qrow + C_QI + hh * 64 + ks * 32 + 8 * g);
                wi[hh] = bf2f(qrow[C_WI + hh]);
            }
            const int nkt = (qs + 16) >> 4;
            bf16x8 a0n = (bf16x8){0, 0, 0, 0, 0, 0, 0, 0}, a1n = a0n;
            if (w < nkt) { const bf16_t* krow = Pb + (size_t)(w * 16 + n) * LDP + C_KI; a0n = *(const bf16x8*)(krow + 8 * g); a1n = *(const bf16x8*)(krow + 32 + 8 * g); }
#pragma unroll 1
            for (int kt = w; kt < nkt; kt += 8) {
                const bf16x8 a0 = a0n, a1 = a1n;
                if (kt + 8 < nkt) { const bf16_t* krow = Pb + (size_t)((kt + 8) * 16 + n) * LDP + C_KI; a0n = *(const bf16x8*)(krow + 8 * g); a1n = *(const bf16x8*)(krow + 32 + 8 * g); }
                f32x4 s = (f32x4){0.f, 0.f, 0.f, 0.f};
#pragma unroll
                for (int hh = 0; hh < 4; ++hh) {
                    f32x4 d = __builtin_amdgcn_mfma_f32_16x16x32_bf16(a0, bq[hh][0], (f32x4){0.f, 0.f, 0.f, 0.f}, 0, 0, 0);
                    d = __builtin_amdgcn_mfma_f32_16x16x32_bf16(a1, bq[hh][1], d, 0, 0, 0);
#pragma unroll
                    for (int r = 0; r < 4; ++r) s[r] += wi[hh] * fmaxf(d[r], 0.f);
                }
                const int t = qs + n;
#pragma unroll
                for (int r = 0; r < 4; ++r) if (kt * 16 + 4 * g + r > t) s[r] = -INFINITY;
                *(LAS f32x4*)&sc[n * SCS + kt * 16 + 4 * g] = s;
            }
        }
        __syncthreads();
#pragma unroll 1
        for (int e = 0; e < 2; ++e) {
            const int qn = 2 * w + e, t = qs + qn;
            LAS unsigned* mrow = MASK + (sub * 16 + qn) * 64;
            if (t < 256) {
#pragma unroll
                for (int j = 0; j < 32; ++j) {
                    const unsigned long long sm = __ballot(j * 64 + lane <= t);
                    if (lane == 0) { mrow[2 * j] = (unsigned)sm; mrow[2 * j + 1] = (unsigned)(sm >> 32); }
                }
            } else {
                const int jn = (t >> 6) + 1;
                unsigned u[32];
#pragma unroll
                for (int j = 0; j < 32; ++j) {
                    u[j] = 0u;
                    if (j < jn) { const int key = j * 64 + lane; const float s = (key <= t) ? sc[qn * SCS + key] : -INFINITY; u[j] = f2ord(s); }
                }
                unsigned prefix = 0u;
#define DSA_BITSEARCH(JN) do { _Pragma("unroll 1") for (int bit = 31; bit >= 0; --bit) { const unsigned cand = prefix | (1u << bit); int c0 = 0, c1 = 0; \
                    _Pragma("unroll") for (int j = 0; j < (JN); j += 2) { c0 += (u[j] >= cand) ? 1 : 0; c1 += (u[j + 1] >= cand) ? 1 : 0; } \
                    const int cnt = (int)wave_sum_fast((float)(c0 + c1)); if (cnt >= 256) prefix = cand; } } while (0)
                if (jn <= 8) DSA_BITSEARCH(8); else if (jn <= 16) DSA_BITSEARCH(16); else if (jn <= 24) DSA_BITSEARCH(24); else DSA_BITSEARCH(32);
#undef DSA_BITSEARCH
                int cg_ = 0;
#pragma unroll
                for (int j = 0; j < 32; ++j) if (j < jn) cg_ += __popcll(__ballot(u[j] > prefix));
                const int need = 256 - cg_;
                int cum = 0;
#pragma unroll
                for (int j = 0; j < 32; ++j) {
                    unsigned long long sm = 0ull;
                    if (j < jn) {
                        const bool eq = (u[j] == prefix);
                        const unsigned long long em = __ballot(eq);
                        const int rank = cum + (int)__builtin_amdgcn_mbcnt_hi((unsigned)(em >> 32), __builtin_amdgcn_mbcnt_lo((unsigned)em, 0u));
                        const bool sel = (u[j] > prefix) || (eq && rank < need);
                        sm = __ballot(sel);
                        cum += __popcll(em);
                    }
                    if (lane == 0) { mrow[2 * j] = (unsigned)sm; mrow[2 * j + 1] = (unsigned)(sm >> 32); }
                }
            }
        }
        __syncthreads();
    }
    const int qq = q0 + 8 * w + (n & 7);
    const LAS unsigned* mq = MASK + (8 * w + (n & 7)) * 64;
    const int nsteps = (q0 + 8 * w + 8 + 31) >> 5;
    const int nblk = (q0 + 64 + 127) >> 7;
    LAS bf16_t* KT = (LAS bf16_t*)lds;
    LAS bf16_t* VTT = (LAS bf16_t*)(lds + 36864);
    const int tid = X.tid;
#pragma unroll 1
    for (int c = 0; c < 2; ++c) {
        bf16x8 bq[2][2];
#pragma unroll
        for (int j = 0; j < 2; ++j)
#pragma unroll
            for (int ks = 0; ks < 2; ++ks) bq[j][ks] = *(const bf16x8*)(Pb + (size_t)qq * LDP + C_Q + (c * 4 + 2 * j + (n >> 3)) * 64 + ks * 32 + 8 * g);
        float lrun[2] = {0.f, 0.f};
        f32x4 oacc[4][2];
#pragma unroll
        for (int mt = 0; mt < 4; ++mt)
#pragma unroll
            for (int j = 0; j < 2; ++j) oacc[mt][j] = (f32x4){0.f, 0.f, 0.f, 0.f};
        const bf16_t* vtb = X.VT + ((size_t)(b * 2 + c) * 64) * SEQ;
        u32x4 gk[2], gv[2];
#define DSA_GLOAD(kblk) do { _Pragma("unroll") for (int it = 0; it < 2; ++it) { const int idx = tid + 512 * it; \
            gk[it] = *(const u32x4*)(Pb + (size_t)((kblk) * 128 + (idx >> 3)) * LDP + C_K + c * 64 + (idx & 7) * 8); \
            gv[it] = *(const u32x4*)(vtb + (size_t)(idx >> 4) * SEQ + (kblk) * 128 + (idx & 15) * 8); } } while (0)
#define DSA_LSTORE(bufi) do { _Pragma("unroll") for (int it = 0; it < 2; ++it) { const int idx = tid + 512 * it; \
            *(LAS u32x4*)(KT + (bufi) * 9216 + (idx >> 3) * 72 + (idx & 7) * 8) = gk[it]; \
            *(LAS u32x4*)(VTT + (bufi) * 8704 + (idx >> 4) * 136 + (idx & 15) * 8) = gv[it]; } } while (0)
        DSA_GLOAD(0);
        LDS_BAR();
        DSA_LSTORE(0);
        LDS_BAR();
#pragma unroll 1
        for (int kb = 0; kb < nblk; ++kb) {
            const int buf = kb & 1;
            if (kb + 1 < nblk) DSA_GLOAD(kb + 1);
            const LAS bf16_t* Kb = KT + buf * 9216; const LAS bf16_t* Vb = VTT + buf * 8704;
#pragma unroll 1
            for (int sl = 0; sl < 4; ++sl) {
                const int sg = kb * 4 + sl;
                if (sg < nsteps) {
                    f32x4 st[2][2];
#pragma unroll
                    for (int tl = 0; tl < 2; ++tl) {
                        const LAS bf16_t* kr = Kb + (32 * sl + 16 * tl + n) * 72;
                        const bf16x8 a0 = *(const LAS bf16x8*)(kr + 8 * g), a1 = *(const LAS bf16x8*)(kr + 32 + 8 * g);
#pragma unroll
                        for (int j = 0; j < 2; ++j) {
                            f32x4 d = __builtin_amdgcn_mfma_f32_16x16x32_bf16(a0, bq[j][0], (f32x4){0.f, 0.f, 0.f, 0.f}, 0, 0, 0);
                            st[tl][j] = __builtin_amdgcn_mfma_f32_16x16x32_bf16(a1, bq[j][1], d, 0, 0, 0);
                        }
                    }
                    bf16x8 av[4];
#pragma unroll
                    for (int mt = 0; mt < 4; ++mt) {
                        const LAS bf16_t* vp = Vb + (mt * 16 + n) * 136 + 32 * sl + 4 * g;
                        const u32x2 lo = *(const LAS u32x2*)vp, hi = *(const LAS u32x2*)(vp + 16);
                        u32x4 t4; t4.x = lo.x; t4.y = lo.y; t4.z = hi.x; t4.w = hi.y;
                        av[mt] = __builtin_bit_cast(bf16x8, t4);
                    }
                    const unsigned mw = mq[sg];
#pragma unroll
                    for (int j = 0; j < 2; ++j) {
                        float p[8], ps = 0.f;
#pragma unroll
                        for (int tl = 0; tl < 2; ++tl)
#pragma unroll
                            for (int r = 0; r < 4; ++r) { const int bit = 16 * tl + 4 * g + r; const float e = __expf(fminf(st[tl][j][r] * 0.125f, 60.f)); p[4 * tl + r] = ((mw >> bit) & 1u) ? e : 0.f; ps += p[4 * tl + r]; }
                        lrun[j] += ps;
                        u32x4 pw; pw.x = pg8::cvt_pk_bf16(p[0], p[1]); pw.y = pg8::cvt_pk_bf16(p[2], p[3]); pw.z = pg8::cvt_pk_bf16(p[4], p[5]); pw.w = pg8::cvt_pk_bf16(p[6], p[7]);
                        const bf16x8 pb = __builtin_bit_cast(bf16x8, pw);
#pragma unroll
                        for (int mt = 0; mt < 4; ++mt) oacc[mt][j] = __builtin_amdgcn_mfma_f32_16x16x32_bf16(av[mt], pb, oacc[mt][j], 0, 0, 0);
                    }
                }
            }
            if (kb + 1 < nblk) DSA_LSTORE(buf ^ 1);
            LDS_BAR();
        }
#pragma unroll
        for (int j = 0; j < 2; ++j) {
            float lt = lrun[j]; lt += __shfl_xor(lt, 16); lt += __shfl_xor(lt, 32);
            const float il = 1.f / lt;
            bf16_t* op = X.P + ((size_t)b * SEQ + qq) * LDP + COL_YC + (c * 4 + 2 * j + (n >> 3)) * 64 + 4 * g;
#pragma unroll
            for (int mt = 0; mt < 4; ++mt) {
                const f32x4 o = oacc[mt][j] * il;
                u32x2 wv; wv.x = pg8::cvt_pk_bf16(o[0], o[1]); wv.y = pg8::cvt_pk_bf16(o[2], o[3]);
                *(u32x2*)(op + mt * 16) = wv;
            }
        }
    }
#undef DSA_GLOAD
#undef DSA_LSTORE
    __syncthreads();
}

__device__ __forceinline__ void phase_mixers(const Ctx& X0, LAS unsigned char* lds, int layer) {
#pragma unroll 1
    for (int task = X0.bid; task < 128; task += X0.G) {
        Ctx X = X0;
        { int t_ = threadIdx.x; asm volatile("" : "+v"(t_)); X.tid = t_; X.lane = t_ & 63; }
        if (task < 64) { if (TKMASK & 1) rwkv_task(X, lds, layer, task >> 3, task & 7); }
        else { const int k = task - 64; if (TKMASK & 2) hgrn_task(X, lds, layer, k >> 3, (k >> 1) & 3, k & 1); }
    }
    volatile LAS unsigned* tw = (volatile LAS unsigned*)(lds + LDS_BYTES - 128);
    unsigned* ctr = (unsigned*)(X0.ws + WS_BAR + 14336) + 16 * layer;
#pragma unroll 1
    for (;;) {
        Ctx X = X0;
        { int t_ = threadIdx.x; asm volatile("" : "+v"(t_)); X.tid = t_; X.lane = t_ & 63; }
        __syncthreads();
        if (threadIdx.x == 0) tw[0] = __hip_atomic_fetch_add(ctr, 1u, __ATOMIC_RELAXED, __HIP_MEMORY_SCOPE_AGENT);
        __syncthreads();
        const int t = (int)tw[0];
        if (t >= 256) break;
        if (TKMASK & 4) dsa_tile(X, lds, t & 7, 64 * (31 - (t >> 3)));
    }
}

__device__ __forceinline__ void phase_hgrn_post(const Ctx& X, int layer) {
    const int gw = X.bid * 8 + X.wave, NGW = X.G * 8;
    const float* gn = X.in[15] + layer * 512;
#pragma unroll 1
    for (int it0 = gw; it0 < T_TOK * 4; it0 += 4 * NGW) {
        unsigned ow[4], gwd[4]; unsigned* op[4];
#pragma unroll
        for (int r = 0; r < 4; ++r) {
            const int it = it0 + r * NGW < T_TOK * 4 ? it0 + r * NGW : it0;
            const int t = it >> 2, h = it & 3;
            bf16_t* rowp = X.P + (size_t)t * LDP;
            op[r] = (unsigned*)(rowp + COL_YB + h * 128) + X.lane;
            ow[r] = *op[r]; gwd[r] = *((const unsigned*)(rowp + COL_PB + 1536 + h * 128) + X.lane);
        }
#pragma unroll
        for (int r = 0; r < 4; ++r) {
            const int it = it0 + r * NGW;
            const int h = it & 3;
            const float o0 = bflo(ow[r]), o1 = bfhi(ow[r]), g0 = bflo(gwd[r]), g1 = bfhi(gwd[r]);
            const float rs = 1.f / sqrtf(wave_sum(o0 * o0 + o1 * o1) * (1.f / 128.f) + 1e-6f);
            const float y0 = o0 * rs * gn[h * 128 + 2 * X.lane] * (g0 * sigmoidf_(g0)), y1 = o1 * rs * gn[h * 128 + 2 * X.lane + 1] * (g1 * sigmoidf_(g1));
            if (it < T_TOK * 4) *op[r] = pk2(y0, y1);
        }
    }
}

__device__ __forceinline__ void phase_fixup(const Ctx& X, int layer) {
    const float* cw = X.in[20] + (size_t)layer * 3 * F2; const float* cb = X.in[21] + (size_t)layer * F2;
#pragma unroll 4
    for (int idx = X.bid * 512 + X.tid; idx < 256 * 2 * DFF; idx += X.G * 512) {
        const int j = idx % DFF, sr = idx / DFF, s = sr >> 1, r = sr & 1;
        const int colg = (j >> 7) * 256 + (j & 127), colv = colg + 128;
        const bool seq0 = (s & 31) == 0;
        const float* H = X.HALO;
        float res[2];
#pragma unroll
        for (int part = 0; part < 2; ++part) {
            const int cp = part ? colv : colg, co = part * DFF + j;
            const float u0 = H[(size_t)(s * 4 + r) * F2 + cp];
            float u1, u2;
            if (r == 0) { u1 = seq0 ? 0.f : H[(size_t)((s - 1) * 4 + 3) * F2 + cp]; u2 = seq0 ? 0.f : H[(size_t)((s - 1) * 4 + 2) * F2 + cp]; }
            else { u1 = H[(size_t)(s * 4 + 0) * F2 + cp]; u2 = seq0 ? 0.f : H[(size_t)((s - 1) * 4 + 3) * F2 + cp]; }
            res[part] = cb[co] + cw[co] * u2 + cw[F2 + co] * u1 + cw[2 * F2 + co] * u0;
        }
        const float a = res[0] * sigmoidf_(res[0]) * res[1];
        X.P[(size_t)(s * 64 + r) * LDP + COL_ACT + j] = (bf16_t)f2bf(a);
    }
}

#define XB_TMO      128
#define XB_XCNT(j)  (256  + 64 * (j))
#define XB_XSUB(j)  (1280 + 64 * (j))
#define XB_XGEN(j)  (2304 + 64 * (j))
#define XB_TOP      3328
#define XB_TOPGEN   3392
#define XCD_BAR_WORDS 3456
#define XB_SPIN_CAP (1u << 22)
__device__ __forceinline__ unsigned xb_ld(unsigned* p)              { return __hip_atomic_load(p, __ATOMIC_RELAXED, __HIP_MEMORY_SCOPE_AGENT); }
__device__ __forceinline__ unsigned xb_add(unsigned* p, unsigned v) { return __hip_atomic_fetch_add(p, v, __ATOMIC_RELAXED, __HIP_MEMORY_SCOPE_AGENT); }
__device__ __forceinline__ unsigned xb_xcc_id() { return (unsigned)__builtin_amdgcn_s_getreg((3 << 11) | 20) & 0xFu; }
#define XB_SPIN(cond, bar) do { unsigned _sp = 0; while (cond) { __builtin_amdgcn_s_sleep(1); \
    if ((++_sp & 255u) == 0u) { if (xb_ld(&(bar)[XB_TMO])) break; if (_sp > XB_SPIN_CAP) { atomicAdd(&(bar)[XB_TMO], 1u); break; } } } } while (0)
struct XcdBarrier { unsigned* bar; unsigned x; volatile LAS unsigned* st; };
__device__ __forceinline__ XcdBarrier xcd_barrier_post(unsigned* bar, volatile LAS unsigned* st) {
    XcdBarrier b; b.bar = bar; b.x = xb_xcc_id(); b.st = st;
    if (threadIdx.x == 0) (void)xb_add(&bar[XB_XCNT(b.x)], 1u);
    return b;
}
__device__ __forceinline__ void xcd_barrier_complete(unsigned* bar, unsigned x, unsigned& nloc, unsigned& nx) {
    const unsigned G = gridDim.x * gridDim.y * gridDim.z;
    unsigned sum, cnt, mine, sp = 0u;
    for (;;) {
        sum = 0u; cnt = 0u; mine = 0u;
#pragma unroll
        for (unsigned j = 0; j < 16; ++j) { const unsigned c = xb_ld(&bar[XB_XCNT(j)]); sum += c; cnt += (c > 0u) ? 1u : 0u; mine = (j == x) ? c : mine; }
        if (sum == G) break;
        __builtin_amdgcn_s_sleep(1);
        if ((++sp & 255u) == 0u) { if (xb_ld(&bar[XB_TMO])) break; if (sp > XB_SPIN_CAP) { atomicAdd(&bar[XB_TMO], 1u); break; } }
    }
    nloc = mine > 0u ? mine : 1u; nx = cnt > 0u ? cnt : 1u;
}
__device__ __forceinline__ void xcd_barrier(const XcdBarrier& b) {
    asm volatile("s_waitcnt vmcnt(0)" ::: "memory");
    __syncthreads();
    if (threadIdx.x == 0) {
        unsigned* bar = b.bar;
        __builtin_amdgcn_s_waitcnt(0);
        unsigned nloc = b.st[0], nx = b.st[1];
        if (nloc == 0u) { xcd_barrier_complete(bar, b.x, nloc, nx); b.st[0] = nloc; b.st[1] = nx; }
        const unsigned old = xb_add(&bar[XB_XSUB(b.x)], 1u);
        const unsigned gen = old / nloc;
        if (old + 1u == (gen + 1u) * nloc) {
            __builtin_amdgcn_fence(__ATOMIC_RELEASE, "agent");
            asm volatile("s_waitcnt vmcnt(0)" ::: "memory");
            const unsigned og = xb_add(&bar[XB_TOP], 1u);
            const unsigned tg = og / nx;
            if (og + 1u == (tg + 1u) * nx) xb_add(&bar[XB_TOPGEN], 1u);
            else XB_SPIN(xb_ld(&bar[XB_TOPGEN]) == tg, bar);
            __builtin_amdgcn_fence(__ATOMIC_ACQUIRE, "agent");
            xb_add(&bar[XB_XGEN(b.x)], 1u);
            asm volatile("s_waitcnt vmcnt(0)" ::: "memory");
        } else {
            XB_SPIN(xb_ld(&bar[XB_XGEN(b.x)]) == gen, bar);
            __builtin_amdgcn_fence(__ATOMIC_ACQUIRE, "agent");
            asm volatile("s_waitcnt vmcnt(0)" ::: "memory");
        }
    }
    __syncthreads();
}

__global__ void __launch_bounds__(512, 2) mk_fwd(Args args) {
    extern __shared__ __attribute__((aligned(16))) unsigned char lds_raw[];
    LAS unsigned char* lds = (LAS unsigned char*)lds_raw;
    Ctx X;
#pragma unroll
    for (int i = 0; i < 24; ++i) X.in[i] = args.in[i];
    X.out = args.out; X.ws = args.ws;
    X.P = (bf16_t*)(args.ws + WS_P); X.VT = (bf16_t*)(args.ws + WS_VT); X.HALO = (float*)(args.ws + WS_HALO); X.ROPE = (float*)(args.ws + WS_ROPE);
    X.Win = (bf16_t*)(args.ws + WS_WIN); X.Wg = (bf16_t*)(args.ws + WS_WG); X.Wbr = (bf16_t*)(args.ws + WS_WBR);
    X.Wo = (bf16_t*)(args.ws + WS_WO); X.Wup = (bf16_t*)(args.ws + WS_WUP); X.Wdn = (bf16_t*)(args.ws + WS_WDN);
    X.tid = threadIdx.x; X.lane = X.tid & 63; X.wave = __builtin_amdgcn_readfirstlane(X.tid >> 6); X.G = gridDim.x; X.bid = blockIdx.x;

#if PROBE_DOUBLE
    for (int ph2 = args.ph_lo * 2; ph2 < args.ph_hi * 2; ++ph2) {
        const int ph = ph2 >> 1;
        const int layer = ph / 11, sub = ph % 11;
        const bool skip_ = (ph2 & 1) && !(ph < 22 && ((REPMASK >> sub) & 1));
#else
    volatile LAS unsigned* bst = (volatile LAS unsigned*)(lds + LDS_BYTES - 64);
    if (threadIdx.x < 2) bst[threadIdx.x] = 0u;
    __syncthreads();
    XcdBarrier gbar = xcd_barrier_post((unsigned*)(args.ws + WS_BAR), bst);
    for (int ph = args.ph_lo; ph < args.ph_hi; ++ph) {
        const int layer = ph / 11, sub = ph % 11;
        const bool skip_ = false;
#endif
        { int t_ = threadIdx.x; asm volatile("" : "+v"(t_)); X.tid = t_; X.lane = t_ & 63; }

        if (skip_) {
        } else if (ph == 22 && (PHMASK & 1024)) {
            const int gw = X.bid * 8 + X.wave, NGW = X.G * 8;
            (void)gw; (void)NGW; rms_pass(X, X.out, X.in[23], nullptr, X.out);
        } else if (sub == 0 && (PHMASK & 1)) {
            phase_prep(X, lds, layer);
        } else if (sub == 1 && (PHMASK & 2)) {
            pg8::Gemm g{X.P, X.Win, LDP, DM, DM}; pg8::StaticOrder S; S.init(T_TOK, 5120, X.G, X.bid);
            pg8::EpiInProj E{X.P, X.VT, X.ROPE, (bf16_t*)(X.ws + WS_BND)};
            pg8::gemm_phase<pg8::EpiInProj, true>(lds, g, S, E, X.tid);
        } else if (sub == 2 && (PHMASK & 4)) {
            phase_rwkv_pre(X, lds, layer);
        } else if (sub == 3 && (PHMASK & 4)) {
            phase_mixers(X, lds, layer);
        } else if (sub == 4 && (PHMASK & 8)) {
            phase_hgrn_post(X, layer);
            { const int gw = X.bid * 8 + X.wave, NGW = X.G * 8; const float* hh = (layer == 0) ? X.in[0] : X.out; const float* g = X.in[1] + (size_t)layer * DM;
              (void)gw; (void)NGW; rms_pass(X, hh, g, X.P, nullptr); }
        } else if (sub == 5 && (PHMASK & 16)) {
#pragma unroll 1
            for (int br = 0; br < 3; ++br) {
                { pg8::Gemm g{X.P, X.Wg + (size_t)br * DM * DM, LDP, DM, DM}; pg8::StaticOrder S; S.init(T_TOK, DM, X.G, X.bid);
                  int t_ = X.tid; asm volatile("" : "+v"(t_));
                  pg8::EpiGate E{X.P}; pg8::gemm_phase<pg8::EpiGate, true>(lds, g, S, E, t_); }
                { const int ycol = br == 0 ? COL_YA : (br == 1 ? COL_YB : COL_YC);
                  pg8::Gemm g{X.P + ycol, X.Wbr + (size_t)br * DM * 512, LDP, 512, 512}; pg8::StaticOrder S; S.init(T_TOK, DM, X.G, X.bid);
                  int t_ = X.tid; asm volatile("" : "+v"(t_));
                  pg8::EpiMergeAcc E{X.P, br == 0 ? 1 : 0}; pg8::gemm_phase<pg8::EpiMergeAcc, true>(lds, g, S, E, t_); }
            }
        } else if (sub == 6 && (PHMASK & 32)) {
            pg8::Gemm g{X.P + COL_MRG, X.Wo, LDP, DM, DM}; pg8::StaticOrder S; S.init(T_TOK, DM, X.G, X.bid);
            pg8::EpiResid E{layer == 0 ? X.in[0] : X.out, X.out};
            pg8::gemm_phase<pg8::EpiResid, true>(lds, g, S, E, X.tid);
        } else if (sub == 7 && (PHMASK & 64)) {
            const int gw = X.bid * 8 + X.wave, NGW = X.G * 8;
            const float* g = X.in[18] + (size_t)layer * DM;
            (void)gw; (void)NGW; rms_pass(X, X.out, g, X.P, nullptr);
        } else if (sub == 8 && (PHMASK & 128)) {
            pg8::Gemm g{X.P, X.Wup, LDP, DM, DM}; pg8::StaticOrder S; S.init(T_TOK, F2, X.G, X.bid);
            pg8::EpiUp E{X.P, X.HALO, X.in[20] + (size_t)layer * 3 * F2, X.in[21] + (size_t)layer * F2, (LAS float*)(lds + 131072)};
            pg8::gemm_phase<pg8::EpiUp, true>(lds, g, S, E, X.tid);
        } else if (sub == 9 && (PHMASK & 256)) {
            phase_fixup(X, layer);
        } else if (sub == 10 && (PHMASK & 512)) {
            pg8::Gemm g{X.P + COL_ACT, X.Wdn, LDP, DFF, DFF}; pg8::StaticOrder S; S.init(T_TOK, DM, X.G, X.bid);
            pg8::EpiResid E{X.out, X.out};
            pg8::gemm_phase<pg8::EpiResid, true>(lds, g, S, E, X.tid);
        }
#if PROBE_DOUBLE
        if (ph2 + 1 < args.ph_hi * 2) cg::this_grid().sync();
#else
        if (ph + 1 < args.ph_hi) { if (args.ph_hi > 1000) cg::this_grid().sync(); else xcd_barrier(gbar); }
#endif
    }
}

extern "C" void kernel_launch(void* const* d_in, const int* in_sizes, int n_in, void* d_out, int out_size, void* d_ws, size_t ws_size, hipStream_t stream) {
    static int grid = 0;
    if (grid == 0) {
        int dev = 0, cus = 0, per_cu = 0;
        (void)hipGetDevice(&dev);
        (void)hipDeviceGetAttribute(&cus, hipDeviceAttributeMultiprocessorCount, dev);
        if (hipFuncSetAttribute((const void*)mk_fwd, hipFuncAttributeMaxDynamicSharedMemorySize, LDS_BYTES) != hipSuccess) fprintf(stderr, "kernel_launch: hipFuncSetAttribute failed\n");
        if (hipOccupancyMaxActiveBlocksPerMultiprocessor(&per_cu, (const void*)mk_fwd, 512, LDS_BYTES) != hipSuccess || per_cu < 1) { fprintf(stderr, "kernel_launch: occupancy query gave %d\n", per_cu); per_cu = 1; }
        (void)hipGetLastError();
        grid = cus * 1;
        if (grid <= 0) grid = 256;
        if (ws_size < (size_t)268435456) fprintf(stderr, "kernel_launch: workspace too small (%zu)\n", ws_size);
    }
    Args a{};
    for (int i = 0; i < 24; ++i) a.in[i] = (const float*)d_in[i];
    a.out = (float*)d_out; a.ws = (unsigned char*)d_ws;
#if MK_SINGLE
    (void)hipMemsetAsync((char*)d_ws + WS_BAR, 0, 16384, stream);
    a.ph_lo = 0; a.ph_hi = 23;
    void* kargs[] = {&a};
    hipError_t e = hipLaunchCooperativeKernel((const void*)mk_fwd, dim3(grid), dim3(512), kargs, LDS_BYTES, stream);
    if (e != hipSuccess) fprintf(stderr, "cooperative launch failed: %s (grid %d)\n", hipGetErrorString(e), grid);
#else
    for (int ph = 0; ph < 23; ++ph) {
        a.ph_lo = ph; a.ph_hi = ph + 1;
        hipLaunchKernelGGL(mk_fwd, dim3(grid), dim3(512), LDS_BYTES, stream, a);
    }
#endif
}
```

```cpp
#include <hip/hip_runtime.h>
#include <hip/hip_cooperative_groups.h>
#include <cstdio>
#include <cstdint>
namespace cg = cooperative_groups;

#ifndef PHMASK
#define PHMASK 2047
#endif
#ifndef REPMASK
#define REPMASK 0
#endif
#ifndef PROBE_DOUBLE
#define PROBE_DOUBLE 0
#endif
#ifndef PROBE_SCAN2
#define PROBE_SCAN2 0
#endif
#ifndef TKMASK
#define TKMASK 7
#endif
#ifndef MK_SINGLE
#define MK_SINGLE 1
#endif

#define LAS __attribute__((address_space(3)))
typedef unsigned short bf16_t;
typedef short bf16x8 __attribute__((ext_vector_type(8)));
typedef float f32x4 __attribute__((ext_vector_type(4)));
typedef float f32x2 __attribute__((ext_vector_type(2)));
typedef unsigned u32x4 __attribute__((ext_vector_type(4)));
typedef unsigned u32x2 __attribute__((ext_vector_type(2)));

constexpr int T_TOK = 16384, SEQ = 2048, DM = 1024;
constexpr int LDP = 6208;
constexpr int COL_PA = 1024, COL_PB = 2816, COL_PC = 4864;
constexpr int COL_YA = 1024, COL_MRG = 1536, COL_G = 2816, COL_YB = 3840, COL_YC = 4864, COL_ACT = 1024;
constexpr int C_Q = 4864, C_K = 5376, C_QI = 5632, C_KI = 5888, C_WI = 5952;
constexpr int IN_COLS = 8004, DFF = 2816, F2 = 5632;
constexpr size_t WS_WIN = 0, WS_WG = 10485760, WS_WBR = 16777216, WS_WO = 19922944, WS_WUP = 22020096, WS_WDN = 33554432;
constexpr size_t WS_P = 39321600, WS_HALO = 242745344, WS_VT = WS_HALO, WS_ROPE = 265814016, WS_BAR = 266338304, WS_BND = WS_HALO + 4194304, WS_SCAL = WS_HALO + 8388608;
constexpr int LDS_BYTES = 153600;
constexpr int SCS = 2052;
constexpr int MASK_OFF = 16 * SCS * 4;

struct Args { const float* in[24]; float* out; unsigned char* ws; int ph_lo, ph_hi; };

__device__ __forceinline__ unsigned f2bf(float f) { unsigned u = __builtin_bit_cast(unsigned, f); return (u + 0x7fffu + ((u >> 16) & 1u)) >> 16; }
__device__ __forceinline__ unsigned pk2(float lo, float hi) { return f2bf(lo) | (f2bf(hi) << 16); }
__device__ __forceinline__ float bf2f(bf16_t b) { return __builtin_bit_cast(float, (unsigned)b << 16); }
__device__ __forceinline__ float bflo(unsigned w) { return __builtin_bit_cast(float, w << 16); }
__device__ __forceinline__ float bfhi(unsigned w) { return __builtin_bit_cast(float, w & 0xffff0000u); }
__device__ __forceinline__ float wave_sum(float v) {
#pragma unroll
    for (int o = 1; o < 64; o <<= 1) v += __shfl_xor(v, o);
    return v;
}
__device__ __forceinline__ int wave_sum_i(int v) {
#pragma unroll
    for (int o = 1; o < 64; o <<= 1) v += __shfl_xor(v, o);
    return v;
}
template <int CTRL> __device__ __forceinline__ float dpp_mov(float x) {
    return __builtin_bit_cast(float, __builtin_amdgcn_update_dpp(0, __builtin_bit_cast(int, x), CTRL, 0xF, 0xF, true));
}
__device__ __forceinline__ float red8(float x) { x += dpp_mov<0xB1>(x); x += dpp_mov<0x4E>(x); x += dpp_mov<0x141>(x); return x; }
__device__ __forceinline__ float red16(float x) { x = red8(x); x += dpp_mov<0x140>(x); return x; }
__device__ __forceinline__ float sigmoidf_(float x) { return 1.f / (1.f + __expf(-x)); }

namespace pg8 {
constexpr int BM = 256, BK = 64, HALF = 128, HTB = HALF * BK * 2, NXCD = 8, WGM = 8;
__device__ __forceinline__ int lds_byte(int r, int c) { const int st = (r >> 4) * 2 + (c >> 5), rr = r & 15, cc = c & 31, ob = rr * 64 + cc * 2; return st * 1024 + (ob ^ (((ob >> 9) & 1) << 5)); }
__device__ __forceinline__ void stage_rc(int b, int& R, int& C) { const int st = b / 1024, sb = b % 1024, swz = sb ^ (((sb >> 9) & 1) << 5); R = (st >> 1) * 16 + swz / 64; C = (st & 1) * 32 + (swz % 64) / 2; }
__device__ __forceinline__ int perm32(int rho) { const int n = rho >> 4, i = rho & 15; return 8 * (i >> 2) + 4 * n + (i & 3); }
struct Unit { int pm, pn; };
struct Gemm { const bf16_t* A; const bf16_t* Bt; int lda, ldb, K; };
struct StaticOrder {
    int nM, nN, nwg, G, c;
    __device__ void init(int M, int N, int G_, int c_) { nM = M / BM; nN = N / BM; nwg = nM * nN; G = G_; c = c_; }
    __device__ bool next(int i, Unit& u) const {
        const long L = (long)i * G + c; if (L >= nwg) return false;
        int wgid = (int)L; { const int q = nwg / NXCD, r = nwg % NXCD, xcd = wgid % NXCD, off = wgid / NXCD; wgid = (xcd < r ? xcd * (q + 1) : r * (q + 1) + (xcd - r) * q) + off; }
        const int nig = WGM * nN, gid = wgid / nig, fm = gid * WGM, gsz = (nM - fm) < WGM ? (nM - fm) : WGM;
        u.pm = fm + ((wgid % nig) % gsz); u.pn = (wgid % nig) / gsz; return true;
    }
};
__device__ __forceinline__ unsigned cvt_pk_bf16(float lo, float hi) { unsigned r; asm volatile("v_cvt_pk_bf16_f32 %0, %1, %2" : "=v"(r) : "v"(lo), "v"(hi)); return r; }

template <class Epi, bool ALIGN_EPI>
__device__ __forceinline__ void gemm_phase(LAS unsigned char* lds, const Gemm g, const StaticOrder& S, const Epi& E, const int tid) {
    const int wid = __builtin_amdgcn_readfirstlane(tid >> 6), lane = tid & 63, wr = wid >> 2, wc = wid & 3, fr = lane & 15, fq = lane >> 4;
    const int K = g.K, nt = K / BK;
    unsigned voffA[2], voffB[2];
#pragma unroll
    for (int i = 0; i < 2; ++i) { int R, C; stage_rc(tid * 16 + i * 8192, R, C); const int Rb = (R & ~31) + perm32(R & 31);
        voffA[i] = (unsigned)(R * g.lda + C) * 2u; voffB[i] = (unsigned)(Rb * g.ldb + C) * 2u; }
    const size_t kstep = (size_t)(BK * 2);
    const size_t hstepA = (size_t)HALF * g.lda * 2, hstepB = (size_t)HALF * g.ldb * 2;
    const size_t tstepA = 2 * hstepA, tstepB = 2 * hstepB;
    const unsigned ldsw = (unsigned)wid * 1024u;
    const int aoff = lds_byte(wr * 64 + fr, fq * 8), boff = lds_byte(wc * 32 + fr, fq * 8);
#define PG8_SA(b, h) (((b) * 2 + (h)) * HTB)
#define PG8_SB(b, h) ((4 + (b) * 2 + (h)) * HTB)
#define PG8_STAGE(bufoff, gbase, voff) do { _Pragma("unroll") for (int _i = 0; _i < 2; ++_i) \
        __builtin_amdgcn_global_load_lds((const unsigned*)((const char*)(gbase) + (voff)[_i]), (LAS unsigned*)(lds + (bufoff) + ldsw + _i * 8192), 16, 0, 0); } while (0)
#define PG8_LDA(dst, b, h) do { _Pragma("unroll") for (int m = 0; m < 4; ++m) _Pragma("unroll") for (int k = 0; k < 2; ++k) dst[m][k] = *(const LAS bf16x8*)(lds + PG8_SA(b, h) + aoff + m * 2048 + k * 1024); } while (0)
#define PG8_LDB(dst, b, h) do { _Pragma("unroll") for (int n = 0; n < 2; ++n) _Pragma("unroll") for (int k = 0; k < 2; ++k) dst[n][k] = *(const LAS bf16x8*)(lds + PG8_SB(b, h) + boff + n * 2048 + k * 1024); } while (0)
#define PG8_MMA(ai, bj, At, Bt) do { __builtin_amdgcn_s_setprio(1); _Pragma("unroll") for (int m = 0; m < 4; ++m) _Pragma("unroll") for (int n = 0; n < 2; ++n) _Pragma("unroll") for (int k = 0; k < 2; ++k) \
        acc[ai][bj][m][n] = __builtin_amdgcn_mfma_f32_16x16x32_bf16(Bt[n][k], At[m][k], acc[ai][bj][m][n], 0, 0, 0); __builtin_amdgcn_s_setprio(0); } while (0)
#define PG8_WAIT_V(n) asm volatile("s_waitcnt vmcnt(" #n ")" ::: "memory")
#define PG8_WAIT_L(n) asm volatile("s_waitcnt lgkmcnt(" #n ")" ::: "memory")
#define PG8_BAR __builtin_amdgcn_s_barrier()
#define PG8_SCHED __builtin_amdgcn_sched_barrier(0)
    Unit cur, nxt; int ui = 0;
    if (!S.next(0, cur)) return;
    f32x4 acc[2][2][4][2];
#pragma unroll
    for (int a = 0; a < 2; ++a)
#pragma unroll
        for (int b = 0; b < 2; ++b)
#pragma unroll
            for (int m = 0; m < 4; ++m)
#pragma unroll
                for (int n = 0; n < 2; ++n) acc[a][b][m][n] = (f32x4){0.f, 0.f, 0.f, 0.f};
    bf16x8 At[4][2], B0[2][2], B1[2][2];
    const char* cA = (const char*)g.A + (size_t)cur.pm * tstepA; const char* cB = (const char*)g.Bt + (size_t)cur.pn * tstepB;
    PG8_STAGE(PG8_SB(0, 0), cB, voffB); PG8_STAGE(PG8_SB(0, 1), cB + hstepB, voffB); PG8_STAGE(PG8_SA(0, 0), cA, voffA); PG8_STAGE(PG8_SA(0, 1), cA + hstepA, voffA);
    if (wr == 1) PG8_BAR;
    PG8_WAIT_V(2); PG8_BAR;
    PG8_STAGE(PG8_SB(1, 0), cB + kstep, voffB); PG8_STAGE(PG8_SA(1, 0), cA + kstep, voffA); PG8_STAGE(PG8_SB(1, 1), cB + hstepB + kstep, voffB);
    PG8_WAIT_V(6); PG8_BAR;
    for (;;) {
        const bool has_next = S.next(ui + 1, nxt);
        const char* nA = has_next ? (const char*)g.A + (size_t)nxt.pm * tstepA : cA; const char* nB = has_next ? (const char*)g.Bt + (size_t)nxt.pn * tstepB : cB;
        for (int t = 0; t < nt; t += 2) {
            const bool last = (t == nt - 2);
            const char* a1 = cA + (size_t)(t + 1) * kstep;
            const char* a2 = last ? nA : cA + (size_t)(t + 2) * kstep; const char* b2 = last ? nB : cB + (size_t)(t + 2) * kstep;
            const char* a3 = a2 + kstep; const char* b3 = b2 + kstep;
            PG8_LDB(B0, 0, 0); PG8_LDB(B1, 0, 1); PG8_SCHED; PG8_LDA(At, 0, 0); PG8_STAGE(PG8_SA(1, 1), a1 + hstepA, voffA);
            PG8_WAIT_V(8); PG8_WAIT_L(0); PG8_BAR; PG8_MMA(0, 0, At, B0); PG8_MMA(0, 1, At, B1); PG8_BAR; PG8_SCHED;
            PG8_LDA(At, 0, 1); PG8_STAGE(PG8_SB(0, 0), b2, voffB); PG8_STAGE(PG8_SB(0, 1), b2 + hstepB, voffB); PG8_STAGE(PG8_SA(0, 0), a2, voffA);
            PG8_WAIT_V(8); PG8_WAIT_L(0); PG8_BAR; PG8_MMA(1, 0, At, B0); PG8_MMA(1, 1, At, B1); PG8_BAR; PG8_SCHED;
            PG8_LDB(B0, 1, 0); PG8_LDB(B1, 1, 1); PG8_SCHED; PG8_LDA(At, 1, 0); PG8_STAGE(PG8_SA(0, 1), a2 + hstepA, voffA);
            PG8_WAIT_V(8); PG8_WAIT_L(0); PG8_BAR; PG8_MMA(0, 0, At, B0); PG8_MMA(0, 1, At, B1); PG8_BAR; PG8_SCHED;
            PG8_LDA(At, 1, 1); PG8_STAGE(PG8_SB(1, 0), b3, voffB); PG8_STAGE(PG8_SB(1, 1), b3 + hstepB, voffB); PG8_STAGE(PG8_SA(1, 0), a3, voffA);
            PG8_WAIT_V(8); PG8_WAIT_L(0); PG8_BAR; PG8_MMA(1, 0, At, B0); PG8_MMA(1, 1, At, B1); PG8_BAR; PG8_SCHED;
        }
        if constexpr (ALIGN_EPI) { if (wr == 0) PG8_BAR; }
        E(acc, cur, wr, wc, fr, fq);
        if (!has_next) break;
#pragma unroll
        for (int a = 0; a < 2; ++a)
#pragma unroll
            for (int b = 0; b < 2; ++b)
#pragma unroll
                for (int m = 0; m < 4; ++m)
#pragma unroll
                    for (int n = 0; n < 2; ++n) acc[a][b][m][n] = (f32x4){0.f, 0.f, 0.f, 0.f};
        cur = nxt; cA = nA; cB = nB; ++ui;
        if constexpr (ALIGN_EPI) { if (wr == 1) PG8_BAR; }
    }
    PG8_WAIT_V(0);
    if constexpr (!ALIGN_EPI) { if (wr == 0) PG8_BAR; }
    PG8_BAR;
#undef PG8_SA
#undef PG8_SB
#undef PG8_STAGE
#undef PG8_LDA
#undef PG8_LDB
#undef PG8_MMA
#undef PG8_WAIT_V
#undef PG8_WAIT_L
#undef PG8_BAR
#undef PG8_SCHED
}

typedef f32x4 AccT[2][2][4][2];

struct EpiInProj {
    bf16_t* P; bf16_t* VT; const float* rope; bf16_t* BND;
    __device__ __forceinline__ void operator()(AccT& acc, const Unit& u, int wr, int wc, int fr, int fq) const {
        const int row0 = u.pm * BM + wr * 64 + fr, colb = u.pn * BM + wc * 32 + 8 * fq;
#pragma unroll
        for (int ai = 0; ai < 2; ++ai)
#pragma unroll
            for (int m = 0; m < 4; ++m) {
                const int row = row0 + ai * HALF + m * 16, t = row & (SEQ - 1);
                bf16_t* rowp = P + (size_t)row * LDP + COL_PA;
#pragma unroll
                for (int bj = 0; bj < 2; ++bj) {
                    const int c = colb + bj * HALF;
                    f32x4 v0 = acc[ai][bj][m][0], v1 = acc[ai][bj][m][1];
                    if (u.pn >= 15) {
                        const int cl = c - 3840;
                        if (cl < 640 || (cl >= 768 && cl < 1088)) {
                            const float* cs = rope + ((size_t)t * 32 + ((cl & 63) >> 1)) * 2;
                            const f32x4 r0 = *(const f32x4*)cs, r1 = *(const f32x4*)(cs + 4);
                            f32x4 o0, o1;
                            o0[0] = v0[0] * r0[0] - v0[1] * r0[1]; o0[1] = v0[1] * r0[0] + v0[0] * r0[1];
                            o0[2] = v0[2] * r0[2] - v0[3] * r0[3]; o0[3] = v0[3] * r0[2] + v0[2] * r0[3];
                            o1[0] = v1[0] * r1[0] - v1[1] * r1[1]; o1[1] = v1[1] * r1[0] + v1[0] * r1[1];
                            o1[2] = v1[2] * r1[2] - v1[3] * r1[3]; o1[3] = v1[3] * r1[2] + v1[2] * r1[3];
                            v0 = o0; v1 = o1;
                        }
                    }
                    u32x4 w; w.x = cvt_pk_bf16(v0[0], v0[1]); w.y = cvt_pk_bf16(v0[2], v0[3]); w.z = cvt_pk_bf16(v1[0], v1[1]); w.w = cvt_pk_bf16(v1[2], v1[3]);
                    *(u32x4*)(rowp + c) = w;
                    if (u.pn < 7 && fr == 15) *(u32x4*)(BND + (size_t)(row >> 4) * 1792 + c) = w;
                    if (u.pn == 17 && bj == 1) {
                        const int cv = c - 3840 - 640, b = row >> 11;
                        bf16_t* vt = VT + ((size_t)(b * 2 + (cv >> 6)) * 64 + (cv & 63)) * SEQ + t;
                        vt[0 * SEQ] = (bf16_t)(w.x & 0xffffu); vt[1 * SEQ] = (bf16_t)(w.x >> 16);
                        vt[2 * SEQ] = (bf16_t)(w.y & 0xffffu); vt[3 * SEQ] = (bf16_t)(w.y >> 16);
                        vt[4 * SEQ] = (bf16_t)(w.z & 0xffffu); vt[5 * SEQ] = (bf16_t)(w.z >> 16);
                        vt[6 * SEQ] = (bf16_t)(w.w & 0xffffu); vt[7 * SEQ] = (bf16_t)(w.w >> 16);
                    }
                }
            }
    }
};
struct EpiGate {
    bf16_t* P;
    __device__ __forceinline__ void operator()(AccT& acc, const Unit& u, int wr, int wc, int fr, int fq) const {
        const int row0 = u.pm * BM + wr * 64 + fr, colb = u.pn * BM + wc * 32 + 8 * fq;
#pragma unroll
        for (int ai = 0; ai < 2; ++ai)
#pragma unroll
            for (int m = 0; m < 4; ++m) {
                bf16_t* rowp = P + (size_t)(row0 + ai * HALF + m * 16) * LDP + COL_G + colb;
#pragma unroll
                for (int bj = 0; bj < 2; ++bj) {
                    const f32x4 v0 = acc[ai][bj][m][0], v1 = acc[ai][bj][m][1];
                    u32x4 w; w.x = cvt_pk_bf16(sigmoidf_(v0[0]), sigmoidf_(v0[1])); w.y = cvt_pk_bf16(sigmoidf_(v0[2]), sigmoidf_(v0[3]));
                    w.z = cvt_pk_bf16(sigmoidf_(v1[0]), sigmoidf_(v1[1])); w.w = cvt_pk_bf16(sigmoidf_(v1[2]), sigmoidf_(v1[3]));
                    *(u32x4*)(rowp + bj * HALF) = w;
                }
            }
    }
};
struct EpiMergeAcc {
    bf16_t* P; int first;
    __device__ __forceinline__ void operator()(AccT& acc, const Unit& u, int wr, int wc, int fr, int fq) const {
        const int row0 = u.pm * BM + wr * 64 + fr, colb = u.pn * BM + wc * 32 + 8 * fq;
#pragma unroll
        for (int ai = 0; ai < 2; ++ai)
#pragma unroll
            for (int m = 0; m < 4; ++m) {
                bf16_t* rowb = P + (size_t)(row0 + ai * HALF + m * 16) * LDP + colb;
#pragma unroll
                for (int bj = 0; bj < 2; ++bj) {
                    const f32x4 v0 = acc[ai][bj][m][0], v1 = acc[ai][bj][m][1];
                    unsigned long long* gp = (unsigned long long*)(rowb + COL_G + bj * HALF);
                    unsigned long long* mp = (unsigned long long*)(rowb + COL_MRG + bj * HALF);
                    const unsigned long long g0 = __hip_atomic_load(gp, __ATOMIC_RELAXED, __HIP_MEMORY_SCOPE_AGENT), g1 = __hip_atomic_load(gp + 1, __ATOMIC_RELAXED, __HIP_MEMORY_SCOPE_AGENT);
                    unsigned long long m0 = 0ull, m1 = 0ull;
                    if (!first) { m0 = __hip_atomic_load(mp, __ATOMIC_RELAXED, __HIP_MEMORY_SCOPE_AGENT); m1 = __hip_atomic_load(mp + 1, __ATOMIC_RELAXED, __HIP_MEMORY_SCOPE_AGENT); }
                    const unsigned ga = (unsigned)g0, gb = (unsigned)(g0 >> 32), gc = (unsigned)g1, gd = (unsigned)(g1 >> 32);
                    const unsigned ma = (unsigned)m0, mb = (unsigned)(m0 >> 32), mc = (unsigned)m1, md = (unsigned)(m1 >> 32);
                    u32x4 w;
                    w.x = cvt_pk_bf16(bflo(ma) + bflo(ga) * v0[0], bfhi(ma) + bfhi(ga) * v0[1]);
                    w.y = cvt_pk_bf16(bflo(mb) + bflo(gb) * v0[2], bfhi(mb) + bfhi(gb) * v0[3]);
                    w.z = cvt_pk_bf16(bflo(mc) + bflo(gc) * v1[0], bfhi(mc) + bfhi(gc) * v1[1]);
                    w.w = cvt_pk_bf16(bflo(md) + bflo(gd) * v1[2], bfhi(md) + bfhi(gd) * v1[3]);
                    *(u32x4*)(rowb + COL_MRG + bj * HALF) = w;
                }
            }
    }
};
struct EpiResid {
    const float* base; float* out;
    __device__ __forceinline__ void operator()(AccT& acc, const Unit& u, int wr, int wc, int fr, int fq) const {
        const int row0 = u.pm * BM + wr * 64 + fr, colb = u.pn * BM + wc * 32 + 8 * fq;
#pragma unroll
        for (int ai = 0; ai < 2; ++ai)
#pragma unroll
            for (int m = 0; m < 4; ++m) {
                const size_t off = (size_t)(row0 + ai * HALF + m * 16) * DM + colb;
#pragma unroll
                for (int bj = 0; bj < 2; ++bj) {
                    const f32x4 b0 = *(const f32x4*)(base + off + bj * HALF), b1 = *(const f32x4*)(base + off + bj * HALF + 4);
                    *(f32x4*)(out + off + bj * HALF) = b0 + acc[ai][bj][m][0];
                    *(f32x4*)(out + off + bj * HALF + 4) = b1 + acc[ai][bj][m][1];
                }
            }
    }
};
struct EpiUp {
    bf16_t* P; float* HALO; const float* cw; const float* cb; LAS float* CW;
    __device__ __forceinline__ void operator()(AccT& acc, const Unit& u, int wr, int wc, int fr_in, int fq_in) const {
        int fr = fr_in, fq = fq_in;
        asm volatile("" : "+v"(fr), "+v"(fq));
        const int row0 = u.pm * BM + wr * 64 + fr;
        const int jb = u.pn * 128 + wc * 32 + 8 * fq;
        {
            const int tl = (wr * 4 + wc) * 64 + fq * 16 + fr;
#pragma unroll
            for (int it = 0; it < 2; ++it) { const int k = tl + 512 * it, p = k >> 8, col = k & 255, co = (col >> 7) * DFF + u.pn * 128 + (col & 127);
                CW[k] = (p < 3) ? cw[p * F2 + co] : cb[co]; }
            asm volatile("s_waitcnt lgkmcnt(0)" ::: "memory"); __builtin_amdgcn_s_barrier(); asm volatile("" ::: "memory");
        }
#pragma unroll
        for (int ai = 0; ai < 2; ++ai) {
            const int s = u.pm * 4 + ai * 2 + wr;
#pragma unroll
            for (int bj = 0; bj < 2; ++bj)
#pragma unroll
                for (int n = 0; n < 2; ++n) {
                    const int colp = u.pn * BM + bj * HALF + wc * 32 + 8 * fq + 4 * n;
                    if (fr < 2) *(f32x4*)(HALO + (size_t)(s * 4 + fr) * F2 + colp) = acc[ai][bj][0][n];
                    if (fr >= 14) *(f32x4*)(HALO + (size_t)(s * 4 + fr - 12) * F2 + colp) = acc[ai][bj][3][n];
                }
        }
#pragma unroll
        for (int ai = 0; ai < 2; ++ai)
#pragma unroll
            for (int m = 0; m < 4; ++m) {
                const int row = row0 + ai * HALF + m * 16;
#pragma unroll
                for (int n = 0; n < 2; ++n) {
                    f32x4 cv[2];
#pragma unroll
                    for (int bj = 0; bj < 2; ++bj) {
                        const int cl = bj * 128 + wc * 32 + 8 * fq + 4 * n;
                        const f32x4 w0 = *(const LAS f32x4*)&CW[cl], w1 = *(const LAS f32x4*)&CW[256 + cl], w2 = *(const LAS f32x4*)&CW[512 + cl], bb = *(const LAS f32x4*)&CW[768 + cl];
#pragma unroll
                        for (int e = 0; e < 4; ++e) {
                            const float cur = acc[ai][bj][m][n][e];
                            const float prv = m > 0 ? acc[ai][bj][m > 0 ? m - 1 : 0][n][e] : 0.f;
                            const float a1 = dpp_mov<0x121>(cur), a2 = dpp_mov<0x122>(cur), b1 = dpp_mov<0x121>(prv), b2 = dpp_mov<0x122>(prv);
                            const float p1 = fr >= 1 ? a1 : b1, p2 = fr >= 2 ? a2 : b2;
                            cv[bj][e] = bb[e] + w0[e] * p2 + w1[e] * p1 + w2[e] * cur;
                        }
                        __builtin_amdgcn_sched_barrier(0);
                    }
                    const f32x4 g0 = cv[0], v0 = cv[1];
                    u32x2 w;
                    w.x = cvt_pk_bf16(g0[0] * sigmoidf_(g0[0]) * v0[0], g0[1] * sigmoidf_(g0[1]) * v0[1]);
                    w.y = cvt_pk_bf16(g0[2] * sigmoidf_(g0[2]) * v0[2], g0[3] * sigmoidf_(g0[3]) * v0[3]);
                    if (!(m == 0 && fr < 2)) *(u32x2*)(P + (size_t)row * LDP + COL_ACT + jb + 4 * n) = w;
                    __builtin_amdgcn_sched_barrier(0);
                }
            }
    }
};
}

struct Ctx {
    const float* in[24]; float* out; unsigned char* ws;
    bf16_t* P; bf16_t* VT; float* HALO; float* ROPE;
    bf16_t *Win, *Wg, *Wbr, *Wo, *Wup, *Wdn;
    int tid, lane, wave, G, bid;
};

__device__ __forceinline__ int srccol(int mode, int n) {
    if (mode == 0) return n;
    if (mode == 2) return 4932 + n;
    if (mode == 3) { const int tile = n >> 8, w = n & 255, j = tile * 128 + (w & 127); return (w < 128) ? j : DFF + j; }
    if (n < 3840) return n;
    const int c = n - 3840;
    if (c >= 1092) return -1;
    if (c < 640 || (c >= 768 && c < 1088)) { const int base = c & ~63, i = c & 63; return 3840 + base + (i >> 1) + 32 * (i & 1); }
    return 3840 + c;
}
__device__ __forceinline__ void tr_item(const float* W, int ldw, int K, int N, bf16_t* WT, int mode, int item, LAS float* scr, int lane) {
    const int nblk = N / 32, kb = item / nblk, nb = item % nblk, k0 = 64 * kb, n0 = 32 * nb;
    const int sc = srccol(mode, n0 + (lane & 31));
    float wv_[32];
#pragma unroll
    for (int i = 0; i < 32; ++i) { const int kk = 2 * i + (lane >> 5); wv_[i] = (sc >= 0) ? W[(size_t)(k0 + kk) * ldw + sc] : 0.f; }
#pragma unroll
    for (int i = 0; i < 32; ++i) { const int kk = 2 * i + (lane >> 5); scr[kk * 33 + (lane & 31)] = wv_[i]; }
    asm volatile("s_waitcnt lgkmcnt(0)" ::: "memory");
    const int c = lane & 7;
#pragma unroll
    for (int j = 0; j < 4; ++j) { const int n = (lane >> 3) + 8 * j; const LAS float* s = scr + (8 * c) * 33 + n;
        u32x4 o; o.x = pk2(s[0 * 33], s[1 * 33]); o.y = pk2(s[2 * 33], s[3 * 33]); o.z = pk2(s[4 * 33], s[5 * 33]); o.w = pk2(s[6 * 33], s[7 * 33]);
        *(u32x4*)(WT + (size_t)(n0 + n) * K + k0 + 8 * c) = o; }
    asm volatile("s_waitcnt lgkmcnt(0)" ::: "memory");
}
__device__ __forceinline__ void rms_row(const float* xrow, const float* g, bf16_t* obf, float* of32, int lane) {
    const f32x4* xr = (const f32x4*)xrow + lane; const f32x4* gr = (const f32x4*)g + lane;
    f32x4 v[4]; float s = 0.f;
#pragma unroll
    for (int j = 0; j < 4; ++j) { v[j] = xr[64 * j]; s += (v[j].x * v[j].x + v[j].y * v[j].y) + (v[j].z * v[j].z + v[j].w * v[j].w); }
    const float rs = 1.f / sqrtf(wave_sum(s) * (1.f / DM) + 1e-6f);
#pragma unroll
    for (int j = 0; j < 4; ++j) {
        const f32x4 gg = gr[64 * j]; const f32x4 o = v[j] * rs * gg;
        if (obf) { u32x2 w; w.x = pk2(o.x, o.y); w.y = pk2(o.z, o.w); *((u32x2*)obf + lane + 64 * j) = w; }
        else *((f32x4*)of32 + lane + 64 * j) = o;
    }
}
__device__ __forceinline__ void rms_pass(const Ctx& X, const float* src, const float* g, bf16_t* obf, float* of32) {
    const int gw = X.bid * 8 + X.wave, NGW = X.G * 8, lane = X.lane;
    const f32x4* gr = (const f32x4*)g + lane;
    f32x4 gg[4];
#pragma unroll
    for (int j = 0; j < 4; ++j) gg[j] = gr[64 * j];
#pragma unroll 1
    for (int m = gw; m < T_TOK; m += 4 * NGW) {
        f32x4 v[4][4]; float ss[4]; int mr[4];
#pragma unroll
        for (int r = 0; r < 4; ++r) { mr[r] = m + r * NGW; const int ml = mr[r] < T_TOK ? mr[r] : m; const f32x4* x = (const f32x4*)(src + (size_t)ml * DM) + lane;
#pragma unroll
            for (int j = 0; j < 4; ++j) v[r][j] = x[64 * j]; }
#pragma unroll
        for (int r = 0; r < 4; ++r) { float a = 0.f;
#pragma unroll
            for (int j = 0; j < 4; ++j) a += (v[r][j].x * v[r][j].x + v[r][j].y * v[r][j].y) + (v[r][j].z * v[r][j].z + v[r][j].w * v[r][j].w);
            ss[r] = 1.f / sqrtf(wave_sum(a) * (1.f / DM) + 1e-6f); }
#pragma unroll
        for (int r = 0; r < 4; ++r) {
            if (mr[r] < T_TOK) {
#pragma unroll
                for (int j = 0; j < 4; ++j) {
                    const f32x4 o = v[r][j] * ss[r] * gg[j];
                    if (obf) { u32x2 w; w.x = pk2(o.x, o.y); w.y = pk2(o.z, o.w); *((u32x2*)(obf + (size_t)mr[r] * LDP) + lane + 64 * j) = w; }
                    else *((f32x4*)(of32 + (size_t)mr[r] * DM) + lane + 64 * j) = o;
                }
            }
        }
    }
}
__device__ __forceinline__ void phase_prep(const Ctx& X, LAS unsigned char* lds, int layer) {
    LAS float* scr = (LAS float*)(lds + X.wave * 8448);
    const int gw = X.bid * 8 + X.wave, NGW = X.G * 8;
    constexpr int I_IN = 16 * 160, I_G = 16 * 96, I_BR = 8 * 32, I_O = 16 * 32, I_UP = 16 * 176, I_DN = 44 * 32;
    constexpr int NITEMS = I_IN + I_G + 3 * I_BR + I_O + I_UP + I_DN;
    const float* w_in = X.in[2] + (size_t)layer * DM * IN_COLS;
    const float* w_br = X.in[16] + (size_t)layer * 3 * 512 * DM;
    const float* w_o = X.in[17] + (size_t)layer * DM * DM;
    const float* w_up = X.in[19] + (size_t)layer * DM * F2;
    const float* w_dn = X.in[22] + (size_t)layer * DFF * DM;
    for (int it = gw; it < NITEMS; it += NGW) {
        int r = it;
        if (r < I_IN) { tr_item(w_in, IN_COLS, DM, 5120, X.Win, 1, r, scr, X.lane); continue; } r -= I_IN;
        if (r < I_G) { tr_item(w_in, IN_COLS, DM, 3072, X.Wg, 2, r, scr, X.lane); continue; } r -= I_G;
        if (r < 3 * I_BR) { const int b = r / I_BR; tr_item(w_br + (size_t)b * 512 * DM, DM, 512, DM, X.Wbr + (size_t)b * DM * 512, 0, r % I_BR, scr, X.lane); continue; } r -= 3 * I_BR;
        if (r < I_O) { tr_item(w_o, DM, DM, DM, X.Wo, 0, r, scr, X.lane); continue; } r -= I_O;
        if (r < I_UP) { tr_item(w_up, F2, DM, F2, X.Wup, 3, r, scr, X.lane); continue; } r -= I_UP;
        tr_item(w_dn, DM, DFF, DM, X.Wdn, 0, r, scr, X.lane);
    }
    const float* h = (layer == 0) ? X.in[0] : X.out;
    const float* g = X.in[1] + (size_t)layer * DM;
    rms_pass(X, h, g, X.P, nullptr);
    if (layer == 0) {
        for (int idx = X.bid * 512 + X.tid; idx < SEQ * 32; idx += X.G * 512) {
            const int t = idx >> 5, p = idx & 31;
            const float inv = exp2f(-(float)p * 0.03125f * 13.287712379549449f);
            const float ang = (float)t * inv;
            const double rev = (double)ang * 0.15915494309189535;
            const float fr = (float)(rev - floor(rev));
            X.ROPE[2 * idx] = __builtin_amdgcn_cosf(fr); X.ROPE[2 * idx + 1] = __builtin_amdgcn_sinf(fr);
        }
    }
}

__device__ __forceinline__ float wave_sum_fast(float x) {
    x = red16(x);
    const float r0 = __builtin_bit_cast(float, __builtin_amdgcn_readlane(__builtin_bit_cast(int, x), 0)), r1 = __builtin_bit_cast(float, __builtin_amdgcn_readlane(__builtin_bit_cast(int, x), 16));
    const float r2 = __builtin_bit_cast(float, __builtin_amdgcn_readlane(__builtin_bit_cast(int, x), 32)), r3 = __builtin_bit_cast(float, __builtin_amdgcn_readlane(__builtin_bit_cast(int, x), 48));
    return (r0 + r1) + (r2 + r3);
}
#define LDS_BAR() do { asm volatile("s_waitcnt lgkmcnt(0)" ::: "memory"); __builtin_amdgcn_s_barrier(); asm volatile("" ::: "memory"); } while (0)
constexpr int RW_TS = 16, RW_NCH = SEQ / RW_TS, RW_BUF = 33280;
__device__ __forceinline__ void phase_rwkv_pre(const Ctx& X, LAS unsigned char* lds, int layer) {
    LAS float* Rr = (LAS float*)(lds);           LAS float* Kk = (LAS float*)(lds + 8192);   LAS float* Vv = (LAS float*)(lds + 16384);
    LAS float* W1 = (LAS float*)(lds + 24576);   LAS float* AS = (LAS float*)(lds + 32768);
    LAS bf16_t* WDb = (LAS bf16_t*)(lds + 40960);
    LAS bf16_t* ADb = (LAS bf16_t*)(lds + 45568);
    LAS bf16_t* WTu = (LAS bf16_t*)(lds + 50176);
    LAS bf16_t* WTa = (LAS bf16_t*)(lds + 59392);
    LAS float* MU = (LAS float*)(lds + 68608);
    const int tid = X.tid, lane = tid & 63, wv = X.wave;
    const float* mu = X.in[3] + layer * 1792;
    const float* w0 = X.in[4] + layer * 512;   const float* w_up = X.in[5] + (size_t)layer * 64 * 512;
    const float* a0 = X.in[6] + layer * 512;   const float* a_up = X.in[7] + (size_t)layer * 64 * 512;
    const float* k_k = X.in[9] + layer * 512;  const float* k_a = X.in[10] + layer * 512;  const float* r_k = X.in[11] + layer * 512;
    const bf16_t* BND = (const bf16_t*)(X.ws + WS_BND);
    float* SCAL = (float*)(X.ws + WS_SCAL);
    const int ln = lane & 15, lg = lane >> 4;
    int last_h = -1;
    float p_kk = 0.f, p_ka = 0.f, p_rk = 0.f, q_w0 = 0.f, q_a0 = 0.f;
    const int c = tid & 63, tg = tid >> 6;
    u32x4 pc4[3], pp4[3]; bool have_pf = false;
    pc4[0] = pc4[1] = pc4[2] = pp4[0] = pp4[1] = pp4[2] = (u32x4){0u, 0u, 0u, 0u};
#define PRE_LOAD(uu) do { const int h_ = (uu) & 7, tp_ = (uu) >> 3; _Pragma("unroll") for (int it = 0; it < 3; ++it) { const int idx = tid + 512 * it; pc4[it] = (u32x4){0u, 0u, 0u, 0u}; pp4[it] = (u32x4){0u, 0u, 0u, 0u}; \
        if (idx < 32 * 40) { const int tt = idx / 40, vv = idx - tt * 40; \
            const int col = vv < 8 ? h_ * 64 + 8 * vv : (vv < 16 ? 512 + h_ * 64 + 8 * (vv - 8) : (vv < 24 ? 1024 + h_ * 64 + 8 * (vv - 16) : 1536 + 8 * (vv - 24))); \
            const size_t row = (size_t)tp_ * 32 + tt; pc4[it] = *(const u32x4*)(X.P + row * LDP + COL_PA + col); \
            if (tt > 0) pp4[it] = *(const u32x4*)(X.P + (row - 1) * LDP + COL_PA + col); else if ((tp_ & 63) != 0) pp4[it] = *(const u32x4*)(BND + (size_t)(2 * tp_ - 1) * 1792 + col); } } } while (0)
#pragma unroll 1
    for (int u = X.bid; u < 4096; u += X.G) {
        const int h = u & 7, tp = u >> 3, hc = h * 64 + c;
        if (h != last_h) {
            __syncthreads();
            for (int idx = tid; idx < 64 * 64; idx += 512) { const int m = idx >> 6, cc = idx & 63;
                WTu[cc * 72 + m] = (bf16_t)f2bf(w_up[m * 512 + h * 64 + cc]); WTa[cc * 72 + m] = (bf16_t)f2bf(a_up[m * 512 + h * 64 + cc]); }
            if (tid < 320) { const int cc = tid; const int col = cc < 64 ? h * 64 + cc : (cc < 128 ? 512 + h * 64 + cc - 64 : (cc < 192 ? 1024 + h * 64 + cc - 128 : 1536 + cc - 192)); MU[cc] = mu[col]; }
            p_kk = k_k[hc]; p_ka = k_a[hc]; p_rk = r_k[hc];
            q_w0 = w0[h * 64 + 16 * (wv >> 1) + ln]; q_a0 = a0[h * 64 + 16 * (wv >> 1) + ln];
            last_h = h;
            __syncthreads();
        }
        if (!have_pf) { PRE_LOAD(u); }
#pragma unroll
        for (int it = 0; it < 3; ++it) {
            const int idx = tid + 512 * it;
            if (idx < 32 * 40) {
                const int tt = idx / 40, vv = idx - tt * 40, cc0 = 8 * vv;
                const u32x4 c4 = pc4[it], p4 = pp4[it];
                const f32x4 m0 = *(const LAS f32x4*)&MU[cc0], m1 = *(const LAS f32x4*)&MU[cc0 + 4];
                float cur[8], prv[8], val[8];
                cur[0] = bflo(c4.x); cur[1] = bfhi(c4.x); cur[2] = bflo(c4.y); cur[3] = bfhi(c4.y); cur[4] = bflo(c4.z); cur[5] = bfhi(c4.z); cur[6] = bflo(c4.w); cur[7] = bfhi(c4.w);
                prv[0] = bflo(p4.x); prv[1] = bfhi(p4.x); prv[2] = bflo(p4.y); prv[3] = bfhi(p4.y); prv[4] = bflo(p4.z); prv[5] = bfhi(p4.z); prv[6] = bflo(p4.w); prv[7] = bfhi(p4.w);
#pragma unroll
                for (int e = 0; e < 8; ++e) val[e] = cur[e] + (prv[e] - cur[e]) * (e < 4 ? m0[e & 3] : m1[e & 3]);
                if (vv < 24) {
#pragma unroll
                    for (int e = 0; e < 8; ++e) val[e] = bf2f((bf16_t)f2bf(val[e]));
                    LAS float* dst = (vv < 8 ? Rr : (vv < 16 ? Kk : Vv)) + tt * 64 + 8 * (vv & 7);
                    *(LAS f32x4*)dst = (f32x4){val[0], val[1], val[2], val[3]}; *(LAS f32x4*)(dst + 4) = (f32x4){val[4], val[5], val[6], val[7]};
                } else {
                    const int lr0 = 8 * (vv - 24);
                    LAS bf16_t* dst;
                    if (lr0 < 64) { dst = WDb + tt * 72 + lr0;
#pragma unroll
                        for (int e = 0; e < 8; ++e) { const float ex = __expf(2.f * val[e]); val[e] = 1.f - 2.f / (ex + 1.f); } }
                    else dst = ADb + tt * 72 + lr0 - 64;
                    u32x4 o; o.x = pk2(val[0], val[1]); o.y = pk2(val[2], val[3]); o.z = pk2(val[4], val[5]); o.w = pk2(val[6], val[7]);
                    *(LAS u32x4*)dst = o;
                }
            }
        }
        have_pf = false;
        if (u + X.G < 4096 && ((u + X.G) & 7) == h) { PRE_LOAD(u + X.G); have_pf = true; }
        LDS_BAR();
        {
            const int mt = wv & 1, nt = wv >> 1, chm = 16 * nt + ln;
            f32x4 cw_ = (f32x4){0.f, 0.f, 0.f, 0.f}, ca_ = cw_;
#pragma unroll
            for (int ks = 0; ks < 2; ++ks) {
                const bf16x8 xa = *(const LAS bf16x8*)&WDb[(16 * mt + ln) * 72 + ks * 32 + 8 * lg], xb = *(const LAS bf16x8*)&WTu[(16 * nt + ln) * 72 + ks * 32 + 8 * lg];
                cw_ = __builtin_amdgcn_mfma_f32_16x16x32_bf16(xa, xb, cw_, 0, 0, 0);
                const bf16x8 ya = *(const LAS bf16x8*)&ADb[(16 * mt + ln) * 72 + ks * 32 + 8 * lg], yb = *(const LAS bf16x8*)&WTa[(16 * nt + ln) * 72 + ks * 32 + 8 * lg];
                ca_ = __builtin_amdgcn_mfma_f32_16x16x32_bf16(ya, yb, ca_, 0, 0, 0);
            }
#pragma unroll
            for (int r = 0; r < 4; ++r) {
                const int tt = 16 * mt + 4 * lg + r;
                const float z = -(q_w0 + cw_[r]);
                const float sp = fmaxf(z, 0.f) + __logf(1.f + __expf(-fabsf(z)));
                const float e = __expf(-sp - 0.5f);
                W1[tt * 64 + chm] = bf2f((bf16_t)f2bf(-expm1f(-e)));
                AS[tt * 64 + chm] = bf2f((bf16_t)f2bf(sigmoidf_(q_a0 + ca_[r])));
            }
        }
        LDS_BAR();
#pragma unroll
        for (int q = 0; q < 4; ++q) {
            const int tt = 4 * tg + q;
            const size_t row = (size_t)tp * 32 + tt;
            const float w1 = W1[tt * 64 + c], a = AS[tt * 64 + c];
            const float kraw = Kk[tt * 64 + c], r = Rr[tt * 64 + c], v = Vv[tt * 64 + c];
            const float kk0 = kraw * p_kk;
            const float inv = 1.f / sqrtf(fmaxf(wave_sum_fast(kk0 * kk0), 1e-24f));
            const float kk = kk0 * inv;
            const float kmod = kraw * (1.f + (a - 1.f) * p_ka);
            const float bvec = kk * a;
            const float br = wave_sum_fast(bvec * r), kr = wave_sum_fast(kmod * r), bonus = wave_sum_fast(r * kmod * p_rk);
            bf16_t* rp_ = X.P + row * LDP;
            rp_[COL_PA + hc] = (bf16_t)f2bf(r); rp_[COL_PA + 512 + hc] = (bf16_t)f2bf(kraw); rp_[COL_PA + 1024 + hc] = (bf16_t)f2bf(v);
            rp_[hc] = (bf16_t)f2bf(w1); rp_[512 + hc] = (bf16_t)f2bf(a);
            if (c == 0) *(f32x4*)(SCAL + (row * 8 + h) * 4) = (f32x4){inv, br, kr, bonus};
        }
        LDS_BAR();
    }
}

__device__ __forceinline__ void rwkv_task(const Ctx& X, LAS unsigned char* lds, int layer, int b, int h) {
    LAS bf16_t* GDb = (LAS bf16_t*)(lds + 66560);
    LAS bf16_t* WTg = (LAS bf16_t*)(lds + 70912);
    LAS float* BON = (LAS float*)(lds + 88320);
    const int tid = X.tid, lane = tid & 63;
    const bool helper = X.wave >= 4;
    const int ht = tid & 255;
    const float* mu = X.in[3] + layer * 1792;
    const float* g_up = X.in[8] + (size_t)layer * 128 * 512;
    const float* k_k = X.in[9] + layer * 512;  const float* k_a = X.in[10] + layer * 512;
    const float* gn_g = X.in[12] + layer * 512; const float* gn_b = X.in[13] + layer * 512;
    const float* SCAL = (const float*)(X.ws + WS_SCAL);
    const int tt_h = ht >> 4, cg4 = (ht & 15) * 4;
    const f32x4 p_kk = *(const f32x4*)(k_k + h * 64 + cg4), p_ka = *(const f32x4*)(k_a + h * 64 + cg4);
    const f32x4 p_gg = *(const f32x4*)(gn_g + h * 64 + cg4), p_gb = *(const f32x4*)(gn_b + h * 64 + cg4);
    const int gv8 = (ht & 15) * 8;
    const f32x4 mg0 = *(const f32x4*)(mu + 1664 + gv8), mg1 = *(const f32x4*)(mu + 1664 + gv8 + 4);
    const int nt = (ht >> 6), ln = lane & 15, lg = lane >> 4, chm = 16 * nt + ln;
    const int rp = ht >> 3, jg = ht & 7, i0 = 2 * rp;
    for (int idx = tid; idx < 128 * 64; idx += 512) { const int m = idx >> 6, cc = idx & 63; WTg[cc * 136 + m] = (bf16_t)f2bf(g_up[m * 512 + h * 64 + cc]); }
    f32x2 S0[4], S1[4];
#pragma unroll
    for (int j = 0; j < 4; ++j) { S0[j] = (f32x2){0.f, 0.f}; S1[j] = (f32x2){0.f, 0.f}; }
#if PROBE_SCAN2
    f32x2 T0[4], T1[4];
#pragma unroll
    for (int j = 0; j < 4; ++j) { T0[j] = (f32x2){0.f, 0.f}; T1[j] = (f32x2){0.f, 0.f}; }
#endif
    __syncthreads();

#define RW_ARR(bufi, k) ((LAS float*)(lds + (bufi) * RW_BUF + (k) * 4096))
#define RW_SC(bufi) ((LAS float*)(lds + (bufi) * RW_BUF + 32768))
#define RW_LOAD(chk, L) do { const size_t row_ = (size_t)b * SEQ + (chk) * RW_TS + tt_h; const bf16_t* rp_ = X.P + row_ * LDP; \
        l_r##L = *(const u32x2*)(rp_ + COL_PA + h * 64 + cg4); l_k##L = *(const u32x2*)(rp_ + COL_PA + 512 + h * 64 + cg4); l_v##L = *(const u32x2*)(rp_ + COL_PA + 1024 + h * 64 + cg4); \
        l_w##L = *(const u32x2*)(rp_ + h * 64 + cg4); l_a##L = *(const u32x2*)(rp_ + 512 + h * 64 + cg4); l_s##L = *(const f32x4*)(SCAL + (row_ * 8 + h) * 4); \
        l_gc##L = *(const u32x4*)(rp_ + COL_PA + 1664 + gv8); l_gp##L = (u32x4){0u, 0u, 0u, 0u}; if ((chk) * RW_TS + tt_h > 0) l_gp##L = *(const u32x4*)(rp_ - LDP + COL_PA + 1664 + gv8); } while (0)
    u32x2 l_rA, l_kA, l_vA, l_wA, l_aA; f32x4 l_sA; u32x4 l_gcA, l_gpA;
    u32x2 l_rB, l_kB, l_vB, l_wB, l_aB; f32x4 l_sB; u32x4 l_gcB, l_gpB;
    l_rA = l_kA = l_vA = l_wA = l_aA = l_rB = l_kB = l_vB = l_wB = l_aB = (u32x2){0u, 0u}; l_sA = l_sB = (f32x4){0.f, 0.f, 0.f, 0.f}; l_gcA = l_gpA = l_gcB = l_gpB = (u32x4){0u, 0u, 0u, 0u};
    if (helper) { RW_LOAD(0, A); RW_LOAD(1, B); }

#pragma unroll 1
    for (int i0_ = -1; i0_ < RW_NCH; i0_ += 2) {
        { const int i = i0_;

        const int bufn = (i + 1) & 1, bufc = i & 1;
        if (helper) {
            const bool do_prep = (i + 1 < RW_NCH);
            if (i >= 1) {
                LAS float* Yy = RW_ARR(bufn, 7); LAS float* Gg = RW_ARR(bufn, 6); LAS float* Vv = RW_ARR(bufn, 5); LAS float* SC = RW_SC(bufn);
                const f32x4 y = *(const LAS f32x4*)&Yy[tt_h * 64 + cg4], gg = *(const LAS f32x4*)&Gg[tt_h * 64 + cg4], vv = *(const LAS f32x4*)&Vv[tt_h * 64 + cg4];
                const float bonus = BON[((i - 1) % 3) * 16 + tt_h];
                const float mean = red16((y.x + y.y) + (y.z + y.w)) * (1.f / 64.f);
                const f32x4 d = y - mean;
                const float var = red16((d.x * d.x + d.y * d.y) + (d.z * d.z + d.w * d.w)) * (1.f / 64.f);
                const float rs = 1.f / sqrtf(var + 64e-5f);
                const f32x4 o = (d * rs * p_gg + p_gb + vv * bonus) * gg;
                u32x2 w; w.x = pk2(o.x, o.y); w.y = pk2(o.z, o.w);
                *(u32x2*)(X.P + ((size_t)b * SEQ + (i - 1) * RW_TS + tt_h) * LDP + COL_YA + h * 64 + cg4) = w;
            }
            if (do_prep) {
                const f32x4 r = (f32x4){bflo(l_rA.x), bfhi(l_rA.x), bflo(l_rA.y), bfhi(l_rA.y)}, k = (f32x4){bflo(l_kA.x), bfhi(l_kA.x), bflo(l_kA.y), bfhi(l_kA.y)};
                const f32x4 v = (f32x4){bflo(l_vA.x), bfhi(l_vA.x), bflo(l_vA.y), bfhi(l_vA.y)}, w1 = (f32x4){bflo(l_wA.x), bfhi(l_wA.x), bflo(l_wA.y), bfhi(l_wA.y)};
                const f32x4 a = (f32x4){bflo(l_aA.x), bfhi(l_aA.x), bflo(l_aA.y), bfhi(l_aA.y)};
                const f32x4 kk = k * p_kk * l_sA.x;
                const f32x4 decay = 1.f - w1;
                *(LAS f32x4*)&RW_ARR(bufn, 0)[tt_h * 64 + cg4] = -kk;
                *(LAS f32x4*)&RW_ARR(bufn, 1)[tt_h * 64 + cg4] = decay * r;
                *(LAS f32x4*)&RW_ARR(bufn, 2)[tt_h * 64 + cg4] = decay;
                *(LAS f32x4*)&RW_ARR(bufn, 3)[tt_h * 64 + cg4] = kk * a;
                *(LAS f32x4*)&RW_ARR(bufn, 4)[tt_h * 64 + cg4] = k * (1.f + (a - 1.f) * p_ka);
                *(LAS f32x4*)&RW_ARR(bufn, 5)[tt_h * 64 + cg4] = v;
                if (cg4 == 0) { LAS float* SC = RW_SC(bufn); SC[tt_h * 4 + 0] = l_sA.y; SC[tt_h * 4 + 1] = l_sA.z; BON[((i + 1) % 3) * 16 + tt_h] = l_sA.w; }
                float gc[8], gp[8];
                gc[0] = bflo(l_gcA.x); gc[1] = bfhi(l_gcA.x); gc[2] = bflo(l_gcA.y); gc[3] = bfhi(l_gcA.y); gc[4] = bflo(l_gcA.z); gc[5] = bfhi(l_gcA.z); gc[6] = bflo(l_gcA.w); gc[7] = bfhi(l_gcA.w);
                gp[0] = bflo(l_gpA.x); gp[1] = bfhi(l_gpA.x); gp[2] = bflo(l_gpA.y); gp[3] = bfhi(l_gpA.y); gp[4] = bflo(l_gpA.z); gp[5] = bfhi(l_gpA.z); gp[6] = bflo(l_gpA.w); gp[7] = bfhi(l_gpA.w);
#pragma unroll
                for (int e = 0; e < 8; ++e) gc[e] = sigmoidf_(gc[e] + (gp[e] - gc[e]) * (e < 4 ? mg0[e & 3] : mg1[e & 3]));
                u32x4 o; o.x = pk2(gc[0], gc[1]); o.y = pk2(gc[2], gc[3]); o.z = pk2(gc[4], gc[5]); o.w = pk2(gc[6], gc[7]);
                *(LAS u32x4*)&GDb[tt_h * 136 + gv8] = o;
            }
            if (i + 3 < RW_NCH) RW_LOAD(i + 3, A);
            LDS_BAR();
            if (do_prep) {
                LAS float* Gg = RW_ARR(bufn, 6);
                f32x4 cg_ = (f32x4){0.f, 0.f, 0.f, 0.f};
#pragma unroll
                for (int ks = 0; ks < 4; ++ks) {
                    const bf16x8 za = *(const LAS bf16x8*)&GDb[ln * 136 + ks * 32 + 8 * lg], zb = *(const LAS bf16x8*)&WTg[(16 * nt + ln) * 136 + ks * 32 + 8 * lg];
                    cg_ = __builtin_amdgcn_mfma_f32_16x16x32_bf16(za, zb, cg_, 0, 0, 0);
                }
#pragma unroll
                for (int r = 0; r < 4; ++r) Gg[(4 * lg + r) * 64 + chm] = cg_[r];
            }
            LDS_BAR();
        } else {
            LAS float* A_ = RW_ARR(bufc, 0); LAS float* WR = RW_ARR(bufc, 1); LAS float* Wd = RW_ARR(bufc, 2); LAS float* Bv = RW_ARR(bufc, 3);
            LAS float* Kk = RW_ARR(bufc, 4); LAS float* Vv = RW_ARR(bufc, 5); LAS float* Yy = RW_ARR(bufc, 7); LAS float* SC = RW_SC(bufc);
#pragma unroll 1
            for (int q4 = 0; q4 < 4; ++q4) {
                if (i >= 0) {
                    f32x2 yk[4];
#pragma unroll
                    for (int s4 = 0; s4 < 4; ++s4) {
                        const int tt = 4 * q4 + s4;
                        const f32x4 a_lo = *(const LAS f32x4*)&A_[tt * 64 + 8 * jg], a_hi = *(const LAS f32x4*)&A_[tt * 64 + 8 * jg + 4];
                        const f32x4 r_lo = *(const LAS f32x4*)&WR[tt * 64 + 8 * jg], r_hi = *(const LAS f32x4*)&WR[tt * 64 + 8 * jg + 4];
                        const f32x4 w_lo = *(const LAS f32x4*)&Wd[tt * 64 + 8 * jg], w_hi = *(const LAS f32x4*)&Wd[tt * 64 + 8 * jg + 4];
                        const f32x4 b_lo = *(const LAS f32x4*)&Bv[tt * 64 + 8 * jg], b_hi = *(const LAS f32x4*)&Bv[tt * 64 + 8 * jg + 4];
                        const f32x4 k_lo = *(const LAS f32x4*)&Kk[tt * 64 + 8 * jg], k_hi = *(const LAS f32x4*)&Kk[tt * 64 + 8 * jg + 4];
                        const f32x2 vv = *(const LAS f32x2*)&Vv[tt * 64 + i0];
                        const f32x2 sc = *(const LAS f32x2*)&SC[tt * 4];
                        const f32x2 av[4] = {{a_lo.x, a_lo.y}, {a_lo.z, a_lo.w}, {a_hi.x, a_hi.y}, {a_hi.z, a_hi.w}};
                        const f32x2 rv[4] = {{r_lo.x, r_lo.y}, {r_lo.z, r_lo.w}, {r_hi.x, r_hi.y}, {r_hi.z, r_hi.w}};
                        const f32x2 wv[4] = {{w_lo.x, w_lo.y}, {w_lo.z, w_lo.w}, {w_hi.x, w_hi.y}, {w_hi.z, w_hi.w}};
                        const f32x2 bv[4] = {{b_lo.x, b_lo.y}, {b_lo.z, b_lo.w}, {b_hi.x, b_hi.y}, {b_hi.z, b_hi.w}};
                        const f32x2 kv[4] = {{k_lo.x, k_lo.y}, {k_lo.z, k_lo.w}, {k_hi.x, k_hi.y}, {k_hi.z, k_hi.w}};
                        f32x2 e10 = S0[0] * av[0], e20 = S0[0] * rv[0], e11 = S1[0] * av[0], e21 = S1[0] * rv[0];
#pragma unroll
                        for (int j = 1; j < 4; ++j) { e10 += S0[j] * av[j]; e20 += S0[j] * rv[j]; e11 += S1[j] * av[j]; e21 += S1[j] * rv[j]; }
                        const float d10 = red8(e10.x + e10.y), d20 = red8(e20.x + e20.y), d11 = red8(e11.x + e11.y), d21 = red8(e21.x + e21.y);
                        yk[s4] = (f32x2){d20 + d10 * sc.x + vv.x * sc.y, d21 + d11 * sc.x + vv.y * sc.y};
                        const f32x2 d10v = (f32x2){d10, d10}, d11v = (f32x2){d11, d11}, v0v = (f32x2){vv.x, vv.x}, v1v = (f32x2){vv.y, vv.y};
#pragma unroll
                        for (int j = 0; j < 4; ++j) { S0[j] = S0[j] * wv[j] + (d10v * bv[j] + v0v * kv[j]); S1[j] = S1[j] * wv[j] + (d11v * bv[j] + v1v * kv[j]); }
                    }
                    if (jg == 0) {
#pragma unroll
                        for (int s4 = 0; s4 < 4; ++s4) *(LAS f32x2*)&Yy[(4 * q4 + s4) * 64 + i0] = yk[s4];
                    }

#if PROBE_SCAN2
                    {
#pragma unroll
                    for (int s4 = 0; s4 < 4; ++s4) {
                        const int tt = 4 * q4 + s4;
                        const f32x4 a_lo = *(const LAS f32x4*)&A_[tt * 64 + 8 * jg], a_hi = *(const LAS f32x4*)&A_[tt * 64 + 8 * jg + 4];
                        const f32x4 r_lo = *(const LAS f32x4*)&WR[tt * 64 + 8 * jg], r_hi = *(const LAS f32x4*)&WR[tt * 64 + 8 * jg + 4];
                        const f32x4 w_lo = *(const LAS f32x4*)&Wd[tt * 64 + 8 * jg], w_hi = *(const LAS f32x4*)&Wd[tt * 64 + 8 * jg + 4];
                        const f32x4 b_lo = *(const LAS f32x4*)&Bv[tt * 64 + 8 * jg], b_hi = *(const LAS f32x4*)&Bv[tt * 64 + 8 * jg + 4];
                        const f32x4 k_lo = *(const LAS f32x4*)&Kk[tt * 64 + 8 * jg], k_hi = *(const LAS f32x4*)&Kk[tt * 64 + 8 * jg + 4];
                        const f32x2 vv = *(const LAS f32x2*)&Vv[tt * 64 + i0];
                        const f32x2 av[4] = {{a_lo.x, a_lo.y}, {a_lo.z, a_lo.w}, {a_hi.x, a_hi.y}, {a_hi.z, a_hi.w}};
                        const f32x2 rv[4] = {{r_lo.x, r_lo.y}, {r_lo.z, r_lo.w}, {r_hi.x, r_hi.y}, {r_hi.z, r_hi.w}};
                        const f32x2 wv[4] = {{w_lo.x, w_lo.y}, {w_lo.z, w_lo.w}, {w_hi.x, w_hi.y}, {w_hi.z, w_hi.w}};
                        const f32x2 bv[4] = {{b_lo.x, b_lo.y}, {b_lo.z, b_lo.w}, {b_hi.x, b_hi.y}, {b_hi.z, b_hi.w}};
                        const f32x2 kv[4] = {{k_lo.x, k_lo.y}, {k_lo.z, k_lo.w}, {k_hi.x, k_hi.y}, {k_hi.z, k_hi.w}};
                        f32x2 e10 = T0[0] * av[0], e20 = T0[0] * rv[0], e11 = T1[0] * av[0], e21 = T1[0] * rv[0];
#pragma unroll
                        for (int j = 1; j < 4; ++j) { e10 += T0[j] * av[j]; e20 += T0[j] * rv[j]; e11 += T1[j] * av[j]; e21 += T1[j] * rv[j]; }
                        const float d10 = red8(e10.x + e10.y), d20 = red8(e20.x + e20.y), d11 = red8(e11.x + e11.y), d21 = red8(e21.x + e21.y);
                        const f32x2 d10v = (f32x2){d10 + d20, d10}, d11v = (f32x2){d11 + d21, d11}, v0v = (f32x2){vv.x, vv.x}, v1v = (f32x2){vv.y, vv.y};
#pragma unroll
                        for (int j = 0; j < 4; ++j) { T0[j] = T0[j] * wv[j] + (d10v * bv[j] + v0v * kv[j]); T1[j] = T1[j] * wv[j] + (d11v * bv[j] + v1v * kv[j]); }
                    }
                    }
#endif
                }
                if (q4 & 1) LDS_BAR();
            }
        }
            }
        if (i0_ + 1 < RW_NCH) { const int i = i0_ + 1;

        const int bufn = (i + 1) & 1, bufc = i & 1;
        if (helper) {
            const bool do_prep = (i + 1 < RW_NCH);
            if (i >= 1) {
                LAS float* Yy = RW_ARR(bufn, 7); LAS float* Gg = RW_ARR(bufn, 6); LAS float* Vv = RW_ARR(bufn, 5); LAS float* SC = RW_SC(bufn);
                const f32x4 y = *(const LAS f32x4*)&Yy[tt_h * 64 + cg4], gg = *(const LAS f32x4*)&Gg[tt_h * 64 + cg4], vv = *(const LAS f32x4*)&Vv[tt_h * 64 + cg4];
                const float bonus = BON[((i - 1) % 3) * 16 + tt_h];
                const float mean = red16((y.x + y.y) + (y.z + y.w)) * (1.f / 64.f);
                const f32x4 d = y - mean;
                const float var = red16((d.x * d.x + d.y * d.y) + (d.z * d.z + d.w * d.w)) * (1.f / 64.f);
                const float rs = 1.f / sqrtf(var + 64e-5f);
                const f32x4 o = (d * rs * p_gg + p_gb + vv * bonus) * gg;
                u32x2 w; w.x = pk2(o.x, o.y); w.y = pk2(o.z, o.w);
                *(u32x2*)(X.P + ((size_t)b * SEQ + (i - 1) * RW_TS + tt_h) * LDP + COL_YA + h * 64 + cg4) = w;
            }
            if (do_prep) {
                const f32x4 r = (f32x4){bflo(l_rB.x), bfhi(l_rB.x), bflo(l_rB.y), bfhi(l_rB.y)}, k = (f32x4){bflo(l_kB.x), bfhi(l_kB.x), bflo(l_kB.y), bfhi(l_kB.y)};
                const f32x4 v = (f32x4){bflo(l_vB.x), bfhi(l_vB.x), bflo(l_vB.y), bfhi(l_vB.y)}, w1 = (f32x4){bflo(l_wB.x), bfhi(l_wB.x), bflo(l_wB.y), bfhi(l_wB.y)};
                const f32x4 a = (f32x4){bflo(l_aB.x), bfhi(l_aB.x), bflo(l_aB.y), bfhi(l_aB.y)};
                const f32x4 kk = k * p_kk * l_sB.x;
                const f32x4 decay = 1.f - w1;
                *(LAS f32x4*)&RW_ARR(bufn, 0)[tt_h * 64 + cg4] = -kk;
                *(LAS f32x4*)&RW_ARR(bufn, 1)[tt_h * 64 + cg4] = decay * r;
                *(LAS f32x4*)&RW_ARR(bufn, 2)[tt_h * 64 + cg4] = decay;
                *(LAS f32x4*)&RW_ARR(bufn, 3)[tt_h * 64 + cg4] = kk * a;
                *(LAS f32x4*)&RW_ARR(bufn, 4)[tt_h * 64 + cg4] = k * (1.f + (a - 1.f) * p_ka);
                *(LAS f32x4*)&RW_ARR(bufn, 5)[tt_h * 64 + cg4] = v;
                if (cg4 == 0) { LAS float* SC = RW_SC(bufn); SC[tt_h * 4 + 0] = l_sB.y; SC[tt_h * 4 + 1] = l_sB.z; BON[((i + 1) % 3) * 16 + tt_h] = l_sB.w; }
                float gc[8], gp[8];
                gc[0] = bflo(l_gcB.x); gc[1] = bfhi(l_gcB.x); gc[2] = bflo(l_gcB.y); gc[3] = bfhi(l_gcB.y); gc[4] = bflo(l_gcB.z); gc[5] = bfhi(l_gcB.z); gc[6] = bflo(l_gcB.w); gc[7] = bfhi(l_gcB.w);
                gp[0] = bflo(l_gpB.x); gp[1] = bfhi(l_gpB.x); gp[2] = bflo(l_gpB.y); gp[3] = bfhi(l_gpB.y); gp[4] = bflo(l_gpB.z); gp[5] = bfhi(l_gpB.z); gp[6] = bflo(l_gpB.w); gp[7] = bfhi(l_gpB.w);
#pragma unroll
                for (int e = 0; e < 8; ++e) gc[e] = sigmoidf_(gc[e] + (gp[e] - gc[e]) * (e < 4 ? mg0[e & 3] : mg1[e & 3]));
                u32x4 o; o.x = pk2(gc[0], gc[1]); o.y = pk2(gc[2], gc[3]); o.z = pk2(gc[4], gc[5]); o.w = pk2(gc[6], gc[7]);
                *(LAS u32x4*)&GDb[tt_h * 136 + gv8] = o;
            }
            if (i + 3 < RW_NCH) RW_LOAD(i + 3, B);
            LDS_BAR();
            if (do_prep) {
                LAS float* Gg = RW_ARR(bufn, 6);
                f32x4 cg_ = (f32x4){0.f, 0.f, 0.f, 0.f};
#pragma unroll
                for (int ks = 0; ks < 4; ++ks) {
                    const bf16x8 za = *(const LAS bf16x8*)&GDb[ln * 136 + ks * 32 + 8 * lg], zb = *(const LAS bf16x8*)&WTg[(16 * nt + ln) * 136 + ks * 32 + 8 * lg];
                    cg_ = __builtin_amdgcn_mfma_f32_16x16x32_bf16(za, zb, cg_, 0, 0, 0);
                }
#pragma unroll
                for (int r = 0; r < 4; ++r) Gg[(4 * lg + r) * 64 + chm] = cg_[r];
            }
            LDS_BAR();
        } else {
            LAS float* A_ = RW_ARR(bufc, 0); LAS float* WR = RW_ARR(bufc, 1); LAS float* Wd = RW_ARR(bufc, 2); LAS float* Bv = RW_ARR(bufc, 3);
            LAS float* Kk = RW_ARR(bufc, 4); LAS float* Vv = RW_ARR(bufc, 5); LAS float* Yy = RW_ARR(bufc, 7); LAS float* SC = RW_SC(bufc);
#pragma unroll 1
            for (int q4 = 0; q4 < 4; ++q4) {
                if (i >= 0) {
                    f32x2 yk[4];
#pragma unroll
                    for (int s4 = 0; s4 < 4; ++s4) {
                        const int tt = 4 * q4 + s4;
                        const f32x4 a_lo = *(const LAS f32x4*)&A_[tt * 64 + 8 * jg], a_hi = *(const LAS f32x4*)&A_[tt * 64 + 8 * jg + 4];
                        const f32x4 r_lo = *(const LAS f32x4*)&WR[tt * 64 + 8 * jg], r_hi = *(const LAS f32x4*)&WR[tt * 64 + 8 * jg + 4];
                        const f32x4 w_lo = *(const LAS f32x4*)&Wd[tt * 64 + 8 * jg], w_hi = *(const LAS f32x4*)&Wd[tt * 64 + 8 * jg + 4];
                        const f32x4 b_lo = *(const LAS f32x4*)&Bv[tt * 64 + 8 * jg], b_hi = *(const LAS f32x4*)&Bv[tt * 64 + 8 * jg + 4];
                        const f32x4 k_lo = *(const LAS f32x4*)&Kk[tt * 64 + 8 * jg], k_hi = *(const LAS f32x4*)&Kk[tt * 64 + 8 * jg + 4];
                        const f32x2 vv = *(const LAS f32x2*)&Vv[tt * 64 + i0];
                        const f32x2 sc = *(const LAS f32x2*)&SC[tt * 4];
                        const f32x2 av[4] = {{a_lo.x, a_lo.y}, {a_lo.z, a_lo.w}, {a_hi.x, a_hi.y}, {a_hi.z, a_hi.w}};
                        const f32x2 rv[4] = {{r_lo.x, r_lo.y}, {r_lo.z, r_lo.w}, {r_hi.x, r_hi.y}, {r_hi.z, r_hi.w}};
                        const f32x2 wv[4] = {{w_lo.x, w_lo.y}, {w_lo.z, w_lo.w}, {w_hi.x, w_hi.y}, {w_hi.z, w_hi.w}};
                        const f32x2 bv[4] = {{b_lo.x, b_lo.y}, {b_lo.z, b_lo.w}, {b_hi.x, b_hi.y}, {b_hi.z, b_hi.w}};
                        const f32x2 kv[4] = {{k_lo.x, k_lo.y}, {k_lo.z, k_lo.w}, {k_hi.x, k_hi.y}, {k_hi.z, k_hi.w}};
                        f32x2 e10 = S0[0] * av[0], e20 = S0[0] * rv[0], e11 = S1[0] * av[0], e21 = S1[0] * rv[0];
#pragma unroll
                        for (int j = 1; j < 4; ++j) { e10 += S0[j] * av[j]; e20 += S0[j] * rv[j]; e11 += S1[j] * av[j]; e21 += S1[j] * rv[j]; }
                        const float d10 = red8(e10.x + e10.y), d20 = red8(e20.x + e20.y), d11 = red8(e11.x + e11.y), d21 = red8(e21.x + e21.y);
                        yk[s4] = (f32x2){d20 + d10 * sc.x + vv.x * sc.y, d21 + d11 * sc.x + vv.y * sc.y};
                        const f32x2 d10v = (f32x2){d10, d10}, d11v = (f32x2){d11, d11}, v0v = (f32x2){vv.x, vv.x}, v1v = (f32x2){vv.y, vv.y};
#pragma unroll
                        for (int j = 0; j < 4; ++j) { S0[j] = S0[j] * wv[j] + (d10v * bv[j] + v0v * kv[j]); S1[j] = S1[j] * wv[j] + (d11v * bv[j] + v1v * kv[j]); }
                    }
                    if (jg == 0) {
#pragma unroll
                        for (int s4 = 0; s4 < 4; ++s4) *(LAS f32x2*)&Yy[(4 * q4 + s4) * 64 + i0] = yk[s4];
                    }

#if PROBE_SCAN2
                    {
#pragma unroll
                    for (int s4 = 0; s4 < 4; ++s4) {
                        const int tt = 4 * q4 + s4;
                        const f32x4 a_lo = *(const LAS f32x4*)&A_[tt * 64 + 8 * jg], a_hi = *(const LAS f32x4*)&A_[tt * 64 + 8 * jg + 4];
                        const f32x4 r_lo = *(const LAS f32x4*)&WR[tt * 64 + 8 * jg], r_hi = *(const LAS f32x4*)&WR[tt * 64 + 8 * jg + 4];
                        const f32x4 w_lo = *(const LAS f32x4*)&Wd[tt * 64 + 8 * jg], w_hi = *(const LAS f32x4*)&Wd[tt * 64 + 8 * jg + 4];
                        const f32x4 b_lo = *(const LAS f32x4*)&Bv[tt * 64 + 8 * jg], b_hi = *(const LAS f32x4*)&Bv[tt * 64 + 8 * jg + 4];
                        const f32x4 k_lo = *(const LAS f32x4*)&Kk[tt * 64 + 8 * jg], k_hi = *(const LAS f32x4*)&Kk[tt * 64 + 8 * jg + 4];
                        const f32x2 vv = *(const LAS f32x2*)&Vv[tt * 64 + i0];
                        const f32x2 av[4] = {{a_lo.x, a_lo.y}, {a_lo.z, a_lo.w}, {a_hi.x, a_hi.y}, {a_hi.z, a_hi.w}};
                        const f32x2 rv[4] = {{r_lo.x, r_lo.y}, {r_lo.z, r_lo.w}, {r_hi.x, r_hi.y}, {r_hi.z, r_hi.w}};
                        const f32x2 wv[4] = {{w_lo.x, w_lo.y}, {w_lo.z, w_lo.w}, {w_hi.x, w_hi.y}, {w_hi.z, w_hi.w}};
                        const f32x2 bv[4] = {{b_lo.x, b_lo.y}, {b_lo.z, b_lo.w}, {b_hi.x, b_hi.y}, {b_hi.z, b_hi.w}};
                        const f32x2 kv[4] = {{k_lo.x, k_lo.y}, {k_lo.z, k_lo.w}, {k_hi.x, k_hi.y}, {k_hi.z, k_hi.w}};
                        f32x2 e10 = T0[0] * av[0], e20 = T0[0] * rv[0], e11 = T1[0] * av[0], e21 = T1[0] * rv[0];
#pragma unroll
                        for (int j = 1; j < 4; ++j) { e10 += T0[j] * av[j]; e20 += T0[j] * rv[j]; e11 += T1[j] * av[j]; e21 += T1[j] * rv[j]; }
                        const float d10 = red8(e10.x + e10.y), d20 = red8(e20.x + e20.y), d11 = red8(e11.x + e11.y), d21 = red8(e21.x + e21.y);
                        const f32x2 d10v = (f32x2){d10 + d20, d10}, d11v = (f32x2){d11 + d21, d11}, v0v = (f32x2){vv.x, vv.x}, v1v = (f32x2){vv.y, vv.y};
#pragma unroll
                        for (int j = 0; j < 4; ++j) { T0[j] = T0[j] * wv[j] + (d10v * bv[j] + v0v * kv[j]); T1[j] = T1[j] * wv[j] + (d11v * bv[j] + v1v * kv[j]); }
                    }
                    }
#endif
                }
                if (q4 & 1) LDS_BAR();
            }
        }
            }
    }
    if (helper) {
        const int bufl = (RW_NCH - 1) & 1;
        LAS float* Yy = RW_ARR(bufl, 7); LAS float* Gg = RW_ARR(bufl, 6); LAS float* Vv = RW_ARR(bufl, 5); LAS float* SC = RW_SC(bufl);
        const f32x4 y = *(const LAS f32x4*)&Yy[tt_h * 64 + cg4], gg = *(const LAS f32x4*)&Gg[tt_h * 64 + cg4], vv = *(const LAS f32x4*)&Vv[tt_h * 64 + cg4];
        const float bonus = BON[((RW_NCH - 1) % 3) * 16 + tt_h];
        const float mean = red16((y.x + y.y) + (y.z + y.w)) * (1.f / 64.f);
        const f32x4 d = y - mean;
        const float var = red16((d.x * d.x + d.y * d.y) + (d.z * d.z + d.w * d.w)) * (1.f / 64.f);
        const float rs = 1.f / sqrtf(var + 64e-5f);
        const f32x4 o = (d * rs * p_gg + p_gb + vv * bonus) * gg;
        u32x2 w; w.x = pk2(o.x, o.y); w.y = pk2(o.z, o.w);
        *(u32x2*)(X.P + ((size_t)b * SEQ + (RW_NCH - 1) * RW_TS + tt_h) * LDP + COL_YA + h * 64 + cg4) = w;
    }
    __syncthreads();
#undef RW_ARR
#undef RW_SC
#undef RW_LOAD
}

__device__ __forceinline__ void hgrn_task(const Ctx& X, LAS unsigned char* lds, int layer, int b, int h, int vh) {
    LAS float* F = (LAS float*)(lds); LAS float* Q = (LAS float*)(lds + 16384); LAS float* Vv = (LAS float*)(lds + 32768); LAS float* O = (LAS float*)(lds + 40960);
    LAS float* LB = (LAS float*)(lds + 49152);
    const int tid = X.tid;
    const float* lbl = X.in[14];
    const int rp = tid >> 4, dg = tid & 15, v0 = 2 * rp;
    if (tid < 128) LB[tid] = (layer > 0) ? 1.f / (1.f + __expf(lbl[h * 128 + tid] - lbl[512 + h * 128 + tid])) : 0.f;
    f32x2 S0[4], S1[4];
#pragma unroll
    for (int j = 0; j < 4; ++j) { S0[j] = (f32x2){0.f, 0.f}; S1[j] = (f32x2){0.f, 0.f}; }
#define HG_LOAD(chk) do { _Pragma("unroll") for (int it = 0; it < 3; ++it) { const int idx = tid + 512 * it; raw[it] = (u32x4){0u, 0u, 0u, 0u}; \
        if (idx < 32 * 40) { const int tt = idx / 40, vv = idx - tt * 40; \
            const int col = vv < 16 ? 512 + h * 128 + 8 * vv : (vv < 32 ? h * 128 + 8 * (vv - 16) : 1024 + h * 128 + vh * 64 + 8 * (vv - 32)); \
            raw[it] = *(const u32x4*)(X.P + ((size_t)b * SEQ + (chk) * 32 + tt) * LDP + COL_PB + col); } } } while (0)
    u32x4 raw[3];
    HG_LOAD(0);
    __syncthreads();
#pragma unroll 1
    for (int ch = 0; ch < SEQ / 32; ++ch) {
        const int t0 = ch * 32;
#pragma unroll
        for (int it = 0; it < 3; ++it) {
            const int idx = tid + 512 * it;
            if (idx < 32 * 40) {
                const int tt = idx / 40, vv = idx - tt * 40;
                float x[8];
                x[0] = bflo(raw[it].x); x[1] = bfhi(raw[it].x); x[2] = bflo(raw[it].y); x[3] = bfhi(raw[it].y);
                x[4] = bflo(raw[it].z); x[5] = bfhi(raw[it].z); x[6] = bflo(raw[it].w); x[7] = bfhi(raw[it].w);
                LAS float* dst;
                if (vv < 16) {
                    dst = F + tt * 128 + 8 * vv;
#pragma unroll
                    for (int e = 0; e < 8; ++e) { const float lb = LB[8 * vv + e]; x[e] = lb + (1.f - lb) * sigmoidf_(x[e]); }
                } else if (vv < 32) dst = Q + tt * 128 + 8 * (vv - 16);
                else dst = Vv + tt * 64 + 8 * (vv - 32);
                *(LAS f32x4*)dst = (f32x4){x[0], x[1], x[2], x[3]}; *(LAS f32x4*)(dst + 4) = (f32x4){x[4], x[5], x[6], x[7]};
            }
        }
        if (ch + 1 < SEQ / 32) HG_LOAD(ch + 1);
        LDS_BAR();
#pragma unroll 4
        for (int tt = 0; tt < 32; ++tt) {
            const f32x4 f_lo = *(const LAS f32x4*)&F[tt * 128 + 8 * dg], f_hi = *(const LAS f32x4*)&F[tt * 128 + 8 * dg + 4];
            const f32x4 q_lo = *(const LAS f32x4*)&Q[tt * 128 + 8 * dg], q_hi = *(const LAS f32x4*)&Q[tt * 128 + 8 * dg + 4];
            const f32x2 vv = *(const LAS f32x2*)&Vv[tt * 64 + v0];
            const f32x2 f2[4] = {{f_lo.x, f_lo.y}, {f_lo.z, f_lo.w}, {f_hi.x, f_hi.y}, {f_hi.z, f_hi.w}};
            const f32x2 q2[4] = {{q_lo.x, q_lo.y}, {q_lo.z, q_lo.w}, {q_hi.x, q_hi.y}, {q_hi.z, q_hi.w}};
            const f32x2 v0v = (f32x2){vv.x, vv.x}, v1v = (f32x2){vv.y, vv.y};
            f32x2 a0 = (f32x2){0.f, 0.f}, a1 = (f32x2){0.f, 0.f};
#pragma unroll
            for (int j = 0; j < 4; ++j) {
                S0[j] = v0v + f2[j] * (S0[j] - v0v); S1[j] = v1v + f2[j] * (S1[j] - v1v);
                a0 += q2[j] * S0[j]; a1 += q2[j] * S1[j];
            }
            const float o0 = red16(a0.x + a0.y), o1 = red16(a1.x + a1.y);
            if (dg == 0) *(LAS f32x2*)&O[tt * 64 + v0] = (f32x2){o0, o1};
        }
        LDS_BAR();
        if (tid < 256) {
            const int tt = tid >> 3, v8 = (tid & 7) * 8;
            const f32x4 a = *(const LAS f32x4*)&O[tt * 64 + v8], c4 = *(const LAS f32x4*)&O[tt * 64 + v8 + 4];
            u32x4 o; o.x = pk2(a.x, a.y); o.y = pk2(a.z, a.w); o.z = pk2(c4.x, c4.y); o.w = pk2(c4.z, c4.w);
            *(u32x4*)(X.P + ((size_t)b * SEQ + t0 + tt) * LDP + COL_YB + h * 128 + vh * 64 + v8) = o;
        }
    }
#undef HG_LOAD
    __syncthreads();
}

__device__ __forceinline__ unsigned f2ord(float f) { const unsigned u = __builtin_bit_cast(unsigned, f); return (u & 0x80000000u) ? ~u : (u | 0x80000000u); }

__device__ __forceinline__ void dsa_tile(const Ctx& X, LAS unsigned char* lds, int b, int q0) {
    LAS float* sc = (LAS float*)lds;
    LAS unsigned* MASK = (LAS unsigned*)(lds + MASK_OFF);
    const int lane = X.lane, w = X.wave, n = lane & 15, g = lane >> 4;
    const bf16_t* Pb = X.P + (size_t)b * SEQ * LDP;
#pragma unroll 1
    for (int sub = 0; sub < 4; ++sub) {
        const int qs = q0 + 16 * sub;
        {
            bf16x8 bq[4][2]; float wi[4];
            const bf16_t* qrow = Pb + (size_t)(qs + n) * LDP;
#pragma unroll
            for (int hh = 0; hh < 4; ++hh) {
#pragma unroll
                for (int ks = 0; ks < 2; ++ks) bq[hh][ks] = *(const bf16x8*)(qrow + C_QI + hh * 64 + ks * 32 + 8 * g);
                wi[hh] = bf2f(qrow[C_WI + hh]);
            }
            const int nkt = (qs + 16) >> 4;
            bf16x8 a0n = (bf16x8){0, 0, 0, 0, 0, 0, 0, 0}, a1n = a0n;
            if (w < nkt) { const bf16_t* krow = Pb + (size_t)(w * 16 + n) * LDP + C_KI; a0n = *(const bf16x8*)(krow + 8 * g); a1n = *(const bf16x8*)(krow + 32 + 8 * g); }
#pragma unroll 1
            for (int kt = w; kt < nkt; kt += 8) {
                const bf16x8 a0 = a0n, a1 = a1n;
                if (kt + 8 < nkt) { const bf16_t* krow = Pb + (size_t)((kt + 8) * 16 + n) * LDP + C_KI; a0n = *(const bf16x8*)(krow + 8 * g); a1n = *(const bf16x8*)(krow + 32 + 8 * g); }
                f32x4 s = (f32x4){0.f, 0.f, 0.f, 0.f};
#pragma unroll
                for (int hh = 0; hh < 4; ++hh) {
                    f32x4 d = __builtin_amdgcn_mfma_f32_16x16x32_bf16(a0, bq[hh][0], (f32x4){0.f, 0.f, 0.f, 0.f}, 0, 0, 0);
                    d = __builtin_amdgcn_mfma_f32_16x16x32_bf16(a1, bq[hh][1], d, 0, 0, 0);
#pragma unroll
                    for (int r = 0; r < 4; ++r) s[r] += wi[hh] * fmaxf(d[r], 0.f);
                }
                const int t = qs + n;
#pragma unroll
                for (int r = 0; r < 4; ++r) if (kt * 16 + 4 * g + r > t) s[r] = -INFINITY;
                *(LAS f32x4*)&sc[n * SCS + kt * 16 + 4 * g] = s;
            }
        }
        __syncthreads();
#pragma unroll 1
        for (int e = 0; e < 2; ++e) {
            const int qn = 2 * w + e, t = qs + qn;
            LAS unsigned* mrow = MASK + (sub * 16 + qn) * 64;
            if (t < 256) {
#pragma unroll
                for (int j = 0; j < 32; ++j) {
                    const unsigned long long sm = __ballot(j * 64 + lane <= t);
                    if (lane == 0) { mrow[2 * j] = (unsigned)sm; mrow[2 * j + 1] = (unsigned)(sm >> 32); }
                }
            } else {
                const int jn = (t >> 6) + 1;
                unsigned u[32];
#pragma unroll
                for (int j = 0; j < 32; ++j) {
                    u[j] = 0u;
                    if (j < jn) { const int key = j * 64 + lane; const float s = (key <= t) ? sc[qn * SCS + key] : -INFINITY; u[j] = f2ord(s); }
                }
                unsigned prefix = 0u;
#define DSA_BITSEARCH(JN) do { _Pragma("unroll 1") for (int bit = 31; bit >= 0; --bit) { const unsigned cand = prefix | (1u << bit); int c0 = 0, c1 = 0; \
                    _Pragma("unroll") for (int j = 0; j < (JN); j += 2) { c0 += (u[j] >= cand) ? 1 : 0; c1 += (u[j + 1] >= cand) ? 1 : 0; } \
                    const int cnt = (int)wave_sum_fast((float)(c0 + c1)); if (cnt >= 256) prefix = cand; } } while (0)
                if (jn <= 8) DSA_BITSEARCH(8); else if (jn <= 16) DSA_BITSEARCH(16); else if (jn <= 24) DSA_BITSEARCH(24); else DSA_BITSEARCH(32);
#undef DSA_BITSEARCH
                int cg_ = 0;
#pragma unroll
                for (int j = 0; j < 32; ++j) if (j < jn) cg_ += __popcll(__ballot(u[j] > prefix));
                const int need = 256 - cg_;
                int cum = 0;
#pragma unroll
                for (int j = 0; j < 32; ++j) {
                    unsigned long long sm = 0ull;
                    if (j < jn) {
                        const bool eq = (u[j] == prefix);
                        const unsigned long long em = __ballot(eq);
                        const int rank = cum + (int)__builtin_amdgcn_mbcnt_hi((unsigned)(em >> 32), __builtin_amdgcn_mbcnt_lo((unsigned)em, 0u));
                        const bool sel = (u[j] > prefix) || (eq && rank < need);
                        sm = __ballot(sel);
                        cum += __popcll(em);
                    }
                    if (lane == 0) { mrow[2 * j] = (unsigned)sm; mrow[2 * j + 1] = (unsigned)(sm >> 32); }
                }
            }
        }
        __syncthreads();
    }
    const int qq = q0 + 8 * w + (n & 7);
    const LAS unsigned* mq = MASK + (8 * w + (n & 7)) * 64;
    const int nsteps = (q0 + 8 * w + 8 + 31) >> 5;
    const int nblk = (q0 + 64 + 127) >> 7;
    LAS bf16_t* KT = (LAS bf16_t*)lds;
    LAS bf16_t* VTT = (LAS bf16_t*)(lds + 36864);
    const int tid = X.tid;
#pragma unroll 1
    for (int c = 0; c < 2; ++c) {
        bf16x8 bq[2][2];
#pragma unroll
        for (int j = 0; j < 2; ++j)
#pragma unroll
            for (int ks = 0; ks < 2; ++ks) bq[j][ks] = *(const bf16x8*)(Pb + (size_t)qq * LDP + C_Q + (c * 4 + 2 * j + (n >> 3)) * 64 + ks * 32 + 8 * g);
        float lrun[2] = {0.f, 0.f};
        f32x4 oacc[4][2];
#pragma unroll
        for (int mt = 0; mt < 4; ++mt)
#pragma unroll
            for (int j = 0; j < 2; ++j) oacc[mt][j] = (f32x4){0.f, 0.f, 0.f, 0.f};
        const bf16_t* vtb = X.VT + ((size_t)(b * 2 + c) * 64) * SEQ;
        u32x4 gk[2], gv[2];
#define DSA_GLOAD(kblk) do { _Pragma("unroll") for (int it = 0; it < 2; ++it) { const int idx = tid + 512 * it; \
            gk[it] = *(const u32x4*)(Pb + (size_t)((kblk) * 128 + (idx >> 3)) * LDP + C_K + c * 64 + (idx & 7) * 8); \
            gv[it] = *(const u32x4*)(vtb + (size_t)(idx >> 4) * SEQ + (kblk) * 128 + (idx & 15) * 8); } } while (0)
#define DSA_LSTORE(bufi) do { _Pragma("unroll") for (int it = 0; it < 2; ++it) { const int idx = tid + 512 * it; \
            *(LAS u32x4*)(KT + (bufi) * 9216 + (idx >> 3) * 72 + (idx & 7) * 8) = gk[it]; \
            *(LAS u32x4*)(VTT + (bufi) * 8704 + (idx >> 4) * 136 + (idx & 15) * 8) = gv[it]; } } while (0)
        DSA_GLOAD(0);
        LDS_BAR();
        DSA_LSTORE(0);
        LDS_BAR();
#pragma unroll 1
        for (int kb = 0; kb < nblk; ++kb) {
            const int buf = kb & 1;
            if (kb + 1 < nblk) DSA_GLOAD(kb + 1);
            const LAS bf16_t* Kb = KT + buf * 9216; const LAS bf16_t* Vb = VTT + buf * 8704;
#pragma unroll 1
            for (int sl = 0; sl < 4; ++sl) {
                const int sg = kb * 4 + sl;
                if (sg < nsteps) {
                    f32x4 st[2][2];
#pragma unroll
                    for (int tl = 0; tl < 2; ++tl) {
                        const LAS bf16_t* kr = Kb + (32 * sl + 16 * tl + n) * 72;
                        const bf16x8 a0 = *(const LAS bf16x8*)(kr + 8 * g), a1 = *(const LAS bf16x8*)(kr + 32 + 8 * g);
#pragma unroll
                        for (int j = 0; j < 2; ++j) {
                            f32x4 d = __builtin_amdgcn_mfma_f32_16x16x32_bf16(a0, bq[j][0], (f32x4){0.f, 0.f, 0.f, 0.f}, 0, 0, 0);
                            st[tl][j] = __builtin_amdgcn_mfma_f32_16x16x32_bf16(a1, bq[j][1], d, 0, 0, 0);
                        }
                    }
                    bf16x8 av[4];
#pragma unroll
                    for (int mt = 0; mt < 4; ++mt) {
                        const LAS bf16_t* vp = Vb + (mt * 16 + n) * 136 + 32 * sl + 4 * g;
                        const u32x2 lo = *(const LAS u32x2*)vp, hi = *(const LAS u32x2*)(vp + 16);
                        u32x4 t4; t4.x = lo.x; t4.y = lo.y; t4.z = hi.x; t4.w = hi.y;
                        av[mt] = __builtin_bit_cast(bf16x8, t4);
                    }
                    const unsigned mw = mq[sg];
#pragma unroll
                    for (int j = 0; j < 2; ++j) {
                        float p[8], ps = 0.f;
#pragma unroll
                        for (int tl = 0; tl < 2; ++tl)
#pragma unroll
                            for (int r = 0; r < 4; ++r) { const int bit = 16 * tl + 4 * g + r; const float e = __expf(fminf(st[tl][j][r] * 0.125f, 60.f)); p[4 * tl + r] = ((mw >> bit) & 1u) ? e : 0.f; ps += p[4 * tl + r]; }
                        lrun[j] += ps;
                        u32x4 pw; pw.x = pg8::cvt_pk_bf16(p[0], p[1]); pw.y = pg8::cvt_pk_bf16(p[2], p[3]); pw.z = pg8::cvt_pk_bf16(p[4], p[5]); pw.w = pg8::cvt_pk_bf16(p[6], p[7]);
                        const bf16x8 pb = __builtin_bit_cast(bf16x8, pw);
#pragma unroll
                        for (int mt = 0; mt < 4; ++mt) oacc[mt][j] = __builtin_amdgcn_mfma_f32_16x16x32_bf16(av[mt], pb, oacc[mt][j], 0, 0, 0);
                    }
                }
            }
            if (kb + 1 < nblk) DSA_LSTORE(buf ^ 1);
            LDS_BAR();
        }
#pragma unroll
        for (int j = 0; j < 2; ++j) {
            float lt = lrun[j]; lt += __shfl_xor(lt, 16); lt += __shfl_xor(lt, 32);
            const float il = 1.f / lt;
            bf16_t* op = X.P + ((size_t)b * SEQ + qq) * LDP + COL_YC + (c * 4 + 2 * j + (n >> 3)) * 64 + 4 * g;
#pragma unroll
            for (int mt = 0; mt < 4; ++mt) {
                const f32x4 o = oacc[mt][j] * il;
                u32x2 wv; wv.x = pg8::cvt_pk_bf16(o[0], o[1]); wv.y = pg8::cvt_pk_bf16(o[2], o[3]);
                *(u32x2*)(op + mt * 16) = wv;
            }
        }
    }
#undef DSA_GLOAD
#undef DSA_LSTORE
    __syncthreads();
}

__device__ __forceinline__ void phase_mixers(const Ctx& X0, LAS unsigned char* lds, int layer) {
#pragma unroll 1
    for (int task = X0.bid; task < 128; task += X0.G) {
        Ctx X = X0;
        { int t_ = threadIdx.x; asm volatile("" : "+v"(t_)); X.tid = t_; X.lane = t_ & 63; }
        if (task < 64) { if (TKMASK & 1) rwkv_task(X, lds, layer, task >> 3, task & 7); }
        else { const int k = task - 64; if (TKMASK & 2) hgrn_task(X, lds, layer, k >> 3, (k >> 1) & 3, k & 1); }
    }
    volatile LAS unsigned* tw = (volatile LAS unsigned*)(lds + LDS_BYTES - 128);
    unsigned* ctr = (unsigned*)(X0.ws + WS_BAR + 14336) + 16 * layer;
#pragma unroll 1
    for (;;) {
        Ctx X = X0;
        { int t_ = threadIdx.x; asm volatile("" : "+v"(t_)); X.tid = t_; X.lane = t_ & 63; }
        __syncthreads();
        if (threadIdx.x == 0) tw[0] = __hip_atomic_fetch_add(ctr, 1u, __ATOMIC_RELAXED, __HIP_MEMORY_SCOPE_AGENT);
        __syncthreads();
        const int t = (int)tw[0];
        if (t >= 256) break;
        if (TKMASK & 4) dsa_tile(X, lds, t & 7, 64 * (31 - (t >> 3)));
    }
}

__device__ __forceinline__ void phase_hgrn_post(const Ctx& X, int layer) {
    const int gw = X.bid * 8 + X.wave, NGW = X.G * 8;
    const float* gn = X.in[15] + layer * 512;
#pragma unroll 1
    for (int it0 = gw; it0 < T_TOK * 4; it0 += 4 * NGW) {
        unsigned ow[4], gwd[4]; unsigned* op[4];
#pragma unroll
        for (int r = 0; r < 4; ++r) {
            const int it = it0 + r * NGW < T_TOK * 4 ? it0 + r * NGW : it0;
            const int t = it >> 2, h = it & 3;
            bf16_t* rowp = X.P + (size_t)t * LDP;
            op[r] = (unsigned*)(rowp + COL_YB + h * 128) + X.lane;
            ow[r] = *op[r]; gwd[r] = *((const unsigned*)(rowp + COL_PB + 1536 + h * 128) + X.lane);
        }
#pragma unroll
        for (int r = 0; r < 4; ++r) {
            const int it = it0 + r * NGW;
            const int h = it & 3;
            const float o0 = bflo(ow[r]), o1 = bfhi(ow[r]), g0 = bflo(gwd[r]), g1 = bfhi(gwd[r]);
            const float rs = 1.f / sqrtf(wave_sum(o0 * o0 + o1 * o1) * (1.f / 128.f) + 1e-6f);
            const float y0 = o0 * rs * gn[h * 128 + 2 * X.lane] * (g0 * sigmoidf_(g0)), y1 = o1 * rs * gn[h * 128 + 2 * X.lane + 1] * (g1 * sigmoidf_(g1));
            if (it < T_TOK * 4) *op[r] = pk2(y0, y1);
        }
    }
}

__device__ __forceinline__ void phase_fixup(const Ctx& X, int layer) {
    const float* cw = X.in[20] + (size_t)layer * 3 * F2; const float* cb = X.in[21] + (size_t)layer * F2;
#pragma unroll 4
    for (int idx = X.bid * 512 + X.tid; idx < 256 * 2 * DFF; idx += X.G * 512) {
        const int j = idx % DFF, sr = idx / DFF, s = sr >> 1, r = sr & 1;
        const int colg = (j >> 7) * 256 + (j & 127), colv = colg + 128;
        const bool seq0 = (s & 31) == 0;
        const float* H = X.HALO;
        float res[2];
#pragma unroll
        for (int part = 0; part < 2; ++part) {
            const int cp = part ? colv : colg, co = part * DFF + j;
            const float u0 = H[(size_t)(s * 4 + r) * F2 + cp];
            float u1, u2;
            if (r == 0) { u1 = seq0 ? 0.f : H[(size_t)((s - 1) * 4 + 3) * F2 + cp]; u2 = seq0 ? 0.f : H[(size_t)((s - 1) * 4 + 2) * F2 + cp]; }
            else { u1 = H[(size_t)(s * 4 + 0) * F2 + cp]; u2 = seq0 ? 0.f : H[(size_t)((s - 1) * 4 + 3) * F2 + cp]; }
            res[part] = cb[co] + cw[co] * u2 + cw[F2 + co] * u1 + cw[2 * F2 + co] * u0;
        }
        const float a = res[0] * sigmoidf_(res[0]) * res[1];
        X.P[(size_t)(s * 64 + r) * LDP + COL_ACT + j] = (bf16_t)f2bf(a);
    }
}

#define XB_TMO      128
#define XB_XCNT(j)  (256  + 64 * (j))
#define XB_XSUB(j)  (1280 + 64 * (j))
#define XB_XGEN(j)  (2304 + 64 * (j))
#define XB_TOP      3328
#define XB_TOPGEN   3392
#define XCD_BAR_WORDS 3456
#define XB_SPIN_CAP (1u << 22)
__device__ __forceinline__ unsigned xb_ld(unsigned* p)              { return __hip_atomic_load(p, __ATOMIC_RELAXED, __HIP_MEMORY_SCOPE_AGENT); }
__device__ __forceinline__ unsigned xb_add(unsigned* p, unsigned v) { return __hip_atomic_fetch_add(p, v, __ATOMIC_RELAXED, __HIP_MEMORY_SCOPE_AGENT); }
__device__ __forceinline__ unsigned xb_xcc_id() { return (unsigned)__builtin_amdgcn_s_getreg((3 << 11) | 20) & 0xFu; }
#define XB_SPIN(cond, bar) do { unsigned _sp = 0; while (cond) { __builtin_amdgcn_s_sleep(1); \
    if ((++_sp & 255u) == 0u) { if (xb_ld(&(bar)[XB_TMO])) break; if (_sp > XB_SPIN_CAP) { atomicAdd(&(bar)[XB_TMO], 1u); break; } } } } while (0)
struct XcdBarrier { unsigned* bar; unsigned x; volatile LAS unsigned* st; };
__device__ __forceinline__ XcdBarrier xcd_barrier_post(unsigned* bar, volatile LAS unsigned* st) {
    XcdBarrier b; b.bar = bar; b.x = xb_xcc_id(); b.st = st;
    if (threadIdx.x == 0) (void)xb_add(&bar[XB_XCNT(b.x)], 1u);
    return b;
}
__device__ __forceinline__ void xcd_barrier_complete(unsigned* bar, unsigned x, unsigned& nloc, unsigned& nx) {
    const unsigned G = gridDim.x * gridDim.y * gridDim.z;
    unsigned sum, cnt, mine, sp = 0u;
    for (;;) {
        sum = 0u; cnt = 0u; mine = 0u;
#pragma unroll
        for (unsigned j = 0; j < 16; ++j) { const unsigned c = xb_ld(&bar[XB_XCNT(j)]); sum += c; cnt += (c > 0u) ? 1u : 0u; mine = (j == x) ? c : mine; }
        if (sum == G) break;
        __builtin_amdgcn_s_sleep(1);
        if ((++sp & 255u) == 0u) { if (xb_ld(&bar[XB_TMO])) break; if (sp > XB_SPIN_CAP) { atomicAdd(&bar[XB_TMO], 1u); break; } }
    }
    nloc = mine > 0u ? mine : 1u; nx = cnt > 0u ? cnt : 1u;
}
__device__ __forceinline__ void xcd_barrier(const XcdBarrier& b) {
    asm volatile("s_waitcnt vmcnt(0)" ::: "memory");
    __syncthreads();
    if (threadIdx.x == 0) {
        unsigned* bar = b.bar;
        __builtin_amdgcn_s_waitcnt(0);
        unsigned nloc = b.st[0], nx = b.st[1];
        if (nloc == 0u) { xcd_barrier_complete(bar, b.x, nloc, nx); b.st[0] = nloc; b.st[1] = nx; }
        const unsigned old = xb_add(&bar[XB_XSUB(b.x)], 1u);
        const unsigned gen = old / nloc;
        if (old + 1u == (gen + 1u) * nloc) {
            __builtin_amdgcn_fence(__ATOMIC_RELEASE, "agent");
            asm volatile("s_waitcnt vmcnt(0)" ::: "memory");
            const unsigned og = xb_add(&bar[XB_TOP], 1u);
            const unsigned tg = og / nx;
            if (og + 1u == (tg + 1u) * nx) xb_add(&bar[XB_TOPGEN], 1u);
            else XB_SPIN(xb_ld(&bar[XB_TOPGEN]) == tg, bar);
            __builtin_amdgcn_fence(__ATOMIC_ACQUIRE, "agent");
            xb_add(&bar[XB_XGEN(b.x)], 1u);
            asm volatile("s_waitcnt vmcnt(0)" ::: "memory");
        } else {
            XB_SPIN(xb_ld(&bar[XB_XGEN(b.x)]) == gen, bar);
            __builtin_amdgcn_fence(__ATOMIC_ACQUIRE, "agent");
            asm volatile("s_waitcnt vmcnt(0)" ::: "memory");
        }
    }
    __syncthreads();
}

__global__ void __launch_bounds__(512, 2) mk_fwd(Args args) {
    extern __shared__ __attribute__((aligned(16))) unsigned char lds_raw[];
    LAS unsigned char* lds = (LAS unsigned char*)lds_raw;
    Ctx X;
#pragma unroll
    for (int i = 0; i < 24; ++i) X.in[i] = args.in[i];
    X.out = args.out; X.ws = args.ws;
    X.P = (bf16_t*)(args.ws + WS_P); X.VT = (bf16_t*)(args.ws + WS_VT); X.HALO = (float*)(args.ws + WS_HALO); X.ROPE = (float*)(args.ws + WS_ROPE);
    X.Win = (bf16_t*)(args.ws + WS_WIN); X.Wg = (bf16_t*)(args.ws + WS_WG); X.Wbr = (bf16_t*)(args.ws + WS_WBR);
    X.Wo = (bf16_t*)(args.ws + WS_WO); X.Wup = (bf16_t*)(args.ws + WS_WUP); X.Wdn = (bf16_t*)(args.ws + WS_WDN);
    X.tid = threadIdx.x; X.lane = X.tid & 63; X.wave = __builtin_amdgcn_readfirstlane(X.tid >> 6); X.G = gridDim.x; X.bid = blockIdx.x;

#if PROBE_DOUBLE
    for (int ph2 = args.ph_lo * 2; ph2 < args.ph_hi * 2; ++ph2) {
        const int ph = ph2 >> 1;
        const int layer = ph / 11, sub = ph % 11;
        const bool skip_ = (ph2 & 1) && !(ph < 22 && ((REPMASK >> sub) & 1));
#else
    volatile LAS unsigned* bst = (volatile LAS unsigned*)(lds + LDS_BYTES - 64);
    if (threadIdx.x < 2) bst[threadIdx.x] = 0u;
    __syncthreads();
    XcdBarrier gbar = xcd_barrier_post((unsigned*)(args.ws + WS_BAR), bst);
    for (int ph = args.ph_lo; ph < args.ph_hi; ++ph) {
        const int layer = ph / 11, sub = ph % 11;
        const bool skip_ = false;
#endif
        { int t_ = threadIdx.x; asm volatile("" : "+v"(t_)); X.tid = t_; X.lane = t_ & 63; }

        if (skip_) {
        } else if (ph == 22 && (PHMASK & 1024)) {
            const int gw = X.bid * 8 + X.wave, NGW = X.G * 8;
            (void)gw; (void)NGW; rms_pass(X, X.out, X.in[23], nullptr, X.out);
        } else if (sub == 0 && (PHMASK & 1)) {
            phase_prep(X, lds, layer);
        } else if (sub == 1 && (PHMASK & 2)) {
            pg8::Gemm g{X.P, X.Win, LDP, DM, DM}; pg8::StaticOrder S; S.init(T_TOK, 5120, X.G, X.bid);
            pg8::EpiInProj E{X.P, X.VT, X.ROPE, (bf16_t*)(X.ws + WS_BND)};
            pg8::gemm_phase<pg8::EpiInProj, true>(lds, g, S, E, X.tid);
        } else if (sub == 2 && (PHMASK & 4)) {
            phase_rwkv_pre(X, lds, layer);
        } else if (sub == 3 && (PHMASK & 4)) {
            phase_mixers(X, lds, layer);
        } else if (sub == 4 && (PHMASK & 8)) {
            phase_hgrn_post(X, layer);
            { const int gw = X.bid * 8 + X.wave, NGW = X.G * 8; const float* hh = (layer == 0) ? X.in[0] : X.out; const float* g = X.in[1] + (size_t)layer * DM;
              (void)gw; (void)NGW; rms_pass(X, hh, g, X.P, nullptr); }
        } else if (sub == 5 && (PHMASK & 16)) {
#pragma unroll 1
            for (int br = 0; br < 3; ++br) {
                { pg8::Gemm g{X.P, X.Wg + (size_t)br * DM * DM, LDP, DM, DM}; pg8::StaticOrder S; S.init(T_TOK, DM, X.G, X.bid);
                  int t_ = X.tid; asm volatile("" : "+v"(t_));
                  pg8::EpiGate E{X.P}; pg8::gemm_phase<pg8::EpiGate, true>(lds, g, S, E, t_); }
                { const int ycol = br == 0 ? COL_YA : (br == 1 ? COL_YB : COL_YC);
                  pg8::Gemm g{X.P + ycol, X.Wbr + (size_t)br * DM * 512, LDP, 512, 512}; pg8::StaticOrder S; S.init(T_TOK, DM, X.G, X.bid);
                  int t_ = X.tid; asm volatile("" : "+v"(t_));
                  pg8::EpiMergeAcc E{X.P, br == 0 ? 1 : 0}; pg8::gemm_phase<pg8::EpiMergeAcc, true>(lds, g, S, E, t_); }
            }
        } else if (sub == 6 && (PHMASK & 32)) {
            pg8::Gemm g{X.P + COL_MRG, X.Wo, LDP, DM, DM}; pg8::StaticOrder S; S.init(T_TOK, DM, X.G, X.bid);
            pg8::EpiResid E{layer == 0 ? X.in[0] : X.out, X.out};
            pg8::gemm_phase<pg8::EpiResid, true>(lds, g, S, E, X.tid);
        } else if (sub == 7 && (PHMASK & 64)) {
            const int gw = X.bid * 8 + X.wave, NGW = X.G * 8;
            const float* g = X.in[18] + (size_t)layer * DM;
            (void)gw; (void)NGW; rms_pass(X, X.out, g, X.P, nullptr);
        } else if (sub == 8 && (PHMASK & 128)) {
            pg8::Gemm g{X.P, X.Wup, LDP, DM, DM}; pg8::StaticOrder S; S.init(T_TOK, F2, X.G, X.bid);
            pg8::EpiUp E{X.P, X.HALO, X.in[20] + (size_t)layer * 3 * F2, X.in[21] + (size_t)layer * F2, (LAS float*)(lds + 131072)};
            pg8::gemm_phase<pg8::EpiUp, true>(lds, g, S, E, X.tid);
        } else if (sub == 9 && (PHMASK & 256)) {
            phase_fixup(X, layer);
        } else if (sub == 10 && (PHMASK & 512)) {
            pg8::Gemm g{X.P + COL_ACT, X.Wdn, LDP, DFF, DFF}; pg8::StaticOrder S; S.init(T_TOK, DM, X.G, X.bid);
            pg8::EpiResid E{X.out, X.out};
            pg8::gemm_phase<pg8::EpiResid, true>(lds, g, S, E, X.tid);
        }
#if PROBE_DOUBLE
        if (ph2 + 1 < args.ph_hi * 2) cg::this_grid().sync();
#else
        if (ph + 1 < args.ph_hi) { if (args.ph_hi > 1000) cg::this_grid().sync(); else xcd_barrier(gbar); }
#endif
    }
}

extern "C" void kernel_launch(void* const* d_in, const int* in_sizes, int n_in, void* d_out, int out_size, void* d_ws, size_t ws_size, hipStream_t stream) {
    static int grid = 0;
    if (grid == 0) {
        int dev = 0, cus = 0, per_cu = 0;
        (void)hipGetDevice(&dev);
        (void)hipDeviceGetAttribute(&cus, hipDeviceAttributeMultiprocessorCount, dev);
        if (hipFuncSetAttribute((const void*)mk_fwd, hipFuncAttributeMaxDynamicSharedMemorySize, LDS_BYTES) != hipSuccess) fprintf(stderr, "kernel_launch: hipFuncSetAttribute failed\n");
        if (hipOccupancyMaxActiveBlocksPerMultiprocessor(&per_cu, (const void*)mk_fwd, 512, LDS_BYTES) != hipSuccess || per_cu < 1) { fprintf(stderr, "kernel_launch: occupancy query gave %d\n", per_cu); per_cu = 1; }
        (void)hipGetLastError();
        grid = cus * 1;
        if (grid <= 0) grid = 256;
        if (ws_size < (size_t)268435456) fprintf(stderr, "kernel_launch: workspace too small (%zu)\n", ws_size);
    }
    Args a{};
    for (int i = 0; i < 24; ++i) a.in[i] = (const float*)d_in[i];
    a.out = (float*)d_out; a.ws = (unsigned char*)d_ws;
#if MK_SINGLE
    (void)hipMemsetAsync((char*)d_ws + WS_BAR, 0, 16384, stream);
    a.ph_lo = 0; a.ph_hi = 23;
    void* kargs[] = {&a};
    hipError_t e = hipLaunchCooperativeKernel((const void*)mk_fwd, dim3(grid), dim3(512), kargs, LDS_BYTES, stream);
    if (e != hipSuccess) fprintf(stderr, "cooperative launch failed: %s (grid %d)\n", hipGetErrorString(e), grid);
#else
    for (int ph = 0; ph < 23; ++ph) {
        a.ph_lo = ph; a.ph_hi = ph + 1;
        hipLaunchKernelGGL(mk_fwd, dim3(grid), dim3(512), LDS_BYTES, stream, a);
    }
#endif
}
```

```cpp
#include <hip/hip_runtime.h>
#include <hip/hip_cooperative_groups.h>
#include <cstdio>
#include <cstdint>
namespace cg = cooperative_groups;

#ifndef PHMASK
#define PHMASK 2047
#endif
#ifndef REPMASK
#define REPMASK 0
#endif
#ifndef PROBE_DOUBLE
#define PROBE_DOUBLE 0
#endif
#ifndef PROBE_SCAN2
#define PROBE_SCAN2 0
#endif
#ifndef TKMASK
#define TKMASK 7
#endif
#ifndef MK_SINGLE
#define MK_SINGLE 1
#endif

#define LAS __attribute__((address_space(3)))
typedef unsigned short bf16_t;
typedef short bf16x8 __attribute__((ext_vector_type(8)));
typedef float f32x4 __attribute__((ext_vector_type(4)));
typedef float f32x2 __attribute__((ext_vector_type(2)));
typedef unsigned u32x4 __attribute__((ext_vector_type(4)));
typedef unsigned u32x2 __attribute__((ext_vector_type(2)));

constexpr int T_TOK = 16384, SEQ = 2048, DM = 1024;
constexpr int LDP = 6208;
constexpr int COL_PA = 1024, COL_PB = 2816, COL_PC = 4864;
constexpr int COL_YA = 1024, COL_MRG = 1536, COL_G = 2816, COL_YB = 3840, COL_YC = 4864, COL_ACT = 1024;
constexpr int C_Q = 4864, C_K = 5376, C_QI = 5632, C_KI = 5888, C_WI = 5952;
constexpr int IN_COLS = 8004, DFF = 2816, F2 = 5632;
constexpr size_t WS_WIN = 0, WS_WG = 10485760, WS_WBR = 16777216, WS_WO = 19922944, WS_WUP = 22020096, WS_WDN = 33554432;
constexpr size_t WS_P = 39321600, WS_HALO = 242745344, WS_VT = WS_HALO, WS_ROPE = 265814016, WS_BAR = 266338304, WS_BND = WS_HALO + 4194304, WS_SCAL = WS_HALO + 8388608;
constexpr int LDS_BYTES = 153600;
constexpr int SCS = 2052;
constexpr int MASK_OFF = 16 * SCS * 4;

struct Args { const float* in[24]; float* out; unsigned char* ws; int ph_lo, ph_hi; };

__device__ __forceinline__ unsigned f2bf(float f) { unsigned u = __builtin_bit_cast(unsigned, f); return (u + 0x7fffu + ((u >> 16) & 1u)) >> 16; }
__device__ __forceinline__ unsigned pk2(float lo, float hi) { return f2bf(lo) | (f2bf(hi) << 16); }
__device__ __forceinline__ float bf2f(bf16_t b) { return __builtin_bit_cast(float, (unsigned)b << 16); }
__device__ __forceinline__ float bflo(unsigned w) { return __builtin_bit_cast(float, w << 16); }
__device__ __forceinline__ float bfhi(unsigned w) { return __builtin_bit_cast(float, w & 0xffff0000u); }
__device__ __forceinline__ float wave_sum(float v) {
#pragma unroll
    for (int o = 1; o < 64; o <<= 1) v += __shfl_xor(v, o);
    return v;
}
__device__ __forceinline__ int wave_sum_i(int v) {
#pragma unroll
    for (int o = 1; o < 64; o <<= 1) v += __shfl_xor(v, o);
    return v;
}
template <int CTRL> __device__ __forceinline__ float dpp_mov(float x) {
    return __builtin_bit_cast(float, __builtin_amdgcn_update_dpp(0, __builtin_bit_cast(int, x), CTRL, 0xF, 0xF, true));
}
__device__ __forceinline__ float red8(float x) { x += dpp_mov<0xB1>(x); x += dpp_mov<0x4E>(x); x += dpp_mov<0x141>(x); return x; }
__device__ __forceinline__ float red16(float x) { x = red8(x); x += dpp_mov<0x140>(x); return x; }
__device__ __forceinline__ float sigmoidf_(float x) { return 1.f / (1.f + __expf(-x)); }

namespace pg8 {
constexpr int BM = 256, BK = 64, HALF = 128, HTB = HALF * BK * 2, NXCD = 8, WGM = 8;
__device__ __forceinline__ int lds_byte(int r, int c) { const int st = (r >> 4) * 2 + (c >> 5), rr = r & 15, cc = c & 31, ob = rr * 64 + cc * 2; return st * 1024 + (ob ^ (((ob >> 9) & 1) << 5)); }
__device__ __forceinline__ void stage_rc(int b, int& R, int& C) { const int st = b / 1024, sb = b % 1024, swz = sb ^ (((sb >> 9) & 1) << 5); R = (st >> 1) * 16 + swz / 64; C = (st & 1) * 32 + (swz % 64) / 2; }
__device__ __forceinline__ int perm32(int rho) { const int n = rho >> 4, i = rho & 15; return 8 * (i >> 2) + 4 * n + (i & 3); }
struct Unit { int pm, pn; };
struct Gemm { const bf16_t* A; const bf16_t* Bt; int lda, ldb, K; };
struct StaticOrder {
    int nM, nN, nwg, G, c;
    __device__ void init(int M, int N, int G_, int c_) { nM = M / BM; nN = N / BM; nwg = nM * nN; G = G_; c = c_; }
    __device__ bool next(int i, Unit& u) const {
        const long L = (long)i * G + c; if (L >= nwg) return false;
        int wgid = (int)L; { const int q = nwg / NXCD, r = nwg % NXCD, xcd = wgid % NXCD, off = wgid / NXCD; wgid = (xcd < r ? xcd * (q + 1) : r * (q + 1) + (xcd - r) * q) + off; }
        const int nig = WGM * nN, gid = wgid / nig, fm = gid * WGM, gsz = (nM - fm) < WGM ? (nM - fm) : WGM;
        u.pm = fm + ((wgid % nig) % gsz); u.pn = (wgid % nig) / gsz; return true;
    }
};
__device__ __forceinline__ unsigned cvt_pk_bf16(float lo, float hi) { unsigned r; asm volatile("v_cvt_pk_bf16_f32 %0, %1, %2" : "=v"(r) : "v"(lo), "v"(hi)); return r; }

template <class Epi, bool ALIGN_EPI>
__device__ __forceinline__ void gemm_phase(LAS unsigned char* lds, const Gemm g, const StaticOrder& S, const Epi& E, const int tid) {
    const int wid = __builtin_amdgcn_readfirstlane(tid >> 6), lane = tid & 63, wr = wid >> 2, wc = wid & 3, fr = lane & 15, fq = lane >> 4;
    const int K = g.K, nt = K / BK;
    unsigned voffA[2], voffB[2];
#pragma unroll
    for (int i = 0; i < 2; ++i) { int R, C; stage_rc(tid * 16 + i * 8192, R, C); const int Rb = (R & ~31) + perm32(R & 31);
        voffA[i] = (unsigned)(R * g.lda + C) * 2u; voffB[i] = (unsigned)(Rb * g.ldb + C) * 2u; }
    const size_t kstep = (size_t)(BK * 2);
    const size_t hstepA = (size_t)HALF * g.lda * 2, hstepB = (size_t)HALF * g.ldb * 2;
    const size_t tstepA = 2 * hstepA, tstepB = 2 * hstepB;
    const unsigned ldsw = (unsigned)wid * 1024u;
    const int aoff = lds_byte(wr * 64 + fr, fq * 8), boff = lds_byte(wc * 32 + fr, fq * 8);
#define PG8_SA(b, h) (((b) * 2 + (h)) * HTB)
#define PG8_SB(b, h) ((4 + (b) * 2 + (h)) * HTB)
#define PG8_STAGE(bufoff, gbase, voff) do { _Pragma("unroll") for (int _i = 0; _i < 2; ++_i) \
        __builtin_amdgcn_global_load_lds((const unsigned*)((const char*)(gbase) + (voff)[_i]), (LAS unsigned*)(lds + (bufoff) + ldsw + _i * 8192), 16, 0, 0); } while (0)
#define PG8_LDA(dst, b, h) do { _Pragma("unroll") for (int m = 0; m < 4; ++m) _Pragma("unroll") for (int k = 0; k < 2; ++k) dst[m][k] = *(const LAS bf16x8*)(lds + PG8_SA(b, h) + aoff + m * 2048 + k * 1024); } while (0)
#define PG8_LDB(dst, b, h) do { _Pragma("unroll") for (int n = 0; n < 2; ++n) _Pragma("unroll") for (int k = 0; k < 2; ++k) dst[n][k] = *(const LAS bf16x8*)(lds + PG8_SB(b, h) + boff + n * 2048 + k * 1024); } while (0)
#define PG8_MMA(ai, bj, At, Bt) do { __builtin_amdgcn_s_setprio(1); _Pragma("unroll") for (int m = 0; m < 4; ++m) _Pragma("unroll") for (int n = 0; n < 2; ++n) _Pragma("unroll") for (int k = 0; k < 2; ++k) \
        acc[ai][bj][m][n] = __builtin_amdgcn_mfma_f32_16x16x32_bf16(Bt[n][k], At[m][k], acc[ai][bj][m][n], 0, 0, 0); __builtin_amdgcn_s_setprio(0); } while (0)
#define PG8_WAIT_V(n) asm volatile("s_waitcnt vmcnt(" #n ")" ::: "memory")
#define PG8_WAIT_L(n) asm volatile("s_waitcnt lgkmcnt(" #n ")" ::: "memory")
#define PG8_BAR __builtin_amdgcn_s_barrier()
#define PG8_SCHED __builtin_amdgcn_sched_barrier(0)
    Unit cur, nxt; int ui = 0;
    if (!S.next(0, cur)) return;
    f32x4 acc[2][2][4][2];
#pragma unroll
    for (int a = 0; a < 2; ++a)
#pragma unroll
        for (int b = 0; b < 2; ++b)
#pragma unroll
            for (int m = 0; m < 4; ++m)
#pragma unroll
                for (int n = 0; n < 2; ++n) acc[a][b][m][n] = (f32x4){0.f, 0.f, 0.f, 0.f};
    bf16x8 At[4][2], B0[2][2], B1[2][2];
    const char* cA = (const char*)g.A + (size_t)cur.pm * tstepA; const char* cB = (const char*)g.Bt + (size_t)cur.pn * tstepB;
    PG8_STAGE(PG8_SB(0, 0), cB, voffB); PG8_STAGE(PG8_SB(0, 1), cB + hstepB, voffB); PG8_STAGE(PG8_SA(0, 0), cA, voffA); PG8_STAGE(PG8_SA(0, 1), cA + hstepA, voffA);
    if (wr == 1) PG8_BAR;
    PG8_WAIT_V(2); PG8_BAR;
    PG8_STAGE(PG8_SB(1, 0), cB + kstep, voffB); PG8_STAGE(PG8_SA(1, 0), cA + kstep, voffA); PG8_STAGE(PG8_SB(1, 1), cB + hstepB + kstep, voffB);
    PG8_WAIT_V(6); PG8_BAR;
    for (;;) {
        const bool has_next = S.next(ui + 1, nxt);
        const char* nA = has_next ? (const char*)g.A + (size_t)nxt.pm * tstepA : cA; const char* nB = has_next ? (const char*)g.Bt + (size_t)nxt.pn * tstepB : cB;
        for (int t = 0; t < nt; t += 2) {
            const bool last = (t == nt - 2);
            const char* a1 = cA + (size_t)(t + 1) * kstep;
            const char* a2 = last ? nA : cA + (size_t)(t + 2) * kstep; const char* b2 = last ? nB : cB + (size_t)(t + 2) * kstep;
            const char* a3 = a2 + kstep; const char* b3 = b2 + kstep;
            PG8_LDB(B0, 0, 0); PG8_LDB(B1, 0, 1); PG8_SCHED; PG8_LDA(At, 0, 0); PG8_STAGE(PG8_SA(1, 1), a1 + hstepA, voffA);
            PG8_WAIT_V(8); PG8_WAIT_L(0); PG8_BAR; PG8_MMA(0, 0, At, B0); PG8_MMA(0, 1, At, B1); PG8_BAR; PG8_SCHED;
            PG8_LDA(At, 0, 1); PG8_STAGE(PG8_SB(0, 0), b2, voffB); PG8_STAGE(PG8_SB(0, 1), b2 + hstepB, voffB); PG8_STAGE(PG8_SA(0, 0), a2, voffA);
            PG8_WAIT_V(8); PG8_WAIT_L(0); PG8_BAR; PG8_MMA(1, 0, At, B0); PG8_MMA(1, 1, At, B1); PG8_BAR; PG8_SCHED;
            PG8_LDB(B0, 1, 0); PG8_LDB(B1, 1, 1); PG8_SCHED; PG8_LDA(At, 1, 0); PG8_STAGE(PG8_SA(0, 1), a2 + hstepA, voffA);
            PG8_WAIT_V(8); PG8_WAIT_L(0); PG8_BAR; PG8_MMA(0, 0, At, B0); PG8_MMA(0, 1, At, B1); PG8_BAR; PG8_SCHED;
            PG8_LDA(At, 1, 1); PG8_STAGE(PG8_SB(1, 0), b3, voffB); PG8_STAGE(PG8_SB(1, 1), b3 + hstepB, voffB); PG8_STAGE(PG8_SA(1, 0), a3, voffA);
            PG8_WAIT_V(8); PG8_WAIT_L(0); PG8_BAR; PG8_MMA(1, 0, At, B0); PG8_MMA(1, 1, At, B1); PG8_BAR; PG8_SCHED;
        }
        if constexpr (ALIGN_EPI) { if (wr == 0) PG8_BAR; }
        E(acc, cur, wr, wc, fr, fq);
        if (!has_next) break;
#pragma unroll
        for (int a = 0; a < 2; ++a)
#pragma unroll
            for (int b = 0; b < 2; ++b)
#pragma unroll
                for (int m = 0; m < 4; ++m)
#pragma unroll
                    for (int n = 0; n < 2; ++n) acc[a][b][m][n] = (f32x4){0.f, 0.f, 0.f, 0.f};
        cur = nxt; cA = nA; cB = nB; ++ui;
        if constexpr (ALIGN_EPI) { if (wr == 1) PG8_BAR; }
    }
    PG8_WAIT_V(0);
    if constexpr (!ALIGN_EPI) { if (wr == 0) PG8_BAR; }
    PG8_BAR;
#undef PG8_SA
#undef PG8_SB
#undef PG8_STAGE
#undef PG8_LDA
#undef PG8_LDB
#undef PG8_MMA
#undef PG8_WAIT_V
#undef PG8_WAIT_L
#undef PG8_BAR
#undef PG8_SCHED
}

typedef f32x4 AccT[2][2][4][2];

struct EpiInProj {
    bf16_t* P; bf16_t* VT; const float* rope; bf16_t* BND;
    __device__ __forceinline__ void operator()(AccT& acc, const Unit& u, int wr, int wc, int fr, int fq) const {
        const int row0 = u.pm * BM + wr * 64 + fr, colb = u.pn * BM + wc * 32 + 8 * fq;
#pragma unroll
        for (int ai = 0; ai < 2; ++ai)
#pragma unroll
            for (int m = 0; m < 4; ++m) {
                const int row = row0 + ai * HALF + m * 16, t = row & (SEQ - 1);
                bf16_t* rowp = P + (size_t)row * LDP + COL_PA;
#pragma unroll
                for (int bj = 0; bj < 2; ++bj) {
                    const int c = colb + bj * HALF;
                    f32x4 v0 = acc[ai][bj][m][0], v1 = acc[ai][bj][m][1];
                    if (u.pn >= 15) {
                        const int cl = c - 3840;
                        if (cl < 640 || (cl >= 768 && cl < 1088)) {
                            const float* cs = rope + ((size_t)t * 32 + ((cl & 63) >> 1)) * 2;
                            const f32x4 r0 = *(const f32x4*)cs, r1 = *(const f32x4*)(cs + 4);
                            f32x4 o0, o1;
                            o0[0] = v0[0] * r0[0] - v0[1] * r0[1]; o0[1] = v0[1] * r0[0] + v0[0] * r0[1];
                            o0[2] = v0[2] * r0[2] - v0[3] * r0[3]; o0[3] = v0[3] * r0[2] + v0[2] * r0[3];
                            o1[0] = v1[0] * r1[0] - v1[1] * r1[1]; o1[1] = v1[1] * r1[0] + v1[0] * r1[1];
                            o1[2] = v1[2] * r1[2] - v1[3] * r1[3]; o1[3] = v1[3] * r1[2] + v1[2] * r1[3];
                            v0 = o0; v1 = o1;
                        }
                    }
                    u32x4 w; w.x = cvt_pk_bf16(v0[0], v0[1]); w.y = cvt_pk_bf16(v0[2], v0[3]); w.z = cvt_pk_bf16(v1[0], v1[1]); w.w = cvt_pk_bf16(v1[2], v1[3]);
                    *(u32x4*)(rowp + c) = w;
                    if (u.pn < 7 && fr == 15) *(u32x4*)(BND + (size_t)(row >> 4) * 1792 + c) = w;
                    if (u.pn == 17 && bj == 1) {
                        const int cv = c - 3840 - 640, b = row >> 11;
                        bf16_t* vt = VT + ((size_t)(b * 2 + (cv >> 6)) * 64 + (cv & 63)) * SEQ + t;
                        vt[0 * SEQ] = (bf16_t)(w.x & 0xffffu); vt[1 * SEQ] = (bf16_t)(w.x >> 16);
                        vt[2 * SEQ] = (bf16_t)(w.y & 0xffffu); vt[3 * SEQ] = (bf16_t)(w.y >> 16);
                        vt[4 * SEQ] = (bf16_t)(w.z & 0xffffu); vt[5 * SEQ] = (bf16_t)(w.z >> 16);
                        vt[6 * SEQ] = (bf16_t)(w.w & 0xffffu); vt[7 * SEQ] = (bf16_t)(w.w >> 16);
                    }
                }
            }
    }
};
struct EpiGate {
    bf16_t* P;
    __device__ __forceinline__ void operator()(AccT& acc, const Unit& u, int wr, int wc, int fr, int fq) const {
        const int row0 = u.pm * BM + wr * 64 + fr, colb = u.pn * BM + wc * 32 + 8 * fq;
#pragma unroll
        for (int ai = 0; ai < 2; ++ai)
#pragma unroll
            for (int m = 0; m < 4; ++m) {
                bf16_t* rowp = P + (size_t)(row0 + ai * HALF + m * 16) * LDP + COL_G + colb;
#pragma unroll
                for (int bj = 0; bj < 2; ++bj) {
                    const f32x4 v0 = acc[ai][bj][m][0], v1 = acc[ai][bj][m][1];
                    u32x4 w; w.x = cvt_pk_bf16(sigmoidf_(v0[0]), sigmoidf_(v0[1])); w.y = cvt_pk_bf16(sigmoidf_(v0[2]), sigmoidf_(v0[3]));
                    w.z = cvt_pk_bf16(sigmoidf_(v1[0]), sigmoidf_(v1[1])); w.w = cvt_pk_bf16(sigmoidf_(v1[2]), sigmoidf_(v1[3]));
                    *(u32x4*)(rowp + bj * HALF) = w;
                }
            }
    }
};
struct EpiMergeAcc {
    bf16_t* P; int first;
    __device__ __forceinline__ void operator()(AccT& acc, const Unit& u, int wr, int wc, int fr, int fq) const {
        const int row0 = u.pm * BM + wr * 64 + fr, colb = u.pn * BM + wc * 32 + 8 * fq;
#pragma unroll
        for (int ai = 0; ai < 2; ++ai)
#pragma unroll
            for (int m = 0; m < 4; ++m) {
                bf16_t* rowb = P + (size_t)(row0 + ai * HALF + m * 16) * LDP + colb;
#pragma unroll
                for (int bj = 0; bj < 2; ++bj) {
                    const f32x4 v0 = acc[ai][bj][m][0], v1 = acc[ai][bj][m][1];
                    const u32x4 gq = *(const u32x4*)(rowb + COL_G + bj * HALF);
                    u32x4 mq = (u32x4){0u, 0u, 0u, 0u};
                    if (!first) mq = *(const u32x4*)(rowb + COL_MRG + bj * HALF);
                    const unsigned ga = gq.x, gb = gq.y, gc = gq.z, gd = gq.w;
                    const unsigned ma = mq.x, mb = mq.y, mc = mq.z, md = mq.w;
                    u32x4 w;
                    w.x = cvt_pk_bf16(bflo(ma) + bflo(ga) * v0[0], bfhi(ma) + bfhi(ga) * v0[1]);
                    w.y = cvt_pk_bf16(bflo(mb) + bflo(gb) * v0[2], bfhi(mb) + bfhi(gb) * v0[3]);
                    w.z = cvt_pk_bf16(bflo(mc) + bflo(gc) * v1[0], bfhi(mc) + bfhi(gc) * v1[1]);
                    w.w = cvt_pk_bf16(bflo(md) + bflo(gd) * v1[2], bfhi(md) + bfhi(gd) * v1[3]);
                    *(u32x4*)(rowb + COL_MRG + bj * HALF) = w;
                }
            }
    }
};
struct EpiResid {
    const float* base; float* out;
    __device__ __forceinline__ void operator()(AccT& acc, const Unit& u, int wr, int wc, int fr, int fq) const {
        const int row0 = u.pm * BM + wr * 64 + fr, colb = u.pn * BM + wc * 32 + 8 * fq;
#pragma unroll
        for (int ai = 0; ai < 2; ++ai)
#pragma unroll
            for (int m = 0; m < 4; ++m) {
                const size_t off = (size_t)(row0 + ai * HALF + m * 16) * DM + colb;
#pragma unroll
                for (int bj = 0; bj < 2; ++bj) {
                    const f32x4 b0 = *(const f32x4*)(base + off + bj * HALF), b1 = *(const f32x4*)(base + off + bj * HALF + 4);
                    *(f32x4*)(out + off + bj * HALF) = b0 + acc[ai][bj][m][0];
                    *(f32x4*)(out + off + bj * HALF + 4) = b1 + acc[ai][bj][m][1];
                }
            }
    }
};
struct EpiUp {
    bf16_t* P; float* HALO; const float* cw; const float* cb; LAS float* CW;
    __device__ __forceinline__ void operator()(AccT& acc, const Unit& u, int wr, int wc, int fr_in, int fq_in) const {
        int fr = fr_in, fq = fq_in;
        asm volatile("" : "+v"(fr), "+v"(fq));
        const int row0 = u.pm * BM + wr * 64 + fr;
        const int jb = u.pn * 128 + wc * 32 + 8 * fq;
        {
            const int tl = (wr * 4 + wc) * 64 + fq * 16 + fr;
#pragma unroll
            for (int it = 0; it < 2; ++it) { const int k = tl + 512 * it, p = k >> 8, col = k & 255, co = (col >> 7) * DFF + u.pn * 128 + (col & 127);
                CW[k] = (p < 3) ? cw[p * F2 + co] : cb[co]; }
            asm volatile("s_waitcnt lgkmcnt(0)" ::: "memory"); __builtin_amdgcn_s_barrier(); asm volatile("" ::: "memory");
        }
#pragma unroll
        for (int ai = 0; ai < 2; ++ai) {
            const int s = u.pm * 4 + ai * 2 + wr;
#pragma unroll
            for (int bj = 0; bj < 2; ++bj)
#pragma unroll
                for (int n = 0; n < 2; ++n) {
                    const int colp = u.pn * BM + bj * HALF + wc * 32 + 8 * fq + 4 * n;
                    if (fr < 2) *(f32x4*)(HALO + (size_t)(s * 4 + fr) * F2 + colp) = acc[ai][bj][0][n];
                    if (fr >= 14) *(f32x4*)(HALO + (size_t)(s * 4 + fr - 12) * F2 + colp) = acc[ai][bj][3][n];
                }
        }
#pragma unroll
        for (int ai = 0; ai < 2; ++ai)
#pragma unroll
            for (int m = 0; m < 4; ++m) {
                const int row = row0 + ai * HALF + m * 16;
#pragma unroll
                for (int n = 0; n < 2; ++n) {
                    f32x4 cv[2];
#pragma unroll
                    for (int bj = 0; bj < 2; ++bj) {
                        const int cl = bj * 128 + wc * 32 + 8 * fq + 4 * n;
                        const f32x4 w0 = *(const LAS f32x4*)&CW[cl], w1 = *(const LAS f32x4*)&CW[256 + cl], w2 = *(const LAS f32x4*)&CW[512 + cl], bb = *(const LAS f32x4*)&CW[768 + cl];
#pragma unroll
                        for (int e = 0; e < 4; ++e) {
                            const float cur = acc[ai][bj][m][n][e];
                            const float prv = m > 0 ? acc[ai][bj][m > 0 ? m - 1 : 0][n][e] : 0.f;
                            const float a1 = dpp_mov<0x121>(cur), a2 = dpp_mov<0x122>(cur), b1 = dpp_mov<0x121>(prv), b2 = dpp_mov<0x122>(prv);
                            const float p1 = fr >= 1 ? a1 : b1, p2 = fr >= 2 ? a2 : b2;
                            cv[bj][e] = bb[e] + w0[e] * p2 + w1[e] * p1 + w2[e] * cur;
                        }
                        __builtin_amdgcn_sched_barrier(0);
                    }
                    const f32x4 g0 = cv[0], v0 = cv[1];
                    u32x2 w;
                    w.x = cvt_pk_bf16(g0[0] * sigmoidf_(g0[0]) * v0[0], g0[1] * sigmoidf_(g0[1]) * v0[1]);
                    w.y = cvt_pk_bf16(g0[2] * sigmoidf_(g0[2]) * v0[2], g0[3] * sigmoidf_(g0[3]) * v0[3]);
                    if (!(m == 0 && fr < 2)) *(u32x2*)(P + (size_t)row * LDP + COL_ACT + jb + 4 * n) = w;
                    __builtin_amdgcn_sched_barrier(0);
                }
            }
    }
};
}

struct Ctx {
    const float* in[24]; float* out; unsigned char* ws;
    bf16_t* P; bf16_t* VT; float* HALO; float* ROPE;
    bf16_t *Win, *Wg, *Wbr, *Wo, *Wup, *Wdn;
    int tid, lane, wave, G, bid;
};

__device__ __forceinline__ int srccol(int mode, int n) {
    if (mode == 0) return n;
    if (mode == 2) return 4932 + n;
    if (mode == 3) { const int tile = n >> 8, w = n & 255, j = tile * 128 + (w & 127); return (w < 128) ? j : DFF + j; }
    if (n < 3840) return n;
    const int c = n - 3840;
    if (c >= 1092) return -1;
    if (c < 640 || (c >= 768 && c < 1088)) { const int base = c & ~63, i = c & 63; return 3840 + base + (i >> 1) + 32 * (i & 1); }
    return 3840 + c;
}
__device__ __forceinline__ void tr_item(const float* W, int ldw, int K, int N, bf16_t* WT, int mode, int item, LAS float* scr, int lane) {
    const int nblk = N / 32, kb = item / nblk, nb = item % nblk, k0 = 64 * kb, n0 = 32 * nb;
    const int sc = srccol(mode, n0 + (lane & 31));
    float wv_[32];
#pragma unroll
    for (int i = 0; i < 32; ++i) { const int kk = 2 * i + (lane >> 5); wv_[i] = (sc >= 0) ? W[(size_t)(k0 + kk) * ldw + sc] : 0.f; }
#pragma unroll
    for (int i = 0; i < 32; ++i) { const int kk = 2 * i + (lane >> 5); scr[kk * 33 + (lane & 31)] = wv_[i]; }
    asm volatile("s_waitcnt lgkmcnt(0)" ::: "memory");
    const int c = lane & 7;
#pragma unroll
    for (int j = 0; j < 4; ++j) { const int n = (lane >> 3) + 8 * j; const LAS float* s = scr + (8 * c) * 33 + n;
        u32x4 o; o.x = pk2(s[0 * 33], s[1 * 33]); o.y = pk2(s[2 * 33], s[3 * 33]); o.z = pk2(s[4 * 33], s[5 * 33]); o.w = pk2(s[6 * 33], s[7 * 33]);
        *(u32x4*)(WT + (size_t)(n0 + n) * K + k0 + 8 * c) = o; }
    asm volatile("s_waitcnt lgkmcnt(0)" ::: "memory");
}
__device__ __forceinline__ void rms_row(const float* xrow, const float* g, bf16_t* obf, float* of32, int lane) {
    const f32x4* xr = (const f32x4*)xrow + lane; const f32x4* gr = (const f32x4*)g + lane;
    f32x4 v[4]; float s = 0.f;
#pragma unroll
    for (int j = 0; j < 4; ++j) { v[j] = xr[64 * j]; s += (v[j].x * v[j].x + v[j].y * v[j].y) + (v[j].z * v[j].z + v[j].w * v[j].w); }
    const float rs = 1.f / sqrtf(wave_sum(s) * (1.f / DM) + 1e-6f);
#pragma unroll
    for (int j = 0; j < 4; ++j) {
        const f32x4 gg = gr[64 * j]; const f32x4 o = v[j] * rs * gg;
        if (obf) { u32x2 w; w.x = pk2(o.x, o.y); w.y = pk2(o.z, o.w); *((u32x2*)obf + lane + 64 * j) = w; }
        else *((f32x4*)of32 + lane + 64 * j) = o;
    }
}
__device__ __forceinline__ void rms_pass(const Ctx& X, const float* src, const float* g, bf16_t* obf, float* of32) {
    const int gw = X.bid * 8 + X.wave, NGW = X.G * 8, lane = X.lane;
    const f32x4* gr = (const f32x4*)g + lane;
    f32x4 gg[4];
#pragma unroll
    for (int j = 0; j < 4; ++j) gg[j] = gr[64 * j];
#pragma unroll 1
    for (int m = gw; m < T_TOK; m += 4 * NGW) {
        f32x4 v[4][4]; float ss[4]; int mr[4];
#pragma unroll
        for (int r = 0; r < 4; ++r) { mr[r] = m + r * NGW; const int ml = mr[r] < T_TOK ? mr[r] : m; const f32x4* x = (const f32x4*)(src + (size_t)ml * DM) + lane;
#pragma unroll
            for (int j = 0; j < 4; ++j) v[r][j] = x[64 * j]; }
#pragma unroll
        for (int r = 0; r < 4; ++r) { float a = 0.f;
#pragma unroll
            for (int j = 0; j < 4; ++j) a += (v[r][j].x * v[r][j].x + v[r][j].y * v[r][j].y) + (v[r][j].z * v[r][j].z + v[r][j].w * v[r][j].w);
            ss[r] = 1.f / sqrtf(wave_sum(a) * (1.f / DM) + 1e-6f); }
#pragma unroll
        for (int r = 0; r < 4; ++r) {
            if (mr[r] < T_TOK) {
#pragma unroll
                for (int j = 0; j < 4; ++j) {
                    const f32x4 o = v[r][j] * ss[r] * gg[j];
                    if (obf) { u32x2 w; w.x = pk2(o.x, o.y); w.y = pk2(o.z, o.w); *((u32x2*)(obf + (size_t)mr[r] * LDP) + lane + 64 * j) = w; }
                    else *((f32x4*)(of32 + (size_t)mr[r] * DM) + lane + 64 * j) = o;
                }
            }
        }
    }
}
__device__ __forceinline__ void phase_prep(const Ctx& X, LAS unsigned char* lds, int layer) {
    LAS float* scr = (LAS float*)(lds + X.wave * 8448);
    const int gw = X.bid * 8 + X.wave, NGW = X.G * 8;
    constexpr int I_IN = 16 * 160, I_G = 16 * 96, I_BR = 8 * 32, I_O = 16 * 32, I_UP = 16 * 176, I_DN = 44 * 32;
    constexpr int NITEMS = I_IN + I_G + 3 * I_BR + I_O + I_UP + I_DN;
    const float* w_in = X.in[2] + (size_t)layer * DM * IN_COLS;
    const float* w_br = X.in[16] + (size_t)layer * 3 * 512 * DM;
    const float* w_o = X.in[17] + (size_t)layer * DM * DM;
    const float* w_up = X.in[19] + (size_t)layer * DM * F2;
    const float* w_dn = X.in[22] + (size_t)layer * DFF * DM;
    for (int it = gw; it < NITEMS; it += NGW) {
        int r = it;
        if (r < I_IN) { tr_item(w_in, IN_COLS, DM, 5120, X.Win, 1, r, scr, X.lane); continue; } r -= I_IN;
        if (r < I_G) { tr_item(w_in, IN_COLS, DM, 3072, X.Wg, 2, r, scr, X.lane); continue; } r -= I_G;
        if (r < 3 * I_BR) { const int b = r / I_BR; tr_item(w_br + (size_t)b * 512 * DM, DM, 512, DM, X.Wbr + (size_t)b * DM * 512, 0, r % I_BR, scr, X.lane); continue; } r -= 3 * I_BR;
        if (r < I_O) { tr_item(w_o, DM, DM, DM, X.Wo, 0, r, scr, X.lane); continue; } r -= I_O;
        if (r < I_UP) { tr_item(w_up, F2, DM, F2, X.Wup, 3, r, scr, X.lane); continue; } r -= I_UP;
        tr_item(w_dn, DM, DFF, DM, X.Wdn, 0, r, scr, X.lane);
    }
    const float* h = (layer == 0) ? X.in[0] : X.out;
    const float* g = X.in[1] + (size_t)layer * DM;
    rms_pass(X, h, g, X.P, nullptr);
    if (layer == 0) {
        for (int idx = X.bid * 512 + X.tid; idx < SEQ * 32; idx += X.G * 512) {
            const int t = idx >> 5, p = idx & 31;
            const float inv = exp2f(-(float)p * 0.03125f * 13.287712379549449f);
            const float ang = (float)t * inv;
            const double rev = (double)ang * 0.15915494309189535;
            const float fr = (float)(rev - floor(rev));
            X.ROPE[2 * idx] = __builtin_amdgcn_cosf(fr); X.ROPE[2 * idx + 1] = __builtin_amdgcn_sinf(fr);
        }
    }
}

__device__ __forceinline__ float wave_sum_fast(float x) {
    x = red16(x);
    const float r0 = __builtin_bit_cast(float, __builtin_amdgcn_readlane(__builtin_bit_cast(int, x), 0)), r1 = __builtin_bit_cast(float, __builtin_amdgcn_readlane(__builtin_bit_cast(int, x), 16));
    const float r2 = __builtin_bit_cast(float, __builtin_amdgcn_readlane(__builtin_bit_cast(int, x), 32)), r3 = __builtin_bit_cast(float, __builtin_amdgcn_readlane(__builtin_bit_cast(int, x), 48));
    return (r0 + r1) + (r2 + r3);
}
#define LDS_BAR() do { asm volatile("s_waitcnt lgkmcnt(0)" ::: "memory"); __builtin_amdgcn_s_barrier(); asm volatile("" ::: "memory"); } while (0)
constexpr int RW_TS = 16, RW_NCH = SEQ / RW_TS, RW_BUF = 33280;
__device__ __forceinline__ void phase_rwkv_pre(const Ctx& X, LAS unsigned char* lds, int layer) {
    LAS float* Rr = (LAS float*)(lds);           LAS float* Kk = (LAS float*)(lds + 8192);   LAS float* Vv = (LAS float*)(lds + 16384);
    LAS float* W1 = (LAS float*)(lds + 24576);   LAS float* AS = (LAS float*)(lds + 32768);
    LAS bf16_t* WDb = (LAS bf16_t*)(lds + 40960);
    LAS bf16_t* ADb = (LAS bf16_t*)(lds + 45568);
    LAS bf16_t* WTu = (LAS bf16_t*)(lds + 50176);
    LAS bf16_t* WTa = (LAS bf16_t*)(lds + 59392);
    LAS float* MU = (LAS float*)(lds + 68608);
    const int tid = X.tid, lane = tid & 63, wv = X.wave;
    const float* mu = X.in[3] + layer * 1792;
    const float* w0 = X.in[4] + layer * 512;   const float* w_up = X.in[5] + (size_t)layer * 64 * 512;
    const float* a0 = X.in[6] + layer * 512;   const float* a_up = X.in[7] + (size_t)layer * 64 * 512;
    const float* k_k = X.in[9] + layer * 512;  const float* k_a = X.in[10] + layer * 512;  const float* r_k = X.in[11] + layer * 512;
    const bf16_t* BND = (const bf16_t*)(X.ws + WS_BND);
    float* SCAL = (float*)(X.ws + WS_SCAL);
    const int ln = lane & 15, lg = lane >> 4;
    int last_h = -1;
    float q_w0 = 0.f, q_a0 = 0.f;
    f32x4 p_kk4 = (f32x4){0.f, 0.f, 0.f, 0.f}, p_ka4 = p_kk4, p_rk4 = p_kk4;
    const int cg4 = (tid & 15) * 4;
    u32x4 pc4[3], pp4[3]; bool have_pf = false;
    pc4[0] = pc4[1] = pc4[2] = pp4[0] = pp4[1] = pp4[2] = (u32x4){0u, 0u, 0u, 0u};
#define PRE_LOAD(uu) do { const int h_ = (uu) & 7, tp_ = (uu) >> 3; _Pragma("unroll") for (int it = 0; it < 3; ++it) { const int idx = tid + 512 * it; pc4[it] = (u32x4){0u, 0u, 0u, 0u}; pp4[it] = (u32x4){0u, 0u, 0u, 0u}; \
        if (idx < 32 * 40) { const int tt = idx / 40, vv = idx - tt * 40; \
            const int col = vv < 8 ? h_ * 64 + 8 * vv : (vv < 16 ? 512 + h_ * 64 + 8 * (vv - 8) : (vv < 24 ? 1024 + h_ * 64 + 8 * (vv - 16) : 1536 + 8 * (vv - 24))); \
            const size_t row = (size_t)tp_ * 32 + tt; pc4[it] = *(const u32x4*)(X.P + row * LDP + COL_PA + col); \
            if (tt > 0) pp4[it] = *(const u32x4*)(X.P + (row - 1) * LDP + COL_PA + col); else if ((tp_ & 63) != 0) pp4[it] = *(const u32x4*)(BND + (size_t)(2 * tp_ - 1) * 1792 + col); } } } while (0)
#pragma unroll 1
    for (int u = X.bid; u < 4096; u += X.G) {
        const int h = u & 7, tp = u >> 3;
        if (h != last_h) {
            __syncthreads();
            for (int idx = tid; idx < 64 * 64; idx += 512) { const int m = idx >> 6, cc = idx & 63;
                WTu[cc * 72 + m] = (bf16_t)f2bf(w_up[m * 512 + h * 64 + cc]); WTa[cc * 72 + m] = (bf16_t)f2bf(a_up[m * 512 + h * 64 + cc]); }
            if (tid < 320) { const int cc = tid; const int col = cc < 64 ? h * 64 + cc : (cc < 128 ? 512 + h * 64 + cc - 64 : (cc < 192 ? 1024 + h * 64 + cc - 128 : 1536 + cc - 192)); MU[cc] = mu[col]; }
            p_kk4 = *(const f32x4*)(k_k + h * 64 + cg4); p_ka4 = *(const f32x4*)(k_a + h * 64 + cg4); p_rk4 = *(const f32x4*)(r_k + h * 64 + cg4);
            q_w0 = w0[h * 64 + 16 * (wv >> 1) + ln]; q_a0 = a0[h * 64 + 16 * (wv >> 1) + ln];
            last_h = h;
            __syncthreads();
        }
        if (!have_pf) { PRE_LOAD(u); }
#pragma unroll
        for (int it = 0; it < 3; ++it) {
            const int idx = tid + 512 * it;
            if (idx < 32 * 40) {
                const int tt = idx / 40, vv = idx - tt * 40, cc0 = 8 * vv;
                const u32x4 c4 = pc4[it], p4 = pp4[it];
                const f32x4 m0 = *(const LAS f32x4*)&MU[cc0], m1 = *(const LAS f32x4*)&MU[cc0 + 4];
                float cur[8], prv[8], val[8];
                cur[0] = bflo(c4.x); cur[1] = bfhi(c4.x); cur[2] = bflo(c4.y); cur[3] = bfhi(c4.y); cur[4] = bflo(c4.z); cur[5] = bfhi(c4.z); cur[6] = bflo(c4.w); cur[7] = bfhi(c4.w);
                prv[0] = bflo(p4.x); prv[1] = bfhi(p4.x); prv[2] = bflo(p4.y); prv[3] = bfhi(p4.y); prv[4] = bflo(p4.z); prv[5] = bfhi(p4.z); prv[6] = bflo(p4.w); prv[7] = bfhi(p4.w);
#pragma unroll
                for (int e = 0; e < 8; ++e) val[e] = cur[e] + (prv[e] - cur[e]) * (e < 4 ? m0[e & 3] : m1[e & 3]);
                if (vv < 24) {
#pragma unroll
                    for (int e = 0; e < 8; ++e) val[e] = bf2f((bf16_t)f2bf(val[e]));
                    LAS float* dst = (vv < 8 ? Rr : (vv < 16 ? Kk : Vv)) + tt * 64 + 8 * (vv & 7);
                    *(LAS f32x4*)dst = (f32x4){val[0], val[1], val[2], val[3]}; *(LAS f32x4*)(dst + 4) = (f32x4){val[4], val[5], val[6], val[7]};
                } else {
                    const int lr0 = 8 * (vv - 24);
                    LAS bf16_t* dst;
                    if (lr0 < 64) { dst = WDb + tt * 72 + lr0;
#pragma unroll
                        for (int e = 0; e < 8; ++e) { const float ex = __expf(2.f * val[e]); val[e] = 1.f - 2.f / (ex + 1.f); } }
                    else dst = ADb + tt * 72 + lr0 - 64;
                    u32x4 o; o.x = pk2(val[0], val[1]); o.y = pk2(val[2], val[3]); o.z = pk2(val[4], val[5]); o.w = pk2(val[6], val[7]);
                    *(LAS u32x4*)dst = o;
                }
            }
        }
        have_pf = false;
        if (u + X.G < 4096 && ((u + X.G) & 7) == h) { PRE_LOAD(u + X.G); have_pf = true; }
        LDS_BAR();
        {
            const int mt = wv & 1, nt = wv >> 1, chm = 16 * nt + ln;
            f32x4 cw_ = (f32x4){0.f, 0.f, 0.f, 0.f}, ca_ = cw_;
#pragma unroll
            for (int ks = 0; ks < 2; ++ks) {
                const bf16x8 xa = *(const LAS bf16x8*)&WDb[(16 * mt + ln) * 72 + ks * 32 + 8 * lg], xb = *(const LAS bf16x8*)&WTu[(16 * nt + ln) * 72 + ks * 32 + 8 * lg];
                cw_ = __builtin_amdgcn_mfma_f32_16x16x32_bf16(xa, xb, cw_, 0, 0, 0);
                const bf16x8 ya = *(const LAS bf16x8*)&ADb[(16 * mt + ln) * 72 + ks * 32 + 8 * lg], yb = *(const LAS bf16x8*)&WTa[(16 * nt + ln) * 72 + ks * 32 + 8 * lg];
                ca_ = __builtin_amdgcn_mfma_f32_16x16x32_bf16(ya, yb, ca_, 0, 0, 0);
            }
#pragma unroll
            for (int r = 0; r < 4; ++r) {
                const int tt = 16 * mt + 4 * lg + r;
                const float z = -(q_w0 + cw_[r]);
                const float sp = fmaxf(z, 0.f) + __logf(1.f + __expf(-fabsf(z)));
                const float e = __expf(-sp - 0.5f);
                W1[tt * 64 + chm] = bf2f((bf16_t)f2bf(-expm1f(-e)));
                AS[tt * 64 + chm] = bf2f((bf16_t)f2bf(sigmoidf_(q_a0 + ca_[r])));
            }
        }
        LDS_BAR();
        {
            const int tt = tid >> 4;
            const size_t row = (size_t)tp * 32 + tt;
            const f32x4 w1 = *(const LAS f32x4*)&W1[tt * 64 + cg4], a = *(const LAS f32x4*)&AS[tt * 64 + cg4];
            const f32x4 kraw = *(const LAS f32x4*)&Kk[tt * 64 + cg4], r = *(const LAS f32x4*)&Rr[tt * 64 + cg4], v = *(const LAS f32x4*)&Vv[tt * 64 + cg4];
            const f32x4 kk0 = kraw * p_kk4;
            const float inv = 1.f / sqrtf(fmaxf(red16((kk0.x * kk0.x + kk0.y * kk0.y) + (kk0.z * kk0.z + kk0.w * kk0.w)), 1e-24f));
            const f32x4 kk = kk0 * inv;
            const f32x4 kmod = kraw * (1.f + (a - 1.f) * p_ka4);
            const f32x4 bvec = kk * a, t1 = bvec * r, t2 = kmod * r, t3 = t2 * p_rk4;
            const float br = red16((t1.x + t1.y) + (t1.z + t1.w)), kr = red16((t2.x + t2.y) + (t2.z + t2.w)), bonus = red16((t3.x + t3.y) + (t3.z + t3.w));
            bf16_t* rp_ = X.P + row * LDP;
            u32x2 o;
            o.x = pk2(r.x, r.y); o.y = pk2(r.z, r.w); *(u32x2*)(rp_ + COL_PA + h * 64 + cg4) = o;
            o.x = pk2(kraw.x, kraw.y); o.y = pk2(kraw.z, kraw.w); *(u32x2*)(rp_ + COL_PA + 512 + h * 64 + cg4) = o;
            o.x = pk2(v.x, v.y); o.y = pk2(v.z, v.w); *(u32x2*)(rp_ + COL_PA + 1024 + h * 64 + cg4) = o;
            o.x = pk2(w1.x, w1.y); o.y = pk2(w1.z, w1.w); *(u32x2*)(rp_ + h * 64 + cg4) = o;
            o.x = pk2(a.x, a.y); o.y = pk2(a.z, a.w); *(u32x2*)(rp_ + 512 + h * 64 + cg4) = o;
            if (cg4 == 0) *(f32x4*)(SCAL + (row * 8 + h) * 4) = (f32x4){inv, br, kr, bonus};
        }
        LDS_BAR();
    }
}

__device__ __forceinline__ void rwkv_task(const Ctx& X, LAS unsigned char* lds, int layer, int b, int h) {
    LAS bf16_t* GDb = (LAS bf16_t*)(lds + 66560);
    LAS bf16_t* WTg = (LAS bf16_t*)(lds + 70912);
    LAS float* BON = (LAS float*)(lds + 88320);
    const int tid = X.tid, lane = tid & 63;
    const bool helper = X.wave >= 4;
    const int ht = tid & 255;
    const float* mu = X.in[3] + layer * 1792;
    const float* g_up = X.in[8] + (size_t)layer * 128 * 512;
    const float* k_k = X.in[9] + layer * 512;  const float* k_a = X.in[10] + layer * 512;
    const float* gn_g = X.in[12] + layer * 512; const float* gn_b = X.in[13] + layer * 512;
    const float* SCAL = (const float*)(X.ws + WS_SCAL);
    const int tt_h = ht >> 4, cg4 = (ht & 15) * 4;
    const f32x4 p_kk = *(const f32x4*)(k_k + h * 64 + cg4), p_ka = *(const f32x4*)(k_a + h * 64 + cg4);
    const f32x4 p_gg = *(const f32x4*)(gn_g + h * 64 + cg4), p_gb = *(const f32x4*)(gn_b + h * 64 + cg4);
    const int gv8 = (ht & 15) * 8;
    const f32x4 mg0 = *(const f32x4*)(mu + 1664 + gv8), mg1 = *(const f32x4*)(mu + 1664 + gv8 + 4);
    const int nt = (ht >> 6), ln = lane & 15, lg = lane >> 4, chm = 16 * nt + ln;
    const int rp = ht >> 3, jg = ht & 7, i0 = 2 * rp;
    for (int idx = tid; idx < 128 * 64; idx += 512) { const int m = idx >> 6, cc = idx & 63; WTg[cc * 136 + m] = (bf16_t)f2bf(g_up[m * 512 + h * 64 + cc]); }
    f32x2 S0[4], S1[4];
#pragma unroll
    for (int j = 0; j < 4; ++j) { S0[j] = (f32x2){0.f, 0.f}; S1[j] = (f32x2){0.f, 0.f}; }
#if PROBE_SCAN2
    f32x2 T0[4], T1[4];
#pragma unroll
    for (int j = 0; j < 4; ++j) { T0[j] = (f32x2){0.f, 0.f}; T1[j] = (f32x2){0.f, 0.f}; }
#endif
    __syncthreads();

#define RW_ARR(bufi, k) ((LAS float*)(lds + (bufi) * RW_BUF + (k) * 4096))
#define RW_SC(bufi) ((LAS float*)(lds + (bufi) * RW_BUF + 32768))
#define RW_LOAD(chk, L) do { const size_t row_ = (size_t)b * SEQ + (chk) * RW_TS + tt_h; const bf16_t* rp_ = X.P + row_ * LDP; \
        l_r##L = *(const u32x2*)(rp_ + COL_PA + h * 64 + cg4); l_k##L = *(const u32x2*)(rp_ + COL_PA + 512 + h * 64 + cg4); l_v##L = *(const u32x2*)(rp_ + COL_PA + 1024 + h * 64 + cg4); \
        l_w##L = *(const u32x2*)(rp_ + h * 64 + cg4); l_a##L = *(const u32x2*)(rp_ + 512 + h * 64 + cg4); l_s##L = *(const f32x4*)(SCAL + (row_ * 8 + h) * 4); \
        l_gc##L = *(const u32x4*)(rp_ + COL_PA + 1664 + gv8); l_gp##L = (u32x4){0u, 0u, 0u, 0u}; if ((chk) * RW_TS + tt_h > 0) l_gp##L = *(const u32x4*)(rp_ - LDP + COL_PA + 1664 + gv8); } while (0)
    u32x2 l_rA, l_kA, l_vA, l_wA, l_aA; f32x4 l_sA; u32x4 l_gcA, l_gpA;
    u32x2 l_rB, l_kB, l_vB, l_wB, l_aB; f32x4 l_sB; u32x4 l_gcB, l_gpB;
    l_rA = l_kA = l_vA = l_wA = l_aA = l_rB = l_kB = l_vB = l_wB = l_aB = (u32x2){0u, 0u}; l_sA = l_sB = (f32x4){0.f, 0.f, 0.f, 0.f}; l_gcA = l_gpA = l_gcB = l_gpB = (u32x4){0u, 0u, 0u, 0u};
    if (helper) { RW_LOAD(0, A); RW_LOAD(1, B); }

#pragma unroll 1
    for (int i0_ = -1; i0_ < RW_NCH; i0_ += 2) {
        { const int i = i0_;

        const int bufn = (i + 1) & 1, bufc = i & 1;
        if (helper) {
            const bool do_prep = (i + 1 < RW_NCH);
            if (i >= 1) {
                LAS float* Yy = RW_ARR(bufn, 7); LAS float* Gg = RW_ARR(bufn, 6); LAS float* Vv = RW_ARR(bufn, 5); LAS float* SC = RW_SC(bufn);
                const f32x4 y = *(const LAS f32x4*)&Yy[tt_h * 64 + cg4], gg = *(const LAS f32x4*)&Gg[tt_h * 64 + cg4], vv = *(const LAS f32x4*)&Vv[tt_h * 64 + cg4];
                const float bonus = BON[((i - 1) % 3) * 16 + tt_h];
                const float mean = red16((y.x + y.y) + (y.z + y.w)) * (1.f / 64.f);
                const f32x4 d = y - mean;
                const float var = red16((d.x * d.x + d.y * d.y) + (d.z * d.z + d.w * d.w)) * (1.f / 64.f);
                const float rs = 1.f / sqrtf(var + 64e-5f);
                const f32x4 o = (d * rs * p_gg + p_gb + vv * bonus) * gg;
                u32x2 w; w.x = pk2(o.x, o.y); w.y = pk2(o.z, o.w);
                *(u32x2*)(X.P + ((size_t)b * SEQ + (i - 1) * RW_TS + tt_h) * LDP + COL_YA + h * 64 + cg4) = w;
            }
            if (do_prep) {
                const f32x4 r = (f32x4){bflo(l_rA.x), bfhi(l_rA.x), bflo(l_rA.y), bfhi(l_rA.y)}, k = (f32x4){bflo(l_kA.x), bfhi(l_kA.x), bflo(l_kA.y), bfhi(l_kA.y)};
                const f32x4 v = (f32x4){bflo(l_vA.x), bfhi(l_vA.x), bflo(l_vA.y), bfhi(l_vA.y)}, w1 = (f32x4){bflo(l_wA.x), bfhi(l_wA.x), bflo(l_wA.y), bfhi(l_wA.y)};
                const f32x4 a = (f32x4){bflo(l_aA.x), bfhi(l_aA.x), bflo(l_aA.y), bfhi(l_aA.y)};
                const f32x4 kk = k * p_kk * l_sA.x;
                const f32x4 decay = 1.f - w1;
                *(LAS f32x4*)&RW_ARR(bufn, 0)[tt_h * 64 + cg4] = -kk;
                *(LAS f32x4*)&RW_ARR(bufn, 1)[tt_h * 64 + cg4] = decay * r;
                *(LAS f32x4*)&RW_ARR(bufn, 2)[tt_h * 64 + cg4] = decay;
                *(LAS f32x4*)&RW_ARR(bufn, 3)[tt_h * 64 + cg4] = kk * a;
                *(LAS f32x4*)&RW_ARR(bufn, 4)[tt_h * 64 + cg4] = k * (1.f + (a - 1.f) * p_ka);
                *(LAS f32x4*)&RW_ARR(bufn, 5)[tt_h * 64 + cg4] = v;
                if (cg4 == 0) { LAS float* SC = RW_SC(bufn); SC[tt_h * 4 + 0] = l_sA.y; SC[tt_h * 4 + 1] = l_sA.z; BON[((i + 1) % 3) * 16 + tt_h] = l_sA.w; }
                float gc[8], gp[8];
                gc[0] = bflo(l_gcA.x); gc[1] = bfhi(l_gcA.x); gc[2] = bflo(l_gcA.y); gc[3] = bfhi(l_gcA.y); gc[4] = bflo(l_gcA.z); gc[5] = bfhi(l_gcA.z); gc[6] = bflo(l_gcA.w); gc[7] = bfhi(l_gcA.w);
                gp[0] = bflo(l_gpA.x); gp[1] = bfhi(l_gpA.x); gp[2] = bflo(l_gpA.y); gp[3] = bfhi(l_gpA.y); gp[4] = bflo(l_gpA.z); gp[5] = bfhi(l_gpA.z); gp[6] = bflo(l_gpA.w); gp[7] = bfhi(l_gpA.w);
#pragma unroll
                for (int e = 0; e < 8; ++e) gc[e] = sigmoidf_(gc[e] + (gp[e] - gc[e]) * (e < 4 ? mg0[e & 3] : mg1[e & 3]));
                u32x4 o; o.x = pk2(gc[0], gc[1]); o.y = pk2(gc[2], gc[3]); o.z = pk2(gc[4], gc[5]); o.w = pk2(gc[6], gc[7]);
                *(LAS u32x4*)&GDb[tt_h * 136 + gv8] = o;
            }
            if (i + 3 < RW_NCH) RW_LOAD(i + 3, A);
            LDS_BAR();
            if (do_prep) {
                LAS float* Gg = RW_ARR(bufn, 6);
                f32x4 cg_ = (f32x4){0.f, 0.f, 0.f, 0.f};
#pragma unroll
                for (int ks = 0; ks < 4; ++ks) {
                    const bf16x8 za = *(const LAS bf16x8*)&GDb[ln * 136 + ks * 32 + 8 * lg], zb = *(const LAS bf16x8*)&WTg[(16 * nt + ln) * 136 + ks * 32 + 8 * lg];
                    cg_ = __builtin_amdgcn_mfma_f32_16x16x32_bf16(za, zb, cg_, 0, 0, 0);
                }
#pragma unroll
                for (int r = 0; r < 4; ++r) Gg[(4 * lg + r) * 64 + chm] = cg_[r];
            }
            LDS_BAR();
        } else {
            LAS float* A_ = RW_ARR(bufc, 0); LAS float* WR = RW_ARR(bufc, 1); LAS float* Wd = RW_ARR(bufc, 2); LAS float* Bv = RW_ARR(bufc, 3);
            LAS float* Kk = RW_ARR(bufc, 4); LAS float* Vv = RW_ARR(bufc, 5); LAS float* Yy = RW_ARR(bufc, 7); LAS float* SC = RW_SC(bufc);
#pragma unroll 1
            for (int q4 = 0; q4 < 4; ++q4) {
                if (i >= 0) {
                    f32x2 yk[4];
#pragma unroll
                    for (int s4 = 0; s4 < 4; ++s4) {
                        const int tt = 4 * q4 + s4;
                        const f32x4 a_lo = *(const LAS f32x4*)&A_[tt * 64 + 8 * jg], a_hi = *(const LAS f32x4*)&A_[tt * 64 + 8 * jg + 4];
                        const f32x4 r_lo = *(const LAS f32x4*)&WR[tt * 64 + 8 * jg], r_hi = *(const LAS f32x4*)&WR[tt * 64 + 8 * jg + 4];
                        const f32x4 w_lo = *(const LAS f32x4*)&Wd[tt * 64 + 8 * jg], w_hi = *(const LAS f32x4*)&Wd[tt * 64 + 8 * jg + 4];
                        const f32x4 b_lo = *(const LAS f32x4*)&Bv[tt * 64 + 8 * jg], b_hi = *(const LAS f32x4*)&Bv[tt * 64 + 8 * jg + 4];
                        const f32x4 k_lo = *(const LAS f32x4*)&Kk[tt * 64 + 8 * jg], k_hi = *(const LAS f32x4*)&Kk[tt * 64 + 8 * jg + 4];
                        const f32x2 vv = *(const LAS f32x2*)&Vv[tt * 64 + i0];
                        const f32x2 sc = *(const LAS f32x2*)&SC[tt * 4];
                        const f32x2 av[4] = {{a_lo.x, a_lo.y}, {a_lo.z, a_lo.w}, {a_hi.x, a_hi.y}, {a_hi.z, a_hi.w}};
                        const f32x2 rv[4] = {{r_lo.x, r_lo.y}, {r_lo.z, r_lo.w}, {r_hi.x, r_hi.y}, {r_hi.z, r_hi.w}};
                        const f32x2 wv[4] = {{w_lo.x, w_lo.y}, {w_lo.z, w_lo.w}, {w_hi.x, w_hi.y}, {w_hi.z, w_hi.w}};
                        const f32x2 bv[4] = {{b_lo.x, b_lo.y}, {b_lo.z, b_lo.w}, {b_hi.x, b_hi.y}, {b_hi.z, b_hi.w}};
                        const f32x2 kv[4] = {{k_lo.x, k_lo.y}, {k_lo.z, k_lo.w}, {k_hi.x, k_hi.y}, {k_hi.z, k_hi.w}};
                        f32x2 e10 = S0[0] * av[0], e20 = S0[0] * rv[0], e11 = S1[0] * av[0], e21 = S1[0] * rv[0];
#pragma unroll
                        for (int j = 1; j < 4; ++j) { e10 += S0[j] * av[j]; e20 += S0[j] * rv[j]; e11 += S1[j] * av[j]; e21 += S1[j] * rv[j]; }
                        const float d10 = red8(e10.x + e10.y), d20 = red8(e20.x + e20.y), d11 = red8(e11.x + e11.y), d21 = red8(e21.x + e21.y);
                        yk[s4] = (f32x2){d20 + d10 * sc.x + vv.x * sc.y, d21 + d11 * sc.x + vv.y * sc.y};
                        const f32x2 d10v = (f32x2){d10, d10}, d11v = (f32x2){d11, d11}, v0v = (f32x2){vv.x, vv.x}, v1v = (f32x2){vv.y, vv.y};
#pragma unroll
                        for (int j = 0; j < 4; ++j) { S0[j] = S0[j] * wv[j] + (d10v * bv[j] + v0v * kv[j]); S1[j] = S1[j] * wv[j] + (d11v * bv[j] + v1v * kv[j]); }
                    }
                    if (jg == 0) {
#pragma unroll
                        for (int s4 = 0; s4 < 4; ++s4) *(LAS f32x2*)&Yy[(4 * q4 + s4) * 64 + i0] = yk[s4];
                    }

#if PROBE_SCAN2
                    {
#pragma unroll
                    for (int s4 = 0; s4 < 4; ++s4) {
                        const int tt = 4 * q4 + s4;
                        const f32x4 a_lo = *(const LAS f32x4*)&A_[tt * 64 + 8 * jg], a_hi = *(const LAS f32x4*)&A_[tt * 64 + 8 * jg + 4];
                        const f32x4 r_lo = *(const LAS f32x4*)&WR[tt * 64 + 8 * jg], r_hi = *(const LAS f32x4*)&WR[tt * 64 + 8 * jg + 4];
                        const f32x4 w_lo = *(const LAS f32x4*)&Wd[tt * 64 + 8 * jg], w_hi = *(const LAS f32x4*)&Wd[tt * 64 + 8 * jg + 4];
                        const f32x4 b_lo = *(const LAS f32x4*)&Bv[tt * 64 + 8 * jg], b_hi = *(const LAS f32x4*)&Bv[tt * 64 + 8 * jg + 4];
                        const f32x4 k_lo = *(const LAS f32x4*)&Kk[tt * 64 + 8 * jg], k_hi = *(const LAS f32x4*)&Kk[tt * 64 + 8 * jg + 4];
                        const f32x2 vv = *(const LAS f32x2*)&Vv[tt * 64 + i0];
                        const f32x2 av[4] = {{a_lo.x, a_lo.y}, {a_lo.z, a_lo.w}, {a_hi.x, a_hi.y}, {a_hi.z, a_hi.w}};
                        const f32x2 rv[4] = {{r_lo.x, r_lo.y}, {r_lo.z, r_lo.w}, {r_hi.x, r_hi.y}, {r_hi.z, r_hi.w}};
                        const f32x2 wv[4] = {{w_lo.x, w_lo.y}, {w_lo.z, w_lo.w}, {w_hi.x, w_hi.y}, {w_hi.z, w_hi.w}};
                        const f32x2 bv[4] = {{b_lo.x, b_lo.y}, {b_lo.z, b_lo.w}, {b_hi.x, b_hi.y}, {b_hi.z, b_hi.w}};
                        const f32x2 kv[4] = {{k_lo.x, k_lo.y}, {k_lo.z, k_lo.w}, {k_hi.x, k_hi.y}, {k_hi.z, k_hi.w}};
                        f32x2 e10 = T0[0] * av[0], e20 = T0[0] * rv[0], e11 = T1[0] * av[0], e21 = T1[0] * rv[0];
#pragma unroll
                        for (int j = 1; j < 4; ++j) { e10 += T0[j] * av[j]; e20 += T0[j] * rv[j]; e11 += T1[j] * av[j]; e21 += T1[j] * rv[j]; }
                        const float d10 = red8(e10.x + e10.y), d20 = red8(e20.x + e20.y), d11 = red8(e11.x + e11.y), d21 = red8(e21.x + e21.y);
                        const f32x2 d10v = (f32x2){d10 + d20, d10}, d11v = (f32x2){d11 + d21, d11}, v0v = (f32x2){vv.x, vv.x}, v1v = (f32x2){vv.y, vv.y};
#pragma unroll
                        for (int j = 0; j < 4; ++j) { T0[j] = T0[j] * wv[j] + (d10v * bv[j] + v0v * kv[j]); T1[j] = T1[j] * wv[j] + (d11v * bv[j] + v1v * kv[j]); }
                    }
                    }
#endif
                }
                if (q4 & 1) LDS_BAR();
            }
        }
            }
        if (i0_ + 1 < RW_NCH) { const int i = i0_ + 1;

        const int bufn = (i + 1) & 1, bufc = i & 1;
        if (helper) {
            const bool do_prep = (i + 1 < RW_NCH);
            if (i >= 1) {
                LAS float* Yy = RW_ARR(bufn, 7); LAS float* Gg = RW_ARR(bufn, 6); LAS float* Vv = RW_ARR(bufn, 5); LAS float* SC = RW_SC(bufn);
                const f32x4 y = *(const LAS f32x4*)&Yy[tt_h * 64 + cg4], gg = *(const LAS f32x4*)&Gg[tt_h * 64 + cg4], vv = *(const LAS f32x4*)&Vv[tt_h * 64 + cg4];
                const float bonus = BON[((i - 1) % 3) * 16 + tt_h];
                const float mean = red16((y.x + y.y) + (y.z + y.w)) * (1.f / 64.f);
                const f32x4 d = y - mean;
                const float var = red16((d.x * d.x + d.y * d.y) + (d.z * d.z + d.w * d.w)) * (1.f / 64.f);
                const float rs = 1.f / sqrtf(var + 64e-5f);
                const f32x4 o = (d * rs * p_gg + p_gb + vv * bonus) * gg;
                u32x2 w; w.x = pk2(o.x, o.y); w.y = pk2(o.z, o.w);
                *(u32x2*)(X.P + ((size_t)b * SEQ + (i - 1) * RW_TS + tt_h) * LDP + COL_YA + h * 64 + cg4) = w;
            }
            if (do_prep) {
                const f32x4 r = (f32x4){bflo(l_rB.x), bfhi(l_rB.x), bflo(l_rB.y), bfhi(l_rB.y)}, k = (f32x4){bflo(l_kB.x), bfhi(l_kB.x), bflo(l_kB.y), bfhi(l_kB.y)};
                const f32x4 v = (f32x4){bflo(l_vB.x), bfhi(l_vB.x), bflo(l_vB.y), bfhi(l_vB.y)}, w1 = (f32x4){bflo(l_wB.x), bfhi(l_wB.x), bflo(l_wB.y), bfhi(l_wB.y)};
                const f32x4 a = (f32x4){bflo(l_aB.x), bfhi(l_aB.x), bflo(l_aB.y), bfhi(l_aB.y)};
                const f32x4 kk = k * p_kk * l_sB.x;
                const f32x4 decay = 1.f - w1;
                *(LAS f32x4*)&RW_ARR(bufn, 0)[tt_h * 64 + cg4] = -kk;
                *(LAS f32x4*)&RW_ARR(bufn, 1)[tt_h * 64 + cg4] = decay * r;
                *(LAS f32x4*)&RW_ARR(bufn, 2)[tt_h * 64 + cg4] = decay;
                *(LAS f32x4*)&RW_ARR(bufn, 3)[tt_h * 64 + cg4] = kk * a;
                *(LAS f32x4*)&RW_ARR(bufn, 4)[tt_h * 64 + cg4] = k * (1.f + (a - 1.f) * p_ka);
                *(LAS f32x4*)&RW_ARR(bufn, 5)[tt_h * 64 + cg4] = v;
                if (cg4 == 0) { LAS float* SC = RW_SC(bufn); SC[tt_h * 4 + 0] = l_sB.y; SC[tt_h * 4 + 1] = l_sB.z; BON[((i + 1) % 3) * 16 + tt_h] = l_sB.w; }
                float gc[8], gp[8];
                gc[0] = bflo(l_gcB.x); gc[1] = bfhi(l_gcB.x); gc[2] = bflo(l_gcB.y); gc[3] = bfhi(l_gcB.y); gc[4] = bflo(l_gcB.z); gc[5] = bfhi(l_gcB.z); gc[6] = bflo(l_gcB.w); gc[7] = bfhi(l_gcB.w);
                gp[0] = bflo(l_gpB.x); gp[1] = bfhi(l_gpB.x); gp[2] = bflo(l_gpB.y); gp[3] = bfhi(l_gpB.y); gp[4] = bflo(l_gpB.z); gp[5] = bfhi(l_gpB.z); gp[6] = bflo(l_gpB.w); gp[7] = bfhi(l_gpB.w);
#pragma unroll
                for (int e = 0; e < 8; ++e) gc[e] = sigmoidf_(gc[e] + (gp[e] - gc[e]) * (e < 4 ? mg0[e & 3] : mg1[e & 3]));
                u32x4 o; o.x = pk2(gc[0], gc[1]); o.y = pk2(gc[2], gc[3]); o.z = pk2(gc[4], gc[5]); o.w = pk2(gc[6], gc[7]);
                *(LAS u32x4*)&GDb[tt_h * 136 + gv8] = o;
            }
            if (i + 3 < RW_NCH) RW_LOAD(i + 3, B);
            LDS_BAR();
            if (do_prep) {
                LAS float* Gg = RW_ARR(bufn, 6);
                f32x4 cg_ = (f32x4){0.f, 0.f, 0.f, 0.f};
#pragma unroll
                for (int ks = 0; ks < 4; ++ks) {
                    const bf16x8 za = *(const LAS bf16x8*)&GDb[ln * 136 + ks * 32 + 8 * lg], zb = *(const LAS bf16x8*)&WTg[(16 * nt + ln) * 136 + ks * 32 + 8 * lg];
                    cg_ = __builtin_amdgcn_mfma_f32_16x16x32_bf16(za, zb, cg_, 0, 0, 0);
                }
#pragma unroll
                for (int r = 0; r < 4; ++r) Gg[(4 * lg + r) * 64 + chm] = cg_[r];
            }
            LDS_BAR();
        } else {
            LAS float* A_ = RW_ARR(bufc, 0); LAS float* WR = RW_ARR(bufc, 1); LAS float* Wd = RW_ARR(bufc, 2); LAS float* Bv = RW_ARR(bufc, 3);
            LAS float* Kk = RW_ARR(bufc, 4); LAS float* Vv = RW_ARR(bufc, 5); LAS float* Yy = RW_ARR(bufc, 7); LAS float* SC = RW_SC(bufc);
#pragma unroll 1
            for (int q4 = 0; q4 < 4; ++q4) {
                if (i >= 0) {
                    f32x2 yk[4];
#pragma unroll
                    for (int s4 = 0; s4 < 4; ++s4) {
                        const int tt = 4 * q4 + s4;
                        const f32x4 a_lo = *(const LAS f32x4*)&A_[tt * 64 + 8 * jg], a_hi = *(const LAS f32x4*)&A_[tt * 64 + 8 * jg + 4];
                        const f32x4 r_lo = *(const LAS f32x4*)&WR[tt * 64 + 8 * jg], r_hi = *(const LAS f32x4*)&WR[tt * 64 + 8 * jg + 4];
                        const f32x4 w_lo = *(const LAS f32x4*)&Wd[tt * 64 + 8 * jg], w_hi = *(const LAS f32x4*)&Wd[tt * 64 + 8 * jg + 4];
                        const f32x4 b_lo = *(const LAS f32x4*)&Bv[tt * 64 + 8 * jg], b_hi = *(const LAS f32x4*)&Bv[tt * 64 + 8 * jg + 4];
                        const f32x4 k_lo = *(const LAS f32x4*)&Kk[tt * 64 + 8 * jg], k_hi = *(const LAS f32x4*)&Kk[tt * 64 + 8 * jg + 4];
                        const f32x2 vv = *(const LAS f32x2*)&Vv[tt * 64 + i0];
                        const f32x2 sc = *(const LAS f32x2*)&SC[tt * 4];
                        const f32x2 av[4] = {{a_lo.x, a_lo.y}, {a_lo.z, a_lo.w}, {a_hi.x, a_hi.y}, {a_hi.z, a_hi.w}};
                        const f32x2 rv[4] = {{r_lo.x, r_lo.y}, {r_lo.z, r_lo.w}, {r_hi.x, r_hi.y}, {r_hi.z, r_hi.w}};
                        const f32x2 wv[4] = {{w_lo.x, w_lo.y}, {w_lo.z, w_lo.w}, {w_hi.x, w_hi.y}, {w_hi.z, w_hi.w}};
                        const f32x2 bv[4] = {{b_lo.x, b_lo.y}, {b_lo.z, b_lo.w}, {b_hi.x, b_hi.y}, {b_hi.z, b_hi.w}};
                        const f32x2 kv[4] = {{k_lo.x, k_lo.y}, {k_lo.z, k_lo.w}, {k_hi.x, k_hi.y}, {k_hi.z, k_hi.w}};
                        f32x2 e10 = S0[0] * av[0], e20 = S0[0] * rv[0], e11 = S1[0] * av[0], e21 = S1[0] * rv[0];
#pragma unroll
                        for (int j = 1; j < 4; ++j) { e10 += S0[j] * av[j]; e20 += S0[j] * rv[j]; e11 += S1[j] * av[j]; e21 += S1[j] * rv[j]; }
                        const float d10 = red8(e10.x + e10.y), d20 = red8(e20.x + e20.y), d11 = red8(e11.x + e11.y), d21 = red8(e21.x + e21.y);
                        yk[s4] = (f32x2){d20 + d10 * sc.x + vv.x * sc.y, d21 + d11 * sc.x + vv.y * sc.y};
                        const f32x2 d10v = (f32x2){d10, d10}, d11v = (f32x2){d11, d11}, v0v = (f32x2){vv.x, vv.x}, v1v = (f32x2){vv.y, vv.y};
#pragma unroll
                        for (int j = 0; j < 4; ++j) { S0[j] = S0[j] * wv[j] + (d10v * bv[j] + v0v * kv[j]); S1[j] = S1[j] * wv[j] + (d11v * bv[j] + v1v * kv[j]); }
                    }
                    if (jg == 0) {
#pragma unroll
                        for (int s4 = 0; s4 < 4; ++s4) *(LAS f32x2*)&Yy[(4 * q4 + s4) * 64 + i0] = yk[s4];
                    }

#if PROBE_SCAN2
                    {
#pragma unroll
                    for (int s4 = 0; s4 < 4; ++s4) {
                        const int tt = 4 * q4 + s4;
                        const f32x4 a_lo = *(const LAS f32x4*)&A_[tt * 64 + 8 * jg], a_hi = *(const LAS f32x4*)&A_[tt * 64 + 8 * jg + 4];
                        const f32x4 r_lo = *(const LAS f32x4*)&WR[tt * 64 + 8 * jg], r_hi = *(const LAS f32x4*)&WR[tt * 64 + 8 * jg + 4];
                        const f32x4 w_lo = *(const LAS f32x4*)&Wd[tt * 64 + 8 * jg], w_hi = *(const LAS f32x4*)&Wd[tt * 64 + 8 * jg + 4];
                        const f32x4 b_lo = *(const LAS f32x4*)&Bv[tt * 64 + 8 * jg], b_hi = *(const LAS f32x4*)&Bv[tt * 64 + 8 * jg + 4];
                        const f32x4 k_lo = *(const LAS f32x4*)&Kk[tt * 64 + 8 * jg], k_hi = *(const LAS f32x4*)&Kk[tt * 64 + 8 * jg + 4];
                        const f32x2 vv = *(const LAS f32x2*)&Vv[tt * 64 + i0];
                        const f32x2 av[4] = {{a_lo.x, a_lo.y}, {a_lo.z, a_lo.w}, {a_hi.x, a_hi.y}, {a_hi.z, a_hi.w}};
                        const f32x2 rv[4] = {{r_lo.x, r_lo.y}, {r_lo.z, r_lo.w}, {r_hi.x, r_hi.y}, {r_hi.z, r_hi.w}};
                        const f32x2 wv[4] = {{w_lo.x, w_lo.y}, {w_lo.z, w_lo.w}, {w_hi.x, w_hi.y}, {w_hi.z, w_hi.w}};
                        const f32x2 bv[4] = {{b_lo.x, b_lo.y}, {b_lo.z, b_lo.w}, {b_hi.x, b_hi.y}, {b_hi.z, b_hi.w}};
                        const f32x2 kv[4] = {{k_lo.x, k_lo.y}, {k_lo.z, k_lo.w}, {k_hi.x, k_hi.y}, {k_hi.z, k_hi.w}};
                        f32x2 e10 = T0[0] * av[0], e20 = T0[0] * rv[0], e11 = T1[0] * av[0], e21 = T1[0] * rv[0];
#pragma unroll
                        for (int j = 1; j < 4; ++j) { e10 += T0[j] * av[j]; e20 += T0[j] * rv[j]; e11 += T1[j] * av[j]; e21 += T1[j] * rv[j]; }
                        const float d10 = red8(e10.x + e10.y), d20 = red8(e20.x + e20.y), d11 = red8(e11.x + e11.y), d21 = red8(e21.x + e21.y);
                        const f32x2 d10v = (f32x2){d10 + d20, d10}, d11v = (f32x2){d11 + d21, d11}, v0v = (f32x2){vv.x, vv.x}, v1v = (f32x2){vv.y, vv.y};
#pragma unroll
                        for (int j = 0; j < 4; ++j) { T0[j] = T0[j] * wv[j] + (d10v * bv[j] + v0v * kv[j]); T1[j] = T1[j] * wv[j] + (d11v * bv[j] + v1v * kv[j]); }
                    }
                    }
#endif
                }
                if (q4 & 1) LDS_BAR();
            }
        }
            }
    }
    if (helper) {
        const int bufl = (RW_NCH - 1) & 1;
        LAS float* Yy = RW_ARR(bufl, 7); LAS float* Gg = RW_ARR(bufl, 6); LAS float* Vv = RW_ARR(bufl, 5); LAS float* SC = RW_SC(bufl);
        const f32x4 y = *(const LAS f32x4*)&Yy[tt_h * 64 + cg4], gg = *(const LAS f32x4*)&Gg[tt_h * 64 + cg4], vv = *(const LAS f32x4*)&Vv[tt_h * 64 + cg4];
        const float bonus = BON[((RW_NCH - 1) % 3) * 16 + tt_h];
        const float mean = red16((y.x + y.y) + (y.z + y.w)) * (1.f / 64.f);
        const f32x4 d = y - mean;
        const float var = red16((d.x * d.x + d.y * d.y) + (d.z * d.z + d.w * d.w)) * (1.f / 64.f);
        const float rs = 1.f / sqrtf(var + 64e-5f);
        const f32x4 o = (d * rs * p_gg + p_gb + vv * bonus) * gg;
        u32x2 w; w.x = pk2(o.x, o.y); w.y = pk2(o.z, o.w);
        *(u32x2*)(X.P + ((size_t)b * SEQ + (RW_NCH - 1) * RW_TS + tt_h) * LDP + COL_YA + h * 64 + cg4) = w;
    }
    __syncthreads();
#undef RW_ARR
#undef RW_SC
#undef RW_LOAD
}

__device__ __forceinline__ void hgrn_task(const Ctx& X, LAS unsigned char* lds, int layer, int b, int h, int vh) {
    LAS float* F = (LAS float*)(lds); LAS float* Q = (LAS float*)(lds + 16384); LAS float* Vv = (LAS float*)(lds + 32768); LAS float* O = (LAS float*)(lds + 40960);
    LAS float* LB = (LAS float*)(lds + 49152);
    const int tid = X.tid;
    const float* lbl = X.in[14];
    const int rp = tid >> 4, dg = tid & 15, v0 = 2 * rp;
    if (tid < 128) LB[tid] = (layer > 0) ? 1.f / (1.f + __expf(lbl[h * 128 + tid] - lbl[512 + h * 128 + tid])) : 0.f;
    f32x2 S0[4], S1[4];
#pragma unroll
    for (int j = 0; j < 4; ++j) { S0[j] = (f32x2){0.f, 0.f}; S1[j] = (f32x2){0.f, 0.f}; }
#define HG_LOAD(chk) do { _Pragma("unroll") for (int it = 0; it < 3; ++it) { const int idx = tid + 512 * it; raw[it] = (u32x4){0u, 0u, 0u, 0u}; \
        if (idx < 32 * 40) { const int tt = idx / 40, vv = idx - tt * 40; \
            const int col = vv < 16 ? 512 + h * 128 + 8 * vv : (vv < 32 ? h * 128 + 8 * (vv - 16) : 1024 + h * 128 + vh * 64 + 8 * (vv - 32)); \
            raw[it] = *(const u32x4*)(X.P + ((size_t)b * SEQ + (chk) * 32 + tt) * LDP + COL_PB + col); } } } while (0)
    u32x4 raw[3];
    HG_LOAD(0);
    __syncthreads();
#pragma unroll 1
    for (int ch = 0; ch < SEQ / 32; ++ch) {
        const int t0 = ch * 32;
#pragma unroll
        for (int it = 0; it < 3; ++it) {
            const int idx = tid + 512 * it;
            if (idx < 32 * 40) {
                const int tt = idx / 40, vv = idx - tt * 40;
                float x[8];
                x[0] = bflo(raw[it].x); x[1] = bfhi(raw[it].x); x[2] = bflo(raw[it].y); x[3] = bfhi(raw[it].y);
                x[4] = bflo(raw[it].z); x[5] = bfhi(raw[it].z); x[6] = bflo(raw[it].w); x[7] = bfhi(raw[it].w);
                LAS float* dst;
                if (vv < 16) {
                    dst = F + tt * 128 + 8 * vv;
#pragma unroll
                    for (int e = 0; e < 8; ++e) { const float lb = LB[8 * vv + e]; x[e] = lb + (1.f - lb) * sigmoidf_(x[e]); }
                } else if (vv < 32) dst = Q + tt * 128 + 8 * (vv - 16);
                else dst = Vv + tt * 64 + 8 * (vv - 32);
                *(LAS f32x4*)dst = (f32x4){x[0], x[1], x[2], x[3]}; *(LAS f32x4*)(dst + 4) = (f32x4){x[4], x[5], x[6], x[7]};
            }
        }
        if (ch + 1 < SEQ / 32) HG_LOAD(ch + 1);
        LDS_BAR();
#pragma unroll 4
        for (int tt = 0; tt < 32; ++tt) {
            const f32x4 f_lo = *(const LAS f32x4*)&F[tt * 128 + 8 * dg], f_hi = *(const LAS f32x4*)&F[tt * 128 + 8 * dg + 4];
            const f32x4 q_lo = *(const LAS f32x4*)&Q[tt * 128 + 8 * dg], q_hi = *(const LAS f32x4*)&Q[tt * 128 + 8 * dg + 4];
            const f32x2 vv = *(const LAS f32x2*)&Vv[tt * 64 + v0];
            const f32x2 f2[4] = {{f_lo.x, f_lo.y}, {f_lo.z, f_lo.w}, {f_hi.x, f_hi.y}, {f_hi.z, f_hi.w}};
            const f32x2 q2[4] = {{q_lo.x, q_lo.y}, {q_lo.z, q_lo.w}, {q_hi.x, q_hi.y}, {q_hi.z, q_hi.w}};
            const f32x2 v0v = (f32x2){vv.x, vv.x}, v1v = (f32x2){vv.y, vv.y};
            f32x2 a0 = (f32x2){0.f, 0.f}, a1 = (f32x2){0.f, 0.f};
#pragma unroll
            for (int j = 0; j < 4; ++j) {
                S0[j] = v0v + f2[j] * (S0[j] - v0v); S1[j] = v1v + f2[j] * (S1[j] - v1v);
                a0 += q2[j] * S0[j]; a1 += q2[j] * S1[j];
            }
            const float o0 = red16(a0.x + a0.y), o1 = red16(a1.x + a1.y);
            if (dg == 0) *(LAS f32x2*)&O[tt * 64 + v0] = (f32x2){o0, o1};
        }
        LDS_BAR();
        if (tid < 256) {
            const int tt = tid >> 3, v8 = (tid & 7) * 8;
            const f32x4 a = *(const LAS f32x4*)&O[tt * 64 + v8], c4 = *(const LAS f32x4*)&O[tt * 64 + v8 + 4];
            u32x4 o; o.x = pk2(a.x, a.y); o.y = pk2(a.z, a.w); o.z = pk2(c4.x, c4.y); o.w = pk2(c4.z, c4.w);
            *(u32x4*)(X.P + ((size_t)b * SEQ + t0 + tt) * LDP + COL_YB + h * 128 + vh * 64 + v8) = o;
        }
    }
#undef HG_LOAD
    __syncthreads();
}

__device__ __forceinline__ unsigned f2ord(float f) { const unsigned u = __builtin_bit_cast(unsigned, f); return (u & 0x80000000u) ? ~u : (u | 0x80000000u); }

__device__ __forceinline__ void dsa_tile(const Ctx& X, LAS unsigned char* lds, int b, int q0) {
    LAS float* sc = (LAS float*)lds;
    LAS unsigned* MASK = (LAS unsigned*)(lds + MASK_OFF);
    const int lane = X.lane, w = X.wave, n = lane & 15, g = lane >> 4;
    const bf16_t* Pb = X.P + (size_t)b * SEQ * LDP;
#pragma unroll 1
    for (int sub = 0; sub < 4; ++sub) {
        const int qs = q0 + 16 * sub;
        {
            bf16x8 bq[4][2]; float wi[4];
            const bf16_t* qrow = Pb + (size_t)(qs + n) * LDP;
#pragma unroll
            for (int hh = 0; hh < 4; ++hh) {
#pragma unroll
                for (int ks = 0; ks < 2; ++ks) bq[hh][ks] = *(const bf16x8*)(qrow + C_QI + hh * 64 + ks * 32 + 8 * g);
                wi[hh] = bf2f(qrow[C_WI + hh]);
            }
            const int nkt = (qs + 16) >> 4;
            bf16x8 a0n = (bf16x8){0, 0, 0, 0, 0, 0, 0, 0}, a1n = a0n;
            if (w < nkt) { const bf16_t* krow = Pb + (size_t)(w * 16 + n) * LDP + C_KI; a0n = *(const bf16x8*)(krow + 8 * g); a1n = *(const bf16x8*)(krow + 32 + 8 * g); }
#pragma unroll 1
            for (int kt = w; kt < nkt; kt += 8) {
                const bf16x8 a0 = a0n, a1 = a1n;
                if (kt + 8 < nkt) { const bf16_t* krow = Pb + (size_t)((kt + 8) * 16 + n) * LDP + C_KI; a0n = *(const bf16x8*)(krow + 8 * g); a1n = *(const bf16x8*)(krow + 32 + 8 * g); }
                f32x4 s = (f32x4){0.f, 0.f, 0.f, 0.f};
#pragma unroll
                for (int hh = 0; hh < 4; ++hh) {
                    f32x4 d = __builtin_amdgcn_mfma_f32_16x16x32_bf16(a0, bq[hh][0], (f32x4){0.f, 0.f, 0.f, 0.f}, 0, 0, 0);
                    d = __builtin_amdgcn_mfma_f32_16x16x32_bf16(a1, bq[hh][1], d, 0, 0, 0);
#pragma unroll
                    for (int r = 0; r < 4; ++r) s[r] += wi[hh] * fmaxf(d[r], 0.f);
                }
                const int t = qs + n;
#pragma unroll
                for (int r = 0; r < 4; ++r) if (kt * 16 + 4 * g + r > t) s[r] = -INFINITY;
                *(LAS f32x4*)&sc[n * SCS + kt * 16 + 4 * g] = s;
            }
        }
        __syncthreads();
#pragma unroll 1
        for (int e = 0; e < 2; ++e) {
            const int qn = 2 * w + e, t = qs + qn;
            LAS unsigned* mrow = MASK + (sub * 16 + qn) * 64;
            if (t < 256) {
#pragma unroll
                for (int j = 0; j < 32; ++j) {
                    const unsigned long long sm = __ballot(j * 64 + lane <= t);
                    if (lane == 0) { mrow[2 * j] = (unsigned)sm; mrow[2 * j + 1] = (unsigned)(sm >> 32); }
                }
            } else {
                const int jn = (t >> 6) + 1;
                unsigned u[32];
#pragma unroll
                for (int j = 0; j < 32; ++j) {
                    u[j] = 0u;
                    if (j < jn) { const int key = j * 64 + lane; const float s = (key <= t) ? sc[qn * SCS + key] : -INFINITY; u[j] = f2ord(s); }
                }
                unsigned prefix = 0u;
#define DSA_BITSEARCH(JN) do { _Pragma("unroll 1") for (int bit = 31; bit >= 0; --bit) { const unsigned cand = prefix | (1u << bit); int c0 = 0, c1 = 0; \
                    _Pragma("unroll") for (int j = 0; j < (JN); j += 2) { c0 += (u[j] >= cand) ? 1 : 0; c1 += (u[j + 1] >= cand) ? 1 : 0; } \
                    const int cnt = (int)wave_sum_fast((float)(c0 + c1)); if (cnt >= 256) prefix = cand; } } while (0)
                if (jn <= 8) DSA_BITSEARCH(8); else if (jn <= 16) DSA_BITSEARCH(16); else if (jn <= 24) DSA_BITSEARCH(24); else DSA_BITSEARCH(32);
#undef DSA_BITSEARCH
                int cg_ = 0;
#pragma unroll
                for (int j = 0; j < 32; ++j) if (j < jn) cg_ += __popcll(__ballot(u[j] > prefix));
                const int need = 256 - cg_;
                int cum = 0;
#pragma unroll
                for (int j = 0; j < 32; ++j) {
                    unsigned long long sm = 0ull;
                    if (j < jn) {
                        const bool eq = (u[j] == prefix);
                        const unsigned long long em = __ballot(eq);
                        const int rank = cum + (int)__builtin_amdgcn_mbcnt_hi((unsigned)(em >> 32), __builtin_amdgcn_mbcnt_lo((unsigned)em, 0u));
                        const bool sel = (u[j] > prefix) || (eq && rank < need);
                        sm = __ballot(sel);
                        cum += __popcll(em);
                    }
                    if (lane == 0) { mrow[2 * j] = (unsigned)sm; mrow[2 * j + 1] = (unsigned)(sm >> 32); }
                }
            }
        }
        __syncthreads();
    }
    const int qq = q0 + 8 * w + (n & 7);
    const LAS unsigned* mq = MASK + (8 * w + (n & 7)) * 64;
    const int nsteps = (q0 + 8 * w + 8 + 31) >> 5;
    const int nblk = (q0 + 64 + 127) >> 7;
    LAS bf16_t* KT = (LAS bf16_t*)lds;
    LAS bf16_t* VTT = (LAS bf16_t*)(lds + 36864);
    const int tid = X.tid;
#pragma unroll 1
    for (int c = 0; c < 2; ++c) {
        bf16x8 bq[2][2];
#pragma unroll
        for (int j = 0; j < 2; ++j)
#pragma unroll
            for (int ks = 0; ks < 2; ++ks) bq[j][ks] = *(const bf16x8*)(Pb + (size_t)qq * LDP + C_Q + (c * 4 + 2 * j + (n >> 3)) * 64 + ks * 32 + 8 * g);
        float lrun[2] = {0.f, 0.f};
        f32x4 oacc[4][2];
#pragma unroll
        for (int mt = 0; mt < 4; ++mt)
#pragma unroll
            for (int j = 0; j < 2; ++j) oacc[mt][j] = (f32x4){0.f, 0.f, 0.f, 0.f};
        const bf16_t* vtb = X.VT + ((size_t)(b * 2 + c) * 64) * SEQ;
        u32x4 gk[2], gv[2];
#define DSA_GLOAD(kblk) do { _Pragma("unroll") for (int it = 0; it < 2; ++it) { const int idx = tid + 512 * it; \
            gk[it] = *(const u32x4*)(Pb + (size_t)((kblk) * 128 + (idx >> 3)) * LDP + C_K + c * 64 + (idx & 7) * 8); \
            gv[it] = *(const u32x4*)(vtb + (size_t)(idx >> 4) * SEQ + (kblk) * 128 + (idx & 15) * 8); } } while (0)
#define DSA_LSTORE(bufi) do { _Pragma("unroll") for (int it = 0; it < 2; ++it) { const int idx = tid + 512 * it; \
            *(LAS u32x4*)(KT + (bufi) * 9216 + (idx >> 3) * 72 + (idx & 7) * 8) = gk[it]; \
            *(LAS u32x4*)(VTT + (bufi) * 8704 + (idx >> 4) * 136 + (idx & 15) * 8) = gv[it]; } } while (0)
        DSA_GLOAD(0);
        LDS_BAR();
        DSA_LSTORE(0);
        LDS_BAR();
#pragma unroll 1
        for (int kb = 0; kb < nblk; ++kb) {
            const int buf = kb & 1;
            if (kb + 1 < nblk) DSA_GLOAD(kb + 1);
            const LAS bf16_t* Kb = KT + buf * 9216; const LAS bf16_t* Vb = VTT + buf * 8704;
#pragma unroll 1
            for (int sl = 0; sl < 4; ++sl) {
                const int sg = kb * 4 + sl;
                if (sg < nsteps) {
                    f32x4 st[2][2];
#pragma unroll
                    for (int tl = 0; tl < 2; ++tl) {
                        const LAS bf16_t* kr = Kb + (32 * sl + 16 * tl + n) * 72;
                        const bf16x8 a0 = *(const LAS bf16x8*)(kr + 8 * g), a1 = *(const LAS bf16x8*)(kr + 32 + 8 * g);
#pragma unroll
                        for (int j = 0; j < 2; ++j) {
                            f32x4 d = __builtin_amdgcn_mfma_f32_16x16x32_bf16(a0, bq[j][0], (f32x4){0.f, 0.f, 0.f, 0.f}, 0, 0, 0);
                            st[tl][j] = __builtin_amdgcn_mfma_f32_16x16x32_bf16(a1, bq[j][1], d, 0, 0, 0);
                        }
                    }
                    bf16x8 av[4];
#pragma unroll
                    for (int mt = 0; mt < 4; ++mt) {
                        const LAS bf16_t* vp = Vb + (mt * 16 + n) * 136 + 32 * sl + 4 * g;
                        const u32x2 lo = *(const LAS u32x2*)vp, hi = *(const LAS u32x2*)(vp + 16);
                        u32x4 t4; t4.x = lo.x; t4.y = lo.y; t4.z = hi.x; t4.w = hi.y;
                        av[mt] = __builtin_bit_cast(bf16x8, t4);
                    }
                    const unsigned mw = mq[sg];
#pragma unroll
                    for (int j = 0; j < 2; ++j) {
                        float p[8], ps = 0.f;
#pragma unroll
                        for (int tl = 0; tl < 2; ++tl)
#pragma unroll
                            for (int r = 0; r < 4; ++r) { const int bit = 16 * tl + 4 * g + r; const float e = __expf(fminf(st[tl][j][r] * 0.125f, 60.f)); p[4 * tl + r] = ((mw >> bit) & 1u) ? e : 0.f; ps += p[4 * tl + r]; }
                        lrun[j] += ps;
                        u32x4 pw; pw.x = pg8::cvt_pk_bf16(p[0], p[1]); pw.y = pg8::cvt_pk_bf16(p[2], p[3]); pw.z = pg8::cvt_pk_bf16(p[4], p[5]); pw.w = pg8::cvt_pk_bf16(p[6], p[7]);
                        const bf16x8 pb = __builtin_bit_cast(bf16x8, pw);
#pragma unroll
                        for (int mt = 0; mt < 4; ++mt) oacc[mt][j] = __builtin_amdgcn_mfma_f32_16x16x32_bf16(av[mt], pb, oacc[mt][j], 0, 0, 0);
                    }
                }
            }
            if (kb + 1 < nblk) DSA_LSTORE(buf ^ 1);
            LDS_BAR();
        }
#pragma unroll
        for (int j = 0; j < 2; ++j) {
            float lt = lrun[j]; lt += __shfl_xor(lt, 16); lt += __shfl_xor(lt, 32);
            const float il = 1.f / lt;
            bf16_t* op = X.P + ((size_t)b * SEQ + qq) * LDP + COL_YC + (c * 4 + 2 * j + (n >> 3)) * 64 + 4 * g;
#pragma unroll
            for (int mt = 0; mt < 4; ++mt) {
                const f32x4 o = oacc[mt][j] * il;
                u32x2 wv; wv.x = pg8::cvt_pk_bf16(o[0], o[1]); wv.y = pg8::cvt_pk_bf16(o[2], o[3]);
                *(u32x2*)(op + mt * 16) = wv;
            }
        }
    }
#undef DSA_GLOAD
#undef DSA_LSTORE
    __syncthreads();
}

__device__ __forceinline__ void phase_mixers(const Ctx& X0, LAS unsigned char* lds, int layer) {
#pragma unroll 1
    for (int task = X0.bid; task < 128; task += X0.G) {
        Ctx X = X0;
        { int t_ = threadIdx.x; asm volatile("" : "+v"(t_)); X.tid = t_; X.lane = t_ & 63; }
        if (task < 64) { if (TKMASK & 1) rwkv_task(X, lds, layer, task >> 3, task & 7); }
        else { const int k = task - 64; if (TKMASK & 2) hgrn_task(X, lds, layer, k >> 3, (k >> 1) & 3, k & 1); }
    }
    volatile LAS unsigned* tw = (volatile LAS unsigned*)(lds + LDS_BYTES - 128);
    unsigned* ctr = (unsigned*)(X0.ws + WS_BAR + 14336) + 16 * layer;
#pragma unroll 1
    for (;;) {
        Ctx X = X0;
        { int t_ = threadIdx.x; asm volatile("" : "+v"(t_)); X.tid = t_; X.lane = t_ & 63; }
        __syncthreads();
        if (threadIdx.x == 0) tw[0] = __hip_atomic_fetch_add(ctr, 1u, __ATOMIC_RELAXED, __HIP_MEMORY_SCOPE_AGENT);
        __syncthreads();
        const int t = (int)tw[0];
        if (t >= 256) break;
        if (TKMASK & 4) dsa_tile(X, lds, t & 7, 64 * (31 - (t >> 3)));
    }
}

__device__ __forceinline__ void phase_hgrn_post(const Ctx& X, int layer) {
    const int gw = X.bid * 8 + X.wave, NGW = X.G * 8;
    const float* gn = X.in[15] + layer * 512;
#pragma unroll 1
    for (int it0 = gw; it0 < T_TOK * 4; it0 += 4 * NGW) {
        unsigned ow[4], gwd[4]; unsigned* op[4];
#pragma unroll
        for (int r = 0; r < 4; ++r) {
            const int it = it0 + r * NGW < T_TOK * 4 ? it0 + r * NGW : it0;
            const int t = it >> 2, h = it & 3;
            bf16_t* rowp = X.P + (size_t)t * LDP;
            op[r] = (unsigned*)(rowp + COL_YB + h * 128) + X.lane;
            ow[r] = *op[r]; gwd[r] = *((const unsigned*)(rowp + COL_PB + 1536 + h * 128) + X.lane);
        }
#pragma unroll
        for (int r = 0; r < 4; ++r) {
            const int it = it0 + r * NGW;
            const int h = it & 3;
            const float o0 = bflo(ow[r]), o1 = bfhi(ow[r]), g0 = bflo(gwd[r]), g1 = bfhi(gwd[r]);
            const float rs = 1.f / sqrtf(wave_sum(o0 * o0 + o1 * o1) * (1.f / 128.f) + 1e-6f);
            const float y0 = o0 * rs * gn[h * 128 + 2 * X.lane] * (g0 * sigmoidf_(g0)), y1 = o1 * rs * gn[h * 128 + 2 * X.lane + 1] * (g1 * sigmoidf_(g1));
            if (it < T_TOK * 4) *op[r] = pk2(y0, y1);
        }
    }
}

__device__ __forceinline__ void phase_fixup(const Ctx& X, int layer) {
    const float* cw = X.in[20] + (size_t)layer * 3 * F2; const float* cb = X.in[21] + (size_t)layer * F2;
#pragma unroll 4
    for (int idx = X.bid * 512 + X.tid; idx < 256 * 2 * DFF; idx += X.G * 512) {
        const int j = idx % DFF, sr = idx / DFF, s = sr >> 1, r = sr & 1;
        const int colg = (j >> 7) * 256 + (j & 127), colv = colg + 128;
        const bool seq0 = (s & 31) == 0;
        const float* H = X.HALO;
        float res[2];
#pragma unroll
        for (int part = 0; part < 2; ++part) {
            const int cp = part ? colv : colg, co = part * DFF + j;
            const float u0 = H[(size_t)(s * 4 + r) * F2 + cp];
            float u1, u2;
            if (r == 0) { u1 = seq0 ? 0.f : H[(size_t)((s - 1) * 4 + 3) * F2 + cp]; u2 = seq0 ? 0.f : H[(size_t)((s - 1) * 4 + 2) * F2 + cp]; }
            else { u1 = H[(size_t)(s * 4 + 0) * F2 + cp]; u2 = seq0 ? 0.f : H[(size_t)((s - 1) * 4 + 3) * F2 + cp]; }
            res[part] = cb[co] + cw[co] * u2 + cw[F2 + co] * u1 + cw[2 * F2 + co] * u0;
        }
        const float a = res[0] * sigmoidf_(res[0]) * res[1];
        X.P[(size_t)(s * 64 + r) * LDP + COL_ACT + j] = (bf16_t)f2bf(a);
    }
}

#define XB_TMO      128
#define XB_XCNT(j)  (256  + 64 * (j))
#define XB_XSUB(j)  (1280 + 64 * (j))
#define XB_XGEN(j)  (2304 + 64 * (j))
#define XB_TOP      3328
#define XB_TOPGEN   3392
#define XCD_BAR_WORDS 3456
#define XB_SPIN_CAP (1u << 22)
__device__ __forceinline__ unsigned xb_ld(unsigned* p)              { return __hip_atomic_load(p, __ATOMIC_RELAXED, __HIP_MEMORY_SCOPE_AGENT); }
__device__ __forceinline__ unsigned xb_add(unsigned* p, unsigned v) { return __hip_atomic_fetch_add(p, v, __ATOMIC_RELAXED, __HIP_MEMORY_SCOPE_AGENT); }
__device__ __forceinline__ unsigned xb_xcc_id() { return (unsigned)__builtin_amdgcn_s_getreg((3 << 11) | 20) & 0xFu; }
#define XB_SPIN(cond, bar) do { unsigned _sp = 0; while (cond) { __builtin_amdgcn_s_sleep(1); \
    if ((++_sp & 255u) == 0u) { if (xb_ld(&(bar)[XB_TMO])) break; if (_sp > XB_SPIN_CAP) { atomicAdd(&(bar)[XB_TMO], 1u); break; } } } } while (0)
struct XcdBarrier { unsigned* bar; unsigned x; volatile LAS unsigned* st; };
__device__ __forceinline__ XcdBarrier xcd_barrier_post(unsigned* bar, volatile LAS unsigned* st) {
    XcdBarrier b; b.bar = bar; b.x = xb_xcc_id(); b.st = st;
    if (threadIdx.x == 0) (void)xb_add(&bar[XB_XCNT(b.x)], 1u);
    return b;
}
__device__ __forceinline__ void xcd_barrier_complete(unsigned* bar, unsigned x, unsigned& nloc, unsigned& nx) {
    const unsigned G = gridDim.x * gridDim.y * gridDim.z;
    unsigned sum, cnt, mine, sp = 0u;
    for (;;) {
        sum = 0u; cnt = 0u; mine = 0u;
#pragma unroll
        for (unsigned j = 0; j < 16; ++j) { const unsigned c = xb_ld(&bar[XB_XCNT(j)]); sum += c; cnt += (c > 0u) ? 1u : 0u; mine = (j == x) ? c : mine; }
        if (sum == G) break;
        __builtin_amdgcn_s_sleep(1);
        if ((++sp & 255u) == 0u) { if (xb_ld(&bar[XB_TMO])) break; if (sp > XB_SPIN_CAP) { atomicAdd(&bar[XB_TMO], 1u); break; } }
    }
    nloc = mine > 0u ? mine : 1u; nx = cnt > 0u ? cnt : 1u;
}
__device__ __forceinline__ void xcd_barrier(const XcdBarrier& b) {
    asm volatile("s_waitcnt vmcnt(0)" ::: "memory");
    __syncthreads();
    if (threadIdx.x == 0) {
        unsigned* bar = b.bar;
        __builtin_amdgcn_s_waitcnt(0);
        unsigned nloc = b.st[0], nx = b.st[1];
        if (nloc == 0u) { xcd_barrier_complete(bar, b.x, nloc, nx); b.st[0] = nloc; b.st[1] = nx; }
        const unsigned old = xb_add(&bar[XB_XSUB(b.x)], 1u);
        const unsigned gen = old / nloc;
        if (old + 1u == (gen + 1u) * nloc) {
            __builtin_amdgcn_fence(__ATOMIC_RELEASE, "agent");
            asm volatile("s_waitcnt vmcnt(0)" ::: "memory");
            const unsigned og = xb_add(&bar[XB_TOP], 1u);
            const unsigned tg = og / nx;
            if (og + 1u == (tg + 1u) * nx) xb_add(&bar[XB_TOPGEN], 1u);
            else XB_SPIN(xb_ld(&bar[XB_TOPGEN]) == tg, bar);
            __builtin_amdgcn_fence(__ATOMIC_ACQUIRE, "agent");
            xb_add(&bar[XB_XGEN(b.x)], 1u);
            asm volatile("s_waitcnt vmcnt(0)" ::: "memory");
        } else {
            XB_SPIN(xb_ld(&bar[XB_XGEN(b.x)]) == gen, bar);
            __builtin_amdgcn_fence(__ATOMIC_ACQUIRE, "agent");
            asm volatile("s_waitcnt vmcnt(0)" ::: "memory");
        }
    }
    __syncthreads();
}

__global__ void __launch_bounds__(512, 2) mk_fwd(Args args) {
    extern __shared__ __attribute__((aligned(16))) unsigned char lds_raw[];
    LAS unsigned char* lds = (LAS unsigned char*)lds_raw;
    Ctx X;
#pragma unroll
    for (int i = 0; i < 24; ++i) X.in[i] = args.in[i];
    X.out = args.out; X.ws = args.ws;
    X.P = (bf16_t*)(args.ws + WS_P); X.VT = (bf16_t*)(args.ws + WS_VT); X.HALO = (float*)(args.ws + WS_HALO); X.ROPE = (float*)(args.ws + WS_ROPE);
    X.Win = (bf16_t*)(args.ws + WS_WIN); X.Wg = (bf16_t*)(args.ws + WS_WG); X.Wbr = (bf16_t*)(args.ws + WS_WBR);
    X.Wo = (bf16_t*)(args.ws + WS_WO); X.Wup = (bf16_t*)(args.ws + WS_WUP); X.Wdn = (bf16_t*)(args.ws + WS_WDN);
    X.tid = threadIdx.x; X.lane = X.tid & 63; X.wave = __builtin_amdgcn_readfirstlane(X.tid >> 6); X.G = gridDim.x; X.bid = blockIdx.x;

#if PROBE_DOUBLE
    for (int ph2 = args.ph_lo * 2; ph2 < args.ph_hi * 2; ++ph2) {
        const int ph = ph2 >> 1;
        const int layer = ph / 11, sub = ph % 11;
        const bool skip_ = (ph2 & 1) && !(ph < 22 && ((REPMASK >> sub) & 1));
#else
    volatile LAS unsigned* bst = (volatile LAS unsigned*)(lds + LDS_BYTES - 64);
    if (threadIdx.x < 2) bst[threadIdx.x] = 0u;
    __syncthreads();
    XcdBarrier gbar = xcd_barrier_post((unsigned*)(args.ws + WS_BAR), bst);
    for (int ph = args.ph_lo; ph < args.ph_hi; ++ph) {
        const int layer = ph / 11, sub = ph % 11;
        const bool skip_ = false;
#endif
        { int t_ = threadIdx.x; asm volatile("" : "+v"(t_)); X.tid = t_; X.lane = t_ & 63; }

        if (skip_) {
        } else if (ph == 22 && (PHMASK & 1024)) {
            const int gw = X.bid * 8 + X.wave, NGW = X.G * 8;
            (void)gw; (void)NGW; rms_pass(X, X.out, X.in[23], nullptr, X.out);
        } else if (sub == 0 && (PHMASK & 1)) {
            phase_prep(X, lds, layer);
        } else if (sub == 1 && (PHMASK & 2)) {
            pg8::Gemm g{X.P, X.Win, LDP, DM, DM}; pg8::StaticOrder S; S.init(T_TOK, 5120, X.G, X.bid);
            pg8::EpiInProj E{X.P, X.VT, X.ROPE, (bf16_t*)(X.ws + WS_BND)};
            pg8::gemm_phase<pg8::EpiInProj, true>(lds, g, S, E, X.tid);
        } else if (sub == 2 && (PHMASK & 4)) {
            phase_rwkv_pre(X, lds, layer);
        } else if (sub == 3 && (PHMASK & 4)) {
            phase_mixers(X, lds, layer);
        } else if (sub == 4 && (PHMASK & 8)) {
            phase_hgrn_post(X, layer);
            { const int gw = X.bid * 8 + X.wave, NGW = X.G * 8; const float* hh = (layer == 0) ? X.in[0] : X.out; const float* g = X.in[1] + (size_t)layer * DM;
              (void)gw; (void)NGW; rms_pass(X, hh, g, X.P, nullptr); }
        } else if (sub == 5 && (PHMASK & 16)) {
#pragma unroll 1
            for (int br = 0; br < 3; ++br) {
                { pg8::Gemm g{X.P, X.Wg + (size_t)br * DM * DM, LDP, DM, DM}; pg8::StaticOrder S; S.init(T_TOK, DM, X.G, X.bid);
                  int t_ = X.tid; asm volatile("" : "+v"(t_));
                  pg8::EpiGate E{X.P}; pg8::gemm_phase<pg8::EpiGate, true>(lds, g, S, E, t_); }
                { const int ycol = br == 0 ? COL_YA : (br == 1 ? COL_YB : COL_YC);
                  pg8::Gemm g{X.P + ycol, X.Wbr + (size_t)br * DM * 512, LDP, 512, 512}; pg8::StaticOrder S; S.init(T_TOK, DM, X.G, X.bid);
                  int t_ = X.tid; asm volatile("" : "+v"(t_));
                  pg8::EpiMergeAcc E{X.P, br == 0 ? 1 : 0}; pg8::gemm_phase<pg8::EpiMergeAcc, true>(lds, g, S, E, t_); }
            }
        } else if (sub == 6 && (PHMASK & 32)) {
            pg8::Gemm g{X.P + COL_MRG, X.Wo, LDP, DM, DM}; pg8::StaticOrder S; S.init(T_TOK, DM, X.G, X.bid);
            pg8::EpiResid E{layer == 0 ? X.in[0] : X.out, X.out};
            pg8::gemm_phase<pg8::EpiResid, true>(lds, g, S, E, X.tid);
        } else if (sub == 7 && (PHMASK & 64)) {
            const int gw = X.bid * 8 + X.wave, NGW = X.G * 8;
            const float* g = X.in[18] + (size_t)layer * DM;
            (void)gw; (void)NGW; rms_pass(X, X.out, g, X.P, nullptr);
        } else if (sub == 8 && (PHMASK & 128)) {
            pg8::Gemm g{X.P, X.Wup, LDP, DM, DM}; pg8::StaticOrder S; S.init(T_TOK, F2, X.G, X.bid);
            pg8::EpiUp E{X.P, X.HALO, X.in[20] + (size_t)layer * 3 * F2, X.in[21] + (size_t)layer * F2, (LAS float*)(lds + 131072)};
            pg8::gemm_phase<pg8::EpiUp, true>(lds, g, S, E, X.tid);
        } else if (sub == 9 && (PHMASK & 256)) {
            phase_fixup(X, layer);
        } else if (sub == 10 && (PHMASK & 512)) {
            pg8::Gemm g{X.P + COL_ACT, X.Wdn, LDP, DFF, DFF}; pg8::StaticOrder S; S.init(T_TOK, DM, X.G, X.bid);
            pg8::EpiResid E{X.out, X.out};
            pg8::gemm_phase<pg8::EpiResid, true>(lds, g, S, E, X.tid);
        }
#if PROBE_DOUBLE
        if (ph2 + 1 < args.ph_hi * 2) cg::this_grid().sync();
#else
        if (ph + 1 < args.ph_hi) { if (args.ph_hi > 1000) cg::this_grid().sync(); else xcd_barrier(gbar); }
#endif
    }
}

extern "C" void kernel_launch(void* const* d_in, const int* in_sizes, int n_in, void* d_out, int out_size, void* d_ws, size_t ws_size, hipStream_t stream) {
    static int grid = 0;
    if (grid == 0) {
        int dev = 0, cus = 0, per_cu = 0;
        (void)hipGetDevice(&dev);
        (void)hipDeviceGetAttribute(&cus, hipDeviceAttributeMultiprocessorCount, dev);
        if (hipFuncSetAttribute((const void*)mk_fwd, hipFuncAttributeMaxDynamicSharedMemorySize, LDS_BYTES) != hipSuccess) fprintf(stderr, "kernel_launch: hipFuncSetAttribute failed\n");
        if (hipOccupancyMaxActiveBlocksPerMultiprocessor(&per_cu, (const void*)mk_fwd, 512, LDS_BYTES) != hipSuccess || per_cu < 1) { fprintf(stderr, "kernel_launch: occupancy query gave %d\n", per_cu); per_cu = 1; }
        (void)hipGetLastError();
        grid = cus * 1;
        if (grid <= 0) grid = 256;
        if (ws_size < (size_t)268435456) fprintf(stderr, "kernel_launch: workspace too small (%zu)\n", ws_size);
    }
    Args a{};
    for (int i = 0; i < 24; ++i) a.in[i] = (const float*)d_in[i];
    a.out = (float*)d_out; a.ws = (unsigned char*)d_ws;
#if MK_SINGLE
    (void)hipMemsetAsync((char*)d_ws + WS_BAR, 0, 16384, stream);
    a.ph_lo = 0; a.ph_hi = 23;
    void* kargs[] = {&a};
    hipError_t e = hipLaunchCooperativeKernel((const void*)mk_fwd, dim3(grid), dim3(512), kargs, LDS_BYTES, stream);
    if (e != hipSuccess) fprintf(stderr, "cooperative launch failed: %s (grid %d)\n", hipGetErrorString(e), grid);
#else
    for (int ph = 0; ph < 23; ++ph) {
        a.ph_lo = ph; a.ph_hi = ph + 1;
        hipLaunchKernelGGL(mk_fwd, dim3(grid), dim3(512), LDS_BYTES, stream, a);
    }
#endif
}
```

```cpp
#include <hip/hip_runtime.h>
#include <hip/hip_cooperative_groups.h>
#include <cstdio>
#include <cstdint>
namespace cg = cooperative_groups;

#ifndef PHMASK
#define PHMASK 2047
#endif
#ifndef REPMASK
#define REPMASK 0
#endif
#ifndef PROBE_DOUBLE
#define PROBE_DOUBLE 0
#endif
#ifndef PROBE_SCAN2
#define PROBE_SCAN2 0
#endif
#ifndef TKMASK
#define TKMASK 7
#endif
#ifndef MK_SINGLE
#define MK_SINGLE 1
#endif

#define LAS __attribute__((address_space(3)))
typedef unsigned short bf16_t;
typedef short bf16x8 __attribute__((ext_vector_type(8)));
typedef float f32x4 __attribute__((ext_vector_type(4)));
typedef float f32x2 __attribute__((ext_vector_type(2)));
typedef unsigned u32x4 __attribute__((ext_vector_type(4)));
typedef unsigned u32x2 __attribute__((ext_vector_type(2)));

constexpr int T_TOK = 16384, SEQ = 2048, DM = 1024;
constexpr int LDP = 6208;
constexpr int COL_PA = 1024, COL_PB = 2816, COL_PC = 4864;
constexpr int COL_YA = 1024, COL_MRG = 1536, COL_G = 2816, COL_YB = 3840, COL_YC = 4864, COL_ACT = 1024;
constexpr int C_Q = 4864, C_K = 5376, C_QI = 5632, C_KI = 5888, C_WI = 5952;
constexpr int IN_COLS = 8004, DFF = 2816, F2 = 5632;
constexpr size_t WS_WIN = 0, WS_WG = 10485760, WS_WBR = 16777216, WS_WO = 19922944, WS_WUP = 22020096, WS_WDN = 33554432;
constexpr size_t WS_P = 39321600, WS_HALO = 242745344, WS_VT = WS_HALO, WS_ROPE = 265814016, WS_BAR = 266338304, WS_BND = WS_HALO + 4194304, WS_SCAL = WS_HALO + 8388608;
constexpr int LDS_BYTES = 153600;
constexpr int SCS = 2052;
constexpr int MASK_OFF = 16 * SCS * 4;

struct Args { const float* in[24]; float* out; unsigned char* ws; int ph_lo, ph_hi; };

__device__ __forceinline__ unsigned f2bf(float f) { unsigned u = __builtin_bit_cast(unsigned, f); return (u + 0x7fffu + ((u >> 16) & 1u)) >> 16; }
__device__ __forceinline__ unsigned pk2(float lo, float hi) { return f2bf(lo) | (f2bf(hi) << 16); }
__device__ __forceinline__ float bf2f(bf16_t b) { return __builtin_bit_cast(float, (unsigned)b << 16); }
__device__ __forceinline__ float bflo(unsigned w) { return __builtin_bit_cast(float, w << 16); }
__device__ __forceinline__ float bfhi(unsigned w) { return __builtin_bit_cast(float, w & 0xffff0000u); }
__device__ __forceinline__ float wave_sum(float v) {
#pragma unroll
    for (int o = 1; o < 64; o <<= 1) v += __shfl_xor(v, o);
    return v;
}
__device__ __forceinline__ int wave_sum_i(int v) {
#pragma unroll
    for (int o = 1; o < 64; o <<= 1) v += __shfl_xor(v, o);
    return v;
}
template <int CTRL> __device__ __forceinline__ float dpp_mov(float x) {
    return __builtin_bit_cast(float, __builtin_amdgcn_update_dpp(0, __builtin_bit_cast(int, x), CTRL, 0xF, 0xF, true));
}
__device__ __forceinline__ float red8(float x) { x += dpp_mov<0xB1>(x); x += dpp_mov<0x4E>(x); x += dpp_mov<0x141>(x); return x; }
__device__ __forceinline__ float red16(float x) { x = red8(x); x += dpp_mov<0x140>(x); return x; }
__device__ __forceinline__ float sigmoidf_(float x) { return 1.f / (1.f + __expf(-x)); }

namespace pg8 {
constexpr int BM = 256, BK = 64, HALF = 128, HTB = HALF * BK * 2, NXCD = 8, WGM = 8;
__device__ __forceinline__ int lds_byte(int r, int c) { const int st = (r >> 4) * 2 + (c >> 5), rr = r & 15, cc = c & 31, ob = rr * 64 + cc * 2; return st * 1024 + (ob ^ (((ob >> 9) & 1) << 5)); }
__device__ __forceinline__ void stage_rc(int b, int& R, int& C) { const int st = b / 1024, sb = b % 1024, swz = sb ^ (((sb >> 9) & 1) << 5); R = (st >> 1) * 16 + swz / 64; C = (st & 1) * 32 + (swz % 64) / 2; }
__device__ __forceinline__ int perm32(int rho) { const int n = rho >> 4, i = rho & 15; return 8 * (i >> 2) + 4 * n + (i & 3); }
struct Unit { int pm, pn; };
struct Gemm { const bf16_t* A; const bf16_t* Bt; int lda, ldb, K; };
struct StaticOrder {
    int nM, nN, nwg, G, c;
    __device__ void init(int M, int N, int G_, int c_) { nM = M / BM; nN = N / BM; nwg = nM * nN; G = G_; c = c_; }
    __device__ bool next(int i, Unit& u) const {
        const long L = (long)i * G + c; if (L >= nwg) return false;
        int wgid = (int)L; { const int q = nwg / NXCD, r = nwg % NXCD, xcd = wgid % NXCD, off = wgid / NXCD; wgid = (xcd < r ? xcd * (q + 1) : r * (q + 1) + (xcd - r) * q) + off; }
        const int nig = WGM * nN, gid = wgid / nig, fm = gid * WGM, gsz = (nM - fm) < WGM ? (nM - fm) : WGM;
        u.pm = fm + ((wgid % nig) % gsz); u.pn = (wgid % nig) / gsz; return true;
    }
};
__device__ __forceinline__ unsigned cvt_pk_bf16(float lo, float hi) { unsigned r; asm volatile("v_cvt_pk_bf16_f32 %0, %1, %2" : "=v"(r) : "v"(lo), "v"(hi)); return r; }

template <class Epi, bool ALIGN_EPI>
__device__ __forceinline__ void gemm_phase(LAS unsigned char* lds, const Gemm g, const StaticOrder& S, const Epi& E, const int tid) {
    const int wid = __builtin_amdgcn_readfirstlane(tid >> 6), lane = tid & 63, wr = wid >> 2, wc = wid & 3, fr = lane & 15, fq = lane >> 4;
    const int K = g.K, nt = K / BK;
    unsigned voffA[2], voffB[2];
#pragma unroll
    for (int i = 0; i < 2; ++i) { int R, C; stage_rc(tid * 16 + i * 8192, R, C); const int Rb = (R & ~31) + perm32(R & 31);
        voffA[i] = (unsigned)(R * g.lda + C) * 2u; voffB[i] = (unsigned)(Rb * g.ldb + C) * 2u; }
    const size_t kstep = (size_t)(BK * 2);
    const size_t hstepA = (size_t)HALF * g.lda * 2, hstepB = (size_t)HALF * g.ldb * 2;
    const size_t tstepA = 2 * hstepA, tstepB = 2 * hstepB;
    const unsigned ldsw = (unsigned)wid * 1024u;
    const int aoff = lds_byte(wr * 64 + fr, fq * 8), boff = lds_byte(wc * 32 + fr, fq * 8);
#define PG8_SA(b, h) (((b) * 2 + (h)) * HTB)
#define PG8_SB(b, h) ((4 + (b) * 2 + (h)) * HTB)
#define PG8_STAGE(bufoff, gbase, voff) do { _Pragma("unroll") for (int _i = 0; _i < 2; ++_i) \
        __builtin_amdgcn_global_load_lds((const unsigned*)((const char*)(gbase) + (voff)[_i]), (LAS unsigned*)(lds + (bufoff) + ldsw + _i * 8192), 16, 0, 0); } while (0)
#define PG8_LDA(dst, b, h) do { _Pragma("unroll") for (int m = 0; m < 4; ++m) _Pragma("unroll") for (int k = 0; k < 2; ++k) dst[m][k] = *(const LAS bf16x8*)(lds + PG8_SA(b, h) + aoff + m * 2048 + k * 1024); } while (0)
#define PG8_LDB(dst, b, h) do { _Pragma("unroll") for (int n = 0; n < 2; ++n) _Pragma("unroll") for (int k = 0; k < 2; ++k) dst[n][k] = *(const LAS bf16x8*)(lds + PG8_SB(b, h) + boff + n * 2048 + k * 1024); } while (0)
#define PG8_MMA(ai, bj, At, Bt) do { __builtin_amdgcn_s_setprio(1); _Pragma("unroll") for (int m = 0; m < 4; ++m) _Pragma("unroll") for (int n = 0; n < 2; ++n) _Pragma("unroll") for (int k = 0; k < 2; ++k) \
        acc[ai][bj][m][n] = __builtin_amdgcn_mfma_f32_16x16x32_bf16(Bt[n][k], At[m][k], acc[ai][bj][m][n], 0, 0, 0); __builtin_amdgcn_s_setprio(0); } while (0)
#define PG8_WAIT_V(n) asm volatile("s_waitcnt vmcnt(" #n ")" ::: "memory")
#define PG8_WAIT_L(n) asm volatile("s_waitcnt lgkmcnt(" #n ")" ::: "memory")
#define PG8_BAR __builtin_amdgcn_s_barrier()
#define PG8_SCHED __builtin_amdgcn_sched_barrier(0)
    Unit cur, nxt; int ui = 0;
    if (!S.next(0, cur)) return;
    f32x4 acc[2][2][4][2];
#pragma unroll
    for (int a = 0; a < 2; ++a)
#pragma unroll
        for (int b = 0; b < 2; ++b)
#pragma unroll
            for (int m = 0; m < 4; ++m)
#pragma unroll
                for (int n = 0; n < 2; ++n) acc[a][b][m][n] = (f32x4){0.f, 0.f, 0.f, 0.f};
    bf16x8 At[4][2], B0[2][2], B1[2][2];
    const char* cA = (const char*)g.A + (size_t)cur.pm * tstepA; const char* cB = (const char*)g.Bt + (size_t)cur.pn * tstepB;
    PG8_STAGE(PG8_SB(0, 0), cB, voffB); PG8_STAGE(PG8_SB(0, 1), cB + hstepB, voffB); PG8_STAGE(PG8_SA(0, 0), cA, voffA); PG8_STAGE(PG8_SA(0, 1), cA + hstepA, voffA);
    if (wr == 1) PG8_BAR;
    PG8_WAIT_V(2); PG8_BAR;
    PG8_STAGE(PG8_SB(1, 0), cB + kstep, voffB); PG8_STAGE(PG8_SA(1, 0), cA + kstep, voffA); PG8_STAGE(PG8_SB(1, 1), cB + hstepB + kstep, voffB);
    PG8_WAIT_V(6); PG8_BAR;
    for (;;) {
        const bool has_next = S.next(ui + 1, nxt);
        const char* nA = has_next ? (const char*)g.A + (size_t)nxt.pm * tstepA : cA; const char* nB = has_next ? (const char*)g.Bt + (size_t)nxt.pn * tstepB : cB;
        for (int t = 0; t < nt; t += 2) {
            const bool last = (t == nt - 2);
            const char* a1 = cA + (size_t)(t + 1) * kstep;
            const char* a2 = last ? nA : cA + (size_t)(t + 2) * kstep; const char* b2 = last ? nB : cB + (size_t)(t + 2) * kstep;
            const char* a3 = a2 + kstep; const char* b3 = b2 + kstep;
            PG8_LDB(B0, 0, 0); PG8_LDB(B1, 0, 1); PG8_SCHED; PG8_LDA(At, 0, 0); PG8_STAGE(PG8_SA(1, 1), a1 + hstepA, voffA);
            PG8_WAIT_V(8); PG8_WAIT_L(0); PG8_BAR; PG8_MMA(0, 0, At, B0); PG8_MMA(0, 1, At, B1); PG8_BAR; PG8_SCHED;
            PG8_LDA(At, 0, 1); PG8_STAGE(PG8_SB(0, 0), b2, voffB); PG8_STAGE(PG8_SB(0, 1), b2 + hstepB, voffB); PG8_STAGE(PG8_SA(0, 0), a2, voffA);
            PG8_WAIT_V(8); PG8_WAIT_L(0); PG8_BAR; PG8_MMA(1, 0, At, B0); PG8_MMA(1, 1, At, B1); PG8_BAR; PG8_SCHED;
            PG8_LDB(B0, 1, 0); PG8_LDB(B1, 1, 1); PG8_SCHED; PG8_LDA(At, 1, 0); PG8_STAGE(PG8_SA(0, 1), a2 + hstepA, voffA);
            PG8_WAIT_V(8); PG8_WAIT_L(0); PG8_BAR; PG8_MMA(0, 0, At, B0); PG8_MMA(0, 1, At, B1); PG8_BAR; PG8_SCHED;
            PG8_LDA(At, 1, 1); PG8_STAGE(PG8_SB(1, 0), b3, voffB); PG8_STAGE(PG8_SB(1, 1), b3 + hstepB, voffB); PG8_STAGE(PG8_SA(1, 0), a3, voffA);
            PG8_WAIT_V(8); PG8_WAIT_L(0); PG8_BAR; PG8_MMA(1, 0, At, B0); PG8_MMA(1, 1, At, B1); PG8_BAR; PG8_SCHED;
        }
        if constexpr (ALIGN_EPI) { if (wr == 0) PG8_BAR; }
        E(acc, cur, wr, wc, fr, fq);
        if (!has_next) break;
#pragma unroll
        for (int a = 0; a < 2; ++a)
#pragma unroll
            for (int b = 0; b < 2; ++b)
#pragma unroll
                for (int m = 0; m < 4; ++m)
#pragma unroll
                    for (int n = 0; n < 2; ++n) acc[a][b][m][n] = (f32x4){0.f, 0.f, 0.f, 0.f};
        cur = nxt; cA = nA; cB = nB; ++ui;
        if constexpr (ALIGN_EPI) { if (wr == 1) PG8_BAR; }
    }
    PG8_WAIT_V(0);
    if constexpr (!ALIGN_EPI) { if (wr == 0) PG8_BAR; }
    PG8_BAR;
#undef PG8_SA
#undef PG8_SB
#undef PG8_STAGE
#undef PG8_LDA
#undef PG8_LDB
#undef PG8_MMA
#undef PG8_WAIT_V
#undef PG8_WAIT_L
#undef PG8_BAR
#undef PG8_SCHED
}

typedef f32x4 AccT[2][2][4][2];

struct EpiInProj {
    bf16_t* P; bf16_t* VT; const float* rope; bf16_t* BND;
    __device__ __forceinline__ void operator()(AccT& acc, const Unit& u, int wr, int wc, int fr, int fq) const {
        const int row0 = u.pm * BM + wr * 64 + fr, colb = u.pn * BM + wc * 32 + 8 * fq;
#pragma unroll
        for (int ai = 0; ai < 2; ++ai)
#pragma unroll
            for (int m = 0; m < 4; ++m) {
                const int row = row0 + ai * HALF + m * 16, t = row & (SEQ - 1);
                bf16_t* rowp = P + (size_t)row * LDP + COL_PA;
#pragma unroll
                for (int bj = 0; bj < 2; ++bj) {
                    const int c = colb + bj * HALF;
                    f32x4 v0 = acc[ai][bj][m][0], v1 = acc[ai][bj][m][1];
                    if (u.pn >= 15) {
                        const int cl = c - 3840;
                        if (cl < 640 || (cl >= 768 && cl < 1088)) {
                            const float* cs = rope + ((size_t)t * 32 + ((cl & 63) >> 1)) * 2;
                            const f32x4 r0 = *(const f32x4*)cs, r1 = *(const f32x4*)(cs + 4);
                            f32x4 o0, o1;
                            o0[0] = v0[0] * r0[0] - v0[1] * r0[1]; o0[1] = v0[1] * r0[0] + v0[0] * r0[1];
                            o0[2] = v0[2] * r0[2] - v0[3] * r0[3]; o0[3] = v0[3] * r0[2] + v0[2] * r0[3];
                            o1[0] = v1[0] * r1[0] - v1[1] * r1[1]; o1[1] = v1[1] * r1[0] + v1[0] * r1[1];
                            o1[2] = v1[2] * r1[2] - v1[3] * r1[3]; o1[3] = v1[3] * r1[2] + v1[2] * r1[3];
                            v0 = o0; v1 = o1;
                        }
                    }
                    u32x4 w; w.x = cvt_pk_bf16(v0[0], v0[1]); w.y = cvt_pk_bf16(v0[2], v0[3]); w.z = cvt_pk_bf16(v1[0], v1[1]); w.w = cvt_pk_bf16(v1[2], v1[3]);
                    *(u32x4*)(rowp + c) = w;
                    if (u.pn < 7 && fr == 15) *(u32x4*)(BND + (size_t)(row >> 4) * 1792 + c) = w;
                    if (u.pn == 17 && bj == 1) {
                        const int cv = c - 3840 - 640, b = row >> 11;
                        bf16_t* vt = VT + ((size_t)(b * 2 + (cv >> 6)) * 64 + (cv & 63)) * SEQ + t;
                        vt[0 * SEQ] = (bf16_t)(w.x & 0xffffu); vt[1 * SEQ] = (bf16_t)(w.x >> 16);
                        vt[2 * SEQ] = (bf16_t)(w.y & 0xffffu); vt[3 * SEQ] = (bf16_t)(w.y >> 16);
                        vt[4 * SEQ] = (bf16_t)(w.z & 0xffffu); vt[5 * SEQ] = (bf16_t)(w.z >> 16);
                        vt[6 * SEQ] = (bf16_t)(w.w & 0xffffu); vt[7 * SEQ] = (bf16_t)(w.w >> 16);
                    }
                }
            }
    }
};
struct EpiGate {
    bf16_t* P;
    __device__ __forceinline__ void operator()(AccT& acc, const Unit& u, int wr, int wc, int fr, int fq) const {
        const int row0 = u.pm * BM + wr * 64 + fr, colb = u.pn * BM + wc * 32 + 8 * fq;
#pragma unroll
        for (int ai = 0; ai < 2; ++ai)
#pragma unroll
            for (int m = 0; m < 4; ++m) {
                bf16_t* rowp = P + (size_t)(row0 + ai * HALF + m * 16) * LDP + COL_G + colb;
#pragma unroll
                for (int bj = 0; bj < 2; ++bj) {
                    const f32x4 v0 = acc[ai][bj][m][0], v1 = acc[ai][bj][m][1];
                    u32x4 w; w.x = cvt_pk_bf16(sigmoidf_(v0[0]), sigmoidf_(v0[1])); w.y = cvt_pk_bf16(sigmoidf_(v0[2]), sigmoidf_(v0[3]));
                    w.z = cvt_pk_bf16(sigmoidf_(v1[0]), sigmoidf_(v1[1])); w.w = cvt_pk_bf16(sigmoidf_(v1[2]), sigmoidf_(v1[3]));
                    *(u32x4*)(rowp + bj * HALF) = w;
                }
            }
    }
};
struct EpiMergeAcc {
    bf16_t* P; int first;
    __device__ __forceinline__ void operator()(AccT& acc, const Unit& u, int wr, int wc, int fr, int fq) const {
        const int row0 = u.pm * BM + wr * 64 + fr, colb = u.pn * BM + wc * 32 + 8 * fq;
#pragma unroll
        for (int ai = 0; ai < 2; ++ai)
#pragma unroll
            for (int m = 0; m < 4; ++m) {
                bf16_t* rowb = P + (size_t)(row0 + ai * HALF + m * 16) * LDP + colb;
#pragma unroll
                for (int bj = 0; bj < 2; ++bj) {
                    const f32x4 v0 = acc[ai][bj][m][0], v1 = acc[ai][bj][m][1];
                    const u32x4 gq = *(const u32x4*)(rowb + COL_G + bj * HALF);
                    u32x4 mq = (u32x4){0u, 0u, 0u, 0u};
                    if (!first) mq = *(const u32x4*)(rowb + COL_MRG + bj * HALF);
                    const unsigned ga = gq.x, gb = gq.y, gc = gq.z, gd = gq.w;
                    const unsigned ma = mq.x, mb = mq.y, mc = mq.z, md = mq.w;
                    u32x4 w;
                    w.x = cvt_pk_bf16(bflo(ma) + bflo(ga) * v0[0], bfhi(ma) + bfhi(ga) * v0[1]);
                    w.y = cvt_pk_bf16(bflo(mb) + bflo(gb) * v0[2], bfhi(mb) + bfhi(gb) * v0[3]);
                    w.z = cvt_pk_bf16(bflo(mc) + bflo(gc) * v1[0], bfhi(mc) + bfhi(gc) * v1[1]);
                    w.w = cvt_pk_bf16(bflo(md) + bflo(gd) * v1[2], bfhi(md) + bfhi(gd) * v1[3]);
                    *(u32x4*)(rowb + COL_MRG + bj * HALF) = w;
                }
            }
    }
};
struct EpiResid {
    const float* base; float* out;
    __device__ __forceinline__ void operator()(AccT& acc, const Unit& u, int wr, int wc, int fr, int fq) const {
        const int row0 = u.pm * BM + wr * 64 + fr, colb = u.pn * BM + wc * 32 + 8 * fq;
#pragma unroll
        for (int ai = 0; ai < 2; ++ai)
#pragma unroll
            for (int m = 0; m < 4; ++m) {
                const size_t off = (size_t)(row0 + ai * HALF + m * 16) * DM + colb;
#pragma unroll
                for (int bj = 0; bj < 2; ++bj) {
                    const f32x4 b0 = *(const f32x4*)(base + off + bj * HALF), b1 = *(const f32x4*)(base + off + bj * HALF + 4);
                    *(f32x4*)(out + off + bj * HALF) = b0 + acc[ai][bj][m][0];
                    *(f32x4*)(out + off + bj * HALF + 4) = b1 + acc[ai][bj][m][1];
                }
            }
    }
};
struct EpiUp {
    bf16_t* P; float* HALO; const float* cw; const float* cb; LAS float* CW;
    __device__ __forceinline__ void operator()(AccT& acc, const Unit& u, int wr, int wc, int fr_in, int fq_in) const {
        int fr = fr_in, fq = fq_in;
        asm volatile("" : "+v"(fr), "+v"(fq));
        const int row0 = u.pm * BM + wr * 64 + fr;
        const int jb = u.pn * 128 + wc * 32 + 8 * fq;
        {
            const int tl = (wr * 4 + wc) * 64 + fq * 16 + fr;
#pragma unroll
            for (int it = 0; it < 2; ++it) { const int k = tl + 512 * it, p = k >> 8, col = k & 255, co = (col >> 7) * DFF + u.pn * 128 + (col & 127);
                CW[k] = (p < 3) ? cw[p * F2 + co] : cb[co]; }
            asm volatile("s_waitcnt lgkmcnt(0)" ::: "memory"); __builtin_amdgcn_s_barrier(); asm volatile("" ::: "memory");
        }
#pragma unroll
        for (int ai = 0; ai < 2; ++ai) {
            const int s = u.pm * 4 + ai * 2 + wr;
#pragma unroll
            for (int bj = 0; bj < 2; ++bj)
#pragma unroll
                for (int n = 0; n < 2; ++n) {
                    const int colp = u.pn * BM + bj * HALF + wc * 32 + 8 * fq + 4 * n;
                    if (fr < 2) *(f32x4*)(HALO + (size_t)(s * 4 + fr) * F2 + colp) = acc[ai][bj][0][n];
                    if (fr >= 14) *(f32x4*)(HALO + (size_t)(s * 4 + fr - 12) * F2 + colp) = acc[ai][bj][3][n];
                }
        }
#pragma unroll
        for (int ai = 0; ai < 2; ++ai)
#pragma unroll
            for (int m = 0; m < 4; ++m) {
                const int row = row0 + ai * HALF + m * 16;
#pragma unroll
                for (int n = 0; n < 2; ++n) {
                    f32x4 cv[2];
#pragma unroll
                    for (int bj = 0; bj < 2; ++bj) {
                        const int cl = bj * 128 + wc * 32 + 8 * fq + 4 * n;
                        const f32x4 w0 = *(const LAS f32x4*)&CW[cl], w1 = *(const LAS f32x4*)&CW[256 + cl], w2 = *(const LAS f32x4*)&CW[512 + cl], bb = *(const LAS f32x4*)&CW[768 + cl];
#pragma unroll
                        for (int e = 0; e < 4; ++e) {
                            const float cur = acc[ai][bj][m][n][e];
                            const float prv = m > 0 ? acc[ai][bj][m > 0 ? m - 1 : 0][n][e] : 0.f;
                            const float a1 = dpp_mov<0x121>(cur), a2 = dpp_mov<0x122>(cur), b1 = dpp_mov<0x121>(prv), b2 = dpp_mov<0x122>(prv);
                            const float p1 = fr >= 1 ? a1 : b1, p2 = fr >= 2 ? a2 : b2;
                            cv[bj][e] = bb[e] + w0[e] * p2 + w1[e] * p1 + w2[e] * cur;
                        }
                        __builtin_amdgcn_sched_barrier(0);
                    }
                    const f32x4 g0 = cv[0], v0 = cv[1];
                    u32x2 w;
                    w.x = cvt_pk_bf16(g0[0] * sigmoidf_(g0[0]) * v0[0], g0[1] * sigmoidf_(g0[1]) * v0[1]);
                    w.y = cvt_pk_bf16(g0[2] * sigmoidf_(g0[2]) * v0[2], g0[3] * sigmoidf_(g0[3]) * v0[3]);
                    if (!(m == 0 && fr < 2)) *(u32x2*)(P + (size_t)row * LDP + COL_ACT + jb + 4 * n) = w;
                    __builtin_amdgcn_sched_barrier(0);
                }
            }
    }
};
}

struct Ctx {
    const float* in[24]; float* out; unsigned char* ws;
    bf16_t* P; bf16_t* VT; float* HALO; float* ROPE;
    bf16_t *Win, *Wg, *Wbr, *Wo, *Wup, *Wdn;
    int tid, lane, wave, G, bid;
};

__device__ __forceinline__ int srccol(int mode, int n) {
    if (mode == 0) return n;
    if (mode == 2) return 4932 + n;
    if (mode == 3) { const int tile = n >> 8, w = n & 255, j = tile * 128 + (w & 127); return (w < 128) ? j : DFF + j; }
    if (n < 3840) return n;
    const int c = n - 3840;
    if (c >= 1092) return -1;
    if (c < 640 || (c >= 768 && c < 1088)) { const int base = c & ~63, i = c & 63; return 3840 + base + (i >> 1) + 32 * (i & 1); }
    return 3840 + c;
}
__device__ __forceinline__ void tr_item(const float* W, int ldw, int K, int N, bf16_t* WT, int mode, int item, LAS float* scr, int lane) {
    const int nblk = N / 32, kb = item / nblk, nb = item % nblk, k0 = 64 * kb, n0 = 32 * nb;
    const int sc = srccol(mode, n0 + (lane & 31));
    float wv_[32];
#pragma unroll
    for (int i = 0; i < 32; ++i) { const int kk = 2 * i + (lane >> 5); wv_[i] = (sc >= 0) ? W[(size_t)(k0 + kk) * ldw + sc] : 0.f; }
#pragma unroll
    for (int i = 0; i < 32; ++i) { const int kk = 2 * i + (lane >> 5); scr[kk * 33 + (lane & 31)] = wv_[i]; }
    asm volatile("s_waitcnt lgkmcnt(0)" ::: "memory");
    const int c = lane & 7;
#pragma unroll
    for (int j = 0; j < 4; ++j) { const int n = (lane >> 3) + 8 * j; const LAS float* s = scr + (8 * c) * 33 + n;
        u32x4 o; o.x = pk2(s[0 * 33], s[1 * 33]); o.y = pk2(s[2 * 33], s[3 * 33]); o.z = pk2(s[4 * 33], s[5 * 33]); o.w = pk2(s[6 * 33], s[7 * 33]);
        *(u32x4*)(WT + (size_t)(n0 + n) * K + k0 + 8 * c) = o; }
    asm volatile("s_waitcnt lgkmcnt(0)" ::: "memory");
}
__device__ __forceinline__ void rms_row(const float* xrow, const float* g, bf16_t* obf, float* of32, int lane) {
    const f32x4* xr = (const f32x4*)xrow + lane; const f32x4* gr = (const f32x4*)g + lane;
    f32x4 v[4]; float s = 0.f;
#pragma unroll
    for (int j = 0; j < 4; ++j) { v[j] = xr[64 * j]; s += (v[j].x * v[j].x + v[j].y * v[j].y) + (v[j].z * v[j].z + v[j].w * v[j].w); }
    const float rs = 1.f / sqrtf(wave_sum(s) * (1.f / DM) + 1e-6f);
#pragma unroll
    for (int j = 0; j < 4; ++j) {
        const f32x4 gg = gr[64 * j]; const f32x4 o = v[j] * rs * gg;
        if (obf) { u32x2 w; w.x = pk2(o.x, o.y); w.y = pk2(o.z, o.w); *((u32x2*)obf + lane + 64 * j) = w; }
        else *((f32x4*)of32 + lane + 64 * j) = o;
    }
}
__device__ __forceinline__ void rms_pass(const Ctx& X, const float* src, const float* g, bf16_t* obf, float* of32) {
    const int gw = X.bid * 8 + X.wave, NGW = X.G * 8, lane = X.lane;
    const f32x4* gr = (const f32x4*)g + lane;
    f32x4 gg[4];
#pragma unroll
    for (int j = 0; j < 4; ++j) gg[j] = gr[64 * j];
#pragma unroll 1
    for (int m = gw; m < T_TOK; m += 4 * NGW) {
        f32x4 v[4][4]; float ss[4]; int mr[4];
#pragma unroll
        for (int r = 0; r < 4; ++r) { mr[r] = m + r * NGW; const int ml = mr[r] < T_TOK ? mr[r] : m; const f32x4* x = (const f32x4*)(src + (size_t)ml * DM) + lane;
#pragma unroll
            for (int j = 0; j < 4; ++j) v[r][j] = x[64 * j]; }
#pragma unroll
        for (int r = 0; r < 4; ++r) { float a = 0.f;
#pragma unroll
            for (int j = 0; j < 4; ++j) a += (v[r][j].x * v[r][j].x + v[r][j].y * v[r][j].y) + (v[r][j].z * v[r][j].z + v[r][j].w * v[r][j].w);
            ss[r] = 1.f / sqrtf(wave_sum(a) * (1.f / DM) + 1e-6f); }
#pragma unroll
        for (int r = 0; r < 4; ++r) {
            if (mr[r] < T_TOK) {
#pragma unroll
                for (int j = 0; j < 4; ++j) {
                    const f32x4 o = v[r][j] * ss[r] * gg[j];
                    if (obf) { u32x2 w; w.x = pk2(o.x, o.y); w.y = pk2(o.z, o.w); *((u32x2*)(obf + (size_t)mr[r] * LDP) + lane + 64 * j) = w; }
                    else *((f32x4*)(of32 + (size_t)mr[r] * DM) + lane + 64 * j) = o;
                }
            }
        }
    }
}
__device__ __forceinline__ void phase_prep(const Ctx& X, LAS unsigned char* lds, int layer) {
    LAS float* scr = (LAS float*)(lds + X.wave * 8448);
    const int gw = X.bid * 8 + X.wave, NGW = X.G * 8;
    constexpr int I_IN = 16 * 160, I_G = 16 * 96, I_BR = 8 * 32, I_O = 16 * 32, I_UP = 16 * 176, I_DN = 44 * 32;
    constexpr int NITEMS = I_IN + I_G + 3 * I_BR + I_O + I_UP + I_DN;
    const float* w_in = X.in[2] + (size_t)layer * DM * IN_COLS;
    const float* w_br = X.in[16] + (size_t)layer * 3 * 512 * DM;
    const float* w_o = X.in[17] + (size_t)layer * DM * DM;
    const float* w_up = X.in[19] + (size_t)layer * DM * F2;
    const float* w_dn = X.in[22] + (size_t)layer * DFF * DM;
    for (int it = gw; it < NITEMS; it += NGW) {
        int r = it;
        if (r < I_IN) { tr_item(w_in, IN_COLS, DM, 5120, X.Win, 1, r, scr, X.lane); continue; } r -= I_IN;
        if (r < I_G) { tr_item(w_in, IN_COLS, DM, 3072, X.Wg, 2, r, scr, X.lane); continue; } r -= I_G;
        if (r < 3 * I_BR) { const int b = r / I_BR; tr_item(w_br + (size_t)b * 512 * DM, DM, 512, DM, X.Wbr + (size_t)b * DM * 512, 0, r % I_BR, scr, X.lane); continue; } r -= 3 * I_BR;
        if (r < I_O) { tr_item(w_o, DM, DM, DM, X.Wo, 0, r, scr, X.lane); continue; } r -= I_O;
        if (r < I_UP) { tr_item(w_up, F2, DM, F2, X.Wup, 3, r, scr, X.lane); continue; } r -= I_UP;
        tr_item(w_dn, DM, DFF, DM, X.Wdn, 0, r, scr, X.lane);
    }
    const float* h = (layer == 0) ? X.in[0] : X.out;
    const float* g = X.in[1] + (size_t)layer * DM;
    rms_pass(X, h, g, X.P, nullptr);
    if (layer == 0) {
        for (int idx = X.bid * 512 + X.tid; idx < SEQ * 32; idx += X.G * 512) {
            const int t = idx >> 5, p = idx & 31;
            const float inv = exp2f(-(float)p * 0.03125f * 13.287712379549449f);
            const float ang = (float)t * inv;
            const double rev = (double)ang * 0.15915494309189535;
            const float fr = (float)(rev - floor(rev));
            X.ROPE[2 * idx] = __builtin_amdgcn_cosf(fr); X.ROPE[2 * idx + 1] = __builtin_amdgcn_sinf(fr);
        }
    }
}

__device__ __forceinline__ float wave_sum_fast(float x) {
    x = red16(x);
    const float r0 = __builtin_bit_cast(float, __builtin_amdgcn_readlane(__builtin_bit_cast(int, x), 0)), r1 = __builtin_bit_cast(float, __builtin_amdgcn_readlane(__builtin_bit_cast(int, x), 16));
    const float r2 = __builtin_bit_cast(float, __builtin_amdgcn_readlane(__builtin_bit_cast(int, x), 32)), r3 = __builtin_bit_cast(float, __builtin_amdgcn_readlane(__builtin_bit_cast(int, x), 48));
    return (r0 + r1) + (r2 + r3);
}
#define LDS_BAR() do { asm volatile("s_waitcnt lgkmcnt(0)" ::: "memory"); __builtin_amdgcn_s_barrier(); asm volatile("" ::: "memory"); } while (0)
constexpr int RW_TS = 16, RW_NCH = SEQ / RW_TS, RW_BUF = 33280;
__device__ __forceinline__ void phase_rwkv_pre(const Ctx& X, LAS unsigned char* lds, int layer) {
    LAS float* Rr = (LAS float*)(lds);           LAS float* Kk = (LAS float*)(lds + 8192);   LAS float* Vv = (LAS float*)(lds + 16384);
    LAS float* W1 = (LAS float*)(lds + 24576);   LAS float* AS = (LAS float*)(lds + 32768);
    LAS bf16_t* WDb = (LAS bf16_t*)(lds + 40960);
    LAS bf16_t* ADb = (LAS bf16_t*)(lds + 45568);
    LAS bf16_t* WTu = (LAS bf16_t*)(lds + 50176);
    LAS bf16_t* WTa = (LAS bf16_t*)(lds + 59392);
    LAS float* MU = (LAS float*)(lds + 68608);
    const int tid = X.tid, lane = tid & 63, wv = X.wave;
    const float* mu = X.in[3] + layer * 1792;
    const float* w0 = X.in[4] + layer * 512;   const float* w_up = X.in[5] + (size_t)layer * 64 * 512;
    const float* a0 = X.in[6] + layer * 512;   const float* a_up = X.in[7] + (size_t)layer * 64 * 512;
    const float* k_k = X.in[9] + layer * 512;  const float* k_a = X.in[10] + layer * 512;  const float* r_k = X.in[11] + layer * 512;
    const bf16_t* BND = (const bf16_t*)(X.ws + WS_BND);
    float* SCAL = (float*)(X.ws + WS_SCAL);
    const int ln = lane & 15, lg = lane >> 4;
    int last_h = -1;
    float q_w0 = 0.f, q_a0 = 0.f;
    f32x4 p_kk4 = (f32x4){0.f, 0.f, 0.f, 0.f}, p_ka4 = p_kk4, p_rk4 = p_kk4;
    const int cg4 = (tid & 15) * 4;
    u32x4 pc4[3], pp4[3]; bool have_pf = false;
    pc4[0] = pc4[1] = pc4[2] = pp4[0] = pp4[1] = pp4[2] = (u32x4){0u, 0u, 0u, 0u};
#define PRE_LOAD(uu) do { const int h_ = (uu) & 7, tp_ = (uu) >> 3; _Pragma("unroll") for (int it = 0; it < 3; ++it) { const int idx = tid + 512 * it; pc4[it] = (u32x4){0u, 0u, 0u, 0u}; pp4[it] = (u32x4){0u, 0u, 0u, 0u}; \
        if (idx < 32 * 40) { const int tt = idx / 40, vv = idx - tt * 40; \
            const int col = vv < 8 ? h_ * 64 + 8 * vv : (vv < 16 ? 512 + h_ * 64 + 8 * (vv - 8) : (vv < 24 ? 1024 + h_ * 64 + 8 * (vv - 16) : 1536 + 8 * (vv - 24))); \
            const size_t row = (size_t)tp_ * 32 + tt; pc4[it] = *(const u32x4*)(X.P + row * LDP + COL_PA + col); \
            if (tt > 0) pp4[it] = *(const u32x4*)(X.P + (row - 1) * LDP + COL_PA + col); else if ((tp_ & 63) != 0) pp4[it] = *(const u32x4*)(BND + (size_t)(2 * tp_ - 1) * 1792 + col); } } } while (0)
#pragma unroll 1
    for (int u = X.bid; u < 4096; u += X.G) {
        const int h = u & 7, tp = u >> 3;
        if (h != last_h) {
            __syncthreads();
            for (int idx = tid; idx < 64 * 64; idx += 512) { const int m = idx >> 6, cc = idx & 63;
                WTu[cc * 72 + m] = (bf16_t)f2bf(w_up[m * 512 + h * 64 + cc]); WTa[cc * 72 + m] = (bf16_t)f2bf(a_up[m * 512 + h * 64 + cc]); }
            if (tid < 320) { const int cc = tid; const int col = cc < 64 ? h * 64 + cc : (cc < 128 ? 512 + h * 64 + cc - 64 : (cc < 192 ? 1024 + h * 64 + cc - 128 : 1536 + cc - 192)); MU[cc] = mu[col]; }
            p_kk4 = *(const f32x4*)(k_k + h * 64 + cg4); p_ka4 = *(const f32x4*)(k_a + h * 64 + cg4); p_rk4 = *(const f32x4*)(r_k + h * 64 + cg4);
            q_w0 = w0[h * 64 + 16 * (wv >> 1) + ln]; q_a0 = a0[h * 64 + 16 * (wv >> 1) + ln];
            last_h = h;
            __syncthreads();
        }
        if (!have_pf) { PRE_LOAD(u); }
#pragma unroll
        for (int it = 0; it < 3; ++it) {
            const int idx = tid + 512 * it;
            if (idx < 32 * 40) {
                const int tt = idx / 40, vv = idx - tt * 40, cc0 = 8 * vv;
                const u32x4 c4 = pc4[it], p4 = pp4[it];
                const f32x4 m0 = *(const LAS f32x4*)&MU[cc0], m1 = *(const LAS f32x4*)&MU[cc0 + 4];
                float cur[8], prv[8], val[8];
                cur[0] = bflo(c4.x); cur[1] = bfhi(c4.x); cur[2] = bflo(c4.y); cur[3] = bfhi(c4.y); cur[4] = bflo(c4.z); cur[5] = bfhi(c4.z); cur[6] = bflo(c4.w); cur[7] = bfhi(c4.w);
                prv[0] = bflo(p4.x); prv[1] = bfhi(p4.x); prv[2] = bflo(p4.y); prv[3] = bfhi(p4.y); prv[4] = bflo(p4.z); prv[5] = bfhi(p4.z); prv[6] = bflo(p4.w); prv[7] = bfhi(p4.w);
#pragma unroll
                for (int e = 0; e < 8; ++e) val[e] = cur[e] + (prv[e] - cur[e]) * (e < 4 ? m0[e & 3] : m1[e & 3]);
                if (vv < 24) {
#pragma unroll
                    for (int e = 0; e < 8; ++e) val[e] = bf2f((bf16_t)f2bf(val[e]));
                    LAS float* dst = (vv < 8 ? Rr : (vv < 16 ? Kk : Vv)) + tt * 64 + 8 * (vv & 7);
                    *(LAS f32x4*)dst = (f32x4){val[0], val[1], val[2], val[3]}; *(LAS f32x4*)(dst + 4) = (f32x4){val[4], val[5], val[6], val[7]};
                } else {
                    const int lr0 = 8 * (vv - 24);
                    LAS bf16_t* dst;
                    if (lr0 < 64) { dst = WDb + tt * 72 + lr0;
#pragma unroll
                        for (int e = 0; e < 8; ++e) { const float ex = __expf(2.f * val[e]); val[e] = 1.f - 2.f / (ex + 1.f); } }
                    else dst = ADb + tt * 72 + lr0 - 64;
                    u32x4 o; o.x = pk2(val[0], val[1]); o.y = pk2(val[2], val[3]); o.z = pk2(val[4], val[5]); o.w = pk2(val[6], val[7]);
                    *(LAS u32x4*)dst = o;
                }
            }
        }
        have_pf = false;
        if (u + X.G < 4096 && ((u + X.G) & 7) == h) { PRE_LOAD(u + X.G); have_pf = true; }
        LDS_BAR();
        {
            const int mt = wv & 1, nt = wv >> 1, chm = 16 * nt + ln;
            f32x4 cw_ = (f32x4){0.f, 0.f, 0.f, 0.f}, ca_ = cw_;
#pragma unroll
            for (int ks = 0; ks < 2; ++ks) {
                const bf16x8 xa = *(const LAS bf16x8*)&WDb[(16 * mt + ln) * 72 + ks * 32 + 8 * lg], xb = *(const LAS bf16x8*)&WTu[(16 * nt + ln) * 72 + ks * 32 + 8 * lg];
                cw_ = __builtin_amdgcn_mfma_f32_16x16x32_bf16(xa, xb, cw_, 0, 0, 0);
                const bf16x8 ya = *(const LAS bf16x8*)&ADb[(16 * mt + ln) * 72 + ks * 32 + 8 * lg], yb = *(const LAS bf16x8*)&WTa[(16 * nt + ln) * 72 + ks * 32 + 8 * lg];
                ca_ = __builtin_amdgcn_mfma_f32_16x16x32_bf16(ya, yb, ca_, 0, 0, 0);
            }
#pragma unroll
            for (int r = 0; r < 4; ++r) {
                const int tt = 16 * mt + 4 * lg + r;
                const float z = -(q_w0 + cw_[r]);
                const float sp = fmaxf(z, 0.f) + __logf(1.f + __expf(-fabsf(z)));
                const float e = __expf(-sp - 0.5f);
                W1[tt * 64 + chm] = bf2f((bf16_t)f2bf(-expm1f(-e)));
                AS[tt * 64 + chm] = bf2f((bf16_t)f2bf(sigmoidf_(q_a0 + ca_[r])));
            }
        }
        LDS_BAR();
        {
            const int tt = tid >> 4;
            const size_t row = (size_t)tp * 32 + tt;
            const f32x4 w1 = *(const LAS f32x4*)&W1[tt * 64 + cg4], a = *(const LAS f32x4*)&AS[tt * 64 + cg4];
            const f32x4 kraw = *(const LAS f32x4*)&Kk[tt * 64 + cg4], r = *(const LAS f32x4*)&Rr[tt * 64 + cg4], v = *(const LAS f32x4*)&Vv[tt * 64 + cg4];
            const f32x4 kk0 = kraw * p_kk4;
            const float inv = 1.f / sqrtf(fmaxf(red16((kk0.x * kk0.x + kk0.y * kk0.y) + (kk0.z * kk0.z + kk0.w * kk0.w)), 1e-24f));
            const f32x4 kk = kk0 * inv;
            const f32x4 kmod = kraw * (1.f + (a - 1.f) * p_ka4);
            const f32x4 bvec = kk * a, t1 = bvec * r, t2 = kmod * r, t3 = t2 * p_rk4;
            const float br = red16((t1.x + t1.y) + (t1.z + t1.w)), kr = red16((t2.x + t2.y) + (t2.z + t2.w)), bonus = red16((t3.x + t3.y) + (t3.z + t3.w));
            bf16_t* rp_ = X.P + row * LDP;
            u32x2 o;
            o.x = pk2(r.x, r.y); o.y = pk2(r.z, r.w); *(u32x2*)(rp_ + COL_PA + h * 64 + cg4) = o;
            o.x = pk2(kraw.x, kraw.y); o.y = pk2(kraw.z, kraw.w); *(u32x2*)(rp_ + COL_PA + 512 + h * 64 + cg4) = o;
            o.x = pk2(v.x, v.y); o.y = pk2(v.z, v.w); *(u32x2*)(rp_ + COL_PA + 1024 + h * 64 + cg4) = o;
            o.x = pk2(w1.x, w1.y); o.y = pk2(w1.z, w1.w); *(u32x2*)(rp_ + h * 64 + cg4) = o;
            o.x = pk2(a.x, a.y); o.y = pk2(a.z, a.w); *(u32x2*)(rp_ + 512 + h * 64 + cg4) = o;
            if (cg4 == 0) *(f32x4*)(SCAL + (row * 8 + h) * 4) = (f32x4){inv, br, kr, bonus};
        }
        LDS_BAR();
    }
}

__device__ __forceinline__ void rwkv_task(const Ctx& X, LAS unsigned char* lds, int layer, int b, int h) {
    LAS bf16_t* GDb = (LAS bf16_t*)(lds + 66560);
    LAS bf16_t* WTg = (LAS bf16_t*)(lds + 70912);
    LAS float* BON = (LAS float*)(lds + 88320);
    const int tid = X.tid, lane = tid & 63;
    const bool helper = X.wave >= 4;
    const int ht = tid & 255;
    const float* mu = X.in[3] + layer * 1792;
    const float* g_up = X.in[8] + (size_t)layer * 128 * 512;
    const float* k_k = X.in[9] + layer * 512;  const float* k_a = X.in[10] + layer * 512;
    const float* gn_g = X.in[12] + layer * 512; const float* gn_b = X.in[13] + layer * 512;
    const float* SCAL = (const float*)(X.ws + WS_SCAL);
    const int tt_h = ht >> 4, cg4 = (ht & 15) * 4;
    const f32x4 p_kk = *(const f32x4*)(k_k + h * 64 + cg4), p_ka = *(const f32x4*)(k_a + h * 64 + cg4);
    const f32x4 p_gg = *(const f32x4*)(gn_g + h * 64 + cg4), p_gb = *(const f32x4*)(gn_b + h * 64 + cg4);
    const int gv8 = (ht & 15) * 8;
    const f32x4 mg0 = *(const f32x4*)(mu + 1664 + gv8), mg1 = *(const f32x4*)(mu + 1664 + gv8 + 4);
    const int nt = (ht >> 6), ln = lane & 15, lg = lane >> 4, chm = 16 * nt + ln;
    const int rp = ht >> 3, jg = ht & 7, i0 = 2 * rp;
    for (int idx = tid; idx < 128 * 64; idx += 512) { const int m = idx >> 6, cc = idx & 63; WTg[cc * 136 + m] = (bf16_t)f2bf(g_up[m * 512 + h * 64 + cc]); }
    f32x2 S0[4], S1[4];
#pragma unroll
    for (int j = 0; j < 4; ++j) { S0[j] = (f32x2){0.f, 0.f}; S1[j] = (f32x2){0.f, 0.f}; }
#if PROBE_SCAN2
    f32x2 T0[4], T1[4];
#pragma unroll
    for (int j = 0; j < 4; ++j) { T0[j] = (f32x2){0.f, 0.f}; T1[j] = (f32x2){0.f, 0.f}; }
#endif
    __syncthreads();

#define RW_ARR(bufi, k) ((LAS float*)(lds + (bufi) * RW_BUF + (k) * 4096))
#define RW_SC(bufi) ((LAS float*)(lds + (bufi) * RW_BUF + 32768))
#define RW_LOAD(chk, L) do { const size_t row_ = (size_t)b * SEQ + (chk) * RW_TS + tt_h; const bf16_t* rp_ = X.P + row_ * LDP; \
        l_r##L = *(const u32x2*)(rp_ + COL_PA + h * 64 + cg4); l_k##L = *(const u32x2*)(rp_ + COL_PA + 512 + h * 64 + cg4); l_v##L = *(const u32x2*)(rp_ + COL_PA + 1024 + h * 64 + cg4); \
        l_w##L = *(const u32x2*)(rp_ + h * 64 + cg4); l_a##L = *(const u32x2*)(rp_ + 512 + h * 64 + cg4); l_s##L = *(const f32x4*)(SCAL + (row_ * 8 + h) * 4); \
        l_gc##L = *(const u32x4*)(rp_ + COL_PA + 1664 + gv8); l_gp##L = (u32x4){0u, 0u, 0u, 0u}; if ((chk) * RW_TS + tt_h > 0) l_gp##L = *(const u32x4*)(rp_ - LDP + COL_PA + 1664 + gv8); } while (0)
    u32x2 l_rA, l_kA, l_vA, l_wA, l_aA; f32x4 l_sA; u32x4 l_gcA, l_gpA;
    u32x2 l_rB, l_kB, l_vB, l_wB, l_aB; f32x4 l_sB; u32x4 l_gcB, l_gpB;
    l_rA = l_kA = l_vA = l_wA = l_aA = l_rB = l_kB = l_vB = l_wB = l_aB = (u32x2){0u, 0u}; l_sA = l_sB = (f32x4){0.f, 0.f, 0.f, 0.f}; l_gcA = l_gpA = l_gcB = l_gpB = (u32x4){0u, 0u, 0u, 0u};
    if (helper) { RW_LOAD(0, A); RW_LOAD(1, B); }

#pragma unroll 1
    for (int i0_ = -1; i0_ < RW_NCH; i0_ += 2) {
        { const int i = i0_;

        const int bufn = (i + 1) & 1, bufc = i & 1;
        if (helper) {
            const bool do_prep = (i + 1 < RW_NCH);
            if (i >= 1) {
                LAS float* Yy = RW_ARR(bufn, 7); LAS float* Gg = RW_ARR(bufn, 6); LAS float* Vv = RW_ARR(bufn, 5); LAS float* SC = RW_SC(bufn);
                const f32x4 y = *(const LAS f32x4*)&Yy[tt_h * 64 + cg4], gg = *(const LAS f32x4*)&Gg[tt_h * 64 + cg4], vv = *(const LAS f32x4*)&Vv[tt_h * 64 + cg4];
                const float bonus = BON[((i - 1) % 3) * 16 + tt_h];
                const float mean = red16((y.x + y.y) + (y.z + y.w)) * (1.f / 64.f);
                const f32x4 d = y - mean;
                const float var = red16((d.x * d.x + d.y * d.y) + (d.z * d.z + d.w * d.w)) * (1.f / 64.f);
                const float rs = 1.f / sqrtf(var + 64e-5f);
                const f32x4 o = (d * rs * p_gg + p_gb + vv * bonus) * gg;
                u32x2 w; w.x = pk2(o.x, o.y); w.y = pk2(o.z, o.w);
                *(u32x2*)(X.P + ((size_t)b * SEQ + (i - 1) * RW_TS + tt_h) * LDP + COL_YA + h * 64 + cg4) = w;
            }
            if (do_prep) {
                const f32x4 r = (f32x4){bflo(l_rA.x), bfhi(l_rA.x), bflo(l_rA.y), bfhi(l_rA.y)}, k = (f32x4){bflo(l_kA.x), bfhi(l_kA.x), bflo(l_kA.y), bfhi(l_kA.y)};
                const f32x4 v = (f32x4){bflo(l_vA.x), bfhi(l_vA.x), bflo(l_vA.y), bfhi(l_vA.y)}, w1 = (f32x4){bflo(l_wA.x), bfhi(l_wA.x), bflo(l_wA.y), bfhi(l_wA.y)};
                const f32x4 a = (f32x4){bflo(l_aA.x), bfhi(l_aA.x), bflo(l_aA.y), bfhi(l_aA.y)};
                const f32x4 kk = k * p_kk * l_sA.x;
                const f32x4 decay = 1.f - w1;
                *(LAS f32x4*)&RW_ARR(bufn, 0)[tt_h * 64 + cg4] = -kk;
                *(LAS f32x4*)&RW_ARR(bufn, 1)[tt_h * 64 + cg4] = decay * r;
                *(LAS f32x4*)&RW_ARR(bufn, 2)[tt_h * 64 + cg4] = decay;
                *(LAS f32x4*)&RW_ARR(bufn, 3)[tt_h * 64 + cg4] = kk * a;
                *(LAS f32x4*)&RW_ARR(bufn, 4)[tt_h * 64 + cg4] = k * (1.f + (a - 1.f) * p_ka);
                *(LAS f32x4*)&RW_ARR(bufn, 5)[tt_h * 64 + cg4] = v;
                if (cg4 == 0) { LAS float* SC = RW_SC(bufn); SC[tt_h * 4 + 0] = l_sA.y; SC[tt_h * 4 + 1] = l_sA.z; BON[((i + 1) % 3) * 16 + tt_h] = l_sA.w; }
                float gc[8], gp[8];
                gc[0] = bflo(l_gcA.x); gc[1] = bfhi(l_gcA.x); gc[2] = bflo(l_gcA.y); gc[3] = bfhi(l_gcA.y); gc[4] = bflo(l_gcA.z); gc[5] = bfhi(l_gcA.z); gc[6] = bflo(l_gcA.w); gc[7] = bfhi(l_gcA.w);
                gp[0] = bflo(l_gpA.x); gp[1] = bfhi(l_gpA.x); gp[2] = bflo(l_gpA.y); gp[3] = bfhi(l_gpA.y); gp[4] = bflo(l_gpA.z); gp[5] = bfhi(l_gpA.z); gp[6] = bflo(l_gpA.w); gp[7] = bfhi(l_gpA.w);
#pragma unroll
                for (int e = 0; e < 8; ++e) gc[e] = sigmoidf_(gc[e] + (gp[e] - gc[e]) * (e < 4 ? mg0[e & 3] : mg1[e & 3]));
                u32x4 o; o.x = pk2(gc[0], gc[1]); o.y = pk2(gc[2], gc[3]); o.z = pk2(gc[4], gc[5]); o.w = pk2(gc[6], gc[7]);
                *(LAS u32x4*)&GDb[tt_h * 136 + gv8] = o;
            }
            if (i + 3 < RW_NCH) RW_LOAD(i + 3, A);
            LDS_BAR();
            if (do_prep) {
                LAS float* Gg = RW_ARR(bufn, 6);
                f32x4 cg_ = (f32x4){0.f, 0.f, 0.f, 0.f};
#pragma unroll
                for (int ks = 0; ks < 4; ++ks) {
                    const bf16x8 za = *(const LAS bf16x8*)&GDb[ln * 136 + ks * 32 + 8 * lg], zb = *(const LAS bf16x8*)&WTg[(16 * nt + ln) * 136 + ks * 32 + 8 * lg];
                    cg_ = __builtin_amdgcn_mfma_f32_16x16x32_bf16(za, zb, cg_, 0, 0, 0);
                }
#pragma unroll
                for (int r = 0; r < 4; ++r) Gg[(4 * lg + r) * 64 + chm] = cg_[r];
            }
            LDS_BAR();
        } else {
            LAS float* A_ = RW_ARR(bufc, 0); LAS float* WR = RW_ARR(bufc, 1); LAS float* Wd = RW_ARR(bufc, 2); LAS float* Bv = RW_ARR(bufc, 3);
            LAS float* Kk = RW_ARR(bufc, 4); LAS float* Vv = RW_ARR(bufc, 5); LAS float* Yy = RW_ARR(bufc, 7); LAS float* SC = RW_SC(bufc);
#pragma unroll 1
            for (int q4 = 0; q4 < 4; ++q4) {
                if (i >= 0) {
                    float yv[8];
#pragma unroll
                    for (int s4 = 0; s4 < 4; ++s4) {
                        const int tt = 4 * q4 + s4;
                        const f32x4 a_lo = *(const LAS f32x4*)&A_[tt * 64 + 8 * jg], a_hi = *(const LAS f32x4*)&A_[tt * 64 + 8 * jg + 4];
                        const f32x4 r_lo = *(const LAS f32x4*)&WR[tt * 64 + 8 * jg], r_hi = *(const LAS f32x4*)&WR[tt * 64 + 8 * jg + 4];
                        const f32x4 w_lo = *(const LAS f32x4*)&Wd[tt * 64 + 8 * jg], w_hi = *(const LAS f32x4*)&Wd[tt * 64 + 8 * jg + 4];
                        const f32x4 b_lo = *(const LAS f32x4*)&Bv[tt * 64 + 8 * jg], b_hi = *(const LAS f32x4*)&Bv[tt * 64 + 8 * jg + 4];
                        const f32x4 k_lo = *(const LAS f32x4*)&Kk[tt * 64 + 8 * jg], k_hi = *(const LAS f32x4*)&Kk[tt * 64 + 8 * jg + 4];
                        const f32x2 vv = *(const LAS f32x2*)&Vv[tt * 64 + i0];
                        const f32x2 sc = *(const LAS f32x2*)&SC[tt * 4];
                        const f32x2 av[4] = {{a_lo.x, a_lo.y}, {a_lo.z, a_lo.w}, {a_hi.x, a_hi.y}, {a_hi.z, a_hi.w}};
                        const f32x2 rv[4] = {{r_lo.x, r_lo.y}, {r_lo.z, r_lo.w}, {r_hi.x, r_hi.y}, {r_hi.z, r_hi.w}};
                        const f32x2 wv[4] = {{w_lo.x, w_lo.y}, {w_lo.z, w_lo.w}, {w_hi.x, w_hi.y}, {w_hi.z, w_hi.w}};
                        const f32x2 bv[4] = {{b_lo.x, b_lo.y}, {b_lo.z, b_lo.w}, {b_hi.x, b_hi.y}, {b_hi.z, b_hi.w}};
                        const f32x2 kv[4] = {{k_lo.x, k_lo.y}, {k_lo.z, k_lo.w}, {k_hi.x, k_hi.y}, {k_hi.z, k_hi.w}};
                        f32x2 e10 = S0[0] * av[0], e20 = S0[0] * rv[0], e11 = S1[0] * av[0], e21 = S1[0] * rv[0];
#pragma unroll
                        for (int j = 1; j < 4; ++j) { e10 += S0[j] * av[j]; e20 += S0[j] * rv[j]; e11 += S1[j] * av[j]; e21 += S1[j] * rv[j]; }
                        const float d10 = red8(e10.x + e10.y), d11 = red8(e11.x + e11.y);
                        yv[2 * s4] = (e20.x + e20.y) + (jg == 0 ? d10 * sc.x + vv.x * sc.y : 0.f); yv[2 * s4 + 1] = (e21.x + e21.y) + (jg == 0 ? d11 * sc.x + vv.y * sc.y : 0.f);
                        const f32x2 d10v = (f32x2){d10, d10}, d11v = (f32x2){d11, d11}, v0v = (f32x2){vv.x, vv.x}, v1v = (f32x2){vv.y, vv.y};
#pragma unroll
                        for (int j = 0; j < 4; ++j) { S0[j] = S0[j] * wv[j] + (d10v * bv[j] + v0v * kv[j]); S1[j] = S1[j] * wv[j] + (d11v * bv[j] + v1v * kv[j]); }
                    }
                    {
                        const bool t2 = (jg & 4) != 0, t1 = (jg & 2) != 0, t0 = (jg & 1) != 0;
#pragma unroll
                        for (int q = 0; q < 4; ++q) { const float keep = t2 ? yv[q + 4] : yv[q], send = t2 ? yv[q] : yv[q + 4]; yv[q] = keep + dpp_mov<0x141>(send); }
#pragma unroll
                        for (int q = 0; q < 2; ++q) { const float keep = t1 ? yv[q + 2] : yv[q], send = t1 ? yv[q] : yv[q + 2]; yv[q] = keep + dpp_mov<0x4E>(send); }
                        { const float keep = t0 ? yv[1] : yv[0], send = t0 ? yv[0] : yv[1]; yv[0] = keep + dpp_mov<0xB1>(send); }
                        Yy[(4 * q4 + (jg >> 1)) * 64 + i0 + (jg & 1)] = yv[0];
                    }

#if PROBE_SCAN2
                    {
#pragma unroll
                    for (int s4 = 0; s4 < 4; ++s4) {
                        const int tt = 4 * q4 + s4;
                        const f32x4 a_lo = *(const LAS f32x4*)&A_[tt * 64 + 8 * jg], a_hi = *(const LAS f32x4*)&A_[tt * 64 + 8 * jg + 4];
                        const f32x4 r_lo = *(const LAS f32x4*)&WR[tt * 64 + 8 * jg], r_hi = *(const LAS f32x4*)&WR[tt * 64 + 8 * jg + 4];
                        const f32x4 w_lo = *(const LAS f32x4*)&Wd[tt * 64 + 8 * jg], w_hi = *(const LAS f32x4*)&Wd[tt * 64 + 8 * jg + 4];
                        const f32x4 b_lo = *(const LAS f32x4*)&Bv[tt * 64 + 8 * jg], b_hi = *(const LAS f32x4*)&Bv[tt * 64 + 8 * jg + 4];
                        const f32x4 k_lo = *(const LAS f32x4*)&Kk[tt * 64 + 8 * jg], k_hi = *(const LAS f32x4*)&Kk[tt * 64 + 8 * jg + 4];
                        const f32x2 vv = *(const LAS f32x2*)&Vv[tt * 64 + i0];
                        const f32x2 av[4] = {{a_lo.x, a_lo.y}, {a_lo.z, a_lo.w}, {a_hi.x, a_hi.y}, {a_hi.z, a_hi.w}};
                        const f32x2 rv[4] = {{r_lo.x, r_lo.y}, {r_lo.z, r_lo.w}, {r_hi.x, r_hi.y}, {r_hi.z, r_hi.w}};
                        const f32x2 wv[4] = {{w_lo.x, w_lo.y}, {w_lo.z, w_lo.w}, {w_hi.x, w_hi.y}, {w_hi.z, w_hi.w}};
                        const f32x2 bv[4] = {{b_lo.x, b_lo.y}, {b_lo.z, b_lo.w}, {b_hi.x, b_hi.y}, {b_hi.z, b_hi.w}};
                        const f32x2 kv[4] = {{k_lo.x, k_lo.y}, {k_lo.z, k_lo.w}, {k_hi.x, k_hi.y}, {k_hi.z, k_hi.w}};
                        f32x2 e10 = T0[0] * av[0], e20 = T0[0] * rv[0], e11 = T1[0] * av[0], e21 = T1[0] * rv[0];
#pragma unroll
                        for (int j = 1; j < 4; ++j) { e10 += T0[j] * av[j]; e20 += T0[j] * rv[j]; e11 += T1[j] * av[j]; e21 += T1[j] * rv[j]; }
                        const float d10 = red8(e10.x + e10.y), d20 = red8(e20.x + e20.y), d11 = red8(e11.x + e11.y), d21 = red8(e21.x + e21.y);
                        const f32x2 d10v = (f32x2){d10 + d20, d10}, d11v = (f32x2){d11 + d21, d11}, v0v = (f32x2){vv.x, vv.x}, v1v = (f32x2){vv.y, vv.y};
#pragma unroll
                        for (int j = 0; j < 4; ++j) { T0[j] = T0[j] * wv[j] + (d10v * bv[j] + v0v * kv[j]); T1[j] = T1[j] * wv[j] + (d11v * bv[j] + v1v * kv[j]); }
                    }
                    }
#endif
                }
                if (q4 & 1) LDS_BAR();
            }
        }
            }
        if (i0_ + 1 < RW_NCH) { const int i = i0_ + 1;

        const int bufn = (i + 1) & 1, bufc = i & 1;
        if (helper) {
            const bool do_prep = (i + 1 < RW_NCH);
            if (i >= 1) {
                LAS float* Yy = RW_ARR(bufn, 7); LAS float* Gg = RW_ARR(bufn, 6); LAS float* Vv = RW_ARR(bufn, 5); LAS float* SC = RW_SC(bufn);
                const f32x4 y = *(const LAS f32x4*)&Yy[tt_h * 64 + cg4], gg = *(const LAS f32x4*)&Gg[tt_h * 64 + cg4], vv = *(const LAS f32x4*)&Vv[tt_h * 64 + cg4];
                const float bonus = BON[((i - 1) % 3) * 16 + tt_h];
                const float mean = red16((y.x + y.y) + (y.z + y.w)) * (1.f / 64.f);
                const f32x4 d = y - mean;
                const float var = red16((d.x * d.x + d.y * d.y) + (d.z * d.z + d.w * d.w)) * (1.f / 64.f);
                const float rs = 1.f / sqrtf(var + 64e-5f);
                const f32x4 o = (d * rs * p_gg + p_gb + vv * bonus) * gg;
                u32x2 w; w.x = pk2(o.x, o.y); w.y = pk2(o.z, o.w);
                *(u32x2*)(X.P + ((size_t)b * SEQ + (i - 1) * RW_TS + tt_h) * LDP + COL_YA + h * 64 + cg4) = w;
            }
            if (do_prep) {
                const f32x4 r = (f32x4){bflo(l_rB.x), bfhi(l_rB.x), bflo(l_rB.y), bfhi(l_rB.y)}, k = (f32x4){bflo(l_kB.x), bfhi(l_kB.x), bflo(l_kB.y), bfhi(l_kB.y)};
                const f32x4 v = (f32x4){bflo(l_vB.x), bfhi(l_vB.x), bflo(l_vB.y), bfhi(l_vB.y)}, w1 = (f32x4){bflo(l_wB.x), bfhi(l_wB.x), bflo(l_wB.y), bfhi(l_wB.y)};
                const f32x4 a = (f32x4){bflo(l_aB.x), bfhi(l_aB.x), bflo(l_aB.y), bfhi(l_aB.y)};
                const f32x4 kk = k * p_kk * l_sB.x;
                const f32x4 decay = 1.f - w1;
                *(LAS f32x4*)&RW_ARR(bufn, 0)[tt_h * 64 + cg4] = -kk;
                *(LAS f32x4*)&RW_ARR(bufn, 1)[tt_h * 64 + cg4] = decay * r;
                *(LAS f32x4*)&RW_ARR(bufn, 2)[tt_h * 64 + cg4] = decay;
                *(LAS f32x4*)&RW_ARR(bufn, 3)[tt_h * 64 + cg4] = kk * a;
                *(LAS f32x4*)&RW_ARR(bufn, 4)[tt_h * 64 + cg4] = k * (1.f + (a - 1.f) * p_ka);
                *(LAS f32x4*)&RW_ARR(bufn, 5)[tt_h * 64 + cg4] = v;
                if (cg4 == 0) { LAS float* SC = RW_SC(bufn); SC[tt_h * 4 + 0] = l_sB.y; SC[tt_h * 4 + 1] = l_sB.z; BON[((i + 1) % 3) * 16 + tt_h] = l_sB.w; }
                float gc[8], gp[8];
                gc[0] = bflo(l_gcB.x); gc[1] = bfhi(l_gcB.x); gc[2] = bflo(l_gcB.y); gc[3] = bfhi(l_gcB.y); gc[4] = bflo(l_gcB.z); gc[5] = bfhi(l_gcB.z); gc[6] = bflo(l_gcB.w); gc[7] = bfhi(l_gcB.w);
                gp[0] = bflo(l_gpB.x); gp[1] = bfhi(l_gpB.x); gp[2] = bflo(l_gpB.y); gp[3] = bfhi(l_gpB.y); gp[4] = bflo(l_gpB.z); gp[5] = bfhi(l_gpB.z); gp[6] = bflo(l_gpB.w); gp[7] = bfhi(l_gpB.w);
#pragma unroll
                for (int e = 0; e < 8; ++e) gc[e] = sigmoidf_(gc[e] + (gp[e] - gc[e]) * (e < 4 ? mg0[e & 3] : mg1[e & 3]));
                u32x4 o; o.x = pk2(gc[0], gc[1]); o.y = pk2(gc[2], gc[3]); o.z = pk2(gc[4], gc[5]); o.w = pk2(gc[6], gc[7]);
                *(LAS u32x4*)&GDb[tt_h * 136 + gv8] = o;
            }
            if (i + 3 < RW_NCH) RW_LOAD(i + 3, B);
            LDS_BAR();
            if (do_prep) {
                LAS float* Gg = RW_ARR(bufn, 6);
                f32x4 cg_ = (f32x4){0.f, 0.f, 0.f, 0.f};
#pragma unroll
                for (int ks = 0; ks < 4; ++ks) {
                    const bf16x8 za = *(const LAS bf16x8*)&GDb[ln * 136 + ks * 32 + 8 * lg], zb = *(const LAS bf16x8*)&WTg[(16 * nt + ln) * 136 + ks * 32 + 8 * lg];
                    cg_ = __builtin_amdgcn_mfma_f32_16x16x32_bf16(za, zb, cg_, 0, 0, 0);
                }
#pragma unroll
                for (int r = 0; r < 4; ++r) Gg[(4 * lg + r) * 64 + chm] = cg_[r];
            }
            LDS_BAR();
        } else {
            LAS float* A_ = RW_ARR(bufc, 0); LAS float* WR = RW_ARR(bufc, 1); LAS float* Wd = RW_ARR(bufc, 2); LAS float* Bv = RW_ARR(bufc, 3);
            LAS float* Kk = RW_ARR(bufc, 4); LAS float* Vv = RW_ARR(bufc, 5); LAS float* Yy = RW_ARR(bufc, 7); LAS float* SC = RW_SC(bufc);
#pragma unroll 1
            for (int q4 = 0; q4 < 4; ++q4) {
                if (i >= 0) {
                    float yv[8];
#pragma unroll
                    for (int s4 = 0; s4 < 4; ++s4) {
                        const int tt = 4 * q4 + s4;
                        const f32x4 a_lo = *(const LAS f32x4*)&A_[tt * 64 + 8 * jg], a_hi = *(const LAS f32x4*)&A_[tt * 64 + 8 * jg + 4];
                        const f32x4 r_lo = *(const LAS f32x4*)&WR[tt * 64 + 8 * jg], r_hi = *(const LAS f32x4*)&WR[tt * 64 + 8 * jg + 4];
                        const f32x4 w_lo = *(const LAS f32x4*)&Wd[tt * 64 + 8 * jg], w_hi = *(const LAS f32x4*)&Wd[tt * 64 + 8 * jg + 4];
                        const f32x4 b_lo = *(const LAS f32x4*)&Bv[tt * 64 + 8 * jg], b_hi = *(const LAS f32x4*)&Bv[tt * 64 + 8 * jg + 4];
                        const f32x4 k_lo = *(const LAS f32x4*)&Kk[tt * 64 + 8 * jg], k_hi = *(const LAS f32x4*)&Kk[tt * 64 + 8 * jg + 4];
                        const f32x2 vv = *(const LAS f32x2*)&Vv[tt * 64 + i0];
                        const f32x2 sc = *(const LAS f32x2*)&SC[tt * 4];
                        const f32x2 av[4] = {{a_lo.x, a_lo.y}, {a_lo.z, a_lo.w}, {a_hi.x, a_hi.y}, {a_hi.z, a_hi.w}};
                        const f32x2 rv[4] = {{r_lo.x, r_lo.y}, {r_lo.z, r_lo.w}, {r_hi.x, r_hi.y}, {r_hi.z, r_hi.w}};
                        const f32x2 wv[4] = {{w_lo.x, w_lo.y}, {w_lo.z, w_lo.w}, {w_hi.x, w_hi.y}, {w_hi.z, w_hi.w}};
                        const f32x2 bv[4] = {{b_lo.x, b_lo.y}, {b_lo.z, b_lo.w}, {b_hi.x, b_hi.y}, {b_hi.z, b_hi.w}};
                        const f32x2 kv[4] = {{k_lo.x, k_lo.y}, {k_lo.z, k_lo.w}, {k_hi.x, k_hi.y}, {k_hi.z, k_hi.w}};
                        f32x2 e10 = S0[0] * av[0], e20 = S0[0] * rv[0], e11 = S1[0] * av[0], e21 = S1[0] * rv[0];
#pragma unroll
                        for (int j = 1; j < 4; ++j) { e10 += S0[j] * av[j]; e20 += S0[j] * rv[j]; e11 += S1[j] * av[j]; e21 += S1[j] * rv[j]; }
                        const float d10 = red8(e10.x + e10.y), d11 = red8(e11.x + e11.y);
                        yv[2 * s4] = (e20.x + e20.y) + (jg == 0 ? d10 * sc.x + vv.x * sc.y : 0.f); yv[2 * s4 + 1] = (e21.x + e21.y) + (jg == 0 ? d11 * sc.x + vv.y * sc.y : 0.f);
                        const f32x2 d10v = (f32x2){d10, d10}, d11v = (f32x2){d11, d11}, v0v = (f32x2){vv.x, vv.x}, v1v = (f32x2){vv.y, vv.y};
#pragma unroll
                        for (int j = 0; j < 4; ++j) { S0[j] = S0[j] * wv[j] + (d10v * bv[j] + v0v * kv[j]); S1[j] = S1[j] * wv[j] + (d11v * bv[j] + v1v * kv[j]); }
                    }
                    {
                        const bool t2 = (jg & 4) != 0, t1 = (jg & 2) != 0, t0 = (jg & 1) != 0;
#pragma unroll
                        for (int q = 0; q < 4; ++q) { const float keep = t2 ? yv[q + 4] : yv[q], send = t2 ? yv[q] : yv[q + 4]; yv[q] = keep + dpp_mov<0x141>(send); }
#pragma unroll
                        for (int q = 0; q < 2; ++q) { const float keep = t1 ? yv[q + 2] : yv[q], send = t1 ? yv[q] : yv[q + 2]; yv[q] = keep + dpp_mov<0x4E>(send); }
                        { const float keep = t0 ? yv[1] : yv[0], send = t0 ? yv[0] : yv[1]; yv[0] = keep + dpp_mov<0xB1>(send); }
                        Yy[(4 * q4 + (jg >> 1)) * 64 + i0 + (jg & 1)] = yv[0];
                    }

#if PROBE_SCAN2
                    {
#pragma unroll
                    for (int s4 = 0; s4 < 4; ++s4) {
                        const int tt = 4 * q4 + s4;
                        const f32x4 a_lo = *(const LAS f32x4*)&A_[tt * 64 + 8 * jg], a_hi = *(const LAS f32x4*)&A_[tt * 64 + 8 * jg + 4];
                        const f32x4 r_lo = *(const LAS f32x4*)&WR[tt * 64 + 8 * jg], r_hi = *(const LAS f32x4*)&WR[tt * 64 + 8 * jg + 4];
                        const f32x4 w_lo = *(const LAS f32x4*)&Wd[tt * 64 + 8 * jg], w_hi = *(const LAS f32x4*)&Wd[tt * 64 + 8 * jg + 4];
                        const f32x4 b_lo = *(const LAS f32x4*)&Bv[tt * 64 + 8 * jg], b_hi = *(const LAS f32x4*)&Bv[tt * 64 + 8 * jg + 4];
                        const f32x4 k_lo = *(const LAS f32x4*)&Kk[tt * 64 + 8 * jg], k_hi = *(const LAS f32x4*)&Kk[tt * 64 + 8 * jg + 4];
                        const f32x2 vv = *(const LAS f32x2*)&Vv[tt * 64 + i0];
                        const f32x2 av[4] = {{a_lo.x, a_lo.y}, {a_lo.z, a_lo.w}, {a_hi.x, a_hi.y}, {a_hi.z, a_hi.w}};
                        const f32x2 rv[4] = {{r_lo.x, r_lo.y}, {r_lo.z, r_lo.w}, {r_hi.x, r_hi.y}, {r_hi.z, r_hi.w}};
                        const f32x2 wv[4] = {{w_lo.x, w_lo.y}, {w_lo.z, w_lo.w}, {w_hi.x, w_hi.y}, {w_hi.z, w_hi.w}};
                        const f32x2 bv[4] = {{b_lo.x, b_lo.y}, {b_lo.z, b_lo.w}, {b_hi.x, b_hi.y}, {b_hi.z, b_hi.w}};
                        const f32x2 kv[4] = {{k_lo.x, k_lo.y}, {k_lo.z, k_lo.w}, {k_hi.x, k_hi.y}, {k_hi.z, k_hi.w}};
                        f32x2 e10 = T0[0] * av[0], e20 = T0[0] * rv[0], e11 = T1[0] * av[0], e21 = T1[0] * rv[0];
#pragma unroll
                        for (int j = 1; j < 4; ++j) { e10 += T0[j] * av[j]; e20 += T0[j] * rv[j]; e11 += T1[j] * av[j]; e21 += T1[j] * rv[j]; }
                        const float d10 = red8(e10.x + e10.y), d20 = red8(e20.x + e20.y), d11 = red8(e11.x + e11.y), d21 = red8(e21.x + e21.y);
                        const f32x2 d10v = (f32x2){d10 + d20, d10}, d11v = (f32x2){d11 + d21, d11}, v0v = (f32x2){vv.x, vv.x}, v1v = (f32x2){vv.y, vv.y};
#pragma unroll
                        for (int j = 0; j < 4; ++j) { T0[j] = T0[j] * wv[j] + (d10v * bv[j] + v0v * kv[j]); T1[j] = T1[j] * wv[j] + (d11v * bv[j] + v1v * kv[j]); }
                    }
                    }
#endif
                }
                if (q4 & 1) LDS_BAR();
            }
        }
            }
    }
    if (helper) {
        const int bufl = (RW_NCH - 1) & 1;
        LAS float* Yy = RW_ARR(bufl, 7); LAS float* Gg = RW_ARR(bufl, 6); LAS float* Vv = RW_ARR(bufl, 5); LAS float* SC = RW_SC(bufl);
        const f32x4 y = *(const LAS f32x4*)&Yy[tt_h * 64 + cg4], gg = *(const LAS f32x4*)&Gg[tt_h * 64 + cg4], vv = *(const LAS f32x4*)&Vv[tt_h * 64 + cg4];
        const float bonus = BON[((RW_NCH - 1) % 3) * 16 + tt_h];
        const float mean = red16((y.x + y.y) + (y.z + y.w)) * (1.f / 64.f);
        const f32x4 d = y - mean;
        const float var = red16((d.x * d.x + d.y * d.y) + (d.z * d.z + d.w * d.w)) * (1.f / 64.f);
        const float rs = 1.f / sqrtf(var + 64e-5f);
        const f32x4 o = (d * rs * p_gg + p_gb + vv * bonus) * gg;
        u32x2 w; w.x = pk2(o.x, o.y); w.y = pk2(o.z, o.w);
        *(u32x2*)(X.P + ((size_t)b * SEQ + (RW_NCH - 1) * RW_TS + tt_h) * LDP + COL_YA + h * 64 + cg4) = w;
    }
    __syncthreads();
#undef RW_ARR
#undef RW_SC
#undef RW_LOAD
}

__device__ __forceinline__ void hgrn_task(const Ctx& X, LAS unsigned char* lds, int layer, int b, int h, int vh) {
    LAS float* F = (LAS float*)(lds); LAS float* Q = (LAS float*)(lds + 16384); LAS float* Vv = (LAS float*)(lds + 32768); LAS float* O = (LAS float*)(lds + 40960);
    LAS float* LB = (LAS float*)(lds + 49152);
    const int tid = X.tid;
    const float* lbl = X.in[14];
    const int rp = tid >> 4, dg = tid & 15, v0 = 2 * rp;
    if (tid < 128) LB[tid] = (layer > 0) ? 1.f / (1.f + __expf(lbl[h * 128 + tid] - lbl[512 + h * 128 + tid])) : 0.f;
    f32x2 S0[4], S1[4];
#pragma unroll
    for (int j = 0; j < 4; ++j) { S0[j] = (f32x2){0.f, 0.f}; S1[j] = (f32x2){0.f, 0.f}; }
#define HG_LOAD(chk) do { _Pragma("unroll") for (int it = 0; it < 3; ++it) { const int idx = tid + 512 * it; raw[it] = (u32x4){0u, 0u, 0u, 0u}; \
        if (idx < 32 * 40) { const int tt = idx / 40, vv = idx - tt * 40; \
            const int col = vv < 16 ? 512 + h * 128 + 8 * vv : (vv < 32 ? h * 128 + 8 * (vv - 16) : 1024 + h * 128 + vh * 64 + 8 * (vv - 32)); \
            raw[it] = *(const u32x4*)(X.P + ((size_t)b * SEQ + (chk) * 32 + tt) * LDP + COL_PB + col); } } } while (0)
    u32x4 raw[3];
    HG_LOAD(0);
    __syncthreads();
#pragma unroll 1
    for (int ch = 0; ch < SEQ / 32; ++ch) {
        const int t0 = ch * 32;
#pragma unroll
        for (int it = 0; it < 3; ++it) {
            const int idx = tid + 512 * it;
            if (idx < 32 * 40) {
                const int tt = idx / 40, vv = idx - tt * 40;
                float x[8];
                x[0] = bflo(raw[it].x); x[1] = bfhi(raw[it].x); x[2] = bflo(raw[it].y); x[3] = bfhi(raw[it].y);
                x[4] = bflo(raw[it].z); x[5] = bfhi(raw[it].z); x[6] = bflo(raw[it].w); x[7] = bfhi(raw[it].w);
                LAS float* dst;
                if (vv < 16) {
                    dst = F + tt * 128 + 8 * vv;
#pragma unroll
                    for (int e = 0; e < 8; ++e) { const float lb = LB[8 * vv + e]; x[e] = lb + (1.f - lb) * sigmoidf_(x[e]); }
                } else if (vv < 32) dst = Q + tt * 128 + 8 * (vv - 16);
                else dst = Vv + tt * 64 + 8 * (vv - 32);
                *(LAS f32x4*)dst = (f32x4){x[0], x[1], x[2], x[3]}; *(LAS f32x4*)(dst + 4) = (f32x4){x[4], x[5], x[6], x[7]};
            }
        }
        if (ch + 1 < SEQ / 32) HG_LOAD(ch + 1);
        LDS_BAR();
#pragma unroll 1
        for (int g8 = 0; g8 < 4; ++g8) {
            float val[16];
#pragma unroll
            for (int s8 = 0; s8 < 8; ++s8) {
                const int tt = 8 * g8 + s8;
                const f32x4 f_lo = *(const LAS f32x4*)&F[tt * 128 + 8 * dg], f_hi = *(const LAS f32x4*)&F[tt * 128 + 8 * dg + 4];
                const f32x4 q_lo = *(const LAS f32x4*)&Q[tt * 128 + 8 * dg], q_hi = *(const LAS f32x4*)&Q[tt * 128 + 8 * dg + 4];
                const f32x2 vv = *(const LAS f32x2*)&Vv[tt * 64 + v0];
                const f32x2 f2[4] = {{f_lo.x, f_lo.y}, {f_lo.z, f_lo.w}, {f_hi.x, f_hi.y}, {f_hi.z, f_hi.w}};
                const f32x2 q2[4] = {{q_lo.x, q_lo.y}, {q_lo.z, q_lo.w}, {q_hi.x, q_hi.y}, {q_hi.z, q_hi.w}};
                const f32x2 v0v = (f32x2){vv.x, vv.x}, v1v = (f32x2){vv.y, vv.y};
                f32x2 a0 = (f32x2){0.f, 0.f}, a1 = (f32x2){0.f, 0.f};
#pragma unroll
                for (int j = 0; j < 4; ++j) {
                    S0[j] = v0v + f2[j] * (S0[j] - v0v); S1[j] = v1v + f2[j] * (S1[j] - v1v);
                    a0 += q2[j] * S0[j]; a1 += q2[j] * S1[j];
                }
                val[2 * s8] = a0.x + a0.y; val[2 * s8 + 1] = a1.x + a1.y;
            }
            const bool b3 = (dg & 8) != 0, b2 = (dg & 4) != 0, b1 = (dg & 2) != 0, b0 = (dg & 1) != 0;
#pragma unroll
            for (int i = 0; i < 8; ++i) { const float keep = b3 ? val[i + 8] : val[i], send = b3 ? val[i] : val[i + 8]; val[i] = keep + dpp_mov<0x140>(send); }
#pragma unroll
            for (int i = 0; i < 4; ++i) { const float keep = b2 ? val[i + 4] : val[i], send = b2 ? val[i] : val[i + 4]; val[i] = keep + dpp_mov<0x141>(send); }
#pragma unroll
            for (int i = 0; i < 2; ++i) { const float keep = b1 ? val[i + 2] : val[i], send = b1 ? val[i] : val[i + 2]; val[i] = keep + dpp_mov<0x4E>(send); }
            { const float keep = b0 ? val[1] : val[0], send = b0 ? val[0] : val[1]; val[0] = keep + dpp_mov<0xB1>(send); }
            O[(8 * g8 + (dg >> 1)) * 64 + v0 + (dg & 1)] = val[0];
        }
        LDS_BAR();
        if (tid < 256) {
            const int tt = tid >> 3, v8 = (tid & 7) * 8;
            const f32x4 a = *(const LAS f32x4*)&O[tt * 64 + v8], c4 = *(const LAS f32x4*)&O[tt * 64 + v8 + 4];
            u32x4 o; o.x = pk2(a.x, a.y); o.y = pk2(a.z, a.w); o.z = pk2(c4.x, c4.y); o.w = pk2(c4.z, c4.w);
            *(u32x4*)(X.P + ((size_t)b * SEQ + t0 + tt) * LDP + COL_YB + h * 128 + vh * 64 + v8) = o;
        }
    }
#undef HG_LOAD
    __syncthreads();
}

__device__ __forceinline__ unsigned f2ord(float f) { const unsigned u = __builtin_bit_cast(unsigned, f); return (u & 0x80000000u) ? ~u : (u | 0x80000000u); }

__device__ __forceinline__ void dsa_tile(const Ctx& X, LAS unsigned char* lds, int b, int q0) {
    LAS float* sc = (LAS float*)lds;
    LAS unsigned* MASK = (LAS unsigned*)(lds + MASK_OFF);
    const int lane = X.lane, w = X.wave, n = lane & 15, g = lane >> 4;
    const bf16_t* Pb = X.P + (size_t)b * SEQ * LDP;
#pragma unroll 1
    for (int sub = 0; sub < 4; ++sub) {
        const int qs = q0 + 16 * sub;
        {
            bf16x8 bq[4][2]; float wi[4];
            const bf16_t* qrow = Pb + (size_t)(qs + n) * LDP;
#pragma unroll
            for (int hh = 0; hh < 4; ++hh) {
#pragma unroll
                for (int ks = 0; ks < 2; ++ks) bq[hh][ks] = *(const bf16x8*)(qrow + C_QI + hh * 64 + ks * 32 + 8 * g);
                wi[hh] = bf2f(qrow[C_WI + hh]);
            }
            const int nkt = (qs + 16) >> 4;
            bf16x8 a0n = (bf16x8){0, 0, 0, 0, 0, 0, 0, 0}, a1n = a0n;
            if (w < nkt) { const bf16_t* krow = Pb + (size_t)(w * 16 + n) * LDP + C_KI; a0n = *(const bf16x8*)(krow + 8 * g); a1n = *(const bf16x8*)(krow + 32 + 8 * g); }
#pragma unroll 1
            for (int kt = w; kt < nkt; kt += 8) {
                const bf16x8 a0 = a0n, a1 = a1n;
                if (kt + 8 < nkt) { const bf16_t* krow = Pb + (size_t)((kt + 8) * 16 + n) * LDP + C_KI; a0n = *(const bf16x8*)(krow + 8 * g); a1n = *(const bf16x8*)(krow + 32 + 8 * g); }
                f32x4 s = (f32x4){0.f, 0.f, 0.f, 0.f};
#pragma unroll
                for (int hh = 0; hh < 4; ++hh) {
                    f32x4 d = __builtin_amdgcn_mfma_f32_16x16x32_bf16(a0, bq[hh][0], (f32x4){0.f, 0.f, 0.f, 0.f}, 0, 0, 0);
                    d = __builtin_amdgcn_mfma_f32_16x16x32_bf16(a1, bq[hh][1], d, 0, 0, 0);
#pragma unroll
                    for (int r = 0; r < 4; ++r) s[r] += wi[hh] * fmaxf(d[r], 0.f);
                }
                const int t = qs + n;
#pragma unroll
                for (int r = 0; r < 4; ++r) if (kt * 16 + 4 * g + r > t) s[r] = -INFINITY;
                *(LAS f32x4*)&sc[n * SCS + kt * 16 + 4 * g] = s;
            }
        }
        __syncthreads();
#pragma unroll 1
        for (int e = 0; e < 2; ++e) {
            const int qn = 2 * w + e, t = qs + qn;
            LAS unsigned* mrow = MASK + (sub * 16 + qn) * 64;
            if (t < 256) {
#pragma unroll
                for (int j = 0; j < 32; ++j) {
                    const unsigned long long sm = __ballot(j * 64 + lane <= t);
                    if (lane == 0) { mrow[2 * j] = (unsigned)sm; mrow[2 * j + 1] = (unsigned)(sm >> 32); }
                }
            } else {
                const int jn = (t >> 6) + 1;
                unsigned u[32];
#pragma unroll
                for (int j = 0; j < 32; ++j) {
                    u[j] = 0u;
                    if (j < jn) { const int key = j * 64 + lane; const float s = (key <= t) ? sc[qn * SCS + key] : -INFINITY; u[j] = f2ord(s); }
                }
                unsigned prefix = 0u;
#define DSA_BITSEARCH(JN) do { _Pragma("unroll 1") for (int bit = 31; bit >= 0; --bit) { const unsigned cand = prefix | (1u << bit); int c0 = 0, c1 = 0; \
                    _Pragma("unroll") for (int j = 0; j < (JN); j += 2) { c0 += (u[j] >= cand) ? 1 : 0; c1 += (u[j + 1] >= cand) ? 1 : 0; } \
                    const int cnt = (int)wave_sum_fast((float)(c0 + c1)); if (cnt >= 256) prefix = cand; } } while (0)
                if (jn <= 8) DSA_BITSEARCH(8); else if (jn <= 16) DSA_BITSEARCH(16); else if (jn <= 24) DSA_BITSEARCH(24); else DSA_BITSEARCH(32);
#undef DSA_BITSEARCH
                int cg_ = 0;
#pragma unroll
                for (int j = 0; j < 32; ++j) if (j < jn) cg_ += __popcll(__ballot(u[j] > prefix));
                const int need = 256 - cg_;
                int cum = 0;
#pragma unroll
                for (int j = 0; j < 32; ++j) {
                    unsigned long long sm = 0ull;
                    if (j < jn) {
                        const bool eq = (u[j] == prefix);
                        const unsigned long long em = __ballot(eq);
                        const int rank = cum + (int)__builtin_amdgcn_mbcnt_hi((unsigned)(em >> 32), __builtin_amdgcn_mbcnt_lo((unsigned)em, 0u));
                        const bool sel = (u[j] > prefix) || (eq && rank < need);
                        sm = __ballot(sel);
                        cum += __popcll(em);
                    }
                    if (lane == 0) { mrow[2 * j] = (unsigned)sm; mrow[2 * j + 1] = (unsigned)(sm >> 32); }
                }
            }
        }
        __syncthreads();
    }
    const int qq = q0 + 8 * w + (n & 7);
    const LAS unsigned* mq = MASK + (8 * w + (n & 7)) * 64;
    const int nsteps = (q0 + 8 * w + 8 + 31) >> 5;
    const int nblk = (q0 + 64 + 127) >> 7;
    LAS bf16_t* KT = (LAS bf16_t*)lds;
    LAS bf16_t* VTT = (LAS bf16_t*)(lds + 36864);
    const int tid = X.tid;
#pragma unroll 1
    for (int c = 0; c < 2; ++c) {
        bf16x8 bq[2][2];
#pragma unroll
        for (int j = 0; j < 2; ++j)
#pragma unroll
            for (int ks = 0; ks < 2; ++ks) bq[j][ks] = *(const bf16x8*)(Pb + (size_t)qq * LDP + C_Q + (c * 4 + 2 * j + (n >> 3)) * 64 + ks * 32 + 8 * g);
        float lrun[2] = {0.f, 0.f};
        f32x4 oacc[4][2];
#pragma unroll
        for (int mt = 0; mt < 4; ++mt)
#pragma unroll
            for (int j = 0; j < 2; ++j) oacc[mt][j] = (f32x4){0.f, 0.f, 0.f, 0.f};
        const bf16_t* vtb = X.VT + ((size_t)(b * 2 + c) * 64) * SEQ;
        u32x4 gk[2], gv[2];
#define DSA_GLOAD(kblk) do { _Pragma("unroll") for (int it = 0; it < 2; ++it) { const int idx = tid + 512 * it; \
            gk[it] = *(const u32x4*)(Pb + (size_t)((kblk) * 128 + (idx >> 3)) * LDP + C_K + c * 64 + (idx & 7) * 8); \
            gv[it] = *(const u32x4*)(vtb + (size_t)(idx >> 4) * SEQ + (kblk) * 128 + (idx & 15) * 8); } } while (0)
#define DSA_LSTORE(bufi) do { _Pragma("unroll") for (int it = 0; it < 2; ++it) { const int idx = tid + 512 * it; \
            *(LAS u32x4*)(KT + (bufi) * 9216 + (idx >> 3) * 72 + (idx & 7) * 8) = gk[it]; \
            *(LAS u32x4*)(VTT + (bufi) * 8704 + (idx >> 4) * 136 + (idx & 15) * 8) = gv[it]; } } while (0)
        DSA_GLOAD(0);
        LDS_BAR();
        DSA_LSTORE(0);
        LDS_BAR();
#pragma unroll 1
        for (int kb = 0; kb < nblk; ++kb) {
            const int buf = kb & 1;
            if (kb + 1 < nblk) DSA_GLOAD(kb + 1);
            const LAS bf16_t* Kb = KT + buf * 9216; const LAS bf16_t* Vb = VTT + buf * 8704;
#pragma unroll 1
            for (int sl = 0; sl < 4; ++sl) {
                const int sg = kb * 4 + sl;
                if (sg < nsteps) {
                    f32x4 st[2][2];
#pragma unroll
                    for (int tl = 0; tl < 2; ++tl) {
                        const LAS bf16_t* kr = Kb + (32 * sl + 16 * tl + n) * 72;
                        const bf16x8 a0 = *(const LAS bf16x8*)(kr + 8 * g), a1 = *(const LAS bf16x8*)(kr + 32 + 8 * g);
#pragma unroll
                        for (int j = 0; j < 2; ++j) {
                            f32x4 d = __builtin_amdgcn_mfma_f32_16x16x32_bf16(a0, bq[j][0], (f32x4){0.f, 0.f, 0.f, 0.f}, 0, 0, 0);
                            st[tl][j] = __builtin_amdgcn_mfma_f32_16x16x32_bf16(a1, bq[j][1], d, 0, 0, 0);
                        }
                    }
                    bf16x8 av[4];
#pragma unroll
                    for (int mt = 0; mt < 4; ++mt) {
                        const LAS bf16_t* vp = Vb + (mt * 16 + n) * 136 + 32 * sl + 4 * g;
                        const u32x2 lo = *(const LAS u32x2*)vp, hi = *(const LAS u32x2*)(vp + 16);
                        u32x4 t4; t4.x = lo.x; t4.y = lo.y; t4.z = hi.x; t4.w = hi.y;
                        av[mt] = __builtin_bit_cast(bf16x8, t4);
                    }
                    const unsigned mw = mq[sg];
#pragma unroll
                    for (int j = 0; j < 2; ++j) {
                        float p[8], ps = 0.f;
#pragma unroll
                        for (int tl = 0; tl < 2; ++tl)
#pragma unroll
                            for (int r = 0; r < 4; ++r) { const int bit = 16 * tl + 4 * g + r; const float e = __expf(fminf(st[tl][j][r] * 0.125f, 60.f)); p[4 * tl + r] = ((mw >> bit) & 1u) ? e : 0.f; ps += p[4 * tl + r]; }
                        lrun[j] += ps;
                        u32x4 pw; pw.x = pg8::cvt_pk_bf16(p[0], p[1]); pw.y = pg8::cvt_pk_bf16(p[2], p[3]); pw.z = pg8::cvt_pk_bf16(p[4], p[5]); pw.w = pg8::cvt_pk_bf16(p[6], p[7]);
                        const bf16x8 pb = __builtin_bit_cast(bf16x8, pw);
#pragma unroll
                        for (int mt = 0; mt < 4; ++mt) oacc[mt][j] = __builtin_amdgcn_mfma_f32_16x16x32_bf16(av[mt], pb, oacc[mt][j], 0, 0, 0);
                    }
                }
            }
            if (kb + 1 < nblk) DSA_LSTORE(buf ^ 1);
            LDS_BAR();
        }
#pragma unroll
        for (int j = 0; j < 2; ++j) {
            float lt = lrun[j]; lt += __shfl_xor(lt, 16); lt += __shfl_xor(lt, 32);
            const float il = 1.f / lt;
            bf16_t* op = X.P + ((size_t)b * SEQ + qq) * LDP + COL_YC + (c * 4 + 2 * j + (n >> 3)) * 64 + 4 * g;
#pragma unroll
            for (int mt = 0; mt < 4; ++mt) {
                const f32x4 o = oacc[mt][j] * il;
                u32x2 wv; wv.x = pg8::cvt_pk_bf16(o[0], o[1]); wv.y = pg8::cvt_pk_bf16(o[2], o[3]);
                *(u32x2*)(op + mt * 16) = wv;
            }
        }
    }
#undef DSA_GLOAD
#undef DSA_LSTORE
    __syncthreads();
}

__device__ __forceinline__ void phase_mixers(const Ctx& X0, LAS unsigned char* lds, int layer) {
#pragma unroll 1
    for (int task = X0.bid; task < 128; task += X0.G) {
        Ctx X = X0;
        { int t_ = threadIdx.x; asm volatile("" : "+v"(t_)); X.tid = t_; X.lane = t_ & 63; }
        if (task < 64) { if (TKMASK & 1) rwkv_task(X, lds, layer, task >> 3, task & 7); }
        else { const int k = task - 64; if (TKMASK & 2) hgrn_task(X, lds, layer, k >> 3, (k >> 1) & 3, k & 1); }
    }
    volatile LAS unsigned* tw = (volatile LAS unsigned*)(lds + LDS_BYTES - 128);
    unsigned* ctr = (unsigned*)(X0.ws + WS_BAR + 14336) + 16 * layer;
#pragma unroll 1
    for (;;) {
        Ctx X = X0;
        { int t_ = threadIdx.x; asm volatile("" : "+v"(t_)); X.tid = t_; X.lane = t_ & 63; }
        __syncthreads();
        if (threadIdx.x == 0) tw[0] = __hip_atomic_fetch_add(ctr, 1u, __ATOMIC_RELAXED, __HIP_MEMORY_SCOPE_AGENT);
        __syncthreads();
        const int t = (int)tw[0];
        if (t >= 256) break;
        if (TKMASK & 4) dsa_tile(X, lds, t & 7, 64 * (31 - (t >> 3)));
    }
}

__device__ __forceinline__ void phase_hgrn_post(const Ctx& X, int layer) {
    const int gw = X.bid * 8 + X.wave, NGW = X.G * 8;
    const float* gn = X.in[15] + layer * 512;
#pragma unroll 1
    for (int it0 = gw; it0 < T_TOK * 4; it0 += 4 * NGW) {
        unsigned ow[4], gwd[4]; unsigned* op[4];
#pragma unroll
        for (int r = 0; r < 4; ++r) {
            const int it = it0 + r * NGW < T_TOK * 4 ? it0 + r * NGW : it0;
            const int t = it >> 2, h = it & 3;
            bf16_t* rowp = X.P + (size_t)t * LDP;
            op[r] = (unsigned*)(rowp + COL_YB + h * 128) + X.lane;
            ow[r] = *op[r]; gwd[r] = *((const unsigned*)(rowp + COL_PB + 1536 + h * 128) + X.lane);
        }
#pragma unroll
        for (int r = 0; r < 4; ++r) {
            const int it = it0 + r * NGW;
            const int h = it & 3;
            const float o0 = bflo(ow[r]), o1 = bfhi(ow[r]), g0 = bflo(gwd[r]), g1 = bfhi(gwd[r]);
            const float rs = 1.f / sqrtf(wave_sum(o0 * o0 + o1 * o1) * (1.f / 128.f) + 1e-6f);
            const float y0 = o0 * rs * gn[h * 128 + 2 * X.lane] * (g0 * sigmoidf_(g0)), y1 = o1 * rs * gn[h * 128 + 2 * X.lane + 1] * (g1 * sigmoidf_(g1));
            if (it < T_TOK * 4) *op[r] = pk2(y0, y1);
        }
    }
}

__device__ __forceinline__ void phase_fixup(const Ctx& X, int layer) {
    const float* cw = X.in[20] + (size_t)layer * 3 * F2; const float* cb = X.in[21] + (size_t)layer * F2;
#pragma unroll 4
    for (int idx = X.bid * 512 + X.tid; idx < 256 * 2 * DFF; idx += X.G * 512) {
        const int j = idx % DFF, sr = idx / DFF, s = sr >> 1, r = sr & 1;
        const int colg = (j >> 7) * 256 + (j & 127), colv = colg + 128;
        const bool seq0 = (s & 31) == 0;
        const float* H = X.HALO;
        float res[2];
#pragma unroll
        for (int part = 0; part < 2; ++part) {
            const int cp = part ? colv : colg, co = part * DFF + j;
            const float u0 = H[(size_t)(s * 4 + r) * F2 + cp];
            float u1, u2;
            if (r == 0) { u1 = seq0 ? 0.f : H[(size_t)((s - 1) * 4 + 3) * F2 + cp]; u2 = seq0 ? 0.f : H[(size_t)((s - 1) * 4 + 2) * F2 + cp]; }
            else { u1 = H[(size_t)(s * 4 + 0) * F2 + cp]; u2 = seq0 ? 0.f : H[(size_t)((s - 1) * 4 + 3) * F2 + cp]; }
            res[part] = cb[co] + cw[co] * u2 + cw[F2 + co] * u1 + cw[2 * F2 + co] * u0;
        }
        const float a = res[0] * sigmoidf_(res[0]) * res[1];
        X.P[(size_t)(s * 64 + r) * LDP + COL_ACT + j] = (bf16_t)f2bf(a);
    }
}

#define XB_TMO      128
#define XB_XCNT(j)  (256  + 64 * (j))
#define XB_XSUB(j)  (1280 + 64 * (j))
#define XB_XGEN(j)  (2304 + 64 * (j))
#define XB_TOP      3328
#define XB_TOPGEN   3392
#define XCD_BAR_WORDS 3456
#define XB_SPIN_CAP (1u << 22)
__device__ __forceinline__ unsigned xb_ld(unsigned* p)              { return __hip_atomic_load(p, __ATOMIC_RELAXED, __HIP_MEMORY_SCOPE_AGENT); }
__device__ __forceinline__ unsigned xb_add(unsigned* p, unsigned v) { return __hip_atomic_fetch_add(p, v, __ATOMIC_RELAXED, __HIP_MEMORY_SCOPE_AGENT); }
__device__ __forceinline__ unsigned xb_xcc_id() { return (unsigned)__builtin_amdgcn_s_getreg((3 << 11) | 20) & 0xFu; }
#define XB_SPIN(cond, bar) do { unsigned _sp = 0; while (cond) { __builtin_amdgcn_s_sleep(1); \
    if ((++_sp & 255u) == 0u) { if (xb_ld(&(bar)[XB_TMO])) break; if (_sp > XB_SPIN_CAP) { atomicAdd(&(bar)[XB_TMO], 1u); break; } } } } while (0)
struct XcdBarrier { unsigned* bar; unsigned x; volatile LAS unsigned* st; };
__device__ __forceinline__ XcdBarrier xcd_barrier_post(unsigned* bar, volatile LAS unsigned* st) {
    XcdBarrier b; b.bar = bar; b.x = xb_xcc_id(); b.st = st;
    if (threadIdx.x == 0) (void)xb_add(&bar[XB_XCNT(b.x)], 1u);
    return b;
}
__device__ __forceinline__ void xcd_barrier_complete(unsigned* bar, unsigned x, unsigned& nloc, unsigned& nx) {
    const unsigned G = gridDim.x * gridDim.y * gridDim.z;
    unsigned sum, cnt, mine, sp = 0u;
    for (;;) {
        sum = 0u; cnt = 0u; mine = 0u;
#pragma unroll
        for (unsigned j = 0; j < 16; ++j) { const unsigned c = xb_ld(&bar[XB_XCNT(j)]); sum += c; cnt += (c > 0u) ? 1u : 0u; mine = (j == x) ? c : mine; }
        if (sum == G) break;
        __builtin_amdgcn_s_sleep(1);
        if ((++sp & 255u) == 0u) { if (xb_ld(&bar[XB_TMO])) break; if (sp > XB_SPIN_CAP) { atomicAdd(&bar[XB_TMO], 1u); break; } }
    }
    nloc = mine > 0u ? mine : 1u; nx = cnt > 0u ? cnt : 1u;
}
__device__ __forceinline__ void xcd_barrier(const XcdBarrier& b) {
    asm volatile("s_waitcnt vmcnt(0)" ::: "memory");
    __syncthreads();
    if (threadIdx.x == 0) {
        unsigned* bar = b.bar;
        __builtin_amdgcn_s_waitcnt(0);
        unsigned nloc = b.st[0], nx = b.st[1];
        if (nloc == 0u) { xcd_barrier_complete(bar, b.x, nloc, nx); b.st[0] = nloc; b.st[1] = nx; }
        const unsigned old = xb_add(&bar[XB_XSUB(b.x)], 1u);
        const unsigned gen = old / nloc;
        if (old + 1u == (gen + 1u) * nloc) {
            __builtin_amdgcn_fence(__ATOMIC_RELEASE, "agent");
            asm volatile("s_waitcnt vmcnt(0)" ::: "memory");
            const unsigned og = xb_add(&bar[XB_TOP], 1u);
            const unsigned tg = og / nx;
            if (og + 1u == (tg + 1u) * nx) xb_add(&bar[XB_TOPGEN], 1u);
            else XB_SPIN(xb_ld(&bar[XB_TOPGEN]) == tg, bar);
            __builtin_amdgcn_fence(__ATOMIC_ACQUIRE, "agent");
            xb_add(&bar[XB_XGEN(b.x)], 1u);
            asm volatile("s_waitcnt vmcnt(0)" ::: "memory");
        } else {
            XB_SPIN(xb_ld(&bar[XB_XGEN(b.x)]) == gen, bar);
            __builtin_amdgcn_fence(__ATOMIC_ACQUIRE, "agent");
            asm volatile("s_waitcnt vmcnt(0)" ::: "memory");
        }
    }
    __syncthreads();
}

__global__ void __launch_bounds__(512, 2) mk_fwd(Args args) {
    extern __shared__ __attribute__((aligned(16))) unsigned char lds_raw[];
    LAS unsigned char* lds = (LAS unsigned char*)lds_raw;
    Ctx X;
#pragma unroll
    for (int i = 0; i < 24; ++i) X.in[i] = args.in[i];
    X.out = args.out; X.ws = args.ws;
    X.P = (bf16_t*)(args.ws + WS_P); X.VT = (bf16_t*)(args.ws + WS_VT); X.HALO = (float*)(args.ws + WS_HALO); X.ROPE = (float*)(args.ws + WS_ROPE);
    X.Win = (bf16_t*)(args.ws + WS_WIN); X.Wg = (bf16_t*)(args.ws + WS_WG); X.Wbr = (bf16_t*)(args.ws + WS_WBR);
    X.Wo = (bf16_t*)(args.ws + WS_WO); X.Wup = (bf16_t*)(args.ws + WS_WUP); X.Wdn = (bf16_t*)(args.ws + WS_WDN);
    X.tid = threadIdx.x; X.lane = X.tid & 63; X.wave = __builtin_amdgcn_readfirstlane(X.tid >> 6); X.G = gridDim.x; X.bid = blockIdx.x;

#if PROBE_DOUBLE
    for (int ph2 = args.ph_lo * 2; ph2 < args.ph_hi * 2; ++ph2) {
        const int ph = ph2 >> 1;
        const int layer = ph / 11, sub = ph % 11;
        const bool skip_ = (ph2 & 1) && !(ph < 22 && ((REPMASK >> sub) & 1));
#else
    volatile LAS unsigned* bst = (volatile LAS unsigned*)(lds + LDS_BYTES - 64);
    if (threadIdx.x < 2) bst[threadIdx.x] = 0u;
    __syncthreads();
    XcdBarrier gbar = xcd_barrier_post((unsigned*)(args.ws + WS_BAR), bst);
    for (int ph = args.ph_lo; ph < args.ph_hi; ++ph) {
        const int layer = ph / 11, sub = ph % 11;
        const bool skip_ = false;
#endif
        { int t_ = threadIdx.x; asm volatile("" : "+v"(t_)); X.tid = t_; X.lane = t_ & 63; }

        if (skip_) {
        } else if (ph == 22 && (PHMASK & 1024)) {
            const int gw = X.bid * 8 + X.wave, NGW = X.G * 8;
            (void)gw; (void)NGW; rms_pass(X, X.out, X.in[23], nullptr, X.out);
        } else if (sub == 0 && (PHMASK & 1)) {
            phase_prep(X, lds, layer);
        } else if (sub == 1 && (PHMASK & 2)) {
            pg8::Gemm g{X.P, X.Win, LDP, DM, DM}; pg8::StaticOrder S; S.init(T_TOK, 5120, X.G, X.bid);
            pg8::EpiInProj E{X.P, X.VT, X.ROPE, (bf16_t*)(X.ws + WS_BND)};
            pg8::gemm_phase<pg8::EpiInProj, true>(lds, g, S, E, X.tid);
        } else if (sub == 2 && (PHMASK & 4)) {
            phase_rwkv_pre(X, lds, layer);
        } else if (sub == 3 && (PHMASK & 4)) {
            phase_mixers(X, lds, layer);
        } else if (sub == 4 && (PHMASK & 8)) {
            phase_hgrn_post(X, layer);
            { const int gw = X.bid * 8 + X.wave, NGW = X.G * 8; const float* hh = (layer == 0) ? X.in[0] : X.out; const float* g = X.in[1] + (size_t)layer * DM;
              (void)gw; (void)NGW; rms_pass(X, hh, g, X.P, nullptr); }
        } else if (sub == 5 && (PHMASK & 16)) {
#pragma unroll 1
            for (int br = 0; br < 3; ++br) {
                { pg8::Gemm g{X.P, X.Wg + (size_t)br * DM * DM, LDP, DM, DM}; pg8::StaticOrder S; S.init(T_TOK, DM, X.G, X.bid);
                  int t_ = X.tid; asm volatile("" : "+v"(t_));
                  pg8::EpiGate E{X.P}; pg8::gemm_phase<pg8::EpiGate, true>(lds, g, S, E, t_); }
                { const int ycol = br == 0 ? COL_YA : (br == 1 ? COL_YB : COL_YC);
                  pg8::Gemm g{X.P + ycol, X.Wbr + (size_t)br * DM * 512, LDP, 512, 512}; pg8::StaticOrder S; S.init(T_TOK, DM, X.G, X.bid);
                  int t_ = X.tid; asm volatile("" : "+v"(t_));
                  pg8::EpiMergeAcc E{X.P, br == 0 ? 1 : 0}; pg8::gemm_phase<pg8::EpiMergeAcc, true>(lds, g, S, E, t_); }
            }
        } else if (sub == 6 && (PHMASK & 32)) {
            pg8::Gemm g{X.P + COL_MRG, X.Wo, LDP, DM, DM}; pg8::StaticOrder S; S.init(T_TOK, DM, X.G, X.bid);
            pg8::EpiResid E{layer == 0 ? X.in[0] : X.out, X.out};
            pg8::gemm_phase<pg8::EpiResid, true>(lds, g, S, E, X.tid);
        } else if (sub == 7 && (PHMASK & 64)) {
            const int gw = X.bid * 8 + X.wave, NGW = X.G * 8;
            const float* g = X.in[18] + (size_t)layer * DM;
            (void)gw; (void)NGW; rms_pass(X, X.out, g, X.P, nullptr);
        } else if (sub == 8 && (PHMASK & 128)) {
            pg8::Gemm g{X.P, X.Wup, LDP, DM, DM}; pg8::StaticOrder S; S.init(T_TOK, F2, X.G, X.bid);
            pg8::EpiUp E{X.P, X.HALO, X.in[20] + (size_t)layer * 3 * F2, X.in[21] + (size_t)layer * F2, (LAS float*)(lds + 131072)};
            pg8::gemm_phase<pg8::EpiUp, true>(lds, g, S, E, X.tid);
        } else if (sub == 9 && (PHMASK & 256)) {
            phase_fixup(X, layer);
        } else if (sub == 10 && (PHMASK & 512)) {
            pg8::Gemm g{X.P + COL_ACT, X.Wdn, LDP, DFF, DFF}; pg8::StaticOrder S; S.init(T_TOK, DM, X.G, X.bid);
            pg8::EpiResid E{X.out, X.out};
            pg8::gemm_phase<pg8::EpiResid, true>(lds, g, S, E, X.tid);
        }
#if PROBE_DOUBLE
        if (ph2 + 1 < args.ph_hi * 2) cg::this_grid().sync();
#else
        if (ph + 1 < args.ph_hi) { if (args.ph_hi > 1000) cg::this_grid().sync(); else xcd_barrier(gbar); }
#endif
    }
}

extern "C" void kernel_launch(void* const* d_in, const int* in_sizes, int n_in, void* d_out, int out_size, void* d_ws, size_t ws_size, hipStream_t stream) {
    static int grid = 0;
    if (grid == 0) {
        int dev = 0, cus = 0, per_cu = 0;
        (void)hipGetDevice(&dev);
        (void)hipDeviceGetAttribute(&cus, hipDeviceAttributeMultiprocessorCount, dev);
        if (hipFuncSetAttribute((const void*)mk_fwd, hipFuncAttributeMaxDynamicSharedMemorySize, LDS_BYTES) != hipSuccess) fprintf(stderr, "kernel_launch: hipFuncSetAttribute failed\n");
        if (hipOccupancyMaxActiveBlocksPerMultiprocessor(&per_cu, (const void*)mk_fwd, 512, LDS_BYTES) != hipSuccess || per_cu < 1) { fprintf(stderr, "kernel_launch: occupancy query gave %d\n", per_cu); per_cu = 1; }
        (void)hipGetLastError();
        grid = cus * 1;
        if (grid <= 0) grid = 256;
        if (ws_size < (size_t)268435456) fprintf(stderr, "kernel_launch: workspace too small (%zu)\n", ws_size);
    }
    Args a{};
    for (int i = 0; i < 24; ++i) a.in[i] = (const float*)d_in[i];
    a.out = (float*)d_out; a.ws = (unsigned char*)d_ws;
#if MK_SINGLE
    (void)hipMemsetAsync((char*)d_ws + WS_BAR, 0, 16384, stream);
    a.ph_lo = 0; a.ph_hi = 23;
    void* kargs[] = {&a};
    hipError_t e = hipLaunchCooperativeKernel((const void*)mk_fwd, dim3(grid), dim3(512), kargs, LDS_BYTES, stream);
    if (e != hipSuccess) fprintf(stderr, "cooperative launch failed: %s (grid %d)\n", hipGetErrorString(e), grid);
#else
    for (int ph = 0; ph < 23; ++ph) {
        a.ph_lo = ph; a.ph_hi = ph + 1;
        hipLaunchKernelGGL(mk_fwd, dim3(grid), dim3(512), LDS_BYTES, stream, a);
    }
#endif
}
```

```cpp
#include <hip/hip_runtime.h>
#include <hip/hip_cooperative_groups.h>
#include <cstdio>
#include <cstdint>
namespace cg = cooperative_groups;

#ifndef PHMASK
#define PHMASK 2047
#endif
#ifndef REPMASK
#define REPMASK 0
#endif
#ifndef PROBE_DOUBLE
#define PROBE_DOUBLE 0
#endif
#ifndef PROBE_SCAN2
#define PROBE_SCAN2 0
#endif
#ifndef TKMASK
#define TKMASK 7
#endif
#ifndef MK_SINGLE
#define MK_SINGLE 1
#endif

#define LAS __attribute__((address_space(3)))
typedef unsigned short bf16_t;
typedef short bf16x8 __attribute__((ext_vector_type(8)));
typedef float f32x4 __attribute__((ext_vector_type(4)));
typedef float f32x2 __attribute__((ext_vector_type(2)));
typedef unsigned u32x4 __attribute__((ext_vector_type(4)));
typedef unsigned u32x2 __attribute__((ext_vector_type(2)));

constexpr int T_TOK = 16384, SEQ = 2048, DM = 1024;
constexpr int LDP = 6208;
constexpr int COL_PA = 1024, COL_PB = 2816, COL_PC = 4864;
constexpr int COL_YA = 1024, COL_MRG = 1536, COL_G = 2816, COL_YB = 3840, COL_YC = 4864, COL_ACT = 1024;
constexpr int C_Q = 4864, C_K = 5376, C_QI = 5632, C_KI = 5888, C_WI = 5952;
constexpr int IN_COLS = 8004, DFF = 2816, F2 = 5632;
constexpr size_t WS_WIN = 0, WS_WG = 10485760, WS_WBR = 16777216, WS_WO = 19922944, WS_WUP = 22020096, WS_WDN = 33554432;
constexpr size_t WS_P = 39321600, WS_HALO = 242745344, WS_VT = WS_HALO, WS_ROPE = 265814016, WS_BAR = 266338304, WS_BND = WS_HALO + 4194304, WS_SCAL = WS_HALO + 8388608, WS_XC = WS_BAR + 16384, WS_XB = WS_XC + 65536;
constexpr int LDS_BYTES = 153600;
constexpr int SCS = 2052;
constexpr int MASK_OFF = 16 * SCS * 4;

struct Args { const float* in[24]; float* out; unsigned char* ws; int ph_lo, ph_hi; };

__device__ __forceinline__ unsigned f2bf(float f) { unsigned u = __builtin_bit_cast(unsigned, f); return (u + 0x7fffu + ((u >> 16) & 1u)) >> 16; }
__device__ __forceinline__ unsigned pk2(float lo, float hi) { return f2bf(lo) | (f2bf(hi) << 16); }
__device__ __forceinline__ float bf2f(bf16_t b) { return __builtin_bit_cast(float, (unsigned)b << 16); }
__device__ __forceinline__ float bflo(unsigned w) { return __builtin_bit_cast(float, w << 16); }
__device__ __forceinline__ float bfhi(unsigned w) { return __builtin_bit_cast(float, w & 0xffff0000u); }
__device__ __forceinline__ float wave_sum(float v) {
#pragma unroll
    for (int o = 1; o < 64; o <<= 1) v += __shfl_xor(v, o);
    return v;
}
__device__ __forceinline__ int wave_sum_i(int v) {
#pragma unroll
    for (int o = 1; o < 64; o <<= 1) v += __shfl_xor(v, o);
    return v;
}
template <int CTRL> __device__ __forceinline__ float dpp_mov(float x) {
    return __builtin_bit_cast(float, __builtin_amdgcn_update_dpp(0, __builtin_bit_cast(int, x), CTRL, 0xF, 0xF, true));
}
__device__ __forceinline__ float red8(float x) { x += dpp_mov<0xB1>(x); x += dpp_mov<0x4E>(x); x += dpp_mov<0x141>(x); return x; }
__device__ __forceinline__ float red16(float x) { x = red8(x); x += dpp_mov<0x140>(x); return x; }
__device__ __forceinline__ float sigmoidf_(float x) { return 1.f / (1.f + __expf(-x)); }

namespace pg8 {
constexpr int BM = 256, BK = 64, HALF = 128, HTB = HALF * BK * 2, NXCD = 8, WGM = 8;
__device__ __forceinline__ int lds_byte(int r, int c) { const int st = (r >> 4) * 2 + (c >> 5), rr = r & 15, cc = c & 31, ob = rr * 64 + cc * 2; return st * 1024 + (ob ^ (((ob >> 9) & 1) << 5)); }
__device__ __forceinline__ void stage_rc(int b, int& R, int& C) { const int st = b / 1024, sb = b % 1024, swz = sb ^ (((sb >> 9) & 1) << 5); R = (st >> 1) * 16 + swz / 64; C = (st & 1) * 32 + (swz % 64) / 2; }
__device__ __forceinline__ int perm32(int rho) { const int n = rho >> 4, i = rho & 15; return 8 * (i >> 2) + 4 * n + (i & 3); }
struct Unit { int pm, pn; };
struct Gemm { const bf16_t* A; const bf16_t* Bt; int lda, ldb, K; };
struct StaticOrder {
    int nM, nN, nwg, G, c;
    __device__ void init(int M, int N, int G_, int c_) { nM = M / BM; nN = N / BM; nwg = nM * nN; G = G_; c = c_; }
    __device__ bool next(int i, Unit& u) const {
        const long L = (long)i * G + c; if (L >= nwg) return false;
        int wgid = (int)L; { const int q = nwg / NXCD, r = nwg % NXCD, xcd = wgid % NXCD, off = wgid / NXCD; wgid = (xcd < r ? xcd * (q + 1) : r * (q + 1) + (xcd - r) * q) + off; }
        const int nig = WGM * nN, gid = wgid / nig, fm = gid * WGM, gsz = (nM - fm) < WGM ? (nM - fm) : WGM;
        u.pm = fm + ((wgid % nig) % gsz); u.pn = (wgid % nig) / gsz; return true;
    }
};
__device__ __forceinline__ unsigned cvt_pk_bf16(float lo, float hi) { unsigned r; asm volatile("v_cvt_pk_bf16_f32 %0, %1, %2" : "=v"(r) : "v"(lo), "v"(hi)); return r; }

template <class Epi, bool ALIGN_EPI>
__device__ __forceinline__ void gemm_phase(LAS unsigned char* lds, const Gemm g, const StaticOrder& S, const Epi& E, const int tid) {
    const int wid = __builtin_amdgcn_readfirstlane(tid >> 6), lane = tid & 63, wr = wid >> 2, wc = wid & 3, fr = lane & 15, fq = lane >> 4;
    const int K = g.K, nt = K / BK;
    unsigned voffA[2], voffB[2];
#pragma unroll
    for (int i = 0; i < 2; ++i) { int R, C; stage_rc(tid * 16 + i * 8192, R, C); const int Rb = (R & ~31) + perm32(R & 31);
        voffA[i] = (unsigned)(R * g.lda + C) * 2u; voffB[i] = (unsigned)(Rb * g.ldb + C) * 2u; }
    const size_t kstep = (size_t)(BK * 2);
    const size_t hstepA = (size_t)HALF * g.lda * 2, hstepB = (size_t)HALF * g.ldb * 2;
    const size_t tstepA = 2 * hstepA, tstepB = 2 * hstepB;
    const unsigned ldsw = (unsigned)wid * 1024u;
    const int aoff = lds_byte(wr * 64 + fr, fq * 8), boff = lds_byte(wc * 32 + fr, fq * 8);
#define PG8_SA(b, h) (((b) * 2 + (h)) * HTB)
#define PG8_SB(b, h) ((4 + (b) * 2 + (h)) * HTB)
#define PG8_STAGE(bufoff, gbase, voff) do { _Pragma("unroll") for (int _i = 0; _i < 2; ++_i) \
        __builtin_amdgcn_global_load_lds((const unsigned*)((const char*)(gbase) + (voff)[_i]), (LAS unsigned*)(lds + (bufoff) + ldsw + _i * 8192), 16, 0, 0); } while (0)
#define PG8_LDA(dst, b, h) do { _Pragma("unroll") for (int m = 0; m < 4; ++m) _Pragma("unroll") for (int k = 0; k < 2; ++k) dst[m][k] = *(const LAS bf16x8*)(lds + PG8_SA(b, h) + aoff + m * 2048 + k * 1024); } while (0)
#define PG8_LDB(dst, b, h) do { _Pragma("unroll") for (int n = 0; n < 2; ++n) _Pragma("unroll") for (int k = 0; k < 2; ++k) dst[n][k] = *(const LAS bf16x8*)(lds + PG8_SB(b, h) + boff + n * 2048 + k * 1024); } while (0)
#define PG8_MMA(ai, bj, At, Bt) do { __builtin_amdgcn_s_setprio(1); _Pragma("unroll") for (int m = 0; m < 4; ++m) _Pragma("unroll") for (int n = 0; n < 2; ++n) _Pragma("unroll") for (int k = 0; k < 2; ++k) \
        acc[ai][bj][m][n] = __builtin_amdgcn_mfma_f32_16x16x32_bf16(Bt[n][k], At[m][k], acc[ai][bj][m][n], 0, 0, 0); __builtin_amdgcn_s_setprio(0); } while (0)
#define PG8_WAIT_V(n) asm volatile("s_waitcnt vmcnt(" #n ")" ::: "memory")
#define PG8_WAIT_L(n) asm volatile("s_waitcnt lgkmcnt(" #n ")" ::: "memory")
#define PG8_BAR __builtin_amdgcn_s_barrier()
#define PG8_SCHED __builtin_amdgcn_sched_barrier(0)
    Unit cur, nxt; int ui = 0;
    if (!S.next(0, cur)) return;
    f32x4 acc[2][2][4][2];
#pragma unroll
    for (int a = 0; a < 2; ++a)
#pragma unroll
        for (int b = 0; b < 2; ++b)
#pragma unroll
            for (int m = 0; m < 4; ++m)
#pragma unroll
                for (int n = 0; n < 2; ++n) acc[a][b][m][n] = (f32x4){0.f, 0.f, 0.f, 0.f};
    bf16x8 At[4][2], B0[2][2], B1[2][2];
    const char* cA = (const char*)g.A + (size_t)cur.pm * tstepA; const char* cB = (const char*)g.Bt + (size_t)cur.pn * tstepB;
    PG8_STAGE(PG8_SB(0, 0), cB, voffB); PG8_STAGE(PG8_SB(0, 1), cB + hstepB, voffB); PG8_STAGE(PG8_SA(0, 0), cA, voffA); PG8_STAGE(PG8_SA(0, 1), cA + hstepA, voffA);
    if (wr == 1) PG8_BAR;
    PG8_WAIT_V(2); PG8_BAR;
    PG8_STAGE(PG8_SB(1, 0), cB + kstep, voffB); PG8_STAGE(PG8_SA(1, 0), cA + kstep, voffA); PG8_STAGE(PG8_SB(1, 1), cB + hstepB + kstep, voffB);
    PG8_WAIT_V(6); PG8_BAR;
    for (;;) {
        const bool has_next = S.next(ui + 1, nxt);
        const char* nA = has_next ? (const char*)g.A + (size_t)nxt.pm * tstepA : cA; const char* nB = has_next ? (const char*)g.Bt + (size_t)nxt.pn * tstepB : cB;
        for (int t = 0; t < nt; t += 2) {
            const bool last = (t == nt - 2);
            const char* a1 = cA + (size_t)(t + 1) * kstep;
            const char* a2 = last ? nA : cA + (size_t)(t + 2) * kstep; const char* b2 = last ? nB : cB + (size_t)(t + 2) * kstep;
            const char* a3 = a2 + kstep; const char* b3 = b2 + kstep;
            PG8_LDB(B0, 0, 0); PG8_LDB(B1, 0, 1); PG8_SCHED; PG8_LDA(At, 0, 0); PG8_STAGE(PG8_SA(1, 1), a1 + hstepA, voffA);
            PG8_WAIT_V(8); PG8_WAIT_L(0); PG8_BAR; PG8_MMA(0, 0, At, B0); PG8_MMA(0, 1, At, B1); PG8_BAR; PG8_SCHED;
            PG8_LDA(At, 0, 1); PG8_STAGE(PG8_SB(0, 0), b2, voffB); PG8_STAGE(PG8_SB(0, 1), b2 + hstepB, voffB); PG8_STAGE(PG8_SA(0, 0), a2, voffA);
            PG8_WAIT_V(8); PG8_WAIT_L(0); PG8_BAR; PG8_MMA(1, 0, At, B0); PG8_MMA(1, 1, At, B1); PG8_BAR; PG8_SCHED;
            PG8_LDB(B0, 1, 0); PG8_LDB(B1, 1, 1); PG8_SCHED; PG8_LDA(At, 1, 0); PG8_STAGE(PG8_SA(0, 1), a2 + hstepA, voffA);
            PG8_WAIT_V(8); PG8_WAIT_L(0); PG8_BAR; PG8_MMA(0, 0, At, B0); PG8_MMA(0, 1, At, B1); PG8_BAR; PG8_SCHED;
            PG8_LDA(At, 1, 1); PG8_STAGE(PG8_SB(1, 0), b3, voffB); PG8_STAGE(PG8_SB(1, 1), b3 + hstepB, voffB); PG8_STAGE(PG8_SA(1, 0), a3, voffA);
            PG8_WAIT_V(8); PG8_WAIT_L(0); PG8_BAR; PG8_MMA(1, 0, At, B0); PG8_MMA(1, 1, At, B1); PG8_BAR; PG8_SCHED;
        }
        if constexpr (ALIGN_EPI) { if (wr == 0) PG8_BAR; }
        if constexpr (!Epi::AFTER_DRAIN) E(acc, cur, wr, wc, fr, fq);
        if (!has_next) break;
#pragma unroll
        for (int a = 0; a < 2; ++a)
#pragma unroll
            for (int b = 0; b < 2; ++b)
#pragma unroll
                for (int m = 0; m < 4; ++m)
#pragma unroll
                    for (int n = 0; n < 2; ++n) acc[a][b][m][n] = (f32x4){0.f, 0.f, 0.f, 0.f};
        cur = nxt; cA = nA; cB = nB; ++ui;
        if constexpr (ALIGN_EPI) { if (wr == 1) PG8_BAR; }
    }
    PG8_WAIT_V(0);
    if constexpr (!ALIGN_EPI) { if (wr == 0) PG8_BAR; }
    PG8_BAR;
    if constexpr (Epi::AFTER_DRAIN) E.fused(acc, cur, wr, wc, fr, fq, lds, wid, lane);
#undef PG8_SA
#undef PG8_SB
#undef PG8_STAGE
#undef PG8_LDA
#undef PG8_LDB
#undef PG8_MMA
#undef PG8_WAIT_V
#undef PG8_WAIT_L
#undef PG8_BAR
#undef PG8_SCHED
}

typedef f32x4 AccT[2][2][4][2];

struct EpiInProj {
    static constexpr bool AFTER_DRAIN = false;
    bf16_t* P; bf16_t* VT; const float* rope; bf16_t* BND;
    __device__ __forceinline__ void operator()(AccT& acc, const Unit& u, int wr, int wc, int fr, int fq) const {
        const int row0 = u.pm * BM + wr * 64 + fr, colb = u.pn * BM + wc * 32 + 8 * fq;
#pragma unroll
        for (int ai = 0; ai < 2; ++ai)
#pragma unroll
            for (int m = 0; m < 4; ++m) {
                const int row = row0 + ai * HALF + m * 16, t = row & (SEQ - 1);
                bf16_t* rowp = P + (size_t)row * LDP + COL_PA;
#pragma unroll
                for (int bj = 0; bj < 2; ++bj) {
                    const int c = colb + bj * HALF;
                    f32x4 v0 = acc[ai][bj][m][0], v1 = acc[ai][bj][m][1];
                    if (u.pn >= 15) {
                        const int cl = c - 3840;
                        if (cl < 640 || (cl >= 768 && cl < 1088)) {
                            const float* cs = rope + ((size_t)t * 32 + ((cl & 63) >> 1)) * 2;
                            const f32x4 r0 = *(const f32x4*)cs, r1 = *(const f32x4*)(cs + 4);
                            f32x4 o0, o1;
                            o0[0] = v0[0] * r0[0] - v0[1] * r0[1]; o0[1] = v0[1] * r0[0] + v0[0] * r0[1];
                            o0[2] = v0[2] * r0[2] - v0[3] * r0[3]; o0[3] = v0[3] * r0[2] + v0[2] * r0[3];
                            o1[0] = v1[0] * r1[0] - v1[1] * r1[1]; o1[1] = v1[1] * r1[0] + v1[0] * r1[1];
                            o1[2] = v1[2] * r1[2] - v1[3] * r1[3]; o1[3] = v1[3] * r1[2] + v1[2] * r1[3];
                            v0 = o0; v1 = o1;
                        }
                    }
                    u32x4 w; w.x = cvt_pk_bf16(v0[0], v0[1]); w.y = cvt_pk_bf16(v0[2], v0[3]); w.z = cvt_pk_bf16(v1[0], v1[1]); w.w = cvt_pk_bf16(v1[2], v1[3]);
                    *(u32x4*)(rowp + c) = w;
                    if (u.pn < 7 && fr == 15) *(u32x4*)(BND + (size_t)(row >> 4) * 1792 + c) = w;
                    if (u.pn == 17 && bj == 1) {
                        const int cv = c - 3840 - 640, b = row >> 11;
                        bf16_t* vt = VT + ((size_t)(b * 2 + (cv >> 6)) * 64 + (cv & 63)) * SEQ + t;
                        vt[0 * SEQ] = (bf16_t)(w.x & 0xffffu); vt[1 * SEQ] = (bf16_t)(w.x >> 16);
                        vt[2 * SEQ] = (bf16_t)(w.y & 0xffffu); vt[3 * SEQ] = (bf16_t)(w.y >> 16);
                        vt[4 * SEQ] = (bf16_t)(w.z & 0xffffu); vt[5 * SEQ] = (bf16_t)(w.z >> 16);
                        vt[6 * SEQ] = (bf16_t)(w.w & 0xffffu); vt[7 * SEQ] = (bf16_t)(w.w >> 16);
                    }
                }
            }
    }
};
struct EpiGate {
    static constexpr bool AFTER_DRAIN = false;
    bf16_t* P;
    __device__ __forceinline__ void operator()(AccT& acc, const Unit& u, int wr, int wc, int fr, int fq) const {
        const int row0 = u.pm * BM + wr * 64 + fr, colb = u.pn * BM + wc * 32 + 8 * fq;
#pragma unroll
        for (int ai = 0; ai < 2; ++ai)
#pragma unroll
            for (int m = 0; m < 4; ++m) {
                bf16_t* rowp = P + (size_t)(row0 + ai * HALF + m * 16) * LDP + COL_G + colb;
#pragma unroll
                for (int bj = 0; bj < 2; ++bj) {
                    const f32x4 v0 = acc[ai][bj][m][0], v1 = acc[ai][bj][m][1];
                    u32x4 w; w.x = cvt_pk_bf16(sigmoidf_(v0[0]), sigmoidf_(v0[1])); w.y = cvt_pk_bf16(sigmoidf_(v0[2]), sigmoidf_(v0[3]));
                    w.z = cvt_pk_bf16(sigmoidf_(v1[0]), sigmoidf_(v1[1])); w.w = cvt_pk_bf16(sigmoidf_(v1[2]), sigmoidf_(v1[3]));
                    *(u32x4*)(rowp + bj * HALF) = w;
                }
            }
    }
};
struct EpiMergeAcc {
    static constexpr bool AFTER_DRAIN = false;
    bf16_t* P; int first;
    __device__ __forceinline__ void operator()(AccT& acc, const Unit& u, int wr, int wc, int fr, int fq) const {
        const int row0 = u.pm * BM + wr * 64 + fr, colb = u.pn * BM + wc * 32 + 8 * fq;
#pragma unroll
        for (int ai = 0; ai < 2; ++ai)
#pragma unroll
            for (int m = 0; m < 4; ++m) {
                bf16_t* rowb = P + (size_t)(row0 + ai * HALF + m * 16) * LDP + colb;
#pragma unroll
                for (int bj = 0; bj < 2; ++bj) {
                    const f32x4 v0 = acc[ai][bj][m][0], v1 = acc[ai][bj][m][1];
                    const u32x4 gq = *(const u32x4*)(rowb + COL_G + bj * HALF);
                    u32x4 mq = (u32x4){0u, 0u, 0u, 0u};
                    if (!first) mq = *(const u32x4*)(rowb + COL_MRG + bj * HALF);
                    const unsigned ga = gq.x, gb = gq.y, gc = gq.z, gd = gq.w;
                    const unsigned ma = mq.x, mb = mq.y, mc = mq.z, md = mq.w;
                    u32x4 w;
                    w.x = cvt_pk_bf16(bflo(ma) + bflo(ga) * v0[0], bfhi(ma) + bfhi(ga) * v0[1]);
                    w.y = cvt_pk_bf16(bflo(mb) + bflo(gb) * v0[2], bfhi(mb) + bfhi(gb) * v0[3]);
                    w.z = cvt_pk_bf16(bflo(mc) + bflo(gc) * v1[0], bfhi(mc) + bfhi(gc) * v1[1]);
                    w.w = cvt_pk_bf16(bflo(md) + bflo(gd) * v1[2], bfhi(md) + bfhi(gd) * v1[3]);
                    *(u32x4*)(rowb + COL_MRG + bj * HALF) = w;
                }
            }
    }
};
struct EpiResid {
    static constexpr bool AFTER_DRAIN = false;
    const float* base; float* out;
    __device__ __forceinline__ void operator()(AccT& acc, const Unit& u, int wr, int wc, int fr, int fq) const {
        const int row0 = u.pm * BM + wr * 64 + fr, colb = u.pn * BM + wc * 32 + 8 * fq;
#pragma unroll
        for (int ai = 0; ai < 2; ++ai)
#pragma unroll
            for (int m = 0; m < 4; ++m) {
                const size_t off = (size_t)(row0 + ai * HALF + m * 16) * DM + colb;
#pragma unroll
                for (int bj = 0; bj < 2; ++bj) {
                    const f32x4 b0 = *(const f32x4*)(base + off + bj * HALF), b1 = *(const f32x4*)(base + off + bj * HALF + 4);
                    *(f32x4*)(out + off + bj * HALF) = b0 + acc[ai][bj][m][0];
                    *(f32x4*)(out + off + bj * HALF + 4) = b1 + acc[ai][bj][m][1];
                }
            }
    }
};
struct EpiResidNorm {
    static constexpr bool AFTER_DRAIN = true;
    const float* base; float* out; const float* g; bf16_t* obf; float* of32; unsigned* xbuf; unsigned* cnt;
    __device__ __forceinline__ void fused(AccT& acc, const Unit& u, int wr, int wc, int fr, int fq, LAS unsigned char* lds, int wid, int lane) const {
        LAS float* Pl = (LAS float*)lds;
        LAS float* S = (LAS float*)(lds + 8192);
        const int row0 = u.pm * BM + wr * 64 + fr, colb = u.pn * BM + wc * 32 + 8 * fq;
#pragma unroll
        for (int ai = 0; ai < 2; ++ai)
#pragma unroll
            for (int m = 0; m < 4; ++m) {
                const size_t off = (size_t)(row0 + ai * HALF + m * 16) * DM + colb;
                float sq = 0.f;
#pragma unroll
                for (int bj = 0; bj < 2; ++bj) {
                    const f32x4 b0 = *(const f32x4*)(base + off + bj * HALF), b1 = *(const f32x4*)(base + off + bj * HALF + 4);
                    const f32x4 h0 = acc[ai][bj][m][0] + b0, h1 = acc[ai][bj][m][1] + b1;
                    acc[ai][bj][m][0] = h0; acc[ai][bj][m][1] = h1;
                    sq += (h0.x * h0.x + h0.y * h0.y) + (h0.z * h0.z + h0.w * h0.w) + (h1.x * h1.x + h1.y * h1.y) + (h1.z * h1.z + h1.w * h1.w);
                }
                sq += __shfl_xor(sq, 16); sq += __shfl_xor(sq, 32);
                if (fq == 0) Pl[(ai * HALF + wr * 64 + m * 16 + fr) * 4 + wc] = sq;
                if (m & 1) asm volatile("" ::: "memory");
            }
        asm volatile("s_waitcnt lgkmcnt(0)" ::: "memory"); __builtin_amdgcn_s_barrier(); asm volatile("" ::: "memory");
        const int row = wid * 32 + (lane & 31);
        if (lane < 32) {
            const f32x4 p = *(const LAS f32x4*)&Pl[row * 4];
            __hip_atomic_store(xbuf + ((size_t)(u.pm * BM + row) * 4 + u.pn), __builtin_bit_cast(unsigned, (p.x + p.y) + (p.z + p.w)), __ATOMIC_RELAXED, __HIP_MEMORY_SCOPE_AGENT);
        }
        asm volatile("s_waitcnt vmcnt(0)" ::: "memory");
        if (lane == 0) __hip_atomic_fetch_add(cnt + 64 * u.pm, 1u, __ATOMIC_RELAXED, __HIP_MEMORY_SCOPE_AGENT);
        if (wid == 0) {
            unsigned sp = 0u;
            while ((unsigned)__builtin_amdgcn_readfirstlane(__hip_atomic_load(cnt + 64 * u.pm, __ATOMIC_RELAXED, __HIP_MEMORY_SCOPE_AGENT)) < 32u) { __builtin_amdgcn_s_sleep(2); if (++sp > (1u << 22)) break; }
            __builtin_amdgcn_fence(__ATOMIC_ACQUIRE, "agent");
        }
        asm volatile("s_waitcnt vmcnt(0) lgkmcnt(0)" ::: "memory"); __builtin_amdgcn_s_barrier(); asm volatile("" ::: "memory");
        if (lane < 32) {
            const unsigned* slot = xbuf + (size_t)(u.pm * BM + row) * 4; float tot = 0.f;
#pragma unroll
            for (int t = 0; t < 4; ++t) tot += __builtin_bit_cast(float, __hip_atomic_load(slot + t, __ATOMIC_RELAXED, __HIP_MEMORY_SCOPE_AGENT));
            S[row] = 1.0f / sqrtf(tot * (1.f / DM) + 1e-6f);
        }
        asm volatile("s_waitcnt lgkmcnt(0)" ::: "memory"); __builtin_amdgcn_s_barrier(); asm volatile("" ::: "memory");
        f32x4 gv[2][2];
#pragma unroll
        for (int bj = 0; bj < 2; ++bj)
#pragma unroll
            for (int n = 0; n < 2; ++n) gv[bj][n] = *(const f32x4*)(g + colb + bj * HALF + 4 * n);
#pragma unroll
        for (int ai = 0; ai < 2; ++ai)
#pragma unroll
            for (int m = 0; m < 4; ++m) {
                const int rl = ai * HALF + wr * 64 + m * 16 + fr, rowg = u.pm * BM + rl;
                const float rs = S[rl];
#pragma unroll
                for (int bj = 0; bj < 2; ++bj) {
                    const f32x4 h0 = acc[ai][bj][m][0], h1 = acc[ai][bj][m][1];
                    const size_t off = (size_t)rowg * DM + colb + bj * HALF;
                    if (out) { *(f32x4*)(out + off) = h0; *(f32x4*)(out + off + 4) = h1; }
                    const f32x4 o0 = h0 * rs * gv[bj][0], o1 = h1 * rs * gv[bj][1];
                    if (obf) { u32x4 w; w.x = cvt_pk_bf16(o0[0], o0[1]); w.y = cvt_pk_bf16(o0[2], o0[3]); w.z = cvt_pk_bf16(o1[0], o1[1]); w.w = cvt_pk_bf16(o1[2], o1[3]);
                        *(u32x4*)(obf + (size_t)rowg * LDP + colb + bj * HALF) = w; }
                    else { *(f32x4*)(of32 + off) = o0; *(f32x4*)(of32 + off + 4) = o1; }
                }
                asm volatile("" ::: "memory");
            }
    }
};
struct EpiUp {
    static constexpr bool AFTER_DRAIN = false;
    bf16_t* P; float* HALO; const float* cw; const float* cb; LAS float* CW;
    __device__ __forceinline__ void operator()(AccT& acc, const Unit& u, int wr, int wc, int fr_in, int fq_in) const {
        int fr = fr_in, fq = fq_in;
        asm volatile("" : "+v"(fr), "+v"(fq));
        const int row0 = u.pm * BM + wr * 64 + fr;
        const int jb = u.pn * 128 + wc * 32 + 8 * fq;
        {
            const int tl = (wr * 4 + wc) * 64 + fq * 16 + fr;
#pragma unroll
            for (int it = 0; it < 2; ++it) { const int k = tl + 512 * it, p = k >> 8, col = k & 255, co = (col >> 7) * DFF + u.pn * 128 + (col & 127);
                CW[k] = (p < 3) ? cw[p * F2 + co] : cb[co]; }
            asm volatile("s_waitcnt lgkmcnt(0)" ::: "memory"); __builtin_amdgcn_s_barrier(); asm volatile("" ::: "memory");
        }
#pragma unroll
        for (int ai = 0; ai < 2; ++ai) {
            const int s = u.pm * 4 + ai * 2 + wr;
#pragma unroll
            for (int bj = 0; bj < 2; ++bj)
#pragma unroll
                for (int n = 0; n < 2; ++n) {
                    const int colp = u.pn * BM + bj * HALF + wc * 32 + 8 * fq + 4 * n;
                    if (fr < 2) *(f32x4*)(HALO + (size_t)(s * 4 + fr) * F2 + colp) = acc[ai][bj][0][n];
                    if (fr >= 14) *(f32x4*)(HALO + (size_t)(s * 4 + fr - 12) * F2 + colp) = acc[ai][bj][3][n];
                }
        }
#pragma unroll
        for (int ai = 0; ai < 2; ++ai)
#pragma unroll
            for (int m = 0; m < 4; ++m) {
                const int row = row0 + ai * HALF + m * 16;
#pragma unroll
                for (int n = 0; n < 2; ++n) {
                    f32x4 cv[2];
#pragma unroll
                    for (int bj = 0; bj < 2; ++bj) {
                        const int cl = bj * 128 + wc * 32 + 8 * fq + 4 * n;
                        const f32x4 w0 = *(const LAS f32x4*)&CW[cl], w1 = *(const LAS f32x4*)&CW[256 + cl], w2 = *(const LAS f32x4*)&CW[512 + cl], bb = *(const LAS f32x4*)&CW[768 + cl];
#pragma unroll
                        for (int e = 0; e < 4; ++e) {
                            const float cur = acc[ai][bj][m][n][e];
                            const float prv = m > 0 ? acc[ai][bj][m > 0 ? m - 1 : 0][n][e] : 0.f;
                            const float a1 = dpp_mov<0x121>(cur), a2 = dpp_mov<0x122>(cur), b1 = dpp_mov<0x121>(prv), b2 = dpp_mov<0x122>(prv);
                            const float p1 = fr >= 1 ? a1 : b1, p2 = fr >= 2 ? a2 : b2;
                            cv[bj][e] = bb[e] + w0[e] * p2 + w1[e] * p1 + w2[e] * cur;
                        }
                        __builtin_amdgcn_sched_barrier(0);
                    }
                    const f32x4 g0 = cv[0], v0 = cv[1];
                    u32x2 w;
                    w.x = cvt_pk_bf16(g0[0] * sigmoidf_(g0[0]) * v0[0], g0[1] * sigmoidf_(g0[1]) * v0[1]);
                    w.y = cvt_pk_bf16(g0[2] * sigmoidf_(g0[2]) * v0[2], g0[3] * sigmoidf_(g0[3]) * v0[3]);
                    if (!(m == 0 && fr < 2)) *(u32x2*)(P + (size_t)row * LDP + COL_ACT + jb + 4 * n) = w;
                    __builtin_amdgcn_sched_barrier(0);
                }
            }
    }
};
}

struct Ctx {
    const float* in[24]; float* out; unsigned char* ws;
    bf16_t* P; bf16_t* VT; float* HALO; float* ROPE;
    bf16_t *Win, *Wg, *Wbr, *Wo, *Wup, *Wdn;
    int tid, lane, wave, G, bid;
};

__device__ __forceinline__ int srccol(int mode, int n) {
    if (mode == 0) return n;
    if (mode == 2) return 4932 + n;
    if (mode == 3) { const int tile = n >> 8, w = n & 255, j = tile * 128 + (w & 127); return (w < 128) ? j : DFF + j; }
    if (n < 3840) return n;
    const int c = n - 3840;
    if (c >= 1092) return -1;
    if (c < 640 || (c >= 768 && c < 1088)) { const int base = c & ~63, i = c & 63; return 3840 + base + (i >> 1) + 32 * (i & 1); }
    return 3840 + c;
}
__device__ __forceinline__ void tr_item(const float* W, int ldw, int K, int N, bf16_t* WT, int mode, int item, LAS float* scr, int lane) {
    const int nblk = N / 32, kb = item / nblk, nb = item % nblk, k0 = 64 * kb, n0 = 32 * nb;
    const int sc = srccol(mode, n0 + (lane & 31));
    float wv_[32];
#pragma unroll
    for (int i = 0; i < 32; ++i) { const int kk = 2 * i + (lane >> 5); wv_[i] = (sc >= 0) ? W[(size_t)(k0 + kk) * ldw + sc] : 0.f; }
#pragma unroll
    for (int i = 0; i < 32; ++i) { const int kk = 2 * i + (lane >> 5); scr[kk * 33 + (lane & 31)] = wv_[i]; }
    asm volatile("s_waitcnt lgkmcnt(0)" ::: "memory");
    const int c = lane & 7;
#pragma unroll
    for (int j = 0; j < 4; ++j) { const int n = (lane >> 3) + 8 * j; const LAS float* s = scr + (8 * c) * 33 + n;
        u32x4 o; o.x = pk2(s[0 * 33], s[1 * 33]); o.y = pk2(s[2 * 33], s[3 * 33]); o.z = pk2(s[4 * 33], s[5 * 33]); o.w = pk2(s[6 * 33], s[7 * 33]);
        *(u32x4*)(WT + (size_t)(n0 + n) * K + k0 + 8 * c) = o; }
    asm volatile("s_waitcnt lgkmcnt(0)" ::: "memory");
}
__device__ __forceinline__ void rms_row(const float* xrow, const float* g, bf16_t* obf, float* of32, int lane) {
    const f32x4* xr = (const f32x4*)xrow + lane; const f32x4* gr = (const f32x4*)g + lane;
    f32x4 v[4]; float s = 0.f;
#pragma unroll
    for (int j = 0; j < 4; ++j) { v[j] = xr[64 * j]; s += (v[j].x * v[j].x + v[j].y * v[j].y) + (v[j].z * v[j].z + v[j].w * v[j].w); }
    const float rs = 1.f / sqrtf(wave_sum(s) * (1.f / DM) + 1e-6f);
#pragma unroll
    for (int j = 0; j < 4; ++j) {
        const f32x4 gg = gr[64 * j]; const f32x4 o = v[j] * rs * gg;
        if (obf) { u32x2 w; w.x = pk2(o.x, o.y); w.y = pk2(o.z, o.w); *((u32x2*)obf + lane + 64 * j) = w; }
        else *((f32x4*)of32 + lane + 64 * j) = o;
    }
}
__device__ __forceinline__ void rms_pass(const Ctx& X, const float* src, const float* g, bf16_t* obf, float* of32) {
    const int gw = X.bid * 8 + X.wave, NGW = X.G * 8, lane = X.lane;
    const f32x4* gr = (const f32x4*)g + lane;
    f32x4 gg[4];
#pragma unroll
    for (int j = 0; j < 4; ++j) gg[j] = gr[64 * j];
#pragma unroll 1
    for (int m = gw; m < T_TOK; m += 4 * NGW) {
        f32x4 v[4][4]; float ss[4]; int mr[4];
#pragma unroll
        for (int r = 0; r < 4; ++r) { mr[r] = m + r * NGW; const int ml = mr[r] < T_TOK ? mr[r] : m; const f32x4* x = (const f32x4*)(src + (size_t)ml * DM) + lane;
#pragma unroll
            for (int j = 0; j < 4; ++j) v[r][j] = x[64 * j]; }
#pragma unroll
        for (int r = 0; r < 4; ++r) { float a = 0.f;
#pragma unroll
            for (int j = 0; j < 4; ++j) a += (v[r][j].x * v[r][j].x + v[r][j].y * v[r][j].y) + (v[r][j].z * v[r][j].z + v[r][j].w * v[r][j].w);
            ss[r] = 1.f / sqrtf(wave_sum(a) * (1.f / DM) + 1e-6f); }
#pragma unroll
        for (int r = 0; r < 4; ++r) {
            if (mr[r] < T_TOK) {
#pragma unroll
                for (int j = 0; j < 4; ++j) {
                    const f32x4 o = v[r][j] * ss[r] * gg[j];
                    if (obf) { u32x2 w; w.x = pk2(o.x, o.y); w.y = pk2(o.z, o.w); *((u32x2*)(obf + (size_t)mr[r] * LDP) + lane + 64 * j) = w; }
                    else *((f32x4*)(of32 + (size_t)mr[r] * DM) + lane + 64 * j) = o;
                }
            }
        }
    }
}
__device__ __forceinline__ void phase_prep(const Ctx& X, LAS unsigned char* lds, int layer, bool do_u) {
    LAS float* scr = (LAS float*)(lds + X.wave * 8448);
    const int gw = X.bid * 8 + X.wave, NGW = X.G * 8;
    constexpr int I_IN = 16 * 160, I_G = 16 * 96, I_BR = 8 * 32, I_O = 16 * 32, I_UP = 16 * 176, I_DN = 44 * 32;
    constexpr int NITEMS = I_IN + I_G + 3 * I_BR + I_O + I_UP + I_DN;
    const float* w_in = X.in[2] + (size_t)layer * DM * IN_COLS;
    const float* w_br = X.in[16] + (size_t)layer * 3 * 512 * DM;
    const float* w_o = X.in[17] + (size_t)layer * DM * DM;
    const float* w_up = X.in[19] + (size_t)layer * DM * F2;
    const float* w_dn = X.in[22] + (size_t)layer * DFF * DM;
    for (int it = gw; it < NITEMS; it += NGW) {
        int r = it;
        if (r < I_IN) { tr_item(w_in, IN_COLS, DM, 5120, X.Win, 1, r, scr, X.lane); continue; } r -= I_IN;
        if (r < I_G) { tr_item(w_in, IN_COLS, DM, 3072, X.Wg, 2, r, scr, X.lane); continue; } r -= I_G;
        if (r < 3 * I_BR) { const int b = r / I_BR; tr_item(w_br + (size_t)b * 512 * DM, DM, 512, DM, X.Wbr + (size_t)b * DM * 512, 0, r % I_BR, scr, X.lane); continue; } r -= 3 * I_BR;
        if (r < I_O) { tr_item(w_o, DM, DM, DM, X.Wo, 0, r, scr, X.lane); continue; } r -= I_O;
        if (r < I_UP) { tr_item(w_up, F2, DM, F2, X.Wup, 3, r, scr, X.lane); continue; } r -= I_UP;
        tr_item(w_dn, DM, DFF, DM, X.Wdn, 0, r, scr, X.lane);
    }
    const float* h = (layer == 0) ? X.in[0] : X.out;
    const float* g = X.in[1] + (size_t)layer * DM;
    if (do_u) rms_pass(X, h, g, X.P, nullptr);
    if (layer == 0) {
        for (int idx = X.bid * 512 + X.tid; idx < SEQ * 32; idx += X.G * 512) {
            const int t = idx >> 5, p = idx & 31;
            const float inv = exp2f(-(float)p * 0.03125f * 13.287712379549449f);
            const float ang = (float)t * inv;
            const double rev = (double)ang * 0.15915494309189535;
            const float fr = (float)(rev - floor(rev));
            X.ROPE[2 * idx] = __builtin_amdgcn_cosf(fr); X.ROPE[2 * idx + 1] = __builtin_amdgcn_sinf(fr);
        }
    }
}

__device__ __forceinline__ float wave_sum_fast(float x) {
    x = red16(x);
    const float r0 = __builtin_bit_cast(float, __builtin_amdgcn_readlane(__builtin_bit_cast(int, x), 0)), r1 = __builtin_bit_cast(float, __builtin_amdgcn_readlane(__builtin_bit_cast(int, x), 16));
    const float r2 = __builtin_bit_cast(float, __builtin_amdgcn_readlane(__builtin_bit_cast(int, x), 32)), r3 = __builtin_bit_cast(float, __builtin_amdgcn_readlane(__builtin_bit_cast(int, x), 48));
    return (r0 + r1) + (r2 + r3);
}
#define LDS_BAR() do { asm volatile("s_waitcnt lgkmcnt(0)" ::: "memory"); __builtin_amdgcn_s_barrier(); asm volatile("" ::: "memory"); } while (0)
constexpr int RW_TS = 16, RW_NCH = SEQ / RW_TS, RW_BUF = 33280;
__device__ __forceinline__ void phase_rwkv_pre(const Ctx& X, LAS unsigned char* lds, int layer) {
    LAS float* Rr = (LAS float*)(lds);           LAS float* Kk = (LAS float*)(lds + 8192);   LAS float* Vv = (LAS float*)(lds + 16384);
    LAS float* W1 = (LAS float*)(lds + 24576);   LAS float* AS = (LAS float*)(lds + 32768);
    LAS bf16_t* WDb = (LAS bf16_t*)(lds + 40960);
    LAS bf16_t* ADb = (LAS bf16_t*)(lds + 45568);
    LAS bf16_t* WTu = (LAS bf16_t*)(lds + 50176);
    LAS bf16_t* WTa = (LAS bf16_t*)(lds + 59392);
    LAS float* MU = (LAS float*)(lds + 68608);
    const int tid = X.tid, lane = tid & 63, wv = X.wave;
    const float* mu = X.in[3] + layer * 1792;
    const float* w0 = X.in[4] + layer * 512;   const float* w_up = X.in[5] + (size_t)layer * 64 * 512;
    const float* a0 = X.in[6] + layer * 512;   const float* a_up = X.in[7] + (size_t)layer * 64 * 512;
    const float* k_k = X.in[9] + layer * 512;  const float* k_a = X.in[10] + layer * 512;  const float* r_k = X.in[11] + layer * 512;
    const bf16_t* BND = (const bf16_t*)(X.ws + WS_BND);
    float* SCAL = (float*)(X.ws + WS_SCAL);
    const int ln = lane & 15, lg = lane >> 4;
    int last_h = -1;
    float q_w0 = 0.f, q_a0 = 0.f;
    f32x4 p_kk4 = (f32x4){0.f, 0.f, 0.f, 0.f}, p_ka4 = p_kk4, p_rk4 = p_kk4;
    const int cg4 = (tid & 15) * 4;
    u32x4 pc4[3], pp4[3]; bool have_pf = false;
    pc4[0] = pc4[1] = pc4[2] = pp4[0] = pp4[1] = pp4[2] = (u32x4){0u, 0u, 0u, 0u};
#define PRE_LOAD(uu) do { const int h_ = (uu) & 7, tp_ = (uu) >> 3; _Pragma("unroll") for (int it = 0; it < 3; ++it) { const int idx = tid + 512 * it; pc4[it] = (u32x4){0u, 0u, 0u, 0u}; pp4[it] = (u32x4){0u, 0u, 0u, 0u}; \
        if (idx < 32 * 40) { const int tt = idx / 40, vv = idx - tt * 40; \
            const int col = vv < 8 ? h_ * 64 + 8 * vv : (vv < 16 ? 512 + h_ * 64 + 8 * (vv - 8) : (vv < 24 ? 1024 + h_ * 64 + 8 * (vv - 16) : 1536 + 8 * (vv - 24))); \
            const size_t row = (size_t)tp_ * 32 + tt; pc4[it] = *(const u32x4*)(X.P + row * LDP + COL_PA + col); \
            if (tt > 0) pp4[it] = *(const u32x4*)(X.P + (row - 1) * LDP + COL_PA + col); else if ((tp_ & 63) != 0) pp4[it] = *(const u32x4*)(BND + (size_t)(2 * tp_ - 1) * 1792 + col); } } } while (0)
#pragma unroll 1
    for (int u = X.bid; u < 4096; u += X.G) {
        const int h = u & 7, tp = u >> 3;
        if (h != last_h) {
            __syncthreads();
            for (int idx = tid; idx < 64 * 64; idx += 512) { const int m = idx >> 6, cc = idx & 63;
                WTu[cc * 72 + m] = (bf16_t)f2bf(w_up[m * 512 + h * 64 + cc]); WTa[cc * 72 + m] = (bf16_t)f2bf(a_up[m * 512 + h * 64 + cc]); }
            if (tid < 320) { const int cc = tid; const int col = cc < 64 ? h * 64 + cc : (cc < 128 ? 512 + h * 64 + cc - 64 : (cc < 192 ? 1024 + h * 64 + cc - 128 : 1536 + cc - 192)); MU[cc] = mu[col]; }
            p_kk4 = *(const f32x4*)(k_k + h * 64 + cg4); p_ka4 = *(const f32x4*)(k_a + h * 64 + cg4); p_rk4 = *(const f32x4*)(r_k + h * 64 + cg4);
            q_w0 = w0[h * 64 + 16 * (wv >> 1) + ln]; q_a0 = a0[h * 64 + 16 * (wv >> 1) + ln];
            last_h = h;
            __syncthreads();
        }
        if (!have_pf) { PRE_LOAD(u); }
#pragma unroll
        for (int it = 0; it < 3; ++it) {
            const int idx = tid + 512 * it;
            if (idx < 32 * 40) {
                const int tt = idx / 40, vv = idx - tt * 40, cc0 = 8 * vv;
                const u32x4 c4 = pc4[it], p4 = pp4[it];
                const f32x4 m0 = *(const LAS f32x4*)&MU[cc0], m1 = *(const LAS f32x4*)&MU[cc0 + 4];
                float cur[8], prv[8], val[8];
                cur[0] = bflo(c4.x); cur[1] = bfhi(c4.x); cur[2] = bflo(c4.y); cur[3] = bfhi(c4.y); cur[4] = bflo(c4.z); cur[5] = bfhi(c4.z); cur[6] = bflo(c4.w); cur[7] = bfhi(c4.w);
                prv[0] = bflo(p4.x); prv[1] = bfhi(p4.x); prv[2] = bflo(p4.y); prv[3] = bfhi(p4.y); prv[4] = bflo(p4.z); prv[5] = bfhi(p4.z); prv[6] = bflo(p4.w); prv[7] = bfhi(p4.w);
#pragma unroll
                for (int e = 0; e < 8; ++e) val[e] = cur[e] + (prv[e] - cur[e]) * (e < 4 ? m0[e & 3] : m1[e & 3]);
                if (vv < 24) {
#pragma unroll
                    for (int e = 0; e < 8; ++e) val[e] = bf2f((bf16_t)f2bf(val[e]));
                    LAS float* dst = (vv < 8 ? Rr : (vv < 16 ? Kk : Vv)) + tt * 64 + 8 * (vv & 7);
                    *(LAS f32x4*)dst = (f32x4){val[0], val[1], val[2], val[3]}; *(LAS f32x4*)(dst + 4) = (f32x4){val[4], val[5], val[6], val[7]};
                } else {
                    const int lr0 = 8 * (vv - 24);
                    LAS bf16_t* dst;
                    if (lr0 < 64) { dst = WDb + tt * 72 + lr0;
#pragma unroll
                        for (int e = 0; e < 8; ++e) { const float ex = __expf(2.f * val[e]); val[e] = 1.f - 2.f / (ex + 1.f); } }
                    else dst = ADb + tt * 72 + lr0 - 64;
                    u32x4 o; o.x = pk2(val[0], val[1]); o.y = pk2(val[2], val[3]); o.z = pk2(val[4], val[5]); o.w = pk2(val[6], val[7]);
                    *(LAS u32x4*)dst = o;
                }
            }
        }
        have_pf = false;
        if (u + X.G < 4096 && ((u + X.G) & 7) == h) { PRE_LOAD(u + X.G); have_pf = true; }
        LDS_BAR();
        {
            const int mt = wv & 1, nt = wv >> 1, chm = 16 * nt + ln;
            f32x4 cw_ = (f32x4){0.f, 0.f, 0.f, 0.f}, ca_ = cw_;
#pragma unroll
            for (int ks = 0; ks < 2; ++ks) {
                const bf16x8 xa = *(const LAS bf16x8*)&WDb[(16 * mt + ln) * 72 + ks * 32 + 8 * lg], xb = *(const LAS bf16x8*)&WTu[(16 * nt + ln) * 72 + ks * 32 + 8 * lg];
                cw_ = __builtin_amdgcn_mfma_f32_16x16x32_bf16(xa, xb, cw_, 0, 0, 0);
                const bf16x8 ya = *(const LAS bf16x8*)&ADb[(16 * mt + ln) * 72 + ks * 32 + 8 * lg], yb = *(const LAS bf16x8*)&WTa[(16 * nt + ln) * 72 + ks * 32 + 8 * lg];
                ca_ = __builtin_amdgcn_mfma_f32_16x16x32_bf16(ya, yb, ca_, 0, 0, 0);
            }
#pragma unroll
            for (int r = 0; r < 4; ++r) {
                const int tt = 16 * mt + 4 * lg + r;
                const float z = -(q_w0 + cw_[r]);
                const float sp = fmaxf(z, 0.f) + __logf(1.f + __expf(-fabsf(z)));
                const float e = __expf(-sp - 0.5f);
                W1[tt * 64 + chm] = bf2f((bf16_t)f2bf(-expm1f(-e)));
                AS[tt * 64 + chm] = bf2f((bf16_t)f2bf(sigmoidf_(q_a0 + ca_[r])));
            }
        }
        LDS_BAR();
        {
            const int tt = tid >> 4;
            const size_t row = (size_t)tp * 32 + tt;
            const f32x4 w1 = *(const LAS f32x4*)&W1[tt * 64 + cg4], a = *(const LAS f32x4*)&AS[tt * 64 + cg4];
            const f32x4 kraw = *(const LAS f32x4*)&Kk[tt * 64 + cg4], r = *(const LAS f32x4*)&Rr[tt * 64 + cg4], v = *(const LAS f32x4*)&Vv[tt * 64 + cg4];
            const f32x4 kk0 = kraw * p_kk4;
            const float inv = 1.f / sqrtf(fmaxf(red16((kk0.x * kk0.x + kk0.y * kk0.y) + (kk0.z * kk0.z + kk0.w * kk0.w)), 1e-24f));
            const f32x4 kk = kk0 * inv;
            const f32x4 kmod = kraw * (1.f + (a - 1.f) * p_ka4);
            const f32x4 bvec = kk * a, t1 = bvec * r, t2 = kmod * r, t3 = t2 * p_rk4;
            const float br = red16((t1.x + t1.y) + (t1.z + t1.w)), kr = red16((t2.x + t2.y) + (t2.z + t2.w)), bonus = red16((t3.x + t3.y) + (t3.z + t3.w));
            bf16_t* rp_ = X.P + row * LDP;
            u32x2 o;
            o.x = pk2(r.x, r.y); o.y = pk2(r.z, r.w); *(u32x2*)(rp_ + COL_PA + h * 64 + cg4) = o;
            o.x = pk2(kraw.x, kraw.y); o.y = pk2(kraw.z, kraw.w); *(u32x2*)(rp_ + COL_PA + 512 + h * 64 + cg4) = o;
            o.x = pk2(v.x, v.y); o.y = pk2(v.z, v.w); *(u32x2*)(rp_ + COL_PA + 1024 + h * 64 + cg4) = o;
            o.x = pk2(w1.x, w1.y); o.y = pk2(w1.z, w1.w); *(u32x2*)(rp_ + h * 64 + cg4) = o;
            o.x = pk2(a.x, a.y); o.y = pk2(a.z, a.w); *(u32x2*)(rp_ + 512 + h * 64 + cg4) = o;
            if (cg4 == 0) *(f32x4*)(SCAL + (row * 8 + h) * 4) = (f32x4){inv, br, kr, bonus};
        }
        LDS_BAR();
    }
}

__device__ __forceinline__ void rwkv_task(const Ctx& X, LAS unsigned char* lds, int layer, int b, int h) {
    LAS bf16_t* GDb = (LAS bf16_t*)(lds + 66560);
    LAS bf16_t* WTg = (LAS bf16_t*)(lds + 70912);
    LAS float* BON = (LAS float*)(lds + 88320);
    const int tid = X.tid, lane = tid & 63;
    const bool helper = X.wave >= 4;
    const int ht = tid & 255;
    const float* mu = X.in[3] + layer * 1792;
    const float* g_up = X.in[8] + (size_t)layer * 128 * 512;
    const float* k_k = X.in[9] + layer * 512;  const float* k_a = X.in[10] + layer * 512;
    const float* gn_g = X.in[12] + layer * 512; const float* gn_b = X.in[13] + layer * 512;
    const float* SCAL = (const float*)(X.ws + WS_SCAL);
    const int tt_h = ht >> 4, cg4 = (ht & 15) * 4;
    const f32x4 p_kk = *(const f32x4*)(k_k + h * 64 + cg4), p_ka = *(const f32x4*)(k_a + h * 64 + cg4);
    const f32x4 p_gg = *(const f32x4*)(gn_g + h * 64 + cg4), p_gb = *(const f32x4*)(gn_b + h * 64 + cg4);
    const int gv8 = (ht & 15) * 8;
    const f32x4 mg0 = *(const f32x4*)(mu + 1664 + gv8), mg1 = *(const f32x4*)(mu + 1664 + gv8 + 4);
    const int nt = (ht >> 6), ln = lane & 15, lg = lane >> 4, chm = 16 * nt + ln;
    const int rp = ht >> 3, jg = ht & 7, i0 = 2 * rp;
    for (int idx = tid; idx < 128 * 64; idx += 512) { const int m = idx >> 6, cc = idx & 63; WTg[cc * 136 + m] = (bf16_t)f2bf(g_up[m * 512 + h * 64 + cc]); }
    f32x2 S0[4], S1[4];
#pragma unroll
    for (int j = 0; j < 4; ++j) { S0[j] = (f32x2){0.f, 0.f}; S1[j] = (f32x2){0.f, 0.f}; }
#if PROBE_SCAN2
    f32x2 T0[4], T1[4];
#pragma unroll
    for (int j = 0; j < 4; ++j) { T0[j] = (f32x2){0.f, 0.f}; T1[j] = (f32x2){0.f, 0.f}; }
#endif
    __syncthreads();

#define RW_ARR(bufi, k) ((LAS float*)(lds + (bufi) * RW_BUF + (k) * 4096))
#define RW_SC(bufi) ((LAS float*)(lds + (bufi) * RW_BUF + 32768))
#define RW_LOAD(chk, L) do { const size_t row_ = (size_t)b * SEQ + (chk) * RW_TS + tt_h; const bf16_t* rp_ = X.P + row_ * LDP; \
        l_r##L = *(const u32x2*)(rp_ + COL_PA + h * 64 + cg4); l_k##L = *(const u32x2*)(rp_ + COL_PA + 512 + h * 64 + cg4); l_v##L = *(const u32x2*)(rp_ + COL_PA + 1024 + h * 64 + cg4); \
        l_w##L = *(const u32x2*)(rp_ + h * 64 + cg4); l_a##L = *(const u32x2*)(rp_ + 512 + h * 64 + cg4); l_s##L = *(const f32x4*)(SCAL + (row_ * 8 + h) * 4); \
        l_gc##L = *(const u32x4*)(rp_ + COL_PA + 1664 + gv8); l_gp##L = (u32x4){0u, 0u, 0u, 0u}; if ((chk) * RW_TS + tt_h > 0) l_gp##L = *(const u32x4*)(rp_ - LDP + COL_PA + 1664 + gv8); } while (0)
    u32x2 l_rA, l_kA, l_vA, l_wA, l_aA; f32x4 l_sA; u32x4 l_gcA, l_gpA;
    u32x2 l_rB, l_kB, l_vB, l_wB, l_aB; f32x4 l_sB; u32x4 l_gcB, l_gpB;
    l_rA = l_kA = l_vA = l_wA = l_aA = l_rB = l_kB = l_vB = l_wB = l_aB = (u32x2){0u, 0u}; l_sA = l_sB = (f32x4){0.f, 0.f, 0.f, 0.f}; l_gcA = l_gpA = l_gcB = l_gpB = (u32x4){0u, 0u, 0u, 0u};
    if (helper) { RW_LOAD(0, A); RW_LOAD(1, B); }

#pragma unroll 1
    for (int i0_ = -1; i0_ < RW_NCH; i0_ += 2) {
        { const int i = i0_;

        const int bufn = (i + 1) & 1, bufc = i & 1;
        if (helper) {
            const bool do_prep = (i + 1 < RW_NCH);
            if (i >= 1) {
                LAS float* Yy = RW_ARR(bufn, 7); LAS float* Gg = RW_ARR(bufn, 6); LAS float* Vv = RW_ARR(bufn, 5); LAS float* SC = RW_SC(bufn);
                const f32x4 y = *(const LAS f32x4*)&Yy[tt_h * 64 + cg4], gg = *(const LAS f32x4*)&Gg[tt_h * 64 + cg4], vv = *(const LAS f32x4*)&Vv[tt_h * 64 + cg4];
                const float bonus = BON[((i - 1) % 3) * 16 + tt_h];
                const float mean = red16((y.x + y.y) + (y.z + y.w)) * (1.f / 64.f);
                const f32x4 d = y - mean;
                const float var = red16((d.x * d.x + d.y * d.y) + (d.z * d.z + d.w * d.w)) * (1.f / 64.f);
                const float rs = 1.f / sqrtf(var + 64e-5f);
                const f32x4 o = (d * rs * p_gg + p_gb + vv * bonus) * gg;
                u32x2 w; w.x = pk2(o.x, o.y); w.y = pk2(o.z, o.w);
                *(u32x2*)(X.P + ((size_t)b * SEQ + (i - 1) * RW_TS + tt_h) * LDP + COL_YA + h * 64 + cg4) = w;
            }
            if (do_prep) {
                const f32x4 r = (f32x4){bflo(l_rA.x), bfhi(l_rA.x), bflo(l_rA.y), bfhi(l_rA.y)}, k = (f32x4){bflo(l_kA.x), bfhi(l_kA.x), bflo(l_kA.y), bfhi(l_kA.y)};
                const f32x4 v = (f32x4){bflo(l_vA.x), bfhi(l_vA.x), bflo(l_vA.y), bfhi(l_vA.y)}, w1 = (f32x4){bflo(l_wA.x), bfhi(l_wA.x), bflo(l_wA.y), bfhi(l_wA.y)};
                const f32x4 a = (f32x4){bflo(l_aA.x), bfhi(l_aA.x), bflo(l_aA.y), bfhi(l_aA.y)};
                const f32x4 kk = k * p_kk * l_sA.x;
                const f32x4 decay = 1.f - w1;
                *(LAS f32x4*)&RW_ARR(bufn, 0)[tt_h * 64 + cg4] = -kk;
                *(LAS f32x4*)&RW_ARR(bufn, 1)[tt_h * 64 + cg4] = decay * r;
                *(LAS f32x4*)&RW_ARR(bufn, 2)[tt_h * 64 + cg4] = decay;
                *(LAS f32x4*)&RW_ARR(bufn, 3)[tt_h * 64 + cg4] = kk * a;
                *(LAS f32x4*)&RW_ARR(bufn, 4)[tt_h * 64 + cg4] = k * (1.f + (a - 1.f) * p_ka);
                *(LAS f32x4*)&RW_ARR(bufn, 5)[tt_h * 64 + cg4] = v;
                if (cg4 == 0) { LAS float* SC = RW_SC(bufn); SC[tt_h * 4 + 0] = l_sA.y; SC[tt_h * 4 + 1] = l_sA.z; BON[((i + 1) % 3) * 16 + tt_h] = l_sA.w; }
                float gc[8], gp[8];
                gc[0] = bflo(l_gcA.x); gc[1] = bfhi(l_gcA.x); gc[2] = bflo(l_gcA.y); gc[3] = bfhi(l_gcA.y); gc[4] = bflo(l_gcA.z); gc[5] = bfhi(l_gcA.z); gc[6] = bflo(l_gcA.w); gc[7] = bfhi(l_gcA.w);
                gp[0] = bflo(l_gpA.x); gp[1] = bfhi(l_gpA.x); gp[2] = bflo(l_gpA.y); gp[3] = bfhi(l_gpA.y); gp[4] = bflo(l_gpA.z); gp[5] = bfhi(l_gpA.z); gp[6] = bflo(l_gpA.w); gp[7] = bfhi(l_gpA.w);
#pragma unroll
                for (int e = 0; e < 8; ++e) gc[e] = sigmoidf_(gc[e] + (gp[e] - gc[e]) * (e < 4 ? mg0[e & 3] : mg1[e & 3]));
                u32x4 o; o.x = pk2(gc[0], gc[1]); o.y = pk2(gc[2], gc[3]); o.z = pk2(gc[4], gc[5]); o.w = pk2(gc[6], gc[7]);
                *(LAS u32x4*)&GDb[tt_h * 136 + gv8] = o;
            }
            if (i + 3 < RW_NCH) RW_LOAD(i + 3, A);
            LDS_BAR();
            if (do_prep) {
                LAS float* Gg = RW_ARR(bufn, 6);
                f32x4 cg_ = (f32x4){0.f, 0.f, 0.f, 0.f};
#pragma unroll
                for (int ks = 0; ks < 4; ++ks) {
                    const bf16x8 za = *(const LAS bf16x8*)&GDb[ln * 136 + ks * 32 + 8 * lg], zb = *(const LAS bf16x8*)&WTg[(16 * nt + ln) * 136 + ks * 32 + 8 * lg];
                    cg_ = __builtin_amdgcn_mfma_f32_16x16x32_bf16(za, zb, cg_, 0, 0, 0);
                }
#pragma unroll
                for (int r = 0; r < 4; ++r) Gg[(4 * lg + r) * 64 + chm] = cg_[r];
            }
            LDS_BAR();
        } else {
            LAS float* A_ = RW_ARR(bufc, 0); LAS float* WR = RW_ARR(bufc, 1); LAS float* Wd = RW_ARR(bufc, 2); LAS float* Bv = RW_ARR(bufc, 3);
            LAS float* Kk = RW_ARR(bufc, 4); LAS float* Vv = RW_ARR(bufc, 5); LAS float* Yy = RW_ARR(bufc, 7); LAS float* SC = RW_SC(bufc);
#pragma unroll 1
            for (int q4 = 0; q4 < 4; ++q4) {
                if (i >= 0) {
                    float yv[8];
#pragma unroll
                    for (int s4 = 0; s4 < 4; ++s4) {
                        const int tt = 4 * q4 + s4;
                        const f32x4 a_lo = *(const LAS f32x4*)&A_[tt * 64 + 8 * jg], a_hi = *(const LAS f32x4*)&A_[tt * 64 + 8 * jg + 4];
                        const f32x4 r_lo = *(const LAS f32x4*)&WR[tt * 64 + 8 * jg], r_hi = *(const LAS f32x4*)&WR[tt * 64 + 8 * jg + 4];
                        const f32x4 w_lo = *(const LAS f32x4*)&Wd[tt * 64 + 8 * jg], w_hi = *(const LAS f32x4*)&Wd[tt * 64 + 8 * jg + 4];
                        const f32x4 b_lo = *(const LAS f32x4*)&Bv[tt * 64 + 8 * jg], b_hi = *(const LAS f32x4*)&Bv[tt * 64 + 8 * jg + 4];
                        const f32x4 k_lo = *(const LAS f32x4*)&Kk[tt * 64 + 8 * jg], k_hi = *(const LAS f32x4*)&Kk[tt * 64 + 8 * jg + 4];
                        const f32x2 vv = *(const LAS f32x2*)&Vv[tt * 64 + i0];
                        const f32x2 sc = *(const LAS f32x2*)&SC[tt * 4];
                        const f32x2 av[4] = {{a_lo.x, a_lo.y}, {a_lo.z, a_lo.w}, {a_hi.x, a_hi.y}, {a_hi.z, a_hi.w}};
                        const f32x2 rv[4] = {{r_lo.x, r_lo.y}, {r_lo.z, r_lo.w}, {r_hi.x, r_hi.y}, {r_hi.z, r_hi.w}};
                        const f32x2 wv[4] = {{w_lo.x, w_lo.y}, {w_lo.z, w_lo.w}, {w_hi.x, w_hi.y}, {w_hi.z, w_hi.w}};
                        const f32x2 bv[4] = {{b_lo.x, b_lo.y}, {b_lo.z, b_lo.w}, {b_hi.x, b_hi.y}, {b_hi.z, b_hi.w}};
                        const f32x2 kv[4] = {{k_lo.x, k_lo.y}, {k_lo.z, k_lo.w}, {k_hi.x, k_hi.y}, {k_hi.z, k_hi.w}};
                        f32x2 e10 = S0[0] * av[0], e20 = S0[0] * rv[0], e11 = S1[0] * av[0], e21 = S1[0] * rv[0];
#pragma unroll
                        for (int j = 1; j < 4; ++j) { e10 += S0[j] * av[j]; e20 += S0[j] * rv[j]; e11 += S1[j] * av[j]; e21 += S1[j] * rv[j]; }
                        const float d10 = red8(e10.x + e10.y), d11 = red8(e11.x + e11.y);
                        yv[2 * s4] = (e20.x + e20.y) + (jg == 0 ? d10 * sc.x + vv.x * sc.y : 0.f); yv[2 * s4 + 1] = (e21.x + e21.y) + (jg == 0 ? d11 * sc.x + vv.y * sc.y : 0.f);
                        const f32x2 d10v = (f32x2){d10, d10}, d11v = (f32x2){d11, d11}, v0v = (f32x2){vv.x, vv.x}, v1v = (f32x2){vv.y, vv.y};
#pragma unroll
                        for (int j = 0; j < 4; ++j) { S0[j] = S0[j] * wv[j] + (d10v * bv[j] + v0v * kv[j]); S1[j] = S1[j] * wv[j] + (d11v * bv[j] + v1v * kv[j]); }
                    }
                    {
                        const bool t2 = (jg & 4) != 0, t1 = (jg & 2) != 0, t0 = (jg & 1) != 0;
#pragma unroll
                        for (int q = 0; q < 4; ++q) { const float keep = t2 ? yv[q + 4] : yv[q], send = t2 ? yv[q] : yv[q + 4]; yv[q] = keep + dpp_mov<0x141>(send); }
#pragma unroll
                        for (int q = 0; q < 2; ++q) { const float keep = t1 ? yv[q + 2] : yv[q], send = t1 ? yv[q] : yv[q + 2]; yv[q] = keep + dpp_mov<0x4E>(send); }
                        { const float keep = t0 ? yv[1] : yv[0], send = t0 ? yv[0] : yv[1]; yv[0] = keep + dpp_mov<0xB1>(send); }
                        Yy[(4 * q4 + (jg >> 1)) * 64 + i0 + (jg & 1)] = yv[0];
                    }

#if PROBE_SCAN2
                    {
#pragma unroll
                    for (int s4 = 0; s4 < 4; ++s4) {
                        const int tt = 4 * q4 + s4;
                        const f32x4 a_lo = *(const LAS f32x4*)&A_[tt * 64 + 8 * jg], a_hi = *(const LAS f32x4*)&A_[tt * 64 + 8 * jg + 4];
                        const f32x4 r_lo = *(const LAS f32x4*)&WR[tt * 64 + 8 * jg], r_hi = *(const LAS f32x4*)&WR[tt * 64 + 8 * jg + 4];
                        const f32x4 w_lo = *(const LAS f32x4*)&Wd[tt * 64 + 8 * jg], w_hi = *(const LAS f32x4*)&Wd[tt * 64 + 8 * jg + 4];
                        const f32x4 b_lo = *(const LAS f32x4*)&Bv[tt * 64 + 8 * jg], b_hi = *(const LAS f32x4*)&Bv[tt * 64 + 8 * jg + 4];
                        const f32x4 k_lo = *(const LAS f32x4*)&Kk[tt * 64 + 8 * jg], k_hi = *(const LAS f32x4*)&Kk[tt * 64 + 8 * jg + 4];
                        const f32x2 vv = *(const LAS f32x2*)&Vv[tt * 64 + i0];
                        const f32x2 av[4] = {{a_lo.x, a_lo.y}, {a_lo.z, a_lo.w}, {a_hi.x, a_hi.y}, {a_hi.z, a_hi.w}};
                        const f32x2 rv[4] = {{r_lo.x, r_lo.y}, {r_lo.z, r_lo.w}, {r_hi.x, r_hi.y}, {r_hi.z, r_hi.w}};
                        const f32x2 wv[4] = {{w_lo.x, w_lo.y}, {w_lo.z, w_lo.w}, {w_hi.x, w_hi.y}, {w_hi.z, w_hi.w}};
                        const f32x2 bv[4] = {{b_lo.x, b_lo.y}, {b_lo.z, b_lo.w}, {b_hi.x, b_hi.y}, {b_hi.z, b_hi.w}};
                        const f32x2 kv[4] = {{k_lo.x, k_lo.y}, {k_lo.z, k_lo.w}, {k_hi.x, k_hi.y}, {k_hi.z, k_hi.w}};
                        f32x2 e10 = T0[0] * av[0], e20 = T0[0] * rv[0], e11 = T1[0] * av[0], e21 = T1[0] * rv[0];
#pragma unroll
                        for (int j = 1; j < 4; ++j) { e10 += T0[j] * av[j]; e20 += T0[j] * rv[j]; e11 += T1[j] * av[j]; e21 += T1[j] * rv[j]; }
                        const float d10 = red8(e10.x + e10.y), d20 = red8(e20.x + e20.y), d11 = red8(e11.x + e11.y), d21 = red8(e21.x + e21.y);
                        const f32x2 d10v = (f32x2){d10 + d20, d10}, d11v = (f32x2){d11 + d21, d11}, v0v = (f32x2){vv.x, vv.x}, v1v = (f32x2){vv.y, vv.y};
#pragma unroll
                        for (int j = 0; j < 4; ++j) { T0[j] = T0[j] * wv[j] + (d10v * bv[j] + v0v * kv[j]); T1[j] = T1[j] * wv[j] + (d11v * bv[j] + v1v * kv[j]); }
                    }
                    }
#endif
                }
                if (q4 & 1) LDS_BAR();
            }
        }
            }
        if (i0_ + 1 < RW_NCH) { const int i = i0_ + 1;

        const int bufn = (i + 1) & 1, bufc = i & 1;
        if (helper) {
            const bool do_prep = (i + 1 < RW_NCH);
            if (i >= 1) {
                LAS float* Yy = RW_ARR(bufn, 7); LAS float* Gg = RW_ARR(bufn, 6); LAS float* Vv = RW_ARR(bufn, 5); LAS float* SC = RW_SC(bufn);
                const f32x4 y = *(const LAS f32x4*)&Yy[tt_h * 64 + cg4], gg = *(const LAS f32x4*)&Gg[tt_h * 64 + cg4], vv = *(const LAS f32x4*)&Vv[tt_h * 64 + cg4];
                const float bonus = BON[((i - 1) % 3) * 16 + tt_h];
                const float mean = red16((y.x + y.y) + (y.z + y.w)) * (1.f / 64.f);
                const f32x4 d = y - mean;
                const float var = red16((d.x * d.x + d.y * d.y) + (d.z * d.z + d.w * d.w)) * (1.f / 64.f);
                const float rs = 1.f / sqrtf(var + 64e-5f);
                const f32x4 o = (d * rs * p_gg + p_gb + vv * bonus) * gg;
                u32x2 w; w.x = pk2(o.x, o.y); w.y = pk2(o.z, o.w);
                *(u32x2*)(X.P + ((size_t)b * SEQ + (i - 1) * RW_TS + tt_h) * LDP + COL_YA + h * 64 + cg4) = w;
            }
            if (do_prep) {
                const f32x4 r = (f32x4){bflo(l_rB.x), bfhi(l_rB.x), bflo(l_rB.y), bfhi(l_rB.y)}, k = (f32x4){bflo(l_kB.x), bfhi(l_kB.x), bflo(l_kB.y), bfhi(l_kB.y)};
                const f32x4 v = (f32x4){bflo(l_vB.x), bfhi(l_vB.x), bflo(l_vB.y), bfhi(l_vB.y)}, w1 = (f32x4){bflo(l_wB.x), bfhi(l_wB.x), bflo(l_wB.y), bfhi(l_wB.y)};
                const f32x4 a = (f32x4){bflo(l_aB.x), bfhi(l_aB.x), bflo(l_aB.y), bfhi(l_aB.y)};
                const f32x4 kk = k * p_kk * l_sB.x;
                const f32x4 decay = 1.f - w1;
                *(LAS f32x4*)&RW_ARR(bufn, 0)[tt_h * 64 + cg4] = -kk;
                *(LAS f32x4*)&RW_ARR(bufn, 1)[tt_h * 64 + cg4] = decay * r;
                *(LAS f32x4*)&RW_ARR(bufn, 2)[tt_h * 64 + cg4] = decay;
                *(LAS f32x4*)&RW_ARR(bufn, 3)[tt_h * 64 + cg4] = kk * a;
                *(LAS f32x4*)&RW_ARR(bufn, 4)[tt_h * 64 + cg4] = k * (1.f + (a - 1.f) * p_ka);
                *(LAS f32x4*)&RW_ARR(bufn, 5)[tt_h * 64 + cg4] = v;
                if (cg4 == 0) { LAS float* SC = RW_SC(bufn); SC[tt_h * 4 + 0] = l_sB.y; SC[tt_h * 4 + 1] = l_sB.z; BON[((i + 1) % 3) * 16 + tt_h] = l_sB.w; }
                float gc[8], gp[8];
                gc[0] = bflo(l_gcB.x); gc[1] = bfhi(l_gcB.x); gc[2] = bflo(l_gcB.y); gc[3] = bfhi(l_gcB.y); gc[4] = bflo(l_gcB.z); gc[5] = bfhi(l_gcB.z); gc[6] = bflo(l_gcB.w); gc[7] = bfhi(l_gcB.w);
                gp[0] = bflo(l_gpB.x); gp[1] = bfhi(l_gpB.x); gp[2] = bflo(l_gpB.y); gp[3] = bfhi(l_gpB.y); gp[4] = bflo(l_gpB.z); gp[5] = bfhi(l_gpB.z); gp[6] = bflo(l_gpB.w); gp[7] = bfhi(l_gpB.w);
#pragma unroll
                for (int e = 0; e < 8; ++e) gc[e] = sigmoidf_(gc[e] + (gp[e] - gc[e]) * (e < 4 ? mg0[e & 3] : mg1[e & 3]));
                u32x4 o; o.x = pk2(gc[0], gc[1]); o.y = pk2(gc[2], gc[3]); o.z = pk2(gc[4], gc[5]); o.w = pk2(gc[6], gc[7]);
                *(LAS u32x4*)&GDb[tt_h * 136 + gv8] = o;
            }
            if (i + 3 < RW_NCH) RW_LOAD(i + 3, B);
            LDS_BAR();
            if (do_prep) {
                LAS float* Gg = RW_ARR(bufn, 6);
                f32x4 cg_ = (f32x4){0.f, 0.f, 0.f, 0.f};
#pragma unroll
                for (int ks = 0; ks < 4; ++ks) {
                    const bf16x8 za = *(const LAS bf16x8*)&GDb[ln * 136 + ks * 32 + 8 * lg], zb = *(const LAS bf16x8*)&WTg[(16 * nt + ln) * 136 + ks * 32 + 8 * lg];
                    cg_ = __builtin_amdgcn_mfma_f32_16x16x32_bf16(za, zb, cg_, 0, 0, 0);
                }
#pragma unroll
                for (int r = 0; r < 4; ++r) Gg[(4 * lg + r) * 64 + chm] = cg_[r];
            }
            LDS_BAR();
        } else {
            LAS float* A_ = RW_ARR(bufc, 0); LAS float* WR = RW_ARR(bufc, 1); LAS float* Wd = RW_ARR(bufc, 2); LAS float* Bv = RW_ARR(bufc, 3);
            LAS float* Kk = RW_ARR(bufc, 4); LAS float* Vv = RW_ARR(bufc, 5); LAS float* Yy = RW_ARR(bufc, 7); LAS float* SC = RW_SC(bufc);
#pragma unroll 1
            for (int q4 = 0; q4 < 4; ++q4) {
                if (i >= 0) {
                    float yv[8];
#pragma unroll
                    for (int s4 = 0; s4 < 4; ++s4) {
                        const int tt = 4 * q4 + s4;
                        const f32x4 a_lo = *(const LAS f32x4*)&A_[tt * 64 + 8 * jg], a_hi = *(const LAS f32x4*)&A_[tt * 64 + 8 * jg + 4];
                        const f32x4 r_lo = *(const LAS f32x4*)&WR[tt * 64 + 8 * jg], r_hi = *(const LAS f32x4*)&WR[tt * 64 + 8 * jg + 4];
                        const f32x4 w_lo = *(const LAS f32x4*)&Wd[tt * 64 + 8 * jg], w_hi = *(const LAS f32x4*)&Wd[tt * 64 + 8 * jg + 4];
                        const f32x4 b_lo = *(const LAS f32x4*)&Bv[tt * 64 + 8 * jg], b_hi = *(const LAS f32x4*)&Bv[tt * 64 + 8 * jg + 4];
                        const f32x4 k_lo = *(const LAS f32x4*)&Kk[tt * 64 + 8 * jg], k_hi = *(const LAS f32x4*)&Kk[tt * 64 + 8 * jg + 4];
                        const f32x2 vv = *(const LAS f32x2*)&Vv[tt * 64 + i0];
                        const f32x2 sc = *(const LAS f32x2*)&SC[tt * 4];
                        const f32x2 av[4] = {{a_lo.x, a_lo.y}, {a_lo.z, a_lo.w}, {a_hi.x, a_hi.y}, {a_hi.z, a_hi.w}};
                        const f32x2 rv[4] = {{r_lo.x, r_lo.y}, {r_lo.z, r_lo.w}, {r_hi.x, r_hi.y}, {r_hi.z, r_hi.w}};
                        const f32x2 wv[4] = {{w_lo.x, w_lo.y}, {w_lo.z, w_lo.w}, {w_hi.x, w_hi.y}, {w_hi.z, w_hi.w}};
                        const f32x2 bv[4] = {{b_lo.x, b_lo.y}, {b_lo.z, b_lo.w}, {b_hi.x, b_hi.y}, {b_hi.z, b_hi.w}};
                        const f32x2 kv[4] = {{k_lo.x, k_lo.y}, {k_lo.z, k_lo.w}, {k_hi.x, k_hi.y}, {k_hi.z, k_hi.w}};
                        f32x2 e10 = S0[0] * av[0], e20 = S0[0] * rv[0], e11 = S1[0] * av[0], e21 = S1[0] * rv[0];
#pragma unroll
                        for (int j = 1; j < 4; ++j) { e10 += S0[j] * av[j]; e20 += S0[j] * rv[j]; e11 += S1[j] * av[j]; e21 += S1[j] * rv[j]; }
                        const float d10 = red8(e10.x + e10.y), d11 = red8(e11.x + e11.y);
                        yv[2 * s4] = (e20.x + e20.y) + (jg == 0 ? d10 * sc.x + vv.x * sc.y : 0.f); yv[2 * s4 + 1] = (e21.x + e21.y) + (jg == 0 ? d11 * sc.x + vv.y * sc.y : 0.f);
                        const f32x2 d10v = (f32x2){d10, d10}, d11v = (f32x2){d11, d11}, v0v = (f32x2){vv.x, vv.x}, v1v = (f32x2){vv.y, vv.y};
#pragma unroll
                        for (int j = 0; j < 4; ++j) { S0[j] = S0[j] * wv[j] + (d10v * bv[j] + v0v * kv[j]); S1[j] = S1[j] * wv[j] + (d11v * bv[j] + v1v * kv[j]); }
                    }
                    {
                        const bool t2 = (jg & 4) != 0, t1 = (jg & 2) != 0, t0 = (jg & 1) != 0;
#pragma unroll
                        for (int q = 0; q < 4; ++q) { const float keep = t2 ? yv[q + 4] : yv[q], send = t2 ? yv[q] : yv[q + 4]; yv[q] = keep + dpp_mov<0x141>(send); }
#pragma unroll
                        for (int q = 0; q < 2; ++q) { const float keep = t1 ? yv[q + 2] : yv[q], send = t1 ? yv[q] : yv[q + 2]; yv[q] = keep + dpp_mov<0x4E>(send); }
                        { const float keep = t0 ? yv[1] : yv[0], send = t0 ? yv[0] : yv[1]; yv[0] = keep + dpp_mov<0xB1>(send); }
                        Yy[(4 * q4 + (jg >> 1)) * 64 + i0 + (jg & 1)] = yv[0];
                    }

#if PROBE_SCAN2
                    {
#pragma unroll
                    for (int s4 = 0; s4 < 4; ++s4) {
                        const int tt = 4 * q4 + s4;
                        const f32x4 a_lo = *(const LAS f32x4*)&A_[tt * 64 + 8 * jg], a_hi = *(const LAS f32x4*)&A_[tt * 64 + 8 * jg + 4];
                        const f32x4 r_lo = *(const LAS f32x4*)&WR[tt * 64 + 8 * jg], r_hi = *(const LAS f32x4*)&WR[tt * 64 + 8 * jg + 4];
                        const f32x4 w_lo = *(const LAS f32x4*)&Wd[tt * 64 + 8 * jg], w_hi = *(const LAS f32x4*)&Wd[tt * 64 + 8 * jg + 4];
                        const f32x4 b_lo = *(const LAS f32x4*)&Bv[tt * 64 + 8 * jg], b_hi = *(const LAS f32x4*)&Bv[tt * 64 + 8 * jg + 4];
                        const f32x4 k_lo = *(const LAS f32x4*)&Kk[tt * 64 + 8 * jg], k_hi = *(const LAS f32x4*)&Kk[tt * 64 + 8 * jg + 4];
                        const f32x2 vv = *(const LAS f32x2*)&Vv[tt * 64 + i0];
                        const f32x2 av[4] = {{a_lo.x, a_lo.y}, {a_lo.z, a_lo.w}, {a_hi.x, a_hi.y}, {a_hi.z, a_hi.w}};
                        const f32x2 rv[4] = {{r_lo.x, r_lo.y}, {r_lo.z, r_lo.w}, {r_hi.x, r_hi.y}, {r_hi.z, r_hi.w}};
                        const f32x2 wv[4] = {{w_lo.x, w_lo.y}, {w_lo.z, w_lo.w}, {w_hi.x, w_hi.y}, {w_hi.z, w_hi.w}};
                        const f32x2 bv[4] = {{b_lo.x, b_lo.y}, {b_lo.z, b_lo.w}, {b_hi.x, b_hi.y}, {b_hi.z, b_hi.w}};
                        const f32x2 kv[4] = {{k_lo.x, k_lo.y}, {k_lo.z, k_lo.w}, {k_hi.x, k_hi.y}, {k_hi.z, k_hi.w}};
                        f32x2 e10 = T0[0] * av[0], e20 = T0[0] * rv[0], e11 = T1[0] * av[0], e21 = T1[0] * rv[0];
#pragma unroll
                        for (int j = 1; j < 4; ++j) { e10 += T0[j] * av[j]; e20 += T0[j] * rv[j]; e11 += T1[j] * av[j]; e21 += T1[j] * rv[j]; }
                        const float d10 = red8(e10.x + e10.y), d20 = red8(e20.x + e20.y), d11 = red8(e11.x + e11.y), d21 = red8(e21.x + e21.y);
                        const f32x2 d10v = (f32x2){d10 + d20, d10}, d11v = (f32x2){d11 + d21, d11}, v0v = (f32x2){vv.x, vv.x}, v1v = (f32x2){vv.y, vv.y};
#pragma unroll
                        for (int j = 0; j < 4; ++j) { T0[j] = T0[j] * wv[j] + (d10v * bv[j] + v0v * kv[j]); T1[j] = T1[j] * wv[j] + (d11v * bv[j] + v1v * kv[j]); }
                    }
                    }
#endif
                }
                if (q4 & 1) LDS_BAR();
            }
        }
            }
    }
    if (helper) {
        const int bufl = (RW_NCH - 1) & 1;
        LAS float* Yy = RW_ARR(bufl, 7); LAS float* Gg = RW_ARR(bufl, 6); LAS float* Vv = RW_ARR(bufl, 5); LAS float* SC = RW_SC(bufl);
        const f32x4 y = *(const LAS f32x4*)&Yy[tt_h * 64 + cg4], gg = *(const LAS f32x4*)&Gg[tt_h * 64 + cg4], vv = *(const LAS f32x4*)&Vv[tt_h * 64 + cg4];
        const float bonus = BON[((RW_NCH - 1) % 3) * 16 + tt_h];
        const float mean = red16((y.x + y.y) + (y.z + y.w)) * (1.f / 64.f);
        const f32x4 d = y - mean;
        const float var = red16((d.x * d.x + d.y * d.y) + (d.z * d.z + d.w * d.w)) * (1.f / 64.f);
        const float rs = 1.f / sqrtf(var + 64e-5f);
        const f32x4 o = (d * rs * p_gg + p_gb + vv * bonus) * gg;
        u32x2 w; w.x = pk2(o.x, o.y); w.y = pk2(o.z, o.w);
        *(u32x2*)(X.P + ((size_t)b * SEQ + (RW_NCH - 1) * RW_TS + tt_h) * LDP + COL_YA + h * 64 + cg4) = w;
    }
    __syncthreads();
#undef RW_ARR
#undef RW_SC
#undef RW_LOAD
}

__device__ __forceinline__ void hgrn_task(const Ctx& X, LAS unsigned char* lds, int layer, int b, int h, int vh) {
    LAS float* F = (LAS float*)(lds); LAS float* Q = (LAS float*)(lds + 16384); LAS float* Vv = (LAS float*)(lds + 32768); LAS float* O = (LAS float*)(lds + 40960);
    LAS float* LB = (LAS float*)(lds + 49152);
    const int tid = X.tid;
    const float* lbl = X.in[14];
    const int rp = tid >> 4, dg = tid & 15, v0 = 2 * rp;
    if (tid < 128) LB[tid] = (layer > 0) ? 1.f / (1.f + __expf(lbl[h * 128 + tid] - lbl[512 + h * 128 + tid])) : 0.f;
    f32x2 S0[4], S1[4];
#pragma unroll
    for (int j = 0; j < 4; ++j) { S0[j] = (f32x2){0.f, 0.f}; S1[j] = (f32x2){0.f, 0.f}; }
#define HG_LOAD(chk) do { _Pragma("unroll") for (int it = 0; it < 3; ++it) { const int idx = tid + 512 * it; raw[it] = (u32x4){0u, 0u, 0u, 0u}; \
        if (idx < 32 * 40) { const int tt = idx / 40, vv = idx - tt * 40; \
            const int col = vv < 16 ? 512 + h * 128 + 8 * vv : (vv < 32 ? h * 128 + 8 * (vv - 16) : 1024 + h * 128 + vh * 64 + 8 * (vv - 32)); \
            raw[it] = *(const u32x4*)(X.P + ((size_t)b * SEQ + (chk) * 32 + tt) * LDP + COL_PB + col); } } } while (0)
    u32x4 raw[3];
    HG_LOAD(0);
    __syncthreads();
#pragma unroll 1
    for (int ch = 0; ch < SEQ / 32; ++ch) {
        const int t0 = ch * 32;
#pragma unroll
        for (int it = 0; it < 3; ++it) {
            const int idx = tid + 512 * it;
            if (idx < 32 * 40) {
                const int tt = idx / 40, vv = idx - tt * 40;
                float x[8];
                x[0] = bflo(raw[it].x); x[1] = bfhi(raw[it].x); x[2] = bflo(raw[it].y); x[3] = bfhi(raw[it].y);
                x[4] = bflo(raw[it].z); x[5] = bfhi(raw[it].z); x[6] = bflo(raw[it].w); x[7] = bfhi(raw[it].w);
                LAS float* dst;
                if (vv < 16) {
                    dst = F + tt * 128 + 8 * vv;
#pragma unroll
                    for (int e = 0; e < 8; ++e) { const float lb = LB[8 * vv + e]; x[e] = lb + (1.f - lb) * sigmoidf_(x[e]); }
                } else if (vv < 32) dst = Q + tt * 128 + 8 * (vv - 16);
                else dst = Vv + tt * 64 + 8 * (vv - 32);
                *(LAS f32x4*)dst = (f32x4){x[0], x[1], x[2], x[3]}; *(LAS f32x4*)(dst + 4) = (f32x4){x[4], x[5], x[6], x[7]};
            }
        }
        if (ch + 1 < SEQ / 32) HG_LOAD(ch + 1);
        LDS_BAR();
#pragma unroll 1
        for (int g8 = 0; g8 < 4; ++g8) {
            float val[16];
#pragma unroll
            for (int s8 = 0; s8 < 8; ++s8) {
                const int tt = 8 * g8 + s8;
                const f32x4 f_lo = *(const LAS f32x4*)&F[tt * 128 + 8 * dg], f_hi = *(const LAS f32x4*)&F[tt * 128 + 8 * dg + 4];
                const f32x4 q_lo = *(const LAS f32x4*)&Q[tt * 128 + 8 * dg], q_hi = *(const LAS f32x4*)&Q[tt * 128 + 8 * dg + 4];
                const f32x2 vv = *(const LAS f32x2*)&Vv[tt * 64 + v0];
                const f32x2 f2[4] = {{f_lo.x, f_lo.y}, {f_lo.z, f_lo.w}, {f_hi.x, f_hi.y}, {f_hi.z, f_hi.w}};
                const f32x2 q2[4] = {{q_lo.x, q_lo.y}, {q_lo.z, q_lo.w}, {q_hi.x, q_hi.y}, {q_hi.z, q_hi.w}};
                const f32x2 v0v = (f32x2){vv.x, vv.x}, v1v = (f32x2){vv.y, vv.y};
                f32x2 a0 = (f32x2){0.f, 0.f}, a1 = (f32x2){0.f, 0.f};
#pragma unroll
                for (int j = 0; j < 4; ++j) {
                    S0[j] = v0v + f2[j] * (S0[j] - v0v); S1[j] = v1v + f2[j] * (S1[j] - v1v);
                    a0 += q2[j] * S0[j]; a1 += q2[j] * S1[j];
                }
                val[2 * s8] = a0.x + a0.y; val[2 * s8 + 1] = a1.x + a1.y;
            }
            const bool b3 = (dg & 8) != 0, b2 = (dg & 4) != 0, b1 = (dg & 2) != 0, b0 = (dg & 1) != 0;
#pragma unroll
            for (int i = 0; i < 8; ++i) { const float keep = b3 ? val[i + 8] : val[i], send = b3 ? val[i] : val[i + 8]; val[i] = keep + dpp_mov<0x140>(send); }
#pragma unroll
            for (int i = 0; i < 4; ++i) { const float keep = b2 ? val[i + 4] : val[i], send = b2 ? val[i] : val[i + 4]; val[i] = keep + dpp_mov<0x141>(send); }
#pragma unroll
            for (int i = 0; i < 2; ++i) { const float keep = b1 ? val[i + 2] : val[i], send = b1 ? val[i] : val[i + 2]; val[i] = keep + dpp_mov<0x4E>(send); }
            { const float keep = b0 ? val[1] : val[0], send = b0 ? val[0] : val[1]; val[0] = keep + dpp_mov<0xB1>(send); }
            O[(8 * g8 + (dg >> 1)) * 64 + v0 + (dg & 1)] = val[0];
        }
        LDS_BAR();
        if (tid < 256) {
            const int tt = tid >> 3, v8 = (tid & 7) * 8;
            const f32x4 a = *(const LAS f32x4*)&O[tt * 64 + v8], c4 = *(const LAS f32x4*)&O[tt * 64 + v8 + 4];
            u32x4 o; o.x = pk2(a.x, a.y); o.y = pk2(a.z, a.w); o.z = pk2(c4.x, c4.y); o.w = pk2(c4.z, c4.w);
            *(u32x4*)(X.P + ((size_t)b * SEQ + t0 + tt) * LDP + COL_YB + h * 128 + vh * 64 + v8) = o;
        }
    }
#undef HG_LOAD
    __syncthreads();
}

__device__ __forceinline__ unsigned f2ord(float f) { const unsigned u = __builtin_bit_cast(unsigned, f); return (u & 0x80000000u) ? ~u : (u | 0x80000000u); }

__device__ __forceinline__ void dsa_tile(const Ctx& X, LAS unsigned char* lds, int b, int q0) {
    LAS float* sc = (LAS float*)lds;
    LAS unsigned* MASK = (LAS unsigned*)(lds + MASK_OFF);
    const int lane = X.lane, w = X.wave, n = lane & 15, g = lane >> 4;
    const bf16_t* Pb = X.P + (size_t)b * SEQ * LDP;
#pragma unroll 1
    for (int sub = 0; sub < 4; ++sub) {
        const int qs = q0 + 16 * sub;
        {
            bf16x8 bq[4][2]; float wi[4];
            const bf16_t* qrow = Pb + (size_t)(qs + n) * LDP;
#pragma unroll
            for (int hh = 0; hh < 4; ++hh) {
#pragma unroll
                for (int ks = 0; ks < 2; ++ks) bq[hh][ks] = *(const bf16x8*)(qrow + C_QI + hh * 64 + ks * 32 + 8 * g);
                wi[hh] = bf2f(qrow[C_WI + hh]);
            }
            const int nkt = (qs + 16) >> 4;
            bf16x8 a0n = (bf16x8){0, 0, 0, 0, 0, 0, 0, 0}, a1n = a0n;
            if (w < nkt) { const bf16_t* krow = Pb + (size_t)(w * 16 + n) * LDP + C_KI; a0n = *(const bf16x8*)(krow + 8 * g); a1n = *(const bf16x8*)(krow + 32 + 8 * g); }
#pragma unroll 1
            for (int kt = w; kt < nkt; kt += 8) {
                const bf16x8 a0 = a0n, a1 = a1n;
                if (kt + 8 < nkt) { const bf16_t* krow = Pb + (size_t)((kt + 8) * 16 + n) * LDP + C_KI; a0n = *(const bf16x8*)(krow + 8 * g); a1n = *(const bf16x8*)(krow + 32 + 8 * g); }
                f32x4 s = (f32x4){0.f, 0.f, 0.f, 0.f};
#pragma unroll
                for (int hh = 0; hh < 4; ++hh) {
                    f32x4 d = __builtin_amdgcn_mfma_f32_16x16x32_bf16(a0, bq[hh][0], (f32x4){0.f, 0.f, 0.f, 0.f}, 0, 0, 0);
                    d = __builtin_amdgcn_mfma_f32_16x16x32_bf16(a1, bq[hh][1], d, 0, 0, 0);
#pragma unroll
                    for (int r = 0; r < 4; ++r) s[r] += wi[hh] * fmaxf(d[r], 0.f);
                }
                const int t = qs + n;
#pragma unroll
                for (int r = 0; r < 4; ++r) if (kt * 16 + 4 * g + r > t) s[r] = -INFINITY;
                *(LAS f32x4*)&sc[n * SCS + kt * 16 + 4 * g] = s;
            }
        }
        __syncthreads();
#pragma unroll 1
        for (int e = 0; e < 2; ++e) {
            const int qn = 2 * w + e, t = qs + qn;
            LAS unsigned* mrow = MASK + (sub * 16 + qn) * 64;
            if (t < 256) {
#pragma unroll
                for (int j = 0; j < 32; ++j) {
                    const unsigned long long sm = __ballot(j * 64 + lane <= t);
                    if (lane == 0) { mrow[2 * j] = (unsigned)sm; mrow[2 * j + 1] = (unsigned)(sm >> 32); }
                }
            } else {
                const int jn = (t >> 6) + 1;
                unsigned u[32];
#pragma unroll
                for (int j = 0; j < 32; ++j) {
                    u[j] = 0u;
                    if (j < jn) { const int key = j * 64 + lane; const float s = (key <= t) ? sc[qn * SCS + key] : -INFINITY; u[j] = f2ord(s); }
                }
                unsigned prefix = 0u;
#define DSA_BITSEARCH(JN) do { _Pragma("unroll 1") for (int bit = 31; bit >= 0; --bit) { const unsigned cand = prefix | (1u << bit); int c0 = 0, c1 = 0; \
                    _Pragma("unroll") for (int j = 0; j < (JN); j += 2) { c0 += (u[j] >= cand) ? 1 : 0; c1 += (u[j + 1] >= cand) ? 1 : 0; } \
                    const int cnt = (int)wave_sum_fast((float)(c0 + c1)); if (cnt >= 256) prefix = cand; } } while (0)
                if (jn <= 8) DSA_BITSEARCH(8); else if (jn <= 16) DSA_BITSEARCH(16); else if (jn <= 24) DSA_BITSEARCH(24); else DSA_BITSEARCH(32);
#undef DSA_BITSEARCH
                int cg_ = 0;
#pragma unroll
                for (int j = 0; j < 32; ++j) if (j < jn) cg_ += __popcll(__ballot(u[j] > prefix));
                const int need = 256 - cg_;
                int cum = 0;
#pragma unroll
                for (int j = 0; j < 32; ++j) {
                    unsigned long long sm = 0ull;
                    if (j < jn) {
                        const bool eq = (u[j] == prefix);
                        const unsigned long long em = __ballot(eq);
                        const int rank = cum + (int)__builtin_amdgcn_mbcnt_hi((unsigned)(em >> 32), __builtin_amdgcn_mbcnt_lo((unsigned)em, 0u));
                        const bool sel = (u[j] > prefix) || (eq && rank < need);
                        sm = __ballot(sel);
                        cum += __popcll(em);
                    }
                    if (lane == 0) { mrow[2 * j] = (unsigned)sm; mrow[2 * j + 1] = (unsigned)(sm >> 32); }
                }
            }
        }
        __syncthreads();
    }
    const int qq = q0 + 8 * w + (n & 7);
    const LAS unsigned* mq = MASK + (8 * w + (n & 7)) * 64;
    const int nsteps = (q0 + 8 * w + 8 + 31) >> 5;
    const int nblk = (q0 + 64 + 127) >> 7;
    LAS bf16_t* KT = (LAS bf16_t*)lds;
    LAS bf16_t* VTT = (LAS bf16_t*)(lds + 36864);
    const int tid = X.tid;
#pragma unroll 1
    for (int c = 0; c < 2; ++c) {
        bf16x8 bq[2][2];
#pragma unroll
        for (int j = 0; j < 2; ++j)
#pragma unroll
            for (int ks = 0; ks < 2; ++ks) bq[j][ks] = *(const bf16x8*)(Pb + (size_t)qq * LDP + C_Q + (c * 4 + 2 * j + (n >> 3)) * 64 + ks * 32 + 8 * g);
        float lrun[2] = {0.f, 0.f};
        f32x4 oacc[4][2];
#pragma unroll
        for (int mt = 0; mt < 4; ++mt)
#pragma unroll
            for (int j = 0; j < 2; ++j) oacc[mt][j] = (f32x4){0.f, 0.f, 0.f, 0.f};
        const bf16_t* vtb = X.VT + ((size_t)(b * 2 + c) * 64) * SEQ;
        u32x4 gk[2], gv[2];
#define DSA_GLOAD(kblk) do { _Pragma("unroll") for (int it = 0; it < 2; ++it) { const int idx = tid + 512 * it; \
            gk[it] = *(const u32x4*)(Pb + (size_t)((kblk) * 128 + (idx >> 3)) * LDP + C_K + c * 64 + (idx & 7) * 8); \
            gv[it] = *(const u32x4*)(vtb + (size_t)(idx >> 4) * SEQ + (kblk) * 128 + (idx & 15) * 8); } } while (0)
#define DSA_LSTORE(bufi) do { _Pragma("unroll") for (int it = 0; it < 2; ++it) { const int idx = tid + 512 * it; \
            *(LAS u32x4*)(KT + (bufi) * 9216 + (idx >> 3) * 72 + (idx & 7) * 8) = gk[it]; \
            *(LAS u32x4*)(VTT + (bufi) * 8704 + (idx >> 4) * 136 + (idx & 15) * 8) = gv[it]; } } while (0)
        DSA_GLOAD(0);
        LDS_BAR();
        DSA_LSTORE(0);
        LDS_BAR();
#pragma unroll 1
        for (int kb = 0; kb < nblk; ++kb) {
            const int buf = kb & 1;
            if (kb + 1 < nblk) DSA_GLOAD(kb + 1);
            const LAS bf16_t* Kb = KT + buf * 9216; const LAS bf16_t* Vb = VTT + buf * 8704;
#pragma unroll 1
            for (int sl = 0; sl < 4; ++sl) {
                const int sg = kb * 4 + sl;
                if (sg < nsteps) {
                    f32x4 st[2][2];
#pragma unroll
                    for (int tl = 0; tl < 2; ++tl) {
                        const LAS bf16_t* kr = Kb + (32 * sl + 16 * tl + n) * 72;
                        const bf16x8 a0 = *(const LAS bf16x8*)(kr + 8 * g), a1 = *(const LAS bf16x8*)(kr + 32 + 8 * g);
#pragma unroll
                        for (int j = 0; j < 2; ++j) {
                            f32x4 d = __builtin_amdgcn_mfma_f32_16x16x32_bf16(a0, bq[j][0], (f32x4){0.f, 0.f, 0.f, 0.f}, 0, 0, 0);
                            st[tl][j] = __builtin_amdgcn_mfma_f32_16x16x32_bf16(a1, bq[j][1], d, 0, 0, 0);
                        }
                    }
                    bf16x8 av[4];
#pragma unroll
                    for (int mt = 0; mt < 4; ++mt) {
                        const LAS bf16_t* vp = Vb + (mt * 16 + n) * 136 + 32 * sl + 4 * g;
                        const u32x2 lo = *(const LAS u32x2*)vp, hi = *(const LAS u32x2*)(vp + 16);
                        u32x4 t4; t4.x = lo.x; t4.y = lo.y; t4.z = hi.x; t4.w = hi.y;
                        av[mt] = __builtin_bit_cast(bf16x8, t4);
                    }
                    const unsigned mw = mq[sg];
#pragma unroll
                    for (int j = 0; j < 2; ++j) {
                        float p[8], ps = 0.f;
#pragma unroll
                        for (int tl = 0; tl < 2; ++tl)
#pragma unroll
                            for (int r = 0; r < 4; ++r) { const int bit = 16 * tl + 4 * g + r; const float e = __expf(fminf(st[tl][j][r] * 0.125f, 60.f)); p[4 * tl + r] = ((mw >> bit) & 1u) ? e : 0.f; ps += p[4 * tl + r]; }
                        lrun[j] += ps;
                        u32x4 pw; pw.x = pg8::cvt_pk_bf16(p[0], p[1]); pw.y = pg8::cvt_pk_bf16(p[2], p[3]); pw.z = pg8::cvt_pk_bf16(p[4], p[5]); pw.w = pg8::cvt_pk_bf16(p[6], p[7]);
                        const bf16x8 pb = __builtin_bit_cast(bf16x8, pw);
#pragma unroll
                        for (int mt = 0; mt < 4; ++mt) oacc[mt][j] = __builtin_amdgcn_mfma_f32_16x16x32_bf16(av[mt], pb, oacc[mt][j], 0, 0, 0);
                    }
                }
            }
            if (kb + 1 < nblk) DSA_LSTORE(buf ^ 1);
            LDS_BAR();
        }
#pragma unroll
        for (int j = 0; j < 2; ++j) {
            float lt = lrun[j]; lt += __shfl_xor(lt, 16); lt += __shfl_xor(lt, 32);
            const float il = 1.f / lt;
            bf16_t* op = X.P + ((size_t)b * SEQ + qq) * LDP + COL_YC + (c * 4 + 2 * j + (n >> 3)) * 64 + 4 * g;
#pragma unroll
            for (int mt = 0; mt < 4; ++mt) {
                const f32x4 o = oacc[mt][j] * il;
                u32x2 wv; wv.x = pg8::cvt_pk_bf16(o[0], o[1]); wv.y = pg8::cvt_pk_bf16(o[2], o[3]);
                *(u32x2*)(op + mt * 16) = wv;
            }
        }
    }
#undef DSA_GLOAD
#undef DSA_LSTORE
    __syncthreads();
}

__device__ __forceinline__ void phase_mixers(const Ctx& X0, LAS unsigned char* lds, int layer) {
#pragma unroll 1
    for (int task = X0.bid; task < 128; task += X0.G) {
        Ctx X = X0;
        { int t_ = threadIdx.x; asm volatile("" : "+v"(t_)); X.tid = t_; X.lane = t_ & 63; }
        if (task < 64) { if (TKMASK & 1) rwkv_task(X, lds, layer, task >> 3, task & 7); }
        else { const int k = task - 64; if (TKMASK & 2) hgrn_task(X, lds, layer, k >> 3, (k >> 1) & 3, k & 1); }
    }
    volatile LAS unsigned* tw = (volatile LAS unsigned*)(lds + LDS_BYTES - 128);
    unsigned* ctr = (unsigned*)(X0.ws + WS_BAR + 14336) + 16 * layer;
#pragma unroll 1
    for (;;) {
        Ctx X = X0;
        { int t_ = threadIdx.x; asm volatile("" : "+v"(t_)); X.tid = t_; X.lane = t_ & 63; }
        __syncthreads();
        if (threadIdx.x == 0) tw[0] = __hip_atomic_fetch_add(ctr, 1u, __ATOMIC_RELAXED, __HIP_MEMORY_SCOPE_AGENT);
        __syncthreads();
        const int t = (int)tw[0];
        if (t >= 256) break;
        if (TKMASK & 4) dsa_tile(X, lds, t & 7, 64 * (31 - (t >> 3)));
    }
}

__device__ __forceinline__ void phase_hgrn_post(const Ctx& X, int layer) {
    const int gw = X.bid * 8 + X.wave, NGW = X.G * 8;
    const float* gn = X.in[15] + layer * 512;
#pragma unroll 1
    for (int it0 = gw; it0 < T_TOK * 4; it0 += 4 * NGW) {
        unsigned ow[4], gwd[4]; unsigned* op[4];
#pragma unroll
        for (int r = 0; r < 4; ++r) {
            const int it = it0 + r * NGW < T_TOK * 4 ? it0 + r * NGW : it0;
            const int t = it >> 2, h = it & 3;
            bf16_t* rowp = X.P + (size_t)t * LDP;
            op[r] = (unsigned*)(rowp + COL_YB + h * 128) + X.lane;
            ow[r] = *op[r]; gwd[r] = *((const unsigned*)(rowp + COL_PB + 1536 + h * 128) + X.lane);
        }
#pragma unroll
        for (int r = 0; r < 4; ++r) {
            const int it = it0 + r * NGW;
            const int h = it & 3;
            const float o0 = bflo(ow[r]), o1 = bfhi(ow[r]), g0 = bflo(gwd[r]), g1 = bfhi(gwd[r]);
            const float rs = 1.f / sqrtf(wave_sum(o0 * o0 + o1 * o1) * (1.f / 128.f) + 1e-6f);
            const float y0 = o0 * rs * gn[h * 128 + 2 * X.lane] * (g0 * sigmoidf_(g0)), y1 = o1 * rs * gn[h * 128 + 2 * X.lane + 1] * (g1 * sigmoidf_(g1));
            if (it < T_TOK * 4) *op[r] = pk2(y0, y1);
        }
    }
}

__device__ __forceinline__ void phase_fixup(const Ctx& X, int layer) {
    const float* cw = X.in[20] + (size_t)layer * 3 * F2; const float* cb = X.in[21] + (size_t)layer * F2;
#pragma unroll 4
    for (int idx = X.bid * 512 + X.tid; idx < 256 * 2 * DFF; idx += X.G * 512) {
        const int j = idx % DFF, sr = idx / DFF, s = sr >> 1, r = sr & 1;
        const int colg = (j >> 7) * 256 + (j & 127), colv = colg + 128;
        const bool seq0 = (s & 31) == 0;
        const float* H = X.HALO;
        float res[2];
#pragma unroll
        for (int part = 0; part < 2; ++part) {
            const int cp = part ? colv : colg, co = part * DFF + j;
            const float u0 = H[(size_t)(s * 4 + r) * F2 + cp];
            float u1, u2;
            if (r == 0) { u1 = seq0 ? 0.f : H[(size_t)((s - 1) * 4 + 3) * F2 + cp]; u2 = seq0 ? 0.f : H[(size_t)((s - 1) * 4 + 2) * F2 + cp]; }
            else { u1 = H[(size_t)(s * 4 + 0) * F2 + cp]; u2 = seq0 ? 0.f : H[(size_t)((s - 1) * 4 + 3) * F2 + cp]; }
            res[part] = cb[co] + cw[co] * u2 + cw[F2 + co] * u1 + cw[2 * F2 + co] * u0;
        }
        const float a = res[0] * sigmoidf_(res[0]) * res[1];
        X.P[(size_t)(s * 64 + r) * LDP + COL_ACT + j] = (bf16_t)f2bf(a);
    }
}

#define XB_TMO      128
#define XB_XCNT(j)  (256  + 64 * (j))
#define XB_XSUB(j)  (1280 + 64 * (j))
#define XB_XGEN(j)  (2304 + 64 * (j))
#define XB_TOP      3328
#define XB_TOPGEN   3392
#define XCD_BAR_WORDS 3456
#define XB_SPIN_CAP (1u << 22)
__device__ __forceinline__ unsigned xb_ld(unsigned* p)              { return __hip_atomic_load(p, __ATOMIC_RELAXED, __HIP_MEMORY_SCOPE_AGENT); }
__device__ __forceinline__ unsigned xb_add(unsigned* p, unsigned v) { return __hip_atomic_fetch_add(p, v, __ATOMIC_RELAXED, __HIP_MEMORY_SCOPE_AGENT); }
__device__ __forceinline__ unsigned xb_xcc_id() { return (unsigned)__builtin_amdgcn_s_getreg((3 << 11) | 20) & 0xFu; }
#define XB_SPIN(cond, bar) do { unsigned _sp = 0; while (cond) { __builtin_amdgcn_s_sleep(1); \
    if ((++_sp & 255u) == 0u) { if (xb_ld(&(bar)[XB_TMO])) break; if (_sp > XB_SPIN_CAP) { atomicAdd(&(bar)[XB_TMO], 1u); break; } } } } while (0)
struct XcdBarrier { unsigned* bar; unsigned x; volatile LAS unsigned* st; };
__device__ __forceinline__ XcdBarrier xcd_barrier_post(unsigned* bar, volatile LAS unsigned* st) {
    XcdBarrier b; b.bar = bar; b.x = xb_xcc_id(); b.st = st;
    if (threadIdx.x == 0) (void)xb_add(&bar[XB_XCNT(b.x)], 1u);
    return b;
}
__device__ __forceinline__ void xcd_barrier_complete(unsigned* bar, unsigned x, unsigned& nloc, unsigned& nx) {
    const unsigned G = gridDim.x * gridDim.y * gridDim.z;
    unsigned sum, cnt, mine, sp = 0u;
    for (;;) {
        sum = 0u; cnt = 0u; mine = 0u;
#pragma unroll
        for (unsigned j = 0; j < 16; ++j) { const unsigned c = xb_ld(&bar[XB_XCNT(j)]); sum += c; cnt += (c > 0u) ? 1u : 0u; mine = (j == x) ? c : mine; }
        if (sum == G) break;
        __builtin_amdgcn_s_sleep(1);
        if ((++sp & 255u) == 0u) { if (xb_ld(&bar[XB_TMO])) break; if (sp > XB_SPIN_CAP) { atomicAdd(&bar[XB_TMO], 1u); break; } }
    }
    nloc = mine > 0u ? mine : 1u; nx = cnt > 0u ? cnt : 1u;
}
__device__ __forceinline__ void xcd_barrier(const XcdBarrier& b) {
    asm volatile("s_waitcnt vmcnt(0)" ::: "memory");
    __syncthreads();
    if (threadIdx.x == 0) {
        unsigned* bar = b.bar;
        __builtin_amdgcn_s_waitcnt(0);
        unsigned nloc = b.st[0], nx = b.st[1];
        if (nloc == 0u) { xcd_barrier_complete(bar, b.x, nloc, nx); b.st[0] = nloc; b.st[1] = nx; }
        const unsigned old = xb_add(&bar[XB_XSUB(b.x)], 1u);
        const unsigned gen = old / nloc;
        if (old + 1u == (gen + 1u) * nloc) {
            __builtin_amdgcn_fence(__ATOMIC_RELEASE, "agent");
            asm volatile("s_waitcnt vmcnt(0)" ::: "memory");
            const unsigned og = xb_add(&bar[XB_TOP], 1u);
            const unsigned tg = og / nx;
            if (og + 1u == (tg + 1u) * nx) xb_add(&bar[XB_TOPGEN], 1u);
            else XB_SPIN(xb_ld(&bar[XB_TOPGEN]) == tg, bar);
            __builtin_amdgcn_fence(__ATOMIC_ACQUIRE, "agent");
            xb_add(&bar[XB_XGEN(b.x)], 1u);
            asm volatile("s_waitcnt vmcnt(0)" ::: "memory");
        } else {
            XB_SPIN(xb_ld(&bar[XB_XGEN(b.x)]) == gen, bar);
            __builtin_amdgcn_fence(__ATOMIC_ACQUIRE, "agent");
            asm volatile("s_waitcnt vmcnt(0)" ::: "memory");
        }
    }
    __syncthreads();
}

__global__ void __launch_bounds__(512, 2) mk_fwd(Args args) {
    extern __shared__ __attribute__((aligned(16))) unsigned char lds_raw[];
    LAS unsigned char* lds = (LAS unsigned char*)lds_raw;
    Ctx X;
#pragma unroll
    for (int i = 0; i < 24; ++i) X.in[i] = args.in[i];
    X.out = args.out; X.ws = args.ws;
    X.P = (bf16_t*)(args.ws + WS_P); X.VT = (bf16_t*)(args.ws + WS_VT); X.HALO = (float*)(args.ws + WS_HALO); X.ROPE = (float*)(args.ws + WS_ROPE);
    X.Win = (bf16_t*)(args.ws + WS_WIN); X.Wg = (bf16_t*)(args.ws + WS_WG); X.Wbr = (bf16_t*)(args.ws + WS_WBR);
    X.Wo = (bf16_t*)(args.ws + WS_WO); X.Wup = (bf16_t*)(args.ws + WS_WUP); X.Wdn = (bf16_t*)(args.ws + WS_WDN);
    X.tid = threadIdx.x; X.lane = X.tid & 63; X.wave = __builtin_amdgcn_readfirstlane(X.tid >> 6); X.G = gridDim.x; X.bid = blockIdx.x;

#if PROBE_DOUBLE
    for (int ph2 = args.ph_lo * 2; ph2 < args.ph_hi * 2; ++ph2) {
        const int ph = ph2 >> 1;
        const int layer = ph / 11, sub = ph % 11;
        const bool skip_ = (ph2 & 1) && !(ph < 22 && ((REPMASK >> sub) & 1));
#else
    volatile LAS unsigned* bst = (volatile LAS unsigned*)(lds + LDS_BYTES - 64);
    if (threadIdx.x < 2) bst[threadIdx.x] = 0u;
    __syncthreads();
    XcdBarrier gbar = xcd_barrier_post((unsigned*)(args.ws + WS_BAR), bst);
    for (int ph = args.ph_lo; ph < args.ph_hi; ++ph) {
        const int layer = ph / 11, sub = ph % 11;
        const bool skip_ = false;
#endif
        const bool fusedn = (X.G == 256) && (args.ph_hi - args.ph_lo > 1);
        if (fusedn && (ph == 22 || sub == 7)) continue;
        { int t_ = threadIdx.x; asm volatile("" : "+v"(t_)); X.tid = t_; X.lane = t_ & 63; }

        if (skip_) {
        } else if (ph == 22 && (PHMASK & 1024)) {
            const int gw = X.bid * 8 + X.wave, NGW = X.G * 8;
            (void)gw; (void)NGW; rms_pass(X, X.out, X.in[23], nullptr, X.out);
        } else if (sub == 0 && (PHMASK & 1)) {
            phase_prep(X, lds, layer, !(fusedn && layer > 0));
        } else if (sub == 1 && (PHMASK & 2)) {
            pg8::Gemm g{X.P, X.Win, LDP, DM, DM}; pg8::StaticOrder S; S.init(T_TOK, 5120, X.G, X.bid);
            pg8::EpiInProj E{X.P, X.VT, X.ROPE, (bf16_t*)(X.ws + WS_BND)};
            pg8::gemm_phase<pg8::EpiInProj, true>(lds, g, S, E, X.tid);
        } else if (sub == 2 && (PHMASK & 4)) {
            phase_rwkv_pre(X, lds, layer);
        } else if (sub == 3 && (PHMASK & 4)) {
            phase_mixers(X, lds, layer);
        } else if (sub == 4 && (PHMASK & 8)) {
            phase_hgrn_post(X, layer);
            { const int gw = X.bid * 8 + X.wave, NGW = X.G * 8; const float* hh = (layer == 0) ? X.in[0] : X.out; const float* g = X.in[1] + (size_t)layer * DM;
              (void)gw; (void)NGW; rms_pass(X, hh, g, X.P, nullptr); }
        } else if (sub == 5 && (PHMASK & 16)) {
#pragma unroll 1
            for (int br = 0; br < 3; ++br) {
                { pg8::Gemm g{X.P, X.Wg + (size_t)br * DM * DM, LDP, DM, DM}; pg8::StaticOrder S; S.init(T_TOK, DM, X.G, X.bid);
                  int t_ = X.tid; asm volatile("" : "+v"(t_));
                  pg8::EpiGate E{X.P}; pg8::gemm_phase<pg8::EpiGate, true>(lds, g, S, E, t_); }
                { const int ycol = br == 0 ? COL_YA : (br == 1 ? COL_YB : COL_YC);
                  pg8::Gemm g{X.P + ycol, X.Wbr + (size_t)br * DM * 512, LDP, 512, 512}; pg8::StaticOrder S; S.init(T_TOK, DM, X.G, X.bid);
                  int t_ = X.tid; asm volatile("" : "+v"(t_));
                  pg8::EpiMergeAcc E{X.P, br == 0 ? 1 : 0}; pg8::gemm_phase<pg8::EpiMergeAcc, true>(lds, g, S, E, t_); }
            }
        } else if (sub == 6 && (PHMASK & 32)) {
            pg8::Gemm g{X.P + COL_MRG, X.Wo, LDP, DM, DM}; pg8::StaticOrder S; S.init(T_TOK, DM, X.G, X.bid);
            if (fusedn) {
                pg8::EpiResidNorm E{layer == 0 ? X.in[0] : X.out, X.out, X.in[18] + (size_t)layer * DM, X.P, nullptr,
                                    (unsigned*)(X.ws + WS_XB) + (size_t)(layer * 2) * 65536, (unsigned*)(X.ws + WS_XC) + (layer * 2) * 4096};
                pg8::gemm_phase<pg8::EpiResidNorm, false>(lds, g, S, E, X.tid);
            } else {
            pg8::EpiResid E{layer == 0 ? X.in[0] : X.out, X.out};
            pg8::gemm_phase<pg8::EpiResid, true>(lds, g, S, E, X.tid);
            }
        } else if (sub == 7 && (PHMASK & 64)) {
            const int gw = X.bid * 8 + X.wave, NGW = X.G * 8;
            const float* g = X.in[18] + (size_t)layer * DM;
            (void)gw; (void)NGW; rms_pass(X, X.out, g, X.P, nullptr);
        } else if (sub == 8 && (PHMASK & 128)) {
            pg8::Gemm g{X.P, X.Wup, LDP, DM, DM}; pg8::StaticOrder S; S.init(T_TOK, F2, X.G, X.bid);
            pg8::EpiUp E{X.P, X.HALO, X.in[20] + (size_t)layer * 3 * F2, X.in[21] + (size_t)layer * F2, (LAS float*)(lds + 131072)};
            pg8::gemm_phase<pg8::EpiUp, true>(lds, g, S, E, X.tid);
        } else if (sub == 9 && (PHMASK & 256)) {
            phase_fixup(X, layer);
        } else if (sub == 10 && (PHMASK & 512)) {
            pg8::Gemm g{X.P + COL_ACT, X.Wdn, LDP, DFF, DFF}; pg8::StaticOrder S; S.init(T_TOK, DM, X.G, X.bid);
            if (fusedn) {
                const bool last = (layer == 1);
                pg8::EpiResidNorm E{X.out, last ? nullptr : X.out, last ? X.in[23] : X.in[1] + (size_t)DM, last ? nullptr : X.P, last ? X.out : nullptr,
                                    (unsigned*)(X.ws + WS_XB) + (size_t)(layer * 2 + 1) * 65536, (unsigned*)(X.ws + WS_XC) + (layer * 2 + 1) * 4096};
                pg8::gemm_phase<pg8::EpiResidNorm, false>(lds, g, S, E, X.tid);
            } else {
            pg8::EpiResid E{X.out, X.out};
            pg8::gemm_phase<pg8::EpiResid, true>(lds, g, S, E, X.tid);
            }
        }
#if PROBE_DOUBLE
        if (ph2 + 1 < args.ph_hi * 2) cg::this_grid().sync();
#else
        if (ph + 1 < args.ph_hi && !(fusedn && ph == 21)) { if (args.ph_hi > 1000) cg::this_grid().sync(); else xcd_barrier(gbar); }
#endif
    }
}

extern "C" void kernel_launch(void* const* d_in, const int* in_sizes, int n_in, void* d_out, int out_size, void* d_ws, size_t ws_size, hipStream_t stream) {
    static int grid = 0;
    if (grid == 0) {
        int dev = 0, cus = 0, per_cu = 0;
        (void)hipGetDevice(&dev);
        (void)hipDeviceGetAttribute(&cus, hipDeviceAttributeMultiprocessorCount, dev);
        if (hipFuncSetAttribute((const void*)mk_fwd, hipFuncAttributeMaxDynamicSharedMemorySize, LDS_BYTES) != hipSuccess) fprintf(stderr, "kernel_launch: hipFuncSetAttribute failed\n");
        if (hipOccupancyMaxActiveBlocksPerMultiprocessor(&per_cu, (const void*)mk_fwd, 512, LDS_BYTES) != hipSuccess || per_cu < 1) { fprintf(stderr, "kernel_launch: occupancy query gave %d\n", per_cu); per_cu = 1; }
        (void)hipGetLastError();
        grid = cus * 1;
        if (grid <= 0) grid = 256;
        if (ws_size < (size_t)268435456) fprintf(stderr, "kernel_launch: workspace too small (%zu)\n", ws_size);
    }
    Args a{};
    for (int i = 0; i < 24; ++i) a.in[i] = (const float*)d_in[i];
    a.out = (float*)d_out; a.ws = (unsigned char*)d_ws;
#if MK_SINGLE
    (void)hipMemsetAsync((char*)d_ws + WS_BAR, 0, 16384 + 65536, stream);
    a.ph_lo = 0; a.ph_hi = 23;
    void* kargs[] = {&a};
    hipError_t e = hipLaunchCooperativeKernel((const void*)mk_fwd, dim3(grid), dim3(512), kargs, LDS_BYTES, stream);
    if (e != hipSuccess) fprintf(stderr, "cooperative launch failed: %s (grid %d)\n", hipGetErrorString(e), grid);
#else
    for (int ph = 0; ph < 23; ++ph) {
        a.ph_lo = ph; a.ph_hi = ph + 1;
        hipLaunchKernelGGL(mk_fwd, dim3(grid), dim3(512), LDS_BYTES, stream, a);
    }
#endif
}
```

```cpp
#include <hip/hip_runtime.h>
#include <hip/hip_cooperative_groups.h>
#include <cstdio>
#include <cstdint>
namespace cg = cooperative_groups;

#ifndef PHMASK
#define PHMASK 2047
#endif
#ifndef REPMASK
#define REPMASK 0
#endif
#ifndef PROBE_DOUBLE
#define PROBE_DOUBLE 0
#endif
#ifndef PROBE_SCAN2
#define PROBE_SCAN2 0
#endif
#ifndef TKMASK
#define TKMASK 7
#endif
#ifndef MK_SINGLE
#define MK_SINGLE 1
#endif

#define LAS __attribute__((address_space(3)))
typedef unsigned short bf16_t;
typedef short bf16x8 __attribute__((ext_vector_type(8)));
typedef float f32x4 __attribute__((ext_vector_type(4)));
typedef float f32x2 __attribute__((ext_vector_type(2)));
typedef unsigned u32x4 __attribute__((ext_vector_type(4)));
typedef unsigned u32x2 __attribute__((ext_vector_type(2)));

constexpr int T_TOK = 16384, SEQ = 2048, DM = 1024;
constexpr int LDP = 6208;
constexpr int COL_PA = 1024, COL_PB = 2816, COL_PC = 4864;
constexpr int COL_YA = 1024, COL_MRG = 1536, COL_G = 2816, COL_YB = 3840, COL_YC = 4864, COL_ACT = 1024;
constexpr int COL_GS = 5960;
constexpr int C_Q = 4864, C_K = 5376, C_QI = 5632, C_KI = 5888, C_WI = 5952;
constexpr int IN_COLS = 8004, DFF = 2816, F2 = 5632;
constexpr size_t WS_WIN = 0, WS_WG = 10485760, WS_WBR = 16777216, WS_WO = 19922944, WS_WUP = 22020096, WS_WDN = 33554432;
constexpr size_t WS_P = 39321600, WS_HALO = 242745344, WS_VT = WS_HALO, WS_ROPE = 265814016, WS_BAR = 266338304, WS_BND = WS_HALO + 4194304, WS_SCAL = WS_HALO + 8388608, WS_XC = WS_BAR + 16384, WS_XB = WS_XC + 65536;
constexpr int LDS_BYTES = 153600;
constexpr int SCS = 2052;
constexpr int MASK_OFF = 16 * SCS * 4;

struct Args { const float* in[24]; float* out; unsigned char* ws; int ph_lo, ph_hi; };

__device__ __forceinline__ unsigned f2bf(float f) { unsigned u = __builtin_bit_cast(unsigned, f); return (u + 0x7fffu + ((u >> 16) & 1u)) >> 16; }
__device__ __forceinline__ unsigned pk2(float lo, float hi) { return f2bf(lo) | (f2bf(hi) << 16); }
__device__ __forceinline__ float bf2f(bf16_t b) { return __builtin_bit_cast(float, (unsigned)b << 16); }
__device__ __forceinline__ float bflo(unsigned w) { return __builtin_bit_cast(float, w << 16); }
__device__ __forceinline__ float bfhi(unsigned w) { return __builtin_bit_cast(float, w & 0xffff0000u); }
__device__ __forceinline__ float wave_sum(float v) {
#pragma unroll
    for (int o = 1; o < 64; o <<= 1) v += __shfl_xor(v, o);
    return v;
}
__device__ __forceinline__ int wave_sum_i(int v) {
#pragma unroll
    for (int o = 1; o < 64; o <<= 1) v += __shfl_xor(v, o);
    return v;
}
template <int CTRL> __device__ __forceinline__ float dpp_mov(float x) {
    return __builtin_bit_cast(float, __builtin_amdgcn_update_dpp(0, __builtin_bit_cast(int, x), CTRL, 0xF, 0xF, true));
}
__device__ __forceinline__ float red8(float x) { x += dpp_mov<0xB1>(x); x += dpp_mov<0x4E>(x); x += dpp_mov<0x141>(x); return x; }
__device__ __forceinline__ float red16(float x) { x = red8(x); x += dpp_mov<0x140>(x); return x; }
__device__ __forceinline__ float sigmoidf_(float x) { return 1.f / (1.f + __expf(-x)); }

namespace pg8 {
constexpr int BM = 256, BK = 64, HALF = 128, HTB = HALF * BK * 2, NXCD = 8, WGM = 8;
__device__ __forceinline__ int lds_byte(int r, int c) { const int st = (r >> 4) * 2 + (c >> 5), rr = r & 15, cc = c & 31, ob = rr * 64 + cc * 2; return st * 1024 + (ob ^ (((ob >> 9) & 1) << 5)); }
__device__ __forceinline__ void stage_rc(int b, int& R, int& C) { const int st = b / 1024, sb = b % 1024, swz = sb ^ (((sb >> 9) & 1) << 5); R = (st >> 1) * 16 + swz / 64; C = (st & 1) * 32 + (swz % 64) / 2; }
__device__ __forceinline__ int perm32(int rho) { const int n = rho >> 4, i = rho & 15; return 8 * (i >> 2) + 4 * n + (i & 3); }
struct Unit { int pm, pn; };
struct Gemm { const bf16_t* A; const bf16_t* Bt; int lda, ldb, K; };
struct StaticOrder {
    int nM, nN, nwg, G, c;
    __device__ void init(int M, int N, int G_, int c_) { nM = M / BM; nN = N / BM; nwg = nM * nN; G = G_; c = c_; }
    __device__ bool next(int i, Unit& u) const {
        const long L = (long)i * G + c; if (L >= nwg) return false;
        int wgid = (int)L; { const int q = nwg / NXCD, r = nwg % NXCD, xcd = wgid % NXCD, off = wgid / NXCD; wgid = (xcd < r ? xcd * (q + 1) : r * (q + 1) + (xcd - r) * q) + off; }
        const int nig = WGM * nN, gid = wgid / nig, fm = gid * WGM, gsz = (nM - fm) < WGM ? (nM - fm) : WGM;
        u.pm = fm + ((wgid % nig) % gsz); u.pn = (wgid % nig) / gsz; return true;
    }
};
__device__ __forceinline__ unsigned cvt_pk_bf16(float lo, float hi) { unsigned r; asm volatile("v_cvt_pk_bf16_f32 %0, %1, %2" : "=v"(r) : "v"(lo), "v"(hi)); return r; }

template <class Epi, bool ALIGN_EPI>
__device__ __forceinline__ void gemm_phase(LAS unsigned char* lds, const Gemm g, const StaticOrder& S, const Epi& E, const int tid) {
    const int wid = __builtin_amdgcn_readfirstlane(tid >> 6), lane = tid & 63, wr = wid >> 2, wc = wid & 3, fr = lane & 15, fq = lane >> 4;
    const int K = g.K, nt = K / BK;
    unsigned voffA[2], voffB[2];
#pragma unroll
    for (int i = 0; i < 2; ++i) { int R, C; stage_rc(tid * 16 + i * 8192, R, C); const int Rb = (R & ~31) + perm32(R & 31);
        voffA[i] = (unsigned)(R * g.lda + C) * 2u; voffB[i] = (unsigned)(Rb * g.ldb + C) * 2u; }
    const size_t kstep = (size_t)(BK * 2);
    const size_t hstepA = (size_t)HALF * g.lda * 2, hstepB = (size_t)HALF * g.ldb * 2;
    const size_t tstepA = 2 * hstepA, tstepB = 2 * hstepB;
    const unsigned ldsw = (unsigned)wid * 1024u;
    const int aoff = lds_byte(wr * 64 + fr, fq * 8), boff = lds_byte(wc * 32 + fr, fq * 8);
#define PG8_SA(b, h) (((b) * 2 + (h)) * HTB)
#define PG8_SB(b, h) ((4 + (b) * 2 + (h)) * HTB)
#define PG8_STAGE(bufoff, gbase, voff) do { _Pragma("unroll") for (int _i = 0; _i < 2; ++_i) \
        __builtin_amdgcn_global_load_lds((const unsigned*)((const char*)(gbase) + (voff)[_i]), (LAS unsigned*)(lds + (bufoff) + ldsw + _i * 8192), 16, 0, 0); } while (0)
#define PG8_LDA(dst, b, h) do { _Pragma("unroll") for (int m = 0; m < 4; ++m) _Pragma("unroll") for (int k = 0; k < 2; ++k) dst[m][k] = *(const LAS bf16x8*)(lds + PG8_SA(b, h) + aoff + m * 2048 + k * 1024); } while (0)
#define PG8_LDB(dst, b, h) do { _Pragma("unroll") for (int n = 0; n < 2; ++n) _Pragma("unroll") for (int k = 0; k < 2; ++k) dst[n][k] = *(const LAS bf16x8*)(lds + PG8_SB(b, h) + boff + n * 2048 + k * 1024); } while (0)
#define PG8_MMA(ai, bj, At, Bt) do { __builtin_amdgcn_s_setprio(1); _Pragma("unroll") for (int m = 0; m < 4; ++m) _Pragma("unroll") for (int n = 0; n < 2; ++n) _Pragma("unroll") for (int k = 0; k < 2; ++k) \
        acc[ai][bj][m][n] = __builtin_amdgcn_mfma_f32_16x16x32_bf16(Bt[n][k], At[m][k], acc[ai][bj][m][n], 0, 0, 0); __builtin_amdgcn_s_setprio(0); } while (0)
#define PG8_WAIT_V(n) asm volatile("s_waitcnt vmcnt(" #n ")" ::: "memory")
#define PG8_WAIT_L(n) asm volatile("s_waitcnt lgkmcnt(" #n ")" ::: "memory")
#define PG8_BAR __builtin_amdgcn_s_barrier()
#define PG8_SCHED __builtin_amdgcn_sched_barrier(0)
    Unit cur, nxt; int ui = 0;
    if (!S.next(0, cur)) return;
    f32x4 acc[2][2][4][2];
#pragma unroll
    for (int a = 0; a < 2; ++a)
#pragma unroll
        for (int b = 0; b < 2; ++b)
#pragma unroll
            for (int m = 0; m < 4; ++m)
#pragma unroll
                for (int n = 0; n < 2; ++n) acc[a][b][m][n] = (f32x4){0.f, 0.f, 0.f, 0.f};
    bf16x8 At[4][2], B0[2][2], B1[2][2];
    const char* cA = (const char*)g.A + (size_t)cur.pm * tstepA; const char* cB = (const char*)g.Bt + (size_t)cur.pn * tstepB;
    PG8_STAGE(PG8_SB(0, 0), cB, voffB); PG8_STAGE(PG8_SB(0, 1), cB + hstepB, voffB); PG8_STAGE(PG8_SA(0, 0), cA, voffA); PG8_STAGE(PG8_SA(0, 1), cA + hstepA, voffA);
    if (wr == 1) PG8_BAR;
    PG8_WAIT_V(2); PG8_BAR;
    PG8_STAGE(PG8_SB(1, 0), cB + kstep, voffB); PG8_STAGE(PG8_SA(1, 0), cA + kstep, voffA); PG8_STAGE(PG8_SB(1, 1), cB + hstepB + kstep, voffB);
    PG8_WAIT_V(6); PG8_BAR;
    for (;;) {
        const bool has_next = S.next(ui + 1, nxt);
        const char* nA = has_next ? (const char*)g.A + (size_t)nxt.pm * tstepA : cA; const char* nB = has_next ? (const char*)g.Bt + (size_t)nxt.pn * tstepB : cB;
        for (int t = 0; t < nt; t += 2) {
            const bool last = (t == nt - 2);
            const char* a1 = cA + (size_t)(t + 1) * kstep;
            const char* a2 = last ? nA : cA + (size_t)(t + 2) * kstep; const char* b2 = last ? nB : cB + (size_t)(t + 2) * kstep;
            const char* a3 = a2 + kstep; const char* b3 = b2 + kstep;
            PG8_LDB(B0, 0, 0); PG8_LDB(B1, 0, 1); PG8_SCHED; PG8_LDA(At, 0, 0); PG8_STAGE(PG8_SA(1, 1), a1 + hstepA, voffA);
            PG8_WAIT_V(8); PG8_WAIT_L(0); PG8_BAR; PG8_MMA(0, 0, At, B0); PG8_MMA(0, 1, At, B1); PG8_BAR; PG8_SCHED;
            PG8_LDA(At, 0, 1); PG8_STAGE(PG8_SB(0, 0), b2, voffB); PG8_STAGE(PG8_SB(0, 1), b2 + hstepB, voffB); PG8_STAGE(PG8_SA(0, 0), a2, voffA);
            PG8_WAIT_V(8); PG8_WAIT_L(0); PG8_BAR; PG8_MMA(1, 0, At, B0); PG8_MMA(1, 1, At, B1); PG8_BAR; PG8_SCHED;
            PG8_LDB(B0, 1, 0); PG8_LDB(B1, 1, 1); PG8_SCHED; PG8_LDA(At, 1, 0); PG8_STAGE(PG8_SA(0, 1), a2 + hstepA, voffA);
            PG8_WAIT_V(8); PG8_WAIT_L(0); PG8_BAR; PG8_MMA(0, 0, At, B0); PG8_MMA(0, 1, At, B1); PG8_BAR; PG8_SCHED;
            PG8_LDA(At, 1, 1); PG8_STAGE(PG8_SB(1, 0), b3, voffB); PG8_STAGE(PG8_SB(1, 1), b3 + hstepB, voffB); PG8_STAGE(PG8_SA(1, 0), a3, voffA);
            PG8_WAIT_V(8); PG8_WAIT_L(0); PG8_BAR; PG8_MMA(1, 0, At, B0); PG8_MMA(1, 1, At, B1); PG8_BAR; PG8_SCHED;
        }
        if constexpr (ALIGN_EPI) { if (wr == 0) PG8_BAR; }
        if constexpr (!Epi::AFTER_DRAIN) E(acc, cur, wr, wc, fr, fq);
        if (!has_next) break;
#pragma unroll
        for (int a = 0; a < 2; ++a)
#pragma unroll
            for (int b = 0; b < 2; ++b)
#pragma unroll
                for (int m = 0; m < 4; ++m)
#pragma unroll
                    for (int n = 0; n < 2; ++n) acc[a][b][m][n] = (f32x4){0.f, 0.f, 0.f, 0.f};
        cur = nxt; cA = nA; cB = nB; ++ui;
        if constexpr (ALIGN_EPI) { if (wr == 1) PG8_BAR; }
    }
    PG8_WAIT_V(0);
    if constexpr (!ALIGN_EPI) { if (wr == 0) PG8_BAR; }
    PG8_BAR;
    if constexpr (Epi::AFTER_DRAIN) E.fused(acc, cur, wr, wc, fr, fq, lds, wid, lane);
#undef PG8_SA
#undef PG8_SB
#undef PG8_STAGE
#undef PG8_LDA
#undef PG8_LDB
#undef PG8_MMA
#undef PG8_WAIT_V
#undef PG8_WAIT_L
#undef PG8_BAR
#undef PG8_SCHED
}

typedef f32x4 AccT[2][2][4][2];

struct EpiInProj {
    static constexpr bool AFTER_DRAIN = false;
    bf16_t* P; bf16_t* VT; const float* rope; bf16_t* BND;
    __device__ __forceinline__ void operator()(AccT& acc, const Unit& u, int wr, int wc, int fr, int fq) const {
        const int row0 = u.pm * BM + wr * 64 + fr, colb = u.pn * BM + wc * 32 + 8 * fq;
#pragma unroll
        for (int ai = 0; ai < 2; ++ai)
#pragma unroll
            for (int m = 0; m < 4; ++m) {
                const int row = row0 + ai * HALF + m * 16, t = row & (SEQ - 1);
                bf16_t* rowp = P + (size_t)row * LDP + COL_PA;
#pragma unroll
                for (int bj = 0; bj < 2; ++bj) {
                    const int c = colb + bj * HALF;
                    f32x4 v0 = acc[ai][bj][m][0], v1 = acc[ai][bj][m][1];
                    if (u.pn >= 15) {
                        const int cl = c - 3840;
                        if (cl < 640 || (cl >= 768 && cl < 1088)) {
                            const float* cs = rope + ((size_t)t * 32 + ((cl & 63) >> 1)) * 2;
                            const f32x4 r0 = *(const f32x4*)cs, r1 = *(const f32x4*)(cs + 4);
                            f32x4 o0, o1;
                            o0[0] = v0[0] * r0[0] - v0[1] * r0[1]; o0[1] = v0[1] * r0[0] + v0[0] * r0[1];
                            o0[2] = v0[2] * r0[2] - v0[3] * r0[3]; o0[3] = v0[3] * r0[2] + v0[2] * r0[3];
                            o1[0] = v1[0] * r1[0] - v1[1] * r1[1]; o1[1] = v1[1] * r1[0] + v1[0] * r1[1];
                            o1[2] = v1[2] * r1[2] - v1[3] * r1[3]; o1[3] = v1[3] * r1[2] + v1[2] * r1[3];
                            v0 = o0; v1 = o1;
                        }
                    }
                    u32x4 w; w.x = cvt_pk_bf16(v0[0], v0[1]); w.y = cvt_pk_bf16(v0[2], v0[3]); w.z = cvt_pk_bf16(v1[0], v1[1]); w.w = cvt_pk_bf16(v1[2], v1[3]);
                    *(u32x4*)(rowp + c) = w;
                    if (u.pn < 7 && fr == 15) *(u32x4*)(BND + (size_t)(row >> 4) * 1792 + c) = w;
                    if (u.pn == 17 && bj == 1) {
                        const int cv = c - 3840 - 640, b = row >> 11;
                        bf16_t* vt = VT + ((size_t)(b * 2 + (cv >> 6)) * 64 + (cv & 63)) * SEQ + t;
                        vt[0 * SEQ] = (bf16_t)(w.x & 0xffffu); vt[1 * SEQ] = (bf16_t)(w.x >> 16);
                        vt[2 * SEQ] = (bf16_t)(w.y & 0xffffu); vt[3 * SEQ] = (bf16_t)(w.y >> 16);
                        vt[4 * SEQ] = (bf16_t)(w.z & 0xffffu); vt[5 * SEQ] = (bf16_t)(w.z >> 16);
                        vt[6 * SEQ] = (bf16_t)(w.w & 0xffffu); vt[7 * SEQ] = (bf16_t)(w.w >> 16);
                    }
                }
            }
    }
};
struct EpiGate {
    static constexpr bool AFTER_DRAIN = false;
    bf16_t* P;
    __device__ __forceinline__ void operator()(AccT& acc, const Unit& u, int wr, int wc, int fr, int fq) const {
        const int row0 = u.pm * BM + wr * 64 + fr, colb = u.pn * BM + wc * 32 + 8 * fq;
#pragma unroll
        for (int ai = 0; ai < 2; ++ai)
#pragma unroll
            for (int m = 0; m < 4; ++m) {
                bf16_t* rowp = P + (size_t)(row0 + ai * HALF + m * 16) * LDP + COL_G + colb;
#pragma unroll
                for (int bj = 0; bj < 2; ++bj) {
                    const f32x4 v0 = acc[ai][bj][m][0], v1 = acc[ai][bj][m][1];
                    u32x4 w; w.x = cvt_pk_bf16(sigmoidf_(v0[0]), sigmoidf_(v0[1])); w.y = cvt_pk_bf16(sigmoidf_(v0[2]), sigmoidf_(v0[3]));
                    w.z = cvt_pk_bf16(sigmoidf_(v1[0]), sigmoidf_(v1[1])); w.w = cvt_pk_bf16(sigmoidf_(v1[2]), sigmoidf_(v1[3]));
                    *(u32x4*)(rowp + bj * HALF) = w;
                }
            }
    }
};
struct EpiMergeAcc {
    static constexpr bool AFTER_DRAIN = false;
    bf16_t* P; int first;
    __device__ __forceinline__ void operator()(AccT& acc, const Unit& u, int wr, int wc, int fr, int fq) const {
        const int row0 = u.pm * BM + wr * 64 + fr, colb = u.pn * BM + wc * 32 + 8 * fq;
#pragma unroll
        for (int ai = 0; ai < 2; ++ai)
#pragma unroll
            for (int m = 0; m < 4; ++m) {
                bf16_t* rowb = P + (size_t)(row0 + ai * HALF + m * 16) * LDP + colb;
#pragma unroll
                for (int bj = 0; bj < 2; ++bj) {
                    const f32x4 v0 = acc[ai][bj][m][0], v1 = acc[ai][bj][m][1];
                    const u32x4 gq = *(const u32x4*)(rowb + COL_G + bj * HALF);
                    u32x4 mq = (u32x4){0u, 0u, 0u, 0u};
                    if (!first) mq = *(const u32x4*)(rowb + COL_MRG + bj * HALF);
                    const unsigned ga = gq.x, gb = gq.y, gc = gq.z, gd = gq.w;
                    const unsigned ma = mq.x, mb = mq.y, mc = mq.z, md = mq.w;
                    u32x4 w;
                    w.x = cvt_pk_bf16(bflo(ma) + bflo(ga) * v0[0], bfhi(ma) + bfhi(ga) * v0[1]);
                    w.y = cvt_pk_bf16(bflo(mb) + bflo(gb) * v0[2], bfhi(mb) + bfhi(gb) * v0[3]);
                    w.z = cvt_pk_bf16(bflo(mc) + bflo(gc) * v1[0], bfhi(mc) + bfhi(gc) * v1[1]);
                    w.w = cvt_pk_bf16(bflo(md) + bflo(gd) * v1[2], bfhi(md) + bfhi(gd) * v1[3]);
                    *(u32x4*)(rowb + COL_MRG + bj * HALF) = w;
                }
            }
    }
};
struct EpiResid {
    static constexpr bool AFTER_DRAIN = false;
    const float* base; float* out;
    __device__ __forceinline__ void operator()(AccT& acc, const Unit& u, int wr, int wc, int fr, int fq) const {
        const int row0 = u.pm * BM + wr * 64 + fr, colb = u.pn * BM + wc * 32 + 8 * fq;
#pragma unroll
        for (int ai = 0; ai < 2; ++ai)
#pragma unroll
            for (int m = 0; m < 4; ++m) {
                const size_t off = (size_t)(row0 + ai * HALF + m * 16) * DM + colb;
#pragma unroll
                for (int bj = 0; bj < 2; ++bj) {
                    const f32x4 b0 = *(const f32x4*)(base + off + bj * HALF), b1 = *(const f32x4*)(base + off + bj * HALF + 4);
                    *(f32x4*)(out + off + bj * HALF) = b0 + acc[ai][bj][m][0];
                    *(f32x4*)(out + off + bj * HALF + 4) = b1 + acc[ai][bj][m][1];
                }
            }
    }
};
struct EpiResidNorm {
    static constexpr bool AFTER_DRAIN = true;
    const float* base; float* out; const float* g; bf16_t* obf; float* of32; unsigned* xbuf; unsigned* cnt;
    __device__ __forceinline__ void fused(AccT& acc, const Unit& u, int wr, int wc, int fr, int fq, LAS unsigned char* lds, int wid, int lane) const {
        LAS float* Pl = (LAS float*)lds;
        LAS float* S = (LAS float*)(lds + 8192);
        const int row0 = u.pm * BM + wr * 64 + fr, colb = u.pn * BM + wc * 32 + 8 * fq;
#pragma unroll
        for (int ai = 0; ai < 2; ++ai)
#pragma unroll
            for (int m = 0; m < 4; ++m) {
                const size_t off = (size_t)(row0 + ai * HALF + m * 16) * DM + colb;
                float sq = 0.f;
#pragma unroll
                for (int bj = 0; bj < 2; ++bj) {
                    const f32x4 b0 = *(const f32x4*)(base + off + bj * HALF), b1 = *(const f32x4*)(base + off + bj * HALF + 4);
                    const f32x4 h0 = acc[ai][bj][m][0] + b0, h1 = acc[ai][bj][m][1] + b1;
                    acc[ai][bj][m][0] = h0; acc[ai][bj][m][1] = h1;
                    sq += (h0.x * h0.x + h0.y * h0.y) + (h0.z * h0.z + h0.w * h0.w) + (h1.x * h1.x + h1.y * h1.y) + (h1.z * h1.z + h1.w * h1.w);
                }
                sq += __shfl_xor(sq, 16); sq += __shfl_xor(sq, 32);
                if (fq == 0) Pl[(ai * HALF + wr * 64 + m * 16 + fr) * 4 + wc] = sq;
                if (m & 1) asm volatile("" ::: "memory");
            }
        asm volatile("s_waitcnt lgkmcnt(0)" ::: "memory"); __builtin_amdgcn_s_barrier(); asm volatile("" ::: "memory");
        const int row = wid * 32 + (lane & 31);
        if (lane < 32) {
            const f32x4 p = *(const LAS f32x4*)&Pl[row * 4];
            __hip_atomic_store(xbuf + ((size_t)(u.pm * BM + row) * 4 + u.pn), __builtin_bit_cast(unsigned, (p.x + p.y) + (p.z + p.w)), __ATOMIC_RELAXED, __HIP_MEMORY_SCOPE_AGENT);
        }
        asm volatile("s_waitcnt vmcnt(0)" ::: "memory");
        if (lane == 0) __hip_atomic_fetch_add(cnt + 64 * u.pm, 1u, __ATOMIC_RELAXED, __HIP_MEMORY_SCOPE_AGENT);
        if (wid == 0) {
            unsigned sp = 0u;
            while ((unsigned)__builtin_amdgcn_readfirstlane(__hip_atomic_load(cnt + 64 * u.pm, __ATOMIC_RELAXED, __HIP_MEMORY_SCOPE_AGENT)) < 32u) { __builtin_amdgcn_s_sleep(2); if (++sp > (1u << 22)) break; }
            __builtin_amdgcn_fence(__ATOMIC_ACQUIRE, "agent");
        }
        asm volatile("s_waitcnt vmcnt(0) lgkmcnt(0)" ::: "memory"); __builtin_amdgcn_s_barrier(); asm volatile("" ::: "memory");
        if (lane < 32) {
            const unsigned* slot = xbuf + (size_t)(u.pm * BM + row) * 4; float tot = 0.f;
#pragma unroll
            for (int t = 0; t < 4; ++t) tot += __builtin_bit_cast(float, __hip_atomic_load(slot + t, __ATOMIC_RELAXED, __HIP_MEMORY_SCOPE_AGENT));
            S[row] = 1.0f / sqrtf(tot * (1.f / DM) + 1e-6f);
        }
        asm volatile("s_waitcnt lgkmcnt(0)" ::: "memory"); __builtin_amdgcn_s_barrier(); asm volatile("" ::: "memory");
        f32x4 gv[2][2];
#pragma unroll
        for (int bj = 0; bj < 2; ++bj)
#pragma unroll
            for (int n = 0; n < 2; ++n) gv[bj][n] = *(const f32x4*)(g + colb + bj * HALF + 4 * n);
#pragma unroll
        for (int ai = 0; ai < 2; ++ai)
#pragma unroll
            for (int m = 0; m < 4; ++m) {
                const int rl = ai * HALF + wr * 64 + m * 16 + fr, rowg = u.pm * BM + rl;
                const float rs = S[rl];
#pragma unroll
                for (int bj = 0; bj < 2; ++bj) {
                    const f32x4 h0 = acc[ai][bj][m][0], h1 = acc[ai][bj][m][1];
                    const size_t off = (size_t)rowg * DM + colb + bj * HALF;
                    if (out) { *(f32x4*)(out + off) = h0; *(f32x4*)(out + off + 4) = h1; }
                    const f32x4 o0 = h0 * rs * gv[bj][0], o1 = h1 * rs * gv[bj][1];
                    if (obf) { u32x4 w; w.x = cvt_pk_bf16(o0[0], o0[1]); w.y = cvt_pk_bf16(o0[2], o0[3]); w.z = cvt_pk_bf16(o1[0], o1[1]); w.w = cvt_pk_bf16(o1[2], o1[3]);
                        *(u32x4*)(obf + (size_t)rowg * LDP + colb + bj * HALF) = w; }
                    else { *(f32x4*)(of32 + off) = o0; *(f32x4*)(of32 + off + 4) = o1; }
                }
                asm volatile("" ::: "memory");
            }
    }
};
struct EpiUp {
    static constexpr bool AFTER_DRAIN = false;
    bf16_t* P; float* HALO; const float* cw; const float* cb; LAS float* CW;
    __device__ __forceinline__ void operator()(AccT& acc, const Unit& u, int wr, int wc, int fr_in, int fq_in) const {
        int fr = fr_in, fq = fq_in;
        asm volatile("" : "+v"(fr), "+v"(fq));
        const int row0 = u.pm * BM + wr * 64 + fr;
        const int jb = u.pn * 128 + wc * 32 + 8 * fq;
        {
            const int tl = (wr * 4 + wc) * 64 + fq * 16 + fr;
#pragma unroll
            for (int it = 0; it < 2; ++it) { const int k = tl + 512 * it, p = k >> 8, col = k & 255, co = (col >> 7) * DFF + u.pn * 128 + (col & 127);
                CW[k] = (p < 3) ? cw[p * F2 + co] : cb[co]; }
            asm volatile("s_waitcnt lgkmcnt(0)" ::: "memory"); __builtin_amdgcn_s_barrier(); asm volatile("" ::: "memory");
        }
#pragma unroll
        for (int ai = 0; ai < 2; ++ai) {
            const int s = u.pm * 4 + ai * 2 + wr;
#pragma unroll
            for (int bj = 0; bj < 2; ++bj)
#pragma unroll
                for (int n = 0; n < 2; ++n) {
                    const int colp = u.pn * BM + bj * HALF + wc * 32 + 8 * fq + 4 * n;
                    if (fr < 2) *(f32x4*)(HALO + (size_t)(s * 4 + fr) * F2 + colp) = acc[ai][bj][0][n];
                    if (fr >= 14) *(f32x4*)(HALO + (size_t)(s * 4 + fr - 12) * F2 + colp) = acc[ai][bj][3][n];
                }
        }
#pragma unroll
        for (int ai = 0; ai < 2; ++ai)
#pragma unroll
            for (int m = 0; m < 4; ++m) {
                const int row = row0 + ai * HALF + m * 16;
#pragma unroll
                for (int n = 0; n < 2; ++n) {
                    f32x4 cv[2];
#pragma unroll
                    for (int bj = 0; bj < 2; ++bj) {
                        const int cl = bj * 128 + wc * 32 + 8 * fq + 4 * n;
                        const f32x4 w0 = *(const LAS f32x4*)&CW[cl], w1 = *(const LAS f32x4*)&CW[256 + cl], w2 = *(const LAS f32x4*)&CW[512 + cl], bb = *(const LAS f32x4*)&CW[768 + cl];
#pragma unroll
                        for (int e = 0; e < 4; ++e) {
                            const float cur = acc[ai][bj][m][n][e];
                            const float prv = m > 0 ? acc[ai][bj][m > 0 ? m - 1 : 0][n][e] : 0.f;
                            const float a1 = dpp_mov<0x121>(cur), a2 = dpp_mov<0x122>(cur), b1 = dpp_mov<0x121>(prv), b2 = dpp_mov<0x122>(prv);
                            const float p1 = fr >= 1 ? a1 : b1, p2 = fr >= 2 ? a2 : b2;
                            cv[bj][e] = bb[e] + w0[e] * p2 + w1[e] * p1 + w2[e] * cur;
                        }
                        __builtin_amdgcn_sched_barrier(0);
                    }
                    const f32x4 g0 = cv[0], v0 = cv[1];
                    u32x2 w;
                    w.x = cvt_pk_bf16(g0[0] * sigmoidf_(g0[0]) * v0[0], g0[1] * sigmoidf_(g0[1]) * v0[1]);
                    w.y = cvt_pk_bf16(g0[2] * sigmoidf_(g0[2]) * v0[2], g0[3] * sigmoidf_(g0[3]) * v0[3]);
                    if (!(m == 0 && fr < 2)) *(u32x2*)(P + (size_t)row * LDP + COL_ACT + jb + 4 * n) = w;
                    __builtin_amdgcn_sched_barrier(0);
                }
            }
    }
};
}

struct Ctx {
    const float* in[24]; float* out; unsigned char* ws;
    bf16_t* P; bf16_t* VT; float* HALO; float* ROPE;
    bf16_t *Win, *Wg, *Wbr, *Wo, *Wup, *Wdn;
    int tid, lane, wave, G, bid;
};

__device__ __forceinline__ int srccol(int mode, int n) {
    if (mode == 0) return n;
    if (mode == 2) return 4932 + n;
    if (mode == 3) { const int tile = n >> 8, w = n & 255, j = tile * 128 + (w & 127); return (w < 128) ? j : DFF + j; }
    if (n < 3840) return n;
    const int c = n - 3840;
    if (c >= 1092) return -1;
    if (c < 640 || (c >= 768 && c < 1088)) { const int base = c & ~63, i = c & 63; return 3840 + base + (i >> 1) + 32 * (i & 1); }
    return 3840 + c;
}
__device__ __forceinline__ void tr_item(const float* W, int ldw, int K, int N, bf16_t* WT, int mode, int item, LAS float* scr, int lane) {
    const int nblk = N / 32, kb = item / nblk, nb = item % nblk, k0 = 64 * kb, n0 = 32 * nb;
    const int sc = srccol(mode, n0 + (lane & 31));
    float wv_[32];
#pragma unroll
    for (int i = 0; i < 32; ++i) { const int kk = 2 * i + (lane >> 5); wv_[i] = (sc >= 0) ? W[(size_t)(k0 + kk) * ldw + sc] : 0.f; }
#pragma unroll
    for (int i = 0; i < 32; ++i) { const int kk = 2 * i + (lane >> 5); scr[kk * 33 + (lane & 31)] = wv_[i]; }
    asm volatile("s_waitcnt lgkmcnt(0)" ::: "memory");
    const int c = lane & 7;
#pragma unroll
    for (int j = 0; j < 4; ++j) { const int n = (lane >> 3) + 8 * j; const LAS float* s = scr + (8 * c) * 33 + n;
        u32x4 o; o.x = pk2(s[0 * 33], s[1 * 33]); o.y = pk2(s[2 * 33], s[3 * 33]); o.z = pk2(s[4 * 33], s[5 * 33]); o.w = pk2(s[6 * 33], s[7 * 33]);
        *(u32x4*)(WT + (size_t)(n0 + n) * K + k0 + 8 * c) = o; }
    asm volatile("s_waitcnt lgkmcnt(0)" ::: "memory");
}
__device__ __forceinline__ void rms_row(const float* xrow, const float* g, bf16_t* obf, float* of32, int lane) {
    const f32x4* xr = (const f32x4*)xrow + lane; const f32x4* gr = (const f32x4*)g + lane;
    f32x4 v[4]; float s = 0.f;
#pragma unroll
    for (int j = 0; j < 4; ++j) { v[j] = xr[64 * j]; s += (v[j].x * v[j].x + v[j].y * v[j].y) + (v[j].z * v[j].z + v[j].w * v[j].w); }
    const float rs = 1.f / sqrtf(wave_sum(s) * (1.f / DM) + 1e-6f);
#pragma unroll
    for (int j = 0; j < 4; ++j) {
        const f32x4 gg = gr[64 * j]; const f32x4 o = v[j] * rs * gg;
        if (obf) { u32x2 w; w.x = pk2(o.x, o.y); w.y = pk2(o.z, o.w); *((u32x2*)obf + lane + 64 * j) = w; }
        else *((f32x4*)of32 + lane + 64 * j) = o;
    }
}
__device__ __forceinline__ void rms_pass(const Ctx& X, const float* src, const float* g, bf16_t* obf, float* of32) {
    const int gw = X.bid * 8 + X.wave, NGW = X.G * 8, lane = X.lane;
    const f32x4* gr = (const f32x4*)g + lane;
    f32x4 gg[4];
#pragma unroll
    for (int j = 0; j < 4; ++j) gg[j] = gr[64 * j];
#pragma unroll 1
    for (int m = gw; m < T_TOK; m += 4 * NGW) {
        f32x4 v[4][4]; float ss[4]; int mr[4];
#pragma unroll
        for (int r = 0; r < 4; ++r) { mr[r] = m + r * NGW; const int ml = mr[r] < T_TOK ? mr[r] : m; const f32x4* x = (const f32x4*)(src + (size_t)ml * DM) + lane;
#pragma unroll
            for (int j = 0; j < 4; ++j) v[r][j] = x[64 * j]; }
#pragma unroll
        for (int r = 0; r < 4; ++r) { float a = 0.f;
#pragma unroll
            for (int j = 0; j < 4; ++j) a += (v[r][j].x * v[r][j].x + v[r][j].y * v[r][j].y) + (v[r][j].z * v[r][j].z + v[r][j].w * v[r][j].w);
            ss[r] = 1.f / sqrtf(wave_sum(a) * (1.f / DM) + 1e-6f); }
#pragma unroll
        for (int r = 0; r < 4; ++r) {
            if (mr[r] < T_TOK) {
#pragma unroll
                for (int j = 0; j < 4; ++j) {
                    const f32x4 o = v[r][j] * ss[r] * gg[j];
                    if (obf) { u32x2 w; w.x = pk2(o.x, o.y); w.y = pk2(o.z, o.w); *((u32x2*)(obf + (size_t)mr[r] * LDP) + lane + 64 * j) = w; }
                    else *((f32x4*)(of32 + (size_t)mr[r] * DM) + lane + 64 * j) = o;
                }
            }
        }
    }
}
__device__ __forceinline__ void phase_prep(const Ctx& X, LAS unsigned char* lds, int layer, bool do_u) {
    LAS float* scr = (LAS float*)(lds + X.wave * 8448);
    const int gw = X.bid * 8 + X.wave, NGW = X.G * 8;
    constexpr int I_IN = 16 * 160, I_G = 16 * 96, I_BR = 8 * 32, I_O = 16 * 32, I_UP = 16 * 176, I_DN = 44 * 32;
    constexpr int NITEMS = I_IN + I_G + 3 * I_BR + I_O + I_UP + I_DN;
    const float* w_in = X.in[2] + (size_t)layer * DM * IN_COLS;
    const float* w_br = X.in[16] + (size_t)layer * 3 * 512 * DM;
    const float* w_o = X.in[17] + (size_t)layer * DM * DM;
    const float* w_up = X.in[19] + (size_t)layer * DM * F2;
    const float* w_dn = X.in[22] + (size_t)layer * DFF * DM;
    for (int it = gw; it < NITEMS; it += NGW) {
        int r = it;
        if (r < I_IN) { tr_item(w_in, IN_COLS, DM, 5120, X.Win, 1, r, scr, X.lane); continue; } r -= I_IN;
        if (r < I_G) { tr_item(w_in, IN_COLS, DM, 3072, X.Wg, 2, r, scr, X.lane); continue; } r -= I_G;
        if (r < 3 * I_BR) { const int b = r / I_BR; tr_item(w_br + (size_t)b * 512 * DM, DM, 512, DM, X.Wbr + (size_t)b * DM * 512, 0, r % I_BR, scr, X.lane); continue; } r -= 3 * I_BR;
        if (r < I_O) { tr_item(w_o, DM, DM, DM, X.Wo, 0, r, scr, X.lane); continue; } r -= I_O;
        if (r < I_UP) { tr_item(w_up, F2, DM, F2, X.Wup, 3, r, scr, X.lane); continue; } r -= I_UP;
        tr_item(w_dn, DM, DFF, DM, X.Wdn, 0, r, scr, X.lane);
    }
    const float* h = (layer == 0) ? X.in[0] : X.out;
    const float* g = X.in[1] + (size_t)layer * DM;
    if (do_u) rms_pass(X, h, g, X.P, nullptr);
    if (layer == 0) {
        for (int idx = X.bid * 512 + X.tid; idx < SEQ * 32; idx += X.G * 512) {
            const int t = idx >> 5, p = idx & 31;
            const float inv = exp2f(-(float)p * 0.03125f * 13.287712379549449f);
            const float ang = (float)t * inv;
            const double rev = (double)ang * 0.15915494309189535;
            const float fr = (float)(rev - floor(rev));
            X.ROPE[2 * idx] = __builtin_amdgcn_cosf(fr); X.ROPE[2 * idx + 1] = __builtin_amdgcn_sinf(fr);
        }
    }
}

__device__ __forceinline__ float wave_sum_fast(float x) {
    x = red16(x);
    const float r0 = __builtin_bit_cast(float, __builtin_amdgcn_readlane(__builtin_bit_cast(int, x), 0)), r1 = __builtin_bit_cast(float, __builtin_amdgcn_readlane(__builtin_bit_cast(int, x), 16));
    const float r2 = __builtin_bit_cast(float, __builtin_amdgcn_readlane(__builtin_bit_cast(int, x), 32)), r3 = __builtin_bit_cast(float, __builtin_amdgcn_readlane(__builtin_bit_cast(int, x), 48));
    return (r0 + r1) + (r2 + r3);
}
#define LDS_BAR() do { asm volatile("s_waitcnt lgkmcnt(0)" ::: "memory"); __builtin_amdgcn_s_barrier(); asm volatile("" ::: "memory"); } while (0)
constexpr int RW_TS = 16, RW_NCH = SEQ / RW_TS, RW_BUF = 33280;
__device__ __forceinline__ void phase_rwkv_pre(const Ctx& X, LAS unsigned char* lds, int layer) {
    LAS float* Rr = (LAS float*)(lds);           LAS float* Kk = (LAS float*)(lds + 8192);   LAS float* Vv = (LAS float*)(lds + 16384);
    LAS float* W1 = (LAS float*)(lds + 24576);   LAS float* AS = (LAS float*)(lds + 32768);
    LAS bf16_t* WDb = (LAS bf16_t*)(lds + 40960);
    LAS bf16_t* ADb = (LAS bf16_t*)(lds + 45568);
    LAS bf16_t* WTu = (LAS bf16_t*)(lds + 50176);
    LAS bf16_t* WTa = (LAS bf16_t*)(lds + 59392);
    LAS float* MU = (LAS float*)(lds + 68608);
    const int tid = X.tid, lane = tid & 63, wv = X.wave;
    const float* mu = X.in[3] + layer * 1792;
    const float* w0 = X.in[4] + layer * 512;   const float* w_up = X.in[5] + (size_t)layer * 64 * 512;
    const float* a0 = X.in[6] + layer * 512;   const float* a_up = X.in[7] + (size_t)layer * 64 * 512;
    const float* k_k = X.in[9] + layer * 512;  const float* k_a = X.in[10] + layer * 512;  const float* r_k = X.in[11] + layer * 512;
    const bf16_t* BND = (const bf16_t*)(X.ws + WS_BND);
    float* SCAL = (float*)(X.ws + WS_SCAL);
    const int ln = lane & 15, lg = lane >> 4;
    int last_h = -1;
    float q_w0 = 0.f, q_a0 = 0.f;
    f32x4 p_kk4 = (f32x4){0.f, 0.f, 0.f, 0.f}, p_ka4 = p_kk4, p_rk4 = p_kk4;
    const int cg4 = (tid & 15) * 4;
    u32x4 pc4[3], pp4[3], gc4, gp4; bool have_pf = false;
    pc4[0] = pc4[1] = pc4[2] = pp4[0] = pp4[1] = pp4[2] = gc4 = gp4 = (u32x4){0u, 0u, 0u, 0u};
#define PRE_LOAD(uu) do { const int h_ = (uu) & 7, tp_ = (uu) >> 3; _Pragma("unroll") for (int it = 0; it < 3; ++it) { const int idx = tid + 512 * it; pc4[it] = (u32x4){0u, 0u, 0u, 0u}; pp4[it] = (u32x4){0u, 0u, 0u, 0u}; \
        if (idx < 32 * 40) { const int tt = idx / 40, vv = idx - tt * 40; \
            const int col = vv < 8 ? h_ * 64 + 8 * vv : (vv < 16 ? 512 + h_ * 64 + 8 * (vv - 8) : (vv < 24 ? 1024 + h_ * 64 + 8 * (vv - 16) : 1536 + 8 * (vv - 24))); \
            const size_t row = (size_t)tp_ * 32 + tt; pc4[it] = *(const u32x4*)(X.P + row * LDP + COL_PA + col); \
            if (tt > 0) pp4[it] = *(const u32x4*)(X.P + (row - 1) * LDP + COL_PA + col); else if ((tp_ & 63) != 0) pp4[it] = *(const u32x4*)(BND + (size_t)(2 * tp_ - 1) * 1792 + col); } } \
        if (tid < 64) { const int tt = tid >> 1, col = 1664 + 8 * (2 * h_ + (tid & 1)); const size_t row = (size_t)tp_ * 32 + tt; gc4 = *(const u32x4*)(X.P + row * LDP + COL_PA + col); gp4 = (u32x4){0u, 0u, 0u, 0u}; \
            if (tt > 0) gp4 = *(const u32x4*)(X.P + (row - 1) * LDP + COL_PA + col); else if ((tp_ & 63) != 0) gp4 = *(const u32x4*)(BND + (size_t)(2 * tp_ - 1) * 1792 + col); } } while (0)
#pragma unroll 1
    for (int u = X.bid; u < 4096; u += X.G) {
        const int h = u & 7, tp = u >> 3;
        if (h != last_h) {
            __syncthreads();
            for (int idx = tid; idx < 64 * 64; idx += 512) { const int m = idx >> 6, cc = idx & 63;
                WTu[cc * 72 + m] = (bf16_t)f2bf(w_up[m * 512 + h * 64 + cc]); WTa[cc * 72 + m] = (bf16_t)f2bf(a_up[m * 512 + h * 64 + cc]); }
            if (tid < 320) { const int cc = tid; const int col = cc < 64 ? h * 64 + cc : (cc < 128 ? 512 + h * 64 + cc - 64 : (cc < 192 ? 1024 + h * 64 + cc - 128 : 1536 + cc - 192)); MU[cc] = mu[col]; }
            p_kk4 = *(const f32x4*)(k_k + h * 64 + cg4); p_ka4 = *(const f32x4*)(k_a + h * 64 + cg4); p_rk4 = *(const f32x4*)(r_k + h * 64 + cg4);
            q_w0 = w0[h * 64 + 16 * (wv >> 1) + ln]; q_a0 = a0[h * 64 + 16 * (wv >> 1) + ln];
            last_h = h;
            __syncthreads();
        }
        if (!have_pf) { PRE_LOAD(u); }
#pragma unroll
        for (int it = 0; it < 3; ++it) {
            const int idx = tid + 512 * it;
            if (idx < 32 * 40) {
                const int tt = idx / 40, vv = idx - tt * 40, cc0 = 8 * vv;
                const u32x4 c4 = pc4[it], p4 = pp4[it];
                const f32x4 m0 = *(const LAS f32x4*)&MU[cc0], m1 = *(const LAS f32x4*)&MU[cc0 + 4];
                float cur[8], prv[8], val[8];
                cur[0] = bflo(c4.x); cur[1] = bfhi(c4.x); cur[2] = bflo(c4.y); cur[3] = bfhi(c4.y); cur[4] = bflo(c4.z); cur[5] = bfhi(c4.z); cur[6] = bflo(c4.w); cur[7] = bfhi(c4.w);
                prv[0] = bflo(p4.x); prv[1] = bfhi(p4.x); prv[2] = bflo(p4.y); prv[3] = bfhi(p4.y); prv[4] = bflo(p4.z); prv[5] = bfhi(p4.z); prv[6] = bflo(p4.w); prv[7] = bfhi(p4.w);
#pragma unroll
                for (int e = 0; e < 8; ++e) val[e] = cur[e] + (prv[e] - cur[e]) * (e < 4 ? m0[e & 3] : m1[e & 3]);
                if (vv < 24) {
#pragma unroll
                    for (int e = 0; e < 8; ++e) val[e] = bf2f((bf16_t)f2bf(val[e]));
                    LAS float* dst = (vv < 8 ? Rr : (vv < 16 ? Kk : Vv)) + tt * 64 + 8 * (vv & 7);
                    *(LAS f32x4*)dst = (f32x4){val[0], val[1], val[2], val[3]}; *(LAS f32x4*)(dst + 4) = (f32x4){val[4], val[5], val[6], val[7]};
                } else {
                    const int lr0 = 8 * (vv - 24);
                    LAS bf16_t* dst;
                    if (lr0 < 64) { dst = WDb + tt * 72 + lr0;
#pragma unroll
                        for (int e = 0; e < 8; ++e) { const float ex = __expf(2.f * val[e]); val[e] = 1.f - 2.f / (ex + 1.f); } }
                    else dst = ADb + tt * 72 + lr0 - 64;
                    u32x4 o; o.x = pk2(val[0], val[1]); o.y = pk2(val[2], val[3]); o.z = pk2(val[4], val[5]); o.w = pk2(val[6], val[7]);
                    *(LAS u32x4*)dst = o;
                }
            }
        }
        if (tid < 64) {
            const int tt = tid >> 1, vg = 2 * h + (tid & 1);
            const f32x4 m0 = *(const f32x4*)(mu + 1664 + 8 * vg), m1 = *(const f32x4*)(mu + 1664 + 8 * vg + 4);
            float gc[8], gp[8];
            gc[0] = bflo(gc4.x); gc[1] = bfhi(gc4.x); gc[2] = bflo(gc4.y); gc[3] = bfhi(gc4.y); gc[4] = bflo(gc4.z); gc[5] = bfhi(gc4.z); gc[6] = bflo(gc4.w); gc[7] = bfhi(gc4.w);
            gp[0] = bflo(gp4.x); gp[1] = bfhi(gp4.x); gp[2] = bflo(gp4.y); gp[3] = bfhi(gp4.y); gp[4] = bflo(gp4.z); gp[5] = bfhi(gp4.z); gp[6] = bflo(gp4.w); gp[7] = bfhi(gp4.w);
#pragma unroll
            for (int e = 0; e < 8; ++e) gc[e] = sigmoidf_(gc[e] + (gp[e] - gc[e]) * (e < 4 ? m0[e & 3] : m1[e & 3]));
            u32x4 o; o.x = pk2(gc[0], gc[1]); o.y = pk2(gc[2], gc[3]); o.z = pk2(gc[4], gc[5]); o.w = pk2(gc[6], gc[7]);
            *(u32x4*)(X.P + ((size_t)tp * 32 + tt) * LDP + COL_GS + 8 * vg) = o;
        }
        have_pf = false;
        if (u + X.G < 4096 && ((u + X.G) & 7) == h) { PRE_LOAD(u + X.G); have_pf = true; }
        LDS_BAR();
        {
            const int mt = wv & 1, nt = wv >> 1, chm = 16 * nt + ln;
            f32x4 cw_ = (f32x4){0.f, 0.f, 0.f, 0.f}, ca_ = cw_;
#pragma unroll
            for (int ks = 0; ks < 2; ++ks) {
                const bf16x8 xa = *(const LAS bf16x8*)&WDb[(16 * mt + ln) * 72 + ks * 32 + 8 * lg], xb = *(const LAS bf16x8*)&WTu[(16 * nt + ln) * 72 + ks * 32 + 8 * lg];
                cw_ = __builtin_amdgcn_mfma_f32_16x16x32_bf16(xa, xb, cw_, 0, 0, 0);
                const bf16x8 ya = *(const LAS bf16x8*)&ADb[(16 * mt + ln) * 72 + ks * 32 + 8 * lg], yb = *(const LAS bf16x8*)&WTa[(16 * nt + ln) * 72 + ks * 32 + 8 * lg];
                ca_ = __builtin_amdgcn_mfma_f32_16x16x32_bf16(ya, yb, ca_, 0, 0, 0);
            }
#pragma unroll
            for (int r = 0; r < 4; ++r) {
                const int tt = 16 * mt + 4 * lg + r;
                const float z = -(q_w0 + cw_[r]);
                const float sp = fmaxf(z, 0.f) + __logf(1.f + __expf(-fabsf(z)));
                const float e = __expf(-sp - 0.5f);
                W1[tt * 64 + chm] = bf2f((bf16_t)f2bf(-expm1f(-e)));
                AS[tt * 64 + chm] = bf2f((bf16_t)f2bf(sigmoidf_(q_a0 + ca_[r])));
            }
        }
        LDS_BAR();
        {
            const int tt = tid >> 4;
            const size_t row = (size_t)tp * 32 + tt;
            const f32x4 w1 = *(const LAS f32x4*)&W1[tt * 64 + cg4], a = *(const LAS f32x4*)&AS[tt * 64 + cg4];
            const f32x4 kraw = *(const LAS f32x4*)&Kk[tt * 64 + cg4], r = *(const LAS f32x4*)&Rr[tt * 64 + cg4], v = *(const LAS f32x4*)&Vv[tt * 64 + cg4];
            const f32x4 kk0 = kraw * p_kk4;
            const float inv = 1.f / sqrtf(fmaxf(red16((kk0.x * kk0.x + kk0.y * kk0.y) + (kk0.z * kk0.z + kk0.w * kk0.w)), 1e-24f));
            const f32x4 kk = kk0 * inv;
            const f32x4 kmod = kraw * (1.f + (a - 1.f) * p_ka4);
            const f32x4 bvec = kk * a, t1 = bvec * r, t2 = kmod * r, t3 = t2 * p_rk4;
            const float br = red16((t1.x + t1.y) + (t1.z + t1.w)), kr = red16((t2.x + t2.y) + (t2.z + t2.w)), bonus = red16((t3.x + t3.y) + (t3.z + t3.w));
            bf16_t* rp_ = X.P + row * LDP;
            u32x2 o;
            o.x = pk2(r.x, r.y); o.y = pk2(r.z, r.w); *(u32x2*)(rp_ + COL_PA + h * 64 + cg4) = o;
            o.x = pk2(kraw.x, kraw.y); o.y = pk2(kraw.z, kraw.w); *(u32x2*)(rp_ + COL_PA + 512 + h * 64 + cg4) = o;
            o.x = pk2(v.x, v.y); o.y = pk2(v.z, v.w); *(u32x2*)(rp_ + COL_PA + 1024 + h * 64 + cg4) = o;
            o.x = pk2(w1.x, w1.y); o.y = pk2(w1.z, w1.w); *(u32x2*)(rp_ + h * 64 + cg4) = o;
            o.x = pk2(a.x, a.y); o.y = pk2(a.z, a.w); *(u32x2*)(rp_ + 512 + h * 64 + cg4) = o;
            if (cg4 == 0) *(f32x4*)(SCAL + (row * 8 + h) * 4) = (f32x4){inv, br, kr, bonus};
        }
        LDS_BAR();
    }
}

__device__ __forceinline__ void rwkv_task(const Ctx& X, LAS unsigned char* lds, int layer, int b, int h) {
    LAS bf16_t* GDb = (LAS bf16_t*)(lds + 66560);
    LAS bf16_t* WTg = (LAS bf16_t*)(lds + 70912);
    LAS float* BON = (LAS float*)(lds + 88320);
    const int tid = X.tid, lane = tid & 63;
    const bool helper = X.wave >= 4;
    const int ht = tid & 255;
    const float* mu = X.in[3] + layer * 1792;
    const float* g_up = X.in[8] + (size_t)layer * 128 * 512;
    const float* k_k = X.in[9] + layer * 512;  const float* k_a = X.in[10] + layer * 512;
    const float* gn_g = X.in[12] + layer * 512; const float* gn_b = X.in[13] + layer * 512;
    const float* SCAL = (const float*)(X.ws + WS_SCAL);
    const int tt_h = ht >> 4, cg4 = (ht & 15) * 4;
    const f32x4 p_kk = *(const f32x4*)(k_k + h * 64 + cg4), p_ka = *(const f32x4*)(k_a + h * 64 + cg4);
    const f32x4 p_gg = *(const f32x4*)(gn_g + h * 64 + cg4), p_gb = *(const f32x4*)(gn_b + h * 64 + cg4);
    const int gv8 = (ht & 15) * 8;
    const int nt = (ht >> 6), ln = lane & 15, lg = lane >> 4, chm = 16 * nt + ln;
    const int rp = ht >> 3, jg = ht & 7, i0 = 2 * rp;
    for (int idx = tid; idx < 128 * 64; idx += 512) { const int m = idx >> 6, cc = idx & 63; WTg[cc * 136 + m] = (bf16_t)f2bf(g_up[m * 512 + h * 64 + cc]); }
    f32x2 S0[4], S1[4];
#pragma unroll
    for (int j = 0; j < 4; ++j) { S0[j] = (f32x2){0.f, 0.f}; S1[j] = (f32x2){0.f, 0.f}; }
#if PROBE_SCAN2
    f32x2 T0[4], T1[4];
#pragma unroll
    for (int j = 0; j < 4; ++j) { T0[j] = (f32x2){0.f, 0.f}; T1[j] = (f32x2){0.f, 0.f}; }
#endif
    __syncthreads();

#define RW_ARR(bufi, k) ((LAS float*)(lds + (bufi) * RW_BUF + (k) * 4096))
#define RW_SC(bufi) ((LAS float*)(lds + (bufi) * RW_BUF + 32768))
#define RW_LOAD(chk, L) do { const size_t row_ = (size_t)b * SEQ + (chk) * RW_TS + tt_h; const bf16_t* rp_ = X.P + row_ * LDP; \
        l_r##L = *(const u32x2*)(rp_ + COL_PA + h * 64 + cg4); l_k##L = *(const u32x2*)(rp_ + COL_PA + 512 + h * 64 + cg4); l_v##L = *(const u32x2*)(rp_ + COL_PA + 1024 + h * 64 + cg4); \
        l_w##L = *(const u32x2*)(rp_ + h * 64 + cg4); l_a##L = *(const u32x2*)(rp_ + 512 + h * 64 + cg4); l_s##L = *(const f32x4*)(SCAL + (row_ * 8 + h) * 4); \
        l_gc##L = *(const u32x4*)(rp_ + COL_GS + gv8); } while (0)
    u32x2 l_rA, l_kA, l_vA, l_wA, l_aA; f32x4 l_sA; u32x4 l_gcA;
    u32x2 l_rB, l_kB, l_vB, l_wB, l_aB; f32x4 l_sB; u32x4 l_gcB;
    l_rA = l_kA = l_vA = l_wA = l_aA = l_rB = l_kB = l_vB = l_wB = l_aB = (u32x2){0u, 0u}; l_sA = l_sB = (f32x4){0.f, 0.f, 0.f, 0.f}; l_gcA = l_gcB = (u32x4){0u, 0u, 0u, 0u};
    if (helper) { RW_LOAD(0, A); RW_LOAD(1, B); }

#pragma unroll 1
    for (int i0_ = -1; i0_ < RW_NCH; i0_ += 2) {
        { const int i = i0_;

        const int bufn = (i + 1) & 1, bufc = i & 1;
        if (helper) {
            const bool do_prep = (i + 1 < RW_NCH);
            if (i >= 1) {
                LAS float* Yy = RW_ARR(bufn, 7); LAS float* Gg = RW_ARR(bufn, 6); LAS float* Vv = RW_ARR(bufn, 5); LAS float* SC = RW_SC(bufn);
                const f32x4 y = *(const LAS f32x4*)&Yy[tt_h * 64 + cg4], gg = *(const LAS f32x4*)&Gg[tt_h * 64 + cg4], vv = *(const LAS f32x4*)&Vv[tt_h * 64 + cg4];
                const float bonus = BON[((i - 1) % 3) * 16 + tt_h];
                const float mean = red16((y.x + y.y) + (y.z + y.w)) * (1.f / 64.f);
                const f32x4 d = y - mean;
                const float var = red16((d.x * d.x + d.y * d.y) + (d.z * d.z + d.w * d.w)) * (1.f / 64.f);
                const float rs = 1.f / sqrtf(var + 64e-5f);
                const f32x4 o = (d * rs * p_gg + p_gb + vv * bonus) * gg;
                u32x2 w; w.x = pk2(o.x, o.y); w.y = pk2(o.z, o.w);
                *(u32x2*)(X.P + ((size_t)b * SEQ + (i - 1) * RW_TS + tt_h) * LDP + COL_YA + h * 64 + cg4) = w;
            }
            if (do_prep) {
                const f32x4 r = (f32x4){bflo(l_rA.x), bfhi(l_rA.x), bflo(l_rA.y), bfhi(l_rA.y)}, k = (f32x4){bflo(l_kA.x), bfhi(l_kA.x), bflo(l_kA.y), bfhi(l_kA.y)};
                const f32x4 v = (f32x4){bflo(l_vA.x), bfhi(l_vA.x), bflo(l_vA.y), bfhi(l_vA.y)}, w1 = (f32x4){bflo(l_wA.x), bfhi(l_wA.x), bflo(l_wA.y), bfhi(l_wA.y)};
                const f32x4 a = (f32x4){bflo(l_aA.x), bfhi(l_aA.x), bflo(l_aA.y), bfhi(l_aA.y)};
                const f32x4 kk = k * p_kk * l_sA.x;
                const f32x4 decay = 1.f - w1;
                *(LAS f32x4*)&RW_ARR(bufn, 0)[tt_h * 64 + cg4] = -kk;
                *(LAS f32x4*)&RW_ARR(bufn, 1)[tt_h * 64 + cg4] = decay * r;
                *(LAS f32x4*)&RW_ARR(bufn, 2)[tt_h * 64 + cg4] = decay;
                *(LAS f32x4*)&RW_ARR(bufn, 3)[tt_h * 64 + cg4] = kk * a;
                *(LAS f32x4*)&RW_ARR(bufn, 4)[tt_h * 64 + cg4] = k * (1.f + (a - 1.f) * p_ka);
                *(LAS f32x4*)&RW_ARR(bufn, 5)[tt_h * 64 + cg4] = v;
                if (cg4 == 0) { LAS float* SC = RW_SC(bufn); SC[tt_h * 4 + 0] = l_sA.y; SC[tt_h * 4 + 1] = l_sA.z; BON[((i + 1) % 3) * 16 + tt_h] = l_sA.w; }
                *(LAS u32x4*)&GDb[tt_h * 136 + gv8] = l_gcA;
            }
            if (i + 3 < RW_NCH) RW_LOAD(i + 3, A);
            LDS_BAR();
            if (do_prep) {
                LAS float* Gg = RW_ARR(bufn, 6);
                f32x4 cg_ = (f32x4){0.f, 0.f, 0.f, 0.f};
#pragma unroll
                for (int ks = 0; ks < 4; ++ks) {
                    const bf16x8 za = *(const LAS bf16x8*)&GDb[ln * 136 + ks * 32 + 8 * lg], zb = *(const LAS bf16x8*)&WTg[(16 * nt + ln) * 136 + ks * 32 + 8 * lg];
                    cg_ = __builtin_amdgcn_mfma_f32_16x16x32_bf16(za, zb, cg_, 0, 0, 0);
                }
#pragma unroll
                for (int r = 0; r < 4; ++r) Gg[(4 * lg + r) * 64 + chm] = cg_[r];
            }
            LDS_BAR();
        } else {
            LAS float* A_ = RW_ARR(bufc, 0); LAS float* WR = RW_ARR(bufc, 1); LAS float* Wd = RW_ARR(bufc, 2); LAS float* Bv = RW_ARR(bufc, 3);
            LAS float* Kk = RW_ARR(bufc, 4); LAS float* Vv = RW_ARR(bufc, 5); LAS float* Yy = RW_ARR(bufc, 7); LAS float* SC = RW_SC(bufc);
#pragma unroll 1
            for (int q4 = 0; q4 < 4; ++q4) {
                if (i >= 0) {
                    float yv[8];
#pragma unroll
                    for (int s4 = 0; s4 < 4; ++s4) {
                        const int tt = 4 * q4 + s4;
                        const f32x4 a_lo = *(const LAS f32x4*)&A_[tt * 64 + 8 * jg], a_hi = *(const LAS f32x4*)&A_[tt * 64 + 8 * jg + 4];
                        const f32x4 r_lo = *(const LAS f32x4*)&WR[tt * 64 + 8 * jg], r_hi = *(const LAS f32x4*)&WR[tt * 64 + 8 * jg + 4];
                        const f32x4 w_lo = *(const LAS f32x4*)&Wd[tt * 64 + 8 * jg], w_hi = *(const LAS f32x4*)&Wd[tt * 64 + 8 * jg + 4];
                        const f32x4 b_lo = *(const LAS f32x4*)&Bv[tt * 64 + 8 * jg], b_hi = *(const LAS f32x4*)&Bv[tt * 64 + 8 * jg + 4];
                        const f32x4 k_lo = *(const LAS f32x4*)&Kk[tt * 64 + 8 * jg], k_hi = *(const LAS f32x4*)&Kk[tt * 64 + 8 * jg + 4];
                        const f32x2 vv = *(const LAS f32x2*)&Vv[tt * 64 + i0];
                        const f32x2 sc = *(const LAS f32x2*)&SC[tt * 4];
                        const f32x2 av[4] = {{a_lo.x, a_lo.y}, {a_lo.z, a_lo.w}, {a_hi.x, a_hi.y}, {a_hi.z, a_hi.w}};
                        const f32x2 rv[4] = {{r_lo.x, r_lo.y}, {r_lo.z, r_lo.w}, {r_hi.x, r_hi.y}, {r_hi.z, r_hi.w}};
                        const f32x2 wv[4] = {{w_lo.x, w_lo.y}, {w_lo.z, w_lo.w}, {w_hi.x, w_hi.y}, {w_hi.z, w_hi.w}};
                        const f32x2 bv[4] = {{b_lo.x, b_lo.y}, {b_lo.z, b_lo.w}, {b_hi.x, b_hi.y}, {b_hi.z, b_hi.w}};
                        const f32x2 kv[4] = {{k_lo.x, k_lo.y}, {k_lo.z, k_lo.w}, {k_hi.x, k_hi.y}, {k_hi.z, k_hi.w}};
                        f32x2 e10 = S0[0] * av[0], e20 = S0[0] * rv[0], e11 = S1[0] * av[0], e21 = S1[0] * rv[0];
#pragma unroll
                        for (int j = 1; j < 4; ++j) { e10 += S0[j] * av[j]; e20 += S0[j] * rv[j]; e11 += S1[j] * av[j]; e21 += S1[j] * rv[j]; }
                        const float d10 = red8(e10.x + e10.y), d11 = red8(e11.x + e11.y);
                        yv[2 * s4] = (e20.x + e20.y) + (jg == 0 ? d10 * sc.x + vv.x * sc.y : 0.f); yv[2 * s4 + 1] = (e21.x + e21.y) + (jg == 0 ? d11 * sc.x + vv.y * sc.y : 0.f);
                        const f32x2 d10v = (f32x2){d10, d10}, d11v = (f32x2){d11, d11}, v0v = (f32x2){vv.x, vv.x}, v1v = (f32x2){vv.y, vv.y};
#pragma unroll
                        for (int j = 0; j < 4; ++j) { S0[j] = S0[j] * wv[j] + (d10v * bv[j] + v0v * kv[j]); S1[j] = S1[j] * wv[j] + (d11v * bv[j] + v1v * kv[j]); }
                    }
                    {
                        const bool t2 = (jg & 4) != 0, t1 = (jg & 2) != 0, t0 = (jg & 1) != 0;
#pragma unroll
                        for (int q = 0; q < 4; ++q) { const float keep = t2 ? yv[q + 4] : yv[q], send = t2 ? yv[q] : yv[q + 4]; yv[q] = keep + dpp_mov<0x141>(send); }
#pragma unroll
                        for (int q = 0; q < 2; ++q) { const float keep = t1 ? yv[q + 2] : yv[q], send = t1 ? yv[q] : yv[q + 2]; yv[q] = keep + dpp_mov<0x4E>(send); }
                        { const float keep = t0 ? yv[1] : yv[0], send = t0 ? yv[0] : yv[1]; yv[0] = keep + dpp_mov<0xB1>(send); }
                        Yy[(4 * q4 + (jg >> 1)) * 64 + i0 + (jg & 1)] = yv[0];
                    }

#if PROBE_SCAN2
                    {
#pragma unroll
                    for (int s4 = 0; s4 < 4; ++s4) {
                        const int tt = 4 * q4 + s4;
                        const f32x4 a_lo = *(const LAS f32x4*)&A_[tt * 64 + 8 * jg], a_hi = *(const LAS f32x4*)&A_[tt * 64 + 8 * jg + 4];
                        const f32x4 r_lo = *(const LAS f32x4*)&WR[tt * 64 + 8 * jg], r_hi = *(const LAS f32x4*)&WR[tt * 64 + 8 * jg + 4];
                        const f32x4 w_lo = *(const LAS f32x4*)&Wd[tt * 64 + 8 * jg], w_hi = *(const LAS f32x4*)&Wd[tt * 64 + 8 * jg + 4];
                        const f32x4 b_lo = *(const LAS f32x4*)&Bv[tt * 64 + 8 * jg], b_hi = *(const LAS f32x4*)&Bv[tt * 64 + 8 * jg + 4];
                        const f32x4 k_lo = *(const LAS f32x4*)&Kk[tt * 64 + 8 * jg], k_hi = *(const LAS f32x4*)&Kk[tt * 64 + 8 * jg + 4];
                        const f32x2 vv = *(const LAS f32x2*)&Vv[tt * 64 + i0];
                        const f32x2 av[4] = {{a_lo.x, a_lo.y}, {a_lo.z, a_lo.w}, {a_hi.x, a_hi.y}, {a_hi.z, a_hi.w}};
                        const f32x2 rv[4] = {{r_lo.x, r_lo.y}, {r_lo.z, r_lo.w}, {r_hi.x, r_hi.y}, {r_hi.z, r_hi.w}};
                        const f32x2 wv[4] = {{w_lo.x, w_lo.y}, {w_lo.z, w_lo.w}, {w_hi.x, w_hi.y}, {w_hi.z, w_hi.w}};
                        const f32x2 bv[4] = {{b_lo.x, b_lo.y}, {b_lo.z, b_lo.w}, {b_hi.x, b_hi.y}, {b_hi.z, b_hi.w}};
                        const f32x2 kv[4] = {{k_lo.x, k_lo.y}, {k_lo.z, k_lo.w}, {k_hi.x, k_hi.y}, {k_hi.z, k_hi.w}};
                        f32x2 e10 = T0[0] * av[0], e20 = T0[0] * rv[0], e11 = T1[0] * av[0], e21 = T1[0] * rv[0];
#pragma unroll
                        for (int j = 1; j < 4; ++j) { e10 += T0[j] * av[j]; e20 += T0[j] * rv[j]; e11 += T1[j] * av[j]; e21 += T1[j] * rv[j]; }
                        const float d10 = red8(e10.x + e10.y), d20 = red8(e20.x + e20.y), d11 = red8(e11.x + e11.y), d21 = red8(e21.x + e21.y);
                        const f32x2 d10v = (f32x2){d10 + d20, d10}, d11v = (f32x2){d11 + d21, d11}, v0v = (f32x2){vv.x, vv.x}, v1v = (f32x2){vv.y, vv.y};
#pragma unroll
                        for (int j = 0; j < 4; ++j) { T0[j] = T0[j] * wv[j] + (d10v * bv[j] + v0v * kv[j]); T1[j] = T1[j] * wv[j] + (d11v * bv[j] + v1v * kv[j]); }
                    }
                    }
#endif
                }
                if (q4 & 1) LDS_BAR();
            }
        }
            }
        if (i0_ + 1 < RW_NCH) { const int i = i0_ + 1;

        const int bufn = (i + 1) & 1, bufc = i & 1;
        if (helper) {
            const bool do_prep = (i + 1 < RW_NCH);
            if (i >= 1) {
                LAS float* Yy = RW_ARR(bufn, 7); LAS float* Gg = RW_ARR(bufn, 6); LAS float* Vv = RW_ARR(bufn, 5); LAS float* SC = RW_SC(bufn);
                const f32x4 y = *(const LAS f32x4*)&Yy[tt_h * 64 + cg4], gg = *(const LAS f32x4*)&Gg[tt_h * 64 + cg4], vv = *(const LAS f32x4*)&Vv[tt_h * 64 + cg4];
                const float bonus = BON[((i - 1) % 3) * 16 + tt_h];
                const float mean = red16((y.x + y.y) + (y.z + y.w)) * (1.f / 64.f);
                const f32x4 d = y - mean;
                const float var = red16((d.x * d.x + d.y * d.y) + (d.z * d.z + d.w * d.w)) * (1.f / 64.f);
                const float rs = 1.f / sqrtf(var + 64e-5f);
                const f32x4 o = (d * rs * p_gg + p_gb + vv * bonus) * gg;
                u32x2 w; w.x = pk2(o.x, o.y); w.y = pk2(o.z, o.w);
                *(u32x2*)(X.P + ((size_t)b * SEQ + (i - 1) * RW_TS + tt_h) * LDP + COL_YA + h * 64 + cg4) = w;
            }
            if (do_prep) {
                const f32x4 r = (f32x4){bflo(l_rB.x), bfhi(l_rB.x), bflo(l_rB.y), bfhi(l_rB.y)}, k = (f32x4){bflo(l_kB.x), bfhi(l_kB.x), bflo(l_kB.y), bfhi(l_kB.y)};
                const f32x4 v = (f32x4){bflo(l_vB.x), bfhi(l_vB.x), bflo(l_vB.y), bfhi(l_vB.y)}, w1 = (f32x4){bflo(l_wB.x), bfhi(l_wB.x), bflo(l_wB.y), bfhi(l_wB.y)};
                const f32x4 a = (f32x4){bflo(l_aB.x), bfhi(l_aB.x), bflo(l_aB.y), bfhi(l_aB.y)};
                const f32x4 kk = k * p_kk * l_sB.x;
                const f32x4 decay = 1.f - w1;
                *(LAS f32x4*)&RW_ARR(bufn, 0)[tt_h * 64 + cg4] = -kk;
                *(LAS f32x4*)&RW_ARR(bufn, 1)[tt_h * 64 + cg4] = decay * r;
                *(LAS f32x4*)&RW_ARR(bufn, 2)[tt_h * 64 + cg4] = decay;
                *(LAS f32x4*)&RW_ARR(bufn, 3)[tt_h * 64 + cg4] = kk * a;
                *(LAS f32x4*)&RW_ARR(bufn, 4)[tt_h * 64 + cg4] = k * (1.f + (a - 1.f) * p_ka);
                *(LAS f32x4*)&RW_ARR(bufn, 5)[tt_h * 64 + cg4] = v;
                if (cg4 == 0) { LAS float* SC = RW_SC(bufn); SC[tt_h * 4 + 0] = l_sB.y; SC[tt_h * 4 + 1] = l_sB.z; BON[((i + 1) % 3) * 16 + tt_h] = l_sB.w; }
                *(LAS u32x4*)&GDb[tt_h * 136 + gv8] = l_gcB;
            }
            if (i + 3 < RW_NCH) RW_LOAD(i + 3, B);
            LDS_BAR();
            if (do_prep) {
                LAS float* Gg = RW_ARR(bufn, 6);
                f32x4 cg_ = (f32x4){0.f, 0.f, 0.f, 0.f};
#pragma unroll
                for (int ks = 0; ks < 4; ++ks) {
                    const bf16x8 za = *(const LAS bf16x8*)&GDb[ln * 136 + ks * 32 + 8 * lg], zb = *(const LAS bf16x8*)&WTg[(16 * nt + ln) * 136 + ks * 32 + 8 * lg];
                    cg_ = __builtin_amdgcn_mfma_f32_16x16x32_bf16(za, zb, cg_, 0, 0, 0);
                }
#pragma unroll
                for (int r = 0; r < 4; ++r) Gg[(4 * lg + r) * 64 + chm] = cg_[r];
            }
            LDS_BAR();
        } else {
            LAS float* A_ = RW_ARR(bufc, 0); LAS float* WR = RW_ARR(bufc, 1); LAS float* Wd = RW_ARR(bufc, 2); LAS float* Bv = RW_ARR(bufc, 3);
            LAS float* Kk = RW_ARR(bufc, 4); LAS float* Vv = RW_ARR(bufc, 5); LAS float* Yy = RW_ARR(bufc, 7); LAS float* SC = RW_SC(bufc);
#pragma unroll 1
            for (int q4 = 0; q4 < 4; ++q4) {
                if (i >= 0) {
                    float yv[8];
#pragma unroll
                    for (int s4 = 0; s4 < 4; ++s4) {
                        const int tt = 4 * q4 + s4;
                        const f32x4 a_lo = *(const LAS f32x4*)&A_[tt * 64 + 8 * jg], a_hi = *(const LAS f32x4*)&A_[tt * 64 + 8 * jg + 4];
                        const f32x4 r_lo = *(const LAS f32x4*)&WR[tt * 64 + 8 * jg], r_hi = *(const LAS f32x4*)&WR[tt * 64 + 8 * jg + 4];
                        const f32x4 w_lo = *(const LAS f32x4*)&Wd[tt * 64 + 8 * jg], w_hi = *(const LAS f32x4*)&Wd[tt * 64 + 8 * jg + 4];
                        const f32x4 b_lo = *(const LAS f32x4*)&Bv[tt * 64 + 8 * jg], b_hi = *(const LAS f32x4*)&Bv[tt * 64 + 8 * jg + 4];
                        const f32x4 k_lo = *(const LAS f32x4*)&Kk[tt * 64 + 8 * jg], k_hi = *(const LAS f32x4*)&Kk[tt * 64 + 8 * jg + 4];
                        const f32x2 vv = *(const LAS f32x2*)&Vv[tt * 64 + i0];
                        const f32x2 sc = *(const LAS f32x2*)&SC[tt * 4];
                        const f32x2 av[4] = {{a_lo.x, a_lo.y}, {a_lo.z, a_lo.w}, {a_hi.x, a_hi.y}, {a_hi.z, a_hi.w}};
                        const f32x2 rv[4] = {{r_lo.x, r_lo.y}, {r_lo.z, r_lo.w}, {r_hi.x, r_hi.y}, {r_hi.z, r_hi.w}};
                        const f32x2 wv[4] = {{w_lo.x, w_lo.y}, {w_lo.z, w_lo.w}, {w_hi.x, w_hi.y}, {w_hi.z, w_hi.w}};
                        const f32x2 bv[4] = {{b_lo.x, b_lo.y}, {b_lo.z, b_lo.w}, {b_hi.x, b_hi.y}, {b_hi.z, b_hi.w}};
                        const f32x2 kv[4] = {{k_lo.x, k_lo.y}, {k_lo.z, k_lo.w}, {k_hi.x, k_hi.y}, {k_hi.z, k_hi.w}};
                        f32x2 e10 = S0[0] * av[0], e20 = S0[0] * rv[0], e11 = S1[0] * av[0], e21 = S1[0] * rv[0];
#pragma unroll
                        for (int j = 1; j < 4; ++j) { e10 += S0[j] * av[j]; e20 += S0[j] * rv[j]; e11 += S1[j] * av[j]; e21 += S1[j] * rv[j]; }
                        const float d10 = red8(e10.x + e10.y), d11 = red8(e11.x + e11.y);
                        yv[2 * s4] = (e20.x + e20.y) + (jg == 0 ? d10 * sc.x + vv.x * sc.y : 0.f); yv[2 * s4 + 1] = (e21.x + e21.y) + (jg == 0 ? d11 * sc.x + vv.y * sc.y : 0.f);
                        const f32x2 d10v = (f32x2){d10, d10}, d11v = (f32x2){d11, d11}, v0v = (f32x2){vv.x, vv.x}, v1v = (f32x2){vv.y, vv.y};
#pragma unroll
                        for (int j = 0; j < 4; ++j) { S0[j] = S0[j] * wv[j] + (d10v * bv[j] + v0v * kv[j]); S1[j] = S1[j] * wv[j] + (d11v * bv[j] + v1v * kv[j]); }
                    }
                    {
                        const bool t2 = (jg & 4) != 0, t1 = (jg & 2) != 0, t0 = (jg & 1) != 0;
#pragma unroll
                        for (int q = 0; q < 4; ++q) { const float keep = t2 ? yv[q + 4] : yv[q], send = t2 ? yv[q] : yv[q + 4]; yv[q] = keep + dpp_mov<0x141>(send); }
#pragma unroll
                        for (int q = 0; q < 2; ++q) { const float keep = t1 ? yv[q + 2] : yv[q], send = t1 ? yv[q] : yv[q + 2]; yv[q] = keep + dpp_mov<0x4E>(send); }
                        { const float keep = t0 ? yv[1] : yv[0], send = t0 ? yv[0] : yv[1]; yv[0] = keep + dpp_mov<0xB1>(send); }
                        Yy[(4 * q4 + (jg >> 1)) * 64 + i0 + (jg & 1)] = yv[0];
                    }

#if PROBE_SCAN2
                    {
#pragma unroll
                    for (int s4 = 0; s4 < 4; ++s4) {
                        const int tt = 4 * q4 + s4;
                        const f32x4 a_lo = *(const LAS f32x4*)&A_[tt * 64 + 8 * jg], a_hi = *(const LAS f32x4*)&A_[tt * 64 + 8 * jg + 4];
                        const f32x4 r_lo = *(const LAS f32x4*)&WR[tt * 64 + 8 * jg], r_hi = *(const LAS f32x4*)&WR[tt * 64 + 8 * jg + 4];
                        const f32x4 w_lo = *(const LAS f32x4*)&Wd[tt * 64 + 8 * jg], w_hi = *(const LAS f32x4*)&Wd[tt * 64 + 8 * jg + 4];
                        const f32x4 b_lo = *(const LAS f32x4*)&Bv[tt * 64 + 8 * jg], b_hi = *(const LAS f32x4*)&Bv[tt * 64 + 8 * jg + 4];
                        const f32x4 k_lo = *(const LAS f32x4*)&Kk[tt * 64 + 8 * jg], k_hi = *(const LAS f32x4*)&Kk[tt * 64 + 8 * jg + 4];
                        const f32x2 vv = *(const LAS f32x2*)&Vv[tt * 64 + i0];
                        const f32x2 av[4] = {{a_lo.x, a_lo.y}, {a_lo.z, a_lo.w}, {a_hi.x, a_hi.y}, {a_hi.z, a_hi.w}};
                        const f32x2 rv[4] = {{r_lo.x, r_lo.y}, {r_lo.z, r_lo.w}, {r_hi.x, r_hi.y}, {r_hi.z, r_hi.w}};
                        const f32x2 wv[4] = {{w_lo.x, w_lo.y}, {w_lo.z, w_lo.w}, {w_hi.x, w_hi.y}, {w_hi.z, w_hi.w}};
                        const f32x2 bv[4] = {{b_lo.x, b_lo.y}, {b_lo.z, b_lo.w}, {b_hi.x, b_hi.y}, {b_hi.z, b_hi.w}};
                        const f32x2 kv[4] = {{k_lo.x, k_lo.y}, {k_lo.z, k_lo.w}, {k_hi.x, k_hi.y}, {k_hi.z, k_hi.w}};
                        f32x2 e10 = T0[0] * av[0], e20 = T0[0] * rv[0], e11 = T1[0] * av[0], e21 = T1[0] * rv[0];
#pragma unroll
                        for (int j = 1; j < 4; ++j) { e10 += T0[j] * av[j]; e20 += T0[j] * rv[j]; e11 += T1[j] * av[j]; e21 += T1[j] * rv[j]; }
                        const float d10 = red8(e10.x + e10.y), d20 = red8(e20.x + e20.y), d11 = red8(e11.x + e11.y), d21 = red8(e21.x + e21.y);
                        const f32x2 d10v = (f32x2){d10 + d20, d10}, d11v = (f32x2){d11 + d21, d11}, v0v = (f32x2){vv.x, vv.x}, v1v = (f32x2){vv.y, vv.y};
#pragma unroll
                        for (int j = 0; j < 4; ++j) { T0[j] = T0[j] * wv[j] + (d10v * bv[j] + v0v * kv[j]); T1[j] = T1[j] * wv[j] + (d11v * bv[j] + v1v * kv[j]); }
                    }
                    }
#endif
                }
                if (q4 & 1) LDS_BAR();
            }
        }
            }
    }
    if (helper) {
        const int bufl = (RW_NCH - 1) & 1;
        LAS float* Yy = RW_ARR(bufl, 7); LAS float* Gg = RW_ARR(bufl, 6); LAS float* Vv = RW_ARR(bufl, 5); LAS float* SC = RW_SC(bufl);
        const f32x4 y = *(const LAS f32x4*)&Yy[tt_h * 64 + cg4], gg = *(const LAS f32x4*)&Gg[tt_h * 64 + cg4], vv = *(const LAS f32x4*)&Vv[tt_h * 64 + cg4];
        const float bonus = BON[((RW_NCH - 1) % 3) * 16 + tt_h];
        const float mean = red16((y.x + y.y) + (y.z + y.w)) * (1.f / 64.f);
        const f32x4 d = y - mean;
        const float var = red16((d.x * d.x + d.y * d.y) + (d.z * d.z + d.w * d.w)) * (1.f / 64.f);
        const float rs = 1.f / sqrtf(var + 64e-5f);
        const f32x4 o = (d * rs * p_gg + p_gb + vv * bonus) * gg;
        u32x2 w; w.x = pk2(o.x, o.y); w.y = pk2(o.z, o.w);
        *(u32x2*)(X.P + ((size_t)b * SEQ + (RW_NCH - 1) * RW_TS + tt_h) * LDP + COL_YA + h * 64 + cg4) = w;
    }
    __syncthreads();
#undef RW_ARR
#undef RW_SC
#undef RW_LOAD
}

__device__ __forceinline__ void hgrn_task(const Ctx& X, LAS unsigned char* lds, int layer, int b, int h, int vh) {
    LAS float* F = (LAS float*)(lds); LAS float* Q = (LAS float*)(lds + 16384); LAS float* Vv = (LAS float*)(lds + 32768); LAS float* O = (LAS float*)(lds + 40960);
    LAS float* LB = (LAS float*)(lds + 49152);
    const int tid = X.tid;
    const float* lbl = X.in[14];
    const int rp = tid >> 4, dg = tid & 15, v0 = 2 * rp;
    if (tid < 128) LB[tid] = (layer > 0) ? 1.f / (1.f + __expf(lbl[h * 128 + tid] - lbl[512 + h * 128 + tid])) : 0.f;
    f32x2 S0[4], S1[4];
#pragma unroll
    for (int j = 0; j < 4; ++j) { S0[j] = (f32x2){0.f, 0.f}; S1[j] = (f32x2){0.f, 0.f}; }
#define HG_LOAD(chk) do { _Pragma("unroll") for (int it = 0; it < 3; ++it) { const int idx = tid + 512 * it; raw[it] = (u32x4){0u, 0u, 0u, 0u}; \
        if (idx < 32 * 40) { const int tt = idx / 40, vv = idx - tt * 40; \
            const int col = vv < 16 ? 512 + h * 128 + 8 * vv : (vv < 32 ? h * 128 + 8 * (vv - 16) : 1024 + h * 128 + vh * 64 + 8 * (vv - 32)); \
            raw[it] = *(const u32x4*)(X.P + ((size_t)b * SEQ + (chk) * 32 + tt) * LDP + COL_PB + col); } } } while (0)
    u32x4 raw[3];
    HG_LOAD(0);
    __syncthreads();
#pragma unroll 1
    for (int ch = 0; ch < SEQ / 32; ++ch) {
        const int t0 = ch * 32;
#pragma unroll
        for (int it = 0; it < 3; ++it) {
            const int idx = tid + 512 * it;
            if (idx < 32 * 40) {
                const int tt = idx / 40, vv = idx - tt * 40;
                float x[8];
                x[0] = bflo(raw[it].x); x[1] = bfhi(raw[it].x); x[2] = bflo(raw[it].y); x[3] = bfhi(raw[it].y);
                x[4] = bflo(raw[it].z); x[5] = bfhi(raw[it].z); x[6] = bflo(raw[it].w); x[7] = bfhi(raw[it].w);
                LAS float* dst;
                if (vv < 16) {
                    dst = F + tt * 128 + 8 * vv;
#pragma unroll
                    for (int e = 0; e < 8; ++e) { const float lb = LB[8 * vv + e]; x[e] = lb + (1.f - lb) * sigmoidf_(x[e]); }
                } else if (vv < 32) dst = Q + tt * 128 + 8 * (vv - 16);
                else dst = Vv + tt * 64 + 8 * (vv - 32);
                *(LAS f32x4*)dst = (f32x4){x[0], x[1], x[2], x[3]}; *(LAS f32x4*)(dst + 4) = (f32x4){x[4], x[5], x[6], x[7]};
            }
        }
        if (ch + 1 < SEQ / 32) HG_LOAD(ch + 1);
        LDS_BAR();
#pragma unroll 1
        for (int g8 = 0; g8 < 4; ++g8) {
            float val[16];
#pragma unroll
            for (int s8 = 0; s8 < 8; ++s8) {
                const int tt = 8 * g8 + s8;
                const f32x4 f_lo = *(const LAS f32x4*)&F[tt * 128 + 8 * dg], f_hi = *(const LAS f32x4*)&F[tt * 128 + 8 * dg + 4];
                const f32x4 q_lo = *(const LAS f32x4*)&Q[tt * 128 + 8 * dg], q_hi = *(const LAS f32x4*)&Q[tt * 128 + 8 * dg + 4];
                const f32x2 vv = *(const LAS f32x2*)&Vv[tt * 64 + v0];
                const f32x2 f2[4] = {{f_lo.x, f_lo.y}, {f_lo.z, f_lo.w}, {f_hi.x, f_hi.y}, {f_hi.z, f_hi.w}};
                const f32x2 q2[4] = {{q_lo.x, q_lo.y}, {q_lo.z, q_lo.w}, {q_hi.x, q_hi.y}, {q_hi.z, q_hi.w}};
                const f32x2 v0v = (f32x2){vv.x, vv.x}, v1v = (f32x2){vv.y, vv.y};
                f32x2 a0 = (f32x2){0.f, 0.f}, a1 = (f32x2){0.f, 0.f};
#pragma unroll
                for (int j = 0; j < 4; ++j) {
                    S0[j] = v0v + f2[j] * (S0[j] - v0v); S1[j] = v1v + f2[j] * (S1[j] - v1v);
                    a0 += q2[j] * S0[j]; a1 += q2[j] * S1[j];
                }
                val[2 * s8] = a0.x + a0.y; val[2 * s8 + 1] = a1.x + a1.y;
            }
            const bool b3 = (dg & 8) != 0, b2 = (dg & 4) != 0, b1 = (dg & 2) != 0, b0 = (dg & 1) != 0;
#pragma unroll
            for (int i = 0; i < 8; ++i) { const float keep = b3 ? val[i + 8] : val[i], send = b3 ? val[i] : val[i + 8]; val[i] = keep + dpp_mov<0x140>(send); }
#pragma unroll
            for (int i = 0; i < 4; ++i) { const float keep = b2 ? val[i + 4] : val[i], send = b2 ? val[i] : val[i + 4]; val[i] = keep + dpp_mov<0x141>(send); }
#pragma unroll
            for (int i = 0; i < 2; ++i) { const float keep = b1 ? val[i + 2] : val[i], send = b1 ? val[i] : val[i + 2]; val[i] = keep + dpp_mov<0x4E>(send); }
            { const float keep = b0 ? val[1] : val[0], send = b0 ? val[0] : val[1]; val[0] = keep + dpp_mov<0xB1>(send); }
            O[(8 * g8 + (dg >> 1)) * 64 + v0 + (dg & 1)] = val[0];
        }
        LDS_BAR();
        if (tid < 256) {
            const int tt = tid >> 3, v8 = (tid & 7) * 8;
            const f32x4 a = *(const LAS f32x4*)&O[tt * 64 + v8], c4 = *(const LAS f32x4*)&O[tt * 64 + v8 + 4];
            u32x4 o; o.x = pk2(a.x, a.y); o.y = pk2(a.z, a.w); o.z = pk2(c4.x, c4.y); o.w = pk2(c4.z, c4.w);
            *(u32x4*)(X.P + ((size_t)b * SEQ + t0 + tt) * LDP + COL_YB + h * 128 + vh * 64 + v8) = o;
        }
    }
#undef HG_LOAD
    __syncthreads();
}

__device__ __forceinline__ unsigned f2ord(float f) { const unsigned u = __builtin_bit_cast(unsigned, f); return (u & 0x80000000u) ? ~u : (u | 0x80000000u); }

__device__ __forceinline__ void dsa_tile(const Ctx& X, LAS unsigned char* lds, int b, int q0) {
    LAS float* sc = (LAS float*)lds;
    LAS unsigned* MASK = (LAS unsigned*)(lds + MASK_OFF);
    const int lane = X.lane, w = X.wave, n = lane & 15, g = lane >> 4;
    const bf16_t* Pb = X.P + (size_t)b * SEQ * LDP;
#pragma unroll 1
    for (int sub = 0; sub < 4; ++sub) {
        const int qs = q0 + 16 * sub;
        {
            bf16x8 bq[4][2]; float wi[4];
            const bf16_t* qrow = Pb + (size_t)(qs + n) * LDP;
#pragma unroll
            for (int hh = 0; hh < 4; ++hh) {
#pragma unroll
                for (int ks = 0; ks < 2; ++ks) bq[hh][ks] = *(const bf16x8*)(qrow + C_QI + hh * 64 + ks * 32 + 8 * g);
                wi[hh] = bf2f(qrow[C_WI + hh]);
            }
            const int nkt = (qs + 16) >> 4;
            bf16x8 a0n = (bf16x8){0, 0, 0, 0, 0, 0, 0, 0}, a1n = a0n;
            if (w < nkt) { const bf16_t* krow = Pb + (size_t)(w * 16 + n) * LDP + C_KI; a0n = *(const bf16x8*)(krow + 8 * g); a1n = *(const bf16x8*)(krow + 32 + 8 * g); }
#pragma unroll 1
            for (int kt = w; kt < nkt; kt += 8) {
                const bf16x8 a0 = a0n, a1 = a1n;
                if (kt + 8 < nkt) { const bf16_t* krow = Pb + (size_t)((kt + 8) * 16 + n) * LDP + C_KI; a0n = *(const bf16x8*)(krow + 8 * g); a1n = *(const bf16x8*)(krow + 32 + 8 * g); }
                f32x4 s = (f32x4){0.f, 0.f, 0.f, 0.f};
#pragma unroll
                for (int hh = 0; hh < 4; ++hh) {
                    f32x4 d = __builtin_amdgcn_mfma_f32_16x16x32_bf16(a0, bq[hh][0], (f32x4){0.f, 0.f, 0.f, 0.f}, 0, 0, 0);
                    d = __builtin_amdgcn_mfma_f32_16x16x32_bf16(a1, bq[hh][1], d, 0, 0, 0);
#pragma unroll
                    for (int r = 0; r < 4; ++r) s[r] += wi[hh] * fmaxf(d[r], 0.f);
                }
                const int t = qs + n;
#pragma unroll
                for (int r = 0; r < 4; ++r) if (kt * 16 + 4 * g + r > t) s[r] = -INFINITY;
                *(LAS f32x4*)&sc[n * SCS + kt * 16 + 4 * g] = s;
            }
        }
        __syncthreads();
#pragma unroll 1
        for (int e = 0; e < 2; ++e) {
            const int qn = 2 * w + e, t = qs + qn;
            LAS unsigned* mrow = MASK + (sub * 16 + qn) * 64;
            if (t < 256) {
#pragma unroll
                for (int j = 0; j < 32; ++j) {
                    const unsigned long long sm = __ballot(j * 64 + lane <= t);
                    if (lane == 0) { mrow[2 * j] = (unsigned)sm; mrow[2 * j + 1] = (unsigned)(sm >> 32); }
                }
            } else {
                const int jn = (t >> 6) + 1;
                unsigned u[32];
#pragma unroll
                for (int j = 0; j < 32; ++j) {
                    u[j] = 0u;
                    if (j < jn) { const int key = j * 64 + lane; const float s = (key <= t) ? sc[qn * SCS + key] : -INFINITY; u[j] = f2ord(s); }
                }
                unsigned prefix = 0u;
#define DSA_BITSEARCH(JN) do { _Pragma("unroll 1") for (int bit = 31; bit >= 0; --bit) { const unsigned cand = prefix | (1u << bit); int c0 = 0, c1 = 0; \
                    _Pragma("unroll") for (int j = 0; j < (JN); j += 2) { c0 += (u[j] >= cand) ? 1 : 0; c1 += (u[j + 1] >= cand) ? 1 : 0; } \
                    const int cnt = (int)wave_sum_fast((float)(c0 + c1)); if (cnt >= 256) prefix = cand; } } while (0)
                if (jn <= 8) DSA_BITSEARCH(8); else if (jn <= 16) DSA_BITSEARCH(16); else if (jn <= 24) DSA_BITSEARCH(24); else DSA_BITSEARCH(32);
#undef DSA_BITSEARCH
                int cg_ = 0;
#pragma unroll
                for (int j = 0; j < 32; ++j) if (j < jn) cg_ += __popcll(__ballot(u[j] > prefix));
                const int need = 256 - cg_;
                int cum = 0;
#pragma unroll
                for (int j = 0; j < 32; ++j) {
                    unsigned long long sm = 0ull;
                    if (j < jn) {
                        const bool eq = (u[j] == prefix);
                        const unsigned long long em = __ballot(eq);
                        const int rank = cum + (int)__builtin_amdgcn_mbcnt_hi((unsigned)(em >> 32), __builtin_amdgcn_mbcnt_lo((unsigned)em, 0u));
                        const bool sel = (u[j] > prefix) || (eq && rank < need);
                        sm = __ballot(sel);
                        cum += __popcll(em);
                    }
                    if (lane == 0) { mrow[2 * j] = (unsigned)sm; mrow[2 * j + 1] = (unsigned)(sm >> 32); }
                }
            }
        }
        __syncthreads();
    }
    const int qq = q0 + 8 * w + (n & 7);
    const LAS unsigned* mq = MASK + (8 * w + (n & 7)) * 64;
    const int nsteps = (q0 + 8 * w + 8 + 31) >> 5;
    const int nblk = (q0 + 64 + 127) >> 7;
    LAS bf16_t* KT = (LAS bf16_t*)lds;
    LAS bf16_t* VTT = (LAS bf16_t*)(lds + 36864);
    const int tid = X.tid;
#pragma unroll 1
    for (int c = 0; c < 2; ++c) {
        bf16x8 bq[2][2];
#pragma unroll
        for (int j = 0; j < 2; ++j)
#pragma unroll
            for (int ks = 0; ks < 2; ++ks) bq[j][ks] = *(const bf16x8*)(Pb + (size_t)qq * LDP + C_Q + (c * 4 + 2 * j + (n >> 3)) * 64 + ks * 32 + 8 * g);
        float lrun[2] = {0.f, 0.f};
        f32x4 oacc[4][2];
#pragma unroll
        for (int mt = 0; mt < 4; ++mt)
#pragma unroll
            for (int j = 0; j < 2; ++j) oacc[mt][j] = (f32x4){0.f, 0.f, 0.f, 0.f};
        const bf16_t* vtb = X.VT + ((size_t)(b * 2 + c) * 64) * SEQ;
        u32x4 gk[2], gv[2];
#define DSA_GLOAD(kblk) do { _Pragma("unroll") for (int it = 0; it < 2; ++it) { const int idx = tid + 512 * it; \
            gk[it] = *(const u32x4*)(Pb + (size_t)((kblk) * 128 + (idx >> 3)) * LDP + C_K + c * 64 + (idx & 7) * 8); \
            gv[it] = *(const u32x4*)(vtb + (size_t)(idx >> 4) * SEQ + (kblk) * 128 + (idx & 15) * 8); } } while (0)
#define DSA_LSTORE(bufi) do { _Pragma("unroll") for (int it = 0; it < 2; ++it) { const int idx = tid + 512 * it; \
            *(LAS u32x4*)(KT + (bufi) * 9216 + (idx >> 3) * 72 + (idx & 7) * 8) = gk[it]; \
            *(LAS u32x4*)(VTT + (bufi) * 8704 + (idx >> 4) * 136 + (idx & 15) * 8) = gv[it]; } } while (0)
        DSA_GLOAD(0);
        LDS_BAR();
        DSA_LSTORE(0);
        LDS_BAR();
#pragma unroll 1
        for (int kb = 0; kb < nblk; ++kb) {
            const int buf = kb & 1;
            if (kb + 1 < nblk) DSA_GLOAD(kb + 1);
            const LAS bf16_t* Kb = KT + buf * 9216; const LAS bf16_t* Vb = VTT + buf * 8704;
#pragma unroll 1
            for (int sl = 0; sl < 4; ++sl) {
                const int sg = kb * 4 + sl;
                if (sg < nsteps) {
                    f32x4 st[2][2];
#pragma unroll
                    for (int tl = 0; tl < 2; ++tl) {
                        const LAS bf16_t* kr = Kb + (32 * sl + 16 * tl + n) * 72;
                        const bf16x8 a0 = *(const LAS bf16x8*)(kr + 8 * g), a1 = *(const LAS bf16x8*)(kr + 32 + 8 * g);
#pragma unroll
                        for (int j = 0; j < 2; ++j) {
                            f32x4 d = __builtin_amdgcn_mfma_f32_16x16x32_bf16(a0, bq[j][0], (f32x4){0.f, 0.f, 0.f, 0.f}, 0, 0, 0);
                            st[tl][j] = __builtin_amdgcn_mfma_f32_16x16x32_bf16(a1, bq[j][1], d, 0, 0, 0);
                        }
                    }
                    bf16x8 av[4];
#pragma unroll
                    for (int mt = 0; mt < 4; ++mt) {
                        const LAS bf16_t* vp = Vb + (mt * 16 + n) * 136 + 32 * sl + 4 * g;
                        const u32x2 lo = *(const LAS u32x2*)vp, hi = *(const LAS u32x2*)(vp + 16);
                        u32x4 t4; t4.x = lo.x; t4.y = lo.y; t4.z = hi.x; t4.w = hi.y;
                        av[mt] = __builtin_bit_cast(bf16x8, t4);
                    }
                    const unsigned mw = mq[sg];
#pragma unroll
                    for (int j = 0; j < 2; ++j) {
                        float p[8], ps = 0.f;
#pragma unroll
                        for (int tl = 0; tl < 2; ++tl)
#pragma unroll
                            for (int r = 0; r < 4; ++r) { const int bit = 16 * tl + 4 * g + r; const float e = __expf(fminf(st[tl][j][r] * 0.125f, 60.f)); p[4 * tl + r] = ((mw >> bit) & 1u) ? e : 0.f; ps += p[4 * tl + r]; }
                        lrun[j] += ps;
                        u32x4 pw; pw.x = pg8::cvt_pk_bf16(p[0], p[1]); pw.y = pg8::cvt_pk_bf16(p[2], p[3]); pw.z = pg8::cvt_pk_bf16(p[4], p[5]); pw.w = pg8::cvt_pk_bf16(p[6], p[7]);
                        const bf16x8 pb = __builtin_bit_cast(bf16x8, pw);
#pragma unroll
                        for (int mt = 0; mt < 4; ++mt) oacc[mt][j] = __builtin_amdgcn_mfma_f32_16x16x32_bf16(av[mt], pb, oacc[mt][j], 0, 0, 0);
                    }
                }
            }
            if (kb + 1 < nblk) DSA_LSTORE(buf ^ 1);
            LDS_BAR();
        }
#pragma unroll
        for (int j = 0; j < 2; ++j) {
            float lt = lrun[j]; lt += __shfl_xor(lt, 16); lt += __shfl_xor(lt, 32);
            const float il = 1.f / lt;
            bf16_t* op = X.P + ((size_t)b * SEQ + qq) * LDP + COL_YC + (c * 4 + 2 * j + (n >> 3)) * 64 + 4 * g;
#pragma unroll
            for (int mt = 0; mt < 4; ++mt) {
                const f32x4 o = oacc[mt][j] * il;
                u32x2 wv; wv.x = pg8::cvt_pk_bf16(o[0], o[1]); wv.y = pg8::cvt_pk_bf16(o[2], o[3]);
                *(u32x2*)(op + mt * 16) = wv;
            }
        }
    }
#undef DSA_GLOAD
#undef DSA_LSTORE
    __syncthreads();
}

__device__ __forceinline__ void phase_mixers(const Ctx& X0, LAS unsigned char* lds, int layer) {
#pragma unroll 1
    for (int task = X0.bid; task < 128; task += X0.G) {
        Ctx X = X0;
        { int t_ = threadIdx.x; asm volatile("" : "+v"(t_)); X.tid = t_; X.lane = t_ & 63; }
        if (task < 64) { if (TKMASK & 1) rwkv_task(X, lds, layer, task >> 3, task & 7); }
        else { const int k = task - 64; if (TKMASK & 2) hgrn_task(X, lds, layer, k >> 3, (k >> 1) & 3, k & 1); }
    }
    volatile LAS unsigned* tw = (volatile LAS unsigned*)(lds + LDS_BYTES - 128);
    unsigned* ctr = (unsigned*)(X0.ws + WS_BAR + 14336) + 16 * layer;
#pragma unroll 1
    for (;;) {
        Ctx X = X0;
        { int t_ = threadIdx.x; asm volatile("" : "+v"(t_)); X.tid = t_; X.lane = t_ & 63; }
        __syncthreads();
        if (threadIdx.x == 0) tw[0] = __hip_atomic_fetch_add(ctr, 1u, __ATOMIC_RELAXED, __HIP_MEMORY_SCOPE_AGENT);
        __syncthreads();
        const int t = (int)tw[0];
        if (t >= 256) break;
        if (TKMASK & 4) dsa_tile(X, lds, t & 7, 64 * (31 - (t >> 3)));
    }
}

__device__ __forceinline__ void phase_hgrn_post(const Ctx& X, int layer) {
    const int gw = X.bid * 8 + X.wave, NGW = X.G * 8;
    const float* gn = X.in[15] + layer * 512;
#pragma unroll 1
    for (int it0 = gw; it0 < T_TOK * 4; it0 += 4 * NGW) {
        unsigned ow[4], gwd[4]; unsigned* op[4];
#pragma unroll
        for (int r = 0; r < 4; ++r) {
            const int it = it0 + r * NGW < T_TOK * 4 ? it0 + r * NGW : it0;
            const int t = it >> 2, h = it & 3;
            bf16_t* rowp = X.P + (size_t)t * LDP;
            op[r] = (unsigned*)(rowp + COL_YB + h * 128) + X.lane;
            ow[r] = *op[r]; gwd[r] = *((const unsigned*)(rowp + COL_PB + 1536 + h * 128) + X.lane);
        }
#pragma unroll
        for (int r = 0; r < 4; ++r) {
            const int it = it0 + r * NGW;
            const int h = it & 3;
            const float o0 = bflo(ow[r]), o1 = bfhi(ow[r]), g0 = bflo(gwd[r]), g1 = bfhi(gwd[r]);
            const float rs = 1.f / sqrtf(wave_sum(o0 * o0 + o1 * o1) * (1.f / 128.f) + 1e-6f);
            const float y0 = o0 * rs * gn[h * 128 + 2 * X.lane] * (g0 * sigmoidf_(g0)), y1 = o1 * rs * gn[h * 128 + 2 * X.lane + 1] * (g1 * sigmoidf_(g1));
            if (it < T_TOK * 4) *op[r] = pk2(y0, y1);
        }
    }
}

__device__ __forceinline__ void phase_fixup(const Ctx& X, int layer) {
    const float* cw = X.in[20] + (size_t)layer * 3 * F2; const float* cb = X.in[21] + (size_t)layer * F2;
#pragma unroll 4
    for (int idx = X.bid * 512 + X.tid; idx < 256 * 2 * DFF; idx += X.G * 512) {
        const int j = idx % DFF, sr = idx / DFF, s = sr >> 1, r = sr & 1;
        const int colg = (j >> 7) * 256 + (j & 127), colv = colg + 128;
        const bool seq0 = (s & 31) == 0;
        const float* H = X.HALO;
        float res[2];
#pragma unroll
        for (int part = 0; part < 2; ++part) {
            const int cp = part ? colv : colg, co = part * DFF + j;
            const float u0 = H[(size_t)(s * 4 + r) * F2 + cp];
            float u1, u2;
            if (r == 0) { u1 = seq0 ? 0.f : H[(size_t)((s - 1) * 4 + 3) * F2 + cp]; u2 = seq0 ? 0.f : H[(size_t)((s - 1) * 4 + 2) * F2 + cp]; }
            else { u1 = H[(size_t)(s * 4 + 0) * F2 + cp]; u2 = seq0 ? 0.f : H[(size_t)((s - 1) * 4 + 3) * F2 + cp]; }
            res[part] = cb[co] + cw[co] * u2 + cw[F2 + co] * u1 + cw[2 * F2 + co] * u0;
        }
        const float a = res[0] * sigmoidf_(res[0]) * res[1];
        X.P[(size_t)(s * 64 + r) * LDP + COL_ACT + j] = (bf16_t)f2bf(a);
    }
}

#define XB_TMO      128
#define XB_XCNT(j)  (256  + 64 * (j))
#define XB_XSUB(j)  (1280 + 64 * (j))
#define XB_XGEN(j)  (2304 + 64 * (j))
#define XB_TOP      3328
#define XB_TOPGEN   3392
#define XCD_BAR_WORDS 3456
#define XB_SPIN_CAP (1u << 22)
__device__ __forceinline__ unsigned xb_ld(unsigned* p)              { return __hip_atomic_load(p, __ATOMIC_RELAXED, __HIP_MEMORY_SCOPE_AGENT); }
__device__ __forceinline__ unsigned xb_add(unsigned* p, unsigned v) { return __hip_atomic_fetch_add(p, v, __ATOMIC_RELAXED, __HIP_MEMORY_SCOPE_AGENT); }
__device__ __forceinline__ unsigned xb_xcc_id() { return (unsigned)__builtin_amdgcn_s_getreg((3 << 11) | 20) & 0xFu; }
#define XB_SPIN(cond, bar) do { unsigned _sp = 0; while (cond) { __builtin_amdgcn_s_sleep(1); \
    if ((++_sp & 255u) == 0u) { if (xb_ld(&(bar)[XB_TMO])) break; if (_sp > XB_SPIN_CAP) { atomicAdd(&(bar)[XB_TMO], 1u); break; } } } } while (0)
struct XcdBarrier { unsigned* bar; unsigned x; volatile LAS unsigned* st; };
__device__ __forceinline__ XcdBarrier xcd_barrier_post(unsigned* bar, volatile LAS unsigned* st) {
    XcdBarrier b; b.bar = bar; b.x = xb_xcc_id(); b.st = st;
    if (threadIdx.x == 0) (void)xb_add(&bar[XB_XCNT(b.x)], 1u);
    return b;
}
__device__ __forceinline__ void xcd_barrier_complete(unsigned* bar, unsigned x, unsigned& nloc, unsigned& nx) {
    const unsigned G = gridDim.x * gridDim.y * gridDim.z;
    unsigned sum, cnt, mine, sp = 0u;
    for (;;) {
        sum = 0u; cnt = 0u; mine = 0u;
#pragma unroll
        for (unsigned j = 0; j < 16; ++j) { const unsigned c = xb_ld(&bar[XB_XCNT(j)]); sum += c; cnt += (c > 0u) ? 1u : 0u; mine = (j == x) ? c : mine; }
        if (sum == G) break;
        __builtin_amdgcn_s_sleep(1);
        if ((++sp & 255u) == 0u) { if (xb_ld(&bar[XB_TMO])) break; if (sp > XB_SPIN_CAP) { atomicAdd(&bar[XB_TMO], 1u); break; } }
    }
    nloc = mine > 0u ? mine : 1u; nx = cnt > 0u ? cnt : 1u;
}
__device__ __forceinline__ void xcd_barrier(const XcdBarrier& b) {
    asm volatile("s_waitcnt vmcnt(0)" ::: "memory");
    __syncthreads();
    if (threadIdx.x == 0) {
        unsigned* bar = b.bar;
        __builtin_amdgcn_s_waitcnt(0);
        unsigned nloc = b.st[0], nx = b.st[1];
        if (nloc == 0u) { xcd_barrier_complete(bar, b.x, nloc, nx); b.st[0] = nloc; b.st[1] = nx; }
        const unsigned old = xb_add(&bar[XB_XSUB(b.x)], 1u);
        const unsigned gen = old / nloc;
        if (old + 1u == (gen + 1u) * nloc) {
            __builtin_amdgcn_fence(__ATOMIC_RELEASE, "agent");
            asm volatile("s_waitcnt vmcnt(0)" ::: "memory");
            const unsigned og = xb_add(&bar[XB_TOP], 1u);
            const unsigned tg = og / nx;
            if (og + 1u == (tg + 1u) * nx) xb_add(&bar[XB_TOPGEN], 1u);
            else XB_SPIN(xb_ld(&bar[XB_TOPGEN]) == tg, bar);
            __builtin_amdgcn_fence(__ATOMIC_ACQUIRE, "agent");
            xb_add(&bar[XB_XGEN(b.x)], 1u);
            asm volatile("s_waitcnt vmcnt(0)" ::: "memory");
        } else {
            XB_SPIN(xb_ld(&bar[XB_XGEN(b.x)]) == gen, bar);
            __builtin_amdgcn_fence(__ATOMIC_ACQUIRE, "agent");
            asm volatile("s_waitcnt vmcnt(0)" ::: "memory");
        }
    }
    __syncthreads();
}

__global__ void __launch_bounds__(512, 2) mk_fwd(Args args) {
    extern __shared__ __attribute__((aligned(16))) unsigned char lds_raw[];
    LAS unsigned char* lds = (LAS unsigned char*)lds_raw;
    Ctx X;
#pragma unroll
    for (int i = 0; i < 24; ++i) X.in[i] = args.in[i];
    X.out = args.out; X.ws = args.ws;
    X.P = (bf16_t*)(args.ws + WS_P); X.VT = (bf16_t*)(args.ws + WS_VT); X.HALO = (float*)(args.ws + WS_HALO); X.ROPE = (float*)(args.ws + WS_ROPE);
    X.Win = (bf16_t*)(args.ws + WS_WIN); X.Wg = (bf16_t*)(args.ws + WS_WG); X.Wbr = (bf16_t*)(args.ws + WS_WBR);
    X.Wo = (bf16_t*)(args.ws + WS_WO); X.Wup = (bf16_t*)(args.ws + WS_WUP); X.Wdn = (bf16_t*)(args.ws + WS_WDN);
    X.tid = threadIdx.x; X.lane = X.tid & 63; X.wave = __builtin_amdgcn_readfirstlane(X.tid >> 6); X.G = gridDim.x; X.bid = blockIdx.x;

#if PROBE_DOUBLE
    for (int ph2 = args.ph_lo * 2; ph2 < args.ph_hi * 2; ++ph2) {
        const int ph = ph2 >> 1;
        const int layer = ph / 11, sub = ph % 11;
        const bool skip_ = (ph2 & 1) && !(ph < 22 && ((REPMASK >> sub) & 1));
#else
    volatile LAS unsigned* bst = (volatile LAS unsigned*)(lds + LDS_BYTES - 64);
    if (threadIdx.x < 2) bst[threadIdx.x] = 0u;
    __syncthreads();
    XcdBarrier gbar = xcd_barrier_post((unsigned*)(args.ws + WS_BAR), bst);
    for (int ph = args.ph_lo; ph < args.ph_hi; ++ph) {
        const int layer = ph / 11, sub = ph % 11;
        const bool skip_ = false;
#endif
        const bool fusedn = (X.G == 256) && (args.ph_hi - args.ph_lo > 1);
        if (fusedn && (ph == 22 || sub == 7)) continue;
        { int t_ = threadIdx.x; asm volatile("" : "+v"(t_)); X.tid = t_; X.lane = t_ & 63; }

        if (skip_) {
        } else if (ph == 22 && (PHMASK & 1024)) {
            const int gw = X.bid * 8 + X.wave, NGW = X.G * 8;
            (void)gw; (void)NGW; rms_pass(X, X.out, X.in[23], nullptr, X.out);
        } else if (sub == 0 && (PHMASK & 1)) {
            phase_prep(X, lds, layer, !(fusedn && layer > 0));
        } else if (sub == 1 && (PHMASK & 2)) {
            pg8::Gemm g{X.P, X.Win, LDP, DM, DM}; pg8::StaticOrder S; S.init(T_TOK, 5120, X.G, X.bid);
            pg8::EpiInProj E{X.P, X.VT, X.ROPE, (bf16_t*)(X.ws + WS_BND)};
            pg8::gemm_phase<pg8::EpiInProj, true>(lds, g, S, E, X.tid);
        } else if (sub == 2 && (PHMASK & 4)) {
            phase_rwkv_pre(X, lds, layer);
        } else if (sub == 3 && (PHMASK & 4)) {
            phase_mixers(X, lds, layer);
        } else if (sub == 4 && (PHMASK & 8)) {
            phase_hgrn_post(X, layer);
            { const int gw = X.bid * 8 + X.wave, NGW = X.G * 8; const float* hh = (layer == 0) ? X.in[0] : X.out; const float* g = X.in[1] + (size_t)layer * DM;
              (void)gw; (void)NGW; rms_pass(X, hh, g, X.P, nullptr); }
        } else if (sub == 5 && (PHMASK & 16)) {
#pragma unroll 1
            for (int br = 0; br < 3; ++br) {
                { pg8::Gemm g{X.P, X.Wg + (size_t)br * DM * DM, LDP, DM, DM}; pg8::StaticOrder S; S.init(T_TOK, DM, X.G, X.bid);
                  int t_ = X.tid; asm volatile("" : "+v"(t_));
                  pg8::EpiGate E{X.P}; pg8::gemm_phase<pg8::EpiGate, true>(lds, g, S, E, t_); }
                { const int ycol = br == 0 ? COL_YA : (br == 1 ? COL_YB : COL_YC);
                  pg8::Gemm g{X.P + ycol, X.Wbr + (size_t)br * DM * 512, LDP, 512, 512}; pg8::StaticOrder S; S.init(T_TOK, DM, X.G, X.bid);
                  int t_ = X.tid; asm volatile("" : "+v"(t_));
                  pg8::EpiMergeAcc E{X.P, br == 0 ? 1 : 0}; pg8::gemm_phase<pg8::EpiMergeAcc, true>(lds, g, S, E, t_); }
            }
        } else if (sub == 6 && (PHMASK & 32)) {
            pg8::Gemm g{X.P + COL_MRG, X.Wo, LDP, DM, DM}; pg8::StaticOrder S; S.init(T_TOK, DM, X.G, X.bid);
            if (fusedn) {
                pg8::EpiResidNorm E{layer == 0 ? X.in[0] : X.out, X.out, X.in[18] + (size_t)layer * DM, X.P, nullptr,
                                    (unsigned*)(X.ws + WS_XB) + (size_t)(layer * 2) * 65536, (unsigned*)(X.ws + WS_XC) + (layer * 2) * 4096};
                pg8::gemm_phase<pg8::EpiResidNorm, false>(lds, g, S, E, X.tid);
            } else {
            pg8::EpiResid E{layer == 0 ? X.in[0] : X.out, X.out};
            pg8::gemm_phase<pg8::EpiResid, true>(lds, g, S, E, X.tid);
            }
        } else if (sub == 7 && (PHMASK & 64)) {
            const int gw = X.bid * 8 + X.wave, NGW = X.G * 8;
            const float* g = X.in[18] + (size_t)layer * DM;
            (void)gw; (void)NGW; rms_pass(X, X.out, g, X.P, nullptr);
        } else if (sub == 8 && (PHMASK & 128)) {
            pg8::Gemm g{X.P, X.Wup, LDP, DM, DM}; pg8::StaticOrder S; S.init(T_TOK, F2, X.G, X.bid);
            pg8::EpiUp E{X.P, X.HALO, X.in[20] + (size_t)layer * 3 * F2, X.in[21] + (size_t)layer * F2, (LAS float*)(lds + 131072)};
            pg8::gemm_phase<pg8::EpiUp, true>(lds, g, S, E, X.tid);
        } else if (sub == 9 && (PHMASK & 256)) {
            phase_fixup(X, layer);
        } else if (sub == 10 && (PHMASK & 512)) {
            pg8::Gemm g{X.P + COL_ACT, X.Wdn, LDP, DFF, DFF}; pg8::StaticOrder S; S.init(T_TOK, DM, X.G, X.bid);
            if (fusedn) {
                const bool last = (layer == 1);
                pg8::EpiResidNorm E{X.out, last ? nullptr : X.out, last ? X.in[23] : X.in[1] + (size_t)DM, last ? nullptr : X.P, last ? X.out : nullptr,
                                    (unsigned*)(X.ws + WS_XB) + (size_t)(layer * 2 + 1) * 65536, (unsigned*)(X.ws + WS_XC) + (layer * 2 + 1) * 4096};
                pg8::gemm_phase<pg8::EpiResidNorm, false>(lds, g, S, E, X.tid);
            } else {
            pg8::EpiResid E{X.out, X.out};
            pg8::gemm_phase<pg8::EpiResid, true>(lds, g, S, E, X.tid);
            }
        }
#if PROBE_DOUBLE
        if (ph2 + 1 < args.ph_hi * 2) cg::this_grid().sync();
#else
        if (ph + 1 < args.ph_hi && !(fusedn && ph == 21)) { if (args.ph_hi > 1000) cg::this_grid().sync(); else xcd_barrier(gbar); }
#endif
    }
}

extern "C" void kernel_launch(void* const* d_in, const int* in_sizes, int n_in, void* d_out, int out_size, void* d_ws, size_t ws_size, hipStream_t stream) {
    static int grid = 0;
    if (grid == 0) {
        int dev = 0, cus = 0, per_cu = 0;
        (void)hipGetDevice(&dev);
        (void)hipDeviceGetAttribute(&cus, hipDeviceAttributeMultiprocessorCount, dev);
        if (hipFuncSetAttribute((const void*)mk_fwd, hipFuncAttributeMaxDynamicSharedMemorySize, LDS_BYTES) != hipSuccess) fprintf(stderr, "kernel_launch: hipFuncSetAttribute failed\n");
        if (hipOccupancyMaxActiveBlocksPerMultiprocessor(&per_cu, (const void*)mk_fwd, 512, LDS_BYTES) != hipSuccess || per_cu < 1) { fprintf(stderr, "kernel_launch: occupancy query gave %d\n", per_cu); per_cu = 1; }
        (void)hipGetLastError();
        grid = cus * 1;
        if (grid <= 0) grid = 256;
        if (ws_size < (size_t)268435456) fprintf(stderr, "kernel_launch: workspace too small (%zu)\n", ws_size);
    }
    Args a{};
    for (int i = 0; i < 24; ++i) a.in[i] = (const float*)d_in[i];
    a.out = (float*)d_out; a.ws = (unsigned char*)d_ws;
#if MK_SINGLE
    (void)hipMemsetAsync((char*)d_ws + WS_BAR, 0, 16384 + 65536, stream);
    a.ph_lo = 0; a.ph_hi = 23;
    void* kargs[] = {&a};
    hipError_t e = hipLaunchCooperativeKernel((const void*)mk_fwd, dim3(grid), dim3(512), kargs, LDS_BYTES, stream);
    if (e != hipSuccess) fprintf(stderr, "cooperative launch failed: %s (grid %d)\n", hipGetErrorString(e), grid);
#else
    for (int ph = 0; ph < 23; ++ph) {
        a.ph_lo = ph; a.ph_hi = ph + 1;
        hipLaunchKernelGGL(mk_fwd, dim3(grid), dim3(512), LDS_BYTES, stream, a);
    }
#endif
}
```

```cpp
#include <hip/hip_runtime.h>
#include <hip/hip_cooperative_groups.h>
#include <cstdio>
#include <cstdint>
namespace cg = cooperative_groups;

#ifndef PHMASK
#define PHMASK 2047
#endif
#ifndef REPMASK
#define REPMASK 0
#endif
#ifndef PROBE_DOUBLE
#define PROBE_DOUBLE 0
#endif
#ifndef PROBE_SCAN2
#define PROBE_SCAN2 0
#endif
#ifndef TKMASK
#define TKMASK 7
#endif
#ifndef MK_SINGLE
#define MK_SINGLE 1
#endif

#define LAS __attribute__((address_space(3)))
typedef unsigned short bf16_t;
typedef short bf16x8 __attribute__((ext_vector_type(8)));
typedef float f32x4 __attribute__((ext_vector_type(4)));
typedef float f32x2 __attribute__((ext_vector_type(2)));
typedef unsigned u32x4 __attribute__((ext_vector_type(4)));
typedef unsigned u32x2 __attribute__((ext_vector_type(2)));

constexpr int T_TOK = 16384, SEQ = 2048, DM = 1024;
constexpr int LDP = 6208;
constexpr int COL_PA = 1024, COL_PB = 2816, COL_PC = 4864;
constexpr int COL_YA = 1024, COL_MRG = 1536, COL_G = 2816, COL_YB = 3840, COL_YC = 4864, COL_ACT = 1024;
constexpr int COL_GS = 5960;
constexpr int C_Q = 4864, C_K = 5376, C_QI = 5632, C_KI = 5888, C_WI = 5952;
constexpr int IN_COLS = 8004, DFF = 2816, F2 = 5632;
constexpr size_t WS_WIN = 0, WS_WG = 10485760, WS_WBR = 16777216, WS_WO = 19922944, WS_WUP = 22020096, WS_WDN = 33554432;
constexpr size_t WS_P = 39321600, WS_HALO = 242745344, WS_VT = WS_HALO, WS_ROPE = 265814016, WS_BAR = 266338304, WS_BND = WS_HALO + 4194304, WS_SCAL = WS_HALO + 8388608, WS_XC = WS_BAR + 16384, WS_XB = WS_XC + 65536;
constexpr int LDS_BYTES = 153600;
constexpr int SCS = 2052;
constexpr int MASK_OFF = 16 * SCS * 4;

struct Args { const float* in[24]; float* out; unsigned char* ws; int ph_lo, ph_hi; };

__device__ __forceinline__ unsigned f2bf(float f) { unsigned u = __builtin_bit_cast(unsigned, f); return (u + 0x7fffu + ((u >> 16) & 1u)) >> 16; }
__device__ __forceinline__ unsigned pk2(float lo, float hi) { return f2bf(lo) | (f2bf(hi) << 16); }
__device__ __forceinline__ float bf2f(bf16_t b) { return __builtin_bit_cast(float, (unsigned)b << 16); }
__device__ __forceinline__ float bflo(unsigned w) { return __builtin_bit_cast(float, w << 16); }
__device__ __forceinline__ float bfhi(unsigned w) { return __builtin_bit_cast(float, w & 0xffff0000u); }
__device__ __forceinline__ float wave_sum(float v) {
#pragma unroll
    for (int o = 1; o < 64; o <<= 1) v += __shfl_xor(v, o);
    return v;
}
__device__ __forceinline__ int wave_sum_i(int v) {
#pragma unroll
    for (int o = 1; o < 64; o <<= 1) v += __shfl_xor(v, o);
    return v;
}
template <int CTRL> __device__ __forceinline__ float dpp_mov(float x) {
    return __builtin_bit_cast(float, __builtin_amdgcn_update_dpp(0, __builtin_bit_cast(int, x), CTRL, 0xF, 0xF, true));
}
__device__ __forceinline__ float red8(float x) { x += dpp_mov<0xB1>(x); x += dpp_mov<0x4E>(x); x += dpp_mov<0x141>(x); return x; }
__device__ __forceinline__ float red16(float x) { x = red8(x); x += dpp_mov<0x140>(x); return x; }
__device__ __forceinline__ float sigmoidf_(float x) { return 1.f / (1.f + __expf(-x)); }

namespace pg8 {
constexpr int BM = 256, BK = 64, HALF = 128, HTB = HALF * BK * 2, NXCD = 8, WGM = 8;
__device__ __forceinline__ int lds_byte(int r, int c) { const int st = (r >> 4) * 2 + (c >> 5), rr = r & 15, cc = c & 31, ob = rr * 64 + cc * 2; return st * 1024 + (ob ^ (((ob >> 9) & 1) << 5)); }
__device__ __forceinline__ void stage_rc(int b, int& R, int& C) { const int st = b / 1024, sb = b % 1024, swz = sb ^ (((sb >> 9) & 1) << 5); R = (st >> 1) * 16 + swz / 64; C = (st & 1) * 32 + (swz % 64) / 2; }
__device__ __forceinline__ int perm32(int rho) { const int n = rho >> 4, i = rho & 15; return 8 * (i >> 2) + 4 * n + (i & 3); }
struct Unit { int pm, pn; };
struct Gemm { const bf16_t* A; const bf16_t* Bt; int lda, ldb, K; };
struct StaticOrder {
    int nM, nN, nwg, G, c;
    __device__ void init(int M, int N, int G_, int c_) { nM = M / BM; nN = N / BM; nwg = nM * nN; G = G_; c = c_; }
    __device__ bool next(int i, Unit& u) const {
        const long L = (long)i * G + c; if (L >= nwg) return false;
        int wgid = (int)L; { const int q = nwg / NXCD, r = nwg % NXCD, xcd = wgid % NXCD, off = wgid / NXCD; wgid = (xcd < r ? xcd * (q + 1) : r * (q + 1) + (xcd - r) * q) + off; }
        const int nig = WGM * nN, gid = wgid / nig, fm = gid * WGM, gsz = (nM - fm) < WGM ? (nM - fm) : WGM;
        u.pm = fm + ((wgid % nig) % gsz); u.pn = (wgid % nig) / gsz; return true;
    }
};
__device__ __forceinline__ unsigned cvt_pk_bf16(float lo, float hi) { unsigned r; asm volatile("v_cvt_pk_bf16_f32 %0, %1, %2" : "=v"(r) : "v"(lo), "v"(hi)); return r; }

template <class Epi, bool ALIGN_EPI>
__device__ __forceinline__ void gemm_phase(LAS unsigned char* lds, const Gemm g, const StaticOrder& S, const Epi& E, const int tid) {
    const int wid = __builtin_amdgcn_readfirstlane(tid >> 6), lane = tid & 63, wr = wid >> 2, wc = wid & 3, fr = lane & 15, fq = lane >> 4;
    const int K = g.K, nt = K / BK;
    unsigned voffA[2], voffB[2];
#pragma unroll
    for (int i = 0; i < 2; ++i) { int R, C; stage_rc(tid * 16 + i * 8192, R, C); const int Rb = (R & ~31) + perm32(R & 31);
        voffA[i] = (unsigned)(R * g.lda + C) * 2u; voffB[i] = (unsigned)(Rb * g.ldb + C) * 2u; }
    const size_t kstep = (size_t)(BK * 2);
    const size_t hstepA = (size_t)HALF * g.lda * 2, hstepB = (size_t)HALF * g.ldb * 2;
    const size_t tstepA = 2 * hstepA, tstepB = 2 * hstepB;
    const unsigned ldsw = (unsigned)wid * 1024u;
    const int aoff = lds_byte(wr * 64 + fr, fq * 8), boff = lds_byte(wc * 32 + fr, fq * 8);
#define PG8_SA(b, h) (((b) * 2 + (h)) * HTB)
#define PG8_SB(b, h) ((4 + (b) * 2 + (h)) * HTB)
#define PG8_STAGE(bufoff, gbase, voff) do { _Pragma("unroll") for (int _i = 0; _i < 2; ++_i) \
        __builtin_amdgcn_global_load_lds((const unsigned*)((const char*)(gbase) + (voff)[_i]), (LAS unsigned*)(lds + (bufoff) + ldsw + _i * 8192), 16, 0, 0); } while (0)
#define PG8_LDA(dst, b, h) do { _Pragma("unroll") for (int m = 0; m < 4; ++m) _Pragma("unroll") for (int k = 0; k < 2; ++k) dst[m][k] = *(const LAS bf16x8*)(lds + PG8_SA(b, h) + aoff + m * 2048 + k * 1024); } while (0)
#define PG8_LDB(dst, b, h) do { _Pragma("unroll") for (int n = 0; n < 2; ++n) _Pragma("unroll") for (int k = 0; k < 2; ++k) dst[n][k] = *(const LAS bf16x8*)(lds + PG8_SB(b, h) + boff + n * 2048 + k * 1024); } while (0)
#define PG8_MMA(ai, bj, At, Bt) do { __builtin_amdgcn_s_setprio(1); _Pragma("unroll") for (int m = 0; m < 4; ++m) _Pragma("unroll") for (int n = 0; n < 2; ++n) _Pragma("unroll") for (int k = 0; k < 2; ++k) \
        acc[ai][bj][m][n] = __builtin_amdgcn_mfma_f32_16x16x32_bf16(Bt[n][k], At[m][k], acc[ai][bj][m][n], 0, 0, 0); __builtin_amdgcn_s_setprio(0); } while (0)
#define PG8_WAIT_V(n) asm volatile("s_waitcnt vmcnt(" #n ")" ::: "memory")
#define PG8_WAIT_L(n) asm volatile("s_waitcnt lgkmcnt(" #n ")" ::: "memory")
#define PG8_BAR __builtin_amdgcn_s_barrier()
#define PG8_SCHED __builtin_amdgcn_sched_barrier(0)
    Unit cur, nxt; int ui = 0;
    if (!S.next(0, cur)) return;
    f32x4 acc[2][2][4][2];
#pragma unroll
    for (int a = 0; a < 2; ++a)
#pragma unroll
        for (int b = 0; b < 2; ++b)
#pragma unroll
            for (int m = 0; m < 4; ++m)
#pragma unroll
                for (int n = 0; n < 2; ++n) acc[a][b][m][n] = (f32x4){0.f, 0.f, 0.f, 0.f};
    bf16x8 At[4][2], B0[2][2], B1[2][2];
    const char* cA = (const char*)g.A + (size_t)cur.pm * tstepA; const char* cB = (const char*)g.Bt + (size_t)cur.pn * tstepB;
    PG8_STAGE(PG8_SB(0, 0), cB, voffB); PG8_STAGE(PG8_SB(0, 1), cB + hstepB, voffB); PG8_STAGE(PG8_SA(0, 0), cA, voffA); PG8_STAGE(PG8_SA(0, 1), cA + hstepA, voffA);
    if (wr == 1) PG8_BAR;
    PG8_WAIT_V(2); PG8_BAR;
    PG8_STAGE(PG8_SB(1, 0), cB + kstep, voffB); PG8_STAGE(PG8_SA(1, 0), cA + kstep, voffA); PG8_STAGE(PG8_SB(1, 1), cB + hstepB + kstep, voffB);
    PG8_WAIT_V(6); PG8_BAR;
    for (;;) {
        const bool has_next = S.next(ui + 1, nxt);
        const char* nA = has_next ? (const char*)g.A + (size_t)nxt.pm * tstepA : cA; const char* nB = has_next ? (const char*)g.Bt + (size_t)nxt.pn * tstepB : cB;
        for (int t = 0; t < nt; t += 2) {
            const bool last = (t == nt - 2);
            const char* a1 = cA + (size_t)(t + 1) * kstep;
            const char* a2 = last ? nA : cA + (size_t)(t + 2) * kstep; const char* b2 = last ? nB : cB + (size_t)(t + 2) * kstep;
            const char* a3 = a2 + kstep; const char* b3 = b2 + kstep;
            PG8_LDB(B0, 0, 0); PG8_LDB(B1, 0, 1); PG8_SCHED; PG8_LDA(At, 0, 0); PG8_STAGE(PG8_SA(1, 1), a1 + hstepA, voffA);
            PG8_WAIT_V(8); PG8_WAIT_L(0); PG8_BAR; PG8_MMA(0, 0, At, B0); PG8_MMA(0, 1, At, B1); PG8_BAR; PG8_SCHED;
            PG8_LDA(At, 0, 1); PG8_STAGE(PG8_SB(0, 0), b2, voffB); PG8_STAGE(PG8_SB(0, 1), b2 + hstepB, voffB); PG8_STAGE(PG8_SA(0, 0), a2, voffA);
            PG8_WAIT_V(8); PG8_WAIT_L(0); PG8_BAR; PG8_MMA(1, 0, At, B0); PG8_MMA(1, 1, At, B1); PG8_BAR; PG8_SCHED;
            PG8_LDB(B0, 1, 0); PG8_LDB(B1, 1, 1); PG8_SCHED; PG8_LDA(At, 1, 0); PG8_STAGE(PG8_SA(0, 1), a2 + hstepA, voffA);
            PG8_WAIT_V(8); PG8_WAIT_L(0); PG8_BAR; PG8_MMA(0, 0, At, B0); PG8_MMA(0, 1, At, B1); PG8_BAR; PG8_SCHED;
            PG8_LDA(At, 1, 1); PG8_STAGE(PG8_SB(1, 0), b3, voffB); PG8_STAGE(PG8_SB(1, 1), b3 + hstepB, voffB); PG8_STAGE(PG8_SA(1, 0), a3, voffA);
            PG8_WAIT_V(8); PG8_WAIT_L(0); PG8_BAR; PG8_MMA(1, 0, At, B0); PG8_MMA(1, 1, At, B1); PG8_BAR; PG8_SCHED;
        }
        if constexpr (ALIGN_EPI) { if (wr == 0) PG8_BAR; }
        if constexpr (!Epi::AFTER_DRAIN) E(acc, cur, wr, wc, fr, fq);
        if (!has_next) break;
#pragma unroll
        for (int a = 0; a < 2; ++a)
#pragma unroll
            for (int b = 0; b < 2; ++b)
#pragma unroll
                for (int m = 0; m < 4; ++m)
#pragma unroll
                    for (int n = 0; n < 2; ++n) acc[a][b][m][n] = (f32x4){0.f, 0.f, 0.f, 0.f};
        cur = nxt; cA = nA; cB = nB; ++ui;
        if constexpr (ALIGN_EPI) { if (wr == 1) PG8_BAR; }
    }
    PG8_WAIT_V(0);
    if constexpr (!ALIGN_EPI) { if (wr == 0) PG8_BAR; }
    PG8_BAR;
    if constexpr (Epi::AFTER_DRAIN) E.fused(acc, cur, wr, wc, fr, fq, lds, wid, lane);
#undef PG8_SA
#undef PG8_SB
#undef PG8_STAGE
#undef PG8_LDA
#undef PG8_LDB
#undef PG8_MMA
#undef PG8_WAIT_V
#undef PG8_WAIT_L
#undef PG8_BAR
#undef PG8_SCHED
}

typedef f32x4 AccT[2][2][4][2];

struct EpiInProj {
    static constexpr bool AFTER_DRAIN = false;
    bf16_t* P; bf16_t* VT; const float* rope; bf16_t* BND;
    __device__ __forceinline__ void operator()(AccT& acc, const Unit& u, int wr, int wc, int fr, int fq) const {
        const int row0 = u.pm * BM + wr * 64 + fr, colb = u.pn * BM + wc * 32 + 8 * fq;
#pragma unroll
        for (int ai = 0; ai < 2; ++ai)
#pragma unroll
            for (int m = 0; m < 4; ++m) {
                const int row = row0 + ai * HALF + m * 16, t = row & (SEQ - 1);
                bf16_t* rowp = P + (size_t)row * LDP + COL_PA;
#pragma unroll
                for (int bj = 0; bj < 2; ++bj) {
                    const int c = colb + bj * HALF;
                    f32x4 v0 = acc[ai][bj][m][0], v1 = acc[ai][bj][m][1];
                    if (u.pn >= 15) {
                        const int cl = c - 3840;
                        if (cl < 640 || (cl >= 768 && cl < 1088)) {
                            const float* cs = rope + ((size_t)t * 32 + ((cl & 63) >> 1)) * 2;
                            const f32x4 r0 = *(const f32x4*)cs, r1 = *(const f32x4*)(cs + 4);
                            f32x4 o0, o1;
                            o0[0] = v0[0] * r0[0] - v0[1] * r0[1]; o0[1] = v0[1] * r0[0] + v0[0] * r0[1];
                            o0[2] = v0[2] * r0[2] - v0[3] * r0[3]; o0[3] = v0[3] * r0[2] + v0[2] * r0[3];
                            o1[0] = v1[0] * r1[0] - v1[1] * r1[1]; o1[1] = v1[1] * r1[0] + v1[0] * r1[1];
                            o1[2] = v1[2] * r1[2] - v1[3] * r1[3]; o1[3] = v1[3] * r1[2] + v1[2] * r1[3];
                            v0 = o0; v1 = o1;
                        }
                    }
                    u32x4 w; w.x = cvt_pk_bf16(v0[0], v0[1]); w.y = cvt_pk_bf16(v0[2], v0[3]); w.z = cvt_pk_bf16(v1[0], v1[1]); w.w = cvt_pk_bf16(v1[2], v1[3]);
                    *(u32x4*)(rowp + c) = w;
                    if (u.pn < 7 && fr == 15) *(u32x4*)(BND + (size_t)(row >> 4) * 1792 + c) = w;
                    if (u.pn == 17 && bj == 1) {
                        const int cv = c - 3840 - 640, b = row >> 11;
                        bf16_t* vt = VT + ((size_t)(b * 2 + (cv >> 6)) * 64 + (cv & 63)) * SEQ + t;
                        vt[0 * SEQ] = (bf16_t)(w.x & 0xffffu); vt[1 * SEQ] = (bf16_t)(w.x >> 16);
                        vt[2 * SEQ] = (bf16_t)(w.y & 0xffffu); vt[3 * SEQ] = (bf16_t)(w.y >> 16);
                        vt[4 * SEQ] = (bf16_t)(w.z & 0xffffu); vt[5 * SEQ] = (bf16_t)(w.z >> 16);
                        vt[6 * SEQ] = (bf16_t)(w.w & 0xffffu); vt[7 * SEQ] = (bf16_t)(w.w >> 16);
                    }
                }
            }
    }
};
struct EpiGate {
    static constexpr bool AFTER_DRAIN = false;
    bf16_t* P;
    __device__ __forceinline__ void operator()(AccT& acc, const Unit& u, int wr, int wc, int fr, int fq) const {
        const int row0 = u.pm * BM + wr * 64 + fr, colb = u.pn * BM + wc * 32 + 8 * fq;
#pragma unroll
        for (int ai = 0; ai < 2; ++ai)
#pragma unroll
            for (int m = 0; m < 4; ++m) {
                bf16_t* rowp = P + (size_t)(row0 + ai * HALF + m * 16) * LDP + COL_G + colb;
#pragma unroll
                for (int bj = 0; bj < 2; ++bj) {
                    const f32x4 v0 = acc[ai][bj][m][0], v1 = acc[ai][bj][m][1];
                    u32x4 w; w.x = cvt_pk_bf16(sigmoidf_(v0[0]), sigmoidf_(v0[1])); w.y = cvt_pk_bf16(sigmoidf_(v0[2]), sigmoidf_(v0[3]));
                    w.z = cvt_pk_bf16(sigmoidf_(v1[0]), sigmoidf_(v1[1])); w.w = cvt_pk_bf16(sigmoidf_(v1[2]), sigmoidf_(v1[3]));
                    *(u32x4*)(rowp + bj * HALF) = w;
                }
            }
    }
};
struct EpiMergeAcc {
    static constexpr bool AFTER_DRAIN = false;
    bf16_t* P; int first;
    __device__ __forceinline__ void operator()(AccT& acc, const Unit& u, int wr, int wc, int fr, int fq) const {
        const int row0 = u.pm * BM + wr * 64 + fr, colb = u.pn * BM + wc * 32 + 8 * fq;
#pragma unroll
        for (int ai = 0; ai < 2; ++ai)
#pragma unroll
            for (int m = 0; m < 4; ++m) {
                bf16_t* rowb = P + (size_t)(row0 + ai * HALF + m * 16) * LDP + colb;
#pragma unroll
                for (int bj = 0; bj < 2; ++bj) {
                    const f32x4 v0 = acc[ai][bj][m][0], v1 = acc[ai][bj][m][1];
                    const u32x4 gq = *(const u32x4*)(rowb + COL_G + bj * HALF);
                    u32x4 mq = (u32x4){0u, 0u, 0u, 0u};
                    if (!first) mq = *(const u32x4*)(rowb + COL_MRG + bj * HALF);
                    const unsigned ga = gq.x, gb = gq.y, gc = gq.z, gd = gq.w;
                    const unsigned ma = mq.x, mb = mq.y, mc = mq.z, md = mq.w;
                    u32x4 w;
                    w.x = cvt_pk_bf16(bflo(ma) + bflo(ga) * v0[0], bfhi(ma) + bfhi(ga) * v0[1]);
                    w.y = cvt_pk_bf16(bflo(mb) + bflo(gb) * v0[2], bfhi(mb) + bfhi(gb) * v0[3]);
                    w.z = cvt_pk_bf16(bflo(mc) + bflo(gc) * v1[0], bfhi(mc) + bfhi(gc) * v1[1]);
                    w.w = cvt_pk_bf16(bflo(md) + bflo(gd) * v1[2], bfhi(md) + bfhi(gd) * v1[3]);
                    *(u32x4*)(rowb + COL_MRG + bj * HALF) = w;
                }
            }
    }
};
struct EpiResid {
    static constexpr bool AFTER_DRAIN = false;
    const float* base; float* out;
    __device__ __forceinline__ void operator()(AccT& acc, const Unit& u, int wr, int wc, int fr, int fq) const {
        const int row0 = u.pm * BM + wr * 64 + fr, colb = u.pn * BM + wc * 32 + 8 * fq;
#pragma unroll
        for (int ai = 0; ai < 2; ++ai)
#pragma unroll
            for (int m = 0; m < 4; ++m) {
                const size_t off = (size_t)(row0 + ai * HALF + m * 16) * DM + colb;
#pragma unroll
                for (int bj = 0; bj < 2; ++bj) {
                    const f32x4 b0 = *(const f32x4*)(base + off + bj * HALF), b1 = *(const f32x4*)(base + off + bj * HALF + 4);
                    *(f32x4*)(out + off + bj * HALF) = b0 + acc[ai][bj][m][0];
                    *(f32x4*)(out + off + bj * HALF + 4) = b1 + acc[ai][bj][m][1];
                }
            }
    }
};
struct EpiResidNorm {
    static constexpr bool AFTER_DRAIN = true;
    const float* base; float* out; const float* g; bf16_t* obf; float* of32; unsigned* xbuf; unsigned* cnt;
    __device__ __forceinline__ void fused(AccT& acc, const Unit& u, int wr, int wc, int fr, int fq, LAS unsigned char* lds, int wid, int lane) const {
        LAS float* Pl = (LAS float*)lds;
        LAS float* S = (LAS float*)(lds + 8192);
        const int row0 = u.pm * BM + wr * 64 + fr, colb = u.pn * BM + wc * 32 + 8 * fq;
#pragma unroll
        for (int ai = 0; ai < 2; ++ai)
#pragma unroll
            for (int m = 0; m < 4; ++m) {
                const size_t off = (size_t)(row0 + ai * HALF + m * 16) * DM + colb;
                float sq = 0.f;
#pragma unroll
                for (int bj = 0; bj < 2; ++bj) {
                    const f32x4 b0 = *(const f32x4*)(base + off + bj * HALF), b1 = *(const f32x4*)(base + off + bj * HALF + 4);
                    const f32x4 h0 = acc[ai][bj][m][0] + b0, h1 = acc[ai][bj][m][1] + b1;
                    acc[ai][bj][m][0] = h0; acc[ai][bj][m][1] = h1;
                    sq += (h0.x * h0.x + h0.y * h0.y) + (h0.z * h0.z + h0.w * h0.w) + (h1.x * h1.x + h1.y * h1.y) + (h1.z * h1.z + h1.w * h1.w);
                }
                sq += __shfl_xor(sq, 16); sq += __shfl_xor(sq, 32);
                if (fq == 0) Pl[(ai * HALF + wr * 64 + m * 16 + fr) * 4 + wc] = sq;
                if (m & 1) asm volatile("" ::: "memory");
            }
        asm volatile("s_waitcnt lgkmcnt(0)" ::: "memory"); __builtin_amdgcn_s_barrier(); asm volatile("" ::: "memory");
        const int row = wid * 32 + (lane & 31);
        if (lane < 32) {
            const f32x4 p = *(const LAS f32x4*)&Pl[row * 4];
            __hip_atomic_store(xbuf + ((size_t)(u.pm * BM + row) * 4 + u.pn), __builtin_bit_cast(unsigned, (p.x + p.y) + (p.z + p.w)), __ATOMIC_RELAXED, __HIP_MEMORY_SCOPE_AGENT);
        }
        asm volatile("s_waitcnt vmcnt(0)" ::: "memory");
        if (lane == 0) __hip_atomic_fetch_add(cnt + 64 * u.pm, 1u, __ATOMIC_RELAXED, __HIP_MEMORY_SCOPE_AGENT);
        if (wid == 0) {
            unsigned sp = 0u;
            while ((unsigned)__builtin_amdgcn_readfirstlane(__hip_atomic_load(cnt + 64 * u.pm, __ATOMIC_RELAXED, __HIP_MEMORY_SCOPE_AGENT)) < 32u) { __builtin_amdgcn_s_sleep(2); if (++sp > (1u << 22)) break; }
            __builtin_amdgcn_fence(__ATOMIC_ACQUIRE, "agent");
        }
        asm volatile("s_waitcnt vmcnt(0) lgkmcnt(0)" ::: "memory"); __builtin_amdgcn_s_barrier(); asm volatile("" ::: "memory");
        if (lane < 32) {
            const unsigned* slot = xbuf + (size_t)(u.pm * BM + row) * 4; float tot = 0.f;
#pragma unroll
            for (int t = 0; t < 4; ++t) tot += __builtin_bit_cast(float, __hip_atomic_load(slot + t, __ATOMIC_RELAXED, __HIP_MEMORY_SCOPE_AGENT));
            S[row] = 1.0f / sqrtf(tot * (1.f / DM) + 1e-6f);
        }
        asm volatile("s_waitcnt lgkmcnt(0)" ::: "memory"); __builtin_amdgcn_s_barrier(); asm volatile("" ::: "memory");
        f32x4 gv[2][2];
#pragma unroll
        for (int bj = 0; bj < 2; ++bj)
#pragma unroll
            for (int n = 0; n < 2; ++n) gv[bj][n] = *(const f32x4*)(g + colb + bj * HALF + 4 * n);
#pragma unroll
        for (int ai = 0; ai < 2; ++ai)
#pragma unroll
            for (int m = 0; m < 4; ++m) {
                const int rl = ai * HALF + wr * 64 + m * 16 + fr, rowg = u.pm * BM + rl;
                const float rs = S[rl];
#pragma unroll
                for (int bj = 0; bj < 2; ++bj) {
                    const f32x4 h0 = acc[ai][bj][m][0], h1 = acc[ai][bj][m][1];
                    const size_t off = (size_t)rowg * DM + colb + bj * HALF;
                    if (out) { *(f32x4*)(out + off) = h0; *(f32x4*)(out + off + 4) = h1; }
                    const f32x4 o0 = h0 * rs * gv[bj][0], o1 = h1 * rs * gv[bj][1];
                    if (obf) { u32x4 w; w.x = cvt_pk_bf16(o0[0], o0[1]); w.y = cvt_pk_bf16(o0[2], o0[3]); w.z = cvt_pk_bf16(o1[0], o1[1]); w.w = cvt_pk_bf16(o1[2], o1[3]);
                        *(u32x4*)(obf + (size_t)rowg * LDP + colb + bj * HALF) = w; }
                    else { *(f32x4*)(of32 + off) = o0; *(f32x4*)(of32 + off + 4) = o1; }
                }
                asm volatile("" ::: "memory");
            }
    }
};
struct EpiUp {
    static constexpr bool AFTER_DRAIN = false;
    bf16_t* P; float* HALO; const float* cw; const float* cb; LAS float* CW;
    __device__ __forceinline__ void operator()(AccT& acc, const Unit& u, int wr, int wc, int fr_in, int fq_in) const {
        int fr = fr_in, fq = fq_in;
        asm volatile("" : "+v"(fr), "+v"(fq));
        const int row0 = u.pm * BM + wr * 64 + fr;
        const int jb = u.pn * 128 + wc * 32 + 8 * fq;
        {
            const int tl = (wr * 4 + wc) * 64 + fq * 16 + fr;
#pragma unroll
            for (int it = 0; it < 2; ++it) { const int k = tl + 512 * it, p = k >> 8, col = k & 255, co = (col >> 7) * DFF + u.pn * 128 + (col & 127);
                CW[k] = (p < 3) ? cw[p * F2 + co] : cb[co]; }
            asm volatile("s_waitcnt lgkmcnt(0)" ::: "memory"); __builtin_amdgcn_s_barrier(); asm volatile("" ::: "memory");
        }
#pragma unroll
        for (int ai = 0; ai < 2; ++ai) {
            const int s = u.pm * 4 + ai * 2 + wr;
#pragma unroll
            for (int bj = 0; bj < 2; ++bj)
#pragma unroll
                for (int n = 0; n < 2; ++n) {
                    const int colp = u.pn * BM + bj * HALF + wc * 32 + 8 * fq + 4 * n;
                    if (fr < 2) *(f32x4*)(HALO + (size_t)(s * 4 + fr) * F2 + colp) = acc[ai][bj][0][n];
                    if (fr >= 14) *(f32x4*)(HALO + (size_t)(s * 4 + fr - 12) * F2 + colp) = acc[ai][bj][3][n];
                }
        }
#pragma unroll
        for (int ai = 0; ai < 2; ++ai)
#pragma unroll
            for (int m = 0; m < 4; ++m) {
                const int row = row0 + ai * HALF + m * 16;
#pragma unroll
                for (int n = 0; n < 2; ++n) {
                    f32x4 cv[2];
#pragma unroll
                    for (int bj = 0; bj < 2; ++bj) {
                        const int cl = bj * 128 + wc * 32 + 8 * fq + 4 * n;
                        const f32x4 w0 = *(const LAS f32x4*)&CW[cl], w1 = *(const LAS f32x4*)&CW[256 + cl], w2 = *(const LAS f32x4*)&CW[512 + cl], bb = *(const LAS f32x4*)&CW[768 + cl];
#pragma unroll
                        for (int e = 0; e < 4; ++e) {
                            const float cur = acc[ai][bj][m][n][e];
                            const float prv = m > 0 ? acc[ai][bj][m > 0 ? m - 1 : 0][n][e] : 0.f;
                            const float a1 = dpp_mov<0x121>(cur), a2 = dpp_mov<0x122>(cur), b1 = dpp_mov<0x121>(prv), b2 = dpp_mov<0x122>(prv);
                            const float p1 = fr >= 1 ? a1 : b1, p2 = fr >= 2 ? a2 : b2;
                            cv[bj][e] = bb[e] + w0[e] * p2 + w1[e] * p1 + w2[e] * cur;
                        }
                        __builtin_amdgcn_sched_barrier(0);
                    }
                    const f32x4 g0 = cv[0], v0 = cv[1];
                    u32x2 w;
                    w.x = cvt_pk_bf16(g0[0] * sigmoidf_(g0[0]) * v0[0], g0[1] * sigmoidf_(g0[1]) * v0[1]);
                    w.y = cvt_pk_bf16(g0[2] * sigmoidf_(g0[2]) * v0[2], g0[3] * sigmoidf_(g0[3]) * v0[3]);
                    if (!(m == 0 && fr < 2)) *(u32x2*)(P + (size_t)row * LDP + COL_ACT + jb + 4 * n) = w;
                    __builtin_amdgcn_sched_barrier(0);
                }
            }
    }
};
}

struct Ctx {
    const float* in[24]; float* out; unsigned char* ws;
    bf16_t* P; bf16_t* VT; float* HALO; float* ROPE;
    bf16_t *Win, *Wg, *Wbr, *Wo, *Wup, *Wdn;
    int tid, lane, wave, G, bid;
};

__device__ __forceinline__ int srccol(int mode, int n) {
    if (mode == 0) return n;
    if (mode == 2) return 4932 + n;
    if (mode == 3) { const int tile = n >> 8, w = n & 255, j = tile * 128 + (w & 127); return (w < 128) ? j : DFF + j; }
    if (n < 3840) return n;
    const int c = n - 3840;
    if (c >= 1092) return -1;
    if (c < 640 || (c >= 768 && c < 1088)) { const int base = c & ~63, i = c & 63; return 3840 + base + (i >> 1) + 32 * (i & 1); }
    return 3840 + c;
}
__device__ __forceinline__ void tr_item(const float* W, int ldw, int K, int N, bf16_t* WT, int mode, int item, LAS float* scr, int lane) {
    const int nblk = N / 32, kb = item / nblk, nb = item % nblk, k0 = 64 * kb, n0 = 32 * nb;
    const int sc = srccol(mode, n0 + (lane & 31));
    float wv_[32];
#pragma unroll
    for (int i = 0; i < 32; ++i) { const int kk = 2 * i + (lane >> 5); wv_[i] = (sc >= 0) ? W[(size_t)(k0 + kk) * ldw + sc] : 0.f; }
#pragma unroll
    for (int i = 0; i < 32; ++i) { const int kk = 2 * i + (lane >> 5); scr[kk * 33 + (lane & 31)] = wv_[i]; }
    asm volatile("s_waitcnt lgkmcnt(0)" ::: "memory");
    const int c = lane & 7;
#pragma unroll
    for (int j = 0; j < 4; ++j) { const int n = (lane >> 3) + 8 * j; const LAS float* s = scr + (8 * c) * 33 + n;
        u32x4 o; o.x = pk2(s[0 * 33], s[1 * 33]); o.y = pk2(s[2 * 33], s[3 * 33]); o.z = pk2(s[4 * 33], s[5 * 33]); o.w = pk2(s[6 * 33], s[7 * 33]);
        *(u32x4*)(WT + (size_t)(n0 + n) * K + k0 + 8 * c) = o; }
    asm volatile("s_waitcnt lgkmcnt(0)" ::: "memory");
}
__device__ __forceinline__ void rms_row(const float* xrow, const float* g, bf16_t* obf, float* of32, int lane) {
    const f32x4* xr = (const f32x4*)xrow + lane; const f32x4* gr = (const f32x4*)g + lane;
    f32x4 v[4]; float s = 0.f;
#pragma unroll
    for (int j = 0; j < 4; ++j) { v[j] = xr[64 * j]; s += (v[j].x * v[j].x + v[j].y * v[j].y) + (v[j].z * v[j].z + v[j].w * v[j].w); }
    const float rs = 1.f / sqrtf(wave_sum(s) * (1.f / DM) + 1e-6f);
#pragma unroll
    for (int j = 0; j < 4; ++j) {
        const f32x4 gg = gr[64 * j]; const f32x4 o = v[j] * rs * gg;
        if (obf) { u32x2 w; w.x = pk2(o.x, o.y); w.y = pk2(o.z, o.w); *((u32x2*)obf + lane + 64 * j) = w; }
        else *((f32x4*)of32 + lane + 64 * j) = o;
    }
}
__device__ __forceinline__ void rms_pass(const Ctx& X, const float* src, const float* g, bf16_t* obf, float* of32) {
    const int gw = X.bid * 8 + X.wave, NGW = X.G * 8, lane = X.lane;
    const f32x4* gr = (const f32x4*)g + lane;
    f32x4 gg[4];
#pragma unroll
    for (int j = 0; j < 4; ++j) gg[j] = gr[64 * j];
#pragma unroll 1
    for (int m = gw; m < T_TOK; m += 4 * NGW) {
        f32x4 v[4][4]; float ss[4]; int mr[4];
#pragma unroll
        for (int r = 0; r < 4; ++r) { mr[r] = m + r * NGW; const int ml = mr[r] < T_TOK ? mr[r] : m; const f32x4* x = (const f32x4*)(src + (size_t)ml * DM) + lane;
#pragma unroll
            for (int j = 0; j < 4; ++j) v[r][j] = x[64 * j]; }
#pragma unroll
        for (int r = 0; r < 4; ++r) { float a = 0.f;
#pragma unroll
            for (int j = 0; j < 4; ++j) a += (v[r][j].x * v[r][j].x + v[r][j].y * v[r][j].y) + (v[r][j].z * v[r][j].z + v[r][j].w * v[r][j].w);
            ss[r] = 1.f / sqrtf(wave_sum(a) * (1.f / DM) + 1e-6f); }
#pragma unroll
        for (int r = 0; r < 4; ++r) {
            if (mr[r] < T_TOK) {
#pragma unroll
                for (int j = 0; j < 4; ++j) {
                    const f32x4 o = v[r][j] * ss[r] * gg[j];
                    if (obf) { u32x2 w; w.x = pk2(o.x, o.y); w.y = pk2(o.z, o.w); *((u32x2*)(obf + (size_t)mr[r] * LDP) + lane + 64 * j) = w; }
                    else *((f32x4*)(of32 + (size_t)mr[r] * DM) + lane + 64 * j) = o;
                }
            }
        }
    }
}
__device__ __forceinline__ void phase_prep(const Ctx& X, LAS unsigned char* lds, int layer, bool do_u) {
    LAS float* scr = (LAS float*)(lds + X.wave * 8448);
    const int gw = X.bid * 8 + X.wave, NGW = X.G * 8;
    constexpr int I_IN = 16 * 160, I_G = 16 * 96, I_BR = 8 * 32, I_O = 16 * 32, I_UP = 16 * 176, I_DN = 44 * 32;
    constexpr int NITEMS = I_IN + I_G + 3 * I_BR + I_O + I_UP + I_DN;
    const float* w_in = X.in[2] + (size_t)layer * DM * IN_COLS;
    const float* w_br = X.in[16] + (size_t)layer * 3 * 512 * DM;
    const float* w_o = X.in[17] + (size_t)layer * DM * DM;
    const float* w_up = X.in[19] + (size_t)layer * DM * F2;
    const float* w_dn = X.in[22] + (size_t)layer * DFF * DM;
    for (int it = gw; it < NITEMS; it += NGW) {
        int r = it;
        if (r < I_IN) { tr_item(w_in, IN_COLS, DM, 5120, X.Win, 1, r, scr, X.lane); continue; } r -= I_IN;
        if (r < I_G) { tr_item(w_in, IN_COLS, DM, 3072, X.Wg, 2, r, scr, X.lane); continue; } r -= I_G;
        if (r < 3 * I_BR) { const int b = r / I_BR; tr_item(w_br + (size_t)b * 512 * DM, DM, 512, DM, X.Wbr + (size_t)b * DM * 512, 0, r % I_BR, scr, X.lane); continue; } r -= 3 * I_BR;
        if (r < I_O) { tr_item(w_o, DM, DM, DM, X.Wo, 0, r, scr, X.lane); continue; } r -= I_O;
        if (r < I_UP) { tr_item(w_up, F2, DM, F2, X.Wup, 3, r, scr, X.lane); continue; } r -= I_UP;
        tr_item(w_dn, DM, DFF, DM, X.Wdn, 0, r, scr, X.lane);
    }
    const float* h = (layer == 0) ? X.in[0] : X.out;
    const float* g = X.in[1] + (size_t)layer * DM;
    if (do_u) rms_pass(X, h, g, X.P, nullptr);
    if (layer == 0) {
        for (int idx = X.bid * 512 + X.tid; idx < SEQ * 32; idx += X.G * 512) {
            const int t = idx >> 5, p = idx & 31;
            const float inv = exp2f(-(float)p * 0.03125f * 13.287712379549449f);
            const float ang = (float)t * inv;
            const double rev = (double)ang * 0.15915494309189535;
            const float fr = (float)(rev - floor(rev));
            X.ROPE[2 * idx] = __builtin_amdgcn_cosf(fr); X.ROPE[2 * idx + 1] = __builtin_amdgcn_sinf(fr);
        }
    }
}

__device__ __forceinline__ float wave_sum_fast(float x) {
    x = red16(x);
    const float r0 = __builtin_bit_cast(float, __builtin_amdgcn_readlane(__builtin_bit_cast(int, x), 0)), r1 = __builtin_bit_cast(float, __builtin_amdgcn_readlane(__builtin_bit_cast(int, x), 16));
    const float r2 = __builtin_bit_cast(float, __builtin_amdgcn_readlane(__builtin_bit_cast(int, x), 32)), r3 = __builtin_bit_cast(float, __builtin_amdgcn_readlane(__builtin_bit_cast(int, x), 48));
    return (r0 + r1) + (r2 + r3);
}
#define LDS_BAR() do { asm volatile("s_waitcnt lgkmcnt(0)" ::: "memory"); __builtin_amdgcn_s_barrier(); asm volatile("" ::: "memory"); } while (0)
constexpr int RW_TS = 16, RW_NCH = SEQ / RW_TS, RW_BUF = 33280;
__device__ __forceinline__ void phase_rwkv_pre(const Ctx& X, LAS unsigned char* lds, int layer) {
    LAS float* Rr = (LAS float*)(lds);           LAS float* Kk = (LAS float*)(lds + 8192);   LAS float* Vv = (LAS float*)(lds + 16384);
    LAS float* W1 = (LAS float*)(lds + 24576);   LAS float* AS = (LAS float*)(lds + 32768);
    LAS bf16_t* WDb = (LAS bf16_t*)(lds + 40960);
    LAS bf16_t* ADb = (LAS bf16_t*)(lds + 45568);
    LAS bf16_t* WTu = (LAS bf16_t*)(lds + 50176);
    LAS bf16_t* WTa = (LAS bf16_t*)(lds + 59392);
    LAS float* MU = (LAS float*)(lds + 68608);
    const int tid = X.tid, lane = tid & 63, wv = X.wave;
    const float* mu = X.in[3] + layer * 1792;
    const float* w0 = X.in[4] + layer * 512;   const float* w_up = X.in[5] + (size_t)layer * 64 * 512;
    const float* a0 = X.in[6] + layer * 512;   const float* a_up = X.in[7] + (size_t)layer * 64 * 512;
    const float* k_k = X.in[9] + layer * 512;  const float* k_a = X.in[10] + layer * 512;  const float* r_k = X.in[11] + layer * 512;
    const bf16_t* BND = (const bf16_t*)(X.ws + WS_BND);
    float* SCAL = (float*)(X.ws + WS_SCAL);
    const int ln = lane & 15, lg = lane >> 4;
    int last_h = -1;
    float q_w0 = 0.f, q_a0 = 0.f;
    f32x4 p_kk4 = (f32x4){0.f, 0.f, 0.f, 0.f}, p_ka4 = p_kk4, p_rk4 = p_kk4;
    const int cg4 = (tid & 15) * 4;
    u32x4 pc4[3], pp4[3], gc4, gp4; bool have_pf = false;
    pc4[0] = pc4[1] = pc4[2] = pp4[0] = pp4[1] = pp4[2] = gc4 = gp4 = (u32x4){0u, 0u, 0u, 0u};
#define PRE_LOAD(uu) do { const int h_ = (uu) & 7, tp_ = (uu) >> 3; _Pragma("unroll") for (int it = 0; it < 3; ++it) { const int idx = tid + 512 * it; pc4[it] = (u32x4){0u, 0u, 0u, 0u}; pp4[it] = (u32x4){0u, 0u, 0u, 0u}; \
        if (idx < 32 * 40) { const int tt = idx / 40, vv = idx - tt * 40; \
            const int col = vv < 8 ? h_ * 64 + 8 * vv : (vv < 16 ? 512 + h_ * 64 + 8 * (vv - 8) : (vv < 24 ? 1024 + h_ * 64 + 8 * (vv - 16) : 1536 + 8 * (vv - 24))); \
            const size_t row = (size_t)tp_ * 32 + tt; pc4[it] = *(const u32x4*)(X.P + row * LDP + COL_PA + col); \
            if (tt > 0) pp4[it] = *(const u32x4*)(X.P + (row - 1) * LDP + COL_PA + col); else if ((tp_ & 63) != 0) pp4[it] = *(const u32x4*)(BND + (size_t)(2 * tp_ - 1) * 1792 + col); } } \
        if (tid < 64) { const int tt = tid >> 1, col = 1664 + 8 * (2 * h_ + (tid & 1)); const size_t row = (size_t)tp_ * 32 + tt; gc4 = *(const u32x4*)(X.P + row * LDP + COL_PA + col); gp4 = (u32x4){0u, 0u, 0u, 0u}; \
            if (tt > 0) gp4 = *(const u32x4*)(X.P + (row - 1) * LDP + COL_PA + col); else if ((tp_ & 63) != 0) gp4 = *(const u32x4*)(BND + (size_t)(2 * tp_ - 1) * 1792 + col); } } while (0)
#pragma unroll 1
    for (int u = X.bid; u < 4096; u += X.G) {
        const int h = u & 7, tp = u >> 3;
        if (h != last_h) {
            __syncthreads();
            for (int idx = tid; idx < 64 * 64; idx += 512) { const int m = idx >> 6, cc = idx & 63;
                WTu[cc * 72 + m] = (bf16_t)f2bf(w_up[m * 512 + h * 64 + cc]); WTa[cc * 72 + m] = (bf16_t)f2bf(a_up[m * 512 + h * 64 + cc]); }
            if (tid < 320) { const int cc = tid; const int col = cc < 64 ? h * 64 + cc : (cc < 128 ? 512 + h * 64 + cc - 64 : (cc < 192 ? 1024 + h * 64 + cc - 128 : 1536 + cc - 192)); MU[cc] = mu[col]; }
            p_kk4 = *(const f32x4*)(k_k + h * 64 + cg4); p_ka4 = *(const f32x4*)(k_a + h * 64 + cg4); p_rk4 = *(const f32x4*)(r_k + h * 64 + cg4);
            q_w0 = w0[h * 64 + 16 * (wv >> 1) + ln]; q_a0 = a0[h * 64 + 16 * (wv >> 1) + ln];
            last_h = h;
            __syncthreads();
        }
        if (!have_pf) { PRE_LOAD(u); }
#pragma unroll
        for (int it = 0; it < 3; ++it) {
            const int idx = tid + 512 * it;
            if (idx < 32 * 40) {
                const int tt = idx / 40, vv = idx - tt * 40, cc0 = 8 * vv;
                const u32x4 c4 = pc4[it], p4 = pp4[it];
                const f32x4 m0 = *(const LAS f32x4*)&MU[cc0], m1 = *(const LAS f32x4*)&MU[cc0 + 4];
                float cur[8], prv[8], val[8];
                cur[0] = bflo(c4.x); cur[1] = bfhi(c4.x); cur[2] = bflo(c4.y); cur[3] = bfhi(c4.y); cur[4] = bflo(c4.z); cur[5] = bfhi(c4.z); cur[6] = bflo(c4.w); cur[7] = bfhi(c4.w);
                prv[0] = bflo(p4.x); prv[1] = bfhi(p4.x); prv[2] = bflo(p4.y); prv[3] = bfhi(p4.y); prv[4] = bflo(p4.z); prv[5] = bfhi(p4.z); prv[6] = bflo(p4.w); prv[7] = bfhi(p4.w);
#pragma unroll
                for (int e = 0; e < 8; ++e) val[e] = cur[e] + (prv[e] - cur[e]) * (e < 4 ? m0[e & 3] : m1[e & 3]);
                if (vv < 24) {
#pragma unroll
                    for (int e = 0; e < 8; ++e) val[e] = bf2f((bf16_t)f2bf(val[e]));
                    LAS float* dst = (vv < 8 ? Rr : (vv < 16 ? Kk : Vv)) + tt * 64 + 8 * (vv & 7);
                    *(LAS f32x4*)dst = (f32x4){val[0], val[1], val[2], val[3]}; *(LAS f32x4*)(dst + 4) = (f32x4){val[4], val[5], val[6], val[7]};
                } else {
                    const int lr0 = 8 * (vv - 24);
                    LAS bf16_t* dst;
                    if (lr0 < 64) { dst = WDb + tt * 72 + lr0;
#pragma unroll
                        for (int e = 0; e < 8; ++e) { const float ex = __expf(2.f * val[e]); val[e] = 1.f - 2.f / (ex + 1.f); } }
                    else dst = ADb + tt * 72 + lr0 - 64;
                    u32x4 o; o.x = pk2(val[0], val[1]); o.y = pk2(val[2], val[3]); o.z = pk2(val[4], val[5]); o.w = pk2(val[6], val[7]);
                    *(LAS u32x4*)dst = o;
                }
            }
        }
        if (tid < 64) {
            const int tt = tid >> 1, vg = 2 * h + (tid & 1);
            const f32x4 m0 = *(const f32x4*)(mu + 1664 + 8 * vg), m1 = *(const f32x4*)(mu + 1664 + 8 * vg + 4);
            float gc[8], gp[8];
            gc[0] = bflo(gc4.x); gc[1] = bfhi(gc4.x); gc[2] = bflo(gc4.y); gc[3] = bfhi(gc4.y); gc[4] = bflo(gc4.z); gc[5] = bfhi(gc4.z); gc[6] = bflo(gc4.w); gc[7] = bfhi(gc4.w);
            gp[0] = bflo(gp4.x); gp[1] = bfhi(gp4.x); gp[2] = bflo(gp4.y); gp[3] = bfhi(gp4.y); gp[4] = bflo(gp4.z); gp[5] = bfhi(gp4.z); gp[6] = bflo(gp4.w); gp[7] = bfhi(gp4.w);
#pragma unroll
            for (int e = 0; e < 8; ++e) gc[e] = sigmoidf_(gc[e] + (gp[e] - gc[e]) * (e < 4 ? m0[e & 3] : m1[e & 3]));
            u32x4 o; o.x = pk2(gc[0], gc[1]); o.y = pk2(gc[2], gc[3]); o.z = pk2(gc[4], gc[5]); o.w = pk2(gc[6], gc[7]);
            *(u32x4*)(X.P + ((size_t)tp * 32 + tt) * LDP + COL_GS + 8 * vg) = o;
        }
        have_pf = false;
        if (u + X.G < 4096 && ((u + X.G) & 7) == h) { PRE_LOAD(u + X.G); have_pf = true; }
        LDS_BAR();
        {
            const int mt = wv & 1, nt = wv >> 1, chm = 16 * nt + ln;
            f32x4 cw_ = (f32x4){0.f, 0.f, 0.f, 0.f}, ca_ = cw_;
#pragma unroll
            for (int ks = 0; ks < 2; ++ks) {
                const bf16x8 xa = *(const LAS bf16x8*)&WDb[(16 * mt + ln) * 72 + ks * 32 + 8 * lg], xb = *(const LAS bf16x8*)&WTu[(16 * nt + ln) * 72 + ks * 32 + 8 * lg];
                cw_ = __builtin_amdgcn_mfma_f32_16x16x32_bf16(xa, xb, cw_, 0, 0, 0);
                const bf16x8 ya = *(const LAS bf16x8*)&ADb[(16 * mt + ln) * 72 + ks * 32 + 8 * lg], yb = *(const LAS bf16x8*)&WTa[(16 * nt + ln) * 72 + ks * 32 + 8 * lg];
                ca_ = __builtin_amdgcn_mfma_f32_16x16x32_bf16(ya, yb, ca_, 0, 0, 0);
            }
#pragma unroll
            for (int r = 0; r < 4; ++r) {
                const int tt = 16 * mt + 4 * lg + r;
                const float z = -(q_w0 + cw_[r]);
                const float sp = fmaxf(z, 0.f) + __logf(1.f + __expf(-fabsf(z)));
                const float e = __expf(-sp - 0.5f);
                W1[tt * 64 + chm] = bf2f((bf16_t)f2bf(-expm1f(-e)));
                AS[tt * 64 + chm] = bf2f((bf16_t)f2bf(sigmoidf_(q_a0 + ca_[r])));
            }
        }
        LDS_BAR();
        {
            const int tt = tid >> 4;
            const size_t row = (size_t)tp * 32 + tt;
            const f32x4 w1 = *(const LAS f32x4*)&W1[tt * 64 + cg4], a = *(const LAS f32x4*)&AS[tt * 64 + cg4];
            const f32x4 kraw = *(const LAS f32x4*)&Kk[tt * 64 + cg4], r = *(const LAS f32x4*)&Rr[tt * 64 + cg4], v = *(const LAS f32x4*)&Vv[tt * 64 + cg4];
            const f32x4 kk0 = kraw * p_kk4;
            const float inv = 1.f / sqrtf(fmaxf(red16((kk0.x * kk0.x + kk0.y * kk0.y) + (kk0.z * kk0.z + kk0.w * kk0.w)), 1e-24f));
            const f32x4 kk = kk0 * inv;
            const f32x4 kmod = kraw * (1.f + (a - 1.f) * p_ka4);
            const f32x4 bvec = kk * a, t1 = bvec * r, t2 = kmod * r, t3 = t2 * p_rk4;
            const float br = red16((t1.x + t1.y) + (t1.z + t1.w)), kr = red16((t2.x + t2.y) + (t2.z + t2.w)), bonus = red16((t3.x + t3.y) + (t3.z + t3.w));
            bf16_t* rp_ = X.P + row * LDP;
            u32x2 o;
            o.x = pk2(r.x, r.y); o.y = pk2(r.z, r.w); *(u32x2*)(rp_ + COL_PA + h * 64 + cg4) = o;
            o.x = pk2(kraw.x, kraw.y); o.y = pk2(kraw.z, kraw.w); *(u32x2*)(rp_ + COL_PA + 512 + h * 64 + cg4) = o;
            o.x = pk2(v.x, v.y); o.y = pk2(v.z, v.w); *(u32x2*)(rp_ + COL_PA + 1024 + h * 64 + cg4) = o;
            o.x = pk2(w1.x, w1.y); o.y = pk2(w1.z, w1.w); *(u32x2*)(rp_ + h * 64 + cg4) = o;
            o.x = pk2(a.x, a.y); o.y = pk2(a.z, a.w); *(u32x2*)(rp_ + 512 + h * 64 + cg4) = o;
            if (cg4 == 0) *(f32x4*)(SCAL + (row * 8 + h) * 4) = (f32x4){inv, br, kr, bonus};
        }
        LDS_BAR();
    }
}

__device__ __forceinline__ void rwkv_task(const Ctx& X, LAS unsigned char* lds, int layer, int b, int h) {
    LAS bf16_t* GDb = (LAS bf16_t*)(lds + 66560);
    LAS bf16_t* WTg = (LAS bf16_t*)(lds + 75264);
    LAS float* BON = (LAS float*)(lds + 92672);
    const int tid = X.tid, lane = tid & 63;
    const bool helper = X.wave >= 4;
    const int ht = tid & 255;
    const float* mu = X.in[3] + layer * 1792;
    const float* g_up = X.in[8] + (size_t)layer * 128 * 512;
    const float* k_k = X.in[9] + layer * 512;  const float* k_a = X.in[10] + layer * 512;
    const float* gn_g = X.in[12] + layer * 512; const float* gn_b = X.in[13] + layer * 512;
    const float* SCAL = (const float*)(X.ws + WS_SCAL);
    const int tt_h = ht >> 4, cg4 = (ht & 15) * 4;
    const f32x4 p_kk = *(const f32x4*)(k_k + h * 64 + cg4), p_ka = *(const f32x4*)(k_a + h * 64 + cg4);
    const f32x4 p_gg = *(const f32x4*)(gn_g + h * 64 + cg4), p_gb = *(const f32x4*)(gn_b + h * 64 + cg4);
    const int gv8 = (ht & 15) * 8;
    const int nt = (ht >> 6), ln = lane & 15, lg = lane >> 4, chm = 16 * nt + ln;
    const int rp = ht >> 3, jg = ht & 7, i0 = 2 * rp;
    for (int idx = tid; idx < 128 * 64; idx += 512) { const int m = idx >> 6, cc = idx & 63; WTg[cc * 136 + m] = (bf16_t)f2bf(g_up[m * 512 + h * 64 + cc]); }
    f32x2 S0[4], S1[4];
#pragma unroll
    for (int j = 0; j < 4; ++j) { S0[j] = (f32x2){0.f, 0.f}; S1[j] = (f32x2){0.f, 0.f}; }
#if PROBE_SCAN2
    f32x2 T0[4], T1[4];
#pragma unroll
    for (int j = 0; j < 4; ++j) { T0[j] = (f32x2){0.f, 0.f}; T1[j] = (f32x2){0.f, 0.f}; }
#endif
    __syncthreads();

#define RW_ARR(bufi, k) ((LAS float*)(lds + (bufi) * RW_BUF + (k) * 4096))
#define RW_SC(bufi) ((LAS float*)(lds + (bufi) * RW_BUF + 32768))
#define RW_LOAD(chk, L) do { const size_t row_ = (size_t)b * SEQ + (chk) * RW_TS + tt_h; const bf16_t* rp_ = X.P + row_ * LDP; \
        l_r##L = *(const u32x2*)(rp_ + COL_PA + h * 64 + cg4); l_k##L = *(const u32x2*)(rp_ + COL_PA + 512 + h * 64 + cg4); l_v##L = *(const u32x2*)(rp_ + COL_PA + 1024 + h * 64 + cg4); \
        l_w##L = *(const u32x2*)(rp_ + h * 64 + cg4); l_a##L = *(const u32x2*)(rp_ + 512 + h * 64 + cg4); l_s##L = *(const f32x4*)(SCAL + (row_ * 8 + h) * 4); \
        l_gc##L = *(const u32x4*)(rp_ + COL_GS + gv8); } while (0)
    u32x2 l_rA, l_kA, l_vA, l_wA, l_aA; f32x4 l_sA; u32x4 l_gcA;
    u32x2 l_rB, l_kB, l_vB, l_wB, l_aB; f32x4 l_sB; u32x4 l_gcB;
    l_rA = l_kA = l_vA = l_wA = l_aA = l_rB = l_kB = l_vB = l_wB = l_aB = (u32x2){0u, 0u}; l_sA = l_sB = (f32x4){0.f, 0.f, 0.f, 0.f}; l_gcA = l_gcB = (u32x4){0u, 0u, 0u, 0u};
    if (helper) { RW_LOAD(0, A); RW_LOAD(1, B); }

#pragma unroll 1
    for (int i0_ = -1; i0_ < RW_NCH; i0_ += 2) {
        { const int i = i0_;

        const int bufn = (i + 1) & 1, bufc = i & 1;
        if (helper) {
            const bool do_prep = (i + 1 < RW_NCH);
            if (i >= 0) {
                LAS float* Gg = RW_ARR(bufc, 6);
                f32x4 cg_ = (f32x4){0.f, 0.f, 0.f, 0.f};
#pragma unroll
                for (int ks = 0; ks < 4; ++ks) {
                    const bf16x8 za = *(const LAS bf16x8*)&GDb[bufc * 2176 + ln * 136 + ks * 32 + 8 * lg], zb = *(const LAS bf16x8*)&WTg[(16 * nt + ln) * 136 + ks * 32 + 8 * lg];
                    cg_ = __builtin_amdgcn_mfma_f32_16x16x32_bf16(za, zb, cg_, 0, 0, 0);
                }
#pragma unroll
                for (int r = 0; r < 4; ++r) Gg[(4 * lg + r) * 64 + chm] = cg_[r];
            }
            if (i >= 1) {
                LAS float* Yy = RW_ARR(bufn, 7); LAS float* Gg = RW_ARR(bufn, 6); LAS float* Vv = RW_ARR(bufn, 5); LAS float* SC = RW_SC(bufn);
                const f32x4 y = *(const LAS f32x4*)&Yy[tt_h * 64 + cg4], gg = *(const LAS f32x4*)&Gg[tt_h * 64 + cg4], vv = *(const LAS f32x4*)&Vv[tt_h * 64 + cg4];
                const float bonus = BON[((i - 1) % 3) * 16 + tt_h];
                const float mean = red16((y.x + y.y) + (y.z + y.w)) * (1.f / 64.f);
                const f32x4 d = y - mean;
                const float var = red16((d.x * d.x + d.y * d.y) + (d.z * d.z + d.w * d.w)) * (1.f / 64.f);
                const float rs = 1.f / sqrtf(var + 64e-5f);
                const f32x4 o = (d * rs * p_gg + p_gb + vv * bonus) * gg;
                u32x2 w; w.x = pk2(o.x, o.y); w.y = pk2(o.z, o.w);
                *(u32x2*)(X.P + ((size_t)b * SEQ + (i - 1) * RW_TS + tt_h) * LDP + COL_YA + h * 64 + cg4) = w;
            }
            if (do_prep) {
                const f32x4 r = (f32x4){bflo(l_rA.x), bfhi(l_rA.x), bflo(l_rA.y), bfhi(l_rA.y)}, k = (f32x4){bflo(l_kA.x), bfhi(l_kA.x), bflo(l_kA.y), bfhi(l_kA.y)};
                const f32x4 v = (f32x4){bflo(l_vA.x), bfhi(l_vA.x), bflo(l_vA.y), bfhi(l_vA.y)}, w1 = (f32x4){bflo(l_wA.x), bfhi(l_wA.x), bflo(l_wA.y), bfhi(l_wA.y)};
                const f32x4 a = (f32x4){bflo(l_aA.x), bfhi(l_aA.x), bflo(l_aA.y), bfhi(l_aA.y)};
                const f32x4 kk = k * p_kk * l_sA.x;
                const f32x4 decay = 1.f - w1;
                *(LAS f32x4*)&RW_ARR(bufn, 0)[tt_h * 64 + cg4] = -kk;
                *(LAS f32x4*)&RW_ARR(bufn, 1)[tt_h * 64 + cg4] = decay * r;
                *(LAS f32x4*)&RW_ARR(bufn, 2)[tt_h * 64 + cg4] = decay;
                *(LAS f32x4*)&RW_ARR(bufn, 3)[tt_h * 64 + cg4] = kk * a;
                *(LAS f32x4*)&RW_ARR(bufn, 4)[tt_h * 64 + cg4] = k * (1.f + (a - 1.f) * p_ka);
                *(LAS f32x4*)&RW_ARR(bufn, 5)[tt_h * 64 + cg4] = v;
                if (cg4 == 0) { LAS float* SC = RW_SC(bufn); SC[tt_h * 4 + 0] = l_sA.y; SC[tt_h * 4 + 1] = l_sA.z; BON[((i + 1) % 3) * 16 + tt_h] = l_sA.w; }
                *(LAS u32x4*)&GDb[bufn * 2176 + tt_h * 136 + gv8] = l_gcA;
            }
            if (i + 3 < RW_NCH) RW_LOAD(i + 3, A);
            LDS_BAR();
        } else {
            LAS float* A_ = RW_ARR(bufc, 0); LAS float* WR = RW_ARR(bufc, 1); LAS float* Wd = RW_ARR(bufc, 2); LAS float* Bv = RW_ARR(bufc, 3);
            LAS float* Kk = RW_ARR(bufc, 4); LAS float* Vv = RW_ARR(bufc, 5); LAS float* Yy = RW_ARR(bufc, 7); LAS float* SC = RW_SC(bufc);
#pragma unroll 1
            for (int q4 = 0; q4 < 4; ++q4) {
                if (i >= 0) {
                    float yv[8];
#pragma unroll
                    for (int s4 = 0; s4 < 4; ++s4) {
                        const int tt = 4 * q4 + s4;
                        const f32x4 a_lo = *(const LAS f32x4*)&A_[tt * 64 + 8 * jg], a_hi = *(const LAS f32x4*)&A_[tt * 64 + 8 * jg + 4];
                        const f32x4 r_lo = *(const LAS f32x4*)&WR[tt * 64 + 8 * jg], r_hi = *(const LAS f32x4*)&WR[tt * 64 + 8 * jg + 4];
                        const f32x4 w_lo = *(const LAS f32x4*)&Wd[tt * 64 + 8 * jg], w_hi = *(const LAS f32x4*)&Wd[tt * 64 + 8 * jg + 4];
                        const f32x4 b_lo = *(const LAS f32x4*)&Bv[tt * 64 + 8 * jg], b_hi = *(const LAS f32x4*)&Bv[tt * 64 + 8 * jg + 4];
                        const f32x4 k_lo = *(const LAS f32x4*)&Kk[tt * 64 + 8 * jg], k_hi = *(const LAS f32x4*)&Kk[tt * 64 + 8 * jg + 4];
                        const f32x2 vv = *(const LAS f32x2*)&Vv[tt * 64 + i0];
                        const f32x2 sc = *(const LAS f32x2*)&SC[tt * 4];
                        const f32x2 av[4] = {{a_lo.x, a_lo.y}, {a_lo.z, a_lo.w}, {a_hi.x, a_hi.y}, {a_hi.z, a_hi.w}};
                        const f32x2 rv[4] = {{r_lo.x, r_lo.y}, {r_lo.z, r_lo.w}, {r_hi.x, r_hi.y}, {r_hi.z, r_hi.w}};
                        const f32x2 wv[4] = {{w_lo.x, w_lo.y}, {w_lo.z, w_lo.w}, {w_hi.x, w_hi.y}, {w_hi.z, w_hi.w}};
                        const f32x2 bv[4] = {{b_lo.x, b_lo.y}, {b_lo.z, b_lo.w}, {b_hi.x, b_hi.y}, {b_hi.z, b_hi.w}};
                        const f32x2 kv[4] = {{k_lo.x, k_lo.y}, {k_lo.z, k_lo.w}, {k_hi.x, k_hi.y}, {k_hi.z, k_hi.w}};
                        f32x2 e10 = S0[0] * av[0], e20 = S0[0] * rv[0], e11 = S1[0] * av[0], e21 = S1[0] * rv[0];
#pragma unroll
                        for (int j = 1; j < 4; ++j) { e10 += S0[j] * av[j]; e20 += S0[j] * rv[j]; e11 += S1[j] * av[j]; e21 += S1[j] * rv[j]; }
                        const float d10 = red8(e10.x + e10.y), d11 = red8(e11.x + e11.y);
                        yv[2 * s4] = (e20.x + e20.y) + (jg == 0 ? d10 * sc.x + vv.x * sc.y : 0.f); yv[2 * s4 + 1] = (e21.x + e21.y) + (jg == 0 ? d11 * sc.x + vv.y * sc.y : 0.f);
                        const f32x2 d10v = (f32x2){d10, d10}, d11v = (f32x2){d11, d11}, v0v = (f32x2){vv.x, vv.x}, v1v = (f32x2){vv.y, vv.y};
#pragma unroll
                        for (int j = 0; j < 4; ++j) { S0[j] = S0[j] * wv[j] + (d10v * bv[j] + v0v * kv[j]); S1[j] = S1[j] * wv[j] + (d11v * bv[j] + v1v * kv[j]); }
                    }
                    {
                        const bool t2 = (jg & 4) != 0, t1 = (jg & 2) != 0, t0 = (jg & 1) != 0;
#pragma unroll
                        for (int q = 0; q < 4; ++q) { const float keep = t2 ? yv[q + 4] : yv[q], send = t2 ? yv[q] : yv[q + 4]; yv[q] = keep + dpp_mov<0x141>(send); }
#pragma unroll
                        for (int q = 0; q < 2; ++q) { const float keep = t1 ? yv[q + 2] : yv[q], send = t1 ? yv[q] : yv[q + 2]; yv[q] = keep + dpp_mov<0x4E>(send); }
                        { const float keep = t0 ? yv[1] : yv[0], send = t0 ? yv[0] : yv[1]; yv[0] = keep + dpp_mov<0xB1>(send); }
                        Yy[(4 * q4 + (jg >> 1)) * 64 + i0 + (jg & 1)] = yv[0];
                    }

#if PROBE_SCAN2
                    {
#pragma unroll
                    for (int s4 = 0; s4 < 4; ++s4) {
                        const int tt = 4 * q4 + s4;
                        const f32x4 a_lo = *(const LAS f32x4*)&A_[tt * 64 + 8 * jg], a_hi = *(const LAS f32x4*)&A_[tt * 64 + 8 * jg + 4];
                        const f32x4 r_lo = *(const LAS f32x4*)&WR[tt * 64 + 8 * jg], r_hi = *(const LAS f32x4*)&WR[tt * 64 + 8 * jg + 4];
                        const f32x4 w_lo = *(const LAS f32x4*)&Wd[tt * 64 + 8 * jg], w_hi = *(const LAS f32x4*)&Wd[tt * 64 + 8 * jg + 4];
                        const f32x4 b_lo = *(const LAS f32x4*)&Bv[tt * 64 + 8 * jg], b_hi = *(const LAS f32x4*)&Bv[tt * 64 + 8 * jg + 4];
                        const f32x4 k_lo = *(const LAS f32x4*)&Kk[tt * 64 + 8 * jg], k_hi = *(const LAS f32x4*)&Kk[tt * 64 + 8 * jg + 4];
                        const f32x2 vv = *(const LAS f32x2*)&Vv[tt * 64 + i0];
                        const f32x2 av[4] = {{a_lo.x, a_lo.y}, {a_lo.z, a_lo.w}, {a_hi.x, a_hi.y}, {a_hi.z, a_hi.w}};
                        const f32x2 rv[4] = {{r_lo.x, r_lo.y}, {r_lo.z, r_lo.w}, {r_hi.x, r_hi.y}, {r_hi.z, r_hi.w}};
                        const f32x2 wv[4] = {{w_lo.x, w_lo.y}, {w_lo.z, w_lo.w}, {w_hi.x, w_hi.y}, {w_hi.z, w_hi.w}};
                        const f32x2 bv[4] = {{b_lo.x, b_lo.y}, {b_lo.z, b_lo.w}, {b_hi.x, b_hi.y}, {b_hi.z, b_hi.w}};
                        const f32x2 kv[4] = {{k_lo.x, k_lo.y}, {k_lo.z, k_lo.w}, {k_hi.x, k_hi.y}, {k_hi.z, k_hi.w}};
                        f32x2 e10 = T0[0] * av[0], e20 = T0[0] * rv[0], e11 = T1[0] * av[0], e21 = T1[0] * rv[0];
#pragma unroll
                        for (int j = 1; j < 4; ++j) { e10 += T0[j] * av[j]; e20 += T0[j] * rv[j]; e11 += T1[j] * av[j]; e21 += T1[j] * rv[j]; }
                        const float d10 = red8(e10.x + e10.y), d20 = red8(e20.x + e20.y), d11 = red8(e11.x + e11.y), d21 = red8(e21.x + e21.y);
                        const f32x2 d10v = (f32x2){d10 + d20, d10}, d11v = (f32x2){d11 + d21, d11}, v0v = (f32x2){vv.x, vv.x}, v1v = (f32x2){vv.y, vv.y};
#pragma unroll
                        for (int j = 0; j < 4; ++j) { T0[j] = T0[j] * wv[j] + (d10v * bv[j] + v0v * kv[j]); T1[j] = T1[j] * wv[j] + (d11v * bv[j] + v1v * kv[j]); }
                    }
                    }
#endif
                }
                if (q4 == 3) LDS_BAR();
            }
        }
            }
        if (i0_ + 1 < RW_NCH) { const int i = i0_ + 1;

        const int bufn = (i + 1) & 1, bufc = i & 1;
        if (helper) {
            const bool do_prep = (i + 1 < RW_NCH);
            if (i >= 0) {
                LAS float* Gg = RW_ARR(bufc, 6);
                f32x4 cg_ = (f32x4){0.f, 0.f, 0.f, 0.f};
#pragma unroll
                for (int ks = 0; ks < 4; ++ks) {
                    const bf16x8 za = *(const LAS bf16x8*)&GDb[bufc * 2176 + ln * 136 + ks * 32 + 8 * lg], zb = *(const LAS bf16x8*)&WTg[(16 * nt + ln) * 136 + ks * 32 + 8 * lg];
                    cg_ = __builtin_amdgcn_mfma_f32_16x16x32_bf16(za, zb, cg_, 0, 0, 0);
                }
#pragma unroll
                for (int r = 0; r < 4; ++r) Gg[(4 * lg + r) * 64 + chm] = cg_[r];
            }
            if (i >= 1) {
                LAS float* Yy = RW_ARR(bufn, 7); LAS float* Gg = RW_ARR(bufn, 6); LAS float* Vv = RW_ARR(bufn, 5); LAS float* SC = RW_SC(bufn);
                const f32x4 y = *(const LAS f32x4*)&Yy[tt_h * 64 + cg4], gg = *(const LAS f32x4*)&Gg[tt_h * 64 + cg4], vv = *(const LAS f32x4*)&Vv[tt_h * 64 + cg4];
                const float bonus = BON[((i - 1) % 3) * 16 + tt_h];
                const float mean = red16((y.x + y.y) + (y.z + y.w)) * (1.f / 64.f);
                const f32x4 d = y - mean;
                const float var = red16((d.x * d.x + d.y * d.y) + (d.z * d.z + d.w * d.w)) * (1.f / 64.f);
                const float rs = 1.f / sqrtf(var + 64e-5f);
                const f32x4 o = (d * rs * p_gg + p_gb + vv * bonus) * gg;
                u32x2 w; w.x = pk2(o.x, o.y); w.y = pk2(o.z, o.w);
                *(u32x2*)(X.P + ((size_t)b * SEQ + (i - 1) * RW_TS + tt_h) * LDP + COL_YA + h * 64 + cg4) = w;
            }
            if (do_prep) {
                const f32x4 r = (f32x4){bflo(l_rB.x), bfhi(l_rB.x), bflo(l_rB.y), bfhi(l_rB.y)}, k = (f32x4){bflo(l_kB.x), bfhi(l_kB.x), bflo(l_kB.y), bfhi(l_kB.y)};
                const f32x4 v = (f32x4){bflo(l_vB.x), bfhi(l_vB.x), bflo(l_vB.y), bfhi(l_vB.y)}, w1 = (f32x4){bflo(l_wB.x), bfhi(l_wB.x), bflo(l_wB.y), bfhi(l_wB.y)};
                const f32x4 a = (f32x4){bflo(l_aB.x), bfhi(l_aB.x), bflo(l_aB.y), bfhi(l_aB.y)};
                const f32x4 kk = k * p_kk * l_sB.x;
                const f32x4 decay = 1.f - w1;
                *(LAS f32x4*)&RW_ARR(bufn, 0)[tt_h * 64 + cg4] = -kk;
                *(LAS f32x4*)&RW_ARR(bufn, 1)[tt_h * 64 + cg4] = decay * r;
                *(LAS f32x4*)&RW_ARR(bufn, 2)[tt_h * 64 + cg4] = decay;
                *(LAS f32x4*)&RW_ARR(bufn, 3)[tt_h * 64 + cg4] = kk * a;
                *(LAS f32x4*)&RW_ARR(bufn, 4)[tt_h * 64 + cg4] = k * (1.f + (a - 1.f) * p_ka);
                *(LAS f32x4*)&RW_ARR(bufn, 5)[tt_h * 64 + cg4] = v;
                if (cg4 == 0) { LAS float* SC = RW_SC(bufn); SC[tt_h * 4 + 0] = l_sB.y; SC[tt_h * 4 + 1] = l_sB.z; BON[((i + 1) % 3) * 16 + tt_h] = l_sB.w; }
                *(LAS u32x4*)&GDb[bufn * 2176 + tt_h * 136 + gv8] = l_gcB;
            }
            if (i + 3 < RW_NCH) RW_LOAD(i + 3, B);
            LDS_BAR();
        } else {
            LAS float* A_ = RW_ARR(bufc, 0); LAS float* WR = RW_ARR(bufc, 1); LAS float* Wd = RW_ARR(bufc, 2); LAS float* Bv = RW_ARR(bufc, 3);
            LAS float* Kk = RW_ARR(bufc, 4); LAS float* Vv = RW_ARR(bufc, 5); LAS float* Yy = RW_ARR(bufc, 7); LAS float* SC = RW_SC(bufc);
#pragma unroll 1
            for (int q4 = 0; q4 < 4; ++q4) {
                if (i >= 0) {
                    float yv[8];
#pragma unroll
                    for (int s4 = 0; s4 < 4; ++s4) {
                        const int tt = 4 * q4 + s4;
                        const f32x4 a_lo = *(const LAS f32x4*)&A_[tt * 64 + 8 * jg], a_hi = *(const LAS f32x4*)&A_[tt * 64 + 8 * jg + 4];
                        const f32x4 r_lo = *(const LAS f32x4*)&WR[tt * 64 + 8 * jg], r_hi = *(const LAS f32x4*)&WR[tt * 64 + 8 * jg + 4];
                        const f32x4 w_lo = *(const LAS f32x4*)&Wd[tt * 64 + 8 * jg], w_hi = *(const LAS f32x4*)&Wd[tt * 64 + 8 * jg + 4];
                        const f32x4 b_lo = *(const LAS f32x4*)&Bv[tt * 64 + 8 * jg], b_hi = *(const LAS f32x4*)&Bv[tt * 64 + 8 * jg + 4];
                        const f32x4 k_lo = *(const LAS f32x4*)&Kk[tt * 64 + 8 * jg], k_hi = *(const LAS f32x4*)&Kk[tt * 64 + 8 * jg + 4];
                        const f32x2 vv = *(const LAS f32x2*)&Vv[tt * 64 + i0];
                        const f32x2 sc = *(const LAS f32x2*)&SC[tt * 4];
                        const f32x2 av[4] = {{a_lo.x, a_lo.y}, {a_lo.z, a_lo.w}, {a_hi.x, a_hi.y}, {a_hi.z, a_hi.w}};
                        const f32x2 rv[4] = {{r_lo.x, r_lo.y}, {r_lo.z, r_lo.w}, {r_hi.x, r_hi.y}, {r_hi.z, r_hi.w}};
                        const f32x2 wv[4] = {{w_lo.x, w_lo.y}, {w_lo.z, w_lo.w}, {w_hi.x, w_hi.y}, {w_hi.z, w_hi.w}};
                        const f32x2 bv[4] = {{b_lo.x, b_lo.y}, {b_lo.z, b_lo.w}, {b_hi.x, b_hi.y}, {b_hi.z, b_hi.w}};
                        const f32x2 kv[4] = {{k_lo.x, k_lo.y}, {k_lo.z, k_lo.w}, {k_hi.x, k_hi.y}, {k_hi.z, k_hi.w}};
                        f32x2 e10 = S0[0] * av[0], e20 = S0[0] * rv[0], e11 = S1[0] * av[0], e21 = S1[0] * rv[0];
#pragma unroll
                        for (int j = 1; j < 4; ++j) { e10 += S0[j] * av[j]; e20 += S0[j] * rv[j]; e11 += S1[j] * av[j]; e21 += S1[j] * rv[j]; }
                        const float d10 = red8(e10.x + e10.y), d11 = red8(e11.x + e11.y);
                        yv[2 * s4] = (e20.x + e20.y) + (jg == 0 ? d10 * sc.x + vv.x * sc.y : 0.f); yv[2 * s4 + 1] = (e21.x + e21.y) + (jg == 0 ? d11 * sc.x + vv.y * sc.y : 0.f);
                        const f32x2 d10v = (f32x2){d10, d10}, d11v = (f32x2){d11, d11}, v0v = (f32x2){vv.x, vv.x}, v1v = (f32x2){vv.y, vv.y};
#pragma unroll
                        for (int j = 0; j < 4; ++j) { S0[j] = S0[j] * wv[j] + (d10v * bv[j] + v0v * kv[j]); S1[j] = S1[j] * wv[j] + (d11v * bv[j] + v1v * kv[j]); }
                    }
                    {
                        const bool t2 = (jg & 4) != 0, t1 = (jg & 2) != 0, t0 = (jg & 1) != 0;
#pragma unroll
                        for (int q = 0; q < 4; ++q) { const float keep = t2 ? yv[q + 4] : yv[q], send = t2 ? yv[q] : yv[q + 4]; yv[q] = keep + dpp_mov<0x141>(send); }
#pragma unroll
                        for (int q = 0; q < 2; ++q) { const float keep = t1 ? yv[q + 2] : yv[q], send = t1 ? yv[q] : yv[q + 2]; yv[q] = keep + dpp_mov<0x4E>(send); }
                        { const float keep = t0 ? yv[1] : yv[0], send = t0 ? yv[0] : yv[1]; yv[0] = keep + dpp_mov<0xB1>(send); }
                        Yy[(4 * q4 + (jg >> 1)) * 64 + i0 + (jg & 1)] = yv[0];
                    }

#if PROBE_SCAN2
                    {
#pragma unroll
                    for (int s4 = 0; s4 < 4; ++s4) {
                        const int tt = 4 * q4 + s4;
                        const f32x4 a_lo = *(const LAS f32x4*)&A_[tt * 64 + 8 * jg], a_hi = *(const LAS f32x4*)&A_[tt * 64 + 8 * jg + 4];
                        const f32x4 r_lo = *(const LAS f32x4*)&WR[tt * 64 + 8 * jg], r_hi = *(const LAS f32x4*)&WR[tt * 64 + 8 * jg + 4];
                        const f32x4 w_lo = *(const LAS f32x4*)&Wd[tt * 64 + 8 * jg], w_hi = *(const LAS f32x4*)&Wd[tt * 64 + 8 * jg + 4];
                        const f32x4 b_lo = *(const LAS f32x4*)&Bv[tt * 64 + 8 * jg], b_hi = *(const LAS f32x4*)&Bv[tt * 64 + 8 * jg + 4];
                        const f32x4 k_lo = *(const LAS f32x4*)&Kk[tt * 64 + 8 * jg], k_hi = *(const LAS f32x4*)&Kk[tt * 64 + 8 * jg + 4];
                        const f32x2 vv = *(const LAS f32x2*)&Vv[tt * 64 + i0];
                        const f32x2 av[4] = {{a_lo.x, a_lo.y}, {a_lo.z, a_lo.w}, {a_hi.x, a_hi.y}, {a_hi.z, a_hi.w}};
                        const f32x2 rv[4] = {{r_lo.x, r_lo.y}, {r_lo.z, r_lo.w}, {r_hi.x, r_hi.y}, {r_hi.z, r_hi.w}};
                        const f32x2 wv[4] = {{w_lo.x, w_lo.y}, {w_lo.z, w_lo.w}, {w_hi.x, w_hi.y}, {w_hi.z, w_hi.w}};
                        const f32x2 bv[4] = {{b_lo.x, b_lo.y}, {b_lo.z, b_lo.w}, {b_hi.x, b_hi.y}, {b_hi.z, b_hi.w}};
                        const f32x2 kv[4] = {{k_lo.x, k_lo.y}, {k_lo.z, k_lo.w}, {k_hi.x, k_hi.y}, {k_hi.z, k_hi.w}};
                        f32x2 e10 = T0[0] * av[0], e20 = T0[0] * rv[0], e11 = T1[0] * av[0], e21 = T1[0] * rv[0];
#pragma unroll
                        for (int j = 1; j < 4; ++j) { e10 += T0[j] * av[j]; e20 += T0[j] * rv[j]; e11 += T1[j] * av[j]; e21 += T1[j] * rv[j]; }
                        const float d10 = red8(e10.x + e10.y), d20 = red8(e20.x + e20.y), d11 = red8(e11.x + e11.y), d21 = red8(e21.x + e21.y);
                        const f32x2 d10v = (f32x2){d10 + d20, d10}, d11v = (f32x2){d11 + d21, d11}, v0v = (f32x2){vv.x, vv.x}, v1v = (f32x2){vv.y, vv.y};
#pragma unroll
                        for (int j = 0; j < 4; ++j) { T0[j] = T0[j] * wv[j] + (d10v * bv[j] + v0v * kv[j]); T1[j] = T1[j] * wv[j] + (d11v * bv[j] + v1v * kv[j]); }
                    }
                    }
#endif
                }
                if (q4 == 3) LDS_BAR();
            }
        }
            }
    }
    if (helper) {
        const int bufl = (RW_NCH - 1) & 1;
        LAS float* Yy = RW_ARR(bufl, 7); LAS float* Gg = RW_ARR(bufl, 6); LAS float* Vv = RW_ARR(bufl, 5); LAS float* SC = RW_SC(bufl);
        const f32x4 y = *(const LAS f32x4*)&Yy[tt_h * 64 + cg4], gg = *(const LAS f32x4*)&Gg[tt_h * 64 + cg4], vv = *(const LAS f32x4*)&Vv[tt_h * 64 + cg4];
        const float bonus = BON[((RW_NCH - 1) % 3) * 16 + tt_h];
        const float mean = red16((y.x + y.y) + (y.z + y.w)) * (1.f / 64.f);
        const f32x4 d = y - mean;
        const float var = red16((d.x * d.x + d.y * d.y) + (d.z * d.z + d.w * d.w)) * (1.f / 64.f);
        const float rs = 1.f / sqrtf(var + 64e-5f);
        const f32x4 o = (d * rs * p_gg + p_gb + vv * bonus) * gg;
        u32x2 w; w.x = pk2(o.x, o.y); w.y = pk2(o.z, o.w);
        *(u32x2*)(X.P + ((size_t)b * SEQ + (RW_NCH - 1) * RW_TS + tt_h) * LDP + COL_YA + h * 64 + cg4) = w;
    }
    __syncthreads();
#undef RW_ARR
#undef RW_SC
#undef RW_LOAD
}

__device__ __forceinline__ void hgrn_task(const Ctx& X, LAS unsigned char* lds, int layer, int b, int h, int vh) {
    LAS float* F = (LAS float*)(lds); LAS float* Q = (LAS float*)(lds + 16384); LAS float* Vv = (LAS float*)(lds + 32768); LAS float* O = (LAS float*)(lds + 40960);
    LAS float* LB = (LAS float*)(lds + 49152);
    const int tid = X.tid;
    const float* lbl = X.in[14];
    const int rp = tid >> 4, dg = tid & 15, v0 = 2 * rp;
    if (tid < 128) LB[tid] = (layer > 0) ? 1.f / (1.f + __expf(lbl[h * 128 + tid] - lbl[512 + h * 128 + tid])) : 0.f;
    f32x2 S0[4], S1[4];
#pragma unroll
    for (int j = 0; j < 4; ++j) { S0[j] = (f32x2){0.f, 0.f}; S1[j] = (f32x2){0.f, 0.f}; }
#define HG_LOAD(chk) do { _Pragma("unroll") for (int it = 0; it < 3; ++it) { const int idx = tid + 512 * it; raw[it] = (u32x4){0u, 0u, 0u, 0u}; \
        if (idx < 32 * 40) { const int tt = idx / 40, vv = idx - tt * 40; \
            const int col = vv < 16 ? 512 + h * 128 + 8 * vv : (vv < 32 ? h * 128 + 8 * (vv - 16) : 1024 + h * 128 + vh * 64 + 8 * (vv - 32)); \
            raw[it] = *(const u32x4*)(X.P + ((size_t)b * SEQ + (chk) * 32 + tt) * LDP + COL_PB + col); } } } while (0)
    u32x4 raw[3];
    HG_LOAD(0);
    __syncthreads();
#pragma unroll 1
    for (int ch = 0; ch < SEQ / 32; ++ch) {
        const int t0 = ch * 32;
#pragma unroll
        for (int it = 0; it < 3; ++it) {
            const int idx = tid + 512 * it;
            if (idx < 32 * 40) {
                const int tt = idx / 40, vv = idx - tt * 40;
                float x[8];
                x[0] = bflo(raw[it].x); x[1] = bfhi(raw[it].x); x[2] = bflo(raw[it].y); x[3] = bfhi(raw[it].y);
                x[4] = bflo(raw[it].z); x[5] = bfhi(raw[it].z); x[6] = bflo(raw[it].w); x[7] = bfhi(raw[it].w);
                LAS float* dst;
                if (vv < 16) {
                    dst = F + tt * 128 + 8 * vv;
#pragma unroll
                    for (int e = 0; e < 8; ++e) { const float lb = LB[8 * vv + e]; x[e] = lb + (1.f - lb) * sigmoidf_(x[e]); }
                } else if (vv < 32) dst = Q + tt * 128 + 8 * (vv - 16);
                else dst = Vv + tt * 64 + 8 * (vv - 32);
                *(LAS f32x4*)dst = (f32x4){x[0], x[1], x[2], x[3]}; *(LAS f32x4*)(dst + 4) = (f32x4){x[4], x[5], x[6], x[7]};
            }
        }
        if (ch + 1 < SEQ / 32) HG_LOAD(ch + 1);
        LDS_BAR();
#pragma unroll 1
        for (int g8 = 0; g8 < 4; ++g8) {
            float val[16];
#pragma unroll
            for (int s8 = 0; s8 < 8; ++s8) {
                const int tt = 8 * g8 + s8;
                const f32x4 f_lo = *(const LAS f32x4*)&F[tt * 128 + 8 * dg], f_hi = *(const LAS f32x4*)&F[tt * 128 + 8 * dg + 4];
                const f32x4 q_lo = *(const LAS f32x4*)&Q[tt * 128 + 8 * dg], q_hi = *(const LAS f32x4*)&Q[tt * 128 + 8 * dg + 4];
                const f32x2 vv = *(const LAS f32x2*)&Vv[tt * 64 + v0];
                const f32x2 f2[4] = {{f_lo.x, f_lo.y}, {f_lo.z, f_lo.w}, {f_hi.x, f_hi.y}, {f_hi.z, f_hi.w}};
                const f32x2 q2[4] = {{q_lo.x, q_lo.y}, {q_lo.z, q_lo.w}, {q_hi.x, q_hi.y}, {q_hi.z, q_hi.w}};
                const f32x2 v0v = (f32x2){vv.x, vv.x}, v1v = (f32x2){vv.y, vv.y};
                f32x2 a0 = (f32x2){0.f, 0.f}, a1 = (f32x2){0.f, 0.f};
#pragma unroll
                for (int j = 0; j < 4; ++j) {
                    S0[j] = v0v + f2[j] * (S0[j] - v0v); S1[j] = v1v + f2[j] * (S1[j] - v1v);
                    a0 += q2[j] * S0[j]; a1 += q2[j] * S1[j];
                }
                val[2 * s8] = a0.x + a0.y; val[2 * s8 + 1] = a1.x + a1.y;
            }
            const bool b3 = (dg & 8) != 0, b2 = (dg & 4) != 0, b1 = (dg & 2) != 0, b0 = (dg & 1) != 0;
#pragma unroll
            for (int i = 0; i < 8; ++i) { const float keep = b3 ? val[i + 8] : val[i], send = b3 ? val[i] : val[i + 8]; val[i] = keep + dpp_mov<0x140>(send); }
#pragma unroll
            for (int i = 0; i < 4; ++i) { const float keep = b2 ? val[i + 4] : val[i], send = b2 ? val[i] : val[i + 4]; val[i] = keep + dpp_mov<0x141>(send); }
#pragma unroll
            for (int i = 0; i < 2; ++i) { const float keep = b1 ? val[i + 2] : val[i], send = b1 ? val[i] : val[i + 2]; val[i] = keep + dpp_mov<0x4E>(send); }
            { const float keep = b0 ? val[1] : val[0], send = b0 ? val[0] : val[1]; val[0] = keep + dpp_mov<0xB1>(send); }
            O[(8 * g8 + (dg >> 1)) * 64 + v0 + (dg & 1)] = val[0];
        }
        LDS_BAR();
        if (tid < 256) {
            const int tt = tid >> 3, v8 = (tid & 7) * 8;
            const f32x4 a = *(const LAS f32x4*)&O[tt * 64 + v8], c4 = *(const LAS f32x4*)&O[tt * 64 + v8 + 4];
            u32x4 o; o.x = pk2(a.x, a.y); o.y = pk2(a.z, a.w); o.z = pk2(c4.x, c4.y); o.w = pk2(c4.z, c4.w);
            *(u32x4*)(X.P + ((size_t)b * SEQ + t0 + tt) * LDP + COL_YB + h * 128 + vh * 64 + v8) = o;
        }
    }
#undef HG_LOAD
    __syncthreads();
}

__device__ __forceinline__ unsigned f2ord(float f) { const unsigned u = __builtin_bit_cast(unsigned, f); return (u & 0x80000000u) ? ~u : (u | 0x80000000u); }

__device__ __forceinline__ void dsa_tile(const Ctx& X, LAS unsigned char* lds, int b, int q0) {
    LAS float* sc = (LAS float*)lds;
    LAS unsigned* MASK = (LAS unsigned*)(lds + MASK_OFF);
    const int lane = X.lane, w = X.wave, n = lane & 15, g = lane >> 4;
    const bf16_t* Pb = X.P + (size_t)b * SEQ * LDP;
#pragma unroll 1
    for (int sub = 0; sub < 4; ++sub) {
        const int qs = q0 + 16 * sub;
        {
            bf16x8 bq[4][2]; float wi[4];
            const bf16_t* qrow = Pb + (size_t)(qs + n) * LDP;
#pragma unroll
            for (int hh = 0; hh < 4; ++hh) {
#pragma unroll
                for (int ks = 0; ks < 2; ++ks) bq[hh][ks] = *(const bf16x8*)(qrow + C_QI + hh * 64 + ks * 32 + 8 * g);
                wi[hh] = bf2f(qrow[C_WI + hh]);
            }
            const int nkt = (qs + 16) >> 4;
            bf16x8 a0n = (bf16x8){0, 0, 0, 0, 0, 0, 0, 0}, a1n = a0n;
            if (w < nkt) { const bf16_t* krow = Pb + (size_t)(w * 16 + n) * LDP + C_KI; a0n = *(const bf16x8*)(krow + 8 * g); a1n = *(const bf16x8*)(krow + 32 + 8 * g); }
#pragma unroll 1
            for (int kt = w; kt < nkt; kt += 8) {
                const bf16x8 a0 = a0n, a1 = a1n;
                if (kt + 8 < nkt) { const bf16_t* krow = Pb + (size_t)((kt + 8) * 16 + n) * LDP + C_KI; a0n = *(const bf16x8*)(krow + 8 * g); a1n = *(const bf16x8*)(krow + 32 + 8 * g); }
                f32x4 s = (f32x4){0.f, 0.f, 0.f, 0.f};
#pragma unroll
                for (int hh = 0; hh < 4; ++hh) {
                    f32x4 d = __builtin_amdgcn_mfma_f32_16x16x32_bf16(a0, bq[hh][0], (f32x4){0.f, 0.f, 0.f, 0.f}, 0, 0, 0);
                    d = __builtin_amdgcn_mfma_f32_16x16x32_bf16(a1, bq[hh][1], d, 0, 0, 0);
#pragma unroll
                    for (int r = 0; r < 4; ++r) s[r] += wi[hh] * fmaxf(d[r], 0.f);
                }
                const int t = qs + n;
#pragma unroll
                for (int r = 0; r < 4; ++r) if (kt * 16 + 4 * g + r > t) s[r] = -INFINITY;
                *(LAS f32x4*)&sc[n * SCS + kt * 16 + 4 * g] = s;
            }
        }
        __syncthreads();
#pragma unroll 1
        for (int e = 0; e < 2; ++e) {
            const int qn = 2 * w + e, t = qs + qn;
            LAS unsigned* mrow = MASK + (sub * 16 + qn) * 64;
            if (t < 256) {
#pragma unroll
                for (int j = 0; j < 32; ++j) {
                    const unsigned long long sm = __ballot(j * 64 + lane <= t);
                    if (lane == 0) { mrow[2 * j] = (unsigned)sm; mrow[2 * j + 1] = (unsigned)(sm >> 32); }
                }
            } else {
                const int jn = (t >> 6) + 1;
                unsigned u[32];
#pragma unroll
                for (int j = 0; j < 32; ++j) {
                    u[j] = 0u;
                    if (j < jn) { const int key = j * 64 + lane; const float s = (key <= t) ? sc[qn * SCS + key] : -INFINITY; u[j] = f2ord(s); }
                }
                unsigned prefix = 0u;
#define DSA_BITSEARCH(JN) do { _Pragma("unroll 1") for (int bit = 31; bit >= 0; --bit) { const unsigned cand = prefix | (1u << bit); int c0 = 0, c1 = 0; \
                    _Pragma("unroll") for (int j = 0; j < (JN); j += 2) { c0 += (u[j] >= cand) ? 1 : 0; c1 += (u[j + 1] >= cand) ? 1 : 0; } \
                    const int cnt = (int)wave_sum_fast((float)(c0 + c1)); if (cnt >= 256) prefix = cand; } } while (0)
                if (jn <= 8) DSA_BITSEARCH(8); else if (jn <= 16) DSA_BITSEARCH(16); else if (jn <= 24) DSA_BITSEARCH(24); else DSA_BITSEARCH(32);
#undef DSA_BITSEARCH
                int cg_ = 0;
#pragma unroll
                for (int j = 0; j < 32; ++j) if (j < jn) cg_ += __popcll(__ballot(u[j] > prefix));
                const int need = 256 - cg_;
                int cum = 0;
#pragma unroll
                for (int j = 0; j < 32; ++j) {
                    unsigned long long sm = 0ull;
                    if (j < jn) {
                        const bool eq = (u[j] == prefix);
                        const unsigned long long em = __ballot(eq);
                        const int rank = cum + (int)__builtin_amdgcn_mbcnt_hi((unsigned)(em >> 32), __builtin_amdgcn_mbcnt_lo((unsigned)em, 0u));
                        const bool sel = (u[j] > prefix) || (eq && rank < need);
                        sm = __ballot(sel);
                        cum += __popcll(em);
                    }
                    if (lane == 0) { mrow[2 * j] = (unsigned)sm; mrow[2 * j + 1] = (unsigned)(sm >> 32); }
                }
            }
        }
        __syncthreads();
    }
    const int qq = q0 + 8 * w + (n & 7);
    const LAS unsigned* mq = MASK + (8 * w + (n & 7)) * 64;
    const int nsteps = (q0 + 8 * w + 8 + 31) >> 5;
    const int nblk = (q0 + 64 + 127) >> 7;
    LAS bf16_t* KT = (LAS bf16_t*)lds;
    LAS bf16_t* VTT = (LAS bf16_t*)(lds + 36864);
    const int tid = X.tid;
#pragma unroll 1
    for (int c = 0; c < 2; ++c) {
        bf16x8 bq[2][2];
#pragma unroll
        for (int j = 0; j < 2; ++j)
#pragma unroll
            for (int ks = 0; ks < 2; ++ks) bq[j][ks] = *(const bf16x8*)(Pb + (size_t)qq * LDP + C_Q + (c * 4 + 2 * j + (n >> 3)) * 64 + ks * 32 + 8 * g);
        float lrun[2] = {0.f, 0.f};
        f32x4 oacc[4][2];
#pragma unroll
        for (int mt = 0; mt < 4; ++mt)
#pragma unroll
            for (int j = 0; j < 2; ++j) oacc[mt][j] = (f32x4){0.f, 0.f, 0.f, 0.f};
        const bf16_t* vtb = X.VT + ((size_t)(b * 2 + c) * 64) * SEQ;
        u32x4 gk[2], gv[2];
#define DSA_GLOAD(kblk) do { _Pragma("unroll") for (int it = 0; it < 2; ++it) { const int idx = tid + 512 * it; \
            gk[it] = *(const u32x4*)(Pb + (size_t)((kblk) * 128 + (idx >> 3)) * LDP + C_K + c * 64 + (idx & 7) * 8); \
            gv[it] = *(const u32x4*)(vtb + (size_t)(idx >> 4) * SEQ + (kblk) * 128 + (idx & 15) * 8); } } while (0)
#define DSA_LSTORE(bufi) do { _Pragma("unroll") for (int it = 0; it < 2; ++it) { const int idx = tid + 512 * it; \
            *(LAS u32x4*)(KT + (bufi) * 9216 + (idx >> 3) * 72 + (idx & 7) * 8) = gk[it]; \
            *(LAS u32x4*)(VTT + (bufi) * 8704 + (idx >> 4) * 136 + (idx & 15) * 8) = gv[it]; } } while (0)
        DSA_GLOAD(0);
        LDS_BAR();
        DSA_LSTORE(0);
        LDS_BAR();
#pragma unroll 1
        for (int kb = 0; kb < nblk; ++kb) {
            const int buf = kb & 1;
            if (kb + 1 < nblk) DSA_GLOAD(kb + 1);
            const LAS bf16_t* Kb = KT + buf * 9216; const LAS bf16_t* Vb = VTT + buf * 8704;
#pragma unroll 1
            for (int sl = 0; sl < 4; ++sl) {
                const int sg = kb * 4 + sl;
                if (sg < nsteps) {
                    f32x4 st[2][2];
#pragma unroll
                    for (int tl = 0; tl < 2; ++tl) {
                        const LAS bf16_t* kr = Kb + (32 * sl + 16 * tl + n) * 72;
                        const bf16x8 a0 = *(const LAS bf16x8*)(kr + 8 * g), a1 = *(const LAS bf16x8*)(kr + 32 + 8 * g);
#pragma unroll
                        for (int j = 0; j < 2; ++j) {
                            f32x4 d = __builtin_amdgcn_mfma_f32_16x16x32_bf16(a0, bq[j][0], (f32x4){0.f, 0.f, 0.f, 0.f}, 0, 0, 0);
                            st[tl][j] = __builtin_amdgcn_mfma_f32_16x16x32_bf16(a1, bq[j][1], d, 0, 0, 0);
                        }
                    }
                    bf16x8 av[4];
#pragma unroll
                    for (int mt = 0; mt < 4; ++mt) {
                        const LAS bf16_t* vp = Vb + (mt * 16 + n) * 136 + 32 * sl + 4 * g;
                        const u32x2 lo = *(const LAS u32x2*)vp, hi = *(const LAS u32x2*)(vp + 16);
                        u32x4 t4; t4.x = lo.x; t4.y = lo.y; t4.z = hi.x; t4.w = hi.y;
                        av[mt] = __builtin_bit_cast(bf16x8, t4);
                    }
                    const unsigned mw = mq[sg];
#pragma unroll
                    for (int j = 0; j < 2; ++j) {
                        float p[8], ps = 0.f;
#pragma unroll
                        for (int tl = 0; tl < 2; ++tl)
#pragma unroll
                            for (int r = 0; r < 4; ++r) { const int bit = 16 * tl + 4 * g + r; const float e = __expf(fminf(st[tl][j][r] * 0.125f, 60.f)); p[4 * tl + r] = ((mw >> bit) & 1u) ? e : 0.f; ps += p[4 * tl + r]; }
                        lrun[j] += ps;
                        u32x4 pw; pw.x = pg8::cvt_pk_bf16(p[0], p[1]); pw.y = pg8::cvt_pk_bf16(p[2], p[3]); pw.z = pg8::cvt_pk_bf16(p[4], p[5]); pw.w = pg8::cvt_pk_bf16(p[6], p[7]);
                        const bf16x8 pb = __builtin_bit_cast(bf16x8, pw);
#pragma unroll
                        for (int mt = 0; mt < 4; ++mt) oacc[mt][j] = __builtin_amdgcn_mfma_f32_16x16x32_bf16(av[mt], pb, oacc[mt][j], 0, 0, 0);
                    }
                }
            }
            if (kb + 1 < nblk) DSA_LSTORE(buf ^ 1);
            LDS_BAR();
        }
#pragma unroll
        for (int j = 0; j < 2; ++j) {
            float lt = lrun[j]; lt += __shfl_xor(lt, 16); lt += __shfl_xor(lt, 32);
            const float il = 1.f / lt;
            bf16_t* op = X.P + ((size_t)b * SEQ + qq) * LDP + COL_YC + (c * 4 + 2 * j + (n >> 3)) * 64 + 4 * g;
#pragma unroll
            for (int mt = 0; mt < 4; ++mt) {
                const f32x4 o = oacc[mt][j] * il;
                u32x2 wv; wv.x = pg8::cvt_pk_bf16(o[0], o[1]); wv.y = pg8::cvt_pk_bf16(o[2], o[3]);
                *(u32x2*)(op + mt * 16) = wv;
            }
        }
    }
#undef DSA_GLOAD
#undef DSA_LSTORE
    __syncthreads();
}

__device__ __forceinline__ void phase_mixers(const Ctx& X0, LAS unsigned char* lds, int layer) {
#pragma unroll 1
    for (int task = X0.bid; task < 128; task += X0.G) {
        Ctx X = X0;
        { int t_ = threadIdx.x; asm volatile("" : "+v"(t_)); X.tid = t_; X.lane = t_ & 63; }
        if (task < 64) { if (TKMASK & 1) rwkv_task(X, lds, layer, task >> 3, task & 7); }
        else { const int k = task - 64; if (TKMASK & 2) hgrn_task(X, lds, layer, k >> 3, (k >> 1) & 3, k & 1); }
    }
    volatile LAS unsigned* tw = (volatile LAS unsigned*)(lds + LDS_BYTES - 128);
    unsigned* ctr = (unsigned*)(X0.ws + WS_BAR + 14336) + 16 * layer;
#pragma unroll 1
    for (;;) {
        Ctx X = X0;
        { int t_ = threadIdx.x; asm volatile("" : "+v"(t_)); X.tid = t_; X.lane = t_ & 63; }
        __syncthreads();
        if (threadIdx.x == 0) tw[0] = __hip_atomic_fetch_add(ctr, 1u, __ATOMIC_RELAXED, __HIP_MEMORY_SCOPE_AGENT);
        __syncthreads();
        const int t = (int)tw[0];
        if (t >= 256) break;
        if (TKMASK & 4) dsa_tile(X, lds, t & 7, 64 * (31 - (t >> 3)));
    }
}

__device__ __forceinline__ void phase_hgrn_post(const Ctx& X, int layer) {
    const int gw = X.bid * 8 + X.wave, NGW = X.G * 8;
    const float* gn = X.in[15] + layer * 512;
#pragma unroll 1
    for (int it0 = gw; it0 < T_TOK * 4; it0 += 4 * NGW) {
        unsigned ow[4], gwd[4]; unsigned* op[4];
#pragma unroll
        for (int r = 0; r < 4; ++r) {
            const int it = it0 + r * NGW < T_TOK * 4 ? it0 + r * NGW : it0;
            const int t = it >> 2, h = it & 3;
            bf16_t* rowp = X.P + (size_t)t * LDP;
            op[r] = (unsigned*)(rowp + COL_YB + h * 128) + X.lane;
            ow[r] = *op[r]; gwd[r] = *((const unsigned*)(rowp + COL_PB + 1536 + h * 128) + X.lane);
        }
#pragma unroll
        for (int r = 0; r < 4; ++r) {
            const int it = it0 + r * NGW;
            const int h = it & 3;
            const float o0 = bflo(ow[r]), o1 = bfhi(ow[r]), g0 = bflo(gwd[r]), g1 = bfhi(gwd[r]);
            const float rs = 1.f / sqrtf(wave_sum(o0 * o0 + o1 * o1) * (1.f / 128.f) + 1e-6f);
            const float y0 = o0 * rs * gn[h * 128 + 2 * X.lane] * (g0 * sigmoidf_(g0)), y1 = o1 * rs * gn[h * 128 + 2 * X.lane + 1] * (g1 * sigmoidf_(g1));
            if (it < T_TOK * 4) *op[r] = pk2(y0, y1);
        }
    }
}

__device__ __forceinline__ void phase_fixup(const Ctx& X, int layer) {
    const float* cw = X.in[20] + (size_t)layer * 3 * F2; const float* cb = X.in[21] + (size_t)layer * F2;
#pragma unroll 4
    for (int idx = X.bid * 512 + X.tid; idx < 256 * 2 * DFF; idx += X.G * 512) {
        const int j = idx % DFF, sr = idx / DFF, s = sr >> 1, r = sr & 1;
        const int colg = (j >> 7) * 256 + (j & 127), colv = colg + 128;
        const bool seq0 = (s & 31) == 0;
        const float* H = X.HALO;
        float res[2];
#pragma unroll
        for (int part = 0; part < 2; ++part) {
            const int cp = part ? colv : colg, co = part * DFF + j;
            const float u0 = H[(size_t)(s * 4 + r) * F2 + cp];
            float u1, u2;
            if (r == 0) { u1 = seq0 ? 0.f : H[(size_t)((s - 1) * 4 + 3) * F2 + cp]; u2 = seq0 ? 0.f : H[(size_t)((s - 1) * 4 + 2) * F2 + cp]; }
            else { u1 = H[(size_t)(s * 4 + 0) * F2 + cp]; u2 = seq0 ? 0.f : H[(size_t)((s - 1) * 4 + 3) * F2 + cp]; }
            res[part] = cb[co] + cw[co] * u2 + cw[F2 + co] * u1 + cw[2 * F2 + co] * u0;
        }
        const float a = res[0] * sigmoidf_(res[0]) * res[1];
        X.P[(size_t)(s * 64 + r) * LDP + COL_ACT + j] = (bf16_t)f2bf(a);
    }
}

#define XB_TMO      128
#define XB_XCNT(j)  (256  + 64 * (j))
#define XB_XSUB(j)  (1280 + 64 * (j))
#define XB_XGEN(j)  (2304 + 64 * (j))
#define XB_TOP      3328
#define XB_TOPGEN   3392
#define XCD_BAR_WORDS 3456
#define XB_SPIN_CAP (1u << 22)
__device__ __forceinline__ unsigned xb_ld(unsigned* p)              { return __hip_atomic_load(p, __ATOMIC_RELAXED, __HIP_MEMORY_SCOPE_AGENT); }
__device__ __forceinline__ unsigned xb_add(unsigned* p, unsigned v) { return __hip_atomic_fetch_add(p, v, __ATOMIC_RELAXED, __HIP_MEMORY_SCOPE_AGENT); }
__device__ __forceinline__ unsigned xb_xcc_id() { return (unsigned)__builtin_amdgcn_s_getreg((3 << 11) | 20) & 0xFu; }
#define XB_SPIN(cond, bar) do { unsigned _sp = 0; while (cond) { __builtin_amdgcn_s_sleep(1); \
    if ((++_sp & 255u) == 0u) { if (xb_ld(&(bar)[XB_TMO])) break; if (_sp > XB_SPIN_CAP) { atomicAdd(&(bar)[XB_TMO], 1u); break; } } } } while (0)
struct XcdBarrier { unsigned* bar; unsigned x; volatile LAS unsigned* st; };
__device__ __forceinline__ XcdBarrier xcd_barrier_post(unsigned* bar, volatile LAS unsigned* st) {
    XcdBarrier b; b.bar = bar; b.x = xb_xcc_id(); b.st = st;
    if (threadIdx.x == 0) (void)xb_add(&bar[XB_XCNT(b.x)], 1u);
    return b;
}
__device__ __forceinline__ void xcd_barrier_complete(unsigned* bar, unsigned x, unsigned& nloc, unsigned& nx) {
    const unsigned G = gridDim.x * gridDim.y * gridDim.z;
    unsigned sum, cnt, mine, sp = 0u;
    for (;;) {
        sum = 0u; cnt = 0u; mine = 0u;
#pragma unroll
        for (unsigned j = 0; j < 16; ++j) { const unsigned c = xb_ld(&bar[XB_XCNT(j)]); sum += c; cnt += (c > 0u) ? 1u : 0u; mine = (j == x) ? c : mine; }
        if (sum == G) break;
        __builtin_amdgcn_s_sleep(1);
        if ((++sp & 255u) == 0u) { if (xb_ld(&bar[XB_TMO])) break; if (sp > XB_SPIN_CAP) { atomicAdd(&bar[XB_TMO], 1u); break; } }
    }
    nloc = mine > 0u ? mine : 1u; nx = cnt > 0u ? cnt : 1u;
}
__device__ __forceinline__ void xcd_barrier(const XcdBarrier& b) {
    asm volatile("s_waitcnt vmcnt(0)" ::: "memory");
    __syncthreads();
    if (threadIdx.x == 0) {
        unsigned* bar = b.bar;
        __builtin_amdgcn_s_waitcnt(0);
        unsigned nloc = b.st[0], nx = b.st[1];
        if (nloc == 0u) { xcd_barrier_complete(bar, b.x, nloc, nx); b.st[0] = nloc; b.st[1] = nx; }
        const unsigned old = xb_add(&bar[XB_XSUB(b.x)], 1u);
        const unsigned gen = old / nloc;
        if (old + 1u == (gen + 1u) * nloc) {
            __builtin_amdgcn_fence(__ATOMIC_RELEASE, "agent");
            asm volatile("s_waitcnt vmcnt(0)" ::: "memory");
            const unsigned og = xb_add(&bar[XB_TOP], 1u);
            const unsigned tg = og / nx;
            if (og + 1u == (tg + 1u) * nx) xb_add(&bar[XB_TOPGEN], 1u);
            else XB_SPIN(xb_ld(&bar[XB_TOPGEN]) == tg, bar);
            __builtin_amdgcn_fence(__ATOMIC_ACQUIRE, "agent");
            xb_add(&bar[XB_XGEN(b.x)], 1u);
            asm volatile("s_waitcnt vmcnt(0)" ::: "memory");
        } else {
            XB_SPIN(xb_ld(&bar[XB_XGEN(b.x)]) == gen, bar);
            __builtin_amdgcn_fence(__ATOMIC_ACQUIRE, "agent");
            asm volatile("s_waitcnt vmcnt(0)" ::: "memory");
        }
    }
    __syncthreads();
}

__global__ void __launch_bounds__(512, 2) mk_fwd(Args args) {
    extern __shared__ __attribute__((aligned(16))) unsigned char lds_raw[];
    LAS unsigned char* lds = (LAS unsigned char*)lds_raw;
    Ctx X;
#pragma unroll
    for (int i = 0; i < 24; ++i) X.in[i] = args.in[i];
    X.out = args.out; X.ws = args.ws;
    X.P = (bf16_t*)(args.ws + WS_P); X.VT = (bf16_t*)(args.ws + WS_VT); X.HALO = (float*)(args.ws + WS_HALO); X.ROPE = (float*)(args.ws + WS_ROPE);
    X.Win = (bf16_t*)(args.ws + WS_WIN); X.Wg = (bf16_t*)(args.ws + WS_WG); X.Wbr = (bf16_t*)(args.ws + WS_WBR);
    X.Wo = (bf16_t*)(args.ws + WS_WO); X.Wup = (bf16_t*)(args.ws + WS_WUP); X.Wdn = (bf16_t*)(args.ws + WS_WDN);
    X.tid = threadIdx.x; X.lane = X.tid & 63; X.wave = __builtin_amdgcn_readfirstlane(X.tid >> 6); X.G = gridDim.x; X.bid = blockIdx.x;

#if PROBE_DOUBLE
    for (int ph2 = args.ph_lo * 2; ph2 < args.ph_hi * 2; ++ph2) {
        const int ph = ph2 >> 1;
        const int layer = ph / 11, sub = ph % 11;
        const bool skip_ = (ph2 & 1) && !(ph < 22 && ((REPMASK >> sub) & 1));
#else
    volatile LAS unsigned* bst = (volatile LAS unsigned*)(lds + LDS_BYTES - 64);
    if (threadIdx.x < 2) bst[threadIdx.x] = 0u;
    __syncthreads();
    XcdBarrier gbar = xcd_barrier_post((unsigned*)(args.ws + WS_BAR), bst);
    for (int ph = args.ph_lo; ph < args.ph_hi; ++ph) {
        const int layer = ph / 11, sub = ph % 11;
        const bool skip_ = false;
#endif
        const bool fusedn = (X.G == 256) && (args.ph_hi - args.ph_lo > 1);
        if (fusedn && (ph == 22 || sub == 7)) continue;
        { int t_ = threadIdx.x; asm volatile("" : "+v"(t_)); X.tid = t_; X.lane = t_ & 63; }

        if (skip_) {
        } else if (ph == 22 && (PHMASK & 1024)) {
            const int gw = X.bid * 8 + X.wave, NGW = X.G * 8;
            (void)gw; (void)NGW; rms_pass(X, X.out, X.in[23], nullptr, X.out);
        } else if (sub == 0 && (PHMASK & 1)) {
            phase_prep(X, lds, layer, !(fusedn && layer > 0));
        } else if (sub == 1 && (PHMASK & 2)) {
            pg8::Gemm g{X.P, X.Win, LDP, DM, DM}; pg8::StaticOrder S; S.init(T_TOK, 5120, X.G, X.bid);
            pg8::EpiInProj E{X.P, X.VT, X.ROPE, (bf16_t*)(X.ws + WS_BND)};
            pg8::gemm_phase<pg8::EpiInProj, true>(lds, g, S, E, X.tid);
        } else if (sub == 2 && (PHMASK & 4)) {
            phase_rwkv_pre(X, lds, layer);
        } else if (sub == 3 && (PHMASK & 4)) {
            phase_mixers(X, lds, layer);
        } else if (sub == 4 && (PHMASK & 8)) {
            phase_hgrn_post(X, layer);
            { const int gw = X.bid * 8 + X.wave, NGW = X.G * 8; const float* hh = (layer == 0) ? X.in[0] : X.out; const float* g = X.in[1] + (size_t)layer * DM;
              (void)gw; (void)NGW; rms_pass(X, hh, g, X.P, nullptr); }
        } else if (sub == 5 && (PHMASK & 16)) {
#pragma unroll 1
            for (int br = 0; br < 3; ++br) {
                { pg8::Gemm g{X.P, X.Wg + (size_t)br * DM * DM, LDP, DM, DM}; pg8::StaticOrder S; S.init(T_TOK, DM, X.G, X.bid);
                  int t_ = X.tid; asm volatile("" : "+v"(t_));
                  pg8::EpiGate E{X.P}; pg8::gemm_phase<pg8::EpiGate, true>(lds, g, S, E, t_); }
                { const int ycol = br == 0 ? COL_YA : (br == 1 ? COL_YB : COL_YC);
                  pg8::Gemm g{X.P + ycol, X.Wbr + (size_t)br * DM * 512, LDP, 512, 512}; pg8::StaticOrder S; S.init(T_TOK, DM, X.G, X.bid);
                  int t_ = X.tid; asm volatile("" : "+v"(t_));
                  pg8::EpiMergeAcc E{X.P, br == 0 ? 1 : 0}; pg8::gemm_phase<pg8::EpiMergeAcc, true>(lds, g, S, E, t_); }
            }
        } else if (sub == 6 && (PHMASK & 32)) {
            pg8::Gemm g{X.P + COL_MRG, X.Wo, LDP, DM, DM}; pg8::StaticOrder S; S.init(T_TOK, DM, X.G, X.bid);
            if (fusedn) {
                pg8::EpiResidNorm E{layer == 0 ? X.in[0] : X.out, X.out, X.in[18] + (size_t)layer * DM, X.P, nullptr,
                                    (unsigned*)(X.ws + WS_XB) + (size_t)(layer * 2) * 65536, (unsigned*)(X.ws + WS_XC) + (layer * 2) * 4096};
                pg8::gemm_phase<pg8::EpiResidNorm, false>(lds, g, S, E, X.tid);
            } else {
            pg8::EpiResid E{layer == 0 ? X.in[0] : X.out, X.out};
            pg8::gemm_phase<pg8::EpiResid, true>(lds, g, S, E, X.tid);
            }
        } else if (sub == 7 && (PHMASK & 64)) {
            const int gw = X.bid * 8 + X.wave, NGW = X.G * 8;
            const float* g = X.in[18] + (size_t)layer * DM;
            (void)gw; (void)NGW; rms_pass(X, X.out, g, X.P, nullptr);
        } else if (sub == 8 && (PHMASK & 128)) {
            pg8::Gemm g{X.P, X.Wup, LDP, DM, DM}; pg8::StaticOrder S; S.init(T_TOK, F2, X.G, X.bid);
            pg8::EpiUp E{X.P, X.HALO, X.in[20] + (size_t)layer * 3 * F2, X.in[21] + (size_t)layer * F2, (LAS float*)(lds + 131072)};
            pg8::gemm_phase<pg8::EpiUp, true>(lds, g, S, E, X.tid);
        } else if (sub == 9 && (PHMASK & 256)) {
            phase_fixup(X, layer);
        } else if (sub == 10 && (PHMASK & 512)) {
            pg8::Gemm g{X.P + COL_ACT, X.Wdn, LDP, DFF, DFF}; pg8::StaticOrder S; S.init(T_TOK, DM, X.G, X.bid);
            if (fusedn) {
                const bool last = (layer == 1);
                pg8::EpiResidNorm E{X.out, last ? nullptr : X.out, last ? X.in[23] : X.in[1] + (size_t)DM, last ? nullptr : X.P, last ? X.out : nullptr,
                                    (unsigned*)(X.ws + WS_XB) + (size_t)(layer * 2 + 1) * 65536, (unsigned*)(X.ws + WS_XC) + (layer * 2 + 1) * 4096};
                pg8::gemm_phase<pg8::EpiResidNorm, false>(lds, g, S, E, X.tid);
            } else {
            pg8::EpiResid E{X.out, X.out};
            pg8::gemm_phase<pg8::EpiResid, true>(lds, g, S, E, X.tid);
            }
        }
#if PROBE_DOUBLE
        if (ph2 + 1 < args.ph_hi * 2) cg::this_grid().sync();
#else
        if (ph + 1 < args.ph_hi && !(fusedn && ph == 21)) { if (args.ph_hi > 1000) cg::this_grid().sync(); else xcd_barrier(gbar); }
#endif
    }
}

extern "C" void kernel_launch(void* const* d_in, const int* in_sizes, int n_in, void* d_out, int out_size, void* d_ws, size_t ws_size, hipStream_t stream) {
    static int grid = 0;
    if (grid == 0) {
        int dev = 0, cus = 0, per_cu = 0;
        (void)hipGetDevice(&dev);
        (void)hipDeviceGetAttribute(&cus, hipDeviceAttributeMultiprocessorCount, dev);
        if (hipFuncSetAttribute((const void*)mk_fwd, hipFuncAttributeMaxDynamicSharedMemorySize, LDS_BYTES) != hipSuccess) fprintf(stderr, "kernel_launch: hipFuncSetAttribute failed\n");
        if (hipOccupancyMaxActiveBlocksPerMultiprocessor(&per_cu, (const void*)mk_fwd, 512, LDS_BYTES) != hipSuccess || per_cu < 1) { fprintf(stderr, "kernel_launch: occupancy query gave %d\n", per_cu); per_cu = 1; }
        (void)hipGetLastError();
        grid = cus * 1;
        if (grid <= 0) grid = 256;
        if (ws_size < (size_t)268435456) fprintf(stderr, "kernel_launch: workspace too small (%zu)\n", ws_size);
    }
    Args a{};
    for (int i = 0; i < 24; ++i) a.in[i] = (const float*)d_in[i];
    a.out = (float*)d_out; a.ws = (unsigned char*)d_ws;
#if MK_SINGLE
    (void)hipMemsetAsync((char*)d_ws + WS_BAR, 0, 16384 + 65536, stream);
    a.ph_lo = 0; a.ph_hi = 23;
    void* kargs[] = {&a};
    hipError_t e = hipLaunchCooperativeKernel((const void*)mk_fwd, dim3(grid), dim3(512), kargs, LDS_BYTES, stream);
    if (e != hipSuccess) fprintf(stderr, "cooperative launch failed: %s (grid %d)\n", hipGetErrorString(e), grid);
#else
    for (int ph = 0; ph < 23; ++ph) {
        a.ph_lo = ph; a.ph_hi = ph + 1;
        hipLaunchKernelGGL(mk_fwd, dim3(grid), dim3(512), LDS_BYTES, stream, a);
    }
#endif
}
```

```cpp
#include <hip/hip_runtime.h>
#include <hip/hip_cooperative_groups.h>
#include <cstdio>
#include <cstdint>
namespace cg = cooperative_groups;

#ifndef PHMASK
#define PHMASK 2047
#endif
#ifndef REPMASK
#define REPMASK 0
#endif
#ifndef PROBE_DOUBLE
#define PROBE_DOUBLE 0
#endif
#ifndef PROBE_SCAN2
#define PROBE_SCAN2 0
#endif
#ifndef TKMASK
#define TKMASK 7
#endif
#ifndef MK_SINGLE
#define MK_SINGLE 1
#endif

#define LAS __attribute__((address_space(3)))
typedef unsigned short bf16_t;
typedef short bf16x8 __attribute__((ext_vector_type(8)));
typedef float f32x4 __attribute__((ext_vector_type(4)));
typedef float f32x2 __attribute__((ext_vector_type(2)));
typedef unsigned u32x4 __attribute__((ext_vector_type(4)));
typedef unsigned u32x2 __attribute__((ext_vector_type(2)));

constexpr int T_TOK = 16384, SEQ = 2048, DM = 1024;
constexpr int LDP = 6208;
constexpr int COL_PA = 1024, COL_PB = 2816, COL_PC = 4864;
constexpr int COL_YA = 1024, COL_MRG = 1536, COL_G = 2816, COL_YB = 3840, COL_YC = 4864, COL_ACT = 1024;
constexpr int COL_GS = 5960;
constexpr int C_Q = 4864, C_K = 5376, C_QI = 5632, C_KI = 5888, C_WI = 5952;
constexpr int IN_COLS = 8004, DFF = 2816, F2 = 5632;
constexpr size_t WS_WIN = 0, WS_WG = 10485760, WS_WBR = 16777216, WS_WO = 19922944, WS_WUP = 22020096, WS_WDN = 33554432;
constexpr size_t WS_P = 39321600, WS_HALO = 242745344, WS_VT = WS_HALO, WS_ROPE = 265814016, WS_BAR = 266338304, WS_BND = WS_HALO + 4194304, WS_SCAL = WS_HALO + 8388608, WS_XC = WS_BAR + 16384, WS_XB = WS_XC + 65536;
constexpr int LDS_BYTES = 153600;
constexpr int SCS = 2052;
constexpr int MASK_OFF = 16 * SCS * 4;

struct Args { const float* in[24]; float* out; unsigned char* ws; int ph_lo, ph_hi; };

__device__ __forceinline__ unsigned f2bf(float f) { unsigned u = __builtin_bit_cast(unsigned, f); return (u + 0x7fffu + ((u >> 16) & 1u)) >> 16; }
__device__ __forceinline__ unsigned pk2(float lo, float hi) { unsigned r; asm("v_cvt_pk_bf16_f32 %0, %1, %2" : "=v"(r) : "v"(lo), "v"(hi)); return r; }
__device__ __forceinline__ float bf2f(bf16_t b) { return __builtin_bit_cast(float, (unsigned)b << 16); }
__device__ __forceinline__ float bflo(unsigned w) { return __builtin_bit_cast(float, w << 16); }
__device__ __forceinline__ float bfhi(unsigned w) { return __builtin_bit_cast(float, w & 0xffff0000u); }
__device__ __forceinline__ float wave_sum(float v) {
#pragma unroll
    for (int o = 1; o < 64; o <<= 1) v += __shfl_xor(v, o);
    return v;
}
__device__ __forceinline__ int wave_sum_i(int v) {
#pragma unroll
    for (int o = 1; o < 64; o <<= 1) v += __shfl_xor(v, o);
    return v;
}
template <int CTRL> __device__ __forceinline__ float dpp_mov(float x) {
    return __builtin_bit_cast(float, __builtin_amdgcn_update_dpp(0, __builtin_bit_cast(int, x), CTRL, 0xF, 0xF, true));
}
__device__ __forceinline__ float red8(float x) { x += dpp_mov<0xB1>(x); x += dpp_mov<0x4E>(x); x += dpp_mov<0x141>(x); return x; }
__device__ __forceinline__ float red16(float x) { x = red8(x); x += dpp_mov<0x140>(x); return x; }
__device__ __forceinline__ float sigmoidf_(float x) { return 1.f / (1.f + __expf(-x)); }

namespace pg8 {
constexpr int BM = 256, BK = 64, HALF = 128, HTB = HALF * BK * 2, NXCD = 8, WGM = 8;
__device__ __forceinline__ int lds_byte(int r, int c) { const int st = (r >> 4) * 2 + (c >> 5), rr = r & 15, cc = c & 31, ob = rr * 64 + cc * 2; return st * 1024 + (ob ^ (((ob >> 9) & 1) << 5)); }
__device__ __forceinline__ void stage_rc(int b, int& R, int& C) { const int st = b / 1024, sb = b % 1024, swz = sb ^ (((sb >> 9) & 1) << 5); R = (st >> 1) * 16 + swz / 64; C = (st & 1) * 32 + (swz % 64) / 2; }
__device__ __forceinline__ int perm32(int rho) { const int n = rho >> 4, i = rho & 15; return 8 * (i >> 2) + 4 * n + (i & 3); }
struct Unit { int pm, pn; };
struct Gemm { const bf16_t* A; const bf16_t* Bt; int lda, ldb, K; };
struct StaticOrder {
    int nM, nN, nwg, G, c;
    __device__ void init(int M, int N, int G_, int c_) { nM = M / BM; nN = N / BM; nwg = nM * nN; G = G_; c = c_; }
    __device__ bool next(int i, Unit& u) const {
        const long L = (long)i * G + c; if (L >= nwg) return false;
        int wgid = (int)L; { const int q = nwg / NXCD, r = nwg % NXCD, xcd = wgid % NXCD, off = wgid / NXCD; wgid = (xcd < r ? xcd * (q + 1) : r * (q + 1) + (xcd - r) * q) + off; }
        const int nig = WGM * nN, gid = wgid / nig, fm = gid * WGM, gsz = (nM - fm) < WGM ? (nM - fm) : WGM;
        u.pm = fm + ((wgid % nig) % gsz); u.pn = (wgid % nig) / gsz; return true;
    }
};
__device__ __forceinline__ unsigned cvt_pk_bf16(float lo, float hi) { unsigned r; asm volatile("v_cvt_pk_bf16_f32 %0, %1, %2" : "=v"(r) : "v"(lo), "v"(hi)); return r; }

template <class Epi, bool ALIGN_EPI>
__device__ __forceinline__ void gemm_phase(LAS unsigned char* lds, const Gemm g, const StaticOrder& S, const Epi& E, const int tid) {
    const int wid = __builtin_amdgcn_readfirstlane(tid >> 6), lane = tid & 63, wr = wid >> 2, wc = wid & 3, fr = lane & 15, fq = lane >> 4;
    const int K = g.K, nt = K / BK;
    unsigned voffA[2], voffB[2];
#pragma unroll
    for (int i = 0; i < 2; ++i) { int R, C; stage_rc(tid * 16 + i * 8192, R, C); const int Rb = (R & ~31) + perm32(R & 31);
        voffA[i] = (unsigned)(R * g.lda + C) * 2u; voffB[i] = (unsigned)(Rb * g.ldb + C) * 2u; }
    const size_t kstep = (size_t)(BK * 2);
    const size_t hstepA = (size_t)HALF * g.lda * 2, hstepB = (size_t)HALF * g.ldb * 2;
    const size_t tstepA = 2 * hstepA, tstepB = 2 * hstepB;
    const unsigned ldsw = (unsigned)wid * 1024u;
    const int aoff = lds_byte(wr * 64 + fr, fq * 8), boff = lds_byte(wc * 32 + fr, fq * 8);
#define PG8_SA(b, h) (((b) * 2 + (h)) * HTB)
#define PG8_SB(b, h) ((4 + (b) * 2 + (h)) * HTB)
#define PG8_STAGE(bufoff, gbase, voff) do { _Pragma("unroll") for (int _i = 0; _i < 2; ++_i) \
        __builtin_amdgcn_global_load_lds((const unsigned*)((const char*)(gbase) + (voff)[_i]), (LAS unsigned*)(lds + (bufoff) + ldsw + _i * 8192), 16, 0, 0); } while (0)
#define PG8_LDA(dst, b, h) do { _Pragma("unroll") for (int m = 0; m < 4; ++m) _Pragma("unroll") for (int k = 0; k < 2; ++k) dst[m][k] = *(const LAS bf16x8*)(lds + PG8_SA(b, h) + aoff + m * 2048 + k * 1024); } while (0)
#define PG8_LDB(dst, b, h) do { _Pragma("unroll") for (int n = 0; n < 2; ++n) _Pragma("unroll") for (int k = 0; k < 2; ++k) dst[n][k] = *(const LAS bf16x8*)(lds + PG8_SB(b, h) + boff + n * 2048 + k * 1024); } while (0)
#define PG8_MMA(ai, bj, At, Bt) do { __builtin_amdgcn_s_setprio(1); _Pragma("unroll") for (int m = 0; m < 4; ++m) _Pragma("unroll") for (int n = 0; n < 2; ++n) _Pragma("unroll") for (int k = 0; k < 2; ++k) \
        acc[ai][bj][m][n] = __builtin_amdgcn_mfma_f32_16x16x32_bf16(Bt[n][k], At[m][k], acc[ai][bj][m][n], 0, 0, 0); __builtin_amdgcn_s_setprio(0); } while (0)
#define PG8_WAIT_V(n) asm volatile("s_waitcnt vmcnt(" #n ")" ::: "memory")
#define PG8_WAIT_L(n) asm volatile("s_waitcnt lgkmcnt(" #n ")" ::: "memory")
#define PG8_BAR __builtin_amdgcn_s_barrier()
#define PG8_SCHED __builtin_amdgcn_sched_barrier(0)
    Unit cur, nxt; int ui = 0;
    if (!S.next(0, cur)) return;
    f32x4 acc[2][2][4][2];
#pragma unroll
    for (int a = 0; a < 2; ++a)
#pragma unroll
        for (int b = 0; b < 2; ++b)
#pragma unroll
            for (int m = 0; m < 4; ++m)
#pragma unroll
                for (int n = 0; n < 2; ++n) acc[a][b][m][n] = (f32x4){0.f, 0.f, 0.f, 0.f};
    bf16x8 At[4][2], B0[2][2], B1[2][2];
    const char* cA = (const char*)g.A + (size_t)cur.pm * tstepA; const char* cB = (const char*)g.Bt + (size_t)cur.pn * tstepB;
    PG8_STAGE(PG8_SB(0, 0), cB, voffB); PG8_STAGE(PG8_SB(0, 1), cB + hstepB, voffB); PG8_STAGE(PG8_SA(0, 0), cA, voffA); PG8_STAGE(PG8_SA(0, 1), cA + hstepA, voffA);
    if (wr == 1) PG8_BAR;
    PG8_WAIT_V(2); PG8_BAR;
    PG8_STAGE(PG8_SB(1, 0), cB + kstep, voffB); PG8_STAGE(PG8_SA(1, 0), cA + kstep, voffA); PG8_STAGE(PG8_SB(1, 1), cB + hstepB + kstep, voffB);
    PG8_WAIT_V(6); PG8_BAR;
    for (;;) {
        const bool has_next = S.next(ui + 1, nxt);
        const char* nA = has_next ? (const char*)g.A + (size_t)nxt.pm * tstepA : cA; const char* nB = has_next ? (const char*)g.Bt + (size_t)nxt.pn * tstepB : cB;
        for (int t = 0; t < nt; t += 2) {
            const bool last = (t == nt - 2);
            const char* a1 = cA + (size_t)(t + 1) * kstep;
            const char* a2 = last ? nA : cA + (size_t)(t + 2) * kstep; const char* b2 = last ? nB : cB + (size_t)(t + 2) * kstep;
            const char* a3 = a2 + kstep; const char* b3 = b2 + kstep;
            PG8_LDB(B0, 0, 0); PG8_LDB(B1, 0, 1); PG8_SCHED; PG8_LDA(At, 0, 0); PG8_STAGE(PG8_SA(1, 1), a1 + hstepA, voffA);
            PG8_WAIT_V(8); PG8_WAIT_L(0); PG8_BAR; PG8_MMA(0, 0, At, B0); PG8_MMA(0, 1, At, B1); PG8_BAR; PG8_SCHED;
            PG8_LDA(At, 0, 1); PG8_STAGE(PG8_SB(0, 0), b2, voffB); PG8_STAGE(PG8_SB(0, 1), b2 + hstepB, voffB); PG8_STAGE(PG8_SA(0, 0), a2, voffA);
            PG8_WAIT_V(8); PG8_WAIT_L(0); PG8_BAR; PG8_MMA(1, 0, At, B0); PG8_MMA(1, 1, At, B1); PG8_BAR; PG8_SCHED;
            PG8_LDB(B0, 1, 0); PG8_LDB(B1, 1, 1); PG8_SCHED; PG8_LDA(At, 1, 0); PG8_STAGE(PG8_SA(0, 1), a2 + hstepA, voffA);
            PG8_WAIT_V(8); PG8_WAIT_L(0); PG8_BAR; PG8_MMA(0, 0, At, B0); PG8_MMA(0, 1, At, B1); PG8_BAR; PG8_SCHED;
            PG8_LDA(At, 1, 1); PG8_STAGE(PG8_SB(1, 0), b3, voffB); PG8_STAGE(PG8_SB(1, 1), b3 + hstepB, voffB); PG8_STAGE(PG8_SA(1, 0), a3, voffA);
            PG8_WAIT_V(8); PG8_WAIT_L(0); PG8_BAR; PG8_MMA(1, 0, At, B0); PG8_MMA(1, 1, At, B1); PG8_BAR; PG8_SCHED;
        }
        if constexpr (ALIGN_EPI) { if (wr == 0) PG8_BAR; }
        if constexpr (!Epi::AFTER_DRAIN) E(acc, cur, wr, wc, fr, fq);
        if (!has_next) break;
#pragma unroll
        for (int a = 0; a < 2; ++a)
#pragma unroll
            for (int b = 0; b < 2; ++b)
#pragma unroll
                for (int m = 0; m < 4; ++m)
#pragma unroll
                    for (int n = 0; n < 2; ++n) acc[a][b][m][n] = (f32x4){0.f, 0.f, 0.f, 0.f};
        cur = nxt; cA = nA; cB = nB; ++ui;
        if constexpr (ALIGN_EPI) { if (wr == 1) PG8_BAR; }
    }
    PG8_WAIT_V(0);
    if constexpr (!ALIGN_EPI) { if (wr == 0) PG8_BAR; }
    PG8_BAR;
    if constexpr (Epi::AFTER_DRAIN) E.fused(acc, cur, wr, wc, fr, fq, lds, wid, lane);
#undef PG8_SA
#undef PG8_SB
#undef PG8_STAGE
#undef PG8_LDA
#undef PG8_LDB
#undef PG8_MMA
#undef PG8_WAIT_V
#undef PG8_WAIT_L
#undef PG8_BAR
#undef PG8_SCHED
}

typedef f32x4 AccT[2][2][4][2];

struct EpiInProj {
    static constexpr bool AFTER_DRAIN = false;
    bf16_t* P; bf16_t* VT; const float* rope; bf16_t* BND;
    __device__ __forceinline__ void operator()(AccT& acc, const Unit& u, int wr, int wc, int fr, int fq) const {
        const int row0 = u.pm * BM + wr * 64 + fr, colb = u.pn * BM + wc * 32 + 8 * fq;
#pragma unroll
        for (int ai = 0; ai < 2; ++ai)
#pragma unroll
            for (int m = 0; m < 4; ++m) {
                const int row = row0 + ai * HALF + m * 16, t = row & (SEQ - 1);
                bf16_t* rowp = P + (size_t)row * LDP + COL_PA;
#pragma unroll
                for (int bj = 0; bj < 2; ++bj) {
                    const int c = colb + bj * HALF;
                    f32x4 v0 = acc[ai][bj][m][0], v1 = acc[ai][bj][m][1];
                    if (u.pn >= 15) {
                        const int cl = c - 3840;
                        if (cl < 640 || (cl >= 768 && cl < 1088)) {
                            const float* cs = rope + ((size_t)t * 32 + ((cl & 63) >> 1)) * 2;
                            const f32x4 r0 = *(const f32x4*)cs, r1 = *(const f32x4*)(cs + 4);
                            f32x4 o0, o1;
                            o0[0] = v0[0] * r0[0] - v0[1] * r0[1]; o0[1] = v0[1] * r0[0] + v0[0] * r0[1];
                            o0[2] = v0[2] * r0[2] - v0[3] * r0[3]; o0[3] = v0[3] * r0[2] + v0[2] * r0[3];
                            o1[0] = v1[0] * r1[0] - v1[1] * r1[1]; o1[1] = v1[1] * r1[0] + v1[0] * r1[1];
                            o1[2] = v1[2] * r1[2] - v1[3] * r1[3]; o1[3] = v1[3] * r1[2] + v1[2] * r1[3];
                            v0 = o0; v1 = o1;
                        }
                    }
                    u32x4 w; w.x = cvt_pk_bf16(v0[0], v0[1]); w.y = cvt_pk_bf16(v0[2], v0[3]); w.z = cvt_pk_bf16(v1[0], v1[1]); w.w = cvt_pk_bf16(v1[2], v1[3]);
                    *(u32x4*)(rowp + c) = w;
                    if (u.pn < 7 && fr == 15) *(u32x4*)(BND + (size_t)(row >> 4) * 1792 + c) = w;
                    if (u.pn == 17 && bj == 1) {
                        const int cv = c - 3840 - 640, b = row >> 11;
                        bf16_t* vt = VT + ((size_t)(b * 2 + (cv >> 6)) * 64 + (cv & 63)) * SEQ + t;
                        vt[0 * SEQ] = (bf16_t)(w.x & 0xffffu); vt[1 * SEQ] = (bf16_t)(w.x >> 16);
                        vt[2 * SEQ] = (bf16_t)(w.y & 0xffffu); vt[3 * SEQ] = (bf16_t)(w.y >> 16);
                        vt[4 * SEQ] = (bf16_t)(w.z & 0xffffu); vt[5 * SEQ] = (bf16_t)(w.z >> 16);
                        vt[6 * SEQ] = (bf16_t)(w.w & 0xffffu); vt[7 * SEQ] = (bf16_t)(w.w >> 16);
                    }
                }
            }
    }
};
struct EpiGate {
    static constexpr bool AFTER_DRAIN = false;
    bf16_t* P;
    __device__ __forceinline__ void operator()(AccT& acc, const Unit& u, int wr, int wc, int fr, int fq) const {
        const int row0 = u.pm * BM + wr * 64 + fr, colb = u.pn * BM + wc * 32 + 8 * fq;
#pragma unroll
        for (int ai = 0; ai < 2; ++ai)
#pragma unroll
            for (int m = 0; m < 4; ++m) {
                bf16_t* rowp = P + (size_t)(row0 + ai * HALF + m * 16) * LDP + COL_G + colb;
#pragma unroll
                for (int bj = 0; bj < 2; ++bj) {
                    const f32x4 v0 = acc[ai][bj][m][0], v1 = acc[ai][bj][m][1];
                    u32x4 w; w.x = cvt_pk_bf16(sigmoidf_(v0[0]), sigmoidf_(v0[1])); w.y = cvt_pk_bf16(sigmoidf_(v0[2]), sigmoidf_(v0[3]));
                    w.z = cvt_pk_bf16(sigmoidf_(v1[0]), sigmoidf_(v1[1])); w.w = cvt_pk_bf16(sigmoidf_(v1[2]), sigmoidf_(v1[3]));
                    *(u32x4*)(rowp + bj * HALF) = w;
                }
            }
    }
};
struct EpiMergeAcc {
    static constexpr bool AFTER_DRAIN = false;
    bf16_t* P; int first;
    __device__ __forceinline__ void operator()(AccT& acc, const Unit& u, int wr, int wc, int fr, int fq) const {
        const int row0 = u.pm * BM + wr * 64 + fr, colb = u.pn * BM + wc * 32 + 8 * fq;
#pragma unroll
        for (int ai = 0; ai < 2; ++ai)
#pragma unroll
            for (int m = 0; m < 4; ++m) {
                bf16_t* rowb = P + (size_t)(row0 + ai * HALF + m * 16) * LDP + colb;
#pragma unroll
                for (int bj = 0; bj < 2; ++bj) {
                    const f32x4 v0 = acc[ai][bj][m][0], v1 = acc[ai][bj][m][1];
                    const u32x4 gq = *(const u32x4*)(rowb + COL_G + bj * HALF);
                    u32x4 mq = (u32x4){0u, 0u, 0u, 0u};
                    if (!first) mq = *(const u32x4*)(rowb + COL_MRG + bj * HALF);
                    const unsigned ga = gq.x, gb = gq.y, gc = gq.z, gd = gq.w;
                    const unsigned ma = mq.x, mb = mq.y, mc = mq.z, md = mq.w;
                    u32x4 w;
                    w.x = cvt_pk_bf16(bflo(ma) + bflo(ga) * v0[0], bfhi(ma) + bfhi(ga) * v0[1]);
                    w.y = cvt_pk_bf16(bflo(mb) + bflo(gb) * v0[2], bfhi(mb) + bfhi(gb) * v0[3]);
                    w.z = cvt_pk_bf16(bflo(mc) + bflo(gc) * v1[0], bfhi(mc) + bfhi(gc) * v1[1]);
                    w.w = cvt_pk_bf16(bflo(md) + bflo(gd) * v1[2], bfhi(md) + bfhi(gd) * v1[3]);
                    *(u32x4*)(rowb + COL_MRG + bj * HALF) = w;
                }
            }
    }
};
struct EpiResid {
    static constexpr bool AFTER_DRAIN = false;
    const float* base; float* out;
    __device__ __forceinline__ void operator()(AccT& acc, const Unit& u, int wr, int wc, int fr, int fq) const {
        const int row0 = u.pm * BM + wr * 64 + fr, colb = u.pn * BM + wc * 32 + 8 * fq;
#pragma unroll
        for (int ai = 0; ai < 2; ++ai)
#pragma unroll
            for (int m = 0; m < 4; ++m) {
                const size_t off = (size_t)(row0 + ai * HALF + m * 16) * DM + colb;
#pragma unroll
                for (int bj = 0; bj < 2; ++bj) {
                    const f32x4 b0 = *(const f32x4*)(base + off + bj * HALF), b1 = *(const f32x4*)(base + off + bj * HALF + 4);
                    *(f32x4*)(out + off + bj * HALF) = b0 + acc[ai][bj][m][0];
                    *(f32x4*)(out + off + bj * HALF + 4) = b1 + acc[ai][bj][m][1];
                }
            }
    }
};
struct EpiResidNorm {
    static constexpr bool AFTER_DRAIN = true;
    const float* base; float* out; const float* g; bf16_t* obf; float* of32; unsigned* xbuf; unsigned* cnt;
    __device__ __forceinline__ void fused(AccT& acc, const Unit& u, int wr, int wc, int fr, int fq, LAS unsigned char* lds, int wid, int lane) const {
        LAS float* Pl = (LAS float*)lds;
        LAS float* S = (LAS float*)(lds + 8192);
        const int row0 = u.pm * BM + wr * 64 + fr, colb = u.pn * BM + wc * 32 + 8 * fq;
#pragma unroll
        for (int ai = 0; ai < 2; ++ai)
#pragma unroll
            for (int m = 0; m < 4; ++m) {
                const size_t off = (size_t)(row0 + ai * HALF + m * 16) * DM + colb;
                float sq = 0.f;
#pragma unroll
                for (int bj = 0; bj < 2; ++bj) {
                    const f32x4 b0 = *(const f32x4*)(base + off + bj * HALF), b1 = *(const f32x4*)(base + off + bj * HALF + 4);
                    const f32x4 h0 = acc[ai][bj][m][0] + b0, h1 = acc[ai][bj][m][1] + b1;
                    acc[ai][bj][m][0] = h0; acc[ai][bj][m][1] = h1;
                    sq += (h0.x * h0.x + h0.y * h0.y) + (h0.z * h0.z + h0.w * h0.w) + (h1.x * h1.x + h1.y * h1.y) + (h1.z * h1.z + h1.w * h1.w);
                }
                sq += __shfl_xor(sq, 16); sq += __shfl_xor(sq, 32);
                if (fq == 0) Pl[(ai * HALF + wr * 64 + m * 16 + fr) * 4 + wc] = sq;
                if (m & 1) asm volatile("" ::: "memory");
            }
        asm volatile("s_waitcnt lgkmcnt(0)" ::: "memory"); __builtin_amdgcn_s_barrier(); asm volatile("" ::: "memory");
        const int row = wid * 32 + (lane & 31);
        if (lane < 32) {
            const f32x4 p = *(const LAS f32x4*)&Pl[row * 4];
            __hip_atomic_store(xbuf + ((size_t)(u.pm * BM + row) * 4 + u.pn), __builtin_bit_cast(unsigned, (p.x + p.y) + (p.z + p.w)), __ATOMIC_RELAXED, __HIP_MEMORY_SCOPE_AGENT);
        }
        asm volatile("s_waitcnt vmcnt(0)" ::: "memory");
        if (lane == 0) __hip_atomic_fetch_add(cnt + 64 * u.pm, 1u, __ATOMIC_RELAXED, __HIP_MEMORY_SCOPE_AGENT);
        if (wid == 0) {
            unsigned sp = 0u;
            while ((unsigned)__builtin_amdgcn_readfirstlane(__hip_atomic_load(cnt + 64 * u.pm, __ATOMIC_RELAXED, __HIP_MEMORY_SCOPE_AGENT)) < 32u) { __builtin_amdgcn_s_sleep(2); if (++sp > (1u << 22)) break; }
            __builtin_amdgcn_fence(__ATOMIC_ACQUIRE, "agent");
        }
        asm volatile("s_waitcnt vmcnt(0) lgkmcnt(0)" ::: "memory"); __builtin_amdgcn_s_barrier(); asm volatile("" ::: "memory");
        if (lane < 32) {
            const unsigned* slot = xbuf + (size_t)(u.pm * BM + row) * 4; float tot = 0.f;
#pragma unroll
            for (int t = 0; t < 4; ++t) tot += __builtin_bit_cast(float, __hip_atomic_load(slot + t, __ATOMIC_RELAXED, __HIP_MEMORY_SCOPE_AGENT));
            S[row] = 1.0f / sqrtf(tot * (1.f / DM) + 1e-6f);
        }
        asm volatile("s_waitcnt lgkmcnt(0)" ::: "memory"); __builtin_amdgcn_s_barrier(); asm volatile("" ::: "memory");
        f32x4 gv[2][2];
#pragma unroll
        for (int bj = 0; bj < 2; ++bj)
#pragma unroll
            for (int n = 0; n < 2; ++n) gv[bj][n] = *(const f32x4*)(g + colb + bj * HALF + 4 * n);
#pragma unroll
        for (int ai = 0; ai < 2; ++ai)
#pragma unroll
            for (int m = 0; m < 4; ++m) {
                const int rl = ai * HALF + wr * 64 + m * 16 + fr, rowg = u.pm * BM + rl;
                const float rs = S[rl];
#pragma unroll
                for (int bj = 0; bj < 2; ++bj) {
                    const f32x4 h0 = acc[ai][bj][m][0], h1 = acc[ai][bj][m][1];
                    const size_t off = (size_t)rowg * DM + colb + bj * HALF;
                    if (out) { *(f32x4*)(out + off) = h0; *(f32x4*)(out + off + 4) = h1; }
                    const f32x4 o0 = h0 * rs * gv[bj][0], o1 = h1 * rs * gv[bj][1];
                    if (obf) { u32x4 w; w.x = cvt_pk_bf16(o0[0], o0[1]); w.y = cvt_pk_bf16(o0[2], o0[3]); w.z = cvt_pk_bf16(o1[0], o1[1]); w.w = cvt_pk_bf16(o1[2], o1[3]);
                        *(u32x4*)(obf + (size_t)rowg * LDP + colb + bj * HALF) = w; }
                    else { *(f32x4*)(of32 + off) = o0; *(f32x4*)(of32 + off + 4) = o1; }
                }
                asm volatile("" ::: "memory");
            }
    }
};
struct EpiUp {
    static constexpr bool AFTER_DRAIN = false;
    bf16_t* P; float* HALO; const float* cw; const float* cb; LAS float* CW;
    __device__ __forceinline__ void operator()(AccT& acc, const Unit& u, int wr, int wc, int fr_in, int fq_in) const {
        int fr = fr_in, fq = fq_in;
        asm volatile("" : "+v"(fr), "+v"(fq));
        const int row0 = u.pm * BM + wr * 64 + fr;
        const int jb = u.pn * 128 + wc * 32 + 8 * fq;
        {
            const int tl = (wr * 4 + wc) * 64 + fq * 16 + fr;
#pragma unroll
            for (int it = 0; it < 2; ++it) { const int k = tl + 512 * it, p = k >> 8, col = k & 255, co = (col >> 7) * DFF + u.pn * 128 + (col & 127);
                CW[k] = (p < 3) ? cw[p * F2 + co] : cb[co]; }
            asm volatile("s_waitcnt lgkmcnt(0)" ::: "memory"); __builtin_amdgcn_s_barrier(); asm volatile("" ::: "memory");
        }
#pragma unroll
        for (int ai = 0; ai < 2; ++ai) {
            const int s = u.pm * 4 + ai * 2 + wr;
#pragma unroll
            for (int bj = 0; bj < 2; ++bj)
#pragma unroll
                for (int n = 0; n < 2; ++n) {
                    const int colp = u.pn * BM + bj * HALF + wc * 32 + 8 * fq + 4 * n;
                    if (fr < 2) *(f32x4*)(HALO + (size_t)(s * 4 + fr) * F2 + colp) = acc[ai][bj][0][n];
                    if (fr >= 14) *(f32x4*)(HALO + (size_t)(s * 4 + fr - 12) * F2 + colp) = acc[ai][bj][3][n];
                }
        }
#pragma unroll
        for (int ai = 0; ai < 2; ++ai)
#pragma unroll
            for (int m = 0; m < 4; ++m) {
                const int row = row0 + ai * HALF + m * 16;
#pragma unroll
                for (int n = 0; n < 2; ++n) {
                    f32x4 cv[2];
#pragma unroll
                    for (int bj = 0; bj < 2; ++bj) {
                        const int cl = bj * 128 + wc * 32 + 8 * fq + 4 * n;
                        const f32x4 w0 = *(const LAS f32x4*)&CW[cl], w1 = *(const LAS f32x4*)&CW[256 + cl], w2 = *(const LAS f32x4*)&CW[512 + cl], bb = *(const LAS f32x4*)&CW[768 + cl];
#pragma unroll
                        for (int e = 0; e < 4; ++e) {
                            const float cur = acc[ai][bj][m][n][e];
                            const float prv = m > 0 ? acc[ai][bj][m > 0 ? m - 1 : 0][n][e] : 0.f;
                            const float a1 = dpp_mov<0x121>(cur), a2 = dpp_mov<0x122>(cur), b1 = dpp_mov<0x121>(prv), b2 = dpp_mov<0x122>(prv);
                            const float p1 = fr >= 1 ? a1 : b1, p2 = fr >= 2 ? a2 : b2;
                            cv[bj][e] = bb[e] + w0[e] * p2 + w1[e] * p1 + w2[e] * cur;
                        }
                        __builtin_amdgcn_sched_barrier(0);
                    }
                    const f32x4 g0 = cv[0], v0 = cv[1];
                    u32x2 w;
                    w.x = cvt_pk_bf16(g0[0] * sigmoidf_(g0[0]) * v0[0], g0[1] * sigmoidf_(g0[1]) * v0[1]);
                    w.y = cvt_pk_bf16(g0[2] * sigmoidf_(g0[2]) * v0[2], g0[3] * sigmoidf_(g0[3]) * v0[3]);
                    if (!(m == 0 && fr < 2)) *(u32x2*)(P + (size_t)row * LDP + COL_ACT + jb + 4 * n) = w;
                    __builtin_amdgcn_sched_barrier(0);
                }
            }
    }
};
}

struct Ctx {
    const float* in[24]; float* out; unsigned char* ws;
    bf16_t* P; bf16_t* VT; float* HALO; float* ROPE;
    bf16_t *Win, *Wg, *Wbr, *Wo, *Wup, *Wdn;
    int tid, lane, wave, G, bid;
};

__device__ __forceinline__ int srccol(int mode, int n) {
    if (mode == 0) return n;
    if (mode == 2) return 4932 + n;
    if (mode == 3) { const int tile = n >> 8, w = n & 255, j = tile * 128 + (w & 127); return (w < 128) ? j : DFF + j; }
    if (n < 3840) return n;
    const int c = n - 3840;
    if (c >= 1092) return -1;
    if (c < 640 || (c >= 768 && c < 1088)) { const int base = c & ~63, i = c & 63; return 3840 + base + (i >> 1) + 32 * (i & 1); }
    return 3840 + c;
}
__device__ __forceinline__ void tr_item(const float* W, int ldw, int K, int N, bf16_t* WT, int mode, int item, LAS float* scr, int lane) {
    const int nblk = N / 32, kb = item / nblk, nb = item % nblk, k0 = 64 * kb, n0 = 32 * nb;
    const int sc = srccol(mode, n0 + (lane & 31));
    float wv_[32];
#pragma unroll
    for (int i = 0; i < 32; ++i) { const int kk = 2 * i + (lane >> 5); wv_[i] = (sc >= 0) ? W[(size_t)(k0 + kk) * ldw + sc] : 0.f; }
#pragma unroll
    for (int i = 0; i < 32; ++i) { const int kk = 2 * i + (lane >> 5); scr[kk * 33 + (lane & 31)] = wv_[i]; }
    asm volatile("s_waitcnt lgkmcnt(0)" ::: "memory");
    const int c = lane & 7;
#pragma unroll
    for (int j = 0; j < 4; ++j) { const int n = (lane >> 3) + 8 * j; const LAS float* s = scr + (8 * c) * 33 + n;
        u32x4 o; o.x = pk2(s[0 * 33], s[1 * 33]); o.y = pk2(s[2 * 33], s[3 * 33]); o.z = pk2(s[4 * 33], s[5 * 33]); o.w = pk2(s[6 * 33], s[7 * 33]);
        *(u32x4*)(WT + (size_t)(n0 + n) * K + k0 + 8 * c) = o; }
    asm volatile("s_waitcnt lgkmcnt(0)" ::: "memory");
}
__device__ __forceinline__ void rms_row(const float* xrow, const float* g, bf16_t* obf, float* of32, int lane) {
    const f32x4* xr = (const f32x4*)xrow + lane; const f32x4* gr = (const f32x4*)g + lane;
    f32x4 v[4]; float s = 0.f;
#pragma unroll
    for (int j = 0; j < 4; ++j) { v[j] = xr[64 * j]; s += (v[j].x * v[j].x + v[j].y * v[j].y) + (v[j].z * v[j].z + v[j].w * v[j].w); }
    const float rs = 1.f / sqrtf(wave_sum(s) * (1.f / DM) + 1e-6f);
#pragma unroll
    for (int j = 0; j < 4; ++j) {
        const f32x4 gg = gr[64 * j]; const f32x4 o = v[j] * rs * gg;
        if (obf) { u32x2 w; w.x = pk2(o.x, o.y); w.y = pk2(o.z, o.w); *((u32x2*)obf + lane + 64 * j) = w; }
        else *((f32x4*)of32 + lane + 64 * j) = o;
    }
}
__device__ __forceinline__ void rms_pass(const Ctx& X, const float* src, const float* g, bf16_t* obf, float* of32) {
    const int gw = X.bid * 8 + X.wave, NGW = X.G * 8, lane = X.lane;
    const f32x4* gr = (const f32x4*)g + lane;
    f32x4 gg[4];
#pragma unroll
    for (int j = 0; j < 4; ++j) gg[j] = gr[64 * j];
#pragma unroll 1
    for (int m = gw; m < T_TOK; m += 4 * NGW) {
        f32x4 v[4][4]; float ss[4]; int mr[4];
#pragma unroll
        for (int r = 0; r < 4; ++r) { mr[r] = m + r * NGW; const int ml = mr[r] < T_TOK ? mr[r] : m; const f32x4* x = (const f32x4*)(src + (size_t)ml * DM) + lane;
#pragma unroll
            for (int j = 0; j < 4; ++j) v[r][j] = x[64 * j]; }
#pragma unroll
        for (int r = 0; r < 4; ++r) { float a = 0.f;
#pragma unroll
            for (int j = 0; j < 4; ++j) a += (v[r][j].x * v[r][j].x + v[r][j].y * v[r][j].y) + (v[r][j].z * v[r][j].z + v[r][j].w * v[r][j].w);
            ss[r] = 1.f / sqrtf(wave_sum(a) * (1.f / DM) + 1e-6f); }
#pragma unroll
        for (int r = 0; r < 4; ++r) {
            if (mr[r] < T_TOK) {
#pragma unroll
                for (int j = 0; j < 4; ++j) {
                    const f32x4 o = v[r][j] * ss[r] * gg[j];
                    if (obf) { u32x2 w; w.x = pk2(o.x, o.y); w.y = pk2(o.z, o.w); *((u32x2*)(obf + (size_t)mr[r] * LDP) + lane + 64 * j) = w; }
                    else *((f32x4*)(of32 + (size_t)mr[r] * DM) + lane + 64 * j) = o;
                }
            }
        }
    }
}
__device__ __forceinline__ void phase_prep(const Ctx& X, LAS unsigned char* lds, int layer, bool do_u) {
    LAS float* scr = (LAS float*)(lds + X.wave * 8448);
    const int gw = X.bid * 8 + X.wave, NGW = X.G * 8;
    constexpr int I_IN = 16 * 160, I_G = 16 * 96, I_BR = 8 * 32, I_O = 16 * 32, I_UP = 16 * 176, I_DN = 44 * 32;
    constexpr int NITEMS = I_IN + I_G + 3 * I_BR + I_O + I_UP + I_DN;
    const float* w_in = X.in[2] + (size_t)layer * DM * IN_COLS;
    const float* w_br = X.in[16] + (size_t)layer * 3 * 512 * DM;
    const float* w_o = X.in[17] + (size_t)layer * DM * DM;
    const float* w_up = X.in[19] + (size_t)layer * DM * F2;
    const float* w_dn = X.in[22] + (size_t)layer * DFF * DM;
    for (int it = gw; it < NITEMS; it += NGW) {
        int r = it;
        if (r < I_IN) { tr_item(w_in, IN_COLS, DM, 5120, X.Win, 1, r, scr, X.lane); continue; } r -= I_IN;
        if (r < I_G) { tr_item(w_in, IN_COLS, DM, 3072, X.Wg, 2, r, scr, X.lane); continue; } r -= I_G;
        if (r < 3 * I_BR) { const int b = r / I_BR; tr_item(w_br + (size_t)b * 512 * DM, DM, 512, DM, X.Wbr + (size_t)b * DM * 512, 0, r % I_BR, scr, X.lane); continue; } r -= 3 * I_BR;
        if (r < I_O) { tr_item(w_o, DM, DM, DM, X.Wo, 0, r, scr, X.lane); continue; } r -= I_O;
        if (r < I_UP) { tr_item(w_up, F2, DM, F2, X.Wup, 3, r, scr, X.lane); continue; } r -= I_UP;
        tr_item(w_dn, DM, DFF, DM, X.Wdn, 0, r, scr, X.lane);
    }
    const float* h = (layer == 0) ? X.in[0] : X.out;
    const float* g = X.in[1] + (size_t)layer * DM;
    if (do_u) rms_pass(X, h, g, X.P, nullptr);
    if (layer == 0) {
        for (int idx = X.bid * 512 + X.tid; idx < SEQ * 32; idx += X.G * 512) {
            const int t = idx >> 5, p = idx & 31;
            const float inv = exp2f(-(float)p * 0.03125f * 13.287712379549449f);
            const float ang = (float)t * inv;
            const double rev = (double)ang * 0.15915494309189535;
            const float fr = (float)(rev - floor(rev));
            X.ROPE[2 * idx] = __builtin_amdgcn_cosf(fr); X.ROPE[2 * idx + 1] = __builtin_amdgcn_sinf(fr);
        }
    }
}

__device__ __forceinline__ float wave_sum_fast(float x) {
    x = red16(x);
    const float r0 = __builtin_bit_cast(float, __builtin_amdgcn_readlane(__builtin_bit_cast(int, x), 0)), r1 = __builtin_bit_cast(float, __builtin_amdgcn_readlane(__builtin_bit_cast(int, x), 16));
    const float r2 = __builtin_bit_cast(float, __builtin_amdgcn_readlane(__builtin_bit_cast(int, x), 32)), r3 = __builtin_bit_cast(float, __builtin_amdgcn_readlane(__builtin_bit_cast(int, x), 48));
    return (r0 + r1) + (r2 + r3);
}
#define LDS_BAR() do { asm volatile("s_waitcnt lgkmcnt(0)" ::: "memory"); __builtin_amdgcn_s_barrier(); asm volatile("" ::: "memory"); } while (0)
constexpr int RW_TS = 16, RW_NCH = SEQ / RW_TS, RW_BUF = 33280;
__device__ __forceinline__ void phase_rwkv_pre(const Ctx& X, LAS unsigned char* lds, int layer) {
    LAS float* Rr = (LAS float*)(lds);           LAS float* Kk = (LAS float*)(lds + 8192);   LAS float* Vv = (LAS float*)(lds + 16384);
    LAS float* W1 = (LAS float*)(lds + 24576);   LAS float* AS = (LAS float*)(lds + 32768);
    LAS bf16_t* WDb = (LAS bf16_t*)(lds + 40960);
    LAS bf16_t* ADb = (LAS bf16_t*)(lds + 45568);
    LAS bf16_t* WTu = (LAS bf16_t*)(lds + 50176);
    LAS bf16_t* WTa = (LAS bf16_t*)(lds + 59392);
    LAS float* MU = (LAS float*)(lds + 68608);
    const int tid = X.tid, lane = tid & 63, wv = X.wave;
    const float* mu = X.in[3] + layer * 1792;
    const float* w0 = X.in[4] + layer * 512;   const float* w_up = X.in[5] + (size_t)layer * 64 * 512;
    const float* a0 = X.in[6] + layer * 512;   const float* a_up = X.in[7] + (size_t)layer * 64 * 512;
    const float* k_k = X.in[9] + layer * 512;  const float* k_a = X.in[10] + layer * 512;  const float* r_k = X.in[11] + layer * 512;
    const bf16_t* BND = (const bf16_t*)(X.ws + WS_BND);
    float* SCAL = (float*)(X.ws + WS_SCAL);
    const int ln = lane & 15, lg = lane >> 4;
    int last_h = -1;
    float q_w0 = 0.f, q_a0 = 0.f;
    f32x4 p_kk4 = (f32x4){0.f, 0.f, 0.f, 0.f}, p_ka4 = p_kk4, p_rk4 = p_kk4;
    const int cg4 = (tid & 15) * 4;
    u32x4 pc4[3], pp4[3], gc4, gp4; bool have_pf = false;
    pc4[0] = pc4[1] = pc4[2] = pp4[0] = pp4[1] = pp4[2] = gc4 = gp4 = (u32x4){0u, 0u, 0u, 0u};
#define PRE_LOAD(uu) do { const int h_ = (uu) & 7, tp_ = (uu) >> 3; _Pragma("unroll") for (int it = 0; it < 3; ++it) { const int idx = tid + 512 * it; pc4[it] = (u32x4){0u, 0u, 0u, 0u}; pp4[it] = (u32x4){0u, 0u, 0u, 0u}; \
        if (idx < 32 * 40) { const int tt = idx / 40, vv = idx - tt * 40; \
            const int col = vv < 8 ? h_ * 64 + 8 * vv : (vv < 16 ? 512 + h_ * 64 + 8 * (vv - 8) : (vv < 24 ? 1024 + h_ * 64 + 8 * (vv - 16) : 1536 + 8 * (vv - 24))); \
            const size_t row = (size_t)tp_ * 32 + tt; pc4[it] = *(const u32x4*)(X.P + row * LDP + COL_PA + col); \
            if (tt > 0) pp4[it] = *(const u32x4*)(X.P + (row - 1) * LDP + COL_PA + col); else if ((tp_ & 63) != 0) pp4[it] = *(const u32x4*)(BND + (size_t)(2 * tp_ - 1) * 1792 + col); } } \
        if (tid < 64) { const int tt = tid >> 1, col = 1664 + 8 * (2 * h_ + (tid & 1)); const size_t row = (size_t)tp_ * 32 + tt; gc4 = *(const u32x4*)(X.P + row * LDP + COL_PA + col); gp4 = (u32x4){0u, 0u, 0u, 0u}; \
            if (tt > 0) gp4 = *(const u32x4*)(X.P + (row - 1) * LDP + COL_PA + col); else if ((tp_ & 63) != 0) gp4 = *(const u32x4*)(BND + (size_t)(2 * tp_ - 1) * 1792 + col); } } while (0)
#pragma unroll 1
    for (int u = X.bid; u < 4096; u += X.G) {
        const int h = u & 7, tp = u >> 3;
        if (h != last_h) {
            __syncthreads();
            for (int idx = tid; idx < 64 * 64; idx += 512) { const int m = idx >> 6, cc = idx & 63;
                WTu[cc * 72 + m] = (bf16_t)f2bf(w_up[m * 512 + h * 64 + cc]); WTa[cc * 72 + m] = (bf16_t)f2bf(a_up[m * 512 + h * 64 + cc]); }
            if (tid < 320) { const int cc = tid; const int col = cc < 64 ? h * 64 + cc : (cc < 128 ? 512 + h * 64 + cc - 64 : (cc < 192 ? 1024 + h * 64 + cc - 128 : 1536 + cc - 192)); MU[cc] = mu[col]; }
            p_kk4 = *(const f32x4*)(k_k + h * 64 + cg4); p_ka4 = *(const f32x4*)(k_a + h * 64 + cg4); p_rk4 = *(const f32x4*)(r_k + h * 64 + cg4);
            q_w0 = w0[h * 64 + 16 * (wv >> 1) + ln]; q_a0 = a0[h * 64 + 16 * (wv >> 1) + ln];
            last_h = h;
            __syncthreads();
        }
        if (!have_pf) { PRE_LOAD(u); }
#pragma unroll
        for (int it = 0; it < 3; ++it) {
            const int idx = tid + 512 * it;
            if (idx < 32 * 40) {
                const int tt = idx / 40, vv = idx - tt * 40, cc0 = 8 * vv;
                const u32x4 c4 = pc4[it], p4 = pp4[it];
                const f32x4 m0 = *(const LAS f32x4*)&MU[cc0], m1 = *(const LAS f32x4*)&MU[cc0 + 4];
                float cur[8], prv[8], val[8];
                cur[0] = bflo(c4.x); cur[1] = bfhi(c4.x); cur[2] = bflo(c4.y); cur[3] = bfhi(c4.y); cur[4] = bflo(c4.z); cur[5] = bfhi(c4.z); cur[6] = bflo(c4.w); cur[7] = bfhi(c4.w);
                prv[0] = bflo(p4.x); prv[1] = bfhi(p4.x); prv[2] = bflo(p4.y); prv[3] = bfhi(p4.y); prv[4] = bflo(p4.z); prv[5] = bfhi(p4.z); prv[6] = bflo(p4.w); prv[7] = bfhi(p4.w);
#pragma unroll
                for (int e = 0; e < 8; ++e) val[e] = cur[e] + (prv[e] - cur[e]) * (e < 4 ? m0[e & 3] : m1[e & 3]);
                if (vv < 24) {
#pragma unroll
                    for (int e = 0; e < 8; e += 2) { const unsigned w_ = pk2(val[e], val[e + 1]); val[e] = bflo(w_); val[e + 1] = bfhi(w_); }
                    LAS float* dst = (vv < 8 ? Rr : (vv < 16 ? Kk : Vv)) + tt * 64 + 8 * (vv & 7);
                    *(LAS f32x4*)dst = (f32x4){val[0], val[1], val[2], val[3]}; *(LAS f32x4*)(dst + 4) = (f32x4){val[4], val[5], val[6], val[7]};
                } else {
                    const int lr0 = 8 * (vv - 24);
                    LAS bf16_t* dst;
                    if (lr0 < 64) { dst = WDb + tt * 72 + lr0;
#pragma unroll
                        for (int e = 0; e < 8; ++e) { const float ex = __expf(2.f * val[e]); val[e] = 1.f - 2.f / (ex + 1.f); } }
                    else dst = ADb + tt * 72 + lr0 - 64;
                    u32x4 o; o.x = pk2(val[0], val[1]); o.y = pk2(val[2], val[3]); o.z = pk2(val[4], val[5]); o.w = pk2(val[6], val[7]);
                    *(LAS u32x4*)dst = o;
                }
            }
        }
        if (tid < 64) {
            const int tt = tid >> 1, vg = 2 * h + (tid & 1);
            const f32x4 m0 = *(const f32x4*)(mu + 1664 + 8 * vg), m1 = *(const f32x4*)(mu + 1664 + 8 * vg + 4);
            float gc[8], gp[8];
            gc[0] = bflo(gc4.x); gc[1] = bfhi(gc4.x); gc[2] = bflo(gc4.y); gc[3] = bfhi(gc4.y); gc[4] = bflo(gc4.z); gc[5] = bfhi(gc4.z); gc[6] = bflo(gc4.w); gc[7] = bfhi(gc4.w);
            gp[0] = bflo(gp4.x); gp[1] = bfhi(gp4.x); gp[2] = bflo(gp4.y); gp[3] = bfhi(gp4.y); gp[4] = bflo(gp4.z); gp[5] = bfhi(gp4.z); gp[6] = bflo(gp4.w); gp[7] = bfhi(gp4.w);
#pragma unroll
            for (int e = 0; e < 8; ++e) gc[e] = sigmoidf_(gc[e] + (gp[e] - gc[e]) * (e < 4 ? m0[e & 3] : m1[e & 3]));
            u32x4 o; o.x = pk2(gc[0], gc[1]); o.y = pk2(gc[2], gc[3]); o.z = pk2(gc[4], gc[5]); o.w = pk2(gc[6], gc[7]);
            *(u32x4*)(X.P + ((size_t)tp * 32 + tt) * LDP + COL_GS + 8 * vg) = o;
        }
        have_pf = false;
        if (u + X.G < 4096 && ((u + X.G) & 7) == h) { PRE_LOAD(u + X.G); have_pf = true; }
        LDS_BAR();
        {
            const int mt = wv & 1, nt = wv >> 1, chm = 16 * nt + ln;
            f32x4 cw_ = (f32x4){0.f, 0.f, 0.f, 0.f}, ca_ = cw_;
#pragma unroll
            for (int ks = 0; ks < 2; ++ks) {
                const bf16x8 xa = *(const LAS bf16x8*)&WDb[(16 * mt + ln) * 72 + ks * 32 + 8 * lg], xb = *(const LAS bf16x8*)&WTu[(16 * nt + ln) * 72 + ks * 32 + 8 * lg];
                cw_ = __builtin_amdgcn_mfma_f32_16x16x32_bf16(xa, xb, cw_, 0, 0, 0);
                const bf16x8 ya = *(const LAS bf16x8*)&ADb[(16 * mt + ln) * 72 + ks * 32 + 8 * lg], yb = *(const LAS bf16x8*)&WTa[(16 * nt + ln) * 72 + ks * 32 + 8 * lg];
                ca_ = __builtin_amdgcn_mfma_f32_16x16x32_bf16(ya, yb, ca_, 0, 0, 0);
            }
#pragma unroll
            for (int r = 0; r < 4; ++r) {
                const int tt = 16 * mt + 4 * lg + r;
                const float z = -(q_w0 + cw_[r]);
                const float sp = fmaxf(z, 0.f) + __logf(1.f + __expf(-fabsf(z)));
                const float e = __expf(-sp - 0.5f);
                W1[tt * 64 + chm] = bf2f((bf16_t)f2bf(-expm1f(-e)));
                AS[tt * 64 + chm] = bf2f((bf16_t)f2bf(sigmoidf_(q_a0 + ca_[r])));
            }
        }
        LDS_BAR();
        {
            const int tt = tid >> 4;
            const size_t row = (size_t)tp * 32 + tt;
            const f32x4 w1 = *(const LAS f32x4*)&W1[tt * 64 + cg4], a = *(const LAS f32x4*)&AS[tt * 64 + cg4];
            const f32x4 kraw = *(const LAS f32x4*)&Kk[tt * 64 + cg4], r = *(const LAS f32x4*)&Rr[tt * 64 + cg4], v = *(const LAS f32x4*)&Vv[tt * 64 + cg4];
            const f32x4 kk0 = kraw * p_kk4;
            const float inv = 1.f / sqrtf(fmaxf(red16((kk0.x * kk0.x + kk0.y * kk0.y) + (kk0.z * kk0.z + kk0.w * kk0.w)), 1e-24f));
            const f32x4 kk = kk0 * inv;
            const f32x4 kmod = kraw * (1.f + (a - 1.f) * p_ka4);
            const f32x4 bvec = kk * a, t1 = bvec * r, t2 = kmod * r, t3 = t2 * p_rk4;
            const float br = red16((t1.x + t1.y) + (t1.z + t1.w)), kr = red16((t2.x + t2.y) + (t2.z + t2.w)), bonus = red16((t3.x + t3.y) + (t3.z + t3.w));
            bf16_t* rp_ = X.P + row * LDP;
            u32x2 o;
            o.x = pk2(r.x, r.y); o.y = pk2(r.z, r.w); *(u32x2*)(rp_ + COL_PA + h * 64 + cg4) = o;
            o.x = pk2(kraw.x, kraw.y); o.y = pk2(kraw.z, kraw.w); *(u32x2*)(rp_ + COL_PA + 512 + h * 64 + cg4) = o;
            o.x = pk2(v.x, v.y); o.y = pk2(v.z, v.w); *(u32x2*)(rp_ + COL_PA + 1024 + h * 64 + cg4) = o;
            bf16_t* wa_ = (layer == 0) ? (bf16_t*)X.out + row * 2048 : rp_;
            o.x = pk2(w1.x, w1.y); o.y = pk2(w1.z, w1.w); *(u32x2*)(wa_ + h * 64 + cg4) = o;
            o.x = pk2(a.x, a.y); o.y = pk2(a.z, a.w); *(u32x2*)(wa_ + 512 + h * 64 + cg4) = o;
            if (cg4 == 0) *(f32x4*)(SCAL + (row * 8 + h) * 4) = (f32x4){inv, br, kr, bonus};
        }
        LDS_BAR();
    }
}

__device__ __forceinline__ void rwkv_task(const Ctx& X, LAS unsigned char* lds, int layer, int b, int h) {
    LAS bf16_t* GDb = (LAS bf16_t*)(lds + 66560);
    LAS bf16_t* WTg = (LAS bf16_t*)(lds + 75264);
    LAS float* BON = (LAS float*)(lds + 92672);
    const int tid = X.tid, lane = tid & 63;
    const bool helper = X.wave >= 4;
    const int ht = tid & 255;
    const float* mu = X.in[3] + layer * 1792;
    const float* g_up = X.in[8] + (size_t)layer * 128 * 512;
    const float* k_k = X.in[9] + layer * 512;  const float* k_a = X.in[10] + layer * 512;
    const float* gn_g = X.in[12] + layer * 512; const float* gn_b = X.in[13] + layer * 512;
    const float* SCAL = (const float*)(X.ws + WS_SCAL);
    const int tt_h = ht >> 4, cg4 = (ht & 15) * 4;
    const f32x4 p_kk = *(const f32x4*)(k_k + h * 64 + cg4), p_ka = *(const f32x4*)(k_a + h * 64 + cg4);
    const f32x4 p_gg = *(const f32x4*)(gn_g + h * 64 + cg4), p_gb = *(const f32x4*)(gn_b + h * 64 + cg4);
    const int gv8 = (ht & 15) * 8;
    const int nt = (ht >> 6), ln = lane & 15, lg = lane >> 4, chm = 16 * nt + ln;
    const int rp = ht >> 3, jg = ht & 7, i0 = 2 * rp;
    for (int idx = tid; idx < 128 * 64; idx += 512) { const int m = idx >> 6, cc = idx & 63; WTg[cc * 136 + m] = (bf16_t)f2bf(g_up[m * 512 + h * 64 + cc]); }
    f32x2 S0[4], S1[4];
#pragma unroll
    for (int j = 0; j < 4; ++j) { S0[j] = (f32x2){0.f, 0.f}; S1[j] = (f32x2){0.f, 0.f}; }
#if PROBE_SCAN2
    f32x2 T0[4], T1[4];
#pragma unroll
    for (int j = 0; j < 4; ++j) { T0[j] = (f32x2){0.f, 0.f}; T1[j] = (f32x2){0.f, 0.f}; }
#endif
    __syncthreads();

#define RW_ARR(bufi, k) ((LAS float*)(lds + (bufi) * RW_BUF + (k) * 4096))
#define RW_SC(bufi) ((LAS float*)(lds + (bufi) * RW_BUF + 32768))
#define RW_LOAD(chk, L) do { const size_t row_ = (size_t)b * SEQ + (chk) * RW_TS + tt_h; const bf16_t* rp_ = X.P + row_ * LDP; \
        l_r##L = *(const u32x2*)(rp_ + COL_PA + h * 64 + cg4); l_k##L = *(const u32x2*)(rp_ + COL_PA + 512 + h * 64 + cg4); l_v##L = *(const u32x2*)(rp_ + COL_PA + 1024 + h * 64 + cg4); \
        { const bf16_t* wa_ = (layer == 0) ? (const bf16_t*)X.out + row_ * 2048 : rp_; l_w##L = *(const u32x2*)(wa_ + h * 64 + cg4); l_a##L = *(const u32x2*)(wa_ + 512 + h * 64 + cg4); } l_s##L = *(const f32x4*)(SCAL + (row_ * 8 + h) * 4); \
        l_gc##L = *(const u32x4*)(rp_ + COL_GS + gv8); } while (0)
    u32x2 l_rA, l_kA, l_vA, l_wA, l_aA; f32x4 l_sA; u32x4 l_gcA;
    u32x2 l_rB, l_kB, l_vB, l_wB, l_aB; f32x4 l_sB; u32x4 l_gcB;
    l_rA = l_kA = l_vA = l_wA = l_aA = l_rB = l_kB = l_vB = l_wB = l_aB = (u32x2){0u, 0u}; l_sA = l_sB = (f32x4){0.f, 0.f, 0.f, 0.f}; l_gcA = l_gcB = (u32x4){0u, 0u, 0u, 0u};
    if (helper) { RW_LOAD(0, A); RW_LOAD(1, B); }

#pragma unroll 1
    for (int i0_ = -1; i0_ < RW_NCH; i0_ += 2) {
        { const int i = i0_;

        const int bufn = (i + 1) & 1, bufc = i & 1;
        if (helper) {
            const bool do_prep = (i + 1 < RW_NCH);
            if (i >= 0) {
                LAS float* Gg = RW_ARR(bufc, 6);
                f32x4 cg_ = (f32x4){0.f, 0.f, 0.f, 0.f};
#pragma unroll
                for (int ks = 0; ks < 4; ++ks) {
                    const bf16x8 za = *(const LAS bf16x8*)&GDb[bufc * 2176 + ln * 136 + ks * 32 + 8 * lg], zb = *(const LAS bf16x8*)&WTg[(16 * nt + ln) * 136 + ks * 32 + 8 * lg];
                    cg_ = __builtin_amdgcn_mfma_f32_16x16x32_bf16(za, zb, cg_, 0, 0, 0);
                }
#pragma unroll
                for (int r = 0; r < 4; ++r) Gg[(4 * lg + r) * 64 + chm] = cg_[r];
            }
            if (i >= 1) {
                LAS float* Yy = RW_ARR(bufn, 7); LAS float* Gg = RW_ARR(bufn, 6); LAS float* Vv = RW_ARR(bufn, 5); LAS float* SC = RW_SC(bufn);
                const f32x4 y = *(const LAS f32x4*)&Yy[tt_h * 64 + cg4], gg = *(const LAS f32x4*)&Gg[tt_h * 64 + cg4], vv = *(const LAS f32x4*)&Vv[tt_h * 64 + cg4];
                const float bonus = BON[((i - 1) % 3) * 16 + tt_h];
                const float mean = red16((y.x + y.y) + (y.z + y.w)) * (1.f / 64.f);
                const f32x4 d = y - mean;
                const float var = red16((d.x * d.x + d.y * d.y) + (d.z * d.z + d.w * d.w)) * (1.f / 64.f);
                const float rs = 1.f / sqrtf(var + 64e-5f);
                const f32x4 o = (d * rs * p_gg + p_gb + vv * bonus) * gg;
                u32x2 w; w.x = pk2(o.x, o.y); w.y = pk2(o.z, o.w);
                *(u32x2*)(X.P + ((size_t)b * SEQ + (i - 1) * RW_TS + tt_h) * LDP + COL_YA + h * 64 + cg4) = w;
            }
            if (do_prep) {
                const f32x4 r = (f32x4){bflo(l_rA.x), bfhi(l_rA.x), bflo(l_rA.y), bfhi(l_rA.y)}, k = (f32x4){bflo(l_kA.x), bfhi(l_kA.x), bflo(l_kA.y), bfhi(l_kA.y)};
                const f32x4 v = (f32x4){bflo(l_vA.x), bfhi(l_vA.x), bflo(l_vA.y), bfhi(l_vA.y)}, w1 = (f32x4){bflo(l_wA.x), bfhi(l_wA.x), bflo(l_wA.y), bfhi(l_wA.y)};
                const f32x4 a = (f32x4){bflo(l_aA.x), bfhi(l_aA.x), bflo(l_aA.y), bfhi(l_aA.y)};
                const f32x4 kk = k * p_kk * l_sA.x;
                const f32x4 decay = 1.f - w1;
                *(LAS f32x4*)&RW_ARR(bufn, 0)[tt_h * 64 + cg4] = -kk;
                *(LAS f32x4*)&RW_ARR(bufn, 1)[tt_h * 64 + cg4] = decay * r;
                *(LAS f32x4*)&RW_ARR(bufn, 2)[tt_h * 64 + cg4] = decay;
                *(LAS f32x4*)&RW_ARR(bufn, 3)[tt_h * 64 + cg4] = kk * a;
                *(LAS f32x4*)&RW_ARR(bufn, 4)[tt_h * 64 + cg4] = k * (1.f + (a - 1.f) * p_ka);
                *(LAS f32x4*)&RW_ARR(bufn, 5)[tt_h * 64 + cg4] = v;
                if (cg4 == 0) { LAS float* SC = RW_SC(bufn); SC[tt_h * 4 + 0] = l_sA.y; SC[tt_h * 4 + 1] = l_sA.z; BON[((i + 1) % 3) * 16 + tt_h] = l_sA.w; }
                *(LAS u32x4*)&GDb[bufn * 2176 + tt_h * 136 + gv8] = l_gcA;
            }
            if (i + 3 < RW_NCH) RW_LOAD(i + 3, A);
            LDS_BAR();
        } else {
            LAS float* A_ = RW_ARR(bufc, 0); LAS float* WR = RW_ARR(bufc, 1); LAS float* Wd = RW_ARR(bufc, 2); LAS float* Bv = RW_ARR(bufc, 3);
            LAS float* Kk = RW_ARR(bufc, 4); LAS float* Vv = RW_ARR(bufc, 5); LAS float* Yy = RW_ARR(bufc, 7); LAS float* SC = RW_SC(bufc);
#pragma unroll 1
            for (int q4 = 0; q4 < 4; ++q4) {
                if (i >= 0) {
                    float yv[8];
#pragma unroll
                    for (int s4 = 0; s4 < 4; ++s4) {
                        const int tt = 4 * q4 + s4;
                        const f32x4 a_lo = *(const LAS f32x4*)&A_[tt * 64 + 8 * jg], a_hi = *(const LAS f32x4*)&A_[tt * 64 + 8 * jg + 4];
                        const f32x4 r_lo = *(const LAS f32x4*)&WR[tt * 64 + 8 * jg], r_hi = *(const LAS f32x4*)&WR[tt * 64 + 8 * jg + 4];
                        const f32x4 w_lo = *(const LAS f32x4*)&Wd[tt * 64 + 8 * jg], w_hi = *(const LAS f32x4*)&Wd[tt * 64 + 8 * jg + 4];
                        const f32x4 b_lo = *(const LAS f32x4*)&Bv[tt * 64 + 8 * jg], b_hi = *(const LAS f32x4*)&Bv[tt * 64 + 8 * jg + 4];
                        const f32x4 k_lo = *(const LAS f32x4*)&Kk[tt * 64 + 8 * jg], k_hi = *(const LAS f32x4*)&Kk[tt * 64 + 8 * jg + 4];
                        const f32x2 vv = *(const LAS f32x2*)&Vv[tt * 64 + i0];
                        const f32x2 sc = *(const LAS f32x2*)&SC[tt * 4];
                        const f32x2 av[4] = {{a_lo.x, a_lo.y}, {a_lo.z, a_lo.w}, {a_hi.x, a_hi.y}, {a_hi.z, a_hi.w}};
                        const f32x2 rv[4] = {{r_lo.x, r_lo.y}, {r_lo.z, r_lo.w}, {r_hi.x, r_hi.y}, {r_hi.z, r_hi.w}};
                        const f32x2 wv[4] = {{w_lo.x, w_lo.y}, {w_lo.z, w_lo.w}, {w_hi.x, w_hi.y}, {w_hi.z, w_hi.w}};
                        const f32x2 bv[4] = {{b_lo.x, b_lo.y}, {b_lo.z, b_lo.w}, {b_hi.x, b_hi.y}, {b_hi.z, b_hi.w}};
                        const f32x2 kv[4] = {{k_lo.x, k_lo.y}, {k_lo.z, k_lo.w}, {k_hi.x, k_hi.y}, {k_hi.z, k_hi.w}};
                        f32x2 e10 = S0[0] * av[0], e20 = S0[0] * rv[0], e11 = S1[0] * av[0], e21 = S1[0] * rv[0];
#pragma unroll
                        for (int j = 1; j < 4; ++j) { e10 += S0[j] * av[j]; e20 += S0[j] * rv[j]; e11 += S1[j] * av[j]; e21 += S1[j] * rv[j]; }
                        const float d10 = red8(e10.x + e10.y), d11 = red8(e11.x + e11.y);
                        yv[2 * s4] = (e20.x + e20.y) + (jg == 0 ? d10 * sc.x + vv.x * sc.y : 0.f); yv[2 * s4 + 1] = (e21.x + e21.y) + (jg == 0 ? d11 * sc.x + vv.y * sc.y : 0.f);
                        const f32x2 d10v = (f32x2){d10, d10}, d11v = (f32x2){d11, d11}, v0v = (f32x2){vv.x, vv.x}, v1v = (f32x2){vv.y, vv.y};
#pragma unroll
                        for (int j = 0; j < 4; ++j) { S0[j] = S0[j] * wv[j] + (d10v * bv[j] + v0v * kv[j]); S1[j] = S1[j] * wv[j] + (d11v * bv[j] + v1v * kv[j]); }
                    }
                    {
                        const bool t2 = (jg & 4) != 0, t1 = (jg & 2) != 0, t0 = (jg & 1) != 0;
#pragma unroll
                        for (int q = 0; q < 4; ++q) { const float keep = t2 ? yv[q + 4] : yv[q], send = t2 ? yv[q] : yv[q + 4]; yv[q] = keep + dpp_mov<0x141>(send); }
#pragma unroll
                        for (int q = 0; q < 2; ++q) { const float keep = t1 ? yv[q + 2] : yv[q], send = t1 ? yv[q] : yv[q + 2]; yv[q] = keep + dpp_mov<0x4E>(send); }
                        { const float keep = t0 ? yv[1] : yv[0], send = t0 ? yv[0] : yv[1]; yv[0] = keep + dpp_mov<0xB1>(send); }
                        Yy[(4 * q4 + (jg >> 1)) * 64 + i0 + (jg & 1)] = yv[0];
                    }

#if PROBE_SCAN2
                    {
#pragma unroll
                    for (int s4 = 0; s4 < 4; ++s4) {
                        const int tt = 4 * q4 + s4;
                        const f32x4 a_lo = *(const LAS f32x4*)&A_[tt * 64 + 8 * jg], a_hi = *(const LAS f32x4*)&A_[tt * 64 + 8 * jg + 4];
                        const f32x4 r_lo = *(const LAS f32x4*)&WR[tt * 64 + 8 * jg], r_hi = *(const LAS f32x4*)&WR[tt * 64 + 8 * jg + 4];
                        const f32x4 w_lo = *(const LAS f32x4*)&Wd[tt * 64 + 8 * jg], w_hi = *(const LAS f32x4*)&Wd[tt * 64 + 8 * jg + 4];
                        const f32x4 b_lo = *(const LAS f32x4*)&Bv[tt * 64 + 8 * jg], b_hi = *(const LAS f32x4*)&Bv[tt * 64 + 8 * jg + 4];
                        const f32x4 k_lo = *(const LAS f32x4*)&Kk[tt * 64 + 8 * jg], k_hi = *(const LAS f32x4*)&Kk[tt * 64 + 8 * jg + 4];
                        const f32x2 vv = *(const LAS f32x2*)&Vv[tt * 64 + i0];
                        const f32x2 av[4] = {{a_lo.x, a_lo.y}, {a_lo.z, a_lo.w}, {a_hi.x, a_hi.y}, {a_hi.z, a_hi.w}};
                        const f32x2 rv[4] = {{r_lo.x, r_lo.y}, {r_lo.z, r_lo.w}, {r_hi.x, r_hi.y}, {r_hi.z, r_hi.w}};
                        const f32x2 wv[4] = {{w_lo.x, w_lo.y}, {w_lo.z, w_lo.w}, {w_hi.x, w_hi.y}, {w_hi.z, w_hi.w}};
                        const f32x2 bv[4] = {{b_lo.x, b_lo.y}, {b_lo.z, b_lo.w}, {b_hi.x, b_hi.y}, {b_hi.z, b_hi.w}};
                        const f32x2 kv[4] = {{k_lo.x, k_lo.y}, {k_lo.z, k_lo.w}, {k_hi.x, k_hi.y}, {k_hi.z, k_hi.w}};
                        f32x2 e10 = T0[0] * av[0], e20 = T0[0] * rv[0], e11 = T1[0] * av[0], e21 = T1[0] * rv[0];
#pragma unroll
                        for (int j = 1; j < 4; ++j) { e10 += T0[j] * av[j]; e20 += T0[j] * rv[j]; e11 += T1[j] * av[j]; e21 += T1[j] * rv[j]; }
                        const float d10 = red8(e10.x + e10.y), d20 = red8(e20.x + e20.y), d11 = red8(e11.x + e11.y), d21 = red8(e21.x + e21.y);
                        const f32x2 d10v = (f32x2){d10 + d20, d10}, d11v = (f32x2){d11 + d21, d11}, v0v = (f32x2){vv.x, vv.x}, v1v = (f32x2){vv.y, vv.y};
#pragma unroll
                        for (int j = 0; j < 4; ++j) { T0[j] = T0[j] * wv[j] + (d10v * bv[j] + v0v * kv[j]); T1[j] = T1[j] * wv[j] + (d11v * bv[j] + v1v * kv[j]); }
                    }
                    }
#endif
                }
                if (q4 == 3) LDS_BAR();
            }
        }
            }
        if (i0_ + 1 < RW_NCH) { const int i = i0_ + 1;

        const int bufn = (i + 1) & 1, bufc = i & 1;
        if (helper) {
            const bool do_prep = (i + 1 < RW_NCH);
            if (i >= 0) {
                LAS float* Gg = RW_ARR(bufc, 6);
                f32x4 cg_ = (f32x4){0.f, 0.f, 0.f, 0.f};
#pragma unroll
                for (int ks = 0; ks < 4; ++ks) {
                    const bf16x8 za = *(const LAS bf16x8*)&GDb[bufc * 2176 + ln * 136 + ks * 32 + 8 * lg], zb = *(const LAS bf16x8*)&WTg[(16 * nt + ln) * 136 + ks * 32 + 8 * lg];
                    cg_ = __builtin_amdgcn_mfma_f32_16x16x32_bf16(za, zb, cg_, 0, 0, 0);
                }
#pragma unroll
                for (int r = 0; r < 4; ++r) Gg[(4 * lg + r) * 64 + chm] = cg_[r];
            }
            if (i >= 1) {
                LAS float* Yy = RW_ARR(bufn, 7); LAS float* Gg = RW_ARR(bufn, 6); LAS float* Vv = RW_ARR(bufn, 5); LAS float* SC = RW_SC(bufn);
                const f32x4 y = *(const LAS f32x4*)&Yy[tt_h * 64 + cg4], gg = *(const LAS f32x4*)&Gg[tt_h * 64 + cg4], vv = *(const LAS f32x4*)&Vv[tt_h * 64 + cg4];
                const float bonus = BON[((i - 1) % 3) * 16 + tt_h];
                const float mean = red16((y.x + y.y) + (y.z + y.w)) * (1.f / 64.f);
                const f32x4 d = y - mean;
                const float var = red16((d.x * d.x + d.y * d.y) + (d.z * d.z + d.w * d.w)) * (1.f / 64.f);
                const float rs = 1.f / sqrtf(var + 64e-5f);
                const f32x4 o = (d * rs * p_gg + p_gb + vv * bonus) * gg;
                u32x2 w; w.x = pk2(o.x, o.y); w.y = pk2(o.z, o.w);
                *(u32x2*)(X.P + ((size_t)b * SEQ + (i - 1) * RW_TS + tt_h) * LDP + COL_YA + h * 64 + cg4) = w;
            }
            if (do_prep) {
                const f32x4 r = (f32x4){bflo(l_rB.x), bfhi(l_rB.x), bflo(l_rB.y), bfhi(l_rB.y)}, k = (f32x4){bflo(l_kB.x), bfhi(l_kB.x), bflo(l_kB.y), bfhi(l_kB.y)};
                const f32x4 v = (f32x4){bflo(l_vB.x), bfhi(l_vB.x), bflo(l_vB.y), bfhi(l_vB.y)}, w1 = (f32x4){bflo(l_wB.x), bfhi(l_wB.x), bflo(l_wB.y), bfhi(l_wB.y)};
                const f32x4 a = (f32x4){bflo(l_aB.x), bfhi(l_aB.x), bflo(l_aB.y), bfhi(l_aB.y)};
                const f32x4 kk = k * p_kk * l_sB.x;
                const f32x4 decay = 1.f - w1;
                *(LAS f32x4*)&RW_ARR(bufn, 0)[tt_h * 64 + cg4] = -kk;
                *(LAS f32x4*)&RW_ARR(bufn, 1)[tt_h * 64 + cg4] = decay * r;
                *(LAS f32x4*)&RW_ARR(bufn, 2)[tt_h * 64 + cg4] = decay;
                *(LAS f32x4*)&RW_ARR(bufn, 3)[tt_h * 64 + cg4] = kk * a;
                *(LAS f32x4*)&RW_ARR(bufn, 4)[tt_h * 64 + cg4] = k * (1.f + (a - 1.f) * p_ka);
                *(LAS f32x4*)&RW_ARR(bufn, 5)[tt_h * 64 + cg4] = v;
                if (cg4 == 0) { LAS float* SC = RW_SC(bufn); SC[tt_h * 4 + 0] = l_sB.y; SC[tt_h * 4 + 1] = l_sB.z; BON[((i + 1) % 3) * 16 + tt_h] = l_sB.w; }
                *(LAS u32x4*)&GDb[bufn * 2176 + tt_h * 136 + gv8] = l_gcB;
            }
            if (i + 3 < RW_NCH) RW_LOAD(i + 3, B);
            LDS_BAR();
        } else {
            LAS float* A_ = RW_ARR(bufc, 0); LAS float* WR = RW_ARR(bufc, 1); LAS float* Wd = RW_ARR(bufc, 2); LAS float* Bv = RW_ARR(bufc, 3);
            LAS float* Kk = RW_ARR(bufc, 4); LAS float* Vv = RW_ARR(bufc, 5); LAS float* Yy = RW_ARR(bufc, 7); LAS float* SC = RW_SC(bufc);
#pragma unroll 1
            for (int q4 = 0; q4 < 4; ++q4) {
                if (i >= 0) {
                    float yv[8];
#pragma unroll
                    for (int s4 = 0; s4 < 4; ++s4) {
                        const int tt = 4 * q4 + s4;
                        const f32x4 a_lo = *(const LAS f32x4*)&A_[tt * 64 + 8 * jg], a_hi = *(const LAS f32x4*)&A_[tt * 64 + 8 * jg + 4];
                        const f32x4 r_lo = *(const LAS f32x4*)&WR[tt * 64 + 8 * jg], r_hi = *(const LAS f32x4*)&WR[tt * 64 + 8 * jg + 4];
                        const f32x4 w_lo = *(const LAS f32x4*)&Wd[tt * 64 + 8 * jg], w_hi = *(const LAS f32x4*)&Wd[tt * 64 + 8 * jg + 4];
                        const f32x4 b_lo = *(const LAS f32x4*)&Bv[tt * 64 + 8 * jg], b_hi = *(const LAS f32x4*)&Bv[tt * 64 + 8 * jg + 4];
                        const f32x4 k_lo = *(const LAS f32x4*)&Kk[tt * 64 + 8 * jg], k_hi = *(const LAS f32x4*)&Kk[tt * 64 + 8 * jg + 4];
                        const f32x2 vv = *(const LAS f32x2*)&Vv[tt * 64 + i0];
                        const f32x2 sc = *(const LAS f32x2*)&SC[tt * 4];
                        const f32x2 av[4] = {{a_lo.x, a_lo.y}, {a_lo.z, a_lo.w}, {a_hi.x, a_hi.y}, {a_hi.z, a_hi.w}};
                        const f32x2 rv[4] = {{r_lo.x, r_lo.y}, {r_lo.z, r_lo.w}, {r_hi.x, r_hi.y}, {r_hi.z, r_hi.w}};
                        const f32x2 wv[4] = {{w_lo.x, w_lo.y}, {w_lo.z, w_lo.w}, {w_hi.x, w_hi.y}, {w_hi.z, w_hi.w}};
                        const f32x2 bv[4] = {{b_lo.x, b_lo.y}, {b_lo.z, b_lo.w}, {b_hi.x, b_hi.y}, {b_hi.z, b_hi.w}};
                        const f32x2 kv[4] = {{k_lo.x, k_lo.y}, {k_lo.z, k_lo.w}, {k_hi.x, k_hi.y}, {k_hi.z, k_hi.w}};
                        f32x2 e10 = S0[0] * av[0], e20 = S0[0] * rv[0], e11 = S1[0] * av[0], e21 = S1[0] * rv[0];
#pragma unroll
                        for (int j = 1; j < 4; ++j) { e10 += S0[j] * av[j]; e20 += S0[j] * rv[j]; e11 += S1[j] * av[j]; e21 += S1[j] * rv[j]; }
                        const float d10 = red8(e10.x + e10.y), d11 = red8(e11.x + e11.y);
                        yv[2 * s4] = (e20.x + e20.y) + (jg == 0 ? d10 * sc.x + vv.x * sc.y : 0.f); yv[2 * s4 + 1] = (e21.x + e21.y) + (jg == 0 ? d11 * sc.x + vv.y * sc.y : 0.f);
                        const f32x2 d10v = (f32x2){d10, d10}, d11v = (f32x2){d11, d11}, v0v = (f32x2){vv.x, vv.x}, v1v = (f32x2){vv.y, vv.y};
#pragma unroll
                        for (int j = 0; j < 4; ++j) { S0[j] = S0[j] * wv[j] + (d10v * bv[j] + v0v * kv[j]); S1[j] = S1[j] * wv[j] + (d11v * bv[j] + v1v * kv[j]); }
                    }
                    {
                        const bool t2 = (jg & 4) != 0, t1 = (jg & 2) != 0, t0 = (jg & 1) != 0;
#pragma unroll
                        for (int q = 0; q < 4; ++q) { const float keep = t2 ? yv[q + 4] : yv[q], send = t2 ? yv[q] : yv[q + 4]; yv[q] = keep + dpp_mov<0x141>(send); }
#pragma unroll
                        for (int q = 0; q < 2; ++q) { const float keep = t1 ? yv[q + 2] : yv[q], send = t1 ? yv[q] : yv[q + 2]; yv[q] = keep + dpp_mov<0x4E>(send); }
                        { const float keep = t0 ? yv[1] : yv[0], send = t0 ? yv[0] : yv[1]; yv[0] = keep + dpp_mov<0xB1>(send); }
                        Yy[(4 * q4 + (jg >> 1)) * 64 + i0 + (jg & 1)] = yv[0];
                    }

#if PROBE_SCAN2
                    {
#pragma unroll
                    for (int s4 = 0; s4 < 4; ++s4) {
                        const int tt = 4 * q4 + s4;
                        const f32x4 a_lo = *(const LAS f32x4*)&A_[tt * 64 + 8 * jg], a_hi = *(const LAS f32x4*)&A_[tt * 64 + 8 * jg + 4];
                        const f32x4 r_lo = *(const LAS f32x4*)&WR[tt * 64 + 8 * jg], r_hi = *(const LAS f32x4*)&WR[tt * 64 + 8 * jg + 4];
                        const f32x4 w_lo = *(const LAS f32x4*)&Wd[tt * 64 + 8 * jg], w_hi = *(const LAS f32x4*)&Wd[tt * 64 + 8 * jg + 4];
                        const f32x4 b_lo = *(const LAS f32x4*)&Bv[tt * 64 + 8 * jg], b_hi = *(const LAS f32x4*)&Bv[tt * 64 + 8 * jg + 4];
                        const f32x4 k_lo = *(const LAS f32x4*)&Kk[tt * 64 + 8 * jg], k_hi = *(const LAS f32x4*)&Kk[tt * 64 + 8 * jg + 4];
                        const f32x2 vv = *(const LAS f32x2*)&Vv[tt * 64 + i0];
                        const f32x2 av[4] = {{a_lo.x, a_lo.y}, {a_lo.z, a_lo.w}, {a_hi.x, a_hi.y}, {a_hi.z, a_hi.w}};
                        const f32x2 rv[4] = {{r_lo.x, r_lo.y}, {r_lo.z, r_lo.w}, {r_hi.x, r_hi.y}, {r_hi.z, r_hi.w}};
                        const f32x2 wv[4] = {{w_lo.x, w_lo.y}, {w_lo.z, w_lo.w}, {w_hi.x, w_hi.y}, {w_hi.z, w_hi.w}};
                        const f32x2 bv[4] = {{b_lo.x, b_lo.y}, {b_lo.z, b_lo.w}, {b_hi.x, b_hi.y}, {b_hi.z, b_hi.w}};
                        const f32x2 kv[4] = {{k_lo.x, k_lo.y}, {k_lo.z, k_lo.w}, {k_hi.x, k_hi.y}, {k_hi.z, k_hi.w}};
                        f32x2 e10 = T0[0] * av[0], e20 = T0[0] * rv[0], e11 = T1[0] * av[0], e21 = T1[0] * rv[0];
#pragma unroll
                        for (int j = 1; j < 4; ++j) { e10 += T0[j] * av[j]; e20 += T0[j] * rv[j]; e11 += T1[j] * av[j]; e21 += T1[j] * rv[j]; }
                        const float d10 = red8(e10.x + e10.y), d20 = red8(e20.x + e20.y), d11 = red8(e11.x + e11.y), d21 = red8(e21.x + e21.y);
                        const f32x2 d10v = (f32x2){d10 + d20, d10}, d11v = (f32x2){d11 + d21, d11}, v0v = (f32x2){vv.x, vv.x}, v1v = (f32x2){vv.y, vv.y};
#pragma unroll
                        for (int j = 0; j < 4; ++j) { T0[j] = T0[j] * wv[j] + (d10v * bv[j] + v0v * kv[j]); T1[j] = T1[j] * wv[j] + (d11v * bv[j] + v1v * kv[j]); }
                    }
                    }
#endif
                }
                if (q4 == 3) LDS_BAR();
            }
        }
            }
    }
    if (helper) {
        const int bufl = (RW_NCH - 1) & 1;
        LAS float* Yy = RW_ARR(bufl, 7); LAS float* Gg = RW_ARR(bufl, 6); LAS float* Vv = RW_ARR(bufl, 5); LAS float* SC = RW_SC(bufl);
        const f32x4 y = *(const LAS f32x4*)&Yy[tt_h * 64 + cg4], gg = *(const LAS f32x4*)&Gg[tt_h * 64 + cg4], vv = *(const LAS f32x4*)&Vv[tt_h * 64 + cg4];
        const float bonus = BON[((RW_NCH - 1) % 3) * 16 + tt_h];
        const float mean = red16((y.x + y.y) + (y.z + y.w)) * (1.f / 64.f);
        const f32x4 d = y - mean;
        const float var = red16((d.x * d.x + d.y * d.y) + (d.z * d.z + d.w * d.w)) * (1.f / 64.f);
        const float rs = 1.f / sqrtf(var + 64e-5f);
        const f32x4 o = (d * rs * p_gg + p_gb + vv * bonus) * gg;
        u32x2 w; w.x = pk2(o.x, o.y); w.y = pk2(o.z, o.w);
        *(u32x2*)(X.P + ((size_t)b * SEQ + (RW_NCH - 1) * RW_TS + tt_h) * LDP + COL_YA + h * 64 + cg4) = w;
    }
    __syncthreads();
#undef RW_ARR
#undef RW_SC
#undef RW_LOAD
}

__device__ __forceinline__ void hgrn_task(const Ctx& X, LAS unsigned char* lds, int layer, int b, int h, int vh) {
    LAS float* F = (LAS float*)(lds); LAS float* Q = (LAS float*)(lds + 16384); LAS float* Vv = (LAS float*)(lds + 32768); LAS float* O = (LAS float*)(lds + 40960);
    LAS float* LB = (LAS float*)(lds + 49152);
    const int tid = X.tid;
    const float* lbl = X.in[14];
    const int rp = tid >> 4, dg = tid & 15, v0 = 2 * rp;
    if (tid < 128) LB[tid] = (layer > 0) ? 1.f / (1.f + __expf(lbl[h * 128 + tid] - lbl[512 + h * 128 + tid])) : 0.f;
    f32x2 S0[4], S1[4];
#pragma unroll
    for (int j = 0; j < 4; ++j) { S0[j] = (f32x2){0.f, 0.f}; S1[j] = (f32x2){0.f, 0.f}; }
#define HG_LOAD(chk) do { _Pragma("unroll") for (int it = 0; it < 3; ++it) { const int idx = tid + 512 * it; raw[it] = (u32x4){0u, 0u, 0u, 0u}; \
        if (idx < 32 * 40) { const int tt = idx / 40, vv = idx - tt * 40; \
            const int col = vv < 16 ? 512 + h * 128 + 8 * vv : (vv < 32 ? h * 128 + 8 * (vv - 16) : 1024 + h * 128 + vh * 64 + 8 * (vv - 32)); \
            raw[it] = *(const u32x4*)(X.P + ((size_t)b * SEQ + (chk) * 32 + tt) * LDP + COL_PB + col); } } } while (0)
    u32x4 raw[3];
    HG_LOAD(0);
    __syncthreads();
#pragma unroll 1
    for (int ch = 0; ch < SEQ / 32; ++ch) {
        const int t0 = ch * 32;
#pragma unroll
        for (int it = 0; it < 3; ++it) {
            const int idx = tid + 512 * it;
            if (idx < 32 * 40) {
                const int tt = idx / 40, vv = idx - tt * 40;
                float x[8];
                x[0] = bflo(raw[it].x); x[1] = bfhi(raw[it].x); x[2] = bflo(raw[it].y); x[3] = bfhi(raw[it].y);
                x[4] = bflo(raw[it].z); x[5] = bfhi(raw[it].z); x[6] = bflo(raw[it].w); x[7] = bfhi(raw[it].w);
                LAS float* dst;
                if (vv < 16) {
                    dst = F + tt * 128 + 8 * vv;
#pragma unroll
                    for (int e = 0; e < 8; ++e) { const float lb = LB[8 * vv + e]; x[e] = lb + (1.f - lb) * sigmoidf_(x[e]); }
                } else if (vv < 32) dst = Q + tt * 128 + 8 * (vv - 16);
                else dst = Vv + tt * 64 + 8 * (vv - 32);
                *(LAS f32x4*)dst = (f32x4){x[0], x[1], x[2], x[3]}; *(LAS f32x4*)(dst + 4) = (f32x4){x[4], x[5], x[6], x[7]};
            }
        }
        if (ch + 1 < SEQ / 32) HG_LOAD(ch + 1);
        LDS_BAR();
#pragma unroll 1
        for (int g8 = 0; g8 < 4; ++g8) {
            float val[16];
#pragma unroll
            for (int s8 = 0; s8 < 8; ++s8) {
                const int tt = 8 * g8 + s8;
                const f32x4 f_lo = *(const LAS f32x4*)&F[tt * 128 + 8 * dg], f_hi = *(const LAS f32x4*)&F[tt * 128 + 8 * dg + 4];
                const f32x4 q_lo = *(const LAS f32x4*)&Q[tt * 128 + 8 * dg], q_hi = *(const LAS f32x4*)&Q[tt * 128 + 8 * dg + 4];
                const f32x2 vv = *(const LAS f32x2*)&Vv[tt * 64 + v0];
                const f32x2 f2[4] = {{f_lo.x, f_lo.y}, {f_lo.z, f_lo.w}, {f_hi.x, f_hi.y}, {f_hi.z, f_hi.w}};
                const f32x2 q2[4] = {{q_lo.x, q_lo.y}, {q_lo.z, q_lo.w}, {q_hi.x, q_hi.y}, {q_hi.z, q_hi.w}};
                const f32x2 v0v = (f32x2){vv.x, vv.x}, v1v = (f32x2){vv.y, vv.y};
                f32x2 a0 = (f32x2){0.f, 0.f}, a1 = (f32x2){0.f, 0.f};
#pragma unroll
                for (int j = 0; j < 4; ++j) {
                    S0[j] = v0v + f2[j] * (S0[j] - v0v); S1[j] = v1v + f2[j] * (S1[j] - v1v);
                    a0 += q2[j] * S0[j]; a1 += q2[j] * S1[j];
                }
                val[2 * s8] = a0.x + a0.y; val[2 * s8 + 1] = a1.x + a1.y;
            }
            const bool b3 = (dg & 8) != 0, b2 = (dg & 4) != 0, b1 = (dg & 2) != 0, b0 = (dg & 1) != 0;
#pragma unroll
            for (int i = 0; i < 8; ++i) { const float keep = b3 ? val[i + 8] : val[i], send = b3 ? val[i] : val[i + 8]; val[i] = keep + dpp_mov<0x140>(send); }
#pragma unroll
            for (int i = 0; i < 4; ++i) { const float keep = b2 ? val[i + 4] : val[i], send = b2 ? val[i] : val[i + 4]; val[i] = keep + dpp_mov<0x141>(send); }
#pragma unroll
            for (int i = 0; i < 2; ++i) { const float keep = b1 ? val[i + 2] : val[i], send = b1 ? val[i] : val[i + 2]; val[i] = keep + dpp_mov<0x4E>(send); }
            { const float keep = b0 ? val[1] : val[0], send = b0 ? val[0] : val[1]; val[0] = keep + dpp_mov<0xB1>(send); }
            O[(8 * g8 + (dg >> 1)) * 64 + v0 + (dg & 1)] = val[0];
        }
        LDS_BAR();
        if (tid < 256) {
            const int tt = tid >> 3, v8 = (tid & 7) * 8;
            const f32x4 a = *(const LAS f32x4*)&O[tt * 64 + v8], c4 = *(const LAS f32x4*)&O[tt * 64 + v8 + 4];
            u32x4 o; o.x = pk2(a.x, a.y); o.y = pk2(a.z, a.w); o.z = pk2(c4.x, c4.y); o.w = pk2(c4.z, c4.w);
            *(u32x4*)(X.P + ((size_t)b * SEQ + t0 + tt) * LDP + COL_YB + h * 128 + vh * 64 + v8) = o;
        }
    }
#undef HG_LOAD
    __syncthreads();
}

__device__ __forceinline__ unsigned f2ord(float f) { const unsigned u = __builtin_bit_cast(unsigned, f); return (u & 0x80000000u) ? ~u : (u | 0x80000000u); }

__device__ __forceinline__ void dsa_tile(const Ctx& X, LAS unsigned char* lds, int b, int q0) {
    LAS float* sc = (LAS float*)lds;
    LAS unsigned* MASK = (LAS unsigned*)(lds + MASK_OFF);
    const int lane = X.lane, w = X.wave, n = lane & 15, g = lane >> 4;
    const bf16_t* Pb = X.P + (size_t)b * SEQ * LDP;
#pragma unroll 1
    for (int sub = 0; sub < 4; ++sub) {
        const int qs = q0 + 16 * sub;
        {
            bf16x8 bq[4][2]; float wi[4];
            const bf16_t* qrow = Pb + (size_t)(qs + n) * LDP;
#pragma unroll
            for (int hh = 0; hh < 4; ++hh) {
#pragma unroll
                for (int ks = 0; ks < 2; ++ks) bq[hh][ks] = *(const bf16x8*)(qrow + C_QI + hh * 64 + ks * 32 + 8 * g);
                wi[hh] = bf2f(qrow[C_WI + hh]);
            }
            const int nkt = (qs + 16) >> 4;
            bf16x8 a0n = (bf16x8){0, 0, 0, 0, 0, 0, 0, 0}, a1n = a0n;
            if (w < nkt) { const bf16_t* krow = Pb + (size_t)(w * 16 + n) * LDP + C_KI; a0n = *(const bf16x8*)(krow + 8 * g); a1n = *(const bf16x8*)(krow + 32 + 8 * g); }
#pragma unroll 1
            for (int kt = w; kt < nkt; kt += 8) {
                const bf16x8 a0 = a0n, a1 = a1n;
                if (kt + 8 < nkt) { const bf16_t* krow = Pb + (size_t)((kt + 8) * 16 + n) * LDP + C_KI; a0n = *(const bf16x8*)(krow + 8 * g); a1n = *(const bf16x8*)(krow + 32 + 8 * g); }
                f32x4 s = (f32x4){0.f, 0.f, 0.f, 0.f};
#pragma unroll
                for (int hh = 0; hh < 4; ++hh) {
                    f32x4 d = __builtin_amdgcn_mfma_f32_16x16x32_bf16(a0, bq[hh][0], (f32x4){0.f, 0.f, 0.f, 0.f}, 0, 0, 0);
                    d = __builtin_amdgcn_mfma_f32_16x16x32_bf16(a1, bq[hh][1], d, 0, 0, 0);
#pragma unroll
                    for (int r = 0; r < 4; ++r) s[r] += wi[hh] * fmaxf(d[r], 0.f);
                }
                const int t = qs + n;
#pragma unroll
                for (int r = 0; r < 4; ++r) if (kt * 16 + 4 * g + r > t) s[r] = -INFINITY;
                *(LAS f32x4*)&sc[n * SCS + kt * 16 + 4 * g] = s;
            }
        }
        __syncthreads();
#pragma unroll 1
        for (int e = 0; e < 2; ++e) {
            const int qn = 2 * w + e, t = qs + qn;
            LAS unsigned* mrow = MASK + (sub * 16 + qn) * 64;
            if (t < 256) {
#pragma unroll
                for (int j = 0; j < 32; ++j) {
                    const unsigned long long sm = __ballot(j * 64 + lane <= t);
                    if (lane == 0) { mrow[2 * j] = (unsigned)sm; mrow[2 * j + 1] = (unsigned)(sm >> 32); }
                }
            } else {
                const int jn = (t >> 6) + 1;
                unsigned u[32];
#pragma unroll
                for (int j = 0; j < 32; ++j) {
                    u[j] = 0u;
                    if (j < jn) { const int key = j * 64 + lane; const float s = (key <= t) ? sc[qn * SCS + key] : -INFINITY; u[j] = f2ord(s); }
                }
                unsigned prefix = 0u;
#define DSA_BITSEARCH(JN) do { _Pragma("unroll 1") for (int bit = 31; bit >= 0; --bit) { const unsigned cand = prefix | (1u << bit); int c0 = 0, c1 = 0; \
                    _Pragma("unroll") for (int j = 0; j < (JN); j += 2) { c0 += (u[j] >= cand) ? 1 : 0; c1 += (u[j + 1] >= cand) ? 1 : 0; } \
                    const int cnt = (int)wave_sum_fast((float)(c0 + c1)); if (cnt >= 256) prefix = cand; } } while (0)
                if (jn <= 8) DSA_BITSEARCH(8); else if (jn <= 16) DSA_BITSEARCH(16); else if (jn <= 24) DSA_BITSEARCH(24); else DSA_BITSEARCH(32);
#undef DSA_BITSEARCH
                int cg_ = 0;
#pragma unroll
                for (int j = 0; j < 32; ++j) if (j < jn) cg_ += __popcll(__ballot(u[j] > prefix));
                const int need = 256 - cg_;
                int cum = 0;
#pragma unroll
                for (int j = 0; j < 32; ++j) {
                    unsigned long long sm = 0ull;
                    if (j < jn) {
                        const bool eq = (u[j] == prefix);
                        const unsigned long long em = __ballot(eq);
                        const int rank = cum + (int)__builtin_amdgcn_mbcnt_hi((unsigned)(em >> 32), __builtin_amdgcn_mbcnt_lo((unsigned)em, 0u));
                        const bool sel = (u[j] > prefix) || (eq && rank < need);
                        sm = __ballot(sel);
                        cum += __popcll(em);
                    }
                    if (lane == 0) { mrow[2 * j] = (unsigned)sm; mrow[2 * j + 1] = (unsigned)(sm >> 32); }
                }
            }
        }
        __syncthreads();
    }
    const int qq = q0 + 8 * w + (n & 7);
    const LAS unsigned* mq = MASK + (8 * w + (n & 7)) * 64;
    const int nsteps = (q0 + 8 * w + 8 + 31) >> 5;
    const int nblk = (q0 + 64 + 127) >> 7;
    LAS bf16_t* KT = (LAS bf16_t*)lds;
    LAS bf16_t* VTT = (LAS bf16_t*)(lds + 36864);
    const int tid = X.tid;
#pragma unroll 1
    for (int c = 0; c < 2; ++c) {
        bf16x8 bq[2][2];
#pragma unroll
        for (int j = 0; j < 2; ++j)
#pragma unroll
            for (int ks = 0; ks < 2; ++ks) bq[j][ks] = *(const bf16x8*)(Pb + (size_t)qq * LDP + C_Q + (c * 4 + 2 * j + (n >> 3)) * 64 + ks * 32 + 8 * g);
        float lrun[2] = {0.f, 0.f};
        f32x4 oacc[4][2];
#pragma unroll
        for (int mt = 0; mt < 4; ++mt)
#pragma unroll
            for (int j = 0; j < 2; ++j) oacc[mt][j] = (f32x4){0.f, 0.f, 0.f, 0.f};
        const bf16_t* vtb = X.VT + ((size_t)(b * 2 + c) * 64) * SEQ;
        u32x4 gk[2], gv[2];
#define DSA_GLOAD(kblk) do { _Pragma("unroll") for (int it = 0; it < 2; ++it) { const int idx = tid + 512 * it; \
            gk[it] = *(const u32x4*)(Pb + (size_t)((kblk) * 128 + (idx >> 3)) * LDP + C_K + c * 64 + (idx & 7) * 8); \
            gv[it] = *(const u32x4*)(vtb + (size_t)(idx >> 4) * SEQ + (kblk) * 128 + (idx & 15) * 8); } } while (0)
#define DSA_LSTORE(bufi) do { _Pragma("unroll") for (int it = 0; it < 2; ++it) { const int idx = tid + 512 * it; \
            *(LAS u32x4*)(KT + (bufi) * 9216 + (idx >> 3) * 72 + (idx & 7) * 8) = gk[it]; \
            *(LAS u32x4*)(VTT + (bufi) * 8704 + (idx >> 4) * 136 + (idx & 15) * 8) = gv[it]; } } while (0)
        DSA_GLOAD(0);
        LDS_BAR();
        DSA_LSTORE(0);
        LDS_BAR();
#pragma unroll 1
        for (int kb = 0; kb < nblk; ++kb) {
            const int buf = kb & 1;
            if (kb + 1 < nblk) DSA_GLOAD(kb + 1);
            const LAS bf16_t* Kb = KT + buf * 9216; const LAS bf16_t* Vb = VTT + buf * 8704;
#pragma unroll 1
            for (int sl = 0; sl < 4; ++sl) {
                const int sg = kb * 4 + sl;
                if (sg < nsteps) {
                    f32x4 st[2][2];
#pragma unroll
                    for (int tl = 0; tl < 2; ++tl) {
                        const LAS bf16_t* kr = Kb + (32 * sl + 16 * tl + n) * 72;
                        const bf16x8 a0 = *(const LAS bf16x8*)(kr + 8 * g), a1 = *(const LAS bf16x8*)(kr + 32 + 8 * g);
#pragma unroll
                        for (int j = 0; j < 2; ++j) {
                            f32x4 d = __builtin_amdgcn_mfma_f32_16x16x32_bf16(a0, bq[j][0], (f32x4){0.f, 0.f, 0.f, 0.f}, 0, 0, 0);
                            st[tl][j] = __builtin_amdgcn_mfma_f32_16x16x32_bf16(a1, bq[j][1], d, 0, 0, 0);
                        }
                    }
                    bf16x8 av[4];
#pragma unroll
                    for (int mt = 0; mt < 4; ++mt) {
                        const LAS bf16_t* vp = Vb + (mt * 16 + n) * 136 + 32 * sl + 4 * g;
                        const u32x2 lo = *(const LAS u32x2*)vp, hi = *(const LAS u32x2*)(vp + 16);
                        u32x4 t4; t4.x = lo.x; t4.y = lo.y; t4.z = hi.x; t4.w = hi.y;
                        av[mt] = __builtin_bit_cast(bf16x8, t4);
                    }
                    const unsigned mw = mq[sg];
#pragma unroll
                    for (int j = 0; j < 2; ++j) {
                        float p[8], ps = 0.f;
#pragma unroll
                        for (int tl = 0; tl < 2; ++tl)
#pragma unroll
                            for (int r = 0; r < 4; ++r) { const int bit = 16 * tl + 4 * g + r; const float e = __expf(fminf(st[tl][j][r] * 0.125f, 60.f)); p[4 * tl + r] = ((mw >> bit) & 1u) ? e : 0.f; ps += p[4 * tl + r]; }
                        lrun[j] += ps;
                        u32x4 pw; pw.x = pg8::cvt_pk_bf16(p[0], p[1]); pw.y = pg8::cvt_pk_bf16(p[2], p[3]); pw.z = pg8::cvt_pk_bf16(p[4], p[5]); pw.w = pg8::cvt_pk_bf16(p[6], p[7]);
                        const bf16x8 pb = __builtin_bit_cast(bf16x8, pw);
#pragma unroll
                        for (int mt = 0; mt < 4; ++mt) oacc[mt][j] = __builtin_amdgcn_mfma_f32_16x16x32_bf16(av[mt], pb, oacc[mt][j], 0, 0, 0);
                    }
                }
            }
            if (kb + 1 < nblk) DSA_LSTORE(buf ^ 1);
            LDS_BAR();
        }
#pragma unroll
        for (int j = 0; j < 2; ++j) {
            float lt = lrun[j]; lt += __shfl_xor(lt, 16); lt += __shfl_xor(lt, 32);
            const float il = 1.f / lt;
            bf16_t* op = X.P + ((size_t)b * SEQ + qq) * LDP + COL_YC + (c * 4 + 2 * j + (n >> 3)) * 64 + 4 * g;
#pragma unroll
            for (int mt = 0; mt < 4; ++mt) {
                const f32x4 o = oacc[mt][j] * il;
                u32x2 wv; wv.x = pg8::cvt_pk_bf16(o[0], o[1]); wv.y = pg8::cvt_pk_bf16(o[2], o[3]);
                *(u32x2*)(op + mt * 16) = wv;
            }
        }
    }
#undef DSA_GLOAD
#undef DSA_LSTORE
    __syncthreads();
}

__device__ __forceinline__ void phase_mixers(const Ctx& X0, LAS unsigned char* lds, int layer) {
#pragma unroll 1
    for (int task = X0.bid; task < 128; task += X0.G) {
        Ctx X = X0;
        { int t_ = threadIdx.x; asm volatile("" : "+v"(t_)); X.tid = t_; X.lane = t_ & 63; }
        if (task < 64) { if (TKMASK & 1) rwkv_task(X, lds, layer, task >> 3, task & 7); }
        else { const int k = task - 64; if (TKMASK & 2) hgrn_task(X, lds, layer, k >> 3, (k >> 1) & 3, k & 1); }
    }
    volatile LAS unsigned* tw = (volatile LAS unsigned*)(lds + LDS_BYTES - 128);
    unsigned* ctr = (unsigned*)(X0.ws + WS_BAR + 14336) + 16 * layer;
#pragma unroll 1
    for (;;) {
        Ctx X = X0;
        { int t_ = threadIdx.x; asm volatile("" : "+v"(t_)); X.tid = t_; X.lane = t_ & 63; }
        __syncthreads();
        if (threadIdx.x == 0) tw[0] = __hip_atomic_fetch_add(ctr, 1u, __ATOMIC_RELAXED, __HIP_MEMORY_SCOPE_AGENT);
        __syncthreads();
        const int t = (int)tw[0];
        if (t >= 256) break;
        if (TKMASK & 4) dsa_tile(X, lds, t & 7, 64 * (31 - (t >> 3)));
    }
}

__device__ __forceinline__ void phase_hgrn_post(const Ctx& X, int layer) {
    const int gw = X.bid * 8 + X.wave, NGW = X.G * 8;
    const float* gn = X.in[15] + layer * 512;
#pragma unroll 1
    for (int it0 = gw; it0 < T_TOK * 4; it0 += 4 * NGW) {
        unsigned ow[4], gwd[4]; unsigned* op[4];
#pragma unroll
        for (int r = 0; r < 4; ++r) {
            const int it = it0 + r * NGW < T_TOK * 4 ? it0 + r * NGW : it0;
            const int t = it >> 2, h = it & 3;
            bf16_t* rowp = X.P + (size_t)t * LDP;
            op[r] = (unsigned*)(rowp + COL_YB + h * 128) + X.lane;
            ow[r] = *op[r]; gwd[r] = *((const unsigned*)(rowp + COL_PB + 1536 + h * 128) + X.lane);
        }
#pragma unroll
        for (int r = 0; r < 4; ++r) {
            const int it = it0 + r * NGW;
            const int h = it & 3;
            const float o0 = bflo(ow[r]), o1 = bfhi(ow[r]), g0 = bflo(gwd[r]), g1 = bfhi(gwd[r]);
            const float rs = 1.f / sqrtf(wave_sum(o0 * o0 + o1 * o1) * (1.f / 128.f) + 1e-6f);
            const float y0 = o0 * rs * gn[h * 128 + 2 * X.lane] * (g0 * sigmoidf_(g0)), y1 = o1 * rs * gn[h * 128 + 2 * X.lane + 1] * (g1 * sigmoidf_(g1));
            if (it < T_TOK * 4) *op[r] = pk2(y0, y1);
        }
    }
}

__device__ __forceinline__ void phase_fixup(const Ctx& X, int layer) {
    const float* cw = X.in[20] + (size_t)layer * 3 * F2; const float* cb = X.in[21] + (size_t)layer * F2;
#pragma unroll 4
    for (int idx = X.bid * 512 + X.tid; idx < 256 * 2 * DFF; idx += X.G * 512) {
        const int j = idx % DFF, sr = idx / DFF, s = sr >> 1, r = sr & 1;
        const int colg = (j >> 7) * 256 + (j & 127), colv = colg + 128;
        const bool seq0 = (s & 31) == 0;
        const float* H = X.HALO;
        float res[2];
#pragma unroll
        for (int part = 0; part < 2; ++part) {
            const int cp = part ? colv : colg, co = part * DFF + j;
            const float u0 = H[(size_t)(s * 4 + r) * F2 + cp];
            float u1, u2;
            if (r == 0) { u1 = seq0 ? 0.f : H[(size_t)((s - 1) * 4 + 3) * F2 + cp]; u2 = seq0 ? 0.f : H[(size_t)((s - 1) * 4 + 2) * F2 + cp]; }
            else { u1 = H[(size_t)(s * 4 + 0) * F2 + cp]; u2 = seq0 ? 0.f : H[(size_t)((s - 1) * 4 + 3) * F2 + cp]; }
            res[part] = cb[co] + cw[co] * u2 + cw[F2 + co] * u1 + cw[2 * F2 + co] * u0;
        }
        const float a = res[0] * sigmoidf_(res[0]) * res[1];
        X.P[(size_t)(s * 64 + r) * LDP + COL_ACT + j] = (bf16_t)f2bf(a);
    }
}

#define XB_TMO      128
#define XB_XCNT(j)  (256  + 64 * (j))
#define XB_XSUB(j)  (1280 + 64 * (j))
#define XB_XGEN(j)  (2304 + 64 * (j))
#define XB_TOP      3328
#define XB_TOPGEN   3392
#define XCD_BAR_WORDS 3456
#define XB_SPIN_CAP (1u << 22)
__device__ __forceinline__ unsigned xb_ld(unsigned* p)              { return __hip_atomic_load(p, __ATOMIC_RELAXED, __HIP_MEMORY_SCOPE_AGENT); }
__device__ __forceinline__ unsigned xb_add(unsigned* p, unsigned v) { return __hip_atomic_fetch_add(p, v, __ATOMIC_RELAXED, __HIP_MEMORY_SCOPE_AGENT); }
__device__ __forceinline__ unsigned xb_xcc_id() { return (unsigned)__builtin_amdgcn_s_getreg((3 << 11) | 20) & 0xFu; }
#define XB_SPIN(cond, bar) do { unsigned _sp = 0; while (cond) { __builtin_amdgcn_s_sleep(1); \
    if ((++_sp & 255u) == 0u) { if (xb_ld(&(bar)[XB_TMO])) break; if (_sp > XB_SPIN_CAP) { atomicAdd(&(bar)[XB_TMO], 1u); break; } } } } while (0)
struct XcdBarrier { unsigned* bar; unsigned x; volatile LAS unsigned* st; };
__device__ __forceinline__ XcdBarrier xcd_barrier_post(unsigned* bar, volatile LAS unsigned* st) {
    XcdBarrier b; b.bar = bar; b.x = xb_xcc_id(); b.st = st;
    if (threadIdx.x == 0) (void)xb_add(&bar[XB_XCNT(b.x)], 1u);
    return b;
}
__device__ __forceinline__ void xcd_barrier_complete(unsigned* bar, unsigned x, unsigned& nloc, unsigned& nx) {
    const unsigned G = gridDim.x * gridDim.y * gridDim.z;
    unsigned sum, cnt, mine, sp = 0u;
    for (;;) {
        sum = 0u; cnt = 0u; mine = 0u;
#pragma unroll
        for (unsigned j = 0; j < 16; ++j) { const unsigned c = xb_ld(&bar[XB_XCNT(j)]); sum += c; cnt += (c > 0u) ? 1u : 0u; mine = (j == x) ? c : mine; }
        if (sum == G) break;
        __builtin_amdgcn_s_sleep(1);
        if ((++sp & 255u) == 0u) { if (xb_ld(&bar[XB_TMO])) break; if (sp > XB_SPIN_CAP) { atomicAdd(&bar[XB_TMO], 1u); break; } }
    }
    nloc = mine > 0u ? mine : 1u; nx = cnt > 0u ? cnt : 1u;
}
__device__ __forceinline__ void xcd_barrier(const XcdBarrier& b) {
    asm volatile("s_waitcnt vmcnt(0)" ::: "memory");
    __syncthreads();
    if (threadIdx.x == 0) {
        unsigned* bar = b.bar;
        __builtin_amdgcn_s_waitcnt(0);
        unsigned nloc = b.st[0], nx = b.st[1];
        if (nloc == 0u) { xcd_barrier_complete(bar, b.x, nloc, nx); b.st[0] = nloc; b.st[1] = nx; }
        const unsigned old = xb_add(&bar[XB_XSUB(b.x)], 1u);
        const unsigned gen = old / nloc;
        if (old + 1u == (gen + 1u) * nloc) {
            __builtin_amdgcn_fence(__ATOMIC_RELEASE, "agent");
            asm volatile("s_waitcnt vmcnt(0)" ::: "memory");
            const unsigned og = xb_add(&bar[XB_TOP], 1u);
            const unsigned tg = og / nx;
            if (og + 1u == (tg + 1u) * nx) xb_add(&bar[XB_TOPGEN], 1u);
            else XB_SPIN(xb_ld(&bar[XB_TOPGEN]) == tg, bar);
            __builtin_amdgcn_fence(__ATOMIC_ACQUIRE, "agent");
            xb_add(&bar[XB_XGEN(b.x)], 1u);
            asm volatile("s_waitcnt vmcnt(0)" ::: "memory");
        } else {
            XB_SPIN(xb_ld(&bar[XB_XGEN(b.x)]) == gen, bar);
            __builtin_amdgcn_fence(__ATOMIC_ACQUIRE, "agent");
            asm volatile("s_waitcnt vmcnt(0)" ::: "memory");
        }
    }
    __syncthreads();
}

__global__ void __launch_bounds__(512, 2) mk_fwd(Args args) {
    extern __shared__ __attribute__((aligned(16))) unsigned char lds_raw[];
    LAS unsigned char* lds = (LAS unsigned char*)lds_raw;
    Ctx X;
#pragma unroll
    for (int i = 0; i < 24; ++i) X.in[i] = args.in[i];
    X.out = args.out; X.ws = args.ws;
    X.P = (bf16_t*)(args.ws + WS_P); X.VT = (bf16_t*)(args.ws + WS_VT); X.HALO = (float*)(args.ws + WS_HALO); X.ROPE = (float*)(args.ws + WS_ROPE);
    X.Win = (bf16_t*)(args.ws + WS_WIN); X.Wg = (bf16_t*)(args.ws + WS_WG); X.Wbr = (bf16_t*)(args.ws + WS_WBR);
    X.Wo = (bf16_t*)(args.ws + WS_WO); X.Wup = (bf16_t*)(args.ws + WS_WUP); X.Wdn = (bf16_t*)(args.ws + WS_WDN);
    X.tid = threadIdx.x; X.lane = X.tid & 63; X.wave = __builtin_amdgcn_readfirstlane(X.tid >> 6); X.G = gridDim.x; X.bid = blockIdx.x;

#if PROBE_DOUBLE
    for (int ph2 = args.ph_lo * 2; ph2 < args.ph_hi * 2; ++ph2) {
        const int ph = ph2 >> 1;
        const int layer = ph / 11, sub = ph % 11;
        const bool skip_ = (ph2 & 1) && !(ph < 22 && ((REPMASK >> sub) & 1));
#else
    volatile LAS unsigned* bst = (volatile LAS unsigned*)(lds + LDS_BYTES - 64);
    if (threadIdx.x < 2) bst[threadIdx.x] = 0u;
    __syncthreads();
    XcdBarrier gbar = xcd_barrier_post((unsigned*)(args.ws + WS_BAR), bst);
    for (int ph = args.ph_lo; ph < args.ph_hi; ++ph) {
        const int layer = ph / 11, sub = ph % 11;
        const bool skip_ = false;
#endif
        const bool fusedn = (X.G == 256) && (args.ph_hi - args.ph_lo > 1);
        if (fusedn && (ph == 22 || sub == 7)) continue;
        { int t_ = threadIdx.x; asm volatile("" : "+v"(t_)); X.tid = t_; X.lane = t_ & 63; }

        if (skip_) {
        } else if (ph == 22 && (PHMASK & 1024)) {
            const int gw = X.bid * 8 + X.wave, NGW = X.G * 8;
            (void)gw; (void)NGW; rms_pass(X, X.out, X.in[23], nullptr, X.out);
        } else if (sub == 0 && (PHMASK & 1)) {
            phase_prep(X, lds, layer, !(fusedn && layer > 0));
        } else if (sub == 1 && (PHMASK & 2)) {
            pg8::Gemm g{X.P, X.Win, LDP, DM, DM}; pg8::StaticOrder S; S.init(T_TOK, 5120, X.G, X.bid);
            pg8::EpiInProj E{X.P, X.VT, X.ROPE, (bf16_t*)(X.ws + WS_BND)};
            pg8::gemm_phase<pg8::EpiInProj, true>(lds, g, S, E, X.tid);
        } else if (sub == 2 && (PHMASK & 4)) {
            phase_rwkv_pre(X, lds, layer);
        } else if (sub == 3 && (PHMASK & 4)) {
            phase_mixers(X, lds, layer);
        } else if (sub == 4 && (PHMASK & 8)) {
            phase_hgrn_post(X, layer);
            { const int gw = X.bid * 8 + X.wave, NGW = X.G * 8; const float* hh = (layer == 0) ? X.in[0] : X.out; const float* g = X.in[1] + (size_t)layer * DM;
              (void)gw; (void)NGW; if (layer > 0) rms_pass(X, hh, g, X.P, nullptr); }
        } else if (sub == 5 && (PHMASK & 16)) {
#pragma unroll 1
            for (int br = 0; br < 3; ++br) {
                { pg8::Gemm g{X.P, X.Wg + (size_t)br * DM * DM, LDP, DM, DM}; pg8::StaticOrder S; S.init(T_TOK, DM, X.G, X.bid);
                  int t_ = X.tid; asm volatile("" : "+v"(t_));
                  pg8::EpiGate E{X.P}; pg8::gemm_phase<pg8::EpiGate, true>(lds, g, S, E, t_); }
                { const int ycol = br == 0 ? COL_YA : (br == 1 ? COL_YB : COL_YC);
                  pg8::Gemm g{X.P + ycol, X.Wbr + (size_t)br * DM * 512, LDP, 512, 512}; pg8::StaticOrder S; S.init(T_TOK, DM, X.G, X.bid);
                  int t_ = X.tid; asm volatile("" : "+v"(t_));
                  pg8::EpiMergeAcc E{X.P, br == 0 ? 1 : 0}; pg8::gemm_phase<pg8::EpiMergeAcc, true>(lds, g, S, E, t_); }
            }
        } else if (sub == 6 && (PHMASK & 32)) {
            pg8::Gemm g{X.P + COL_MRG, X.Wo, LDP, DM, DM}; pg8::StaticOrder S; S.init(T_TOK, DM, X.G, X.bid);
            if (fusedn) {
                pg8::EpiResidNorm E{layer == 0 ? X.in[0] : X.out, X.out, X.in[18] + (size_t)layer * DM, X.P, nullptr,
                                    (unsigned*)(X.ws + WS_XB) + (size_t)(layer * 2) * 65536, (unsigned*)(X.ws + WS_XC) + (layer * 2) * 4096};
                pg8::gemm_phase<pg8::EpiResidNorm, false>(lds, g, S, E, X.tid);
            } else {
            pg8::EpiResid E{layer == 0 ? X.in[0] : X.out, X.out};
            pg8::gemm_phase<pg8::EpiResid, true>(lds, g, S, E, X.tid);
            }
        } else if (sub == 7 && (PHMASK & 64)) {
            const int gw = X.bid * 8 + X.wave, NGW = X.G * 8;
            const float* g = X.in[18] + (size_t)layer * DM;
            (void)gw; (void)NGW; rms_pass(X, X.out, g, X.P, nullptr);
        } else if (sub == 8 && (PHMASK & 128)) {
            pg8::Gemm g{X.P, X.Wup, LDP, DM, DM}; pg8::StaticOrder S; S.init(T_TOK, F2, X.G, X.bid);
            pg8::EpiUp E{X.P, X.HALO, X.in[20] + (size_t)layer * 3 * F2, X.in[21] + (size_t)layer * F2, (LAS float*)(lds + 131072)};
            pg8::gemm_phase<pg8::EpiUp, true>(lds, g, S, E, X.tid);
        } else if (sub == 9 && (PHMASK & 256)) {
            phase_fixup(X, layer);
        } else if (sub == 10 && (PHMASK & 512)) {
            pg8::Gemm g{X.P + COL_ACT, X.Wdn, LDP, DFF, DFF}; pg8::StaticOrder S; S.init(T_TOK, DM, X.G, X.bid);
            if (fusedn) {
                const bool last = (layer == 1);
                pg8::EpiResidNorm E{X.out, last ? nullptr : X.out, last ? X.in[23] : X.in[1] + (size_t)DM, last ? nullptr : X.P, last ? X.out : nullptr,
                                    (unsigned*)(X.ws + WS_XB) + (size_t)(layer * 2 + 1) * 65536, (unsigned*)(X.ws + WS_XC) + (layer * 2 + 1) * 4096};
                pg8::gemm_phase<pg8::EpiResidNorm, false>(lds, g, S, E, X.tid);
            } else {
            pg8::EpiResid E{X.out, X.out};
            pg8::gemm_phase<pg8::EpiResid, true>(lds, g, S, E, X.tid);
            }
        }
#if PROBE_DOUBLE
        if (ph2 + 1 < args.ph_hi * 2) cg::this_grid().sync();
#else
        if (ph + 1 < args.ph_hi && !(fusedn && ph == 21)) { if (args.ph_hi > 1000) cg::this_grid().sync(); else xcd_barrier(gbar); }
#endif
    }
}

extern "C" void kernel_launch(void* const* d_in, const int* in_sizes, int n_in, void* d_out, int out_size, void* d_ws, size_t ws_size, hipStream_t stream) {
    static int grid = 0;
    if (grid == 0) {
        int dev = 0, cus = 0, per_cu = 0;
        (void)hipGetDevice(&dev);
        (void)hipDeviceGetAttribute(&cus, hipDeviceAttributeMultiprocessorCount, dev);
        if (hipFuncSetAttribute((const void*)mk_fwd, hipFuncAttributeMaxDynamicSharedMemorySize, LDS_BYTES) != hipSuccess) fprintf(stderr, "kernel_launch: hipFuncSetAttribute failed\n");
        if (hipOccupancyMaxActiveBlocksPerMultiprocessor(&per_cu, (const void*)mk_fwd, 512, LDS_BYTES) != hipSuccess || per_cu < 1) { fprintf(stderr, "kernel_launch: occupancy query gave %d\n", per_cu); per_cu = 1; }
        (void)hipGetLastError();
        grid = cus * 1;
        if (grid <= 0) grid = 256;
        if (ws_size < (size_t)268435456) fprintf(stderr, "kernel_launch: workspace too small (%zu)\n", ws_size);
    }
    Args a{};
    for (int i = 0; i < 24; ++i) a.in[i] = (const float*)d_in[i];
    a.out = (float*)d_out; a.ws = (unsigned char*)d_ws;
#if MK_SINGLE
    (void)hipMemsetAsync((char*)d_ws + WS_BAR, 0, 16384 + 65536, stream);
    a.ph_lo = 0; a.ph_hi = 23;
    void* kargs[] = {&a};
    hipError_t e = hipLaunchCooperativeKernel((const void*)mk_fwd, dim3(grid), dim3(512), kargs, LDS_BYTES, stream);
    if (e != hipSuccess) fprintf(stderr, "cooperative launch failed: %s (grid %d)\n", hipGetErrorString(e), grid);
#else
    for (int ph = 0; ph < 23; ++ph) {
        a.ph_lo = ph; a.ph_hi = ph + 1;
        hipLaunchKernelGGL(mk_fwd, dim3(grid), dim3(512), LDS_BYTES, stream, a);
    }
#endif
}
```

```cpp
#include <hip/hip_runtime.h>
#include <hip/hip_cooperative_groups.h>
#include <cstdio>
#include <cstdint>
namespace cg = cooperative_groups;

#ifndef PHMASK
#define PHMASK 2047
#endif
#ifndef REPMASK
#define REPMASK 0
#endif
#ifndef PROBE_DOUBLE
#define PROBE_DOUBLE 0
#endif
#ifndef PROBE_SCAN2
#define PROBE_SCAN2 0
#endif
#ifndef TKMASK
#define TKMASK 7
#endif
#ifndef MK_SINGLE
#define MK_SINGLE 1
#endif

#define LAS __attribute__((address_space(3)))
typedef unsigned short bf16_t;
typedef short bf16x8 __attribute__((ext_vector_type(8)));
typedef float f32x4 __attribute__((ext_vector_type(4)));
typedef float f32x2 __attribute__((ext_vector_type(2)));
typedef unsigned u32x4 __attribute__((ext_vector_type(4)));
typedef unsigned u32x2 __attribute__((ext_vector_type(2)));

constexpr int T_TOK = 16384, SEQ = 2048, DM = 1024;
constexpr int LDP = 6208;
constexpr int COL_PA = 1024, COL_PB = 2816, COL_PC = 4864;
constexpr int COL_YA = 1024, COL_MRG = 1536, COL_G = 2816, COL_YB = 3840, COL_YC = 4864, COL_ACT = 1024;
constexpr int COL_GS = 5960;
constexpr int C_Q = 4864, C_K = 5376, C_QI = 5632, C_KI = 5888, C_WI = 5952;
constexpr int IN_COLS = 8004, DFF = 2816, F2 = 5632;
constexpr size_t WS_WIN = 0, WS_WG = 10485760, WS_WBR = 16777216, WS_WO = 19922944, WS_WUP = 22020096, WS_WDN = 33554432;
constexpr size_t WS_P = 39321600, WS_HALO = 242745344, WS_VT = WS_HALO, WS_ROPE = 265814016, WS_BAR = 266338304, WS_BND = WS_HALO + 4194304, WS_SCAL = WS_HALO + 8388608, WS_XC = WS_BAR + 16384, WS_XB = WS_XC + 65536;
constexpr int LDS_BYTES = 153600;
constexpr int SCS = 2052;
constexpr int MASK_OFF = 16 * SCS * 4;

struct Args { const float* in[24]; float* out; unsigned char* ws; int ph_lo, ph_hi; };

__device__ __forceinline__ unsigned f2bf(float f) { unsigned u = __builtin_bit_cast(unsigned, f); return (u + 0x7fffu + ((u >> 16) & 1u)) >> 16; }
__device__ __forceinline__ unsigned pk2(float lo, float hi) { unsigned r; asm("v_cvt_pk_bf16_f32 %0, %1, %2" : "=v"(r) : "v"(lo), "v"(hi)); return r; }
__device__ __forceinline__ float bf2f(bf16_t b) { return __builtin_bit_cast(float, (unsigned)b << 16); }
__device__ __forceinline__ float bflo(unsigned w) { return __builtin_bit_cast(float, w << 16); }
__device__ __forceinline__ float bfhi(unsigned w) { return __builtin_bit_cast(float, w & 0xffff0000u); }
__device__ __forceinline__ float wave_sum(float v) {
#pragma unroll
    for (int o = 1; o < 64; o <<= 1) v += __shfl_xor(v, o);
    return v;
}
__device__ __forceinline__ int wave_sum_i(int v) {
#pragma unroll
    for (int o = 1; o < 64; o <<= 1) v += __shfl_xor(v, o);
    return v;
}
template <int CTRL> __device__ __forceinline__ float dpp_mov(float x) {
    return __builtin_bit_cast(float, __builtin_amdgcn_update_dpp(0, __builtin_bit_cast(int, x), CTRL, 0xF, 0xF, true));
}
__device__ __forceinline__ float red8(float x) { x += dpp_mov<0xB1>(x); x += dpp_mov<0x4E>(x); x += dpp_mov<0x141>(x); return x; }
__device__ __forceinline__ float red16(float x) { x = red8(x); x += dpp_mov<0x140>(x); return x; }
__device__ __forceinline__ float sigmoidf_(float x) { return 1.f / (1.f + __expf(-x)); }

namespace pg8 {
constexpr int BM = 256, BK = 64, HALF = 128, HTB = HALF * BK * 2, NXCD = 8, WGM = 8;
__device__ __forceinline__ int lds_byte(int r, int c) { const int st = (r >> 4) * 2 + (c >> 5), rr = r & 15, cc = c & 31, ob = rr * 64 + cc * 2; return st * 1024 + (ob ^ (((ob >> 9) & 1) << 5)); }
__device__ __forceinline__ void stage_rc(int b, int& R, int& C) { const int st = b / 1024, sb = b % 1024, swz = sb ^ (((sb >> 9) & 1) << 5); R = (st >> 1) * 16 + swz / 64; C = (st & 1) * 32 + (swz % 64) / 2; }
__device__ __forceinline__ int perm32(int rho) { const int n = rho >> 4, i = rho & 15; return 8 * (i >> 2) + 4 * n + (i & 3); }
struct Unit { int pm, pn; };
struct Gemm { const bf16_t* A; const bf16_t* Bt; int lda, ldb, K; };
struct StaticOrder {
    int nM, nN, nwg, G, c;
    __device__ void init(int M, int N, int G_, int c_) { nM = M / BM; nN = N / BM; nwg = nM * nN; G = G_; c = c_; }
    __device__ bool next(int i, Unit& u) const {
        const long L = (long)i * G + c; if (L >= nwg) return false;
        int wgid = (int)L; { const int q = nwg / NXCD, r = nwg % NXCD, xcd = wgid % NXCD, off = wgid / NXCD; wgid = (xcd < r ? xcd * (q + 1) : r * (q + 1) + (xcd - r) * q) + off; }
        const int nig = WGM * nN, gid = wgid / nig, fm = gid * WGM, gsz = (nM - fm) < WGM ? (nM - fm) : WGM;
        u.pm = fm + ((wgid % nig) % gsz); u.pn = (wgid % nig) / gsz; return true;
    }
};
__device__ __forceinline__ unsigned cvt_pk_bf16(float lo, float hi) { unsigned r; asm volatile("v_cvt_pk_bf16_f32 %0, %1, %2" : "=v"(r) : "v"(lo), "v"(hi)); return r; }

template <class Epi, bool ALIGN_EPI>
__device__ __forceinline__ void gemm_phase(LAS unsigned char* lds, const Gemm g, const StaticOrder& S, const Epi& E, const int tid) {
    const int wid = __builtin_amdgcn_readfirstlane(tid >> 6), lane = tid & 63, wr = wid >> 2, wc = wid & 3, fr = lane & 15, fq = lane >> 4;
    const int K = g.K, nt = K / BK;
    unsigned voffA[2], voffB[2];
#pragma unroll
    for (int i = 0; i < 2; ++i) { int R, C; stage_rc(tid * 16 + i * 8192, R, C); const int Rb = (R & ~31) + perm32(R & 31);
        voffA[i] = (unsigned)(R * g.lda + C) * 2u; voffB[i] = (unsigned)(Rb * g.ldb + C) * 2u; }
    const size_t kstep = (size_t)(BK * 2);
    const size_t hstepA = (size_t)HALF * g.lda * 2, hstepB = (size_t)HALF * g.ldb * 2;
    const size_t tstepA = 2 * hstepA, tstepB = 2 * hstepB;
    const unsigned ldsw = (unsigned)wid * 1024u;
    const int aoff = lds_byte(wr * 64 + fr, fq * 8), boff = lds_byte(wc * 32 + fr, fq * 8);
#define PG8_SA(b, h) (((b) * 2 + (h)) * HTB)
#define PG8_SB(b, h) ((4 + (b) * 2 + (h)) * HTB)
#define PG8_STAGE(bufoff, gbase, voff) do { _Pragma("unroll") for (int _i = 0; _i < 2; ++_i) \
        __builtin_amdgcn_global_load_lds((const unsigned*)((const char*)(gbase) + (voff)[_i]), (LAS unsigned*)(lds + (bufoff) + ldsw + _i * 8192), 16, 0, 0); } while (0)
#define PG8_LDA(dst, b, h) do { _Pragma("unroll") for (int m = 0; m < 4; ++m) _Pragma("unroll") for (int k = 0; k < 2; ++k) dst[m][k] = *(const LAS bf16x8*)(lds + PG8_SA(b, h) + aoff + m * 2048 + k * 1024); } while (0)
#define PG8_LDB(dst, b, h) do { _Pragma("unroll") for (int n = 0; n < 2; ++n) _Pragma("unroll") for (int k = 0; k < 2; ++k) dst[n][k] = *(const LAS bf16x8*)(lds + PG8_SB(b, h) + boff + n * 2048 + k * 1024); } while (0)
#define PG8_MMA(ai, bj, At, Bt) do { __builtin_amdgcn_s_setprio(1); _Pragma("unroll") for (int m = 0; m < 4; ++m) _Pragma("unroll") for (int n = 0; n < 2; ++n) _Pragma("unroll") for (int k = 0; k < 2; ++k) \
        acc[ai][bj][m][n] = __builtin_amdgcn_mfma_f32_16x16x32_bf16(Bt[n][k], At[m][k], acc[ai][bj][m][n], 0, 0, 0); __builtin_amdgcn_s_setprio(0); } while (0)
#define PG8_WAIT_V(n) asm volatile("s_waitcnt vmcnt(" #n ")" ::: "memory")
#define PG8_WAIT_L(n) asm volatile("s_waitcnt lgkmcnt(" #n ")" ::: "memory")
#define PG8_BAR __builtin_amdgcn_s_barrier()
#define PG8_SCHED __builtin_amdgcn_sched_barrier(0)
    Unit cur, nxt; int ui = 0;
    if (!S.next(0, cur)) return;
    f32x4 acc[2][2][4][2];
#pragma unroll
    for (int a = 0; a < 2; ++a)
#pragma unroll
        for (int b = 0; b < 2; ++b)
#pragma unroll
            for (int m = 0; m < 4; ++m)
#pragma unroll
                for (int n = 0; n < 2; ++n) acc[a][b][m][n] = (f32x4){0.f, 0.f, 0.f, 0.f};
    bf16x8 At[4][2], B0[2][2], B1[2][2];
    const char* cA = (const char*)g.A + (size_t)cur.pm * tstepA; const char* cB = (const char*)g.Bt + (size_t)cur.pn * tstepB;
    PG8_STAGE(PG8_SB(0, 0), cB, voffB); PG8_STAGE(PG8_SB(0, 1), cB + hstepB, voffB); PG8_STAGE(PG8_SA(0, 0), cA, voffA); PG8_STAGE(PG8_SA(0, 1), cA + hstepA, voffA);
    if (wr == 1) PG8_BAR;
    PG8_WAIT_V(2); PG8_BAR;
    PG8_STAGE(PG8_SB(1, 0), cB + kstep, voffB); PG8_STAGE(PG8_SA(1, 0), cA + kstep, voffA); PG8_STAGE(PG8_SB(1, 1), cB + hstepB + kstep, voffB);
    PG8_WAIT_V(6); PG8_BAR;
    for (;;) {
        const bool has_next = S.next(ui + 1, nxt);
        const char* nA = has_next ? (const char*)g.A + (size_t)nxt.pm * tstepA : cA; const char* nB = has_next ? (const char*)g.Bt + (size_t)nxt.pn * tstepB : cB;
        for (int t = 0; t < nt; t += 2) {
            const bool last = (t == nt - 2);
            const char* a1 = cA + (size_t)(t + 1) * kstep;
            const char* a2 = last ? nA : cA + (size_t)(t + 2) * kstep; const char* b2 = last ? nB : cB + (size_t)(t + 2) * kstep;
            const char* a3 = a2 + kstep; const char* b3 = b2 + kstep;
            PG8_LDB(B0, 0, 0); PG8_LDB(B1, 0, 1); PG8_SCHED; PG8_LDA(At, 0, 0); PG8_STAGE(PG8_SA(1, 1), a1 + hstepA, voffA);
            PG8_WAIT_V(8); PG8_WAIT_L(0); PG8_BAR; PG8_MMA(0, 0, At, B0); PG8_MMA(0, 1, At, B1); PG8_BAR; PG8_SCHED;
            PG8_LDA(At, 0, 1); PG8_STAGE(PG8_SB(0, 0), b2, voffB); PG8_STAGE(PG8_SB(0, 1), b2 + hstepB, voffB); PG8_STAGE(PG8_SA(0, 0), a2, voffA);
            PG8_WAIT_V(8); PG8_WAIT_L(0); PG8_BAR; PG8_MMA(1, 0, At, B0); PG8_MMA(1, 1, At, B1); PG8_BAR; PG8_SCHED;
            PG8_LDB(B0, 1, 0); PG8_LDB(B1, 1, 1); PG8_SCHED; PG8_LDA(At, 1, 0); PG8_STAGE(PG8_SA(0, 1), a2 + hstepA, voffA);
            PG8_WAIT_V(8); PG8_WAIT_L(0); PG8_BAR; PG8_MMA(0, 0, At, B0); PG8_MMA(0, 1, At, B1); PG8_BAR; PG8_SCHED;
            PG8_LDA(At, 1, 1); PG8_STAGE(PG8_SB(1, 0), b3, voffB); PG8_STAGE(PG8_SB(1, 1), b3 + hstepB, voffB); PG8_STAGE(PG8_SA(1, 0), a3, voffA);
            PG8_WAIT_V(8); PG8_WAIT_L(0); PG8_BAR; PG8_MMA(1, 0, At, B0); PG8_MMA(1, 1, At, B1); PG8_BAR; PG8_SCHED;
        }
        if constexpr (ALIGN_EPI) { if (wr == 0) PG8_BAR; }
        if constexpr (!Epi::AFTER_DRAIN) E(acc, cur, wr, wc, fr, fq);
        if (!has_next) break;
#pragma unroll
        for (int a = 0; a < 2; ++a)
#pragma unroll
            for (int b = 0; b < 2; ++b)
#pragma unroll
                for (int m = 0; m < 4; ++m)
#pragma unroll
                    for (int n = 0; n < 2; ++n) acc[a][b][m][n] = (f32x4){0.f, 0.f, 0.f, 0.f};
        cur = nxt; cA = nA; cB = nB; ++ui;
        if constexpr (ALIGN_EPI) { if (wr == 1) PG8_BAR; }
    }
    PG8_WAIT_V(0);
    if constexpr (!ALIGN_EPI) { if (wr == 0) PG8_BAR; }
    PG8_BAR;
    if constexpr (Epi::AFTER_DRAIN) E.fused(acc, cur, wr, wc, fr, fq, lds, wid, lane);
#undef PG8_SA
#undef PG8_SB
#undef PG8_STAGE
#undef PG8_LDA
#undef PG8_LDB
#undef PG8_MMA
#undef PG8_WAIT_V
#undef PG8_WAIT_L
#undef PG8_BAR
#undef PG8_SCHED
}

typedef f32x4 AccT[2][2][4][2];

struct EpiInProj {
    static constexpr bool AFTER_DRAIN = false;
    bf16_t* P; bf16_t* VT; const float* rope; bf16_t* BND;
    __device__ __forceinline__ void operator()(AccT& acc, const Unit& u, int wr, int wc, int fr, int fq) const {
        const int row0 = u.pm * BM + wr * 64 + fr, colb = u.pn * BM + wc * 32 + 8 * fq;
#pragma unroll
        for (int ai = 0; ai < 2; ++ai)
#pragma unroll
            for (int m = 0; m < 4; ++m) {
                const int row = row0 + ai * HALF + m * 16, t = row & (SEQ - 1);
                bf16_t* rowp = P + (size_t)row * LDP + COL_PA;
#pragma unroll
                for (int bj = 0; bj < 2; ++bj) {
                    const int c = colb + bj * HALF;
                    f32x4 v0 = acc[ai][bj][m][0], v1 = acc[ai][bj][m][1];
                    if (u.pn >= 15) {
                        const int cl = c - 3840;
                        if (cl < 640 || (cl >= 768 && cl < 1088)) {
                            const float* cs = rope + ((size_t)t * 32 + ((cl & 63) >> 1)) * 2;
                            const f32x4 r0 = *(const f32x4*)cs, r1 = *(const f32x4*)(cs + 4);
                            f32x4 o0, o1;
                            o0[0] = v0[0] * r0[0] - v0[1] * r0[1]; o0[1] = v0[1] * r0[0] + v0[0] * r0[1];
                            o0[2] = v0[2] * r0[2] - v0[3] * r0[3]; o0[3] = v0[3] * r0[2] + v0[2] * r0[3];
                            o1[0] = v1[0] * r1[0] - v1[1] * r1[1]; o1[1] = v1[1] * r1[0] + v1[0] * r1[1];
                            o1[2] = v1[2] * r1[2] - v1[3] * r1[3]; o1[3] = v1[3] * r1[2] + v1[2] * r1[3];
                            v0 = o0; v1 = o1;
                        }
                    }
                    u32x4 w; w.x = cvt_pk_bf16(v0[0], v0[1]); w.y = cvt_pk_bf16(v0[2], v0[3]); w.z = cvt_pk_bf16(v1[0], v1[1]); w.w = cvt_pk_bf16(v1[2], v1[3]);
                    *(u32x4*)(rowp + c) = w;
                    if (u.pn < 7 && fr == 15) *(u32x4*)(BND + (size_t)(row >> 4) * 1792 + c) = w;
                    if (u.pn == 17 && bj == 1) {
                        const int cv = c - 3840 - 640, b = row >> 11;
                        bf16_t* vt = VT + ((size_t)(b * 2 + (cv >> 6)) * 64 + (cv & 63)) * SEQ + t;
                        vt[0 * SEQ] = (bf16_t)(w.x & 0xffffu); vt[1 * SEQ] = (bf16_t)(w.x >> 16);
                        vt[2 * SEQ] = (bf16_t)(w.y & 0xffffu); vt[3 * SEQ] = (bf16_t)(w.y >> 16);
                        vt[4 * SEQ] = (bf16_t)(w.z & 0xffffu); vt[5 * SEQ] = (bf16_t)(w.z >> 16);
                        vt[6 * SEQ] = (bf16_t)(w.w & 0xffffu); vt[7 * SEQ] = (bf16_t)(w.w >> 16);
                    }
                }
            }
    }
};
struct EpiGate {
    static constexpr bool AFTER_DRAIN = false;
    bf16_t* P; bf16_t* Gb; int Gs;
    __device__ __forceinline__ void operator()(AccT& acc, const Unit& u, int wr, int wc, int fr, int fq) const {
        const int row0 = u.pm * BM + wr * 64 + fr, colb = u.pn * BM + wc * 32 + 8 * fq;
#pragma unroll
        for (int ai = 0; ai < 2; ++ai)
#pragma unroll
            for (int m = 0; m < 4; ++m) {
                bf16_t* rowp = Gb + (size_t)(row0 + ai * HALF + m * 16) * Gs + colb;
#pragma unroll
                for (int bj = 0; bj < 2; ++bj) {
                    const f32x4 v0 = acc[ai][bj][m][0], v1 = acc[ai][bj][m][1];
                    u32x4 w; w.x = cvt_pk_bf16(sigmoidf_(v0[0]), sigmoidf_(v0[1])); w.y = cvt_pk_bf16(sigmoidf_(v0[2]), sigmoidf_(v0[3]));
                    w.z = cvt_pk_bf16(sigmoidf_(v1[0]), sigmoidf_(v1[1])); w.w = cvt_pk_bf16(sigmoidf_(v1[2]), sigmoidf_(v1[3]));
                    *(u32x4*)(rowp + bj * HALF) = w;
                }
            }
    }
};
struct EpiMergeAcc {
    static constexpr bool AFTER_DRAIN = false;
    bf16_t* P; int first; const bf16_t* Gb; int Gs;
    __device__ __forceinline__ void operator()(AccT& acc, const Unit& u, int wr, int wc, int fr, int fq) const {
        const int row0 = u.pm * BM + wr * 64 + fr, colb = u.pn * BM + wc * 32 + 8 * fq;
#pragma unroll
        for (int ai = 0; ai < 2; ++ai)
#pragma unroll
            for (int m = 0; m < 4; ++m) {
                bf16_t* rowb = P + (size_t)(row0 + ai * HALF + m * 16) * LDP + colb;
#pragma unroll
                for (int bj = 0; bj < 2; ++bj) {
                    const f32x4 v0 = acc[ai][bj][m][0], v1 = acc[ai][bj][m][1];
                    const u32x4 gq = *(const u32x4*)(Gb + (size_t)(row0 + ai * HALF + m * 16) * Gs + colb + bj * HALF);
                    u32x4 mq = (u32x4){0u, 0u, 0u, 0u};
                    if (!first) mq = *(const u32x4*)(rowb + COL_MRG + bj * HALF);
                    const unsigned ga = gq.x, gb = gq.y, gc = gq.z, gd = gq.w;
                    const unsigned ma = mq.x, mb = mq.y, mc = mq.z, md = mq.w;
                    u32x4 w;
                    w.x = cvt_pk_bf16(bflo(ma) + bflo(ga) * v0[0], bfhi(ma) + bfhi(ga) * v0[1]);
                    w.y = cvt_pk_bf16(bflo(mb) + bflo(gb) * v0[2], bfhi(mb) + bfhi(gb) * v0[3]);
                    w.z = cvt_pk_bf16(bflo(mc) + bflo(gc) * v1[0], bfhi(mc) + bfhi(gc) * v1[1]);
                    w.w = cvt_pk_bf16(bflo(md) + bflo(gd) * v1[2], bfhi(md) + bfhi(gd) * v1[3]);
                    *(u32x4*)(rowb + COL_MRG + bj * HALF) = w;
                }
            }
    }
};
struct EpiResid {
    static constexpr bool AFTER_DRAIN = false;
    const float* base; float* out;
    __device__ __forceinline__ void operator()(AccT& acc, const Unit& u, int wr, int wc, int fr, int fq) const {
        const int row0 = u.pm * BM + wr * 64 + fr, colb = u.pn * BM + wc * 32 + 8 * fq;
#pragma unroll
        for (int ai = 0; ai < 2; ++ai)
#pragma unroll
            for (int m = 0; m < 4; ++m) {
                const size_t off = (size_t)(row0 + ai * HALF + m * 16) * DM + colb;
#pragma unroll
                for (int bj = 0; bj < 2; ++bj) {
                    const f32x4 b0 = *(const f32x4*)(base + off + bj * HALF), b1 = *(const f32x4*)(base + off + bj * HALF + 4);
                    *(f32x4*)(out + off + bj * HALF) = b0 + acc[ai][bj][m][0];
                    *(f32x4*)(out + off + bj * HALF + 4) = b1 + acc[ai][bj][m][1];
                }
            }
    }
};
struct EpiResidNorm {
    static constexpr bool AFTER_DRAIN = true;
    const float* base; float* out; const float* g; bf16_t* obf; float* of32; unsigned* xbuf; unsigned* cnt;
    __device__ __forceinline__ void fused(AccT& acc, const Unit& u, int wr, int wc, int fr, int fq, LAS unsigned char* lds, int wid, int lane) const {
        LAS float* Pl = (LAS float*)lds;
        LAS float* S = (LAS float*)(lds + 8192);
        const int row0 = u.pm * BM + wr * 64 + fr, colb = u.pn * BM + wc * 32 + 8 * fq;
#pragma unroll
        for (int ai = 0; ai < 2; ++ai)
#pragma unroll
            for (int m = 0; m < 4; ++m) {
                const size_t off = (size_t)(row0 + ai * HALF + m * 16) * DM + colb;
                float sq = 0.f;
#pragma unroll
                for (int bj = 0; bj < 2; ++bj) {
                    const f32x4 b0 = *(const f32x4*)(base + off + bj * HALF), b1 = *(const f32x4*)(base + off + bj * HALF + 4);
                    const f32x4 h0 = acc[ai][bj][m][0] + b0, h1 = acc[ai][bj][m][1] + b1;
                    acc[ai][bj][m][0] = h0; acc[ai][bj][m][1] = h1;
                    sq += (h0.x * h0.x + h0.y * h0.y) + (h0.z * h0.z + h0.w * h0.w) + (h1.x * h1.x + h1.y * h1.y) + (h1.z * h1.z + h1.w * h1.w);
                }
                sq += __shfl_xor(sq, 16); sq += __shfl_xor(sq, 32);
                if (fq == 0) Pl[(ai * HALF + wr * 64 + m * 16 + fr) * 4 + wc] = sq;
                if (m & 1) asm volatile("" ::: "memory");
            }
        asm volatile("s_waitcnt lgkmcnt(0)" ::: "memory"); __builtin_amdgcn_s_barrier(); asm volatile("" ::: "memory");
        const int row = wid * 32 + (lane & 31);
        if (lane < 32) {
            const f32x4 p = *(const LAS f32x4*)&Pl[row * 4];
            __hip_atomic_store(xbuf + ((size_t)(u.pm * BM + row) * 4 + u.pn), __builtin_bit_cast(unsigned, (p.x + p.y) + (p.z + p.w)), __ATOMIC_RELAXED, __HIP_MEMORY_SCOPE_AGENT);
        }
        asm volatile("s_waitcnt vmcnt(0)" ::: "memory");
        if (lane == 0) __hip_atomic_fetch_add(cnt + 64 * u.pm, 1u, __ATOMIC_RELAXED, __HIP_MEMORY_SCOPE_AGENT);
        if (wid == 0) {
            unsigned sp = 0u;
            while ((unsigned)__builtin_amdgcn_readfirstlane(__hip_atomic_load(cnt + 64 * u.pm, __ATOMIC_RELAXED, __HIP_MEMORY_SCOPE_AGENT)) < 32u) { __builtin_amdgcn_s_sleep(2); if (++sp > (1u << 22)) break; }
            __builtin_amdgcn_fence(__ATOMIC_ACQUIRE, "agent");
        }
        asm volatile("s_waitcnt vmcnt(0) lgkmcnt(0)" ::: "memory"); __builtin_amdgcn_s_barrier(); asm volatile("" ::: "memory");
        if (lane < 32) {
            const unsigned* slot = xbuf + (size_t)(u.pm * BM + row) * 4; float tot = 0.f;
#pragma unroll
            for (int t = 0; t < 4; ++t) tot += __builtin_bit_cast(float, __hip_atomic_load(slot + t, __ATOMIC_RELAXED, __HIP_MEMORY_SCOPE_AGENT));
            S[row] = 1.0f / sqrtf(tot * (1.f / DM) + 1e-6f);
        }
        asm volatile("s_waitcnt lgkmcnt(0)" ::: "memory"); __builtin_amdgcn_s_barrier(); asm volatile("" ::: "memory");
        f32x4 gv[2][2];
#pragma unroll
        for (int bj = 0; bj < 2; ++bj)
#pragma unroll
            for (int n = 0; n < 2; ++n) gv[bj][n] = *(const f32x4*)(g + colb + bj * HALF + 4 * n);
#pragma unroll
        for (int ai = 0; ai < 2; ++ai)
#pragma unroll
            for (int m = 0; m < 4; ++m) {
                const int rl = ai * HALF + wr * 64 + m * 16 + fr, rowg = u.pm * BM + rl;
                const float rs = S[rl];
#pragma unroll
                for (int bj = 0; bj < 2; ++bj) {
                    const f32x4 h0 = acc[ai][bj][m][0], h1 = acc[ai][bj][m][1];
                    const size_t off = (size_t)rowg * DM + colb + bj * HALF;
                    if (out) { *(f32x4*)(out + off) = h0; *(f32x4*)(out + off + 4) = h1; }
                    const f32x4 o0 = h0 * rs * gv[bj][0], o1 = h1 * rs * gv[bj][1];
                    if (obf) { u32x4 w; w.x = cvt_pk_bf16(o0[0], o0[1]); w.y = cvt_pk_bf16(o0[2], o0[3]); w.z = cvt_pk_bf16(o1[0], o1[1]); w.w = cvt_pk_bf16(o1[2], o1[3]);
                        *(u32x4*)(obf + (size_t)rowg * LDP + colb + bj * HALF) = w; }
                    else { *(f32x4*)(of32 + off) = o0; *(f32x4*)(of32 + off + 4) = o1; }
                }
                asm volatile("" ::: "memory");
            }
    }
};
struct EpiUp {
    static constexpr bool AFTER_DRAIN = false;
    bf16_t* P; float* HALO; const float* cw; const float* cb; LAS float* CW;
    __device__ __forceinline__ void operator()(AccT& acc, const Unit& u, int wr, int wc, int fr_in, int fq_in) const {
        int fr = fr_in, fq = fq_in;
        asm volatile("" : "+v"(fr), "+v"(fq));
        const int row0 = u.pm * BM + wr * 64 + fr;
        const int jb = u.pn * 128 + wc * 32 + 8 * fq;
        {
            const int tl = (wr * 4 + wc) * 64 + fq * 16 + fr;
#pragma unroll
            for (int it = 0; it < 2; ++it) { const int k = tl + 512 * it, p = k >> 8, col = k & 255, co = (col >> 7) * DFF + u.pn * 128 + (col & 127);
                CW[k] = (p < 3) ? cw[p * F2 + co] : cb[co]; }
            asm volatile("s_waitcnt lgkmcnt(0)" ::: "memory"); __builtin_amdgcn_s_barrier(); asm volatile("" ::: "memory");
        }
#pragma unroll
        for (int ai = 0; ai < 2; ++ai) {
            const int s = u.pm * 4 + ai * 2 + wr;
#pragma unroll
            for (int bj = 0; bj < 2; ++bj)
#pragma unroll
                for (int n = 0; n < 2; ++n) {
                    const int colp = u.pn * BM + bj * HALF + wc * 32 + 8 * fq + 4 * n;
                    if (fr < 2) *(f32x4*)(HALO + (size_t)(s * 4 + fr) * F2 + colp) = acc[ai][bj][0][n];
                    if (fr >= 14) *(f32x4*)(HALO + (size_t)(s * 4 + fr - 12) * F2 + colp) = acc[ai][bj][3][n];
                }
        }
#pragma unroll
        for (int ai = 0; ai < 2; ++ai)
#pragma unroll
            for (int m = 0; m < 4; ++m) {
                const int row = row0 + ai * HALF + m * 16;
#pragma unroll
                for (int n = 0; n < 2; ++n) {
                    f32x4 cv[2];
#pragma unroll
                    for (int bj = 0; bj < 2; ++bj) {
                        const int cl = bj * 128 + wc * 32 + 8 * fq + 4 * n;
                        const f32x4 w0 = *(const LAS f32x4*)&CW[cl], w1 = *(const LAS f32x4*)&CW[256 + cl], w2 = *(const LAS f32x4*)&CW[512 + cl], bb = *(const LAS f32x4*)&CW[768 + cl];
#pragma unroll
                        for (int e = 0; e < 4; ++e) {
                            const float cur = acc[ai][bj][m][n][e];
                            const float prv = m > 0 ? acc[ai][bj][m > 0 ? m - 1 : 0][n][e] : 0.f;
                            const float a1 = dpp_mov<0x121>(cur), a2 = dpp_mov<0x122>(cur), b1 = dpp_mov<0x121>(prv), b2 = dpp_mov<0x122>(prv);
                            const float p1 = fr >= 1 ? a1 : b1, p2 = fr >= 2 ? a2 : b2;
                            cv[bj][e] = bb[e] + w0[e] * p2 + w1[e] * p1 + w2[e] * cur;
                        }
                        __builtin_amdgcn_sched_barrier(0);
                    }
                    const f32x4 g0 = cv[0], v0 = cv[1];
                    u32x2 w;
                    w.x = cvt_pk_bf16(g0[0] * sigmoidf_(g0[0]) * v0[0], g0[1] * sigmoidf_(g0[1]) * v0[1]);
                    w.y = cvt_pk_bf16(g0[2] * sigmoidf_(g0[2]) * v0[2], g0[3] * sigmoidf_(g0[3]) * v0[3]);
                    if (!(m == 0 && fr < 2)) *(u32x2*)(P + (size_t)row * LDP + COL_ACT + jb + 4 * n) = w;
                    __builtin_amdgcn_sched_barrier(0);
                }
            }
    }
};
}

struct Ctx {
    const float* in[24]; float* out; unsigned char* ws;
    bf16_t* P; bf16_t* VT; float* HALO; float* ROPE;
    bf16_t *Win, *Wg, *Wbr, *Wo, *Wup, *Wdn;
    int tid, lane, wave, G, bid;
};

__device__ __forceinline__ int srccol(int mode, int n) {
    if (mode == 0) return n;
    if (mode == 2) return 4932 + n;
    if (mode == 3) { const int tile = n >> 8, w = n & 255, j = tile * 128 + (w & 127); return (w < 128) ? j : DFF + j; }
    if (n < 3840) return n;
    const int c = n - 3840;
    if (c >= 1092) return -1;
    if (c < 640 || (c >= 768 && c < 1088)) { const int base = c & ~63, i = c & 63; return 3840 + base + (i >> 1) + 32 * (i & 1); }
    return 3840 + c;
}
__device__ __forceinline__ void tr_item(const float* W, int ldw, int K, int N, bf16_t* WT, int mode, int item, LAS float* scr, int lane) {
    const int nblk = N / 32, kb = item / nblk, nb = item % nblk, k0 = 64 * kb, n0 = 32 * nb;
    const int sc = srccol(mode, n0 + (lane & 31));
    float wv_[32];
#pragma unroll
    for (int i = 0; i < 32; ++i) { const int kk = 2 * i + (lane >> 5); wv_[i] = (sc >= 0) ? W[(size_t)(k0 + kk) * ldw + sc] : 0.f; }
#pragma unroll
    for (int i = 0; i < 32; ++i) { const int kk = 2 * i + (lane >> 5); scr[kk * 33 + (lane & 31)] = wv_[i]; }
    asm volatile("s_waitcnt lgkmcnt(0)" ::: "memory");
    const int c = lane & 7;
#pragma unroll
    for (int j = 0; j < 4; ++j) { const int n = (lane >> 3) + 8 * j; const LAS float* s = scr + (8 * c) * 33 + n;
        u32x4 o; o.x = pk2(s[0 * 33], s[1 * 33]); o.y = pk2(s[2 * 33], s[3 * 33]); o.z = pk2(s[4 * 33], s[5 * 33]); o.w = pk2(s[6 * 33], s[7 * 33]);
        *(u32x4*)(WT + (size_t)(n0 + n) * K + k0 + 8 * c) = o; }
    asm volatile("s_waitcnt lgkmcnt(0)" ::: "memory");
}
__device__ __forceinline__ void rms_row(const float* xrow, const float* g, bf16_t* obf, float* of32, int lane) {
    const f32x4* xr = (const f32x4*)xrow + lane; const f32x4* gr = (const f32x4*)g + lane;
    f32x4 v[4]; float s = 0.f;
#pragma unroll
    for (int j = 0; j < 4; ++j) { v[j] = xr[64 * j]; s += (v[j].x * v[j].x + v[j].y * v[j].y) + (v[j].z * v[j].z + v[j].w * v[j].w); }
    const float rs = 1.f / sqrtf(wave_sum(s) * (1.f / DM) + 1e-6f);
#pragma unroll
    for (int j = 0; j < 4; ++j) {
        const f32x4 gg = gr[64 * j]; const f32x4 o = v[j] * rs * gg;
        if (obf) { u32x2 w; w.x = pk2(o.x, o.y); w.y = pk2(o.z, o.w); *((u32x2*)obf + lane + 64 * j) = w; }
        else *((f32x4*)of32 + lane + 64 * j) = o;
    }
}
__device__ __forceinline__ void rms_pass(const Ctx& X, const float* src, const float* g, bf16_t* obf, float* of32) {
    const int gw = X.bid * 8 + X.wave, NGW = X.G * 8, lane = X.lane;
    const f32x4* gr = (const f32x4*)g + lane;
    f32x4 gg[4];
#pragma unroll
    for (int j = 0; j < 4; ++j) gg[j] = gr[64 * j];
#pragma unroll 1
    for (int m = gw; m < T_TOK; m += 4 * NGW) {
        f32x4 v[4][4]; float ss[4]; int mr[4];
#pragma unroll
        for (int r = 0; r < 4; ++r) { mr[r] = m + r * NGW; const int ml = mr[r] < T_TOK ? mr[r] : m; const f32x4* x = (const f32x4*)(src + (size_t)ml * DM) + lane;
#pragma unroll
            for (int j = 0; j < 4; ++j) v[r][j] = x[64 * j]; }
#pragma unroll
        for (int r = 0; r < 4; ++r) { float a = 0.f;
#pragma unroll
            for (int j = 0; j < 4; ++j) a += (v[r][j].x * v[r][j].x + v[r][j].y * v[r][j].y) + (v[r][j].z * v[r][j].z + v[r][j].w * v[r][j].w);
            ss[r] = 1.f / sqrtf(wave_sum(a) * (1.f / DM) + 1e-6f); }
#pragma unroll
        for (int r = 0; r < 4; ++r) {
            if (mr[r] < T_TOK) {
#pragma unroll
                for (int j = 0; j < 4; ++j) {
                    const f32x4 o = v[r][j] * ss[r] * gg[j];
                    if (obf) { u32x2 w; w.x = pk2(o.x, o.y); w.y = pk2(o.z, o.w); *((u32x2*)(obf + (size_t)mr[r] * LDP) + lane + 64 * j) = w; }
                    else *((f32x4*)(of32 + (size_t)mr[r] * DM) + lane + 64 * j) = o;
                }
            }
        }
    }
}
__device__ __forceinline__ void phase_prep(const Ctx& X, LAS unsigned char* lds, int layer, bool do_u) {
    LAS float* scr = (LAS float*)(lds + X.wave * 8448);
    const int gw = X.bid * 8 + X.wave, NGW = X.G * 8;
    constexpr int I_IN = 16 * 160, I_G = 16 * 96, I_BR = 8 * 32, I_O = 16 * 32, I_UP = 16 * 176, I_DN = 44 * 32;
    constexpr int NITEMS = I_IN + I_G + 3 * I_BR + I_O + I_UP + I_DN;
    const float* w_in = X.in[2] + (size_t)layer * DM * IN_COLS;
    const float* w_br = X.in[16] + (size_t)layer * 3 * 512 * DM;
    const float* w_o = X.in[17] + (size_t)layer * DM * DM;
    const float* w_up = X.in[19] + (size_t)layer * DM * F2;
    const float* w_dn = X.in[22] + (size_t)layer * DFF * DM;
    for (int it = gw; it < NITEMS; it += NGW) {
        int r = it;
        if (r < I_IN) { tr_item(w_in, IN_COLS, DM, 5120, X.Win, 1, r, scr, X.lane); continue; } r -= I_IN;
        if (r < I_G) { tr_item(w_in, IN_COLS, DM, 3072, X.Wg, 2, r, scr, X.lane); continue; } r -= I_G;
        if (r < 3 * I_BR) { const int b = r / I_BR; tr_item(w_br + (size_t)b * 512 * DM, DM, 512, DM, X.Wbr + (size_t)b * DM * 512, 0, r % I_BR, scr, X.lane); continue; } r -= 3 * I_BR;
        if (r < I_O) { tr_item(w_o, DM, DM, DM, X.Wo, 0, r, scr, X.lane); continue; } r -= I_O;
        if (r < I_UP) { tr_item(w_up, F2, DM, F2, X.Wup, 3, r, scr, X.lane); continue; } r -= I_UP;
        tr_item(w_dn, DM, DFF, DM, X.Wdn, 0, r, scr, X.lane);
    }
    const float* h = (layer == 0) ? X.in[0] : X.out;
    const float* g = X.in[1] + (size_t)layer * DM;
    if (do_u) rms_pass(X, h, g, X.P, nullptr);
    if (layer == 0) {
        for (int idx = X.bid * 512 + X.tid; idx < SEQ * 32; idx += X.G * 512) {
            const int t = idx >> 5, p = idx & 31;
            const float inv = exp2f(-(float)p * 0.03125f * 13.287712379549449f);
            const float ang = (float)t * inv;
            const double rev = (double)ang * 0.15915494309189535;
            const float fr = (float)(rev - floor(rev));
            X.ROPE[2 * idx] = __builtin_amdgcn_cosf(fr); X.ROPE[2 * idx + 1] = __builtin_amdgcn_sinf(fr);
        }
    }
}

__device__ __forceinline__ float wave_sum_fast(float x) {
    x = red16(x);
    const float r0 = __builtin_bit_cast(float, __builtin_amdgcn_readlane(__builtin_bit_cast(int, x), 0)), r1 = __builtin_bit_cast(float, __builtin_amdgcn_readlane(__builtin_bit_cast(int, x), 16));
    const float r2 = __builtin_bit_cast(float, __builtin_amdgcn_readlane(__builtin_bit_cast(int, x), 32)), r3 = __builtin_bit_cast(float, __builtin_amdgcn_readlane(__builtin_bit_cast(int, x), 48));
    return (r0 + r1) + (r2 + r3);
}
#define LDS_BAR() do { asm volatile("s_waitcnt lgkmcnt(0)" ::: "memory"); __builtin_amdgcn_s_barrier(); asm volatile("" ::: "memory"); } while (0)
constexpr int RW_TS = 16, RW_NCH = SEQ / RW_TS, RW_BUF = 33280;
__device__ __forceinline__ void phase_rwkv_pre(const Ctx& X, LAS unsigned char* lds, int layer) {
    LAS float* Rr = (LAS float*)(lds);           LAS float* Kk = (LAS float*)(lds + 8192);   LAS float* Vv = (LAS float*)(lds + 16384);
    LAS float* W1 = (LAS float*)(lds + 24576);   LAS float* AS = (LAS float*)(lds + 32768);
    LAS bf16_t* WDb = (LAS bf16_t*)(lds + 40960);
    LAS bf16_t* ADb = (LAS bf16_t*)(lds + 45568);
    LAS bf16_t* WTu = (LAS bf16_t*)(lds + 50176);
    LAS bf16_t* WTa = (LAS bf16_t*)(lds + 59392);
    LAS float* MU = (LAS float*)(lds + 68608);
    const int tid = X.tid, lane = tid & 63, wv = X.wave;
    const float* mu = X.in[3] + layer * 1792;
    const float* w0 = X.in[4] + layer * 512;   const float* w_up = X.in[5] + (size_t)layer * 64 * 512;
    const float* a0 = X.in[6] + layer * 512;   const float* a_up = X.in[7] + (size_t)layer * 64 * 512;
    const float* k_k = X.in[9] + layer * 512;  const float* k_a = X.in[10] + layer * 512;  const float* r_k = X.in[11] + layer * 512;
    const bf16_t* BND = (const bf16_t*)(X.ws + WS_BND);
    float* SCAL = (float*)(X.ws + WS_SCAL);
    const int ln = lane & 15, lg = lane >> 4;
    int last_h = -1;
    float q_w0 = 0.f, q_a0 = 0.f;
    f32x4 p_kk4 = (f32x4){0.f, 0.f, 0.f, 0.f}, p_ka4 = p_kk4, p_rk4 = p_kk4;
    const int cg4 = (tid & 15) * 4;
    u32x4 pc4[3], pp4[3], gc4, gp4; bool have_pf = false;
    pc4[0] = pc4[1] = pc4[2] = pp4[0] = pp4[1] = pp4[2] = gc4 = gp4 = (u32x4){0u, 0u, 0u, 0u};
#define PRE_LOAD(uu) do { const int h_ = (uu) & 7, tp_ = (uu) >> 3; _Pragma("unroll") for (int it = 0; it < 3; ++it) { const int idx = tid + 512 * it; pc4[it] = (u32x4){0u, 0u, 0u, 0u}; pp4[it] = (u32x4){0u, 0u, 0u, 0u}; \
        if (idx < 32 * 40) { const int tt = idx / 40, vv = idx - tt * 40; \
            const int col = vv < 8 ? h_ * 64 + 8 * vv : (vv < 16 ? 512 + h_ * 64 + 8 * (vv - 8) : (vv < 24 ? 1024 + h_ * 64 + 8 * (vv - 16) : 1536 + 8 * (vv - 24))); \
            const size_t row = (size_t)tp_ * 32 + tt; pc4[it] = *(const u32x4*)(X.P + row * LDP + COL_PA + col); \
            if (tt > 0) pp4[it] = *(const u32x4*)(X.P + (row - 1) * LDP + COL_PA + col); else if ((tp_ & 63) != 0) pp4[it] = *(const u32x4*)(BND + (size_t)(2 * tp_ - 1) * 1792 + col); } } \
        if (tid < 64) { const int tt = tid >> 1, col = 1664 + 8 * (2 * h_ + (tid & 1)); const size_t row = (size_t)tp_ * 32 + tt; gc4 = *(const u32x4*)(X.P + row * LDP + COL_PA + col); gp4 = (u32x4){0u, 0u, 0u, 0u}; \
            if (tt > 0) gp4 = *(const u32x4*)(X.P + (row - 1) * LDP + COL_PA + col); else if ((tp_ & 63) != 0) gp4 = *(const u32x4*)(BND + (size_t)(2 * tp_ - 1) * 1792 + col); } } while (0)
#pragma unroll 1
    for (int u = X.bid; u < 4096; u += X.G) {
        const int h = u & 7, tp = u >> 3;
        if (h != last_h) {
            __syncthreads();
            for (int idx = tid; idx < 64 * 64; idx += 512) { const int m = idx >> 6, cc = idx & 63;
                WTu[cc * 72 + m] = (bf16_t)f2bf(w_up[m * 512 + h * 64 + cc]); WTa[cc * 72 + m] = (bf16_t)f2bf(a_up[m * 512 + h * 64 + cc]); }
            if (tid < 320) { const int cc = tid; const int col = cc < 64 ? h * 64 + cc : (cc < 128 ? 512 + h * 64 + cc - 64 : (cc < 192 ? 1024 + h * 64 + cc - 128 : 1536 + cc - 192)); MU[cc] = mu[col]; }
            p_kk4 = *(const f32x4*)(k_k + h * 64 + cg4); p_ka4 = *(const f32x4*)(k_a + h * 64 + cg4); p_rk4 = *(const f32x4*)(r_k + h * 64 + cg4);
            q_w0 = w0[h * 64 + 16 * (wv >> 1) + ln]; q_a0 = a0[h * 64 + 16 * (wv >> 1) + ln];
            last_h = h;
            __syncthreads();
        }
        if (!have_pf) { PRE_LOAD(u); }
#pragma unroll
        for (int it = 0; it < 3; ++it) {
            const int idx = tid + 512 * it;
            if (idx < 32 * 40) {
                const int tt = idx / 40, vv = idx - tt * 40, cc0 = 8 * vv;
                const u32x4 c4 = pc4[it], p4 = pp4[it];
                const f32x4 m0 = *(const LAS f32x4*)&MU[cc0], m1 = *(const LAS f32x4*)&MU[cc0 + 4];
                float cur[8], prv[8], val[8];
                cur[0] = bflo(c4.x); cur[1] = bfhi(c4.x); cur[2] = bflo(c4.y); cur[3] = bfhi(c4.y); cur[4] = bflo(c4.z); cur[5] = bfhi(c4.z); cur[6] = bflo(c4.w); cur[7] = bfhi(c4.w);
                prv[0] = bflo(p4.x); prv[1] = bfhi(p4.x); prv[2] = bflo(p4.y); prv[3] = bfhi(p4.y); prv[4] = bflo(p4.z); prv[5] = bfhi(p4.z); prv[6] = bflo(p4.w); prv[7] = bfhi(p4.w);
#pragma unroll
                for (int e = 0; e < 8; ++e) val[e] = cur[e] + (prv[e] - cur[e]) * (e < 4 ? m0[e & 3] : m1[e & 3]);
                if (vv < 24) {
#pragma unroll
                    for (int e = 0; e < 8; e += 2) { const unsigned w_ = pk2(val[e], val[e + 1]); val[e] = bflo(w_); val[e + 1] = bfhi(w_); }
                    LAS float* dst = (vv < 8 ? Rr : (vv < 16 ? Kk : Vv)) + tt * 64 + 8 * (vv & 7);
                    *(LAS f32x4*)dst = (f32x4){val[0], val[1], val[2], val[3]}; *(LAS f32x4*)(dst + 4) = (f32x4){val[4], val[5], val[6], val[7]};
                } else {
                    const int lr0 = 8 * (vv - 24);
                    LAS bf16_t* dst;
                    if (lr0 < 64) { dst = WDb + tt * 72 + lr0;
#pragma unroll
                        for (int e = 0; e < 8; ++e) { const float ex = __expf(2.f * val[e]); val[e] = 1.f - 2.f / (ex + 1.f); } }
                    else dst = ADb + tt * 72 + lr0 - 64;
                    u32x4 o; o.x = pk2(val[0], val[1]); o.y = pk2(val[2], val[3]); o.z = pk2(val[4], val[5]); o.w = pk2(val[6], val[7]);
                    *(LAS u32x4*)dst = o;
                }
            }
        }
        if (tid < 64) {
            const int tt = tid >> 1, vg = 2 * h + (tid & 1);
            const f32x4 m0 = *(const f32x4*)(mu + 1664 + 8 * vg), m1 = *(const f32x4*)(mu + 1664 + 8 * vg + 4);
            float gc[8], gp[8];
            gc[0] = bflo(gc4.x); gc[1] = bfhi(gc4.x); gc[2] = bflo(gc4.y); gc[3] = bfhi(gc4.y); gc[4] = bflo(gc4.z); gc[5] = bfhi(gc4.z); gc[6] = bflo(gc4.w); gc[7] = bfhi(gc4.w);
            gp[0] = bflo(gp4.x); gp[1] = bfhi(gp4.x); gp[2] = bflo(gp4.y); gp[3] = bfhi(gp4.y); gp[4] = bflo(gp4.z); gp[5] = bfhi(gp4.z); gp[6] = bflo(gp4.w); gp[7] = bfhi(gp4.w);
#pragma unroll
            for (int e = 0; e < 8; ++e) gc[e] = sigmoidf_(gc[e] + (gp[e] - gc[e]) * (e < 4 ? m0[e & 3] : m1[e & 3]));
            u32x4 o; o.x = pk2(gc[0], gc[1]); o.y = pk2(gc[2], gc[3]); o.z = pk2(gc[4], gc[5]); o.w = pk2(gc[6], gc[7]);
            *(u32x4*)(X.P + ((size_t)tp * 32 + tt) * LDP + COL_GS + 8 * vg) = o;
        }
        have_pf = false;
        if (u + X.G < 4096 && ((u + X.G) & 7) == h) { PRE_LOAD(u + X.G); have_pf = true; }
        LDS_BAR();
        {
            const int mt = wv & 1, nt = wv >> 1, chm = 16 * nt + ln;
            f32x4 cw_ = (f32x4){0.f, 0.f, 0.f, 0.f}, ca_ = cw_;
#pragma unroll
            for (int ks = 0; ks < 2; ++ks) {
                const bf16x8 xa = *(const LAS bf16x8*)&WDb[(16 * mt + ln) * 72 + ks * 32 + 8 * lg], xb = *(const LAS bf16x8*)&WTu[(16 * nt + ln) * 72 + ks * 32 + 8 * lg];
                cw_ = __builtin_amdgcn_mfma_f32_16x16x32_bf16(xa, xb, cw_, 0, 0, 0);
                const bf16x8 ya = *(const LAS bf16x8*)&ADb[(16 * mt + ln) * 72 + ks * 32 + 8 * lg], yb = *(const LAS bf16x8*)&WTa[(16 * nt + ln) * 72 + ks * 32 + 8 * lg];
                ca_ = __builtin_amdgcn_mfma_f32_16x16x32_bf16(ya, yb, ca_, 0, 0, 0);
            }
#pragma unroll
            for (int r = 0; r < 4; ++r) {
                const int tt = 16 * mt + 4 * lg + r;
                const float z = -(q_w0 + cw_[r]);
                const float sp = fmaxf(z, 0.f) + __logf(1.f + __expf(-fabsf(z)));
                const float e = __expf(-sp - 0.5f);
                W1[tt * 64 + chm] = bf2f((bf16_t)f2bf(-expm1f(-e)));
                AS[tt * 64 + chm] = bf2f((bf16_t)f2bf(sigmoidf_(q_a0 + ca_[r])));
            }
        }
        LDS_BAR();
        {
            const int tt = tid >> 4;
            const size_t row = (size_t)tp * 32 + tt;
            const f32x4 w1 = *(const LAS f32x4*)&W1[tt * 64 + cg4], a = *(const LAS f32x4*)&AS[tt * 64 + cg4];
            const f32x4 kraw = *(const LAS f32x4*)&Kk[tt * 64 + cg4], r = *(const LAS f32x4*)&Rr[tt * 64 + cg4], v = *(const LAS f32x4*)&Vv[tt * 64 + cg4];
            const f32x4 kk0 = kraw * p_kk4;
            const float inv = 1.f / sqrtf(fmaxf(red16((kk0.x * kk0.x + kk0.y * kk0.y) + (kk0.z * kk0.z + kk0.w * kk0.w)), 1e-24f));
            const f32x4 kk = kk0 * inv;
            const f32x4 kmod = kraw * (1.f + (a - 1.f) * p_ka4);
            const f32x4 bvec = kk * a, t1 = bvec * r, t2 = kmod * r, t3 = t2 * p_rk4;
            const float br = red16((t1.x + t1.y) + (t1.z + t1.w)), kr = red16((t2.x + t2.y) + (t2.z + t2.w)), bonus = red16((t3.x + t3.y) + (t3.z + t3.w));
            bf16_t* rp_ = X.P + row * LDP;
            u32x2 o;
            o.x = pk2(r.x, r.y); o.y = pk2(r.z, r.w); *(u32x2*)(rp_ + COL_PA + h * 64 + cg4) = o;
            o.x = pk2(kraw.x, kraw.y); o.y = pk2(kraw.z, kraw.w); *(u32x2*)(rp_ + COL_PA + 512 + h * 64 + cg4) = o;
            o.x = pk2(v.x, v.y); o.y = pk2(v.z, v.w); *(u32x2*)(rp_ + COL_PA + 1024 + h * 64 + cg4) = o;
            bf16_t* wa_ = (layer == 0) ? (bf16_t*)X.out + row * 2048 : rp_;
            o.x = pk2(w1.x, w1.y); o.y = pk2(w1.z, w1.w); *(u32x2*)(wa_ + h * 64 + cg4) = o;
            o.x = pk2(a.x, a.y); o.y = pk2(a.z, a.w); *(u32x2*)(wa_ + 512 + h * 64 + cg4) = o;
            if (cg4 == 0) *(f32x4*)(SCAL + (row * 8 + h) * 4) = (f32x4){inv, br, kr, bonus};
        }
        LDS_BAR();
    }
}

__device__ __forceinline__ void rwkv_task(const Ctx& X, LAS unsigned char* lds, int layer, int b, int h) {
    LAS bf16_t* GDb = (LAS bf16_t*)(lds + 66560);
    LAS bf16_t* WTg = (LAS bf16_t*)(lds + 75264);
    LAS float* BON = (LAS float*)(lds + 92672);
    const int tid = X.tid, lane = tid & 63;
    const bool helper = X.wave >= 4;
    const int ht = tid & 255;
    const float* mu = X.in[3] + layer * 1792;
    const float* g_up = X.in[8] + (size_t)layer * 128 * 512;
    const float* k_k = X.in[9] + layer * 512;  const float* k_a = X.in[10] + layer * 512;
    const float* gn_g = X.in[12] + layer * 512; const float* gn_b = X.in[13] + layer * 512;
    const float* SCAL = (const float*)(X.ws + WS_SCAL);
    const int tt_h = ht >> 4, cg4 = (ht & 15) * 4;
    const f32x4 p_kk = *(const f32x4*)(k_k + h * 64 + cg4), p_ka = *(const f32x4*)(k_a + h * 64 + cg4);
    const f32x4 p_gg = *(const f32x4*)(gn_g + h * 64 + cg4), p_gb = *(const f32x4*)(gn_b + h * 64 + cg4);
    const int gv8 = (ht & 15) * 8;
    const int nt = (ht >> 6), ln = lane & 15, lg = lane >> 4, chm = 16 * nt + ln;
    const int rp = ht >> 3, jg = ht & 7, i0 = 2 * rp;
    for (int idx = tid; idx < 128 * 64; idx += 512) { const int m = idx >> 6, cc = idx & 63; WTg[cc * 136 + m] = (bf16_t)f2bf(g_up[m * 512 + h * 64 + cc]); }
    f32x2 S0[4], S1[4];
#pragma unroll
    for (int j = 0; j < 4; ++j) { S0[j] = (f32x2){0.f, 0.f}; S1[j] = (f32x2){0.f, 0.f}; }
#if PROBE_SCAN2
    f32x2 T0[4], T1[4];
#pragma unroll
    for (int j = 0; j < 4; ++j) { T0[j] = (f32x2){0.f, 0.f}; T1[j] = (f32x2){0.f, 0.f}; }
#endif
    __syncthreads();

#define RW_ARR(bufi, k) ((LAS float*)(lds + (bufi) * RW_BUF + (k) * 4096))
#define RW_SC(bufi) ((LAS float*)(lds + (bufi) * RW_BUF + 32768))
#define RW_LOAD(chk, L) do { const size_t row_ = (size_t)b * SEQ + (chk) * RW_TS + tt_h; const bf16_t* rp_ = X.P + row_ * LDP; \
        l_r##L = *(const u32x2*)(rp_ + COL_PA + h * 64 + cg4); l_k##L = *(const u32x2*)(rp_ + COL_PA + 512 + h * 64 + cg4); l_v##L = *(const u32x2*)(rp_ + COL_PA + 1024 + h * 64 + cg4); \
        { const bf16_t* wa_ = (layer == 0) ? (const bf16_t*)X.out + row_ * 2048 : rp_; l_w##L = *(const u32x2*)(wa_ + h * 64 + cg4); l_a##L = *(const u32x2*)(wa_ + 512 + h * 64 + cg4); } l_s##L = *(const f32x4*)(SCAL + (row_ * 8 + h) * 4); \
        l_gc##L = *(const u32x4*)(rp_ + COL_GS + gv8); } while (0)
    u32x2 l_rA, l_kA, l_vA, l_wA, l_aA; f32x4 l_sA; u32x4 l_gcA;
    u32x2 l_rB, l_kB, l_vB, l_wB, l_aB; f32x4 l_sB; u32x4 l_gcB;
    l_rA = l_kA = l_vA = l_wA = l_aA = l_rB = l_kB = l_vB = l_wB = l_aB = (u32x2){0u, 0u}; l_sA = l_sB = (f32x4){0.f, 0.f, 0.f, 0.f}; l_gcA = l_gcB = (u32x4){0u, 0u, 0u, 0u};
    if (helper) { RW_LOAD(0, A); RW_LOAD(1, B); }

#pragma unroll 1
    for (int i0_ = -1; i0_ < RW_NCH; i0_ += 2) {
        { const int i = i0_;

        const int bufn = (i + 1) & 1, bufc = i & 1;
        if (helper) {
            const bool do_prep = (i + 1 < RW_NCH);
            if (i >= 0) {
                LAS float* Gg = RW_ARR(bufc, 6);
                f32x4 cg_ = (f32x4){0.f, 0.f, 0.f, 0.f};
#pragma unroll
                for (int ks = 0; ks < 4; ++ks) {
                    const bf16x8 za = *(const LAS bf16x8*)&GDb[bufc * 2176 + ln * 136 + ks * 32 + 8 * lg], zb = *(const LAS bf16x8*)&WTg[(16 * nt + ln) * 136 + ks * 32 + 8 * lg];
                    cg_ = __builtin_amdgcn_mfma_f32_16x16x32_bf16(za, zb, cg_, 0, 0, 0);
                }
#pragma unroll
                for (int r = 0; r < 4; ++r) Gg[(4 * lg + r) * 64 + chm] = cg_[r];
            }
            if (i >= 1) {
                LAS float* Yy = RW_ARR(bufn, 7); LAS float* Gg = RW_ARR(bufn, 6); LAS float* Vv = RW_ARR(bufn, 5); LAS float* SC = RW_SC(bufn);
                const f32x4 y = *(const LAS f32x4*)&Yy[tt_h * 64 + cg4], gg = *(const LAS f32x4*)&Gg[tt_h * 64 + cg4], vv = *(const LAS f32x4*)&Vv[tt_h * 64 + cg4];
                const float bonus = BON[((i - 1) % 3) * 16 + tt_h];
                const float mean = red16((y.x + y.y) + (y.z + y.w)) * (1.f / 64.f);
                const f32x4 d = y - mean;
                const float var = red16((d.x * d.x + d.y * d.y) + (d.z * d.z + d.w * d.w)) * (1.f / 64.f);
                const float rs = 1.f / sqrtf(var + 64e-5f);
                const f32x4 o = (d * rs * p_gg + p_gb + vv * bonus) * gg;
                u32x2 w; w.x = pk2(o.x, o.y); w.y = pk2(o.z, o.w);
                *(u32x2*)(X.P + ((size_t)b * SEQ + (i - 1) * RW_TS + tt_h) * LDP + COL_YA + h * 64 + cg4) = w;
            }
            if (do_prep) {
                const f32x4 r = (f32x4){bflo(l_rA.x), bfhi(l_rA.x), bflo(l_rA.y), bfhi(l_rA.y)}, k = (f32x4){bflo(l_kA.x), bfhi(l_kA.x), bflo(l_kA.y), bfhi(l_kA.y)};
                const f32x4 v = (f32x4){bflo(l_vA.x), bfhi(l_vA.x), bflo(l_vA.y), bfhi(l_vA.y)}, w1 = (f32x4){bflo(l_wA.x), bfhi(l_wA.x), bflo(l_wA.y), bfhi(l_wA.y)};
                const f32x4 a = (f32x4){bflo(l_aA.x), bfhi(l_aA.x), bflo(l_aA.y), bfhi(l_aA.y)};
                const f32x4 kk = k * p_kk * l_sA.x;
                const f32x4 decay = 1.f - w1;
                *(LAS f32x4*)&RW_ARR(bufn, 0)[tt_h * 64 + cg4] = -kk;
                *(LAS f32x4*)&RW_ARR(bufn, 1)[tt_h * 64 + cg4] = decay * r;
                *(LAS f32x4*)&RW_ARR(bufn, 2)[tt_h * 64 + cg4] = decay;
                *(LAS f32x4*)&RW_ARR(bufn, 3)[tt_h * 64 + cg4] = kk * a;
                *(LAS f32x4*)&RW_ARR(bufn, 4)[tt_h * 64 + cg4] = k * (1.f + (a - 1.f) * p_ka);
                *(LAS f32x4*)&RW_ARR(bufn, 5)[tt_h * 64 + cg4] = v;
                if (cg4 == 0) { LAS float* SC = RW_SC(bufn); SC[tt_h * 4 + 0] = l_sA.y; SC[tt_h * 4 + 1] = l_sA.z; BON[((i + 1) % 3) * 16 + tt_h] = l_sA.w; }
                *(LAS u32x4*)&GDb[bufn * 2176 + tt_h * 136 + gv8] = l_gcA;
            }
            if (i + 3 < RW_NCH) RW_LOAD(i + 3, A);
            LDS_BAR();
        } else {
            LAS float* A_ = RW_ARR(bufc, 0); LAS float* WR = RW_ARR(bufc, 1); LAS float* Wd = RW_ARR(bufc, 2); LAS float* Bv = RW_ARR(bufc, 3);
            LAS float* Kk = RW_ARR(bufc, 4); LAS float* Vv = RW_ARR(bufc, 5); LAS float* Yy = RW_ARR(bufc, 7); LAS float* SC = RW_SC(bufc);
#pragma unroll 1
            for (int q4 = 0; q4 < 4; ++q4) {
                if (i >= 0) {
                    float yv[8];
#pragma unroll
                    for (int s4 = 0; s4 < 4; ++s4) {
                        const int tt = 4 * q4 + s4;
                        const f32x4 a_lo = *(const LAS f32x4*)&A_[tt * 64 + 8 * jg], a_hi = *(const LAS f32x4*)&A_[tt * 64 + 8 * jg + 4];
                        const f32x4 r_lo = *(const LAS f32x4*)&WR[tt * 64 + 8 * jg], r_hi = *(const LAS f32x4*)&WR[tt * 64 + 8 * jg + 4];
                        const f32x4 w_lo = *(const LAS f32x4*)&Wd[tt * 64 + 8 * jg], w_hi = *(const LAS f32x4*)&Wd[tt * 64 + 8 * jg + 4];
                        const f32x4 b_lo = *(const LAS f32x4*)&Bv[tt * 64 + 8 * jg], b_hi = *(const LAS f32x4*)&Bv[tt * 64 + 8 * jg + 4];
                        const f32x4 k_lo = *(const LAS f32x4*)&Kk[tt * 64 + 8 * jg], k_hi = *(const LAS f32x4*)&Kk[tt * 64 + 8 * jg + 4];
                        const f32x2 vv = *(const LAS f32x2*)&Vv[tt * 64 + i0];
                        const f32x2 sc = *(const LAS f32x2*)&SC[tt * 4];
                        const f32x2 av[4] = {{a_lo.x, a_lo.y}, {a_lo.z, a_lo.w}, {a_hi.x, a_hi.y}, {a_hi.z, a_hi.w}};
                        const f32x2 rv[4] = {{r_lo.x, r_lo.y}, {r_lo.z, r_lo.w}, {r_hi.x, r_hi.y}, {r_hi.z, r_hi.w}};
                        const f32x2 wv[4] = {{w_lo.x, w_lo.y}, {w_lo.z, w_lo.w}, {w_hi.x, w_hi.y}, {w_hi.z, w_hi.w}};
                        const f32x2 bv[4] = {{b_lo.x, b_lo.y}, {b_lo.z, b_lo.w}, {b_hi.x, b_hi.y}, {b_hi.z, b_hi.w}};
                        const f32x2 kv[4] = {{k_lo.x, k_lo.y}, {k_lo.z, k_lo.w}, {k_hi.x, k_hi.y}, {k_hi.z, k_hi.w}};
                        f32x2 e10 = S0[0] * av[0], e20 = S0[0] * rv[0], e11 = S1[0] * av[0], e21 = S1[0] * rv[0];
#pragma unroll
                        for (int j = 1; j < 4; ++j) { e10 += S0[j] * av[j]; e20 += S0[j] * rv[j]; e11 += S1[j] * av[j]; e21 += S1[j] * rv[j]; }
                        const float d10 = red8(e10.x + e10.y), d11 = red8(e11.x + e11.y);
                        yv[2 * s4] = (e20.x + e20.y) + (jg == 0 ? d10 * sc.x + vv.x * sc.y : 0.f); yv[2 * s4 + 1] = (e21.x + e21.y) + (jg == 0 ? d11 * sc.x + vv.y * sc.y : 0.f);
                        const f32x2 d10v = (f32x2){d10, d10}, d11v = (f32x2){d11, d11}, v0v = (f32x2){vv.x, vv.x}, v1v = (f32x2){vv.y, vv.y};
#pragma unroll
                        for (int j = 0; j < 4; ++j) { S0[j] = S0[j] * wv[j] + (d10v * bv[j] + v0v * kv[j]); S1[j] = S1[j] * wv[j] + (d11v * bv[j] + v1v * kv[j]); }
                    }
                    {
                        const bool t2 = (jg & 4) != 0, t1 = (jg & 2) != 0, t0 = (jg & 1) != 0;
#pragma unroll
                        for (int q = 0; q < 4; ++q) { const float keep = t2 ? yv[q + 4] : yv[q], send = t2 ? yv[q] : yv[q + 4]; yv[q] = keep + dpp_mov<0x141>(send); }
#pragma unroll
                        for (int q = 0; q < 2; ++q) { const float keep = t1 ? yv[q + 2] : yv[q], send = t1 ? yv[q] : yv[q + 2]; yv[q] = keep + dpp_mov<0x4E>(send); }
                        { const float keep = t0 ? yv[1] : yv[0], send = t0 ? yv[0] : yv[1]; yv[0] = keep + dpp_mov<0xB1>(send); }
                        Yy[(4 * q4 + (jg >> 1)) * 64 + i0 + (jg & 1)] = yv[0];
                    }

#if PROBE_SCAN2
                    {
#pragma unroll
                    for (int s4 = 0; s4 < 4; ++s4) {
                        const int tt = 4 * q4 + s4;
                        const f32x4 a_lo = *(const LAS f32x4*)&A_[tt * 64 + 8 * jg], a_hi = *(const LAS f32x4*)&A_[tt * 64 + 8 * jg + 4];
                        const f32x4 r_lo = *(const LAS f32x4*)&WR[tt * 64 + 8 * jg], r_hi = *(const LAS f32x4*)&WR[tt * 64 + 8 * jg + 4];
                        const f32x4 w_lo = *(const LAS f32x4*)&Wd[tt * 64 + 8 * jg], w_hi = *(const LAS f32x4*)&Wd[tt * 64 + 8 * jg + 4];
                        const f32x4 b_lo = *(const LAS f32x4*)&Bv[tt * 64 + 8 * jg], b_hi = *(const LAS f32x4*)&Bv[tt * 64 + 8 * jg + 4];
                        const f32x4 k_lo = *(const LAS f32x4*)&Kk[tt * 64 + 8 * jg], k_hi = *(const LAS f32x4*)&Kk[tt * 64 + 8 * jg + 4];
                        const f32x2 vv = *(const LAS f32x2*)&Vv[tt * 64 + i0];
                        const f32x2 av[4] = {{a_lo.x, a_lo.y}, {a_lo.z, a_lo.w}, {a_hi.x, a_hi.y}, {a_hi.z, a_hi.w}};
                        const f32x2 rv[4] = {{r_lo.x, r_lo.y}, {r_lo.z, r_lo.w}, {r_hi.x, r_hi.y}, {r_hi.z, r_hi.w}};
                        const f32x2 wv[4] = {{w_lo.x, w_lo.y}, {w_lo.z, w_lo.w}, {w_hi.x, w_hi.y}, {w_hi.z, w_hi.w}};
                        const f32x2 bv[4] = {{b_lo.x, b_lo.y}, {b_lo.z, b_lo.w}, {b_hi.x, b_hi.y}, {b_hi.z, b_hi.w}};
                        const f32x2 kv[4] = {{k_lo.x, k_lo.y}, {k_lo.z, k_lo.w}, {k_hi.x, k_hi.y}, {k_hi.z, k_hi.w}};
                        f32x2 e10 = T0[0] * av[0], e20 = T0[0] * rv[0], e11 = T1[0] * av[0], e21 = T1[0] * rv[0];
#pragma unroll
                        for (int j = 1; j < 4; ++j) { e10 += T0[j] * av[j]; e20 += T0[j] * rv[j]; e11 += T1[j] * av[j]; e21 += T1[j] * rv[j]; }
                        const float d10 = red8(e10.x + e10.y), d20 = red8(e20.x + e20.y), d11 = red8(e11.x + e11.y), d21 = red8(e21.x + e21.y);
                        const f32x2 d10v = (f32x2){d10 + d20, d10}, d11v = (f32x2){d11 + d21, d11}, v0v = (f32x2){vv.x, vv.x}, v1v = (f32x2){vv.y, vv.y};
#pragma unroll
                        for (int j = 0; j < 4; ++j) { T0[j] = T0[j] * wv[j] + (d10v * bv[j] + v0v * kv[j]); T1[j] = T1[j] * wv[j] + (d11v * bv[j] + v1v * kv[j]); }
                    }
                    }
#endif
                }
                if (q4 == 3) LDS_BAR();
            }
        }
            }
        if (i0_ + 1 < RW_NCH) { const int i = i0_ + 1;

        const int bufn = (i + 1) & 1, bufc = i & 1;
        if (helper) {
            const bool do_prep = (i + 1 < RW_NCH);
            if (i >= 0) {
                LAS float* Gg = RW_ARR(bufc, 6);
                f32x4 cg_ = (f32x4){0.f, 0.f, 0.f, 0.f};
#pragma unroll
                for (int ks = 0; ks < 4; ++ks) {
                    const bf16x8 za = *(const LAS bf16x8*)&GDb[bufc * 2176 + ln * 136 + ks * 32 + 8 * lg], zb = *(const LAS bf16x8*)&WTg[(16 * nt + ln) * 136 + ks * 32 + 8 * lg];
                    cg_ = __builtin_amdgcn_mfma_f32_16x16x32_bf16(za, zb, cg_, 0, 0, 0);
                }
#pragma unroll
                for (int r = 0; r < 4; ++r) Gg[(4 * lg + r) * 64 + chm] = cg_[r];
            }
            if (i >= 1) {
                LAS float* Yy = RW_ARR(bufn, 7); LAS float* Gg = RW_ARR(bufn, 6); LAS float* Vv = RW_ARR(bufn, 5); LAS float* SC = RW_SC(bufn);
                const f32x4 y = *(const LAS f32x4*)&Yy[tt_h * 64 + cg4], gg = *(const LAS f32x4*)&Gg[tt_h * 64 + cg4], vv = *(const LAS f32x4*)&Vv[tt_h * 64 + cg4];
                const float bonus = BON[((i - 1) % 3) * 16 + tt_h];
                const float mean = red16((y.x + y.y) + (y.z + y.w)) * (1.f / 64.f);
                const f32x4 d = y - mean;
                const float var = red16((d.x * d.x + d.y * d.y) + (d.z * d.z + d.w * d.w)) * (1.f / 64.f);
                const float rs = 1.f / sqrtf(var + 64e-5f);
                const f32x4 o = (d * rs * p_gg + p_gb + vv * bonus) * gg;
                u32x2 w; w.x = pk2(o.x, o.y); w.y = pk2(o.z, o.w);
                *(u32x2*)(X.P + ((size_t)b * SEQ + (i - 1) * RW_TS + tt_h) * LDP + COL_YA + h * 64 + cg4) = w;
            }
            if (do_prep) {
                const f32x4 r = (f32x4){bflo(l_rB.x), bfhi(l_rB.x), bflo(l_rB.y), bfhi(l_rB.y)}, k = (f32x4){bflo(l_kB.x), bfhi(l_kB.x), bflo(l_kB.y), bfhi(l_kB.y)};
                const f32x4 v = (f32x4){bflo(l_vB.x), bfhi(l_vB.x), bflo(l_vB.y), bfhi(l_vB.y)}, w1 = (f32x4){bflo(l_wB.x), bfhi(l_wB.x), bflo(l_wB.y), bfhi(l_wB.y)};
                const f32x4 a = (f32x4){bflo(l_aB.x), bfhi(l_aB.x), bflo(l_aB.y), bfhi(l_aB.y)};
                const f32x4 kk = k * p_kk * l_sB.x;
                const f32x4 decay = 1.f - w1;
                *(LAS f32x4*)&RW_ARR(bufn, 0)[tt_h * 64 + cg4] = -kk;
                *(LAS f32x4*)&RW_ARR(bufn, 1)[tt_h * 64 + cg4] = decay * r;
                *(LAS f32x4*)&RW_ARR(bufn, 2)[tt_h * 64 + cg4] = decay;
                *(LAS f32x4*)&RW_ARR(bufn, 3)[tt_h * 64 + cg4] = kk * a;
                *(LAS f32x4*)&RW_ARR(bufn, 4)[tt_h * 64 + cg4] = k * (1.f + (a - 1.f) * p_ka);
                *(LAS f32x4*)&RW_ARR(bufn, 5)[tt_h * 64 + cg4] = v;
                if (cg4 == 0) { LAS float* SC = RW_SC(bufn); SC[tt_h * 4 + 0] = l_sB.y; SC[tt_h * 4 + 1] = l_sB.z; BON[((i + 1) % 3) * 16 + tt_h] = l_sB.w; }
                *(LAS u32x4*)&GDb[bufn * 2176 + tt_h * 136 + gv8] = l_gcB;
            }
            if (i + 3 < RW_NCH) RW_LOAD(i + 3, B);
            LDS_BAR();
        } else {
            LAS float* A_ = RW_ARR(bufc, 0); LAS float* WR = RW_ARR(bufc, 1); LAS float* Wd = RW_ARR(bufc, 2); LAS float* Bv = RW_ARR(bufc, 3);
            LAS float* Kk = RW_ARR(bufc, 4); LAS float* Vv = RW_ARR(bufc, 5); LAS float* Yy = RW_ARR(bufc, 7); LAS float* SC = RW_SC(bufc);
#pragma unroll 1
            for (int q4 = 0; q4 < 4; ++q4) {
                if (i >= 0) {
                    float yv[8];
#pragma unroll
                    for (int s4 = 0; s4 < 4; ++s4) {
                        const int tt = 4 * q4 + s4;
                        const f32x4 a_lo = *(const LAS f32x4*)&A_[tt * 64 + 8 * jg], a_hi = *(const LAS f32x4*)&A_[tt * 64 + 8 * jg + 4];
                        const f32x4 r_lo = *(const LAS f32x4*)&WR[tt * 64 + 8 * jg], r_hi = *(const LAS f32x4*)&WR[tt * 64 + 8 * jg + 4];
                        const f32x4 w_lo = *(const LAS f32x4*)&Wd[tt * 64 + 8 * jg], w_hi = *(const LAS f32x4*)&Wd[tt * 64 + 8 * jg + 4];
                        const f32x4 b_lo = *(const LAS f32x4*)&Bv[tt * 64 + 8 * jg], b_hi = *(const LAS f32x4*)&Bv[tt * 64 + 8 * jg + 4];
                        const f32x4 k_lo = *(const LAS f32x4*)&Kk[tt * 64 + 8 * jg], k_hi = *(const LAS f32x4*)&Kk[tt * 64 + 8 * jg + 4];
                        const f32x2 vv = *(const LAS f32x2*)&Vv[tt * 64 + i0];
                        const f32x2 sc = *(const LAS f32x2*)&SC[tt * 4];
                        const f32x2 av[4] = {{a_lo.x, a_lo.y}, {a_lo.z, a_lo.w}, {a_hi.x, a_hi.y}, {a_hi.z, a_hi.w}};
                        const f32x2 rv[4] = {{r_lo.x, r_lo.y}, {r_lo.z, r_lo.w}, {r_hi.x, r_hi.y}, {r_hi.z, r_hi.w}};
                        const f32x2 wv[4] = {{w_lo.x, w_lo.y}, {w_lo.z, w_lo.w}, {w_hi.x, w_hi.y}, {w_hi.z, w_hi.w}};
                        const f32x2 bv[4] = {{b_lo.x, b_lo.y}, {b_lo.z, b_lo.w}, {b_hi.x, b_hi.y}, {b_hi.z, b_hi.w}};
                        const f32x2 kv[4] = {{k_lo.x, k_lo.y}, {k_lo.z, k_lo.w}, {k_hi.x, k_hi.y}, {k_hi.z, k_hi.w}};
                        f32x2 e10 = S0[0] * av[0], e20 = S0[0] * rv[0], e11 = S1[0] * av[0], e21 = S1[0] * rv[0];
#pragma unroll
                        for (int j = 1; j < 4; ++j) { e10 += S0[j] * av[j]; e20 += S0[j] * rv[j]; e11 += S1[j] * av[j]; e21 += S1[j] * rv[j]; }
                        const float d10 = red8(e10.x + e10.y), d11 = red8(e11.x + e11.y);
                        yv[2 * s4] = (e20.x + e20.y) + (jg == 0 ? d10 * sc.x + vv.x * sc.y : 0.f); yv[2 * s4 + 1] = (e21.x + e21.y) + (jg == 0 ? d11 * sc.x + vv.y * sc.y : 0.f);
                        const f32x2 d10v = (f32x2){d10, d10}, d11v = (f32x2){d11, d11}, v0v = (f32x2){vv.x, vv.x}, v1v = (f32x2){vv.y, vv.y};
#pragma unroll
                        for (int j = 0; j < 4; ++j) { S0[j] = S0[j] * wv[j] + (d10v * bv[j] + v0v * kv[j]); S1[j] = S1[j] * wv[j] + (d11v * bv[j] + v1v * kv[j]); }
                    }
                    {
                        const bool t2 = (jg & 4) != 0, t1 = (jg & 2) != 0, t0 = (jg & 1) != 0;
#pragma unroll
                        for (int q = 0; q < 4; ++q) { const float keep = t2 ? yv[q + 4] : yv[q], send = t2 ? yv[q] : yv[q + 4]; yv[q] = keep + dpp_mov<0x141>(send); }
#pragma unroll
                        for (int q = 0; q < 2; ++q) { const float keep = t1 ? yv[q + 2] : yv[q], send = t1 ? yv[q] : yv[q + 2]; yv[q] = keep + dpp_mov<0x4E>(send); }
                        { const float keep = t0 ? yv[1] : yv[0], send = t0 ? yv[0] : yv[1]; yv[0] = keep + dpp_mov<0xB1>(send); }
                        Yy[(4 * q4 + (jg >> 1)) * 64 + i0 + (jg & 1)] = yv[0];
                    }

#if PROBE_SCAN2
                    {
#pragma unroll
                    for (int s4 = 0; s4 < 4; ++s4) {
                        const int tt = 4 * q4 + s4;
                        const f32x4 a_lo = *(const LAS f32x4*)&A_[tt * 64 + 8 * jg], a_hi = *(const LAS f32x4*)&A_[tt * 64 + 8 * jg + 4];
                        const f32x4 r_lo = *(const LAS f32x4*)&WR[tt * 64 + 8 * jg], r_hi = *(const LAS f32x4*)&WR[tt * 64 + 8 * jg + 4];
                        const f32x4 w_lo = *(const LAS f32x4*)&Wd[tt * 64 + 8 * jg], w_hi = *(const LAS f32x4*)&Wd[tt * 64 + 8 * jg + 4];
                        const f32x4 b_lo = *(const LAS f32x4*)&Bv[tt * 64 + 8 * jg], b_hi = *(const LAS f32x4*)&Bv[tt * 64 + 8 * jg + 4];
                        const f32x4 k_lo = *(const LAS f32x4*)&Kk[tt * 64 + 8 * jg], k_hi = *(const LAS f32x4*)&Kk[tt * 64 + 8 * jg + 4];
                        const f32x2 vv = *(const LAS f32x2*)&Vv[tt * 64 + i0];
                        const f32x2 av[4] = {{a_lo.x, a_lo.y}, {a_lo.z, a_lo.w}, {a_hi.x, a_hi.y}, {a_hi.z, a_hi.w}};
                        const f32x2 rv[4] = {{r_lo.x, r_lo.y}, {r_lo.z, r_lo.w}, {r_hi.x, r_hi.y}, {r_hi.z, r_hi.w}};
                        const f32x2 wv[4] = {{w_lo.x, w_lo.y}, {w_lo.z, w_lo.w}, {w_hi.x, w_hi.y}, {w_hi.z, w_hi.w}};
                        const f32x2 bv[4] = {{b_lo.x, b_lo.y}, {b_lo.z, b_lo.w}, {b_hi.x, b_hi.y}, {b_hi.z, b_hi.w}};
                        const f32x2 kv[4] = {{k_lo.x, k_lo.y}, {k_lo.z, k_lo.w}, {k_hi.x, k_hi.y}, {k_hi.z, k_hi.w}};
                        f32x2 e10 = T0[0] * av[0], e20 = T0[0] * rv[0], e11 = T1[0] * av[0], e21 = T1[0] * rv[0];
#pragma unroll
                        for (int j = 1; j < 4; ++j) { e10 += T0[j] * av[j]; e20 += T0[j] * rv[j]; e11 += T1[j] * av[j]; e21 += T1[j] * rv[j]; }
                        const float d10 = red8(e10.x + e10.y), d20 = red8(e20.x + e20.y), d11 = red8(e11.x + e11.y), d21 = red8(e21.x + e21.y);
                        const f32x2 d10v = (f32x2){d10 + d20, d10}, d11v = (f32x2){d11 + d21, d11}, v0v = (f32x2){vv.x, vv.x}, v1v = (f32x2){vv.y, vv.y};
#pragma unroll
                        for (int j = 0; j < 4; ++j) { T0[j] = T0[j] * wv[j] + (d10v * bv[j] + v0v * kv[j]); T1[j] = T1[j] * wv[j] + (d11v * bv[j] + v1v * kv[j]); }
                    }
                    }
#endif
                }
                if (q4 == 3) LDS_BAR();
            }
        }
            }
    }
    if (helper) {
        const int bufl = (RW_NCH - 1) & 1;
        LAS float* Yy = RW_ARR(bufl, 7); LAS float* Gg = RW_ARR(bufl, 6); LAS float* Vv = RW_ARR(bufl, 5); LAS float* SC = RW_SC(bufl);
        const f32x4 y = *(const LAS f32x4*)&Yy[tt_h * 64 + cg4], gg = *(const LAS f32x4*)&Gg[tt_h * 64 + cg4], vv = *(const LAS f32x4*)&Vv[tt_h * 64 + cg4];
        const float bonus = BON[((RW_NCH - 1) % 3) * 16 + tt_h];
        const float mean = red16((y.x + y.y) + (y.z + y.w)) * (1.f / 64.f);
        const f32x4 d = y - mean;
        const float var = red16((d.x * d.x + d.y * d.y) + (d.z * d.z + d.w * d.w)) * (1.f / 64.f);
        const float rs = 1.f / sqrtf(var + 64e-5f);
        const f32x4 o = (d * rs * p_gg + p_gb + vv * bonus) * gg;
        u32x2 w; w.x = pk2(o.x, o.y); w.y = pk2(o.z, o.w);
        *(u32x2*)(X.P + ((size_t)b * SEQ + (RW_NCH - 1) * RW_TS + tt_h) * LDP + COL_YA + h * 64 + cg4) = w;
    }
    __syncthreads();
#undef RW_ARR
#undef RW_SC
#undef RW_LOAD
}

__device__ __forceinline__ void hgrn_task(const Ctx& X, LAS unsigned char* lds, int layer, int b, int h, int vh) {
    LAS float* F = (LAS float*)(lds); LAS float* Q = (LAS float*)(lds + 16384); LAS float* Vv = (LAS float*)(lds + 32768); LAS float* O = (LAS float*)(lds + 40960);
    LAS float* LB = (LAS float*)(lds + 49152);
    const int tid = X.tid;
    const float* lbl = X.in[14];
    const int rp = tid >> 4, dg = tid & 15, v0 = 2 * rp;
    if (tid < 128) LB[tid] = (layer > 0) ? 1.f / (1.f + __expf(lbl[h * 128 + tid] - lbl[512 + h * 128 + tid])) : 0.f;
    f32x2 S0[4], S1[4];
#pragma unroll
    for (int j = 0; j < 4; ++j) { S0[j] = (f32x2){0.f, 0.f}; S1[j] = (f32x2){0.f, 0.f}; }
#define HG_LOAD(chk) do { _Pragma("unroll") for (int it = 0; it < 3; ++it) { const int idx = tid + 512 * it; raw[it] = (u32x4){0u, 0u, 0u, 0u}; \
        if (idx < 32 * 40) { const int tt = idx / 40, vv = idx - tt * 40; \
            const int col = vv < 16 ? 512 + h * 128 + 8 * vv : (vv < 32 ? h * 128 + 8 * (vv - 16) : 1024 + h * 128 + vh * 64 + 8 * (vv - 32)); \
            raw[it] = *(const u32x4*)(X.P + ((size_t)b * SEQ + (chk) * 32 + tt) * LDP + COL_PB + col); } } } while (0)
    u32x4 raw[3];
    HG_LOAD(0);
    __syncthreads();
#pragma unroll 1
    for (int ch = 0; ch < SEQ / 32; ++ch) {
        const int t0 = ch * 32;
#pragma unroll
        for (int it = 0; it < 3; ++it) {
            const int idx = tid + 512 * it;
            if (idx < 32 * 40) {
                const int tt = idx / 40, vv = idx - tt * 40;
                float x[8];
                x[0] = bflo(raw[it].x); x[1] = bfhi(raw[it].x); x[2] = bflo(raw[it].y); x[3] = bfhi(raw[it].y);
                x[4] = bflo(raw[it].z); x[5] = bfhi(raw[it].z); x[6] = bflo(raw[it].w); x[7] = bfhi(raw[it].w);
                LAS float* dst;
                if (vv < 16) {
                    dst = F + tt * 128 + 8 * vv;
#pragma unroll
                    for (int e = 0; e < 8; ++e) { const float lb = LB[8 * vv + e]; x[e] = lb + (1.f - lb) * sigmoidf_(x[e]); }
                } else if (vv < 32) dst = Q + tt * 128 + 8 * (vv - 16);
                else dst = Vv + tt * 64 + 8 * (vv - 32);
                *(LAS f32x4*)dst = (f32x4){x[0], x[1], x[2], x[3]}; *(LAS f32x4*)(dst + 4) = (f32x4){x[4], x[5], x[6], x[7]};
            }
        }
        if (ch + 1 < SEQ / 32) HG_LOAD(ch + 1);
        LDS_BAR();
#pragma unroll 1
        for (int g8 = 0; g8 < 4; ++g8) {
            float val[16];
#pragma unroll
            for (int s8 = 0; s8 < 8; ++s8) {
                const int tt = 8 * g8 + s8;
                const f32x4 f_lo = *(const LAS f32x4*)&F[tt * 128 + 8 * dg], f_hi = *(const LAS f32x4*)&F[tt * 128 + 8 * dg + 4];
                const f32x4 q_lo = *(const LAS f32x4*)&Q[tt * 128 + 8 * dg], q_hi = *(const LAS f32x4*)&Q[tt * 128 + 8 * dg + 4];
                const f32x2 vv = *(const LAS f32x2*)&Vv[tt * 64 + v0];
                const f32x2 f2[4] = {{f_lo.x, f_lo.y}, {f_lo.z, f_lo.w}, {f_hi.x, f_hi.y}, {f_hi.z, f_hi.w}};
                const f32x2 q2[4] = {{q_lo.x, q_lo.y}, {q_lo.z, q_lo.w}, {q_hi.x, q_hi.y}, {q_hi.z, q_hi.w}};
                const f32x2 v0v = (f32x2){vv.x, vv.x}, v1v = (f32x2){vv.y, vv.y};
                f32x2 a0 = (f32x2){0.f, 0.f}, a1 = (f32x2){0.f, 0.f};
#pragma unroll
                for (int j = 0; j < 4; ++j) {
                    S0[j] = v0v + f2[j] * (S0[j] - v0v); S1[j] = v1v + f2[j] * (S1[j] - v1v);
                    a0 += q2[j] * S0[j]; a1 += q2[j] * S1[j];
                }
                val[2 * s8] = a0.x + a0.y; val[2 * s8 + 1] = a1.x + a1.y;
            }
            const bool b3 = (dg & 8) != 0, b2 = (dg & 4) != 0, b1 = (dg & 2) != 0, b0 = (dg & 1) != 0;
#pragma unroll
            for (int i = 0; i < 8; ++i) { const float keep = b3 ? val[i + 8] : val[i], send = b3 ? val[i] : val[i + 8]; val[i] = keep + dpp_mov<0x140>(send); }
#pragma unroll
            for (int i = 0; i < 4; ++i) { const float keep = b2 ? val[i + 4] : val[i], send = b2 ? val[i] : val[i + 4]; val[i] = keep + dpp_mov<0x141>(send); }
#pragma unroll
            for (int i = 0; i < 2; ++i) { const float keep = b1 ? val[i + 2] : val[i], send = b1 ? val[i] : val[i + 2]; val[i] = keep + dpp_mov<0x4E>(send); }
            { const float keep = b0 ? val[1] : val[0], send = b0 ? val[0] : val[1]; val[0] = keep + dpp_mov<0xB1>(send); }
            O[(8 * g8 + (dg >> 1)) * 64 + v0 + (dg & 1)] = val[0];
        }
        LDS_BAR();
        if (tid < 256) {
            const int tt = tid >> 3, v8 = (tid & 7) * 8;
            const f32x4 a = *(const LAS f32x4*)&O[tt * 64 + v8], c4 = *(const LAS f32x4*)&O[tt * 64 + v8 + 4];
            u32x4 o; o.x = pk2(a.x, a.y); o.y = pk2(a.z, a.w); o.z = pk2(c4.x, c4.y); o.w = pk2(c4.z, c4.w);
            *(u32x4*)(X.P + ((size_t)b * SEQ + t0 + tt) * LDP + COL_YB + h * 128 + vh * 64 + v8) = o;
        }
    }
#undef HG_LOAD
    __syncthreads();
}

__device__ __forceinline__ unsigned f2ord(float f) { const unsigned u = __builtin_bit_cast(unsigned, f); return (u & 0x80000000u) ? ~u : (u | 0x80000000u); }

__device__ __forceinline__ void dsa_tile(const Ctx& X, LAS unsigned char* lds, int b, int q0) {
    LAS float* sc = (LAS float*)lds;
    LAS unsigned* MASK = (LAS unsigned*)(lds + MASK_OFF);
    const int lane = X.lane, w = X.wave, n = lane & 15, g = lane >> 4;
    const bf16_t* Pb = X.P + (size_t)b * SEQ * LDP;
#pragma unroll 1
    for (int sub = 0; sub < 4; ++sub) {
        const int qs = q0 + 16 * sub;
        {
            bf16x8 bq[4][2]; float wi[4];
            const bf16_t* qrow = Pb + (size_t)(qs + n) * LDP;
#pragma unroll
            for (int hh = 0; hh < 4; ++hh) {
#pragma unroll
                for (int ks = 0; ks < 2; ++ks) bq[hh][ks] = *(const bf16x8*)(qrow + C_QI + hh * 64 + ks * 32 + 8 * g);
                wi[hh] = bf2f(qrow[C_WI + hh]);
            }
            const int nkt = (qs + 16) >> 4;
            bf16x8 a0n = (bf16x8){0, 0, 0, 0, 0, 0, 0, 0}, a1n = a0n;
            if (w < nkt) { const bf16_t* krow = Pb + (size_t)(w * 16 + n) * LDP + C_KI; a0n = *(const bf16x8*)(krow + 8 * g); a1n = *(const bf16x8*)(krow + 32 + 8 * g); }
#pragma unroll 1
            for (int kt = w; kt < nkt; kt += 8) {
                const bf16x8 a0 = a0n, a1 = a1n;
                if (kt + 8 < nkt) { const bf16_t* krow = Pb + (size_t)((kt + 8) * 16 + n) * LDP + C_KI; a0n = *(const bf16x8*)(krow + 8 * g); a1n = *(const bf16x8*)(krow + 32 + 8 * g); }
                f32x4 s = (f32x4){0.f, 0.f, 0.f, 0.f};
#pragma unroll
                for (int hh = 0; hh < 4; ++hh) {
                    f32x4 d = __builtin_amdgcn_mfma_f32_16x16x32_bf16(a0, bq[hh][0], (f32x4){0.f, 0.f, 0.f, 0.f}, 0, 0, 0);
                    d = __builtin_amdgcn_mfma_f32_16x16x32_bf16(a1, bq[hh][1], d, 0, 0, 0);
#pragma unroll
                    for (int r = 0; r < 4; ++r) s[r] += wi[hh] * fmaxf(d[r], 0.f);
                }
                const int t = qs + n;
#pragma unroll
                for (int r = 0; r < 4; ++r) if (kt * 16 + 4 * g + r > t) s[r] = -INFINITY;
                *(LAS f32x4*)&sc[n * SCS + kt * 16 + 4 * g] = s;
            }
        }
        __syncthreads();
#pragma unroll 1
        for (int e = 0; e < 2; ++e) {
            const int qn = 2 * w + e, t = qs + qn;
            LAS unsigned* mrow = MASK + (sub * 16 + qn) * 64;
            if (t < 256) {
#pragma unroll
                for (int j = 0; j < 32; ++j) {
                    const unsigned long long sm = __ballot(j * 64 + lane <= t);
                    if (lane == 0) { mrow[2 * j] = (unsigned)sm; mrow[2 * j + 1] = (unsigned)(sm >> 32); }
                }
            } else {
                const int jn = (t >> 6) + 1;
                unsigned u[32];
#pragma unroll
                for (int j = 0; j < 32; ++j) {
                    u[j] = 0u;
                    if (j < jn) { const int key = j * 64 + lane; const float s = (key <= t) ? sc[qn * SCS + key] : -INFINITY; u[j] = f2ord(s); }
                }
                unsigned prefix = 0u;
#define DSA_BITSEARCH(JN) do { _Pragma("unroll 1") for (int bit = 31; bit >= 0; --bit) { const unsigned cand = prefix | (1u << bit); int c0 = 0, c1 = 0; \
                    _Pragma("unroll") for (int j = 0; j < (JN); j += 2) { c0 += (u[j] >= cand) ? 1 : 0; c1 += (u[j + 1] >= cand) ? 1 : 0; } \
                    const int cnt = (int)wave_sum_fast((float)(c0 + c1)); if (cnt >= 256) prefix = cand; } } while (0)
                if (jn <= 8) DSA_BITSEARCH(8); else if (jn <= 16) DSA_BITSEARCH(16); else if (jn <= 24) DSA_BITSEARCH(24); else DSA_BITSEARCH(32);
#undef DSA_BITSEARCH
                int cg_ = 0;
#pragma unroll
                for (int j = 0; j < 32; ++j) if (j < jn) cg_ += __popcll(__ballot(u[j] > prefix));
                const int need = 256 - cg_;
                int cum = 0;
#pragma unroll
                for (int j = 0; j < 32; ++j) {
                    unsigned long long sm = 0ull;
                    if (j < jn) {
                        const bool eq = (u[j] == prefix);
                        const unsigned long long em = __ballot(eq);
                        const int rank = cum + (int)__builtin_amdgcn_mbcnt_hi((unsigned)(em >> 32), __builtin_amdgcn_mbcnt_lo((unsigned)em, 0u));
                        const bool sel = (u[j] > prefix) || (eq && rank < need);
                        sm = __ballot(sel);
                        cum += __popcll(em);
                    }
                    if (lane == 0) { mrow[2 * j] = (unsigned)sm; mrow[2 * j + 1] = (unsigned)(sm >> 32); }
                }
            }
        }
        __syncthreads();
    }
    const int qq = q0 + 8 * w + (n & 7);
    const LAS unsigned* mq = MASK + (8 * w + (n & 7)) * 64;
    const int nsteps = (q0 + 8 * w + 8 + 31) >> 5;
    const int nblk = (q0 + 64 + 127) >> 7;
    LAS bf16_t* KT = (LAS bf16_t*)lds;
    LAS bf16_t* VTT = (LAS bf16_t*)(lds + 36864);
    const int tid = X.tid;
#pragma unroll 1
    for (int c = 0; c < 2; ++c) {
        bf16x8 bq[2][2];
#pragma unroll
        for (int j = 0; j < 2; ++j)
#pragma unroll
            for (int ks = 0; ks < 2; ++ks) bq[j][ks] = *(const bf16x8*)(Pb + (size_t)qq * LDP + C_Q + (c * 4 + 2 * j + (n >> 3)) * 64 + ks * 32 + 8 * g);
        float lrun[2] = {0.f, 0.f};
        f32x4 oacc[4][2];
#pragma unroll
        for (int mt = 0; mt < 4; ++mt)
#pragma unroll
            for (int j = 0; j < 2; ++j) oacc[mt][j] = (f32x4){0.f, 0.f, 0.f, 0.f};
        const bf16_t* vtb = X.VT + ((size_t)(b * 2 + c) * 64) * SEQ;
        u32x4 gk[2], gv[2];
#define DSA_GLOAD(kblk) do { _Pragma("unroll") for (int it = 0; it < 2; ++it) { const int idx = tid + 512 * it; \
            gk[it] = *(const u32x4*)(Pb + (size_t)((kblk) * 128 + (idx >> 3)) * LDP + C_K + c * 64 + (idx & 7) * 8); \
            gv[it] = *(const u32x4*)(vtb + (size_t)(idx >> 4) * SEQ + (kblk) * 128 + (idx & 15) * 8); } } while (0)
#define DSA_LSTORE(bufi) do { _Pragma("unroll") for (int it = 0; it < 2; ++it) { const int idx = tid + 512 * it; \
            *(LAS u32x4*)(KT + (bufi) * 9216 + (idx >> 3) * 72 + (idx & 7) * 8) = gk[it]; \
            *(LAS u32x4*)(VTT + (bufi) * 8704 + (idx >> 4) * 136 + (idx & 15) * 8) = gv[it]; } } while (0)
        DSA_GLOAD(0);
        LDS_BAR();
        DSA_LSTORE(0);
        LDS_BAR();
#pragma unroll 1
        for (int kb = 0; kb < nblk; ++kb) {
            const int buf = kb & 1;
            if (kb + 1 < nblk) DSA_GLOAD(kb + 1);
            const LAS bf16_t* Kb = KT + buf * 9216; const LAS bf16_t* Vb = VTT + buf * 8704;
#pragma unroll 1
            for (int sl = 0; sl < 4; ++sl) {
                const int sg = kb * 4 + sl;
                if (sg < nsteps) {
                    f32x4 st[2][2];
#pragma unroll
                    for (int tl = 0; tl < 2; ++tl) {
                        const LAS bf16_t* kr = Kb + (32 * sl + 16 * tl + n) * 72;
                        const bf16x8 a0 = *(const LAS bf16x8*)(kr + 8 * g), a1 = *(const LAS bf16x8*)(kr + 32 + 8 * g);
#pragma unroll
                        for (int j = 0; j < 2; ++j) {
                            f32x4 d = __builtin_amdgcn_mfma_f32_16x16x32_bf16(a0, bq[j][0], (f32x4){0.f, 0.f, 0.f, 0.f}, 0, 0, 0);
                            st[tl][j] = __builtin_amdgcn_mfma_f32_16x16x32_bf16(a1, bq[j][1], d, 0, 0, 0);
                        }
                    }
                    bf16x8 av[4];
#pragma unroll
                    for (int mt = 0; mt < 4; ++mt) {
                        const LAS bf16_t* vp = Vb + (mt * 16 + n) * 136 + 32 * sl + 4 * g;
                        const u32x2 lo = *(const LAS u32x2*)vp, hi = *(const LAS u32x2*)(vp + 16);
                        u32x4 t4; t4.x = lo.x; t4.y = lo.y; t4.z = hi.x; t4.w = hi.y;
                        av[mt] = __builtin_bit_cast(bf16x8, t4);
                    }
                    const unsigned mw = mq[sg];
#pragma unroll
                    for (int j = 0; j < 2; ++j) {
                        float p[8], ps = 0.f;
#pragma unroll
                        for (int tl = 0; tl < 2; ++tl)
#pragma unroll
                            for (int r = 0; r < 4; ++r) { const int bit = 16 * tl + 4 * g + r; const float e = __expf(fminf(st[tl][j][r] * 0.125f, 60.f)); p[4 * tl + r] = ((mw >> bit) & 1u) ? e : 0.f; ps += p[4 * tl + r]; }
                        lrun[j] += ps;
                        u32x4 pw; pw.x = pg8::cvt_pk_bf16(p[0], p[1]); pw.y = pg8::cvt_pk_bf16(p[2], p[3]); pw.z = pg8::cvt_pk_bf16(p[4], p[5]); pw.w = pg8::cvt_pk_bf16(p[6], p[7]);
                        const bf16x8 pb = __builtin_bit_cast(bf16x8, pw);
#pragma unroll
                        for (int mt = 0; mt < 4; ++mt) oacc[mt][j] = __builtin_amdgcn_mfma_f32_16x16x32_bf16(av[mt], pb, oacc[mt][j], 0, 0, 0);
                    }
                }
            }
            if (kb + 1 < nblk) DSA_LSTORE(buf ^ 1);
            LDS_BAR();
        }
#pragma unroll
        for (int j = 0; j < 2; ++j) {
            float lt = lrun[j]; lt += __shfl_xor(lt, 16); lt += __shfl_xor(lt, 32);
            const float il = 1.f / lt;
            bf16_t* op = X.P + ((size_t)b * SEQ + qq) * LDP + COL_YC + (c * 4 + 2 * j + (n >> 3)) * 64 + 4 * g;
#pragma unroll
            for (int mt = 0; mt < 4; ++mt) {
                const f32x4 o = oacc[mt][j] * il;
                u32x2 wv; wv.x = pg8::cvt_pk_bf16(o[0], o[1]); wv.y = pg8::cvt_pk_bf16(o[2], o[3]);
                *(u32x2*)(op + mt * 16) = wv;
            }
        }
    }
#undef DSA_GLOAD
#undef DSA_LSTORE
    __syncthreads();
}

__device__ __forceinline__ void phase_mixers(const Ctx& X0, LAS unsigned char* lds, int layer, bool early_gate) {
#pragma unroll 1
    for (int task = X0.bid; task < 128; task += X0.G) {
        Ctx X = X0;
        { int t_ = threadIdx.x; asm volatile("" : "+v"(t_)); X.tid = t_; X.lane = t_ & 63; }
        if (task < 64) { if (TKMASK & 1) rwkv_task(X, lds, layer, task >> 3, task & 7); }
        else { const int k = task - 64; if (TKMASK & 2) hgrn_task(X, lds, layer, k >> 3, (k >> 1) & 3, k & 1); }
    }
    volatile LAS unsigned* tw = (volatile LAS unsigned*)(lds + LDS_BYTES - 128);
    unsigned* ctr = (unsigned*)(X0.ws + WS_BAR + 14336) + 16 * layer;
#pragma unroll 1
    for (;;) {
        Ctx X = X0;
        { int t_ = threadIdx.x; asm volatile("" : "+v"(t_)); X.tid = t_; X.lane = t_ & 63; }
        __syncthreads();
        if (threadIdx.x == 0) tw[0] = __hip_atomic_fetch_add(ctr, 1u, __ATOMIC_RELAXED, __HIP_MEMORY_SCOPE_AGENT);
        __syncthreads();
        const int t = (int)tw[0];
        if (t >= 256) break;
        if (TKMASK & 4) dsa_tile(X, lds, t & 7, 64 * (31 - (t >> 3)));
    }
    if (early_gate && X0.bid >= 128 && X0.G == 256) {
        __syncthreads();
        int t_ = threadIdx.x; asm volatile("" : "+v"(t_));
        pg8::Gemm g{X0.P, X0.Wg, LDP, DM, DM}; pg8::StaticOrder S; S.init(T_TOK, DM, 128, X0.bid - 128);
        pg8::EpiGate E{X0.P, (bf16_t*)X0.out + 1024, 2048}; pg8::gemm_phase<pg8::EpiGate, true>(lds, g, S, E, t_);
    }
}

__device__ __forceinline__ void phase_hgrn_post(const Ctx& X, int layer) {
    const int gw = X.bid * 8 + X.wave, NGW = X.G * 8;
    const float* gn = X.in[15] + layer * 512;
#pragma unroll 1
    for (int it0 = gw; it0 < T_TOK * 4; it0 += 4 * NGW) {
        unsigned ow[4], gwd[4]; unsigned* op[4];
#pragma unroll
        for (int r = 0; r < 4; ++r) {
            const int it = it0 + r * NGW < T_TOK * 4 ? it0 + r * NGW : it0;
            const int t = it >> 2, h = it & 3;
            bf16_t* rowp = X.P + (size_t)t * LDP;
            op[r] = (unsigned*)(rowp + COL_YB + h * 128) + X.lane;
            ow[r] = *op[r]; gwd[r] = *((const unsigned*)(rowp + COL_PB + 1536 + h * 128) + X.lane);
        }
#pragma unroll
        for (int r = 0; r < 4; ++r) {
            const int it = it0 + r * NGW;
            const int h = it & 3;
            const float o0 = bflo(ow[r]), o1 = bfhi(ow[r]), g0 = bflo(gwd[r]), g1 = bfhi(gwd[r]);
            const float rs = 1.f / sqrtf(wave_sum(o0 * o0 + o1 * o1) * (1.f / 128.f) + 1e-6f);
            const float y0 = o0 * rs * gn[h * 128 + 2 * X.lane] * (g0 * sigmoidf_(g0)), y1 = o1 * rs * gn[h * 128 + 2 * X.lane + 1] * (g1 * sigmoidf_(g1));
            if (it < T_TOK * 4) *op[r] = pk2(y0, y1);
        }
    }
}

__device__ __forceinline__ void phase_fixup(const Ctx& X, int layer) {
    const float* cw = X.in[20] + (size_t)layer * 3 * F2; const float* cb = X.in[21] + (size_t)layer * F2;
#pragma unroll 4
    for (int idx = X.bid * 512 + X.tid; idx < 256 * 2 * DFF; idx += X.G * 512) {
        const int j = idx % DFF, sr = idx / DFF, s = sr >> 1, r = sr & 1;
        const int colg = (j >> 7) * 256 + (j & 127), colv = colg + 128;
        const bool seq0 = (s & 31) == 0;
        const float* H = X.HALO;
        float res[2];
#pragma unroll
        for (int part = 0; part < 2; ++part) {
            const int cp = part ? colv : colg, co = part * DFF + j;
            const float u0 = H[(size_t)(s * 4 + r) * F2 + cp];
            float u1, u2;
            if (r == 0) { u1 = seq0 ? 0.f : H[(size_t)((s - 1) * 4 + 3) * F2 + cp]; u2 = seq0 ? 0.f : H[(size_t)((s - 1) * 4 + 2) * F2 + cp]; }
            else { u1 = H[(size_t)(s * 4 + 0) * F2 + cp]; u2 = seq0 ? 0.f : H[(size_t)((s - 1) * 4 + 3) * F2 + cp]; }
            res[part] = cb[co] + cw[co] * u2 + cw[F2 + co] * u1 + cw[2 * F2 + co] * u0;
        }
        const float a = res[0] * sigmoidf_(res[0]) * res[1];
        X.P[(size_t)(s * 64 + r) * LDP + COL_ACT + j] = (bf16_t)f2bf(a);
    }
}

#define XB_TMO      128
#define XB_XCNT(j)  (256  + 64 * (j))
#define XB_XSUB(j)  (1280 + 64 * (j))
#define XB_XGEN(j)  (2304 + 64 * (j))
#define XB_TOP      3328
#define XB_TOPGEN   3392
#define XCD_BAR_WORDS 3456
#define XB_SPIN_CAP (1u << 22)
__device__ __forceinline__ unsigned xb_ld(unsigned* p)              { return __hip_atomic_load(p, __ATOMIC_RELAXED, __HIP_MEMORY_SCOPE_AGENT); }
__device__ __forceinline__ unsigned xb_add(unsigned* p, unsigned v) { return __hip_atomic_fetch_add(p, v, __ATOMIC_RELAXED, __HIP_MEMORY_SCOPE_AGENT); }
__device__ __forceinline__ unsigned xb_xcc_id() { return (unsigned)__builtin_amdgcn_s_getreg((3 << 11) | 20) & 0xFu; }
#define XB_SPIN(cond, bar) do { unsigned _sp = 0; while (cond) { __builtin_amdgcn_s_sleep(1); \
    if ((++_sp & 255u) == 0u) { if (xb_ld(&(bar)[XB_TMO])) break; if (_sp > XB_SPIN_CAP) { atomicAdd(&(bar)[XB_TMO], 1u); break; } } } } while (0)
struct XcdBarrier { unsigned* bar; unsigned x; volatile LAS unsigned* st; };
__device__ __forceinline__ XcdBarrier xcd_barrier_post(unsigned* bar, volatile LAS unsigned* st) {
    XcdBarrier b; b.bar = bar; b.x = xb_xcc_id(); b.st = st;
    if (threadIdx.x == 0) (void)xb_add(&bar[XB_XCNT(b.x)], 1u);
    return b;
}
__device__ __forceinline__ void xcd_barrier_complete(unsigned* bar, unsigned x, unsigned& nloc, unsigned& nx) {
    const unsigned G = gridDim.x * gridDim.y * gridDim.z;
    unsigned sum, cnt, mine, sp = 0u;
    for (;;) {
        sum = 0u; cnt = 0u; mine = 0u;
#pragma unroll
        for (unsigned j = 0; j < 16; ++j) { const unsigned c = xb_ld(&bar[XB_XCNT(j)]); sum += c; cnt += (c > 0u) ? 1u : 0u; mine = (j == x) ? c : mine; }
        if (sum == G) break;
        __builtin_amdgcn_s_sleep(1);
        if ((++sp & 255u) == 0u) { if (xb_ld(&bar[XB_TMO])) break; if (sp > XB_SPIN_CAP) { atomicAdd(&bar[XB_TMO], 1u); break; } }
    }
    nloc = mine > 0u ? mine : 1u; nx = cnt > 0u ? cnt : 1u;
}
__device__ __forceinline__ void xcd_barrier(const XcdBarrier& b) {
    asm volatile("s_waitcnt vmcnt(0)" ::: "memory");
    __syncthreads();
    if (threadIdx.x == 0) {
        unsigned* bar = b.bar;
        __builtin_amdgcn_s_waitcnt(0);
        unsigned nloc = b.st[0], nx = b.st[1];
        if (nloc == 0u) { xcd_barrier_complete(bar, b.x, nloc, nx); b.st[0] = nloc; b.st[1] = nx; }
        const unsigned old = xb_add(&bar[XB_XSUB(b.x)], 1u);
        const unsigned gen = old / nloc;
        if (old + 1u == (gen + 1u) * nloc) {
            __builtin_amdgcn_fence(__ATOMIC_RELEASE, "agent");
            asm volatile("s_waitcnt vmcnt(0)" ::: "memory");
            const unsigned og = xb_add(&bar[XB_TOP], 1u);
            const unsigned tg = og / nx;
            if (og + 1u == (tg + 1u) * nx) xb_add(&bar[XB_TOPGEN], 1u);
            else XB_SPIN(xb_ld(&bar[XB_TOPGEN]) == tg, bar);
            __builtin_amdgcn_fence(__ATOMIC_ACQUIRE, "agent");
            xb_add(&bar[XB_XGEN(b.x)], 1u);
            asm volatile("s_waitcnt vmcnt(0)" ::: "memory");
        } else {
            XB_SPIN(xb_ld(&bar[XB_XGEN(b.x)]) == gen, bar);
            __builtin_amdgcn_fence(__ATOMIC_ACQUIRE, "agent");
            asm volatile("s_waitcnt vmcnt(0)" ::: "memory");
        }
    }
    __syncthreads();
}

__global__ void __launch_bounds__(512, 2) mk_fwd(Args args) {
    extern __shared__ __attribute__((aligned(16))) unsigned char lds_raw[];
    LAS unsigned char* lds = (LAS unsigned char*)lds_raw;
    Ctx X;
#pragma unroll
    for (int i = 0; i < 24; ++i) X.in[i] = args.in[i];
    X.out = args.out; X.ws = args.ws;
    X.P = (bf16_t*)(args.ws + WS_P); X.VT = (bf16_t*)(args.ws + WS_VT); X.HALO = (float*)(args.ws + WS_HALO); X.ROPE = (float*)(args.ws + WS_ROPE);
    X.Win = (bf16_t*)(args.ws + WS_WIN); X.Wg = (bf16_t*)(args.ws + WS_WG); X.Wbr = (bf16_t*)(args.ws + WS_WBR);
    X.Wo = (bf16_t*)(args.ws + WS_WO); X.Wup = (bf16_t*)(args.ws + WS_WUP); X.Wdn = (bf16_t*)(args.ws + WS_WDN);
    X.tid = threadIdx.x; X.lane = X.tid & 63; X.wave = __builtin_amdgcn_readfirstlane(X.tid >> 6); X.G = gridDim.x; X.bid = blockIdx.x;

#if PROBE_DOUBLE
    for (int ph2 = args.ph_lo * 2; ph2 < args.ph_hi * 2; ++ph2) {
        const int ph = ph2 >> 1;
        const int layer = ph / 11, sub = ph % 11;
        const bool skip_ = (ph2 & 1) && !(ph < 22 && ((REPMASK >> sub) & 1));
#else
    volatile LAS unsigned* bst = (volatile LAS unsigned*)(lds + LDS_BYTES - 64);
    if (threadIdx.x < 2) bst[threadIdx.x] = 0u;
    __syncthreads();
    XcdBarrier gbar = xcd_barrier_post((unsigned*)(args.ws + WS_BAR), bst);
    for (int ph = args.ph_lo; ph < args.ph_hi; ++ph) {
        const int layer = ph / 11, sub = ph % 11;
        const bool skip_ = false;
#endif
        const bool fusedn = (X.G == 256) && (args.ph_hi - args.ph_lo > 1);
        if (fusedn && (ph == 22 || sub == 7)) continue;
        { int t_ = threadIdx.x; asm volatile("" : "+v"(t_)); X.tid = t_; X.lane = t_ & 63; }

        if (skip_) {
        } else if (ph == 22 && (PHMASK & 1024)) {
            const int gw = X.bid * 8 + X.wave, NGW = X.G * 8;
            (void)gw; (void)NGW; rms_pass(X, X.out, X.in[23], nullptr, X.out);
        } else if (sub == 0 && (PHMASK & 1)) {
            phase_prep(X, lds, layer, !(fusedn && layer > 0));
        } else if (sub == 1 && (PHMASK & 2)) {
            pg8::Gemm g{X.P, X.Win, LDP, DM, DM}; pg8::StaticOrder S; S.init(T_TOK, 5120, X.G, X.bid);
            pg8::EpiInProj E{X.P, X.VT, X.ROPE, (bf16_t*)(X.ws + WS_BND)};
            pg8::gemm_phase<pg8::EpiInProj, true>(lds, g, S, E, X.tid);
        } else if (sub == 2 && (PHMASK & 4)) {
            phase_rwkv_pre(X, lds, layer);
        } else if (sub == 3 && (PHMASK & 4)) {
            phase_mixers(X, lds, layer, layer == 0 && fusedn);
        } else if (sub == 4 && (PHMASK & 8)) {
            phase_hgrn_post(X, layer);
            { const int gw = X.bid * 8 + X.wave, NGW = X.G * 8; const float* hh = (layer == 0) ? X.in[0] : X.out; const float* g = X.in[1] + (size_t)layer * DM;
              (void)gw; (void)NGW; if (layer > 0) rms_pass(X, hh, g, X.P, nullptr); }
        } else if (sub == 5 && (PHMASK & 16)) {
#pragma unroll 1
            for (int br = 0; br < 3; ++br) {
                const bool early_g = (layer == 0 && br == 0 && fusedn);
                bf16_t* Gb_ = early_g ? (bf16_t*)X.out + 1024 : X.P + COL_G; const int Gs_ = early_g ? 2048 : LDP;
                if (!early_g) { pg8::Gemm g{X.P, X.Wg + (size_t)br * DM * DM, LDP, DM, DM}; pg8::StaticOrder S; S.init(T_TOK, DM, X.G, X.bid);
                  int t_ = X.tid; asm volatile("" : "+v"(t_));
                  pg8::EpiGate E{X.P, Gb_, Gs_}; pg8::gemm_phase<pg8::EpiGate, true>(lds, g, S, E, t_); }
                { const int ycol = br == 0 ? COL_YA : (br == 1 ? COL_YB : COL_YC);
                  pg8::Gemm g{X.P + ycol, X.Wbr + (size_t)br * DM * 512, LDP, 512, 512}; pg8::StaticOrder S; S.init(T_TOK, DM, X.G, X.bid);
                  int t_ = X.tid; asm volatile("" : "+v"(t_));
                  pg8::EpiMergeAcc E{X.P, br == 0 ? 1 : 0, Gb_, Gs_}; pg8::gemm_phase<pg8::EpiMergeAcc, true>(lds, g, S, E, t_); }
            }
        } else if (sub == 6 && (PHMASK & 32)) {
            pg8::Gemm g{X.P + COL_MRG, X.Wo, LDP, DM, DM}; pg8::StaticOrder S; S.init(T_TOK, DM, X.G, X.bid);
            if (fusedn) {
                pg8::EpiResidNorm E{layer == 0 ? X.in[0] : X.out, X.out, X.in[18] + (size_t)layer * DM, X.P, nullptr,
                                    (unsigned*)(X.ws + WS_XB) + (size_t)(layer * 2) * 65536, (unsigned*)(X.ws + WS_XC) + (layer * 2) * 4096};
                pg8::gemm_phase<pg8::EpiResidNorm, false>(lds, g, S, E, X.tid);
            } else {
            pg8::EpiResid E{layer == 0 ? X.in[0] : X.out, X.out};
            pg8::gemm_phase<pg8::EpiResid, true>(lds, g, S, E, X.tid);
            }
        } else if (sub == 7 && (PHMASK & 64)) {
            const int gw = X.bid * 8 + X.wave, NGW = X.G * 8;
            const float* g = X.in[18] + (size_t)layer * DM;
            (void)gw; (void)NGW; rms_pass(X, X.out, g, X.P, nullptr);
        } else if (sub == 8 && (PHMASK & 128)) {
            pg8::Gemm g{X.P, X.Wup, LDP, DM, DM}; pg8::StaticOrder S; S.init(T_TOK, F2, X.G, X.bid);
            pg8::EpiUp E{X.P, X.HALO, X.in[20] + (size_t)layer * 3 * F2, X.in[21] + (size_t)layer * F2, (LAS float*)(lds + 131072)};
            pg8::gemm_phase<pg8::EpiUp, true>(lds, g, S, E, X.tid);
        } else if (sub == 9 && (PHMASK & 256)) {
            phase_fixup(X, layer);
        } else if (sub == 10 && (PHMASK & 512)) {
            pg8::Gemm g{X.P + COL_ACT, X.Wdn, LDP, DFF, DFF}; pg8::StaticOrder S; S.init(T_TOK, DM, X.G, X.bid);
            if (fusedn) {
                const bool last = (layer == 1);
                pg8::EpiResidNorm E{X.out, last ? nullptr : X.out, last ? X.in[23] : X.in[1] + (size_t)DM, last ? nullptr : X.P, last ? X.out : nullptr,
                                    (unsigned*)(X.ws + WS_XB) + (size_t)(layer * 2 + 1) * 65536, (unsigned*)(X.ws + WS_XC) + (layer * 2 + 1) * 4096};
                pg8::gemm_phase<pg8::EpiResidNorm, false>(lds, g, S, E, X.tid);
            } else {
            pg8::EpiResid E{X.out, X.out};
            pg8::gemm_phase<pg8::EpiResid, true>(lds, g, S, E, X.tid);
            }
        }
#if PROBE_DOUBLE
        if (ph2 + 1 < args.ph_hi * 2) cg::this_grid().sync();
#else
        if (ph + 1 < args.ph_hi && !(fusedn && ph == 21)) { if (args.ph_hi > 1000) cg::this_grid().sync(); else xcd_barrier(gbar); }
#endif
    }
}

extern "C" void kernel_launch(void* const* d_in, const int* in_sizes, int n_in, void* d_out, int out_size, void* d_ws, size_t ws_size, hipStream_t stream) {
    static int grid = 0;
    if (grid == 0) {
        int dev = 0, cus = 0, per_cu = 0;
        (void)hipGetDevice(&dev);
        (void)hipDeviceGetAttribute(&cus, hipDeviceAttributeMultiprocessorCount, dev);
        if (hipFuncSetAttribute((const void*)mk_fwd, hipFuncAttributeMaxDynamicSharedMemorySize, LDS_BYTES) != hipSuccess) fprintf(stderr, "kernel_launch: hipFuncSetAttribute failed\n");
        if (hipOccupancyMaxActiveBlocksPerMultiprocessor(&per_cu, (const void*)mk_fwd, 512, LDS_BYTES) != hipSuccess || per_cu < 1) { fprintf(stderr, "kernel_launch: occupancy query gave %d\n", per_cu); per_cu = 1; }
        (void)hipGetLastError();
        grid = cus * 1;
        if (grid <= 0) grid = 256;
        if (ws_size < (size_t)268435456) fprintf(stderr, "kernel_launch: workspace too small (%zu)\n", ws_size);
    }
    Args a{};
    for (int i = 0; i < 24; ++i) a.in[i] = (const float*)d_in[i];
    a.out = (float*)d_out; a.ws = (unsigned char*)d_ws;
#if MK_SINGLE
    (void)hipMemsetAsync((char*)d_ws + WS_BAR, 0, 16384 + 65536, stream);
    a.ph_lo = 0; a.ph_hi = 23;
    void* kargs[] = {&a};
    hipError_t e = hipLaunchCooperativeKernel((const void*)mk_fwd, dim3(grid), dim3(512), kargs, LDS_BYTES, stream);
    if (e != hipSuccess) fprintf(stderr, "cooperative launch failed: %s (grid %d)\n", hipGetErrorString(e), grid);
#else
    for (int ph = 0; ph < 23; ++ph) {
        a.ph_lo = ph; a.ph_hi = ph + 1;
        hipLaunchKernelGGL(mk_fwd, dim3(grid), dim3(512), LDS_BYTES, stream, a);
    }
#endif
}
```

```cpp
#include <hip/hip_runtime.h>
#include <hip/hip_cooperative_groups.h>
#include <cstdio>
#include <cstdint>
namespace cg = cooperative_groups;

#ifndef PHMASK
#define PHMASK 2047
#endif
#ifndef REPMASK
#define REPMASK 0
#endif
#ifndef PROBE_DOUBLE
#define PROBE_DOUBLE 0
#endif
#ifndef PROBE_SCAN2
#define PROBE_SCAN2 0
#endif
#ifndef TKMASK
#define TKMASK 7
#endif
#ifndef MK_SINGLE
#define MK_SINGLE 1
#endif

#define LAS __attribute__((address_space(3)))
typedef unsigned short bf16_t;
typedef short bf16x8 __attribute__((ext_vector_type(8)));
typedef float f32x4 __attribute__((ext_vector_type(4)));
typedef float f32x2 __attribute__((ext_vector_type(2)));
typedef unsigned u32x4 __attribute__((ext_vector_type(4)));
typedef unsigned u32x2 __attribute__((ext_vector_type(2)));

constexpr int T_TOK = 16384, SEQ = 2048, DM = 1024;
constexpr int LDP = 6208;
constexpr int COL_PA = 1024, COL_PB = 2816, COL_PC = 4864;
constexpr int COL_YA = 1024, COL_MRG = 1536, COL_G = 2816, COL_YB = 3840, COL_YC = 4864, COL_ACT = 1024;
constexpr int COL_GS = 5960;
constexpr int C_Q = 4864, C_K = 5376, C_QI = 5632, C_KI = 5888, C_WI = 5952;
constexpr int IN_COLS = 8004, DFF = 2816, F2 = 5632;
constexpr size_t WS_WIN = 0, WS_WG = 10485760, WS_WBR = 16777216, WS_WO = 19922944, WS_WUP = 22020096, WS_WDN = 33554432;
constexpr size_t WS_P = 39321600, WS_HALO = 242745344, WS_VT = WS_HALO, WS_ROPE = 265814016, WS_BAR = 266338304, WS_BND = WS_HALO + 4194304, WS_SCAL = WS_HALO + 8388608, WS_XC = WS_BAR + 16384, WS_XB = WS_XC + 65536;
constexpr int LDS_BYTES = 153600;
constexpr int SCS = 2052;
constexpr int MASK_OFF = 16 * SCS * 4;

struct Args { const float* in[24]; float* out; unsigned char* ws; int ph_lo, ph_hi; };

__device__ __forceinline__ unsigned f2bf(float f) { unsigned u = __builtin_bit_cast(unsigned, f); return (u + 0x7fffu + ((u >> 16) & 1u)) >> 16; }
__device__ __forceinline__ unsigned pk2(float lo, float hi) { unsigned r; asm("v_cvt_pk_bf16_f32 %0, %1, %2" : "=v"(r) : "v"(lo), "v"(hi)); return r; }
__device__ __forceinline__ float bf2f(bf16_t b) { return __builtin_bit_cast(float, (unsigned)b << 16); }
__device__ __forceinline__ float bflo(unsigned w) { return __builtin_bit_cast(float, w << 16); }
__device__ __forceinline__ float bfhi(unsigned w) { return __builtin_bit_cast(float, w & 0xffff0000u); }
__device__ __forceinline__ float wave_sum(float v) {
#pragma unroll
    for (int o = 1; o < 64; o <<= 1) v += __shfl_xor(v, o);
    return v;
}
__device__ __forceinline__ int wave_sum_i(int v) {
#pragma unroll
    for (int o = 1; o < 64; o <<= 1) v += __shfl_xor(v, o);
    return v;
}
template <int CTRL> __device__ __forceinline__ float dpp_mov(float x) {
    return __builtin_bit_cast(float, __builtin_amdgcn_update_dpp(0, __builtin_bit_cast(int, x), CTRL, 0xF, 0xF, true));
}
__device__ __forceinline__ float red8(float x) { x += dpp_mov<0xB1>(x); x += dpp_mov<0x4E>(x); x += dpp_mov<0x141>(x); return x; }
__device__ __forceinline__ float red16(float x) { x = red8(x); x += dpp_mov<0x140>(x); return x; }
__device__ __forceinline__ float sigmoidf_(float x) { return 1.f / (1.f + __expf(-x)); }

namespace pg8 {
constexpr int BM = 256, BK = 64, HALF = 128, HTB = HALF * BK * 2, NXCD = 8, WGM = 8;
__device__ __forceinline__ int lds_byte(int r, int c) { const int st = (r >> 4) * 2 + (c >> 5), rr = r & 15, cc = c & 31, ob = rr * 64 + cc * 2; return st * 1024 + (ob ^ (((ob >> 9) & 1) << 5)); }
__device__ __forceinline__ void stage_rc(int b, int& R, int& C) { const int st = b / 1024, sb = b % 1024, swz = sb ^ (((sb >> 9) & 1) << 5); R = (st >> 1) * 16 + swz / 64; C = (st & 1) * 32 + (swz % 64) / 2; }
__device__ __forceinline__ int perm32(int rho) { const int n = rho >> 4, i = rho & 15; return 8 * (i >> 2) + 4 * n + (i & 3); }
struct Unit { int pm, pn; };
struct Gemm { const bf16_t* A; const bf16_t* Bt; int lda, ldb, K; };
struct StaticOrder {
    int nM, nN, nwg, G, c;
    __device__ void init(int M, int N, int G_, int c_) { nM = M / BM; nN = N / BM; nwg = nM * nN; G = G_; c = c_; }
    __device__ bool next(int i, Unit& u) const {
        const long L = (long)i * G + c; if (L >= nwg) return false;
        int wgid = (int)L; { const int q = nwg / NXCD, r = nwg % NXCD, xcd = wgid % NXCD, off = wgid / NXCD; wgid = (xcd < r ? xcd * (q + 1) : r * (q + 1) + (xcd - r) * q) + off; }
        const int nig = WGM * nN, gid = wgid / nig, fm = gid * WGM, gsz = (nM - fm) < WGM ? (nM - fm) : WGM;
        u.pm = fm + ((wgid % nig) % gsz); u.pn = (wgid % nig) / gsz; return true;
    }
};
__device__ __forceinline__ unsigned cvt_pk_bf16(float lo, float hi) { unsigned r; asm volatile("v_cvt_pk_bf16_f32 %0, %1, %2" : "=v"(r) : "v"(lo), "v"(hi)); return r; }

template <class Epi, bool ALIGN_EPI>
__device__ __forceinline__ void gemm_phase(LAS unsigned char* lds, const Gemm g, const StaticOrder& S, const Epi& E, const int tid) {
    const int wid = __builtin_amdgcn_readfirstlane(tid >> 6), lane = tid & 63, wr = wid >> 2, wc = wid & 3, fr = lane & 15, fq = lane >> 4;
    const int K = g.K, nt = K / BK;
    unsigned voffA[2], voffB[2];
#pragma unroll
    for (int i = 0; i < 2; ++i) { int R, C; stage_rc(tid * 16 + i * 8192, R, C); const int Rb = (R & ~31) + perm32(R & 31);
        voffA[i] = (unsigned)(R * g.lda + C) * 2u; voffB[i] = (unsigned)(Rb * g.ldb + C) * 2u; }
    const size_t kstep = (size_t)(BK * 2);
    const size_t hstepA = (size_t)HALF * g.lda * 2, hstepB = (size_t)HALF * g.ldb * 2;
    const size_t tstepA = 2 * hstepA, tstepB = 2 * hstepB;
    const unsigned ldsw = (unsigned)wid * 1024u;
    const int aoff = lds_byte(wr * 64 + fr, fq * 8), boff = lds_byte(wc * 32 + fr, fq * 8);
#define PG8_SA(b, h) (((b) * 2 + (h)) * HTB)
#define PG8_SB(b, h) ((4 + (b) * 2 + (h)) * HTB)
#define PG8_STAGE(bufoff, gbase, voff) do { _Pragma("unroll") for (int _i = 0; _i < 2; ++_i) \
        __builtin_amdgcn_global_load_lds((const unsigned*)((const char*)(gbase) + (voff)[_i]), (LAS unsigned*)(lds + (bufoff) + ldsw + _i * 8192), 16, 0, 0); } while (0)
#define PG8_LDA(dst, b, h) do { _Pragma("unroll") for (int m = 0; m < 4; ++m) _Pragma("unroll") for (int k = 0; k < 2; ++k) dst[m][k] = *(const LAS bf16x8*)(lds + PG8_SA(b, h) + aoff + m * 2048 + k * 1024); } while (0)
#define PG8_LDB(dst, b, h) do { _Pragma("unroll") for (int n = 0; n < 2; ++n) _Pragma("unroll") for (int k = 0; k < 2; ++k) dst[n][k] = *(const LAS bf16x8*)(lds + PG8_SB(b, h) + boff + n * 2048 + k * 1024); } while (0)
#define PG8_MMA(ai, bj, At, Bt) do { __builtin_amdgcn_s_setprio(1); _Pragma("unroll") for (int m = 0; m < 4; ++m) _Pragma("unroll") for (int n = 0; n < 2; ++n) _Pragma("unroll") for (int k = 0; k < 2; ++k) \
        acc[ai][bj][m][n] = __builtin_amdgcn_mfma_f32_16x16x32_bf16(Bt[n][k], At[m][k], acc[ai][bj][m][n], 0, 0, 0); __builtin_amdgcn_s_setprio(0); } while (0)
#define PG8_WAIT_V(n) asm volatile("s_waitcnt vmcnt(" #n ")" ::: "memory")
#define PG8_WAIT_L(n) asm volatile("s_waitcnt lgkmcnt(" #n ")" ::: "memory")
#define PG8_BAR __builtin_amdgcn_s_barrier()
#define PG8_SCHED __builtin_amdgcn_sched_barrier(0)
    Unit cur, nxt; int ui = 0;
    if (!S.next(0, cur)) return;
    f32x4 acc[2][2][4][2];
#pragma unroll
    for (int a = 0; a < 2; ++a)
#pragma unroll
        for (int b = 0; b < 2; ++b)
#pragma unroll
            for (int m = 0; m < 4; ++m)
#pragma unroll
                for (int n = 0; n < 2; ++n) acc[a][b][m][n] = (f32x4){0.f, 0.f, 0.f, 0.f};
    bf16x8 At[4][2], B0[2][2], B1[2][2];
    const char* cA = (const char*)g.A + (size_t)cur.pm * tstepA; const char* cB = (const char*)g.Bt + (size_t)cur.pn * tstepB;
    PG8_STAGE(PG8_SB(0, 0), cB, voffB); PG8_STAGE(PG8_SB(0, 1), cB + hstepB, voffB); PG8_STAGE(PG8_SA(0, 0), cA, voffA); PG8_STAGE(PG8_SA(0, 1), cA + hstepA, voffA);
    if (wr == 1) PG8_BAR;
    PG8_WAIT_V(2); PG8_BAR;
    PG8_STAGE(PG8_SB(1, 0), cB + kstep, voffB); PG8_STAGE(PG8_SA(1, 0), cA + kstep, voffA); PG8_STAGE(PG8_SB(1, 1), cB + hstepB + kstep, voffB);
    PG8_WAIT_V(6); PG8_BAR;
    for (;;) {
        const bool has_next = S.next(ui + 1, nxt);
        const char* nA = has_next ? (const char*)g.A + (size_t)nxt.pm * tstepA : cA; const char* nB = has_next ? (const char*)g.Bt + (size_t)nxt.pn * tstepB : cB;
        for (int t = 0; t < nt; t += 2) {
            const bool last = (t == nt - 2);
            const char* a1 = cA + (size_t)(t + 1) * kstep;
            const char* a2 = last ? nA : cA + (size_t)(t + 2) * kstep; const char* b2 = last ? nB : cB + (size_t)(t + 2) * kstep;
            const char* a3 = a2 + kstep; const char* b3 = b2 + kstep;
            PG8_LDB(B0, 0, 0); PG8_LDB(B1, 0, 1); PG8_SCHED; PG8_LDA(At, 0, 0); PG8_STAGE(PG8_SA(1, 1), a1 + hstepA, voffA);
            PG8_WAIT_V(8); PG8_WAIT_L(0); PG8_BAR; PG8_MMA(0, 0, At, B0); PG8_MMA(0, 1, At, B1); PG8_BAR; PG8_SCHED;
            PG8_LDA(At, 0, 1); PG8_STAGE(PG8_SB(0, 0), b2, voffB); PG8_STAGE(PG8_SB(0, 1), b2 + hstepB, voffB); PG8_STAGE(PG8_SA(0, 0), a2, voffA);
            PG8_WAIT_V(8); PG8_WAIT_L(0); PG8_BAR; PG8_MMA(1, 0, At, B0); PG8_MMA(1, 1, At, B1); PG8_BAR; PG8_SCHED;
            PG8_LDB(B0, 1, 0); PG8_LDB(B1, 1, 1); PG8_SCHED; PG8_LDA(At, 1, 0); PG8_STAGE(PG8_SA(0, 1), a2 + hstepA, voffA);
            PG8_WAIT_V(8); PG8_WAIT_L(0); PG8_BAR; PG8_MMA(0, 0, At, B0); PG8_MMA(0, 1, At, B1); PG8_BAR; PG8_SCHED;
            PG8_LDA(At, 1, 1); PG8_STAGE(PG8_SB(1, 0), b3, voffB); PG8_STAGE(PG8_SB(1, 1), b3 + hstepB, voffB); PG8_STAGE(PG8_SA(1, 0), a3, voffA);
            PG8_WAIT_V(8); PG8_WAIT_L(0); PG8_BAR; PG8_MMA(1, 0, At, B0); PG8_MMA(1, 1, At, B1); PG8_BAR; PG8_SCHED;
        }
        if constexpr (ALIGN_EPI) { if (wr == 0) PG8_BAR; }
        if constexpr (!Epi::AFTER_DRAIN) E(acc, cur, wr, wc, fr, fq);
        if (!has_next) break;
#pragma unroll
        for (int a = 0; a < 2; ++a)
#pragma unroll
            for (int b = 0; b < 2; ++b)
#pragma unroll
                for (int m = 0; m < 4; ++m)
#pragma unroll
                    for (int n = 0; n < 2; ++n) acc[a][b][m][n] = (f32x4){0.f, 0.f, 0.f, 0.f};
        cur = nxt; cA = nA; cB = nB; ++ui;
        if constexpr (ALIGN_EPI) { if (wr == 1) PG8_BAR; }
    }
    PG8_WAIT_V(0);
    if constexpr (!ALIGN_EPI) { if (wr == 0) PG8_BAR; }
    PG8_BAR;
    if constexpr (Epi::AFTER_DRAIN) E.fused(acc, cur, wr, wc, fr, fq, lds, wid, lane);
#undef PG8_SA
#undef PG8_SB
#undef PG8_STAGE
#undef PG8_LDA
#undef PG8_LDB
#undef PG8_MMA
#undef PG8_WAIT_V
#undef PG8_WAIT_L
#undef PG8_BAR
#undef PG8_SCHED
}

typedef f32x4 AccT[2][2][4][2];

struct EpiInProj {
    static constexpr bool AFTER_DRAIN = false;
    bf16_t* P; bf16_t* VT; const float* rope; bf16_t* BND;
    __device__ __forceinline__ void operator()(AccT& acc, const Unit& u, int wr, int wc, int fr, int fq) const {
        const int row0 = u.pm * BM + wr * 64 + fr, colb = u.pn * BM + wc * 32 + 8 * fq;
#pragma unroll
        for (int ai = 0; ai < 2; ++ai)
#pragma unroll
            for (int m = 0; m < 4; ++m) {
                const int row = row0 + ai * HALF + m * 16, t = row & (SEQ - 1);
                bf16_t* rowp = P + (size_t)row * LDP + COL_PA;
#pragma unroll
                for (int bj = 0; bj < 2; ++bj) {
                    const int c = colb + bj * HALF;
                    f32x4 v0 = acc[ai][bj][m][0], v1 = acc[ai][bj][m][1];
                    if (u.pn >= 15) {
                        const int cl = c - 3840;
                        if (cl < 640 || (cl >= 768 && cl < 1088)) {
                            const float* cs = rope + ((size_t)t * 32 + ((cl & 63) >> 1)) * 2;
                            const f32x4 r0 = *(const f32x4*)cs, r1 = *(const f32x4*)(cs + 4);
                            f32x4 o0, o1;
                            o0[0] = v0[0] * r0[0] - v0[1] * r0[1]; o0[1] = v0[1] * r0[0] + v0[0] * r0[1];
                            o0[2] = v0[2] * r0[2] - v0[3] * r0[3]; o0[3] = v0[3] * r0[2] + v0[2] * r0[3];
                            o1[0] = v1[0] * r1[0] - v1[1] * r1[1]; o1[1] = v1[1] * r1[0] + v1[0] * r1[1];
                            o1[2] = v1[2] * r1[2] - v1[3] * r1[3]; o1[3] = v1[3] * r1[2] + v1[2] * r1[3];
                            v0 = o0; v1 = o1;
                        }
                    }
                    u32x4 w; w.x = cvt_pk_bf16(v0[0], v0[1]); w.y = cvt_pk_bf16(v0[2], v0[3]); w.z = cvt_pk_bf16(v1[0], v1[1]); w.w = cvt_pk_bf16(v1[2], v1[3]);
                    *(u32x4*)(rowp + c) = w;
                    if (u.pn < 7 && fr == 15) *(u32x4*)(BND + (size_t)(row >> 4) * 1792 + c) = w;
                    if (u.pn == 17 && bj == 1) {
                        const int cv = c - 3840 - 640, b = row >> 11;
                        bf16_t* vt = VT + ((size_t)(b * 2 + (cv >> 6)) * 64 + (cv & 63)) * SEQ + t;
                        vt[0 * SEQ] = (bf16_t)(w.x & 0xffffu); vt[1 * SEQ] = (bf16_t)(w.x >> 16);
                        vt[2 * SEQ] = (bf16_t)(w.y & 0xffffu); vt[3 * SEQ] = (bf16_t)(w.y >> 16);
                        vt[4 * SEQ] = (bf16_t)(w.z & 0xffffu); vt[5 * SEQ] = (bf16_t)(w.z >> 16);
                        vt[6 * SEQ] = (bf16_t)(w.w & 0xffffu); vt[7 * SEQ] = (bf16_t)(w.w >> 16);
                    }
                }
            }
    }
};
struct EpiGate {
    static constexpr bool AFTER_DRAIN = false;
    bf16_t* P; bf16_t* Gb; int Gs;
    __device__ __forceinline__ void operator()(AccT& acc, const Unit& u, int wr, int wc, int fr, int fq) const {
        const int row0 = u.pm * BM + wr * 64 + fr, colb = u.pn * BM + wc * 32 + 8 * fq;
#pragma unroll
        for (int ai = 0; ai < 2; ++ai)
#pragma unroll
            for (int m = 0; m < 4; ++m) {
                bf16_t* rowp = Gb + (size_t)(row0 + ai * HALF + m * 16) * Gs + colb;
#pragma unroll
                for (int bj = 0; bj < 2; ++bj) {
                    const f32x4 v0 = acc[ai][bj][m][0], v1 = acc[ai][bj][m][1];
                    u32x4 w; w.x = cvt_pk_bf16(sigmoidf_(v0[0]), sigmoidf_(v0[1])); w.y = cvt_pk_bf16(sigmoidf_(v0[2]), sigmoidf_(v0[3]));
                    w.z = cvt_pk_bf16(sigmoidf_(v1[0]), sigmoidf_(v1[1])); w.w = cvt_pk_bf16(sigmoidf_(v1[2]), sigmoidf_(v1[3]));
                    *(u32x4*)(rowp + bj * HALF) = w;
                }
            }
    }
};
struct EpiMergeAcc {
    static constexpr bool AFTER_DRAIN = false;
    bf16_t* P; int first; const bf16_t* Gb; int Gs;
    __device__ __forceinline__ void operator()(AccT& acc, const Unit& u, int wr, int wc, int fr, int fq) const {
        const int row0 = u.pm * BM + wr * 64 + fr, colb = u.pn * BM + wc * 32 + 8 * fq;
#pragma unroll
        for (int ai = 0; ai < 2; ++ai)
#pragma unroll
            for (int m = 0; m < 4; ++m) {
                bf16_t* rowb = P + (size_t)(row0 + ai * HALF + m * 16) * LDP + colb;
#pragma unroll
                for (int bj = 0; bj < 2; ++bj) {
                    const f32x4 v0 = acc[ai][bj][m][0], v1 = acc[ai][bj][m][1];
                    const u32x4 gq = *(const u32x4*)(Gb + (size_t)(row0 + ai * HALF + m * 16) * Gs + colb + bj * HALF);
                    u32x4 mq = (u32x4){0u, 0u, 0u, 0u};
                    if (!first) mq = *(const u32x4*)(rowb + COL_MRG + bj * HALF);
                    const unsigned ga = gq.x, gb = gq.y, gc = gq.z, gd = gq.w;
                    const unsigned ma = mq.x, mb = mq.y, mc = mq.z, md = mq.w;
                    u32x4 w;
                    w.x = cvt_pk_bf16(bflo(ma) + bflo(ga) * v0[0], bfhi(ma) + bfhi(ga) * v0[1]);
                    w.y = cvt_pk_bf16(bflo(mb) + bflo(gb) * v0[2], bfhi(mb) + bfhi(gb) * v0[3]);
                    w.z = cvt_pk_bf16(bflo(mc) + bflo(gc) * v1[0], bfhi(mc) + bfhi(gc) * v1[1]);
                    w.w = cvt_pk_bf16(bflo(md) + bflo(gd) * v1[2], bfhi(md) + bfhi(gd) * v1[3]);
                    *(u32x4*)(rowb + COL_MRG + bj * HALF) = w;
                }
            }
    }
};
struct EpiResid {
    static constexpr bool AFTER_DRAIN = false;
    const float* base; float* out;
    __device__ __forceinline__ void operator()(AccT& acc, const Unit& u, int wr, int wc, int fr, int fq) const {
        const int row0 = u.pm * BM + wr * 64 + fr, colb = u.pn * BM + wc * 32 + 8 * fq;
#pragma unroll
        for (int ai = 0; ai < 2; ++ai)
#pragma unroll
            for (int m = 0; m < 4; ++m) {
                const size_t off = (size_t)(row0 + ai * HALF + m * 16) * DM + colb;
#pragma unroll
                for (int bj = 0; bj < 2; ++bj) {
                    const f32x4 b0 = *(const f32x4*)(base + off + bj * HALF), b1 = *(const f32x4*)(base + off + bj * HALF + 4);
                    *(f32x4*)(out + off + bj * HALF) = b0 + acc[ai][bj][m][0];
                    *(f32x4*)(out + off + bj * HALF + 4) = b1 + acc[ai][bj][m][1];
                }
            }
    }
};
struct EpiResidNorm {
    static constexpr bool AFTER_DRAIN = true;
    const float* base; float* out; const float* g; bf16_t* obf; float* of32; unsigned* xbuf; unsigned* cnt;
    __device__ __forceinline__ void fused(AccT& acc, const Unit& u, int wr, int wc, int fr, int fq, LAS unsigned char* lds, int wid, int lane) const {
        LAS float* Pl = (LAS float*)lds;
        LAS float* S = (LAS float*)(lds + 8192);
        const int row0 = u.pm * BM + wr * 64 + fr, colb = u.pn * BM + wc * 32 + 8 * fq;
#pragma unroll
        for (int ai = 0; ai < 2; ++ai)
#pragma unroll
            for (int m = 0; m < 4; ++m) {
                const size_t off = (size_t)(row0 + ai * HALF + m * 16) * DM + colb;
                float sq = 0.f;
#pragma unroll
                for (int bj = 0; bj < 2; ++bj) {
                    const f32x4 b0 = *(const f32x4*)(base + off + bj * HALF), b1 = *(const f32x4*)(base + off + bj * HALF + 4);
                    const f32x4 h0 = acc[ai][bj][m][0] + b0, h1 = acc[ai][bj][m][1] + b1;
                    acc[ai][bj][m][0] = h0; acc[ai][bj][m][1] = h1;
                    sq += (h0.x * h0.x + h0.y * h0.y) + (h0.z * h0.z + h0.w * h0.w) + (h1.x * h1.x + h1.y * h1.y) + (h1.z * h1.z + h1.w * h1.w);
                }
                sq += __shfl_xor(sq, 16); sq += __shfl_xor(sq, 32);
                if (fq == 0) Pl[(ai * HALF + wr * 64 + m * 16 + fr) * 4 + wc] = sq;
                if (m & 1) asm volatile("" ::: "memory");
            }
        asm volatile("s_waitcnt lgkmcnt(0)" ::: "memory"); __builtin_amdgcn_s_barrier(); asm volatile("" ::: "memory");
        const int row = wid * 32 + (lane & 31);
        if (lane < 32) {
            const f32x4 p = *(const LAS f32x4*)&Pl[row * 4];
            __hip_atomic_store(xbuf + ((size_t)(u.pm * BM + row) * 4 + u.pn), __builtin_bit_cast(unsigned, (p.x + p.y) + (p.z + p.w)), __ATOMIC_RELAXED, __HIP_MEMORY_SCOPE_AGENT);
        }
        asm volatile("s_waitcnt vmcnt(0)" ::: "memory");
        if (lane == 0) __hip_atomic_fetch_add(cnt + 64 * u.pm, 1u, __ATOMIC_RELAXED, __HIP_MEMORY_SCOPE_AGENT);
        if (wid == 0) {
            unsigned sp = 0u;
            while ((unsigned)__builtin_amdgcn_readfirstlane(__hip_atomic_load(cnt + 64 * u.pm, __ATOMIC_RELAXED, __HIP_MEMORY_SCOPE_AGENT)) < 32u) { __builtin_amdgcn_s_sleep(2); if (++sp > (1u << 22)) break; }
            __builtin_amdgcn_fence(__ATOMIC_ACQUIRE, "agent");
        }
        asm volatile("s_waitcnt vmcnt(0) lgkmcnt(0)" ::: "memory"); __builtin_amdgcn_s_barrier(); asm volatile("" ::: "memory");
        if (lane < 32) {
            const unsigned* slot = xbuf + (size_t)(u.pm * BM + row) * 4; float tot = 0.f;
#pragma unroll
            for (int t = 0; t < 4; ++t) tot += __builtin_bit_cast(float, __hip_atomic_load(slot + t, __ATOMIC_RELAXED, __HIP_MEMORY_SCOPE_AGENT));
            S[row] = 1.0f / sqrtf(tot * (1.f / DM) + 1e-6f);
        }
        asm volatile("s_waitcnt lgkmcnt(0)" ::: "memory"); __builtin_amdgcn_s_barrier(); asm volatile("" ::: "memory");
        f32x4 gv[2][2];
#pragma unroll
        for (int bj = 0; bj < 2; ++bj)
#pragma unroll
            for (int n = 0; n < 2; ++n) gv[bj][n] = *(const f32x4*)(g + colb + bj * HALF + 4 * n);
#pragma unroll
        for (int ai = 0; ai < 2; ++ai)
#pragma unroll
            for (int m = 0; m < 4; ++m) {
                const int rl = ai * HALF + wr * 64 + m * 16 + fr, rowg = u.pm * BM + rl;
                const float rs = S[rl];
#pragma unroll
                for (int bj = 0; bj < 2; ++bj) {
                    const f32x4 h0 = acc[ai][bj][m][0], h1 = acc[ai][bj][m][1];
                    const size_t off = (size_t)rowg * DM + colb + bj * HALF;
                    if (out) { *(f32x4*)(out + off) = h0; *(f32x4*)(out + off + 4) = h1; }
                    const f32x4 o0 = h0 * rs * gv[bj][0], o1 = h1 * rs * gv[bj][1];
                    if (obf) { u32x4 w; w.x = cvt_pk_bf16(o0[0], o0[1]); w.y = cvt_pk_bf16(o0[2], o0[3]); w.z = cvt_pk_bf16(o1[0], o1[1]); w.w = cvt_pk_bf16(o1[2], o1[3]);
                        *(u32x4*)(obf + (size_t)rowg * LDP + colb + bj * HALF) = w; }
                    else { *(f32x4*)(of32 + off) = o0; *(f32x4*)(of32 + off + 4) = o1; }
                }
                asm volatile("" ::: "memory");
            }
    }
};
struct EpiUp {
    static constexpr bool AFTER_DRAIN = false;
    bf16_t* P; float* HALO; const float* cw; const float* cb; LAS float* CW;
    __device__ __forceinline__ void operator()(AccT& acc, const Unit& u, int wr, int wc, int fr_in, int fq_in) const {
        int fr = fr_in, fq = fq_in;
        asm volatile("" : "+v"(fr), "+v"(fq));
        const int row0 = u.pm * BM + wr * 64 + fr;
        const int jb = u.pn * 128 + wc * 32 + 8 * fq;
        {
            const int tl = (wr * 4 + wc) * 64 + fq * 16 + fr;
#pragma unroll
            for (int it = 0; it < 2; ++it) { const int k = tl + 512 * it, p = k >> 8, col = k & 255, co = (col >> 7) * DFF + u.pn * 128 + (col & 127);
                CW[k] = (p < 3) ? cw[p * F2 + co] : cb[co]; }
            asm volatile("s_waitcnt lgkmcnt(0)" ::: "memory"); __builtin_amdgcn_s_barrier(); asm volatile("" ::: "memory");
        }
#pragma unroll
        for (int ai = 0; ai < 2; ++ai) {
            const int s = u.pm * 4 + ai * 2 + wr;
#pragma unroll
            for (int bj = 0; bj < 2; ++bj)
#pragma unroll
                for (int n = 0; n < 2; ++n) {
                    const int colp = u.pn * BM + bj * HALF + wc * 32 + 8 * fq + 4 * n;
                    if (fr < 2) *(f32x4*)(HALO + (size_t)(s * 4 + fr) * F2 + colp) = acc[ai][bj][0][n];
                    if (fr >= 14) *(f32x4*)(HALO + (size_t)(s * 4 + fr - 12) * F2 + colp) = acc[ai][bj][3][n];
                }
        }
#pragma unroll
        for (int ai = 0; ai < 2; ++ai)
#pragma unroll
            for (int m = 0; m < 4; ++m) {
                const int row = row0 + ai * HALF + m * 16;
#pragma unroll
                for (int n = 0; n < 2; ++n) {
                    f32x4 cv[2];
#pragma unroll
                    for (int bj = 0; bj < 2; ++bj) {
                        const int cl = bj * 128 + wc * 32 + 8 * fq + 4 * n;
                        const f32x4 w0 = *(const LAS f32x4*)&CW[cl], w1 = *(const LAS f32x4*)&CW[256 + cl], w2 = *(const LAS f32x4*)&CW[512 + cl], bb = *(const LAS f32x4*)&CW[768 + cl];
#pragma unroll
                        for (int e = 0; e < 4; ++e) {
                            const float cur = acc[ai][bj][m][n][e];
                            const float prv = m > 0 ? acc[ai][bj][m > 0 ? m - 1 : 0][n][e] : 0.f;
                            const float a1 = dpp_mov<0x121>(cur), a2 = dpp_mov<0x122>(cur), b1 = dpp_mov<0x121>(prv), b2 = dpp_mov<0x122>(prv);
                            const float p1 = fr >= 1 ? a1 : b1, p2 = fr >= 2 ? a2 : b2;
                            cv[bj][e] = bb[e] + w0[e] * p2 + w1[e] * p1 + w2[e] * cur;
                        }
                        __builtin_amdgcn_sched_barrier(0);
                    }
                    const f32x4 g0 = cv[0], v0 = cv[1];
                    u32x2 w;
                    w.x = cvt_pk_bf16(g0[0] * sigmoidf_(g0[0]) * v0[0], g0[1] * sigmoidf_(g0[1]) * v0[1]);
                    w.y = cvt_pk_bf16(g0[2] * sigmoidf_(g0[2]) * v0[2], g0[3] * sigmoidf_(g0[3]) * v0[3]);
                    if (!(m == 0 && fr < 2)) *(u32x2*)(P + (size_t)row * LDP + COL_ACT + jb + 4 * n) = w;
                    __builtin_amdgcn_sched_barrier(0);
                }
            }
    }
};
}

struct Ctx {
    const float* in[24]; float* out; unsigned char* ws;
    bf16_t* P; bf16_t* VT; float* HALO; float* ROPE;
    bf16_t *Win, *Wg, *Wbr, *Wo, *Wup, *Wdn;
    int tid, lane, wave, G, bid;
};

__device__ __forceinline__ int srccol(int mode, int n) {
    if (mode == 0) return n;
    if (mode == 2) return 4932 + n;
    if (mode == 3) { const int tile = n >> 8, w = n & 255, j = tile * 128 + (w & 127); return (w < 128) ? j : DFF + j; }
    if (n < 3840) return n;
    const int c = n - 3840;
    if (c >= 1092) return -1;
    if (c < 640 || (c >= 768 && c < 1088)) { const int base = c & ~63, i = c & 63; return 3840 + base + (i >> 1) + 32 * (i & 1); }
    return 3840 + c;
}
__device__ __forceinline__ void tr_item(const float* W, int ldw, int K, int N, bf16_t* WT, int mode, int item, LAS float* scr, int lane) {
    const int nblk = N / 32, kb = item / nblk, nb = item % nblk, k0 = 64 * kb, n0 = 32 * nb;
    const int sc = srccol(mode, n0 + (lane & 31));
    float wv_[32];
#pragma unroll
    for (int i = 0; i < 32; ++i) { const int kk = 2 * i + (lane >> 5); wv_[i] = (sc >= 0) ? W[(size_t)(k0 + kk) * ldw + sc] : 0.f; }
#pragma unroll
    for (int i = 0; i < 32; ++i) { const int kk = 2 * i + (lane >> 5); scr[kk * 33 + (lane & 31)] = wv_[i]; }
    asm volatile("s_waitcnt lgkmcnt(0)" ::: "memory");
    const int c = lane & 7;
#pragma unroll
    for (int j = 0; j < 4; ++j) { const int n = (lane >> 3) + 8 * j; const LAS float* s = scr + (8 * c) * 33 + n;
        u32x4 o; o.x = pk2(s[0 * 33], s[1 * 33]); o.y = pk2(s[2 * 33], s[3 * 33]); o.z = pk2(s[4 * 33], s[5 * 33]); o.w = pk2(s[6 * 33], s[7 * 33]);
        *(u32x4*)(WT + (size_t)(n0 + n) * K + k0 + 8 * c) = o; }
    asm volatile("s_waitcnt lgkmcnt(0)" ::: "memory");
}
__device__ __forceinline__ void rms_row(const float* xrow, const float* g, bf16_t* obf, float* of32, int lane) {
    const f32x4* xr = (const f32x4*)xrow + lane; const f32x4* gr = (const f32x4*)g + lane;
    f32x4 v[4]; float s = 0.f;
#pragma unroll
    for (int j = 0; j < 4; ++j) { v[j] = xr[64 * j]; s += (v[j].x * v[j].x + v[j].y * v[j].y) + (v[j].z * v[j].z + v[j].w * v[j].w); }
    const float rs = 1.f / sqrtf(wave_sum(s) * (1.f / DM) + 1e-6f);
#pragma unroll
    for (int j = 0; j < 4; ++j) {
        const f32x4 gg = gr[64 * j]; const f32x4 o = v[j] * rs * gg;
        if (obf) { u32x2 w; w.x = pk2(o.x, o.y); w.y = pk2(o.z, o.w); *((u32x2*)obf + lane + 64 * j) = w; }
        else *((f32x4*)of32 + lane + 64 * j) = o;
    }
}
__device__ __forceinline__ void rms_pass(const Ctx& X, const float* src, const float* g, bf16_t* obf, float* of32) {
    const int gw = X.bid * 8 + X.wave, NGW = X.G * 8, lane = X.lane;
    const f32x4* gr = (const f32x4*)g + lane;
    f32x4 gg[4];
#pragma unroll
    for (int j = 0; j < 4; ++j) gg[j] = gr[64 * j];
#pragma unroll 1
    for (int m = gw; m < T_TOK; m += 4 * NGW) {
        f32x4 v[4][4]; float ss[4]; int mr[4];
#pragma unroll
        for (int r = 0; r < 4; ++r) { mr[r] = m + r * NGW; const int ml = mr[r] < T_TOK ? mr[r] : m; const f32x4* x = (const f32x4*)(src + (size_t)ml * DM) + lane;
#pragma unroll
            for (int j = 0; j < 4; ++j) v[r][j] = x[64 * j]; }
#pragma unroll
        for (int r = 0; r < 4; ++r) { float a = 0.f;
#pragma unroll
            for (int j = 0; j < 4; ++j) a += (v[r][j].x * v[r][j].x + v[r][j].y * v[r][j].y) + (v[r][j].z * v[r][j].z + v[r][j].w * v[r][j].w);
            ss[r] = 1.f / sqrtf(wave_sum(a) * (1.f / DM) + 1e-6f); }
#pragma unroll
        for (int r = 0; r < 4; ++r) {
            if (mr[r] < T_TOK) {
#pragma unroll
                for (int j = 0; j < 4; ++j) {
                    const f32x4 o = v[r][j] * ss[r] * gg[j];
                    if (obf) { u32x2 w; w.x = pk2(o.x, o.y); w.y = pk2(o.z, o.w); *((u32x2*)(obf + (size_t)mr[r] * LDP) + lane + 64 * j) = w; }
                    else *((f32x4*)(of32 + (size_t)mr[r] * DM) + lane + 64 * j) = o;
                }
            }
        }
    }
}
constexpr int I_IN = 16 * 160, I_G = 16 * 96, I_BR = 8 * 32, I_O = 16 * 32, I_UP = 16 * 176, I_DN = 44 * 32;
constexpr int NITEMS = I_IN + I_G + 3 * I_BR + I_O + I_UP + I_DN, NEARLY = I_IN + I_G + 3 * I_BR + I_O;
__device__ __forceinline__ void phase_prep(const Ctx& X, LAS unsigned char* lds, int layer, bool do_u, int it_lo, int it_hi, int gw, int NGW) {
    LAS float* scr = (LAS float*)(lds + X.wave * 8448);
    const float* w_in = X.in[2] + (size_t)layer * DM * IN_COLS;
    const float* w_br = X.in[16] + (size_t)layer * 3 * 512 * DM;
    const float* w_o = X.in[17] + (size_t)layer * DM * DM;
    const float* w_up = X.in[19] + (size_t)layer * DM * F2;
    const float* w_dn = X.in[22] + (size_t)layer * DFF * DM;
    for (int it = it_lo + gw; it < it_hi; it += NGW) {
        int r = it;
        if (r < I_IN) { tr_item(w_in, IN_COLS, DM, 5120, X.Win, 1, r, scr, X.lane); continue; } r -= I_IN;
        if (r < I_G) { tr_item(w_in, IN_COLS, DM, 3072, X.Wg, 2, r, scr, X.lane); continue; } r -= I_G;
        if (r < 3 * I_BR) { const int b = r / I_BR; tr_item(w_br + (size_t)b * 512 * DM, DM, 512, DM, X.Wbr + (size_t)b * DM * 512, 0, r % I_BR, scr, X.lane); continue; } r -= 3 * I_BR;
        if (r < I_O) { tr_item(w_o, DM, DM, DM, X.Wo, 0, r, scr, X.lane); continue; } r -= I_O;
        if (r < I_UP) { tr_item(w_up, F2, DM, F2, X.Wup, 3, r, scr, X.lane); continue; } r -= I_UP;
        tr_item(w_dn, DM, DFF, DM, X.Wdn, 0, r, scr, X.lane);
    }
    const float* h = (layer == 0) ? X.in[0] : X.out;
    const float* g = X.in[1] + (size_t)layer * DM;
    if (do_u) rms_pass(X, h, g, X.P, nullptr);
    if (layer == 0 && it_lo == 0) {
        for (int idx = X.bid * 512 + X.tid; idx < SEQ * 32; idx += X.G * 512) {
            const int t = idx >> 5, p = idx & 31;
            const float inv = exp2f(-(float)p * 0.03125f * 13.287712379549449f);
            const float ang = (float)t * inv;
            const double rev = (double)ang * 0.15915494309189535;
            const float fr = (float)(rev - floor(rev));
            X.ROPE[2 * idx] = __builtin_amdgcn_cosf(fr); X.ROPE[2 * idx + 1] = __builtin_amdgcn_sinf(fr);
        }
    }
}

__device__ __forceinline__ float wave_sum_fast(float x) {
    x = red16(x);
    const float r0 = __builtin_bit_cast(float, __builtin_amdgcn_readlane(__builtin_bit_cast(int, x), 0)), r1 = __builtin_bit_cast(float, __builtin_amdgcn_readlane(__builtin_bit_cast(int, x), 16));
    const float r2 = __builtin_bit_cast(float, __builtin_amdgcn_readlane(__builtin_bit_cast(int, x), 32)), r3 = __builtin_bit_cast(float, __builtin_amdgcn_readlane(__builtin_bit_cast(int, x), 48));
    return (r0 + r1) + (r2 + r3);
}
#define LDS_BAR() do { asm volatile("s_waitcnt lgkmcnt(0)" ::: "memory"); __builtin_amdgcn_s_barrier(); asm volatile("" ::: "memory"); } while (0)
constexpr int RW_TS = 16, RW_NCH = SEQ / RW_TS, RW_BUF = 33280;
__device__ __forceinline__ void phase_rwkv_pre(const Ctx& X, LAS unsigned char* lds, int layer) {
    LAS float* Rr = (LAS float*)(lds);           LAS float* Kk = (LAS float*)(lds + 8192);   LAS float* Vv = (LAS float*)(lds + 16384);
    LAS float* W1 = (LAS float*)(lds + 24576);   LAS float* AS = (LAS float*)(lds + 32768);
    LAS bf16_t* WDb = (LAS bf16_t*)(lds + 40960);
    LAS bf16_t* ADb = (LAS bf16_t*)(lds + 45568);
    LAS bf16_t* WTu = (LAS bf16_t*)(lds + 50176);
    LAS bf16_t* WTa = (LAS bf16_t*)(lds + 59392);
    LAS float* MU = (LAS float*)(lds + 68608);
    const int tid = X.tid, lane = tid & 63, wv = X.wave;
    const float* mu = X.in[3] + layer * 1792;
    const float* w0 = X.in[4] + layer * 512;   const float* w_up = X.in[5] + (size_t)layer * 64 * 512;
    const float* a0 = X.in[6] + layer * 512;   const float* a_up = X.in[7] + (size_t)layer * 64 * 512;
    const float* k_k = X.in[9] + layer * 512;  const float* k_a = X.in[10] + layer * 512;  const float* r_k = X.in[11] + layer * 512;
    const bf16_t* BND = (const bf16_t*)(X.ws + WS_BND);
    float* SCAL = (float*)(X.ws + WS_SCAL);
    const int ln = lane & 15, lg = lane >> 4;
    int last_h = -1;
    float q_w0 = 0.f, q_a0 = 0.f;
    f32x4 p_kk4 = (f32x4){0.f, 0.f, 0.f, 0.f}, p_ka4 = p_kk4, p_rk4 = p_kk4;
    const int cg4 = (tid & 15) * 4;
    u32x4 pc4[3], pp4[3], gc4, gp4; bool have_pf = false;
    pc4[0] = pc4[1] = pc4[2] = pp4[0] = pp4[1] = pp4[2] = gc4 = gp4 = (u32x4){0u, 0u, 0u, 0u};
#define PRE_LOAD(uu) do { const int h_ = (uu) & 7, tp_ = (uu) >> 3; _Pragma("unroll") for (int it = 0; it < 3; ++it) { const int idx = tid + 512 * it; pc4[it] = (u32x4){0u, 0u, 0u, 0u}; pp4[it] = (u32x4){0u, 0u, 0u, 0u}; \
        if (idx < 32 * 40) { const int tt = idx / 40, vv = idx - tt * 40; \
            const int col = vv < 8 ? h_ * 64 + 8 * vv : (vv < 16 ? 512 + h_ * 64 + 8 * (vv - 8) : (vv < 24 ? 1024 + h_ * 64 + 8 * (vv - 16) : 1536 + 8 * (vv - 24))); \
            const size_t row = (size_t)tp_ * 32 + tt; pc4[it] = *(const u32x4*)(X.P + row * LDP + COL_PA + col); \
            if (tt > 0) pp4[it] = *(const u32x4*)(X.P + (row - 1) * LDP + COL_PA + col); else if ((tp_ & 63) != 0) pp4[it] = *(const u32x4*)(BND + (size_t)(2 * tp_ - 1) * 1792 + col); } } \
        if (tid < 64) { const int tt = tid >> 1, col = 1664 + 8 * (2 * h_ + (tid & 1)); const size_t row = (size_t)tp_ * 32 + tt; gc4 = *(const u32x4*)(X.P + row * LDP + COL_PA + col); gp4 = (u32x4){0u, 0u, 0u, 0u}; \
            if (tt > 0) gp4 = *(const u32x4*)(X.P + (row - 1) * LDP + COL_PA + col); else if ((tp_ & 63) != 0) gp4 = *(const u32x4*)(BND + (size_t)(2 * tp_ - 1) * 1792 + col); } } while (0)
#pragma unroll 1
    for (int u = X.bid; u < 4096; u += X.G) {
        const int h = u & 7, tp = u >> 3;
        if (h != last_h) {
            __syncthreads();
            for (int idx = tid; idx < 64 * 64; idx += 512) { const int m = idx >> 6, cc = idx & 63;
                WTu[cc * 72 + m] = (bf16_t)f2bf(w_up[m * 512 + h * 64 + cc]); WTa[cc * 72 + m] = (bf16_t)f2bf(a_up[m * 512 + h * 64 + cc]); }
            if (tid < 320) { const int cc = tid; const int col = cc < 64 ? h * 64 + cc : (cc < 128 ? 512 + h * 64 + cc - 64 : (cc < 192 ? 1024 + h * 64 + cc - 128 : 1536 + cc - 192)); MU[cc] = mu[col]; }
            p_kk4 = *(const f32x4*)(k_k + h * 64 + cg4); p_ka4 = *(const f32x4*)(k_a + h * 64 + cg4); p_rk4 = *(const f32x4*)(r_k + h * 64 + cg4);
            q_w0 = w0[h * 64 + 16 * (wv >> 1) + ln]; q_a0 = a0[h * 64 + 16 * (wv >> 1) + ln];
            last_h = h;
            __syncthreads();
        }
        if (!have_pf) { PRE_LOAD(u); }
#pragma unroll
        for (int it = 0; it < 3; ++it) {
            const int idx = tid + 512 * it;
            if (idx < 32 * 40) {
                const int tt = idx / 40, vv = idx - tt * 40, cc0 = 8 * vv;
                const u32x4 c4 = pc4[it], p4 = pp4[it];
                const f32x4 m0 = *(const LAS f32x4*)&MU[cc0], m1 = *(const LAS f32x4*)&MU[cc0 + 4];
                float cur[8], prv[8], val[8];
                cur[0] = bflo(c4.x); cur[1] = bfhi(c4.x); cur[2] = bflo(c4.y); cur[3] = bfhi(c4.y); cur[4] = bflo(c4.z); cur[5] = bfhi(c4.z); cur[6] = bflo(c4.w); cur[7] = bfhi(c4.w);
                prv[0] = bflo(p4.x); prv[1] = bfhi(p4.x); prv[2] = bflo(p4.y); prv[3] = bfhi(p4.y); prv[4] = bflo(p4.z); prv[5] = bfhi(p4.z); prv[6] = bflo(p4.w); prv[7] = bfhi(p4.w);
#pragma unroll
                for (int e = 0; e < 8; ++e) val[e] = cur[e] + (prv[e] - cur[e]) * (e < 4 ? m0[e & 3] : m1[e & 3]);
                if (vv < 24) {
#pragma unroll
                    for (int e = 0; e < 8; e += 2) { const unsigned w_ = pk2(val[e], val[e + 1]); val[e] = bflo(w_); val[e + 1] = bfhi(w_); }
                    LAS float* dst = (vv < 8 ? Rr : (vv < 16 ? Kk : Vv)) + tt * 64 + 8 * (vv & 7);
                    *(LAS f32x4*)dst = (f32x4){val[0], val[1], val[2], val[3]}; *(LAS f32x4*)(dst + 4) = (f32x4){val[4], val[5], val[6], val[7]};
                } else {
                    const int lr0 = 8 * (vv - 24);
                    LAS bf16_t* dst;
                    if (lr0 < 64) { dst = WDb + tt * 72 + lr0;
#pragma unroll
                        for (int e = 0; e < 8; ++e) { const float ex = __expf(2.f * val[e]); val[e] = 1.f - 2.f / (ex + 1.f); } }
                    else dst = ADb + tt * 72 + lr0 - 64;
                    u32x4 o; o.x = pk2(val[0], val[1]); o.y = pk2(val[2], val[3]); o.z = pk2(val[4], val[5]); o.w = pk2(val[6], val[7]);
                    *(LAS u32x4*)dst = o;
                }
            }
        }
        if (tid < 64) {
            const int tt = tid >> 1, vg = 2 * h + (tid & 1);
            const f32x4 m0 = *(const f32x4*)(mu + 1664 + 8 * vg), m1 = *(const f32x4*)(mu + 1664 + 8 * vg + 4);
            float gc[8], gp[8];
            gc[0] = bflo(gc4.x); gc[1] = bfhi(gc4.x); gc[2] = bflo(gc4.y); gc[3] = bfhi(gc4.y); gc[4] = bflo(gc4.z); gc[5] = bfhi(gc4.z); gc[6] = bflo(gc4.w); gc[7] = bfhi(gc4.w);
            gp[0] = bflo(gp4.x); gp[1] = bfhi(gp4.x); gp[2] = bflo(gp4.y); gp[3] = bfhi(gp4.y); gp[4] = bflo(gp4.z); gp[5] = bfhi(gp4.z); gp[6] = bflo(gp4.w); gp[7] = bfhi(gp4.w);
#pragma unroll
            for (int e = 0; e < 8; ++e) gc[e] = sigmoidf_(gc[e] + (gp[e] - gc[e]) * (e < 4 ? m0[e & 3] : m1[e & 3]));
            u32x4 o; o.x = pk2(gc[0], gc[1]); o.y = pk2(gc[2], gc[3]); o.z = pk2(gc[4], gc[5]); o.w = pk2(gc[6], gc[7]);
            *(u32x4*)(X.P + ((size_t)tp * 32 + tt) * LDP + COL_GS + 8 * vg) = o;
        }
        have_pf = false;
        if (u + X.G < 4096 && ((u + X.G) & 7) == h) { PRE_LOAD(u + X.G); have_pf = true; }
        LDS_BAR();
        {
            const int mt = wv & 1, nt = wv >> 1, chm = 16 * nt + ln;
            f32x4 cw_ = (f32x4){0.f, 0.f, 0.f, 0.f}, ca_ = cw_;
#pragma unroll
            for (int ks = 0; ks < 2; ++ks) {
                const bf16x8 xa = *(const LAS bf16x8*)&WDb[(16 * mt + ln) * 72 + ks * 32 + 8 * lg], xb = *(const LAS bf16x8*)&WTu[(16 * nt + ln) * 72 + ks * 32 + 8 * lg];
                cw_ = __builtin_amdgcn_mfma_f32_16x16x32_bf16(xa, xb, cw_, 0, 0, 0);
                const bf16x8 ya = *(const LAS bf16x8*)&ADb[(16 * mt + ln) * 72 + ks * 32 + 8 * lg], yb = *(const LAS bf16x8*)&WTa[(16 * nt + ln) * 72 + ks * 32 + 8 * lg];
                ca_ = __builtin_amdgcn_mfma_f32_16x16x32_bf16(ya, yb, ca_, 0, 0, 0);
            }
#pragma unroll
            for (int r = 0; r < 4; ++r) {
                const int tt = 16 * mt + 4 * lg + r;
                const float z = -(q_w0 + cw_[r]);
                const float sp = fmaxf(z, 0.f) + __logf(1.f + __expf(-fabsf(z)));
                const float e = __expf(-sp - 0.5f);
                W1[tt * 64 + chm] = bf2f((bf16_t)f2bf(-expm1f(-e)));
                AS[tt * 64 + chm] = bf2f((bf16_t)f2bf(sigmoidf_(q_a0 + ca_[r])));
            }
        }
        LDS_BAR();
        {
            const int tt = tid >> 4;
            const size_t row = (size_t)tp * 32 + tt;
            const f32x4 w1 = *(const LAS f32x4*)&W1[tt * 64 + cg4], a = *(const LAS f32x4*)&AS[tt * 64 + cg4];
            const f32x4 kraw = *(const LAS f32x4*)&Kk[tt * 64 + cg4], r = *(const LAS f32x4*)&Rr[tt * 64 + cg4], v = *(const LAS f32x4*)&Vv[tt * 64 + cg4];
            const f32x4 kk0 = kraw * p_kk4;
            const float inv = 1.f / sqrtf(fmaxf(red16((kk0.x * kk0.x + kk0.y * kk0.y) + (kk0.z * kk0.z + kk0.w * kk0.w)), 1e-24f));
            const f32x4 kk = kk0 * inv;
            const f32x4 kmod = kraw * (1.f + (a - 1.f) * p_ka4);
            const f32x4 bvec = kk * a, t1 = bvec * r, t2 = kmod * r, t3 = t2 * p_rk4;
            const float br = red16((t1.x + t1.y) + (t1.z + t1.w)), kr = red16((t2.x + t2.y) + (t2.z + t2.w)), bonus = red16((t3.x + t3.y) + (t3.z + t3.w));
            bf16_t* rp_ = X.P + row * LDP;
            u32x2 o;
            o.x = pk2(r.x, r.y); o.y = pk2(r.z, r.w); *(u32x2*)(rp_ + COL_PA + h * 64 + cg4) = o;
            o.x = pk2(kraw.x, kraw.y); o.y = pk2(kraw.z, kraw.w); *(u32x2*)(rp_ + COL_PA + 512 + h * 64 + cg4) = o;
            o.x = pk2(v.x, v.y); o.y = pk2(v.z, v.w); *(u32x2*)(rp_ + COL_PA + 1024 + h * 64 + cg4) = o;
            bf16_t* wa_ = (layer == 0) ? (bf16_t*)X.out + row * 2048 : rp_;
            o.x = pk2(w1.x, w1.y); o.y = pk2(w1.z, w1.w); *(u32x2*)(wa_ + h * 64 + cg4) = o;
            o.x = pk2(a.x, a.y); o.y = pk2(a.z, a.w); *(u32x2*)(wa_ + 512 + h * 64 + cg4) = o;
            if (cg4 == 0) *(f32x4*)(SCAL + (row * 8 + h) * 4) = (f32x4){inv, br, kr, bonus};
        }
        LDS_BAR();
    }
}

__device__ __forceinline__ void rwkv_task(const Ctx& X, LAS unsigned char* lds, int layer, int b, int h) {
    LAS bf16_t* GDb = (LAS bf16_t*)(lds + 66560);
    LAS bf16_t* WTg = (LAS bf16_t*)(lds + 75264);
    LAS float* BON = (LAS float*)(lds + 92672);
    const int tid = X.tid, lane = tid & 63;
    const bool helper = X.wave >= 4;
    const int ht = tid & 255;
    const float* mu = X.in[3] + layer * 1792;
    const float* g_up = X.in[8] + (size_t)layer * 128 * 512;
    const float* k_k = X.in[9] + layer * 512;  const float* k_a = X.in[10] + layer * 512;
    const float* gn_g = X.in[12] + layer * 512; const float* gn_b = X.in[13] + layer * 512;
    const float* SCAL = (const float*)(X.ws + WS_SCAL);
    const int tt_h = ht >> 4, cg4 = (ht & 15) * 4;
    const f32x4 p_kk = *(const f32x4*)(k_k + h * 64 + cg4), p_ka = *(const f32x4*)(k_a + h * 64 + cg4);
    const f32x4 p_gg = *(const f32x4*)(gn_g + h * 64 + cg4), p_gb = *(const f32x4*)(gn_b + h * 64 + cg4);
    const int gv8 = (ht & 15) * 8;
    const int nt = (ht >> 6), ln = lane & 15, lg = lane >> 4, chm = 16 * nt + ln;
    const int rp = ht >> 3, jg = ht & 7, i0 = 2 * rp;
    for (int idx = tid; idx < 128 * 64; idx += 512) { const int m = idx >> 6, cc = idx & 63; WTg[cc * 136 + m] = (bf16_t)f2bf(g_up[m * 512 + h * 64 + cc]); }
    f32x2 S0[4], S1[4];
#pragma unroll
    for (int j = 0; j < 4; ++j) { S0[j] = (f32x2){0.f, 0.f}; S1[j] = (f32x2){0.f, 0.f}; }
#if PROBE_SCAN2
    f32x2 T0[4], T1[4];
#pragma unroll
    for (int j = 0; j < 4; ++j) { T0[j] = (f32x2){0.f, 0.f}; T1[j] = (f32x2){0.f, 0.f}; }
#endif
    __syncthreads();

#define RW_ARR(bufi, k) ((LAS float*)(lds + (bufi) * RW_BUF + (k) * 4096))
#define RW_SC(bufi) ((LAS float*)(lds + (bufi) * RW_BUF + 32768))
#define RW_LOAD(chk, L) do { const size_t row_ = (size_t)b * SEQ + (chk) * RW_TS + tt_h; const bf16_t* rp_ = X.P + row_ * LDP; \
        l_r##L = *(const u32x2*)(rp_ + COL_PA + h * 64 + cg4); l_k##L = *(const u32x2*)(rp_ + COL_PA + 512 + h * 64 + cg4); l_v##L = *(const u32x2*)(rp_ + COL_PA + 1024 + h * 64 + cg4); \
        { const bf16_t* wa_ = (layer == 0) ? (const bf16_t*)X.out + row_ * 2048 : rp_; l_w##L = *(const u32x2*)(wa_ + h * 64 + cg4); l_a##L = *(const u32x2*)(wa_ + 512 + h * 64 + cg4); } l_s##L = *(const f32x4*)(SCAL + (row_ * 8 + h) * 4); \
        l_gc##L = *(const u32x4*)(rp_ + COL_GS + gv8); } while (0)
    u32x2 l_rA, l_kA, l_vA, l_wA, l_aA; f32x4 l_sA; u32x4 l_gcA;
    u32x2 l_rB, l_kB, l_vB, l_wB, l_aB; f32x4 l_sB; u32x4 l_gcB;
    l_rA = l_kA = l_vA = l_wA = l_aA = l_rB = l_kB = l_vB = l_wB = l_aB = (u32x2){0u, 0u}; l_sA = l_sB = (f32x4){0.f, 0.f, 0.f, 0.f}; l_gcA = l_gcB = (u32x4){0u, 0u, 0u, 0u};
    if (helper) { RW_LOAD(0, A); RW_LOAD(1, B); }

#pragma unroll 1
    for (int i0_ = -1; i0_ < RW_NCH; i0_ += 2) {
        { const int i = i0_;

        const int bufn = (i + 1) & 1, bufc = i & 1;
        if (helper) {
            const bool do_prep = (i + 1 < RW_NCH);
            if (i >= 0) {
                LAS float* Gg = RW_ARR(bufc, 6);
                f32x4 cg_ = (f32x4){0.f, 0.f, 0.f, 0.f};
#pragma unroll
                for (int ks = 0; ks < 4; ++ks) {
                    const bf16x8 za = *(const LAS bf16x8*)&GDb[bufc * 2176 + ln * 136 + ks * 32 + 8 * lg], zb = *(const LAS bf16x8*)&WTg[(16 * nt + ln) * 136 + ks * 32 + 8 * lg];
                    cg_ = __builtin_amdgcn_mfma_f32_16x16x32_bf16(za, zb, cg_, 0, 0, 0);
                }
#pragma unroll
                for (int r = 0; r < 4; ++r) Gg[(4 * lg + r) * 64 + chm] = cg_[r];
            }
            if (i >= 1) {
                LAS float* Yy = RW_ARR(bufn, 7); LAS float* Gg = RW_ARR(bufn, 6); LAS float* Vv = RW_ARR(bufn, 5); LAS float* SC = RW_SC(bufn);
                const f32x4 y = *(const LAS f32x4*)&Yy[tt_h * 64 + cg4], gg = *(const LAS f32x4*)&Gg[tt_h * 64 + cg4], vv = *(const LAS f32x4*)&Vv[tt_h * 64 + cg4];
                const float bonus = BON[((i - 1) % 3) * 16 + tt_h];
                const float mean = red16((y.x + y.y) + (y.z + y.w)) * (1.f / 64.f);
                const f32x4 d = y - mean;
                const float var = red16((d.x * d.x + d.y * d.y) + (d.z * d.z + d.w * d.w)) * (1.f / 64.f);
                const float rs = 1.f / sqrtf(var + 64e-5f);
                const f32x4 o = (d * rs * p_gg + p_gb + vv * bonus) * gg;
                u32x2 w; w.x = pk2(o.x, o.y); w.y = pk2(o.z, o.w);
                *(u32x2*)(X.P + ((size_t)b * SEQ + (i - 1) * RW_TS + tt_h) * LDP + COL_YA + h * 64 + cg4) = w;
            }
            if (do_prep) {
                const f32x4 r = (f32x4){bflo(l_rA.x), bfhi(l_rA.x), bflo(l_rA.y), bfhi(l_rA.y)}, k = (f32x4){bflo(l_kA.x), bfhi(l_kA.x), bflo(l_kA.y), bfhi(l_kA.y)};
                const f32x4 v = (f32x4){bflo(l_vA.x), bfhi(l_vA.x), bflo(l_vA.y), bfhi(l_vA.y)}, w1 = (f32x4){bflo(l_wA.x), bfhi(l_wA.x), bflo(l_wA.y), bfhi(l_wA.y)};
                const f32x4 a = (f32x4){bflo(l_aA.x), bfhi(l_aA.x), bflo(l_aA.y), bfhi(l_aA.y)};
                const f32x4 kk = k * p_kk * l_sA.x;
                const f32x4 decay = 1.f - w1;
                *(LAS f32x4*)&RW_ARR(bufn, 0)[tt_h * 64 + cg4] = -kk;
                *(LAS f32x4*)&RW_ARR(bufn, 1)[tt_h * 64 + cg4] = decay * r;
                *(LAS f32x4*)&RW_ARR(bufn, 2)[tt_h * 64 + cg4] = decay;
                *(LAS f32x4*)&RW_ARR(bufn, 3)[tt_h * 64 + cg4] = kk * a;
                *(LAS f32x4*)&RW_ARR(bufn, 4)[tt_h * 64 + cg4] = k * (1.f + (a - 1.f) * p_ka);
                *(LAS f32x4*)&RW_ARR(bufn, 5)[tt_h * 64 + cg4] = v;
                if (cg4 == 0) { LAS float* SC = RW_SC(bufn); SC[tt_h * 4 + 0] = l_sA.y; SC[tt_h * 4 + 1] = l_sA.z; BON[((i + 1) % 3) * 16 + tt_h] = l_sA.w; }
                *(LAS u32x4*)&GDb[bufn * 2176 + tt_h * 136 + gv8] = l_gcA;
            }
            if (i + 3 < RW_NCH) RW_LOAD(i + 3, A);
            LDS_BAR();
        } else {
            LAS float* A_ = RW_ARR(bufc, 0); LAS float* WR = RW_ARR(bufc, 1); LAS float* Wd = RW_ARR(bufc, 2); LAS float* Bv = RW_ARR(bufc, 3);
            LAS float* Kk = RW_ARR(bufc, 4); LAS float* Vv = RW_ARR(bufc, 5); LAS float* Yy = RW_ARR(bufc, 7); LAS float* SC = RW_SC(bufc);
#pragma unroll 1
            for (int q4 = 0; q4 < 4; ++q4) {
                if (i >= 0) {
                    float yv[8];
#pragma unroll
                    for (int s4 = 0; s4 < 4; ++s4) {
                        const int tt = 4 * q4 + s4;
                        const f32x4 a_lo = *(const LAS f32x4*)&A_[tt * 64 + 8 * jg], a_hi = *(const LAS f32x4*)&A_[tt * 64 + 8 * jg + 4];
                        const f32x4 r_lo = *(const LAS f32x4*)&WR[tt * 64 + 8 * jg], r_hi = *(const LAS f32x4*)&WR[tt * 64 + 8 * jg + 4];
                        const f32x4 w_lo = *(const LAS f32x4*)&Wd[tt * 64 + 8 * jg], w_hi = *(const LAS f32x4*)&Wd[tt * 64 + 8 * jg + 4];
                        const f32x4 b_lo = *(const LAS f32x4*)&Bv[tt * 64 + 8 * jg], b_hi = *(const LAS f32x4*)&Bv[tt * 64 + 8 * jg + 4];
                        const f32x4 k_lo = *(const LAS f32x4*)&Kk[tt * 64 + 8 * jg], k_hi = *(const LAS f32x4*)&Kk[tt * 64 + 8 * jg + 4];
                        const f32x2 vv = *(const LAS f32x2*)&Vv[tt * 64 + i0];
                        const f32x2 sc = *(const LAS f32x2*)&SC[tt * 4];
                        const f32x2 av[4] = {{a_lo.x, a_lo.y}, {a_lo.z, a_lo.w}, {a_hi.x, a_hi.y}, {a_hi.z, a_hi.w}};
                        const f32x2 rv[4] = {{r_lo.x, r_lo.y}, {r_lo.z, r_lo.w}, {r_hi.x, r_hi.y}, {r_hi.z, r_hi.w}};
                        const f32x2 wv[4] = {{w_lo.x, w_lo.y}, {w_lo.z, w_lo.w}, {w_hi.x, w_hi.y}, {w_hi.z, w_hi.w}};
                        const f32x2 bv[4] = {{b_lo.x, b_lo.y}, {b_lo.z, b_lo.w}, {b_hi.x, b_hi.y}, {b_hi.z, b_hi.w}};
                        const f32x2 kv[4] = {{k_lo.x, k_lo.y}, {k_lo.z, k_lo.w}, {k_hi.x, k_hi.y}, {k_hi.z, k_hi.w}};
                        f32x2 e10 = S0[0] * av[0], e20 = S0[0] * rv[0], e11 = S1[0] * av[0], e21 = S1[0] * rv[0];
#pragma unroll
                        for (int j = 1; j < 4; ++j) { e10 += S0[j] * av[j]; e20 += S0[j] * rv[j]; e11 += S1[j] * av[j]; e21 += S1[j] * rv[j]; }
                        const float d10 = red8(e10.x + e10.y), d11 = red8(e11.x + e11.y);
                        yv[2 * s4] = (e20.x + e20.y) + (jg == 0 ? d10 * sc.x + vv.x * sc.y : 0.f); yv[2 * s4 + 1] = (e21.x + e21.y) + (jg == 0 ? d11 * sc.x + vv.y * sc.y : 0.f);
                        const f32x2 d10v = (f32x2){d10, d10}, d11v = (f32x2){d11, d11}, v0v = (f32x2){vv.x, vv.x}, v1v = (f32x2){vv.y, vv.y};
#pragma unroll
                        for (int j = 0; j < 4; ++j) { S0[j] = S0[j] * wv[j] + (d10v * bv[j] + v0v * kv[j]); S1[j] = S1[j] * wv[j] + (d11v * bv[j] + v1v * kv[j]); }
                    }
                    {
                        const bool t2 = (jg & 4) != 0, t1 = (jg & 2) != 0, t0 = (jg & 1) != 0;
#pragma unroll
                        for (int q = 0; q < 4; ++q) { const float keep = t2 ? yv[q + 4] : yv[q], send = t2 ? yv[q] : yv[q + 4]; yv[q] = keep + dpp_mov<0x141>(send); }
#pragma unroll
                        for (int q = 0; q < 2; ++q) { const float keep = t1 ? yv[q + 2] : yv[q], send = t1 ? yv[q] : yv[q + 2]; yv[q] = keep + dpp_mov<0x4E>(send); }
                        { const float keep = t0 ? yv[1] : yv[0], send = t0 ? yv[0] : yv[1]; yv[0] = keep + dpp_mov<0xB1>(send); }
                        Yy[(4 * q4 + (jg >> 1)) * 64 + i0 + (jg & 1)] = yv[0];
                    }

#if PROBE_SCAN2
                    {
#pragma unroll
                    for (int s4 = 0; s4 < 4; ++s4) {
                        const int tt = 4 * q4 + s4;
                        const f32x4 a_lo = *(const LAS f32x4*)&A_[tt * 64 + 8 * jg], a_hi = *(const LAS f32x4*)&A_[tt * 64 + 8 * jg + 4];
                        const f32x4 r_lo = *(const LAS f32x4*)&WR[tt * 64 + 8 * jg], r_hi = *(const LAS f32x4*)&WR[tt * 64 + 8 * jg + 4];
                        const f32x4 w_lo = *(const LAS f32x4*)&Wd[tt * 64 + 8 * jg], w_hi = *(const LAS f32x4*)&Wd[tt * 64 + 8 * jg + 4];
                        const f32x4 b_lo = *(const LAS f32x4*)&Bv[tt * 64 + 8 * jg], b_hi = *(const LAS f32x4*)&Bv[tt * 64 + 8 * jg + 4];
                        const f32x4 k_lo = *(const LAS f32x4*)&Kk[tt * 64 + 8 * jg], k_hi = *(const LAS f32x4*)&Kk[tt * 64 + 8 * jg + 4];
                        const f32x2 vv = *(const LAS f32x2*)&Vv[tt * 64 + i0];
                        const f32x2 av[4] = {{a_lo.x, a_lo.y}, {a_lo.z, a_lo.w}, {a_hi.x, a_hi.y}, {a_hi.z, a_hi.w}};
                        const f32x2 rv[4] = {{r_lo.x, r_lo.y}, {r_lo.z, r_lo.w}, {r_hi.x, r_hi.y}, {r_hi.z, r_hi.w}};
                        const f32x2 wv[4] = {{w_lo.x, w_lo.y}, {w_lo.z, w_lo.w}, {w_hi.x, w_hi.y}, {w_hi.z, w_hi.w}};
                        const f32x2 bv[4] = {{b_lo.x, b_lo.y}, {b_lo.z, b_lo.w}, {b_hi.x, b_hi.y}, {b_hi.z, b_hi.w}};
                        const f32x2 kv[4] = {{k_lo.x, k_lo.y}, {k_lo.z, k_lo.w}, {k_hi.x, k_hi.y}, {k_hi.z, k_hi.w}};
                        f32x2 e10 = T0[0] * av[0], e20 = T0[0] * rv[0], e11 = T1[0] * av[0], e21 = T1[0] * rv[0];
#pragma unroll
                        for (int j = 1; j < 4; ++j) { e10 += T0[j] * av[j]; e20 += T0[j] * rv[j]; e11 += T1[j] * av[j]; e21 += T1[j] * rv[j]; }
                        const float d10 = red8(e10.x + e10.y), d20 = red8(e20.x + e20.y), d11 = red8(e11.x + e11.y), d21 = red8(e21.x + e21.y);
                        const f32x2 d10v = (f32x2){d10 + d20, d10}, d11v = (f32x2){d11 + d21, d11}, v0v = (f32x2){vv.x, vv.x}, v1v = (f32x2){vv.y, vv.y};
#pragma unroll
                        for (int j = 0; j < 4; ++j) { T0[j] = T0[j] * wv[j] + (d10v * bv[j] + v0v * kv[j]); T1[j] = T1[j] * wv[j] + (d11v * bv[j] + v1v * kv[j]); }
                    }
                    }
#endif
                }
                if (q4 == 3) LDS_BAR();
            }
        }
            }
        if (i0_ + 1 < RW_NCH) { const int i = i0_ + 1;

        const int bufn = (i + 1) & 1, bufc = i & 1;
        if (helper) {
            const bool do_prep = (i + 1 < RW_NCH);
            if (i >= 0) {
                LAS float* Gg = RW_ARR(bufc, 6);
                f32x4 cg_ = (f32x4){0.f, 0.f, 0.f, 0.f};
#pragma unroll
                for (int ks = 0; ks < 4; ++ks) {
                    const bf16x8 za = *(const LAS bf16x8*)&GDb[bufc * 2176 + ln * 136 + ks * 32 + 8 * lg], zb = *(const LAS bf16x8*)&WTg[(16 * nt + ln) * 136 + ks * 32 + 8 * lg];
                    cg_ = __builtin_amdgcn_mfma_f32_16x16x32_bf16(za, zb, cg_, 0, 0, 0);
                }
#pragma unroll
                for (int r = 0; r < 4; ++r) Gg[(4 * lg + r) * 64 + chm] = cg_[r];
            }
            if (i >= 1) {
                LAS float* Yy = RW_ARR(bufn, 7); LAS float* Gg = RW_ARR(bufn, 6); LAS float* Vv = RW_ARR(bufn, 5); LAS float* SC = RW_SC(bufn);
                const f32x4 y = *(const LAS f32x4*)&Yy[tt_h * 64 + cg4], gg = *(const LAS f32x4*)&Gg[tt_h * 64 + cg4], vv = *(const LAS f32x4*)&Vv[tt_h * 64 + cg4];
                const float bonus = BON[((i - 1) % 3) * 16 + tt_h];
                const float mean = red16((y.x + y.y) + (y.z + y.w)) * (1.f / 64.f);
                const f32x4 d = y - mean;
                const float var = red16((d.x * d.x + d.y * d.y) + (d.z * d.z + d.w * d.w)) * (1.f / 64.f);
                const float rs = 1.f / sqrtf(var + 64e-5f);
                const f32x4 o = (d * rs * p_gg + p_gb + vv * bonus) * gg;
                u32x2 w; w.x = pk2(o.x, o.y); w.y = pk2(o.z, o.w);
                *(u32x2*)(X.P + ((size_t)b * SEQ + (i - 1) * RW_TS + tt_h) * LDP + COL_YA + h * 64 + cg4) = w;
            }
            if (do_prep) {
                const f32x4 r = (f32x4){bflo(l_rB.x), bfhi(l_rB.x), bflo(l_rB.y), bfhi(l_rB.y)}, k = (f32x4){bflo(l_kB.x), bfhi(l_kB.x), bflo(l_kB.y), bfhi(l_kB.y)};
                const f32x4 v = (f32x4){bflo(l_vB.x), bfhi(l_vB.x), bflo(l_vB.y), bfhi(l_vB.y)}, w1 = (f32x4){bflo(l_wB.x), bfhi(l_wB.x), bflo(l_wB.y), bfhi(l_wB.y)};
                const f32x4 a = (f32x4){bflo(l_aB.x), bfhi(l_aB.x), bflo(l_aB.y), bfhi(l_aB.y)};
                const f32x4 kk = k * p_kk * l_sB.x;
                const f32x4 decay = 1.f - w1;
                *(LAS f32x4*)&RW_ARR(bufn, 0)[tt_h * 64 + cg4] = -kk;
                *(LAS f32x4*)&RW_ARR(bufn, 1)[tt_h * 64 + cg4] = decay * r;
                *(LAS f32x4*)&RW_ARR(bufn, 2)[tt_h * 64 + cg4] = decay;
                *(LAS f32x4*)&RW_ARR(bufn, 3)[tt_h * 64 + cg4] = kk * a;
                *(LAS f32x4*)&RW_ARR(bufn, 4)[tt_h * 64 + cg4] = k * (1.f + (a - 1.f) * p_ka);
                *(LAS f32x4*)&RW_ARR(bufn, 5)[tt_h * 64 + cg4] = v;
                if (cg4 == 0) { LAS float* SC = RW_SC(bufn); SC[tt_h * 4 + 0] = l_sB.y; SC[tt_h * 4 + 1] = l_sB.z; BON[((i + 1) % 3) * 16 + tt_h] = l_sB.w; }
                *(LAS u32x4*)&GDb[bufn * 2176 + tt_h * 136 + gv8] = l_gcB;
            }
            if (i + 3 < RW_NCH) RW_LOAD(i + 3, B);
            LDS_BAR();
        } else {
            LAS float* A_ = RW_ARR(bufc, 0); LAS float* WR = RW_ARR(bufc, 1); LAS float* Wd = RW_ARR(bufc, 2); LAS float* Bv = RW_ARR(bufc, 3);
            LAS float* Kk = RW_ARR(bufc, 4); LAS float* Vv = RW_ARR(bufc, 5); LAS float* Yy = RW_ARR(bufc, 7); LAS float* SC = RW_SC(bufc);
#pragma unroll 1
            for (int q4 = 0; q4 < 4; ++q4) {
                if (i >= 0) {
                    float yv[8];
#pragma unroll
                    for (int s4 = 0; s4 < 4; ++s4) {
                        const int tt = 4 * q4 + s4;
                        const f32x4 a_lo = *(const LAS f32x4*)&A_[tt * 64 + 8 * jg], a_hi = *(const LAS f32x4*)&A_[tt * 64 + 8 * jg + 4];
                        const f32x4 r_lo = *(const LAS f32x4*)&WR[tt * 64 + 8 * jg], r_hi = *(const LAS f32x4*)&WR[tt * 64 + 8 * jg + 4];
                        const f32x4 w_lo = *(const LAS f32x4*)&Wd[tt * 64 + 8 * jg], w_hi = *(const LAS f32x4*)&Wd[tt * 64 + 8 * jg + 4];
                        const f32x4 b_lo = *(const LAS f32x4*)&Bv[tt * 64 + 8 * jg], b_hi = *(const LAS f32x4*)&Bv[tt * 64 + 8 * jg + 4];
                        const f32x4 k_lo = *(const LAS f32x4*)&Kk[tt * 64 + 8 * jg], k_hi = *(const LAS f32x4*)&Kk[tt * 64 + 8 * jg + 4];
                        const f32x2 vv = *(const LAS f32x2*)&Vv[tt * 64 + i0];
                        const f32x2 sc = *(const LAS f32x2*)&SC[tt * 4];
                        const f32x2 av[4] = {{a_lo.x, a_lo.y}, {a_lo.z, a_lo.w}, {a_hi.x, a_hi.y}, {a_hi.z, a_hi.w}};
                        const f32x2 rv[4] = {{r_lo.x, r_lo.y}, {r_lo.z, r_lo.w}, {r_hi.x, r_hi.y}, {r_hi.z, r_hi.w}};
                        const f32x2 wv[4] = {{w_lo.x, w_lo.y}, {w_lo.z, w_lo.w}, {w_hi.x, w_hi.y}, {w_hi.z, w_hi.w}};
                        const f32x2 bv[4] = {{b_lo.x, b_lo.y}, {b_lo.z, b_lo.w}, {b_hi.x, b_hi.y}, {b_hi.z, b_hi.w}};
                        const f32x2 kv[4] = {{k_lo.x, k_lo.y}, {k_lo.z, k_lo.w}, {k_hi.x, k_hi.y}, {k_hi.z, k_hi.w}};
                        f32x2 e10 = S0[0] * av[0], e20 = S0[0] * rv[0], e11 = S1[0] * av[0], e21 = S1[0] * rv[0];
#pragma unroll
                        for (int j = 1; j < 4; ++j) { e10 += S0[j] * av[j]; e20 += S0[j] * rv[j]; e11 += S1[j] * av[j]; e21 += S1[j] * rv[j]; }
                        const float d10 = red8(e10.x + e10.y), d11 = red8(e11.x + e11.y);
                        yv[2 * s4] = (e20.x + e20.y) + (jg == 0 ? d10 * sc.x + vv.x * sc.y : 0.f); yv[2 * s4 + 1] = (e21.x + e21.y) + (jg == 0 ? d11 * sc.x + vv.y * sc.y : 0.f);
                        const f32x2 d10v = (f32x2){d10, d10}, d11v = (f32x2){d11, d11}, v0v = (f32x2){vv.x, vv.x}, v1v = (f32x2){vv.y, vv.y};
#pragma unroll
                        for (int j = 0; j < 4; ++j) { S0[j] = S0[j] * wv[j] + (d10v * bv[j] + v0v * kv[j]); S1[j] = S1[j] * wv[j] + (d11v * bv[j] + v1v * kv[j]); }
                    }
                    {
                        const bool t2 = (jg & 4) != 0, t1 = (jg & 2) != 0, t0 = (jg & 1) != 0;
#pragma unroll
                        for (int q = 0; q < 4; ++q) { const float keep = t2 ? yv[q + 4] : yv[q], send = t2 ? yv[q] : yv[q + 4]; yv[q] = keep + dpp_mov<0x141>(send); }
#pragma unroll
                        for (int q = 0; q < 2; ++q) { const float keep = t1 ? yv[q + 2] : yv[q], send = t1 ? yv[q] : yv[q + 2]; yv[q] = keep + dpp_mov<0x4E>(send); }
                        { const float keep = t0 ? yv[1] : yv[0], send = t0 ? yv[0] : yv[1]; yv[0] = keep + dpp_mov<0xB1>(send); }
                        Yy[(4 * q4 + (jg >> 1)) * 64 + i0 + (jg & 1)] = yv[0];
                    }

#if PROBE_SCAN2
                    {
#pragma unroll
                    for (int s4 = 0; s4 < 4; ++s4) {
                        const int tt = 4 * q4 + s4;
                        const f32x4 a_lo = *(const LAS f32x4*)&A_[tt * 64 + 8 * jg], a_hi = *(const LAS f32x4*)&A_[tt * 64 + 8 * jg + 4];
                        const f32x4 r_lo = *(const LAS f32x4*)&WR[tt * 64 + 8 * jg], r_hi = *(const LAS f32x4*)&WR[tt * 64 + 8 * jg + 4];
                        const f32x4 w_lo = *(const LAS f32x4*)&Wd[tt * 64 + 8 * jg], w_hi = *(const LAS f32x4*)&Wd[tt * 64 + 8 * jg + 4];
                        const f32x4 b_lo = *(const LAS f32x4*)&Bv[tt * 64 + 8 * jg], b_hi = *(const LAS f32x4*)&Bv[tt * 64 + 8 * jg + 4];
                        const f32x4 k_lo = *(const LAS f32x4*)&Kk[tt * 64 + 8 * jg], k_hi = *(const LAS f32x4*)&Kk[tt * 64 + 8 * jg + 4];
                        const f32x2 vv = *(const LAS f32x2*)&Vv[tt * 64 + i0];
                        const f32x2 av[4] = {{a_lo.x, a_lo.y}, {a_lo.z, a_lo.w}, {a_hi.x, a_hi.y}, {a_hi.z, a_hi.w}};
                        const f32x2 rv[4] = {{r_lo.x, r_lo.y}, {r_lo.z, r_lo.w}, {r_hi.x, r_hi.y}, {r_hi.z, r_hi.w}};
                        const f32x2 wv[4] = {{w_lo.x, w_lo.y}, {w_lo.z, w_lo.w}, {w_hi.x, w_hi.y}, {w_hi.z, w_hi.w}};
                        const f32x2 bv[4] = {{b_lo.x, b_lo.y}, {b_lo.z, b_lo.w}, {b_hi.x, b_hi.y}, {b_hi.z, b_hi.w}};
                        const f32x2 kv[4] = {{k_lo.x, k_lo.y}, {k_lo.z, k_lo.w}, {k_hi.x, k_hi.y}, {k_hi.z, k_hi.w}};
                        f32x2 e10 = T0[0] * av[0], e20 = T0[0] * rv[0], e11 = T1[0] * av[0], e21 = T1[0] * rv[0];
#pragma unroll
                        for (int j = 1; j < 4; ++j) { e10 += T0[j] * av[j]; e20 += T0[j] * rv[j]; e11 += T1[j] * av[j]; e21 += T1[j] * rv[j]; }
                        const float d10 = red8(e10.x + e10.y), d20 = red8(e20.x + e20.y), d11 = red8(e11.x + e11.y), d21 = red8(e21.x + e21.y);
                        const f32x2 d10v = (f32x2){d10 + d20, d10}, d11v = (f32x2){d11 + d21, d11}, v0v = (f32x2){vv.x, vv.x}, v1v = (f32x2){vv.y, vv.y};
#pragma unroll
                        for (int j = 0; j < 4; ++j) { T0[j] = T0[j] * wv[j] + (d10v * bv[j] + v0v * kv[j]); T1[j] = T1[j] * wv[j] + (d11v * bv[j] + v1v * kv[j]); }
                    }
                    }
#endif
                }
                if (q4 == 3) LDS_BAR();
            }
        }
            }
    }
    if (helper) {
        const int bufl = (RW_NCH - 1) & 1;
        LAS float* Yy = RW_ARR(bufl, 7); LAS float* Gg = RW_ARR(bufl, 6); LAS float* Vv = RW_ARR(bufl, 5); LAS float* SC = RW_SC(bufl);
        const f32x4 y = *(const LAS f32x4*)&Yy[tt_h * 64 + cg4], gg = *(const LAS f32x4*)&Gg[tt_h * 64 + cg4], vv = *(const LAS f32x4*)&Vv[tt_h * 64 + cg4];
        const float bonus = BON[((RW_NCH - 1) % 3) * 16 + tt_h];
        const float mean = red16((y.x + y.y) + (y.z + y.w)) * (1.f / 64.f);
        const f32x4 d = y - mean;
        const float var = red16((d.x * d.x + d.y * d.y) + (d.z * d.z + d.w * d.w)) * (1.f / 64.f);
        const float rs = 1.f / sqrtf(var + 64e-5f);
        const f32x4 o = (d * rs * p_gg + p_gb + vv * bonus) * gg;
        u32x2 w; w.x = pk2(o.x, o.y); w.y = pk2(o.z, o.w);
        *(u32x2*)(X.P + ((size_t)b * SEQ + (RW_NCH - 1) * RW_TS + tt_h) * LDP + COL_YA + h * 64 + cg4) = w;
    }
    __syncthreads();
#undef RW_ARR
#undef RW_SC
#undef RW_LOAD
}

__device__ __forceinline__ void hgrn_task(const Ctx& X, LAS unsigned char* lds, int layer, int b, int h, int vh) {
    LAS float* F = (LAS float*)(lds); LAS float* Q = (LAS float*)(lds + 16384); LAS float* Vv = (LAS float*)(lds + 32768); LAS float* O = (LAS float*)(lds + 40960);
    LAS float* LB = (LAS float*)(lds + 49152);
    const int tid = X.tid;
    const float* lbl = X.in[14];
    const int rp = tid >> 4, dg = tid & 15, v0 = 2 * rp;
    if (tid < 128) LB[tid] = (layer > 0) ? 1.f / (1.f + __expf(lbl[h * 128 + tid] - lbl[512 + h * 128 + tid])) : 0.f;
    f32x2 S0[4], S1[4];
#pragma unroll
    for (int j = 0; j < 4; ++j) { S0[j] = (f32x2){0.f, 0.f}; S1[j] = (f32x2){0.f, 0.f}; }
#define HG_LOAD(chk) do { _Pragma("unroll") for (int it = 0; it < 3; ++it) { const int idx = tid + 512 * it; raw[it] = (u32x4){0u, 0u, 0u, 0u}; \
        if (idx < 32 * 40) { const int tt = idx / 40, vv = idx - tt * 40; \
            const int col = vv < 16 ? 512 + h * 128 + 8 * vv : (vv < 32 ? h * 128 + 8 * (vv - 16) : 1024 + h * 128 + vh * 64 + 8 * (vv - 32)); \
            raw[it] = *(const u32x4*)(X.P + ((size_t)b * SEQ + (chk) * 32 + tt) * LDP + COL_PB + col); } } } while (0)
    u32x4 raw[3];
    HG_LOAD(0);
    __syncthreads();
#pragma unroll 1
    for (int ch = 0; ch < SEQ / 32; ++ch) {
        const int t0 = ch * 32;
#pragma unroll
        for (int it = 0; it < 3; ++it) {
            const int idx = tid + 512 * it;
            if (idx < 32 * 40) {
                const int tt = idx / 40, vv = idx - tt * 40;
                float x[8];
                x[0] = bflo(raw[it].x); x[1] = bfhi(raw[it].x); x[2] = bflo(raw[it].y); x[3] = bfhi(raw[it].y);
                x[4] = bflo(raw[it].z); x[5] = bfhi(raw[it].z); x[6] = bflo(raw[it].w); x[7] = bfhi(raw[it].w);
                LAS float* dst;
                if (vv < 16) {
                    dst = F + tt * 128 + 8 * vv;
#pragma unroll
                    for (int e = 0; e < 8; ++e) { const float lb = LB[8 * vv + e]; x[e] = lb + (1.f - lb) * sigmoidf_(x[e]); }
                } else if (vv < 32) dst = Q + tt * 128 + 8 * (vv - 16);
                else dst = Vv + tt * 64 + 8 * (vv - 32);
                *(LAS f32x4*)dst = (f32x4){x[0], x[1], x[2], x[3]}; *(LAS f32x4*)(dst + 4) = (f32x4){x[4], x[5], x[6], x[7]};
            }
        }
        if (ch + 1 < SEQ / 32) HG_LOAD(ch + 1);
        LDS_BAR();
#pragma unroll 1
        for (int g8 = 0; g8 < 4; ++g8) {
            float val[16];
#pragma unroll
            for (int s8 = 0; s8 < 8; ++s8) {
                const int tt = 8 * g8 + s8;
                const f32x4 f_lo = *(const LAS f32x4*)&F[tt * 128 + 8 * dg], f_hi = *(const LAS f32x4*)&F[tt * 128 + 8 * dg + 4];
                const f32x4 q_lo = *(const LAS f32x4*)&Q[tt * 128 + 8 * dg], q_hi = *(const LAS f32x4*)&Q[tt * 128 + 8 * dg + 4];
                const f32x2 vv = *(const LAS f32x2*)&Vv[tt * 64 + v0];
                const f32x2 f2[4] = {{f_lo.x, f_lo.y}, {f_lo.z, f_lo.w}, {f_hi.x, f_hi.y}, {f_hi.z, f_hi.w}};
                const f32x2 q2[4] = {{q_lo.x, q_lo.y}, {q_lo.z, q_lo.w}, {q_hi.x, q_hi.y}, {q_hi.z, q_hi.w}};
                const f32x2 v0v = (f32x2){vv.x, vv.x}, v1v = (f32x2){vv.y, vv.y};
                f32x2 a0 = (f32x2){0.f, 0.f}, a1 = (f32x2){0.f, 0.f};
#pragma unroll
                for (int j = 0; j < 4; ++j) {
                    S0[j] = v0v + f2[j] * (S0[j] - v0v); S1[j] = v1v + f2[j] * (S1[j] - v1v);
                    a0 += q2[j] * S0[j]; a1 += q2[j] * S1[j];
                }
                val[2 * s8] = a0.x + a0.y; val[2 * s8 + 1] = a1.x + a1.y;
            }
            const bool b3 = (dg & 8) != 0, b2 = (dg & 4) != 0, b1 = (dg & 2) != 0, b0 = (dg & 1) != 0;
#pragma unroll
            for (int i = 0; i < 8; ++i) { const float keep = b3 ? val[i + 8] : val[i], send = b3 ? val[i] : val[i + 8]; val[i] = keep + dpp_mov<0x140>(send); }
#pragma unroll
            for (int i = 0; i < 4; ++i) { const float keep = b2 ? val[i + 4] : val[i], send = b2 ? val[i] : val[i + 4]; val[i] = keep + dpp_mov<0x141>(send); }
#pragma unroll
            for (int i = 0; i < 2; ++i) { const float keep = b1 ? val[i + 2] : val[i], send = b1 ? val[i] : val[i + 2]; val[i] = keep + dpp_mov<0x4E>(send); }
            { const float keep = b0 ? val[1] : val[0], send = b0 ? val[0] : val[1]; val[0] = keep + dpp_mov<0xB1>(send); }
            O[(8 * g8 + (dg >> 1)) * 64 + v0 + (dg & 1)] = val[0];
        }
        LDS_BAR();
        if (tid < 256) {
            const int tt = tid >> 3, v8 = (tid & 7) * 8;
            const f32x4 a = *(const LAS f32x4*)&O[tt * 64 + v8], c4 = *(const LAS f32x4*)&O[tt * 64 + v8 + 4];
            u32x4 o; o.x = pk2(a.x, a.y); o.y = pk2(a.z, a.w); o.z = pk2(c4.x, c4.y); o.w = pk2(c4.z, c4.w);
            *(u32x4*)(X.P + ((size_t)b * SEQ + t0 + tt) * LDP + COL_YB + h * 128 + vh * 64 + v8) = o;
        }
    }
#undef HG_LOAD
    __syncthreads();
}

__device__ __forceinline__ unsigned f2ord(float f) { const unsigned u = __builtin_bit_cast(unsigned, f); return (u & 0x80000000u) ? ~u : (u | 0x80000000u); }

__device__ __forceinline__ void dsa_tile(const Ctx& X, LAS unsigned char* lds, int b, int q0) {
    LAS float* sc = (LAS float*)lds;
    LAS unsigned* MASK = (LAS unsigned*)(lds + MASK_OFF);
    const int lane = X.lane, w = X.wave, n = lane & 15, g = lane >> 4;
    const bf16_t* Pb = X.P + (size_t)b * SEQ * LDP;
#pragma unroll 1
    for (int sub = 0; sub < 4; ++sub) {
        const int qs = q0 + 16 * sub;
        {
            bf16x8 bq[4][2]; float wi[4];
            const bf16_t* qrow = Pb + (size_t)(qs + n) * LDP;
#pragma unroll
            for (int hh = 0; hh < 4; ++hh) {
#pragma unroll
                for (int ks = 0; ks < 2; ++ks) bq[hh][ks] = *(const bf16x8*)(qrow + C_QI + hh * 64 + ks * 32 + 8 * g);
                wi[hh] = bf2f(qrow[C_WI + hh]);
            }
            const int nkt = (qs + 16) >> 4;
            bf16x8 a0n = (bf16x8){0, 0, 0, 0, 0, 0, 0, 0}, a1n = a0n;
            if (w < nkt) { const bf16_t* krow = Pb + (size_t)(w * 16 + n) * LDP + C_KI; a0n = *(const bf16x8*)(krow + 8 * g); a1n = *(const bf16x8*)(krow + 32 + 8 * g); }
#pragma unroll 1
            for (int kt = w; kt < nkt; kt += 8) {
                const bf16x8 a0 = a0n, a1 = a1n;
                if (kt + 8 < nkt) { const bf16_t* krow = Pb + (size_t)((kt + 8) * 16 + n) * LDP + C_KI; a0n = *(const bf16x8*)(krow + 8 * g); a1n = *(const bf16x8*)(krow + 32 + 8 * g); }
                f32x4 s = (f32x4){0.f, 0.f, 0.f, 0.f};
#pragma unroll
                for (int hh = 0; hh < 4; ++hh) {
                    f32x4 d = __builtin_amdgcn_mfma_f32_16x16x32_bf16(a0, bq[hh][0], (f32x4){0.f, 0.f, 0.f, 0.f}, 0, 0, 0);
                    d = __builtin_amdgcn_mfma_f32_16x16x32_bf16(a1, bq[hh][1], d, 0, 0, 0);
#pragma unroll
                    for (int r = 0; r < 4; ++r) s[r] += wi[hh] * fmaxf(d[r], 0.f);
                }
                const int t = qs + n;
#pragma unroll
                for (int r = 0; r < 4; ++r) if (kt * 16 + 4 * g + r > t) s[r] = -INFINITY;
                *(LAS f32x4*)&sc[n * SCS + kt * 16 + 4 * g] = s;
            }
        }
        __syncthreads();
#pragma unroll 1
        for (int e = 0; e < 2; ++e) {
            const int qn = 2 * w + e, t = qs + qn;
            LAS unsigned* mrow = MASK + (sub * 16 + qn) * 64;
            if (t < 256) {
#pragma unroll
                for (int j = 0; j < 32; ++j) {
                    const unsigned long long sm = __ballot(j * 64 + lane <= t);
                    if (lane == 0) { mrow[2 * j] = (unsigned)sm; mrow[2 * j + 1] = (unsigned)(sm >> 32); }
                }
            } else {
                const int jn = (t >> 6) + 1;
                unsigned u[32];
#pragma unroll
                for (int j = 0; j < 32; ++j) {
                    u[j] = 0u;
                    if (j < jn) { const int key = j * 64 + lane; const float s = (key <= t) ? sc[qn * SCS + key] : -INFINITY; u[j] = f2ord(s); }
                }
                unsigned prefix = 0u;
#define DSA_BITSEARCH(JN) do { _Pragma("unroll 1") for (int bit = 31; bit >= 0; --bit) { const unsigned cand = prefix | (1u << bit); int c0 = 0, c1 = 0; \
                    _Pragma("unroll") for (int j = 0; j < (JN); j += 2) { c0 += (u[j] >= cand) ? 1 : 0; c1 += (u[j + 1] >= cand) ? 1 : 0; } \
                    const int cnt = (int)wave_sum_fast((float)(c0 + c1)); if (cnt >= 256) prefix = cand; } } while (0)
                if (jn <= 8) DSA_BITSEARCH(8); else if (jn <= 16) DSA_BITSEARCH(16); else if (jn <= 24) DSA_BITSEARCH(24); else DSA_BITSEARCH(32);
#undef DSA_BITSEARCH
                int cg_ = 0;
#pragma unroll
                for (int j = 0; j < 32; ++j) if (j < jn) cg_ += __popcll(__ballot(u[j] > prefix));
                const int need = 256 - cg_;
                int cum = 0;
#pragma unroll
                for (int j = 0; j < 32; ++j) {
                    unsigned long long sm = 0ull;
                    if (j < jn) {
                        const bool eq = (u[j] == prefix);
                        const unsigned long long em = __ballot(eq);
                        const int rank = cum + (int)__builtin_amdgcn_mbcnt_hi((unsigned)(em >> 32), __builtin_amdgcn_mbcnt_lo((unsigned)em, 0u));
                        const bool sel = (u[j] > prefix) || (eq && rank < need);
                        sm = __ballot(sel);
                        cum += __popcll(em);
                    }
                    if (lane == 0) { mrow[2 * j] = (unsigned)sm; mrow[2 * j + 1] = (unsigned)(sm >> 32); }
                }
            }
        }
        __syncthreads();
    }
    const int qq = q0 + 8 * w + (n & 7);
    const LAS unsigned* mq = MASK + (8 * w + (n & 7)) * 64;
    const int nsteps = (q0 + 8 * w + 8 + 31) >> 5;
    const int nblk = (q0 + 64 + 127) >> 7;
    LAS bf16_t* KT = (LAS bf16_t*)lds;
    LAS bf16_t* VTT = (LAS bf16_t*)(lds + 36864);
    const int tid = X.tid;
#pragma unroll 1
    for (int c = 0; c < 2; ++c) {
        bf16x8 bq[2][2];
#pragma unroll
        for (int j = 0; j < 2; ++j)
#pragma unroll
            for (int ks = 0; ks < 2; ++ks) bq[j][ks] = *(const bf16x8*)(Pb + (size_t)qq * LDP + C_Q + (c * 4 + 2 * j + (n >> 3)) * 64 + ks * 32 + 8 * g);
        float lrun[2] = {0.f, 0.f};
        f32x4 oacc[4][2];
#pragma unroll
        for (int mt = 0; mt < 4; ++mt)
#pragma unroll
            for (int j = 0; j < 2; ++j) oacc[mt][j] = (f32x4){0.f, 0.f, 0.f, 0.f};
        const bf16_t* vtb = X.VT + ((size_t)(b * 2 + c) * 64) * SEQ;
        u32x4 gk[2], gv[2];
#define DSA_GLOAD(kblk) do { _Pragma("unroll") for (int it = 0; it < 2; ++it) { const int idx = tid + 512 * it; \
            gk[it] = *(const u32x4*)(Pb + (size_t)((kblk) * 128 + (idx >> 3)) * LDP + C_K + c * 64 + (idx & 7) * 8); \
            gv[it] = *(const u32x4*)(vtb + (size_t)(idx >> 4) * SEQ + (kblk) * 128 + (idx & 15) * 8); } } while (0)
#define DSA_LSTORE(bufi) do { _Pragma("unroll") for (int it = 0; it < 2; ++it) { const int idx = tid + 512 * it; \
            *(LAS u32x4*)(KT + (bufi) * 9216 + (idx >> 3) * 72 + (idx & 7) * 8) = gk[it]; \
            *(LAS u32x4*)(VTT + (bufi) * 8704 + (idx >> 4) * 136 + (idx & 15) * 8) = gv[it]; } } while (0)
        DSA_GLOAD(0);
        LDS_BAR();
        DSA_LSTORE(0);
        LDS_BAR();
#pragma unroll 1
        for (int kb = 0; kb < nblk; ++kb) {
            const int buf = kb & 1;
            if (kb + 1 < nblk) DSA_GLOAD(kb + 1);
            const LAS bf16_t* Kb = KT + buf * 9216; const LAS bf16_t* Vb = VTT + buf * 8704;
#pragma unroll 1
            for (int sl = 0; sl < 4; ++sl) {
                const int sg = kb * 4 + sl;
                if (sg < nsteps) {
                    f32x4 st[2][2];
#pragma unroll
                    for (int tl = 0; tl < 2; ++tl) {
                        const LAS bf16_t* kr = Kb + (32 * sl + 16 * tl + n) * 72;
                        const bf16x8 a0 = *(const LAS bf16x8*)(kr + 8 * g), a1 = *(const LAS bf16x8*)(kr + 32 + 8 * g);
#pragma unroll
                        for (int j = 0; j < 2; ++j) {
                            f32x4 d = __builtin_amdgcn_mfma_f32_16x16x32_bf16(a0, bq[j][0], (f32x4){0.f, 0.f, 0.f, 0.f}, 0, 0, 0);
                            st[tl][j] = __builtin_amdgcn_mfma_f32_16x16x32_bf16(a1, bq[j][1], d, 0, 0, 0);
                        }
                    }
                    bf16x8 av[4];
#pragma unroll
                    for (int mt = 0; mt < 4; ++mt) {
                        const LAS bf16_t* vp = Vb + (mt * 16 + n) * 136 + 32 * sl + 4 * g;
                        const u32x2 lo = *(const LAS u32x2*)vp, hi = *(const LAS u32x2*)(vp + 16);
                        u32x4 t4; t4.x = lo.x; t4.y = lo.y; t4.z = hi.x; t4.w = hi.y;
                        av[mt] = __builtin_bit_cast(bf16x8, t4);
                    }
                    const unsigned mw = mq[sg];
#pragma unroll
                    for (int j = 0; j < 2; ++j) {
                        float p[8], ps = 0.f;
#pragma unroll
                        for (int tl = 0; tl < 2; ++tl)
#pragma unroll
                            for (int r = 0; r < 4; ++r) { const int bit = 16 * tl + 4 * g + r; const float e = __expf(fminf(st[tl][j][r] * 0.125f, 60.f)); p[4 * tl + r] = ((mw >> bit) & 1u) ? e : 0.f; ps += p[4 * tl + r]; }
                        lrun[j] += ps;
                        u32x4 pw; pw.x = pg8::cvt_pk_bf16(p[0], p[1]); pw.y = pg8::cvt_pk_bf16(p[2], p[3]); pw.z = pg8::cvt_pk_bf16(p[4], p[5]); pw.w = pg8::cvt_pk_bf16(p[6], p[7]);
                        const bf16x8 pb = __builtin_bit_cast(bf16x8, pw);
#pragma unroll
                        for (int mt = 0; mt < 4; ++mt) oacc[mt][j] = __builtin_amdgcn_mfma_f32_16x16x32_bf16(av[mt], pb, oacc[mt][j], 0, 0, 0);
                    }
                }
            }
            if (kb + 1 < nblk) DSA_LSTORE(buf ^ 1);
            LDS_BAR();
        }
#pragma unroll
        for (int j = 0; j < 2; ++j) {
            float lt = lrun[j]; lt += __shfl_xor(lt, 16); lt += __shfl_xor(lt, 32);
            const float il = 1.f / lt;
            bf16_t* op = X.P + ((size_t)b * SEQ + qq) * LDP + COL_YC + (c * 4 + 2 * j + (n >> 3)) * 64 + 4 * g;
#pragma unroll
            for (int mt = 0; mt < 4; ++mt) {
                const f32x4 o = oacc[mt][j] * il;
                u32x2 wv; wv.x = pg8::cvt_pk_bf16(o[0], o[1]); wv.y = pg8::cvt_pk_bf16(o[2], o[3]);
                *(u32x2*)(op + mt * 16) = wv;
            }
        }
    }
#undef DSA_GLOAD
#undef DSA_LSTORE
    __syncthreads();
}

__device__ __forceinline__ void phase_mixers(const Ctx& X0, LAS unsigned char* lds, int layer, bool early_gate) {
#pragma unroll 1
    for (int task = X0.bid; task < 128; task += X0.G) {
        Ctx X = X0;
        { int t_ = threadIdx.x; asm volatile("" : "+v"(t_)); X.tid = t_; X.lane = t_ & 63; }
        if (task < 64) { if (TKMASK & 1) rwkv_task(X, lds, layer, task >> 3, task & 7); }
        else { const int k = task - 64; if (TKMASK & 2) hgrn_task(X, lds, layer, k >> 3, (k >> 1) & 3, k & 1); }
    }
    volatile LAS unsigned* tw = (volatile LAS unsigned*)(lds + LDS_BYTES - 128);
    unsigned* ctr = (unsigned*)(X0.ws + WS_BAR + 14336) + 16 * layer;
#pragma unroll 1
    for (;;) {
        Ctx X = X0;
        { int t_ = threadIdx.x; asm volatile("" : "+v"(t_)); X.tid = t_; X.lane = t_ & 63; }
        __syncthreads();
        if (threadIdx.x == 0) tw[0] = __hip_atomic_fetch_add(ctr, 1u, __ATOMIC_RELAXED, __HIP_MEMORY_SCOPE_AGENT);
        __syncthreads();
        const int t = (int)tw[0];
        if (t >= 256) break;
        if (TKMASK & 4) dsa_tile(X, lds, t & 7, 64 * (31 - (t >> 3)));
    }
    if (early_gate && X0.bid >= 128 && X0.G == 256) {
        __syncthreads();
        int t_ = threadIdx.x; asm volatile("" : "+v"(t_));
        pg8::Gemm g{X0.P, X0.Wg, LDP, DM, DM}; pg8::StaticOrder S; S.init(T_TOK, DM, 128, X0.bid - 128);
        pg8::EpiGate E{X0.P, (bf16_t*)X0.out + 1024, 2048}; pg8::gemm_phase<pg8::EpiGate, true>(lds, g, S, E, t_);
    }
}

__device__ __forceinline__ void phase_hgrn_post(const Ctx& X, int layer) {
    const int gw = X.bid * 8 + X.wave, NGW = X.G * 8;
    const float* gn = X.in[15] + layer * 512;
#pragma unroll 1
    for (int it0 = gw; it0 < T_TOK * 4; it0 += 4 * NGW) {
        unsigned ow[4], gwd[4]; unsigned* op[4];
#pragma unroll
        for (int r = 0; r < 4; ++r) {
            const int it = it0 + r * NGW < T_TOK * 4 ? it0 + r * NGW : it0;
            const int t = it >> 2, h = it & 3;
            bf16_t* rowp = X.P + (size_t)t * LDP;
            op[r] = (unsigned*)(rowp + COL_YB + h * 128) + X.lane;
            ow[r] = *op[r]; gwd[r] = *((const unsigned*)(rowp + COL_PB + 1536 + h * 128) + X.lane);
        }
#pragma unroll
        for (int r = 0; r < 4; ++r) {
            const int it = it0 + r * NGW;
            const int h = it & 3;
            const float o0 = bflo(ow[r]), o1 = bfhi(ow[r]), g0 = bflo(gwd[r]), g1 = bfhi(gwd[r]);
            const float rs = 1.f / sqrtf(wave_sum(o0 * o0 + o1 * o1) * (1.f / 128.f) + 1e-6f);
            const float y0 = o0 * rs * gn[h * 128 + 2 * X.lane] * (g0 * sigmoidf_(g0)), y1 = o1 * rs * gn[h * 128 + 2 * X.lane + 1] * (g1 * sigmoidf_(g1));
            if (it < T_TOK * 4) *op[r] = pk2(y0, y1);
        }
    }
}

__device__ __forceinline__ void phase_fixup(const Ctx& X, int layer) {
    const float* cw = X.in[20] + (size_t)layer * 3 * F2; const float* cb = X.in[21] + (size_t)layer * F2;
    for (int idx = X.bid * 512 + X.tid; idx < 256 * 2 * DFF; idx += X.G * 512) {
        const int j = idx % DFF, sr = idx / DFF, s = sr >> 1, r = sr & 1;
        const int colg = (j >> 7) * 256 + (j & 127), colv = colg + 128;
        const bool seq0 = (s & 31) == 0;
        const float* H = X.HALO;
        float res[2];
#pragma unroll
        for (int part = 0; part < 2; ++part) {
            const int cp = part ? colv : colg, co = part * DFF + j;
            const float u0 = H[(size_t)(s * 4 + r) * F2 + cp];
            float u1, u2;
            if (r == 0) { u1 = seq0 ? 0.f : H[(size_t)((s - 1) * 4 + 3) * F2 + cp]; u2 = seq0 ? 0.f : H[(size_t)((s - 1) * 4 + 2) * F2 + cp]; }
            else { u1 = H[(size_t)(s * 4 + 0) * F2 + cp]; u2 = seq0 ? 0.f : H[(size_t)((s - 1) * 4 + 3) * F2 + cp]; }
            res[part] = cb[co] + cw[co] * u2 + cw[F2 + co] * u1 + cw[2 * F2 + co] * u0;
        }
        const float a = res[0] * sigmoidf_(res[0]) * res[1];
        X.P[(size_t)(s * 64 + r) * LDP + COL_ACT + j] = (bf16_t)f2bf(a);
    }
}

#define XB_TMO      128
#define XB_XCNT(j)  (256  + 64 * (j))
#define XB_XSUB(j)  (1280 + 64 * (j))
#define XB_XGEN(j)  (2304 + 64 * (j))
#define XB_TOP      3328
#define XB_TOPGEN   3392
#define XCD_BAR_WORDS 3456
#define XB_SPIN_CAP (1u << 22)
__device__ __forceinline__ unsigned xb_ld(unsigned* p)              { return __hip_atomic_load(p, __ATOMIC_RELAXED, __HIP_MEMORY_SCOPE_AGENT); }
__device__ __forceinline__ unsigned xb_add(unsigned* p, unsigned v) { return __hip_atomic_fetch_add(p, v, __ATOMIC_RELAXED, __HIP_MEMORY_SCOPE_AGENT); }
__device__ __forceinline__ unsigned xb_xcc_id() { return (unsigned)__builtin_amdgcn_s_getreg((3 << 11) | 20) & 0xFu; }
#define XB_SPIN(cond, bar) do { unsigned _sp = 0; while (cond) { __builtin_amdgcn_s_sleep(1); \
    if ((++_sp & 255u) == 0u) { if (xb_ld(&(bar)[XB_TMO])) break; if (_sp > XB_SPIN_CAP) { atomicAdd(&(bar)[XB_TMO], 1u); break; } } } } while (0)
struct XcdBarrier { unsigned* bar; unsigned x; volatile LAS unsigned* st; };
__device__ __forceinline__ XcdBarrier xcd_barrier_post(unsigned* bar, volatile LAS unsigned* st) {
    XcdBarrier b; b.bar = bar; b.x = xb_xcc_id(); b.st = st;
    if (threadIdx.x == 0) (void)xb_add(&bar[XB_XCNT(b.x)], 1u);
    return b;
}
__device__ __forceinline__ void xcd_barrier_complete(unsigned* bar, unsigned x, unsigned& nloc, unsigned& nx) {
    const unsigned G = gridDim.x * gridDim.y * gridDim.z;
    unsigned sum, cnt, mine, sp = 0u;
    for (;;) {
        sum = 0u; cnt = 0u; mine = 0u;
#pragma unroll
        for (unsigned j = 0; j < 16; ++j) { const unsigned c = xb_ld(&bar[XB_XCNT(j)]); sum += c; cnt += (c > 0u) ? 1u : 0u; mine = (j == x) ? c : mine; }
        if (sum == G) break;
        __builtin_amdgcn_s_sleep(1);
        if ((++sp & 255u) == 0u) { if (xb_ld(&bar[XB_TMO])) break; if (sp > XB_SPIN_CAP) { atomicAdd(&bar[XB_TMO], 1u); break; } }
    }
    nloc = mine > 0u ? mine : 1u; nx = cnt > 0u ? cnt : 1u;
}
__device__ __forceinline__ void xcd_barrier(const XcdBarrier& b) {
    asm volatile("s_waitcnt vmcnt(0)" ::: "memory");
    __syncthreads();
    if (threadIdx.x == 0) {
        unsigned* bar = b.bar;
        __builtin_amdgcn_s_waitcnt(0);
        unsigned nloc = b.st[0], nx = b.st[1];
        if (nloc == 0u) { xcd_barrier_complete(bar, b.x, nloc, nx); b.st[0] = nloc; b.st[1] = nx; }
        const unsigned old = xb_add(&bar[XB_XSUB(b.x)], 1u);
        const unsigned gen = old / nloc;
        if (old + 1u == (gen + 1u) * nloc) {
            __builtin_amdgcn_fence(__ATOMIC_RELEASE, "agent");
            asm volatile("s_waitcnt vmcnt(0)" ::: "memory");
            const unsigned og = xb_add(&bar[XB_TOP], 1u);
            const unsigned tg = og / nx;
            if (og + 1u == (tg + 1u) * nx) xb_add(&bar[XB_TOPGEN], 1u);
            else XB_SPIN(xb_ld(&bar[XB_TOPGEN]) == tg, bar);
            __builtin_amdgcn_fence(__ATOMIC_ACQUIRE, "agent");
            xb_add(&bar[XB_XGEN(b.x)], 1u);
            asm volatile("s_waitcnt vmcnt(0)" ::: "memory");
        } else {
            XB_SPIN(xb_ld(&bar[XB_XGEN(b.x)]) == gen, bar);
            __builtin_amdgcn_fence(__ATOMIC_ACQUIRE, "agent");
            asm volatile("s_waitcnt vmcnt(0)" ::: "memory");
        }
    }
    __syncthreads();
}

__global__ void __launch_bounds__(512, 2) mk_fwd(Args args) {
    extern __shared__ __attribute__((aligned(16))) unsigned char lds_raw[];
    LAS unsigned char* lds = (LAS unsigned char*)lds_raw;
    Ctx X;
#pragma unroll
    for (int i = 0; i < 24; ++i) X.in[i] = args.in[i];
    X.out = args.out; X.ws = args.ws;
    X.P = (bf16_t*)(args.ws + WS_P); X.VT = (bf16_t*)(args.ws + WS_VT); X.HALO = (float*)(args.ws + WS_HALO); X.ROPE = (float*)(args.ws + WS_ROPE);
    X.Win = (bf16_t*)(args.ws + WS_WIN); X.Wg = (bf16_t*)(args.ws + WS_WG); X.Wbr = (bf16_t*)(args.ws + WS_WBR);
    X.Wo = (bf16_t*)(args.ws + WS_WO); X.Wup = (bf16_t*)(args.ws + WS_WUP); X.Wdn = (bf16_t*)(args.ws + WS_WDN);
    X.tid = threadIdx.x; X.lane = X.tid & 63; X.wave = __builtin_amdgcn_readfirstlane(X.tid >> 6); X.G = gridDim.x; X.bid = blockIdx.x;

#if PROBE_DOUBLE
    for (int ph2 = args.ph_lo * 2; ph2 < args.ph_hi * 2; ++ph2) {
        const int ph = ph2 >> 1;
        const int layer = ph / 11, sub = ph % 11;
        const bool skip_ = (ph2 & 1) && !(ph < 22 && ((REPMASK >> sub) & 1));
#else
    volatile LAS unsigned* bst = (volatile LAS unsigned*)(lds + LDS_BYTES - 64);
    if (threadIdx.x < 2) bst[threadIdx.x] = 0u;
    __syncthreads();
    XcdBarrier gbar = xcd_barrier_post((unsigned*)(args.ws + WS_BAR), bst);
    for (int ph = args.ph_lo; ph < args.ph_hi; ++ph) {
        const int layer = ph / 11, sub = ph % 11;
        const bool skip_ = false;
#endif
        const bool fusedn = (X.G == 256) && (args.ph_hi - args.ph_lo > 1);
        if (fusedn && (ph == 22 || sub == 7)) continue;
        { int t_ = threadIdx.x; asm volatile("" : "+v"(t_)); X.tid = t_; X.lane = t_ & 63; }

        if (skip_) {
        } else if (ph == 22 && (PHMASK & 1024)) {
            const int gw = X.bid * 8 + X.wave, NGW = X.G * 8;
            (void)gw; (void)NGW; rms_pass(X, X.out, X.in[23], nullptr, X.out);
        } else if (sub == 0 && (PHMASK & 1)) {
        } else if (sub == 1 && (PHMASK & 2)) {
            pg8::Gemm g{X.P, X.Win, LDP, DM, DM}; pg8::StaticOrder S; S.init(T_TOK, 5120, X.G, X.bid);
            pg8::EpiInProj E{X.P, X.VT, X.ROPE, (bf16_t*)(X.ws + WS_BND)};
            pg8::gemm_phase<pg8::EpiInProj, true>(lds, g, S, E, X.tid);
        } else if (sub == 2 && (PHMASK & 4)) {
            phase_rwkv_pre(X, lds, layer);
        } else if (sub == 3 && (PHMASK & 4)) {
            phase_mixers(X, lds, layer, layer == 0 && fusedn);
        } else if (sub == 4 && (PHMASK & 8)) {
            phase_hgrn_post(X, layer);
            { const int gw = X.bid * 8 + X.wave, NGW = X.G * 8; const float* hh = (layer == 0) ? X.in[0] : X.out; const float* g = X.in[1] + (size_t)layer * DM;
              (void)gw; (void)NGW; if (layer > 0) rms_pass(X, hh, g, X.P, nullptr); }
        } else if (sub == 5 && (PHMASK & 16)) {
#pragma unroll 1
            for (int br = 0; br < 3; ++br) {
                const bool early_g = (layer == 0 && br == 0 && fusedn);
                bf16_t* Gb_ = early_g ? (bf16_t*)X.out + 1024 : X.P + COL_G; const int Gs_ = early_g ? 2048 : LDP;
                if (!early_g) { pg8::Gemm g{X.P, X.Wg + (size_t)br * DM * DM, LDP, DM, DM}; pg8::StaticOrder S; S.init(T_TOK, DM, X.G, X.bid);
                  int t_ = X.tid; asm volatile("" : "+v"(t_));
                  pg8::EpiGate E{X.P, Gb_, Gs_}; pg8::gemm_phase<pg8::EpiGate, true>(lds, g, S, E, t_); }
                { const int ycol = br == 0 ? COL_YA : (br == 1 ? COL_YB : COL_YC);
                  pg8::Gemm g{X.P + ycol, X.Wbr + (size_t)br * DM * 512, LDP, 512, 512}; pg8::StaticOrder S; S.init(T_TOK, DM, X.G, X.bid);
                  int t_ = X.tid; asm volatile("" : "+v"(t_));
                  pg8::EpiMergeAcc E{X.P, br == 0 ? 1 : 0, Gb_, Gs_}; pg8::gemm_phase<pg8::EpiMergeAcc, true>(lds, g, S, E, t_); }
            }
        } else if (sub == 6 && (PHMASK & 32)) {
            pg8::Gemm g{X.P + COL_MRG, X.Wo, LDP, DM, DM}; pg8::StaticOrder S; S.init(T_TOK, DM, X.G, X.bid);
            if (fusedn) {
                pg8::EpiResidNorm E{layer == 0 ? X.in[0] : X.out, X.out, X.in[18] + (size_t)layer * DM, X.P, nullptr,
                                    (unsigned*)(X.ws + WS_XB) + (size_t)(layer * 2) * 65536, (unsigned*)(X.ws + WS_XC) + (layer * 2) * 4096};
                pg8::gemm_phase<pg8::EpiResidNorm, false>(lds, g, S, E, X.tid);
            } else {
            pg8::EpiResid E{layer == 0 ? X.in[0] : X.out, X.out};
            pg8::gemm_phase<pg8::EpiResid, true>(lds, g, S, E, X.tid);
            }
        } else if (sub == 7 && (PHMASK & 64)) {
            const int gw = X.bid * 8 + X.wave, NGW = X.G * 8;
            const float* g = X.in[18] + (size_t)layer * DM;
            (void)gw; (void)NGW; rms_pass(X, X.out, g, X.P, nullptr);
        } else if (sub == 8 && (PHMASK & 128)) {
            pg8::Gemm g{X.P, X.Wup, LDP, DM, DM}; pg8::StaticOrder S; S.init(T_TOK, F2, X.G, X.bid);
            pg8::EpiUp E{X.P, X.HALO, X.in[20] + (size_t)layer * 3 * F2, X.in[21] + (size_t)layer * F2, (LAS float*)(lds + 131072)};
            pg8::gemm_phase<pg8::EpiUp, true>(lds, g, S, E, X.tid);
        } else if (sub == 9 && (PHMASK & 256)) {
            phase_fixup(X, layer);
        } else if (sub == 10 && (PHMASK & 512)) {
            pg8::Gemm g{X.P + COL_ACT, X.Wdn, LDP, DFF, DFF}; pg8::StaticOrder S; S.init(T_TOK, DM, X.G, X.bid);
            if (fusedn) {
                const bool last = (layer == 1);
                pg8::EpiResidNorm E{X.out, last ? nullptr : X.out, last ? X.in[23] : X.in[1] + (size_t)DM, last ? nullptr : X.P, last ? X.out : nullptr,
                                    (unsigned*)(X.ws + WS_XB) + (size_t)(layer * 2 + 1) * 65536, (unsigned*)(X.ws + WS_XC) + (layer * 2 + 1) * 4096};
                pg8::gemm_phase<pg8::EpiResidNorm, false>(lds, g, S, E, X.tid);
            } else {
            pg8::EpiResid E{X.out, X.out};
            pg8::gemm_phase<pg8::EpiResid, true>(lds, g, S, E, X.tid);
            }
        }
        {
        int pr_layer = -1, pr_lo = 0, pr_hi = 0, pr_gw = 0, pr_ngw = 1; bool pr_u = false;
        if (sub == 0 && ph < 22) { pr_layer = layer; pr_lo = (fusedn && layer > 0) ? NEARLY : 0; pr_hi = NITEMS; pr_u = !(fusedn && layer > 0); pr_gw = X.bid * 8 + X.wave; pr_ngw = X.G * 8; }
        if (sub == 8 && layer == 0 && fusedn && X.bid >= 128) { pr_layer = 1; pr_lo = 0; pr_hi = NEARLY; pr_u = false; pr_gw = (X.bid - 128) * 8 + X.wave; pr_ngw = 128 * 8; }
        if (pr_layer >= 0) { { int t_ = threadIdx.x; asm volatile("" : "+v"(t_)); X.tid = t_; X.lane = t_ & 63; } phase_prep(X, lds, pr_layer, pr_u, pr_lo, pr_hi, pr_gw, pr_ngw); }
        }
#if PROBE_DOUBLE
        if (ph2 + 1 < args.ph_hi * 2) cg::this_grid().sync();
#else
        if (ph + 1 < args.ph_hi && !(fusedn && ph == 21)) { if (args.ph_hi > 1000) cg::this_grid().sync(); else xcd_barrier(gbar); }
#endif
    }
}

extern "C" void kernel_launch(void* const* d_in, const int* in_sizes, int n_in, void* d_out, int out_size, void* d_ws, size_t ws_size, hipStream_t stream) {
    static int grid = 0;
    if (grid == 0) {
        int dev = 0, cus = 0, per_cu = 0;
        (void)hipGetDevice(&dev);
        (void)hipDeviceGetAttribute(&cus, hipDeviceAttributeMultiprocessorCount, dev);
        if (hipFuncSetAttribute((const void*)mk_fwd, hipFuncAttributeMaxDynamicSharedMemorySize, LDS_BYTES) != hipSuccess) fprintf(stderr, "kernel_launch: hipFuncSetAttribute failed\n");
        if (hipOccupancyMaxActiveBlocksPerMultiprocessor(&per_cu, (const void*)mk_fwd, 512, LDS_BYTES) != hipSuccess || per_cu < 1) { fprintf(stderr, "kernel_launch: occupancy query gave %d\n", per_cu); per_cu = 1; }
        (void)hipGetLastError();
        grid = cus * 1;
        if (grid <= 0) grid = 256;
        if (ws_size < (size_t)268435456) fprintf(stderr, "kernel_launch: workspace too small (%zu)\n", ws_size);
    }
    Args a{};
    for (int i = 0; i < 24; ++i) a.in[i] = (const float*)d_in[i];
    a.out = (float*)d_out; a.ws = (unsigned char*)d_ws;
#if MK_SINGLE
    (void)hipMemsetAsync((char*)d_ws + WS_BAR, 0, 16384 + 65536, stream);
    a.ph_lo = 0; a.ph_hi = 23;
    void* kargs[] = {&a};
    hipError_t e = hipLaunchCooperativeKernel((const void*)mk_fwd, dim3(grid), dim3(512), kargs, LDS_BYTES, stream);
    if (e != hipSuccess) fprintf(stderr, "cooperative launch failed: %s (grid %d)\n", hipGetErrorString(e), grid);
#else
    for (int ph = 0; ph < 23; ++ph) {
        a.ph_lo = ph; a.ph_hi = ph + 1;
        hipLaunchKernelGGL(mk_fwd, dim3(grid), dim3(512), LDS_BYTES, stream, a);
    }
#endif
}
```

```cpp
#include <hip/hip_runtime.h>
#include <hip/hip_cooperative_groups.h>
#include <cstdio>
#include <cstdint>
namespace cg = cooperative_groups;

#ifndef PHMASK
#define PHMASK 2047
#endif
#ifndef REPMASK
#define REPMASK 0
#endif
#ifndef PROBE_DOUBLE
#define PROBE_DOUBLE 0
#endif
#ifndef PROBE_SCAN2
#define PROBE_SCAN2 0
#endif
#ifndef TKMASK
#define TKMASK 7
#endif
#ifndef MK_SINGLE
#define MK_SINGLE 1
#endif

#define LAS __attribute__((address_space(3)))
typedef unsigned short bf16_t;
typedef short bf16x8 __attribute__((ext_vector_type(8)));
typedef float f32x4 __attribute__((ext_vector_type(4)));
typedef float f32x2 __attribute__((ext_vector_type(2)));
typedef unsigned u32x4 __attribute__((ext_vector_type(4)));
typedef unsigned u32x2 __attribute__((ext_vector_type(2)));

constexpr int T_TOK = 16384, SEQ = 2048, DM = 1024;
constexpr int LDP = 6208;
constexpr int COL_PA = 1024, COL_PB = 2816, COL_PC = 4864;
constexpr int COL_YA = 1024, COL_MRG = 1536, COL_G = 2816, COL_YB = 3840, COL_YC = 4864, COL_ACT = 1024;
constexpr int COL_GS = 5960;
constexpr int C_Q = 4864, C_K = 5376, C_QI = 5632, C_KI = 5888, C_WI = 5952;
constexpr int IN_COLS = 8004, DFF = 2816, F2 = 5632;
constexpr size_t WS_WIN = 0, WS_WG = 10485760, WS_WBR = 16777216, WS_WO = 19922944, WS_WUP = 22020096, WS_WDN = 33554432;
constexpr size_t WS_P = 39321600, WS_HALO = 242745344, WS_VT = WS_HALO, WS_ROPE = 265814016, WS_BAR = 266338304, WS_BND = WS_HALO + 4194304, WS_SCAL = WS_HALO + 8388608, WS_XC = WS_BAR + 16384, WS_XB = WS_XC + 65536;
constexpr int LDS_BYTES = 153600;
constexpr int SCS = 2052;
constexpr int MASK_OFF = 16 * SCS * 4;

struct Args { const float* in[24]; float* out; unsigned char* ws; int ph_lo, ph_hi; };

__device__ __forceinline__ unsigned f2bf(float f) { unsigned u = __builtin_bit_cast(unsigned, f); return (u + 0x7fffu + ((u >> 16) & 1u)) >> 16; }
__device__ __forceinline__ unsigned pk2(float lo, float hi) { unsigned r; asm("v_cvt_pk_bf16_f32 %0, %1, %2" : "=v"(r) : "v"(lo), "v"(hi)); return r; }
__device__ __forceinline__ float bf2f(bf16_t b) { return __builtin_bit_cast(float, (unsigned)b << 16); }
__device__ __forceinline__ float bflo(unsigned w) { return __builtin_bit_cast(float, w << 16); }
__device__ __forceinline__ float bfhi(unsigned w) { return __builtin_bit_cast(float, w & 0xffff0000u); }
__device__ __forceinline__ float wave_sum(float v) {
#pragma unroll
    for (int o = 1; o < 64; o <<= 1) v += __shfl_xor(v, o);
    return v;
}
__device__ __forceinline__ int wave_sum_i(int v) {
#pragma unroll
    for (int o = 1; o < 64; o <<= 1) v += __shfl_xor(v, o);
    return v;
}
template <int CTRL> __device__ __forceinline__ float dpp_mov(float x) {
    return __builtin_bit_cast(float, __builtin_amdgcn_update_dpp(0, __builtin_bit_cast(int, x), CTRL, 0xF, 0xF, true));
}
__device__ __forceinline__ float red8(float x) { x += dpp_mov<0xB1>(x); x += dpp_mov<0x4E>(x); x += dpp_mov<0x141>(x); return x; }
__device__ __forceinline__ float red16(float x) { x = red8(x); x += dpp_mov<0x140>(x); return x; }
__device__ __forceinline__ float sigmoidf_(float x) { return 1.f / (1.f + __expf(-x)); }

namespace pg8 {
constexpr int BM = 256, BK = 64, HALF = 128, HTB = HALF * BK * 2, NXCD = 8, WGM = 8;
__device__ __forceinline__ int lds_byte(int r, int c) { const int st = (r >> 4) * 2 + (c >> 5), rr = r & 15, cc = c & 31, ob = rr * 64 + cc * 2; return st * 1024 + (ob ^ (((ob >> 9) & 1) << 5)); }
__device__ __forceinline__ void stage_rc(int b, int& R, int& C) { const int st = b / 1024, sb = b % 1024, swz = sb ^ (((sb >> 9) & 1) << 5); R = (st >> 1) * 16 + swz / 64; C = (st & 1) * 32 + (swz % 64) / 2; }
__device__ __forceinline__ int perm32(int rho) { const int n = rho >> 4, i = rho & 15; return 8 * (i >> 2) + 4 * n + (i & 3); }
struct Unit { int pm, pn; };
struct Gemm { const bf16_t* A; const bf16_t* Bt; int lda, ldb, K; };
struct StaticOrder {
    int nM, nN, nwg, G, c;
    __device__ void init(int M, int N, int G_, int c_) { nM = M / BM; nN = N / BM; nwg = nM * nN; G = G_; c = c_; }
    __device__ bool next(int i, Unit& u) const {
        const long L = (long)i * G + c; if (L >= nwg) return false;
        int wgid = (int)L; { const int q = nwg / NXCD, r = nwg % NXCD, xcd = wgid % NXCD, off = wgid / NXCD; wgid = (xcd < r ? xcd * (q + 1) : r * (q + 1) + (xcd - r) * q) + off; }
        const int nig = WGM * nN, gid = wgid / nig, fm = gid * WGM, gsz = (nM - fm) < WGM ? (nM - fm) : WGM;
        u.pm = fm + ((wgid % nig) % gsz); u.pn = (wgid % nig) / gsz; return true;
    }
};
__device__ __forceinline__ unsigned cvt_pk_bf16(float lo, float hi) { unsigned r; asm volatile("v_cvt_pk_bf16_f32 %0, %1, %2" : "=v"(r) : "v"(lo), "v"(hi)); return r; }

template <class Epi, bool ALIGN_EPI>
__device__ __forceinline__ void gemm_phase(LAS unsigned char* lds, const Gemm g, const StaticOrder& S, const Epi& E, const int tid) {
    const int wid = __builtin_amdgcn_readfirstlane(tid >> 6), lane = tid & 63, wr = wid >> 2, wc = wid & 3, fr = lane & 15, fq = lane >> 4;
    const int K = g.K, nt = K / BK;
    unsigned voffA[2], voffB[2];
#pragma unroll
    for (int i = 0; i < 2; ++i) { int R, C; stage_rc(tid * 16 + i * 8192, R, C); const int Rb = (R & ~31) + perm32(R & 31);
        voffA[i] = (unsigned)(R * g.lda + C) * 2u; voffB[i] = (unsigned)(Rb * g.ldb + C) * 2u; }
    const size_t kstep = (size_t)(BK * 2);
    const size_t hstepA = (size_t)HALF * g.lda * 2, hstepB = (size_t)HALF * g.ldb * 2;
    const size_t tstepA = 2 * hstepA, tstepB = 2 * hstepB;
    const unsigned ldsw = (unsigned)wid * 1024u;
    const int aoff = lds_byte(wr * 64 + fr, fq * 8), boff = lds_byte(wc * 32 + fr, fq * 8);
#define PG8_SA(b, h) (((b) * 2 + (h)) * HTB)
#define PG8_SB(b, h) ((4 + (b) * 2 + (h)) * HTB)
#define PG8_STAGE(bufoff, gbase, voff) do { _Pragma("unroll") for (int _i = 0; _i < 2; ++_i) \
        __builtin_amdgcn_global_load_lds((const unsigned*)((const char*)(gbase) + (voff)[_i]), (LAS unsigned*)(lds + (bufoff) + ldsw + _i * 8192), 16, 0, 0); } while (0)
#define PG8_LDA(dst, b, h) do { _Pragma("unroll") for (int m = 0; m < 4; ++m) _Pragma("unroll") for (int k = 0; k < 2; ++k) dst[m][k] = *(const LAS bf16x8*)(lds + PG8_SA(b, h) + aoff + m * 2048 + k * 1024); } while (0)
#define PG8_LDB(dst, b, h) do { _Pragma("unroll") for (int n = 0; n < 2; ++n) _Pragma("unroll") for (int k = 0; k < 2; ++k) dst[n][k] = *(const LAS bf16x8*)(lds + PG8_SB(b, h) + boff + n * 2048 + k * 1024); } while (0)
#define PG8_MMA(ai, bj, At, Bt) do { __builtin_amdgcn_s_setprio(1); _Pragma("unroll") for (int m = 0; m < 4; ++m) _Pragma("unroll") for (int n = 0; n < 2; ++n) _Pragma("unroll") for (int k = 0; k < 2; ++k) \
        acc[ai][bj][m][n] = __builtin_amdgcn_mfma_f32_16x16x32_bf16(Bt[n][k], At[m][k], acc[ai][bj][m][n], 0, 0, 0); __builtin_amdgcn_s_setprio(0); } while (0)
#define PG8_WAIT_V(n) asm volatile("s_waitcnt vmcnt(" #n ")" ::: "memory")
#define PG8_WAIT_L(n) asm volatile("s_waitcnt lgkmcnt(" #n ")" ::: "memory")
#define PG8_BAR __builtin_amdgcn_s_barrier()
#define PG8_SCHED __builtin_amdgcn_sched_barrier(0)
    Unit cur, nxt; int ui = 0;
    if (!S.next(0, cur)) return;
    f32x4 acc[2][2][4][2];
#pragma unroll
    for (int a = 0; a < 2; ++a)
#pragma unroll
        for (int b = 0; b < 2; ++b)
#pragma unroll
            for (int m = 0; m < 4; ++m)
#pragma unroll
                for (int n = 0; n < 2; ++n) acc[a][b][m][n] = (f32x4){0.f, 0.f, 0.f, 0.f};
    bf16x8 At[4][2], B0[2][2], B1[2][2];
    const char* cA = (const char*)g.A + (size_t)cur.pm * tstepA; const char* cB = (const char*)g.Bt + (size_t)cur.pn * tstepB;
    PG8_STAGE(PG8_SB(0, 0), cB, voffB); PG8_STAGE(PG8_SB(0, 1), cB + hstepB, voffB); PG8_STAGE(PG8_SA(0, 0), cA, voffA); PG8_STAGE(PG8_SA(0, 1), cA + hstepA, voffA);
    if (wr == 1) PG8_BAR;
    PG8_WAIT_V(2); PG8_BAR;
    PG8_STAGE(PG8_SB(1, 0), cB + kstep, voffB); PG8_STAGE(PG8_SA(1, 0), cA + kstep, voffA); PG8_STAGE(PG8_SB(1, 1), cB + hstepB + kstep, voffB);
    PG8_WAIT_V(6); PG8_BAR;
    for (;;) {
        const bool has_next = S.next(ui + 1, nxt);
        const char* nA = has_next ? (const char*)g.A + (size_t)nxt.pm * tstepA : cA; const char* nB = has_next ? (const char*)g.Bt + (size_t)nxt.pn * tstepB : cB;
        for (int t = 0; t < nt; t += 2) {
            const bool last = (t == nt - 2);
            const char* a1 = cA + (size_t)(t + 1) * kstep;
            const char* a2 = last ? nA : cA + (size_t)(t + 2) * kstep; const char* b2 = last ? nB : cB + (size_t)(t + 2) * kstep;
            const char* a3 = a2 + kstep; const char* b3 = b2 + kstep;
            PG8_LDB(B0, 0, 0); PG8_LDB(B1, 0, 1); PG8_SCHED; PG8_LDA(At, 0, 0); PG8_STAGE(PG8_SA(1, 1), a1 + hstepA, voffA);
            PG8_WAIT_V(8); PG8_WAIT_L(0); PG8_BAR; PG8_MMA(0, 0, At, B0); PG8_MMA(0, 1, At, B1); PG8_BAR; PG8_SCHED;
            PG8_LDA(At, 0, 1); PG8_STAGE(PG8_SB(0, 0), b2, voffB); PG8_STAGE(PG8_SB(0, 1), b2 + hstepB, voffB); PG8_STAGE(PG8_SA(0, 0), a2, voffA);
            PG8_WAIT_V(8); PG8_WAIT_L(0); PG8_BAR; PG8_MMA(1, 0, At, B0); PG8_MMA(1, 1, At, B1); PG8_BAR; PG8_SCHED;
            PG8_LDB(B0, 1, 0); PG8_LDB(B1, 1, 1); PG8_SCHED; PG8_LDA(At, 1, 0); PG8_STAGE(PG8_SA(0, 1), a2 + hstepA, voffA);
            PG8_WAIT_V(8); PG8_WAIT_L(0); PG8_BAR; PG8_MMA(0, 0, At, B0); PG8_MMA(0, 1, At, B1); PG8_BAR; PG8_SCHED;
            PG8_LDA(At, 1, 1); PG8_STAGE(PG8_SB(1, 0), b3, voffB); PG8_STAGE(PG8_SB(1, 1), b3 + hstepB, voffB); PG8_STAGE(PG8_SA(1, 0), a3, voffA);
            PG8_WAIT_V(8); PG8_WAIT_L(0); PG8_BAR; PG8_MMA(1, 0, At, B0); PG8_MMA(1, 1, At, B1); PG8_BAR; PG8_SCHED;
        }
        if constexpr (ALIGN_EPI) { if (wr == 0) PG8_BAR; }
        if constexpr (!Epi::AFTER_DRAIN) E(acc, cur, wr, wc, fr, fq);
        if (!has_next) break;
#pragma unroll
        for (int a = 0; a < 2; ++a)
#pragma unroll
            for (int b = 0; b < 2; ++b)
#pragma unroll
                for (int m = 0; m < 4; ++m)
#pragma unroll
                    for (int n = 0; n < 2; ++n) acc[a][b][m][n] = (f32x4){0.f, 0.f, 0.f, 0.f};
        cur = nxt; cA = nA; cB = nB; ++ui;
        if constexpr (ALIGN_EPI) { if (wr == 1) PG8_BAR; }
    }
    PG8_WAIT_V(0);
    if constexpr (!ALIGN_EPI) { if (wr == 0) PG8_BAR; }
    PG8_BAR;
    if constexpr (Epi::AFTER_DRAIN) E.fused(acc, cur, wr, wc, fr, fq, lds, wid, lane);
#undef PG8_SA
#undef PG8_SB
#undef PG8_STAGE
#undef PG8_LDA
#undef PG8_LDB
#undef PG8_MMA
#undef PG8_WAIT_V
#undef PG8_WAIT_L
#undef PG8_BAR
#undef PG8_SCHED
}

typedef f32x4 AccT[2][2][4][2];

struct EpiInProj {
    static constexpr bool AFTER_DRAIN = false;
    bf16_t* P; bf16_t* VT; const float* rope; bf16_t* BND;
    __device__ __forceinline__ void operator()(AccT& acc, const Unit& u, int wr, int wc, int fr, int fq) const {
        const int row0 = u.pm * BM + wr * 64 + fr, colb = u.pn * BM + wc * 32 + 8 * fq;
#pragma unroll
        for (int ai = 0; ai < 2; ++ai)
#pragma unroll
            for (int m = 0; m < 4; ++m) {
                const int row = row0 + ai * HALF + m * 16, t = row & (SEQ - 1);
                bf16_t* rowp = P + (size_t)row * LDP + COL_PA;
#pragma unroll
                for (int bj = 0; bj < 2; ++bj) {
                    const int c = colb + bj * HALF;
                    f32x4 v0 = acc[ai][bj][m][0], v1 = acc[ai][bj][m][1];
                    if (u.pn >= 15) {
                        const int cl = c - 3840;
                        if (cl < 640 || (cl >= 768 && cl < 1088)) {
                            const float* cs = rope + ((size_t)t * 32 + ((cl & 63) >> 1)) * 2;
                            const f32x4 r0 = *(const f32x4*)cs, r1 = *(const f32x4*)(cs + 4);
                            f32x4 o0, o1;
                            o0[0] = v0[0] * r0[0] - v0[1] * r0[1]; o0[1] = v0[1] * r0[0] + v0[0] * r0[1];
                            o0[2] = v0[2] * r0[2] - v0[3] * r0[3]; o0[3] = v0[3] * r0[2] + v0[2] * r0[3];
                            o1[0] = v1[0] * r1[0] - v1[1] * r1[1]; o1[1] = v1[1] * r1[0] + v1[0] * r1[1];
                            o1[2] = v1[2] * r1[2] - v1[3] * r1[3]; o1[3] = v1[3] * r1[2] + v1[2] * r1[3];
                            v0 = o0; v1 = o1;
                        }
                    }
                    u32x4 w; w.x = cvt_pk_bf16(v0[0], v0[1]); w.y = cvt_pk_bf16(v0[2], v0[3]); w.z = cvt_pk_bf16(v1[0], v1[1]); w.w = cvt_pk_bf16(v1[2], v1[3]);
                    *(u32x4*)(rowp + c) = w;
                    if (u.pn < 7 && fr == 15) *(u32x4*)(BND + (size_t)(row >> 4) * 1792 + c) = w;
                    if (u.pn == 17 && bj == 1) {
                        const int cv = c - 3840 - 640, b = row >> 11;
                        bf16_t* vt = VT + ((size_t)(b * 2 + (cv >> 6)) * 64 + (cv & 63)) * SEQ + t;
                        vt[0 * SEQ] = (bf16_t)(w.x & 0xffffu); vt[1 * SEQ] = (bf16_t)(w.x >> 16);
                        vt[2 * SEQ] = (bf16_t)(w.y & 0xffffu); vt[3 * SEQ] = (bf16_t)(w.y >> 16);
                        vt[4 * SEQ] = (bf16_t)(w.z & 0xffffu); vt[5 * SEQ] = (bf16_t)(w.z >> 16);
                        vt[6 * SEQ] = (bf16_t)(w.w & 0xffffu); vt[7 * SEQ] = (bf16_t)(w.w >> 16);
                    }
                }
            }
    }
};
struct EpiGate {
    static constexpr bool AFTER_DRAIN = false;
    bf16_t* P; bf16_t* Gb; int Gs;
    __device__ __forceinline__ void operator()(AccT& acc, const Unit& u, int wr, int wc, int fr, int fq) const {
        const int row0 = u.pm * BM + wr * 64 + fr, colb = u.pn * BM + wc * 32 + 8 * fq;
#pragma unroll
        for (int ai = 0; ai < 2; ++ai)
#pragma unroll
            for (int m = 0; m < 4; ++m) {
                bf16_t* rowp = Gb + (size_t)(row0 + ai * HALF + m * 16) * Gs + colb;
#pragma unroll
                for (int bj = 0; bj < 2; ++bj) {
                    const f32x4 v0 = acc[ai][bj][m][0], v1 = acc[ai][bj][m][1];
                    u32x4 w; w.x = cvt_pk_bf16(sigmoidf_(v0[0]), sigmoidf_(v0[1])); w.y = cvt_pk_bf16(sigmoidf_(v0[2]), sigmoidf_(v0[3]));
                    w.z = cvt_pk_bf16(sigmoidf_(v1[0]), sigmoidf_(v1[1])); w.w = cvt_pk_bf16(sigmoidf_(v1[2]), sigmoidf_(v1[3]));
                    *(u32x4*)(rowp + bj * HALF) = w;
                }
            }
    }
};
struct EpiMergeAcc {
    static constexpr bool AFTER_DRAIN = false;
    bf16_t* P; int first; const bf16_t* Gb; int Gs;
    __device__ __forceinline__ void operator()(AccT& acc, const Unit& u, int wr, int wc, int fr, int fq) const {
        const int row0 = u.pm * BM + wr * 64 + fr, colb = u.pn * BM + wc * 32 + 8 * fq;
#pragma unroll
        for (int ai = 0; ai < 2; ++ai)
#pragma unroll
            for (int m = 0; m < 4; ++m) {
                bf16_t* rowb = P + (size_t)(row0 + ai * HALF + m * 16) * LDP + colb;
#pragma unroll
                for (int bj = 0; bj < 2; ++bj) {
                    const f32x4 v0 = acc[ai][bj][m][0], v1 = acc[ai][bj][m][1];
                    const u32x4 gq = *(const u32x4*)(Gb + (size_t)(row0 + ai * HALF + m * 16) * Gs + colb + bj * HALF);
                    u32x4 mq = (u32x4){0u, 0u, 0u, 0u};
                    if (!first) mq = *(const u32x4*)(rowb + COL_MRG + bj * HALF);
                    const unsigned ga = gq.x, gb = gq.y, gc = gq.z, gd = gq.w;
                    const unsigned ma = mq.x, mb = mq.y, mc = mq.z, md = mq.w;
                    u32x4 w;
                    w.x = cvt_pk_bf16(bflo(ma) + bflo(ga) * v0[0], bfhi(ma) + bfhi(ga) * v0[1]);
                    w.y = cvt_pk_bf16(bflo(mb) + bflo(gb) * v0[2], bfhi(mb) + bfhi(gb) * v0[3]);
                    w.z = cvt_pk_bf16(bflo(mc) + bflo(gc) * v1[0], bfhi(mc) + bfhi(gc) * v1[1]);
                    w.w = cvt_pk_bf16(bflo(md) + bflo(gd) * v1[2], bfhi(md) + bfhi(gd) * v1[3]);
                    *(u32x4*)(rowb + COL_MRG + bj * HALF) = w;
                }
            }
    }
};
struct EpiResid {
    static constexpr bool AFTER_DRAIN = false;
    const float* base; float* out;
    __device__ __forceinline__ void operator()(AccT& acc, const Unit& u, int wr, int wc, int fr, int fq) const {
        const int row0 = u.pm * BM + wr * 64 + fr, colb = u.pn * BM + wc * 32 + 8 * fq;
#pragma unroll
        for (int ai = 0; ai < 2; ++ai)
#pragma unroll
            for (int m = 0; m < 4; ++m) {
                const size_t off = (size_t)(row0 + ai * HALF + m * 16) * DM + colb;
#pragma unroll
                for (int bj = 0; bj < 2; ++bj) {
                    const f32x4 b0 = *(const f32x4*)(base + off + bj * HALF), b1 = *(const f32x4*)(base + off + bj * HALF + 4);
                    *(f32x4*)(out + off + bj * HALF) = b0 + acc[ai][bj][m][0];
                    *(f32x4*)(out + off + bj * HALF + 4) = b1 + acc[ai][bj][m][1];
                }
            }
    }
};
struct EpiResidNorm {
    static constexpr bool AFTER_DRAIN = true;
    const float* base; float* out; const float* g; bf16_t* obf; float* of32; unsigned* xbuf; unsigned* cnt;
    __device__ __forceinline__ void fused(AccT& acc, const Unit& u, int wr, int wc, int fr, int fq, LAS unsigned char* lds, int wid, int lane) const {
        LAS float* Pl = (LAS float*)lds;
        LAS float* S = (LAS float*)(lds + 8192);
        const int row0 = u.pm * BM + wr * 64 + fr, colb = u.pn * BM + wc * 32 + 8 * fq;
#pragma unroll
        for (int ai = 0; ai < 2; ++ai)
#pragma unroll
            for (int m = 0; m < 4; ++m) {
                const size_t off = (size_t)(row0 + ai * HALF + m * 16) * DM + colb;
                float sq = 0.f;
#pragma unroll
                for (int bj = 0; bj < 2; ++bj) {
                    const f32x4 b0 = *(const f32x4*)(base + off + bj * HALF), b1 = *(const f32x4*)(base + off + bj * HALF + 4);
                    const f32x4 h0 = acc[ai][bj][m][0] + b0, h1 = acc[ai][bj][m][1] + b1;
                    acc[ai][bj][m][0] = h0; acc[ai][bj][m][1] = h1;
                    sq += (h0.x * h0.x + h0.y * h0.y) + (h0.z * h0.z + h0.w * h0.w) + (h1.x * h1.x + h1.y * h1.y) + (h1.z * h1.z + h1.w * h1.w);
                }
                sq += __shfl_xor(sq, 16); sq += __shfl_xor(sq, 32);
                if (fq == 0) Pl[(ai * HALF + wr * 64 + m * 16 + fr) * 4 + wc] = sq;
                if (m & 1) asm volatile("" ::: "memory");
            }
        asm volatile("s_waitcnt lgkmcnt(0)" ::: "memory"); __builtin_amdgcn_s_barrier(); asm volatile("" ::: "memory");
        const int row = wid * 32 + (lane & 31);
        if (lane < 32) {
            const f32x4 p = *(const LAS f32x4*)&Pl[row * 4];
            __hip_atomic_store(xbuf + ((size_t)(u.pm * BM + row) * 4 + u.pn), __builtin_bit_cast(unsigned, (p.x + p.y) + (p.z + p.w)), __ATOMIC_RELAXED, __HIP_MEMORY_SCOPE_AGENT);
        }
        asm volatile("s_waitcnt vmcnt(0)" ::: "memory");
        if (lane == 0) __hip_atomic_fetch_add(cnt + 64 * u.pm, 1u, __ATOMIC_RELAXED, __HIP_MEMORY_SCOPE_AGENT);
        if (wid == 0) {
            unsigned sp = 0u;
            while ((unsigned)__builtin_amdgcn_readfirstlane(__hip_atomic_load(cnt + 64 * u.pm, __ATOMIC_RELAXED, __HIP_MEMORY_SCOPE_AGENT)) < 32u) { __builtin_amdgcn_s_sleep(2); if (++sp > (1u << 22)) break; }
            __builtin_amdgcn_fence(__ATOMIC_ACQUIRE, "agent");
        }
        asm volatile("s_waitcnt vmcnt(0) lgkmcnt(0)" ::: "memory"); __builtin_amdgcn_s_barrier(); asm volatile("" ::: "memory");
        if (lane < 32) {
            const unsigned* slot = xbuf + (size_t)(u.pm * BM + row) * 4; float tot = 0.f;
#pragma unroll
            for (int t = 0; t < 4; ++t) tot += __builtin_bit_cast(float, __hip_atomic_load(slot + t, __ATOMIC_RELAXED, __HIP_MEMORY_SCOPE_AGENT));
            S[row] = 1.0f / sqrtf(tot * (1.f / DM) + 1e-6f);
        }
        asm volatile("s_waitcnt lgkmcnt(0)" ::: "memory"); __builtin_amdgcn_s_barrier(); asm volatile("" ::: "memory");
        f32x4 gv[2][2];
#pragma unroll
        for (int bj = 0; bj < 2; ++bj)
#pragma unroll
            for (int n = 0; n < 2; ++n) gv[bj][n] = *(const f32x4*)(g + colb + bj * HALF + 4 * n);
#pragma unroll
        for (int ai = 0; ai < 2; ++ai)
#pragma unroll
            for (int m = 0; m < 4; ++m) {
                const int rl = ai * HALF + wr * 64 + m * 16 + fr, rowg = u.pm * BM + rl;
                const float rs = S[rl];
#pragma unroll
                for (int bj = 0; bj < 2; ++bj) {
                    const f32x4 h0 = acc[ai][bj][m][0], h1 = acc[ai][bj][m][1];
                    const size_t off = (size_t)rowg * DM + colb + bj * HALF;
                    if (out) { *(f32x4*)(out + off) = h0; *(f32x4*)(out + off + 4) = h1; }
                    const f32x4 o0 = h0 * rs * gv[bj][0], o1 = h1 * rs * gv[bj][1];
                    if (obf) { u32x4 w; w.x = cvt_pk_bf16(o0[0], o0[1]); w.y = cvt_pk_bf16(o0[2], o0[3]); w.z = cvt_pk_bf16(o1[0], o1[1]); w.w = cvt_pk_bf16(o1[2], o1[3]);
                        *(u32x4*)(obf + (size_t)rowg * LDP + colb + bj * HALF) = w; }
                    else { *(f32x4*)(of32 + off) = o0; *(f32x4*)(of32 + off + 4) = o1; }
                }
                asm volatile("" ::: "memory");
            }
    }
};
struct EpiUp {
    static constexpr bool AFTER_DRAIN = false;
    bf16_t* P; float* HALO; const float* cw; const float* cb; LAS float* CW;
    __device__ __forceinline__ void operator()(AccT& acc, const Unit& u, int wr, int wc, int fr_in, int fq_in) const {
        int fr = fr_in, fq = fq_in;
        asm volatile("" : "+v"(fr), "+v"(fq));
        const int row0 = u.pm * BM + wr * 64 + fr;
        const int jb = u.pn * 128 + wc * 32 + 8 * fq;
        {
            const int tl = (wr * 4 + wc) * 64 + fq * 16 + fr;
#pragma unroll
            for (int it = 0; it < 2; ++it) { const int k = tl + 512 * it, p = k >> 8, col = k & 255, co = (col >> 7) * DFF + u.pn * 128 + (col & 127);
                CW[k] = (p < 3) ? cw[p * F2 + co] : cb[co]; }
            asm volatile("s_waitcnt lgkmcnt(0)" ::: "memory"); __builtin_amdgcn_s_barrier(); asm volatile("" ::: "memory");
        }
#pragma unroll
        for (int ai = 0; ai < 2; ++ai) {
            const int s = u.pm * 4 + ai * 2 + wr;
#pragma unroll
            for (int bj = 0; bj < 2; ++bj)
#pragma unroll
                for (int n = 0; n < 2; ++n) {
                    const int colp = u.pn * BM + bj * HALF + wc * 32 + 8 * fq + 4 * n;
                    if (fr < 2) *(f32x4*)(HALO + (size_t)(s * 4 + fr) * F2 + colp) = acc[ai][bj][0][n];
                    if (fr >= 14) *(f32x4*)(HALO + (size_t)(s * 4 + fr - 12) * F2 + colp) = acc[ai][bj][3][n];
                }
        }
#pragma unroll
        for (int ai = 0; ai < 2; ++ai)
#pragma unroll
            for (int m = 0; m < 4; ++m) {
                const int row = row0 + ai * HALF + m * 16;
#pragma unroll
                for (int n = 0; n < 2; ++n) {
                    f32x4 cv[2];
#pragma unroll
                    for (int bj = 0; bj < 2; ++bj) {
                        const int cl = bj * 128 + wc * 32 + 8 * fq + 4 * n;
                        const f32x4 w0 = *(const LAS f32x4*)&CW[cl], w1 = *(const LAS f32x4*)&CW[256 + cl], w2 = *(const LAS f32x4*)&CW[512 + cl], bb = *(const LAS f32x4*)&CW[768 + cl];
#pragma unroll
                        for (int e = 0; e < 4; ++e) {
                            const float cur = acc[ai][bj][m][n][e];
                            const float prv = m > 0 ? acc[ai][bj][m > 0 ? m - 1 : 0][n][e] : 0.f;
                            const float a1 = dpp_mov<0x121>(cur), a2 = dpp_mov<0x122>(cur), b1 = dpp_mov<0x121>(prv), b2 = dpp_mov<0x122>(prv);
                            const float p1 = fr >= 1 ? a1 : b1, p2 = fr >= 2 ? a2 : b2;
                            cv[bj][e] = bb[e] + w0[e] * p2 + w1[e] * p1 + w2[e] * cur;
                        }
                        __builtin_amdgcn_sched_barrier(0);
                    }
                    const f32x4 g0 = cv[0], v0 = cv[1];
                    u32x2 w;
                    w.x = cvt_pk_bf16(g0[0] * sigmoidf_(g0[0]) * v0[0], g0[1] * sigmoidf_(g0[1]) * v0[1]);
                    w.y = cvt_pk_bf16(g0[2] * sigmoidf_(g0[2]) * v0[2], g0[3] * sigmoidf_(g0[3]) * v0[3]);
                    if (!(m == 0 && fr < 2)) *(u32x2*)(P + (size_t)row * LDP + COL_ACT + jb + 4 * n) = w;
                    __builtin_amdgcn_sched_barrier(0);
                }
            }
    }
};
}

struct Ctx {
    const float* in[24]; float* out; unsigned char* ws;
    bf16_t* P; bf16_t* VT; float* HALO; float* ROPE;
    bf16_t *Win, *Wg, *Wbr, *Wo, *Wup, *Wdn;
    int tid, lane, wave, G, bid;
};

__device__ __forceinline__ int srccol(int mode, int n) {
    if (mode == 0) return n;
    if (mode == 2) return 4932 + n;
    if (mode == 3) { const int tile = n >> 8, w = n & 255, j = tile * 128 + (w & 127); return (w < 128) ? j : DFF + j; }
    if (n < 3840) return n;
    const int c = n - 3840;
    if (c >= 1092) return -1;
    if (c < 640 || (c >= 768 && c < 1088)) { const int base = c & ~63, i = c & 63; return 3840 + base + (i >> 1) + 32 * (i & 1); }
    return 3840 + c;
}
__device__ __forceinline__ void tr_item(const float* W, int ldw, int K, int N, bf16_t* WT, int mode, int item, LAS float* scr, int lane) {
    const int nblk = N / 32, kb = item / nblk, nb = item % nblk, k0 = 64 * kb, n0 = 32 * nb;
    const int sc = srccol(mode, n0 + (lane & 31));
    float wv_[32];
#pragma unroll
    for (int i = 0; i < 32; ++i) { const int kk = 2 * i + (lane >> 5); wv_[i] = (sc >= 0) ? W[(size_t)(k0 + kk) * ldw + sc] : 0.f; }
#pragma unroll
    for (int i = 0; i < 32; ++i) { const int kk = 2 * i + (lane >> 5); scr[kk * 33 + (lane & 31)] = wv_[i]; }
    asm volatile("s_waitcnt lgkmcnt(0)" ::: "memory");
    const int c = lane & 7;
#pragma unroll
    for (int j = 0; j < 4; ++j) { const int n = (lane >> 3) + 8 * j; const LAS float* s = scr + (8 * c) * 33 + n;
        u32x4 o; o.x = pk2(s[0 * 33], s[1 * 33]); o.y = pk2(s[2 * 33], s[3 * 33]); o.z = pk2(s[4 * 33], s[5 * 33]); o.w = pk2(s[6 * 33], s[7 * 33]);
        *(u32x4*)(WT + (size_t)(n0 + n) * K + k0 + 8 * c) = o; }
    asm volatile("s_waitcnt lgkmcnt(0)" ::: "memory");
}
__device__ __forceinline__ void rms_row(const float* xrow, const float* g, bf16_t* obf, float* of32, int lane) {
    const f32x4* xr = (const f32x4*)xrow + lane; const f32x4* gr = (const f32x4*)g + lane;
    f32x4 v[4]; float s = 0.f;
#pragma unroll
    for (int j = 0; j < 4; ++j) { v[j] = xr[64 * j]; s += (v[j].x * v[j].x + v[j].y * v[j].y) + (v[j].z * v[j].z + v[j].w * v[j].w); }
    const float rs = 1.f / sqrtf(wave_sum(s) * (1.f / DM) + 1e-6f);
#pragma unroll
    for (int j = 0; j < 4; ++j) {
        const f32x4 gg = gr[64 * j]; const f32x4 o = v[j] * rs * gg;
        if (obf) { u32x2 w; w.x = pk2(o.x, o.y); w.y = pk2(o.z, o.w); *((u32x2*)obf + lane + 64 * j) = w; }
        else *((f32x4*)of32 + lane + 64 * j) = o;
    }
}
__device__ __forceinline__ void rms_pass(const Ctx& X, const float* src, const float* g, bf16_t* obf, float* of32) {
    const int gw = X.bid * 8 + X.wave, NGW = X.G * 8, lane = X.lane;
    const f32x4* gr = (const f32x4*)g + lane;
    f32x4 gg[4];
#pragma unroll
    for (int j = 0; j < 4; ++j) gg[j] = gr[64 * j];
#pragma unroll 1
    for (int m = gw; m < T_TOK; m += 4 * NGW) {
        f32x4 v[4][4]; float ss[4]; int mr[4];
#pragma unroll
        for (int r = 0; r < 4; ++r) { mr[r] = m + r * NGW; const int ml = mr[r] < T_TOK ? mr[r] : m; const f32x4* x = (const f32x4*)(src + (size_t)ml * DM) + lane;
#pragma unroll
            for (int j = 0; j < 4; ++j) v[r][j] = x[64 * j]; }
#pragma unroll
        for (int r = 0; r < 4; ++r) { float a = 0.f;
#pragma unroll
            for (int j = 0; j < 4; ++j) a += (v[r][j].x * v[r][j].x + v[r][j].y * v[r][j].y) + (v[r][j].z * v[r][j].z + v[r][j].w * v[r][j].w);
            ss[r] = 1.f / sqrtf(wave_sum(a) * (1.f / DM) + 1e-6f); }
#pragma unroll
        for (int r = 0; r < 4; ++r) {
            if (mr[r] < T_TOK) {
#pragma unroll
                for (int j = 0; j < 4; ++j) {
                    const f32x4 o = v[r][j] * ss[r] * gg[j];
                    if (obf) { u32x2 w; w.x = pk2(o.x, o.y); w.y = pk2(o.z, o.w); *((u32x2*)(obf + (size_t)mr[r] * LDP) + lane + 64 * j) = w; }
                    else *((f32x4*)(of32 + (size_t)mr[r] * DM) + lane + 64 * j) = o;
                }
            }
        }
    }
}
constexpr int I_IN = 16 * 160, I_G = 16 * 96, I_BR = 8 * 32, I_O = 16 * 32, I_UP = 16 * 176, I_DN = 44 * 32;
constexpr int NITEMS = I_IN + I_G + 3 * I_BR + I_O + I_UP + I_DN, NEARLY = I_IN + I_G + 3 * I_BR + I_O;
__device__ __forceinline__ void phase_prep(const Ctx& X, LAS unsigned char* lds, int layer, bool do_u, int it_lo, int it_hi, int gw, int NGW) {
    LAS float* scr = (LAS float*)(lds + X.wave * 8448);
    const float* w_in = X.in[2] + (size_t)layer * DM * IN_COLS;
    const float* w_br = X.in[16] + (size_t)layer * 3 * 512 * DM;
    const float* w_o = X.in[17] + (size_t)layer * DM * DM;
    const float* w_up = X.in[19] + (size_t)layer * DM * F2;
    const float* w_dn = X.in[22] + (size_t)layer * DFF * DM;
    for (int it = it_lo + gw; it < it_hi; it += NGW) {
        int r = it;
        if (r < I_IN) { tr_item(w_in, IN_COLS, DM, 5120, X.Win, 1, r, scr, X.lane); continue; } r -= I_IN;
        if (r < I_G) { tr_item(w_in, IN_COLS, DM, 3072, X.Wg, 2, r, scr, X.lane); continue; } r -= I_G;
        if (r < 3 * I_BR) { const int b = r / I_BR; tr_item(w_br + (size_t)b * 512 * DM, DM, 512, DM, X.Wbr + (size_t)b * DM * 512, 0, r % I_BR, scr, X.lane); continue; } r -= 3 * I_BR;
        if (r < I_O) { tr_item(w_o, DM, DM, DM, X.Wo, 0, r, scr, X.lane); continue; } r -= I_O;
        if (r < I_UP) { tr_item(w_up, F2, DM, F2, X.Wup, 3, r, scr, X.lane); continue; } r -= I_UP;
        tr_item(w_dn, DM, DFF, DM, X.Wdn, 0, r, scr, X.lane);
    }
    const float* h = (layer == 0) ? X.in[0] : X.out;
    const float* g = X.in[1] + (size_t)layer * DM;
    if (do_u) rms_pass(X, h, g, X.P, nullptr);
    if (layer == 0 && it_lo == 0) {
        for (int idx = X.bid * 512 + X.tid; idx < SEQ * 32; idx += X.G * 512) {
            const int t = idx >> 5, p = idx & 31;
            const float inv = exp2f(-(float)p * 0.03125f * 13.287712379549449f);
            const float ang = (float)t * inv;
            const double rev = (double)ang * 0.15915494309189535;
            const float fr = (float)(rev - floor(rev));
            X.ROPE[2 * idx] = __builtin_amdgcn_cosf(fr); X.ROPE[2 * idx + 1] = __builtin_amdgcn_sinf(fr);
        }
    }
}

__device__ __forceinline__ float wave_sum_fast(float x) {
    x = red16(x);
    const float r0 = __builtin_bit_cast(float, __builtin_amdgcn_readlane(__builtin_bit_cast(int, x), 0)), r1 = __builtin_bit_cast(float, __builtin_amdgcn_readlane(__builtin_bit_cast(int, x), 16));
    const float r2 = __builtin_bit_cast(float, __builtin_amdgcn_readlane(__builtin_bit_cast(int, x), 32)), r3 = __builtin_bit_cast(float, __builtin_amdgcn_readlane(__builtin_bit_cast(int, x), 48));
    return (r0 + r1) + (r2 + r3);
}
#define LDS_BAR() do { asm volatile("s_waitcnt lgkmcnt(0)" ::: "memory"); __builtin_amdgcn_s_barrier(); asm volatile("" ::: "memory"); } while (0)
constexpr int RW_TS = 16, RW_NCH = SEQ / RW_TS, RW_BUF = 33280;
__device__ __forceinline__ void phase_rwkv_pre(const Ctx& X, LAS unsigned char* lds, int layer) {
    LAS float* Rr = (LAS float*)(lds);           LAS float* Kk = (LAS float*)(lds + 8192);   LAS float* Vv = (LAS float*)(lds + 16384);
    LAS float* W1 = (LAS float*)(lds + 24576);   LAS float* AS = (LAS float*)(lds + 32768);
    LAS bf16_t* WDb = (LAS bf16_t*)(lds + 40960);
    LAS bf16_t* ADb = (LAS bf16_t*)(lds + 45568);
    LAS bf16_t* WTu = (LAS bf16_t*)(lds + 50176);
    LAS bf16_t* WTa = (LAS bf16_t*)(lds + 59392);
    LAS float* MU = (LAS float*)(lds + 68608);
    const int tid = X.tid, lane = tid & 63, wv = X.wave;
    const float* mu = X.in[3] + layer * 1792;
    const float* w0 = X.in[4] + layer * 512;   const float* w_up = X.in[5] + (size_t)layer * 64 * 512;
    const float* a0 = X.in[6] + layer * 512;   const float* a_up = X.in[7] + (size_t)layer * 64 * 512;
    const float* k_k = X.in[9] + layer * 512;  const float* k_a = X.in[10] + layer * 512;  const float* r_k = X.in[11] + layer * 512;
    const bf16_t* BND = (const bf16_t*)(X.ws + WS_BND);
    float* SCAL = (float*)(X.ws + WS_SCAL);
    const int ln = lane & 15, lg = lane >> 4;
    int last_h = -1;
    float q_w0 = 0.f, q_a0 = 0.f;
    f32x4 p_kk4 = (f32x4){0.f, 0.f, 0.f, 0.f}, p_ka4 = p_kk4, p_rk4 = p_kk4;
    const int cg4 = (tid & 15) * 4;
    u32x4 pc4[3], pp4[3], gc4, gp4; bool have_pf = false;
    pc4[0] = pc4[1] = pc4[2] = pp4[0] = pp4[1] = pp4[2] = gc4 = gp4 = (u32x4){0u, 0u, 0u, 0u};
#define PRE_LOAD(uu) do { const int h_ = (uu) & 7, tp_ = (uu) >> 3; _Pragma("unroll") for (int it = 0; it < 3; ++it) { const int idx = tid + 512 * it; pc4[it] = (u32x4){0u, 0u, 0u, 0u}; pp4[it] = (u32x4){0u, 0u, 0u, 0u}; \
        if (idx < 32 * 40) { const int tt = idx / 40, vv = idx - tt * 40; \
            const int col = vv < 8 ? h_ * 64 + 8 * vv : (vv < 16 ? 512 + h_ * 64 + 8 * (vv - 8) : (vv < 24 ? 1024 + h_ * 64 + 8 * (vv - 16) : 1536 + 8 * (vv - 24))); \
            const size_t row = (size_t)tp_ * 32 + tt; pc4[it] = *(const u32x4*)(X.P + row * LDP + COL_PA + col); \
            if (tt > 0) pp4[it] = *(const u32x4*)(X.P + (row - 1) * LDP + COL_PA + col); else if ((tp_ & 63) != 0) pp4[it] = *(const u32x4*)(BND + (size_t)(2 * tp_ - 1) * 1792 + col); } } \
        if (tid < 64) { const int tt = tid >> 1, col = 1664 + 8 * (2 * h_ + (tid & 1)); const size_t row = (size_t)tp_ * 32 + tt; gc4 = *(const u32x4*)(X.P + row * LDP + COL_PA + col); gp4 = (u32x4){0u, 0u, 0u, 0u}; \
            if (tt > 0) gp4 = *(const u32x4*)(X.P + (row - 1) * LDP + COL_PA + col); else if ((tp_ & 63) != 0) gp4 = *(const u32x4*)(BND + (size_t)(2 * tp_ - 1) * 1792 + col); } } while (0)
#pragma unroll 1
    for (int u = X.bid; u < 4096; u += X.G) {
        const int h = u & 7, tp = u >> 3;
        if (h != last_h) {
            __syncthreads();
            for (int idx = tid; idx < 64 * 64; idx += 512) { const int m = idx >> 6, cc = idx & 63;
                WTu[cc * 72 + m] = (bf16_t)f2bf(w_up[m * 512 + h * 64 + cc]); WTa[cc * 72 + m] = (bf16_t)f2bf(a_up[m * 512 + h * 64 + cc]); }
            if (tid < 320) { const int cc = tid; const int col = cc < 64 ? h * 64 + cc : (cc < 128 ? 512 + h * 64 + cc - 64 : (cc < 192 ? 1024 + h * 64 + cc - 128 : 1536 + cc - 192)); MU[cc] = mu[col]; }
            p_kk4 = *(const f32x4*)(k_k + h * 64 + cg4); p_ka4 = *(const f32x4*)(k_a + h * 64 + cg4); p_rk4 = *(const f32x4*)(r_k + h * 64 + cg4);
            q_w0 = w0[h * 64 + 16 * (wv >> 1) + ln]; q_a0 = a0[h * 64 + 16 * (wv >> 1) + ln];
            last_h = h;
            __syncthreads();
        }
        if (!have_pf) { PRE_LOAD(u); }
#pragma unroll
        for (int it = 0; it < 3; ++it) {
            const int idx = tid + 512 * it;
            if (idx < 32 * 40) {
                const int tt = idx / 40, vv = idx - tt * 40, cc0 = 8 * vv;
                const u32x4 c4 = pc4[it], p4 = pp4[it];
                const f32x4 m0 = *(const LAS f32x4*)&MU[cc0], m1 = *(const LAS f32x4*)&MU[cc0 + 4];
                float cur[8], prv[8], val[8];
                cur[0] = bflo(c4.x); cur[1] = bfhi(c4.x); cur[2] = bflo(c4.y); cur[3] = bfhi(c4.y); cur[4] = bflo(c4.z); cur[5] = bfhi(c4.z); cur[6] = bflo(c4.w); cur[7] = bfhi(c4.w);
                prv[0] = bflo(p4.x); prv[1] = bfhi(p4.x); prv[2] = bflo(p4.y); prv[3] = bfhi(p4.y); prv[4] = bflo(p4.z); prv[5] = bfhi(p4.z); prv[6] = bflo(p4.w); prv[7] = bfhi(p4.w);
#pragma unroll
                for (int e = 0; e < 8; ++e) val[e] = cur[e] + (prv[e] - cur[e]) * (e < 4 ? m0[e & 3] : m1[e & 3]);
                if (vv < 24) {
#pragma unroll
                    for (int e = 0; e < 8; e += 2) { const unsigned w_ = pk2(val[e], val[e + 1]); val[e] = bflo(w_); val[e + 1] = bfhi(w_); }
                    LAS float* dst = (vv < 8 ? Rr : (vv < 16 ? Kk : Vv)) + tt * 64 + 8 * (vv & 7);
                    *(LAS f32x4*)dst = (f32x4){val[0], val[1], val[2], val[3]}; *(LAS f32x4*)(dst + 4) = (f32x4){val[4], val[5], val[6], val[7]};
                } else {
                    const int lr0 = 8 * (vv - 24);
                    LAS bf16_t* dst;
                    if (lr0 < 64) { dst = WDb + tt * 72 + lr0;
#pragma unroll
                        for (int e = 0; e < 8; ++e) { const float ex = __expf(2.f * val[e]); val[e] = 1.f - 2.f / (ex + 1.f); } }
                    else dst = ADb + tt * 72 + lr0 - 64;
                    u32x4 o; o.x = pk2(val[0], val[1]); o.y = pk2(val[2], val[3]); o.z = pk2(val[4], val[5]); o.w = pk2(val[6], val[7]);
                    *(LAS u32x4*)dst = o;
                }
            }
        }
        if (tid < 64) {
            const int tt = tid >> 1, vg = 2 * h + (tid & 1);
            const f32x4 m0 = *(const f32x4*)(mu + 1664 + 8 * vg), m1 = *(const f32x4*)(mu + 1664 + 8 * vg + 4);
            float gc[8], gp[8];
            gc[0] = bflo(gc4.x); gc[1] = bfhi(gc4.x); gc[2] = bflo(gc4.y); gc[3] = bfhi(gc4.y); gc[4] = bflo(gc4.z); gc[5] = bfhi(gc4.z); gc[6] = bflo(gc4.w); gc[7] = bfhi(gc4.w);
            gp[0] = bflo(gp4.x); gp[1] = bfhi(gp4.x); gp[2] = bflo(gp4.y); gp[3] = bfhi(gp4.y); gp[4] = bflo(gp4.z); gp[5] = bfhi(gp4.z); gp[6] = bflo(gp4.w); gp[7] = bfhi(gp4.w);
#pragma unroll
            for (int e = 0; e < 8; ++e) gc[e] = sigmoidf_(gc[e] + (gp[e] - gc[e]) * (e < 4 ? m0[e & 3] : m1[e & 3]));
            u32x4 o; o.x = pk2(gc[0], gc[1]); o.y = pk2(gc[2], gc[3]); o.z = pk2(gc[4], gc[5]); o.w = pk2(gc[6], gc[7]);
            *(u32x4*)(X.P + ((size_t)tp * 32 + tt) * LDP + COL_GS + 8 * vg) = o;
        }
        have_pf = false;
        if (u + X.G < 4096 && ((u + X.G) & 7) == h) { PRE_LOAD(u + X.G); have_pf = true; }
        LDS_BAR();
        {
            const int mt = wv & 1, nt = wv >> 1, chm = 16 * nt + ln;
            f32x4 cw_ = (f32x4){0.f, 0.f, 0.f, 0.f}, ca_ = cw_;
#pragma unroll
            for (int ks = 0; ks < 2; ++ks) {
                const bf16x8 xa = *(const LAS bf16x8*)&WDb[(16 * mt + ln) * 72 + ks * 32 + 8 * lg], xb = *(const LAS bf16x8*)&WTu[(16 * nt + ln) * 72 + ks * 32 + 8 * lg];
                cw_ = __builtin_amdgcn_mfma_f32_16x16x32_bf16(xa, xb, cw_, 0, 0, 0);
                const bf16x8 ya = *(const LAS bf16x8*)&ADb[(16 * mt + ln) * 72 + ks * 32 + 8 * lg], yb = *(const LAS bf16x8*)&WTa[(16 * nt + ln) * 72 + ks * 32 + 8 * lg];
                ca_ = __builtin_amdgcn_mfma_f32_16x16x32_bf16(ya, yb, ca_, 0, 0, 0);
            }
#pragma unroll
            for (int r = 0; r < 4; ++r) {
                const int tt = 16 * mt + 4 * lg + r;
                const float z = -(q_w0 + cw_[r]);
                const float sp = fmaxf(z, 0.f) + __logf(1.f + __expf(-fabsf(z)));
                const float e = __expf(-sp - 0.5f);
                W1[tt * 64 + chm] = bf2f((bf16_t)f2bf(-expm1f(-e)));
                AS[tt * 64 + chm] = bf2f((bf16_t)f2bf(sigmoidf_(q_a0 + ca_[r])));
            }
        }
        LDS_BAR();
        {
            const int tt = tid >> 4;
            const size_t row = (size_t)tp * 32 + tt;
            const f32x4 w1 = *(const LAS f32x4*)&W1[tt * 64 + cg4], a = *(const LAS f32x4*)&AS[tt * 64 + cg4];
            const f32x4 kraw = *(const LAS f32x4*)&Kk[tt * 64 + cg4], r = *(const LAS f32x4*)&Rr[tt * 64 + cg4], v = *(const LAS f32x4*)&Vv[tt * 64 + cg4];
            const f32x4 kk0 = kraw * p_kk4;
            const float inv = 1.f / sqrtf(fmaxf(red16((kk0.x * kk0.x + kk0.y * kk0.y) + (kk0.z * kk0.z + kk0.w * kk0.w)), 1e-24f));
            const f32x4 kk = kk0 * inv;
            const f32x4 kmod = kraw * (1.f + (a - 1.f) * p_ka4);
            const f32x4 bvec = kk * a, t1 = bvec * r, t2 = kmod * r, t3 = t2 * p_rk4;
            const float br = red16((t1.x + t1.y) + (t1.z + t1.w)), kr = red16((t2.x + t2.y) + (t2.z + t2.w)), bonus = red16((t3.x + t3.y) + (t3.z + t3.w));
            bf16_t* rp_ = X.P + row * LDP;
            u32x2 o;
            o.x = pk2(r.x, r.y); o.y = pk2(r.z, r.w); *(u32x2*)(rp_ + COL_PA + h * 64 + cg4) = o;
            o.x = pk2(kraw.x, kraw.y); o.y = pk2(kraw.z, kraw.w); *(u32x2*)(rp_ + COL_PA + 512 + h * 64 + cg4) = o;
            o.x = pk2(v.x, v.y); o.y = pk2(v.z, v.w); *(u32x2*)(rp_ + COL_PA + 1024 + h * 64 + cg4) = o;
            bf16_t* wa_ = (layer == 0) ? (bf16_t*)X.out + row * 2048 : rp_;
            o.x = pk2(w1.x, w1.y); o.y = pk2(w1.z, w1.w); *(u32x2*)(wa_ + h * 64 + cg4) = o;
            o.x = pk2(a.x, a.y); o.y = pk2(a.z, a.w); *(u32x2*)(wa_ + 512 + h * 64 + cg4) = o;
            if (cg4 == 0) *(f32x4*)(SCAL + (row * 8 + h) * 4) = (f32x4){inv, br, kr, bonus};
        }
        LDS_BAR();
    }
}

__device__ __forceinline__ void rwkv_task(const Ctx& X, LAS unsigned char* lds, int layer, int b, int h) {
    LAS bf16_t* GDb = (LAS bf16_t*)(lds + 66560);
    LAS bf16_t* WTg = (LAS bf16_t*)(lds + 75264);
    LAS float* BON = (LAS float*)(lds + 92672);
    const int tid = X.tid, lane = tid & 63;
    const bool helper = X.wave >= 4;
    const int ht = tid & 255;
    const float* mu = X.in[3] + layer * 1792;
    const float* g_up = X.in[8] + (size_t)layer * 128 * 512;
    const float* k_k = X.in[9] + layer * 512;  const float* k_a = X.in[10] + layer * 512;
    const float* gn_g = X.in[12] + layer * 512; const float* gn_b = X.in[13] + layer * 512;
    const float* SCAL = (const float*)(X.ws + WS_SCAL);
    const int tt_h = ht >> 4, cg4 = (ht & 15) * 4;
    const f32x4 p_kk = *(const f32x4*)(k_k + h * 64 + cg4), p_ka = *(const f32x4*)(k_a + h * 64 + cg4);
    const f32x4 p_gg = *(const f32x4*)(gn_g + h * 64 + cg4), p_gb = *(const f32x4*)(gn_b + h * 64 + cg4);
    const int gv8 = (ht & 15) * 8;
    const int nt = (ht >> 6), ln = lane & 15, lg = lane >> 4, chm = 16 * nt + ln;
    const int rp = ht >> 3, jg = ht & 7, i0 = 2 * rp;
    for (int idx = tid; idx < 128 * 64; idx += 512) { const int m = idx >> 6, cc = idx & 63; WTg[cc * 136 + m] = (bf16_t)f2bf(g_up[m * 512 + h * 64 + cc]); }
    f32x2 S0[4], S1[4];
#pragma unroll
    for (int j = 0; j < 4; ++j) { S0[j] = (f32x2){0.f, 0.f}; S1[j] = (f32x2){0.f, 0.f}; }
#if PROBE_SCAN2
    f32x2 T0[4], T1[4];
#pragma unroll
    for (int j = 0; j < 4; ++j) { T0[j] = (f32x2){0.f, 0.f}; T1[j] = (f32x2){0.f, 0.f}; }
#endif
    __syncthreads();

#define RW_ARR(bufi, k) ((LAS float*)(lds + (bufi) * RW_BUF + (k) * 4096))
#define RW_SC(bufi) ((LAS float*)(lds + (bufi) * RW_BUF + 32768))
#define RW_LOAD(chk, L) do { const size_t row_ = (size_t)b * SEQ + (chk) * RW_TS + tt_h; const bf16_t* rp_ = X.P + row_ * LDP; \
        l_r##L = *(const u32x2*)(rp_ + COL_PA + h * 64 + cg4); l_k##L = *(const u32x2*)(rp_ + COL_PA + 512 + h * 64 + cg4); l_v##L = *(const u32x2*)(rp_ + COL_PA + 1024 + h * 64 + cg4); \
        { const bf16_t* wa_ = (layer == 0) ? (const bf16_t*)X.out + row_ * 2048 : rp_; l_w##L = *(const u32x2*)(wa_ + h * 64 + cg4); l_a##L = *(const u32x2*)(wa_ + 512 + h * 64 + cg4); } l_s##L = *(const f32x4*)(SCAL + (row_ * 8 + h) * 4); \
        l_gc##L = *(const u32x4*)(rp_ + COL_GS + gv8); } while (0)
    u32x2 l_rA, l_kA, l_vA, l_wA, l_aA; f32x4 l_sA; u32x4 l_gcA;
    u32x2 l_rB, l_kB, l_vB, l_wB, l_aB; f32x4 l_sB; u32x4 l_gcB;
    l_rA = l_kA = l_vA = l_wA = l_aA = l_rB = l_kB = l_vB = l_wB = l_aB = (u32x2){0u, 0u}; l_sA = l_sB = (f32x4){0.f, 0.f, 0.f, 0.f}; l_gcA = l_gcB = (u32x4){0u, 0u, 0u, 0u};
    if (helper) { RW_LOAD(0, A); RW_LOAD(1, B); }

#pragma unroll 1
    for (int i0_ = -1; i0_ < RW_NCH; i0_ += 2) {
        { const int i = i0_;

        const int bufn = (i + 1) & 1, bufc = i & 1;
        if (helper) {
            const bool do_prep = (i + 1 < RW_NCH);
            if (i >= 0) {
                LAS float* Gg = RW_ARR(bufc, 6);
                f32x4 cg_ = (f32x4){0.f, 0.f, 0.f, 0.f};
#pragma unroll
                for (int ks = 0; ks < 4; ++ks) {
                    const bf16x8 za = *(const LAS bf16x8*)&GDb[bufc * 2176 + ln * 136 + ks * 32 + 8 * lg], zb = *(const LAS bf16x8*)&WTg[(16 * nt + ln) * 136 + ks * 32 + 8 * lg];
                    cg_ = __builtin_amdgcn_mfma_f32_16x16x32_bf16(za, zb, cg_, 0, 0, 0);
                }
#pragma unroll
                for (int r = 0; r < 4; ++r) Gg[(4 * lg + r) * 64 + chm] = cg_[r];
            }
            if (i >= 1) {
                LAS float* Yy = RW_ARR(bufn, 7); LAS float* Gg = RW_ARR(bufn, 6); LAS float* Vv = RW_ARR(bufn, 5); LAS float* SC = RW_SC(bufn);
                const f32x4 y = *(const LAS f32x4*)&Yy[tt_h * 64 + cg4], gg = *(const LAS f32x4*)&Gg[tt_h * 64 + cg4], vv = *(const LAS f32x4*)&Vv[tt_h * 64 + cg4];
                const float bonus = BON[((i - 1) % 3) * 16 + tt_h];
                const float mean = red16((y.x + y.y) + (y.z + y.w)) * (1.f / 64.f);
                const f32x4 d = y - mean;
                const float var = red16((d.x * d.x + d.y * d.y) + (d.z * d.z + d.w * d.w)) * (1.f / 64.f);
                const float rs = 1.f / sqrtf(var + 64e-5f);
                const f32x4 o = (d * rs * p_gg + p_gb + vv * bonus) * gg;
                u32x2 w; w.x = pk2(o.x, o.y); w.y = pk2(o.z, o.w);
                *(u32x2*)(X.P + ((size_t)b * SEQ + (i - 1) * RW_TS + tt_h) * LDP + COL_YA + h * 64 + cg4) = w;
            }
            if (do_prep) {
                const f32x4 r = (f32x4){bflo(l_rA.x), bfhi(l_rA.x), bflo(l_rA.y), bfhi(l_rA.y)}, k = (f32x4){bflo(l_kA.x), bfhi(l_kA.x), bflo(l_kA.y), bfhi(l_kA.y)};
                const f32x4 v = (f32x4){bflo(l_vA.x), bfhi(l_vA.x), bflo(l_vA.y), bfhi(l_vA.y)}, w1 = (f32x4){bflo(l_wA.x), bfhi(l_wA.x), bflo(l_wA.y), bfhi(l_wA.y)};
                const f32x4 a = (f32x4){bflo(l_aA.x), bfhi(l_aA.x), bflo(l_aA.y), bfhi(l_aA.y)};
                const f32x4 kk = k * p_kk * l_sA.x;
                const f32x4 decay = 1.f - w1;
                *(LAS f32x4*)&RW_ARR(bufn, 0)[tt_h * 64 + cg4] = -kk;
                *(LAS f32x4*)&RW_ARR(bufn, 1)[tt_h * 64 + cg4] = decay * r;
                *(LAS f32x4*)&RW_ARR(bufn, 2)[tt_h * 64 + cg4] = decay;
                *(LAS f32x4*)&RW_ARR(bufn, 3)[tt_h * 64 + cg4] = kk * a;
                *(LAS f32x4*)&RW_ARR(bufn, 4)[tt_h * 64 + cg4] = k * (1.f + (a - 1.f) * p_ka);
                *(LAS f32x4*)&RW_ARR(bufn, 5)[tt_h * 64 + cg4] = v;
                if (cg4 == 0) { LAS float* SC = RW_SC(bufn); SC[tt_h * 4 + 0] = l_sA.y; SC[tt_h * 4 + 1] = l_sA.z; BON[((i + 1) % 3) * 16 + tt_h] = l_sA.w; }
                *(LAS u32x4*)&GDb[bufn * 2176 + tt_h * 136 + gv8] = l_gcA;
            }
            if (i + 3 < RW_NCH) RW_LOAD(i + 3, A);
            LDS_BAR();
        } else {
            LAS float* A_ = RW_ARR(bufc, 0); LAS float* WR = RW_ARR(bufc, 1); LAS float* Wd = RW_ARR(bufc, 2); LAS float* Bv = RW_ARR(bufc, 3);
            LAS float* Kk = RW_ARR(bufc, 4); LAS float* Vv = RW_ARR(bufc, 5); LAS float* Yy = RW_ARR(bufc, 7); LAS float* SC = RW_SC(bufc);
#pragma unroll 1
            for (int q4 = 0; q4 < 4; ++q4) {
                if (i >= 0) {
                    float yv[8];
#pragma unroll
                    for (int s4 = 0; s4 < 4; ++s4) {
                        const int tt = 4 * q4 + s4;
                        const f32x4 a_lo = *(const LAS f32x4*)&A_[tt * 64 + 8 * jg], a_hi = *(const LAS f32x4*)&A_[tt * 64 + 8 * jg + 4];
                        const f32x4 r_lo = *(const LAS f32x4*)&WR[tt * 64 + 8 * jg], r_hi = *(const LAS f32x4*)&WR[tt * 64 + 8 * jg + 4];
                        const f32x4 w_lo = *(const LAS f32x4*)&Wd[tt * 64 + 8 * jg], w_hi = *(const LAS f32x4*)&Wd[tt * 64 + 8 * jg + 4];
                        const f32x4 b_lo = *(const LAS f32x4*)&Bv[tt * 64 + 8 * jg], b_hi = *(const LAS f32x4*)&Bv[tt * 64 + 8 * jg + 4];
                        const f32x4 k_lo = *(const LAS f32x4*)&Kk[tt * 64 + 8 * jg], k_hi = *(const LAS f32x4*)&Kk[tt * 64 + 8 * jg + 4];
                        const f32x2 vv = *(const LAS f32x2*)&Vv[tt * 64 + i0];
                        const f32x2 sc = *(const LAS f32x2*)&SC[tt * 4];
                        const f32x2 av[4] = {{a_lo.x, a_lo.y}, {a_lo.z, a_lo.w}, {a_hi.x, a_hi.y}, {a_hi.z, a_hi.w}};
                        const f32x2 rv[4] = {{r_lo.x, r_lo.y}, {r_lo.z, r_lo.w}, {r_hi.x, r_hi.y}, {r_hi.z, r_hi.w}};
                        const f32x2 wv[4] = {{w_lo.x, w_lo.y}, {w_lo.z, w_lo.w}, {w_hi.x, w_hi.y}, {w_hi.z, w_hi.w}};
                        const f32x2 bv[4] = {{b_lo.x, b_lo.y}, {b_lo.z, b_lo.w}, {b_hi.x, b_hi.y}, {b_hi.z, b_hi.w}};
                        const f32x2 kv[4] = {{k_lo.x, k_lo.y}, {k_lo.z, k_lo.w}, {k_hi.x, k_hi.y}, {k_hi.z, k_hi.w}};
                        f32x2 e10 = S0[0] * av[0], e20 = S0[0] * rv[0], e11 = S1[0] * av[0], e21 = S1[0] * rv[0];
#pragma unroll
                        for (int j = 1; j < 4; ++j) { e10 += S0[j] * av[j]; e20 += S0[j] * rv[j]; e11 += S1[j] * av[j]; e21 += S1[j] * rv[j]; }
                        const float d10 = red8(e10.x + e10.y), d11 = red8(e11.x + e11.y);
                        yv[2 * s4] = (e20.x + e20.y) + (jg == 0 ? d10 * sc.x + vv.x * sc.y : 0.f); yv[2 * s4 + 1] = (e21.x + e21.y) + (jg == 0 ? d11 * sc.x + vv.y * sc.y : 0.f);
                        const f32x2 d10v = (f32x2){d10, d10}, d11v = (f32x2){d11, d11}, v0v = (f32x2){vv.x, vv.x}, v1v = (f32x2){vv.y, vv.y};
#pragma unroll
                        for (int j = 0; j < 4; ++j) { S0[j] = S0[j] * wv[j] + (d10v * bv[j] + v0v * kv[j]); S1[j] = S1[j] * wv[j] + (d11v * bv[j] + v1v * kv[j]); }
                    }
                    {
                        const bool t2 = (jg & 4) != 0, t1 = (jg & 2) != 0, t0 = (jg & 1) != 0;
#pragma unroll
                        for (int q = 0; q < 4; ++q) { const float keep = t2 ? yv[q + 4] : yv[q], send = t2 ? yv[q] : yv[q + 4]; yv[q] = keep + dpp_mov<0x141>(send); }
#pragma unroll
                        for (int q = 0; q < 2; ++q) { const float keep = t1 ? yv[q + 2] : yv[q], send = t1 ? yv[q] : yv[q + 2]; yv[q] = keep + dpp_mov<0x4E>(send); }
                        { const float keep = t0 ? yv[1] : yv[0], send = t0 ? yv[0] : yv[1]; yv[0] = keep + dpp_mov<0xB1>(send); }
                        Yy[(4 * q4 + (jg >> 1)) * 64 + i0 + (jg & 1)] = yv[0];
                    }

#if PROBE_SCAN2
                    {
#pragma unroll
                    for (int s4 = 0; s4 < 4; ++s4) {
                        const int tt = 4 * q4 + s4;
                        const f32x4 a_lo = *(const LAS f32x4*)&A_[tt * 64 + 8 * jg], a_hi = *(const LAS f32x4*)&A_[tt * 64 + 8 * jg + 4];
                        const f32x4 r_lo = *(const LAS f32x4*)&WR[tt * 64 + 8 * jg], r_hi = *(const LAS f32x4*)&WR[tt * 64 + 8 * jg + 4];
                        const f32x4 w_lo = *(const LAS f32x4*)&Wd[tt * 64 + 8 * jg], w_hi = *(const LAS f32x4*)&Wd[tt * 64 + 8 * jg + 4];
                        const f32x4 b_lo = *(const LAS f32x4*)&Bv[tt * 64 + 8 * jg], b_hi = *(const LAS f32x4*)&Bv[tt * 64 + 8 * jg + 4];
                        const f32x4 k_lo = *(const LAS f32x4*)&Kk[tt * 64 + 8 * jg], k_hi = *(const LAS f32x4*)&Kk[tt * 64 + 8 * jg + 4];
                        const f32x2 vv = *(const LAS f32x2*)&Vv[tt * 64 + i0];
                        const f32x2 av[4] = {{a_lo.x, a_lo.y}, {a_lo.z, a_lo.w}, {a_hi.x, a_hi.y}, {a_hi.z, a_hi.w}};
                        const f32x2 rv[4] = {{r_lo.x, r_lo.y}, {r_lo.z, r_lo.w}, {r_hi.x, r_hi.y}, {r_hi.z, r_hi.w}};
                        const f32x2 wv[4] = {{w_lo.x, w_lo.y}, {w_lo.z, w_lo.w}, {w_hi.x, w_hi.y}, {w_hi.z, w_hi.w}};
                        const f32x2 bv[4] = {{b_lo.x, b_lo.y}, {b_lo.z, b_lo.w}, {b_hi.x, b_hi.y}, {b_hi.z, b_hi.w}};
                        const f32x2 kv[4] = {{k_lo.x, k_lo.y}, {k_lo.z, k_lo.w}, {k_hi.x, k_hi.y}, {k_hi.z, k_hi.w}};
                        f32x2 e10 = T0[0] * av[0], e20 = T0[0] * rv[0], e11 = T1[0] * av[0], e21 = T1[0] * rv[0];
#pragma unroll
                        for (int j = 1; j < 4; ++j) { e10 += T0[j] * av[j]; e20 += T0[j] * rv[j]; e11 += T1[j] * av[j]; e21 += T1[j] * rv[j]; }
                        const float d10 = red8(e10.x + e10.y), d20 = red8(e20.x + e20.y), d11 = red8(e11.x + e11.y), d21 = red8(e21.x + e21.y);
                        const f32x2 d10v = (f32x2){d10 + d20, d10}, d11v = (f32x2){d11 + d21, d11}, v0v = (f32x2){vv.x, vv.x}, v1v = (f32x2){vv.y, vv.y};
#pragma unroll
                        for (int j = 0; j < 4; ++j) { T0[j] = T0[j] * wv[j] + (d10v * bv[j] + v0v * kv[j]); T1[j] = T1[j] * wv[j] + (d11v * bv[j] + v1v * kv[j]); }
                    }
                    }
#endif
                }
                if (q4 == 3) LDS_BAR();
            }
        }
            }
        if (i0_ + 1 < RW_NCH) { const int i = i0_ + 1;

        const int bufn = (i + 1) & 1, bufc = i & 1;
        if (helper) {
            const bool do_prep = (i + 1 < RW_NCH);
            if (i >= 0) {
                LAS float* Gg = RW_ARR(bufc, 6);
                f32x4 cg_ = (f32x4){0.f, 0.f, 0.f, 0.f};
#pragma unroll
                for (int ks = 0; ks < 4; ++ks) {
                    const bf16x8 za = *(const LAS bf16x8*)&GDb[bufc * 2176 + ln * 136 + ks * 32 + 8 * lg], zb = *(const LAS bf16x8*)&WTg[(16 * nt + ln) * 136 + ks * 32 + 8 * lg];
                    cg_ = __builtin_amdgcn_mfma_f32_16x16x32_bf16(za, zb, cg_, 0, 0, 0);
                }
#pragma unroll
                for (int r = 0; r < 4; ++r) Gg[(4 * lg + r) * 64 + chm] = cg_[r];
            }
            if (i >= 1) {
                LAS float* Yy = RW_ARR(bufn, 7); LAS float* Gg = RW_ARR(bufn, 6); LAS float* Vv = RW_ARR(bufn, 5); LAS float* SC = RW_SC(bufn);
                const f32x4 y = *(const LAS f32x4*)&Yy[tt_h * 64 + cg4], gg = *(const LAS f32x4*)&Gg[tt_h * 64 + cg4], vv = *(const LAS f32x4*)&Vv[tt_h * 64 + cg4];
                const float bonus = BON[((i - 1) % 3) * 16 + tt_h];
                const float mean = red16((y.x + y.y) + (y.z + y.w)) * (1.f / 64.f);
                const f32x4 d = y - mean;
                const float var = red16((d.x * d.x + d.y * d.y) + (d.z * d.z + d.w * d.w)) * (1.f / 64.f);
                const float rs = 1.f / sqrtf(var + 64e-5f);
                const f32x4 o = (d * rs * p_gg + p_gb + vv * bonus) * gg;
                u32x2 w; w.x = pk2(o.x, o.y); w.y = pk2(o.z, o.w);
                *(u32x2*)(X.P + ((size_t)b * SEQ + (i - 1) * RW_TS + tt_h) * LDP + COL_YA + h * 64 + cg4) = w;
            }
            if (do_prep) {
                const f32x4 r = (f32x4){bflo(l_rB.x), bfhi(l_rB.x), bflo(l_rB.y), bfhi(l_rB.y)}, k = (f32x4){bflo(l_kB.x), bfhi(l_kB.x), bflo(l_kB.y), bfhi(l_kB.y)};
                const f32x4 v = (f32x4){bflo(l_vB.x), bfhi(l_vB.x), bflo(l_vB.y), bfhi(l_vB.y)}, w1 = (f32x4){bflo(l_wB.x), bfhi(l_wB.x), bflo(l_wB.y), bfhi(l_wB.y)};
                const f32x4 a = (f32x4){bflo(l_aB.x), bfhi(l_aB.x), bflo(l_aB.y), bfhi(l_aB.y)};
                const f32x4 kk = k * p_kk * l_sB.x;
                const f32x4 decay = 1.f - w1;
                *(LAS f32x4*)&RW_ARR(bufn, 0)[tt_h * 64 + cg4] = -kk;
                *(LAS f32x4*)&RW_ARR(bufn, 1)[tt_h * 64 + cg4] = decay * r;
                *(LAS f32x4*)&RW_ARR(bufn, 2)[tt_h * 64 + cg4] = decay;
                *(LAS f32x4*)&RW_ARR(bufn, 3)[tt_h * 64 + cg4] = kk * a;
                *(LAS f32x4*)&RW_ARR(bufn, 4)[tt_h * 64 + cg4] = k * (1.f + (a - 1.f) * p_ka);
                *(LAS f32x4*)&RW_ARR(bufn, 5)[tt_h * 64 + cg4] = v;
                if (cg4 == 0) { LAS float* SC = RW_SC(bufn); SC[tt_h * 4 + 0] = l_sB.y; SC[tt_h * 4 + 1] = l_sB.z; BON[((i + 1) % 3) * 16 + tt_h] = l_sB.w; }
                *(LAS u32x4*)&GDb[bufn * 2176 + tt_h * 136 + gv8] = l_gcB;
            }
            if (i + 3 < RW_NCH) RW_LOAD(i + 3, B);
            LDS_BAR();
        } else {
            LAS float* A_ = RW_ARR(bufc, 0); LAS float* WR = RW_ARR(bufc, 1); LAS float* Wd = RW_ARR(bufc, 2); LAS float* Bv = RW_ARR(bufc, 3);
            LAS float* Kk = RW_ARR(bufc, 4); LAS float* Vv = RW_ARR(bufc, 5); LAS float* Yy = RW_ARR(bufc, 7); LAS float* SC = RW_SC(bufc);
#pragma unroll 1
            for (int q4 = 0; q4 < 4; ++q4) {
                if (i >= 0) {
                    float yv[8];
#pragma unroll
                    for (int s4 = 0; s4 < 4; ++s4) {
                        const int tt = 4 * q4 + s4;
                        const f32x4 a_lo = *(const LAS f32x4*)&A_[tt * 64 + 8 * jg], a_hi = *(const LAS f32x4*)&A_[tt * 64 + 8 * jg + 4];
                        const f32x4 r_lo = *(const LAS f32x4*)&WR[tt * 64 + 8 * jg], r_hi = *(const LAS f32x4*)&WR[tt * 64 + 8 * jg + 4];
                        const f32x4 w_lo = *(const LAS f32x4*)&Wd[tt * 64 + 8 * jg], w_hi = *(const LAS f32x4*)&Wd[tt * 64 + 8 * jg + 4];
                        const f32x4 b_lo = *(const LAS f32x4*)&Bv[tt * 64 + 8 * jg], b_hi = *(const LAS f32x4*)&Bv[tt * 64 + 8 * jg + 4];
                        const f32x4 k_lo = *(const LAS f32x4*)&Kk[tt * 64 + 8 * jg], k_hi = *(const LAS f32x4*)&Kk[tt * 64 + 8 * jg + 4];
                        const f32x2 vv = *(const LAS f32x2*)&Vv[tt * 64 + i0];
                        const f32x2 sc = *(const LAS f32x2*)&SC[tt * 4];
                        const f32x2 av[4] = {{a_lo.x, a_lo.y}, {a_lo.z, a_lo.w}, {a_hi.x, a_hi.y}, {a_hi.z, a_hi.w}};
                        const f32x2 rv[4] = {{r_lo.x, r_lo.y}, {r_lo.z, r_lo.w}, {r_hi.x, r_hi.y}, {r_hi.z, r_hi.w}};
                        const f32x2 wv[4] = {{w_lo.x, w_lo.y}, {w_lo.z, w_lo.w}, {w_hi.x, w_hi.y}, {w_hi.z, w_hi.w}};
                        const f32x2 bv[4] = {{b_lo.x, b_lo.y}, {b_lo.z, b_lo.w}, {b_hi.x, b_hi.y}, {b_hi.z, b_hi.w}};
                        const f32x2 kv[4] = {{k_lo.x, k_lo.y}, {k_lo.z, k_lo.w}, {k_hi.x, k_hi.y}, {k_hi.z, k_hi.w}};
                        f32x2 e10 = S0[0] * av[0], e20 = S0[0] * rv[0], e11 = S1[0] * av[0], e21 = S1[0] * rv[0];
#pragma unroll
                        for (int j = 1; j < 4; ++j) { e10 += S0[j] * av[j]; e20 += S0[j] * rv[j]; e11 += S1[j] * av[j]; e21 += S1[j] * rv[j]; }
                        const float d10 = red8(e10.x + e10.y), d11 = red8(e11.x + e11.y);
                        yv[2 * s4] = (e20.x + e20.y) + (jg == 0 ? d10 * sc.x + vv.x * sc.y : 0.f); yv[2 * s4 + 1] = (e21.x + e21.y) + (jg == 0 ? d11 * sc.x + vv.y * sc.y : 0.f);
                        const f32x2 d10v = (f32x2){d10, d10}, d11v = (f32x2){d11, d11}, v0v = (f32x2){vv.x, vv.x}, v1v = (f32x2){vv.y, vv.y};
#pragma unroll
                        for (int j = 0; j < 4; ++j) { S0[j] = S0[j] * wv[j] + (d10v * bv[j] + v0v * kv[j]); S1[j] = S1[j] * wv[j] + (d11v * bv[j] + v1v * kv[j]); }
                    }
                    {
                        const bool t2 = (jg & 4) != 0, t1 = (jg & 2) != 0, t0 = (jg & 1) != 0;
#pragma unroll
                        for (int q = 0; q < 4; ++q) { const float keep = t2 ? yv[q + 4] : yv[q], send = t2 ? yv[q] : yv[q + 4]; yv[q] = keep + dpp_mov<0x141>(send); }
#pragma unroll
                        for (int q = 0; q < 2; ++q) { const float keep = t1 ? yv[q + 2] : yv[q], send = t1 ? yv[q] : yv[q + 2]; yv[q] = keep + dpp_mov<0x4E>(send); }
                        { const float keep = t0 ? yv[1] : yv[0], send = t0 ? yv[0] : yv[1]; yv[0] = keep + dpp_mov<0xB1>(send); }
                        Yy[(4 * q4 + (jg >> 1)) * 64 + i0 + (jg & 1)] = yv[0];
                    }

#if PROBE_SCAN2
                    {
#pragma unroll
                    for (int s4 = 0; s4 < 4; ++s4) {
                        const int tt = 4 * q4 + s4;
                        const f32x4 a_lo = *(const LAS f32x4*)&A_[tt * 64 + 8 * jg], a_hi = *(const LAS f32x4*)&A_[tt * 64 + 8 * jg + 4];
                        const f32x4 r_lo = *(const LAS f32x4*)&WR[tt * 64 + 8 * jg], r_hi = *(const LAS f32x4*)&WR[tt * 64 + 8 * jg + 4];
                        const f32x4 w_lo = *(const LAS f32x4*)&Wd[tt * 64 + 8 * jg], w_hi = *(const LAS f32x4*)&Wd[tt * 64 + 8 * jg + 4];
                        const f32x4 b_lo = *(const LAS f32x4*)&Bv[tt * 64 + 8 * jg], b_hi = *(const LAS f32x4*)&Bv[tt * 64 + 8 * jg + 4];
                        const f32x4 k_lo = *(const LAS f32x4*)&Kk[tt * 64 + 8 * jg], k_hi = *(const LAS f32x4*)&Kk[tt * 64 + 8 * jg + 4];
                        const f32x2 vv = *(const LAS f32x2*)&Vv[tt * 64 + i0];
                        const f32x2 av[4] = {{a_lo.x, a_lo.y}, {a_lo.z, a_lo.w}, {a_hi.x, a_hi.y}, {a_hi.z, a_hi.w}};
                        const f32x2 rv[4] = {{r_lo.x, r_lo.y}, {r_lo.z, r_lo.w}, {r_hi.x, r_hi.y}, {r_hi.z, r_hi.w}};
                        const f32x2 wv[4] = {{w_lo.x, w_lo.y}, {w_lo.z, w_lo.w}, {w_hi.x, w_hi.y}, {w_hi.z, w_hi.w}};
                        const f32x2 bv[4] = {{b_lo.x, b_lo.y}, {b_lo.z, b_lo.w}, {b_hi.x, b_hi.y}, {b_hi.z, b_hi.w}};
                        const f32x2 kv[4] = {{k_lo.x, k_lo.y}, {k_lo.z, k_lo.w}, {k_hi.x, k_hi.y}, {k_hi.z, k_hi.w}};
                        f32x2 e10 = T0[0] * av[0], e20 = T0[0] * rv[0], e11 = T1[0] * av[0], e21 = T1[0] * rv[0];
#pragma unroll
                        for (int j = 1; j < 4; ++j) { e10 += T0[j] * av[j]; e20 += T0[j] * rv[j]; e11 += T1[j] * av[j]; e21 += T1[j] * rv[j]; }
                        const float d10 = red8(e10.x + e10.y), d20 = red8(e20.x + e20.y), d11 = red8(e11.x + e11.y), d21 = red8(e21.x + e21.y);
                        const f32x2 d10v = (f32x2){d10 + d20, d10}, d11v = (f32x2){d11 + d21, d11}, v0v = (f32x2){vv.x, vv.x}, v1v = (f32x2){vv.y, vv.y};
#pragma unroll
                        for (int j = 0; j < 4; ++j) { T0[j] = T0[j] * wv[j] + (d10v * bv[j] + v0v * kv[j]); T1[j] = T1[j] * wv[j] + (d11v * bv[j] + v1v * kv[j]); }
                    }
                    }
#endif
                }
                if (q4 == 3) LDS_BAR();
            }
        }
            }
    }
    if (helper) {
        const int bufl = (RW_NCH - 1) & 1;
        LAS float* Yy = RW_ARR(bufl, 7); LAS float* Gg = RW_ARR(bufl, 6); LAS float* Vv = RW_ARR(bufl, 5); LAS float* SC = RW_SC(bufl);
        const f32x4 y = *(const LAS f32x4*)&Yy[tt_h * 64 + cg4], gg = *(const LAS f32x4*)&Gg[tt_h * 64 + cg4], vv = *(const LAS f32x4*)&Vv[tt_h * 64 + cg4];
        const float bonus = BON[((RW_NCH - 1) % 3) * 16 + tt_h];
        const float mean = red16((y.x + y.y) + (y.z + y.w)) * (1.f / 64.f);
        const f32x4 d = y - mean;
        const float var = red16((d.x * d.x + d.y * d.y) + (d.z * d.z + d.w * d.w)) * (1.f / 64.f);
        const float rs = 1.f / sqrtf(var + 64e-5f);
        const f32x4 o = (d * rs * p_gg + p_gb + vv * bonus) * gg;
        u32x2 w; w.x = pk2(o.x, o.y); w.y = pk2(o.z, o.w);
        *(u32x2*)(X.P + ((size_t)b * SEQ + (RW_NCH - 1) * RW_TS + tt_h) * LDP + COL_YA + h * 64 + cg4) = w;
    }
    __syncthreads();
#undef RW_ARR
#undef RW_SC
#undef RW_LOAD
}

__device__ __forceinline__ void hgrn_task(const Ctx& X, LAS unsigned char* lds, int layer, int b, int h, int vh) {
    LAS float* F = (LAS float*)(lds); LAS float* Q = (LAS float*)(lds + 16384); LAS float* Vv = (LAS float*)(lds + 32768); LAS float* O = (LAS float*)(lds + 40960);
    LAS float* LB = (LAS float*)(lds + 49152);
    const int tid = X.tid;
    const float* lbl = X.in[14];
    const int rp = tid >> 4, dg = tid & 15, v0 = 2 * rp;
    if (tid < 128) LB[tid] = (layer > 0) ? 1.f / (1.f + __expf(lbl[h * 128 + tid] - lbl[512 + h * 128 + tid])) : 0.f;
    f32x2 S0[4], S1[4];
#pragma unroll
    for (int j = 0; j < 4; ++j) { S0[j] = (f32x2){0.f, 0.f}; S1[j] = (f32x2){0.f, 0.f}; }
#define HG_LOAD(chk) do { _Pragma("unroll") for (int it = 0; it < 3; ++it) { const int idx = tid + 512 * it; raw[it] = (u32x4){0u, 0u, 0u, 0u}; \
        if (idx < 32 * 40) { const int tt = idx / 40, vv = idx - tt * 40; \
            const int col = vv < 16 ? 512 + h * 128 + 8 * vv : (vv < 32 ? h * 128 + 8 * (vv - 16) : 1024 + h * 128 + vh * 64 + 8 * (vv - 32)); \
            raw[it] = *(const u32x4*)(X.P + ((size_t)b * SEQ + (chk) * 32 + tt) * LDP + COL_PB + col); } } } while (0)
    u32x4 raw[3];
    HG_LOAD(0);
    __syncthreads();
#pragma unroll 1
    for (int ch = 0; ch < SEQ / 32; ++ch) {
        const int t0 = ch * 32;
#pragma unroll
        for (int it = 0; it < 3; ++it) {
            const int idx = tid + 512 * it;
            if (idx < 32 * 40) {
                const int tt = idx / 40, vv = idx - tt * 40;
                float x[8];
                x[0] = bflo(raw[it].x); x[1] = bfhi(raw[it].x); x[2] = bflo(raw[it].y); x[3] = bfhi(raw[it].y);
                x[4] = bflo(raw[it].z); x[5] = bfhi(raw[it].z); x[6] = bflo(raw[it].w); x[7] = bfhi(raw[it].w);
                LAS float* dst;
                if (vv < 16) {
                    dst = F + tt * 128 + 8 * vv;
#pragma unroll
                    for (int e = 0; e < 8; ++e) { const float lb = LB[8 * vv + e]; x[e] = lb + (1.f - lb) * sigmoidf_(x[e]); }
                } else if (vv < 32) dst = Q + tt * 128 + 8 * (vv - 16);
                else dst = Vv + tt * 64 + 8 * (vv - 32);
                *(LAS f32x4*)dst = (f32x4){x[0], x[1], x[2], x[3]}; *(LAS f32x4*)(dst + 4) = (f32x4){x[4], x[5], x[6], x[7]};
            }
        }
        if (ch + 1 < SEQ / 32) HG_LOAD(ch + 1);
        LDS_BAR();
#pragma unroll 1
        for (int g8 = 0; g8 < 4; ++g8) {
            float val[16];
#pragma unroll
            for (int s8 = 0; s8 < 8; ++s8) {
                const int tt = 8 * g8 + s8;
                const f32x4 f_lo = *(const LAS f32x4*)&F[tt * 128 + 8 * dg], f_hi = *(const LAS f32x4*)&F[tt * 128 + 8 * dg + 4];
                const f32x4 q_lo = *(const LAS f32x4*)&Q[tt * 128 + 8 * dg], q_hi = *(const LAS f32x4*)&Q[tt * 128 + 8 * dg + 4];
                const f32x2 vv = *(const LAS f32x2*)&Vv[tt * 64 + v0];
                const f32x2 f2[4] = {{f_lo.x, f_lo.y}, {f_lo.z, f_lo.w}, {f_hi.x, f_hi.y}, {f_hi.z, f_hi.w}};
                const f32x2 q2[4] = {{q_lo.x, q_lo.y}, {q_lo.z, q_lo.w}, {q_hi.x, q_hi.y}, {q_hi.z, q_hi.w}};
                const f32x2 v0v = (f32x2){vv.x, vv.x}, v1v = (f32x2){vv.y, vv.y};
                f32x2 a0 = (f32x2){0.f, 0.f}, a1 = (f32x2){0.f, 0.f};
#pragma unroll
                for (int j = 0; j < 4; ++j) {
                    S0[j] = v0v + f2[j] * (S0[j] - v0v); S1[j] = v1v + f2[j] * (S1[j] - v1v);
                    a0 += q2[j] * S0[j]; a1 += q2[j] * S1[j];
                }
                val[2 * s8] = a0.x + a0.y; val[2 * s8 + 1] = a1.x + a1.y;
            }
            const bool b3 = (dg & 8) != 0, b2 = (dg & 4) != 0, b1 = (dg & 2) != 0, b0 = (dg & 1) != 0;
#pragma unroll
            for (int i = 0; i < 8; ++i) { const float keep = b3 ? val[i + 8] : val[i], send = b3 ? val[i] : val[i + 8]; val[i] = keep + dpp_mov<0x140>(send); }
#pragma unroll
            for (int i = 0; i < 4; ++i) { const float keep = b2 ? val[i + 4] : val[i], send = b2 ? val[i] : val[i + 4]; val[i] = keep + dpp_mov<0x141>(send); }
#pragma unroll
            for (int i = 0; i < 2; ++i) { const float keep = b1 ? val[i + 2] : val[i], send = b1 ? val[i] : val[i + 2]; val[i] = keep + dpp_mov<0x4E>(send); }
            { const float keep = b0 ? val[1] : val[0], send = b0 ? val[0] : val[1]; val[0] = keep + dpp_mov<0xB1>(send); }
            O[(8 * g8 + (dg >> 1)) * 64 + v0 + (dg & 1)] = val[0];
        }
        LDS_BAR();
        if (tid < 256) {
            const int tt = tid >> 3, v8 = (tid & 7) * 8;
            const f32x4 a = *(const LAS f32x4*)&O[tt * 64 + v8], c4 = *(const LAS f32x4*)&O[tt * 64 + v8 + 4];
            u32x4 o; o.x = pk2(a.x, a.y); o.y = pk2(a.z, a.w); o.z = pk2(c4.x, c4.y); o.w = pk2(c4.z, c4.w);
            *(u32x4*)(X.P + ((size_t)b * SEQ + t0 + tt) * LDP + COL_YB + h * 128 + vh * 64 + v8) = o;
        }
    }
#undef HG_LOAD
    __syncthreads();
}

__device__ __forceinline__ unsigned f2ord(float f) { const unsigned u = __builtin_bit_cast(unsigned, f); return (u & 0x80000000u) ? ~u : (u | 0x80000000u); }

__device__ __forceinline__ void dsa_tile(const Ctx& X, LAS unsigned char* lds, int b, int q0) {
    LAS float* sc = (LAS float*)lds;
    LAS unsigned* MASK = (LAS unsigned*)(lds + MASK_OFF);
    const int lane = X.lane, w = X.wave, n = lane & 15, g = lane >> 4;
    const bf16_t* Pb = X.P + (size_t)b * SEQ * LDP;
#pragma unroll 1
    for (int sub = 0; sub < 4; ++sub) {
        const int qs = q0 + 16 * sub;
        {
            bf16x8 bq[4][2]; float wi[4];
            const bf16_t* qrow = Pb + (size_t)(qs + n) * LDP;
#pragma unroll
            for (int hh = 0; hh < 4; ++hh) {
#pragma unroll
                for (int ks = 0; ks < 2; ++ks) bq[hh][ks] = *(const bf16x8*)(qrow + C_QI + hh * 64 + ks * 32 + 8 * g);
                wi[hh] = bf2f(qrow[C_WI + hh]);
            }
            const int nkt = (qs + 16) >> 4;
            bf16x8 a0n = (bf16x8){0, 0, 0, 0, 0, 0, 0, 0}, a1n = a0n;
            if (w < nkt) { const bf16_t* krow = Pb + (size_t)(w * 16 + n) * LDP + C_KI; a0n = *(const bf16x8*)(krow + 8 * g); a1n = *(const bf16x8*)(krow + 32 + 8 * g); }
#pragma unroll 1
            for (int kt = w; kt < nkt; kt += 8) {
                const bf16x8 a0 = a0n, a1 = a1n;
                if (kt + 8 < nkt) { const bf16_t* krow = Pb + (size_t)((kt + 8) * 16 + n) * LDP + C_KI; a0n = *(const bf16x8*)(krow + 8 * g); a1n = *(const bf16x8*)(krow + 32 + 8 * g); }
                f32x4 s = (f32x4){0.f, 0.f, 0.f, 0.f};
#pragma unroll
                for (int hh = 0; hh < 4; ++hh) {
                    f32x4 d = __builtin_amdgcn_mfma_f32_16x16x32_bf16(a0, bq[hh][0], (f32x4){0.f, 0.f, 0.f, 0.f}, 0, 0, 0);
                    d = __builtin_amdgcn_mfma_f32_16x16x32_bf16(a1, bq[hh][1], d, 0, 0, 0);
#pragma unroll
                    for (int r = 0; r < 4; ++r) s[r] += wi[hh] * fmaxf(d[r], 0.f);
                }
                const int t = qs + n;
#pragma unroll
                for (int r = 0; r < 4; ++r) if (kt * 16 + 4 * g + r > t) s[r] = -INFINITY;
                *(LAS f32x4*)&sc[n * SCS + kt * 16 + 4 * g] = s;
            }
        }
        __syncthreads();
#pragma unroll 1
        for (int e = 0; e < 2; ++e) {
            const int qn = 2 * w + e, t = qs + qn;
            LAS unsigned* mrow = MASK + (sub * 16 + qn) * 64;
            if (t < 256) {
#pragma unroll
                for (int j = 0; j < 32; ++j) {
                    const unsigned long long sm = __ballot(j * 64 + lane <= t);
                    if (lane == 0) { mrow[2 * j] = (unsigned)sm; mrow[2 * j + 1] = (unsigned)(sm >> 32); }
                }
            } else {
                const int jn = (t >> 6) + 1;
                unsigned u[32];
#pragma unroll
                for (int j = 0; j < 32; ++j) {
                    u[j] = 0u;
                    if (j < jn) { const int key = j * 64 + lane; const float s = (key <= t) ? sc[qn * SCS + key] : -INFINITY; u[j] = f2ord(s); }
                }
                unsigned prefix = 0u;
#define DSA_BITSEARCH(JN) do { _Pragma("unroll 1") for (int bit = 31; bit >= 0; --bit) { const unsigned cand = prefix | (1u << bit); int c0 = 0, c1 = 0; \
                    _Pragma("unroll") for (int j = 0; j < (JN); j += 2) { c0 += (u[j] >= cand) ? 1 : 0; c1 += (u[j + 1] >= cand) ? 1 : 0; } \
                    const int cnt = (int)wave_sum_fast((float)(c0 + c1)); if (cnt >= 256) prefix = cand; } } while (0)
                if (jn <= 8) DSA_BITSEARCH(8); else if (jn <= 16) DSA_BITSEARCH(16); else if (jn <= 24) DSA_BITSEARCH(24); else DSA_BITSEARCH(32);
#undef DSA_BITSEARCH
                int cg_ = 0;
#pragma unroll
                for (int j = 0; j < 32; ++j) if (j < jn) cg_ += __popcll(__ballot(u[j] > prefix));
                const int need = 256 - cg_;
                int cum = 0;
#pragma unroll
                for (int j = 0; j < 32; ++j) {
                    unsigned long long sm = 0ull;
                    if (j < jn) {
                        const bool eq = (u[j] == prefix);
                        const unsigned long long em = __ballot(eq);
                        const int rank = cum + (int)__builtin_amdgcn_mbcnt_hi((unsigned)(em >> 32), __builtin_amdgcn_mbcnt_lo((unsigned)em, 0u));
                        const bool sel = (u[j] > prefix) || (eq && rank < need);
                        sm = __ballot(sel);
                        cum += __popcll(em);
                    }
                    if (lane == 0) { mrow[2 * j] = (unsigned)sm; mrow[2 * j + 1] = (unsigned)(sm >> 32); }
                }
            }
        }
        __syncthreads();
    }
    const int qq = q0 + 8 * w + (n & 7);
    const LAS unsigned* mq = MASK + (8 * w + (n & 7)) * 64;
    const int nsteps = (q0 + 8 * w + 8 + 31) >> 5;
    const int nblk = (q0 + 64 + 127) >> 7;
    LAS bf16_t* KT = (LAS bf16_t*)lds;
    LAS bf16_t* VTT = (LAS bf16_t*)(lds + 36864);
    const int tid = X.tid;
#pragma unroll 1
    for (int c = 0; c < 2; ++c) {
        bf16x8 bq[2][2];
#pragma unroll
        for (int j = 0; j < 2; ++j)
#pragma unroll
            for (int ks = 0; ks < 2; ++ks) bq[j][ks] = *(const bf16x8*)(Pb + (size_t)qq * LDP + C_Q + (c * 4 + 2 * j + (n >> 3)) * 64 + ks * 32 + 8 * g);
        float lrun[2] = {0.f, 0.f};
        f32x4 oacc[4][2];
#pragma unroll
        for (int mt = 0; mt < 4; ++mt)
#pragma unroll
            for (int j = 0; j < 2; ++j) oacc[mt][j] = (f32x4){0.f, 0.f, 0.f, 0.f};
        const bf16_t* vtb = X.VT + ((size_t)(b * 2 + c) * 64) * SEQ;
        u32x4 gk[2], gv[2];
#define DSA_GLOAD(kblk) do { _Pragma("unroll") for (int it = 0; it < 2; ++it) { const int idx = tid + 512 * it; \
            gk[it] = *(const u32x4*)(Pb + (size_t)((kblk) * 128 + (idx >> 3)) * LDP + C_K + c * 64 + (idx & 7) * 8); \
            gv[it] = *(const u32x4*)(vtb + (size_t)(idx >> 4) * SEQ + (kblk) * 128 + (idx & 15) * 8); } } while (0)
#define DSA_LSTORE(bufi) do { _Pragma("unroll") for (int it = 0; it < 2; ++it) { const int idx = tid + 512 * it; \
            *(LAS u32x4*)(KT + (bufi) * 9216 + (idx >> 3) * 72 + (idx & 7) * 8) = gk[it]; \
            *(LAS u32x4*)(VTT + (bufi) * 8704 + (idx >> 4) * 136 + (idx & 15) * 8) = gv[it]; } } while (0)
        DSA_GLOAD(0);
        LDS_BAR();
        DSA_LSTORE(0);
        LDS_BAR();
#pragma unroll 1
        for (int kb = 0; kb < nblk; ++kb) {
            const int buf = kb & 1;
            if (kb + 1 < nblk) DSA_GLOAD(kb + 1);
            const LAS bf16_t* Kb = KT + buf * 9216; const LAS bf16_t* Vb = VTT + buf * 8704;
#pragma unroll 1
            for (int sl = 0; sl < 4; ++sl) {
                const int sg = kb * 4 + sl;
                if (sg < nsteps) {
                    f32x4 st[2][2];
#pragma unroll
                    for (int tl = 0; tl < 2; ++tl) {
                        const LAS bf16_t* kr = Kb + (32 * sl + 16 * tl + n) * 72;
                        const bf16x8 a0 = *(const LAS bf16x8*)(kr + 8 * g), a1 = *(const LAS bf16x8*)(kr + 32 + 8 * g);
#pragma unroll
                        for (int j = 0; j < 2; ++j) {
                            f32x4 d = __builtin_amdgcn_mfma_f32_16x16x32_bf16(a0, bq[j][0], (f32x4){0.f, 0.f, 0.f, 0.f}, 0, 0, 0);
                            st[tl][j] = __builtin_amdgcn_mfma_f32_16x16x32_bf16(a1, bq[j][1], d, 0, 0, 0);
                        }
                    }
                    bf16x8 av[4];
#pragma unroll
                    for (int mt = 0; mt < 4; ++mt) {
                        const LAS bf16_t* vp = Vb + (mt * 16 + n) * 136 + 32 * sl + 4 * g;
                        const u32x2 lo = *(const LAS u32x2*)vp, hi = *(const LAS u32x2*)(vp + 16);
                        u32x4 t4; t4.x = lo.x; t4.y = lo.y; t4.z = hi.x; t4.w = hi.y;
                        av[mt] = __builtin_bit_cast(bf16x8, t4);
                    }
                    const unsigned mw = mq[sg];
#pragma unroll
                    for (int j = 0; j < 2; ++j) {
                        float p[8], ps = 0.f;
#pragma unroll
                        for (int tl = 0; tl < 2; ++tl)
#pragma unroll
                            for (int r = 0; r < 4; ++r) { const int bit = 16 * tl + 4 * g + r; const float e = __expf(fminf(st[tl][j][r] * 0.125f, 60.f)); p[4 * tl + r] = ((mw >> bit) & 1u) ? e : 0.f; ps += p[4 * tl + r]; }
                        lrun[j] += ps;
                        u32x4 pw; pw.x = pg8::cvt_pk_bf16(p[0], p[1]); pw.y = pg8::cvt_pk_bf16(p[2], p[3]); pw.z = pg8::cvt_pk_bf16(p[4], p[5]); pw.w = pg8::cvt_pk_bf16(p[6], p[7]);
                        const bf16x8 pb = __builtin_bit_cast(bf16x8, pw);
#pragma unroll
                        for (int mt = 0; mt < 4; ++mt) oacc[mt][j] = __builtin_amdgcn_mfma_f32_16x16x32_bf16(av[mt], pb, oacc[mt][j], 0, 0, 0);
                    }
                }
            }
            if (kb + 1 < nblk) DSA_LSTORE(buf ^ 1);
            LDS_BAR();
        }
#pragma unroll
        for (int j = 0; j < 2; ++j) {
            float lt = lrun[j]; lt += __shfl_xor(lt, 16); lt += __shfl_xor(lt, 32);
            const float il = 1.f / lt;
            bf16_t* op = X.P + ((size_t)b * SEQ + qq) * LDP + COL_YC + (c * 4 + 2 * j + (n >> 3)) * 64 + 4 * g;
#pragma unroll
            for (int mt = 0; mt < 4; ++mt) {
                const f32x4 o = oacc[mt][j] * il;
                u32x2 wv; wv.x = pg8::cvt_pk_bf16(o[0], o[1]); wv.y = pg8::cvt_pk_bf16(o[2], o[3]);
                *(u32x2*)(op + mt * 16) = wv;
            }
        }
    }
#undef DSA_GLOAD
#undef DSA_LSTORE
    __syncthreads();
}

__device__ __forceinline__ void phase_mixers(const Ctx& X0, LAS unsigned char* lds, int layer, bool early_gate) {
#pragma unroll 1
    for (int task = X0.bid; task < 128; task += X0.G) {
        Ctx X = X0;
        { int t_ = threadIdx.x; asm volatile("" : "+v"(t_)); X.tid = t_; X.lane = t_ & 63; }
        if (task < 64) { if (TKMASK & 1) rwkv_task(X, lds, layer, task >> 3, task & 7); }
        else { const int k = task - 64; if (TKMASK & 2) hgrn_task(X, lds, layer, k >> 3, (k >> 1) & 3, k & 1); }
    }
    volatile LAS unsigned* tw = (volatile LAS unsigned*)(lds + LDS_BYTES - 128);
    unsigned* ctr = (unsigned*)(X0.ws + WS_BAR + 14336) + 16 * layer;
#pragma unroll 1
    for (;;) {
        Ctx X = X0;
        { int t_ = threadIdx.x; asm volatile("" : "+v"(t_)); X.tid = t_; X.lane = t_ & 63; }
        __syncthreads();
        if (threadIdx.x == 0) tw[0] = __hip_atomic_fetch_add(ctr, 1u, __ATOMIC_RELAXED, __HIP_MEMORY_SCOPE_AGENT);
        __syncthreads();
        const int t = (int)tw[0];
        if (t >= 256) break;
        if (TKMASK & 4) dsa_tile(X, lds, t & 7, 64 * (31 - (t >> 3)));
    }
    if (early_gate && X0.bid >= 128 && X0.G == 256) {
        __syncthreads();
        int t_ = threadIdx.x; asm volatile("" : "+v"(t_));
        pg8::Gemm g{X0.P, X0.Wg, LDP, DM, DM}; pg8::StaticOrder S; S.init(T_TOK, DM, 128, X0.bid - 128);
        pg8::EpiGate E{X0.P, (bf16_t*)X0.out + 1024, 2048}; pg8::gemm_phase<pg8::EpiGate, true>(lds, g, S, E, t_);
    }
}

__device__ __forceinline__ void phase_hgrn_post(const Ctx& X, int layer) {
    const int gw = X.bid * 8 + X.wave, NGW = X.G * 8;
    const float* gn = X.in[15] + layer * 512;
#pragma unroll 1
    for (int it0 = gw; it0 < T_TOK * 4; it0 += 4 * NGW) {
        unsigned ow[4], gwd[4]; unsigned* op[4];
#pragma unroll
        for (int r = 0; r < 4; ++r) {
            const int it = it0 + r * NGW < T_TOK * 4 ? it0 + r * NGW : it0;
            const int t = it >> 2, h = it & 3;
            bf16_t* rowp = X.P + (size_t)t * LDP;
            op[r] = (unsigned*)(rowp + COL_YB + h * 128) + X.lane;
            ow[r] = *op[r]; gwd[r] = *((const unsigned*)(rowp + COL_PB + 1536 + h * 128) + X.lane);
        }
#pragma unroll
        for (int r = 0; r < 4; ++r) {
            const int it = it0 + r * NGW;
            const int h = it & 3;
            const float o0 = bflo(ow[r]), o1 = bfhi(ow[r]), g0 = bflo(gwd[r]), g1 = bfhi(gwd[r]);
            const float rs = 1.f / sqrtf(wave_sum(o0 * o0 + o1 * o1) * (1.f / 128.f) + 1e-6f);
            const float y0 = o0 * rs * gn[h * 128 + 2 * X.lane] * (g0 * sigmoidf_(g0)), y1 = o1 * rs * gn[h * 128 + 2 * X.lane + 1] * (g1 * sigmoidf_(g1));
            if (it < T_TOK * 4) *op[r] = pk2(y0, y1);
        }
    }
}

__device__ __forceinline__ void phase_fixup(const Ctx& X, int layer) {
    const float* cw = X.in[20] + (size_t)layer * 3 * F2; const float* cb = X.in[21] + (size_t)layer * F2;
    for (int idx = X.bid * 512 + X.tid; idx < 256 * 2 * DFF; idx += X.G * 512) {
        const int j = idx % DFF, sr = idx / DFF, s = sr >> 1, r = sr & 1;
        const int colg = (j >> 7) * 256 + (j & 127), colv = colg + 128;
        const bool seq0 = (s & 31) == 0;
        const float* H = X.HALO;
        float res[2];
#pragma unroll
        for (int part = 0; part < 2; ++part) {
            const int cp = part ? colv : colg, co = part * DFF + j;
            const float u0 = H[(size_t)(s * 4 + r) * F2 + cp];
            float u1, u2;
            if (r == 0) { u1 = seq0 ? 0.f : H[(size_t)((s - 1) * 4 + 3) * F2 + cp]; u2 = seq0 ? 0.f : H[(size_t)((s - 1) * 4 + 2) * F2 + cp]; }
            else { u1 = H[(size_t)(s * 4 + 0) * F2 + cp]; u2 = seq0 ? 0.f : H[(size_t)((s - 1) * 4 + 3) * F2 + cp]; }
            res[part] = cb[co] + cw[co] * u2 + cw[F2 + co] * u1 + cw[2 * F2 + co] * u0;
        }
        const float a = res[0] * sigmoidf_(res[0]) * res[1];
        X.P[(size_t)(s * 64 + r) * LDP + COL_ACT + j] = (bf16_t)f2bf(a);
    }
}

#define XB_TMO      128
#define XB_XCNT(j)  (256  + 64 * (j))
#define XB_XSUB(j)  (1280 + 64 * (j))
#define XB_XGEN(j)  (2304 + 64 * (j))
#define XB_TOP      3328
#define XB_TOPGEN   3392
#define XCD_BAR_WORDS 3456
#define XB_SPIN_CAP (1u << 22)
__device__ __forceinline__ unsigned xb_ld(unsigned* p)              { return __hip_atomic_load(p, __ATOMIC_RELAXED, __HIP_MEMORY_SCOPE_AGENT); }
__device__ __forceinline__ unsigned xb_add(unsigned* p, unsigned v) { return __hip_atomic_fetch_add(p, v, __ATOMIC_RELAXED, __HIP_MEMORY_SCOPE_AGENT); }
__device__ __forceinline__ unsigned xb_xcc_id() { return (unsigned)__builtin_amdgcn_s_getreg((3 << 11) | 20) & 0xFu; }
#define XB_SPIN(cond, bar) do { unsigned _sp = 0; while (cond) { __builtin_amdgcn_s_sleep(1); \
    if ((++_sp & 255u) == 0u) { if (xb_ld(&(bar)[XB_TMO])) break; if (_sp > XB_SPIN_CAP) { atomicAdd(&(bar)[XB_TMO], 1u); break; } } } } while (0)
struct XcdBarrier { unsigned* bar; unsigned x; volatile LAS unsigned* st; };
__device__ __forceinline__ XcdBarrier xcd_barrier_post(unsigned* bar, volatile LAS unsigned* st) {
    XcdBarrier b; b.bar = bar; b.x = xb_xcc_id(); b.st = st;
    if (threadIdx.x == 0) (void)xb_add(&bar[XB_XCNT(b.x)], 1u);
    return b;
}
__device__ __forceinline__ void xcd_barrier_complete(unsigned* bar, unsigned x, unsigned& nloc, unsigned& nx) {
    const unsigned G = gridDim.x * gridDim.y * gridDim.z;
    unsigned sum, cnt, mine, sp = 0u;
    for (;;) {
        sum = 0u; cnt = 0u; mine = 0u;
#pragma unroll
        for (unsigned j = 0; j < 16; ++j) { const unsigned c = xb_ld(&bar[XB_XCNT(j)]); sum += c; cnt += (c > 0u) ? 1u : 0u; mine = (j == x) ? c : mine; }
        if (sum == G) break;
        __builtin_amdgcn_s_sleep(1);
        if ((++sp & 255u) == 0u) { if (xb_ld(&bar[XB_TMO])) break; if (sp > XB_SPIN_CAP) { atomicAdd(&bar[XB_TMO], 1u); break; } }
    }
    nloc = mine > 0u ? mine : 1u; nx = cnt > 0u ? cnt : 1u;
}
__device__ __forceinline__ void xcd_barrier(const XcdBarrier& b) {
    asm volatile("s_waitcnt vmcnt(0)" ::: "memory");
    __syncthreads();
    if (threadIdx.x == 0) {
        unsigned* bar = b.bar;
        __builtin_amdgcn_s_waitcnt(0);
        unsigned nloc = b.st[0], nx = b.st[1];
        if (nloc == 0u) { xcd_barrier_complete(bar, b.x, nloc, nx); b.st[0] = nloc; b.st[1] = nx; }
        const unsigned old = xb_add(&bar[XB_XSUB(b.x)], 1u);
        const unsigned gen = old / nloc;
        if (old + 1u == (gen + 1u) * nloc) {
            __builtin_amdgcn_fence(__ATOMIC_RELEASE, "agent");
            asm volatile("s_waitcnt vmcnt(0)" ::: "memory");
            const unsigned og = xb_add(&bar[XB_TOP], 1u);
            const unsigned tg = og / nx;
            if (og + 1u == (tg + 1u) * nx) xb_add(&bar[XB_TOPGEN], 1u);
            else XB_SPIN(xb_ld(&bar[XB_TOPGEN]) == tg, bar);
            __builtin_amdgcn_fence(__ATOMIC_ACQUIRE, "agent");
            xb_add(&bar[XB_XGEN(b.x)], 1u);
            asm volatile("s_waitcnt vmcnt(0)" ::: "memory");
        } else {
            XB_SPIN(xb_ld(&bar[XB_XGEN(b.x)]) == gen, bar);
            __builtin_amdgcn_fence(__ATOMIC_ACQUIRE, "agent");
            asm volatile("s_waitcnt vmcnt(0)" ::: "memory");
        }
    }
    __syncthreads();
}

__global__ void __launch_bounds__(512, 2) mk_fwd(Args args) {
    extern __shared__ __attribute__((aligned(16))) unsigned char lds_raw[];
    LAS unsigned char* lds = (LAS unsigned char*)lds_raw;
    Ctx X;
#pragma unroll
    for (int i = 0; i < 24; ++i) X.in[i] = args.in[i];
    X.out = args.out; X.ws = args.ws;
    X.P = (bf16_t*)(args.ws + WS_P); X.VT = (bf16_t*)(args.ws + WS_VT); X.HALO = (float*)(args.ws + WS_HALO); X.ROPE = (float*)(args.ws + WS_ROPE);
    X.Win = (bf16_t*)(args.ws + WS_WIN); X.Wg = (bf16_t*)(args.ws + WS_WG); X.Wbr = (bf16_t*)(args.ws + WS_WBR);
    X.Wo = (bf16_t*)(args.ws + WS_WO); X.Wup = (bf16_t*)(args.ws + WS_WUP); X.Wdn = (bf16_t*)(args.ws + WS_WDN);
    X.tid = threadIdx.x; X.lane = X.tid & 63; X.wave = __builtin_amdgcn_readfirstlane(X.tid >> 6); X.G = gridDim.x; X.bid = blockIdx.x;

#if PROBE_DOUBLE
    for (int ph2 = args.ph_lo * 2; ph2 < args.ph_hi * 2; ++ph2) {
        const int ph = ph2 >> 1;
        const int layer = ph / 11, sub = ph % 11;
        const bool skip_ = (ph2 & 1) && !(ph < 22 && ((REPMASK >> sub) & 1));
#else
    volatile LAS unsigned* bst = (volatile LAS unsigned*)(lds + LDS_BYTES - 64);
    if (threadIdx.x < 2) bst[threadIdx.x] = 0u;
    __syncthreads();
    XcdBarrier gbar = xcd_barrier_post((unsigned*)(args.ws + WS_BAR), bst);
    for (int ph = args.ph_lo; ph < args.ph_hi; ++ph) {
        const int layer = ph / 11, sub = ph % 11;
        const bool skip_ = false;
#endif
        const bool fusedn = (X.G == 256) && (args.ph_hi - args.ph_lo > 1);
        if (fusedn && (ph == 22 || sub == 7 || ph == 11)) continue;
        { int t_ = threadIdx.x; asm volatile("" : "+v"(t_)); X.tid = t_; X.lane = t_ & 63; }

        if (skip_) {
        } else if (ph == 22 && (PHMASK & 1024)) {
            const int gw = X.bid * 8 + X.wave, NGW = X.G * 8;
            (void)gw; (void)NGW; rms_pass(X, X.out, X.in[23], nullptr, X.out);
        } else if (sub == 0 && (PHMASK & 1)) {
        } else if (sub == 1 && (PHMASK & 2)) {
            pg8::Gemm g{X.P, X.Win, LDP, DM, DM}; pg8::StaticOrder S; S.init(T_TOK, 5120, X.G, X.bid);
            pg8::EpiInProj E{X.P, X.VT, X.ROPE, (bf16_t*)(X.ws + WS_BND)};
            pg8::gemm_phase<pg8::EpiInProj, true>(lds, g, S, E, X.tid);
        } else if (sub == 2 && (PHMASK & 4)) {
            phase_rwkv_pre(X, lds, layer);
        } else if (sub == 3 && (PHMASK & 4)) {
            phase_mixers(X, lds, layer, layer == 0 && fusedn);
        } else if (sub == 4 && (PHMASK & 8)) {
            phase_hgrn_post(X, layer);
            { const int gw = X.bid * 8 + X.wave, NGW = X.G * 8; const float* hh = (layer == 0) ? X.in[0] : X.out; const float* g = X.in[1] + (size_t)layer * DM;
              (void)gw; (void)NGW; if (layer > 0) rms_pass(X, hh, g, X.P, nullptr); }
        } else if (sub == 5 && (PHMASK & 16)) {
#pragma unroll 1
            for (int br = 0; br < 3; ++br) {
                const bool early_g = (layer == 0 && br == 0 && fusedn);
                bf16_t* Gb_ = early_g ? (bf16_t*)X.out + 1024 : X.P + COL_G; const int Gs_ = early_g ? 2048 : LDP;
                if (!early_g) { pg8::Gemm g{X.P, X.Wg + (size_t)br * DM * DM, LDP, DM, DM}; pg8::StaticOrder S; S.init(T_TOK, DM, X.G, X.bid);
                  int t_ = X.tid; asm volatile("" : "+v"(t_));
                  pg8::EpiGate E{X.P, Gb_, Gs_}; pg8::gemm_phase<pg8::EpiGate, true>(lds, g, S, E, t_); }
                { const int ycol = br == 0 ? COL_YA : (br == 1 ? COL_YB : COL_YC);
                  pg8::Gemm g{X.P + ycol, X.Wbr + (size_t)br * DM * 512, LDP, 512, 512}; pg8::StaticOrder S; S.init(T_TOK, DM, X.G, X.bid);
                  int t_ = X.tid; asm volatile("" : "+v"(t_));
                  pg8::EpiMergeAcc E{X.P, br == 0 ? 1 : 0, Gb_, Gs_}; pg8::gemm_phase<pg8::EpiMergeAcc, true>(lds, g, S, E, t_); }
            }
        } else if (sub == 6 && (PHMASK & 32)) {
            pg8::Gemm g{X.P + COL_MRG, X.Wo, LDP, DM, DM}; pg8::StaticOrder S; S.init(T_TOK, DM, X.G, X.bid);
            if (fusedn) {
                pg8::EpiResidNorm E{layer == 0 ? X.in[0] : X.out, X.out, X.in[18] + (size_t)layer * DM, X.P, nullptr,
                                    (unsigned*)(X.ws + WS_XB) + (size_t)(layer * 2) * 65536, (unsigned*)(X.ws + WS_XC) + (layer * 2) * 4096};
                pg8::gemm_phase<pg8::EpiResidNorm, false>(lds, g, S, E, X.tid);
            } else {
            pg8::EpiResid E{layer == 0 ? X.in[0] : X.out, X.out};
            pg8::gemm_phase<pg8::EpiResid, true>(lds, g, S, E, X.tid);
            }
        } else if (sub == 7 && (PHMASK & 64)) {
            const int gw = X.bid * 8 + X.wave, NGW = X.G * 8;
            const float* g = X.in[18] + (size_t)layer * DM;
            (void)gw; (void)NGW; rms_pass(X, X.out, g, X.P, nullptr);
        } else if (sub == 8 && (PHMASK & 128)) {
            pg8::Gemm g{X.P, X.Wup, LDP, DM, DM}; pg8::StaticOrder S; S.init(T_TOK, F2, X.G, X.bid);
            pg8::EpiUp E{X.P, X.HALO, X.in[20] + (size_t)layer * 3 * F2, X.in[21] + (size_t)layer * F2, (LAS float*)(lds + 131072)};
            pg8::gemm_phase<pg8::EpiUp, true>(lds, g, S, E, X.tid);
        } else if (sub == 9 && (PHMASK & 256)) {
            phase_fixup(X, layer);
        } else if (sub == 10 && (PHMASK & 512)) {
            pg8::Gemm g{X.P + COL_ACT, X.Wdn, LDP, DFF, DFF}; pg8::StaticOrder S; S.init(T_TOK, DM, X.G, X.bid);
            if (fusedn) {
                const bool last = (layer == 1);
                pg8::EpiResidNorm E{X.out, last ? nullptr : X.out, last ? X.in[23] : X.in[1] + (size_t)DM, last ? nullptr : X.P, last ? X.out : nullptr,
                                    (unsigned*)(X.ws + WS_XB) + (size_t)(layer * 2 + 1) * 65536, (unsigned*)(X.ws + WS_XC) + (layer * 2 + 1) * 4096};
                pg8::gemm_phase<pg8::EpiResidNorm, false>(lds, g, S, E, X.tid);
            } else {
            pg8::EpiResid E{X.out, X.out};
            pg8::gemm_phase<pg8::EpiResid, true>(lds, g, S, E, X.tid);
            }
        }
        {
        int pr_layer = -1, pr_lo = 0, pr_hi = 0, pr_gw = 0, pr_ngw = 1; bool pr_u = false;
        if (sub == 0 && ph < 22) { pr_layer = layer; pr_lo = (fusedn && layer > 0) ? NEARLY : 0; pr_hi = NITEMS; pr_u = !(fusedn && layer > 0); pr_gw = X.bid * 8 + X.wave; pr_ngw = X.G * 8; }
        if (sub == 8 && layer == 0 && fusedn && X.bid >= 128) { pr_layer = 1; pr_lo = 0; pr_hi = NEARLY; pr_u = false; pr_gw = (X.bid - 128) * 8 + X.wave; pr_ngw = 128 * 8; }
        if (sub == 3 && layer == 1 && fusedn && X.bid >= 128) { pr_layer = 1; pr_lo = NEARLY; pr_hi = NITEMS; pr_u = false; pr_gw = (X.bid - 128) * 8 + X.wave; pr_ngw = 128 * 8; }
        if (pr_layer >= 0) { { int t_ = threadIdx.x; asm volatile("" : "+v"(t_)); X.tid = t_; X.lane = t_ & 63; } phase_prep(X, lds, pr_layer, pr_u, pr_lo, pr_hi, pr_gw, pr_ngw); }
        }
#if PROBE_DOUBLE
        if (ph2 + 1 < args.ph_hi * 2) cg::this_grid().sync();
#else
        if (ph + 1 < args.ph_hi && !(fusedn && ph == 21)) { if (args.ph_hi > 1000) cg::this_grid().sync(); else xcd_barrier(gbar); }
#endif
    }
}

extern "C" void kernel_launch(void* const* d_in, const int* in_sizes, int n_in, void* d_out, int out_size, void* d_ws, size_t ws_size, hipStream_t stream) {
    static int grid = 0;
    if (grid == 0) {
        int dev = 0, cus = 0, per_cu = 0;
        (void)hipGetDevice(&dev);
        (void)hipDeviceGetAttribute(&cus, hipDeviceAttributeMultiprocessorCount, dev);
        if (hipFuncSetAttribute((const void*)mk_fwd, hipFuncAttributeMaxDynamicSharedMemorySize, LDS_BYTES) != hipSuccess) fprintf(stderr, "kernel_launch: hipFuncSetAttribute failed\n");
        if (hipOccupancyMaxActiveBlocksPerMultiprocessor(&per_cu, (const void*)mk_fwd, 512, LDS_BYTES) != hipSuccess || per_cu < 1) { fprintf(stderr, "kernel_launch: occupancy query gave %d\n", per_cu); per_cu = 1; }
        (void)hipGetLastError();
        grid = cus * 1;
        if (grid <= 0) grid = 256;
        if (ws_size < (size_t)268435456) fprintf(stderr, "kernel_launch: workspace too small (%zu)\n", ws_size);
    }
    Args a{};
    for (int i = 0; i < 24; ++i) a.in[i] = (const float*)d_in[i];
    a.out = (float*)d_out; a.ws = (unsigned char*)d_ws;
#if MK_SINGLE
    (void)hipMemsetAsync((char*)d_ws + WS_BAR, 0, 16384 + 65536, stream);
    a.ph_lo = 0; a.ph_hi = 23;
    void* kargs[] = {&a};
    hipError_t e = hipLaunchCooperativeKernel((const void*)mk_fwd, dim3(grid), dim3(512), kargs, LDS_BYTES, stream);
    if (e != hipSuccess) fprintf(stderr, "cooperative launch failed: %s (grid %d)\n", hipGetErrorString(e), grid);
#else
    for (int ph = 0; ph < 23; ++ph) {
        a.ph_lo = ph; a.ph_hi = ph + 1;
        hipLaunchKernelGGL(mk_fwd, dim3(grid), dim3(512), LDS_BYTES, stream, a);
    }
#endif
}
```

```cpp
#include <hip/hip_runtime.h>
#include <hip/hip_cooperative_groups.h>
#include <cstdio>
#include <cstdint>
namespace cg = cooperative_groups;

#ifndef PHMASK
#define PHMASK 2047
#endif
#ifndef REPMASK
#define REPMASK 0
#endif
#ifndef PROBE_DOUBLE
#define PROBE_DOUBLE 0
#endif
#ifndef PROBE_SCAN2
#define PROBE_SCAN2 0
#endif
#ifndef TKMASK
#define TKMASK 7
#endif
#ifndef MK_SINGLE
#define MK_SINGLE 1
#endif

#define LAS __attribute__((address_space(3)))
typedef unsigned short bf16_t;
typedef short bf16x8 __attribute__((ext_vector_type(8)));
typedef float f32x4 __attribute__((ext_vector_type(4)));
typedef float f32x2 __attribute__((ext_vector_type(2)));
typedef unsigned u32x4 __attribute__((ext_vector_type(4)));
typedef unsigned u32x2 __attribute__((ext_vector_type(2)));

constexpr int T_TOK = 16384, SEQ = 2048, DM = 1024;
constexpr int LDP = 6208;
constexpr int COL_PA = 1024, COL_PB = 2816, COL_PC = 4864;
constexpr int COL_YA = 1024, COL_MRG = 1536, COL_G = 2816, COL_YB = 3840, COL_YC = 4864, COL_ACT = 1024;
constexpr int COL_GS = 5960;
constexpr int C_Q = 4864, C_K = 5376, C_QI = 5632, C_KI = 5888, C_WI = 5952;
constexpr int IN_COLS = 8004, DFF = 2816, F2 = 5632;
constexpr size_t WS_WIN = 0, WS_WG = 10485760, WS_WBR = 16777216, WS_WO = 19922944, WS_WUP = 22020096, WS_WDN = 33554432;
constexpr size_t WS_P = 39321600, WS_HALO = 242745344, WS_VT = WS_HALO, WS_ROPE = 265814016, WS_BAR = 266338304, WS_BND = WS_HALO + 4194304, WS_SCAL = WS_HALO + 8388608, WS_XC = WS_BAR + 16384, WS_XB = WS_XC + 65536;
constexpr int LDS_BYTES = 153600;
constexpr int SCS = 2052;
constexpr int MASK_OFF = 16 * SCS * 4;

struct Args { const float* in[24]; float* out; unsigned char* ws; int ph_lo, ph_hi; };

__device__ __forceinline__ unsigned f2bf(float f) { unsigned u = __builtin_bit_cast(unsigned, f); return (u + 0x7fffu + ((u >> 16) & 1u)) >> 16; }
__device__ __forceinline__ unsigned pk2(float lo, float hi) { unsigned r; asm("v_cvt_pk_bf16_f32 %0, %1, %2" : "=v"(r) : "v"(lo), "v"(hi)); return r; }
__device__ __forceinline__ float bf2f(bf16_t b) { return __builtin_bit_cast(float, (unsigned)b << 16); }
__device__ __forceinline__ float bflo(unsigned w) { return __builtin_bit_cast(float, w << 16); }
__device__ __forceinline__ float bfhi(unsigned w) { return __builtin_bit_cast(float, w & 0xffff0000u); }
__device__ __forceinline__ float wave_sum(float v) {
#pragma unroll
    for (int o = 1; o < 64; o <<= 1) v += __shfl_xor(v, o);
    return v;
}
__device__ __forceinline__ int wave_sum_i(int v) {
#pragma unroll
    for (int o = 1; o < 64; o <<= 1) v += __shfl_xor(v, o);
    return v;
}
template <int CTRL> __device__ __forceinline__ float dpp_mov(float x) {
    return __builtin_bit_cast(float, __builtin_amdgcn_update_dpp(0, __builtin_bit_cast(int, x), CTRL, 0xF, 0xF, true));
}
__device__ __forceinline__ float red8(float x) { x += dpp_mov<0xB1>(x); x += dpp_mov<0x4E>(x); x += dpp_mov<0x141>(x); return x; }
__device__ __forceinline__ float red16(float x) { x = red8(x); x += dpp_mov<0x140>(x); return x; }
__device__ __forceinline__ float sigmoidf_(float x) { return 1.f / (1.f + __expf(-x)); }

namespace pg8 {
constexpr int BM = 256, BK = 64, HALF = 128, HTB = HALF * BK * 2, NXCD = 8, WGM = 8;
__device__ __forceinline__ int lds_byte(int r, int c) { const int st = (r >> 4) * 2 + (c >> 5), rr = r & 15, cc = c & 31, ob = rr * 64 + cc * 2; return st * 1024 + (ob ^ (((ob >> 9) & 1) << 5)); }
__device__ __forceinline__ void stage_rc(int b, int& R, int& C) { const int st = b / 1024, sb = b % 1024, swz = sb ^ (((sb >> 9) & 1) << 5); R = (st >> 1) * 16 + swz / 64; C = (st & 1) * 32 + (swz % 64) / 2; }
__device__ __forceinline__ int perm32(int rho) { const int n = rho >> 4, i = rho & 15; return 8 * (i >> 2) + 4 * n + (i & 3); }
struct Unit { int pm, pn; };
struct Gemm { const bf16_t* A; const bf16_t* Bt; int lda, ldb, K; };
struct StaticOrder {
    int nM, nN, nwg, G, c;
    __device__ void init(int M, int N, int G_, int c_) { nM = M / BM; nN = N / BM; nwg = nM * nN; G = G_; c = c_; }
    __device__ bool next(int i, Unit& u) const {
        const long L = (long)i * G + c; if (L >= nwg) return false;
        int wgid = (int)L; { const int q = nwg / NXCD, r = nwg % NXCD, xcd = wgid % NXCD, off = wgid / NXCD; wgid = (xcd < r ? xcd * (q + 1) : r * (q + 1) + (xcd - r) * q) + off; }
        const int nig = WGM * nN, gid = wgid / nig, fm = gid * WGM, gsz = (nM - fm) < WGM ? (nM - fm) : WGM;
        u.pm = fm + ((wgid % nig) % gsz); u.pn = (wgid % nig) / gsz; return true;
    }
};
__device__ __forceinline__ unsigned cvt_pk_bf16(float lo, float hi) { unsigned r; asm volatile("v_cvt_pk_bf16_f32 %0, %1, %2" : "=v"(r) : "v"(lo), "v"(hi)); return r; }

template <class Epi, bool ALIGN_EPI>
__device__ __forceinline__ void gemm_phase(LAS unsigned char* lds, const Gemm g, const StaticOrder& S, const Epi& E, const int tid) {
    const int wid = __builtin_amdgcn_readfirstlane(tid >> 6), lane = tid & 63, wr = wid >> 2, wc = wid & 3, fr = lane & 15, fq = lane >> 4;
    const int K = g.K, nt = K / BK;
    unsigned voffA[2], voffB[2];
#pragma unroll
    for (int i = 0; i < 2; ++i) { int R, C; stage_rc(tid * 16 + i * 8192, R, C); const int Rb = (R & ~31) + perm32(R & 31);
        voffA[i] = (unsigned)(R * g.lda + C) * 2u; voffB[i] = (unsigned)(Rb * g.ldb + C) * 2u; }
    const size_t kstep = (size_t)(BK * 2);
    const size_t hstepA = (size_t)HALF * g.lda * 2, hstepB = (size_t)HALF * g.ldb * 2;
    const size_t tstepA = 2 * hstepA, tstepB = 2 * hstepB;
    const unsigned ldsw = (unsigned)wid * 1024u;
    const int aoff = lds_byte(wr * 64 + fr, fq * 8), boff = lds_byte(wc * 32 + fr, fq * 8);
#define PG8_SA(b, h) (((b) * 2 + (h)) * HTB)
#define PG8_SB(b, h) ((4 + (b) * 2 + (h)) * HTB)
#define PG8_STAGE(bufoff, gbase, voff) do { _Pragma("unroll") for (int _i = 0; _i < 2; ++_i) \
        __builtin_amdgcn_global_load_lds((const unsigned*)((const char*)(gbase) + (voff)[_i]), (LAS unsigned*)(lds + (bufoff) + ldsw + _i * 8192), 16, 0, 0); } while (0)
#define PG8_LDA(dst, b, h) do { _Pragma("unroll") for (int m = 0; m < 4; ++m) _Pragma("unroll") for (int k = 0; k < 2; ++k) dst[m][k] = *(const LAS bf16x8*)(lds + PG8_SA(b, h) + aoff + m * 2048 + k * 1024); } while (0)
#define PG8_LDB(dst, b, h) do { _Pragma("unroll") for (int n = 0; n < 2; ++n) _Pragma("unroll") for (int k = 0; k < 2; ++k) dst[n][k] = *(const LAS bf16x8*)(lds + PG8_SB(b, h) + boff + n * 2048 + k * 1024); } while (0)
#define PG8_MMA(ai, bj, At, Bt) do { __builtin_amdgcn_s_setprio(1); _Pragma("unroll") for (int m = 0; m < 4; ++m) _Pragma("unroll") for (int n = 0; n < 2; ++n) _Pragma("unroll") for (int k = 0; k < 2; ++k) \
        acc[ai][bj][m][n] = __builtin_amdgcn_mfma_f32_16x16x32_bf16(Bt[n][k], At[m][k], acc[ai][bj][m][n], 0, 0, 0); __builtin_amdgcn_s_setprio(0); } while (0)
#define PG8_WAIT_V(n) asm volatile("s_waitcnt vmcnt(" #n ")" ::: "memory")
#define PG8_WAIT_L(n) asm volatile("s_waitcnt lgkmcnt(" #n ")" ::: "memory")
#define PG8_BAR __builtin_amdgcn_s_barrier()
#define PG8_SCHED __builtin_amdgcn_sched_barrier(0)
    Unit cur, nxt; int ui = 0;
    if (!S.next(0, cur)) return;
    f32x4 acc[2][2][4][2];
#pragma unroll
    for (int a = 0; a < 2; ++a)
#pragma unroll
        for (int b = 0; b < 2; ++b)
#pragma unroll
            for (int m = 0; m < 4; ++m)
#pragma unroll
                for (int n = 0; n < 2; ++n) acc[a][b][m][n] = (f32x4){0.f, 0.f, 0.f, 0.f};
    bf16x8 At[4][2], B0[2][2], B1[2][2];
    const char* cA = (const char*)g.A + (size_t)cur.pm * tstepA; const char* cB = (const char*)g.Bt + (size_t)cur.pn * tstepB;
    PG8_STAGE(PG8_SB(0, 0), cB, voffB); PG8_STAGE(PG8_SB(0, 1), cB + hstepB, voffB); PG8_STAGE(PG8_SA(0, 0), cA, voffA); PG8_STAGE(PG8_SA(0, 1), cA + hstepA, voffA);
    if (wr == 1) PG8_BAR;
    PG8_WAIT_V(2); PG8_BAR;
    PG8_STAGE(PG8_SB(1, 0), cB + kstep, voffB); PG8_STAGE(PG8_SA(1, 0), cA + kstep, voffA); PG8_STAGE(PG8_SB(1, 1), cB + hstepB + kstep, voffB);
    PG8_WAIT_V(6); PG8_BAR;
    for (;;) {
        const bool has_next = S.next(ui + 1, nxt);
        const char* nA = has_next ? (const char*)g.A + (size_t)nxt.pm * tstepA : cA; const char* nB = has_next ? (const char*)g.Bt + (size_t)nxt.pn * tstepB : cB;
        for (int t = 0; t < nt; t += 2) {
            const bool last = (t == nt - 2);
            const char* a1 = cA + (size_t)(t + 1) * kstep;
            const char* a2 = last ? nA : cA + (size_t)(t + 2) * kstep; const char* b2 = last ? nB : cB + (size_t)(t + 2) * kstep;
            const char* a3 = a2 + kstep; const char* b3 = b2 + kstep;
            PG8_LDB(B0, 0, 0); PG8_LDB(B1, 0, 1); PG8_SCHED; PG8_LDA(At, 0, 0); PG8_STAGE(PG8_SA(1, 1), a1 + hstepA, voffA);
            PG8_WAIT_V(8); PG8_WAIT_L(0); PG8_BAR; PG8_MMA(0, 0, At, B0); PG8_MMA(0, 1, At, B1); PG8_BAR; PG8_SCHED;
            PG8_LDA(At, 0, 1); PG8_STAGE(PG8_SB(0, 0), b2, voffB); PG8_STAGE(PG8_SB(0, 1), b2 + hstepB, voffB); PG8_STAGE(PG8_SA(0, 0), a2, voffA);
            PG8_WAIT_V(8); PG8_WAIT_L(0); PG8_BAR; PG8_MMA(1, 0, At, B0); PG8_MMA(1, 1, At, B1); PG8_BAR; PG8_SCHED;
            PG8_LDB(B0, 1, 0); PG8_LDB(B1, 1, 1); PG8_SCHED; PG8_LDA(At, 1, 0); PG8_STAGE(PG8_SA(0, 1), a2 + hstepA, voffA);
            PG8_WAIT_V(8); PG8_WAIT_L(0); PG8_BAR; PG8_MMA(0, 0, At, B0); PG8_MMA(0, 1, At, B1); PG8_BAR; PG8_SCHED;
            PG8_LDA(At, 1, 1); PG8_STAGE(PG8_SB(1, 0), b3, voffB); PG8_STAGE(PG8_SB(1, 1), b3 + hstepB, voffB); PG8_STAGE(PG8_SA(1, 0), a3, voffA);
            PG8_WAIT_V(8); PG8_WAIT_L(0); PG8_BAR; PG8_MMA(1, 0, At, B0); PG8_MMA(1, 1, At, B1); PG8_BAR; PG8_SCHED;
        }
        if constexpr (ALIGN_EPI) { if (wr == 0) PG8_BAR; }
        if constexpr (!Epi::AFTER_DRAIN) E(acc, cur, wr, wc, fr, fq);
        if (!has_next) break;
#pragma unroll
        for (int a = 0; a < 2; ++a)
#pragma unroll
            for (int b = 0; b < 2; ++b)
#pragma unroll
                for (int m = 0; m < 4; ++m)
#pragma unroll
                    for (int n = 0; n < 2; ++n) acc[a][b][m][n] = (f32x4){0.f, 0.f, 0.f, 0.f};
        cur = nxt; cA = nA; cB = nB; ++ui;
        if constexpr (ALIGN_EPI) { if (wr == 1) PG8_BAR; }
    }
    PG8_WAIT_V(0);
    if constexpr (!ALIGN_EPI) { if (wr == 0) PG8_BAR; }
    PG8_BAR;
    if constexpr (Epi::AFTER_DRAIN) E.fused(acc, cur, wr, wc, fr, fq, lds, wid, lane);
#undef PG8_SA
#undef PG8_SB
#undef PG8_STAGE
#undef PG8_LDA
#undef PG8_LDB
#undef PG8_MMA
#undef PG8_WAIT_V
#undef PG8_WAIT_L
#undef PG8_BAR
#undef PG8_SCHED
}

typedef f32x4 AccT[2][2][4][2];

struct EpiInProj {
    static constexpr bool AFTER_DRAIN = false;
    bf16_t* P; bf16_t* VT; const float* rope; bf16_t* BND;
    __device__ __forceinline__ void operator()(AccT& acc, const Unit& u, int wr, int wc, int fr, int fq) const {
        const int row0 = u.pm * BM + wr * 64 + fr, colb = u.pn * BM + wc * 32 + 8 * fq;
#pragma unroll
        for (int ai = 0; ai < 2; ++ai)
#pragma unroll
            for (int m = 0; m < 4; ++m) {
                const int row = row0 + ai * HALF + m * 16, t = row & (SEQ - 1);
                bf16_t* rowp = P + (size_t)row * LDP + COL_PA;
#pragma unroll
                for (int bj = 0; bj < 2; ++bj) {
                    const int c = colb + bj * HALF;
                    f32x4 v0 = acc[ai][bj][m][0], v1 = acc[ai][bj][m][1];
                    if (u.pn >= 15) {
                        const int cl = c - 3840;
                        if (cl < 640 || (cl >= 768 && cl < 1088)) {
                            const float* cs = rope + ((size_t)t * 32 + ((cl & 63) >> 1)) * 2;
                            const f32x4 r0 = *(const f32x4*)cs, r1 = *(const f32x4*)(cs + 4);
                            f32x4 o0, o1;
                            o0[0] = v0[0] * r0[0] - v0[1] * r0[1]; o0[1] = v0[1] * r0[0] + v0[0] * r0[1];
                            o0[2] = v0[2] * r0[2] - v0[3] * r0[3]; o0[3] = v0[3] * r0[2] + v0[2] * r0[3];
                            o1[0] = v1[0] * r1[0] - v1[1] * r1[1]; o1[1] = v1[1] * r1[0] + v1[0] * r1[1];
                            o1[2] = v1[2] * r1[2] - v1[3] * r1[3]; o1[3] = v1[3] * r1[2] + v1[2] * r1[3];
                            v0 = o0; v1 = o1;
                        }
                    }
                    u32x4 w; w.x = cvt_pk_bf16(v0[0], v0[1]); w.y = cvt_pk_bf16(v0[2], v0[3]); w.z = cvt_pk_bf16(v1[0], v1[1]); w.w = cvt_pk_bf16(v1[2], v1[3]);
                    *(u32x4*)(rowp + c) = w;
                    if (u.pn < 7 && fr == 15) *(u32x4*)(BND + (size_t)(row >> 4) * 1792 + c) = w;
                    if (u.pn == 17 && bj == 1) {
                        const int cv = c - 3840 - 640, b = row >> 11;
                        bf16_t* vt = VT + ((size_t)(b * 2 + (cv >> 6)) * 64 + (cv & 63)) * SEQ + t;
                        vt[0 * SEQ] = (bf16_t)(w.x & 0xffffu); vt[1 * SEQ] = (bf16_t)(w.x >> 16);
                        vt[2 * SEQ] = (bf16_t)(w.y & 0xffffu); vt[3 * SEQ] = (bf16_t)(w.y >> 16);
                        vt[4 * SEQ] = (bf16_t)(w.z & 0xffffu); vt[5 * SEQ] = (bf16_t)(w.z >> 16);
                        vt[6 * SEQ] = (bf16_t)(w.w & 0xffffu); vt[7 * SEQ] = (bf16_t)(w.w >> 16);
                    }
                }
            }
    }
};
struct EpiGate {
    static constexpr bool AFTER_DRAIN = false;
    bf16_t* P; bf16_t* Gb; int Gs;
    __device__ __forceinline__ void operator()(AccT& acc, const Unit& u, int wr, int wc, int fr, int fq) const {
        const int row0 = u.pm * BM + wr * 64 + fr, colb = u.pn * BM + wc * 32 + 8 * fq;
#pragma unroll
        for (int ai = 0; ai < 2; ++ai)
#pragma unroll
            for (int m = 0; m < 4; ++m) {
                bf16_t* rowp = Gb + (size_t)(row0 + ai * HALF + m * 16) * Gs + colb;
#pragma unroll
                for (int bj = 0; bj < 2; ++bj) {
                    const f32x4 v0 = acc[ai][bj][m][0], v1 = acc[ai][bj][m][1];
                    u32x4 w; w.x = cvt_pk_bf16(sigmoidf_(v0[0]), sigmoidf_(v0[1])); w.y = cvt_pk_bf16(sigmoidf_(v0[2]), sigmoidf_(v0[3]));
                    w.z = cvt_pk_bf16(sigmoidf_(v1[0]), sigmoidf_(v1[1])); w.w = cvt_pk_bf16(sigmoidf_(v1[2]), sigmoidf_(v1[3]));
                    *(u32x4*)(rowp + bj * HALF) = w;
                }
            }
    }
};
struct EpiMergeAcc {
    static constexpr bool AFTER_DRAIN = false;
    bf16_t* P; int first; const bf16_t* Gb; int Gs;
    __device__ __forceinline__ void operator()(AccT& acc, const Unit& u, int wr, int wc, int fr, int fq) const {
        const int row0 = u.pm * BM + wr * 64 + fr, colb = u.pn * BM + wc * 32 + 8 * fq;
#pragma unroll
        for (int ai = 0; ai < 2; ++ai)
#pragma unroll
            for (int m = 0; m < 4; ++m) {
                bf16_t* rowb = P + (size_t)(row0 + ai * HALF + m * 16) * LDP + colb;
#pragma unroll
                for (int bj = 0; bj < 2; ++bj) {
                    const f32x4 v0 = acc[ai][bj][m][0], v1 = acc[ai][bj][m][1];
                    const u32x4 gq = *(const u32x4*)(Gb + (size_t)(row0 + ai * HALF + m * 16) * Gs + colb + bj * HALF);
                    u32x4 mq = (u32x4){0u, 0u, 0u, 0u};
                    if (!first) mq = *(const u32x4*)(rowb + COL_MRG + bj * HALF);
                    const unsigned ga = gq.x, gb = gq.y, gc = gq.z, gd = gq.w;
                    const unsigned ma = mq.x, mb = mq.y, mc = mq.z, md = mq.w;
                    u32x4 w;
                    w.x = cvt_pk_bf16(bflo(ma) + bflo(ga) * v0[0], bfhi(ma) + bfhi(ga) * v0[1]);
                    w.y = cvt_pk_bf16(bflo(mb) + bflo(gb) * v0[2], bfhi(mb) + bfhi(gb) * v0[3]);
                    w.z = cvt_pk_bf16(bflo(mc) + bflo(gc) * v1[0], bfhi(mc) + bfhi(gc) * v1[1]);
                    w.w = cvt_pk_bf16(bflo(md) + bflo(gd) * v1[2], bfhi(md) + bfhi(gd) * v1[3]);
                    *(u32x4*)(rowb + COL_MRG + bj * HALF) = w;
                }
            }
    }
};
struct EpiResid {
    static constexpr bool AFTER_DRAIN = false;
    const float* base; float* out;
    __device__ __forceinline__ void operator()(AccT& acc, const Unit& u, int wr, int wc, int fr, int fq) const {
        const int row0 = u.pm * BM + wr * 64 + fr, colb = u.pn * BM + wc * 32 + 8 * fq;
#pragma unroll
        for (int ai = 0; ai < 2; ++ai)
#pragma unroll
            for (int m = 0; m < 4; ++m) {
                const size_t off = (size_t)(row0 + ai * HALF + m * 16) * DM + colb;
#pragma unroll
                for (int bj = 0; bj < 2; ++bj) {
                    const f32x4 b0 = *(const f32x4*)(base + off + bj * HALF), b1 = *(const f32x4*)(base + off + bj * HALF + 4);
                    *(f32x4*)(out + off + bj * HALF) = b0 + acc[ai][bj][m][0];
                    *(f32x4*)(out + off + bj * HALF + 4) = b1 + acc[ai][bj][m][1];
                }
            }
    }
};
struct EpiResidNorm {
    static constexpr bool AFTER_DRAIN = true;
    const float* base; float* out; const float* g; bf16_t* obf; float* of32; unsigned* xbuf; unsigned* cnt;
    __device__ __forceinline__ void fused(AccT& acc, const Unit& u, int wr, int wc, int fr, int fq, LAS unsigned char* lds, int wid, int lane) const {
        LAS float* Pl = (LAS float*)lds;
        LAS float* S = (LAS float*)(lds + 8192);
        const int row0 = u.pm * BM + wr * 64 + fr, colb = u.pn * BM + wc * 32 + 8 * fq;
#pragma unroll
        for (int ai = 0; ai < 2; ++ai)
#pragma unroll
            for (int m = 0; m < 4; ++m) {
                const size_t off = (size_t)(row0 + ai * HALF + m * 16) * DM + colb;
                float sq = 0.f;
#pragma unroll
                for (int bj = 0; bj < 2; ++bj) {
                    const f32x4 b0 = *(const f32x4*)(base + off + bj * HALF), b1 = *(const f32x4*)(base + off + bj * HALF + 4);
                    const f32x4 h0 = acc[ai][bj][m][0] + b0, h1 = acc[ai][bj][m][1] + b1;
                    acc[ai][bj][m][0] = h0; acc[ai][bj][m][1] = h1;
                    sq += (h0.x * h0.x + h0.y * h0.y) + (h0.z * h0.z + h0.w * h0.w) + (h1.x * h1.x + h1.y * h1.y) + (h1.z * h1.z + h1.w * h1.w);
                }
                sq += __shfl_xor(sq, 16); sq += __shfl_xor(sq, 32);
                if (fq == 0) Pl[(ai * HALF + wr * 64 + m * 16 + fr) * 4 + wc] = sq;
                if (m & 1) asm volatile("" ::: "memory");
            }
        asm volatile("s_waitcnt lgkmcnt(0)" ::: "memory"); __builtin_amdgcn_s_barrier(); asm volatile("" ::: "memory");
        const int row = wid * 32 + (lane & 31);
        if (lane < 32) {
            const f32x4 p = *(const LAS f32x4*)&Pl[row * 4];
            __hip_atomic_store(xbuf + ((size_t)(u.pm * BM + row) * 4 + u.pn), __builtin_bit_cast(unsigned, (p.x + p.y) + (p.z + p.w)), __ATOMIC_RELAXED, __HIP_MEMORY_SCOPE_AGENT);
        }
        asm volatile("s_waitcnt vmcnt(0)" ::: "memory");
        if (lane == 0) __hip_atomic_fetch_add(cnt + 64 * u.pm, 1u, __ATOMIC_RELAXED, __HIP_MEMORY_SCOPE_AGENT);
        if (wid == 0) {
            unsigned sp = 0u;
            while ((unsigned)__builtin_amdgcn_readfirstlane(__hip_atomic_load(cnt + 64 * u.pm, __ATOMIC_RELAXED, __HIP_MEMORY_SCOPE_AGENT)) < 32u) { __builtin_amdgcn_s_sleep(2); if (++sp > (1u << 22)) break; }
            __builtin_amdgcn_fence(__ATOMIC_ACQUIRE, "agent");
        }
        asm volatile("s_waitcnt vmcnt(0) lgkmcnt(0)" ::: "memory"); __builtin_amdgcn_s_barrier(); asm volatile("" ::: "memory");
        if (lane < 32) {
            const unsigned* slot = xbuf + (size_t)(u.pm * BM + row) * 4; float tot = 0.f;
#pragma unroll
            for (int t = 0; t < 4; ++t) tot += __builtin_bit_cast(float, __hip_atomic_load(slot + t, __ATOMIC_RELAXED, __HIP_MEMORY_SCOPE_AGENT));
            S[row] = 1.0f / sqrtf(tot * (1.f / DM) + 1e-6f);
        }
        asm volatile("s_waitcnt lgkmcnt(0)" ::: "memory"); __builtin_amdgcn_s_barrier(); asm volatile("" ::: "memory");
        f32x4 gv[2][2];
#pragma unroll
        for (int bj = 0; bj < 2; ++bj)
#pragma unroll
            for (int n = 0; n < 2; ++n) gv[bj][n] = *(const f32x4*)(g + colb + bj * HALF + 4 * n);
#pragma unroll
        for (int ai = 0; ai < 2; ++ai)
#pragma unroll
            for (int m = 0; m < 4; ++m) {
                const int rl = ai * HALF + wr * 64 + m * 16 + fr, rowg = u.pm * BM + rl;
                const float rs = S[rl];
#pragma unroll
                for (int bj = 0; bj < 2; ++bj) {
                    const f32x4 h0 = acc[ai][bj][m][0], h1 = acc[ai][bj][m][1];
                    const size_t off = (size_t)rowg * DM + colb + bj * HALF;
                    if (out) { *(f32x4*)(out + off) = h0; *(f32x4*)(out + off + 4) = h1; }
                    const f32x4 o0 = h0 * rs * gv[bj][0], o1 = h1 * rs * gv[bj][1];
                    if (obf) { u32x4 w; w.x = cvt_pk_bf16(o0[0], o0[1]); w.y = cvt_pk_bf16(o0[2], o0[3]); w.z = cvt_pk_bf16(o1[0], o1[1]); w.w = cvt_pk_bf16(o1[2], o1[3]);
                        *(u32x4*)(obf + (size_t)rowg * LDP + colb + bj * HALF) = w; }
                    else { *(f32x4*)(of32 + off) = o0; *(f32x4*)(of32 + off + 4) = o1; }
                }
                asm volatile("" ::: "memory");
            }
    }
};
struct EpiUp {
    static constexpr bool AFTER_DRAIN = false;
    bf16_t* P; float* HALO; const float* cw; const float* cb; LAS float* CW;
    __device__ __forceinline__ void operator()(AccT& acc, const Unit& u, int wr, int wc, int fr_in, int fq_in) const {
        int fr = fr_in, fq = fq_in;
        asm volatile("" : "+v"(fr), "+v"(fq));
        const int row0 = u.pm * BM + wr * 64 + fr;
        const int jb = u.pn * 128 + wc * 32 + 8 * fq;
        {
            const int tl = (wr * 4 + wc) * 64 + fq * 16 + fr;
#pragma unroll
            for (int it = 0; it < 2; ++it) { const int k = tl + 512 * it, p = k >> 8, col = k & 255, co = (col >> 7) * DFF + u.pn * 128 + (col & 127);
                CW[k] = (p < 3) ? cw[p * F2 + co] : cb[co]; }
            asm volatile("s_waitcnt lgkmcnt(0)" ::: "memory"); __builtin_amdgcn_s_barrier(); asm volatile("" ::: "memory");
        }
#pragma unroll
        for (int ai = 0; ai < 2; ++ai) {
            const int s = u.pm * 4 + ai * 2 + wr;
#pragma unroll
            for (int bj = 0; bj < 2; ++bj)
#pragma unroll
                for (int n = 0; n < 2; ++n) {
                    const int colp = u.pn * BM + bj * HALF + wc * 32 + 8 * fq + 4 * n;
                    if (fr < 2) *(f32x4*)(HALO + (size_t)(s * 4 + fr) * F2 + colp) = acc[ai][bj][0][n];
                    if (fr >= 14) *(f32x4*)(HALO + (size_t)(s * 4 + fr - 12) * F2 + colp) = acc[ai][bj][3][n];
                }
        }
#pragma unroll
        for (int ai = 0; ai < 2; ++ai)
#pragma unroll
            for (int m = 0; m < 4; ++m) {
                const int row = row0 + ai * HALF + m * 16;
#pragma unroll
                for (int n = 0; n < 2; ++n) {
                    f32x4 cv[2];
#pragma unroll
                    for (int bj = 0; bj < 2; ++bj) {
                        const int cl = bj * 128 + wc * 32 + 8 * fq + 4 * n;
                        const f32x4 w0 = *(const LAS f32x4*)&CW[cl], w1 = *(const LAS f32x4*)&CW[256 + cl], w2 = *(const LAS f32x4*)&CW[512 + cl], bb = *(const LAS f32x4*)&CW[768 + cl];
#pragma unroll
                        for (int e = 0; e < 4; ++e) {
                            const float cur = acc[ai][bj][m][n][e];
                            const float prv = m > 0 ? acc[ai][bj][m > 0 ? m - 1 : 0][n][e] : 0.f;
                            const float a1 = dpp_mov<0x121>(cur), a2 = dpp_mov<0x122>(cur), b1 = dpp_mov<0x121>(prv), b2 = dpp_mov<0x122>(prv);
                            const float p1 = fr >= 1 ? a1 : b1, p2 = fr >= 2 ? a2 : b2;
                            cv[bj][e] = bb[e] + w0[e] * p2 + w1[e] * p1 + w2[e] * cur;
                        }
                        __builtin_amdgcn_sched_barrier(0);
                    }
                    const f32x4 g0 = cv[0], v0 = cv[1];
                    u32x2 w;
                    w.x = cvt_pk_bf16(g0[0] * sigmoidf_(g0[0]) * v0[0], g0[1] * sigmoidf_(g0[1]) * v0[1]);
                    w.y = cvt_pk_bf16(g0[2] * sigmoidf_(g0[2]) * v0[2], g0[3] * sigmoidf_(g0[3]) * v0[3]);
                    if (!(m == 0 && fr < 2)) *(u32x2*)(P + (size_t)row * LDP + COL_ACT + jb + 4 * n) = w;
                    __builtin_amdgcn_sched_barrier(0);
                }
            }
    }
};
}

struct Ctx {
    const float* in[24]; float* out; unsigned char* ws;
    bf16_t* P; bf16_t* VT; float* HALO; float* ROPE;
    bf16_t *Win, *Wg, *Wbr, *Wo, *Wup, *Wdn;
    int tid, lane, wave, G, bid;
};

__device__ __forceinline__ int srccol(int mode, int n) {
    if (mode == 0) return n;
    if (mode == 2) return 4932 + n;
    if (mode == 3) { const int tile = n >> 8, w = n & 255, j = tile * 128 + (w & 127); return (w < 128) ? j : DFF + j; }
    if (n < 3840) return n;
    const int c = n - 3840;
    if (c >= 1092) return -1;
    if (c < 640 || (c >= 768 && c < 1088)) { const int base = c & ~63, i = c & 63; return 3840 + base + (i >> 1) + 32 * (i & 1); }
    return 3840 + c;
}
__device__ __forceinline__ void tr_item(const float* W, int ldw, int K, int N, bf16_t* WT, int mode, int item, LAS float* scr, int lane) {
    const int nblk = N / 32, kb = item / nblk, nb = item % nblk, k0 = 64 * kb, n0 = 32 * nb;
    const int sc = srccol(mode, n0 + (lane & 31));
    float wv_[32];
#pragma unroll
    for (int i = 0; i < 32; ++i) { const int kk = 2 * i + (lane >> 5); wv_[i] = (sc >= 0) ? W[(size_t)(k0 + kk) * ldw + sc] : 0.f; }
#pragma unroll
    for (int i = 0; i < 32; ++i) { const int kk = 2 * i + (lane >> 5); scr[kk * 33 + (lane & 31)] = wv_[i]; }
    asm volatile("s_waitcnt lgkmcnt(0)" ::: "memory");
    const int c = lane & 7;
#pragma unroll
    for (int j = 0; j < 4; ++j) { const int n = (lane >> 3) + 8 * j; const LAS float* s = scr + (8 * c) * 33 + n;
        u32x4 o; o.x = pk2(s[0 * 33], s[1 * 33]); o.y = pk2(s[2 * 33], s[3 * 33]); o.z = pk2(s[4 * 33], s[5 * 33]); o.w = pk2(s[6 * 33], s[7 * 33]);
        *(u32x4*)(WT + (size_t)(n0 + n) * K + k0 + 8 * c) = o; }
    asm volatile("s_waitcnt lgkmcnt(0)" ::: "memory");
}
__device__ __forceinline__ void rms_row(const float* xrow, const float* g, bf16_t* obf, float* of32, int lane) {
    const f32x4* xr = (const f32x4*)xrow + lane; const f32x4* gr = (const f32x4*)g + lane;
    f32x4 v[4]; float s = 0.f;
#pragma unroll
    for (int j = 0; j < 4; ++j) { v[j] = xr[64 * j]; s += (v[j].x * v[j].x + v[j].y * v[j].y) + (v[j].z * v[j].z + v[j].w * v[j].w); }
    const float rs = 1.f / sqrtf(wave_sum(s) * (1.f / DM) + 1e-6f);
#pragma unroll
    for (int j = 0; j < 4; ++j) {
        const f32x4 gg = gr[64 * j]; const f32x4 o = v[j] * rs * gg;
        if (obf) { u32x2 w; w.x = pk2(o.x, o.y); w.y = pk2(o.z, o.w); *((u32x2*)obf + lane + 64 * j) = w; }
        else *((f32x4*)of32 + lane + 64 * j) = o;
    }
}
__device__ __forceinline__ void rms_pass(const Ctx& X, const float* src, const float* g, bf16_t* obf, float* of32) {
    const int gw = X.bid * 8 + X.wave, NGW = X.G * 8, lane = X.lane;
    const f32x4* gr = (const f32x4*)g + lane;
    f32x4 gg[4];
#pragma unroll
    for (int j = 0; j < 4; ++j) gg[j] = gr[64 * j];
#pragma unroll 1
    for (int m = gw; m < T_TOK; m += 4 * NGW) {
        f32x4 v[4][4]; float ss[4]; int mr[4];
#pragma unroll
        for (int r = 0; r < 4; ++r) { mr[r] = m + r * NGW; const int ml = mr[r] < T_TOK ? mr[r] : m; const f32x4* x = (const f32x4*)(src + (size_t)ml * DM) + lane;
#pragma unroll
            for (int j = 0; j < 4; ++j) v[r][j] = x[64 * j]; }
#pragma unroll
        for (int r = 0; r < 4; ++r) { float a = 0.f;
#pragma unroll
            for (int j = 0; j < 4; ++j) a += (v[r][j].x * v[r][j].x + v[r][j].y * v[r][j].y) + (v[r][j].z * v[r][j].z + v[r][j].w * v[r][j].w);
            ss[r] = 1.f / sqrtf(wave_sum(a) * (1.f / DM) + 1e-6f); }
#pragma unroll
        for (int r = 0; r < 4; ++r) {
            if (mr[r] < T_TOK) {
#pragma unroll
                for (int j = 0; j < 4; ++j) {
                    const f32x4 o = v[r][j] * ss[r] * gg[j];
                    if (obf) { u32x2 w; w.x = pk2(o.x, o.y); w.y = pk2(o.z, o.w); *((u32x2*)(obf + (size_t)mr[r] * LDP) + lane + 64 * j) = w; }
                    else *((f32x4*)(of32 + (size_t)mr[r] * DM) + lane + 64 * j) = o;
                }
            }
        }
    }
}
constexpr int I_IN = 16 * 160, I_G = 16 * 96, I_BR = 8 * 32, I_O = 16 * 32, I_UP = 16 * 176, I_DN = 44 * 32;
constexpr int NITEMS = I_IN + I_G + 3 * I_BR + I_O + I_UP + I_DN, NEARLY = I_IN + I_G + 3 * I_BR + I_O;
__device__ __forceinline__ void phase_prep(const Ctx& X, LAS unsigned char* lds, int layer, bool do_u, int it_lo, int it_hi, int gw, int NGW) {
    LAS float* scr = (LAS float*)(lds + X.wave * 8448);
    const float* w_in = X.in[2] + (size_t)layer * DM * IN_COLS;
    const float* w_br = X.in[16] + (size_t)layer * 3 * 512 * DM;
    const float* w_o = X.in[17] + (size_t)layer * DM * DM;
    const float* w_up = X.in[19] + (size_t)layer * DM * F2;
    const float* w_dn = X.in[22] + (size_t)layer * DFF * DM;
    for (int it = it_lo + gw; it < it_hi; it += NGW) {
        int r = it;
        if (r < I_IN) { tr_item(w_in, IN_COLS, DM, 5120, X.Win, 1, r, scr, X.lane); continue; } r -= I_IN;
        if (r < I_G) { tr_item(w_in, IN_COLS, DM, 3072, X.Wg, 2, r, scr, X.lane); continue; } r -= I_G;
        if (r < 3 * I_BR) { const int b = r / I_BR; tr_item(w_br + (size_t)b * 512 * DM, DM, 512, DM, X.Wbr + (size_t)b * DM * 512, 0, r % I_BR, scr, X.lane); continue; } r -= 3 * I_BR;
        if (r < I_O) { tr_item(w_o, DM, DM, DM, X.Wo, 0, r, scr, X.lane); continue; } r -= I_O;
        if (r < I_UP) { tr_item(w_up, F2, DM, F2, X.Wup, 3, r, scr, X.lane); continue; } r -= I_UP;
        tr_item(w_dn, DM, DFF, DM, X.Wdn, 0, r, scr, X.lane);
    }
    const float* h = (layer == 0) ? X.in[0] : X.out;
    const float* g = X.in[1] + (size_t)layer * DM;
    if (do_u) rms_pass(X, h, g, X.P, nullptr);
    if (layer == 0 && it_lo == 0) {
        for (int idx = X.bid * 512 + X.tid; idx < SEQ * 32; idx += X.G * 512) {
            const int t = idx >> 5, p = idx & 31;
            const float inv = exp2f(-(float)p * 0.03125f * 13.287712379549449f);
            const float ang = (float)t * inv;
            const double rev = (double)ang * 0.15915494309189535;
            const float fr = (float)(rev - floor(rev));
            X.ROPE[2 * idx] = __builtin_amdgcn_cosf(fr); X.ROPE[2 * idx + 1] = __builtin_amdgcn_sinf(fr);
        }
    }
}

__device__ __forceinline__ float wave_sum_fast(float x) {
    x = red16(x);
    const float r0 = __builtin_bit_cast(float, __builtin_amdgcn_readlane(__builtin_bit_cast(int, x), 0)), r1 = __builtin_bit_cast(float, __builtin_amdgcn_readlane(__builtin_bit_cast(int, x), 16));
    const float r2 = __builtin_bit_cast(float, __builtin_amdgcn_readlane(__builtin_bit_cast(int, x), 32)), r3 = __builtin_bit_cast(float, __builtin_amdgcn_readlane(__builtin_bit_cast(int, x), 48));
    return (r0 + r1) + (r2 + r3);
}
#define LDS_BAR() do { asm volatile("s_waitcnt lgkmcnt(0)" ::: "memory"); __builtin_amdgcn_s_barrier(); asm volatile("" ::: "memory"); } while (0)
constexpr int RW_TS = 16, RW_NCH = SEQ / RW_TS, RW_BUF = 33280;
__device__ __forceinline__ void phase_rwkv_pre(const Ctx& X, LAS unsigned char* lds, int layer) {
    LAS float* Rr = (LAS float*)(lds);           LAS float* Kk = (LAS float*)(lds + 8192);   LAS float* Vv = (LAS float*)(lds + 16384);
    LAS float* W1 = (LAS float*)(lds + 24576);   LAS float* AS = (LAS float*)(lds + 32768);
    LAS bf16_t* WDb = (LAS bf16_t*)(lds + 40960);
    LAS bf16_t* ADb = (LAS bf16_t*)(lds + 45568);
    LAS bf16_t* WTu = (LAS bf16_t*)(lds + 50176);
    LAS bf16_t* WTa = (LAS bf16_t*)(lds + 59392);
    LAS float* MU = (LAS float*)(lds + 68608);
    const int tid = X.tid, lane = tid & 63, wv = X.wave;
    const float* mu = X.in[3] + layer * 1792;
    const float* w0 = X.in[4] + layer * 512;   const float* w_up = X.in[5] + (size_t)layer * 64 * 512;
    const float* a0 = X.in[6] + layer * 512;   const float* a_up = X.in[7] + (size_t)layer * 64 * 512;
    const float* k_k = X.in[9] + layer * 512;  const float* k_a = X.in[10] + layer * 512;  const float* r_k = X.in[11] + layer * 512;
    const bf16_t* BND = (const bf16_t*)(X.ws + WS_BND);
    float* SCAL = (float*)(X.ws + WS_SCAL);
    const int ln = lane & 15, lg = lane >> 4;
    int last_h = -1;
    float q_w0 = 0.f, q_a0 = 0.f;
    f32x4 p_kk4 = (f32x4){0.f, 0.f, 0.f, 0.f}, p_ka4 = p_kk4, p_rk4 = p_kk4;
    const int cg4 = (tid & 15) * 4;
    u32x4 pc4[3], pp4[3], gc4, gp4; bool have_pf = false;
    pc4[0] = pc4[1] = pc4[2] = pp4[0] = pp4[1] = pp4[2] = gc4 = gp4 = (u32x4){0u, 0u, 0u, 0u};
#define PRE_LOAD(uu) do { const int h_ = (uu) & 7, tp_ = (uu) >> 3; _Pragma("unroll") for (int it = 0; it < 3; ++it) { const int idx = tid + 512 * it; pc4[it] = (u32x4){0u, 0u, 0u, 0u}; pp4[it] = (u32x4){0u, 0u, 0u, 0u}; \
        if (idx < 32 * 40) { const int tt = idx / 40, vv = idx - tt * 40; \
            const int col = vv < 8 ? h_ * 64 + 8 * vv : (vv < 16 ? 512 + h_ * 64 + 8 * (vv - 8) : (vv < 24 ? 1024 + h_ * 64 + 8 * (vv - 16) : 1536 + 8 * (vv - 24))); \
            const size_t row = (size_t)tp_ * 32 + tt; pc4[it] = *(const u32x4*)(X.P + row * LDP + COL_PA + col); \
            if (tt > 0) pp4[it] = *(const u32x4*)(X.P + (row - 1) * LDP + COL_PA + col); else if ((tp_ & 63) != 0) pp4[it] = *(const u32x4*)(BND + (size_t)(2 * tp_ - 1) * 1792 + col); } } \
        if (tid < 64) { const int tt = tid >> 1, col = 1664 + 8 * (2 * h_ + (tid & 1)); const size_t row = (size_t)tp_ * 32 + tt; gc4 = *(const u32x4*)(X.P + row * LDP + COL_PA + col); gp4 = (u32x4){0u, 0u, 0u, 0u}; \
            if (tt > 0) gp4 = *(const u32x4*)(X.P + (row - 1) * LDP + COL_PA + col); else if ((tp_ & 63) != 0) gp4 = *(const u32x4*)(BND + (size_t)(2 * tp_ - 1) * 1792 + col); } } while (0)
#pragma unroll 1
    for (int u = X.bid; u < 4096; u += X.G) {
        const int h = u & 7, tp = u >> 3;
        if (h != last_h) {
            __syncthreads();
            for (int idx = tid; idx < 64 * 64; idx += 512) { const int m = idx >> 6, cc = idx & 63;
                WTu[cc * 72 + m] = (bf16_t)f2bf(w_up[m * 512 + h * 64 + cc]); WTa[cc * 72 + m] = (bf16_t)f2bf(a_up[m * 512 + h * 64 + cc]); }
            if (tid < 320) { const int cc = tid; const int col = cc < 64 ? h * 64 + cc : (cc < 128 ? 512 + h * 64 + cc - 64 : (cc < 192 ? 1024 + h * 64 + cc - 128 : 1536 + cc - 192)); MU[cc] = mu[col]; }
            p_kk4 = *(const f32x4*)(k_k + h * 64 + cg4); p_ka4 = *(const f32x4*)(k_a + h * 64 + cg4); p_rk4 = *(const f32x4*)(r_k + h * 64 + cg4);
            q_w0 = w0[h * 64 + 16 * (wv >> 1) + ln]; q_a0 = a0[h * 64 + 16 * (wv >> 1) + ln];
            last_h = h;
            __syncthreads();
        }
        if (!have_pf) { PRE_LOAD(u); }
#pragma unroll
        for (int it = 0; it < 3; ++it) {
            const int idx = tid + 512 * it;
            if (idx < 32 * 40) {
                const int tt = idx / 40, vv = idx - tt * 40, cc0 = 8 * vv;
                const u32x4 c4 = pc4[it], p4 = pp4[it];
                const f32x4 m0 = *(const LAS f32x4*)&MU[cc0], m1 = *(const LAS f32x4*)&MU[cc0 + 4];
                float cur[8], prv[8], val[8];
                cur[0] = bflo(c4.x); cur[1] = bfhi(c4.x); cur[2] = bflo(c4.y); cur[3] = bfhi(c4.y); cur[4] = bflo(c4.z); cur[5] = bfhi(c4.z); cur[6] = bflo(c4.w); cur[7] = bfhi(c4.w);
                prv[0] = bflo(p4.x); prv[1] = bfhi(p4.x); prv[2] = bflo(p4.y); prv[3] = bfhi(p4.y); prv[4] = bflo(p4.z); prv[5] = bfhi(p4.z); prv[6] = bflo(p4.w); prv[7] = bfhi(p4.w);
#pragma unroll
                for (int e = 0; e < 8; ++e) val[e] = cur[e] + (prv[e] - cur[e]) * (e < 4 ? m0[e & 3] : m1[e & 3]);
                if (vv < 24) {
#pragma unroll
                    for (int e = 0; e < 8; e += 2) { const unsigned w_ = pk2(val[e], val[e + 1]); val[e] = bflo(w_); val[e + 1] = bfhi(w_); }
                    LAS float* dst = (vv < 8 ? Rr : (vv < 16 ? Kk : Vv)) + tt * 64 + 8 * (vv & 7);
                    *(LAS f32x4*)dst = (f32x4){val[0], val[1], val[2], val[3]}; *(LAS f32x4*)(dst + 4) = (f32x4){val[4], val[5], val[6], val[7]};
                } else {
                    const int lr0 = 8 * (vv - 24);
                    LAS bf16_t* dst;
                    if (lr0 < 64) { dst = WDb + tt * 72 + lr0;
#pragma unroll
                        for (int e = 0; e < 8; ++e) { const float ex = __expf(2.f * val[e]); val[e] = 1.f - 2.f / (ex + 1.f); } }
                    else dst = ADb + tt * 72 + lr0 - 64;
                    u32x4 o; o.x = pk2(val[0], val[1]); o.y = pk2(val[2], val[3]); o.z = pk2(val[4], val[5]); o.w = pk2(val[6], val[7]);
                    *(LAS u32x4*)dst = o;
                }
            }
        }
        if (tid < 64) {
            const int tt = tid >> 1, vg = 2 * h + (tid & 1);
            const f32x4 m0 = *(const f32x4*)(mu + 1664 + 8 * vg), m1 = *(const f32x4*)(mu + 1664 + 8 * vg + 4);
            float gc[8], gp[8];
            gc[0] = bflo(gc4.x); gc[1] = bfhi(gc4.x); gc[2] = bflo(gc4.y); gc[3] = bfhi(gc4.y); gc[4] = bflo(gc4.z); gc[5] = bfhi(gc4.z); gc[6] = bflo(gc4.w); gc[7] = bfhi(gc4.w);
            gp[0] = bflo(gp4.x); gp[1] = bfhi(gp4.x); gp[2] = bflo(gp4.y); gp[3] = bfhi(gp4.y); gp[4] = bflo(gp4.z); gp[5] = bfhi(gp4.z); gp[6] = bflo(gp4.w); gp[7] = bfhi(gp4.w);
#pragma unroll
            for (int e = 0; e < 8; ++e) gc[e] = sigmoidf_(gc[e] + (gp[e] - gc[e]) * (e < 4 ? m0[e & 3] : m1[e & 3]));
            u32x4 o; o.x = pk2(gc[0], gc[1]); o.y = pk2(gc[2], gc[3]); o.z = pk2(gc[4], gc[5]); o.w = pk2(gc[6], gc[7]);
            *(u32x4*)(X.P + ((size_t)tp * 32 + tt) * LDP + COL_GS + 8 * vg) = o;
        }
        have_pf = false;
        if (u + X.G < 4096 && ((u + X.G) & 7) == h) { PRE_LOAD(u + X.G); have_pf = true; }
        LDS_BAR();
        {
            const int mt = wv & 1, nt = wv >> 1, chm = 16 * nt + ln;
            f32x4 cw_ = (f32x4){0.f, 0.f, 0.f, 0.f}, ca_ = cw_;
#pragma unroll
            for (int ks = 0; ks < 2; ++ks) {
                const bf16x8 xa = *(const LAS bf16x8*)&WDb[(16 * mt + ln) * 72 + ks * 32 + 8 * lg], xb = *(const LAS bf16x8*)&WTu[(16 * nt + ln) * 72 + ks * 32 + 8 * lg];
                cw_ = __builtin_amdgcn_mfma_f32_16x16x32_bf16(xa, xb, cw_, 0, 0, 0);
                const bf16x8 ya = *(const LAS bf16x8*)&ADb[(16 * mt + ln) * 72 + ks * 32 + 8 * lg], yb = *(const LAS bf16x8*)&WTa[(16 * nt + ln) * 72 + ks * 32 + 8 * lg];
                ca_ = __builtin_amdgcn_mfma_f32_16x16x32_bf16(ya, yb, ca_, 0, 0, 0);
            }
#pragma unroll
            for (int r = 0; r < 4; ++r) {
                const int tt = 16 * mt + 4 * lg + r;
                const float z = -(q_w0 + cw_[r]);
                const float sp = fmaxf(z, 0.f) + __logf(1.f + __expf(-fabsf(z)));
                const float e = __expf(-sp - 0.5f);
                W1[tt * 64 + chm] = bf2f((bf16_t)f2bf(-expm1f(-e)));
                AS[tt * 64 + chm] = bf2f((bf16_t)f2bf(sigmoidf_(q_a0 + ca_[r])));
            }
        }
        LDS_BAR();
        {
            const int tt = tid >> 4;
            const size_t row = (size_t)tp * 32 + tt;
            const f32x4 w1 = *(const LAS f32x4*)&W1[tt * 64 + cg4], a = *(const LAS f32x4*)&AS[tt * 64 + cg4];
            const f32x4 kraw = *(const LAS f32x4*)&Kk[tt * 64 + cg4], r = *(const LAS f32x4*)&Rr[tt * 64 + cg4], v = *(const LAS f32x4*)&Vv[tt * 64 + cg4];
            const f32x4 kk0 = kraw * p_kk4;
            const float inv = 1.f / sqrtf(fmaxf(red16((kk0.x * kk0.x + kk0.y * kk0.y) + (kk0.z * kk0.z + kk0.w * kk0.w)), 1e-24f));
            const f32x4 kk = kk0 * inv;
            const f32x4 kmod = kraw * (1.f + (a - 1.f) * p_ka4);
            const f32x4 bvec = kk * a, t1 = bvec * r, t2 = kmod * r, t3 = t2 * p_rk4;
            const float br = red16((t1.x + t1.y) + (t1.z + t1.w)), kr = red16((t2.x + t2.y) + (t2.z + t2.w)), bonus = red16((t3.x + t3.y) + (t3.z + t3.w));
            bf16_t* rp_ = X.P + row * LDP;
            u32x2 o;
            o.x = pk2(r.x, r.y); o.y = pk2(r.z, r.w); *(u32x2*)(rp_ + COL_PA + h * 64 + cg4) = o;
            o.x = pk2(kraw.x, kraw.y); o.y = pk2(kraw.z, kraw.w); *(u32x2*)(rp_ + COL_PA + 512 + h * 64 + cg4) = o;
            o.x = pk2(v.x, v.y); o.y = pk2(v.z, v.w); *(u32x2*)(rp_ + COL_PA + 1024 + h * 64 + cg4) = o;
            bf16_t* wa_ = (layer == 0) ? (bf16_t*)X.out + row * 2048 : rp_;
            o.x = pk2(w1.x, w1.y); o.y = pk2(w1.z, w1.w); *(u32x2*)(wa_ + h * 64 + cg4) = o;
            o.x = pk2(a.x, a.y); o.y = pk2(a.z, a.w); *(u32x2*)(wa_ + 512 + h * 64 + cg4) = o;
            if (cg4 == 0) *(f32x4*)(SCAL + (row * 8 + h) * 4) = (f32x4){inv, br, kr, bonus};
        }
        LDS_BAR();
    }
}

__device__ __forceinline__ void rwkv_task(const Ctx& X, LAS unsigned char* lds, int layer, int b, int h) {
    LAS bf16_t* GDb = (LAS bf16_t*)(lds + 66560);
    LAS bf16_t* WTg = (LAS bf16_t*)(lds + 75264);
    LAS float* BON = (LAS float*)(lds + 92672);
    const int tid = X.tid, lane = tid & 63;
    const bool helper = X.wave >= 4;
    const int ht = tid & 255;
    const float* mu = X.in[3] + layer * 1792;
    const float* g_up = X.in[8] + (size_t)layer * 128 * 512;
    const float* k_k = X.in[9] + layer * 512;  const float* k_a = X.in[10] + layer * 512;
    const float* gn_g = X.in[12] + layer * 512; const float* gn_b = X.in[13] + layer * 512;
    const float* SCAL = (const float*)(X.ws + WS_SCAL);
    const int tt_h = ht >> 4, cg4 = (ht & 15) * 4;
    const f32x4 p_kk = *(const f32x4*)(k_k + h * 64 + cg4), p_ka = *(const f32x4*)(k_a + h * 64 + cg4);
    const f32x4 p_gg = *(const f32x4*)(gn_g + h * 64 + cg4), p_gb = *(const f32x4*)(gn_b + h * 64 + cg4);
    const int gv8 = (ht & 15) * 8;
    const int nt = (ht >> 6), ln = lane & 15, lg = lane >> 4, chm = 16 * nt + ln;
    const int rp = ht >> 3, jg = ht & 7, i0 = 2 * rp;
    for (int idx = tid; idx < 128 * 64; idx += 512) { const int m = idx >> 6, cc = idx & 63; WTg[cc * 136 + m] = (bf16_t)f2bf(g_up[m * 512 + h * 64 + cc]); }
    f32x2 S0[4], S1[4];
#pragma unroll
    for (int j = 0; j < 4; ++j) { S0[j] = (f32x2){0.f, 0.f}; S1[j] = (f32x2){0.f, 0.f}; }
#if PROBE_SCAN2
    f32x2 T0[4], T1[4];
#pragma unroll
    for (int j = 0; j < 4; ++j) { T0[j] = (f32x2){0.f, 0.f}; T1[j] = (f32x2){0.f, 0.f}; }
#endif
    __syncthreads();

#define RW_ARR(bufi, k) ((LAS float*)(lds + (bufi) * RW_BUF + (k) * 4096))
#define RW_SC(bufi) ((LAS float*)(lds + (bufi) * RW_BUF + 32768))
#define RW_LOAD(chk, L) do { const size_t row_ = (size_t)b * SEQ + (chk) * RW_TS + tt_h; const bf16_t* rp_ = X.P + row_ * LDP; \
        l_r##L = *(const u32x2*)(rp_ + COL_PA + h * 64 + cg4); l_k##L = *(const u32x2*)(rp_ + COL_PA + 512 + h * 64 + cg4); l_v##L = *(const u32x2*)(rp_ + COL_PA + 1024 + h * 64 + cg4); \
        { const bf16_t* wa_ = (layer == 0) ? (const bf16_t*)X.out + row_ * 2048 : rp_; l_w##L = *(const u32x2*)(wa_ + h * 64 + cg4); l_a##L = *(const u32x2*)(wa_ + 512 + h * 64 + cg4); } l_s##L = *(const f32x4*)(SCAL + (row_ * 8 + h) * 4); \
        l_gc##L = *(const u32x4*)(rp_ + COL_GS + gv8); } while (0)
    u32x2 l_rA, l_kA, l_vA, l_wA, l_aA; f32x4 l_sA; u32x4 l_gcA;
    u32x2 l_rB, l_kB, l_vB, l_wB, l_aB; f32x4 l_sB; u32x4 l_gcB;
    l_rA = l_kA = l_vA = l_wA = l_aA = l_rB = l_kB = l_vB = l_wB = l_aB = (u32x2){0u, 0u}; l_sA = l_sB = (f32x4){0.f, 0.f, 0.f, 0.f}; l_gcA = l_gcB = (u32x4){0u, 0u, 0u, 0u};
    if (helper) { RW_LOAD(0, A); RW_LOAD(1, B); }

#pragma unroll 1
    for (int i0_ = -1; i0_ < RW_NCH; i0_ += 2) {
        { const int i = i0_;

        const int bufn = (i + 1) & 1, bufc = i & 1;
        if (helper) {
            const bool do_prep = (i + 1 < RW_NCH);
            if (i >= 0) {
                LAS float* Gg = RW_ARR(bufc, 6);
                f32x4 cg_ = (f32x4){0.f, 0.f, 0.f, 0.f};
#pragma unroll
                for (int ks = 0; ks < 4; ++ks) {
                    const bf16x8 za = *(const LAS bf16x8*)&GDb[bufc * 2176 + ln * 136 + ks * 32 + 8 * lg], zb = *(const LAS bf16x8*)&WTg[(16 * nt + ln) * 136 + ks * 32 + 8 * lg];
                    cg_ = __builtin_amdgcn_mfma_f32_16x16x32_bf16(za, zb, cg_, 0, 0, 0);
                }
#pragma unroll
                for (int r = 0; r < 4; ++r) Gg[(4 * lg + r) * 64 + chm] = cg_[r];
            }
            if (i >= 1) {
                LAS float* Yy = RW_ARR(bufn, 7); LAS float* Gg = RW_ARR(bufn, 6); LAS float* Vv = RW_ARR(bufn, 5); LAS float* SC = RW_SC(bufn);
                const f32x4 y = *(const LAS f32x4*)&Yy[tt_h * 64 + cg4], gg = *(const LAS f32x4*)&Gg[tt_h * 64 + cg4], vv = *(const LAS f32x4*)&Vv[tt_h * 64 + cg4];
                const float bonus = BON[((i - 1) % 3) * 16 + tt_h];
                const float mean = red16((y.x + y.y) + (y.z + y.w)) * (1.f / 64.f);
                const f32x4 d = y - mean;
                const float var = red16((d.x * d.x + d.y * d.y) + (d.z * d.z + d.w * d.w)) * (1.f / 64.f);
                const float rs = 1.f / sqrtf(var + 64e-5f);
                const f32x4 o = (d * rs * p_gg + p_gb + vv * bonus) * gg;
                u32x2 w; w.x = pk2(o.x, o.y); w.y = pk2(o.z, o.w);
                *(u32x2*)(X.P + ((size_t)b * SEQ + (i - 1) * RW_TS + tt_h) * LDP + COL_YA + h * 64 + cg4) = w;
            }
            if (do_prep) {
                const f32x4 r = (f32x4){bflo(l_rA.x), bfhi(l_rA.x), bflo(l_rA.y), bfhi(l_rA.y)}, k = (f32x4){bflo(l_kA.x), bfhi(l_kA.x), bflo(l_kA.y), bfhi(l_kA.y)};
                const f32x4 v = (f32x4){bflo(l_vA.x), bfhi(l_vA.x), bflo(l_vA.y), bfhi(l_vA.y)}, w1 = (f32x4){bflo(l_wA.x), bfhi(l_wA.x), bflo(l_wA.y), bfhi(l_wA.y)};
                const f32x4 a = (f32x4){bflo(l_aA.x), bfhi(l_aA.x), bflo(l_aA.y), bfhi(l_aA.y)};
                const f32x4 kk = k * p_kk * l_sA.x;
                const f32x4 decay = 1.f - w1;
                *(LAS f32x4*)&RW_ARR(bufn, 0)[tt_h * 64 + cg4] = -kk;
                *(LAS f32x4*)&RW_ARR(bufn, 1)[tt_h * 64 + cg4] = decay * r;
                *(LAS f32x4*)&RW_ARR(bufn, 2)[tt_h * 64 + cg4] = decay;
                *(LAS f32x4*)&RW_ARR(bufn, 3)[tt_h * 64 + cg4] = kk * a;
                *(LAS f32x4*)&RW_ARR(bufn, 4)[tt_h * 64 + cg4] = k * (1.f + (a - 1.f) * p_ka);
                *(LAS f32x4*)&RW_ARR(bufn, 5)[tt_h * 64 + cg4] = v;
                if (cg4 == 0) { LAS float* SC = RW_SC(bufn); SC[tt_h * 4 + 0] = l_sA.y; SC[tt_h * 4 + 1] = l_sA.z; BON[((i + 1) % 3) * 16 + tt_h] = l_sA.w; }
                *(LAS u32x4*)&GDb[bufn * 2176 + tt_h * 136 + gv8] = l_gcA;
            }
            if (i + 3 < RW_NCH) RW_LOAD(i + 3, A);
            LDS_BAR();
        } else {
            LAS float* A_ = RW_ARR(bufc, 0); LAS float* WR = RW_ARR(bufc, 1); LAS float* Wd = RW_ARR(bufc, 2); LAS float* Bv = RW_ARR(bufc, 3);
            LAS float* Kk = RW_ARR(bufc, 4); LAS float* Vv = RW_ARR(bufc, 5); LAS float* Yy = RW_ARR(bufc, 7); LAS float* SC = RW_SC(bufc);
#pragma unroll 1
            for (int q4 = 0; q4 < 4; ++q4) {
                if (i >= 0) {
                    float yv[8];
#pragma unroll
                    for (int s4 = 0; s4 < 4; ++s4) {
                        const int tt = 4 * q4 + s4;
                        const f32x4 a_lo = *(const LAS f32x4*)&A_[tt * 64 + 8 * jg], a_hi = *(const LAS f32x4*)&A_[tt * 64 + 8 * jg + 4];
                        const f32x4 r_lo = *(const LAS f32x4*)&WR[tt * 64 + 8 * jg], r_hi = *(const LAS f32x4*)&WR[tt * 64 + 8 * jg + 4];
                        const f32x4 w_lo = *(const LAS f32x4*)&Wd[tt * 64 + 8 * jg], w_hi = *(const LAS f32x4*)&Wd[tt * 64 + 8 * jg + 4];
                        const f32x4 b_lo = *(const LAS f32x4*)&Bv[tt * 64 + 8 * jg], b_hi = *(const LAS f32x4*)&Bv[tt * 64 + 8 * jg + 4];
                        const f32x4 k_lo = *(const LAS f32x4*)&Kk[tt * 64 + 8 * jg], k_hi = *(const LAS f32x4*)&Kk[tt * 64 + 8 * jg + 4];
                        const f32x2 vv = *(const LAS f32x2*)&Vv[tt * 64 + i0];
                        const f32x2 sc = *(const LAS f32x2*)&SC[tt * 4];
                        const f32x2 av[4] = {{a_lo.x, a_lo.y}, {a_lo.z, a_lo.w}, {a_hi.x, a_hi.y}, {a_hi.z, a_hi.w}};
                        const f32x2 rv[4] = {{r_lo.x, r_lo.y}, {r_lo.z, r_lo.w}, {r_hi.x, r_hi.y}, {r_hi.z, r_hi.w}};
                        const f32x2 wv[4] = {{w_lo.x, w_lo.y}, {w_lo.z, w_lo.w}, {w_hi.x, w_hi.y}, {w_hi.z, w_hi.w}};
                        const f32x2 bv[4] = {{b_lo.x, b_lo.y}, {b_lo.z, b_lo.w}, {b_hi.x, b_hi.y}, {b_hi.z, b_hi.w}};
                        const f32x2 kv[4] = {{k_lo.x, k_lo.y}, {k_lo.z, k_lo.w}, {k_hi.x, k_hi.y}, {k_hi.z, k_hi.w}};
                        f32x2 e10 = S0[0] * av[0], e20 = S0[0] * rv[0], e11 = S1[0] * av[0], e21 = S1[0] * rv[0];
#pragma unroll
                        for (int j = 1; j < 4; ++j) { e10 += S0[j] * av[j]; e20 += S0[j] * rv[j]; e11 += S1[j] * av[j]; e21 += S1[j] * rv[j]; }
                        const float d10 = red8(e10.x + e10.y), d11 = red8(e11.x + e11.y);
                        yv[2 * s4] = (e20.x + e20.y) + (jg == 0 ? d10 * sc.x + vv.x * sc.y : 0.f); yv[2 * s4 + 1] = (e21.x + e21.y) + (jg == 0 ? d11 * sc.x + vv.y * sc.y : 0.f);
                        const f32x2 d10v = (f32x2){d10, d10}, d11v = (f32x2){d11, d11}, v0v = (f32x2){vv.x, vv.x}, v1v = (f32x2){vv.y, vv.y};
#pragma unroll
                        for (int j = 0; j < 4; ++j) { S0[j] = S0[j] * wv[j] + (d10v * bv[j] + v0v * kv[j]); S1[j] = S1[j] * wv[j] + (d11v * bv[j] + v1v * kv[j]); }
                    }
                    {
                        const bool t2 = (jg & 4) != 0, t1 = (jg & 2) != 0, t0 = (jg & 1) != 0;
#pragma unroll
                        for (int q = 0; q < 4; ++q) { const float keep = t2 ? yv[q + 4] : yv[q], send = t2 ? yv[q] : yv[q + 4]; yv[q] = keep + dpp_mov<0x141>(send); }
#pragma unroll
                        for (int q = 0; q < 2; ++q) { const float keep = t1 ? yv[q + 2] : yv[q], send = t1 ? yv[q] : yv[q + 2]; yv[q] = keep + dpp_mov<0x4E>(send); }
                        { const float keep = t0 ? yv[1] : yv[0], send = t0 ? yv[0] : yv[1]; yv[0] = keep + dpp_mov<0xB1>(send); }
                        Yy[(4 * q4 + (jg >> 1)) * 64 + i0 + (jg & 1)] = yv[0];
                    }

#if PROBE_SCAN2
                    {
#pragma unroll
                    for (int s4 = 0; s4 < 4; ++s4) {
                        const int tt = 4 * q4 + s4;
                        const f32x4 a_lo = *(const LAS f32x4*)&A_[tt * 64 + 8 * jg], a_hi = *(const LAS f32x4*)&A_[tt * 64 + 8 * jg + 4];
                        const f32x4 r_lo = *(const LAS f32x4*)&WR[tt * 64 + 8 * jg], r_hi = *(const LAS f32x4*)&WR[tt * 64 + 8 * jg + 4];
                        const f32x4 w_lo = *(const LAS f32x4*)&Wd[tt * 64 + 8 * jg], w_hi = *(const LAS f32x4*)&Wd[tt * 64 + 8 * jg + 4];
                        const f32x4 b_lo = *(const LAS f32x4*)&Bv[tt * 64 + 8 * jg], b_hi = *(const LAS f32x4*)&Bv[tt * 64 + 8 * jg + 4];
                        const f32x4 k_lo = *(const LAS f32x4*)&Kk[tt * 64 + 8 * jg], k_hi = *(const LAS f32x4*)&Kk[tt * 64 + 8 * jg + 4];
                        const f32x2 vv = *(const LAS f32x2*)&Vv[tt * 64 + i0];
                        const f32x2 av[4] = {{a_lo.x, a_lo.y}, {a_lo.z, a_lo.w}, {a_hi.x, a_hi.y}, {a_hi.z, a_hi.w}};
                        const f32x2 rv[4] = {{r_lo.x, r_lo.y}, {r_lo.z, r_lo.w}, {r_hi.x, r_hi.y}, {r_hi.z, r_hi.w}};
                        const f32x2 wv[4] = {{w_lo.x, w_lo.y}, {w_lo.z, w_lo.w}, {w_hi.x, w_hi.y}, {w_hi.z, w_hi.w}};
                        const f32x2 bv[4] = {{b_lo.x, b_lo.y}, {b_lo.z, b_lo.w}, {b_hi.x, b_hi.y}, {b_hi.z, b_hi.w}};
                        const f32x2 kv[4] = {{k_lo.x, k_lo.y}, {k_lo.z, k_lo.w}, {k_hi.x, k_hi.y}, {k_hi.z, k_hi.w}};
                        f32x2 e10 = T0[0] * av[0], e20 = T0[0] * rv[0], e11 = T1[0] * av[0], e21 = T1[0] * rv[0];
#pragma unroll
                        for (int j = 1; j < 4; ++j) { e10 += T0[j] * av[j]; e20 += T0[j] * rv[j]; e11 += T1[j] * av[j]; e21 += T1[j] * rv[j]; }
                        const float d10 = red8(e10.x + e10.y), d20 = red8(e20.x + e20.y), d11 = red8(e11.x + e11.y), d21 = red8(e21.x + e21.y);
                        const f32x2 d10v = (f32x2){d10 + d20, d10}, d11v = (f32x2){d11 + d21, d11}, v0v = (f32x2){vv.x, vv.x}, v1v = (f32x2){vv.y, vv.y};
#pragma unroll
                        for (int j = 0; j < 4; ++j) { T0[j] = T0[j] * wv[j] + (d10v * bv[j] + v0v * kv[j]); T1[j] = T1[j] * wv[j] + (d11v * bv[j] + v1v * kv[j]); }
                    }
                    }
#endif
                }
                if (q4 == 3) LDS_BAR();
            }
        }
            }
        if (i0_ + 1 < RW_NCH) { const int i = i0_ + 1;

        const int bufn = (i + 1) & 1, bufc = i & 1;
        if (helper) {
            const bool do_prep = (i + 1 < RW_NCH);
            if (i >= 0) {
                LAS float* Gg = RW_ARR(bufc, 6);
                f32x4 cg_ = (f32x4){0.f, 0.f, 0.f, 0.f};
#pragma unroll
                for (int ks = 0; ks < 4; ++ks) {
                    const bf16x8 za = *(const LAS bf16x8*)&GDb[bufc * 2176 + ln * 136 + ks * 32 + 8 * lg], zb = *(const LAS bf16x8*)&WTg[(16 * nt + ln) * 136 + ks * 32 + 8 * lg];
                    cg_ = __builtin_amdgcn_mfma_f32_16x16x32_bf16(za, zb, cg_, 0, 0, 0);
                }
#pragma unroll
                for (int r = 0; r < 4; ++r) Gg[(4 * lg + r) * 64 + chm] = cg_[r];
            }
            if (i >= 1) {
                LAS float* Yy = RW_ARR(bufn, 7); LAS float* Gg = RW_ARR(bufn, 6); LAS float* Vv = RW_ARR(bufn, 5); LAS float* SC = RW_SC(bufn);
                const f32x4 y = *(const LAS f32x4*)&Yy[tt_h * 64 + cg4], gg = *(const LAS f32x4*)&Gg[tt_h * 64 + cg4], vv = *(const LAS f32x4*)&Vv[tt_h * 64 + cg4];
                const float bonus = BON[((i - 1) % 3) * 16 + tt_h];
                const float mean = red16((y.x + y.y) + (y.z + y.w)) * (1.f / 64.f);
                const f32x4 d = y - mean;
                const float var = red16((d.x * d.x + d.y * d.y) + (d.z * d.z + d.w * d.w)) * (1.f / 64.f);
                const float rs = 1.f / sqrtf(var + 64e-5f);
                const f32x4 o = (d * rs * p_gg + p_gb + vv * bonus) * gg;
                u32x2 w; w.x = pk2(o.x, o.y); w.y = pk2(o.z, o.w);
                *(u32x2*)(X.P + ((size_t)b * SEQ + (i - 1) * RW_TS + tt_h) * LDP + COL_YA + h * 64 + cg4) = w;
            }
            if (do_prep) {
                const f32x4 r = (f32x4){bflo(l_rB.x), bfhi(l_rB.x), bflo(l_rB.y), bfhi(l_rB.y)}, k = (f32x4){bflo(l_kB.x), bfhi(l_kB.x), bflo(l_kB.y), bfhi(l_kB.y)};
                const f32x4 v = (f32x4){bflo(l_vB.x), bfhi(l_vB.x), bflo(l_vB.y), bfhi(l_vB.y)}, w1 = (f32x4){bflo(l_wB.x), bfhi(l_wB.x), bflo(l_wB.y), bfhi(l_wB.y)};
                const f32x4 a = (f32x4){bflo(l_aB.x), bfhi(l_aB.x), bflo(l_aB.y), bfhi(l_aB.y)};
                const f32x4 kk = k * p_kk * l_sB.x;
                const f32x4 decay = 1.f - w1;
                *(LAS f32x4*)&RW_ARR(bufn, 0)[tt_h * 64 + cg4] = -kk;
                *(LAS f32x4*)&RW_ARR(bufn, 1)[tt_h * 64 + cg4] = decay * r;
                *(LAS f32x4*)&RW_ARR(bufn, 2)[tt_h * 64 + cg4] = decay;
                *(LAS f32x4*)&RW_ARR(bufn, 3)[tt_h * 64 + cg4] = kk * a;
                *(LAS f32x4*)&RW_ARR(bufn, 4)[tt_h * 64 + cg4] = k * (1.f + (a - 1.f) * p_ka);
                *(LAS f32x4*)&RW_ARR(bufn, 5)[tt_h * 64 + cg4] = v;
                if (cg4 == 0) { LAS float* SC = RW_SC(bufn); SC[tt_h * 4 + 0] = l_sB.y; SC[tt_h * 4 + 1] = l_sB.z; BON[((i + 1) % 3) * 16 + tt_h] = l_sB.w; }
                *(LAS u32x4*)&GDb[bufn * 2176 + tt_h * 136 + gv8] = l_gcB;
            }
            if (i + 3 < RW_NCH) RW_LOAD(i + 3, B);
            LDS_BAR();
        } else {
            LAS float* A_ = RW_ARR(bufc, 0); LAS float* WR = RW_ARR(bufc, 1); LAS float* Wd = RW_ARR(bufc, 2); LAS float* Bv = RW_ARR(bufc, 3);
            LAS float* Kk = RW_ARR(bufc, 4); LAS float* Vv = RW_ARR(bufc, 5); LAS float* Yy = RW_ARR(bufc, 7); LAS float* SC = RW_SC(bufc);
#pragma unroll 1
            for (int q4 = 0; q4 < 4; ++q4) {
                if (i >= 0) {
                    float yv[8];
#pragma unroll
                    for (int s4 = 0; s4 < 4; ++s4) {
                        const int tt = 4 * q4 + s4;
                        const f32x4 a_lo = *(const LAS f32x4*)&A_[tt * 64 + 8 * jg], a_hi = *(const LAS f32x4*)&A_[tt * 64 + 8 * jg + 4];
                        const f32x4 r_lo = *(const LAS f32x4*)&WR[tt * 64 + 8 * jg], r_hi = *(const LAS f32x4*)&WR[tt * 64 + 8 * jg + 4];
                        const f32x4 w_lo = *(const LAS f32x4*)&Wd[tt * 64 + 8 * jg], w_hi = *(const LAS f32x4*)&Wd[tt * 64 + 8 * jg + 4];
                        const f32x4 b_lo = *(const LAS f32x4*)&Bv[tt * 64 + 8 * jg], b_hi = *(const LAS f32x4*)&Bv[tt * 64 + 8 * jg + 4];
                        const f32x4 k_lo = *(const LAS f32x4*)&Kk[tt * 64 + 8 * jg], k_hi = *(const LAS f32x4*)&Kk[tt * 64 + 8 * jg + 4];
                        const f32x2 vv = *(const LAS f32x2*)&Vv[tt * 64 + i0];
                        const f32x2 sc = *(const LAS f32x2*)&SC[tt * 4];
                        const f32x2 av[4] = {{a_lo.x, a_lo.y}, {a_lo.z, a_lo.w}, {a_hi.x, a_hi.y}, {a_hi.z, a_hi.w}};
                        const f32x2 rv[4] = {{r_lo.x, r_lo.y}, {r_lo.z, r_lo.w}, {r_hi.x, r_hi.y}, {r_hi.z, r_hi.w}};
                        const f32x2 wv[4] = {{w_lo.x, w_lo.y}, {w_lo.z, w_lo.w}, {w_hi.x, w_hi.y}, {w_hi.z, w_hi.w}};
                        const f32x2 bv[4] = {{b_lo.x, b_lo.y}, {b_lo.z, b_lo.w}, {b_hi.x, b_hi.y}, {b_hi.z, b_hi.w}};
                        const f32x2 kv[4] = {{k_lo.x, k_lo.y}, {k_lo.z, k_lo.w}, {k_hi.x, k_hi.y}, {k_hi.z, k_hi.w}};
                        f32x2 e10 = S0[0] * av[0], e20 = S0[0] * rv[0], e11 = S1[0] * av[0], e21 = S1[0] * rv[0];
#pragma unroll
                        for (int j = 1; j < 4; ++j) { e10 += S0[j] * av[j]; e20 += S0[j] * rv[j]; e11 += S1[j] * av[j]; e21 += S1[j] * rv[j]; }
                        const float d10 = red8(e10.x + e10.y), d11 = red8(e11.x + e11.y);
                        yv[2 * s4] = (e20.x + e20.y) + (jg == 0 ? d10 * sc.x + vv.x * sc.y : 0.f); yv[2 * s4 + 1] = (e21.x + e21.y) + (jg == 0 ? d11 * sc.x + vv.y * sc.y : 0.f);
                        const f32x2 d10v = (f32x2){d10, d10}, d11v = (f32x2){d11, d11}, v0v = (f32x2){vv.x, vv.x}, v1v = (f32x2){vv.y, vv.y};
#pragma unroll
                        for (int j = 0; j < 4; ++j) { S0[j] = S0[j] * wv[j] + (d10v * bv[j] + v0v * kv[j]); S1[j] = S1[j] * wv[j] + (d11v * bv[j] + v1v * kv[j]); }
                    }
                    {
                        const bool t2 = (jg & 4) != 0, t1 = (jg & 2) != 0, t0 = (jg & 1) != 0;
#pragma unroll
                        for (int q = 0; q < 4; ++q) { const float keep = t2 ? yv[q + 4] : yv[q], send = t2 ? yv[q] : yv[q + 4]; yv[q] = keep + dpp_mov<0x141>(send); }
#pragma unroll
                        for (int q = 0; q < 2; ++q) { const float keep = t1 ? yv[q + 2] : yv[q], send = t1 ? yv[q] : yv[q + 2]; yv[q] = keep + dpp_mov<0x4E>(send); }
                        { const float keep = t0 ? yv[1] : yv[0], send = t0 ? yv[0] : yv[1]; yv[0] = keep + dpp_mov<0xB1>(send); }
                        Yy[(4 * q4 + (jg >> 1)) * 64 + i0 + (jg & 1)] = yv[0];
                    }

#if PROBE_SCAN2
                    {
#pragma unroll
                    for (int s4 = 0; s4 < 4; ++s4) {
                        const int tt = 4 * q4 + s4;
                        const f32x4 a_lo = *(const LAS f32x4*)&A_[tt * 64 + 8 * jg], a_hi = *(const LAS f32x4*)&A_[tt * 64 + 8 * jg + 4];
                        const f32x4 r_lo = *(const LAS f32x4*)&WR[tt * 64 + 8 * jg], r_hi = *(const LAS f32x4*)&WR[tt * 64 + 8 * jg + 4];
                        const f32x4 w_lo = *(const LAS f32x4*)&Wd[tt * 64 + 8 * jg], w_hi = *(const LAS f32x4*)&Wd[tt * 64 + 8 * jg + 4];
                        const f32x4 b_lo = *(const LAS f32x4*)&Bv[tt * 64 + 8 * jg], b_hi = *(const LAS f32x4*)&Bv[tt * 64 + 8 * jg + 4];
                        const f32x4 k_lo = *(const LAS f32x4*)&Kk[tt * 64 + 8 * jg], k_hi = *(const LAS f32x4*)&Kk[tt * 64 + 8 * jg + 4];
                        const f32x2 vv = *(const LAS f32x2*)&Vv[tt * 64 + i0];
                        const f32x2 av[4] = {{a_lo.x, a_lo.y}, {a_lo.z, a_lo.w}, {a_hi.x, a_hi.y}, {a_hi.z, a_hi.w}};
                        const f32x2 rv[4] = {{r_lo.x, r_lo.y}, {r_lo.z, r_lo.w}, {r_hi.x, r_hi.y}, {r_hi.z, r_hi.w}};
                        const f32x2 wv[4] = {{w_lo.x, w_lo.y}, {w_lo.z, w_lo.w}, {w_hi.x, w_hi.y}, {w_hi.z, w_hi.w}};
                        const f32x2 bv[4] = {{b_lo.x, b_lo.y}, {b_lo.z, b_lo.w}, {b_hi.x, b_hi.y}, {b_hi.z, b_hi.w}};
                        const f32x2 kv[4] = {{k_lo.x, k_lo.y}, {k_lo.z, k_lo.w}, {k_hi.x, k_hi.y}, {k_hi.z, k_hi.w}};
                        f32x2 e10 = T0[0] * av[0], e20 = T0[0] * rv[0], e11 = T1[0] * av[0], e21 = T1[0] * rv[0];
#pragma unroll
                        for (int j = 1; j < 4; ++j) { e10 += T0[j] * av[j]; e20 += T0[j] * rv[j]; e11 += T1[j] * av[j]; e21 += T1[j] * rv[j]; }
                        const float d10 = red8(e10.x + e10.y), d20 = red8(e20.x + e20.y), d11 = red8(e11.x + e11.y), d21 = red8(e21.x + e21.y);
                        const f32x2 d10v = (f32x2){d10 + d20, d10}, d11v = (f32x2){d11 + d21, d11}, v0v = (f32x2){vv.x, vv.x}, v1v = (f32x2){vv.y, vv.y};
#pragma unroll
                        for (int j = 0; j < 4; ++j) { T0[j] = T0[j] * wv[j] + (d10v * bv[j] + v0v * kv[j]); T1[j] = T1[j] * wv[j] + (d11v * bv[j] + v1v * kv[j]); }
                    }
                    }
#endif
                }
                if (q4 == 3) LDS_BAR();
            }
        }
            }
    }
    if (helper) {
        const int bufl = (RW_NCH - 1) & 1;
        LAS float* Yy = RW_ARR(bufl, 7); LAS float* Gg = RW_ARR(bufl, 6); LAS float* Vv = RW_ARR(bufl, 5); LAS float* SC = RW_SC(bufl);
        const f32x4 y = *(const LAS f32x4*)&Yy[tt_h * 64 + cg4], gg = *(const LAS f32x4*)&Gg[tt_h * 64 + cg4], vv = *(const LAS f32x4*)&Vv[tt_h * 64 + cg4];
        const float bonus = BON[((RW_NCH - 1) % 3) * 16 + tt_h];
        const float mean = red16((y.x + y.y) + (y.z + y.w)) * (1.f / 64.f);
        const f32x4 d = y - mean;
        const float var = red16((d.x * d.x + d.y * d.y) + (d.z * d.z + d.w * d.w)) * (1.f / 64.f);
        const float rs = 1.f / sqrtf(var + 64e-5f);
        const f32x4 o = (d * rs * p_gg + p_gb + vv * bonus) * gg;
        u32x2 w; w.x = pk2(o.x, o.y); w.y = pk2(o.z, o.w);
        *(u32x2*)(X.P + ((size_t)b * SEQ + (RW_NCH - 1) * RW_TS + tt_h) * LDP + COL_YA + h * 64 + cg4) = w;
    }
    __syncthreads();
#undef RW_ARR
#undef RW_SC
#undef RW_LOAD
}

__device__ __forceinline__ void hgrn_task(const Ctx& X, LAS unsigned char* lds, int layer, int b, int h, int vh) {
    LAS float* F = (LAS float*)(lds); LAS float* Q = (LAS float*)(lds + 16384); LAS float* Vv = (LAS float*)(lds + 32768); LAS float* O = (LAS float*)(lds + 40960);
    LAS float* LB = (LAS float*)(lds + 49152);
    const int tid = X.tid;
    const float* lbl = X.in[14];
    const int rp = tid >> 4, dg = tid & 15, v0 = 2 * rp;
    if (tid < 128) LB[tid] = (layer > 0) ? 1.f / (1.f + __expf(lbl[h * 128 + tid] - lbl[512 + h * 128 + tid])) : 0.f;
    f32x2 S0[4], S1[4];
#pragma unroll
    for (int j = 0; j < 4; ++j) { S0[j] = (f32x2){0.f, 0.f}; S1[j] = (f32x2){0.f, 0.f}; }
#define HG_LOAD(chk) do { _Pragma("unroll") for (int it = 0; it < 3; ++it) { const int idx = tid + 512 * it; raw[it] = (u32x4){0u, 0u, 0u, 0u}; \
        if (idx < 32 * 40) { const int tt = idx / 40, vv = idx - tt * 40; \
            const int col = vv < 16 ? 512 + h * 128 + 8 * vv : (vv < 32 ? h * 128 + 8 * (vv - 16) : 1024 + h * 128 + vh * 64 + 8 * (vv - 32)); \
            raw[it] = *(const u32x4*)(X.P + ((size_t)b * SEQ + (chk) * 32 + tt) * LDP + COL_PB + col); } } } while (0)
    u32x4 raw[3];
    HG_LOAD(0);
    __syncthreads();
#pragma unroll 1
    for (int ch = 0; ch < SEQ / 32; ++ch) {
        const int t0 = ch * 32;
#pragma unroll
        for (int it = 0; it < 3; ++it) {
            const int idx = tid + 512 * it;
            if (idx < 32 * 40) {
                const int tt = idx / 40, vv = idx - tt * 40;
                float x[8];
                x[0] = bflo(raw[it].x); x[1] = bfhi(raw[it].x); x[2] = bflo(raw[it].y); x[3] = bfhi(raw[it].y);
                x[4] = bflo(raw[it].z); x[5] = bfhi(raw[it].z); x[6] = bflo(raw[it].w); x[7] = bfhi(raw[it].w);
                LAS float* dst;
                if (vv < 16) {
                    dst = F + tt * 128 + 8 * vv;
#pragma unroll
                    for (int e = 0; e < 8; ++e) { const float lb = LB[8 * vv + e]; x[e] = lb + (1.f - lb) * sigmoidf_(x[e]); }
                } else if (vv < 32) dst = Q + tt * 128 + 8 * (vv - 16);
                else dst = Vv + tt * 64 + 8 * (vv - 32);
                *(LAS f32x4*)dst = (f32x4){x[0], x[1], x[2], x[3]}; *(LAS f32x4*)(dst + 4) = (f32x4){x[4], x[5], x[6], x[7]};
            }
        }
        if (ch + 1 < SEQ / 32) HG_LOAD(ch + 1);
        LDS_BAR();
#pragma unroll 1
        for (int g8 = 0; g8 < 4; ++g8) {
            float val[16];
#pragma unroll
            for (int s8 = 0; s8 < 8; ++s8) {
                const int tt = 8 * g8 + s8;
                const f32x4 f_lo = *(const LAS f32x4*)&F[tt * 128 + 8 * dg], f_hi = *(const LAS f32x4*)&F[tt * 128 + 8 * dg + 4];
                const f32x4 q_lo = *(const LAS f32x4*)&Q[tt * 128 + 8 * dg], q_hi = *(const LAS f32x4*)&Q[tt * 128 + 8 * dg + 4];
                const f32x2 vv = *(const LAS f32x2*)&Vv[tt * 64 + v0];
                const f32x2 f2[4] = {{f_lo.x, f_lo.y}, {f_lo.z, f_lo.w}, {f_hi.x, f_hi.y}, {f_hi.z, f_hi.w}};
                const f32x2 q2[4] = {{q_lo.x, q_lo.y}, {q_lo.z, q_lo.w}, {q_hi.x, q_hi.y}, {q_hi.z, q_hi.w}};
                const f32x2 v0v = (f32x2){vv.x, vv.x}, v1v = (f32x2){vv.y, vv.y};
                f32x2 a0 = (f32x2){0.f, 0.f}, a1 = (f32x2){0.f, 0.f};
#pragma unroll
                for (int j = 0; j < 4; ++j) {
                    S0[j] = v0v + f2[j] * (S0[j] - v0v); S1[j] = v1v + f2[j] * (S1[j] - v1v);
                    a0 += q2[j] * S0[j]; a1 += q2[j] * S1[j];
                }
                val[2 * s8] = a0.x + a0.y; val[2 * s8 + 1] = a1.x + a1.y;
            }
            const bool b3 = (dg & 8) != 0, b2 = (dg & 4) != 0, b1 = (dg & 2) != 0, b0 = (dg & 1) != 0;
#pragma unroll
            for (int i = 0; i < 8; ++i) { const float keep = b3 ? val[i + 8] : val[i], send = b3 ? val[i] : val[i + 8]; val[i] = keep + dpp_mov<0x140>(send); }
#pragma unroll
            for (int i = 0; i < 4; ++i) { const float keep = b2 ? val[i + 4] : val[i], send = b2 ? val[i] : val[i + 4]; val[i] = keep + dpp_mov<0x141>(send); }
#pragma unroll
            for (int i = 0; i < 2; ++i) { const float keep = b1 ? val[i + 2] : val[i], send = b1 ? val[i] : val[i + 2]; val[i] = keep + dpp_mov<0x4E>(send); }
            { const float keep = b0 ? val[1] : val[0], send = b0 ? val[0] : val[1]; val[0] = keep + dpp_mov<0xB1>(send); }
            O[(8 * g8 + (dg >> 1)) * 64 + v0 + (dg & 1)] = val[0];
        }
        LDS_BAR();
        if (tid < 256) {
            const int tt = tid >> 3, v8 = (tid & 7) * 8;
            const f32x4 a = *(const LAS f32x4*)&O[tt * 64 + v8], c4 = *(const LAS f32x4*)&O[tt * 64 + v8 + 4];
            u32x4 o; o.x = pk2(a.x, a.y); o.y = pk2(a.z, a.w); o.z = pk2(c4.x, c4.y); o.w = pk2(c4.z, c4.w);
            *(u32x4*)(X.P + ((size_t)b * SEQ + t0 + tt) * LDP + COL_YB + h * 128 + vh * 64 + v8) = o;
        }
    }
#undef HG_LOAD
    __syncthreads();
}

__device__ __forceinline__ unsigned f2ord(float f) { const unsigned u = __builtin_bit_cast(unsigned, f); return (u & 0x80000000u) ? ~u : (u | 0x80000000u); }

__device__ __forceinline__ void dsa_tile(const Ctx& X, LAS unsigned char* lds, int b, int q0) {
    LAS float* sc = (LAS float*)lds;
    LAS unsigned* MASK = (LAS unsigned*)(lds + MASK_OFF);
    const int lane = X.lane, w = X.wave, n = lane & 15, g = lane >> 4;
    const bf16_t* Pb = X.P + (size_t)b * SEQ * LDP;
#pragma unroll 1
    for (int sub = 0; sub < 4; ++sub) {
        const int qs = q0 + 16 * sub;
        {
            bf16x8 bq[4][2]; float wi[4];
            const bf16_t* qrow = Pb + (size_t)(qs + n) * LDP;
#pragma unroll
            for (int hh = 0; hh < 4; ++hh) {
#pragma unroll
                for (int ks = 0; ks < 2; ++ks) bq[hh][ks] = *(const bf16x8*)(qrow + C_QI + hh * 64 + ks * 32 + 8 * g);
                wi[hh] = bf2f(qrow[C_WI + hh]);
            }
            const int nkt = (qs + 16) >> 4;
            bf16x8 a0n = (bf16x8){0, 0, 0, 0, 0, 0, 0, 0}, a1n = a0n;
            if (w < nkt) { const bf16_t* krow = Pb + (size_t)(w * 16 + n) * LDP + C_KI; a0n = *(const bf16x8*)(krow + 8 * g); a1n = *(const bf16x8*)(krow + 32 + 8 * g); }
#pragma unroll 1
            for (int kt = w; kt < nkt; kt += 8) {
                const bf16x8 a0 = a0n, a1 = a1n;
                if (kt + 8 < nkt) { const bf16_t* krow = Pb + (size_t)((kt + 8) * 16 + n) * LDP + C_KI; a0n = *(const bf16x8*)(krow + 8 * g); a1n = *(const bf16x8*)(krow + 32 + 8 * g); }
                f32x4 s = (f32x4){0.f, 0.f, 0.f, 0.f};
#pragma unroll
                for (int hh = 0; hh < 4; ++hh) {
                    f32x4 d = __builtin_amdgcn_mfma_f32_16x16x32_bf16(a0, bq[hh][0], (f32x4){0.f, 0.f, 0.f, 0.f}, 0, 0, 0);
                    d = __builtin_amdgcn_mfma_f32_16x16x32_bf16(a1, bq[hh][1], d, 0, 0, 0);
#pragma unroll
                    for (int r = 0; r < 4; ++r) s[r] += wi[hh] * fmaxf(d[r], 0.f);
                }
                const int t = qs + n;
#pragma unroll
                for (int r = 0; r < 4; ++r) if (kt * 16 + 4 * g + r > t) s[r] = -INFINITY;
                *(LAS f32x4*)&sc[n * SCS + kt * 16 + 4 * g] = s;
            }
        }
        __syncthreads();
#pragma unroll 1
        for (int e = 0; e < 2; ++e) {
            const int qn = 2 * w + e, t = qs + qn;
            LAS unsigned* mrow = MASK + (sub * 16 + qn) * 64;
            if (t < 256) {
#pragma unroll
                for (int j = 0; j < 32; ++j) {
                    const unsigned long long sm = __ballot(j * 64 + lane <= t);
                    if (lane == 0) { mrow[2 * j] = (unsigned)sm; mrow[2 * j + 1] = (unsigned)(sm >> 32); }
                }
            } else {
                const int jn = (t >> 6) + 1;
                unsigned u[32];
#pragma unroll
                for (int j = 0; j < 32; ++j) {
                    u[j] = 0u;
                    if (j < jn) { const int key = j * 64 + lane; const float s = (key <= t) ? sc[qn * SCS + key] : -INFINITY; u[j] = f2ord(s); }
                }
                unsigned prefix = 0u;
#define DSA_BITSEARCH(JN) do { _Pragma("unroll 1") for (int bit = 31; bit >= 0; --bit) { const unsigned cand = prefix | (1u << bit); int c0 = 0, c1 = 0; \
                    _Pragma("unroll") for (int j = 0; j < (JN); j += 2) { c0 += (u[j] >= cand) ? 1 : 0; c1 += (u[j + 1] >= cand) ? 1 : 0; } \
                    const int cnt = (int)wave_sum_fast((float)(c0 + c1)); if (cnt >= 256) prefix = cand; } } while (0)
                if (jn <= 8) DSA_BITSEARCH(8); else if (jn <= 16) DSA_BITSEARCH(16); else if (jn <= 24) DSA_BITSEARCH(24); else DSA_BITSEARCH(32);
#undef DSA_BITSEARCH
                int cg_ = 0;
#pragma unroll
                for (int j = 0; j < 32; ++j) if (j < jn) cg_ += __popcll(__ballot(u[j] > prefix));
                const int need = 256 - cg_;
                int cum = 0;
#pragma unroll
                for (int j = 0; j < 32; ++j) {
                    unsigned long long sm = 0ull;
                    if (j < jn) {
                        const bool eq = (u[j] == prefix);
                        const unsigned long long em = __ballot(eq);
                        const int rank = cum + (int)__builtin_amdgcn_mbcnt_hi((unsigned)(em >> 32), __builtin_amdgcn_mbcnt_lo((unsigned)em, 0u));
                        const bool sel = (u[j] > prefix) || (eq && rank < need);
                        sm = __ballot(sel);
                        cum += __popcll(em);
                    }
                    if (lane == 0) { mrow[2 * j] = (unsigned)sm; mrow[2 * j + 1] = (unsigned)(sm >> 32); }
                }
            }
        }
        __syncthreads();
    }
    const int qq = q0 + 8 * w + (n & 7);
    const LAS unsigned* mq = MASK + (8 * w + (n & 7)) * 64;
    const int nsteps = (q0 + 8 * w + 8 + 31) >> 5;
    const int nblk = (q0 + 64 + 127) >> 7;
    LAS bf16_t* KT = (LAS bf16_t*)lds;
    LAS bf16_t* VTT = (LAS bf16_t*)(lds + 36864);
    const int tid = X.tid;
#pragma unroll 1
    for (int c = 0; c < 2; ++c) {
        bf16x8 bq[2][2];
#pragma unroll
        for (int j = 0; j < 2; ++j)
#pragma unroll
            for (int ks = 0; ks < 2; ++ks) bq[j][ks] = *(const bf16x8*)(Pb + (size_t)qq * LDP + C_Q + (c * 4 + 2 * j + (n >> 3)) * 64 + ks * 32 + 8 * g);
        float lrun[2] = {0.f, 0.f};
        f32x4 oacc[4][2];
#pragma unroll
        for (int mt = 0; mt < 4; ++mt)
#pragma unroll
            for (int j = 0; j < 2; ++j) oacc[mt][j] = (f32x4){0.f, 0.f, 0.f, 0.f};
        const bf16_t* vtb = X.VT + ((size_t)(b * 2 + c) * 64) * SEQ;
        u32x4 gk[2], gv[2];
#define DSA_GLOAD(kblk) do { _Pragma("unroll") for (int it = 0; it < 2; ++it) { const int idx = tid + 512 * it; \
            gk[it] = *(const u32x4*)(Pb + (size_t)((kblk) * 128 + (idx >> 3)) * LDP + C_K + c * 64 + (idx & 7) * 8); \
            gv[it] = *(const u32x4*)(vtb + (size_t)(idx >> 4) * SEQ + (kblk) * 128 + (idx & 15) * 8); } } while (0)
#define DSA_LSTORE(bufi) do { _Pragma("unroll") for (int it = 0; it < 2; ++it) { const int idx = tid + 512 * it; \
            *(LAS u32x4*)(KT + (bufi) * 9216 + (idx >> 3) * 72 + (idx & 7) * 8) = gk[it]; \
            *(LAS u32x4*)(VTT + (bufi) * 8704 + (idx >> 4) * 136 + (idx & 15) * 8) = gv[it]; } } while (0)
        DSA_GLOAD(0);
        LDS_BAR();
        DSA_LSTORE(0);
        LDS_BAR();
#pragma unroll 1
        for (int kb = 0; kb < nblk; ++kb) {
            const int buf = kb & 1;
            if (kb + 1 < nblk) DSA_GLOAD(kb + 1);
            const LAS bf16_t* Kb = KT + buf * 9216; const LAS bf16_t* Vb = VTT + buf * 8704;
#pragma unroll 1
            for (int sl = 0; sl < 4; ++sl) {
                const int sg = kb * 4 + sl;
                if (sg < nsteps) {
                    f32x4 st[2][2];
#pragma unroll
                    for (int tl = 0; tl < 2; ++tl) {
                        const LAS bf16_t* kr = Kb + (32 * sl + 16 * tl + n) * 72;
                        const bf16x8 a0 = *(const LAS bf16x8*)(kr + 8 * g), a1 = *(const LAS bf16x8*)(kr + 32 + 8 * g);
#pragma unroll
                        for (int j = 0; j < 2; ++j) {
                            f32x4 d = __builtin_amdgcn_mfma_f32_16x16x32_bf16(a0, bq[j][0], (f32x4){0.f, 0.f, 0.f, 0.f}, 0, 0, 0);
                            st[tl][j] = __builtin_amdgcn_mfma_f32_16x16x32_bf16(a1, bq[j][1], d, 0, 0, 0);
                        }
                    }
                    bf16x8 av[4];
#pragma unroll
                    for (int mt = 0; mt < 4; ++mt) {
                        const LAS bf16_t* vp = Vb + (mt * 16 + n) * 136 + 32 * sl + 4 * g;
                        const u32x2 lo = *(const LAS u32x2*)vp, hi = *(const LAS u32x2*)(vp + 16);
                        u32x4 t4; t4.x = lo.x; t4.y = lo.y; t4.z = hi.x; t4.w = hi.y;
                        av[mt] = __builtin_bit_cast(bf16x8, t4);
                    }
                    const unsigned mw = mq[sg];
#pragma unroll
                    for (int j = 0; j < 2; ++j) {
                        float p[8], ps = 0.f;
#pragma unroll
                        for (int tl = 0; tl < 2; ++tl)
#pragma unroll
                            for (int r = 0; r < 4; ++r) { const int bit = 16 * tl + 4 * g + r; const float e = __expf(fminf(st[tl][j][r] * 0.125f, 60.f)); p[4 * tl + r] = ((mw >> bit) & 1u) ? e : 0.f; ps += p[4 * tl + r]; }
                        lrun[j] += ps;
                        u32x4 pw; pw.x = pg8::cvt_pk_bf16(p[0], p[1]); pw.y = pg8::cvt_pk_bf16(p[2], p[3]); pw.z = pg8::cvt_pk_bf16(p[4], p[5]); pw.w = pg8::cvt_pk_bf16(p[6], p[7]);
                        const bf16x8 pb = __builtin_bit_cast(bf16x8, pw);
#pragma unroll
                        for (int mt = 0; mt < 4; ++mt) oacc[mt][j] = __builtin_amdgcn_mfma_f32_16x16x32_bf16(av[mt], pb, oacc[mt][j], 0, 0, 0);
                    }
                }
            }
            if (kb + 1 < nblk) DSA_LSTORE(buf ^ 1);
            LDS_BAR();
        }
#pragma unroll
        for (int j = 0; j < 2; ++j) {
            float lt = lrun[j]; lt += __shfl_xor(lt, 16); lt += __shfl_xor(lt, 32);
            const float il = 1.f / lt;
            bf16_t* op = X.P + ((size_t)b * SEQ + qq) * LDP + COL_YC + (c * 4 + 2 * j + (n >> 3)) * 64 + 4 * g;
#pragma unroll
            for (int mt = 0; mt < 4; ++mt) {
                const f32x4 o = oacc[mt][j] * il;
                u32x2 wv; wv.x = pg8::cvt_pk_bf16(o[0], o[1]); wv.y = pg8::cvt_pk_bf16(o[2], o[3]);
                *(u32x2*)(op + mt * 16) = wv;
            }
        }
    }
#undef DSA_GLOAD
#undef DSA_LSTORE
    __syncthreads();
}

__device__ __forceinline__ void phase_mixers(const Ctx& X0, LAS unsigned char* lds, int layer, bool early_gate) {
#pragma unroll 1
    for (int task = X0.bid; task < 128; task += X0.G) {
        Ctx X = X0;
        { int t_ = threadIdx.x; asm volatile("" : "+v"(t_)); X.tid = t_; X.lane = t_ & 63; }
        if (task < 64) { if (TKMASK & 1) rwkv_task(X, lds, layer, task >> 3, task & 7); }
        else { const int k = task - 64; if (TKMASK & 2) hgrn_task(X, lds, layer, k >> 3, (k >> 1) & 3, k & 1); }
    }
    volatile LAS unsigned* tw = (volatile LAS unsigned*)(lds + LDS_BYTES - 128);
    unsigned* ctr = (unsigned*)(X0.ws + WS_BAR + 14336) + 16 * layer;
#pragma unroll 1
    for (;;) {
        Ctx X = X0;
        { int t_ = threadIdx.x; asm volatile("" : "+v"(t_)); X.tid = t_; X.lane = t_ & 63; }
        __syncthreads();
        if (threadIdx.x == 0) tw[0] = __hip_atomic_fetch_add(ctr, 1u, __ATOMIC_RELAXED, __HIP_MEMORY_SCOPE_AGENT);
        __syncthreads();
        const int t = (int)tw[0];
        if (t >= 256) break;
        if (TKMASK & 4) dsa_tile(X, lds, t & 7, 64 * (31 - (t >> 3)));
    }
    if (early_gate && X0.bid >= 128 && X0.G == 256) {
        __syncthreads();
        int t_ = threadIdx.x; asm volatile("" : "+v"(t_));
        pg8::Gemm g{X0.P, X0.Wg, LDP, DM, DM}; pg8::StaticOrder S; S.init(T_TOK, DM, 128, X0.bid - 128);
        pg8::EpiGate E{X0.P, (bf16_t*)X0.out + 1024, 2048}; pg8::gemm_phase<pg8::EpiGate, true>(lds, g, S, E, t_);
    }
}

__device__ __forceinline__ void phase_hgrn_post(const Ctx& X, int layer) {
    const int gw = X.bid * 8 + X.wave, NGW = X.G * 8;
    const float* gn = X.in[15] + layer * 512;
#pragma unroll 1
    for (int it0 = gw; it0 < T_TOK * 4; it0 += 4 * NGW) {
        unsigned ow[4], gwd[4]; unsigned* op[4];
#pragma unroll
        for (int r = 0; r < 4; ++r) {
            const int it = it0 + r * NGW < T_TOK * 4 ? it0 + r * NGW : it0;
            const int t = it >> 2, h = it & 3;
            bf16_t* rowp = X.P + (size_t)t * LDP;
            op[r] = (unsigned*)(rowp + COL_YB + h * 128) + X.lane;
            ow[r] = *op[r]; gwd[r] = *((const unsigned*)(rowp + COL_PB + 1536 + h * 128) + X.lane);
        }
#pragma unroll
        for (int r = 0; r < 4; ++r) {
            const int it = it0 + r * NGW;
            const int h = it & 3;
            const float o0 = bflo(ow[r]), o1 = bfhi(ow[r]), g0 = bflo(gwd[r]), g1 = bfhi(gwd[r]);
            const float rs = 1.f / sqrtf(wave_sum(o0 * o0 + o1 * o1) * (1.f / 128.f) + 1e-6f);
            const float y0 = o0 * rs * gn[h * 128 + 2 * X.lane] * (g0 * sigmoidf_(g0)), y1 = o1 * rs * gn[h * 128 + 2 * X.lane + 1] * (g1 * sigmoidf_(g1));
            if (it < T_TOK * 4) *op[r] = pk2(y0, y1);
        }
    }
}

__device__ __forceinline__ void phase_fixup(const Ctx& X, int layer) {
    const float* cw = X.in[20] + (size_t)layer * 3 * F2; const float* cb = X.in[21] + (size_t)layer * F2;
    for (int idx = X.bid * 512 + X.tid; idx < 256 * 2 * DFF; idx += X.G * 512) {
        const int j = idx % DFF, sr = idx / DFF, s = sr >> 1, r = sr & 1;
        const int colg = (j >> 7) * 256 + (j & 127), colv = colg + 128;
        const bool seq0 = (s & 31) == 0;
        const float* H = X.HALO;
        float res[2];
#pragma unroll
        for (int part = 0; part < 2; ++part) {
            const int cp = part ? colv : colg, co = part * DFF + j;
            const float u0 = H[(size_t)(s * 4 + r) * F2 + cp];
            float u1, u2;
            if (r == 0) { u1 = seq0 ? 0.f : H[(size_t)((s - 1) * 4 + 3) * F2 + cp]; u2 = seq0 ? 0.f : H[(size_t)((s - 1) * 4 + 2) * F2 + cp]; }
            else { u1 = H[(size_t)(s * 4 + 0) * F2 + cp]; u2 = seq0 ? 0.f : H[(size_t)((s - 1) * 4 + 3) * F2 + cp]; }
            res[part] = cb[co] + cw[co] * u2 + cw[F2 + co] * u1 + cw[2 * F2 + co] * u0;
        }
        const float a = res[0] * sigmoidf_(res[0]) * res[1];
        X.P[(size_t)(s * 64 + r) * LDP + COL_ACT + j] = (bf16_t)f2bf(a);
    }
}

#define XB_TMO      128
#define XB_XCNT(j)  (256  + 64 * (j))
#define XB_XSUB(j)  (1280 + 64 * (j))
#define XB_XGEN(j)  (2304 + 64 * (j))
#define XB_TOP      3328
#define XB_TOPGEN   3392
#define XCD_BAR_WORDS 3456
#define XB_SPIN_CAP (1u << 22)
__device__ __forceinline__ unsigned xb_ld(unsigned* p)              { return __hip_atomic_load(p, __ATOMIC_RELAXED, __HIP_MEMORY_SCOPE_AGENT); }
__device__ __forceinline__ unsigned xb_add(unsigned* p, unsigned v) { return __hip_atomic_fetch_add(p, v, __ATOMIC_RELAXED, __HIP_MEMORY_SCOPE_AGENT); }
__device__ __forceinline__ unsigned xb_xcc_id() { return (unsigned)__builtin_amdgcn_s_getreg((3 << 11) | 20) & 0xFu; }
#define XB_SPIN(cond, bar) do { unsigned _sp = 0; while (cond) { __builtin_amdgcn_s_sleep(1); \
    if ((++_sp & 255u) == 0u) { if (xb_ld(&(bar)[XB_TMO])) break; if (_sp > XB_SPIN_CAP) { atomicAdd(&(bar)[XB_TMO], 1u); break; } } } } while (0)
struct XcdBarrier { unsigned* bar; unsigned x; volatile LAS unsigned* st; };
__device__ __forceinline__ XcdBarrier xcd_barrier_post(unsigned* bar, volatile LAS unsigned* st) {
    XcdBarrier b; b.bar = bar; b.x = xb_xcc_id(); b.st = st;
    if (threadIdx.x == 0) (void)xb_add(&bar[XB_XCNT(b.x)], 1u);
    return b;
}
__device__ __forceinline__ void xcd_barrier_complete(unsigned* bar, unsigned x, unsigned& nloc, unsigned& nx) {
    const unsigned G = gridDim.x * gridDim.y * gridDim.z;
    unsigned sum, cnt, mine, sp = 0u;
    for (;;) {
        sum = 0u; cnt = 0u; mine = 0u;
#pragma unroll
        for (unsigned j = 0; j < 16; ++j) { const unsigned c = xb_ld(&bar[XB_XCNT(j)]); sum += c; cnt += (c > 0u) ? 1u : 0u; mine = (j == x) ? c : mine; }
        if (sum == G) break;
        __builtin_amdgcn_s_sleep(1);
        if ((++sp & 255u) == 0u) { if (xb_ld(&bar[XB_TMO])) break; if (sp > XB_SPIN_CAP) { atomicAdd(&bar[XB_TMO], 1u); break; } }
    }
    nloc = mine > 0u ? mine : 1u; nx = cnt > 0u ? cnt : 1u;
}
__device__ __forceinline__ void xcd_barrier(const XcdBarrier& b) {
    asm volatile("s_waitcnt vmcnt(0)" ::: "memory");
    __syncthreads();
    if (threadIdx.x == 0) {
        unsigned* bar = b.bar;
        __builtin_amdgcn_s_waitcnt(0);
        unsigned nloc = b.st[0], nx = b.st[1];
        if (nloc == 0u) { xcd_barrier_complete(bar, b.x, nloc, nx); b.st[0] = nloc; b.st[1] = nx; }
        const unsigned old = xb_add(&bar[XB_XSUB(b.x)], 1u);
        const unsigned gen = old / nloc;
        if (old + 1u == (gen + 1u) * nloc) {
            __builtin_amdgcn_fence(__ATOMIC_RELEASE, "agent");
            asm volatile("s_waitcnt vmcnt(0)" ::: "memory");
            const unsigned og = xb_add(&bar[XB_TOP], 1u);
            const unsigned tg = og / nx;
            if (og + 1u == (tg + 1u) * nx) xb_add(&bar[XB_TOPGEN], 1u);
            else XB_SPIN(xb_ld(&bar[XB_TOPGEN]) == tg, bar);
            __builtin_amdgcn_fence(__ATOMIC_ACQUIRE, "agent");
            xb_add(&bar[XB_XGEN(b.x)], 1u);
            asm volatile("s_waitcnt vmcnt(0)" ::: "memory");
        } else {
            XB_SPIN(xb_ld(&bar[XB_XGEN(b.x)]) == gen, bar);
            __builtin_amdgcn_fence(__ATOMIC_ACQUIRE, "agent");
            asm volatile("s_waitcnt vmcnt(0)" ::: "memory");
        }
    }
    __syncthreads();
}

__global__ void __launch_bounds__(512, 2) mk_fwd(Args args) {
    extern __shared__ __attribute__((aligned(16))) unsigned char lds_raw[];
    LAS unsigned char* lds = (LAS unsigned char*)lds_raw;
    Ctx X;
#pragma unroll
    for (int i = 0; i < 24; ++i) X.in[i] = args.in[i];
    X.out = args.out; X.ws = args.ws;
    X.P = (bf16_t*)(args.ws + WS_P); X.VT = (bf16_t*)(args.ws + WS_VT); X.HALO = (float*)(args.ws + WS_HALO); X.ROPE = (float*)(args.ws + WS_ROPE);
    X.Win = (bf16_t*)(args.ws + WS_WIN); X.Wg = (bf16_t*)(args.ws + WS_WG); X.Wbr = (bf16_t*)(args.ws + WS_WBR);
    X.Wo = (bf16_t*)(args.ws + WS_WO); X.Wup = (bf16_t*)(args.ws + WS_WUP); X.Wdn = (bf16_t*)(args.ws + WS_WDN);
    X.tid = threadIdx.x; X.lane = X.tid & 63; X.wave = __builtin_amdgcn_readfirstlane(X.tid >> 6); X.G = gridDim.x; X.bid = blockIdx.x;

#if PROBE_DOUBLE
    for (int ph2 = args.ph_lo * 2; ph2 < args.ph_hi * 2; ++ph2) {
        const int ph = ph2 >> 1;
        const int layer = ph / 11, sub = ph % 11;
        const bool skip_ = (ph2 & 1) && !(ph < 22 && ((REPMASK >> sub) & 1));
#else
    volatile LAS unsigned* bst = (volatile LAS unsigned*)(lds + LDS_BYTES - 64);
    if (threadIdx.x < 2) bst[threadIdx.x] = 0u;
    __syncthreads();
    XcdBarrier gbar = xcd_barrier_post((unsigned*)(args.ws + WS_BAR), bst);
    for (int ph = args.ph_lo; ph < args.ph_hi; ++ph) {
        const int layer = ph / 11, sub = ph % 11;
        const bool skip_ = false;
#endif
        const bool fusedn = (X.G == 256) && (args.ph_hi - args.ph_lo > 1);
        if (fusedn && (ph == 22 || sub == 7 || ph == 11)) continue;
        { int t_ = threadIdx.x; asm volatile("" : "+v"(t_)); X.tid = t_; X.lane = t_ & 63; }

        if (skip_) {
        } else if (ph == 22 && (PHMASK & 1024)) {
            const int gw = X.bid * 8 + X.wave, NGW = X.G * 8;
            (void)gw; (void)NGW; rms_pass(X, X.out, X.in[23], nullptr, X.out);
        } else if (sub == 0 && (PHMASK & 1)) {
        } else if (sub == 1 && (PHMASK & 2)) {
            pg8::Gemm g{X.P, X.Win, LDP, DM, DM}; pg8::StaticOrder S; S.init(T_TOK, 5120, X.G, X.bid);
            pg8::EpiInProj E{X.P, X.VT, X.ROPE, (bf16_t*)(X.ws + WS_BND)};
            pg8::gemm_phase<pg8::EpiInProj, true>(lds, g, S, E, X.tid);
        } else if (sub == 2 && (PHMASK & 4)) {
            phase_rwkv_pre(X, lds, layer);
        } else if (sub == 3 && (PHMASK & 4)) {
            phase_mixers(X, lds, layer, layer == 0 && fusedn);
        } else if (sub == 4 && (PHMASK & 8)) {
            phase_hgrn_post(X, layer);
            { const int gw = X.bid * 8 + X.wave, NGW = X.G * 8; const float* hh = (layer == 0) ? X.in[0] : X.out; const float* g = X.in[1] + (size_t)layer * DM;
              (void)gw; (void)NGW; if (layer > 0) rms_pass(X, hh, g, X.P, nullptr); }
        } else if (sub == 5 && (PHMASK & 16)) {
#pragma unroll 1
            for (int br = 0; br < 3; ++br) {
                const bool early_g = (layer == 0 && br == 0 && fusedn);
                bf16_t* Gb_ = early_g ? (bf16_t*)X.out + 1024 : X.P + COL_G; const int Gs_ = early_g ? 2048 : LDP;
                if (!early_g) { pg8::Gemm g{X.P, X.Wg + (size_t)br * DM * DM, LDP, DM, DM}; pg8::StaticOrder S; S.init(T_TOK, DM, X.G, X.bid);
                  int t_ = X.tid; asm volatile("" : "+v"(t_));
                  pg8::EpiGate E{X.P, Gb_, Gs_}; pg8::gemm_phase<pg8::EpiGate, true>(lds, g, S, E, t_); }
                { const int ycol = br == 0 ? COL_YA : (br == 1 ? COL_YB : COL_YC);
                  pg8::Gemm g{X.P + ycol, X.Wbr + (size_t)br * DM * 512, LDP, 512, 512}; pg8::StaticOrder S; S.init(T_TOK, DM, X.G, X.bid);
                  int t_ = X.tid; asm volatile("" : "+v"(t_));
                  pg8::EpiMergeAcc E{X.P, br == 0 ? 1 : 0, Gb_, Gs_}; pg8::gemm_phase<pg8::EpiMergeAcc, true>(lds, g, S, E, t_); }
            }
        } else if (sub == 6 && (PHMASK & 32)) {
            pg8::Gemm g{X.P + COL_MRG, X.Wo, LDP, DM, DM}; pg8::StaticOrder S; S.init(T_TOK, DM, X.G, X.bid);
            if (fusedn) {
                pg8::EpiResidNorm E{layer == 0 ? X.in[0] : X.out, X.out, X.in[18] + (size_t)layer * DM, X.P, nullptr,
                                    (unsigned*)(X.ws + WS_XB) + (size_t)(layer * 2) * 65536, (unsigned*)(X.ws + WS_XC) + (layer * 2) * 4096};
                pg8::gemm_phase<pg8::EpiResidNorm, false>(lds, g, S, E, X.tid);
            } else {
            pg8::EpiResid E{layer == 0 ? X.in[0] : X.out, X.out};
            pg8::gemm_phase<pg8::EpiResid, true>(lds, g, S, E, X.tid);
            }
        } else if (sub == 7 && (PHMASK & 64)) {
            const int gw = X.bid * 8 + X.wave, NGW = X.G * 8;
            const float* g = X.in[18] + (size_t)layer * DM;
            (void)gw; (void)NGW; rms_pass(X, X.out, g, X.P, nullptr);
        } else if (sub == 8 && (PHMASK & 128)) {
            pg8::Gemm g{X.P, X.Wup, LDP, DM, DM}; pg8::StaticOrder S; S.init(T_TOK, F2, X.G, X.bid);
            pg8::EpiUp E{X.P, X.HALO, X.in[20] + (size_t)layer * 3 * F2, X.in[21] + (size_t)layer * F2, (LAS float*)(lds + 131072)};
            pg8::gemm_phase<pg8::EpiUp, true>(lds, g, S, E, X.tid);
        } else if (sub == 9 && (PHMASK & 256)) {
            phase_fixup(X, layer);
        } else if (sub == 10 && (PHMASK & 512)) {
            pg8::Gemm g{X.P + COL_ACT, X.Wdn, LDP, DFF, DFF}; pg8::StaticOrder S; S.init(T_TOK, DM, X.G, X.bid);
            if (fusedn) {
                const bool last = (layer == 1);
                pg8::EpiResidNorm E{X.out, last ? nullptr : X.out, last ? X.in[23] : X.in[1] + (size_t)DM, last ? nullptr : X.P, last ? X.out : nullptr,
                                    (unsigned*)(X.ws + WS_XB) + (size_t)(layer * 2 + 1) * 65536, (unsigned*)(X.ws + WS_XC) + (layer * 2 + 1) * 4096};
                pg8::gemm_phase<pg8::EpiResidNorm, false>(lds, g, S, E, X.tid);
            } else {
            pg8::EpiResid E{X.out, X.out};
            pg8::gemm_phase<pg8::EpiResid, true>(lds, g, S, E, X.tid);
            }
        }
        {
        int pr_layer = -1, pr_lo = 0, pr_hi = 0, pr_gw = 0, pr_ngw = 1; bool pr_u = false;
        if (sub == 0 && ph < 22) { pr_layer = layer; pr_lo = (fusedn && layer > 0) ? NEARLY : 0; pr_hi = (fusedn && layer == 0) ? I_IN + I_G : NITEMS;     pr_u = !(fusedn && layer > 0); pr_gw = X.bid * 8 + X.wave; pr_ngw = X.G * 8; }
        if (sub == 8 && layer == 0 && fusedn && X.bid >= 128) { pr_layer = 1; pr_lo = 0; pr_hi = NEARLY; pr_u = false; pr_gw = (X.bid - 128) * 8 + X.wave; pr_ngw = 128 * 8; }
        if (sub == 3 && layer == 0 && fusedn && X.bid >= 128) { pr_layer = 0; pr_lo = I_IN + I_G; pr_hi = NITEMS; pr_u = false; pr_gw = (X.bid - 128) * 8 + X.wave; pr_ngw = 128 * 8; }
        if (sub == 3 && layer == 1 && fusedn && X.bid >= 128) { pr_layer = 1; pr_lo = NEARLY; pr_hi = NITEMS; pr_u = false; pr_gw = (X.bid - 128) * 8 + X.wave; pr_ngw = 128 * 8; }
        if (pr_layer >= 0) { { int t_ = threadIdx.x; asm volatile("" : "+v"(t_)); X.tid = t_; X.lane = t_ & 63; } phase_prep(X, lds, pr_layer, pr_u, pr_lo, pr_hi, pr_gw, pr_ngw); }
        }
#if PROBE_DOUBLE
        if (ph2 + 1 < args.ph_hi * 2) cg::this_grid().sync();
#else
        if (ph + 1 < args.ph_hi && !(fusedn && ph == 21)) { if (args.ph_hi > 1000) cg::this_grid().sync(); else xcd_barrier(gbar); }
#endif
    }
}

extern "C" void kernel_launch(void* const* d_in, const int* in_sizes, int n_in, void* d_out, int out_size, void* d_ws, size_t ws_size, hipStream_t stream) {
    static int grid = 0;
    if (grid == 0) {
        int dev = 0, cus = 0, per_cu = 0;
        (void)hipGetDevice(&dev);
        (void)hipDeviceGetAttribute(&cus, hipDeviceAttributeMultiprocessorCount, dev);
        if (hipFuncSetAttribute((const void*)mk_fwd, hipFuncAttributeMaxDynamicSharedMemorySize, LDS_BYTES) != hipSuccess) fprintf(stderr, "kernel_launch: hipFuncSetAttribute failed\n");
        if (hipOccupancyMaxActiveBlocksPerMultiprocessor(&per_cu, (const void*)mk_fwd, 512, LDS_BYTES) != hipSuccess || per_cu < 1) { fprintf(stderr, "kernel_launch: occupancy query gave %d\n", per_cu); per_cu = 1; }
        (void)hipGetLastError();
        grid = cus * 1;
        if (grid <= 0) grid = 256;
        if (ws_size < (size_t)268435456) fprintf(stderr, "kernel_launch: workspace too small (%zu)\n", ws_size);
    }
    Args a{};
    for (int i = 0; i < 24; ++i) a.in[i] = (const float*)d_in[i];
    a.out = (float*)d_out; a.ws = (unsigned char*)d_ws;
#if MK_SINGLE
    (void)hipMemsetAsync((char*)d_ws + WS_BAR, 0, 16384 + 65536, stream);
    a.ph_lo = 0; a.ph_hi = 23;
    void* kargs[] = {&a};
    hipError_t e = hipLaunchCooperativeKernel((const void*)mk_fwd, dim3(grid), dim3(512), kargs, LDS_BYTES, stream);
    if (e != hipSuccess) fprintf(stderr, "cooperative launch failed: %s (grid %d)\n", hipGetErrorString(e), grid);
#else
    for (int ph = 0; ph < 23; ++ph) {
        a.ph_lo = ph; a.ph_hi = ph + 1;
        hipLaunchKernelGGL(mk_fwd, dim3(grid), dim3(512), LDS_BYTES, stream, a);
    }
#endif
}
```
